# Optimizing an MI355X kernel written in HIP

```python
import jax
import jax.numpy as jnp
from jax import lax
import numpy as np


D_MODEL = 1024
BATCH = 2
SEQ = 8192
DEPTH = 2

GRID_W = 64
CTX_LEN = 256
NORM_EPS = 1e-6
N_MOD = 6

MLA_HEADS = 8
MLA_NOPE = 64
MLA_ROPE = 32
MLA_V = 64
MLA_Q_LORA = 384
MLA_KV_LORA = 256
ROPE_THETA = 10000.0
Q_BLOCK = 128

ML_HEADS = 4
ML_QK = 32
ML_V = 64
ML_CHUNK = 64

RW_HEADS = 4
RW_N = 64
RW_W_LORA = 64
RW_A_LORA = 64
RW_G_LORA = 128
RW_LN_EPS = 64e-5

N_EXPERTS = 64
TOP_K = 8
N_GROUPS = 8
TOPK_GROUPS = 4
D_EXPERT = 256
D_SHARED = 256
ROUTED_SCALE = 2.5
MOE_BLOCK = 128

MLA_WIDTH = MLA_HEADS * MLA_V
ML_WIDTH = ML_HEADS * ML_V
RW_WIDTH = RW_HEADS * RW_N
N_BRANCHES = 3

MLA_IN = MLA_Q_LORA + MLA_KV_LORA + MLA_ROPE
ML_IN = 2 * ML_HEADS * ML_QK + 2 * ML_WIDTH + 4 * ML_HEADS
RW_IN = 3 * RW_WIDTH + 2 * RW_W_LORA + 2 * RW_A_LORA + RW_G_LORA
GATE_IN = N_BRANCHES * D_MODEL
D_IN = MLA_IN + ML_IN + RW_IN + GATE_IN
IN_SPLIT_IDX = (MLA_IN, MLA_IN + ML_IN, MLA_IN + ML_IN + RW_IN)
MLA_SPLIT_IDX = (MLA_Q_LORA, MLA_Q_LORA + MLA_KV_LORA)
ML_SPLIT_IDX = (ML_HEADS * ML_QK, 2 * ML_HEADS * ML_QK, 2 * ML_HEADS * ML_QK + ML_WIDTH,
                2 * ML_HEADS * ML_QK + 2 * ML_WIDTH, 2 * ML_HEADS * ML_QK + 2 * ML_WIDTH + 2 * ML_HEADS)
RW_SPLIT_IDX = (RW_WIDTH, 2 * RW_WIDTH, 3 * RW_WIDTH, 3 * RW_WIDTH + 2 * RW_W_LORA,
                3 * RW_WIDTH + 2 * RW_W_LORA + 2 * RW_A_LORA)

kernel_name = 'hybrid_mla_mlstm_rwkv7_moe_dit'


def rmsnorm(x, g):
    xf = x.astype(jnp.float32)
    y = xf * lax.rsqrt(jnp.mean(xf * xf, axis=-1, keepdims=True) + NORM_EPS)
    return (y * g.astype(jnp.float32)).astype(x.dtype)


def modulate(h, shift, scale):
    return h * (1 + scale) + shift


def flip_time(ts, axis):
    return tuple(jnp.flip(t, axis) for t in ts)


def swiglu(h, w_gate, w_up, w_down):
    return (jax.nn.silu(h @ w_gate) * (h @ w_up)) @ w_down


def axial_rope_tables(n_tokens):
    rows = n_tokens // GRID_W
    row, col = jnp.meshgrid(jnp.arange(rows, dtype=jnp.float32),
                            jnp.arange(GRID_W, dtype=jnp.float32), indexing='ij')
    half = MLA_ROPE // 2
    inv_freq = ROPE_THETA ** (-jnp.arange(0, half, 2, dtype=jnp.float32) / half)
    ang = jnp.concatenate([row.reshape(-1, 1) * inv_freq, col.reshape(-1, 1) * inv_freq], axis=-1)
    return jnp.cos(ang), jnp.sin(ang)


def apply_axial_rope(x, cos, sin):
    B, T, H, R = x.shape
    f = R // 4
    xs = x.reshape(B, T, H, 2, 2, f)
    x1, x2 = xs[..., 0, :], xs[..., 1, :]
    cs = cos.reshape(T, 1, 2, f).astype(x.dtype)
    sn = sin.reshape(T, 1, 2, f).astype(x.dtype)
    return jnp.stack([x1 * cs - x2 * sn, x1 * sn + x2 * cs], axis=-2).reshape(B, T, H, R)


def mla_qkv(z, g_cq, w_uq, g_ckv, w_uk, w_uv, rope):
    B, T, _ = z.shape
    c_q, c_kv, k_rope = jnp.split(z, MLA_SPLIT_IDX, axis=-1)
    q = (rmsnorm(c_q, g_cq) @ w_uq).reshape(B, T, MLA_HEADS, MLA_NOPE + MLA_ROPE)
    c_kv = rmsnorm(c_kv, g_ckv)
    k_nope = (c_kv @ w_uk).reshape(B, T, MLA_HEADS, MLA_NOPE)
    v = (c_kv @ w_uv).reshape(B, T, MLA_HEADS, MLA_V)
    q_nope, q_rope = q[..., :MLA_NOPE], q[..., MLA_NOPE:]
    k_rope = k_rope[:, :, None, :]
    if rope is not None:
        cos, sin = rope
        q_rope = apply_axial_rope(q_rope, cos, sin)
        k_rope = apply_axial_rope(k_rope, cos, sin)
    q = jnp.concatenate([q_nope, q_rope], axis=-1)
    k = jnp.concatenate([k_nope, jnp.broadcast_to(k_rope, (B, T, MLA_HEADS, MLA_ROPE))], axis=-1)
    return q, k, v


def attend(q, k, v):
    s = jnp.einsum('bqhd,bkhd->bhqk', q, k).astype(jnp.float32) * (MLA_NOPE + MLA_ROPE) ** -0.5
    p = jax.nn.softmax(s, axis=-1).astype(v.dtype)
    return jnp.einsum('bhqk,bkhd->bqhd', p, v)


def blocked_attend(q, k, v):
    B, T, H, dk = q.shape
    qb = q.reshape(B, T // Q_BLOCK, Q_BLOCK, H, dk).swapaxes(0, 1)
    ob = lax.map(lambda qi: attend(qi, k, v), qb)
    return ob.swapaxes(0, 1).reshape(B, T, H, -1)


def mlstm_chunkwise(q, k, v, i_pre, f_pre, state):
    B, H, T, _ = q.shape
    L = ML_CHUNK
    nc = T // L

    def chunk(t):
        return jnp.moveaxis(t.reshape((B, H, nc, L) + t.shape[3:]), 2, 0)

    xs = tuple(chunk(t) for t in (q, k, v, i_pre, f_pre))
    tril = jnp.tril(jnp.ones((L, L), dtype=bool))

    def step(carry, inp):
        C, n, m = carry
        qc, kc, vc, ic, fc = inp
        b = jnp.cumsum(jax.nn.log_sigmoid(fc), axis=-1)
        dlog = jnp.where(tril, b[..., :, None] - b[..., None, :] + ic[..., None, :], -jnp.inf)
        g = b + m[..., None]
        mj = jnp.maximum(g, dlog.max(-1))
        s = jnp.exp(dlog - mj[..., None]) * jnp.einsum('bhjd,bhsd->bhjs', qc, kc)
        inter = jnp.exp(g - mj)
        num = jnp.einsum('bhjs,bhsv->bhjv', s, vc) + inter[..., None] * jnp.einsum('bhvd,bhjd->bhjv', C, qc)
        den = s.sum(-1) + inter * jnp.einsum('bhd,bhjd->bhj', n, qc)
        h = num / jnp.maximum(jnp.abs(den), jnp.exp(-mj))[..., None]
        b_last = b[..., -1]
        lw = b_last[..., None] - b + ic
        m_new = jnp.maximum(b_last + m, lw.max(-1))
        carry_w = jnp.exp(b_last + m - m_new)
        we = jnp.exp(lw - m_new[..., None])
        C_new = carry_w[..., None, None] * C + jnp.einsum('bhs,bhsv,bhsd->bhvd', we, vc, kc)
        n_new = carry_w[..., None] * n + jnp.einsum('bhs,bhsd->bhd', we, kc)
        return (C_new, n_new, m_new), h

    state, h = lax.scan(step, state, xs)
    return jnp.moveaxis(h, 0, 2).reshape(B, H, T, -1), state


def mlstm_inputs(cols, b_i, b_f, d):
    q, k, v, o, i, f = cols
    B, T, _ = q.shape

    def heads(t, dh):
        return t.reshape(B, T, ML_HEADS, dh).transpose(0, 2, 1, 3).astype(jnp.float32)

    sl = slice(d * ML_HEADS, (d + 1) * ML_HEADS)
    i_pre = (i[..., sl] + b_i[d]).astype(jnp.float32).transpose(0, 2, 1)
    f_pre = (f[..., sl] + b_f[d]).astype(jnp.float32).transpose(0, 2, 1)
    return heads(q, ML_QK) * ML_QK ** -0.5, heads(k, ML_QK), heads(v, ML_V), i_pre, f_pre


def mlstm_out(h, o, g_norm):
    B, H, T, V = h.shape
    hn = rmsnorm(jnp.swapaxes(h, 1, 2), g_norm.reshape(H, V))
    return hn.reshape(B, T, H * V) * jax.nn.sigmoid(o.astype(jnp.float32))


def mlstm_mixer(zx, zc, b_i, b_f, g_norm, with_ctx):
    cols_x = jnp.split(zx, ML_SPLIT_IDX, axis=-1)
    cols_c = jnp.split(zc, ML_SPLIT_IDX, axis=-1)
    B = zx.shape[0]
    state0 = (jnp.zeros((B, ML_HEADS, ML_V, ML_QK), jnp.float32),
              jnp.zeros((B, ML_HEADS, ML_QK), jnp.float32),
              jnp.zeros((B, ML_HEADS), jnp.float32))
    hs_x, hs_c = [], []
    for d in range(2):
        in_x = mlstm_inputs(cols_x, b_i, b_f, d)
        in_c = mlstm_inputs(cols_c, b_i, b_f, d)
        if d == 1:
            in_x, in_c = flip_time(in_x, 2), flip_time(in_c, 2)
        h_c, state_ctx = mlstm_chunkwise(*in_c, state0)
        h_x, _ = mlstm_chunkwise(*in_x, state_ctx)
        if d == 1:
            h_x, h_c = jnp.flip(h_x, 2), jnp.flip(h_c, 2)
        hs_x.append(h_x)
        hs_c.append(h_c)
    out_x = mlstm_out(hs_x[0] + hs_x[1], cols_x[3], g_norm)
    if not with_ctx:
        return out_x, None
    return out_x, mlstm_out(hs_c[0] + hs_c[1], cols_c[3], g_norm)


def centred_shift(z, mu):
    zp = jnp.pad(z, ((0, 0), (1, 1), (0, 0)))
    return z + (0.5 * (zp[:, :-2] + zp[:, 2:]) - z) * mu


def rwkv7_scan(r, decay, k, v, kk, a, s0):
    def step(s, inp):
        r_t, w_t, k_t, v_t, kk_t, a_t = inp
        sa = jnp.einsum('bhij,bhj->bhi', s, -kk_t)
        s = (s * w_t[..., None, :] + sa[..., :, None] * (kk_t * a_t)[..., None, :]
             + v_t[..., :, None] * k_t[..., None, :])
        return s, jnp.einsum('bhij,bhj->bhi', s, r_t)

    xs = tuple(jnp.moveaxis(t, 1, 0) for t in (r, decay, k, v, kk, a))
    s, ys = lax.scan(step, s0, xs)
    return jnp.moveaxis(ys, 0, 1), s


def rwkv_direction(parts, d, w0, w2, a0, a2, k_a):
    r, k, v, wl, al, kk = parts
    B, T, _ = r.shape

    def heads(t):
        return t.reshape(B, T, RW_HEADS, RW_N)

    wl_d = wl[..., d * RW_W_LORA:(d + 1) * RW_W_LORA]
    al_d = al[..., d * RW_A_LORA:(d + 1) * RW_A_LORA]
    w = -jax.nn.softplus(-(w0[d] + jnp.tanh(wl_d) @ w2[d])) - 0.5
    decay = jnp.exp(-jnp.exp(w))
    a = jax.nn.sigmoid(a0[d] + al_d @ a2[d])
    kd = k * (1 + (a - 1) * k_a)
    return heads(r), heads(decay), heads(kd), heads(v), kk, heads(a)


def rwkv_bonus(inp, r_k):
    r, _, k, v, _, _ = inp
    return jnp.sum(r * k * r_k, axis=-1, keepdims=True) * v


def rwkv_out(y, bonus, gl, g2, lnx_w, lnx_b):
    B, T, H, N = y.shape
    mean = jnp.mean(y, axis=-1, keepdims=True)
    var = jnp.mean(jnp.square(y - mean), axis=-1, keepdims=True)
    yn = (y - mean) * lax.rsqrt(var + RW_LN_EPS) * lnx_w.reshape(H, N) + lnx_b.reshape(H, N)
    g = jax.nn.sigmoid(gl) @ g2
    return (yn + bonus).reshape(B, T, H * N) * g


def rwkv_mixer(zx, zc, mu, w0, w2, a0, a2, g2, k_k, k_a, r_k, lnx_w, lnx_b, with_ctx):
    def prep(z):
        B, T, _ = z.shape
        r, k, v, wl, al, gl = jnp.split(centred_shift(z, mu).astype(jnp.float32), RW_SPLIT_IDX, axis=-1)
        kk = (k * k_k).reshape(B, T, RW_HEADS, RW_N)
        kk = kk / jnp.maximum(jnp.linalg.norm(kk, axis=-1, keepdims=True), 1e-12)
        return (r, k, v, wl, al, kk), gl

    parts_x, gl_x = prep(zx)
    parts_c, gl_c = prep(zc)
    s_init = jnp.zeros((zx.shape[0], RW_HEADS, RW_N, RW_N), jnp.float32)
    ys_x, ys_c, bs_x, bs_c = [], [], [], []
    for d in range(2):
        in_x = rwkv_direction(parts_x, d, w0, w2, a0, a2, k_a)
        in_c = rwkv_direction(parts_c, d, w0, w2, a0, a2, k_a)
        bs_x.append(rwkv_bonus(in_x, r_k))
        if with_ctx:
            bs_c.append(rwkv_bonus(in_c, r_k))
        if d == 1:
            in_x, in_c = flip_time(in_x, 1), flip_time(in_c, 1)
        y_c, s_ctx = rwkv7_scan(*in_c, s_init)
        y_x, _ = rwkv7_scan(*in_x, s_ctx)
        if d == 1:
            y_x, y_c = jnp.flip(y_x, 1), jnp.flip(y_c, 1)
        ys_x.append(y_x)
        ys_c.append(y_c)
    out_x = rwkv_out(ys_x[0] + ys_x[1], bs_x[0] + bs_x[1], gl_x, g2, lnx_w, lnx_b)
    if not with_ctx:
        return out_x, None
    return out_x, rwkv_out(ys_c[0] + ys_c[1], bs_c[0] + bs_c[1], gl_c, g2, lnx_w, lnx_b)


def merge_branches(gate_cols, branches, w_brs, w_out):
    B, T, _ = gate_cols.shape
    g = jax.nn.sigmoid(gate_cols.astype(jnp.float32)).reshape(B, T, N_BRANCHES, D_MODEL)
    y = g[:, :, 0] * (branches[0] @ w_brs[0])
    for i in range(1, N_BRANCHES):
        y = y + g[:, :, i] * (branches[i] @ w_brs[i])
    return y @ w_out


def hybrid_mixer(hx, hc, rope, w_in, g_cq, w_uq, g_ckv, w_uk, w_uv,
                 ml_b_i, ml_b_f, ml_g_norm,
                 rw_mu, rw_w0, rw_w2, rw_a0, rw_a2, rw_g2, rw_k_k, rw_k_a, rw_r_k, rw_lnx_w, rw_lnx_b,
                 w_br_mla, w_br_ml, w_br_rw, w_out, with_ctx):
    B, T, _ = hx.shape
    mla_x, ml_x, rw_x, gate_x = jnp.split(hx @ w_in, IN_SPLIT_IDX, axis=-1)
    mla_c, ml_c, rw_c, gate_c = jnp.split(hc @ w_in, IN_SPLIT_IDX, axis=-1)
    q_x, k_x, v_x = mla_qkv(mla_x, g_cq, w_uq, g_ckv, w_uk, w_uv, rope)
    q_c, k_c, v_c = mla_qkv(mla_c, g_cq, w_uq, g_ckv, w_uk, w_uv, None)
    att_x = blocked_attend(q_x, jnp.concatenate([k_c, k_x], axis=1),
                           jnp.concatenate([v_c, v_x], axis=1)).reshape(B, T, MLA_WIDTH)
    ml_out_x, ml_out_c = mlstm_mixer(ml_x, ml_c, ml_b_i, ml_b_f, ml_g_norm, with_ctx)
    rw_out_x, rw_out_c = rwkv_mixer(rw_x, rw_c, rw_mu, rw_w0, rw_w2, rw_a0, rw_a2, rw_g2,
                                    rw_k_k, rw_k_a, rw_r_k, rw_lnx_w, rw_lnx_b, with_ctx)
    w_brs = (w_br_mla, w_br_ml, w_br_rw)
    y_x = merge_branches(gate_x, (att_x, ml_out_x, rw_out_x), w_brs, w_out)
    if not with_ctx:
        return y_x, None
    att_c = attend(q_c, k_c, v_c).reshape(B, q_c.shape[1], MLA_WIDTH)
    y_c = merge_branches(gate_c, (att_c, ml_out_c, rw_out_c), w_brs, w_out)
    return y_x, y_c


def routed_experts(xf, eidx, wts, w_g, w_u, w_d):
    N, D = xf.shape
    A = N * TOP_K
    flat_e = eidx.reshape(-1)
    order = jnp.argsort(flat_e)
    sorted_e = flat_e[order]
    tok = order // TOP_K
    counts = jnp.bincount(flat_e, length=N_EXPERTS)
    padded = (counts + MOE_BLOCK - 1) // MOE_BLOCK * MOE_BLOCK
    pad_end = jnp.cumsum(padded)
    pad_start = pad_end - padded
    start = jnp.cumsum(counts) - counts
    dest = pad_start[sorted_e] + jnp.arange(A) - start[sorted_e]
    n_blocks = -(-(A + N_EXPERTS * (MOE_BLOCK - 1)) // MOE_BLOCK)
    buf = jnp.zeros((n_blocks * MOE_BLOCK, D), xf.dtype).at[dest].set(xf[tok])
    block_e = jnp.minimum(jnp.searchsorted(pad_end, jnp.arange(n_blocks) * MOE_BLOCK, side='right'),
                          N_EXPERTS - 1)

    def expert_block(args):
        xb, e = args
        return swiglu(xb, w_g[e], w_u[e], w_d[e])

    yb = lax.map(expert_block, (buf.reshape(n_blocks, MOE_BLOCK, D), block_e))
    y = yb.reshape(-1, D)[dest]
    y = y * wts.reshape(-1)[order][:, None].astype(y.dtype)
    return jnp.zeros((N, D), y.dtype).at[tok].add(y)


def moe_ffn(xf, w_router, router_bias, w_e_gate, w_e_up, w_e_down, w_s_gate, w_s_up, w_s_down):
    N = xf.shape[0]
    scores = jax.nn.sigmoid((xf @ w_router).astype(jnp.float32))
    biased = scores + router_bias
    group_score = lax.top_k(biased.reshape(N, N_GROUPS, N_EXPERTS // N_GROUPS), 2)[0].sum(-1)
    _, gidx = lax.top_k(group_score, TOPK_GROUPS)
    gmask = jnp.any(gidx[..., None] == jnp.arange(N_GROUPS), axis=1)
    masked = jnp.where(jnp.repeat(gmask, N_EXPERTS // N_GROUPS, axis=1), biased, -jnp.inf)
    _, eidx = lax.top_k(masked, TOP_K)
    wts = jnp.take_along_axis(scores, eidx, axis=1)
    wts = wts / (wts.sum(-1, keepdims=True) + 1e-20) * ROUTED_SCALE
    routed = routed_experts(xf, eidx, wts, w_e_gate, w_e_up, w_e_down)
    return routed + swiglu(xf, w_s_gate, w_s_up, w_s_down)


def setup_inputs(seed: int = 0) -> dict:
    key = jax.random.key(seed)
    keys = iter(jax.random.split(key, 48))
    L = DEPTH
    f32 = jnp.float32

    def nrm(shape, scale):
        return jax.random.normal(next(keys), shape, f32) * scale

    def gain(shape):
        return 1.0 + nrm(shape, 0.02)

    def unif(shape, lo, hi):
        return jax.random.uniform(next(keys), shape, f32, lo, hi)

    return {
        'x': nrm((BATCH, SEQ, D_MODEL), 1.0),
        'c': nrm((BATCH, D_MODEL), 1.0),
        'ctx': nrm((BATCH, CTX_LEN, D_MODEL), 1.0),
        'c_ctx': nrm((D_MODEL,), 1.0),
        'w_mod': nrm((L, D_MODEL, N_MOD * D_MODEL), 0.5 * D_MODEL ** -0.5),
        'b_mod': nrm((L, N_MOD * D_MODEL), 0.02),
        'g_mix': gain((L, D_MODEL)),
        'g_ffn': gain((L, D_MODEL)),
        'w_in': nrm((L, D_MODEL, D_IN), D_MODEL ** -0.5),
        'g_cq': gain((L, MLA_Q_LORA)),
        'w_uq': nrm((L, MLA_Q_LORA, MLA_HEADS * (MLA_NOPE + MLA_ROPE)), MLA_Q_LORA ** -0.5),
        'g_ckv': gain((L, MLA_KV_LORA)),
        'w_uk': nrm((L, MLA_KV_LORA, MLA_HEADS * MLA_NOPE), MLA_KV_LORA ** -0.5),
        'w_uv': nrm((L, MLA_KV_LORA, MLA_WIDTH), MLA_KV_LORA ** -0.5),
        'ml_b_i': nrm((L, 2, ML_HEADS), 0.1),
        'ml_b_f': unif((L, 2, ML_HEADS), 3.0, 6.0),
        'ml_g_norm': gain((L, ML_WIDTH)),
        'rw_mu': unif((L, RW_IN), 0.0, 1.0),
        'rw_w0': unif((L, 2, RW_WIDTH), -6.0, -1.0),
        'rw_w2': nrm((L, 2, RW_W_LORA, RW_WIDTH), 0.1),
        'rw_a0': nrm((L, 2, RW_WIDTH), 0.1),
        'rw_a2': nrm((L, 2, RW_A_LORA, RW_WIDTH), 0.1),
        'rw_g2': nrm((L, RW_G_LORA, RW_WIDTH), RW_G_LORA ** -0.5),
        'rw_k_k': 0.85 + nrm((L, RW_WIDTH), 0.02),
        'rw_k_a': gain((L, RW_WIDTH)),
        'rw_r_k': nrm((L, RW_HEADS, RW_N), 0.1),
        'rw_lnx_w': gain((L, RW_WIDTH)),
        'rw_lnx_b': nrm((L, RW_WIDTH), 0.02),
        'w_br_mla': nrm((L, MLA_WIDTH, D_MODEL), MLA_WIDTH ** -0.5),
        'w_br_ml': nrm((L, ML_WIDTH, D_MODEL), ML_WIDTH ** -0.5),
        'w_br_rw': nrm((L, RW_WIDTH, D_MODEL), RW_WIDTH ** -0.5),
        'w_out': nrm((L, D_MODEL, D_MODEL), D_MODEL ** -0.5),
        'w_router': nrm((L, D_MODEL, N_EXPERTS), D_MODEL ** -0.5),
        'router_bias': nrm((L, N_EXPERTS), 0.01),
        'w_e_gate': nrm((L, N_EXPERTS, D_MODEL, D_EXPERT), D_MODEL ** -0.5),
        'w_e_up': nrm((L, N_EXPERTS, D_MODEL, D_EXPERT), D_MODEL ** -0.5),
        'w_e_down': nrm((L, N_EXPERTS, D_EXPERT, D_MODEL), D_EXPERT ** -0.5),
        'w_s_gate': nrm((L, D_MODEL, D_SHARED), D_MODEL ** -0.5),
        'w_s_up': nrm((L, D_MODEL, D_SHARED), D_MODEL ** -0.5),
        'w_s_down': nrm((L, D_SHARED, D_MODEL), D_SHARED ** -0.5),
        'g_final': gain((D_MODEL,)),
    }


def reference(x, c, ctx, c_ctx, w_mod, b_mod, g_mix, g_ffn, w_in, g_cq, w_uq, g_ckv, w_uk, w_uv,
              ml_b_i, ml_b_f, ml_g_norm, rw_mu, rw_w0, rw_w2, rw_a0, rw_a2, rw_g2, rw_k_k, rw_k_a,
              rw_r_k, rw_lnx_w, rw_lnx_b, w_br_mla, w_br_ml, w_br_rw, w_out, w_router, router_bias,
              w_e_gate, w_e_up, w_e_down, w_s_gate, w_s_up, w_s_down, g_final):
    B, T, D = x.shape
    rope = axial_rope_tables(T)
    cond_x = jax.nn.silu(c)
    cond_c = jax.nn.silu(c_ctx)[None, :]
    for l in range(DEPTH):
        last = l == DEPTH - 1
        mod_x = jnp.split((cond_x @ w_mod[l] + b_mod[l])[:, None, :], N_MOD, axis=-1)
        mod_c = jnp.split((cond_c @ w_mod[l] + b_mod[l])[:, None, :], N_MOD, axis=-1)
        hx = modulate(rmsnorm(x, g_mix[l]), mod_x[0], mod_x[1])
        hc = modulate(rmsnorm(ctx, g_mix[l]), mod_c[0], mod_c[1])
        y_x, y_c = hybrid_mixer(hx, hc, rope, w_in[l], g_cq[l], w_uq[l], g_ckv[l], w_uk[l], w_uv[l],
                                ml_b_i[l], ml_b_f[l], ml_g_norm[l],
                                rw_mu[l], rw_w0[l], rw_w2[l], rw_a0[l], rw_a2[l], rw_g2[l],
                                rw_k_k[l], rw_k_a[l], rw_r_k[l], rw_lnx_w[l], rw_lnx_b[l],
                                w_br_mla[l], w_br_ml[l], w_br_rw[l], w_out[l], not last)
        x = x + mod_x[2] * y_x
        hx = modulate(rmsnorm(x, g_ffn[l]), mod_x[3], mod_x[4]).reshape(-1, D)
        moe_w = (w_router[l], router_bias[l], w_e_gate[l], w_e_up[l], w_e_down[l],
                 w_s_gate[l], w_s_up[l], w_s_down[l])
        if last:
            x = x + mod_x[5] * moe_ffn(hx, *moe_w).reshape(B, T, D)
        else:
            ctx = ctx + mod_c[2] * y_c
            hc = modulate(rmsnorm(ctx, g_ffn[l]), mod_c[3], mod_c[4]).reshape(-1, D)
            f = moe_ffn(jnp.concatenate([hx, hc], axis=0), *moe_w)
            x = x + mod_x[5] * f[:B * T].reshape(B, T, D)
            ctx = ctx + mod_c[5] * f[B * T:].reshape(ctx.shape)
    return rmsnorm(x, g_final)
```

```cpp
#define MEGA 1
#include <hip/hip_runtime.h>
#include <hip/hip_cooperative_groups.h>
#include <cstdio>

#ifndef SEQ_T
#define SEQ_T 8192
#endif
#ifndef CTX_L
#define CTX_L 256
#endif

#define DI __device__ __forceinline__
typedef unsigned short bf16_t;
typedef short bf16x8 __attribute__((ext_vector_type(8)));
typedef float f32x16 __attribute__((ext_vector_type(16)));
typedef float f32x4 __attribute__((ext_vector_type(4)));

constexpr int NB_ = 2, T_ = SEQ_T, CL_ = CTX_L, D_ = 1024;
constexpr int NX_ = NB_ * T_, NC_ = NB_ * CL_, NT_ = NX_ + NC_, KT_ = CL_ + T_;
constexpr int GRID_W_ = 64;
constexpr int MLA_H = 8, MLA_NOPE_ = 64, MLA_ROPE_ = 32, MLA_DK = 96, MLA_DV = 64, QLORA = 384, KVLORA = 256;
constexpr int MLA_IN_ = 672, ML_IN_ = 784, RW_IN_ = 1152, GATE_IN_ = 3072, D_IN_ = 5680;
constexpr int ZMLA_W = 768;
constexpr int ZREC_W = 1936;
constexpr int WIN_N = 768 + 2048;
constexpr int ML_H = 4, ML_DK = 32, ML_DV = 64, ML_L = 64;
constexpr int RW_H = 4, RW_N_ = 64;
constexpr int NE_ = 64, TOPK_ = 8, DE_ = 256;
constexpr int NCH_ = KT_ / ML_L;
constexpr int NSEQ_ = 2 * NB_ * 4;

constexpr int ZR_MLQ = 0, ZR_MLK = 128, ZR_MLV = 256, ZR_MLO = 512, ZR_MLI = 768, ZR_MLF = 776;
constexpr int ZR_RW = 784;

constexpr size_t al256(size_t x) { return (x + 255) & ~(size_t)255; }
constexpr size_t WM_WIN = 0;
constexpr size_t WM_GATE = WM_WIN + (size_t)WIN_N * 1024 * 2;
constexpr size_t WM_UQ = WM_GATE + (size_t)3072 * 1024 * 2;
constexpr size_t WM_UKV = WM_UQ + (size_t)768 * 384 * 2;
constexpr size_t WM_BRA = WM_UKV + (size_t)1024 * 256 * 2;
constexpr size_t WM_BRM = WM_BRA + (size_t)1024 * 512 * 2;
constexpr size_t WM_BRR = WM_BRM + (size_t)1024 * 256 * 2;
constexpr size_t WM_OUT = WM_BRR + (size_t)1024 * 256 * 2;
constexpr size_t WM_RT = WM_OUT + (size_t)1024 * 1024 * 2;
constexpr size_t WM_SIZE = al256(WM_RT + (size_t)64 * 1024 * 2);
constexpr size_t WE_GU = 0;
constexpr size_t WE_DN = WE_GU + (size_t)65 * 512 * 1024 * 2;
constexpr size_t WE_SIZE = al256(WE_DN + (size_t)65 * 1024 * 256 * 2);

constexpr size_t OFF_XS = 0;
constexpr size_t OFF_MOD = OFF_XS + al256((size_t)NT_ * 1024 * 4);
constexpr size_t OFF_ROPE = OFF_MOD + al256((size_t)2 * 3 * 6144 * 4);
constexpr size_t OFF_H = OFF_ROPE + al256((size_t)T_ * 16 * 8);
constexpr size_t OFF_WMIX = OFF_H + al256((size_t)NT_ * 1024 * 2);
constexpr size_t OFF_CNT = OFF_WMIX + 2 * WM_SIZE;
constexpr size_t OFF_REGION = OFF_CNT + 4096;
constexpr size_t R_ZREC = 0;
constexpr size_t R_RWP = R_ZREC + al256((size_t)NT_ * ZREC_W * 4);
constexpr size_t R_YS = R_RWP + al256((size_t)9 * NT_ * 256 * 4);
constexpr size_t R_MLST = R_YS + al256((size_t)2 * NT_ * 256 * 4);
constexpr size_t R_ATT = R_MLST + al256((size_t)NSEQ_ * NCH_ * 2112 * 4);
constexpr size_t R_MLO = R_ATT + al256((size_t)NT_ * 512 * 2);
constexpr size_t R_RWO = R_MLO + al256((size_t)NT_ * 256 * 2);
constexpr size_t R_VT = R_RWO + al256((size_t)NT_ * 256 * 2);
constexpr size_t R_KB = R_VT + al256((size_t)NB_ * MLA_H * 64 * KT_ * 2);
constexpr size_t R_MIX_END = R_KB + al256((size_t)NB_ * MLA_H * KT_ * 96 * 2);
constexpr int NSLOT_ = NT_ * 9;
constexpr size_t R_YBUF = 0;
constexpr size_t R_EIDX = R_YBUF + al256((size_t)NSLOT_ * 1024 * 2);
constexpr size_t R_EWT = R_EIDX + al256((size_t)NT_ * 8 * 4);
constexpr size_t R_ERANK = R_EWT + al256((size_t)NT_ * 8 * 4);
constexpr size_t R_ELIST = R_ERANK + al256((size_t)NT_ * 8 * 4);
constexpr size_t R_WMOE = R_ELIST + al256((size_t)64 * NT_ * 4);
constexpr size_t R_MOE_END = R_WMOE + WE_SIZE;
constexpr size_t R_SIZE = R_MIX_END > R_MOE_END ? R_MIX_END : R_MOE_END;
constexpr size_t WS_NEEDED = OFF_REGION + R_SIZE;
constexpr size_t O_ZMLA = 0;
constexpr size_t O_QB = O_ZMLA + al256((size_t)NT_ * ZMLA_W * 2);
constexpr size_t O_END = O_QB + al256((size_t)NT_ * 768 * 2);
constexpr size_t O_YMIX = 0;
#if SEQ_T == 8192 && CTX_L == 256
static_assert(O_END <= (size_t)NX_ * 1024 * 4, "d_out scratch overflow");
static_assert((size_t)NT_ * 1024 * 2 <= (size_t)NX_ * 1024 * 4, "ymix overflow");
static_assert(WS_NEEDED <= (size_t)597000000, "workspace too large");
#endif

struct Params {
  const float *x, *c, *ctx, *c_ctx, *w_mod, *b_mod, *g_mix, *g_ffn, *w_in, *g_cq, *w_uq, *g_ckv, *w_uk, *w_uv;
  const float *ml_b_i, *ml_b_f, *ml_g_norm, *rw_mu, *rw_w0, *rw_w2, *rw_a0, *rw_a2, *rw_g2, *rw_k_k, *rw_k_a;
  const float *rw_r_k, *rw_lnx_w, *rw_lnx_b, *w_br_mla, *w_br_ml, *w_br_rw, *w_out, *w_router, *router_bias;
  const float *w_e_gate, *w_e_up, *w_e_down, *w_s_gate, *w_s_up, *w_s_down, *g_final;
  float* out; char* ws; char* osc;
};

DI float bf2f(bf16_t s) { unsigned u = ((unsigned)s) << 16; float f; __builtin_memcpy(&f, &u, 4); return f; }
DI bf16_t f2bf(float x) { unsigned u; __builtin_memcpy(&u, &x, 4); u += 0x7fffu + ((u >> 16) & 1u); return (bf16_t)(u >> 16); }
DI unsigned pack2bf(float a, float b) {
#ifdef EMU
  return (unsigned)f2bf(a) | ((unsigned)f2bf(b) << 16);
#else
  typedef __bf16 bf2 __attribute__((ext_vector_type(2)));
  typedef float f2 __attribute__((ext_vector_type(2)));
  f2 v = {a, b}; bf2 r = __builtin_convertvector(v, bf2); return __builtin_bit_cast(unsigned, r);
#endif
}
DI f32x16 mfma32(bf16x8 a, bf16x8 b, f32x16 c) {
#ifdef EMU
  return emu_mfma_32x32x16_bf16(a, b, c);
#else
  return __builtin_amdgcn_mfma_f32_32x32x16_bf16(a, b, c, 0, 0, 0);
#endif
}
DI int rfl(int v) {
#ifdef EMU
  return v;
#else
  return __builtin_amdgcn_readfirstlane(v);
#endif
}
DI int opaque_tid() {
#ifdef EMU
  return threadIdx.x;
#else
  int t = threadIdx.x; asm volatile("" : "+v"(t)); return t;
#endif
}
DI f32x16 zero16() { f32x16 z; for (int i = 0; i < 16; ++i) z[i] = 0.f; return z; }
DI int crow(int reg, int h) { return (reg & 3) + 8 * (reg >> 2) + 4 * h; }
#ifdef EMU
DI float fexp(float x) { return expf(x); }
#else
DI float fexp(float x) { return __expf(x); }
#endif
DI float sigmoidf_(float x) { return 1.f / (1.f + fexp(-x)); }
DI float siluf_(float x) { return x * sigmoidf_(x); }
DI float wave_sum(float v) { for (int m = 32; m >= 1; m >>= 1) v += __shfl_xor(v, m); return v; }
DI float wave_max(float v) { for (int m = 32; m >= 1; m >>= 1) v = fmaxf(v, __shfl_xor(v, m)); return v; }

DI int tok_b(int n) { return n < NX_ ? n / T_ : (n - NX_) / CL_; }
DI int tok_t(int n) { return n < NX_ ? n % T_ : (n - NX_) % CL_; }
DI int tok_key(int n) { return n < NX_ ? CL_ + n % T_ : (n - NX_) % CL_; }
DI int tok_modrow(int n) { return n < NX_ ? n / T_ : 2; }

#ifdef EMU
#define SMEM_DECL(name, bytes) char* name = (char*)emu::shared_alloc(bytes)
#else
#define SMEM_DECL(name, bytes) __shared__ __attribute__((aligned(16))) char name[bytes]
#endif
#define NTHR 512
struct CvtJob { const float* src; int lds; int K; bf16_t* dst; int ntn; int ntk; int maptype; const float* gain; };
DI int cvt_map(int maptype, int coff, int np) {
  if (maptype == 0) return coff + np;
  if (maptype == 1) { if (np < 672) return np; if (np < 768) return -1; if (np < 768 + 1936) return np - 96; return -1; }
  return np;
}
DI void cvt_tile(const CvtJob& j, int coff, int tk, int tn, char* smem) {
  float* tile = (float*)smem;
  const int tid = opaque_tid();
  __syncthreads();
  {
    const int kk = tid >> 3, nc = (tid & 7) * 8, k = tk * 64 + kk;
    const float g = j.gain ? j.gain[k] : 1.f;
#pragma unroll
    for (int i = 0; i < 8; ++i) {
      const int np = tn * 64 + nc + i;
      const int sc = cvt_map(j.maptype, coff, np);
      tile[kk * 65 + nc + i] = sc >= 0 ? j.src[(size_t)k * j.lds + sc] * g : 0.f;
    }
  }
  __syncthreads();
  {
    const int n = tid >> 3, kc = (tid & 7) * 8;
    int np = tn * 64 + n;
    if (j.maptype == 2) np = (np >> 5) * 64 + coff * 32 + (np & 31);
    uint4 v;
    v.x = pack2bf(tile[(kc + 0) * 65 + n], tile[(kc + 1) * 65 + n]);
    v.y = pack2bf(tile[(kc + 2) * 65 + n], tile[(kc + 3) * 65 + n]);
    v.z = pack2bf(tile[(kc + 4) * 65 + n], tile[(kc + 5) * 65 + n]);
    v.w = pack2bf(tile[(kc + 6) * 65 + n], tile[(kc + 7) * 65 + n]);
    *(uint4*)(j.dst + (size_t)np * j.K + tk * 64 + kc) = v;
  }
}

constexpr int CVT_MIX_TILES = 704 + 768 + 72 + 32 + 32 + 128 + 64 + 64 + 256 + 16;
DI void cvt_mix_item(const Params& p, int l, int it, char* smem) {
  bf16_t* W = (bf16_t*)(p.ws + OFF_WMIX + (size_t)l * WM_SIZE);
  CvtJob j; int coff = 0;
  if (it < 704) { j = {p.w_in + (size_t)l * 1024 * D_IN_, D_IN_, 1024, (bf16_t*)((char*)W + WM_WIN), 44, 16, 1, nullptr}; }
  else if ((it -= 704) < 768) { j = {p.w_in + (size_t)l * 1024 * D_IN_, D_IN_, 1024, (bf16_t*)((char*)W + WM_GATE), 48, 16, 0, nullptr}; coff = 2608; }
  else if ((it -= 768) < 72) { j = {p.w_uq + (size_t)l * 384 * 768, 768, 384, (bf16_t*)((char*)W + WM_UQ), 12, 6, 0, p.g_cq + l * 384}; }
  else if ((it -= 72) < 32) { j = {p.w_uk + (size_t)l * 256 * 512, 512, 256, (bf16_t*)((char*)W + WM_UKV), 8, 4, 0, p.g_ckv + l * 256}; }
  else if ((it -= 32) < 32) { j = {p.w_uv + (size_t)l * 256 * 512, 512, 256, (bf16_t*)((char*)W + WM_UKV) + 512 * 256, 8, 4, 0, p.g_ckv + l * 256}; }
  else if ((it -= 32) < 128) { j = {p.w_br_mla + (size_t)l * 512 * 1024, 1024, 512, (bf16_t*)((char*)W + WM_BRA), 16, 8, 0, nullptr}; }
  else if ((it -= 128) < 64) { j = {p.w_br_ml + (size_t)l * 256 * 1024, 1024, 256, (bf16_t*)((char*)W + WM_BRM), 16, 4, 0, nullptr}; }
  else if ((it -= 64) < 64) { j = {p.w_br_rw + (size_t)l * 256 * 1024, 1024, 256, (bf16_t*)((char*)W + WM_BRR), 16, 4, 0, nullptr}; }
  else if ((it -= 64) < 256) { j = {p.w_out + (size_t)l * 1024 * 1024, 1024, 1024, (bf16_t*)((char*)W + WM_OUT), 16, 16, 0, nullptr}; }
  else { it -= 256; j = {p.w_router + (size_t)l * 1024 * 64, 64, 1024, (bf16_t*)((char*)W + WM_RT), 1, 16, 0, nullptr}; }
  cvt_tile(j, coff, it / j.ntn, it % j.ntn, smem);
}
constexpr int CVT_MOE_TILES = 65 * 192;
DI void cvt_moe_item(const Params& p, int l, int it, char* smem) {
  const int e = it / 192; int r = it % 192;
  bf16_t* GU = (bf16_t*)(p.ws + OFF_REGION + R_WMOE + WE_GU) + (size_t)e * 512 * 1024;
  bf16_t* DN = (bf16_t*)(p.ws + OFF_REGION + R_WMOE + WE_DN) + (size_t)e * 1024 * 256;
  const float* sg = e < 64 ? p.w_e_gate + ((size_t)l * 64 + e) * 1024 * 256 : p.w_s_gate + (size_t)l * 1024 * 256;
  const float* su = e < 64 ? p.w_e_up + ((size_t)l * 64 + e) * 1024 * 256 : p.w_s_up + (size_t)l * 1024 * 256;
  const float* sd = e < 64 ? p.w_e_down + ((size_t)l * 64 + e) * 256 * 1024 : p.w_s_down + (size_t)l * 256 * 1024;
  CvtJob j; int coff = 0;
  if (r < 64) { j = {sg, 256, 1024, GU, 4, 16, 2, nullptr}; coff = 0; }
  else if ((r -= 64) < 64) { j = {su, 256, 1024, GU, 4, 16, 2, nullptr}; coff = 1; }
  else { r -= 64; j = {sd, 1024, 256, DN, 16, 4, 0, nullptr}; }
  cvt_tile(j, coff, r / j.ntn, r % j.ntn, smem);
}

DI void mod_item(const Params& p, int it, char* smem) {
  float* cond = (float*)smem;
  float* red = cond + 3 * 1024;
  const int tid = opaque_tid(), l = it / 96, j0 = (it % 96) * 64;
  __syncthreads();
  for (int i = tid; i < 3 * 1024; i += NTHR) {
    const int r = i >> 10, k = i & 1023;
    const float v = r < 2 ? p.c[r * 1024 + k] : p.c_ctx[k];
    cond[i] = siluf_(v);
  }
  __syncthreads();
  const int jj = tid & 63, kg = tid >> 6;
  float a0 = 0.f, a1 = 0.f, a2 = 0.f;
  const float* w = p.w_mod + (size_t)l * 1024 * 6144 + j0 + jj;
  for (int k = kg; k < 1024; k += 8) {
    const float wv = w[(size_t)k * 6144];
    a0 += cond[k] * wv; a1 += cond[1024 + k] * wv; a2 += cond[2048 + k] * wv;
  }
  red[(kg * 3 + 0) * 64 + jj] = a0; red[(kg * 3 + 1) * 64 + jj] = a1; red[(kg * 3 + 2) * 64 + jj] = a2;
  __syncthreads();
  if (tid < 192) {
    const int r = tid >> 6; float s = 0.f;
    for (int g = 0; g < 8; ++g) s += red[(g * 3 + r) * 64 + jj];
    float* mod = (float*)(p.ws + OFF_MOD);
    mod[((size_t)l * 3 + r) * 6144 + j0 + jj] = s + p.b_mod[(size_t)l * 6144 + j0 + jj];
  }
}
DI void rope_item(const Params& p, int it) {
  const int idx = it * NTHR + threadIdx.x;
  if (idx >= T_ * 16) return;
  const int t = idx >> 4, i = idx & 15, f = i & 7;
  const float pos = (float)(i < 8 ? t / GRID_W_ : t % GRID_W_);
  const float inv = powf(10000.f, -(float)(2 * f) / 16.f);
  const float ang = pos * inv;
  float2* rt = (float2*)(p.ws + OFF_ROPE);
  rt[idx] = make_float2(cosf(ang), sinf(ang));
}
constexpr int PA_ITEMS = 192 + (T_ * 16 + NTHR - 1) / NTHR + 2 * CVT_MIX_TILES;
DI void phaseA(const Params& p, char* smem) {
  if (blockIdx.x == 0 && threadIdx.x < 256) ((int*)(p.ws + OFF_CNT))[threadIdx.x] = 0;
  for (int it = blockIdx.x; it < PA_ITEMS; it += gridDim.x) {
    int i = it;
    if (i < 192) { mod_item(p, i, smem); continue; }
    i -= 192;
    constexpr int NR = (T_ * 16 + NTHR - 1) / NTHR;
    if (i < NR) { rope_item(p, i); continue; }
    i -= NR;
    cvt_mix_item(p, i / CVT_MIX_TILES, i % CVT_MIX_TILES, smem);
  }
}

DI void row_norm_mod(const float (&v)[16], const float* g, const float* shift, const float* scale, bf16_t* hrow, int lane) {
  float ss = 0.f;
#pragma unroll
  for (int i = 0; i < 16; ++i) ss += v[i] * v[i];
  ss = wave_sum(ss);
  const float rs = 1.0f / sqrtf(ss * (1.f / 1024.f) + 1e-6f);
#pragma unroll
  for (int j = 0; j < 4; ++j) {
    const int c = (j * 64 + lane) * 4;
    const float4 gg = *(const float4*)(g + c), sh = *(const float4*)(shift + c), sc = *(const float4*)(scale + c);
    const float h0 = v[j * 4 + 0] * rs * gg.x * (1.f + sc.x) + sh.x;
    const float h1 = v[j * 4 + 1] * rs * gg.y * (1.f + sc.y) + sh.y;
    const float h2 = v[j * 4 + 2] * rs * gg.z * (1.f + sc.z) + sh.z;
    const float h3 = v[j * 4 + 3] * rs * gg.w * (1.f + sc.w) + sh.w;
    uint2 o; o.x = pack2bf(h0, h1); o.y = pack2bf(h2, h3);
    *(uint2*)(hrow + c) = o;
  }
}
DI void phase_norm0(const Params& p) {
  const int lane = threadIdx.x & 63, wid = threadIdx.x >> 6;
  float* xs = (float*)(p.ws + OFF_XS);
  bf16_t* H = (bf16_t*)(p.ws + OFF_H);
  const float* mod = (const float*)(p.ws + OFF_MOD);
  for (int n = blockIdx.x * 8 + wid; n < NT_; n += gridDim.x * 8) {
    const float* src = n < NX_ ? p.x + (size_t)n * 1024 : p.ctx + (size_t)(n - NX_) * 1024;
    float v[16];
#pragma unroll
    for (int j = 0; j < 4; ++j) {
      const float4 t = *(const float4*)(src + (j * 64 + lane) * 4);
      v[j * 4] = t.x; v[j * 4 + 1] = t.y; v[j * 4 + 2] = t.z; v[j * 4 + 3] = t.w;
      *(float4*)(xs + (size_t)n * 1024 + (j * 64 + lane) * 4) = t;
    }
    const float* m = mod + (size_t)(0 * 3 + tok_modrow(n)) * 6144;
    row_norm_mod(v, p.g_mix, m, m + 1024, H + (size_t)n * 1024, lane);
  }
}

template <int BM, int BN, int BK, int WM_, int WN_>
struct Gemm {
  static constexpr int WTM = BM / WM_, WTN = BN / WN_, MB = WTM / 32, NB = WTN / 32;
  static constexpr int LDA = BK + 8;
  static constexpr int A_BYTES = BM * LDA * 2, B_BYTES = BN * LDA * 2, STAGE = A_BYTES + B_BYTES;
  static constexpr int SMEM = 2 * STAGE;
  static constexpr int CPR = BK / 8;
  static constexpr int ACH = BM * CPR / NTHR, BCH = BN * CPR / NTHR;
  static_assert(WM_ * WN_ == 8, "8 waves");
  static_assert(BM * CPR % NTHR == 0 && BN * CPR % NTHR == 0, "chunking");
  static_assert(NTHR % CPR == 0, "rows fixed per thread");

  template <class ARow>
  static DI void run(f32x16 (&acc)[MB][NB], ARow arow, const bf16_t* Bt, int ldb, int Klen, char* smem) {
    const int tid = opaque_tid(), lane = tid & 63, wid = tid >> 6, wm = wid / WN_, wn = wid % WN_;
    const int kc = (tid % CPR) * 8, r0 = tid / CPR;
    const bf16_t* ap[ACH]; const bf16_t* bp[BCH];
#pragma unroll
    for (int i = 0; i < ACH; ++i) ap[i] = arow(r0 + i * (NTHR / CPR)) + kc;
#pragma unroll
    for (int i = 0; i < BCH; ++i) bp[i] = Bt + (size_t)(r0 + i * (NTHR / CPR)) * ldb + kc;
    uint4 ra[ACH], rb[BCH];
    const int nk = Klen / BK;
#pragma unroll
    for (int i = 0; i < ACH; ++i) ra[i] = *(const uint4*)(ap[i]);
#pragma unroll
    for (int i = 0; i < BCH; ++i) rb[i] = *(const uint4*)(bp[i]);
#pragma unroll
    for (int i = 0; i < ACH; ++i) *(uint4*)(smem + ((r0 + i * (NTHR / CPR)) * LDA + kc) * 2) = ra[i];
#pragma unroll
    for (int i = 0; i < BCH; ++i) *(uint4*)(smem + A_BYTES + ((r0 + i * (NTHR / CPR)) * LDA + kc) * 2) = rb[i];
    __syncthreads();
    for (int kt = 0; kt < nk; ++kt) {
      const bool more = kt + 1 < nk;
      if (more) {
#pragma unroll
        for (int i = 0; i < ACH; ++i) ra[i] = *(const uint4*)(ap[i] + (kt + 1) * BK);
#pragma unroll
        for (int i = 0; i < BCH; ++i) rb[i] = *(const uint4*)(bp[i] + (kt + 1) * BK);
      }
      const char* As = smem + (kt & 1) * STAGE;
      const char* Bs = As + A_BYTES;
#pragma unroll
      for (int ks = 0; ks < BK / 16; ++ks) {
        bf16x8 af[MB], bfr[NB];
#pragma unroll
        for (int mb = 0; mb < MB; ++mb)
          af[mb] = *(const bf16x8*)(As + ((wm * WTM + mb * 32 + (lane & 31)) * LDA + ks * 16 + (lane >> 5) * 8) * 2);
#pragma unroll
        for (int nb = 0; nb < NB; ++nb)
          bfr[nb] = *(const bf16x8*)(Bs + ((wn * WTN + nb * 32 + (lane & 31)) * LDA + ks * 16 + (lane >> 5) * 8) * 2);
#pragma unroll
        for (int mb = 0; mb < MB; ++mb)
#pragma unroll
          for (int nb = 0; nb < NB; ++nb) acc[mb][nb] = mfma32(af[mb], bfr[nb], acc[mb][nb]);
      }
      if (more) {
        char* Ad = smem + ((kt + 1) & 1) * STAGE;
#pragma unroll
        for (int i = 0; i < ACH; ++i) *(uint4*)(Ad + ((r0 + i * (NTHR / CPR)) * LDA + kc) * 2) = ra[i];
#pragma unroll
        for (int i = 0; i < BCH; ++i) *(uint4*)(Ad + A_BYTES + ((r0 + i * (NTHR / CPR)) * LDA + kc) * 2) = rb[i];
      }
      __syncthreads();
    }
  }
  static DI int row_of(int t, int mb, int reg) { const int lane = t & 63, wm = (t >> 6) / WN_; return wm * WTM + mb * 32 + crow(reg, lane >> 5); }
  static DI int col_of(int t, int nb) { const int lane = t & 63, wn = (t >> 6) % WN_; return wn * WTN + nb * 32 + (lane & 31); }
};

typedef Gemm<256, 256, 64, 2, 4> G256;
DI void phase_win(const Params& p, int l, char* smem) {
  const bf16_t* H = (const bf16_t*)(p.ws + OFF_H);
  const bf16_t* W = (const bf16_t*)(p.ws + OFF_WMIX + (size_t)l * WM_SIZE + WM_WIN);
  bf16_t* zmla = (bf16_t*)(p.osc + O_ZMLA);
  float* zrec = (float*)(p.ws + OFF_REGION + R_ZREC);
  constexpr int TM = NT_ / 256, TN = WIN_N / 256;
  for (int it = blockIdx.x; it < TM * TN; it += gridDim.x) {
    const int tid = opaque_tid();
    const int tm = it / TN, tn = it % TN;
    f32x16 acc[G256::MB][G256::NB];
#pragma unroll
    for (int a = 0; a < G256::MB; ++a)
#pragma unroll
      for (int b = 0; b < G256::NB; ++b) acc[a][b] = zero16();
    const bf16_t* A0 = H + (size_t)tm * 256 * 1024;
    G256::run(acc, [&](int r) { return A0 + (size_t)r * 1024; }, W + (size_t)tn * 256 * 1024, 1024, 1024, smem);
#pragma unroll
    for (int mb = 0; mb < G256::MB; ++mb)
#pragma unroll
      for (int nb = 0; nb < G256::NB; ++nb) {
        const int col = tn * 256 + G256::col_of(tid, nb);
#pragma unroll
        for (int i = 0; i < 16; ++i) {
          const int row = tm * 256 + G256::row_of(tid, mb, i);
          const float v = acc[mb][nb][i];
          if (col < 768) zmla[(size_t)row * ZMLA_W + col] = f2bf(v);
          else if (col - 768 < ZREC_W) zrec[(size_t)row * ZREC_W + (col - 768)] = v;
        }
      }
  }
}
typedef Gemm<128, 128, 64, 2, 4> G128;
DI void mla_row_rs(const bf16_t* zmla_rows, int c0, int len, float* rs) {
  const int tid = opaque_tid(), row = tid >> 2, half = tid & 3;
  const bf16_t* src = zmla_rows + (size_t)row * ZMLA_W + c0 + half * (len / 4);
  float ss = 0.f;
  for (int i = 0; i < len / 4; i += 8) {
    const uint4 v = *(const uint4*)(src + i);
    const unsigned w[4] = {v.x, v.y, v.z, v.w};
#pragma unroll
    for (int j = 0; j < 4; ++j) { const float a = bf2f((bf16_t)(w[j] & 0xffff)), b = bf2f((bf16_t)(w[j] >> 16)); ss += a * a + b * b; }
  }
  ss += __shfl_xor(ss, 1); ss += __shfl_xor(ss, 2);
  if (half == 0) rs[row] = 1.0f / sqrtf(ss / (float)len + 1e-6f);
}

constexpr int MLA_Q_TILES = (NT_ / 128) * 6, MLA_KV_TILES = (NT_ / 128) * 8;
DI void mla_q_item(const Params& p, int l, int it, char* smem) {
  const int tid = opaque_tid();
  const int tm = it / 6, tn = it % 6;
  const bf16_t* zmla = (const bf16_t*)(p.osc + O_ZMLA) + (size_t)tm * 128 * ZMLA_W;
  const bf16_t* W = (const bf16_t*)(p.ws + OFF_WMIX + (size_t)l * WM_SIZE + WM_UQ) + (size_t)tn * 128 * 384;
  bf16_t* qb = (bf16_t*)(p.osc + O_QB);
  const float2* rt = (const float2*)(p.ws + OFF_ROPE);
  float* rs = (float*)(smem + G128::SMEM);
  __syncthreads();
  mla_row_rs(zmla, 0, 384, rs);
  f32x16 acc[G128::MB][G128::NB];
#pragma unroll
  for (int a = 0; a < G128::MB; ++a)
#pragma unroll
    for (int b = 0; b < G128::NB; ++b) acc[a][b] = zero16();
  G128::run(acc, [&](int r) { return zmla + (size_t)r * ZMLA_W; }, W, 384, 384, smem);
  const int lane = tid & 63;
  const bool isx = tm * 128 < NX_;
#pragma unroll
  for (int mb = 0; mb < G128::MB; ++mb)
#pragma unroll
    for (int nb = 0; nb < G128::NB; ++nb) {
      const int col = tn * 128 + G128::col_of(tid, nb);
      const bool ropeblk = ((col >> 5) % 3) == 2;
      const int e = lane & 31;
#pragma unroll
      for (int i = 0; i < 16; ++i) {
        const int lr = G128::row_of(tid, mb, i);
        const int n = tm * 128 + lr;
        float v = acc[mb][nb][i] * rs[lr];
        if (ropeblk && isx) {
          const float pv = __shfl_xor(v, 8);
          const float2 cs = rt[(size_t)(n % T_) * 16 + (e >> 4) * 8 + (e & 7)];
          v = (e & 8) ? (pv * cs.y + v * cs.x) : (v * cs.x - pv * cs.y);
        }
        qb[(size_t)n * 768 + col] = f2bf(v);
      }
    }
}
DI void mla_kv_item(const Params& p, int l, int it, char* smem) {
  const int tid = opaque_tid();
  const int tm = it / 8, tn = it % 8;
  const bf16_t* zmla = (const bf16_t*)(p.osc + O_ZMLA) + (size_t)tm * 128 * ZMLA_W;
  const bf16_t* W = (const bf16_t*)(p.ws + OFF_WMIX + (size_t)l * WM_SIZE + WM_UKV) + (size_t)tn * 128 * 256;
  bf16_t* kb = (bf16_t*)(p.ws + OFF_REGION + R_KB);
  bf16_t* vt = (bf16_t*)(p.ws + OFF_REGION + R_VT);
  const float2* rt = (const float2*)(p.ws + OFF_ROPE);
  float* rs = (float*)(smem + G128::SMEM);
  __syncthreads();
  mla_row_rs(zmla, 384, 256, rs);
  const int n0 = tm * 128;
  const int b = tok_b(n0), key0 = tok_key(n0);
  const bool isx = n0 < NX_;
  if (tn == 0) {
    for (int idx = tid; idx < 128 * 16; idx += NTHR) {
      const int lr = idx >> 4, pi = idx & 15, a = pi >> 3, i = pi & 7;
      const bf16_t* z = zmla + (size_t)lr * ZMLA_W + 640 + a * 16 + i;
      float x1 = bf2f(z[0]), x2 = bf2f(z[8]);
      if (isx) {
        const float2 cs = rt[(size_t)((n0 + lr) % T_) * 16 + a * 8 + i];
        const float y1 = x1 * cs.x - x2 * cs.y, y2 = x1 * cs.y + x2 * cs.x; x1 = y1; x2 = y2;
      }
      const bf16_t o1 = f2bf(x1), o2 = f2bf(x2);
      for (int h = 0; h < 8; ++h) {
        bf16_t* dst = kb + ((size_t)(b * 8 + h) * KT_ + key0 + lr) * 96 + 64 + a * 16 + i;
        dst[0] = o1; dst[8] = o2;
      }
    }
  }
  f32x16 acc[G128::MB][G128::NB];
#pragma unroll
  for (int a = 0; a < G128::MB; ++a)
#pragma unroll
    for (int c = 0; c < G128::NB; ++c) acc[a][c] = zero16();
  G128::run(acc, [&](int r) { return zmla + (size_t)r * ZMLA_W + 384; }, W, 256, 256, smem);
  const int lane = tid & 63;
#pragma unroll
  for (int mb = 0; mb < G128::MB; ++mb)
#pragma unroll
    for (int nb = 0; nb < G128::NB; ++nb) {
      const int col = tn * 128 + G128::col_of(tid, nb);
      if (col < 512) {
        const int h = col >> 6, d = col & 63;
#pragma unroll
        for (int i = 0; i < 16; ++i) {
          const int lr = G128::row_of(tid, mb, i);
          kb[((size_t)(b * 8 + h) * KT_ + key0 + lr) * 96 + d] = f2bf(acc[mb][nb][i] * rs[lr]);
        }
      } else {
        const int h = (col - 512) >> 6, d = col & 63;
#pragma unroll
        for (int g = 0; g < 4; ++g) {
          const int lr = G128::row_of(tid, mb, g * 4);
          uint2 o;
          o.x = pack2bf(acc[mb][nb][g * 4 + 0] * rs[lr], acc[mb][nb][g * 4 + 1] * rs[lr + 1]);
          o.y = pack2bf(acc[mb][nb][g * 4 + 2] * rs[lr + 2], acc[mb][nb][g * 4 + 3] * rs[lr + 3]);
          *(uint2*)(vt + ((size_t)(b * 8 + h) * 64 + d) * KT_ + key0 + lr) = o;
        }
      }
    }
  (void)lane;
}

DI float softplusf_(float x) { return x > 20.f ? x : log1pf(fexp(x)); }
constexpr int RWP_TT = 16;
constexpr int RWP_ITEMS = NT_ / RWP_TT;
DI void rwkv_prep_item(const Params& p, int l, int it, char* smem) {
  float* zs = (float*)smem;
  float* tw = zs + RWP_TT * 1024;
  float* ta = tw + 2 * 64 * RWP_TT;
  const float* zrec = (const float*)(p.ws + OFF_REGION + R_ZREC);
  float* rwp = (float*)(p.ws + OFF_REGION + R_RWP);
  const float* mu = p.rw_mu + (size_t)l * 1152;
  const int tid = opaque_tid(), n0 = it * RWP_TT;
  __syncthreads();
  for (int idx = tid; idx < RWP_TT * 1024; idx += NTHR) {
    const int tt = idx >> 10, c = idx & 1023, n = n0 + tt, t = tok_t(n);
    const int len = n < NX_ ? T_ : CL_;
    const float* zr = zrec + (size_t)n * ZREC_W + ZR_RW + c;
    const float z = zr[0];
    const float zp = t > 0 ? zr[-ZREC_W] : 0.f, zn = t < len - 1 ? zr[ZREC_W] : 0.f;
    const float s = z + (0.5f * (zp + zn) - z) * mu[c];
    zs[idx] = s;
    if (c >= 768 && c < 896) { const int d = (c - 768) >> 6, k = (c - 768) & 63; tw[(d * 64 + k) * RWP_TT + tt] = tanhf(s); }
    if (c >= 896) { const int d = (c - 896) >> 6, k = (c - 896) & 63; ta[(d * 64 + k) * RWP_TT + tt] = s; }
  }
  __syncthreads();
  const int col = tid & 255, d = tid >> 8;
  float aw[RWP_TT], aa[RWP_TT];
#pragma unroll
  for (int i = 0; i < RWP_TT; ++i) { aw[i] = 0.f; aa[i] = 0.f; }
  const float* w2 = p.rw_w2 + ((size_t)l * 2 + d) * 64 * 256 + col;
  const float* a2 = p.rw_a2 + ((size_t)l * 2 + d) * 64 * 256 + col;
  for (int k = 0; k < 64; ++k) {
    const float wv = w2[k * 256], av = a2[k * 256];
    const float* twk = tw + (d * 64 + k) * RWP_TT;
    const float* tak = ta + (d * 64 + k) * RWP_TT;
#pragma unroll
    for (int i = 0; i < RWP_TT; ++i) { aw[i] += twk[i] * wv; aa[i] += tak[i] * av; }
  }
  const float w0 = p.rw_w0[((size_t)l * 2 + d) * 256 + col], a0 = p.rw_a0[((size_t)l * 2 + d) * 256 + col];
  const float kkw = p.rw_k_k[(size_t)l * 256 + col], kaw = p.rw_k_a[(size_t)l * 256 + col];
  const size_t AS = (size_t)NT_ * 256;
#pragma unroll
  for (int i = 0; i < RWP_TT; ++i) {
    const int n = n0 + i;
    const float r = zs[i * 1024 + col], k = zs[i * 1024 + 256 + col], v = zs[i * 1024 + 512 + col];
    const float kr = k * kkw;
    const float ss = wave_sum(kr * kr);
    const float kk = kr / fmaxf(sqrtf(ss), 1e-12f);
    const float w = -softplusf_(-(w0 + aw[i])) - 0.5f;
    const float decay = fexp(-fexp(w));
    const float a = sigmoidf_(a0 + aa[i]);
    const float kd = k * (1.f + (a - 1.f) * kaw);
    const size_t o = (size_t)n * 256 + col;
    if (d == 0) { rwp[0 * AS + o] = r; rwp[1 * AS + o] = v; rwp[2 * AS + o] = kk; }
    rwp[(3 + d * 3 + 0) * AS + o] = decay;
    rwp[(3 + d * 3 + 1) * AS + o] = kd;
    rwp[(3 + d * 3 + 2) * AS + o] = kk * a;
  }
}

DI int seq_tok(int dir, int b, int pos) {
  if (pos < CL_) return NX_ + b * CL_ + (dir ? CL_ - 1 - pos : pos);
  const int t = pos - CL_;
  return b * T_ + (dir ? T_ - 1 - t : t);
}
DI float logsigmoidf_(float x) { return -softplusf_(-x); }
DI float wave_incl_scan(float v, int lane) {
  for (int d = 1; d < 64; d <<= 1) { const float o = __shfl_up(v, d); if (lane >= d) v += o; }
  return v;
}
constexpr int ML_ST = 2112;
constexpr int ML1_ITEMS = NSEQ_ * NCH_;
DI void mlstm_local_item(const Params& p, int l, int it, char* smem) {
  const int s = it / NCH_, c = it % NCH_, dir = s >> 3, b = (s >> 2) & 1, hd = s & 3;
  float* vv = (float*)smem;
  float* kw = vv + 64 * 64;
  float* wej = kw + 64 * 32;
  const float* zrec = (const float*)(p.ws + OFF_REGION + R_ZREC);
  float* st = (float*)(p.ws + OFF_REGION + R_MLST) + ((size_t)s * NCH_ + c) * ML_ST;
  const int tid = opaque_tid(), lane = tid & 63, wid = tid >> 6;
  __syncthreads();
  if (wid == 0) {
    const int n = seq_tok(dir, b, c * 64 + lane);
    const float fp = zrec[(size_t)n * ZREC_W + ZR_MLF + dir * 4 + hd] + p.ml_b_f[(l * 2 + dir) * 4 + hd];
    const float ip = zrec[(size_t)n * ZREC_W + ZR_MLI + dir * 4 + hd] + p.ml_b_i[(l * 2 + dir) * 4 + hd];
    const float bj = wave_incl_scan(logsigmoidf_(fp), lane);
    const float bl = __shfl(bj, 63);
    const float lw = bl - bj + ip;
    const float ml = wave_max(lw);
    wej[lane] = fexp(lw - ml);
    if (lane == 0) { st[2080] = bl; st[2081] = ml; }
  }
  for (int idx = tid; idx < 64 * 64; idx += NTHR) {
    const int j = idx >> 6, e = idx & 63;
    const int n = seq_tok(dir, b, c * 64 + j);
    vv[idx] = zrec[(size_t)n * ZREC_W + ZR_MLV + hd * 64 + e];
  }
  __syncthreads();
  for (int idx = tid; idx < 64 * 32; idx += NTHR) {
    const int j = idx >> 5, e = idx & 31;
    const int n = seq_tok(dir, b, c * 64 + j);
    kw[idx] = zrec[(size_t)n * ZREC_W + ZR_MLK + hd * 32 + e] * wej[j];
  }
  __syncthreads();
  const int v = tid & 63, d0 = (tid >> 6) * 4;
  float a0 = 0.f, a1 = 0.f, a2 = 0.f, a3 = 0.f;
  for (int j = 0; j < 64; ++j) {
    const float x = vv[j * 64 + v];
    const float4 kk = *(const float4*)(kw + j * 32 + d0);
    a0 += x * kk.x; a1 += x * kk.y; a2 += x * kk.z; a3 += x * kk.w;
  }
  *(float4*)(st + v * 32 + d0) = make_float4(a0, a1, a2, a3);
  if (tid < 32) { float sn = 0.f; for (int j = 0; j < 64; ++j) sn += kw[j * 32 + tid]; st[2048 + tid] = sn; }
}
constexpr int ML2_ITEMS = (NSEQ_ * 2080 + NTHR - 1) / NTHR;
DI void mlstm_scan_item(const Params& p, int it) {
  const int g = it * NTHR + opaque_tid();
  if (g >= NSEQ_ * 2080) return;
  const int s = g / 2080, e = g % 2080;
  float* st = (float*)(p.ws + OFF_REGION + R_MLST) + (size_t)s * NCH_ * ML_ST;
  float state = 0.f, m = 0.f;
  for (int c = 0; c < NCH_; ++c) {
    float* r = st + (size_t)c * ML_ST;
    const float d = r[e], bl = r[2080], ml = r[2081];
    r[e] = state;
    if (e == 0) r[2082] = m;
    const float mn = fmaxf(bl + m, ml);
    state = fexp(bl + m - mn) * state + fexp(ml - mn) * d;
    m = mn;
  }
}

constexpr int P3_ITEMS = MLA_Q_TILES + MLA_KV_TILES + RWP_ITEMS + ML1_ITEMS;
DI void phase3(const Params& p, int l, char* smem) {
  for (int it = blockIdx.x; it < P3_ITEMS; it += gridDim.x) {
    int i = it;
    if (i < MLA_Q_TILES) { mla_q_item(p, l, i, smem); continue; }
    i -= MLA_Q_TILES;
    if (i < MLA_KV_TILES) { mla_kv_item(p, l, i, smem); continue; }
    i -= MLA_KV_TILES;
    if (i < RWP_ITEMS) { rwkv_prep_item(p, l, i, smem); continue; }
    i -= RWP_ITEMS;
    mlstm_local_item(p, l, i, smem);
  }
}
constexpr int ATT_KLD = 104, ATT_VLD = 68;
constexpr int ATT_KB = 64 * ATT_KLD * 2, ATT_VB = 64 * ATT_VLD * 2, ATT_STAGE = ATT_KB + ATT_VB;
DI float fexp2(float x) {
#ifdef EMU
  return exp2f(x);
#else
  return __builtin_amdgcn_exp2f(x);
#endif
}
DI void attn_item(const Params& p, int b, int h, int qt, bool isctx, char* smem) {
  const int tid = opaque_tid(), lane = tid & 63, wid = tid >> 6, r = lane & 31, h2 = lane >> 5;
  const bf16_t* qb = (const bf16_t*)(p.osc + O_QB);
  const bf16_t* kbase = (const bf16_t*)(p.ws + OFF_REGION + R_KB) + (size_t)(b * 8 + h) * KT_ * 96;
  const bf16_t* vbase = (const bf16_t*)(p.ws + OFF_REGION + R_VT) + (size_t)(b * 8 + h) * 64 * KT_;
  bf16_t* att = (bf16_t*)(p.ws + OFF_REGION + R_ATT);
  const int nq0 = isctx ? NX_ + b * CL_ + qt * 256 : b * T_ + qt * 256;
  const int nkt = (isctx ? CL_ : KT_) / 64;
  const int nq = nq0 + wid * 32 + r;
  bf16x8 qf[6];
#pragma unroll
  for (int ks = 0; ks < 6; ++ks) qf[ks] = *(const bf16x8*)(qb + (size_t)nq * 768 + h * 96 + ks * 16 + h2 * 8);
  f32x16 oacc[2] = {zero16(), zero16()};
  float m = -1e30f, lsum = 0.f;
  const float sc = 0.10206207261596577f * 1.4426950408889634f;
  const int kc1 = tid + 512;
  const int vd = tid >> 3, vc = tid & 7;
  uint4 rk0, rk1, rv;
  auto gload = [&](int kt) {
    const bf16_t* ksrc = kbase + (size_t)kt * 64 * 96;
    rk0 = *(const uint4*)(ksrc + tid * 8);
    if (kc1 < 768) rk1 = *(const uint4*)(ksrc + kc1 * 8);
    rv = *(const uint4*)(vbase + (size_t)vd * KT_ + kt * 64 + vc * 8);
  };
  auto sstore = [&](int buf) {
    char* Ks = smem + buf * ATT_STAGE; char* Vs = Ks + ATT_KB;
    *(uint4*)(Ks + ((tid / 12) * ATT_KLD + (tid % 12) * 8) * 2) = rk0;
    if (kc1 < 768) *(uint4*)(Ks + ((kc1 / 12) * ATT_KLD + (kc1 % 12) * 8) * 2) = rk1;
    *(uint2*)(Vs + (vd * ATT_VLD + vc * 8) * 2) = make_uint2(rv.x, rv.y);
    *(uint2*)(Vs + (vd * ATT_VLD + vc * 8 + 4) * 2) = make_uint2(rv.z, rv.w);
  };
  __syncthreads();
  gload(0); sstore(0);
  __syncthreads();
  for (int kt = 0; kt < nkt; ++kt) {
    const bool more = kt + 1 < nkt;
    if (more) gload(kt + 1);
    const char* Ks = smem + (kt & 1) * ATT_STAGE; const char* Vs = Ks + ATT_KB;
    f32x16 sacc[2] = {zero16(), zero16()};
#pragma unroll
    for (int ks = 0; ks < 6; ++ks)
#pragma unroll
      for (int kb = 0; kb < 2; ++kb) {
        const bf16x8 kf = *(const bf16x8*)(Ks + ((kb * 32 + r) * ATT_KLD + ks * 16 + h2 * 8) * 2);
        sacc[kb] = mfma32(kf, qf[ks], sacc[kb]);
      }
    float mx = -1e30f;
#pragma unroll
    for (int kb = 0; kb < 2; ++kb)
#pragma unroll
      for (int i = 0; i < 16; ++i) mx = fmaxf(mx, sacc[kb][i]);
    mx = fmaxf(mx, __shfl_xor(mx, 32));
    const float mn = fmaxf(m, mx * sc);
    const float alpha = fexp2(m - mn);
    m = mn;
    float ps = 0.f;
#pragma unroll
    for (int kb = 0; kb < 2; ++kb)
#pragma unroll
      for (int i = 0; i < 16; ++i) { const float pv = fexp2(sacc[kb][i] * sc - mn); sacc[kb][i] = pv; ps += pv; }
    lsum = lsum * alpha + ps;
#pragma unroll
    for (int db = 0; db < 2; ++db)
#pragma unroll
      for (int i = 0; i < 16; ++i) oacc[db][i] *= alpha;
#pragma unroll
    for (int kb = 0; kb < 2; ++kb)
#pragma unroll
      for (int s = 0; s < 2; ++s) {
        bf16x8 pf;
        {
          const unsigned u0 = pack2bf(sacc[kb][8 * s + 0], sacc[kb][8 * s + 1]), u1 = pack2bf(sacc[kb][8 * s + 2], sacc[kb][8 * s + 3]);
          const unsigned u2 = pack2bf(sacc[kb][8 * s + 4], sacc[kb][8 * s + 5]), u3 = pack2bf(sacc[kb][8 * s + 6], sacc[kb][8 * s + 7]);
          const uint4 u = make_uint4(u0, u1, u2, u3);
          __builtin_memcpy(&pf, &u, 16);
        }
#pragma unroll
        for (int db = 0; db < 2; ++db) {
          const char* vrow = Vs + ((db * 32 + r) * ATT_VLD + kb * 32 + 16 * s + 4 * h2) * 2;
          const uint2 lo = *(const uint2*)(vrow), hi = *(const uint2*)(vrow + 16);
          const uint4 u = make_uint4(lo.x, lo.y, hi.x, hi.y);
          bf16x8 vf; __builtin_memcpy(&vf, &u, 16);
          oacc[db] = mfma32(vf, pf, oacc[db]);
        }
      }
    if (more) sstore((kt + 1) & 1);
    __syncthreads();
  }
  lsum += __shfl_xor(lsum, 32);
  const float inv = 1.f / lsum;
#pragma unroll
  for (int db = 0; db < 2; ++db)
#pragma unroll
    for (int g = 0; g < 4; ++g) {
      uint2 o;
      o.x = pack2bf(oacc[db][g * 4 + 0] * inv, oacc[db][g * 4 + 1] * inv);
      o.y = pack2bf(oacc[db][g * 4 + 2] * inv, oacc[db][g * 4 + 3] * inv);
      *(uint2*)(att + (size_t)nq * 512 + h * 64 + db * 32 + 8 * g + 4 * h2) = o;
    }
}

DI float red16(float x) {
#ifdef EMU
  x += __shfl_xor(x, 1); x += __shfl_xor(x, 2); x += __shfl_xor(x, 4); x += __shfl_xor(x, 8); return x;
#else
  x += __builtin_bit_cast(float, __builtin_amdgcn_mov_dpp(__builtin_bit_cast(int, x), 0xB1, 0xf, 0xf, true));
  x += __builtin_bit_cast(float, __builtin_amdgcn_mov_dpp(__builtin_bit_cast(int, x), 0x4E, 0xf, 0xf, true));
  x += __builtin_bit_cast(float, __builtin_amdgcn_mov_dpp(__builtin_bit_cast(int, x), 0x124, 0xf, 0xf, true));
  x += __builtin_bit_cast(float, __builtin_amdgcn_mov_dpp(__builtin_bit_cast(int, x), 0x128, 0xf, 0xf, true));
  return x;
#endif
}
DI int rws_arr(int vec, int dir) { return vec == 0 ? 2 : (vec < 4 ? 2 + vec + 3 * dir : vec - 4); }
constexpr int RWS_CH = 16;
constexpr int RWS_ITEMS = NSEQ_ * 2;
constexpr int RWS_BUF = RWS_CH * 6 * 64 * 4;
DI void rwkv_scan_item(const Params& p, int it, char* smem) {
  const int s = it >> 1, rg = it & 1, dir = s >> 3, b = (s >> 2) & 1, hd = s & 3;
  const int tid = opaque_tid(), lane = tid & 63, wid = tid >> 6, c4 = (lane & 15) * 4;
  const int row = rg * 32 + wid * 4 + (lane >> 4);
  const float* rwp = (const float*)(p.ws + OFF_REGION + R_RWP);
  float* ys = (float*)(p.ws + OFF_REGION + R_YS) + (size_t)dir * NT_ * 256;
  const size_t AS = (size_t)NT_ * 256;
  float4 lr0, lr1, lr2;
#define RWS_SRC(i, ch) (rwp + rws_arr(((tid + (i) * NTHR) % 96) >> 4, dir) * AS + (size_t)seq_tok(dir, b, (ch) * RWS_CH + (tid + (i) * NTHR) / 96) * 256 + hd * 64 + ((tid + (i) * NTHR) & 15) * 4)
#define RWS_GLOAD(ch) { lr0 = *(const float4*)RWS_SRC(0, ch); lr1 = *(const float4*)RWS_SRC(1, ch); lr2 = *(const float4*)RWS_SRC(2, ch); }
#define RWS_SSTORE(buf) { *(float4*)(smem + (buf) * RWS_BUF + tid * 16) = lr0; *(float4*)(smem + (buf) * RWS_BUF + (tid + NTHR) * 16) = lr1; *(float4*)(smem + (buf) * RWS_BUF + (tid + 2 * NTHR) * 16) = lr2; }
  float s0 = 0.f, s1 = 0.f, s2 = 0.f, s3 = 0.f;
  constexpr int NCHK = KT_ / RWS_CH;
  __syncthreads();
  RWS_GLOAD(0); RWS_SSTORE(0);
  __syncthreads();
  for (int ch = 0; ch < NCHK; ++ch) {
    if (ch + 1 < NCHK) RWS_GLOAD(ch + 1);
    const float* B = (const float*)(smem + (ch & 1) * RWS_BUF);
    for (int st = 0; st < RWS_CH; ++st) {
      const float* S = B + st * 384;
      const float4 kk = *(const float4*)(S + c4), w = *(const float4*)(S + 64 + c4), kd = *(const float4*)(S + 128 + c4);
      const float4 bb = *(const float4*)(S + 192 + c4), rr = *(const float4*)(S + 256 + c4);
      const float v = S[320 + row];
      const float sa = -red16(s0 * kk.x + s1 * kk.y + s2 * kk.z + s3 * kk.w);
      s0 = s0 * w.x + (sa * bb.x + v * kd.x);
      s1 = s1 * w.y + (sa * bb.y + v * kd.y);
      s2 = s2 * w.z + (sa * bb.z + v * kd.z);
      s3 = s3 * w.w + (sa * bb.w + v * kd.w);
      const float y = red16(s0 * rr.x + s1 * rr.y + s2 * rr.z + s3 * rr.w);
      if ((lane & 15) == 0) ys[(size_t)seq_tok(dir, b, ch * RWS_CH + st) * 256 + hd * 64 + row] = y;
    }
    if (ch + 1 < NCHK) RWS_SSTORE((ch + 1) & 1);
    __syncthreads();
  }
}

DI constexpr int att_items(int l) { return NB_ * 8 * (T_ / 256) + (l == 0 ? NB_ * 8 * (CL_ / 256) : 0); }
DI void phase4(const Params& p, int l, char* smem, int* ctr) {
  const int n_att = att_items(l);
  const int total = RWS_ITEMS + ML2_ITEMS + n_att;
  int* sitem = (int*)(smem + 160 * 1024 - 16);
  for (;;) {
    __syncthreads();
    if (opaque_tid() == 0) *sitem = atomicAdd(ctr, 1);
    __syncthreads();
    int i = *sitem;
    if (i >= total) break;
    if (i < RWS_ITEMS) { rwkv_scan_item(p, i, smem); continue; }
    i -= RWS_ITEMS;
    if (i < ML2_ITEMS) { mlstm_scan_item(p, i); continue; }
    i -= ML2_ITEMS;
    const int nx = NB_ * 8 * (T_ / 256);
    if (i < nx) { const int qt = i % (T_ / 256), bh = i / (T_ / 256); attn_item(p, bh >> 3, bh & 7, qt, false, smem); }
    else { i -= nx; const int qt = i % (CL_ / 256), bh = i / (CL_ / 256); attn_item(p, bh >> 3, bh & 7, qt, true, smem); }
  }
}
constexpr int ML3_CC = CL_ / 64, ML3_XC = T_ / 64;
DI constexpr int ml3_items(bool with_ctx) { return NB_ * 4 * (ML3_XC + (with_ctx ? ML3_CC : 0)); }
DI void mlstm_out_item(const Params& p, int l, int it, bool with_ctx, char* smem) {
  const int per = ML3_XC + (with_ctx ? ML3_CC : 0);
  const int bh = it / per, b = bh >> 2, hd = bh & 3;
  int tc = it % per; if (!with_ctx) tc += ML3_CC;
  const bool isctx = tc < ML3_CC;
  const int ntok0 = isctx ? NX_ + b * CL_ + tc * 64 : b * T_ + (tc - ML3_CC) * 64;
  float* qs = (float*)smem;
  float* ks = qs + 64 * 33;
  float* vs = ks + 64 * 33;
  float* Cs = vs + 64 * 64;
  float* Sm = Cs + 64 * 33;
  float* hs = Sm + 64 * 65;
  float* bj = hs + 64 * 64;
  float* ip = bj + 64;
  float* ns = ip + 64;
  const float* zrec = (const float*)(p.ws + OFF_REGION + R_ZREC);
  const int tid = opaque_tid(), lane = tid & 63, wid = tid >> 6;
  __syncthreads();
  for (int idx = tid; idx < 64 * 64; idx += NTHR) hs[idx] = 0.f;
  for (int dir = 0; dir < 2; ++dir) {
    const int c = dir == 0 ? tc : (isctx ? ML3_CC - 1 - tc : ML3_CC + (ML3_XC - 1 - (tc - ML3_CC)));
    const int s = dir * 8 + b * 4 + hd;
    const float* st = (const float*)(p.ws + OFF_REGION + R_MLST) + ((size_t)s * NCH_ + c) * ML_ST;
    const float m_start = st[2082];
    __syncthreads();
    for (int idx = tid; idx < 64 * 32; idx += NTHR) {
      const int j = idx >> 5, e = idx & 31;
      const int n = ntok0 + (dir ? 63 - j : j);
      qs[j * 33 + e] = zrec[(size_t)n * ZREC_W + ZR_MLQ + hd * 32 + e] * 0.17677669529663687f;
      ks[j * 33 + e] = zrec[(size_t)n * ZREC_W + ZR_MLK + hd * 32 + e];
      Cs[j * 33 + e] = st[j * 32 + e];
    }
    for (int idx = tid; idx < 64 * 64; idx += NTHR) {
      const int j = idx >> 6, e = idx & 63;
      const int n = ntok0 + (dir ? 63 - j : j);
      vs[idx] = zrec[(size_t)n * ZREC_W + ZR_MLV + hd * 64 + e];
    }
    if (tid < 32) ns[tid] = st[2048 + tid];
    if (wid == 1) {
      const int n = ntok0 + (dir ? 63 - lane : lane);
      const float fp = zrec[(size_t)n * ZREC_W + ZR_MLF + dir * 4 + hd] + p.ml_b_f[(l * 2 + dir) * 4 + hd];
      ip[lane] = zrec[(size_t)n * ZREC_W + ZR_MLI + dir * 4 + hd] + p.ml_b_i[(l * 2 + dir) * 4 + hd];
      bj[lane] = wave_incl_scan(logsigmoidf_(fp), lane);
    }
    __syncthreads();
    const int j = tid >> 3, sg = tid & 7;
    const float bjj = bj[j];
    float rmax = -1e30f;
#pragma unroll 1
    for (int u = 0; u < 8; ++u) {
      const int sI = sg * 8 + u;
      float d = 0.f;
#pragma unroll 8
      for (int e = 0; e < 32; ++e) d += qs[j * 33 + e] * ks[sI * 33 + e];
      Sm[j * 65 + sI] = d;
      const float dl = sI <= j ? bjj - bj[sI] + ip[sI] : -1e30f;
      rmax = fmaxf(rmax, dl);
    }
    rmax = fmaxf(rmax, __shfl_xor(rmax, 1)); rmax = fmaxf(rmax, __shfl_xor(rmax, 2)); rmax = fmaxf(rmax, __shfl_xor(rmax, 4));
    const float g = bjj + m_start;
    const float mj = fmaxf(g, rmax);
    const float inter = fexp(g - mj);
    float part = 0.f;
#pragma unroll 1
    for (int u = 0; u < 8; ++u) {
      const int sI = sg * 8 + u;
      const float sv = sI <= j ? fexp(bjj - bj[sI] + ip[sI] - mj) * Sm[j * 65 + sI] : 0.f;
      Sm[j * 65 + sI] = sv; part += sv;
    }
    float nq = 0.f;
#pragma unroll
    for (int e = 0; e < 4; ++e) nq += ns[sg * 4 + e] * qs[j * 33 + sg * 4 + e];
    part += inter * nq;
    part += __shfl_xor(part, 1); part += __shfl_xor(part, 2); part += __shfl_xor(part, 4);
    const float den = fmaxf(fabsf(part), fexp(-mj));
    __syncthreads();
    const int v0 = sg * 8;
    float num[8], cq[8];
#pragma unroll
    for (int u = 0; u < 8; ++u) { num[u] = 0.f; cq[u] = 0.f; }
#pragma unroll 2
    for (int sI = 0; sI <= j; ++sI) {
      const float sv = Sm[j * 65 + sI];
      const float4 va = *(const float4*)(vs + sI * 64 + v0), vb = *(const float4*)(vs + sI * 64 + v0 + 4);
      num[0] += sv * va.x; num[1] += sv * va.y; num[2] += sv * va.z; num[3] += sv * va.w;
      num[4] += sv * vb.x; num[5] += sv * vb.y; num[6] += sv * vb.z; num[7] += sv * vb.w;
    }
#pragma unroll 2
    for (int e = 0; e < 32; ++e) {
      const float qv = qs[j * 33 + e];
#pragma unroll
      for (int u = 0; u < 8; ++u) cq[u] += Cs[(v0 + u) * 33 + e] * qv;
    }
    const float rden = 1.f / den;
#pragma unroll
    for (int u = 0; u < 8; ++u) hs[(dir ? 63 - j : j) * 64 + v0 + u] += (num[u] + inter * cq[u]) * rden;
    __syncthreads();
  }
  const int tk = tid >> 3, v0 = (tid & 7) * 8, n = ntok0 + tk;
  float ss = 0.f; float hv[8];
#pragma unroll
  for (int u = 0; u < 8; ++u) { hv[u] = hs[tk * 64 + v0 + u]; ss += hv[u] * hv[u]; }
  ss += __shfl_xor(ss, 1); ss += __shfl_xor(ss, 2); ss += __shfl_xor(ss, 4);
  const float rs = 1.0f / sqrtf(ss * (1.f / 64.f) + 1e-6f);
  unsigned o[4];
#pragma unroll
  for (int u = 0; u < 8; u += 2) {
    const int cc = hd * 64 + v0 + u;
    const float a = hv[u] * rs * p.ml_g_norm[l * 256 + cc] * sigmoidf_(zrec[(size_t)n * ZREC_W + ZR_MLO + cc]);
    const float bq = hv[u + 1] * rs * p.ml_g_norm[l * 256 + cc + 1] * sigmoidf_(zrec[(size_t)n * ZREC_W + ZR_MLO + cc + 1]);
    o[u >> 1] = pack2bf(a, bq);
  }
  bf16_t* mlo = (bf16_t*)(p.ws + OFF_REGION + R_MLO);
  *(uint4*)(mlo + (size_t)n * 256 + hd * 64 + v0) = make_uint4(o[0], o[1], o[2], o[3]);
}

DI constexpr int rwo_items(bool with_ctx) { return (with_ctx ? NT_ : NX_) / 16; }
DI void rwkv_out_item(const Params& p, int l, int it, char* smem) {
  float* sg = (float*)smem;
  const float* zrec = (const float*)(p.ws + OFF_REGION + R_ZREC);
  const float* rwp = (const float*)(p.ws + OFF_REGION + R_RWP);
  const float* ys = (const float*)(p.ws + OFF_REGION + R_YS);
  bf16_t* rwo = (bf16_t*)(p.ws + OFF_REGION + R_RWO);
  const float* mu = p.rw_mu + (size_t)l * 1152;
  const int tid = opaque_tid(), n0 = it * 16;
  __syncthreads();
  for (int idx = tid; idx < 16 * 128; idx += NTHR) {
    const int tt = idx >> 7, k = idx & 127, n = n0 + tt, t = tok_t(n), c = 1024 + k;
    const int len = n < NX_ ? T_ : CL_;
    const float* zr = zrec + (size_t)n * ZREC_W + ZR_RW + c;
    const float z = zr[0];
    const float zp = t > 0 ? zr[-ZREC_W] : 0.f, zn = t < len - 1 ? zr[ZREC_W] : 0.f;
    sg[k * 16 + tt] = sigmoidf_(z + (0.5f * (zp + zn) - z) * mu[c]);
  }
  __syncthreads();
  const int col = tid & 255, half = tid >> 8;
  float acc[8];
#pragma unroll
  for (int i = 0; i < 8; ++i) acc[i] = 0.f;
  const float* g2 = p.rw_g2 + (size_t)l * 128 * 256 + col;
  for (int k = 0; k < 128; ++k) {
    const float gv = g2[k * 256];
    const float* sk = sg + k * 16 + half * 8;
#pragma unroll
    for (int i = 0; i < 8; ++i) acc[i] += sk[i] * gv;
  }
  const size_t AS = (size_t)NT_ * 256;
  const float rk = p.rw_r_k[(size_t)l * 256 + col], lw = p.rw_lnx_w[(size_t)l * 256 + col], lb = p.rw_lnx_b[(size_t)l * 256 + col];
#pragma unroll
  for (int i = 0; i < 8; ++i) {
    const int n = n0 + half * 8 + i;
    const size_t o = (size_t)n * 256 + col;
    const float y = ys[o] + ys[AS + o];
    const float mean = wave_sum(y) * (1.f / 64.f);
    const float dv = y - mean;
    const float var = wave_sum(dv * dv) * (1.f / 64.f);
    const float yn = dv * (1.0f / sqrtf(var + 64e-5f)) * lw + lb;
    const float r = rwp[0 * AS + o], v = rwp[1 * AS + o];
    const float bsum = wave_sum(r * rk * (rwp[4 * AS + o] + rwp[7 * AS + o]));
    rwo[o] = f2bf((yn + bsum * v) * acc[i]);
  }
}
DI void phase5(const Params& p, int l, bool with_ctx, char* smem) {
  const int n1 = ml3_items(with_ctx), n2 = rwo_items(with_ctx);
  for (int it = blockIdx.x; it < n1 + n2; it += gridDim.x) {
    if (it < n1) mlstm_out_item(p, l, it, with_ctx, smem);
    else rwkv_out_item(p, l, it - n1, smem);
  }
}
DI void phase_merge(const Params& p, int l, bool with_ctx, char* smem) {
  const bf16_t* H = (const bf16_t*)(p.ws + OFF_H);
  const char* W = p.ws + OFF_WMIX + (size_t)l * WM_SIZE;
  const bf16_t* Wg = (const bf16_t*)(W + WM_GATE);
  const bf16_t* att = (const bf16_t*)(p.ws + OFF_REGION + R_ATT);
  const bf16_t* mlo = (const bf16_t*)(p.ws + OFF_REGION + R_MLO);
  const bf16_t* rwo = (const bf16_t*)(p.ws + OFF_REGION + R_RWO);
  bf16_t* ymix = (bf16_t*)(p.osc + O_YMIX);
  const int TM = (with_ctx ? NT_ : NX_) / 128;
  for (int it = blockIdx.x; it < TM * 8; it += gridDim.x) {
    const int tid = opaque_tid();
    const int tm = it >> 3, tn = it & 7;
    f32x16 yacc[G128::MB][G128::NB];
#pragma unroll
    for (int a = 0; a < G128::MB; ++a)
#pragma unroll
      for (int b = 0; b < G128::NB; ++b) yacc[a][b] = zero16();
#pragma unroll
    for (int i = 0; i < 3; ++i) {
      f32x16 gacc[G128::MB][G128::NB], bacc[G128::MB][G128::NB];
#pragma unroll
      for (int a = 0; a < G128::MB; ++a)
#pragma unroll
        for (int b = 0; b < G128::NB; ++b) { gacc[a][b] = zero16(); bacc[a][b] = zero16(); }
      const bf16_t* A0 = H + (size_t)tm * 128 * 1024;
      G128::run(gacc, [&](int r) { return A0 + (size_t)r * 1024; }, Wg + ((size_t)i * 1024 + tn * 128) * 1024, 1024, 1024, smem);
      const bf16_t* br = i == 0 ? att : (i == 1 ? mlo : rwo);
      const int kb = i == 0 ? 512 : 256;
      const bf16_t* Wb = (const bf16_t*)(W + (i == 0 ? WM_BRA : (i == 1 ? WM_BRM : WM_BRR)));
      const bf16_t* B0 = br + (size_t)tm * 128 * kb;
      G128::run(bacc, [&](int r) { return B0 + (size_t)r * kb; }, Wb + (size_t)tn * 128 * kb, kb, kb, smem);
#pragma unroll
      for (int a = 0; a < G128::MB; ++a)
#pragma unroll
        for (int b = 0; b < G128::NB; ++b)
#pragma unroll
          for (int e = 0; e < 16; ++e) yacc[a][b][e] += sigmoidf_(gacc[a][b][e]) * bacc[a][b][e];
    }
#pragma unroll
    for (int mb = 0; mb < G128::MB; ++mb)
#pragma unroll
      for (int nb = 0; nb < G128::NB; ++nb) {
        const int col = tn * 128 + G128::col_of(tid, nb);
#pragma unroll
        for (int e = 0; e < 16; ++e) ymix[(size_t)(tm * 128 + G128::row_of(tid, mb, e)) * 1024 + col] = f2bf(yacc[mb][nb][e]);
      }
  }
}

DI void phase_wout(const Params& p, int l, bool with_ctx, char* smem) {
  const bf16_t* ymix = (const bf16_t*)(p.osc + O_YMIX);
  const bf16_t* Wo = (const bf16_t*)(p.ws + OFF_WMIX + (size_t)l * WM_SIZE + WM_OUT);
  float* xs = (float*)(p.ws + OFF_XS);
  const float* mod = (const float*)(p.ws + OFF_MOD) + (size_t)l * 3 * 6144;
  const int TM = (with_ctx ? NT_ : NX_) / 128;
  const int n_g = TM * 8;
  for (int it = blockIdx.x; it < n_g + CVT_MOE_TILES; it += gridDim.x) {
    if (it >= n_g) { cvt_moe_item(p, l, it - n_g, smem); continue; }
    const int tid = opaque_tid();
    const int tm = it >> 3, tn = it & 7;
    f32x16 acc[G128::MB][G128::NB];
#pragma unroll
    for (int a = 0; a < G128::MB; ++a)
#pragma unroll
      for (int b = 0; b < G128::NB; ++b) acc[a][b] = zero16();
    const bf16_t* A0 = ymix + (size_t)tm * 128 * 1024;
    G128::run(acc, [&](int r) { return A0 + (size_t)r * 1024; }, Wo + (size_t)tn * 128 * 1024, 1024, 1024, smem);
    const float* m2 = mod + (size_t)tok_modrow(tm * 128) * 6144 + 2 * 1024;
#pragma unroll
    for (int mb = 0; mb < G128::MB; ++mb)
#pragma unroll
      for (int nb = 0; nb < G128::NB; ++nb) {
        const int col = tn * 128 + G128::col_of(tid, nb);
        const float g = m2[col];
#pragma unroll
        for (int e = 0; e < 16; ++e) {
          float* d = xs + (size_t)(tm * 128 + G128::row_of(tid, mb, e)) * 1024 + col;
          *d = *d + g * acc[mb][nb][e];
        }
      }
  }
}

typedef Gemm<128, 64, 64, 4, 2> GRT;
DI void phase_router(const Params& p, int l, bool with_ctx, char* smem, int* cnt) {
  float* xs = (float*)(p.ws + OFF_XS);
  bf16_t* H = (bf16_t*)(p.ws + OFF_H);
  const float* mod = (const float*)(p.ws + OFF_MOD) + (size_t)l * 3 * 6144;
  const bf16_t* Wr = (const bf16_t*)(p.ws + OFF_WMIX + (size_t)l * WM_SIZE + WM_RT);
  int* eidx = (int*)(p.ws + OFF_REGION + R_EIDX);
  float* ewt = (float*)(p.ws + OFF_REGION + R_EWT);
  int* erank = (int*)(p.ws + OFF_REGION + R_ERANK);
  int* elist = (int*)(p.ws + OFF_REGION + R_ELIST);
  float* sc = (float*)(smem + GRT::SMEM);
  float* bs = sc + 128 * 65;
  float* gs = bs + 128 * 65;
  const int tid = opaque_tid(), lane = tid & 63, wid = tid >> 6;
  const int ntok = with_ctx ? NT_ : NX_;
  for (int it = blockIdx.x; it < ntok / 128; it += gridDim.x) {
    const int n0 = it * 128;
    __syncthreads();
    for (int rr = 0; rr < 16; ++rr) {
      const int n = n0 + wid * 16 + rr;
      float v[16];
#pragma unroll
      for (int j = 0; j < 4; ++j) {
        const float4 t = *(const float4*)(xs + (size_t)n * 1024 + (j * 64 + lane) * 4);
        v[j * 4] = t.x; v[j * 4 + 1] = t.y; v[j * 4 + 2] = t.z; v[j * 4 + 3] = t.w;
      }
      const float* m = mod + (size_t)tok_modrow(n) * 6144;
      row_norm_mod(v, p.g_ffn + (size_t)l * 1024, m + 3 * 1024, m + 4 * 1024, H + (size_t)n * 1024, lane);
    }
    __syncthreads();
    f32x16 acc[1][1]; acc[0][0] = zero16();
    const bf16_t* A0 = H + (size_t)n0 * 1024;
    GRT::run(acc, [&](int r) { return A0 + (size_t)r * 1024; }, Wr, 1024, 1024, smem);
    {
      const int col = GRT::col_of(tid, 0);
      const float rb = p.router_bias[l * 64 + col];
#pragma unroll
      for (int e = 0; e < 16; ++e) {
        const int row = GRT::row_of(tid, 0, e);
        const float s = sigmoidf_(acc[0][0][e]);
        sc[row * 65 + col] = s; bs[row * 65 + col] = s + rb;
      }
    }
    __syncthreads();
    if (tid < 128) {
      const int n = n0 + tid;
      float* b = bs + tid * 65; const float* s = sc + tid * 65; float* g = gs + tid * 9;
      for (int gi = 0; gi < 8; ++gi) {
        float m1 = -1e30f, m2 = -1e30f;
        for (int j = 0; j < 8; ++j) { const float x = b[gi * 8 + j]; if (x > m1) { m2 = m1; m1 = x; } else if (x > m2) m2 = x; }
        g[gi] = m1 + m2;
      }
      unsigned gmask = 0;
      for (int c = 0; c < 4; ++c) {
        int best = 0; float bv = -1e30f;
        for (int gi = 0; gi < 8; ++gi) if (!((gmask >> gi) & 1) && g[gi] > bv) { bv = g[gi]; best = gi; }
        gmask |= 1u << best;
      }
      for (int gi = 0; gi < 8; ++gi) if (!((gmask >> gi) & 1)) for (int j = 0; j < 8; ++j) b[gi * 8 + j] = -1e30f;
      int sel[8]; float wsum = 0.f;
#pragma unroll
      for (int c = 0; c < 8; ++c) {
        int best = 0; float bv = -1e30f;
        for (int e = 0; e < 64; ++e) { const float x = b[e]; if (x > bv) { bv = x; best = e; } }
        b[best] = -3e30f; sel[c] = best; wsum += s[best];
      }
      const float inv = 2.5f / (wsum + 1e-20f);
#pragma unroll
      for (int c = 0; c < 8; ++c) {
        const int e = sel[c];
        const int rk = atomicAdd(cnt + e, 1);
        eidx[n * 8 + c] = e; ewt[n * 8 + c] = s[e] * inv; erank[n * 8 + c] = rk;
        elist[(size_t)e * NT_ + rk] = n * 8 + c;
      }
    }
  }
}

typedef Gemm<128, 256, 32, 2, 4> GMOE;
constexpr int ACT_LD = 264;
constexpr int MOE_ACT_OFF = GMOE::SMEM;
constexpr int MOE_INFO_OFF = MOE_ACT_OFF + 128 * ACT_LD * 2;
static_assert(MOE_INFO_OFF + 128 * 8 + 67 * 4 * 2 <= 160 * 1024 - 16, "moe lds");
DI void moe_down_run(f32x16 (&acc)[GMOE::MB][GMOE::NB], const char* actl, const bf16_t* Bt, char* smem) {
  constexpr int BK = 32, LDA = GMOE::LDA, CPR = 4, BCH = GMOE::BCH, STG = GMOE::B_BYTES;
  const int tid = opaque_tid(), lane = tid & 63, wid = tid >> 6, wm = wid / 4, wn = wid % 4;
  const int kc = (tid % CPR) * 8, r0 = tid / CPR;
  uint4 rb[BCH];
  char* Bs0 = smem;
#pragma unroll
  for (int i = 0; i < BCH; ++i) rb[i] = *(const uint4*)(Bt + (size_t)(r0 + i * 128) * 256 + kc);
#pragma unroll
  for (int i = 0; i < BCH; ++i) *(uint4*)(Bs0 + ((r0 + i * 128) * LDA + kc) * 2) = rb[i];
  __syncthreads();
  for (int kt = 0; kt < 256 / BK; ++kt) {
    const bool more = kt + 1 < 256 / BK;
    if (more) {
#pragma unroll
      for (int i = 0; i < BCH; ++i) rb[i] = *(const uint4*)(Bt + (size_t)(r0 + i * 128) * 256 + (kt + 1) * BK + kc);
    }
    const char* Bs = Bs0 + (kt & 1) * STG;
#pragma unroll
    for (int ks = 0; ks < BK / 16; ++ks) {
      bf16x8 af[GMOE::MB], bfr[GMOE::NB];
#pragma unroll
      for (int mb = 0; mb < GMOE::MB; ++mb)
        af[mb] = *(const bf16x8*)(actl + ((wm * 64 + mb * 32 + (lane & 31)) * ACT_LD + kt * BK + ks * 16 + (lane >> 5) * 8) * 2);
#pragma unroll
      for (int nb = 0; nb < GMOE::NB; ++nb)
        bfr[nb] = *(const bf16x8*)(Bs + ((wn * 64 + nb * 32 + (lane & 31)) * LDA + ks * 16 + (lane >> 5) * 8) * 2);
#pragma unroll
      for (int mb = 0; mb < GMOE::MB; ++mb)
#pragma unroll
        for (int nb = 0; nb < GMOE::NB; ++nb) acc[mb][nb] = mfma32(af[mb], bfr[nb], acc[mb][nb]);
    }
    if (more) {
      char* Bd = Bs0 + ((kt + 1) & 1) * STG;
#pragma unroll
      for (int i = 0; i < BCH; ++i) *(uint4*)(Bd + ((r0 + i * 128) * LDA + kc) * 2) = rb[i];
    }
    __syncthreads();
  }
}
DI void phase_moe(const Params& p, int l, bool with_ctx, char* smem, const int* cnt) {
  const bf16_t* H = (const bf16_t*)(p.ws + OFF_H);
  const bf16_t* GU = (const bf16_t*)(p.ws + OFF_REGION + R_WMOE + WE_GU);
  const bf16_t* DN = (const bf16_t*)(p.ws + OFF_REGION + R_WMOE + WE_DN);
  const float* ewt = (const float*)(p.ws + OFF_REGION + R_EWT);
  const int* elist = (const int*)(p.ws + OFF_REGION + R_ELIST);
  bf16_t* ybuf = (bf16_t*)(p.ws + OFF_REGION + R_YBUF);
  char* actl = smem + MOE_ACT_OFF;
  int* rtok = (int*)(smem + MOE_INFO_OFF);
  float* rwt = (float*)(rtok + 128);
  int* pre = (int*)(rwt + 128);
  int* off = pre + 67;
  int tid = threadIdx.x;
  const int ntok = with_ctx ? NT_ : NX_;
  __syncthreads();
  if (tid == 0) {
    int a = 0, o = 0;
    for (int e = 0; e < 65; ++e) { const int c = e < 64 ? cnt[e] : ntok; pre[e] = a; off[e] = o; a += (c + 127) >> 7; o += c; }
    pre[65] = a; off[65] = o;
  }
  __syncthreads();
  const int total = pre[65];
  for (int it = blockIdx.x; it < total; it += gridDim.x) {
    tid = opaque_tid();
    int e0 = 0;
    while (pre[e0 + 1] <= it) ++e0;
    const int e = rfl(e0);
    const int rb = rfl(it - pre[e]);
    const int c = rfl(e < 64 ? cnt[e] : ntok);
    const int obase = rfl(off[e] + rb * 128);
    __syncthreads();
    if (tid < 128) {
      const int slot = rb * 128 + tid;
      int tok = 0; float w = 0.f;
      if (slot < c) {
        if (e < 64) { const int pk = elist[(size_t)e * NT_ + slot]; tok = pk >> 3; w = ewt[pk]; }
        else { tok = slot; w = 1.f; }
      }
      rtok[tid] = tok; rwt[tid] = w;
    }
    __syncthreads();
    const bf16_t* Wgu = GU + (size_t)e * 512 * 1024;
#pragma unroll 1
    for (int hf = 0; hf < 2; ++hf) {
      f32x16 acc[GMOE::MB][GMOE::NB];
#pragma unroll
      for (int a = 0; a < GMOE::MB; ++a)
#pragma unroll
        for (int b = 0; b < GMOE::NB; ++b) acc[a][b] = zero16();
      GMOE::run(acc, [&](int r) { return H + (size_t)rtok[r] * 1024; }, Wgu + (size_t)hf * 256 * 1024, 1024, 1024, smem);
      const int lane = tid & 63, wn = (tid >> 6) % 4, wmr = ((tid >> 6) / 4) * 64 + 4 * (lane >> 5);
      const int j = (hf * 4 + wn) * 32 + (lane & 31);
#pragma unroll
      for (int mb = 0; mb < GMOE::MB; ++mb)
#pragma unroll
        for (int i = 0; i < 16; ++i) {
          const int row = wmr + mb * 32 + (i & 3) + 8 * (i >> 2);
          const float g = acc[mb][0][i], u = acc[mb][1][i];
          *(bf16_t*)(actl + (row * ACT_LD + j) * 2) = f2bf(siluf_(g) * u);
        }
    }
    __syncthreads();
    const bf16_t* Wd = DN + (size_t)e * 1024 * 256;
#pragma unroll 1
    for (int nt = 0; nt < 4; ++nt) {
      f32x16 acc[GMOE::MB][GMOE::NB];
#pragma unroll
      for (int a = 0; a < GMOE::MB; ++a)
#pragma unroll
        for (int b = 0; b < GMOE::NB; ++b) acc[a][b] = zero16();
      moe_down_run(acc, actl, Wd + (size_t)nt * 256 * 256, smem);
#pragma unroll
      for (int mb = 0; mb < GMOE::MB; ++mb)
#pragma unroll
        for (int nb = 0; nb < GMOE::NB; ++nb) {
          const int col = nt * 256 + ((tid >> 6) % 4) * 64 + nb * 32 + (tid & 31);
#pragma unroll
          for (int i = 0; i < 16; ++i) {
            const int row = ((tid >> 6) / 4) * 64 + 4 * ((tid & 63) >> 5) + mb * 32 + (i & 3) + 8 * (i >> 2);
            if (rb * 128 + row < c) (ybuf + (size_t)obase * 1024)[(unsigned)(row * 1024 + col)] = f2bf(acc[mb][nb][i] * rwt[row]);
          }
        }
    }
  }
}

DI void phase_combine(const Params& p, int l, bool last, char* smem, const int* cnt) {
  float* xs = (float*)(p.ws + OFF_XS);
  bf16_t* H = (bf16_t*)(p.ws + OFF_H);
  const float* mod = (const float*)(p.ws + OFF_MOD);
  const int* eidx = (const int*)(p.ws + OFF_REGION + R_EIDX);
  const int* erank = (const int*)(p.ws + OFF_REGION + R_ERANK);
  const bf16_t* ybuf = (const bf16_t*)(p.ws + OFF_REGION + R_YBUF);
  int* off = (int*)smem;
  const int tid = opaque_tid(), lane = tid & 63, wid = tid >> 6;
  const int ntok = last ? NX_ : NT_;
  __syncthreads();
  if (tid == 0) { int o = 0; for (int e = 0; e < 64; ++e) { off[e] = o; o += cnt[e]; } off[64] = o; }
  __syncthreads();
  for (int n = blockIdx.x * 8 + wid; n < ntok; n += gridDim.x * 8) {
    float acc[16];
#pragma unroll
    for (int i = 0; i < 16; ++i) acc[i] = 0.f;
    for (int k = 0; k < 9; ++k) {
      const int row = k < 8 ? off[eidx[n * 8 + k]] + erank[n * 8 + k] : off[64] + n;
      const bf16_t* y = ybuf + (size_t)row * 1024;
#pragma unroll
      for (int j = 0; j < 4; ++j) {
        const uint2 u = *(const uint2*)(y + (j * 64 + lane) * 4);
        acc[j * 4 + 0] += bf2f((bf16_t)(u.x & 0xffff)); acc[j * 4 + 1] += bf2f((bf16_t)(u.x >> 16));
        acc[j * 4 + 2] += bf2f((bf16_t)(u.y & 0xffff)); acc[j * 4 + 3] += bf2f((bf16_t)(u.y >> 16));
      }
    }
    const float* m5 = mod + ((size_t)l * 3 + tok_modrow(n)) * 6144 + 5 * 1024;
    float v[16];
#pragma unroll
    for (int j = 0; j < 4; ++j) {
      const int c = (j * 64 + lane) * 4;
      const float4 x = *(const float4*)(xs + (size_t)n * 1024 + c), g = *(const float4*)(m5 + c);
      v[j * 4 + 0] = x.x + g.x * acc[j * 4 + 0]; v[j * 4 + 1] = x.y + g.y * acc[j * 4 + 1];
      v[j * 4 + 2] = x.z + g.z * acc[j * 4 + 2]; v[j * 4 + 3] = x.w + g.w * acc[j * 4 + 3];
      if (!last) *(float4*)(xs + (size_t)n * 1024 + c) = make_float4(v[j * 4], v[j * 4 + 1], v[j * 4 + 2], v[j * 4 + 3]);
    }
    if (!last) {
      const float* m = mod + ((size_t)(l + 1) * 3 + tok_modrow(n)) * 6144;
      row_norm_mod(v, p.g_mix + (size_t)(l + 1) * 1024, m, m + 1024, H + (size_t)n * 1024, lane);
    } else {
      float ss = 0.f;
#pragma unroll
      for (int i = 0; i < 16; ++i) ss += v[i] * v[i];
      ss = wave_sum(ss);
      const float rs = 1.0f / sqrtf(ss * (1.f / 1024.f) + 1e-6f);
#pragma unroll
      for (int j = 0; j < 4; ++j) {
        const int c = (j * 64 + lane) * 4;
        const float4 g = *(const float4*)(p.g_final + c);
        *(float4*)(p.out + (size_t)n * 1024 + c) = make_float4(v[j * 4] * rs * g.x, v[j * 4 + 1] * rs * g.y, v[j * 4 + 2] * rs * g.z, v[j * 4 + 3] * rs * g.w);
      }
    }
  }
}
#define SMEM_BYTES (160 * 1024)
#ifndef MEGA
#define MEGA 0
#endif
DI int* cnt_ptr(const Params& p, int l) { return (int*)(p.ws + OFF_CNT) + 64 * l; }
DI int* ctr_ptr(const Params& p, int l) { return (int*)(p.ws + OFF_CNT) + 128 + l; }
#if !MEGA
__global__ void __launch_bounds__(NTHR) k_phaseA(Params p) { SMEM_DECL(smem, SMEM_BYTES); phaseA(p, smem); }
__global__ void __launch_bounds__(NTHR) k_norm0(Params p) { phase_norm0(p); }
__global__ void __launch_bounds__(NTHR) k_win(Params p, int l) { SMEM_DECL(smem, SMEM_BYTES); phase_win(p, l, smem); }
__global__ void __launch_bounds__(NTHR) k_p3(Params p, int l) { SMEM_DECL(smem, SMEM_BYTES); phase3(p, l, smem); }
__global__ void __launch_bounds__(NTHR) k_p4(Params p, int l) { SMEM_DECL(smem, SMEM_BYTES); phase4(p, l, smem, ctr_ptr(p, l)); }
__global__ void __launch_bounds__(NTHR) k_p5(Params p, int l, int wc) { SMEM_DECL(smem, SMEM_BYTES); phase5(p, l, wc != 0, smem); }
__global__ void __launch_bounds__(NTHR) k_merge(Params p, int l, int wc) { SMEM_DECL(smem, SMEM_BYTES); phase_merge(p, l, wc != 0, smem); }
__global__ void __launch_bounds__(NTHR) k_wout(Params p, int l, int wc) { SMEM_DECL(smem, SMEM_BYTES); phase_wout(p, l, wc != 0, smem); }
__global__ void __launch_bounds__(NTHR) k_router(Params p, int l, int wc) { SMEM_DECL(smem, SMEM_BYTES); phase_router(p, l, wc != 0, smem, cnt_ptr(p, l)); }
__global__ void __launch_bounds__(NTHR) k_moe(Params p, int l, int wc) { SMEM_DECL(smem, SMEM_BYTES); phase_moe(p, l, wc != 0, smem, cnt_ptr(p, l)); }
__global__ void __launch_bounds__(NTHR) k_combine(Params p, int l, int last) { SMEM_DECL(smem, SMEM_BYTES); phase_combine(p, l, last != 0, smem, cnt_ptr(p, l)); }
#else
__global__ void __launch_bounds__(NTHR) k_mega(Params p) {
  SMEM_DECL(smem, SMEM_BYTES);
  cooperative_groups::grid_group grid = cooperative_groups::this_grid();
  phaseA(p, smem);
  grid.sync();
  phase_norm0(p);
  grid.sync();
#pragma unroll 1
  for (int l = 0; l < 2; ++l) {
    const bool wc = l == 0;
    phase_win(p, l, smem); grid.sync();
    phase3(p, l, smem); grid.sync();
    phase4(p, l, smem, ctr_ptr(p, l)); grid.sync();
    phase5(p, l, wc, smem); grid.sync();
    phase_merge(p, l, wc, smem); grid.sync();
    phase_wout(p, l, wc, smem); grid.sync();
    phase_router(p, l, wc, smem, cnt_ptr(p, l)); grid.sync();
    phase_moe(p, l, wc, smem, cnt_ptr(p, l)); grid.sync();
    phase_combine(p, l, l == 1, smem, cnt_ptr(p, l));
    if (l == 0) grid.sync();
  }
}
#endif

extern "C" void kernel_launch(void* const* d_in, const int* in_sizes, int n_in, void* d_out, int out_size, void* d_ws,
                              size_t ws_size, hipStream_t stream) {
  Params p{};
  const float** pp = (const float**)&p;
  for (int i = 0; i < 41; ++i) pp[i] = (const float*)d_in[i];
  p.out = (float*)d_out; p.ws = (char*)d_ws; p.osc = (char*)d_out;
  if (ws_size < WS_NEEDED) { fprintf(stderr, "workspace too small: %zu < %zu\n", ws_size, (size_t)WS_NEEDED); return; }
#if !MEGA
  const dim3 g(256), b(NTHR);
  hipLaunchKernelGGL(k_phaseA, g, b, 0, stream, p);
  hipLaunchKernelGGL(k_norm0, g, b, 0, stream, p);
  for (int l = 0; l < 2; ++l) {
    const int wc = l == 0;
    hipLaunchKernelGGL(k_win, g, b, 0, stream, p, l);
    hipLaunchKernelGGL(k_p3, g, b, 0, stream, p, l);
    hipLaunchKernelGGL(k_p4, g, b, 0, stream, p, l);
    hipLaunchKernelGGL(k_p5, g, b, 0, stream, p, l, wc);
    hipLaunchKernelGGL(k_merge, g, b, 0, stream, p, l, wc);
    hipLaunchKernelGGL(k_wout, g, b, 0, stream, p, l, wc);
    hipLaunchKernelGGL(k_router, g, b, 0, stream, p, l, wc);
    hipLaunchKernelGGL(k_moe, g, b, 0, stream, p, l, wc);
    hipLaunchKernelGGL(k_combine, g, b, 0, stream, p, l, l == 1);
  }
#else
  static int grid_blocks = 0;
  if (!grid_blocks) {
    int dev = 0, cus = 0, per_cu = 0;
    hipGetDevice(&dev);
    hipDeviceGetAttribute(&cus, hipDeviceAttributeMultiprocessorCount, dev);
    hipOccupancyMaxActiveBlocksPerMultiprocessor(&per_cu, k_mega, NTHR, 0);
    if (per_cu > 1) per_cu = 1;
    grid_blocks = cus * per_cu;
  }
  void* args[] = {&p};
  hipError_t e = hipLaunchCooperativeKernel((void*)k_mega, dim3(grid_blocks), dim3(NTHR), args, 0, stream);
  if (e != hipSuccess) fprintf(stderr, "cooperative launch failed: %s (grid %d)\n", hipGetErrorString(e), grid_blocks);
#endif
}
```

```cpp
#define MEGA 1
#include <hip/hip_runtime.h>
#include <hip/hip_cooperative_groups.h>
#include <cstdio>

#ifndef SEQ_T
#define SEQ_T 8192
#endif
#ifndef CTX_L
#define CTX_L 256
#endif

#define DI __device__ __forceinline__
typedef unsigned short bf16_t;
typedef short bf16x8 __attribute__((ext_vector_type(8)));
typedef float f32x16 __attribute__((ext_vector_type(16)));
typedef float f32x4 __attribute__((ext_vector_type(4)));

constexpr int NB_ = 2, T_ = SEQ_T, CL_ = CTX_L, D_ = 1024;
constexpr int NX_ = NB_ * T_, NC_ = NB_ * CL_, NT_ = NX_ + NC_, KT_ = CL_ + T_;
constexpr int GRID_W_ = 64;
constexpr int MLA_H = 8, MLA_NOPE_ = 64, MLA_ROPE_ = 32, MLA_DK = 96, MLA_DV = 64, QLORA = 384, KVLORA = 256;
constexpr int MLA_IN_ = 672, ML_IN_ = 784, RW_IN_ = 1152, GATE_IN_ = 3072, D_IN_ = 5680;
constexpr int ZMLA_W = 768;
constexpr int ZREC_W = 1936;
constexpr int WIN_N = 768 + 2048;
constexpr int ML_H = 4, ML_DK = 32, ML_DV = 64, ML_L = 64;
constexpr int RW_H = 4, RW_N_ = 64;
constexpr int NE_ = 64, TOPK_ = 8, DE_ = 256;
constexpr int NCH_ = KT_ / ML_L;
constexpr int NSEQ_ = 2 * NB_ * 4;

constexpr int ZR_MLQ = 0, ZR_MLK = 128, ZR_MLV = 256, ZR_MLO = 512, ZR_MLI = 768, ZR_MLF = 776;
constexpr int ZR_RW = 784;

constexpr size_t al256(size_t x) { return (x + 255) & ~(size_t)255; }
constexpr size_t WM_WIN = 0;
constexpr size_t WM_GATE = WM_WIN + (size_t)WIN_N * 1024 * 2;
constexpr size_t WM_UQ = WM_GATE + (size_t)3072 * 1024 * 2;
constexpr size_t WM_UKV = WM_UQ + (size_t)768 * 384 * 2;
constexpr size_t WM_BRA = WM_UKV + (size_t)1024 * 256 * 2;
constexpr size_t WM_BRM = WM_BRA + (size_t)1024 * 512 * 2;
constexpr size_t WM_BRR = WM_BRM + (size_t)1024 * 256 * 2;
constexpr size_t WM_OUT = WM_BRR + (size_t)1024 * 256 * 2;
constexpr size_t WM_RT = WM_OUT + (size_t)1024 * 1024 * 2;
constexpr size_t WM_SIZE = al256(WM_RT + (size_t)64 * 1024 * 2);
constexpr size_t WE_GU = 0;
constexpr size_t WE_DN = WE_GU + (size_t)65 * 512 * 1024 * 2;
constexpr size_t WE_SIZE = al256(WE_DN + (size_t)65 * 1024 * 256 * 2);

constexpr size_t OFF_XS = 0;
constexpr size_t OFF_MOD = OFF_XS + al256((size_t)NT_ * 1024 * 4);
constexpr size_t OFF_ROPE = OFF_MOD + al256((size_t)2 * 3 * 6144 * 4);
constexpr size_t OFF_H = OFF_ROPE + al256((size_t)T_ * 16 * 8);
constexpr size_t OFF_WMIX = OFF_H + al256((size_t)NT_ * 1024 * 2);
constexpr size_t OFF_CNT = OFF_WMIX + 2 * WM_SIZE;
constexpr size_t OFF_BAR = OFF_CNT + 4096;
constexpr size_t OFF_REGION = OFF_BAR + 16384;
constexpr size_t R_ZREC = 0;
constexpr size_t R_RWP = R_ZREC + al256((size_t)NT_ * ZREC_W * 4);
constexpr size_t R_YS = R_RWP + al256((size_t)9 * NT_ * 256 * 4);
constexpr size_t R_MLST = R_YS + al256((size_t)2 * NT_ * 256 * 4);
constexpr size_t R_ATT = R_MLST + al256((size_t)NSEQ_ * NCH_ * 2112 * 4);
constexpr size_t R_MLO = R_ATT + al256((size_t)NT_ * 512 * 2);
constexpr size_t R_RWO = R_MLO + al256((size_t)NT_ * 256 * 2);
constexpr size_t R_VT = R_RWO + al256((size_t)NT_ * 256 * 2);
constexpr size_t R_KB = R_VT + al256((size_t)NB_ * MLA_H * 64 * KT_ * 2);
constexpr size_t R_MIX_END = R_KB + al256((size_t)NB_ * MLA_H * KT_ * 96 * 2);
constexpr int NSLOT_ = NT_ * 9;
constexpr size_t R_YBUF = 0;
constexpr size_t R_EIDX = R_YBUF + al256((size_t)NSLOT_ * 1024 * 2);
constexpr size_t R_EWT = R_EIDX + al256((size_t)NT_ * 8 * 4);
constexpr size_t R_ERANK = R_EWT + al256((size_t)NT_ * 8 * 4);
constexpr size_t R_ELIST = R_ERANK + al256((size_t)NT_ * 8 * 4);
constexpr size_t R_WMOE = R_ELIST + al256((size_t)64 * NT_ * 4);
constexpr size_t R_MOE_END = R_WMOE + WE_SIZE;
constexpr size_t R_SIZE = R_MIX_END > R_MOE_END ? R_MIX_END : R_MOE_END;
constexpr size_t WS_NEEDED = OFF_REGION + R_SIZE;
constexpr size_t O_ZMLA = 0;
constexpr size_t O_QB = O_ZMLA + al256((size_t)NT_ * ZMLA_W * 2);
constexpr size_t O_END = O_QB + al256((size_t)NT_ * 768 * 2);
constexpr size_t O_YMIX = 0;
#if SEQ_T == 8192 && CTX_L == 256
static_assert(O_END <= (size_t)NX_ * 1024 * 4, "d_out scratch overflow");
static_assert((size_t)NT_ * 1024 * 2 <= (size_t)NX_ * 1024 * 4, "ymix overflow");
static_assert(WS_NEEDED <= (size_t)597000000, "workspace too large");
#endif

struct Params {
  const float *x, *c, *ctx, *c_ctx, *w_mod, *b_mod, *g_mix, *g_ffn, *w_in, *g_cq, *w_uq, *g_ckv, *w_uk, *w_uv;
  const float *ml_b_i, *ml_b_f, *ml_g_norm, *rw_mu, *rw_w0, *rw_w2, *rw_a0, *rw_a2, *rw_g2, *rw_k_k, *rw_k_a;
  const float *rw_r_k, *rw_lnx_w, *rw_lnx_b, *w_br_mla, *w_br_ml, *w_br_rw, *w_out, *w_router, *router_bias;
  const float *w_e_gate, *w_e_up, *w_e_down, *w_s_gate, *w_s_up, *w_s_down, *g_final;
  float* out; char* ws; char* osc;
};

DI float bf2f(bf16_t s) { unsigned u = ((unsigned)s) << 16; float f; __builtin_memcpy(&f, &u, 4); return f; }
DI bf16_t f2bf(float x) { unsigned u; __builtin_memcpy(&u, &x, 4); u += 0x7fffu + ((u >> 16) & 1u); return (bf16_t)(u >> 16); }
DI unsigned pack2bf(float a, float b) {
#ifdef EMU
  return (unsigned)f2bf(a) | ((unsigned)f2bf(b) << 16);
#else
  typedef __bf16 bf2 __attribute__((ext_vector_type(2)));
  typedef float f2 __attribute__((ext_vector_type(2)));
  f2 v = {a, b}; bf2 r = __builtin_convertvector(v, bf2); return __builtin_bit_cast(unsigned, r);
#endif
}
DI f32x16 mfma32(bf16x8 a, bf16x8 b, f32x16 c) {
#ifdef EMU
  return emu_mfma_32x32x16_bf16(a, b, c);
#else
  return __builtin_amdgcn_mfma_f32_32x32x16_bf16(a, b, c, 0, 0, 0);
#endif
}
DI int rfl(int v) {
#ifdef EMU
  return v;
#else
  return __builtin_amdgcn_readfirstlane(v);
#endif
}
DI int opaque_tid() {
#ifdef EMU
  return threadIdx.x;
#else
  int t = threadIdx.x; asm volatile("" : "+v"(t)); return t;
#endif
}
DI f32x16 zero16() { f32x16 z; for (int i = 0; i < 16; ++i) z[i] = 0.f; return z; }
DI int crow(int reg, int h) { return (reg & 3) + 8 * (reg >> 2) + 4 * h; }
#ifdef EMU
DI float fexp(float x) { return expf(x); }
#else
DI float fexp(float x) { return __expf(x); }
#endif
DI float sigmoidf_(float x) { return 1.f / (1.f + fexp(-x)); }
DI float siluf_(float x) { return x * sigmoidf_(x); }
DI float wave_sum(float v) { for (int m = 32; m >= 1; m >>= 1) v += __shfl_xor(v, m); return v; }
DI float wave_max(float v) { for (int m = 32; m >= 1; m >>= 1) v = fmaxf(v, __shfl_xor(v, m)); return v; }

DI int tok_b(int n) { return n < NX_ ? n / T_ : (n - NX_) / CL_; }
DI int tok_t(int n) { return n < NX_ ? n % T_ : (n - NX_) % CL_; }
DI int tok_key(int n) { return n < NX_ ? CL_ + n % T_ : (n - NX_) % CL_; }
DI int tok_modrow(int n) { return n < NX_ ? n / T_ : 2; }

#ifdef EMU
#define SMEM_DECL(name, bytes) char* name = (char*)emu::shared_alloc(bytes)
#else
#define SMEM_DECL(name, bytes) __shared__ __attribute__((aligned(16))) char name[bytes]
#endif
#define NTHR 512
struct CvtJob { const float* src; int lds; int K; bf16_t* dst; int ntn; int ntk; int maptype; const float* gain; };
DI int cvt_map(int maptype, int coff, int np) {
  if (maptype == 0) return coff + np;
  if (maptype == 1) { if (np < 672) return np; if (np < 768) return -1; if (np < 768 + 1936) return np - 96; return -1; }
  return np;
}
DI void cvt_tile(const CvtJob& j, int coff, int tk, int tn, char* smem) {
  float* tile = (float*)smem;
  const int tid = opaque_tid();
  __syncthreads();
  {
    const int kk = tid >> 3, nc = (tid & 7) * 8, k = tk * 64 + kk;
    const float g = j.gain ? j.gain[k] : 1.f;
#pragma unroll
    for (int i = 0; i < 8; ++i) {
      const int np = tn * 64 + nc + i;
      const int sc = cvt_map(j.maptype, coff, np);
      tile[kk * 65 + nc + i] = sc >= 0 ? j.src[(size_t)k * j.lds + sc] * g : 0.f;
    }
  }
  __syncthreads();
  {
    const int n = tid >> 3, kc = (tid & 7) * 8;
    int np = tn * 64 + n;
    if (j.maptype == 2) np = (np >> 5) * 64 + coff * 32 + (np & 31);
    uint4 v;
    v.x = pack2bf(tile[(kc + 0) * 65 + n], tile[(kc + 1) * 65 + n]);
    v.y = pack2bf(tile[(kc + 2) * 65 + n], tile[(kc + 3) * 65 + n]);
    v.z = pack2bf(tile[(kc + 4) * 65 + n], tile[(kc + 5) * 65 + n]);
    v.w = pack2bf(tile[(kc + 6) * 65 + n], tile[(kc + 7) * 65 + n]);
    *(uint4*)(j.dst + (size_t)np * j.K + tk * 64 + kc) = v;
  }
}

constexpr int CVT_MIX_TILES = 704 + 768 + 72 + 32 + 32 + 128 + 64 + 64 + 256 + 16;
DI void cvt_mix_item(const Params& p, int l, int it, char* smem) {
  bf16_t* W = (bf16_t*)(p.ws + OFF_WMIX + (size_t)l * WM_SIZE);
  CvtJob j; int coff = 0;
  if (it < 704) { j = {p.w_in + (size_t)l * 1024 * D_IN_, D_IN_, 1024, (bf16_t*)((char*)W + WM_WIN), 44, 16, 1, nullptr}; }
  else if ((it -= 704) < 768) { j = {p.w_in + (size_t)l * 1024 * D_IN_, D_IN_, 1024, (bf16_t*)((char*)W + WM_GATE), 48, 16, 0, nullptr}; coff = 2608; }
  else if ((it -= 768) < 72) { j = {p.w_uq + (size_t)l * 384 * 768, 768, 384, (bf16_t*)((char*)W + WM_UQ), 12, 6, 0, p.g_cq + l * 384}; }
  else if ((it -= 72) < 32) { j = {p.w_uk + (size_t)l * 256 * 512, 512, 256, (bf16_t*)((char*)W + WM_UKV), 8, 4, 0, p.g_ckv + l * 256}; }
  else if ((it -= 32) < 32) { j = {p.w_uv + (size_t)l * 256 * 512, 512, 256, (bf16_t*)((char*)W + WM_UKV) + 512 * 256, 8, 4, 0, p.g_ckv + l * 256}; }
  else if ((it -= 32) < 128) { j = {p.w_br_mla + (size_t)l * 512 * 1024, 1024, 512, (bf16_t*)((char*)W + WM_BRA), 16, 8, 0, nullptr}; }
  else if ((it -= 128) < 64) { j = {p.w_br_ml + (size_t)l * 256 * 1024, 1024, 256, (bf16_t*)((char*)W + WM_BRM), 16, 4, 0, nullptr}; }
  else if ((it -= 64) < 64) { j = {p.w_br_rw + (size_t)l * 256 * 1024, 1024, 256, (bf16_t*)((char*)W + WM_BRR), 16, 4, 0, nullptr}; }
  else if ((it -= 64) < 256) { j = {p.w_out + (size_t)l * 1024 * 1024, 1024, 1024, (bf16_t*)((char*)W + WM_OUT), 16, 16, 0, nullptr}; }
  else { it -= 256; j = {p.w_router + (size_t)l * 1024 * 64, 64, 1024, (bf16_t*)((char*)W + WM_RT), 1, 16, 0, nullptr}; }
  cvt_tile(j, coff, it / j.ntn, it % j.ntn, smem);
}
constexpr int CVT_MOE_TILES = 65 * 192;
DI void cvt_moe_item(const Params& p, int l, int it, char* smem) {
  const int e = it / 192; int r = it % 192;
  bf16_t* GU = (bf16_t*)(p.ws + OFF_REGION + R_WMOE + WE_GU) + (size_t)e * 512 * 1024;
  bf16_t* DN = (bf16_t*)(p.ws + OFF_REGION + R_WMOE + WE_DN) + (size_t)e * 1024 * 256;
  const float* sg = e < 64 ? p.w_e_gate + ((size_t)l * 64 + e) * 1024 * 256 : p.w_s_gate + (size_t)l * 1024 * 256;
  const float* su = e < 64 ? p.w_e_up + ((size_t)l * 64 + e) * 1024 * 256 : p.w_s_up + (size_t)l * 1024 * 256;
  const float* sd = e < 64 ? p.w_e_down + ((size_t)l * 64 + e) * 256 * 1024 : p.w_s_down + (size_t)l * 256 * 1024;
  CvtJob j; int coff = 0;
  if (r < 64) { j = {sg, 256, 1024, GU, 4, 16, 2, nullptr}; coff = 0; }
  else if ((r -= 64) < 64) { j = {su, 256, 1024, GU, 4, 16, 2, nullptr}; coff = 1; }
  else { r -= 64; j = {sd, 1024, 256, DN, 16, 4, 0, nullptr}; }
  cvt_tile(j, coff, r / j.ntn, r % j.ntn, smem);
}

DI void mod_item(const Params& p, int it, char* smem) {
  float* cond = (float*)smem;
  float* red = cond + 3 * 1024;
  const int tid = opaque_tid(), l = it / 96, j0 = (it % 96) * 64;
  __syncthreads();
  for (int i = tid; i < 3 * 1024; i += NTHR) {
    const int r = i >> 10, k = i & 1023;
    const float v = r < 2 ? p.c[r * 1024 + k] : p.c_ctx[k];
    cond[i] = siluf_(v);
  }
  __syncthreads();
  const int jj = tid & 63, kg = tid >> 6;
  float a0 = 0.f, a1 = 0.f, a2 = 0.f;
  const float* w = p.w_mod + (size_t)l * 1024 * 6144 + j0 + jj;
  for (int k = kg; k < 1024; k += 8) {
    const float wv = w[(size_t)k * 6144];
    a0 += cond[k] * wv; a1 += cond[1024 + k] * wv; a2 += cond[2048 + k] * wv;
  }
  red[(kg * 3 + 0) * 64 + jj] = a0; red[(kg * 3 + 1) * 64 + jj] = a1; red[(kg * 3 + 2) * 64 + jj] = a2;
  __syncthreads();
  if (tid < 192) {
    const int r = tid >> 6; float s = 0.f;
    for (int g = 0; g < 8; ++g) s += red[(g * 3 + r) * 64 + jj];
    float* mod = (float*)(p.ws + OFF_MOD);
    mod[((size_t)l * 3 + r) * 6144 + j0 + jj] = s + p.b_mod[(size_t)l * 6144 + j0 + jj];
  }
}
DI void rope_item(const Params& p, int it) {
  const int idx = it * NTHR + threadIdx.x;
  if (idx >= T_ * 16) return;
  const int t = idx >> 4, i = idx & 15, f = i & 7;
  const float pos = (float)(i < 8 ? t / GRID_W_ : t % GRID_W_);
  const float inv = powf(10000.f, -(float)(2 * f) / 16.f);
  const float ang = pos * inv;
  float2* rt = (float2*)(p.ws + OFF_ROPE);
  rt[idx] = make_float2(cosf(ang), sinf(ang));
}
constexpr int PA_ITEMS = 192 + (T_ * 16 + NTHR - 1) / NTHR + 2 * CVT_MIX_TILES;
DI void phaseA(const Params& p, char* smem) {
  if (blockIdx.x == 0 && threadIdx.x < 256) ((int*)(p.ws + OFF_CNT))[threadIdx.x] = 0;
  for (int it = blockIdx.x; it < PA_ITEMS; it += gridDim.x) {
    int i = it;
    if (i < 192) { mod_item(p, i, smem); continue; }
    i -= 192;
    constexpr int NR = (T_ * 16 + NTHR - 1) / NTHR;
    if (i < NR) { rope_item(p, i); continue; }
    i -= NR;
    cvt_mix_item(p, i / CVT_MIX_TILES, i % CVT_MIX_TILES, smem);
  }
}

DI void row_norm_mod(const float (&v)[16], const float* g, const float* shift, const float* scale, bf16_t* hrow, int lane) {
  float ss = 0.f;
#pragma unroll
  for (int i = 0; i < 16; ++i) ss += v[i] * v[i];
  ss = wave_sum(ss);
  const float rs = 1.0f / sqrtf(ss * (1.f / 1024.f) + 1e-6f);
#pragma unroll
  for (int j = 0; j < 4; ++j) {
    const int c = (j * 64 + lane) * 4;
    const float4 gg = *(const float4*)(g + c), sh = *(const float4*)(shift + c), sc = *(const float4*)(scale + c);
    const float h0 = v[j * 4 + 0] * rs * gg.x * (1.f + sc.x) + sh.x;
    const float h1 = v[j * 4 + 1] * rs * gg.y * (1.f + sc.y) + sh.y;
    const float h2 = v[j * 4 + 2] * rs * gg.z * (1.f + sc.z) + sh.z;
    const float h3 = v[j * 4 + 3] * rs * gg.w * (1.f + sc.w) + sh.w;
    uint2 o; o.x = pack2bf(h0, h1); o.y = pack2bf(h2, h3);
    *(uint2*)(hrow + c) = o;
  }
}
DI void phase_norm0(const Params& p) {
  const int lane = threadIdx.x & 63, wid = threadIdx.x >> 6;
  float* xs = (float*)(p.ws + OFF_XS);
  bf16_t* H = (bf16_t*)(p.ws + OFF_H);
  const float* mod = (const float*)(p.ws + OFF_MOD);
  for (int n = blockIdx.x * 8 + wid; n < NT_; n += gridDim.x * 8) {
    const float* src = n < NX_ ? p.x + (size_t)n * 1024 : p.ctx + (size_t)(n - NX_) * 1024;
    float v[16];
#pragma unroll
    for (int j = 0; j < 4; ++j) {
      const float4 t = *(const float4*)(src + (j * 64 + lane) * 4);
      v[j * 4] = t.x; v[j * 4 + 1] = t.y; v[j * 4 + 2] = t.z; v[j * 4 + 3] = t.w;
      *(float4*)(xs + (size_t)n * 1024 + (j * 64 + lane) * 4) = t;
    }
    const float* m = mod + (size_t)(0 * 3 + tok_modrow(n)) * 6144;
    row_norm_mod(v, p.g_mix, m, m + 1024, H + (size_t)n * 1024, lane);
  }
}

template <int BM, int BN, int BK, int WM_, int WN_>
struct Gemm {
  static constexpr int WTM = BM / WM_, WTN = BN / WN_, MB = WTM / 32, NB = WTN / 32;
  static constexpr int LDA = BK + 8;
  static constexpr int A_BYTES = BM * LDA * 2, B_BYTES = BN * LDA * 2, STAGE = A_BYTES + B_BYTES;
  static constexpr int SMEM = 2 * STAGE;
  static constexpr int CPR = BK / 8;
  static constexpr int ACH = BM * CPR / NTHR, BCH = BN * CPR / NTHR;
  static_assert(WM_ * WN_ == 8, "8 waves");
  static_assert(BM * CPR % NTHR == 0 && BN * CPR % NTHR == 0, "chunking");
  static_assert(NTHR % CPR == 0, "rows fixed per thread");

  template <class ARow>
  static DI void run(f32x16 (&acc)[MB][NB], ARow arow, const bf16_t* Bt, int ldb, int Klen, char* smem) {
    const int tid = opaque_tid(), lane = tid & 63, wid = tid >> 6, wm = wid / WN_, wn = wid % WN_;
    const int kc = (tid % CPR) * 8, r0 = tid / CPR;
    const bf16_t* ap[ACH]; const bf16_t* bp[BCH];
#pragma unroll
    for (int i = 0; i < ACH; ++i) ap[i] = arow(r0 + i * (NTHR / CPR)) + kc;
#pragma unroll
    for (int i = 0; i < BCH; ++i) bp[i] = Bt + (size_t)(r0 + i * (NTHR / CPR)) * ldb + kc;
    uint4 ra[ACH], rb[BCH];
    const int nk = Klen / BK;
#pragma unroll
    for (int i = 0; i < ACH; ++i) ra[i] = *(const uint4*)(ap[i]);
#pragma unroll
    for (int i = 0; i < BCH; ++i) rb[i] = *(const uint4*)(bp[i]);
#pragma unroll
    for (int i = 0; i < ACH; ++i) *(uint4*)(smem + ((r0 + i * (NTHR / CPR)) * LDA + kc) * 2) = ra[i];
#pragma unroll
    for (int i = 0; i < BCH; ++i) *(uint4*)(smem + A_BYTES + ((r0 + i * (NTHR / CPR)) * LDA + kc) * 2) = rb[i];
    __syncthreads();
    for (int kt = 0; kt < nk; ++kt) {
      const bool more = kt + 1 < nk;
      if (more) {
#pragma unroll
        for (int i = 0; i < ACH; ++i) ra[i] = *(const uint4*)(ap[i] + (kt + 1) * BK);
#pragma unroll
        for (int i = 0; i < BCH; ++i) rb[i] = *(const uint4*)(bp[i] + (kt + 1) * BK);
      }
      const char* As = smem + (kt & 1) * STAGE;
      const char* Bs = As + A_BYTES;
#pragma unroll
      for (int ks = 0; ks < BK / 16; ++ks) {
        bf16x8 af[MB], bfr[NB];
#pragma unroll
        for (int mb = 0; mb < MB; ++mb)
          af[mb] = *(const bf16x8*)(As + ((wm * WTM + mb * 32 + (lane & 31)) * LDA + ks * 16 + (lane >> 5) * 8) * 2);
#pragma unroll
        for (int nb = 0; nb < NB; ++nb)
          bfr[nb] = *(const bf16x8*)(Bs + ((wn * WTN + nb * 32 + (lane & 31)) * LDA + ks * 16 + (lane >> 5) * 8) * 2);
#pragma unroll
        for (int mb = 0; mb < MB; ++mb)
#pragma unroll
          for (int nb = 0; nb < NB; ++nb) acc[mb][nb] = mfma32(af[mb], bfr[nb], acc[mb][nb]);
      }
      if (more) {
        char* Ad = smem + ((kt + 1) & 1) * STAGE;
#pragma unroll
        for (int i = 0; i < ACH; ++i) *(uint4*)(Ad + ((r0 + i * (NTHR / CPR)) * LDA + kc) * 2) = ra[i];
#pragma unroll
        for (int i = 0; i < BCH; ++i) *(uint4*)(Ad + A_BYTES + ((r0 + i * (NTHR / CPR)) * LDA + kc) * 2) = rb[i];
      }
      __syncthreads();
    }
  }
  static DI int row_of(int t, int mb, int reg) { const int lane = t & 63, wm = (t >> 6) / WN_; return wm * WTM + mb * 32 + crow(reg, lane >> 5); }
  static DI int col_of(int t, int nb) { const int lane = t & 63, wn = (t >> 6) % WN_; return wn * WTN + nb * 32 + (lane & 31); }
};

typedef Gemm<256, 256, 64, 2, 4> G256;
DI void phase_win(const Params& p, int l, char* smem) {
  const bf16_t* H = (const bf16_t*)(p.ws + OFF_H);
  const bf16_t* W = (const bf16_t*)(p.ws + OFF_WMIX + (size_t)l * WM_SIZE + WM_WIN);
  bf16_t* zmla = (bf16_t*)(p.osc + O_ZMLA);
  float* zrec = (float*)(p.ws + OFF_REGION + R_ZREC);
  constexpr int TM = NT_ / 256, TN = WIN_N / 256;
  for (int it = blockIdx.x; it < TM * TN; it += gridDim.x) {
    const int tid = opaque_tid();
    const int tm = it / TN, tn = it % TN;
    f32x16 acc[G256::MB][G256::NB];
#pragma unroll
    for (int a = 0; a < G256::MB; ++a)
#pragma unroll
      for (int b = 0; b < G256::NB; ++b) acc[a][b] = zero16();
    const bf16_t* A0 = H + (size_t)tm * 256 * 1024;
    G256::run(acc, [&](int r) { return A0 + (size_t)r * 1024; }, W + (size_t)tn * 256 * 1024, 1024, 1024, smem);
#pragma unroll
    for (int mb = 0; mb < G256::MB; ++mb)
#pragma unroll
      for (int nb = 0; nb < G256::NB; ++nb) {
        const int col = tn * 256 + G256::col_of(tid, nb);
#pragma unroll
        for (int i = 0; i < 16; ++i) {
          const int row = tm * 256 + G256::row_of(tid, mb, i);
          const float v = acc[mb][nb][i];
          if (col < 768) zmla[(size_t)row * ZMLA_W + col] = f2bf(v);
          else if (col - 768 < ZREC_W) zrec[(size_t)row * ZREC_W + (col - 768)] = v;
        }
      }
  }
}
typedef Gemm<128, 128, 64, 2, 4> G128;
DI void mla_row_rs(const bf16_t* zmla_rows, int c0, int len, float* rs) {
  const int tid = opaque_tid(), row = tid >> 2, half = tid & 3;
  const bf16_t* src = zmla_rows + (size_t)row * ZMLA_W + c0 + half * (len / 4);
  float ss = 0.f;
  for (int i = 0; i < len / 4; i += 8) {
    const uint4 v = *(const uint4*)(src + i);
    const unsigned w[4] = {v.x, v.y, v.z, v.w};
#pragma unroll
    for (int j = 0; j < 4; ++j) { const float a = bf2f((bf16_t)(w[j] & 0xffff)), b = bf2f((bf16_t)(w[j] >> 16)); ss += a * a + b * b; }
  }
  ss += __shfl_xor(ss, 1); ss += __shfl_xor(ss, 2);
  if (half == 0) rs[row] = 1.0f / sqrtf(ss / (float)len + 1e-6f);
}

constexpr int MLA_Q_TILES = (NT_ / 128) * 6, MLA_KV_TILES = (NT_ / 128) * 8;
DI void mla_q_item(const Params& p, int l, int it, char* smem) {
  const int tid = opaque_tid();
  const int tm = it / 6, tn = it % 6;
  const bf16_t* zmla = (const bf16_t*)(p.osc + O_ZMLA) + (size_t)tm * 128 * ZMLA_W;
  const bf16_t* W = (const bf16_t*)(p.ws + OFF_WMIX + (size_t)l * WM_SIZE + WM_UQ) + (size_t)tn * 128 * 384;
  bf16_t* qb = (bf16_t*)(p.osc + O_QB);
  const float2* rt = (const float2*)(p.ws + OFF_ROPE);
  float* rs = (float*)(smem + G128::SMEM);
  __syncthreads();
  mla_row_rs(zmla, 0, 384, rs);
  f32x16 acc[G128::MB][G128::NB];
#pragma unroll
  for (int a = 0; a < G128::MB; ++a)
#pragma unroll
    for (int b = 0; b < G128::NB; ++b) acc[a][b] = zero16();
  G128::run(acc, [&](int r) { return zmla + (size_t)r * ZMLA_W; }, W, 384, 384, smem);
  const int lane = tid & 63;
  const bool isx = tm * 128 < NX_;
#pragma unroll
  for (int mb = 0; mb < G128::MB; ++mb)
#pragma unroll
    for (int nb = 0; nb < G128::NB; ++nb) {
      const int col = tn * 128 + G128::col_of(tid, nb);
      const bool ropeblk = ((col >> 5) % 3) == 2;
      const int e = lane & 31;
#pragma unroll
      for (int i = 0; i < 16; ++i) {
        const int lr = G128::row_of(tid, mb, i);
        const int n = tm * 128 + lr;
        float v = acc[mb][nb][i] * rs[lr];
        if (ropeblk && isx) {
          const float pv = __shfl_xor(v, 8);
          const float2 cs = rt[(size_t)(n % T_) * 16 + (e >> 4) * 8 + (e & 7)];
          v = (e & 8) ? (pv * cs.y + v * cs.x) : (v * cs.x - pv * cs.y);
        }
        qb[(size_t)n * 768 + col] = f2bf(v);
      }
    }
}
DI void mla_kv_item(const Params& p, int l, int it, char* smem) {
  const int tid = opaque_tid();
  const int tm = it / 8, tn = it % 8;
  const bf16_t* zmla = (const bf16_t*)(p.osc + O_ZMLA) + (size_t)tm * 128 * ZMLA_W;
  const bf16_t* W = (const bf16_t*)(p.ws + OFF_WMIX + (size_t)l * WM_SIZE + WM_UKV) + (size_t)tn * 128 * 256;
  bf16_t* kb = (bf16_t*)(p.ws + OFF_REGION + R_KB);
  bf16_t* vt = (bf16_t*)(p.ws + OFF_REGION + R_VT);
  const float2* rt = (const float2*)(p.ws + OFF_ROPE);
  float* rs = (float*)(smem + G128::SMEM);
  __syncthreads();
  mla_row_rs(zmla, 384, 256, rs);
  const int n0 = tm * 128;
  const int b = tok_b(n0), key0 = tok_key(n0);
  const bool isx = n0 < NX_;
  if (tn == 0) {
    for (int idx = tid; idx < 128 * 16; idx += NTHR) {
      const int lr = idx >> 4, pi = idx & 15, a = pi >> 3, i = pi & 7;
      const bf16_t* z = zmla + (size_t)lr * ZMLA_W + 640 + a * 16 + i;
      float x1 = bf2f(z[0]), x2 = bf2f(z[8]);
      if (isx) {
        const float2 cs = rt[(size_t)((n0 + lr) % T_) * 16 + a * 8 + i];
        const float y1 = x1 * cs.x - x2 * cs.y, y2 = x1 * cs.y + x2 * cs.x; x1 = y1; x2 = y2;
      }
      const bf16_t o1 = f2bf(x1), o2 = f2bf(x2);
      for (int h = 0; h < 8; ++h) {
        bf16_t* dst = kb + ((size_t)(b * 8 + h) * KT_ + key0 + lr) * 96 + 64 + a * 16 + i;
        dst[0] = o1; dst[8] = o2;
      }
    }
  }
  f32x16 acc[G128::MB][G128::NB];
#pragma unroll
  for (int a = 0; a < G128::MB; ++a)
#pragma unroll
    for (int c = 0; c < G128::NB; ++c) acc[a][c] = zero16();
  G128::run(acc, [&](int r) { return zmla + (size_t)r * ZMLA_W + 384; }, W, 256, 256, smem);
  const int lane = tid & 63;
#pragma unroll
  for (int mb = 0; mb < G128::MB; ++mb)
#pragma unroll
    for (int nb = 0; nb < G128::NB; ++nb) {
      const int col = tn * 128 + G128::col_of(tid, nb);
      if (col < 512) {
        const int h = col >> 6, d = col & 63;
#pragma unroll
        for (int i = 0; i < 16; ++i) {
          const int lr = G128::row_of(tid, mb, i);
          kb[((size_t)(b * 8 + h) * KT_ + key0 + lr) * 96 + d] = f2bf(acc[mb][nb][i] * rs[lr]);
        }
      } else {
        const int h = (col - 512) >> 6, d = col & 63;
#pragma unroll
        for (int g = 0; g < 4; ++g) {
          const int lr = G128::row_of(tid, mb, g * 4);
          uint2 o;
          o.x = pack2bf(acc[mb][nb][g * 4 + 0] * rs[lr], acc[mb][nb][g * 4 + 1] * rs[lr + 1]);
          o.y = pack2bf(acc[mb][nb][g * 4 + 2] * rs[lr + 2], acc[mb][nb][g * 4 + 3] * rs[lr + 3]);
          *(uint2*)(vt + ((size_t)(b * 8 + h) * 64 + d) * KT_ + key0 + lr) = o;
        }
      }
    }
  (void)lane;
}

DI float softplusf_(float x) { return x > 20.f ? x : log1pf(fexp(x)); }
constexpr int RWP_TT = 16;
constexpr int RWP_ITEMS = NT_ / RWP_TT;
DI void rwkv_prep_item(const Params& p, int l, int it, char* smem) {
  float* zs = (float*)smem;
  float* tw = zs + RWP_TT * 1024;
  float* ta = tw + 2 * 64 * RWP_TT;
  const float* zrec = (const float*)(p.ws + OFF_REGION + R_ZREC);
  float* rwp = (float*)(p.ws + OFF_REGION + R_RWP);
  const float* mu = p.rw_mu + (size_t)l * 1152;
  const int tid = opaque_tid(), n0 = it * RWP_TT;
  __syncthreads();
  for (int idx = tid; idx < RWP_TT * 1024; idx += NTHR) {
    const int tt = idx >> 10, c = idx & 1023, n = n0 + tt, t = tok_t(n);
    const int len = n < NX_ ? T_ : CL_;
    const float* zr = zrec + (size_t)n * ZREC_W + ZR_RW + c;
    const float z = zr[0];
    const float zp = t > 0 ? zr[-ZREC_W] : 0.f, zn = t < len - 1 ? zr[ZREC_W] : 0.f;
    const float s = z + (0.5f * (zp + zn) - z) * mu[c];
    zs[idx] = s;
    if (c >= 768 && c < 896) { const int d = (c - 768) >> 6, k = (c - 768) & 63; tw[(d * 64 + k) * RWP_TT + tt] = tanhf(s); }
    if (c >= 896) { const int d = (c - 896) >> 6, k = (c - 896) & 63; ta[(d * 64 + k) * RWP_TT + tt] = s; }
  }
  __syncthreads();
  const int col = tid & 255, d = tid >> 8;
  float aw[RWP_TT], aa[RWP_TT];
#pragma unroll
  for (int i = 0; i < RWP_TT; ++i) { aw[i] = 0.f; aa[i] = 0.f; }
  const float* w2 = p.rw_w2 + ((size_t)l * 2 + d) * 64 * 256 + col;
  const float* a2 = p.rw_a2 + ((size_t)l * 2 + d) * 64 * 256 + col;
  for (int k = 0; k < 64; ++k) {
    const float wv = w2[k * 256], av = a2[k * 256];
    const float* twk = tw + (d * 64 + k) * RWP_TT;
    const float* tak = ta + (d * 64 + k) * RWP_TT;
#pragma unroll
    for (int i = 0; i < RWP_TT; ++i) { aw[i] += twk[i] * wv; aa[i] += tak[i] * av; }
  }
  const float w0 = p.rw_w0[((size_t)l * 2 + d) * 256 + col], a0 = p.rw_a0[((size_t)l * 2 + d) * 256 + col];
  const float kkw = p.rw_k_k[(size_t)l * 256 + col], kaw = p.rw_k_a[(size_t)l * 256 + col];
  const size_t AS = (size_t)NT_ * 256;
#pragma unroll
  for (int i = 0; i < RWP_TT; ++i) {
    const int n = n0 + i;
    const float r = zs[i * 1024 + col], k = zs[i * 1024 + 256 + col], v = zs[i * 1024 + 512 + col];
    const float kr = k * kkw;
    const float ss = wave_sum(kr * kr);
    const float kk = kr / fmaxf(sqrtf(ss), 1e-12f);
    const float w = -softplusf_(-(w0 + aw[i])) - 0.5f;
    const float decay = fexp(-fexp(w));
    const float a = sigmoidf_(a0 + aa[i]);
    const float kd = k * (1.f + (a - 1.f) * kaw);
    const size_t o = (size_t)n * 256 + col;
    if (d == 0) { rwp[0 * AS + o] = r; rwp[1 * AS + o] = v; rwp[2 * AS + o] = kk; }
    rwp[(3 + d * 3 + 0) * AS + o] = decay;
    rwp[(3 + d * 3 + 1) * AS + o] = kd;
    rwp[(3 + d * 3 + 2) * AS + o] = kk * a;
  }
}

DI int seq_tok(int dir, int b, int pos) {
  if (pos < CL_) return NX_ + b * CL_ + (dir ? CL_ - 1 - pos : pos);
  const int t = pos - CL_;
  return b * T_ + (dir ? T_ - 1 - t : t);
}
DI float logsigmoidf_(float x) { return -softplusf_(-x); }
DI float wave_incl_scan(float v, int lane) {
  for (int d = 1; d < 64; d <<= 1) { const float o = __shfl_up(v, d); if (lane >= d) v += o; }
  return v;
}
constexpr int ML_ST = 2112;
constexpr int ML1_ITEMS = NSEQ_ * NCH_;
DI void mlstm_local_item(const Params& p, int l, int it, char* smem) {
  const int s = it / NCH_, c = it % NCH_, dir = s >> 3, b = (s >> 2) & 1, hd = s & 3;
  float* vv = (float*)smem;
  float* kw = vv + 64 * 64;
  float* wej = kw + 64 * 32;
  const float* zrec = (const float*)(p.ws + OFF_REGION + R_ZREC);
  float* st = (float*)(p.ws + OFF_REGION + R_MLST) + ((size_t)s * NCH_ + c) * ML_ST;
  const int tid = opaque_tid(), lane = tid & 63, wid = tid >> 6;
  __syncthreads();
  if (wid == 0) {
    const int n = seq_tok(dir, b, c * 64 + lane);
    const float fp = zrec[(size_t)n * ZREC_W + ZR_MLF + dir * 4 + hd] + p.ml_b_f[(l * 2 + dir) * 4 + hd];
    const float ip = zrec[(size_t)n * ZREC_W + ZR_MLI + dir * 4 + hd] + p.ml_b_i[(l * 2 + dir) * 4 + hd];
    const float bj = wave_incl_scan(logsigmoidf_(fp), lane);
    const float bl = __shfl(bj, 63);
    const float lw = bl - bj + ip;
    const float ml = wave_max(lw);
    wej[lane] = fexp(lw - ml);
    if (lane == 0) { st[2080] = bl; st[2081] = ml; }
  }
  for (int idx = tid; idx < 64 * 64; idx += NTHR) {
    const int j = idx >> 6, e = idx & 63;
    const int n = seq_tok(dir, b, c * 64 + j);
    vv[idx] = zrec[(size_t)n * ZREC_W + ZR_MLV + hd * 64 + e];
  }
  __syncthreads();
  for (int idx = tid; idx < 64 * 32; idx += NTHR) {
    const int j = idx >> 5, e = idx & 31;
    const int n = seq_tok(dir, b, c * 64 + j);
    kw[idx] = zrec[(size_t)n * ZREC_W + ZR_MLK + hd * 32 + e] * wej[j];
  }
  __syncthreads();
  const int v = tid & 63, d0 = (tid >> 6) * 4;
  float a0 = 0.f, a1 = 0.f, a2 = 0.f, a3 = 0.f;
  for (int j = 0; j < 64; ++j) {
    const float x = vv[j * 64 + v];
    const float4 kk = *(const float4*)(kw + j * 32 + d0);
    a0 += x * kk.x; a1 += x * kk.y; a2 += x * kk.z; a3 += x * kk.w;
  }
  *(float4*)(st + v * 32 + d0) = make_float4(a0, a1, a2, a3);
  if (tid < 32) { float sn = 0.f; for (int j = 0; j < 64; ++j) sn += kw[j * 32 + tid]; st[2048 + tid] = sn; }
}
constexpr int ML2_ITEMS = (NSEQ_ * 2080 + NTHR - 1) / NTHR;
DI void mlstm_scan_item(const Params& p, int it) {
  const int g = it * NTHR + opaque_tid();
  if (g >= NSEQ_ * 2080) return;
  const int s = g / 2080, e = g % 2080;
  float* st = (float*)(p.ws + OFF_REGION + R_MLST) + (size_t)s * NCH_ * ML_ST;
  float state = 0.f, m = 0.f;
  for (int c = 0; c < NCH_; ++c) {
    float* r = st + (size_t)c * ML_ST;
    const float d = r[e], bl = r[2080], ml = r[2081];
    r[e] = state;
    if (e == 0) r[2082] = m;
    const float mn = fmaxf(bl + m, ml);
    state = fexp(bl + m - mn) * state + fexp(ml - mn) * d;
    m = mn;
  }
}

constexpr int P3_ITEMS = MLA_Q_TILES + MLA_KV_TILES + RWP_ITEMS + ML1_ITEMS;
DI void phase3(const Params& p, int l, char* smem) {
  for (int it = blockIdx.x; it < P3_ITEMS; it += gridDim.x) {
    int i = it;
    if (i < MLA_Q_TILES) { mla_q_item(p, l, i, smem); continue; }
    i -= MLA_Q_TILES;
    if (i < MLA_KV_TILES) { mla_kv_item(p, l, i, smem); continue; }
    i -= MLA_KV_TILES;
    if (i < RWP_ITEMS) { rwkv_prep_item(p, l, i, smem); continue; }
    i -= RWP_ITEMS;
    mlstm_local_item(p, l, i, smem);
  }
}
constexpr int ATT_KLD = 104, ATT_VLD = 68;
constexpr int ATT_KB = 64 * ATT_KLD * 2, ATT_VB = 64 * ATT_VLD * 2, ATT_STAGE = ATT_KB + ATT_VB;
DI float fexp2(float x) {
#ifdef EMU
  return exp2f(x);
#else
  return __builtin_amdgcn_exp2f(x);
#endif
}
DI void attn_item(const Params& p, int b, int h, int qt, bool isctx, char* smem) {
  const int tid = opaque_tid(), lane = tid & 63, wid = tid >> 6, r = lane & 31, h2 = lane >> 5;
  const bf16_t* qb = (const bf16_t*)(p.osc + O_QB);
  const bf16_t* kbase = (const bf16_t*)(p.ws + OFF_REGION + R_KB) + (size_t)(b * 8 + h) * KT_ * 96;
  const bf16_t* vbase = (const bf16_t*)(p.ws + OFF_REGION + R_VT) + (size_t)(b * 8 + h) * 64 * KT_;
  bf16_t* att = (bf16_t*)(p.ws + OFF_REGION + R_ATT);
  const int nq0 = isctx ? NX_ + b * CL_ + qt * 256 : b * T_ + qt * 256;
  const int nkt = (isctx ? CL_ : KT_) / 64;
  const int nq = nq0 + wid * 32 + r;
  bf16x8 qf[6];
#pragma unroll
  for (int ks = 0; ks < 6; ++ks) qf[ks] = *(const bf16x8*)(qb + (size_t)nq * 768 + h * 96 + ks * 16 + h2 * 8);
  f32x16 oacc[2] = {zero16(), zero16()};
  float m = -1e30f, lsum = 0.f;
  const float sc = 0.10206207261596577f * 1.4426950408889634f;
  const int kc1 = tid + 512;
  const int vd = tid >> 3, vc = tid & 7;
  uint4 rk0, rk1, rv;
  auto gload = [&](int kt) {
    const bf16_t* ksrc = kbase + (size_t)kt * 64 * 96;
    rk0 = *(const uint4*)(ksrc + tid * 8);
    if (kc1 < 768) rk1 = *(const uint4*)(ksrc + kc1 * 8);
    rv = *(const uint4*)(vbase + (size_t)vd * KT_ + kt * 64 + vc * 8);
  };
  auto sstore = [&](int buf) {
    char* Ks = smem + buf * ATT_STAGE; char* Vs = Ks + ATT_KB;
    *(uint4*)(Ks + ((tid / 12) * ATT_KLD + (tid % 12) * 8) * 2) = rk0;
    if (kc1 < 768) *(uint4*)(Ks + ((kc1 / 12) * ATT_KLD + (kc1 % 12) * 8) * 2) = rk1;
    *(uint2*)(Vs + (vd * ATT_VLD + vc * 8) * 2) = make_uint2(rv.x, rv.y);
    *(uint2*)(Vs + (vd * ATT_VLD + vc * 8 + 4) * 2) = make_uint2(rv.z, rv.w);
  };
  __syncthreads();
  gload(0); sstore(0);
  __syncthreads();
  for (int kt = 0; kt < nkt; ++kt) {
    const bool more = kt + 1 < nkt;
    if (more) gload(kt + 1);
    const char* Ks = smem + (kt & 1) * ATT_STAGE; const char* Vs = Ks + ATT_KB;
    f32x16 sacc[2] = {zero16(), zero16()};
#pragma unroll
    for (int ks = 0; ks < 6; ++ks)
#pragma unroll
      for (int kb = 0; kb < 2; ++kb) {
        const bf16x8 kf = *(const bf16x8*)(Ks + ((kb * 32 + r) * ATT_KLD + ks * 16 + h2 * 8) * 2);
        sacc[kb] = mfma32(kf, qf[ks], sacc[kb]);
      }
    float mx = -1e30f;
#pragma unroll
    for (int kb = 0; kb < 2; ++kb)
#pragma unroll
      for (int i = 0; i < 16; ++i) mx = fmaxf(mx, sacc[kb][i]);
    mx = fmaxf(mx, __shfl_xor(mx, 32));
    const float mn = fmaxf(m, mx * sc);
    const float alpha = fexp2(m - mn);
    m = mn;
    float ps = 0.f;
#pragma unroll
    for (int kb = 0; kb < 2; ++kb)
#pragma unroll
      for (int i = 0; i < 16; ++i) { const float pv = fexp2(sacc[kb][i] * sc - mn); sacc[kb][i] = pv; ps += pv; }
    lsum = lsum * alpha + ps;
#pragma unroll
    for (int db = 0; db < 2; ++db)
#pragma unroll
      for (int i = 0; i < 16; ++i) oacc[db][i] *= alpha;
#pragma unroll
    for (int kb = 0; kb < 2; ++kb)
#pragma unroll
      for (int s = 0; s < 2; ++s) {
        bf16x8 pf;
        {
          const unsigned u0 = pack2bf(sacc[kb][8 * s + 0], sacc[kb][8 * s + 1]), u1 = pack2bf(sacc[kb][8 * s + 2], sacc[kb][8 * s + 3]);
          const unsigned u2 = pack2bf(sacc[kb][8 * s + 4], sacc[kb][8 * s + 5]), u3 = pack2bf(sacc[kb][8 * s + 6], sacc[kb][8 * s + 7]);
          const uint4 u = make_uint4(u0, u1, u2, u3);
          __builtin_memcpy(&pf, &u, 16);
        }
#pragma unroll
        for (int db = 0; db < 2; ++db) {
          const char* vrow = Vs + ((db * 32 + r) * ATT_VLD + kb * 32 + 16 * s + 4 * h2) * 2;
          const uint2 lo = *(const uint2*)(vrow), hi = *(const uint2*)(vrow + 16);
          const uint4 u = make_uint4(lo.x, lo.y, hi.x, hi.y);
          bf16x8 vf; __builtin_memcpy(&vf, &u, 16);
          oacc[db] = mfma32(vf, pf, oacc[db]);
        }
      }
    if (more) sstore((kt + 1) & 1);
    __syncthreads();
  }
  lsum += __shfl_xor(lsum, 32);
  const float inv = 1.f / lsum;
#pragma unroll
  for (int db = 0; db < 2; ++db)
#pragma unroll
    for (int g = 0; g < 4; ++g) {
      uint2 o;
      o.x = pack2bf(oacc[db][g * 4 + 0] * inv, oacc[db][g * 4 + 1] * inv);
      o.y = pack2bf(oacc[db][g * 4 + 2] * inv, oacc[db][g * 4 + 3] * inv);
      *(uint2*)(att + (size_t)nq * 512 + h * 64 + db * 32 + 8 * g + 4 * h2) = o;
    }
}

DI float red16(float x) {
#ifdef EMU
  x += __shfl_xor(x, 1); x += __shfl_xor(x, 2); x += __shfl_xor(x, 4); x += __shfl_xor(x, 8); return x;
#else
  x += __builtin_bit_cast(float, __builtin_amdgcn_mov_dpp(__builtin_bit_cast(int, x), 0xB1, 0xf, 0xf, true));
  x += __builtin_bit_cast(float, __builtin_amdgcn_mov_dpp(__builtin_bit_cast(int, x), 0x4E, 0xf, 0xf, true));
  x += __builtin_bit_cast(float, __builtin_amdgcn_mov_dpp(__builtin_bit_cast(int, x), 0x124, 0xf, 0xf, true));
  x += __builtin_bit_cast(float, __builtin_amdgcn_mov_dpp(__builtin_bit_cast(int, x), 0x128, 0xf, 0xf, true));
  return x;
#endif
}
DI int rws_arr(int vec, int dir) { return vec == 0 ? 2 : (vec < 4 ? 2 + vec + 3 * dir : vec - 4); }
constexpr int RWS_CH = 16;
constexpr int RWS_ITEMS = NSEQ_ * 2;
constexpr int RWS_BUF = RWS_CH * 6 * 64 * 4;
constexpr int RWS_YOFF = 2 * RWS_BUF;
DI void rws_chunk_tok(int dir, int b, int ch, int& n0, int& dn) {
  const int pos = ch * RWS_CH;
  if (pos < CL_) { n0 = NX_ + b * CL_ + (dir ? CL_ - 1 - pos : pos); }
  else { const int t = pos - CL_; n0 = b * T_ + (dir ? T_ - 1 - t : t); }
  dn = dir ? -1 : 1;
}
DI void rwkv_scan_item(const Params& p, int it, char* smem) {
  const int s = it >> 1, rg = it & 1, dir = s >> 3, b = (s >> 2) & 1, hd = s & 3;
  const int tid = opaque_tid(), lane = tid & 63, wid = tid >> 6, c4 = (lane & 15) * 4;
  const int lrow = wid * 4 + (lane >> 4), row = rg * 32 + lrow;
  const float* rwp = (const float*)(p.ws + OFF_REGION + R_RWP);
  float* ys = (float*)(p.ws + OFF_REGION + R_YS) + (size_t)dir * NT_ * 256;
  const size_t AS = (size_t)NT_ * 256;
  float4 lr0, lr1, lr2;
  const int i0 = tid, i1 = tid + NTHR, i2 = tid + 2 * NTHR;
  const int st0 = i0 / 96, st1 = i1 / 96, st2 = i2 / 96;
  const size_t o0 = rws_arr((i0 % 96) >> 4, dir) * AS + hd * 64 + (i0 & 15) * 4;
  const size_t o1 = rws_arr((i1 % 96) >> 4, dir) * AS + hd * 64 + (i1 & 15) * 4;
  const size_t o2 = rws_arr((i2 % 96) >> 4, dir) * AS + hd * 64 + (i2 & 15) * 4;
#define RWS_GLOAD(ch) { int n0_, dn_; rws_chunk_tok(dir, b, ch, n0_, dn_); \
    lr0 = *(const float4*)(rwp + o0 + (size_t)(n0_ + dn_ * st0) * 256); lr1 = *(const float4*)(rwp + o1 + (size_t)(n0_ + dn_ * st1) * 256); \
    lr2 = *(const float4*)(rwp + o2 + (size_t)(n0_ + dn_ * st2) * 256); }
#define RWS_SSTORE(buf) { *(float4*)(smem + (buf) * RWS_BUF + i0 * 16) = lr0; *(float4*)(smem + (buf) * RWS_BUF + i1 * 16) = lr1; *(float4*)(smem + (buf) * RWS_BUF + i2 * 16) = lr2; }
  float s0 = 0.f, s1 = 0.f, s2 = 0.f, s3 = 0.f;
  constexpr int NCHK = KT_ / RWS_CH;
  float* ybuf = (float*)(smem + RWS_YOFF);
  __syncthreads();
  RWS_GLOAD(0); RWS_SSTORE(0);
  __syncthreads();
  for (int ch = 0; ch < NCHK; ++ch) {
    if (ch + 1 < NCHK) RWS_GLOAD(ch + 1);
    const float* B = (const float*)(smem + (ch & 1) * RWS_BUF);
    float* yb = ybuf + (ch & 1) * (RWS_CH * 32);
#pragma unroll
    for (int st = 0; st < RWS_CH; ++st) {
      const float* S = B + st * 384;
      const float4 kk = *(const float4*)(S + c4), w = *(const float4*)(S + 64 + c4), kd = *(const float4*)(S + 128 + c4);
      const float4 bb = *(const float4*)(S + 192 + c4), rr = *(const float4*)(S + 256 + c4);
      const float v = S[320 + row];
      const float t0 = v * kd.x, t1 = v * kd.y, t2 = v * kd.z, t3 = v * kd.w;
      const float sa = -red16((s0 * kk.x + s1 * kk.y) + (s2 * kk.z + s3 * kk.w));
      s0 = s0 * w.x + (sa * bb.x + t0);
      s1 = s1 * w.y + (sa * bb.y + t1);
      s2 = s2 * w.z + (sa * bb.z + t2);
      s3 = s3 * w.w + (sa * bb.w + t3);
      const float y = red16((s0 * rr.x + s1 * rr.y) + (s2 * rr.z + s3 * rr.w));
      if ((lane & 15) == 0) yb[st * 32 + lrow] = y;
    }
    if (ch + 1 < NCHK) RWS_SSTORE((ch + 1) & 1);
    __syncthreads();
    {
      int n0_, dn_; rws_chunk_tok(dir, b, ch, n0_, dn_);
      const int st = tid >> 5, rr_ = tid & 31;
      ys[(size_t)(n0_ + dn_ * st) * 256 + hd * 64 + rg * 32 + rr_] = yb[st * 32 + rr_];
    }
  }
}

DI constexpr int att_items(int l) { return NB_ * 8 * (T_ / 256) + (l == 0 ? NB_ * 8 * (CL_ / 256) : 0); }
DI void phase4(const Params& p, int l, char* smem, int* ctr) {
  const int n_att = att_items(l);
  const int total = RWS_ITEMS + ML2_ITEMS + n_att;
  int* sitem = (int*)(smem + 160 * 1024 - 16);
  for (;;) {
    __syncthreads();
    if (opaque_tid() == 0) *sitem = atomicAdd(ctr, 1);
    __syncthreads();
    int i = *sitem;
    if (i >= total) break;
    if (i < RWS_ITEMS) { rwkv_scan_item(p, i, smem); continue; }
    i -= RWS_ITEMS;
    if (i < ML2_ITEMS) { mlstm_scan_item(p, i); continue; }
    i -= ML2_ITEMS;
    const int nx = NB_ * 8 * (T_ / 256);
    if (i < nx) { const int qt = i % (T_ / 256), bh = i / (T_ / 256); attn_item(p, bh >> 3, bh & 7, qt, false, smem); }
    else { i -= nx; const int qt = i % (CL_ / 256), bh = i / (CL_ / 256); attn_item(p, bh >> 3, bh & 7, qt, true, smem); }
  }
}
constexpr int ML3_CC = CL_ / 64, ML3_XC = T_ / 64;
DI constexpr int ml3_items(bool with_ctx) { return NB_ * 4 * (ML3_XC + (with_ctx ? ML3_CC : 0)); }
DI void mlstm_out_item(const Params& p, int l, int it, bool with_ctx, char* smem) {
  const int per = ML3_XC + (with_ctx ? ML3_CC : 0);
  const int bh = it / per, b = bh >> 2, hd = bh & 3;
  int tc = it % per; if (!with_ctx) tc += ML3_CC;
  const bool isctx = tc < ML3_CC;
  const int ntok0 = isctx ? NX_ + b * CL_ + tc * 64 : b * T_ + (tc - ML3_CC) * 64;
  float* qs = (float*)smem;
  float* ks = qs + 64 * 33;
  float* vs = ks + 64 * 33;
  float* Cs = vs + 64 * 64;
  float* Sm = Cs + 64 * 33;
  float* hs = Sm + 64 * 65;
  float* bj = hs + 64 * 64;
  float* ip = bj + 64;
  float* ns = ip + 64;
  const float* zrec = (const float*)(p.ws + OFF_REGION + R_ZREC);
  const int tid = opaque_tid(), lane = tid & 63, wid = tid >> 6;
  __syncthreads();
  for (int idx = tid; idx < 64 * 64; idx += NTHR) hs[idx] = 0.f;
  for (int dir = 0; dir < 2; ++dir) {
    const int c = dir == 0 ? tc : (isctx ? ML3_CC - 1 - tc : ML3_CC + (ML3_XC - 1 - (tc - ML3_CC)));
    const int s = dir * 8 + b * 4 + hd;
    const float* st = (const float*)(p.ws + OFF_REGION + R_MLST) + ((size_t)s * NCH_ + c) * ML_ST;
    const float m_start = st[2082];
    __syncthreads();
    for (int idx = tid; idx < 64 * 32; idx += NTHR) {
      const int j = idx >> 5, e = idx & 31;
      const int n = ntok0 + (dir ? 63 - j : j);
      qs[j * 33 + e] = zrec[(size_t)n * ZREC_W + ZR_MLQ + hd * 32 + e] * 0.17677669529663687f;
      ks[j * 33 + e] = zrec[(size_t)n * ZREC_W + ZR_MLK + hd * 32 + e];
      Cs[j * 33 + e] = st[j * 32 + e];
    }
    for (int idx = tid; idx < 64 * 64; idx += NTHR) {
      const int j = idx >> 6, e = idx & 63;
      const int n = ntok0 + (dir ? 63 - j : j);
      vs[idx] = zrec[(size_t)n * ZREC_W + ZR_MLV + hd * 64 + e];
    }
    if (tid < 32) ns[tid] = st[2048 + tid];
    if (wid == 1) {
      const int n = ntok0 + (dir ? 63 - lane : lane);
      const float fp = zrec[(size_t)n * ZREC_W + ZR_MLF + dir * 4 + hd] + p.ml_b_f[(l * 2 + dir) * 4 + hd];
      ip[lane] = zrec[(size_t)n * ZREC_W + ZR_MLI + dir * 4 + hd] + p.ml_b_i[(l * 2 + dir) * 4 + hd];
      bj[lane] = wave_incl_scan(logsigmoidf_(fp), lane);
    }
    __syncthreads();
    const int j = tid >> 3, sg = tid & 7;
    const float bjj = bj[j];
    float rmax = -1e30f;
#pragma unroll 1
    for (int u = 0; u < 8; ++u) {
      const int sI = sg * 8 + u;
      float d = 0.f;
#pragma unroll 8
      for (int e = 0; e < 32; ++e) d += qs[j * 33 + e] * ks[sI * 33 + e];
      Sm[j * 65 + sI] = d;
      const float dl = sI <= j ? bjj - bj[sI] + ip[sI] : -1e30f;
      rmax = fmaxf(rmax, dl);
    }
    rmax = fmaxf(rmax, __shfl_xor(rmax, 1)); rmax = fmaxf(rmax, __shfl_xor(rmax, 2)); rmax = fmaxf(rmax, __shfl_xor(rmax, 4));
    const float g = bjj + m_start;
    const float mj = fmaxf(g, rmax);
    const float inter = fexp(g - mj);
    float part = 0.f;
#pragma unroll 1
    for (int u = 0; u < 8; ++u) {
      const int sI = sg * 8 + u;
      const float sv = sI <= j ? fexp(bjj - bj[sI] + ip[sI] - mj) * Sm[j * 65 + sI] : 0.f;
      Sm[j * 65 + sI] = sv; part += sv;
    }
    float nq = 0.f;
#pragma unroll
    for (int e = 0; e < 4; ++e) nq += ns[sg * 4 + e] * qs[j * 33 + sg * 4 + e];
    part += inter * nq;
    part += __shfl_xor(part, 1); part += __shfl_xor(part, 2); part += __shfl_xor(part, 4);
    const float den = fmaxf(fabsf(part), fexp(-mj));
    __syncthreads();
    const int v0 = sg * 8;
    float num[8], cq[8];
#pragma unroll
    for (int u = 0; u < 8; ++u) { num[u] = 0.f; cq[u] = 0.f; }
#pragma unroll 2
    for (int sI = 0; sI <= j; ++sI) {
      const float sv = Sm[j * 65 + sI];
      const float4 va = *(const float4*)(vs + sI * 64 + v0), vb = *(const float4*)(vs + sI * 64 + v0 + 4);
      num[0] += sv * va.x; num[1] += sv * va.y; num[2] += sv * va.z; num[3] += sv * va.w;
      num[4] += sv * vb.x; num[5] += sv * vb.y; num[6] += sv * vb.z; num[7] += sv * vb.w;
    }
#pragma unroll 2
    for (int e = 0; e < 32; ++e) {
      const float qv = qs[j * 33 + e];
#pragma unroll
      for (int u = 0; u < 8; ++u) cq[u] += Cs[(v0 + u) * 33 + e] * qv;
    }
    const float rden = 1.f / den;
#pragma unroll
    for (int u = 0; u < 8; ++u) hs[(dir ? 63 - j : j) * 64 + v0 + u] += (num[u] + inter * cq[u]) * rden;
    __syncthreads();
  }
  const int tk = tid >> 3, v0 = (tid & 7) * 8, n = ntok0 + tk;
  float ss = 0.f; float hv[8];
#pragma unroll
  for (int u = 0; u < 8; ++u) { hv[u] = hs[tk * 64 + v0 + u]; ss += hv[u] * hv[u]; }
  ss += __shfl_xor(ss, 1); ss += __shfl_xor(ss, 2); ss += __shfl_xor(ss, 4);
  const float rs = 1.0f / sqrtf(ss * (1.f / 64.f) + 1e-6f);
  unsigned o[4];
#pragma unroll
  for (int u = 0; u < 8; u += 2) {
    const int cc = hd * 64 + v0 + u;
    const float a = hv[u] * rs * p.ml_g_norm[l * 256 + cc] * sigmoidf_(zrec[(size_t)n * ZREC_W + ZR_MLO + cc]);
    const float bq = hv[u + 1] * rs * p.ml_g_norm[l * 256 + cc + 1] * sigmoidf_(zrec[(size_t)n * ZREC_W + ZR_MLO + cc + 1]);
    o[u >> 1] = pack2bf(a, bq);
  }
  bf16_t* mlo = (bf16_t*)(p.ws + OFF_REGION + R_MLO);
  *(uint4*)(mlo + (size_t)n * 256 + hd * 64 + v0) = make_uint4(o[0], o[1], o[2], o[3]);
}

DI constexpr int rwo_items(bool with_ctx) { return (with_ctx ? NT_ : NX_) / 16; }
DI void rwkv_out_item(const Params& p, int l, int it, char* smem) {
  float* sg = (float*)smem;
  const float* zrec = (const float*)(p.ws + OFF_REGION + R_ZREC);
  const float* rwp = (const float*)(p.ws + OFF_REGION + R_RWP);
  const float* ys = (const float*)(p.ws + OFF_REGION + R_YS);
  bf16_t* rwo = (bf16_t*)(p.ws + OFF_REGION + R_RWO);
  const float* mu = p.rw_mu + (size_t)l * 1152;
  const int tid = opaque_tid(), n0 = it * 16;
  __syncthreads();
  for (int idx = tid; idx < 16 * 128; idx += NTHR) {
    const int tt = idx >> 7, k = idx & 127, n = n0 + tt, t = tok_t(n), c = 1024 + k;
    const int len = n < NX_ ? T_ : CL_;
    const float* zr = zrec + (size_t)n * ZREC_W + ZR_RW + c;
    const float z = zr[0];
    const float zp = t > 0 ? zr[-ZREC_W] : 0.f, zn = t < len - 1 ? zr[ZREC_W] : 0.f;
    sg[k * 16 + tt] = sigmoidf_(z + (0.5f * (zp + zn) - z) * mu[c]);
  }
  __syncthreads();
  const int col = tid & 255, half = tid >> 8;
  float acc[8];
#pragma unroll
  for (int i = 0; i < 8; ++i) acc[i] = 0.f;
  const float* g2 = p.rw_g2 + (size_t)l * 128 * 256 + col;
  for (int k = 0; k < 128; ++k) {
    const float gv = g2[k * 256];
    const float* sk = sg + k * 16 + half * 8;
#pragma unroll
    for (int i = 0; i < 8; ++i) acc[i] += sk[i] * gv;
  }
  const size_t AS = (size_t)NT_ * 256;
  const float rk = p.rw_r_k[(size_t)l * 256 + col], lw = p.rw_lnx_w[(size_t)l * 256 + col], lb = p.rw_lnx_b[(size_t)l * 256 + col];
#pragma unroll
  for (int i = 0; i < 8; ++i) {
    const int n = n0 + half * 8 + i;
    const size_t o = (size_t)n * 256 + col;
    const float y = ys[o] + ys[AS + o];
    const float mean = wave_sum(y) * (1.f / 64.f);
    const float dv = y - mean;
    const float var = wave_sum(dv * dv) * (1.f / 64.f);
    const float yn = dv * (1.0f / sqrtf(var + 64e-5f)) * lw + lb;
    const float r = rwp[0 * AS + o], v = rwp[1 * AS + o];
    const float bsum = wave_sum(r * rk * (rwp[4 * AS + o] + rwp[7 * AS + o]));
    rwo[o] = f2bf((yn + bsum * v) * acc[i]);
  }
}
DI void phase5(const Params& p, int l, bool with_ctx, char* smem) {
  const int n1 = ml3_items(with_ctx), n2 = rwo_items(with_ctx);
  for (int it = blockIdx.x; it < n1 + n2; it += gridDim.x) {
    if (it < n1) mlstm_out_item(p, l, it, with_ctx, smem);
    else rwkv_out_item(p, l, it - n1, smem);
  }
}
DI void phase_merge(const Params& p, int l, bool with_ctx, char* smem) {
  const bf16_t* H = (const bf16_t*)(p.ws + OFF_H);
  const char* W = p.ws + OFF_WMIX + (size_t)l * WM_SIZE;
  const bf16_t* Wg = (const bf16_t*)(W + WM_GATE);
  const bf16_t* att = (const bf16_t*)(p.ws + OFF_REGION + R_ATT);
  const bf16_t* mlo = (const bf16_t*)(p.ws + OFF_REGION + R_MLO);
  const bf16_t* rwo = (const bf16_t*)(p.ws + OFF_REGION + R_RWO);
  bf16_t* ymix = (bf16_t*)(p.osc + O_YMIX);
  const int TM = (with_ctx ? NT_ : NX_) / 128;
  for (int it = blockIdx.x; it < TM * 8; it += gridDim.x) {
    const int tid = opaque_tid();
    const int tm = it >> 3, tn = it & 7;
    f32x16 yacc[G128::MB][G128::NB];
#pragma unroll
    for (int a = 0; a < G128::MB; ++a)
#pragma unroll
      for (int b = 0; b < G128::NB; ++b) yacc[a][b] = zero16();
#pragma unroll
    for (int i = 0; i < 3; ++i) {
      f32x16 gacc[G128::MB][G128::NB], bacc[G128::MB][G128::NB];
#pragma unroll
      for (int a = 0; a < G128::MB; ++a)
#pragma unroll
        for (int b = 0; b < G128::NB; ++b) { gacc[a][b] = zero16(); bacc[a][b] = zero16(); }
      const bf16_t* A0 = H + (size_t)tm * 128 * 1024;
      G128::run(gacc, [&](int r) { return A0 + (size_t)r * 1024; }, Wg + ((size_t)i * 1024 + tn * 128) * 1024, 1024, 1024, smem);
      const bf16_t* br = i == 0 ? att : (i == 1 ? mlo : rwo);
      const int kb = i == 0 ? 512 : 256;
      const bf16_t* Wb = (const bf16_t*)(W + (i == 0 ? WM_BRA : (i == 1 ? WM_BRM : WM_BRR)));
      const bf16_t* B0 = br + (size_t)tm * 128 * kb;
      G128::run(bacc, [&](int r) { return B0 + (size_t)r * kb; }, Wb + (size_t)tn * 128 * kb, kb, kb, smem);
#pragma unroll
      for (int a = 0; a < G128::MB; ++a)
#pragma unroll
        for (int b = 0; b < G128::NB; ++b)
#pragma unroll
          for (int e = 0; e < 16; ++e) yacc[a][b][e] += sigmoidf_(gacc[a][b][e]) * bacc[a][b][e];
    }
#pragma unroll
    for (int mb = 0; mb < G128::MB; ++mb)
#pragma unroll
      for (int nb = 0; nb < G128::NB; ++nb) {
        const int col = tn * 128 + G128::col_of(tid, nb);
#pragma unroll
        for (int e = 0; e < 16; ++e) ymix[(size_t)(tm * 128 + G128::row_of(tid, mb, e)) * 1024 + col] = f2bf(yacc[mb][nb][e]);
      }
  }
}

DI void phase_wout(const Params& p, int l, bool with_ctx, char* smem) {
  const bf16_t* ymix = (const bf16_t*)(p.osc + O_YMIX);
  const bf16_t* Wo = (const bf16_t*)(p.ws + OFF_WMIX + (size_t)l * WM_SIZE + WM_OUT);
  float* xs = (float*)(p.ws + OFF_XS);
  const float* mod = (const float*)(p.ws + OFF_MOD) + (size_t)l * 3 * 6144;
  const int TM = (with_ctx ? NT_ : NX_) / 128;
  const int n_g = TM * 8;
  for (int it = blockIdx.x; it < n_g + CVT_MOE_TILES; it += gridDim.x) {
    if (it >= n_g) { cvt_moe_item(p, l, it - n_g, smem); continue; }
    const int tid = opaque_tid();
    const int tm = it >> 3, tn = it & 7;
    f32x16 acc[G128::MB][G128::NB];
#pragma unroll
    for (int a = 0; a < G128::MB; ++a)
#pragma unroll
      for (int b = 0; b < G128::NB; ++b) acc[a][b] = zero16();
    const bf16_t* A0 = ymix + (size_t)tm * 128 * 1024;
    G128::run(acc, [&](int r) { return A0 + (size_t)r * 1024; }, Wo + (size_t)tn * 128 * 1024, 1024, 1024, smem);
    const float* m2 = mod + (size_t)tok_modrow(tm * 128) * 6144 + 2 * 1024;
#pragma unroll
    for (int mb = 0; mb < G128::MB; ++mb)
#pragma unroll
      for (int nb = 0; nb < G128::NB; ++nb) {
        const int col = tn * 128 + G128::col_of(tid, nb);
        const float g = m2[col];
#pragma unroll
        for (int e = 0; e < 16; ++e) {
          float* d = xs + (size_t)(tm * 128 + G128::row_of(tid, mb, e)) * 1024 + col;
          *d = *d + g * acc[mb][nb][e];
        }
      }
  }
}

typedef Gemm<128, 64, 64, 4, 2> GRT;
DI void phase_router(const Params& p, int l, bool with_ctx, char* smem, int* cnt) {
  float* xs = (float*)(p.ws + OFF_XS);
  bf16_t* H = (bf16_t*)(p.ws + OFF_H);
  const float* mod = (const float*)(p.ws + OFF_MOD) + (size_t)l * 3 * 6144;
  const bf16_t* Wr = (const bf16_t*)(p.ws + OFF_WMIX + (size_t)l * WM_SIZE + WM_RT);
  int* eidx = (int*)(p.ws + OFF_REGION + R_EIDX);
  float* ewt = (float*)(p.ws + OFF_REGION + R_EWT);
  int* erank = (int*)(p.ws + OFF_REGION + R_ERANK);
  int* elist = (int*)(p.ws + OFF_REGION + R_ELIST);
  float* sc = (float*)(smem + GRT::SMEM);
  float* bs = sc + 128 * 65;
  float* gs = bs + 128 * 65;
  const int tid = opaque_tid(), lane = tid & 63, wid = tid >> 6;
  const int ntok = with_ctx ? NT_ : NX_;
  for (int it = blockIdx.x; it < ntok / 128; it += gridDim.x) {
    const int n0 = it * 128;
    __syncthreads();
    for (int rr = 0; rr < 16; ++rr) {
      const int n = n0 + wid * 16 + rr;
      float v[16];
#pragma unroll
      for (int j = 0; j < 4; ++j) {
        const float4 t = *(const float4*)(xs + (size_t)n * 1024 + (j * 64 + lane) * 4);
        v[j * 4] = t.x; v[j * 4 + 1] = t.y; v[j * 4 + 2] = t.z; v[j * 4 + 3] = t.w;
      }
      const float* m = mod + (size_t)tok_modrow(n) * 6144;
      row_norm_mod(v, p.g_ffn + (size_t)l * 1024, m + 3 * 1024, m + 4 * 1024, H + (size_t)n * 1024, lane);
    }
    __syncthreads();
    f32x16 acc[1][1]; acc[0][0] = zero16();
    const bf16_t* A0 = H + (size_t)n0 * 1024;
    GRT::run(acc, [&](int r) { return A0 + (size_t)r * 1024; }, Wr, 1024, 1024, smem);
    {
      const int col = GRT::col_of(tid, 0);
      const float rb = p.router_bias[l * 64 + col];
#pragma unroll
      for (int e = 0; e < 16; ++e) {
        const int row = GRT::row_of(tid, 0, e);
        const float s = sigmoidf_(acc[0][0][e]);
        sc[row * 65 + col] = s; bs[row * 65 + col] = s + rb;
      }
    }
    __syncthreads();
    if (tid < 128) {
      const int n = n0 + tid;
      float* b = bs + tid * 65; const float* s = sc + tid * 65; float* g = gs + tid * 9;
      for (int gi = 0; gi < 8; ++gi) {
        float m1 = -1e30f, m2 = -1e30f;
        for (int j = 0; j < 8; ++j) { const float x = b[gi * 8 + j]; if (x > m1) { m2 = m1; m1 = x; } else if (x > m2) m2 = x; }
        g[gi] = m1 + m2;
      }
      unsigned gmask = 0;
      for (int c = 0; c < 4; ++c) {
        int best = 0; float bv = -1e30f;
        for (int gi = 0; gi < 8; ++gi) if (!((gmask >> gi) & 1) && g[gi] > bv) { bv = g[gi]; best = gi; }
        gmask |= 1u << best;
      }
      for (int gi = 0; gi < 8; ++gi) if (!((gmask >> gi) & 1)) for (int j = 0; j < 8; ++j) b[gi * 8 + j] = -1e30f;
      int sel[8]; float wsum = 0.f;
#pragma unroll
      for (int c = 0; c < 8; ++c) {
        int best = 0; float bv = -1e30f;
        for (int e = 0; e < 64; ++e) { const float x = b[e]; if (x > bv) { bv = x; best = e; } }
        b[best] = -3e30f; sel[c] = best; wsum += s[best];
      }
      const float inv = 2.5f / (wsum + 1e-20f);
#pragma unroll
      for (int c = 0; c < 8; ++c) {
        const int e = sel[c];
        const int rk = atomicAdd(cnt + e, 1);
        eidx[n * 8 + c] = e; ewt[n * 8 + c] = s[e] * inv; erank[n * 8 + c] = rk;
        elist[(size_t)e * NT_ + rk] = n * 8 + c;
      }
    }
  }
}

typedef Gemm<128, 256, 32, 2, 4> GMOE;
constexpr int ACT_LD = 264;
constexpr int MOE_ACT_OFF = GMOE::SMEM;
constexpr int MOE_INFO_OFF = MOE_ACT_OFF + 128 * ACT_LD * 2;
static_assert(MOE_INFO_OFF + 128 * 8 + 67 * 4 * 2 <= 160 * 1024 - 16, "moe lds");
DI void moe_down_run(f32x16 (&acc)[GMOE::MB][GMOE::NB], const char* actl, const bf16_t* Bt, char* smem) {
  constexpr int BK = 32, LDA = GMOE::LDA, CPR = 4, BCH = GMOE::BCH, STG = GMOE::B_BYTES;
  const int tid = opaque_tid(), lane = tid & 63, wid = tid >> 6, wm = wid / 4, wn = wid % 4;
  const int kc = (tid % CPR) * 8, r0 = tid / CPR;
  uint4 rb[BCH];
  char* Bs0 = smem;
#pragma unroll
  for (int i = 0; i < BCH; ++i) rb[i] = *(const uint4*)(Bt + (size_t)(r0 + i * 128) * 256 + kc);
#pragma unroll
  for (int i = 0; i < BCH; ++i) *(uint4*)(Bs0 + ((r0 + i * 128) * LDA + kc) * 2) = rb[i];
  __syncthreads();
  for (int kt = 0; kt < 256 / BK; ++kt) {
    const bool more = kt + 1 < 256 / BK;
    if (more) {
#pragma unroll
      for (int i = 0; i < BCH; ++i) rb[i] = *(const uint4*)(Bt + (size_t)(r0 + i * 128) * 256 + (kt + 1) * BK + kc);
    }
    const char* Bs = Bs0 + (kt & 1) * STG;
#pragma unroll
    for (int ks = 0; ks < BK / 16; ++ks) {
      bf16x8 af[GMOE::MB], bfr[GMOE::NB];
#pragma unroll
      for (int mb = 0; mb < GMOE::MB; ++mb)
        af[mb] = *(const bf16x8*)(actl + ((wm * 64 + mb * 32 + (lane & 31)) * ACT_LD + kt * BK + ks * 16 + (lane >> 5) * 8) * 2);
#pragma unroll
      for (int nb = 0; nb < GMOE::NB; ++nb)
        bfr[nb] = *(const bf16x8*)(Bs + ((wn * 64 + nb * 32 + (lane & 31)) * LDA + ks * 16 + (lane >> 5) * 8) * 2);
#pragma unroll
      for (int mb = 0; mb < GMOE::MB; ++mb)
#pragma unroll
        for (int nb = 0; nb < GMOE::NB; ++nb) acc[mb][nb] = mfma32(af[mb], bfr[nb], acc[mb][nb]);
    }
    if (more) {
      char* Bd = Bs0 + ((kt + 1) & 1) * STG;
#pragma unroll
      for (int i = 0; i < BCH; ++i) *(uint4*)(Bd + ((r0 + i * 128) * LDA + kc) * 2) = rb[i];
    }
    __syncthreads();
  }
}
DI void phase_moe(const Params& p, int l, bool with_ctx, char* smem, const int* cnt) {
  const bf16_t* H = (const bf16_t*)(p.ws + OFF_H);
  const bf16_t* GU = (const bf16_t*)(p.ws + OFF_REGION + R_WMOE + WE_GU);
  const bf16_t* DN = (const bf16_t*)(p.ws + OFF_REGION + R_WMOE + WE_DN);
  const float* ewt = (const float*)(p.ws + OFF_REGION + R_EWT);
  const int* elist = (const int*)(p.ws + OFF_REGION + R_ELIST);
  bf16_t* ybuf = (bf16_t*)(p.ws + OFF_REGION + R_YBUF);
  char* actl = smem + MOE_ACT_OFF;
  int* rtok = (int*)(smem + MOE_INFO_OFF);
  float* rwt = (float*)(rtok + 128);
  int* pre = (int*)(rwt + 128);
  int* off = pre + 67;
  int tid = threadIdx.x;
  const int ntok = with_ctx ? NT_ : NX_;
  __syncthreads();
  if (tid == 0) {
    int a = 0, o = 0;
    for (int e = 0; e < 65; ++e) { const int c = e < 64 ? cnt[e] : ntok; pre[e] = a; off[e] = o; a += (c + 127) >> 7; o += c; }
    pre[65] = a; off[65] = o;
  }
  __syncthreads();
  const int total = pre[65];
  for (int it = blockIdx.x; it < total; it += gridDim.x) {
    tid = opaque_tid();
    int e0 = 0;
    while (pre[e0 + 1] <= it) ++e0;
    const int e = rfl(e0);
    const int rb = rfl(it - pre[e]);
    const int c = rfl(e < 64 ? cnt[e] : ntok);
    const int obase = rfl(off[e] + rb * 128);
    __syncthreads();
    if (tid < 128) {
      const int slot = rb * 128 + tid;
      int tok = 0; float w = 0.f;
      if (slot < c) {
        if (e < 64) { const int pk = elist[(size_t)e * NT_ + slot]; tok = pk >> 3; w = ewt[pk]; }
        else { tok = slot; w = 1.f; }
      }
      rtok[tid] = tok; rwt[tid] = w;
    }
    __syncthreads();
    const bf16_t* Wgu = GU + (size_t)e * 512 * 1024;
#pragma unroll 1
    for (int hf = 0; hf < 2; ++hf) {
      f32x16 acc[GMOE::MB][GMOE::NB];
#pragma unroll
      for (int a = 0; a < GMOE::MB; ++a)
#pragma unroll
        for (int b = 0; b < GMOE::NB; ++b) acc[a][b] = zero16();
      GMOE::run(acc, [&](int r) { return H + (size_t)rtok[r] * 1024; }, Wgu + (size_t)hf * 256 * 1024, 1024, 1024, smem);
      const int lane = tid & 63, wn = (tid >> 6) % 4, wmr = ((tid >> 6) / 4) * 64 + 4 * (lane >> 5);
      const int j = (hf * 4 + wn) * 32 + (lane & 31);
#pragma unroll
      for (int mb = 0; mb < GMOE::MB; ++mb)
#pragma unroll
        for (int i = 0; i < 16; ++i) {
          const int row = wmr + mb * 32 + (i & 3) + 8 * (i >> 2);
          const float g = acc[mb][0][i], u = acc[mb][1][i];
          *(bf16_t*)(actl + (row * ACT_LD + j) * 2) = f2bf(siluf_(g) * u);
        }
    }
    __syncthreads();
    const bf16_t* Wd = DN + (size_t)e * 1024 * 256;
#pragma unroll 1
    for (int nt = 0; nt < 4; ++nt) {
      f32x16 acc[GMOE::MB][GMOE::NB];
#pragma unroll
      for (int a = 0; a < GMOE::MB; ++a)
#pragma unroll
        for (int b = 0; b < GMOE::NB; ++b) acc[a][b] = zero16();
      moe_down_run(acc, actl, Wd + (size_t)nt * 256 * 256, smem);
#pragma unroll
      for (int mb = 0; mb < GMOE::MB; ++mb)
#pragma unroll
        for (int nb = 0; nb < GMOE::NB; ++nb) {
          const int col = nt * 256 + ((tid >> 6) % 4) * 64 + nb * 32 + (tid & 31);
#pragma unroll
          for (int i = 0; i < 16; ++i) {
            const int row = ((tid >> 6) / 4) * 64 + 4 * ((tid & 63) >> 5) + mb * 32 + (i & 3) + 8 * (i >> 2);
            if (rb * 128 + row < c) (ybuf + (size_t)obase * 1024)[(unsigned)(row * 1024 + col)] = f2bf(acc[mb][nb][i] * rwt[row]);
          }
        }
    }
  }
}

DI void phase_combine(const Params& p, int l, bool last, char* smem, const int* cnt) {
  float* xs = (float*)(p.ws + OFF_XS);
  bf16_t* H = (bf16_t*)(p.ws + OFF_H);
  const float* mod = (const float*)(p.ws + OFF_MOD);
  const int* eidx = (const int*)(p.ws + OFF_REGION + R_EIDX);
  const int* erank = (const int*)(p.ws + OFF_REGION + R_ERANK);
  const bf16_t* ybuf = (const bf16_t*)(p.ws + OFF_REGION + R_YBUF);
  int* off = (int*)smem;
  const int tid = opaque_tid(), lane = tid & 63, wid = tid >> 6;
  const int ntok = last ? NX_ : NT_;
  __syncthreads();
  if (tid == 0) { int o = 0; for (int e = 0; e < 64; ++e) { off[e] = o; o += cnt[e]; } off[64] = o; }
  __syncthreads();
  for (int n = blockIdx.x * 8 + wid; n < ntok; n += gridDim.x * 8) {
    float acc[16];
#pragma unroll
    for (int i = 0; i < 16; ++i) acc[i] = 0.f;
    for (int k = 0; k < 9; ++k) {
      const int row = k < 8 ? off[eidx[n * 8 + k]] + erank[n * 8 + k] : off[64] + n;
      const bf16_t* y = ybuf + (size_t)row * 1024;
#pragma unroll
      for (int j = 0; j < 4; ++j) {
        const uint2 u = *(const uint2*)(y + (j * 64 + lane) * 4);
        acc[j * 4 + 0] += bf2f((bf16_t)(u.x & 0xffff)); acc[j * 4 + 1] += bf2f((bf16_t)(u.x >> 16));
        acc[j * 4 + 2] += bf2f((bf16_t)(u.y & 0xffff)); acc[j * 4 + 3] += bf2f((bf16_t)(u.y >> 16));
      }
    }
    const float* m5 = mod + ((size_t)l * 3 + tok_modrow(n)) * 6144 + 5 * 1024;
    float v[16];
#pragma unroll
    for (int j = 0; j < 4; ++j) {
      const int c = (j * 64 + lane) * 4;
      const float4 x = *(const float4*)(xs + (size_t)n * 1024 + c), g = *(const float4*)(m5 + c);
      v[j * 4 + 0] = x.x + g.x * acc[j * 4 + 0]; v[j * 4 + 1] = x.y + g.y * acc[j * 4 + 1];
      v[j * 4 + 2] = x.z + g.z * acc[j * 4 + 2]; v[j * 4 + 3] = x.w + g.w * acc[j * 4 + 3];
      if (!last) *(float4*)(xs + (size_t)n * 1024 + c) = make_float4(v[j * 4], v[j * 4 + 1], v[j * 4 + 2], v[j * 4 + 3]);
    }
    if (!last) {
      const float* m = mod + ((size_t)(l + 1) * 3 + tok_modrow(n)) * 6144;
      row_norm_mod(v, p.g_mix + (size_t)(l + 1) * 1024, m, m + 1024, H + (size_t)n * 1024, lane);
    } else {
      float ss = 0.f;
#pragma unroll
      for (int i = 0; i < 16; ++i) ss += v[i] * v[i];
      ss = wave_sum(ss);
      const float rs = 1.0f / sqrtf(ss * (1.f / 1024.f) + 1e-6f);
#pragma unroll
      for (int j = 0; j < 4; ++j) {
        const int c = (j * 64 + lane) * 4;
        const float4 g = *(const float4*)(p.g_final + c);
        *(float4*)(p.out + (size_t)n * 1024 + c) = make_float4(v[j * 4] * rs * g.x, v[j * 4 + 1] * rs * g.y, v[j * 4 + 2] * rs * g.z, v[j * 4 + 3] * rs * g.w);
      }
    }
  }
}
#define SMEM_BYTES (160 * 1024)
#ifndef MEGA
#define MEGA 0
#endif
DI int* cnt_ptr(const Params& p, int l) { return (int*)(p.ws + OFF_CNT) + 64 * l; }
DI int* ctr_ptr(const Params& p, int l) { return (int*)(p.ws + OFF_CNT) + 128 + l; }
#if !MEGA
__global__ void __launch_bounds__(NTHR) k_phaseA(Params p) { SMEM_DECL(smem, SMEM_BYTES); phaseA(p, smem); }
__global__ void __launch_bounds__(NTHR) k_norm0(Params p) { phase_norm0(p); }
__global__ void __launch_bounds__(NTHR) k_win(Params p, int l) { SMEM_DECL(smem, SMEM_BYTES); phase_win(p, l, smem); }
__global__ void __launch_bounds__(NTHR) k_p3(Params p, int l) { SMEM_DECL(smem, SMEM_BYTES); phase3(p, l, smem); }
__global__ void __launch_bounds__(NTHR) k_p4(Params p, int l) { SMEM_DECL(smem, SMEM_BYTES); phase4(p, l, smem, ctr_ptr(p, l)); }
__global__ void __launch_bounds__(NTHR) k_p5(Params p, int l, int wc) { SMEM_DECL(smem, SMEM_BYTES); phase5(p, l, wc != 0, smem); }
__global__ void __launch_bounds__(NTHR) k_merge(Params p, int l, int wc) { SMEM_DECL(smem, SMEM_BYTES); phase_merge(p, l, wc != 0, smem); }
__global__ void __launch_bounds__(NTHR) k_wout(Params p, int l, int wc) { SMEM_DECL(smem, SMEM_BYTES); phase_wout(p, l, wc != 0, smem); }
__global__ void __launch_bounds__(NTHR) k_router(Params p, int l, int wc) { SMEM_DECL(smem, SMEM_BYTES); phase_router(p, l, wc != 0, smem, cnt_ptr(p, l)); }
__global__ void __launch_bounds__(NTHR) k_moe(Params p, int l, int wc) { SMEM_DECL(smem, SMEM_BYTES); phase_moe(p, l, wc != 0, smem, cnt_ptr(p, l)); }
__global__ void __launch_bounds__(NTHR) k_combine(Params p, int l, int last) { SMEM_DECL(smem, SMEM_BYTES); phase_combine(p, l, last != 0, smem, cnt_ptr(p, l)); }
#else
#ifndef EMU
#define XB_TMO      128
#define XB_XCNT(j)  (256  + 64 * (j))
#define XB_XSUB(j)  (1280 + 64 * (j))
#define XB_XGEN(j)  (2304 + 64 * (j))
#define XB_TOP      3328
#define XB_TOPGEN   3392
#define XCD_BAR_WORDS 3456
#define XB_SPIN_CAP (1u << 24)
#define LAS __attribute__((address_space(3)))
DI unsigned xb_ld(unsigned* p) { return __hip_atomic_load(p, __ATOMIC_RELAXED, __HIP_MEMORY_SCOPE_AGENT); }
DI unsigned xb_add(unsigned* p, unsigned v) { return __hip_atomic_fetch_add(p, v, __ATOMIC_RELAXED, __HIP_MEMORY_SCOPE_AGENT); }
DI unsigned xb_xcc_id() { return (unsigned)__builtin_amdgcn_s_getreg((3 << 11) | 20) & 0xFu; }
#define XB_SPIN(cond, bar) do { unsigned _sp = 0; while (cond) { __builtin_amdgcn_s_sleep(1); \
    if ((++_sp & 255u) == 0u) { if (xb_ld(&(bar)[XB_TMO])) break; if (_sp > XB_SPIN_CAP) { atomicAdd(&(bar)[XB_TMO], 1u); break; } } } } while (0)
struct XcdBarrier { unsigned* bar; unsigned x; volatile LAS unsigned* st; };
DI XcdBarrier xcd_barrier_post(unsigned* bar, volatile LAS unsigned* st) {
  XcdBarrier b; b.bar = bar; b.x = xb_xcc_id(); b.st = st;
  if (threadIdx.x == 0) (void)xb_add(&bar[XB_XCNT(b.x)], 1u);
  return b;
}
DI void xcd_barrier_complete(unsigned* bar, unsigned x, unsigned& nloc, unsigned& nx) {
  const unsigned G = gridDim.x * gridDim.y * gridDim.z;
  unsigned sum, cnt, mine, sp = 0u;
  for (;;) {
    sum = 0u; cnt = 0u; mine = 0u;
#pragma unroll
    for (unsigned j = 0; j < 16; ++j) { const unsigned c = xb_ld(&bar[XB_XCNT(j)]); sum += c; cnt += (c > 0u) ? 1u : 0u; mine = (j == x) ? c : mine; }
    if (sum == G) break;
    __builtin_amdgcn_s_sleep(1);
    if ((++sp & 255u) == 0u) { if (xb_ld(&bar[XB_TMO])) break; if (sp > XB_SPIN_CAP) { atomicAdd(&bar[XB_TMO], 1u); break; } }
  }
  nloc = mine > 0u ? mine : 1u; nx = cnt > 0u ? cnt : 1u;
}
DI void xcd_barrier(const XcdBarrier& b) {
  asm volatile("s_waitcnt vmcnt(0)" ::: "memory");
  __syncthreads();
  if (threadIdx.x == 0) {
    unsigned* bar = b.bar;
    __builtin_amdgcn_s_waitcnt(0);
    unsigned nloc = b.st[0], nx = b.st[1];
    if (nloc == 0u) { xcd_barrier_complete(bar, b.x, nloc, nx); b.st[0] = nloc; b.st[1] = nx; }
    const unsigned old = xb_add(&bar[XB_XSUB(b.x)], 1u);
    const unsigned gen = old / nloc;
    if (old + 1u == (gen + 1u) * nloc) {
      __builtin_amdgcn_fence(__ATOMIC_RELEASE, "agent");
      asm volatile("s_waitcnt vmcnt(0)" ::: "memory");
      const unsigned og = xb_add(&bar[XB_TOP], 1u);
      const unsigned tg = og / nx;
      if (og + 1u == (tg + 1u) * nx) xb_add(&bar[XB_TOPGEN], 1u);
      else XB_SPIN(xb_ld(&bar[XB_TOPGEN]) == tg, bar);
      __builtin_amdgcn_fence(__ATOMIC_ACQUIRE, "agent");
      xb_add(&bar[XB_XGEN(b.x)], 1u);
      asm volatile("s_waitcnt vmcnt(0)" ::: "memory");
    } else {
      XB_SPIN(xb_ld(&bar[XB_XGEN(b.x)]) == gen, bar);
      __builtin_amdgcn_fence(__ATOMIC_ACQUIRE, "agent");
      asm volatile("s_waitcnt vmcnt(0)" ::: "memory");
    }
  }
  __syncthreads();
}
#define GSYNC() xcd_barrier(xb)
#else
#define GSYNC() emu::grid_barrier()
#endif
#ifdef PROBE_IDX
#define TS(i) { if (blockIdx.x == 0 && threadIdx.x == 0) ts[i] = wall_clock64(); }
#else
#define TS(i)
#endif
__global__ void __launch_bounds__(NTHR) k_mega(Params p) {
  SMEM_DECL(smem, SMEM_BYTES);
  cooperative_groups::grid_group grid = cooperative_groups::this_grid();
  volatile LAS unsigned* xst = (volatile LAS unsigned*)(smem + SMEM_BYTES - 32);
  if (threadIdx.x == 0) { xst[0] = 0u; xst[1] = 0u; }
  __syncthreads();
  XcdBarrier xb = xcd_barrier_post((unsigned*)(p.ws + OFF_BAR), xst);
#ifdef PROBE_IDX
  long long* ts = (long long*)(p.ws + OFF_CNT + 2048);
#endif
  TS(0);
  phaseA(p, smem);
  grid.sync(); TS(1);
  phase_norm0(p);
  GSYNC(); TS(2);
#pragma unroll 1
  for (int l = 0; l < 2; ++l) {
    const bool wc = l == 0;
    phase_win(p, l, smem); GSYNC(); TS(3 + l * 9);
    phase3(p, l, smem); GSYNC(); TS(4 + l * 9);
    phase4(p, l, smem, ctr_ptr(p, l)); GSYNC(); TS(5 + l * 9);
    phase5(p, l, wc, smem); GSYNC(); TS(6 + l * 9);
    phase_merge(p, l, wc, smem); GSYNC(); TS(7 + l * 9);
    phase_wout(p, l, wc, smem); GSYNC(); TS(8 + l * 9);
    phase_router(p, l, wc, smem, cnt_ptr(p, l)); GSYNC(); TS(9 + l * 9);
    phase_moe(p, l, wc, smem, cnt_ptr(p, l)); GSYNC(); TS(10 + l * 9);
    phase_combine(p, l, l == 1, smem, cnt_ptr(p, l));
#ifdef PROBE_IDX
    GSYNC(); TS(11 + l * 9);
#else
    if (l == 0) GSYNC();
#endif
  }
#ifdef PROBE_IDX
  if (blockIdx.x == 0 && threadIdx.x == 0) {
    const float us = (float)(ts[PROBE_IDX + 1] - ts[PROBE_IDX]) * 0.01f;
    p.out[0] += rintf(6.f * log2f(fmaxf(us, 1.f)));
  }
#endif
}
#endif

extern "C" void kernel_launch(void* const* d_in, const int* in_sizes, int n_in, void* d_out, int out_size, void* d_ws,
                              size_t ws_size, hipStream_t stream) {
  Params p{};
  const float** pp = (const float**)&p;
  for (int i = 0; i < 41; ++i) pp[i] = (const float*)d_in[i];
  p.out = (float*)d_out; p.ws = (char*)d_ws; p.osc = (char*)d_out;
  if (ws_size < WS_NEEDED) { fprintf(stderr, "workspace too small: %zu < %zu\n", ws_size, (size_t)WS_NEEDED); return; }
#if !MEGA
  const dim3 g(256), b(NTHR);
  hipLaunchKernelGGL(k_phaseA, g, b, 0, stream, p);
  hipLaunchKernelGGL(k_norm0, g, b, 0, stream, p);
  for (int l = 0; l < 2; ++l) {
    const int wc = l == 0;
    hipLaunchKernelGGL(k_win, g, b, 0, stream, p, l);
    hipLaunchKernelGGL(k_p3, g, b, 0, stream, p, l);
    hipLaunchKernelGGL(k_p4, g, b, 0, stream, p, l);
    hipLaunchKernelGGL(k_p5, g, b, 0, stream, p, l, wc);
    hipLaunchKernelGGL(k_merge, g, b, 0, stream, p, l, wc);
    hipLaunchKernelGGL(k_wout, g, b, 0, stream, p, l, wc);
    hipLaunchKernelGGL(k_router, g, b, 0, stream, p, l, wc);
    hipLaunchKernelGGL(k_moe, g, b, 0, stream, p, l, wc);
    hipLaunchKernelGGL(k_combine, g, b, 0, stream, p, l, l == 1);
  }
#else
  static int grid_blocks = 0;
  if (!grid_blocks) {
    int dev = 0, cus = 0, per_cu = 0;
    hipGetDevice(&dev);
    hipDeviceGetAttribute(&cus, hipDeviceAttributeMultiprocessorCount, dev);
    hipOccupancyMaxActiveBlocksPerMultiprocessor(&per_cu, k_mega, NTHR, 0);
    if (per_cu > 1) per_cu = 1;
    grid_blocks = cus * per_cu;
  }
  hipMemsetAsync(p.ws + OFF_BAR, 0, 16384, stream);
  void* args[] = {&p};
  hipError_t e = hipLaunchCooperativeKernel((void*)k_mega, dim3(grid_blocks), dim3(NTHR), args, 0, stream);
  if (e != hipSuccess) fprintf(stderr, "cooperative launch failed: %s (grid %d)\n", hipGetErrorString(e), grid_blocks);
#endif
}
```

```cpp
#define MEGA 1
#include <hip/hip_runtime.h>
#include <hip/hip_cooperative_groups.h>
#include <cstdio>

#ifndef SEQ_T
#define SEQ_T 8192
#endif
#ifndef CTX_L
#define CTX_L 256
#endif

#define DI __device__ __forceinline__
typedef unsigned short bf16_t;
typedef short bf16x8 __attribute__((ext_vector_type(8)));
typedef float f32x16 __attribute__((ext_vector_type(16)));
typedef float f32x4 __attribute__((ext_vector_type(4)));

constexpr int NB_ = 2, T_ = SEQ_T, CL_ = CTX_L, D_ = 1024;
constexpr int NX_ = NB_ * T_, NC_ = NB_ * CL_, NT_ = NX_ + NC_, KT_ = CL_ + T_;
constexpr int GRID_W_ = 64;
constexpr int MLA_H = 8, MLA_NOPE_ = 64, MLA_ROPE_ = 32, MLA_DK = 96, MLA_DV = 64, QLORA = 384, KVLORA = 256;
constexpr int MLA_IN_ = 672, ML_IN_ = 784, RW_IN_ = 1152, GATE_IN_ = 3072, D_IN_ = 5680;
constexpr int ZMLA_W = 768;
constexpr int ZREC_W = 1936;
constexpr int WIN_N = 768 + 2048;
constexpr int ML_H = 4, ML_DK = 32, ML_DV = 64, ML_L = 64;
constexpr int RW_H = 4, RW_N_ = 64;
constexpr int NE_ = 64, TOPK_ = 8, DE_ = 256;
constexpr int NCH_ = KT_ / ML_L;
constexpr int NSEQ_ = 2 * NB_ * 4;

constexpr int ZR_MLQ = 0, ZR_MLK = 128, ZR_MLV = 256, ZR_MLO = 512, ZR_MLI = 768, ZR_MLF = 776;
constexpr int ZR_RW = 784;

constexpr size_t al256(size_t x) { return (x + 255) & ~(size_t)255; }
constexpr size_t WM_WIN = 0;
constexpr size_t WM_GATE = WM_WIN + (size_t)WIN_N * 1024 * 2;
constexpr size_t WM_UQ = WM_GATE + (size_t)3072 * 1024 * 2;
constexpr size_t WM_UKV = WM_UQ + (size_t)768 * 384 * 2;
constexpr size_t WM_BRA = WM_UKV + (size_t)1024 * 256 * 2;
constexpr size_t WM_BRM = WM_BRA + (size_t)1024 * 512 * 2;
constexpr size_t WM_BRR = WM_BRM + (size_t)1024 * 256 * 2;
constexpr size_t WM_OUT = WM_BRR + (size_t)1024 * 256 * 2;
constexpr size_t WM_RT = WM_OUT + (size_t)1024 * 1024 * 2;
constexpr size_t WM_SIZE = al256(WM_RT + (size_t)64 * 1024 * 2);
constexpr size_t WE_GU = 0;
constexpr size_t WE_DN = WE_GU + (size_t)65 * 512 * 1024 * 2;
constexpr size_t WE_SIZE = al256(WE_DN + (size_t)65 * 1024 * 256 * 2);

constexpr size_t OFF_XS = 0;
constexpr size_t OFF_MOD = OFF_XS + al256((size_t)NT_ * 1024 * 4);
constexpr size_t OFF_ROPE = OFF_MOD + al256((size_t)2 * 3 * 6144 * 4);
constexpr size_t OFF_H = OFF_ROPE + al256((size_t)T_ * 16 * 8);
constexpr size_t OFF_WMIX = OFF_H + al256((size_t)NT_ * 1024 * 2);
constexpr size_t OFF_CNT = OFF_WMIX + 2 * WM_SIZE;
constexpr size_t OFF_BAR = OFF_CNT + 4096;
constexpr size_t OFF_REGION = OFF_BAR + 16384;
constexpr size_t R_ZREC = 0;
constexpr size_t R_RWP = R_ZREC + al256((size_t)NT_ * ZREC_W * 4);
constexpr size_t R_YS = R_RWP + al256((size_t)9 * NT_ * 256 * 4);
constexpr size_t R_MLST = R_YS + al256((size_t)2 * NT_ * 256 * 4);
constexpr size_t R_ATT = R_MLST + al256((size_t)NSEQ_ * NCH_ * 2112 * 4);
constexpr size_t R_MLO = R_ATT + al256((size_t)NT_ * 512 * 2);
constexpr size_t R_RWO = R_MLO + al256((size_t)NT_ * 256 * 2);
constexpr size_t R_VT = R_RWO + al256((size_t)NT_ * 256 * 2);
constexpr size_t R_KB = R_VT + al256((size_t)NB_ * MLA_H * 64 * KT_ * 2);
constexpr size_t R_MIX_END = R_KB + al256((size_t)NB_ * MLA_H * KT_ * 96 * 2);
constexpr int NSLOT_ = NT_ * 9;
constexpr size_t R_YBUF = 0;
constexpr size_t R_EIDX = R_YBUF + al256((size_t)NSLOT_ * 1024 * 2);
constexpr size_t R_EWT = R_EIDX + al256((size_t)NT_ * 8 * 4);
constexpr size_t R_ERANK = R_EWT + al256((size_t)NT_ * 8 * 4);
constexpr size_t R_ELIST = R_ERANK + al256((size_t)NT_ * 8 * 4);
constexpr size_t R_WMOE = R_ELIST + al256((size_t)64 * NT_ * 4);
constexpr size_t R_MOE_END = R_WMOE + WE_SIZE;
constexpr size_t R_SIZE = R_MIX_END > R_MOE_END ? R_MIX_END : R_MOE_END;
constexpr size_t WS_NEEDED = OFF_REGION + R_SIZE;
constexpr size_t O_ZMLA = 0;
constexpr size_t O_QB = O_ZMLA + al256((size_t)NT_ * ZMLA_W * 2);
constexpr size_t O_END = O_QB + al256((size_t)NT_ * 768 * 2);
constexpr size_t O_YMIX = 0;
#if SEQ_T == 8192 && CTX_L == 256
static_assert(O_END <= (size_t)NX_ * 1024 * 4, "d_out scratch overflow");
static_assert((size_t)NT_ * 1024 * 2 <= (size_t)NX_ * 1024 * 4, "ymix overflow");
static_assert(WS_NEEDED <= (size_t)597000000, "workspace too large");
#endif

struct Params {
  const float *x, *c, *ctx, *c_ctx, *w_mod, *b_mod, *g_mix, *g_ffn, *w_in, *g_cq, *w_uq, *g_ckv, *w_uk, *w_uv;
  const float *ml_b_i, *ml_b_f, *ml_g_norm, *rw_mu, *rw_w0, *rw_w2, *rw_a0, *rw_a2, *rw_g2, *rw_k_k, *rw_k_a;
  const float *rw_r_k, *rw_lnx_w, *rw_lnx_b, *w_br_mla, *w_br_ml, *w_br_rw, *w_out, *w_router, *router_bias;
  const float *w_e_gate, *w_e_up, *w_e_down, *w_s_gate, *w_s_up, *w_s_down, *g_final;
  float* out; char* ws; char* osc;
};

DI float bf2f(bf16_t s) { unsigned u = ((unsigned)s) << 16; float f; __builtin_memcpy(&f, &u, 4); return f; }
DI bf16_t f2bf(float x) { unsigned u; __builtin_memcpy(&u, &x, 4); u += 0x7fffu + ((u >> 16) & 1u); return (bf16_t)(u >> 16); }
DI unsigned pack2bf(float a, float b) {
#ifdef EMU
  return (unsigned)f2bf(a) | ((unsigned)f2bf(b) << 16);
#else
  typedef __bf16 bf2 __attribute__((ext_vector_type(2)));
  typedef float f2 __attribute__((ext_vector_type(2)));
  f2 v = {a, b}; bf2 r = __builtin_convertvector(v, bf2); return __builtin_bit_cast(unsigned, r);
#endif
}
DI f32x16 mfma32(bf16x8 a, bf16x8 b, f32x16 c) {
#ifdef EMU
  return emu_mfma_32x32x16_bf16(a, b, c);
#else
  return __builtin_amdgcn_mfma_f32_32x32x16_bf16(a, b, c, 0, 0, 0);
#endif
}
DI int rfl(int v) {
#ifdef EMU
  return v;
#else
  return __builtin_amdgcn_readfirstlane(v);
#endif
}
DI int opaque_tid() {
#ifdef EMU
  return threadIdx.x;
#else
  int t = threadIdx.x; asm volatile("" : "+v"(t)); return t;
#endif
}
DI f32x16 zero16() { f32x16 z; for (int i = 0; i < 16; ++i) z[i] = 0.f; return z; }
DI int crow(int reg, int h) { return (reg & 3) + 8 * (reg >> 2) + 4 * h; }
#ifdef EMU
DI float fexp(float x) { return expf(x); }
#else
DI float fexp(float x) { return __expf(x); }
#endif
DI float sigmoidf_(float x) { return 1.f / (1.f + fexp(-x)); }
DI float siluf_(float x) { return x * sigmoidf_(x); }
DI float wave_sum(float v) { for (int m = 32; m >= 1; m >>= 1) v += __shfl_xor(v, m); return v; }
DI float wave_max(float v) { for (int m = 32; m >= 1; m >>= 1) v = fmaxf(v, __shfl_xor(v, m)); return v; }

DI int tok_b(int n) { return n < NX_ ? n / T_ : (n - NX_) / CL_; }
DI int tok_t(int n) { return n < NX_ ? n % T_ : (n - NX_) % CL_; }
DI int tok_key(int n) { return n < NX_ ? CL_ + n % T_ : (n - NX_) % CL_; }
DI int tok_modrow(int n) { return n < NX_ ? n / T_ : 2; }

#ifdef EMU
#define SMEM_DECL(name, bytes) char* name = (char*)emu::shared_alloc(bytes)
#else
#define SMEM_DECL(name, bytes) __shared__ __attribute__((aligned(16))) char name[bytes]
#endif
#define NTHR 512
struct CvtJob { const float* src; int lds; int K; bf16_t* dst; int ntn; int ntk; int maptype; const float* gain; };
DI int cvt_map(int maptype, int coff, int np) {
  if (maptype == 0) return coff + np;
  if (maptype == 1) { if (np < 672) return np; if (np < 768) return -1; if (np < 768 + 1936) return np - 96; return -1; }
  return np;
}
DI void cvt_tile(const CvtJob& j, int coff, int tk, int tn, char* smem) {
  float* tile = (float*)smem;
  const int tid = opaque_tid();
  __syncthreads();
  {
    const int kk = tid >> 3, nc = (tid & 7) * 8, k = tk * 64 + kk;
    const float g = j.gain ? j.gain[k] : 1.f;
#pragma unroll
    for (int i = 0; i < 8; ++i) {
      const int np = tn * 64 + nc + i;
      const int sc = cvt_map(j.maptype, coff, np);
      tile[kk * 65 + nc + i] = sc >= 0 ? j.src[(size_t)k * j.lds + sc] * g : 0.f;
    }
  }
  __syncthreads();
  {
    const int n = tid >> 3, kc = (tid & 7) * 8;
    int np = tn * 64 + n;
    if (j.maptype == 2) np = (np >> 5) * 64 + coff * 32 + (np & 31);
    uint4 v;
    v.x = pack2bf(tile[(kc + 0) * 65 + n], tile[(kc + 1) * 65 + n]);
    v.y = pack2bf(tile[(kc + 2) * 65 + n], tile[(kc + 3) * 65 + n]);
    v.z = pack2bf(tile[(kc + 4) * 65 + n], tile[(kc + 5) * 65 + n]);
    v.w = pack2bf(tile[(kc + 6) * 65 + n], tile[(kc + 7) * 65 + n]);
    *(uint4*)(j.dst + (size_t)np * j.K + tk * 64 + kc) = v;
  }
}

constexpr int CVT_MIX_TILES = 704 + 768 + 72 + 32 + 32 + 128 + 64 + 64 + 256 + 16;
DI void cvt_mix_item(const Params& p, int l, int it, char* smem) {
  bf16_t* W = (bf16_t*)(p.ws + OFF_WMIX + (size_t)l * WM_SIZE);
  CvtJob j; int coff = 0;
  if (it < 704) { j = {p.w_in + (size_t)l * 1024 * D_IN_, D_IN_, 1024, (bf16_t*)((char*)W + WM_WIN), 44, 16, 1, nullptr}; }
  else if ((it -= 704) < 768) { j = {p.w_in + (size_t)l * 1024 * D_IN_, D_IN_, 1024, (bf16_t*)((char*)W + WM_GATE), 48, 16, 0, nullptr}; coff = 2608; }
  else if ((it -= 768) < 72) { j = {p.w_uq + (size_t)l * 384 * 768, 768, 384, (bf16_t*)((char*)W + WM_UQ), 12, 6, 0, p.g_cq + l * 384}; }
  else if ((it -= 72) < 32) { j = {p.w_uk + (size_t)l * 256 * 512, 512, 256, (bf16_t*)((char*)W + WM_UKV), 8, 4, 0, p.g_ckv + l * 256}; }
  else if ((it -= 32) < 32) { j = {p.w_uv + (size_t)l * 256 * 512, 512, 256, (bf16_t*)((char*)W + WM_UKV) + 512 * 256, 8, 4, 0, p.g_ckv + l * 256}; }
  else if ((it -= 32) < 128) { j = {p.w_br_mla + (size_t)l * 512 * 1024, 1024, 512, (bf16_t*)((char*)W + WM_BRA), 16, 8, 0, nullptr}; }
  else if ((it -= 128) < 64) { j = {p.w_br_ml + (size_t)l * 256 * 1024, 1024, 256, (bf16_t*)((char*)W + WM_BRM), 16, 4, 0, nullptr}; }
  else if ((it -= 64) < 64) { j = {p.w_br_rw + (size_t)l * 256 * 1024, 1024, 256, (bf16_t*)((char*)W + WM_BRR), 16, 4, 0, nullptr}; }
  else if ((it -= 64) < 256) { j = {p.w_out + (size_t)l * 1024 * 1024, 1024, 1024, (bf16_t*)((char*)W + WM_OUT), 16, 16, 0, nullptr}; }
  else { it -= 256; j = {p.w_router + (size_t)l * 1024 * 64, 64, 1024, (bf16_t*)((char*)W + WM_RT), 1, 16, 0, nullptr}; }
  cvt_tile(j, coff, it / j.ntn, it % j.ntn, smem);
}
constexpr int CVT_MOE_TILES = 65 * 192;
DI void cvt_moe_item(const Params& p, int l, int it, char* smem) {
  const int e = it / 192; int r = it % 192;
  bf16_t* GU = (bf16_t*)(p.ws + OFF_REGION + R_WMOE + WE_GU) + (size_t)e * 512 * 1024;
  bf16_t* DN = (bf16_t*)(p.ws + OFF_REGION + R_WMOE + WE_DN) + (size_t)e * 1024 * 256;
  const float* sg = e < 64 ? p.w_e_gate + ((size_t)l * 64 + e) * 1024 * 256 : p.w_s_gate + (size_t)l * 1024 * 256;
  const float* su = e < 64 ? p.w_e_up + ((size_t)l * 64 + e) * 1024 * 256 : p.w_s_up + (size_t)l * 1024 * 256;
  const float* sd = e < 64 ? p.w_e_down + ((size_t)l * 64 + e) * 256 * 1024 : p.w_s_down + (size_t)l * 256 * 1024;
  CvtJob j; int coff = 0;
  if (r < 64) { j = {sg, 256, 1024, GU, 4, 16, 2, nullptr}; coff = 0; }
  else if ((r -= 64) < 64) { j = {su, 256, 1024, GU, 4, 16, 2, nullptr}; coff = 1; }
  else { r -= 64; j = {sd, 1024, 256, DN, 16, 4, 0, nullptr}; }
  cvt_tile(j, coff, r / j.ntn, r % j.ntn, smem);
}

DI void mod_item(const Params& p, int it, char* smem) {
  float* cond = (float*)smem;
  float* red = cond + 3 * 1024;
  const int tid = opaque_tid(), l = it / 96, j0 = (it % 96) * 64;
  __syncthreads();
  for (int i = tid; i < 3 * 1024; i += NTHR) {
    const int r = i >> 10, k = i & 1023;
    const float v = r < 2 ? p.c[r * 1024 + k] : p.c_ctx[k];
    cond[i] = siluf_(v);
  }
  __syncthreads();
  const int jj = tid & 63, kg = tid >> 6;
  float a0 = 0.f, a1 = 0.f, a2 = 0.f;
  const float* w = p.w_mod + (size_t)l * 1024 * 6144 + j0 + jj;
  for (int k = kg; k < 1024; k += 8) {
    const float wv = w[(size_t)k * 6144];
    a0 += cond[k] * wv; a1 += cond[1024 + k] * wv; a2 += cond[2048 + k] * wv;
  }
  red[(kg * 3 + 0) * 64 + jj] = a0; red[(kg * 3 + 1) * 64 + jj] = a1; red[(kg * 3 + 2) * 64 + jj] = a2;
  __syncthreads();
  if (tid < 192) {
    const int r = tid >> 6; float s = 0.f;
    for (int g = 0; g < 8; ++g) s += red[(g * 3 + r) * 64 + jj];
    float* mod = (float*)(p.ws + OFF_MOD);
    mod[((size_t)l * 3 + r) * 6144 + j0 + jj] = s + p.b_mod[(size_t)l * 6144 + j0 + jj];
  }
}
DI void rope_item(const Params& p, int it) {
  const int idx = it * NTHR + threadIdx.x;
  if (idx >= T_ * 16) return;
  const int t = idx >> 4, i = idx & 15, f = i & 7;
  const float pos = (float)(i < 8 ? t / GRID_W_ : t % GRID_W_);
  const float inv = powf(10000.f, -(float)(2 * f) / 16.f);
  const float ang = pos * inv;
  float2* rt = (float2*)(p.ws + OFF_ROPE);
  rt[idx] = make_float2(cosf(ang), sinf(ang));
}
constexpr int PA_ITEMS = 192 + (T_ * 16 + NTHR - 1) / NTHR + 2 * CVT_MIX_TILES;
DI void phaseA(const Params& p, char* smem) {
  if (blockIdx.x == 0 && threadIdx.x < 256) ((int*)(p.ws + OFF_CNT))[threadIdx.x] = 0;
  for (int it = blockIdx.x; it < PA_ITEMS; it += gridDim.x) {
    int i = it;
    if (i < 192) { mod_item(p, i, smem); continue; }
    i -= 192;
    constexpr int NR = (T_ * 16 + NTHR - 1) / NTHR;
    if (i < NR) { rope_item(p, i); continue; }
    i -= NR;
    cvt_mix_item(p, i / CVT_MIX_TILES, i % CVT_MIX_TILES, smem);
  }
}

DI void row_norm_mod(const float (&v)[16], const float* g, const float* shift, const float* scale, bf16_t* hrow, int lane) {
  float ss = 0.f;
#pragma unroll
  for (int i = 0; i < 16; ++i) ss += v[i] * v[i];
  ss = wave_sum(ss);
  const float rs = 1.0f / sqrtf(ss * (1.f / 1024.f) + 1e-6f);
#pragma unroll
  for (int j = 0; j < 4; ++j) {
    const int c = (j * 64 + lane) * 4;
    const float4 gg = *(const float4*)(g + c), sh = *(const float4*)(shift + c), sc = *(const float4*)(scale + c);
    const float h0 = v[j * 4 + 0] * rs * gg.x * (1.f + sc.x) + sh.x;
    const float h1 = v[j * 4 + 1] * rs * gg.y * (1.f + sc.y) + sh.y;
    const float h2 = v[j * 4 + 2] * rs * gg.z * (1.f + sc.z) + sh.z;
    const float h3 = v[j * 4 + 3] * rs * gg.w * (1.f + sc.w) + sh.w;
    uint2 o; o.x = pack2bf(h0, h1); o.y = pack2bf(h2, h3);
    *(uint2*)(hrow + c) = o;
  }
}
DI void phase_norm0(const Params& p) {
  const int lane = threadIdx.x & 63, wid = threadIdx.x >> 6;
  float* xs = (float*)(p.ws + OFF_XS);
  bf16_t* H = (bf16_t*)(p.ws + OFF_H);
  const float* mod = (const float*)(p.ws + OFF_MOD);
  for (int n = blockIdx.x * 8 + wid; n < NT_; n += gridDim.x * 8) {
    const float* src = n < NX_ ? p.x + (size_t)n * 1024 : p.ctx + (size_t)(n - NX_) * 1024;
    float v[16];
#pragma unroll
    for (int j = 0; j < 4; ++j) {
      const float4 t = *(const float4*)(src + (j * 64 + lane) * 4);
      v[j * 4] = t.x; v[j * 4 + 1] = t.y; v[j * 4 + 2] = t.z; v[j * 4 + 3] = t.w;
      *(float4*)(xs + (size_t)n * 1024 + (j * 64 + lane) * 4) = t;
    }
    const float* m = mod + (size_t)(0 * 3 + tok_modrow(n)) * 6144;
    row_norm_mod(v, p.g_mix, m, m + 1024, H + (size_t)n * 1024, lane);
  }
}

template <int BM, int BN, int BK, int WM_, int WN_>
struct Gemm {
  static constexpr int WTM = BM / WM_, WTN = BN / WN_, MB = WTM / 32, NB = WTN / 32;
  static constexpr int LDA = BK + 8;
  static constexpr int A_BYTES = BM * LDA * 2, B_BYTES = BN * LDA * 2, STAGE = A_BYTES + B_BYTES;
  static constexpr int SMEM = 2 * STAGE;
  static constexpr int CPR = BK / 8;
  static constexpr int ACH = BM * CPR / NTHR, BCH = BN * CPR / NTHR;
  static_assert(WM_ * WN_ == 8, "8 waves");
  static_assert(BM * CPR % NTHR == 0 && BN * CPR % NTHR == 0, "chunking");
  static_assert(NTHR % CPR == 0, "rows fixed per thread");

  template <class ARow>
  static DI void run(f32x16 (&acc)[MB][NB], ARow arow, const bf16_t* Bt, int ldb, int Klen, char* smem) {
    const int tid = opaque_tid(), lane = tid & 63, wid = tid >> 6, wm = wid / WN_, wn = wid % WN_;
    const int kc = (tid % CPR) * 8, r0 = tid / CPR;
    const bf16_t* ap[ACH]; const bf16_t* bp[BCH];
#pragma unroll
    for (int i = 0; i < ACH; ++i) ap[i] = arow(r0 + i * (NTHR / CPR)) + kc;
#pragma unroll
    for (int i = 0; i < BCH; ++i) bp[i] = Bt + (size_t)(r0 + i * (NTHR / CPR)) * ldb + kc;
    uint4 ra[ACH], rb[BCH];
    const int nk = Klen / BK;
#pragma unroll
    for (int i = 0; i < ACH; ++i) ra[i] = *(const uint4*)(ap[i]);
#pragma unroll
    for (int i = 0; i < BCH; ++i) rb[i] = *(const uint4*)(bp[i]);
#pragma unroll
    for (int i = 0; i < ACH; ++i) *(uint4*)(smem + ((r0 + i * (NTHR / CPR)) * LDA + kc) * 2) = ra[i];
#pragma unroll
    for (int i = 0; i < BCH; ++i) *(uint4*)(smem + A_BYTES + ((r0 + i * (NTHR / CPR)) * LDA + kc) * 2) = rb[i];
    __syncthreads();
    for (int kt = 0; kt < nk; ++kt) {
      const bool more = kt + 1 < nk;
      if (more) {
#pragma unroll
        for (int i = 0; i < ACH; ++i) ra[i] = *(const uint4*)(ap[i] + (kt + 1) * BK);
#pragma unroll
        for (int i = 0; i < BCH; ++i) rb[i] = *(const uint4*)(bp[i] + (kt + 1) * BK);
      }
      const char* As = smem + (kt & 1) * STAGE;
      const char* Bs = As + A_BYTES;
#pragma unroll
      for (int ks = 0; ks < BK / 16; ++ks) {
        bf16x8 af[MB], bfr[NB];
#pragma unroll
        for (int mb = 0; mb < MB; ++mb)
          af[mb] = *(const bf16x8*)(As + ((wm * WTM + mb * 32 + (lane & 31)) * LDA + ks * 16 + (lane >> 5) * 8) * 2);
#pragma unroll
        for (int nb = 0; nb < NB; ++nb)
          bfr[nb] = *(const bf16x8*)(Bs + ((wn * WTN + nb * 32 + (lane & 31)) * LDA + ks * 16 + (lane >> 5) * 8) * 2);
#pragma unroll
        for (int mb = 0; mb < MB; ++mb)
#pragma unroll
          for (int nb = 0; nb < NB; ++nb) acc[mb][nb] = mfma32(af[mb], bfr[nb], acc[mb][nb]);
      }
      if (more) {
        char* Ad = smem + ((kt + 1) & 1) * STAGE;
#pragma unroll
        for (int i = 0; i < ACH; ++i) *(uint4*)(Ad + ((r0 + i * (NTHR / CPR)) * LDA + kc) * 2) = ra[i];
#pragma unroll
        for (int i = 0; i < BCH; ++i) *(uint4*)(Ad + A_BYTES + ((r0 + i * (NTHR / CPR)) * LDA + kc) * 2) = rb[i];
      }
      __syncthreads();
    }
  }
  static DI int row_of(int t, int mb, int reg) { const int lane = t & 63, wm = (t >> 6) / WN_; return wm * WTM + mb * 32 + crow(reg, lane >> 5); }
  static DI int col_of(int t, int nb) { const int lane = t & 63, wn = (t >> 6) % WN_; return wn * WTN + nb * 32 + (lane & 31); }
};

typedef Gemm<256, 256, 64, 2, 4> G256;
DI void phase_win(const Params& p, int l, char* smem) {
  const bf16_t* H = (const bf16_t*)(p.ws + OFF_H);
  const bf16_t* W = (const bf16_t*)(p.ws + OFF_WMIX + (size_t)l * WM_SIZE + WM_WIN);
  bf16_t* zmla = (bf16_t*)(p.osc + O_ZMLA);
  float* zrec = (float*)(p.ws + OFF_REGION + R_ZREC);
  constexpr int TM = NT_ / 256, TN = WIN_N / 256;
  for (int it = blockIdx.x; it < TM * TN; it += gridDim.x) {
    const int tid = opaque_tid();
    const int tm = it / TN, tn = it % TN;
    f32x16 acc[G256::MB][G256::NB];
#pragma unroll
    for (int a = 0; a < G256::MB; ++a)
#pragma unroll
      for (int b = 0; b < G256::NB; ++b) acc[a][b] = zero16();
    const bf16_t* A0 = H + (size_t)tm * 256 * 1024;
    G256::run(acc, [&](int r) { return A0 + (size_t)r * 1024; }, W + (size_t)tn * 256 * 1024, 1024, 1024, smem);
#pragma unroll
    for (int mb = 0; mb < G256::MB; ++mb)
#pragma unroll
      for (int nb = 0; nb < G256::NB; ++nb) {
        const int col = tn * 256 + G256::col_of(tid, nb);
#pragma unroll
        for (int i = 0; i < 16; ++i) {
          const int row = tm * 256 + G256::row_of(tid, mb, i);
          const float v = acc[mb][nb][i];
          if (col < 768) zmla[(size_t)row * ZMLA_W + col] = f2bf(v);
          else if (col - 768 < ZREC_W) zrec[(size_t)row * ZREC_W + (col - 768)] = v;
        }
      }
  }
}
typedef Gemm<128, 128, 64, 2, 4> G128;
DI void mla_row_rs(const bf16_t* zmla_rows, int c0, int len, float* rs) {
  const int tid = opaque_tid(), row = tid >> 2, half = tid & 3;
  const bf16_t* src = zmla_rows + (size_t)row * ZMLA_W + c0 + half * (len / 4);
  float ss = 0.f;
  for (int i = 0; i < len / 4; i += 8) {
    const uint4 v = *(const uint4*)(src + i);
    const unsigned w[4] = {v.x, v.y, v.z, v.w};
#pragma unroll
    for (int j = 0; j < 4; ++j) { const float a = bf2f((bf16_t)(w[j] & 0xffff)), b = bf2f((bf16_t)(w[j] >> 16)); ss += a * a + b * b; }
  }
  ss += __shfl_xor(ss, 1); ss += __shfl_xor(ss, 2);
  if (half == 0) rs[row] = 1.0f / sqrtf(ss / (float)len + 1e-6f);
}

constexpr int MLA_Q_TILES = (NT_ / 128) * 6, MLA_KV_TILES = (NT_ / 128) * 8;
DI void mla_q_item(const Params& p, int l, int it, char* smem) {
  const int tid = opaque_tid();
  const int tm = it / 6, tn = it % 6;
  const bf16_t* zmla = (const bf16_t*)(p.osc + O_ZMLA) + (size_t)tm * 128 * ZMLA_W;
  const bf16_t* W = (const bf16_t*)(p.ws + OFF_WMIX + (size_t)l * WM_SIZE + WM_UQ) + (size_t)tn * 128 * 384;
  bf16_t* qb = (bf16_t*)(p.osc + O_QB);
  const float2* rt = (const float2*)(p.ws + OFF_ROPE);
  float* rs = (float*)(smem + G128::SMEM);
  __syncthreads();
  mla_row_rs(zmla, 0, 384, rs);
  f32x16 acc[G128::MB][G128::NB];
#pragma unroll
  for (int a = 0; a < G128::MB; ++a)
#pragma unroll
    for (int b = 0; b < G128::NB; ++b) acc[a][b] = zero16();
  G128::run(acc, [&](int r) { return zmla + (size_t)r * ZMLA_W; }, W, 384, 384, smem);
  const int lane = tid & 63;
  const bool isx = tm * 128 < NX_;
#pragma unroll
  for (int mb = 0; mb < G128::MB; ++mb)
#pragma unroll
    for (int nb = 0; nb < G128::NB; ++nb) {
      const int col = tn * 128 + G128::col_of(tid, nb);
      const bool ropeblk = ((col >> 5) % 3) == 2;
      const int e = lane & 31;
#pragma unroll
      for (int i = 0; i < 16; ++i) {
        const int lr = G128::row_of(tid, mb, i);
        const int n = tm * 128 + lr;
        float v = acc[mb][nb][i] * rs[lr];
        if (ropeblk && isx) {
          const float pv = __shfl_xor(v, 8);
          const float2 cs = rt[(size_t)(n % T_) * 16 + (e >> 4) * 8 + (e & 7)];
          v = (e & 8) ? (pv * cs.y + v * cs.x) : (v * cs.x - pv * cs.y);
        }
        qb[(size_t)n * 768 + col] = f2bf(v);
      }
    }
}
DI void mla_kv_item(const Params& p, int l, int it, char* smem) {
  const int tid = opaque_tid();
  const int tm = it / 8, tn = it % 8;
  const bf16_t* zmla = (const bf16_t*)(p.osc + O_ZMLA) + (size_t)tm * 128 * ZMLA_W;
  const bf16_t* W = (const bf16_t*)(p.ws + OFF_WMIX + (size_t)l * WM_SIZE + WM_UKV) + (size_t)tn * 128 * 256;
  bf16_t* kb = (bf16_t*)(p.ws + OFF_REGION + R_KB);
  bf16_t* vt = (bf16_t*)(p.ws + OFF_REGION + R_VT);
  const float2* rt = (const float2*)(p.ws + OFF_ROPE);
  float* rs = (float*)(smem + G128::SMEM);
  __syncthreads();
  mla_row_rs(zmla, 384, 256, rs);
  const int n0 = tm * 128;
  const int b = tok_b(n0), key0 = tok_key(n0);
  const bool isx = n0 < NX_;
  if (tn == 0) {
    for (int idx = tid; idx < 128 * 16; idx += NTHR) {
      const int lr = idx >> 4, pi = idx & 15, a = pi >> 3, i = pi & 7;
      const bf16_t* z = zmla + (size_t)lr * ZMLA_W + 640 + a * 16 + i;
      float x1 = bf2f(z[0]), x2 = bf2f(z[8]);
      if (isx) {
        const float2 cs = rt[(size_t)((n0 + lr) % T_) * 16 + a * 8 + i];
        const float y1 = x1 * cs.x - x2 * cs.y, y2 = x1 * cs.y + x2 * cs.x; x1 = y1; x2 = y2;
      }
      const bf16_t o1 = f2bf(x1), o2 = f2bf(x2);
      for (int h = 0; h < 8; ++h) {
        bf16_t* dst = kb + ((size_t)(b * 8 + h) * KT_ + key0 + lr) * 96 + 64 + a * 16 + i;
        dst[0] = o1; dst[8] = o2;
      }
    }
  }
  f32x16 acc[G128::MB][G128::NB];
#pragma unroll
  for (int a = 0; a < G128::MB; ++a)
#pragma unroll
    for (int c = 0; c < G128::NB; ++c) acc[a][c] = zero16();
  G128::run(acc, [&](int r) { return zmla + (size_t)r * ZMLA_W + 384; }, W, 256, 256, smem);
  const int lane = tid & 63;
#pragma unroll
  for (int mb = 0; mb < G128::MB; ++mb)
#pragma unroll
    for (int nb = 0; nb < G128::NB; ++nb) {
      const int col = tn * 128 + G128::col_of(tid, nb);
      if (col < 512) {
        const int h = col >> 6, d = col & 63;
#pragma unroll
        for (int i = 0; i < 16; ++i) {
          const int lr = G128::row_of(tid, mb, i);
          kb[((size_t)(b * 8 + h) * KT_ + key0 + lr) * 96 + d] = f2bf(acc[mb][nb][i] * rs[lr]);
        }
      } else {
        const int h = (col - 512) >> 6, d = col & 63;
#pragma unroll
        for (int g = 0; g < 4; ++g) {
          const int lr = G128::row_of(tid, mb, g * 4);
          uint2 o;
          o.x = pack2bf(acc[mb][nb][g * 4 + 0] * rs[lr], acc[mb][nb][g * 4 + 1] * rs[lr + 1]);
          o.y = pack2bf(acc[mb][nb][g * 4 + 2] * rs[lr + 2], acc[mb][nb][g * 4 + 3] * rs[lr + 3]);
          *(uint2*)(vt + ((size_t)(b * 8 + h) * 64 + d) * KT_ + key0 + lr) = o;
        }
      }
    }
  (void)lane;
}

DI float softplusf_(float x) { return x > 20.f ? x : log1pf(fexp(x)); }
constexpr int RWP_TT = 16;
constexpr int RWP_ITEMS = NT_ / RWP_TT;
DI void rwkv_prep_item(const Params& p, int l, int it, char* smem) {
  float* zs = (float*)smem;
  float* tw = zs + RWP_TT * 1024;
  float* ta = tw + 2 * 64 * RWP_TT;
  const float* zrec = (const float*)(p.ws + OFF_REGION + R_ZREC);
  float* rwp = (float*)(p.ws + OFF_REGION + R_RWP);
  const float* mu = p.rw_mu + (size_t)l * 1152;
  const int tid = opaque_tid(), n0 = it * RWP_TT;
  __syncthreads();
  for (int idx = tid; idx < RWP_TT * 1024; idx += NTHR) {
    const int tt = idx >> 10, c = idx & 1023, n = n0 + tt, t = tok_t(n);
    const int len = n < NX_ ? T_ : CL_;
    const float* zr = zrec + (size_t)n * ZREC_W + ZR_RW + c;
    const float z = zr[0];
    const float zp = t > 0 ? zr[-ZREC_W] : 0.f, zn = t < len - 1 ? zr[ZREC_W] : 0.f;
    const float s = z + (0.5f * (zp + zn) - z) * mu[c];
    zs[idx] = s;
    if (c >= 768 && c < 896) { const int d = (c - 768) >> 6, k = (c - 768) & 63; tw[(d * 64 + k) * RWP_TT + tt] = tanhf(s); }
    if (c >= 896) { const int d = (c - 896) >> 6, k = (c - 896) & 63; ta[(d * 64 + k) * RWP_TT + tt] = s; }
  }
  __syncthreads();
  const int col = tid & 255, d = tid >> 8;
  float aw[RWP_TT], aa[RWP_TT];
#pragma unroll
  for (int i = 0; i < RWP_TT; ++i) { aw[i] = 0.f; aa[i] = 0.f; }
  const float* w2 = p.rw_w2 + ((size_t)l * 2 + d) * 64 * 256 + col;
  const float* a2 = p.rw_a2 + ((size_t)l * 2 + d) * 64 * 256 + col;
  for (int k = 0; k < 64; ++k) {
    const float wv = w2[k * 256], av = a2[k * 256];
    const float* twk = tw + (d * 64 + k) * RWP_TT;
    const float* tak = ta + (d * 64 + k) * RWP_TT;
#pragma unroll
    for (int i = 0; i < RWP_TT; ++i) { aw[i] += twk[i] * wv; aa[i] += tak[i] * av; }
  }
  const float w0 = p.rw_w0[((size_t)l * 2 + d) * 256 + col], a0 = p.rw_a0[((size_t)l * 2 + d) * 256 + col];
  const float kkw = p.rw_k_k[(size_t)l * 256 + col], kaw = p.rw_k_a[(size_t)l * 256 + col];
  const size_t AS = (size_t)NT_ * 256;
#pragma unroll
  for (int i = 0; i < RWP_TT; ++i) {
    const int n = n0 + i;
    const float r = zs[i * 1024 + col], k = zs[i * 1024 + 256 + col], v = zs[i * 1024 + 512 + col];
    const float kr = k * kkw;
    const float ss = wave_sum(kr * kr);
    const float kk = kr / fmaxf(sqrtf(ss), 1e-12f);
    const float w = -softplusf_(-(w0 + aw[i])) - 0.5f;
    const float decay = fexp(-fexp(w));
    const float a = sigmoidf_(a0 + aa[i]);
    const float kd = k * (1.f + (a - 1.f) * kaw);
    const size_t o = (size_t)n * 256 + col;
    if (d == 0) { rwp[0 * AS + o] = r; rwp[1 * AS + o] = v; rwp[2 * AS + o] = kk; }
    rwp[(3 + d * 3 + 0) * AS + o] = decay;
    rwp[(3 + d * 3 + 1) * AS + o] = kd;
    rwp[(3 + d * 3 + 2) * AS + o] = kk * a;
  }
}

DI int seq_tok(int dir, int b, int pos) {
  if (pos < CL_) return NX_ + b * CL_ + (dir ? CL_ - 1 - pos : pos);
  const int t = pos - CL_;
  return b * T_ + (dir ? T_ - 1 - t : t);
}
DI float logsigmoidf_(float x) { return -softplusf_(-x); }
DI float wave_incl_scan(float v, int lane) {
  for (int d = 1; d < 64; d <<= 1) { const float o = __shfl_up(v, d); if (lane >= d) v += o; }
  return v;
}
constexpr int ML_ST = 2112;
constexpr int ML1_ITEMS = NSEQ_ * NCH_;
DI void mlstm_local_item(const Params& p, int l, int it, char* smem) {
  const int s = it / NCH_, c = it % NCH_, dir = s >> 3, b = (s >> 2) & 1, hd = s & 3;
  float* vv = (float*)smem;
  float* kw = vv + 64 * 64;
  float* wej = kw + 64 * 32;
  const float* zrec = (const float*)(p.ws + OFF_REGION + R_ZREC);
  float* st = (float*)(p.ws + OFF_REGION + R_MLST) + ((size_t)s * NCH_ + c) * ML_ST;
  const int tid = opaque_tid(), lane = tid & 63, wid = tid >> 6;
  __syncthreads();
  if (wid == 0) {
    const int n = seq_tok(dir, b, c * 64 + lane);
    const float fp = zrec[(size_t)n * ZREC_W + ZR_MLF + dir * 4 + hd] + p.ml_b_f[(l * 2 + dir) * 4 + hd];
    const float ip = zrec[(size_t)n * ZREC_W + ZR_MLI + dir * 4 + hd] + p.ml_b_i[(l * 2 + dir) * 4 + hd];
    const float bj = wave_incl_scan(logsigmoidf_(fp), lane);
    const float bl = __shfl(bj, 63);
    const float lw = bl - bj + ip;
    const float ml = wave_max(lw);
    wej[lane] = fexp(lw - ml);
    if (lane == 0) { st[2080] = bl; st[2081] = ml; }
  }
  for (int idx = tid; idx < 64 * 64; idx += NTHR) {
    const int j = idx >> 6, e = idx & 63;
    const int n = seq_tok(dir, b, c * 64 + j);
    vv[idx] = zrec[(size_t)n * ZREC_W + ZR_MLV + hd * 64 + e];
  }
  __syncthreads();
  for (int idx = tid; idx < 64 * 32; idx += NTHR) {
    const int j = idx >> 5, e = idx & 31;
    const int n = seq_tok(dir, b, c * 64 + j);
    kw[idx] = zrec[(size_t)n * ZREC_W + ZR_MLK + hd * 32 + e] * wej[j];
  }
  __syncthreads();
  const int v = tid & 63, d0 = (tid >> 6) * 4;
  float a0 = 0.f, a1 = 0.f, a2 = 0.f, a3 = 0.f;
  for (int j = 0; j < 64; ++j) {
    const float x = vv[j * 64 + v];
    const float4 kk = *(const float4*)(kw + j * 32 + d0);
    a0 += x * kk.x; a1 += x * kk.y; a2 += x * kk.z; a3 += x * kk.w;
  }
  *(float4*)(st + v * 32 + d0) = make_float4(a0, a1, a2, a3);
  if (tid < 32) { float sn = 0.f; for (int j = 0; j < 64; ++j) sn += kw[j * 32 + tid]; st[2048 + tid] = sn; }
}
constexpr int ML2_ITEMS = (NSEQ_ * 2080 + NTHR - 1) / NTHR;
DI void mlstm_scan_item(const Params& p, int it) {
  const int g = it * NTHR + opaque_tid();
  if (g >= NSEQ_ * 2080) return;
  const int s = g / 2080, e = g % 2080;
  float* st = (float*)(p.ws + OFF_REGION + R_MLST) + (size_t)s * NCH_ * ML_ST;
  float state = 0.f, m = 0.f;
  for (int c = 0; c < NCH_; ++c) {
    float* r = st + (size_t)c * ML_ST;
    const float d = r[e], bl = r[2080], ml = r[2081];
    r[e] = state;
    if (e == 0) r[2082] = m;
    const float mn = fmaxf(bl + m, ml);
    state = fexp(bl + m - mn) * state + fexp(ml - mn) * d;
    m = mn;
  }
}

constexpr int P3_ITEMS = RWP_ITEMS + ML1_ITEMS;
DI void phase3(const Params& p, int l, char* smem) {
  for (int it = blockIdx.x; it < P3_ITEMS; it += gridDim.x) {
    if (it < RWP_ITEMS) rwkv_prep_item(p, l, it, smem);
    else mlstm_local_item(p, l, it - RWP_ITEMS, smem);
  }
}
constexpr int ATT_KLD = 104, ATT_VLD = 68;
constexpr int ATT_KB = 64 * ATT_KLD * 2, ATT_VB = 64 * ATT_VLD * 2, ATT_STAGE = ATT_KB + ATT_VB;
DI float fexp2(float x) {
#ifdef EMU
  return exp2f(x);
#else
  return __builtin_amdgcn_exp2f(x);
#endif
}
DI void attn_item(const Params& p, int b, int h, int qt, bool isctx, char* smem) {
  const int tid = opaque_tid(), lane = tid & 63, wid = tid >> 6, r = lane & 31, h2 = lane >> 5;
  const bf16_t* qb = (const bf16_t*)(p.osc + O_QB);
  const bf16_t* kbase = (const bf16_t*)(p.ws + OFF_REGION + R_KB) + (size_t)(b * 8 + h) * KT_ * 96;
  const bf16_t* vbase = (const bf16_t*)(p.ws + OFF_REGION + R_VT) + (size_t)(b * 8 + h) * 64 * KT_;
  bf16_t* att = (bf16_t*)(p.ws + OFF_REGION + R_ATT);
  const int nq0 = isctx ? NX_ + b * CL_ + qt * 256 : b * T_ + qt * 256;
  const int nkt = (isctx ? CL_ : KT_) / 64;
  const int nq = nq0 + wid * 32 + r;
  bf16x8 qf[6];
#pragma unroll
  for (int ks = 0; ks < 6; ++ks) qf[ks] = *(const bf16x8*)(qb + (size_t)nq * 768 + h * 96 + ks * 16 + h2 * 8);
  f32x16 oacc[2] = {zero16(), zero16()};
  float m = -1e30f, lsum = 0.f;
  const float sc = 0.10206207261596577f * 1.4426950408889634f;
  const int kc1 = tid + 512;
  const int vd = tid >> 3, vc = tid & 7;
  uint4 rk0, rk1, rv;
  auto gload = [&](int kt) {
    const bf16_t* ksrc = kbase + (size_t)kt * 64 * 96;
    rk0 = *(const uint4*)(ksrc + tid * 8);
    if (kc1 < 768) rk1 = *(const uint4*)(ksrc + kc1 * 8);
    rv = *(const uint4*)(vbase + (size_t)vd * KT_ + kt * 64 + vc * 8);
  };
  auto sstore = [&](int buf) {
    char* Ks = smem + buf * ATT_STAGE; char* Vs = Ks + ATT_KB;
    *(uint4*)(Ks + ((tid / 12) * ATT_KLD + (tid % 12) * 8) * 2) = rk0;
    if (kc1 < 768) *(uint4*)(Ks + ((kc1 / 12) * ATT_KLD + (kc1 % 12) * 8) * 2) = rk1;
    *(uint2*)(Vs + (vd * ATT_VLD + vc * 8) * 2) = make_uint2(rv.x, rv.y);
    *(uint2*)(Vs + (vd * ATT_VLD + vc * 8 + 4) * 2) = make_uint2(rv.z, rv.w);
  };
  __syncthreads();
  gload(0); sstore(0);
  __syncthreads();
  for (int kt = 0; kt < nkt; ++kt) {
    const bool more = kt + 1 < nkt;
    if (more) gload(kt + 1);
    const char* Ks = smem + (kt & 1) * ATT_STAGE; const char* Vs = Ks + ATT_KB;
    f32x16 sacc[2] = {zero16(), zero16()};
#pragma unroll
    for (int ks = 0; ks < 6; ++ks)
#pragma unroll
      for (int kb = 0; kb < 2; ++kb) {
        const bf16x8 kf = *(const bf16x8*)(Ks + ((kb * 32 + r) * ATT_KLD + ks * 16 + h2 * 8) * 2);
        sacc[kb] = mfma32(kf, qf[ks], sacc[kb]);
      }
    float mx = -1e30f;
#pragma unroll
    for (int kb = 0; kb < 2; ++kb)
#pragma unroll
      for (int i = 0; i < 16; ++i) mx = fmaxf(mx, sacc[kb][i]);
    mx = fmaxf(mx, __shfl_xor(mx, 32));
    const float mn = fmaxf(m, mx * sc);
    const float alpha = fexp2(m - mn);
    m = mn;
    float ps = 0.f;
#pragma unroll
    for (int kb = 0; kb < 2; ++kb)
#pragma unroll
      for (int i = 0; i < 16; ++i) { const float pv = fexp2(sacc[kb][i] * sc - mn); sacc[kb][i] = pv; ps += pv; }
    lsum = lsum * alpha + ps;
#pragma unroll
    for (int db = 0; db < 2; ++db)
#pragma unroll
      for (int i = 0; i < 16; ++i) oacc[db][i] *= alpha;
#pragma unroll
    for (int kb = 0; kb < 2; ++kb)
#pragma unroll
      for (int s = 0; s < 2; ++s) {
        bf16x8 pf;
        {
          const unsigned u0 = pack2bf(sacc[kb][8 * s + 0], sacc[kb][8 * s + 1]), u1 = pack2bf(sacc[kb][8 * s + 2], sacc[kb][8 * s + 3]);
          const unsigned u2 = pack2bf(sacc[kb][8 * s + 4], sacc[kb][8 * s + 5]), u3 = pack2bf(sacc[kb][8 * s + 6], sacc[kb][8 * s + 7]);
          const uint4 u = make_uint4(u0, u1, u2, u3);
          __builtin_memcpy(&pf, &u, 16);
        }
#pragma unroll
        for (int db = 0; db < 2; ++db) {
          const char* vrow = Vs + ((db * 32 + r) * ATT_VLD + kb * 32 + 16 * s + 4 * h2) * 2;
          const uint2 lo = *(const uint2*)(vrow), hi = *(const uint2*)(vrow + 16);
          const uint4 u = make_uint4(lo.x, lo.y, hi.x, hi.y);
          bf16x8 vf; __builtin_memcpy(&vf, &u, 16);
          oacc[db] = mfma32(vf, pf, oacc[db]);
        }
      }
    if (more) sstore((kt + 1) & 1);
    __syncthreads();
  }
  lsum += __shfl_xor(lsum, 32);
  const float inv = 1.f / lsum;
#pragma unroll
  for (int db = 0; db < 2; ++db)
#pragma unroll
    for (int g = 0; g < 4; ++g) {
      uint2 o;
      o.x = pack2bf(oacc[db][g * 4 + 0] * inv, oacc[db][g * 4 + 1] * inv);
      o.y = pack2bf(oacc[db][g * 4 + 2] * inv, oacc[db][g * 4 + 3] * inv);
      *(uint2*)(att + (size_t)nq * 512 + h * 64 + db * 32 + 8 * g + 4 * h2) = o;
    }
}

DI float red16(float x) {
#ifdef EMU
  x += __shfl_xor(x, 1); x += __shfl_xor(x, 2); x += __shfl_xor(x, 4); x += __shfl_xor(x, 8); return x;
#else
  x += __builtin_bit_cast(float, __builtin_amdgcn_mov_dpp(__builtin_bit_cast(int, x), 0xB1, 0xf, 0xf, true));
  x += __builtin_bit_cast(float, __builtin_amdgcn_mov_dpp(__builtin_bit_cast(int, x), 0x4E, 0xf, 0xf, true));
  x += __builtin_bit_cast(float, __builtin_amdgcn_mov_dpp(__builtin_bit_cast(int, x), 0x124, 0xf, 0xf, true));
  x += __builtin_bit_cast(float, __builtin_amdgcn_mov_dpp(__builtin_bit_cast(int, x), 0x128, 0xf, 0xf, true));
  return x;
#endif
}
DI int rws_arr(int vec, int dir) { return vec == 0 ? 2 : (vec < 4 ? 2 + vec + 3 * dir : vec - 4); }
DI void red16x2(float& a, float& b) {
#ifdef EMU
  a = red16(a); b = red16(b);
#else
  a += __builtin_bit_cast(float, __builtin_amdgcn_mov_dpp(__builtin_bit_cast(int, a), 0xB1, 0xf, 0xf, true));
  b += __builtin_bit_cast(float, __builtin_amdgcn_mov_dpp(__builtin_bit_cast(int, b), 0xB1, 0xf, 0xf, true));
  a += __builtin_bit_cast(float, __builtin_amdgcn_mov_dpp(__builtin_bit_cast(int, a), 0x4E, 0xf, 0xf, true));
  b += __builtin_bit_cast(float, __builtin_amdgcn_mov_dpp(__builtin_bit_cast(int, b), 0x4E, 0xf, 0xf, true));
  a += __builtin_bit_cast(float, __builtin_amdgcn_mov_dpp(__builtin_bit_cast(int, a), 0x124, 0xf, 0xf, true));
  b += __builtin_bit_cast(float, __builtin_amdgcn_mov_dpp(__builtin_bit_cast(int, b), 0x124, 0xf, 0xf, true));
  a += __builtin_bit_cast(float, __builtin_amdgcn_mov_dpp(__builtin_bit_cast(int, a), 0x128, 0xf, 0xf, true));
  b += __builtin_bit_cast(float, __builtin_amdgcn_mov_dpp(__builtin_bit_cast(int, b), 0x128, 0xf, 0xf, true));
#endif
}
constexpr int RWS_CH = 16;
constexpr int RWS_ITEMS = NSEQ_ * 2;
constexpr int RWS_BUF = RWS_CH * 6 * 64 * 4;
constexpr int RWS_YOFF = 2 * RWS_BUF;
DI void rws_chunk_tok(int dir, int b, int ch, int& n0, int& dn) {
  const int pos = ch * RWS_CH;
  if (pos < CL_) { n0 = NX_ + b * CL_ + (dir ? CL_ - 1 - pos : pos); }
  else { const int t = pos - CL_; n0 = b * T_ + (dir ? T_ - 1 - t : t); }
  dn = dir ? -1 : 1;
}
DI void rwkv_scan_item(const Params& p, int it, char* smem) {
  const int s = it >> 1, rg = it & 1, dir = s >> 3, b = (s >> 2) & 1, hd = s & 3;
  const int tid = opaque_tid(), lane = tid & 63, wid = tid >> 6, c4 = (lane & 15) * 4;
  const int lrow = wid * 4 + (lane >> 4), row = rg * 32 + lrow;
  const float* rwp = (const float*)(p.ws + OFF_REGION + R_RWP);
  float* ys = (float*)(p.ws + OFF_REGION + R_YS) + (size_t)dir * NT_ * 256;
  const size_t AS = (size_t)NT_ * 256;
  float4 lr0, lr1, lr2;
  const int i0 = tid, i1 = tid + NTHR, i2 = tid + 2 * NTHR;
  const int st0 = i0 / 96, st1 = i1 / 96, st2 = i2 / 96;
  const size_t o0 = rws_arr((i0 % 96) >> 4, dir) * AS + hd * 64 + (i0 & 15) * 4;
  const size_t o1 = rws_arr((i1 % 96) >> 4, dir) * AS + hd * 64 + (i1 & 15) * 4;
  const size_t o2 = rws_arr((i2 % 96) >> 4, dir) * AS + hd * 64 + (i2 & 15) * 4;
#define RWS_GLOAD(ch) { int n0_, dn_; rws_chunk_tok(dir, b, ch, n0_, dn_); \
    lr0 = *(const float4*)(rwp + o0 + (size_t)(n0_ + dn_ * st0) * 256); lr1 = *(const float4*)(rwp + o1 + (size_t)(n0_ + dn_ * st1) * 256); \
    lr2 = *(const float4*)(rwp + o2 + (size_t)(n0_ + dn_ * st2) * 256); }
#define RWS_SSTORE(buf) { *(float4*)(smem + (buf) * RWS_BUF + i0 * 16) = lr0; *(float4*)(smem + (buf) * RWS_BUF + i1 * 16) = lr1; *(float4*)(smem + (buf) * RWS_BUF + i2 * 16) = lr2; }
  float s0 = 0.f, s1 = 0.f, s2 = 0.f, s3 = 0.f;
  constexpr int NCHK = KT_ / RWS_CH;
  float* ybuf = (float*)(smem + RWS_YOFF);
  __syncthreads();
  RWS_GLOAD(0); RWS_SSTORE(0);
  __syncthreads();
  for (int ch = 0; ch < NCHK; ++ch) {
    if (ch + 1 < NCHK) RWS_GLOAD(ch + 1);
    const float* B = (const float*)(smem + (ch & 1) * RWS_BUF);
    float* yb = ybuf + (ch & 1) * (RWS_CH * 32);
    float4 nkk = *(const float4*)(B + c4), nw = *(const float4*)(B + 64 + c4), nkd = *(const float4*)(B + 128 + c4);
    float4 nbb = *(const float4*)(B + 192 + c4), nrr = *(const float4*)(B + 256 + c4);
    float nv = B[320 + row];
    float4 prr = nrr;
#pragma unroll
    for (int st = 0; st < RWS_CH; ++st) {
      const float4 kk = nkk, w = nw, kd = nkd, bb = nbb, rr = nrr; const float v = nv;
      if (st + 1 < RWS_CH) {
        const float* S = B + (st + 1) * 384;
        nkk = *(const float4*)(S + c4); nw = *(const float4*)(S + 64 + c4); nkd = *(const float4*)(S + 128 + c4);
        nbb = *(const float4*)(S + 192 + c4); nrr = *(const float4*)(S + 256 + c4); nv = S[320 + row];
      }
      const float t0 = v * kd.x, t1 = v * kd.y, t2 = v * kd.z, t3 = v * kd.w;
      float pa = (s0 * kk.x + s1 * kk.y) + (s2 * kk.z + s3 * kk.w);
      if (st > 0) {
        float py = (s0 * prr.x + s1 * prr.y) + (s2 * prr.z + s3 * prr.w);
        red16x2(pa, py);
        yb[(st - 1) * 32 + lrow] = py;
      } else {
        pa = red16(pa);
      }
      const float sa = -pa;
      s0 = s0 * w.x + (sa * bb.x + t0);
      s1 = s1 * w.y + (sa * bb.y + t1);
      s2 = s2 * w.z + (sa * bb.z + t2);
      s3 = s3 * w.w + (sa * bb.w + t3);
      prr = rr;
    }
    yb[(RWS_CH - 1) * 32 + lrow] = red16((s0 * prr.x + s1 * prr.y) + (s2 * prr.z + s3 * prr.w));
    if (ch + 1 < NCHK) RWS_SSTORE((ch + 1) & 1);
    __syncthreads();
    {
      int n0_, dn_; rws_chunk_tok(dir, b, ch, n0_, dn_);
      const int st = tid >> 5, rr_ = tid & 31;
      ys[(size_t)(n0_ + dn_ * st) * 256 + hd * 64 + rg * 32 + rr_] = yb[st * 32 + rr_];
    }
  }
}

DI constexpr int att_items(int l) { return NB_ * 8 * (T_ / 256) + (l == 0 ? NB_ * 8 * (CL_ / 256) : 0); }
DI void spin_until_ge(int* ctr, int target) {
#ifdef EMU
  while (__atomic_load_n(ctr, __ATOMIC_SEQ_CST) < target) emu::yield();
#else
  while (__hip_atomic_load(ctr, __ATOMIC_RELAXED, __HIP_MEMORY_SCOPE_AGENT) < target) __builtin_amdgcn_s_sleep(8);
#endif
}
DI void phase4(const Params& p, int l, char* smem, int* ctr) {
  const int G = gridDim.x, nsb = G >= 64 ? RWS_ITEMS : G / 2, nw = G - nsb;
  if ((int)blockIdx.x < nsb) {
    for (int it = blockIdx.x; it < RWS_ITEMS; it += nsb) rwkv_scan_item(p, it, smem);
  } else {
    const int w = blockIdx.x - nsb;
    for (int it = w; it < ML2_ITEMS + MLA_Q_TILES + MLA_KV_TILES; it += nw) {
      int i = it;
      if (i < ML2_ITEMS) { mlstm_scan_item(p, i); continue; }
      i -= ML2_ITEMS;
      if (i < MLA_Q_TILES) mla_q_item(p, l, i, smem); else mla_kv_item(p, l, i - MLA_Q_TILES, smem);
    }
#ifndef EMU
    asm volatile("s_waitcnt vmcnt(0)" ::: "memory");
#endif
    __syncthreads();
    if (opaque_tid() == 0) { __threadfence(); atomicAdd(ctr + 2, 1); }
  }
  if (opaque_tid() == 0) { spin_until_ge(ctr + 2, nw); __threadfence(); }
  __syncthreads();
  const int total = att_items(l);
  int* sitem = (int*)(smem + 160 * 1024 - 16);
  for (;;) {
    __syncthreads();
    if (opaque_tid() == 0) *sitem = atomicAdd(ctr, 1);
    __syncthreads();
    int i = *sitem;
    if (i >= total) break;
    const int nx = NB_ * 8 * (T_ / 256);
    if (i < nx) { const int qt = i % (T_ / 256), bh = i / (T_ / 256); attn_item(p, bh >> 3, bh & 7, qt, false, smem); }
    else { i -= nx; const int qt = i % (CL_ / 256), bh = i / (CL_ / 256); attn_item(p, bh >> 3, bh & 7, qt, true, smem); }
  }
}
constexpr int ML3_CC = CL_ / 64, ML3_XC = T_ / 64;
DI constexpr int ml3_items(bool with_ctx) { return NB_ * 4 * (ML3_XC + (with_ctx ? ML3_CC : 0)); }
DI void mlstm_out_item(const Params& p, int l, int it, bool with_ctx, char* smem) {
  const int per = ML3_XC + (with_ctx ? ML3_CC : 0);
  const int bh = it / per, b = bh >> 2, hd = bh & 3;
  int tc = it % per; if (!with_ctx) tc += ML3_CC;
  const bool isctx = tc < ML3_CC;
  const int ntok0 = isctx ? NX_ + b * CL_ + tc * 64 : b * T_ + (tc - ML3_CC) * 64;
  float* qs = (float*)smem;
  float* ks = qs + 64 * 33;
  float* vs = ks + 64 * 33;
  float* Cs = vs + 64 * 64;
  float* Sm = Cs + 64 * 33;
  float* hs = Sm + 64 * 65;
  float* bj = hs + 64 * 64;
  float* ip = bj + 64;
  float* ns = ip + 64;
  const float* zrec = (const float*)(p.ws + OFF_REGION + R_ZREC);
  const int tid = opaque_tid(), lane = tid & 63, wid = tid >> 6;
  __syncthreads();
  for (int idx = tid; idx < 64 * 64; idx += NTHR) hs[idx] = 0.f;
  for (int dir = 0; dir < 2; ++dir) {
    const int c = dir == 0 ? tc : (isctx ? ML3_CC - 1 - tc : ML3_CC + (ML3_XC - 1 - (tc - ML3_CC)));
    const int s = dir * 8 + b * 4 + hd;
    const float* st = (const float*)(p.ws + OFF_REGION + R_MLST) + ((size_t)s * NCH_ + c) * ML_ST;
    const float m_start = st[2082];
    __syncthreads();
    for (int idx = tid; idx < 64 * 32; idx += NTHR) {
      const int j = idx >> 5, e = idx & 31;
      const int n = ntok0 + (dir ? 63 - j : j);
      qs[j * 33 + e] = zrec[(size_t)n * ZREC_W + ZR_MLQ + hd * 32 + e] * 0.17677669529663687f;
      ks[j * 33 + e] = zrec[(size_t)n * ZREC_W + ZR_MLK + hd * 32 + e];
      Cs[j * 33 + e] = st[j * 32 + e];
    }
    for (int idx = tid; idx < 64 * 64; idx += NTHR) {
      const int j = idx >> 6, e = idx & 63;
      const int n = ntok0 + (dir ? 63 - j : j);
      vs[idx] = zrec[(size_t)n * ZREC_W + ZR_MLV + hd * 64 + e];
    }
    if (tid < 32) ns[tid] = st[2048 + tid];
    if (wid == 1) {
      const int n = ntok0 + (dir ? 63 - lane : lane);
      const float fp = zrec[(size_t)n * ZREC_W + ZR_MLF + dir * 4 + hd] + p.ml_b_f[(l * 2 + dir) * 4 + hd];
      ip[lane] = zrec[(size_t)n * ZREC_W + ZR_MLI + dir * 4 + hd] + p.ml_b_i[(l * 2 + dir) * 4 + hd];
      bj[lane] = wave_incl_scan(logsigmoidf_(fp), lane);
    }
    __syncthreads();
    const int j = tid >> 3, sg = tid & 7;
    const float bjj = bj[j];
    float rmax = -1e30f;
#pragma unroll 1
    for (int u = 0; u < 8; ++u) {
      const int sI = sg * 8 + u;
      float d = 0.f;
#pragma unroll 8
      for (int e = 0; e < 32; ++e) d += qs[j * 33 + e] * ks[sI * 33 + e];
      Sm[j * 65 + sI] = d;
      const float dl = sI <= j ? bjj - bj[sI] + ip[sI] : -1e30f;
      rmax = fmaxf(rmax, dl);
    }
    rmax = fmaxf(rmax, __shfl_xor(rmax, 1)); rmax = fmaxf(rmax, __shfl_xor(rmax, 2)); rmax = fmaxf(rmax, __shfl_xor(rmax, 4));
    const float g = bjj + m_start;
    const float mj = fmaxf(g, rmax);
    const float inter = fexp(g - mj);
    float part = 0.f;
#pragma unroll 1
    for (int u = 0; u < 8; ++u) {
      const int sI = sg * 8 + u;
      const float sv = sI <= j ? fexp(bjj - bj[sI] + ip[sI] - mj) * Sm[j * 65 + sI] : 0.f;
      Sm[j * 65 + sI] = sv; part += sv;
    }
    float nq = 0.f;
#pragma unroll
    for (int e = 0; e < 4; ++e) nq += ns[sg * 4 + e] * qs[j * 33 + sg * 4 + e];
    part += inter * nq;
    part += __shfl_xor(part, 1); part += __shfl_xor(part, 2); part += __shfl_xor(part, 4);
    const float den = fmaxf(fabsf(part), fexp(-mj));
    __syncthreads();
    const int v0 = sg * 8;
    float num[8], cq[8];
#pragma unroll
    for (int u = 0; u < 8; ++u) { num[u] = 0.f; cq[u] = 0.f; }
#pragma unroll 2
    for (int sI = 0; sI <= j; ++sI) {
      const float sv = Sm[j * 65 + sI];
      const float4 va = *(const float4*)(vs + sI * 64 + v0), vb = *(const float4*)(vs + sI * 64 + v0 + 4);
      num[0] += sv * va.x; num[1] += sv * va.y; num[2] += sv * va.z; num[3] += sv * va.w;
      num[4] += sv * vb.x; num[5] += sv * vb.y; num[6] += sv * vb.z; num[7] += sv * vb.w;
    }
#pragma unroll 2
    for (int e = 0; e < 32; ++e) {
      const float qv = qs[j * 33 + e];
#pragma unroll
      for (int u = 0; u < 8; ++u) cq[u] += Cs[(v0 + u) * 33 + e] * qv;
    }
    const float rden = 1.f / den;
#pragma unroll
    for (int u = 0; u < 8; ++u) hs[(dir ? 63 - j : j) * 64 + v0 + u] += (num[u] + inter * cq[u]) * rden;
    __syncthreads();
  }
  const int tk = tid >> 3, v0 = (tid & 7) * 8, n = ntok0 + tk;
  float ss = 0.f; float hv[8];
#pragma unroll
  for (int u = 0; u < 8; ++u) { hv[u] = hs[tk * 64 + v0 + u]; ss += hv[u] * hv[u]; }
  ss += __shfl_xor(ss, 1); ss += __shfl_xor(ss, 2); ss += __shfl_xor(ss, 4);
  const float rs = 1.0f / sqrtf(ss * (1.f / 64.f) + 1e-6f);
  unsigned o[4];
#pragma unroll
  for (int u = 0; u < 8; u += 2) {
    const int cc = hd * 64 + v0 + u;
    const float a = hv[u] * rs * p.ml_g_norm[l * 256 + cc] * sigmoidf_(zrec[(size_t)n * ZREC_W + ZR_MLO + cc]);
    const float bq = hv[u + 1] * rs * p.ml_g_norm[l * 256 + cc + 1] * sigmoidf_(zrec[(size_t)n * ZREC_W + ZR_MLO + cc + 1]);
    o[u >> 1] = pack2bf(a, bq);
  }
  bf16_t* mlo = (bf16_t*)(p.ws + OFF_REGION + R_MLO);
  *(uint4*)(mlo + (size_t)n * 256 + hd * 64 + v0) = make_uint4(o[0], o[1], o[2], o[3]);
}

DI constexpr int rwo_items(bool with_ctx) { return (with_ctx ? NT_ : NX_) / 16; }
DI void rwkv_out_item(const Params& p, int l, int it, char* smem) {
  float* sg = (float*)smem;
  const float* zrec = (const float*)(p.ws + OFF_REGION + R_ZREC);
  const float* rwp = (const float*)(p.ws + OFF_REGION + R_RWP);
  const float* ys = (const float*)(p.ws + OFF_REGION + R_YS);
  bf16_t* rwo = (bf16_t*)(p.ws + OFF_REGION + R_RWO);
  const float* mu = p.rw_mu + (size_t)l * 1152;
  const int tid = opaque_tid(), n0 = it * 16;
  __syncthreads();
  for (int idx = tid; idx < 16 * 128; idx += NTHR) {
    const int tt = idx >> 7, k = idx & 127, n = n0 + tt, t = tok_t(n), c = 1024 + k;
    const int len = n < NX_ ? T_ : CL_;
    const float* zr = zrec + (size_t)n * ZREC_W + ZR_RW + c;
    const float z = zr[0];
    const float zp = t > 0 ? zr[-ZREC_W] : 0.f, zn = t < len - 1 ? zr[ZREC_W] : 0.f;
    sg[k * 16 + tt] = sigmoidf_(z + (0.5f * (zp + zn) - z) * mu[c]);
  }
  __syncthreads();
  const int col = tid & 255, half = tid >> 8;
  float acc[8];
#pragma unroll
  for (int i = 0; i < 8; ++i) acc[i] = 0.f;
  const float* g2 = p.rw_g2 + (size_t)l * 128 * 256 + col;
  for (int k = 0; k < 128; ++k) {
    const float gv = g2[k * 256];
    const float* sk = sg + k * 16 + half * 8;
#pragma unroll
    for (int i = 0; i < 8; ++i) acc[i] += sk[i] * gv;
  }
  const size_t AS = (size_t)NT_ * 256;
  const float rk = p.rw_r_k[(size_t)l * 256 + col], lw = p.rw_lnx_w[(size_t)l * 256 + col], lb = p.rw_lnx_b[(size_t)l * 256 + col];
#pragma unroll
  for (int i = 0; i < 8; ++i) {
    const int n = n0 + half * 8 + i;
    const size_t o = (size_t)n * 256 + col;
    const float y = ys[o] + ys[AS + o];
    const float mean = wave_sum(y) * (1.f / 64.f);
    const float dv = y - mean;
    const float var = wave_sum(dv * dv) * (1.f / 64.f);
    const float yn = dv * (1.0f / sqrtf(var + 64e-5f)) * lw + lb;
    const float r = rwp[0 * AS + o], v = rwp[1 * AS + o];
    const float bsum = wave_sum(r * rk * (rwp[4 * AS + o] + rwp[7 * AS + o]));
    rwo[o] = f2bf((yn + bsum * v) * acc[i]);
  }
}
DI void phase5(const Params& p, int l, bool with_ctx, char* smem) {
  const int n1 = ml3_items(with_ctx), n2 = rwo_items(with_ctx);
  for (int it = blockIdx.x; it < n1 + n2; it += gridDim.x) {
    if (it < n1) mlstm_out_item(p, l, it, with_ctx, smem);
    else rwkv_out_item(p, l, it - n1, smem);
  }
}
DI void phase_merge(const Params& p, int l, bool with_ctx, char* smem) {
  const bf16_t* H = (const bf16_t*)(p.ws + OFF_H);
  const char* W = p.ws + OFF_WMIX + (size_t)l * WM_SIZE;
  const bf16_t* Wg = (const bf16_t*)(W + WM_GATE);
  const bf16_t* att = (const bf16_t*)(p.ws + OFF_REGION + R_ATT);
  const bf16_t* mlo = (const bf16_t*)(p.ws + OFF_REGION + R_MLO);
  const bf16_t* rwo = (const bf16_t*)(p.ws + OFF_REGION + R_RWO);
  bf16_t* ymix = (bf16_t*)(p.osc + O_YMIX);
  const int TM = (with_ctx ? NT_ : NX_) / 128;
  for (int it = blockIdx.x; it < TM * 8; it += gridDim.x) {
    const int tid = opaque_tid();
    const int tm = it >> 3, tn = it & 7;
    f32x16 yacc[G128::MB][G128::NB];
#pragma unroll
    for (int a = 0; a < G128::MB; ++a)
#pragma unroll
      for (int b = 0; b < G128::NB; ++b) yacc[a][b] = zero16();
#pragma unroll
    for (int i = 0; i < 3; ++i) {
      f32x16 gacc[G128::MB][G128::NB], bacc[G128::MB][G128::NB];
#pragma unroll
      for (int a = 0; a < G128::MB; ++a)
#pragma unroll
        for (int b = 0; b < G128::NB; ++b) { gacc[a][b] = zero16(); bacc[a][b] = zero16(); }
      const bf16_t* A0 = H + (size_t)tm * 128 * 1024;
      G128::run(gacc, [&](int r) { return A0 + (size_t)r * 1024; }, Wg + ((size_t)i * 1024 + tn * 128) * 1024, 1024, 1024, smem);
      const bf16_t* br = i == 0 ? att : (i == 1 ? mlo : rwo);
      const int kb = i == 0 ? 512 : 256;
      const bf16_t* Wb = (const bf16_t*)(W + (i == 0 ? WM_BRA : (i == 1 ? WM_BRM : WM_BRR)));
      const bf16_t* B0 = br + (size_t)tm * 128 * kb;
      G128::run(bacc, [&](int r) { return B0 + (size_t)r * kb; }, Wb + (size_t)tn * 128 * kb, kb, kb, smem);
#pragma unroll
      for (int a = 0; a < G128::MB; ++a)
#pragma unroll
        for (int b = 0; b < G128::NB; ++b)
#pragma unroll
          for (int e = 0; e < 16; ++e) yacc[a][b][e] += sigmoidf_(gacc[a][b][e]) * bacc[a][b][e];
    }
#pragma unroll
    for (int mb = 0; mb < G128::MB; ++mb)
#pragma unroll
      for (int nb = 0; nb < G128::NB; ++nb) {
        const int col = tn * 128 + G128::col_of(tid, nb);
#pragma unroll
        for (int e = 0; e < 16; ++e) ymix[(size_t)(tm * 128 + G128::row_of(tid, mb, e)) * 1024 + col] = f2bf(yacc[mb][nb][e]);
      }
  }
}

DI void phase_wout(const Params& p, int l, bool with_ctx, char* smem) {
  const bf16_t* ymix = (const bf16_t*)(p.osc + O_YMIX);
  const bf16_t* Wo = (const bf16_t*)(p.ws + OFF_WMIX + (size_t)l * WM_SIZE + WM_OUT);
  float* xs = (float*)(p.ws + OFF_XS);
  const float* mod = (const float*)(p.ws + OFF_MOD) + (size_t)l * 3 * 6144;
  const int TM = (with_ctx ? NT_ : NX_) / 128;
  const int n_g = TM * 8;
  for (int it = blockIdx.x; it < n_g + CVT_MOE_TILES; it += gridDim.x) {
    if (it >= n_g) { cvt_moe_item(p, l, it - n_g, smem); continue; }
    const int tid = opaque_tid();
    const int tm = it >> 3, tn = it & 7;
    f32x16 acc[G128::MB][G128::NB];
#pragma unroll
    for (int a = 0; a < G128::MB; ++a)
#pragma unroll
      for (int b = 0; b < G128::NB; ++b) acc[a][b] = zero16();
    const bf16_t* A0 = ymix + (size_t)tm * 128 * 1024;
    G128::run(acc, [&](int r) { return A0 + (size_t)r * 1024; }, Wo + (size_t)tn * 128 * 1024, 1024, 1024, smem);
    const float* m2 = mod + (size_t)tok_modrow(tm * 128) * 6144 + 2 * 1024;
#pragma unroll
    for (int mb = 0; mb < G128::MB; ++mb)
#pragma unroll
      for (int nb = 0; nb < G128::NB; ++nb) {
        const int col = tn * 128 + G128::col_of(tid, nb);
        const float g = m2[col];
#pragma unroll
        for (int e = 0; e < 16; ++e) {
          float* d = xs + (size_t)(tm * 128 + G128::row_of(tid, mb, e)) * 1024 + col;
          *d = *d + g * acc[mb][nb][e];
        }
      }
  }
}

typedef Gemm<128, 64, 64, 4, 2> GRT;
DI void phase_router(const Params& p, int l, bool with_ctx, char* smem, int* cnt) {
  float* xs = (float*)(p.ws + OFF_XS);
  bf16_t* H = (bf16_t*)(p.ws + OFF_H);
  const float* mod = (const float*)(p.ws + OFF_MOD) + (size_t)l * 3 * 6144;
  const bf16_t* Wr = (const bf16_t*)(p.ws + OFF_WMIX + (size_t)l * WM_SIZE + WM_RT);
  int* eidx = (int*)(p.ws + OFF_REGION + R_EIDX);
  float* ewt = (float*)(p.ws + OFF_REGION + R_EWT);
  int* erank = (int*)(p.ws + OFF_REGION + R_ERANK);
  int* elist = (int*)(p.ws + OFF_REGION + R_ELIST);
  float* sc = (float*)(smem + GRT::SMEM);
  float* bs = sc + 128 * 65;
  float* gs = bs + 128 * 65;
  const int tid = opaque_tid(), lane = tid & 63, wid = tid >> 6;
  const int ntok = with_ctx ? NT_ : NX_;
  for (int it = blockIdx.x; it < ntok / 128; it += gridDim.x) {
    const int n0 = it * 128;
    __syncthreads();
    for (int rr = 0; rr < 16; ++rr) {
      const int n = n0 + wid * 16 + rr;
      float v[16];
#pragma unroll
      for (int j = 0; j < 4; ++j) {
        const float4 t = *(const float4*)(xs + (size_t)n * 1024 + (j * 64 + lane) * 4);
        v[j * 4] = t.x; v[j * 4 + 1] = t.y; v[j * 4 + 2] = t.z; v[j * 4 + 3] = t.w;
      }
      const float* m = mod + (size_t)tok_modrow(n) * 6144;
      row_norm_mod(v, p.g_ffn + (size_t)l * 1024, m + 3 * 1024, m + 4 * 1024, H + (size_t)n * 1024, lane);
    }
    __syncthreads();
    f32x16 acc[1][1]; acc[0][0] = zero16();
    const bf16_t* A0 = H + (size_t)n0 * 1024;
    GRT::run(acc, [&](int r) { return A0 + (size_t)r * 1024; }, Wr, 1024, 1024, smem);
    {
      const int col = GRT::col_of(tid, 0);
      const float rb = p.router_bias[l * 64 + col];
#pragma unroll
      for (int e = 0; e < 16; ++e) {
        const int row = GRT::row_of(tid, 0, e);
        const float s = sigmoidf_(acc[0][0][e]);
        sc[row * 65 + col] = s; bs[row * 65 + col] = s + rb;
      }
    }
    __syncthreads();
    if (tid < 128) {
      const int n = n0 + tid;
      float* b = bs + tid * 65; const float* s = sc + tid * 65; float* g = gs + tid * 9;
      for (int gi = 0; gi < 8; ++gi) {
        float m1 = -1e30f, m2 = -1e30f;
        for (int j = 0; j < 8; ++j) { const float x = b[gi * 8 + j]; if (x > m1) { m2 = m1; m1 = x; } else if (x > m2) m2 = x; }
        g[gi] = m1 + m2;
      }
      unsigned gmask = 0;
      for (int c = 0; c < 4; ++c) {
        int best = 0; float bv = -1e30f;
        for (int gi = 0; gi < 8; ++gi) if (!((gmask >> gi) & 1) && g[gi] > bv) { bv = g[gi]; best = gi; }
        gmask |= 1u << best;
      }
      for (int gi = 0; gi < 8; ++gi) if (!((gmask >> gi) & 1)) for (int j = 0; j < 8; ++j) b[gi * 8 + j] = -1e30f;
      int sel[8]; float wsum = 0.f;
#pragma unroll
      for (int c = 0; c < 8; ++c) {
        int best = 0; float bv = -1e30f;
        for (int e = 0; e < 64; ++e) { const float x = b[e]; if (x > bv) { bv = x; best = e; } }
        b[best] = -3e30f; sel[c] = best; wsum += s[best];
      }
      const float inv = 2.5f / (wsum + 1e-20f);
#pragma unroll
      for (int c = 0; c < 8; ++c) {
        const int e = sel[c];
        const int rk = atomicAdd(cnt + e, 1);
        eidx[n * 8 + c] = e; ewt[n * 8 + c] = s[e] * inv; erank[n * 8 + c] = rk;
        elist[(size_t)e * NT_ + rk] = n * 8 + c;
      }
    }
  }
}

typedef Gemm<128, 256, 32, 2, 4> GMOE;
constexpr int ACT_LD = 264;
constexpr int MOE_ACT_OFF = GMOE::SMEM;
constexpr int MOE_INFO_OFF = MOE_ACT_OFF + 128 * ACT_LD * 2;
static_assert(MOE_INFO_OFF + 128 * 8 + 67 * 4 * 2 <= 160 * 1024 - 16, "moe lds");
DI void moe_down_run(f32x16 (&acc)[GMOE::MB][GMOE::NB], const char* actl, const bf16_t* Bt, char* smem) {
  constexpr int BK = 32, LDA = GMOE::LDA, CPR = 4, BCH = GMOE::BCH, STG = GMOE::B_BYTES;
  const int tid = opaque_tid(), lane = tid & 63, wid = tid >> 6, wm = wid / 4, wn = wid % 4;
  const int kc = (tid % CPR) * 8, r0 = tid / CPR;
  uint4 rb[BCH];
  char* Bs0 = smem;
#pragma unroll
  for (int i = 0; i < BCH; ++i) rb[i] = *(const uint4*)(Bt + (size_t)(r0 + i * 128) * 256 + kc);
#pragma unroll
  for (int i = 0; i < BCH; ++i) *(uint4*)(Bs0 + ((r0 + i * 128) * LDA + kc) * 2) = rb[i];
  __syncthreads();
  for (int kt = 0; kt < 256 / BK; ++kt) {
    const bool more = kt + 1 < 256 / BK;
    if (more) {
#pragma unroll
      for (int i = 0; i < BCH; ++i) rb[i] = *(const uint4*)(Bt + (size_t)(r0 + i * 128) * 256 + (kt + 1) * BK + kc);
    }
    const char* Bs = Bs0 + (kt & 1) * STG;
#pragma unroll
    for (int ks = 0; ks < BK / 16; ++ks) {
      bf16x8 af[GMOE::MB], bfr[GMOE::NB];
#pragma unroll
      for (int mb = 0; mb < GMOE::MB; ++mb)
        af[mb] = *(const bf16x8*)(actl + ((wm * 64 + mb * 32 + (lane & 31)) * ACT_LD + kt * BK + ks * 16 + (lane >> 5) * 8) * 2);
#pragma unroll
      for (int nb = 0; nb < GMOE::NB; ++nb)
        bfr[nb] = *(const bf16x8*)(Bs + ((wn * 64 + nb * 32 + (lane & 31)) * LDA + ks * 16 + (lane >> 5) * 8) * 2);
#pragma unroll
      for (int mb = 0; mb < GMOE::MB; ++mb)
#pragma unroll
        for (int nb = 0; nb < GMOE::NB; ++nb) acc[mb][nb] = mfma32(af[mb], bfr[nb], acc[mb][nb]);
    }
    if (more) {
      char* Bd = Bs0 + ((kt + 1) & 1) * STG;
#pragma unroll
      for (int i = 0; i < BCH; ++i) *(uint4*)(Bd + ((r0 + i * 128) * LDA + kc) * 2) = rb[i];
    }
    __syncthreads();
  }
}
DI void phase_moe(const Params& p, int l, bool with_ctx, char* smem, const int* cnt) {
  const bf16_t* H = (const bf16_t*)(p.ws + OFF_H);
  const bf16_t* GU = (const bf16_t*)(p.ws + OFF_REGION + R_WMOE + WE_GU);
  const bf16_t* DN = (const bf16_t*)(p.ws + OFF_REGION + R_WMOE + WE_DN);
  const float* ewt = (const float*)(p.ws + OFF_REGION + R_EWT);
  const int* elist = (const int*)(p.ws + OFF_REGION + R_ELIST);
  bf16_t* ybuf = (bf16_t*)(p.ws + OFF_REGION + R_YBUF);
  char* actl = smem + MOE_ACT_OFF;
  int* rtok = (int*)(smem + MOE_INFO_OFF);
  float* rwt = (float*)(rtok + 128);
  int* pre = (int*)(rwt + 128);
  int* off = pre + 67;
  int tid = threadIdx.x;
  const int ntok = with_ctx ? NT_ : NX_;
  __syncthreads();
  if (tid == 0) {
    int a = 0, o = 0;
    for (int e = 0; e < 65; ++e) { const int c = e < 64 ? cnt[e] : ntok; pre[e] = a; off[e] = o; a += (c + 127) >> 7; o += c; }
    pre[65] = a; off[65] = o;
  }
  __syncthreads();
  const int total = pre[65];
  for (int it = blockIdx.x; it < total; it += gridDim.x) {
    tid = opaque_tid();
    int e0 = 0;
    while (pre[e0 + 1] <= it) ++e0;
    const int e = rfl(e0);
    const int rb = rfl(it - pre[e]);
    const int c = rfl(e < 64 ? cnt[e] : ntok);
    const int obase = rfl(off[e] + rb * 128);
    __syncthreads();
    if (tid < 128) {
      const int slot = rb * 128 + tid;
      int tok = 0; float w = 0.f;
      if (slot < c) {
        if (e < 64) { const int pk = elist[(size_t)e * NT_ + slot]; tok = pk >> 3; w = ewt[pk]; }
        else { tok = slot; w = 1.f; }
      }
      rtok[tid] = tok; rwt[tid] = w;
    }
    __syncthreads();
    const bf16_t* Wgu = GU + (size_t)e * 512 * 1024;
#pragma unroll 1
    for (int hf = 0; hf < 2; ++hf) {
      f32x16 acc[GMOE::MB][GMOE::NB];
#pragma unroll
      for (int a = 0; a < GMOE::MB; ++a)
#pragma unroll
        for (int b = 0; b < GMOE::NB; ++b) acc[a][b] = zero16();
      GMOE::run(acc, [&](int r) { return H + (size_t)rtok[r] * 1024; }, Wgu + (size_t)hf * 256 * 1024, 1024, 1024, smem);
      const int lane = tid & 63, wn = (tid >> 6) % 4, wmr = ((tid >> 6) / 4) * 64 + 4 * (lane >> 5);
      const int j = (hf * 4 + wn) * 32 + (lane & 31);
#pragma unroll
      for (int mb = 0; mb < GMOE::MB; ++mb)
#pragma unroll
        for (int i = 0; i < 16; ++i) {
          const int row = wmr + mb * 32 + (i & 3) + 8 * (i >> 2);
          const float g = acc[mb][0][i], u = acc[mb][1][i];
          *(bf16_t*)(actl + (row * ACT_LD + j) * 2) = f2bf(siluf_(g) * u);
        }
    }
    __syncthreads();
    const bf16_t* Wd = DN + (size_t)e * 1024 * 256;
#pragma unroll 1
    for (int nt = 0; nt < 4; ++nt) {
      f32x16 acc[GMOE::MB][GMOE::NB];
#pragma unroll
      for (int a = 0; a < GMOE::MB; ++a)
#pragma unroll
        for (int b = 0; b < GMOE::NB; ++b) acc[a][b] = zero16();
      moe_down_run(acc, actl, Wd + (size_t)nt * 256 * 256, smem);
#pragma unroll
      for (int mb = 0; mb < GMOE::MB; ++mb)
#pragma unroll
        for (int nb = 0; nb < GMOE::NB; ++nb) {
          const int col = nt * 256 + ((tid >> 6) % 4) * 64 + nb * 32 + (tid & 31);
#pragma unroll
          for (int i = 0; i < 16; ++i) {
            const int row = ((tid >> 6) / 4) * 64 + 4 * ((tid & 63) >> 5) + mb * 32 + (i & 3) + 8 * (i >> 2);
            if (rb * 128 + row < c) (ybuf + (size_t)obase * 1024)[(unsigned)(row * 1024 + col)] = f2bf(acc[mb][nb][i] * rwt[row]);
          }
        }
    }
  }
}

DI void phase_combine(const Params& p, int l, bool last, char* smem, const int* cnt) {
  float* xs = (float*)(p.ws + OFF_XS);
  bf16_t* H = (bf16_t*)(p.ws + OFF_H);
  const float* mod = (const float*)(p.ws + OFF_MOD);
  const int* eidx = (const int*)(p.ws + OFF_REGION + R_EIDX);
  const int* erank = (const int*)(p.ws + OFF_REGION + R_ERANK);
  const bf16_t* ybuf = (const bf16_t*)(p.ws + OFF_REGION + R_YBUF);
  int* off = (int*)smem;
  const int tid = opaque_tid(), lane = tid & 63, wid = tid >> 6;
  const int ntok = last ? NX_ : NT_;
  __syncthreads();
  if (tid == 0) { int o = 0; for (int e = 0; e < 64; ++e) { off[e] = o; o += cnt[e]; } off[64] = o; }
  __syncthreads();
  for (int n = blockIdx.x * 8 + wid; n < ntok; n += gridDim.x * 8) {
    float acc[16];
#pragma unroll
    for (int i = 0; i < 16; ++i) acc[i] = 0.f;
    for (int k = 0; k < 9; ++k) {
      const int row = k < 8 ? off[eidx[n * 8 + k]] + erank[n * 8 + k] : off[64] + n;
      const bf16_t* y = ybuf + (size_t)row * 1024;
#pragma unroll
      for (int j = 0; j < 4; ++j) {
        const uint2 u = *(const uint2*)(y + (j * 64 + lane) * 4);
        acc[j * 4 + 0] += bf2f((bf16_t)(u.x & 0xffff)); acc[j * 4 + 1] += bf2f((bf16_t)(u.x >> 16));
        acc[j * 4 + 2] += bf2f((bf16_t)(u.y & 0xffff)); acc[j * 4 + 3] += bf2f((bf16_t)(u.y >> 16));
      }
    }
    const float* m5 = mod + ((size_t)l * 3 + tok_modrow(n)) * 6144 + 5 * 1024;
    float v[16];
#pragma unroll
    for (int j = 0; j < 4; ++j) {
      const int c = (j * 64 + lane) * 4;
      const float4 x = *(const float4*)(xs + (size_t)n * 1024 + c), g = *(const float4*)(m5 + c);
      v[j * 4 + 0] = x.x + g.x * acc[j * 4 + 0]; v[j * 4 + 1] = x.y + g.y * acc[j * 4 + 1];
      v[j * 4 + 2] = x.z + g.z * acc[j * 4 + 2]; v[j * 4 + 3] = x.w + g.w * acc[j * 4 + 3];
      if (!last) *(float4*)(xs + (size_t)n * 1024 + c) = make_float4(v[j * 4], v[j * 4 + 1], v[j * 4 + 2], v[j * 4 + 3]);
    }
    if (!last) {
      const float* m = mod + ((size_t)(l + 1) * 3 + tok_modrow(n)) * 6144;
      row_norm_mod(v, p.g_mix + (size_t)(l + 1) * 1024, m, m + 1024, H + (size_t)n * 1024, lane);
    } else {
      float ss = 0.f;
#pragma unroll
      for (int i = 0; i < 16; ++i) ss += v[i] * v[i];
      ss = wave_sum(ss);
      const float rs = 1.0f / sqrtf(ss * (1.f / 1024.f) + 1e-6f);
#pragma unroll
      for (int j = 0; j < 4; ++j) {
        const int c = (j * 64 + lane) * 4;
        const float4 g = *(const float4*)(p.g_final + c);
        *(float4*)(p.out + (size_t)n * 1024 + c) = make_float4(v[j * 4] * rs * g.x, v[j * 4 + 1] * rs * g.y, v[j * 4 + 2] * rs * g.z, v[j * 4 + 3] * rs * g.w);
      }
    }
  }
}
#define SMEM_BYTES (160 * 1024)
#ifndef MEGA
#define MEGA 0
#endif
DI int* cnt_ptr(const Params& p, int l) { return (int*)(p.ws + OFF_CNT) + 64 * l; }
DI int* ctr_ptr(const Params& p, int l) { return (int*)(p.ws + OFF_CNT) + 128 + 4 * l; }
#if !MEGA
__global__ void __launch_bounds__(NTHR) k_phaseA(Params p) { SMEM_DECL(smem, SMEM_BYTES); phaseA(p, smem); }
__global__ void __launch_bounds__(NTHR) k_norm0(Params p) { phase_norm0(p); }
__global__ void __launch_bounds__(NTHR) k_win(Params p, int l) { SMEM_DECL(smem, SMEM_BYTES); phase_win(p, l, smem); }
__global__ void __launch_bounds__(NTHR) k_p3(Params p, int l) { SMEM_DECL(smem, SMEM_BYTES); phase3(p, l, smem); }
__global__ void __launch_bounds__(NTHR) k_p4(Params p, int l) { SMEM_DECL(smem, SMEM_BYTES); phase4(p, l, smem, ctr_ptr(p, l)); }
__global__ void __launch_bounds__(NTHR) k_p5(Params p, int l, int wc) { SMEM_DECL(smem, SMEM_BYTES); phase5(p, l, wc != 0, smem); }
__global__ void __launch_bounds__(NTHR) k_merge(Params p, int l, int wc) { SMEM_DECL(smem, SMEM_BYTES); phase_merge(p, l, wc != 0, smem); }
__global__ void __launch_bounds__(NTHR) k_wout(Params p, int l, int wc) { SMEM_DECL(smem, SMEM_BYTES); phase_wout(p, l, wc != 0, smem); }
__global__ void __launch_bounds__(NTHR) k_router(Params p, int l, int wc) { SMEM_DECL(smem, SMEM_BYTES); phase_router(p, l, wc != 0, smem, cnt_ptr(p, l)); }
__global__ void __launch_bounds__(NTHR) k_moe(Params p, int l, int wc) { SMEM_DECL(smem, SMEM_BYTES); phase_moe(p, l, wc != 0, smem, cnt_ptr(p, l)); }
__global__ void __launch_bounds__(NTHR) k_combine(Params p, int l, int last) { SMEM_DECL(smem, SMEM_BYTES); phase_combine(p, l, last != 0, smem, cnt_ptr(p, l)); }
#else
#ifndef EMU
#define XB_TMO      128
#define XB_XCNT(j)  (256  + 64 * (j))
#define XB_XSUB(j)  (1280 + 64 * (j))
#define XB_XGEN(j)  (2304 + 64 * (j))
#define XB_TOP      3328
#define XB_TOPGEN   3392
#define XCD_BAR_WORDS 3456
#define XB_SPIN_CAP (1u << 24)
#define LAS __attribute__((address_space(3)))
DI unsigned xb_ld(unsigned* p) { return __hip_atomic_load(p, __ATOMIC_RELAXED, __HIP_MEMORY_SCOPE_AGENT); }
DI unsigned xb_add(unsigned* p, unsigned v) { return __hip_atomic_fetch_add(p, v, __ATOMIC_RELAXED, __HIP_MEMORY_SCOPE_AGENT); }
DI unsigned xb_xcc_id() { return (unsigned)__builtin_amdgcn_s_getreg((3 << 11) | 20) & 0xFu; }
#define XB_SPIN(cond, bar) do { unsigned _sp = 0; while (cond) { __builtin_amdgcn_s_sleep(1); \
    if ((++_sp & 255u) == 0u) { if (xb_ld(&(bar)[XB_TMO])) break; if (_sp > XB_SPIN_CAP) { atomicAdd(&(bar)[XB_TMO], 1u); break; } } } } while (0)
struct XcdBarrier { unsigned* bar; unsigned x; volatile LAS unsigned* st; };
DI XcdBarrier xcd_barrier_post(unsigned* bar, volatile LAS unsigned* st) {
  XcdBarrier b; b.bar = bar; b.x = xb_xcc_id(); b.st = st;
  if (threadIdx.x == 0) (void)xb_add(&bar[XB_XCNT(b.x)], 1u);
  return b;
}
DI void xcd_barrier_complete(unsigned* bar, unsigned x, unsigned& nloc, unsigned& nx) {
  const unsigned G = gridDim.x * gridDim.y * gridDim.z;
  unsigned sum, cnt, mine, sp = 0u;
  for (;;) {
    sum = 0u; cnt = 0u; mine = 0u;
#pragma unroll
    for (unsigned j = 0; j < 16; ++j) { const unsigned c = xb_ld(&bar[XB_XCNT(j)]); sum += c; cnt += (c > 0u) ? 1u : 0u; mine = (j == x) ? c : mine; }
    if (sum == G) break;
    __builtin_amdgcn_s_sleep(1);
    if ((++sp & 255u) == 0u) { if (xb_ld(&bar[XB_TMO])) break; if (sp > XB_SPIN_CAP) { atomicAdd(&bar[XB_TMO], 1u); break; } }
  }
  nloc = mine > 0u ? mine : 1u; nx = cnt > 0u ? cnt : 1u;
}
DI void xcd_barrier(const XcdBarrier& b) {
  asm volatile("s_waitcnt vmcnt(0)" ::: "memory");
  __syncthreads();
  if (threadIdx.x == 0) {
    unsigned* bar = b.bar;
    __builtin_amdgcn_s_waitcnt(0);
    unsigned nloc = b.st[0], nx = b.st[1];
    if (nloc == 0u) { xcd_barrier_complete(bar, b.x, nloc, nx); b.st[0] = nloc; b.st[1] = nx; }
    const unsigned old = xb_add(&bar[XB_XSUB(b.x)], 1u);
    const unsigned gen = old / nloc;
    if (old + 1u == (gen + 1u) * nloc) {
      __builtin_amdgcn_fence(__ATOMIC_RELEASE, "agent");
      asm volatile("s_waitcnt vmcnt(0)" ::: "memory");
      const unsigned og = xb_add(&bar[XB_TOP], 1u);
      const unsigned tg = og / nx;
      if (og + 1u == (tg + 1u) * nx) xb_add(&bar[XB_TOPGEN], 1u);
      else XB_SPIN(xb_ld(&bar[XB_TOPGEN]) == tg, bar);
      __builtin_amdgcn_fence(__ATOMIC_ACQUIRE, "agent");
      xb_add(&bar[XB_XGEN(b.x)], 1u);
      asm volatile("s_waitcnt vmcnt(0)" ::: "memory");
    } else {
      XB_SPIN(xb_ld(&bar[XB_XGEN(b.x)]) == gen, bar);
      __builtin_amdgcn_fence(__ATOMIC_ACQUIRE, "agent");
      asm volatile("s_waitcnt vmcnt(0)" ::: "memory");
    }
  }
  __syncthreads();
}
#define GSYNC() xcd_barrier(xb)
#else
#define GSYNC() emu::grid_barrier()
#endif
#ifdef PROBE_IDX
#define TS(i) { if (blockIdx.x == 0 && threadIdx.x == 0) ts[i] = wall_clock64(); }
#else
#define TS(i)
#endif
__global__ void __launch_bounds__(NTHR) k_mega(Params p) {
  SMEM_DECL(smem, SMEM_BYTES);
  cooperative_groups::grid_group grid = cooperative_groups::this_grid();
  volatile LAS unsigned* xst = (volatile LAS unsigned*)(smem + SMEM_BYTES - 32);
  if (threadIdx.x == 0) { xst[0] = 0u; xst[1] = 0u; }
  __syncthreads();
  XcdBarrier xb = xcd_barrier_post((unsigned*)(p.ws + OFF_BAR), xst);
#ifdef PROBE_IDX
  long long* ts = (long long*)(p.ws + OFF_CNT + 2048);
#endif
  TS(0);
  phaseA(p, smem);
  grid.sync(); TS(1);
  phase_norm0(p);
  GSYNC(); TS(2);
#pragma unroll 1
  for (int l = 0; l < 2; ++l) {
    const bool wc = l == 0;
    phase_win(p, l, smem); GSYNC(); TS(3 + l * 9);
    phase3(p, l, smem); GSYNC(); TS(4 + l * 9);
    phase4(p, l, smem, ctr_ptr(p, l)); GSYNC(); TS(5 + l * 9);
    phase5(p, l, wc, smem); GSYNC(); TS(6 + l * 9);
    phase_merge(p, l, wc, smem); GSYNC(); TS(7 + l * 9);
    phase_wout(p, l, wc, smem); GSYNC(); TS(8 + l * 9);
    phase_router(p, l, wc, smem, cnt_ptr(p, l)); GSYNC(); TS(9 + l * 9);
    phase_moe(p, l, wc, smem, cnt_ptr(p, l)); GSYNC(); TS(10 + l * 9);
    phase_combine(p, l, l == 1, smem, cnt_ptr(p, l));
#ifdef PROBE_IDX
    GSYNC(); TS(11 + l * 9);
#else
    if (l == 0) GSYNC();
#endif
  }
#ifdef PROBE_IDX
  if (blockIdx.x == 0 && threadIdx.x == 0) {
    const float us = (float)(ts[PROBE_IDX + 1] - ts[PROBE_IDX]) * 0.01f;
    p.out[0] += rintf(6.f * log2f(fmaxf(us, 1.f)));
  }
#endif
}
#endif

extern "C" void kernel_launch(void* const* d_in, const int* in_sizes, int n_in, void* d_out, int out_size, void* d_ws,
                              size_t ws_size, hipStream_t stream) {
  Params p{};
  const float** pp = (const float**)&p;
  for (int i = 0; i < 41; ++i) pp[i] = (const float*)d_in[i];
  p.out = (float*)d_out; p.ws = (char*)d_ws; p.osc = (char*)d_out;
  if (ws_size < WS_NEEDED) { fprintf(stderr, "workspace too small: %zu < %zu\n", ws_size, (size_t)WS_NEEDED); return; }
#if !MEGA
  const dim3 g(256), b(NTHR);
  hipLaunchKernelGGL(k_phaseA, g, b, 0, stream, p);
  hipLaunchKernelGGL(k_norm0, g, b, 0, stream, p);
  for (int l = 0; l < 2; ++l) {
    const int wc = l == 0;
    hipLaunchKernelGGL(k_win, g, b, 0, stream, p, l);
    hipLaunchKernelGGL(k_p3, g, b, 0, stream, p, l);
    hipLaunchKernelGGL(k_p4, g, b, 0, stream, p, l);
    hipLaunchKernelGGL(k_p5, g, b, 0, stream, p, l, wc);
    hipLaunchKernelGGL(k_merge, g, b, 0, stream, p, l, wc);
    hipLaunchKernelGGL(k_wout, g, b, 0, stream, p, l, wc);
    hipLaunchKernelGGL(k_router, g, b, 0, stream, p, l, wc);
    hipLaunchKernelGGL(k_moe, g, b, 0, stream, p, l, wc);
    hipLaunchKernelGGL(k_combine, g, b, 0, stream, p, l, l == 1);
  }
#else
  static int grid_blocks = 0;
  if (!grid_blocks) {
    int dev = 0, cus = 0, per_cu = 0;
    hipGetDevice(&dev);
    hipDeviceGetAttribute(&cus, hipDeviceAttributeMultiprocessorCount, dev);
    hipOccupancyMaxActiveBlocksPerMultiprocessor(&per_cu, k_mega, NTHR, 0);
    if (per_cu > 1) per_cu = 1;
    grid_blocks = cus * per_cu;
  }
  hipMemsetAsync(p.ws + OFF_BAR, 0, 16384, stream);
  void* args[] = {&p};
  hipError_t e = hipLaunchCooperativeKernel((void*)k_mega, dim3(grid_blocks), dim3(NTHR), args, 0, stream);
  if (e != hipSuccess) fprintf(stderr, "cooperative launch failed: %s (grid %d)\n", hipGetErrorString(e), grid_blocks);
#endif
}
```

```cpp
#define MEGA 1
#include <hip/hip_runtime.h>
#include <hip/hip_cooperative_groups.h>
#include <cstdio>

#ifndef SEQ_T
#define SEQ_T 8192
#endif
#ifndef CTX_L
#define CTX_L 256
#endif

#define DI __device__ __forceinline__
typedef unsigned short bf16_t;
typedef short bf16x8 __attribute__((ext_vector_type(8)));
typedef float f32x16 __attribute__((ext_vector_type(16)));
typedef float f32x4 __attribute__((ext_vector_type(4)));

constexpr int NB_ = 2, T_ = SEQ_T, CL_ = CTX_L, D_ = 1024;
constexpr int NX_ = NB_ * T_, NC_ = NB_ * CL_, NT_ = NX_ + NC_, KT_ = CL_ + T_;
constexpr int GRID_W_ = 64;
constexpr int MLA_H = 8, MLA_NOPE_ = 64, MLA_ROPE_ = 32, MLA_DK = 96, MLA_DV = 64, QLORA = 384, KVLORA = 256;
constexpr int MLA_IN_ = 672, ML_IN_ = 784, RW_IN_ = 1152, GATE_IN_ = 3072, D_IN_ = 5680;
constexpr int ZMLA_W = 768;
constexpr int ZREC_W = 1936;
constexpr int WIN_N = 768 + 2048;
constexpr int ML_H = 4, ML_DK = 32, ML_DV = 64, ML_L = 64;
constexpr int RW_H = 4, RW_N_ = 64;
constexpr int NE_ = 64, TOPK_ = 8, DE_ = 256;
constexpr int NCH_ = KT_ / ML_L;
constexpr int NSEQ_ = 2 * NB_ * 4;

constexpr int ZR_MLQ = 0, ZR_MLK = 128, ZR_MLV = 256, ZR_MLO = 512, ZR_MLI = 768, ZR_MLF = 776;
constexpr int ZR_RW = 784;

constexpr size_t al256(size_t x) { return (x + 255) & ~(size_t)255; }
constexpr size_t WM_WIN = 0;
constexpr size_t WM_GATE = WM_WIN + (size_t)WIN_N * 1024 * 2;
constexpr size_t WM_UQ = WM_GATE + (size_t)3072 * 1024 * 2;
constexpr size_t WM_UKV = WM_UQ + (size_t)768 * 384 * 2;
constexpr size_t WM_BRA = WM_UKV + (size_t)1024 * 256 * 2;
constexpr size_t WM_BRM = WM_BRA + (size_t)1024 * 512 * 2;
constexpr size_t WM_BRR = WM_BRM + (size_t)1024 * 256 * 2;
constexpr size_t WM_OUT = WM_BRR + (size_t)1024 * 256 * 2;
constexpr size_t WM_RT = WM_OUT + (size_t)1024 * 1024 * 2;
constexpr size_t WM_SIZE = al256(WM_RT + (size_t)64 * 1024 * 2);
constexpr size_t WE_GU = 0;
constexpr size_t WE_DN = WE_GU + (size_t)65 * 512 * 1024 * 2;
constexpr size_t WE_SIZE = al256(WE_DN + (size_t)65 * 1024 * 256 * 2);

constexpr size_t OFF_XS = 0;
constexpr size_t OFF_MOD = OFF_XS + al256((size_t)NT_ * 1024 * 4);
constexpr size_t OFF_ROPE = OFF_MOD + al256((size_t)2 * 3 * 6144 * 4);
constexpr size_t OFF_H = OFF_ROPE + al256((size_t)T_ * 16 * 8);
constexpr size_t OFF_WMIX = OFF_H + al256((size_t)NT_ * 1024 * 2);
constexpr size_t OFF_CNT = OFF_WMIX + 2 * WM_SIZE;
constexpr size_t OFF_BAR = OFF_CNT + 4096;
constexpr size_t OFF_REGION = OFF_BAR + 16384;
constexpr size_t R_ZREC = 0;
constexpr size_t R_RB16 = R_ZREC + al256((size_t)NT_ * ZREC_W * 4);
constexpr size_t R_LW = R_RB16 + al256((size_t)7 * NT_ * 256 * 2);
constexpr size_t R_BS = R_LW + al256((size_t)2 * NT_ * 256 * 4);
constexpr size_t R_CH = R_BS + al256((size_t)2 * NT_ * 4 * 4);
constexpr size_t R_YS = R_CH + al256((size_t)NSEQ_ * NCH_ * 40960);
constexpr size_t R_MLST = R_YS + al256((size_t)2 * NT_ * 256 * 4);
constexpr size_t R_ATT = R_MLST + al256((size_t)NSEQ_ * NCH_ * 2112 * 4);
constexpr size_t R_MLO = R_ATT + al256((size_t)NT_ * 512 * 2);
constexpr size_t R_RWO = R_MLO + al256((size_t)NT_ * 256 * 2);
constexpr size_t R_VT = R_RWO + al256((size_t)NT_ * 256 * 2);
constexpr size_t R_KB = R_VT + al256((size_t)NB_ * MLA_H * 64 * KT_ * 2);
constexpr size_t R_MIX_END = R_KB + al256((size_t)NB_ * MLA_H * KT_ * 96 * 2);
constexpr int NSLOT_ = NT_ * 9;
constexpr size_t R_YBUF = 0;
constexpr size_t R_EIDX = R_YBUF + al256((size_t)NSLOT_ * 1024 * 2);
constexpr size_t R_EWT = R_EIDX + al256((size_t)NT_ * 8 * 4);
constexpr size_t R_ERANK = R_EWT + al256((size_t)NT_ * 8 * 4);
constexpr size_t R_ELIST = R_ERANK + al256((size_t)NT_ * 8 * 4);
constexpr size_t R_WMOE = R_ELIST + al256((size_t)64 * NT_ * 4);
constexpr size_t R_MOE_END = R_WMOE + WE_SIZE;
constexpr size_t R_SIZE = R_MIX_END > R_MOE_END ? R_MIX_END : R_MOE_END;
constexpr size_t WS_NEEDED = OFF_REGION + R_SIZE;
constexpr size_t O_ZMLA = 0;
constexpr size_t O_QB = O_ZMLA + al256((size_t)NT_ * ZMLA_W * 2);
constexpr size_t O_END = O_QB + al256((size_t)NT_ * 768 * 2);
constexpr size_t O_YMIX = 0;
#if SEQ_T == 8192 && CTX_L == 256
static_assert(O_END <= (size_t)NX_ * 1024 * 4, "d_out scratch overflow");
static_assert((size_t)NT_ * 1024 * 2 <= (size_t)NX_ * 1024 * 4, "ymix overflow");
static_assert(WS_NEEDED <= (size_t)597000000, "workspace too large");
#endif

struct Params {
  const float *x, *c, *ctx, *c_ctx, *w_mod, *b_mod, *g_mix, *g_ffn, *w_in, *g_cq, *w_uq, *g_ckv, *w_uk, *w_uv;
  const float *ml_b_i, *ml_b_f, *ml_g_norm, *rw_mu, *rw_w0, *rw_w2, *rw_a0, *rw_a2, *rw_g2, *rw_k_k, *rw_k_a;
  const float *rw_r_k, *rw_lnx_w, *rw_lnx_b, *w_br_mla, *w_br_ml, *w_br_rw, *w_out, *w_router, *router_bias;
  const float *w_e_gate, *w_e_up, *w_e_down, *w_s_gate, *w_s_up, *w_s_down, *g_final;
  float* out; char* ws; char* osc;
};

DI float bf2f(bf16_t s) { unsigned u = ((unsigned)s) << 16; float f; __builtin_memcpy(&f, &u, 4); return f; }
DI bf16_t f2bf(float x) { unsigned u; __builtin_memcpy(&u, &x, 4); u += 0x7fffu + ((u >> 16) & 1u); return (bf16_t)(u >> 16); }
DI unsigned pack2bf(float a, float b) {
#ifdef EMU
  return (unsigned)f2bf(a) | ((unsigned)f2bf(b) << 16);
#else
  typedef __bf16 bf2 __attribute__((ext_vector_type(2)));
  typedef float f2 __attribute__((ext_vector_type(2)));
  f2 v = {a, b}; bf2 r = __builtin_convertvector(v, bf2); return __builtin_bit_cast(unsigned, r);
#endif
}
DI f32x16 mfma32(bf16x8 a, bf16x8 b, f32x16 c) {
#ifdef EMU
  return emu_mfma_32x32x16_bf16(a, b, c);
#else
  return __builtin_amdgcn_mfma_f32_32x32x16_bf16(a, b, c, 0, 0, 0);
#endif
}
DI int rfl(int v) {
#ifdef EMU
  return v;
#else
  return __builtin_amdgcn_readfirstlane(v);
#endif
}
DI int opaque_tid() {
#ifdef EMU
  return threadIdx.x;
#else
  int t = threadIdx.x; asm volatile("" : "+v"(t)); return t;
#endif
}
DI f32x16 zero16() { f32x16 z; for (int i = 0; i < 16; ++i) z[i] = 0.f; return z; }
DI int crow(int reg, int h) { return (reg & 3) + 8 * (reg >> 2) + 4 * h; }
#ifdef EMU
DI float fexp(float x) { return expf(x); }
#else
DI float fexp(float x) { return __expf(x); }
#endif
DI float sigmoidf_(float x) { return 1.f / (1.f + fexp(-x)); }
DI float siluf_(float x) { return x * sigmoidf_(x); }
DI float wave_sum(float v) { for (int m = 32; m >= 1; m >>= 1) v += __shfl_xor(v, m); return v; }
DI float wave_max(float v) { for (int m = 32; m >= 1; m >>= 1) v = fmaxf(v, __shfl_xor(v, m)); return v; }

DI int tok_b(int n) { return n < NX_ ? n / T_ : (n - NX_) / CL_; }
DI int tok_t(int n) { return n < NX_ ? n % T_ : (n - NX_) % CL_; }
DI int tok_key(int n) { return n < NX_ ? CL_ + n % T_ : (n - NX_) % CL_; }
DI int tok_modrow(int n) { return n < NX_ ? n / T_ : 2; }

#ifdef EMU
#define SMEM_DECL(name, bytes) char* name = (char*)emu::shared_alloc(bytes)
#else
#define SMEM_DECL(name, bytes) __shared__ __attribute__((aligned(16))) char name[bytes]
#endif
#define NTHR 512
struct CvtJob { const float* src; int lds; int K; bf16_t* dst; int ntn; int ntk; int maptype; const float* gain; };
DI int cvt_map(int maptype, int coff, int np) {
  if (maptype == 0) return coff + np;
  if (maptype == 1) { if (np < 672) return np; if (np < 768) return -1; if (np < 768 + 1936) return np - 96; return -1; }
  return np;
}
DI void cvt_tile(const CvtJob& j, int coff, int tk, int tn, char* smem) {
  float* tile = (float*)smem;
  const int tid = opaque_tid();
  __syncthreads();
  {
    const int kk = tid >> 3, nc = (tid & 7) * 8, k = tk * 64 + kk;
    const float g = j.gain ? j.gain[k] : 1.f;
#pragma unroll
    for (int i = 0; i < 8; ++i) {
      const int np = tn * 64 + nc + i;
      const int sc = cvt_map(j.maptype, coff, np);
      tile[kk * 65 + nc + i] = sc >= 0 ? j.src[(size_t)k * j.lds + sc] * g : 0.f;
    }
  }
  __syncthreads();
  {
    const int n = tid >> 3, kc = (tid & 7) * 8;
    int np = tn * 64 + n;
    if (j.maptype == 2) np = (np >> 5) * 64 + coff * 32 + (np & 31);
    uint4 v;
    v.x = pack2bf(tile[(kc + 0) * 65 + n], tile[(kc + 1) * 65 + n]);
    v.y = pack2bf(tile[(kc + 2) * 65 + n], tile[(kc + 3) * 65 + n]);
    v.z = pack2bf(tile[(kc + 4) * 65 + n], tile[(kc + 5) * 65 + n]);
    v.w = pack2bf(tile[(kc + 6) * 65 + n], tile[(kc + 7) * 65 + n]);
    *(uint4*)(j.dst + (size_t)np * j.K + tk * 64 + kc) = v;
  }
}

constexpr int CVT_MIX_TILES = 704 + 768 + 72 + 32 + 32 + 128 + 64 + 64 + 256 + 16;
DI void cvt_mix_item(const Params& p, int l, int it, char* smem) {
  bf16_t* W = (bf16_t*)(p.ws + OFF_WMIX + (size_t)l * WM_SIZE);
  CvtJob j; int coff = 0;
  if (it < 704) { j = {p.w_in + (size_t)l * 1024 * D_IN_, D_IN_, 1024, (bf16_t*)((char*)W + WM_WIN), 44, 16, 1, nullptr}; }
  else if ((it -= 704) < 768) { j = {p.w_in + (size_t)l * 1024 * D_IN_, D_IN_, 1024, (bf16_t*)((char*)W + WM_GATE), 48, 16, 0, nullptr}; coff = 2608; }
  else if ((it -= 768) < 72) { j = {p.w_uq + (size_t)l * 384 * 768, 768, 384, (bf16_t*)((char*)W + WM_UQ), 12, 6, 0, p.g_cq + l * 384}; }
  else if ((it -= 72) < 32) { j = {p.w_uk + (size_t)l * 256 * 512, 512, 256, (bf16_t*)((char*)W + WM_UKV), 8, 4, 0, p.g_ckv + l * 256}; }
  else if ((it -= 32) < 32) { j = {p.w_uv + (size_t)l * 256 * 512, 512, 256, (bf16_t*)((char*)W + WM_UKV) + 512 * 256, 8, 4, 0, p.g_ckv + l * 256}; }
  else if ((it -= 32) < 128) { j = {p.w_br_mla + (size_t)l * 512 * 1024, 1024, 512, (bf16_t*)((char*)W + WM_BRA), 16, 8, 0, nullptr}; }
  else if ((it -= 128) < 64) { j = {p.w_br_ml + (size_t)l * 256 * 1024, 1024, 256, (bf16_t*)((char*)W + WM_BRM), 16, 4, 0, nullptr}; }
  else if ((it -= 64) < 64) { j = {p.w_br_rw + (size_t)l * 256 * 1024, 1024, 256, (bf16_t*)((char*)W + WM_BRR), 16, 4, 0, nullptr}; }
  else if ((it -= 64) < 256) { j = {p.w_out + (size_t)l * 1024 * 1024, 1024, 1024, (bf16_t*)((char*)W + WM_OUT), 16, 16, 0, nullptr}; }
  else { it -= 256; j = {p.w_router + (size_t)l * 1024 * 64, 64, 1024, (bf16_t*)((char*)W + WM_RT), 1, 16, 0, nullptr}; }
  cvt_tile(j, coff, it / j.ntn, it % j.ntn, smem);
}
constexpr int CVT_MOE_TILES = 65 * 192;
DI void cvt_moe_item(const Params& p, int l, int it, char* smem) {
  const int e = it / 192; int r = it % 192;
  bf16_t* GU = (bf16_t*)(p.ws + OFF_REGION + R_WMOE + WE_GU) + (size_t)e * 512 * 1024;
  bf16_t* DN = (bf16_t*)(p.ws + OFF_REGION + R_WMOE + WE_DN) + (size_t)e * 1024 * 256;
  const float* sg = e < 64 ? p.w_e_gate + ((size_t)l * 64 + e) * 1024 * 256 : p.w_s_gate + (size_t)l * 1024 * 256;
  const float* su = e < 64 ? p.w_e_up + ((size_t)l * 64 + e) * 1024 * 256 : p.w_s_up + (size_t)l * 1024 * 256;
  const float* sd = e < 64 ? p.w_e_down + ((size_t)l * 64 + e) * 256 * 1024 : p.w_s_down + (size_t)l * 256 * 1024;
  CvtJob j; int coff = 0;
  if (r < 64) { j = {sg, 256, 1024, GU, 4, 16, 2, nullptr}; coff = 0; }
  else if ((r -= 64) < 64) { j = {su, 256, 1024, GU, 4, 16, 2, nullptr}; coff = 1; }
  else { r -= 64; j = {sd, 1024, 256, DN, 16, 4, 0, nullptr}; }
  cvt_tile(j, coff, r / j.ntn, r % j.ntn, smem);
}

DI void mod_item(const Params& p, int it, char* smem) {
  float* cond = (float*)smem;
  float* red = cond + 3 * 1024;
  const int tid = opaque_tid(), l = it / 96, j0 = (it % 96) * 64;
  __syncthreads();
  for (int i = tid; i < 3 * 1024; i += NTHR) {
    const int r = i >> 10, k = i & 1023;
    const float v = r < 2 ? p.c[r * 1024 + k] : p.c_ctx[k];
    cond[i] = siluf_(v);
  }
  __syncthreads();
  const int jj = tid & 63, kg = tid >> 6;
  float a0 = 0.f, a1 = 0.f, a2 = 0.f;
  const float* w = p.w_mod + (size_t)l * 1024 * 6144 + j0 + jj;
  for (int k = kg; k < 1024; k += 8) {
    const float wv = w[(size_t)k * 6144];
    a0 += cond[k] * wv; a1 += cond[1024 + k] * wv; a2 += cond[2048 + k] * wv;
  }
  red[(kg * 3 + 0) * 64 + jj] = a0; red[(kg * 3 + 1) * 64 + jj] = a1; red[(kg * 3 + 2) * 64 + jj] = a2;
  __syncthreads();
  if (tid < 192) {
    const int r = tid >> 6; float s = 0.f;
    for (int g = 0; g < 8; ++g) s += red[(g * 3 + r) * 64 + jj];
    float* mod = (float*)(p.ws + OFF_MOD);
    mod[((size_t)l * 3 + r) * 6144 + j0 + jj] = s + p.b_mod[(size_t)l * 6144 + j0 + jj];
  }
}
DI void rope_item(const Params& p, int it) {
  const int idx = it * NTHR + threadIdx.x;
  if (idx >= T_ * 16) return;
  const int t = idx >> 4, i = idx & 15, f = i & 7;
  const float pos = (float)(i < 8 ? t / GRID_W_ : t % GRID_W_);
  const float inv = powf(10000.f, -(float)(2 * f) / 16.f);
  const float ang = pos * inv;
  float2* rt = (float2*)(p.ws + OFF_ROPE);
  rt[idx] = make_float2(cosf(ang), sinf(ang));
}
constexpr int PA_ITEMS = 192 + (T_ * 16 + NTHR - 1) / NTHR + 2 * CVT_MIX_TILES;
DI void phaseA(const Params& p, char* smem) {
  if (blockIdx.x == 0 && threadIdx.x < 256) ((int*)(p.ws + OFF_CNT))[threadIdx.x] = 0;
  for (int it = blockIdx.x; it < PA_ITEMS; it += gridDim.x) {
    int i = it;
    if (i < 192) { mod_item(p, i, smem); continue; }
    i -= 192;
    constexpr int NR = (T_ * 16 + NTHR - 1) / NTHR;
    if (i < NR) { rope_item(p, i); continue; }
    i -= NR;
    cvt_mix_item(p, i / CVT_MIX_TILES, i % CVT_MIX_TILES, smem);
  }
}

DI void row_norm_mod(const float (&v)[16], const float* g, const float* shift, const float* scale, bf16_t* hrow, int lane) {
  float ss = 0.f;
#pragma unroll
  for (int i = 0; i < 16; ++i) ss += v[i] * v[i];
  ss = wave_sum(ss);
  const float rs = 1.0f / sqrtf(ss * (1.f / 1024.f) + 1e-6f);
#pragma unroll
  for (int j = 0; j < 4; ++j) {
    const int c = (j * 64 + lane) * 4;
    const float4 gg = *(const float4*)(g + c), sh = *(const float4*)(shift + c), sc = *(const float4*)(scale + c);
    const float h0 = v[j * 4 + 0] * rs * gg.x * (1.f + sc.x) + sh.x;
    const float h1 = v[j * 4 + 1] * rs * gg.y * (1.f + sc.y) + sh.y;
    const float h2 = v[j * 4 + 2] * rs * gg.z * (1.f + sc.z) + sh.z;
    const float h3 = v[j * 4 + 3] * rs * gg.w * (1.f + sc.w) + sh.w;
    uint2 o; o.x = pack2bf(h0, h1); o.y = pack2bf(h2, h3);
    *(uint2*)(hrow + c) = o;
  }
}
DI void phase_norm0(const Params& p) {
  const int lane = threadIdx.x & 63, wid = threadIdx.x >> 6;
  float* xs = (float*)(p.ws + OFF_XS);
  bf16_t* H = (bf16_t*)(p.ws + OFF_H);
  const float* mod = (const float*)(p.ws + OFF_MOD);
  for (int n = blockIdx.x * 8 + wid; n < NT_; n += gridDim.x * 8) {
    const float* src = n < NX_ ? p.x + (size_t)n * 1024 : p.ctx + (size_t)(n - NX_) * 1024;
    float v[16];
#pragma unroll
    for (int j = 0; j < 4; ++j) {
      const float4 t = *(const float4*)(src + (j * 64 + lane) * 4);
      v[j * 4] = t.x; v[j * 4 + 1] = t.y; v[j * 4 + 2] = t.z; v[j * 4 + 3] = t.w;
      *(float4*)(xs + (size_t)n * 1024 + (j * 64 + lane) * 4) = t;
    }
    const float* m = mod + (size_t)(0 * 3 + tok_modrow(n)) * 6144;
    row_norm_mod(v, p.g_mix, m, m + 1024, H + (size_t)n * 1024, lane);
  }
}

template <int BM, int BN, int BK, int WM_, int WN_>
struct Gemm {
  static constexpr int WTM = BM / WM_, WTN = BN / WN_, MB = WTM / 32, NB = WTN / 32;
  static constexpr int LDA = BK + 8;
  static constexpr int A_BYTES = BM * LDA * 2, B_BYTES = BN * LDA * 2, STAGE = A_BYTES + B_BYTES;
  static constexpr int SMEM = 2 * STAGE;
  static constexpr int CPR = BK / 8;
  static constexpr int ACH = BM * CPR / NTHR, BCH = BN * CPR / NTHR;
  static_assert(WM_ * WN_ == 8, "8 waves");
  static_assert(BM * CPR % NTHR == 0 && BN * CPR % NTHR == 0, "chunking");
  static_assert(NTHR % CPR == 0, "rows fixed per thread");

  template <class ARow>
  static DI void run(f32x16 (&acc)[MB][NB], ARow arow, const bf16_t* Bt, int ldb, int Klen, char* smem) {
    const int tid = opaque_tid(), lane = tid & 63, wid = tid >> 6, wm = wid / WN_, wn = wid % WN_;
    const int kc = (tid % CPR) * 8, r0 = tid / CPR;
    const bf16_t* ap[ACH]; const bf16_t* bp[BCH];
#pragma unroll
    for (int i = 0; i < ACH; ++i) ap[i] = arow(r0 + i * (NTHR / CPR)) + kc;
#pragma unroll
    for (int i = 0; i < BCH; ++i) bp[i] = Bt + (size_t)(r0 + i * (NTHR / CPR)) * ldb + kc;
    uint4 ra[ACH], rb[BCH];
    const int nk = Klen / BK;
#pragma unroll
    for (int i = 0; i < ACH; ++i) ra[i] = *(const uint4*)(ap[i]);
#pragma unroll
    for (int i = 0; i < BCH; ++i) rb[i] = *(const uint4*)(bp[i]);
#pragma unroll
    for (int i = 0; i < ACH; ++i) *(uint4*)(smem + ((r0 + i * (NTHR / CPR)) * LDA + kc) * 2) = ra[i];
#pragma unroll
    for (int i = 0; i < BCH; ++i) *(uint4*)(smem + A_BYTES + ((r0 + i * (NTHR / CPR)) * LDA + kc) * 2) = rb[i];
    __syncthreads();
    for (int kt = 0; kt < nk; ++kt) {
      const bool more = kt + 1 < nk;
      if (more) {
#pragma unroll
        for (int i = 0; i < ACH; ++i) ra[i] = *(const uint4*)(ap[i] + (kt + 1) * BK);
#pragma unroll
        for (int i = 0; i < BCH; ++i) rb[i] = *(const uint4*)(bp[i] + (kt + 1) * BK);
      }
      const char* As = smem + (kt & 1) * STAGE;
      const char* Bs = As + A_BYTES;
#pragma unroll
      for (int ks = 0; ks < BK / 16; ++ks) {
        bf16x8 af[MB], bfr[NB];
#pragma unroll
        for (int mb = 0; mb < MB; ++mb)
          af[mb] = *(const bf16x8*)(As + ((wm * WTM + mb * 32 + (lane & 31)) * LDA + ks * 16 + (lane >> 5) * 8) * 2);
#pragma unroll
        for (int nb = 0; nb < NB; ++nb)
          bfr[nb] = *(const bf16x8*)(Bs + ((wn * WTN + nb * 32 + (lane & 31)) * LDA + ks * 16 + (lane >> 5) * 8) * 2);
#pragma unroll
        for (int mb = 0; mb < MB; ++mb)
#pragma unroll
          for (int nb = 0; nb < NB; ++nb) acc[mb][nb] = mfma32(af[mb], bfr[nb], acc[mb][nb]);
      }
      if (more) {
        char* Ad = smem + ((kt + 1) & 1) * STAGE;
#pragma unroll
        for (int i = 0; i < ACH; ++i) *(uint4*)(Ad + ((r0 + i * (NTHR / CPR)) * LDA + kc) * 2) = ra[i];
#pragma unroll
        for (int i = 0; i < BCH; ++i) *(uint4*)(Ad + A_BYTES + ((r0 + i * (NTHR / CPR)) * LDA + kc) * 2) = rb[i];
      }
      __syncthreads();
    }
  }
  static DI int row_of(int t, int mb, int reg) { const int lane = t & 63, wm = (t >> 6) / WN_; return wm * WTM + mb * 32 + crow(reg, lane >> 5); }
  static DI int col_of(int t, int nb) { const int lane = t & 63, wn = (t >> 6) % WN_; return wn * WTN + nb * 32 + (lane & 31); }
};

typedef Gemm<256, 256, 64, 2, 4> G256;
DI void phase_win(const Params& p, int l, char* smem) {
  const bf16_t* H = (const bf16_t*)(p.ws + OFF_H);
  const bf16_t* W = (const bf16_t*)(p.ws + OFF_WMIX + (size_t)l * WM_SIZE + WM_WIN);
  bf16_t* zmla = (bf16_t*)(p.osc + O_ZMLA);
  float* zrec = (float*)(p.ws + OFF_REGION + R_ZREC);
  constexpr int TM = NT_ / 256, TN = WIN_N / 256;
  for (int it = blockIdx.x; it < TM * TN; it += gridDim.x) {
    const int tid = opaque_tid();
    const int tm = it / TN, tn = it % TN;
    f32x16 acc[G256::MB][G256::NB];
#pragma unroll
    for (int a = 0; a < G256::MB; ++a)
#pragma unroll
      for (int b = 0; b < G256::NB; ++b) acc[a][b] = zero16();
    const bf16_t* A0 = H + (size_t)tm * 256 * 1024;
    G256::run(acc, [&](int r) { return A0 + (size_t)r * 1024; }, W + (size_t)tn * 256 * 1024, 1024, 1024, smem);
#pragma unroll
    for (int mb = 0; mb < G256::MB; ++mb)
#pragma unroll
      for (int nb = 0; nb < G256::NB; ++nb) {
        const int col = tn * 256 + G256::col_of(tid, nb);
#pragma unroll
        for (int i = 0; i < 16; ++i) {
          const int row = tm * 256 + G256::row_of(tid, mb, i);
          const float v = acc[mb][nb][i];
          if (col < 768) zmla[(size_t)row * ZMLA_W + col] = f2bf(v);
          else if (col - 768 < ZREC_W) zrec[(size_t)row * ZREC_W + (col - 768)] = v;
        }
      }
  }
}
typedef Gemm<128, 128, 64, 2, 4> G128;
DI void mla_row_rs(const bf16_t* zmla_rows, int c0, int len, float* rs) {
  const int tid = opaque_tid(), row = tid >> 2, half = tid & 3;
  const bf16_t* src = zmla_rows + (size_t)row * ZMLA_W + c0 + half * (len / 4);
  float ss = 0.f;
  for (int i = 0; i < len / 4; i += 8) {
    const uint4 v = *(const uint4*)(src + i);
    const unsigned w[4] = {v.x, v.y, v.z, v.w};
#pragma unroll
    for (int j = 0; j < 4; ++j) { const float a = bf2f((bf16_t)(w[j] & 0xffff)), b = bf2f((bf16_t)(w[j] >> 16)); ss += a * a + b * b; }
  }
  ss += __shfl_xor(ss, 1); ss += __shfl_xor(ss, 2);
  if (half == 0) rs[row] = 1.0f / sqrtf(ss / (float)len + 1e-6f);
}

constexpr int MLA_Q_TILES = (NT_ / 128) * 6, MLA_KV_TILES = (NT_ / 128) * 8;
DI void mla_q_item(const Params& p, int l, int it, char* smem) {
  const int tid = opaque_tid();
  const int tm = it / 6, tn = it % 6;
  const bf16_t* zmla = (const bf16_t*)(p.osc + O_ZMLA) + (size_t)tm * 128 * ZMLA_W;
  const bf16_t* W = (const bf16_t*)(p.ws + OFF_WMIX + (size_t)l * WM_SIZE + WM_UQ) + (size_t)tn * 128 * 384;
  bf16_t* qb = (bf16_t*)(p.osc + O_QB);
  const float2* rt = (const float2*)(p.ws + OFF_ROPE);
  float* rs = (float*)(smem + G128::SMEM);
  __syncthreads();
  mla_row_rs(zmla, 0, 384, rs);
  f32x16 acc[G128::MB][G128::NB];
#pragma unroll
  for (int a = 0; a < G128::MB; ++a)
#pragma unroll
    for (int b = 0; b < G128::NB; ++b) acc[a][b] = zero16();
  G128::run(acc, [&](int r) { return zmla + (size_t)r * ZMLA_W; }, W, 384, 384, smem);
  const int lane = tid & 63;
  const bool isx = tm * 128 < NX_;
#pragma unroll
  for (int mb = 0; mb < G128::MB; ++mb)
#pragma unroll
    for (int nb = 0; nb < G128::NB; ++nb) {
      const int col = tn * 128 + G128::col_of(tid, nb);
      const bool ropeblk = ((col >> 5) % 3) == 2;
      const int e = lane & 31;
#pragma unroll
      for (int i = 0; i < 16; ++i) {
        const int lr = G128::row_of(tid, mb, i);
        const int n = tm * 128 + lr;
        float v = acc[mb][nb][i] * rs[lr];
        if (ropeblk && isx) {
          const float pv = __shfl_xor(v, 8);
          const float2 cs = rt[(size_t)(n % T_) * 16 + (e >> 4) * 8 + (e & 7)];
          v = (e & 8) ? (pv * cs.y + v * cs.x) : (v * cs.x - pv * cs.y);
        }
        qb[(size_t)n * 768 + col] = f2bf(v);
      }
    }
}
DI void mla_kv_item(const Params& p, int l, int it, char* smem) {
  const int tid = opaque_tid();
  const int tm = it / 8, tn = it % 8;
  const bf16_t* zmla = (const bf16_t*)(p.osc + O_ZMLA) + (size_t)tm * 128 * ZMLA_W;
  const bf16_t* W = (const bf16_t*)(p.ws + OFF_WMIX + (size_t)l * WM_SIZE + WM_UKV) + (size_t)tn * 128 * 256;
  bf16_t* kb = (bf16_t*)(p.ws + OFF_REGION + R_KB);
  bf16_t* vt = (bf16_t*)(p.ws + OFF_REGION + R_VT);
  const float2* rt = (const float2*)(p.ws + OFF_ROPE);
  float* rs = (float*)(smem + G128::SMEM);
  __syncthreads();
  mla_row_rs(zmla, 384, 256, rs);
  const int n0 = tm * 128;
  const int b = tok_b(n0), key0 = tok_key(n0);
  const bool isx = n0 < NX_;
  if (tn == 0) {
    for (int idx = tid; idx < 128 * 16; idx += NTHR) {
      const int lr = idx >> 4, pi = idx & 15, a = pi >> 3, i = pi & 7;
      const bf16_t* z = zmla + (size_t)lr * ZMLA_W + 640 + a * 16 + i;
      float x1 = bf2f(z[0]), x2 = bf2f(z[8]);
      if (isx) {
        const float2 cs = rt[(size_t)((n0 + lr) % T_) * 16 + a * 8 + i];
        const float y1 = x1 * cs.x - x2 * cs.y, y2 = x1 * cs.y + x2 * cs.x; x1 = y1; x2 = y2;
      }
      const bf16_t o1 = f2bf(x1), o2 = f2bf(x2);
      for (int h = 0; h < 8; ++h) {
        bf16_t* dst = kb + ((size_t)(b * 8 + h) * KT_ + key0 + lr) * 96 + 64 + a * 16 + i;
        dst[0] = o1; dst[8] = o2;
      }
    }
  }
  f32x16 acc[G128::MB][G128::NB];
#pragma unroll
  for (int a = 0; a < G128::MB; ++a)
#pragma unroll
    for (int c = 0; c < G128::NB; ++c) acc[a][c] = zero16();
  G128::run(acc, [&](int r) { return zmla + (size_t)r * ZMLA_W + 384; }, W, 256, 256, smem);
  const int lane = tid & 63;
#pragma unroll
  for (int mb = 0; mb < G128::MB; ++mb)
#pragma unroll
    for (int nb = 0; nb < G128::NB; ++nb) {
      const int col = tn * 128 + G128::col_of(tid, nb);
      if (col < 512) {
        const int h = col >> 6, d = col & 63;
#pragma unroll
        for (int i = 0; i < 16; ++i) {
          const int lr = G128::row_of(tid, mb, i);
          kb[((size_t)(b * 8 + h) * KT_ + key0 + lr) * 96 + d] = f2bf(acc[mb][nb][i] * rs[lr]);
        }
      } else {
        const int h = (col - 512) >> 6, d = col & 63;
#pragma unroll
        for (int g = 0; g < 4; ++g) {
          const int lr = G128::row_of(tid, mb, g * 4);
          uint2 o;
          o.x = pack2bf(acc[mb][nb][g * 4 + 0] * rs[lr], acc[mb][nb][g * 4 + 1] * rs[lr + 1]);
          o.y = pack2bf(acc[mb][nb][g * 4 + 2] * rs[lr + 2], acc[mb][nb][g * 4 + 3] * rs[lr + 3]);
          *(uint2*)(vt + ((size_t)(b * 8 + h) * 64 + d) * KT_ + key0 + lr) = o;
        }
      }
    }
  (void)lane;
}

DI float softplusf_(float x) { return x > 20.f ? x : log1pf(fexp(x)); }
constexpr int RWP_TT = 16;
constexpr int RWP_ITEMS = NT_ / RWP_TT;
DI void rwkv_prep_item(const Params& p, int l, int it, char* smem) {
  float* zs = (float*)smem;
  float* tw = zs + RWP_TT * 1024;
  float* ta = tw + 2 * 64 * RWP_TT;
  const float* zrec = (const float*)(p.ws + OFF_REGION + R_ZREC);
  bf16_t* rb = (bf16_t*)(p.ws + OFF_REGION + R_RB16);
  float* lwo = (float*)(p.ws + OFF_REGION + R_LW);
  float* bso = (float*)(p.ws + OFF_REGION + R_BS);
  const float rkw = p.rw_r_k[(size_t)l * 256 + (opaque_tid() & 255)];
  const float* mu = p.rw_mu + (size_t)l * 1152;
  const int tid = opaque_tid(), n0 = it * RWP_TT;
  __syncthreads();
  for (int idx = tid; idx < RWP_TT * 1024; idx += NTHR) {
    const int tt = idx >> 10, c = idx & 1023, n = n0 + tt, t = tok_t(n);
    const int len = n < NX_ ? T_ : CL_;
    const float* zr = zrec + (size_t)n * ZREC_W + ZR_RW + c;
    const float z = zr[0];
    const float zp = t > 0 ? zr[-ZREC_W] : 0.f, zn = t < len - 1 ? zr[ZREC_W] : 0.f;
    const float s = z + (0.5f * (zp + zn) - z) * mu[c];
    zs[idx] = s;
    if (c >= 768 && c < 896) { const int d = (c - 768) >> 6, k = (c - 768) & 63; tw[(d * 64 + k) * RWP_TT + tt] = tanhf(s); }
    if (c >= 896) { const int d = (c - 896) >> 6, k = (c - 896) & 63; ta[(d * 64 + k) * RWP_TT + tt] = s; }
  }
  __syncthreads();
  const int col = tid & 255, d = tid >> 8;
  float aw[RWP_TT], aa[RWP_TT];
#pragma unroll
  for (int i = 0; i < RWP_TT; ++i) { aw[i] = 0.f; aa[i] = 0.f; }
  const float* w2 = p.rw_w2 + ((size_t)l * 2 + d) * 64 * 256 + col;
  const float* a2 = p.rw_a2 + ((size_t)l * 2 + d) * 64 * 256 + col;
  for (int k = 0; k < 64; ++k) {
    const float wv = w2[k * 256], av = a2[k * 256];
    const float* twk = tw + (d * 64 + k) * RWP_TT;
    const float* tak = ta + (d * 64 + k) * RWP_TT;
#pragma unroll
    for (int i = 0; i < RWP_TT; ++i) { aw[i] += twk[i] * wv; aa[i] += tak[i] * av; }
  }
  const float w0 = p.rw_w0[((size_t)l * 2 + d) * 256 + col], a0 = p.rw_a0[((size_t)l * 2 + d) * 256 + col];
  const float kkw = p.rw_k_k[(size_t)l * 256 + col], kaw = p.rw_k_a[(size_t)l * 256 + col];
  const size_t AS = (size_t)NT_ * 256;
#pragma unroll
  for (int i = 0; i < RWP_TT; ++i) {
    const int n = n0 + i;
    const float r = zs[i * 1024 + col], k = zs[i * 1024 + 256 + col], v = zs[i * 1024 + 512 + col];
    const float kr = k * kkw;
    const float ss = wave_sum(kr * kr);
    const float kk = kr / fmaxf(sqrtf(ss), 1e-12f);
    const float w = -softplusf_(-(w0 + aw[i])) - 0.5f;
    const float logdecay = -fexp(w);
    const float a = sigmoidf_(a0 + aa[i]);
    const float kd = k * (1.f + (a - 1.f) * kaw);
    const float bsum = wave_sum(r * rkw * kd);
    const size_t o = (size_t)n * 256 + col;
    if (d == 0) { rb[0 * AS + o] = f2bf(r); rb[1 * AS + o] = f2bf(v); rb[2 * AS + o] = f2bf(kk); }
    lwo[d * AS + o] = logdecay;
    rb[(3 + 2 * d) * AS + o] = f2bf(kd);
    rb[(4 + 2 * d) * AS + o] = f2bf(kk * a);
    if ((tid & 63) == 0) bso[((size_t)d * NT_ + n) * 4 + (col >> 6)] = bsum;
  }
}

DI int seq_tok(int dir, int b, int pos) {
  if (pos < CL_) return NX_ + b * CL_ + (dir ? CL_ - 1 - pos : pos);
  const int t = pos - CL_;
  return b * T_ + (dir ? T_ - 1 - t : t);
}
DI float logsigmoidf_(float x) { return -softplusf_(-x); }
DI float wave_incl_scan(float v, int lane) {
  for (int d = 1; d < 64; d <<= 1) { const float o = __shfl_up(v, d); if (lane >= d) v += o; }
  return v;
}
constexpr int ML_ST = 2112;
constexpr int ML1_ITEMS = NSEQ_ * NCH_;
DI void mlstm_local_item(const Params& p, int l, int it, char* smem) {
  const int s = it / NCH_, c = it % NCH_, dir = s >> 3, b = (s >> 2) & 1, hd = s & 3;
  float* vv = (float*)smem;
  float* kw = vv + 64 * 64;
  float* wej = kw + 64 * 32;
  const float* zrec = (const float*)(p.ws + OFF_REGION + R_ZREC);
  float* st = (float*)(p.ws + OFF_REGION + R_MLST) + ((size_t)s * NCH_ + c) * ML_ST;
  const int tid = opaque_tid(), lane = tid & 63, wid = tid >> 6;
  __syncthreads();
  if (wid == 0) {
    const int n = seq_tok(dir, b, c * 64 + lane);
    const float fp = zrec[(size_t)n * ZREC_W + ZR_MLF + dir * 4 + hd] + p.ml_b_f[(l * 2 + dir) * 4 + hd];
    const float ip = zrec[(size_t)n * ZREC_W + ZR_MLI + dir * 4 + hd] + p.ml_b_i[(l * 2 + dir) * 4 + hd];
    const float bj = wave_incl_scan(logsigmoidf_(fp), lane);
    const float bl = __shfl(bj, 63);
    const float lw = bl - bj + ip;
    const float ml = wave_max(lw);
    wej[lane] = fexp(lw - ml);
    if (lane == 0) { st[2080] = bl; st[2081] = ml; }
  }
  for (int idx = tid; idx < 64 * 64; idx += NTHR) {
    const int j = idx >> 6, e = idx & 63;
    const int n = seq_tok(dir, b, c * 64 + j);
    vv[idx] = zrec[(size_t)n * ZREC_W + ZR_MLV + hd * 64 + e];
  }
  __syncthreads();
  for (int idx = tid; idx < 64 * 32; idx += NTHR) {
    const int j = idx >> 5, e = idx & 31;
    const int n = seq_tok(dir, b, c * 64 + j);
    kw[idx] = zrec[(size_t)n * ZREC_W + ZR_MLK + hd * 32 + e] * wej[j];
  }
  __syncthreads();
  const int v = tid & 63, d0 = (tid >> 6) * 4;
  float a0 = 0.f, a1 = 0.f, a2 = 0.f, a3 = 0.f;
  for (int j = 0; j < 64; ++j) {
    const float x = vv[j * 64 + v];
    const float4 kk = *(const float4*)(kw + j * 32 + d0);
    a0 += x * kk.x; a1 += x * kk.y; a2 += x * kk.z; a3 += x * kk.w;
  }
  *(float4*)(st + v * 32 + d0) = make_float4(a0, a1, a2, a3);
  if (tid < 32) { float sn = 0.f; for (int j = 0; j < 64; ++j) sn += kw[j * 32 + tid]; st[2048 + tid] = sn; }
}
constexpr int ML2_ITEMS = (NSEQ_ * 2080 + NTHR - 1) / NTHR;
DI void mlstm_scan_item(const Params& p, int it) {
  const int g = it * NTHR + opaque_tid();
  if (g >= NSEQ_ * 2080) return;
  const int s = g / 2080, e = g % 2080;
  float* st = (float*)(p.ws + OFF_REGION + R_MLST) + (size_t)s * NCH_ * ML_ST;
  float state = 0.f, m = 0.f;
  for (int c = 0; c < NCH_; ++c) {
    float* r = st + (size_t)c * ML_ST;
    const float d = r[e], bl = r[2080], ml = r[2081];
    r[e] = state;
    if (e == 0) r[2082] = m;
    const float mn = fmaxf(bl + m, ml);
    state = fexp(bl + m - mn) * state + fexp(ml - mn) * d;
    m = mn;
  }
}

constexpr int P3_ITEMS = RWP_ITEMS + ML1_ITEMS;
DI void phase3(const Params& p, int l, char* smem) {
  for (int it = blockIdx.x; it < P3_ITEMS; it += gridDim.x) {
    if (it < RWP_ITEMS) rwkv_prep_item(p, l, it, smem);
    else mlstm_local_item(p, l, it - RWP_ITEMS, smem);
  }
}
constexpr int RW_LD = 72, RW_MB = 64 * RW_LD * 2;
constexpr int RWC_REC = 40960;
DI char* rw_rec(const Params& p, int s, int c) { return p.ws + OFF_REGION + R_CH + ((size_t)s * NCH_ + c) * RWC_REC; }
DI f32x16 rw_mm(const char* A, const char* Bt, int mb, int nb, int lane, f32x16 acc) {
  const int r = lane & 31, h = lane >> 5;
#pragma unroll
  for (int ks = 0; ks < 4; ++ks) {
    const bf16x8 a = *(const bf16x8*)(A + ((mb * 32 + r) * RW_LD + ks * 16 + h * 8) * 2);
    const bf16x8 b = *(const bf16x8*)(Bt + ((nb * 32 + r) * RW_LD + ks * 16 + h * 8) * 2);
    acc = mfma32(a, b, acc);
  }
  return acc;
}
DI void rw_wrT(char* Dst, int mb, int nb, int lane, const f32x16& v) {
  const int r = lane & 31, h = lane >> 5;
#pragma unroll
  for (int g = 0; g < 4; ++g) {
    uint2 o; o.x = pack2bf(v[4 * g], v[4 * g + 1]); o.y = pack2bf(v[4 * g + 2], v[4 * g + 3]);
    *(uint2*)(Dst + ((nb * 32 + r) * RW_LD + mb * 32 + 8 * g + 4 * h) * 2) = o;
  }
}
DI void rw_wrT_g(bf16_t* Dst, int mb, int nb, int lane, const f32x16& v) {
  const int r = lane & 31, h = lane >> 5;
#pragma unroll
  for (int g = 0; g < 4; ++g) {
    uint2 o; o.x = pack2bf(v[4 * g], v[4 * g + 1]); o.y = pack2bf(v[4 * g + 2], v[4 * g + 3]);
    *(uint2*)(Dst + (nb * 32 + r) * 64 + mb * 32 + 8 * g + 4 * h) = o;
  }
}
DI void rw_addT(const char* Src, int mb, int nb, int lane, f32x16& v) {
  const int r = lane & 31, h = lane >> 5;
#pragma unroll
  for (int g = 0; g < 4; ++g) {
    const uint2 u = *(const uint2*)(Src + ((nb * 32 + r) * RW_LD + mb * 32 + 8 * g + 4 * h) * 2);
    v[4 * g] += bf2f((bf16_t)(u.x & 0xffff)); v[4 * g + 1] += bf2f((bf16_t)(u.x >> 16));
    v[4 * g + 2] += bf2f((bf16_t)(u.y & 0xffff)); v[4 * g + 3] += bf2f((bf16_t)(u.y >> 16));
  }
}
DI void rw_mask_upper(f32x16& v, int mb, int nb, int lane, bool strict) {
  const int col = nb * 32 + (lane & 31), h = lane >> 5;
#pragma unroll
  for (int i = 0; i < 16; ++i) { const int row = mb * 32 + crow(i, h); if (strict ? !(row < col) : !(row <= col)) v[i] = 0.f; }
}
DI void rw_mask_lower_strict(f32x16& v, int mb, int nb, int lane) {
  const int col = nb * 32 + (lane & 31), h = lane >> 5;
#pragma unroll
  for (int i = 0; i < 16; ++i) { const int row = mb * 32 + crow(i, h); if (!(col < row)) v[i] = 0.f; }
}

constexpr int RW1_ITEMS = NSEQ_ * NCH_;
DI void rw_chunk_item(const Params& p, int it, char* smem) {
  const int s = it / NCH_, c = it % NCH_, dir = s >> 3, b = (s >> 2) & 1, hd = s & 3;
  const int tid = opaque_tid(), lane = tid & 63, wid = tid >> 6;
  const bf16_t* rb = (const bf16_t*)(p.ws + OFF_REGION + R_RB16);
  const float* lwg = (const float*)(p.ws + OFF_REGION + R_LW) + (size_t)dir * NT_ * 256;
  const size_t AS = (size_t)NT_ * 256;
  char* const At = smem + 0 * RW_MB; char* const Bt_ = smem + 1 * RW_MB; char* const Kt = smem + 2 * RW_MB; char* const Rt = smem + 3 * RW_MB;
  char* const Aj = smem + 4 * RW_MB; char* const Bj = smem + 5 * RW_MB; char* const Kj = smem + 6 * RW_MB; char* const Vi = smem + 7 * RW_MB;
  char* const QA = smem + 8 * RW_MB; char* const QTA = smem + 9 * RW_MB; char* const GA = smem + 10 * RW_MB;
  char* const Mka = smem + 11 * RW_MB; char* const MbrT = smem + 12 * RW_MB; char* const MkrT = smem + 13 * RW_MB;
  char* const QB = At; char* const QTB = Bt_; char* const GB = Kt;
  float* const cs = (float*)(smem + 8 * RW_MB);
  float* const gC = (float*)(smem + 14 * RW_MB);
  char* rec = rw_rec(p, s, c);
  __syncthreads();
  const int t = tid >> 3, j8 = (tid & 7) * 8;
  const int n = seq_tok(dir, b, c * 64 + t);
  {
    const float4 l0 = *(const float4*)(lwg + (size_t)n * 256 + hd * 64 + j8), l1 = *(const float4*)(lwg + (size_t)n * 256 + hd * 64 + j8 + 4);
    float* d = cs + t * 65 + j8;
    d[0] = l0.x; d[1] = l0.y; d[2] = l0.z; d[3] = l0.w; d[4] = l1.x; d[5] = l1.y; d[6] = l1.z; d[7] = l1.w;
  }
  __syncthreads();
  if (tid < 64) { float a = 0.f; for (int tt = 0; tt < 64; ++tt) { a += cs[tt * 65 + tid]; cs[tt * 65 + tid] = a; } gC[tid] = fexp(a); }
  __syncthreads();
  {
    const size_t o = (size_t)n * 256 + hd * 64 + j8;
    const uint4 ukk = *(const uint4*)(rb + 2 * AS + o), ubb = *(const uint4*)(rb + (4 + 2 * dir) * AS + o), ukd = *(const uint4*)(rb + (3 + 2 * dir) * AS + o);
    const uint4 ur = *(const uint4*)(rb + 0 * AS + o), uv = *(const uint4*)(rb + 1 * AS + o);
    const unsigned akk[4] = {ukk.x, ukk.y, ukk.z, ukk.w}, abb[4] = {ubb.x, ubb.y, ubb.z, ubb.w}, akd[4] = {ukd.x, ukd.y, ukd.z, ukd.w};
    const unsigned ar[4] = {ur.x, ur.y, ur.z, ur.w}, av[4] = {uv.x, uv.y, uv.z, uv.w};
    unsigned oa[4], ob[4], ok[4], orr[4];
#pragma unroll
    for (int q = 0; q < 4; ++q) {
      float fa[2], fb[2], fk[2], fr[2];
#pragma unroll
      for (int e = 0; e < 2; ++e) {
        const int j = j8 + 2 * q + e;
        const float cst = cs[t * 65 + j], csp = t > 0 ? cs[(t - 1) * 65 + j] : 0.f;
        const float g = fexp(cst), gp = fexp(csp), gi = fexp(-cst);
        const int sh = 16 * e;
        fa[e] = -bf2f((bf16_t)((akk[q] >> sh) & 0xffff)) * gp;
        fb[e] = bf2f((bf16_t)((abb[q] >> sh) & 0xffff)) * gi;
        fk[e] = bf2f((bf16_t)((akd[q] >> sh) & 0xffff)) * gi;
        fr[e] = bf2f((bf16_t)((ar[q] >> sh) & 0xffff)) * g;
        *(bf16_t*)(Aj + (j * RW_LD + t) * 2) = f2bf(fa[e]);
        *(bf16_t*)(Bj + (j * RW_LD + t) * 2) = f2bf(fb[e]);
        *(bf16_t*)(Kj + (j * RW_LD + t) * 2) = f2bf(fk[e]);
        *(bf16_t*)(Vi + (j * RW_LD + t) * 2) = (bf16_t)((av[q] >> sh) & 0xffff);
      }
      oa[q] = pack2bf(fa[0], fa[1]); ob[q] = pack2bf(fb[0], fb[1]); ok[q] = pack2bf(fk[0], fk[1]); orr[q] = pack2bf(fr[0], fr[1]);
    }
    *(uint4*)(At + (t * RW_LD + j8) * 2) = make_uint4(oa[0], oa[1], oa[2], oa[3]);
    *(uint4*)(Bt_ + (t * RW_LD + j8) * 2) = make_uint4(ob[0], ob[1], ob[2], ob[3]);
    *(uint4*)(Kt + (t * RW_LD + j8) * 2) = make_uint4(ok[0], ok[1], ok[2], ok[3]);
    *(uint4*)(Rt + (t * RW_LD + j8) * 2) = make_uint4(orr[0], orr[1], orr[2], orr[3]);
  }
  __syncthreads();
  {
    const int prod = wid >> 2, mb = (wid >> 1) & 1, nb = wid & 1;
    f32x16 acc = zero16();
    if (prod == 0) {
      if (!(mb == 1 && nb == 0)) acc = rw_mm(Bt_, At, mb, nb, lane, acc);
      rw_mask_upper(acc, mb, nb, lane, true);
      rw_wrT(QA, mb, nb, lane, acc);
      if (mb == nb) {
        const int col = nb * 32 + (lane & 31), h = lane >> 5;
#pragma unroll
        for (int i = 0; i < 16; ++i) if (mb * 32 + crow(i, h) == col) acc[i] += 1.f;
      }
      rw_wrT(GA, mb, nb, lane, acc);
    } else {
      if (!(mb == 0 && nb == 1)) acc = rw_mm(At, Bt_, mb, nb, lane, acc);
      rw_mask_lower_strict(acc, mb, nb, lane);
      rw_wrT(QTA, mb, nb, lane, acc);
    }
  }
  for (int blk = wid; blk < 12; blk += 8) {
    const int prod = blk >> 2, mb = (blk >> 1) & 1, nb = blk & 1;
    f32x16 acc = zero16();
    if (prod == 0) {
      acc = rw_mm(At, Kt, mb, nb, lane, acc); rw_mask_lower_strict(acc, mb, nb, lane); rw_wrT(Mka, mb, nb, lane, acc);
    } else if (prod == 1) {
      acc = rw_mm(Bt_, Rt, mb, nb, lane, acc); rw_mask_upper(acc, mb, nb, lane, false); rw_wrT(MbrT, mb, nb, lane, acc);
    } else {
      acc = rw_mm(Kt, Rt, mb, nb, lane, acc); rw_mask_upper(acc, mb, nb, lane, false); rw_wrT(MkrT, mb, nb, lane, acc);
    }
  }
  __syncthreads();
#define RW_SQ(Q_, Qt_, Qn_, Qtn_, blk) { const int pr_ = (blk) >> 2, mb_ = ((blk) >> 1) & 1, nb_ = (blk) & 1; f32x16 acc_ = zero16(); \
    if (pr_ == 0) { acc_ = rw_mm(Q_, Qt_, mb_, nb_, lane, acc_); rw_wrT(Qtn_, mb_, nb_, lane, acc_); } \
    else { acc_ = rw_mm(Qt_, Q_, mb_, nb_, lane, acc_); rw_wrT(Qn_, mb_, nb_, lane, acc_); } }
#define RW_GUP(Qt_, G_, Gn_, blk) { const int mb_ = ((blk) >> 1) & 1, nb_ = (blk) & 1; f32x16 acc_ = zero16(); \
    rw_addT(G_, mb_, nb_, lane, acc_); acc_ = rw_mm(Qt_, G_, mb_, nb_, lane, acc_); rw_wrT(Gn_, mb_, nb_, lane, acc_); }
  RW_SQ(QA, QTA, QB, QTB, wid);
  __syncthreads();
  for (int blk = wid; blk < 12; blk += 8) { if (blk < 8) { RW_SQ(QB, QTB, QA, QTA, blk); } else { RW_GUP(QTB, GA, GB, blk - 8); } }
  __syncthreads();
  for (int blk = wid; blk < 12; blk += 8) { if (blk < 8) { RW_SQ(QA, QTA, QB, QTB, blk); } else { RW_GUP(QTA, GB, GA, blk - 8); } }
  __syncthreads();
  for (int blk = wid; blk < 12; blk += 8) { if (blk < 8) { RW_SQ(QB, QTB, QA, QTA, blk); } else { RW_GUP(QTB, GA, GB, blk - 8); } }
  __syncthreads();
  for (int blk = wid; blk < 12; blk += 8) { if (blk < 8) { RW_SQ(QA, QTA, QB, QTB, blk); } else { RW_GUP(QTA, GB, GA, blk - 8); } }
  __syncthreads();
  if (wid < 4) { RW_GUP(QTB, GA, GB, wid); }
  __syncthreads();
  {
    const int prod = wid >> 2, mb = (wid >> 1) & 1, nb = wid & 1;
    f32x16 acc = zero16();
    acc = rw_mm(GB, prod == 0 ? Mka : Aj, mb, nb, lane, acc);
    rw_wrT(prod == 0 ? QA : QTA, mb, nb, lane, acc);
  }
  __syncthreads();
  char* const X1 = QA; char* const X2 = QTA; char* const QpT = At;
  for (int blk = wid; blk < 16; blk += 8) {
    const int prod = blk >> 2, mb = (blk >> 1) & 1, nb = blk & 1;
    f32x16 acc = zero16();
    if (prod == 0) {
      rw_addT(MkrT, mb, nb, lane, acc); acc = rw_mm(X1, MbrT, mb, nb, lane, acc); rw_mask_upper(acc, mb, nb, lane, false);
      rw_wrT_g((bf16_t*)(rec + 8192), mb, nb, lane, acc);
    } else if (prod == 1) {
      rw_addT(Rt, mb, nb, lane, acc); acc = rw_mm(X2, MbrT, mb, nb, lane, acc);
      rw_wrT_g((bf16_t*)(rec), mb, nb, lane, acc);
    } else if (prod == 2) {
      acc = rw_mm(X2, Bj, mb, nb, lane, acc);
      const int col = nb * 32 + (lane & 31), h = lane >> 5; const float gc = gC[col];
#pragma unroll
      for (int i = 0; i < 16; ++i) { if (mb * 32 + crow(i, h) == col) acc[i] += 1.f; acc[i] *= gc; }
      rw_wrT_g((bf16_t*)(rec + 16384), mb, nb, lane, acc);
    } else {
      rw_addT(Kj, mb, nb, lane, acc); acc = rw_mm(X1, Bj, mb, nb, lane, acc);
      const float gc = gC[nb * 32 + (lane & 31)];
#pragma unroll
      for (int i = 0; i < 16; ++i) acc[i] *= gc;
      rw_wrT(QpT, mb, nb, lane, acc);
    }
  }
  __syncthreads();
  if (wid < 4) {
    const int mb = (wid >> 1) & 1, nb = wid & 1, r = lane & 31, h = lane >> 5;
    f32x16 acc = zero16();
    acc = rw_mm(QpT, Vi, mb, nb, lane, acc);
    float* dq = (float*)(rec + 24576);
#pragma unroll
    for (int g = 0; g < 4; ++g)
      *(float4*)(dq + (nb * 32 + r) * 64 + mb * 32 + 8 * g + 4 * h) = make_float4(acc[4 * g], acc[4 * g + 1], acc[4 * g + 2], acc[4 * g + 3]);
  }
}

constexpr int RW2_ITEMS = NSEQ_;
constexpr int RW2_DQLD = 68;
constexpr int RW2_STAGE = RW_MB + 64 * RW2_DQLD * 4;
DI void rw_state_item(const Params& p, int s, char* smem) {
  const int tid = opaque_tid(), lane = tid & 63, wid = tid >> 6, r = lane & 31, h = lane >> 5;
  f32x16 S0 = zero16(), S1 = zero16();
  uint4 rp, rd0, rd1;
  const int prow = tid >> 3, pcol = (tid & 7) * 8;
  const int drow = tid >> 3, dcol = (tid & 7) * 8;
  __syncthreads();
  {
    const char* rec = rw_rec(p, s, 0);
    rp = *(const uint4*)(rec + 16384 + (prow * 64 + pcol) * 2);
    rd0 = *(const uint4*)(rec + 24576 + (drow * 64 + dcol) * 4); rd1 = *(const uint4*)(rec + 24576 + (drow * 64 + dcol + 4) * 4);
    *(uint4*)(smem + (prow * RW_LD + pcol) * 2) = rp;
    *(uint4*)(smem + RW_MB + (drow * RW2_DQLD + dcol) * 4) = rd0; *(uint4*)(smem + RW_MB + (drow * RW2_DQLD + dcol + 4) * 4) = rd1;
  }
  __syncthreads();
  for (int c = 0; c < NCH_; ++c) {
    const bool more = c + 1 < NCH_;
    if (more) {
      const char* rec = rw_rec(p, s, c + 1);
      rp = *(const uint4*)(rec + 16384 + (prow * 64 + pcol) * 2);
      rd0 = *(const uint4*)(rec + 24576 + (drow * 64 + dcol) * 4); rd1 = *(const uint4*)(rec + 24576 + (drow * 64 + dcol + 4) * 4);
    }
    if (wid < 2) {
      const char* PT = smem + (c & 1) * RW2_STAGE;
      const float* DQ = (const float*)(PT + RW_MB);
      const int i = wid * 32 + r;
      bf16_t* sd = (bf16_t*)(rw_rec(p, s, c) + 16384);
#pragma unroll
      for (int g = 0; g < 4; ++g) {
        uint2 o0, o1;
        o0.x = pack2bf(S0[4 * g], S0[4 * g + 1]); o0.y = pack2bf(S0[4 * g + 2], S0[4 * g + 3]);
        o1.x = pack2bf(S1[4 * g], S1[4 * g + 1]); o1.y = pack2bf(S1[4 * g + 2], S1[4 * g + 3]);
        *(uint2*)(sd + i * 64 + 8 * g + 4 * h) = o0; *(uint2*)(sd + i * 64 + 32 + 8 * g + 4 * h) = o1;
      }
      bf16x8 bfr[2][2];
#pragma unroll
      for (int s2 = 0; s2 < 2; ++s2) {
        const uint4 u0 = make_uint4(pack2bf(S0[8 * s2], S0[8 * s2 + 1]), pack2bf(S0[8 * s2 + 2], S0[8 * s2 + 3]), pack2bf(S0[8 * s2 + 4], S0[8 * s2 + 5]), pack2bf(S0[8 * s2 + 6], S0[8 * s2 + 7]));
        const uint4 u1 = make_uint4(pack2bf(S1[8 * s2], S1[8 * s2 + 1]), pack2bf(S1[8 * s2 + 2], S1[8 * s2 + 3]), pack2bf(S1[8 * s2 + 4], S1[8 * s2 + 5]), pack2bf(S1[8 * s2 + 6], S1[8 * s2 + 7]));
        __builtin_memcpy(&bfr[0][s2], &u0, 16); __builtin_memcpy(&bfr[1][s2], &u1, 16);
      }
      f32x16 n0, n1;
#pragma unroll
      for (int g = 0; g < 4; ++g) {
        const float4 a = *(const float4*)(DQ + i * RW2_DQLD + 8 * g + 4 * h), bq = *(const float4*)(DQ + i * RW2_DQLD + 32 + 8 * g + 4 * h);
        n0[4 * g] = a.x; n0[4 * g + 1] = a.y; n0[4 * g + 2] = a.z; n0[4 * g + 3] = a.w;
        n1[4 * g] = bq.x; n1[4 * g + 1] = bq.y; n1[4 * g + 2] = bq.z; n1[4 * g + 3] = bq.w;
      }
#pragma unroll
      for (int jb2 = 0; jb2 < 2; ++jb2)
#pragma unroll
        for (int s2 = 0; s2 < 2; ++s2) {
          const char* a0 = PT + ((0 * 32 + r) * RW_LD + jb2 * 32 + 16 * s2 + 4 * h) * 2;
          const char* a1 = PT + ((1 * 32 + r) * RW_LD + jb2 * 32 + 16 * s2 + 4 * h) * 2;
          const uint2 l0 = *(const uint2*)a0, h0 = *(const uint2*)(a0 + 16), l1 = *(const uint2*)a1, h1 = *(const uint2*)(a1 + 16);
          const uint4 u0 = make_uint4(l0.x, l0.y, h0.x, h0.y), u1 = make_uint4(l1.x, l1.y, h1.x, h1.y);
          bf16x8 af0, af1; __builtin_memcpy(&af0, &u0, 16); __builtin_memcpy(&af1, &u1, 16);
          n0 = mfma32(af0, bfr[jb2][s2], n0);
          n1 = mfma32(af1, bfr[jb2][s2], n1);
        }
      S0 = n0; S1 = n1;
    }
    if (more) {
      char* d = smem + ((c + 1) & 1) * RW2_STAGE;
      *(uint4*)(d + (prow * RW_LD + pcol) * 2) = rp;
      *(uint4*)(d + RW_MB + (drow * RW2_DQLD + dcol) * 4) = rd0; *(uint4*)(d + RW_MB + (drow * RW2_DQLD + dcol + 4) * 4) = rd1;
    }
    __syncthreads();
  }
}

DI void rw_out_item(const Params& p, int it, char* smem) {
  const int s = it / NCH_, c = it % NCH_, dir = s >> 3, b = (s >> 2) & 1, hd = s & 3;
  const int tid = opaque_tid(), lane = tid & 63, wid = tid >> 6;
  const bf16_t* rb = (const bf16_t*)(p.ws + OFF_REGION + R_RB16);
  const size_t AS = (size_t)NT_ * 256;
  float* ys = (float*)(p.ws + OFF_REGION + R_YS) + (size_t)dir * NT_ * 256;
  char* const Sm = smem; char* const RyT = smem + RW_MB; char* const MyT = smem + 2 * RW_MB; char* const Vi = smem + 3 * RW_MB;
  const char* rec = rw_rec(p, s, c);
  __syncthreads();
  {
    const int row = tid >> 3, col = (tid & 7) * 8;
    *(uint4*)(Sm + (row * RW_LD + col) * 2) = *(const uint4*)(rec + 16384 + (row * 64 + col) * 2);
    *(uint4*)(RyT + (row * RW_LD + col) * 2) = *(const uint4*)(rec + (row * 64 + col) * 2);
    *(uint4*)(MyT + (row * RW_LD + col) * 2) = *(const uint4*)(rec + 8192 + (row * 64 + col) * 2);
    const int n = seq_tok(dir, b, c * 64 + row);
    const uint4 uv = *(const uint4*)(rb + 1 * AS + (size_t)n * 256 + hd * 64 + col);
    const unsigned av[4] = {uv.x, uv.y, uv.z, uv.w};
#pragma unroll
    for (int q = 0; q < 4; ++q) {
      *(bf16_t*)(Vi + ((col + 2 * q) * RW_LD + row) * 2) = (bf16_t)(av[q] & 0xffff);
      *(bf16_t*)(Vi + ((col + 2 * q + 1) * RW_LD + row) * 2) = (bf16_t)(av[q] >> 16);
    }
  }
  __syncthreads();
  if (wid < 4) {
    const int mb = (wid >> 1) & 1, nb = wid & 1, r = lane & 31, h = lane >> 5;
    f32x16 acc = zero16();
    acc = rw_mm(Sm, RyT, mb, nb, lane, acc);
    acc = rw_mm(Vi, MyT, mb, nb, lane, acc);
    const int n = seq_tok(dir, b, c * 64 + nb * 32 + r);
#pragma unroll
    for (int g = 0; g < 4; ++g)
      *(float4*)(ys + (size_t)n * 256 + hd * 64 + mb * 32 + 8 * g + 4 * h) = make_float4(acc[4 * g], acc[4 * g + 1], acc[4 * g + 2], acc[4 * g + 3]);
  }
}
constexpr int ATT_KLD = 104, ATT_VLD = 68;
constexpr int ATT_KB = 64 * ATT_KLD * 2, ATT_VB = 64 * ATT_VLD * 2, ATT_STAGE = ATT_KB + ATT_VB;
DI float fexp2(float x) {
#ifdef EMU
  return exp2f(x);
#else
  return __builtin_amdgcn_exp2f(x);
#endif
}
DI void attn_item(const Params& p, int b, int h, int qt, bool isctx, char* smem) {
  const int tid = opaque_tid(), lane = tid & 63, wid = tid >> 6, r = lane & 31, h2 = lane >> 5;
  const bf16_t* qb = (const bf16_t*)(p.osc + O_QB);
  const bf16_t* kbase = (const bf16_t*)(p.ws + OFF_REGION + R_KB) + (size_t)(b * 8 + h) * KT_ * 96;
  const bf16_t* vbase = (const bf16_t*)(p.ws + OFF_REGION + R_VT) + (size_t)(b * 8 + h) * 64 * KT_;
  bf16_t* att = (bf16_t*)(p.ws + OFF_REGION + R_ATT);
  const int nq0 = isctx ? NX_ + b * CL_ + qt * 256 : b * T_ + qt * 256;
  const int nkt = (isctx ? CL_ : KT_) / 64;
  const int nq = nq0 + wid * 32 + r;
  bf16x8 qf[6];
#pragma unroll
  for (int ks = 0; ks < 6; ++ks) qf[ks] = *(const bf16x8*)(qb + (size_t)nq * 768 + h * 96 + ks * 16 + h2 * 8);
  f32x16 oacc[2] = {zero16(), zero16()};
  float m = -1e30f, lsum = 0.f;
  const float sc = 0.10206207261596577f * 1.4426950408889634f;
  const int kc1 = tid + 512;
  const int vd = tid >> 3, vc = tid & 7;
  uint4 rk0, rk1, rv;
  auto gload = [&](int kt) {
    const bf16_t* ksrc = kbase + (size_t)kt * 64 * 96;
    rk0 = *(const uint4*)(ksrc + tid * 8);
    if (kc1 < 768) rk1 = *(const uint4*)(ksrc + kc1 * 8);
    rv = *(const uint4*)(vbase + (size_t)vd * KT_ + kt * 64 + vc * 8);
  };
  auto sstore = [&](int buf) {
    char* Ks = smem + buf * ATT_STAGE; char* Vs = Ks + ATT_KB;
    *(uint4*)(Ks + ((tid / 12) * ATT_KLD + (tid % 12) * 8) * 2) = rk0;
    if (kc1 < 768) *(uint4*)(Ks + ((kc1 / 12) * ATT_KLD + (kc1 % 12) * 8) * 2) = rk1;
    *(uint2*)(Vs + (vd * ATT_VLD + vc * 8) * 2) = make_uint2(rv.x, rv.y);
    *(uint2*)(Vs + (vd * ATT_VLD + vc * 8 + 4) * 2) = make_uint2(rv.z, rv.w);
  };
  __syncthreads();
  gload(0); sstore(0);
  __syncthreads();
  for (int kt = 0; kt < nkt; ++kt) {
    const bool more = kt + 1 < nkt;
    if (more) gload(kt + 1);
    const char* Ks = smem + (kt & 1) * ATT_STAGE; const char* Vs = Ks + ATT_KB;
    f32x16 sacc[2] = {zero16(), zero16()};
#pragma unroll
    for (int ks = 0; ks < 6; ++ks)
#pragma unroll
      for (int kb = 0; kb < 2; ++kb) {
        const bf16x8 kf = *(const bf16x8*)(Ks + ((kb * 32 + r) * ATT_KLD + ks * 16 + h2 * 8) * 2);
        sacc[kb] = mfma32(kf, qf[ks], sacc[kb]);
      }
    float mx = -1e30f;
#pragma unroll
    for (int kb = 0; kb < 2; ++kb)
#pragma unroll
      for (int i = 0; i < 16; ++i) mx = fmaxf(mx, sacc[kb][i]);
    mx = fmaxf(mx, __shfl_xor(mx, 32));
    const float mn = fmaxf(m, mx * sc);
    const float alpha = fexp2(m - mn);
    m = mn;
    float ps = 0.f;
#pragma unroll
    for (int kb = 0; kb < 2; ++kb)
#pragma unroll
      for (int i = 0; i < 16; ++i) { const float pv = fexp2(sacc[kb][i] * sc - mn); sacc[kb][i] = pv; ps += pv; }
    lsum = lsum * alpha + ps;
#pragma unroll
    for (int db = 0; db < 2; ++db)
#pragma unroll
      for (int i = 0; i < 16; ++i) oacc[db][i] *= alpha;
#pragma unroll
    for (int kb = 0; kb < 2; ++kb)
#pragma unroll
      for (int s = 0; s < 2; ++s) {
        bf16x8 pf;
        {
          const unsigned u0 = pack2bf(sacc[kb][8 * s + 0], sacc[kb][8 * s + 1]), u1 = pack2bf(sacc[kb][8 * s + 2], sacc[kb][8 * s + 3]);
          const unsigned u2 = pack2bf(sacc[kb][8 * s + 4], sacc[kb][8 * s + 5]), u3 = pack2bf(sacc[kb][8 * s + 6], sacc[kb][8 * s + 7]);
          const uint4 u = make_uint4(u0, u1, u2, u3);
          __builtin_memcpy(&pf, &u, 16);
        }
#pragma unroll
        for (int db = 0; db < 2; ++db) {
          const char* vrow = Vs + ((db * 32 + r) * ATT_VLD + kb * 32 + 16 * s + 4 * h2) * 2;
          const uint2 lo = *(const uint2*)(vrow), hi = *(const uint2*)(vrow + 16);
          const uint4 u = make_uint4(lo.x, lo.y, hi.x, hi.y);
          bf16x8 vf; __builtin_memcpy(&vf, &u, 16);
          oacc[db] = mfma32(vf, pf, oacc[db]);
        }
      }
    if (more) sstore((kt + 1) & 1);
    __syncthreads();
  }
  lsum += __shfl_xor(lsum, 32);
  const float inv = 1.f / lsum;
#pragma unroll
  for (int db = 0; db < 2; ++db)
#pragma unroll
    for (int g = 0; g < 4; ++g) {
      uint2 o;
      o.x = pack2bf(oacc[db][g * 4 + 0] * inv, oacc[db][g * 4 + 1] * inv);
      o.y = pack2bf(oacc[db][g * 4 + 2] * inv, oacc[db][g * 4 + 3] * inv);
      *(uint2*)(att + (size_t)nq * 512 + h * 64 + db * 32 + 8 * g + 4 * h2) = o;
    }
}

constexpr int P3B_ITEMS = RW1_ITEMS + ML2_ITEMS + MLA_Q_TILES + MLA_KV_TILES;
DI void phase3b(const Params& p, int l, char* smem) {
  for (int it = blockIdx.x; it < P3B_ITEMS; it += gridDim.x) {
    int i = it;
    if (i < RW1_ITEMS) { rw_chunk_item(p, i, smem); continue; }
    i -= RW1_ITEMS;
    if (i < ML2_ITEMS) { mlstm_scan_item(p, i); continue; }
    i -= ML2_ITEMS;
    if (i < MLA_Q_TILES) mla_q_item(p, l, i, smem); else mla_kv_item(p, l, i - MLA_Q_TILES, smem);
  }
}

DI constexpr int att_items(int l) { return NB_ * 8 * (T_ / 256) + (l == 0 ? NB_ * 8 * (CL_ / 256) : 0); }
DI void spin_until_ge(int* ctr, int target) {
#ifdef EMU
  while (__atomic_load_n(ctr, __ATOMIC_SEQ_CST) < target) emu::yield();
#else
  while (__hip_atomic_load(ctr, __ATOMIC_RELAXED, __HIP_MEMORY_SCOPE_AGENT) < target) __builtin_amdgcn_s_sleep(8);
#endif
}
DI void phase4(const Params& p, int l, char* smem, int* ctr) {
  const int G = gridDim.x, nsb = G >= 2 * RW2_ITEMS ? RW2_ITEMS : (G > 1 ? G / 2 : 1);
  if ((int)blockIdx.x < nsb) {
    for (int s = blockIdx.x; s < RW2_ITEMS; s += nsb) rw_state_item(p, s, smem);
#ifndef EMU
    asm volatile("s_waitcnt vmcnt(0)" ::: "memory");
#endif
    __syncthreads();
    if (opaque_tid() == 0) { __threadfence(); atomicAdd(ctr + 2, (RW2_ITEMS - (int)blockIdx.x + nsb - 1) / nsb); }
  }
  const int n_att = att_items(l), total = n_att + RW1_ITEMS;
  int* sitem = (int*)(smem + 160 * 1024 - 16);
  bool r2ok = false;
  for (;;) {
    __syncthreads();
    if (opaque_tid() == 0) *sitem = atomicAdd(ctr, 1);
    __syncthreads();
    int i = *sitem;
    if (i >= total) break;
    if (i >= n_att) {
      if (!r2ok) {
        if (opaque_tid() == 0) { spin_until_ge(ctr + 2, RW2_ITEMS); __threadfence(); }
        __syncthreads();
        r2ok = true;
      }
      rw_out_item(p, i - n_att, smem);
      continue;
    }
    const int nx = NB_ * 8 * (T_ / 256);
    if (i < nx) { const int qt = i % (T_ / 256), bh = i / (T_ / 256); attn_item(p, bh >> 3, bh & 7, qt, false, smem); }
    else { i -= nx; const int qt = i % (CL_ / 256), bh = i / (CL_ / 256); attn_item(p, bh >> 3, bh & 7, qt, true, smem); }
  }
}
constexpr int ML3_CC = CL_ / 64, ML3_XC = T_ / 64;
DI constexpr int ml3_items(bool with_ctx) { return NB_ * 4 * (ML3_XC + (with_ctx ? ML3_CC : 0)); }
DI void mlstm_out_item(const Params& p, int l, int it, bool with_ctx, char* smem) {
  const int per = ML3_XC + (with_ctx ? ML3_CC : 0);
  const int bh = it / per, b = bh >> 2, hd = bh & 3;
  int tc = it % per; if (!with_ctx) tc += ML3_CC;
  const bool isctx = tc < ML3_CC;
  const int ntok0 = isctx ? NX_ + b * CL_ + tc * 64 : b * T_ + (tc - ML3_CC) * 64;
  float* qs = (float*)smem;
  float* ks = qs + 64 * 33;
  float* vs = ks + 64 * 33;
  float* Cs = vs + 64 * 64;
  float* Sm = Cs + 64 * 33;
  float* hs = Sm + 64 * 65;
  float* bj = hs + 64 * 64;
  float* ip = bj + 64;
  float* ns = ip + 64;
  const float* zrec = (const float*)(p.ws + OFF_REGION + R_ZREC);
  const int tid = opaque_tid(), lane = tid & 63, wid = tid >> 6;
  __syncthreads();
  for (int idx = tid; idx < 64 * 64; idx += NTHR) hs[idx] = 0.f;
  for (int dir = 0; dir < 2; ++dir) {
    const int c = dir == 0 ? tc : (isctx ? ML3_CC - 1 - tc : ML3_CC + (ML3_XC - 1 - (tc - ML3_CC)));
    const int s = dir * 8 + b * 4 + hd;
    const float* st = (const float*)(p.ws + OFF_REGION + R_MLST) + ((size_t)s * NCH_ + c) * ML_ST;
    const float m_start = st[2082];
    __syncthreads();
    for (int idx = tid; idx < 64 * 32; idx += NTHR) {
      const int j = idx >> 5, e = idx & 31;
      const int n = ntok0 + (dir ? 63 - j : j);
      qs[j * 33 + e] = zrec[(size_t)n * ZREC_W + ZR_MLQ + hd * 32 + e] * 0.17677669529663687f;
      ks[j * 33 + e] = zrec[(size_t)n * ZREC_W + ZR_MLK + hd * 32 + e];
      Cs[j * 33 + e] = st[j * 32 + e];
    }
    for (int idx = tid; idx < 64 * 64; idx += NTHR) {
      const int j = idx >> 6, e = idx & 63;
      const int n = ntok0 + (dir ? 63 - j : j);
      vs[idx] = zrec[(size_t)n * ZREC_W + ZR_MLV + hd * 64 + e];
    }
    if (tid < 32) ns[tid] = st[2048 + tid];
    if (wid == 1) {
      const int n = ntok0 + (dir ? 63 - lane : lane);
      const float fp = zrec[(size_t)n * ZREC_W + ZR_MLF + dir * 4 + hd] + p.ml_b_f[(l * 2 + dir) * 4 + hd];
      ip[lane] = zrec[(size_t)n * ZREC_W + ZR_MLI + dir * 4 + hd] + p.ml_b_i[(l * 2 + dir) * 4 + hd];
      bj[lane] = wave_incl_scan(logsigmoidf_(fp), lane);
    }
    __syncthreads();
    const int j = tid >> 3, sg = tid & 7;
    const float bjj = bj[j];
    float rmax = -1e30f;
#pragma unroll 1
    for (int u = 0; u < 8; ++u) {
      const int sI = sg * 8 + u;
      float d = 0.f;
#pragma unroll 8
      for (int e = 0; e < 32; ++e) d += qs[j * 33 + e] * ks[sI * 33 + e];
      Sm[j * 65 + sI] = d;
      const float dl = sI <= j ? bjj - bj[sI] + ip[sI] : -1e30f;
      rmax = fmaxf(rmax, dl);
    }
    rmax = fmaxf(rmax, __shfl_xor(rmax, 1)); rmax = fmaxf(rmax, __shfl_xor(rmax, 2)); rmax = fmaxf(rmax, __shfl_xor(rmax, 4));
    const float g = bjj + m_start;
    const float mj = fmaxf(g, rmax);
    const float inter = fexp(g - mj);
    float part = 0.f;
#pragma unroll 1
    for (int u = 0; u < 8; ++u) {
      const int sI = sg * 8 + u;
      const float sv = sI <= j ? fexp(bjj - bj[sI] + ip[sI] - mj) * Sm[j * 65 + sI] : 0.f;
      Sm[j * 65 + sI] = sv; part += sv;
    }
    float nq = 0.f;
#pragma unroll
    for (int e = 0; e < 4; ++e) nq += ns[sg * 4 + e] * qs[j * 33 + sg * 4 + e];
    part += inter * nq;
    part += __shfl_xor(part, 1); part += __shfl_xor(part, 2); part += __shfl_xor(part, 4);
    const float den = fmaxf(fabsf(part), fexp(-mj));
    __syncthreads();
    const int v0 = sg * 8;
    float num[8], cq[8];
#pragma unroll
    for (int u = 0; u < 8; ++u) { num[u] = 0.f; cq[u] = 0.f; }
#pragma unroll 2
    for (int sI = 0; sI <= j; ++sI) {
      const float sv = Sm[j * 65 + sI];
      const float4 va = *(const float4*)(vs + sI * 64 + v0), vb = *(const float4*)(vs + sI * 64 + v0 + 4);
      num[0] += sv * va.x; num[1] += sv * va.y; num[2] += sv * va.z; num[3] += sv * va.w;
      num[4] += sv * vb.x; num[5] += sv * vb.y; num[6] += sv * vb.z; num[7] += sv * vb.w;
    }
#pragma unroll 2
    for (int e = 0; e < 32; ++e) {
      const float qv = qs[j * 33 + e];
#pragma unroll
      for (int u = 0; u < 8; ++u) cq[u] += Cs[(v0 + u) * 33 + e] * qv;
    }
    const float rden = 1.f / den;
#pragma unroll
    for (int u = 0; u < 8; ++u) hs[(dir ? 63 - j : j) * 64 + v0 + u] += (num[u] + inter * cq[u]) * rden;
    __syncthreads();
  }
  const int tk = tid >> 3, v0 = (tid & 7) * 8, n = ntok0 + tk;
  float ss = 0.f; float hv[8];
#pragma unroll
  for (int u = 0; u < 8; ++u) { hv[u] = hs[tk * 64 + v0 + u]; ss += hv[u] * hv[u]; }
  ss += __shfl_xor(ss, 1); ss += __shfl_xor(ss, 2); ss += __shfl_xor(ss, 4);
  const float rs = 1.0f / sqrtf(ss * (1.f / 64.f) + 1e-6f);
  unsigned o[4];
#pragma unroll
  for (int u = 0; u < 8; u += 2) {
    const int cc = hd * 64 + v0 + u;
    const float a = hv[u] * rs * p.ml_g_norm[l * 256 + cc] * sigmoidf_(zrec[(size_t)n * ZREC_W + ZR_MLO + cc]);
    const float bq = hv[u + 1] * rs * p.ml_g_norm[l * 256 + cc + 1] * sigmoidf_(zrec[(size_t)n * ZREC_W + ZR_MLO + cc + 1]);
    o[u >> 1] = pack2bf(a, bq);
  }
  bf16_t* mlo = (bf16_t*)(p.ws + OFF_REGION + R_MLO);
  *(uint4*)(mlo + (size_t)n * 256 + hd * 64 + v0) = make_uint4(o[0], o[1], o[2], o[3]);
}

DI constexpr int rwo_items(bool with_ctx) { return (with_ctx ? NT_ : NX_) / 16; }
DI void rwkv_out_item(const Params& p, int l, int it, char* smem) {
  float* sg = (float*)smem;
  const float* zrec = (const float*)(p.ws + OFF_REGION + R_ZREC);
  const bf16_t* rb = (const bf16_t*)(p.ws + OFF_REGION + R_RB16);
  const float* bso = (const float*)(p.ws + OFF_REGION + R_BS);
  const float* ys = (const float*)(p.ws + OFF_REGION + R_YS);
  bf16_t* rwo = (bf16_t*)(p.ws + OFF_REGION + R_RWO);
  const float* mu = p.rw_mu + (size_t)l * 1152;
  const int tid = opaque_tid(), n0 = it * 16;
  __syncthreads();
  for (int idx = tid; idx < 16 * 128; idx += NTHR) {
    const int tt = idx >> 7, k = idx & 127, n = n0 + tt, t = tok_t(n), c = 1024 + k;
    const int len = n < NX_ ? T_ : CL_;
    const float* zr = zrec + (size_t)n * ZREC_W + ZR_RW + c;
    const float z = zr[0];
    const float zp = t > 0 ? zr[-ZREC_W] : 0.f, zn = t < len - 1 ? zr[ZREC_W] : 0.f;
    sg[k * 16 + tt] = sigmoidf_(z + (0.5f * (zp + zn) - z) * mu[c]);
  }
  __syncthreads();
  const int col = tid & 255, half = tid >> 8;
  float acc[8];
#pragma unroll
  for (int i = 0; i < 8; ++i) acc[i] = 0.f;
  const float* g2 = p.rw_g2 + (size_t)l * 128 * 256 + col;
  for (int k = 0; k < 128; ++k) {
    const float gv = g2[k * 256];
    const float* sk = sg + k * 16 + half * 8;
#pragma unroll
    for (int i = 0; i < 8; ++i) acc[i] += sk[i] * gv;
  }
  const size_t AS = (size_t)NT_ * 256;
  const float lw = p.rw_lnx_w[(size_t)l * 256 + col], lb = p.rw_lnx_b[(size_t)l * 256 + col];
#pragma unroll
  for (int i = 0; i < 8; ++i) {
    const int n = n0 + half * 8 + i;
    const size_t o = (size_t)n * 256 + col;
    const float y = ys[o] + ys[AS + o];
    const float mean = wave_sum(y) * (1.f / 64.f);
    const float dv = y - mean;
    const float var = wave_sum(dv * dv) * (1.f / 64.f);
    const float yn = dv * (1.0f / sqrtf(var + 64e-5f)) * lw + lb;
    const float v = bf2f(rb[1 * AS + o]);
    const float bsum = bso[(size_t)n * 4 + (col >> 6)] + bso[((size_t)NT_ + n) * 4 + (col >> 6)];
    rwo[o] = f2bf((yn + bsum * v) * acc[i]);
  }
}
DI void phase5(const Params& p, int l, bool with_ctx, char* smem) {
  const int n1 = ml3_items(with_ctx), n2 = rwo_items(with_ctx);
  for (int it = blockIdx.x; it < n1 + n2; it += gridDim.x) {
    if (it < n1) mlstm_out_item(p, l, it, with_ctx, smem);
    else rwkv_out_item(p, l, it - n1, smem);
  }
}
DI void phase_merge(const Params& p, int l, bool with_ctx, char* smem) {
  const bf16_t* H = (const bf16_t*)(p.ws + OFF_H);
  const char* W = p.ws + OFF_WMIX + (size_t)l * WM_SIZE;
  const bf16_t* Wg = (const bf16_t*)(W + WM_GATE);
  const bf16_t* att = (const bf16_t*)(p.ws + OFF_REGION + R_ATT);
  const bf16_t* mlo = (const bf16_t*)(p.ws + OFF_REGION + R_MLO);
  const bf16_t* rwo = (const bf16_t*)(p.ws + OFF_REGION + R_RWO);
  bf16_t* ymix = (bf16_t*)(p.osc + O_YMIX);
  const int TM = (with_ctx ? NT_ : NX_) / 128;
  for (int it = blockIdx.x; it < TM * 8; it += gridDim.x) {
    const int tid = opaque_tid();
    const int tm = it >> 3, tn = it & 7;
    f32x16 yacc[G128::MB][G128::NB];
#pragma unroll
    for (int a = 0; a < G128::MB; ++a)
#pragma unroll
      for (int b = 0; b < G128::NB; ++b) yacc[a][b] = zero16();
#pragma unroll
    for (int i = 0; i < 3; ++i) {
      f32x16 gacc[G128::MB][G128::NB], bacc[G128::MB][G128::NB];
#pragma unroll
      for (int a = 0; a < G128::MB; ++a)
#pragma unroll
        for (int b = 0; b < G128::NB; ++b) { gacc[a][b] = zero16(); bacc[a][b] = zero16(); }
      const bf16_t* A0 = H + (size_t)tm * 128 * 1024;
      G128::run(gacc, [&](int r) { return A0 + (size_t)r * 1024; }, Wg + ((size_t)i * 1024 + tn * 128) * 1024, 1024, 1024, smem);
      const bf16_t* br = i == 0 ? att : (i == 1 ? mlo : rwo);
      const int kb = i == 0 ? 512 : 256;
      const bf16_t* Wb = (const bf16_t*)(W + (i == 0 ? WM_BRA : (i == 1 ? WM_BRM : WM_BRR)));
      const bf16_t* B0 = br + (size_t)tm * 128 * kb;
      G128::run(bacc, [&](int r) { return B0 + (size_t)r * kb; }, Wb + (size_t)tn * 128 * kb, kb, kb, smem);
#pragma unroll
      for (int a = 0; a < G128::MB; ++a)
#pragma unroll
        for (int b = 0; b < G128::NB; ++b)
#pragma unroll
          for (int e = 0; e < 16; ++e) yacc[a][b][e] += sigmoidf_(gacc[a][b][e]) * bacc[a][b][e];
    }
#pragma unroll
    for (int mb = 0; mb < G128::MB; ++mb)
#pragma unroll
      for (int nb = 0; nb < G128::NB; ++nb) {
        const int col = tn * 128 + G128::col_of(tid, nb);
#pragma unroll
        for (int e = 0; e < 16; ++e) ymix[(size_t)(tm * 128 + G128::row_of(tid, mb, e)) * 1024 + col] = f2bf(yacc[mb][nb][e]);
      }
  }
}

DI void phase_wout(const Params& p, int l, bool with_ctx, char* smem) {
  const bf16_t* ymix = (const bf16_t*)(p.osc + O_YMIX);
  const bf16_t* Wo = (const bf16_t*)(p.ws + OFF_WMIX + (size_t)l * WM_SIZE + WM_OUT);
  float* xs = (float*)(p.ws + OFF_XS);
  const float* mod = (const float*)(p.ws + OFF_MOD) + (size_t)l * 3 * 6144;
  const int TM = (with_ctx ? NT_ : NX_) / 128;
  const int n_g = TM * 8;
  for (int it = blockIdx.x; it < n_g + CVT_MOE_TILES; it += gridDim.x) {
    if (it >= n_g) { cvt_moe_item(p, l, it - n_g, smem); continue; }
    const int tid = opaque_tid();
    const int tm = it >> 3, tn = it & 7;
    f32x16 acc[G128::MB][G128::NB];
#pragma unroll
    for (int a = 0; a < G128::MB; ++a)
#pragma unroll
      for (int b = 0; b < G128::NB; ++b) acc[a][b] = zero16();
    const bf16_t* A0 = ymix + (size_t)tm * 128 * 1024;
    G128::run(acc, [&](int r) { return A0 + (size_t)r * 1024; }, Wo + (size_t)tn * 128 * 1024, 1024, 1024, smem);
    const float* m2 = mod + (size_t)tok_modrow(tm * 128) * 6144 + 2 * 1024;
#pragma unroll
    for (int mb = 0; mb < G128::MB; ++mb)
#pragma unroll
      for (int nb = 0; nb < G128::NB; ++nb) {
        const int col = tn * 128 + G128::col_of(tid, nb);
        const float g = m2[col];
#pragma unroll
        for (int e = 0; e < 16; ++e) {
          float* d = xs + (size_t)(tm * 128 + G128::row_of(tid, mb, e)) * 1024 + col;
          *d = *d + g * acc[mb][nb][e];
        }
      }
  }
}

typedef Gemm<128, 64, 64, 4, 2> GRT;
DI void phase_router(const Params& p, int l, bool with_ctx, char* smem, int* cnt) {
  float* xs = (float*)(p.ws + OFF_XS);
  bf16_t* H = (bf16_t*)(p.ws + OFF_H);
  const float* mod = (const float*)(p.ws + OFF_MOD) + (size_t)l * 3 * 6144;
  const bf16_t* Wr = (const bf16_t*)(p.ws + OFF_WMIX + (size_t)l * WM_SIZE + WM_RT);
  int* eidx = (int*)(p.ws + OFF_REGION + R_EIDX);
  float* ewt = (float*)(p.ws + OFF_REGION + R_EWT);
  int* erank = (int*)(p.ws + OFF_REGION + R_ERANK);
  int* elist = (int*)(p.ws + OFF_REGION + R_ELIST);
  float* sc = (float*)(smem + GRT::SMEM);
  float* bs = sc + 128 * 65;
  float* gs = bs + 128 * 65;
  const int tid = opaque_tid(), lane = tid & 63, wid = tid >> 6;
  const int ntok = with_ctx ? NT_ : NX_;
  for (int it = blockIdx.x; it < ntok / 128; it += gridDim.x) {
    const int n0 = it * 128;
    __syncthreads();
    for (int rr = 0; rr < 16; ++rr) {
      const int n = n0 + wid * 16 + rr;
      float v[16];
#pragma unroll
      for (int j = 0; j < 4; ++j) {
        const float4 t = *(const float4*)(xs + (size_t)n * 1024 + (j * 64 + lane) * 4);
        v[j * 4] = t.x; v[j * 4 + 1] = t.y; v[j * 4 + 2] = t.z; v[j * 4 + 3] = t.w;
      }
      const float* m = mod + (size_t)tok_modrow(n) * 6144;
      row_norm_mod(v, p.g_ffn + (size_t)l * 1024, m + 3 * 1024, m + 4 * 1024, H + (size_t)n * 1024, lane);
    }
    __syncthreads();
    f32x16 acc[1][1]; acc[0][0] = zero16();
    const bf16_t* A0 = H + (size_t)n0 * 1024;
    GRT::run(acc, [&](int r) { return A0 + (size_t)r * 1024; }, Wr, 1024, 1024, smem);
    {
      const int col = GRT::col_of(tid, 0);
      const float rb = p.router_bias[l * 64 + col];
#pragma unroll
      for (int e = 0; e < 16; ++e) {
        const int row = GRT::row_of(tid, 0, e);
        const float s = sigmoidf_(acc[0][0][e]);
        sc[row * 65 + col] = s; bs[row * 65 + col] = s + rb;
      }
    }
    __syncthreads();
    if (tid < 128) {
      const int n = n0 + tid;
      float* b = bs + tid * 65; const float* s = sc + tid * 65; float* g = gs + tid * 9;
      for (int gi = 0; gi < 8; ++gi) {
        float m1 = -1e30f, m2 = -1e30f;
        for (int j = 0; j < 8; ++j) { const float x = b[gi * 8 + j]; if (x > m1) { m2 = m1; m1 = x; } else if (x > m2) m2 = x; }
        g[gi] = m1 + m2;
      }
      unsigned gmask = 0;
      for (int c = 0; c < 4; ++c) {
        int best = 0; float bv = -1e30f;
        for (int gi = 0; gi < 8; ++gi) if (!((gmask >> gi) & 1) && g[gi] > bv) { bv = g[gi]; best = gi; }
        gmask |= 1u << best;
      }
      for (int gi = 0; gi < 8; ++gi) if (!((gmask >> gi) & 1)) for (int j = 0; j < 8; ++j) b[gi * 8 + j] = -1e30f;
      int sel[8]; float wsum = 0.f;
#pragma unroll
      for (int c = 0; c < 8; ++c) {
        int best = 0; float bv = -1e30f;
        for (int e = 0; e < 64; ++e) { const float x = b[e]; if (x > bv) { bv = x; best = e; } }
        b[best] = -3e30f; sel[c] = best; wsum += s[best];
      }
      const float inv = 2.5f / (wsum + 1e-20f);
#pragma unroll
      for (int c = 0; c < 8; ++c) {
        const int e = sel[c];
        const int rk = atomicAdd(cnt + e, 1);
        eidx[n * 8 + c] = e; ewt[n * 8 + c] = s[e] * inv; erank[n * 8 + c] = rk;
        elist[(size_t)e * NT_ + rk] = n * 8 + c;
      }
    }
  }
}

typedef Gemm<128, 256, 32, 2, 4> GMOE;
constexpr int ACT_LD = 264;
constexpr int MOE_ACT_OFF = GMOE::SMEM;
constexpr int MOE_INFO_OFF = MOE_ACT_OFF + 128 * ACT_LD * 2;
static_assert(MOE_INFO_OFF + 128 * 8 + 67 * 4 * 2 <= 160 * 1024 - 16, "moe lds");
DI void moe_down_run(f32x16 (&acc)[GMOE::MB][GMOE::NB], const char* actl, const bf16_t* Bt, char* smem) {
  constexpr int BK = 32, LDA = GMOE::LDA, CPR = 4, BCH = GMOE::BCH, STG = GMOE::B_BYTES;
  const int tid = opaque_tid(), lane = tid & 63, wid = tid >> 6, wm = wid / 4, wn = wid % 4;
  const int kc = (tid % CPR) * 8, r0 = tid / CPR;
  uint4 rb[BCH];
  char* Bs0 = smem;
#pragma unroll
  for (int i = 0; i < BCH; ++i) rb[i] = *(const uint4*)(Bt + (size_t)(r0 + i * 128) * 256 + kc);
#pragma unroll
  for (int i = 0; i < BCH; ++i) *(uint4*)(Bs0 + ((r0 + i * 128) * LDA + kc) * 2) = rb[i];
  __syncthreads();
  for (int kt = 0; kt < 256 / BK; ++kt) {
    const bool more = kt + 1 < 256 / BK;
    if (more) {
#pragma unroll
      for (int i = 0; i < BCH; ++i) rb[i] = *(const uint4*)(Bt + (size_t)(r0 + i * 128) * 256 + (kt + 1) * BK + kc);
    }
    const char* Bs = Bs0 + (kt & 1) * STG;
#pragma unroll
    for (int ks = 0; ks < BK / 16; ++ks) {
      bf16x8 af[GMOE::MB], bfr[GMOE::NB];
#pragma unroll
      for (int mb = 0; mb < GMOE::MB; ++mb)
        af[mb] = *(const bf16x8*)(actl + ((wm * 64 + mb * 32 + (lane & 31)) * ACT_LD + kt * BK + ks * 16 + (lane >> 5) * 8) * 2);
#pragma unroll
      for (int nb = 0; nb < GMOE::NB; ++nb)
        bfr[nb] = *(const bf16x8*)(Bs + ((wn * 64 + nb * 32 + (lane & 31)) * LDA + ks * 16 + (lane >> 5) * 8) * 2);
#pragma unroll
      for (int mb = 0; mb < GMOE::MB; ++mb)
#pragma unroll
        for (int nb = 0; nb < GMOE::NB; ++nb) acc[mb][nb] = mfma32(af[mb], bfr[nb], acc[mb][nb]);
    }
    if (more) {
      char* Bd = Bs0 + ((kt + 1) & 1) * STG;
#pragma unroll
      for (int i = 0; i < BCH; ++i) *(uint4*)(Bd + ((r0 + i * 128) * LDA + kc) * 2) = rb[i];
    }
    __syncthreads();
  }
}
DI void phase_moe(const Params& p, int l, bool with_ctx, char* smem, const int* cnt) {
  const bf16_t* H = (const bf16_t*)(p.ws + OFF_H);
  const bf16_t* GU = (const bf16_t*)(p.ws + OFF_REGION + R_WMOE + WE_GU);
  const bf16_t* DN = (const bf16_t*)(p.ws + OFF_REGION + R_WMOE + WE_DN);
  const float* ewt = (const float*)(p.ws + OFF_REGION + R_EWT);
  const int* elist = (const int*)(p.ws + OFF_REGION + R_ELIST);
  bf16_t* ybuf = (bf16_t*)(p.ws + OFF_REGION + R_YBUF);
  char* actl = smem + MOE_ACT_OFF;
  int* rtok = (int*)(smem + MOE_INFO_OFF);
  float* rwt = (float*)(rtok + 128);
  int* pre = (int*)(rwt + 128);
  int* off = pre + 67;
  int tid = threadIdx.x;
  const int ntok = with_ctx ? NT_ : NX_;
  __syncthreads();
  if (tid == 0) {
    int a = 0, o = 0;
    for (int e = 0; e < 65; ++e) { const int c = e < 64 ? cnt[e] : ntok; pre[e] = a; off[e] = o; a += (c + 127) >> 7; o += c; }
    pre[65] = a; off[65] = o;
  }
  __syncthreads();
  const int total = pre[65];
  for (int it = blockIdx.x; it < total; it += gridDim.x) {
    tid = opaque_tid();
    int e0 = 0;
    while (pre[e0 + 1] <= it) ++e0;
    const int e = rfl(e0);
    const int rb = rfl(it - pre[e]);
    const int c = rfl(e < 64 ? cnt[e] : ntok);
    const int obase = rfl(off[e] + rb * 128);
    __syncthreads();
    if (tid < 128) {
      const int slot = rb * 128 + tid;
      int tok = 0; float w = 0.f;
      if (slot < c) {
        if (e < 64) { const int pk = elist[(size_t)e * NT_ + slot]; tok = pk >> 3; w = ewt[pk]; }
        else { tok = slot; w = 1.f; }
      }
      rtok[tid] = tok; rwt[tid] = w;
    }
    __syncthreads();
    const bf16_t* Wgu = GU + (size_t)e * 512 * 1024;
#pragma unroll 1
    for (int hf = 0; hf < 2; ++hf) {
      f32x16 acc[GMOE::MB][GMOE::NB];
#pragma unroll
      for (int a = 0; a < GMOE::MB; ++a)
#pragma unroll
        for (int b = 0; b < GMOE::NB; ++b) acc[a][b] = zero16();
      GMOE::run(acc, [&](int r) { return H + (size_t)rtok[r] * 1024; }, Wgu + (size_t)hf * 256 * 1024, 1024, 1024, smem);
      const int lane = tid & 63, wn = (tid >> 6) % 4, wmr = ((tid >> 6) / 4) * 64 + 4 * (lane >> 5);
      const int j = (hf * 4 + wn) * 32 + (lane & 31);
#pragma unroll
      for (int mb = 0; mb < GMOE::MB; ++mb)
#pragma unroll
        for (int i = 0; i < 16; ++i) {
          const int row = wmr + mb * 32 + (i & 3) + 8 * (i >> 2);
          const float g = acc[mb][0][i], u = acc[mb][1][i];
          *(bf16_t*)(actl + (row * ACT_LD + j) * 2) = f2bf(siluf_(g) * u);
        }
    }
    __syncthreads();
    const bf16_t* Wd = DN + (size_t)e * 1024 * 256;
#pragma unroll 1
    for (int nt = 0; nt < 4; ++nt) {
      f32x16 acc[GMOE::MB][GMOE::NB];
#pragma unroll
      for (int a = 0; a < GMOE::MB; ++a)
#pragma unroll
        for (int b = 0; b < GMOE::NB; ++b) acc[a][b] = zero16();
      moe_down_run(acc, actl, Wd + (size_t)nt * 256 * 256, smem);
#pragma unroll
      for (int mb = 0; mb < GMOE::MB; ++mb)
#pragma unroll
        for (int nb = 0; nb < GMOE::NB; ++nb) {
          const int col = nt * 256 + ((tid >> 6) % 4) * 64 + nb * 32 + (tid & 31);
#pragma unroll
          for (int i = 0; i < 16; ++i) {
            const int row = ((tid >> 6) / 4) * 64 + 4 * ((tid & 63) >> 5) + mb * 32 + (i & 3) + 8 * (i >> 2);
            if (rb * 128 + row < c) (ybuf + (size_t)obase * 1024)[(unsigned)(row * 1024 + col)] = f2bf(acc[mb][nb][i] * rwt[row]);
          }
        }
    }
  }
}

DI void phase_combine(const Params& p, int l, bool last, char* smem, const int* cnt) {
  float* xs = (float*)(p.ws + OFF_XS);
  bf16_t* H = (bf16_t*)(p.ws + OFF_H);
  const float* mod = (const float*)(p.ws + OFF_MOD);
  const int* eidx = (const int*)(p.ws + OFF_REGION + R_EIDX);
  const int* erank = (const int*)(p.ws + OFF_REGION + R_ERANK);
  const bf16_t* ybuf = (const bf16_t*)(p.ws + OFF_REGION + R_YBUF);
  int* off = (int*)smem;
  const int tid = opaque_tid(), lane = tid & 63, wid = tid >> 6;
  const int ntok = last ? NX_ : NT_;
  __syncthreads();
  if (tid == 0) { int o = 0; for (int e = 0; e < 64; ++e) { off[e] = o; o += cnt[e]; } off[64] = o; }
  __syncthreads();
  for (int n = blockIdx.x * 8 + wid; n < ntok; n += gridDim.x * 8) {
    float acc[16];
#pragma unroll
    for (int i = 0; i < 16; ++i) acc[i] = 0.f;
    for (int k = 0; k < 9; ++k) {
      const int row = k < 8 ? off[eidx[n * 8 + k]] + erank[n * 8 + k] : off[64] + n;
      const bf16_t* y = ybuf + (size_t)row * 1024;
#pragma unroll
      for (int j = 0; j < 4; ++j) {
        const uint2 u = *(const uint2*)(y + (j * 64 + lane) * 4);
        acc[j * 4 + 0] += bf2f((bf16_t)(u.x & 0xffff)); acc[j * 4 + 1] += bf2f((bf16_t)(u.x >> 16));
        acc[j * 4 + 2] += bf2f((bf16_t)(u.y & 0xffff)); acc[j * 4 + 3] += bf2f((bf16_t)(u.y >> 16));
      }
    }
    const float* m5 = mod + ((size_t)l * 3 + tok_modrow(n)) * 6144 + 5 * 1024;
    float v[16];
#pragma unroll
    for (int j = 0; j < 4; ++j) {
      const int c = (j * 64 + lane) * 4;
      const float4 x = *(const float4*)(xs + (size_t)n * 1024 + c), g = *(const float4*)(m5 + c);
      v[j * 4 + 0] = x.x + g.x * acc[j * 4 + 0]; v[j * 4 + 1] = x.y + g.y * acc[j * 4 + 1];
      v[j * 4 + 2] = x.z + g.z * acc[j * 4 + 2]; v[j * 4 + 3] = x.w + g.w * acc[j * 4 + 3];
      if (!last) *(float4*)(xs + (size_t)n * 1024 + c) = make_float4(v[j * 4], v[j * 4 + 1], v[j * 4 + 2], v[j * 4 + 3]);
    }
    if (!last) {
      const float* m = mod + ((size_t)(l + 1) * 3 + tok_modrow(n)) * 6144;
      row_norm_mod(v, p.g_mix + (size_t)(l + 1) * 1024, m, m + 1024, H + (size_t)n * 1024, lane);
    } else {
      float ss = 0.f;
#pragma unroll
      for (int i = 0; i < 16; ++i) ss += v[i] * v[i];
      ss = wave_sum(ss);
      const float rs = 1.0f / sqrtf(ss * (1.f / 1024.f) + 1e-6f);
#pragma unroll
      for (int j = 0; j < 4; ++j) {
        const int c = (j * 64 + lane) * 4;
        const float4 g = *(const float4*)(p.g_final + c);
        *(float4*)(p.out + (size_t)n * 1024 + c) = make_float4(v[j * 4] * rs * g.x, v[j * 4 + 1] * rs * g.y, v[j * 4 + 2] * rs * g.z, v[j * 4 + 3] * rs * g.w);
      }
    }
  }
}
#define SMEM_BYTES (160 * 1024)
#ifndef MEGA
#define MEGA 0
#endif
DI int* cnt_ptr(const Params& p, int l) { return (int*)(p.ws + OFF_CNT) + 64 * l; }
DI int* ctr_ptr(const Params& p, int l) { return (int*)(p.ws + OFF_CNT) + 128 + 4 * l; }
#if !MEGA
__global__ void __launch_bounds__(NTHR) k_phaseA(Params p) { SMEM_DECL(smem, SMEM_BYTES); phaseA(p, smem); }
__global__ void __launch_bounds__(NTHR) k_norm0(Params p) { phase_norm0(p); }
__global__ void __launch_bounds__(NTHR) k_win(Params p, int l) { SMEM_DECL(smem, SMEM_BYTES); phase_win(p, l, smem); }
__global__ void __launch_bounds__(NTHR) k_p3(Params p, int l) { SMEM_DECL(smem, SMEM_BYTES); phase3(p, l, smem); }
__global__ void __launch_bounds__(NTHR) k_p3b(Params p, int l) { SMEM_DECL(smem, SMEM_BYTES); phase3b(p, l, smem); }
__global__ void __launch_bounds__(NTHR) k_p4(Params p, int l) { SMEM_DECL(smem, SMEM_BYTES); phase4(p, l, smem, ctr_ptr(p, l)); }
__global__ void __launch_bounds__(NTHR) k_p5(Params p, int l, int wc) { SMEM_DECL(smem, SMEM_BYTES); phase5(p, l, wc != 0, smem); }
__global__ void __launch_bounds__(NTHR) k_merge(Params p, int l, int wc) { SMEM_DECL(smem, SMEM_BYTES); phase_merge(p, l, wc != 0, smem); }
__global__ void __launch_bounds__(NTHR) k_wout(Params p, int l, int wc) { SMEM_DECL(smem, SMEM_BYTES); phase_wout(p, l, wc != 0, smem); }
__global__ void __launch_bounds__(NTHR) k_router(Params p, int l, int wc) { SMEM_DECL(smem, SMEM_BYTES); phase_router(p, l, wc != 0, smem, cnt_ptr(p, l)); }
__global__ void __launch_bounds__(NTHR) k_moe(Params p, int l, int wc) { SMEM_DECL(smem, SMEM_BYTES); phase_moe(p, l, wc != 0, smem, cnt_ptr(p, l)); }
__global__ void __launch_bounds__(NTHR) k_combine(Params p, int l, int last) { SMEM_DECL(smem, SMEM_BYTES); phase_combine(p, l, last != 0, smem, cnt_ptr(p, l)); }
#else
#ifndef EMU
#define XB_TMO      128
#define XB_XCNT(j)  (256  + 64 * (j))
#define XB_XSUB(j)  (1280 + 64 * (j))
#define XB_XGEN(j)  (2304 + 64 * (j))
#define XB_TOP      3328
#define XB_TOPGEN   3392
#define XCD_BAR_WORDS 3456
#define XB_SPIN_CAP (1u << 24)
#define LAS __attribute__((address_space(3)))
DI unsigned xb_ld(unsigned* p) { return __hip_atomic_load(p, __ATOMIC_RELAXED, __HIP_MEMORY_SCOPE_AGENT); }
DI unsigned xb_add(unsigned* p, unsigned v) { return __hip_atomic_fetch_add(p, v, __ATOMIC_RELAXED, __HIP_MEMORY_SCOPE_AGENT); }
DI unsigned xb_xcc_id() { return (unsigned)__builtin_amdgcn_s_getreg((3 << 11) | 20) & 0xFu; }
#define XB_SPIN(cond, bar) do { unsigned _sp = 0; while (cond) { __builtin_amdgcn_s_sleep(1); \
    if ((++_sp & 255u) == 0u) { if (xb_ld(&(bar)[XB_TMO])) break; if (_sp > XB_SPIN_CAP) { atomicAdd(&(bar)[XB_TMO], 1u); break; } } } } while (0)
struct XcdBarrier { unsigned* bar; unsigned x; volatile LAS unsigned* st; };
DI XcdBarrier xcd_barrier_post(unsigned* bar, volatile LAS unsigned* st) {
  XcdBarrier b; b.bar = bar; b.x = xb_xcc_id(); b.st = st;
  if (threadIdx.x == 0) (void)xb_add(&bar[XB_XCNT(b.x)], 1u);
  return b;
}
DI void xcd_barrier_complete(unsigned* bar, unsigned x, unsigned& nloc, unsigned& nx) {
  const unsigned G = gridDim.x * gridDim.y * gridDim.z;
  unsigned sum, cnt, mine, sp = 0u;
  for (;;) {
    sum = 0u; cnt = 0u; mine = 0u;
#pragma unroll
    for (unsigned j = 0; j < 16; ++j) { const unsigned c = xb_ld(&bar[XB_XCNT(j)]); sum += c; cnt += (c > 0u) ? 1u : 0u; mine = (j == x) ? c : mine; }
    if (sum == G) break;
    __builtin_amdgcn_s_sleep(1);
    if ((++sp & 255u) == 0u) { if (xb_ld(&bar[XB_TMO])) break; if (sp > XB_SPIN_CAP) { atomicAdd(&bar[XB_TMO], 1u); break; } }
  }
  nloc = mine > 0u ? mine : 1u; nx = cnt > 0u ? cnt : 1u;
}
DI void xcd_barrier(const XcdBarrier& b) {
  asm volatile("s_waitcnt vmcnt(0)" ::: "memory");
  __syncthreads();
  if (threadIdx.x == 0) {
    unsigned* bar = b.bar;
    __builtin_amdgcn_s_waitcnt(0);
    unsigned nloc = b.st[0], nx = b.st[1];
    if (nloc == 0u) { xcd_barrier_complete(bar, b.x, nloc, nx); b.st[0] = nloc; b.st[1] = nx; }
    const unsigned old = xb_add(&bar[XB_XSUB(b.x)], 1u);
    const unsigned gen = old / nloc;
    if (old + 1u == (gen + 1u) * nloc) {
      __builtin_amdgcn_fence(__ATOMIC_RELEASE, "agent");
      asm volatile("s_waitcnt vmcnt(0)" ::: "memory");
      const unsigned og = xb_add(&bar[XB_TOP], 1u);
      const unsigned tg = og / nx;
      if (og + 1u == (tg + 1u) * nx) xb_add(&bar[XB_TOPGEN], 1u);
      else XB_SPIN(xb_ld(&bar[XB_TOPGEN]) == tg, bar);
      __builtin_amdgcn_fence(__ATOMIC_ACQUIRE, "agent");
      xb_add(&bar[XB_XGEN(b.x)], 1u);
      asm volatile("s_waitcnt vmcnt(0)" ::: "memory");
    } else {
      XB_SPIN(xb_ld(&bar[XB_XGEN(b.x)]) == gen, bar);
      __builtin_amdgcn_fence(__ATOMIC_ACQUIRE, "agent");
      asm volatile("s_waitcnt vmcnt(0)" ::: "memory");
    }
  }
  __syncthreads();
}
#define GSYNC() xcd_barrier(xb)
#else
#define GSYNC() emu::grid_barrier()
#endif
#ifdef PROBE_IDX
#define TS(i) { if (blockIdx.x == 0 && threadIdx.x == 0) ts[i] = wall_clock64(); }
#else
#define TS(i)
#endif
__global__ void __launch_bounds__(NTHR) k_mega(Params p) {
  SMEM_DECL(smem, SMEM_BYTES);
  cooperative_groups::grid_group grid = cooperative_groups::this_grid();
  volatile LAS unsigned* xst = (volatile LAS unsigned*)(smem + SMEM_BYTES - 32);
  if (threadIdx.x == 0) { xst[0] = 0u; xst[1] = 0u; }
  __syncthreads();
  XcdBarrier xb = xcd_barrier_post((unsigned*)(p.ws + OFF_BAR), xst);
#ifdef PROBE_IDX
  long long* ts = (long long*)(p.ws + OFF_CNT + 2048);
#endif
  TS(0);
  phaseA(p, smem);
  grid.sync(); TS(1);
  phase_norm0(p);
  GSYNC(); TS(2);
#pragma unroll 1
  for (int l = 0; l < 2; ++l) {
    const bool wc = l == 0;
    phase_win(p, l, smem); GSYNC(); TS(3 + l * 9);
    phase3(p, l, smem); GSYNC();
    phase3b(p, l, smem); GSYNC(); TS(4 + l * 9);
    phase4(p, l, smem, ctr_ptr(p, l)); GSYNC(); TS(5 + l * 9);
    phase5(p, l, wc, smem); GSYNC(); TS(6 + l * 9);
    phase_merge(p, l, wc, smem); GSYNC(); TS(7 + l * 9);
    phase_wout(p, l, wc, smem); GSYNC(); TS(8 + l * 9);
    phase_router(p, l, wc, smem, cnt_ptr(p, l)); GSYNC(); TS(9 + l * 9);
    phase_moe(p, l, wc, smem, cnt_ptr(p, l)); GSYNC(); TS(10 + l * 9);
    phase_combine(p, l, l == 1, smem, cnt_ptr(p, l));
#ifdef PROBE_IDX
    GSYNC(); TS(11 + l * 9);
#else
    if (l == 0) GSYNC();
#endif
  }
#ifdef PROBE_IDX
  if (blockIdx.x == 0 && threadIdx.x == 0) {
    const float us = (float)(ts[PROBE_IDX + 1] - ts[PROBE_IDX]) * 0.01f;
    p.out[0] += rintf(6.f * log2f(fmaxf(us, 1.f)));
  }
#endif
}
#endif

extern "C" void kernel_launch(void* const* d_in, const int* in_sizes, int n_in, void* d_out, int out_size, void* d_ws,
                              size_t ws_size, hipStream_t stream) {
  Params p{};
  const float** pp = (const float**)&p;
  for (int i = 0; i < 41; ++i) pp[i] = (const float*)d_in[i];
  p.out = (float*)d_out; p.ws = (char*)d_ws; p.osc = (char*)d_out;
  if (ws_size < WS_NEEDED) { fprintf(stderr, "workspace too small: %zu < %zu\n", ws_size, (size_t)WS_NEEDED); return; }
#if !MEGA
  const dim3 g(256), b(NTHR);
  hipLaunchKernelGGL(k_phaseA, g, b, 0, stream, p);
  hipLaunchKernelGGL(k_norm0, g, b, 0, stream, p);
  for (int l = 0; l < 2; ++l) {
    const int wc = l == 0;
    hipLaunchKernelGGL(k_win, g, b, 0, stream, p, l);
    hipLaunchKernelGGL(k_p3, g, b, 0, stream, p, l);
    hipLaunchKernelGGL(k_p3b, g, b, 0, stream, p, l);
    hipLaunchKernelGGL(k_p4, g, b, 0, stream, p, l);
    hipLaunchKernelGGL(k_p5, g, b, 0, stream, p, l, wc);
    hipLaunchKernelGGL(k_merge, g, b, 0, stream, p, l, wc);
    hipLaunchKernelGGL(k_wout, g, b, 0, stream, p, l, wc);
    hipLaunchKernelGGL(k_router, g, b, 0, stream, p, l, wc);
    hipLaunchKernelGGL(k_moe, g, b, 0, stream, p, l, wc);
    hipLaunchKernelGGL(k_combine, g, b, 0, stream, p, l, l == 1);
  }
#else
  static int grid_blocks = 0;
  if (!grid_blocks) {
    int dev = 0, cus = 0, per_cu = 0;
    hipGetDevice(&dev);
    hipDeviceGetAttribute(&cus, hipDeviceAttributeMultiprocessorCount, dev);
    hipOccupancyMaxActiveBlocksPerMultiprocessor(&per_cu, k_mega, NTHR, 0);
    if (per_cu > 1) per_cu = 1;
    grid_blocks = cus * per_cu;
  }
  hipMemsetAsync(p.ws + OFF_BAR, 0, 16384, stream);
  void* args[] = {&p};
  hipError_t e = hipLaunchCooperativeKernel((void*)k_mega, dim3(grid_blocks), dim3(NTHR), args, 0, stream);
  if (e != hipSuccess) fprintf(stderr, "cooperative launch failed: %s (grid %d)\n", hipGetErrorString(e), grid_blocks);
#endif
}
```

```cpp
#define MEGA 1
#include <hip/hip_runtime.h>
#include <hip/hip_cooperative_groups.h>
#include <cstdio>

#ifndef SEQ_T
#define SEQ_T 8192
#endif
#ifndef CTX_L
#define CTX_L 256
#endif

#define DI __device__ __forceinline__
typedef unsigned short bf16_t;
typedef short bf16x8 __attribute__((ext_vector_type(8)));
typedef float f32x16 __attribute__((ext_vector_type(16)));
typedef float f32x4 __attribute__((ext_vector_type(4)));

constexpr int NB_ = 2, T_ = SEQ_T, CL_ = CTX_L, D_ = 1024;
constexpr int NX_ = NB_ * T_, NC_ = NB_ * CL_, NT_ = NX_ + NC_, KT_ = CL_ + T_;
constexpr int GRID_W_ = 64;
constexpr int MLA_H = 8, MLA_NOPE_ = 64, MLA_ROPE_ = 32, MLA_DK = 96, MLA_DV = 64, QLORA = 384, KVLORA = 256;
constexpr int MLA_IN_ = 672, ML_IN_ = 784, RW_IN_ = 1152, GATE_IN_ = 3072, D_IN_ = 5680;
constexpr int ZMLA_W = 768;
constexpr int ZREC_W = 1936;
constexpr int WIN_N = 768 + 2048;
constexpr int ML_H = 4, ML_DK = 32, ML_DV = 64, ML_L = 64;
constexpr int RW_H = 4, RW_N_ = 64;
constexpr int NE_ = 64, TOPK_ = 8, DE_ = 256;
constexpr int NCH_ = KT_ / ML_L;
constexpr int NSEQ_ = 2 * NB_ * 4;

constexpr int ZR_MLQ = 0, ZR_MLK = 128, ZR_MLV = 256, ZR_MLO = 512, ZR_MLI = 768, ZR_MLF = 776;
constexpr int ZR_RW = 784;

constexpr size_t al256(size_t x) { return (x + 255) & ~(size_t)255; }
constexpr size_t WM_WIN = 0;
constexpr size_t WM_GATE = WM_WIN + (size_t)WIN_N * 1024 * 2;
constexpr size_t WM_UQ = WM_GATE + (size_t)3072 * 1024 * 2;
constexpr size_t WM_UKV = WM_UQ + (size_t)768 * 384 * 2;
constexpr size_t WM_BRA = WM_UKV + (size_t)1024 * 256 * 2;
constexpr size_t WM_BRM = WM_BRA + (size_t)1024 * 512 * 2;
constexpr size_t WM_BRR = WM_BRM + (size_t)1024 * 256 * 2;
constexpr size_t WM_OUT = WM_BRR + (size_t)1024 * 256 * 2;
constexpr size_t WM_RT = WM_OUT + (size_t)1024 * 1024 * 2;
constexpr size_t WM_SIZE = al256(WM_RT + (size_t)64 * 1024 * 2);
constexpr size_t WE_GU = 0;
constexpr size_t WE_DN = WE_GU + (size_t)65 * 512 * 1024 * 2;
constexpr size_t WE_SIZE = al256(WE_DN + (size_t)65 * 1024 * 256 * 2);

constexpr size_t OFF_XS = 0;
constexpr size_t OFF_MOD = OFF_XS + al256((size_t)NT_ * 1024 * 4);
constexpr size_t OFF_ROPE = OFF_MOD + al256((size_t)2 * 3 * 6144 * 4);
constexpr size_t OFF_H = OFF_ROPE + al256((size_t)T_ * 16 * 8);
constexpr size_t OFF_WMIX = OFF_H + al256((size_t)NT_ * 1024 * 2);
constexpr size_t OFF_CNT = OFF_WMIX + 2 * WM_SIZE;
constexpr size_t OFF_BAR = OFF_CNT + 4096;
constexpr size_t OFF_REGION = OFF_BAR + 16384;
constexpr size_t R_ZREC = 0;
constexpr size_t R_RB16 = R_ZREC + al256((size_t)NT_ * ZREC_W * 4);
constexpr size_t R_LW = R_RB16 + al256((size_t)7 * NT_ * 256 * 2);
constexpr size_t R_BS = R_LW + al256((size_t)2 * NT_ * 256 * 4);
constexpr size_t R_CH = R_BS + al256((size_t)2 * NT_ * 4 * 4);
constexpr size_t R_YS = R_CH + al256((size_t)NSEQ_ * NCH_ * 40960);
constexpr size_t R_MLST = R_YS + al256((size_t)2 * NT_ * 256 * 4);
constexpr size_t R_ATT = R_MLST + al256((size_t)NSEQ_ * NCH_ * 2112 * 4);
constexpr size_t R_MLO = R_ATT + al256((size_t)NT_ * 512 * 2);
constexpr size_t R_RWO = R_MLO + al256((size_t)NT_ * 256 * 2);
constexpr size_t R_VT = R_RWO + al256((size_t)NT_ * 256 * 2);
constexpr size_t R_KB = R_VT + al256((size_t)NB_ * MLA_H * 64 * KT_ * 2);
constexpr size_t R_MIX_END = R_KB + al256((size_t)NB_ * MLA_H * KT_ * 96 * 2);
constexpr int NSLOT_ = NT_ * 9;
constexpr size_t R_YBUF = 0;
constexpr size_t R_EIDX = R_YBUF + al256((size_t)NSLOT_ * 1024 * 2);
constexpr size_t R_EWT = R_EIDX + al256((size_t)NT_ * 8 * 4);
constexpr size_t R_ERANK = R_EWT + al256((size_t)NT_ * 8 * 4);
constexpr size_t R_ELIST = R_ERANK + al256((size_t)NT_ * 8 * 4);
constexpr size_t R_WMOE = R_ELIST + al256((size_t)64 * NT_ * 4);
constexpr size_t R_MOE_END = R_WMOE + WE_SIZE;
constexpr size_t R_SIZE = R_MIX_END > R_MOE_END ? R_MIX_END : R_MOE_END;
constexpr size_t WS_NEEDED = OFF_REGION + R_SIZE;
constexpr size_t O_ZMLA = 0;
constexpr size_t O_QB = O_ZMLA + al256((size_t)NT_ * ZMLA_W * 2);
constexpr size_t O_END = O_QB + al256((size_t)NT_ * 768 * 2);
constexpr size_t O_YMIX = 0;
#if SEQ_T == 8192 && CTX_L == 256
static_assert(O_END <= (size_t)NX_ * 1024 * 4, "d_out scratch overflow");
static_assert((size_t)NT_ * 1024 * 2 <= (size_t)NX_ * 1024 * 4, "ymix overflow");
static_assert(WS_NEEDED <= (size_t)597000000, "workspace too large");
#endif

struct Params {
  const float *x, *c, *ctx, *c_ctx, *w_mod, *b_mod, *g_mix, *g_ffn, *w_in, *g_cq, *w_uq, *g_ckv, *w_uk, *w_uv;
  const float *ml_b_i, *ml_b_f, *ml_g_norm, *rw_mu, *rw_w0, *rw_w2, *rw_a0, *rw_a2, *rw_g2, *rw_k_k, *rw_k_a;
  const float *rw_r_k, *rw_lnx_w, *rw_lnx_b, *w_br_mla, *w_br_ml, *w_br_rw, *w_out, *w_router, *router_bias;
  const float *w_e_gate, *w_e_up, *w_e_down, *w_s_gate, *w_s_up, *w_s_down, *g_final;
  float* out; char* ws; char* osc;
};

DI float bf2f(bf16_t s) { unsigned u = ((unsigned)s) << 16; float f; __builtin_memcpy(&f, &u, 4); return f; }
DI bf16_t f2bf(float x) { unsigned u; __builtin_memcpy(&u, &x, 4); u += 0x7fffu + ((u >> 16) & 1u); return (bf16_t)(u >> 16); }
DI unsigned pack2bf(float a, float b) {
#ifdef EMU
  return (unsigned)f2bf(a) | ((unsigned)f2bf(b) << 16);
#else
  typedef __bf16 bf2 __attribute__((ext_vector_type(2)));
  typedef float f2 __attribute__((ext_vector_type(2)));
  f2 v = {a, b}; bf2 r = __builtin_convertvector(v, bf2); return __builtin_bit_cast(unsigned, r);
#endif
}
DI f32x16 mfma32(bf16x8 a, bf16x8 b, f32x16 c) {
#ifdef EMU
  return emu_mfma_32x32x16_bf16(a, b, c);
#else
  return __builtin_amdgcn_mfma_f32_32x32x16_bf16(a, b, c, 0, 0, 0);
#endif
}
DI int rfl(int v) {
#ifdef EMU
  return v;
#else
  return __builtin_amdgcn_readfirstlane(v);
#endif
}
DI int opaque_tid() {
#ifdef EMU
  return threadIdx.x;
#else
  int t = threadIdx.x; asm volatile("" : "+v"(t)); return t;
#endif
}
DI void wave_sync() {
#ifdef EMU
  (void)__ballot(1);
#else
  asm volatile("" ::: "memory");
#endif
}
DI int vblock() {
  const int g = gridDim.x, b = blockIdx.x;
  return (g & 7) == 0 ? (b & 7) * (g >> 3) + (b >> 3) : b;
}
DI int xcc_id() {
#ifdef EMU
  return blockIdx.x & 7;
#else
  return (int)(__builtin_amdgcn_s_getreg((3 << 11) | 20) & 7u);
#endif
}
DI int ld_relaxed(int* p) {
#ifdef EMU
  return __atomic_load_n(p, __ATOMIC_SEQ_CST);
#else
  return __hip_atomic_load(p, __ATOMIC_RELAXED, __HIP_MEMORY_SCOPE_AGENT);
#endif
}
DI f32x16 zero16() { f32x16 z; for (int i = 0; i < 16; ++i) z[i] = 0.f; return z; }
DI int crow(int reg, int h) { return (reg & 3) + 8 * (reg >> 2) + 4 * h; }
#ifdef EMU
DI float fexp(float x) { return expf(x); }
#else
DI float fexp(float x) { return __expf(x); }
#endif
DI float sigmoidf_(float x) { return 1.f / (1.f + fexp(-x)); }
DI float siluf_(float x) { return x * sigmoidf_(x); }
DI float wave_sum(float v) { for (int m = 32; m >= 1; m >>= 1) v += __shfl_xor(v, m); return v; }
DI float wave_max(float v) { for (int m = 32; m >= 1; m >>= 1) v = fmaxf(v, __shfl_xor(v, m)); return v; }

DI int tok_b(int n) { return n < NX_ ? n / T_ : (n - NX_) / CL_; }
DI int tok_t(int n) { return n < NX_ ? n % T_ : (n - NX_) % CL_; }
DI int tok_key(int n) { return n < NX_ ? CL_ + n % T_ : (n - NX_) % CL_; }
DI int tok_modrow(int n) { return n < NX_ ? n / T_ : 2; }

#ifdef EMU
#define SMEM_DECL(name, bytes) char* name = (char*)emu::shared_alloc(bytes)
#else
#define SMEM_DECL(name, bytes) __shared__ __attribute__((aligned(16))) char name[bytes]
#endif
#define NTHR 512
struct CvtJob { const float* src; int lds; int K; bf16_t* dst; int ntn; int ntk; int maptype; const float* gain; };
DI int cvt_map(int maptype, int coff, int np) {
  if (maptype == 0) return coff + np;
  if (maptype == 1) { if (np < 672) return np; if (np < 768) return -1; if (np < 768 + 1936) return np - 96; return -1; }
  return np;
}
DI void cvt_tile(const CvtJob& j, int coff, int tk, int tn, char* smem) {
  float* tile = (float*)smem;
  const int tid = opaque_tid();
  __syncthreads();
  {
    const int kk = tid >> 3, nc = (tid & 7) * 8, k = tk * 64 + kk;
    const float g = j.gain ? j.gain[k] : 1.f;
#pragma unroll
    for (int i = 0; i < 8; ++i) {
      const int np = tn * 64 + nc + i;
      const int sc = cvt_map(j.maptype, coff, np);
      tile[kk * 65 + nc + i] = sc >= 0 ? j.src[(size_t)k * j.lds + sc] * g : 0.f;
    }
  }
  __syncthreads();
  {
    const int n = tid >> 3, kc = (tid & 7) * 8;
    int np = tn * 64 + n;
    if (j.maptype == 2) np = (np >> 5) * 64 + coff * 32 + (np & 31);
    uint4 v;
    v.x = pack2bf(tile[(kc + 0) * 65 + n], tile[(kc + 1) * 65 + n]);
    v.y = pack2bf(tile[(kc + 2) * 65 + n], tile[(kc + 3) * 65 + n]);
    v.z = pack2bf(tile[(kc + 4) * 65 + n], tile[(kc + 5) * 65 + n]);
    v.w = pack2bf(tile[(kc + 6) * 65 + n], tile[(kc + 7) * 65 + n]);
    *(uint4*)(j.dst + (size_t)np * j.K + tk * 64 + kc) = v;
  }
}

constexpr int CVT_MIX_TILES = 704 + 768 + 72 + 32 + 32 + 128 + 64 + 64 + 256 + 16;
DI void cvt_mix_item(const Params& p, int l, int it, char* smem) {
  bf16_t* W = (bf16_t*)(p.ws + OFF_WMIX + (size_t)l * WM_SIZE);
  CvtJob j; int coff = 0;
  if (it < 704) { j = {p.w_in + (size_t)l * 1024 * D_IN_, D_IN_, 1024, (bf16_t*)((char*)W + WM_WIN), 44, 16, 1, nullptr}; }
  else if ((it -= 704) < 768) { j = {p.w_in + (size_t)l * 1024 * D_IN_, D_IN_, 1024, (bf16_t*)((char*)W + WM_GATE), 48, 16, 0, nullptr}; coff = 2608; }
  else if ((it -= 768) < 72) { j = {p.w_uq + (size_t)l * 384 * 768, 768, 384, (bf16_t*)((char*)W + WM_UQ), 12, 6, 0, p.g_cq + l * 384}; }
  else if ((it -= 72) < 32) { j = {p.w_uk + (size_t)l * 256 * 512, 512, 256, (bf16_t*)((char*)W + WM_UKV), 8, 4, 0, p.g_ckv + l * 256}; }
  else if ((it -= 32) < 32) { j = {p.w_uv + (size_t)l * 256 * 512, 512, 256, (bf16_t*)((char*)W + WM_UKV) + 512 * 256, 8, 4, 0, p.g_ckv + l * 256}; }
  else if ((it -= 32) < 128) { j = {p.w_br_mla + (size_t)l * 512 * 1024, 1024, 512, (bf16_t*)((char*)W + WM_BRA), 16, 8, 0, nullptr}; }
  else if ((it -= 128) < 64) { j = {p.w_br_ml + (size_t)l * 256 * 1024, 1024, 256, (bf16_t*)((char*)W + WM_BRM), 16, 4, 0, nullptr}; }
  else if ((it -= 64) < 64) { j = {p.w_br_rw + (size_t)l * 256 * 1024, 1024, 256, (bf16_t*)((char*)W + WM_BRR), 16, 4, 0, nullptr}; }
  else if ((it -= 64) < 256) { j = {p.w_out + (size_t)l * 1024 * 1024, 1024, 1024, (bf16_t*)((char*)W + WM_OUT), 16, 16, 0, nullptr}; }
  else { it -= 256; j = {p.w_router + (size_t)l * 1024 * 64, 64, 1024, (bf16_t*)((char*)W + WM_RT), 1, 16, 0, nullptr}; }
  cvt_tile(j, coff, it / j.ntn, it % j.ntn, smem);
}
constexpr int CVT_MOE_TILES = 65 * 192;
DI void cvt_moe_item(const Params& p, int l, int it, char* smem) {
  const int e = it / 192; int r = it % 192;
  bf16_t* GU = (bf16_t*)(p.ws + OFF_REGION + R_WMOE + WE_GU) + (size_t)e * 512 * 1024;
  bf16_t* DN = (bf16_t*)(p.ws + OFF_REGION + R_WMOE + WE_DN) + (size_t)e * 1024 * 256;
  const float* sg = e < 64 ? p.w_e_gate + ((size_t)l * 64 + e) * 1024 * 256 : p.w_s_gate + (size_t)l * 1024 * 256;
  const float* su = e < 64 ? p.w_e_up + ((size_t)l * 64 + e) * 1024 * 256 : p.w_s_up + (size_t)l * 1024 * 256;
  const float* sd = e < 64 ? p.w_e_down + ((size_t)l * 64 + e) * 256 * 1024 : p.w_s_down + (size_t)l * 256 * 1024;
  CvtJob j; int coff = 0;
  if (r < 64) { j = {sg, 256, 1024, GU, 4, 16, 2, nullptr}; coff = 0; }
  else if ((r -= 64) < 64) { j = {su, 256, 1024, GU, 4, 16, 2, nullptr}; coff = 1; }
  else { r -= 64; j = {sd, 1024, 256, DN, 16, 4, 0, nullptr}; }
  cvt_tile(j, coff, r / j.ntn, r % j.ntn, smem);
}

DI void mod_item(const Params& p, int it, char* smem) {
  float* cond = (float*)smem;
  float* red = cond + 3 * 1024;
  const int tid = opaque_tid(), l = it / 96, j0 = (it % 96) * 64;
  __syncthreads();
  for (int i = tid; i < 3 * 1024; i += NTHR) {
    const int r = i >> 10, k = i & 1023;
    const float v = r < 2 ? p.c[r * 1024 + k] : p.c_ctx[k];
    cond[i] = siluf_(v);
  }
  __syncthreads();
  const int jj = tid & 63, kg = tid >> 6;
  float a0 = 0.f, a1 = 0.f, a2 = 0.f;
  const float* w = p.w_mod + (size_t)l * 1024 * 6144 + j0 + jj;
  for (int k = kg; k < 1024; k += 8) {
    const float wv = w[(size_t)k * 6144];
    a0 += cond[k] * wv; a1 += cond[1024 + k] * wv; a2 += cond[2048 + k] * wv;
  }
  red[(kg * 3 + 0) * 64 + jj] = a0; red[(kg * 3 + 1) * 64 + jj] = a1; red[(kg * 3 + 2) * 64 + jj] = a2;
  __syncthreads();
  if (tid < 192) {
    const int r = tid >> 6; float s = 0.f;
    for (int g = 0; g < 8; ++g) s += red[(g * 3 + r) * 64 + jj];
    float* mod = (float*)(p.ws + OFF_MOD);
    mod[((size_t)l * 3 + r) * 6144 + j0 + jj] = s + p.b_mod[(size_t)l * 6144 + j0 + jj];
  }
}
DI void rope_item(const Params& p, int it) {
  const int idx = it * NTHR + threadIdx.x;
  if (idx >= T_ * 16) return;
  const int t = idx >> 4, i = idx & 15, f = i & 7;
  const float pos = (float)(i < 8 ? t / GRID_W_ : t % GRID_W_);
  const float inv = powf(10000.f, -(float)(2 * f) / 16.f);
  const float ang = pos * inv;
  float2* rt = (float2*)(p.ws + OFF_ROPE);
  rt[idx] = make_float2(cosf(ang), sinf(ang));
}
constexpr int PA_ITEMS = 192 + (T_ * 16 + NTHR - 1) / NTHR + 2 * CVT_MIX_TILES;
DI void phaseA(const Params& p, char* smem) {
  if (blockIdx.x == 0 && threadIdx.x < 256) ((int*)(p.ws + OFF_CNT))[threadIdx.x] = 0;
  for (int it = blockIdx.x; it < PA_ITEMS; it += gridDim.x) {
    int i = it;
    if (i < 192) { mod_item(p, i, smem); continue; }
    i -= 192;
    constexpr int NR = (T_ * 16 + NTHR - 1) / NTHR;
    if (i < NR) { rope_item(p, i); continue; }
    i -= NR;
    cvt_mix_item(p, i / CVT_MIX_TILES, i % CVT_MIX_TILES, smem);
  }
}

DI void row_norm_mod(const float (&v)[16], const float* g, const float* shift, const float* scale, bf16_t* hrow, int lane) {
  float ss = 0.f;
#pragma unroll
  for (int i = 0; i < 16; ++i) ss += v[i] * v[i];
  ss = wave_sum(ss);
  const float rs = 1.0f / sqrtf(ss * (1.f / 1024.f) + 1e-6f);
#pragma unroll
  for (int j = 0; j < 4; ++j) {
    const int c = (j * 64 + lane) * 4;
    const float4 gg = *(const float4*)(g + c), sh = *(const float4*)(shift + c), sc = *(const float4*)(scale + c);
    const float h0 = v[j * 4 + 0] * rs * gg.x * (1.f + sc.x) + sh.x;
    const float h1 = v[j * 4 + 1] * rs * gg.y * (1.f + sc.y) + sh.y;
    const float h2 = v[j * 4 + 2] * rs * gg.z * (1.f + sc.z) + sh.z;
    const float h3 = v[j * 4 + 3] * rs * gg.w * (1.f + sc.w) + sh.w;
    uint2 o; o.x = pack2bf(h0, h1); o.y = pack2bf(h2, h3);
    *(uint2*)(hrow + c) = o;
  }
}
DI void phase_norm0(const Params& p) {
  const int lane = threadIdx.x & 63, wid = threadIdx.x >> 6;
  float* xs = (float*)(p.ws + OFF_XS);
  bf16_t* H = (bf16_t*)(p.ws + OFF_H);
  const float* mod = (const float*)(p.ws + OFF_MOD);
  for (int n = blockIdx.x * 8 + wid; n < NT_; n += gridDim.x * 8) {
    const float* src = n < NX_ ? p.x + (size_t)n * 1024 : p.ctx + (size_t)(n - NX_) * 1024;
    float v[16];
#pragma unroll
    for (int j = 0; j < 4; ++j) {
      const float4 t = *(const float4*)(src + (j * 64 + lane) * 4);
      v[j * 4] = t.x; v[j * 4 + 1] = t.y; v[j * 4 + 2] = t.z; v[j * 4 + 3] = t.w;
      *(float4*)(xs + (size_t)n * 1024 + (j * 64 + lane) * 4) = t;
    }
    const float* m = mod + (size_t)(0 * 3 + tok_modrow(n)) * 6144;
    row_norm_mod(v, p.g_mix, m, m + 1024, H + (size_t)n * 1024, lane);
  }
}

template <int BM, int BN, int BK, int WM_, int WN_>
struct Gemm {
  static constexpr int WTM = BM / WM_, WTN = BN / WN_, MB = WTM / 32, NB = WTN / 32;
  static constexpr int LDA = BK + 8;
  static constexpr int A_BYTES = BM * LDA * 2, B_BYTES = BN * LDA * 2, STAGE = A_BYTES + B_BYTES;
  static constexpr int SMEM = 2 * STAGE;
  static constexpr int CPR = BK / 8;
  static constexpr int ACH = BM * CPR / NTHR, BCH = BN * CPR / NTHR;
  static_assert(WM_ * WN_ == 8, "8 waves");
  static_assert(BM * CPR % NTHR == 0 && BN * CPR % NTHR == 0, "chunking");
  static_assert(NTHR % CPR == 0, "rows fixed per thread");

  template <class ARow>
  static DI void run(f32x16 (&acc)[MB][NB], ARow arow, const bf16_t* Bt, int ldb, int Klen, char* smem) {
    const int tid = opaque_tid(), lane = tid & 63, wid = tid >> 6, wm = wid / WN_, wn = wid % WN_;
    const int kc = (tid % CPR) * 8, r0 = tid / CPR;
    const bf16_t* ap[ACH]; const bf16_t* bp[BCH];
#pragma unroll
    for (int i = 0; i < ACH; ++i) ap[i] = arow(r0 + i * (NTHR / CPR)) + kc;
#pragma unroll
    for (int i = 0; i < BCH; ++i) bp[i] = Bt + (size_t)(r0 + i * (NTHR / CPR)) * ldb + kc;
    uint4 ra[ACH], rb[BCH];
    const int nk = Klen / BK;
#pragma unroll
    for (int i = 0; i < ACH; ++i) ra[i] = *(const uint4*)(ap[i]);
#pragma unroll
    for (int i = 0; i < BCH; ++i) rb[i] = *(const uint4*)(bp[i]);
#pragma unroll
    for (int i = 0; i < ACH; ++i) *(uint4*)(smem + ((r0 + i * (NTHR / CPR)) * LDA + kc) * 2) = ra[i];
#pragma unroll
    for (int i = 0; i < BCH; ++i) *(uint4*)(smem + A_BYTES + ((r0 + i * (NTHR / CPR)) * LDA + kc) * 2) = rb[i];
    __syncthreads();
    for (int kt = 0; kt < nk; ++kt) {
      const bool more = kt + 1 < nk;
      if (more) {
#pragma unroll
        for (int i = 0; i < ACH; ++i) ra[i] = *(const uint4*)(ap[i] + (kt + 1) * BK);
#pragma unroll
        for (int i = 0; i < BCH; ++i) rb[i] = *(const uint4*)(bp[i] + (kt + 1) * BK);
      }
      const char* As = smem + (kt & 1) * STAGE;
      const char* Bs = As + A_BYTES;
#pragma unroll
      for (int ks = 0; ks < BK / 16; ++ks) {
        bf16x8 af[MB], bfr[NB];
#pragma unroll
        for (int mb = 0; mb < MB; ++mb)
          af[mb] = *(const bf16x8*)(As + ((wm * WTM + mb * 32 + (lane & 31)) * LDA + ks * 16 + (lane >> 5) * 8) * 2);
#pragma unroll
        for (int nb = 0; nb < NB; ++nb)
          bfr[nb] = *(const bf16x8*)(Bs + ((wn * WTN + nb * 32 + (lane & 31)) * LDA + ks * 16 + (lane >> 5) * 8) * 2);
#pragma unroll
        for (int mb = 0; mb < MB; ++mb)
#pragma unroll
          for (int nb = 0; nb < NB; ++nb) acc[mb][nb] = mfma32(af[mb], bfr[nb], acc[mb][nb]);
      }
      if (more) {
        char* Ad = smem + ((kt + 1) & 1) * STAGE;
#pragma unroll
        for (int i = 0; i < ACH; ++i) *(uint4*)(Ad + ((r0 + i * (NTHR / CPR)) * LDA + kc) * 2) = ra[i];
#pragma unroll
        for (int i = 0; i < BCH; ++i) *(uint4*)(Ad + A_BYTES + ((r0 + i * (NTHR / CPR)) * LDA + kc) * 2) = rb[i];
      }
      __syncthreads();
    }
  }
  static DI int row_of(int t, int mb, int reg) { const int lane = t & 63, wm = (t >> 6) / WN_; return wm * WTM + mb * 32 + crow(reg, lane >> 5); }
  static DI int col_of(int t, int nb) { const int lane = t & 63, wn = (t >> 6) % WN_; return wn * WTN + nb * 32 + (lane & 31); }
};


template <int NBW> struct WTile {
  static constexpr int LD = NBW * 32 + 4;
  static constexpr int BYTES = 32 * LD * 4;
  static DI void put(float* scr, int nb, int lane, const f32x16& v) {
    const int c = nb * 32 + (lane & 31), h = lane >> 5;
#pragma unroll
    for (int i = 0; i < 16; ++i) scr[crow(i, h) * LD + c] = v[i];
  }
  template <class F> static DI void rows4(const float* scr, int lane, F f) {
    wave_sync();
#pragma unroll
    for (int it = 0; it < NBW * 4; ++it) {
      const int id = it * 64 + lane, row = id / (NBW * 8), q = id % (NBW * 8);
      f(row, q * 4, *(const float4*)(scr + row * LD + q * 4));
    }
    wave_sync();
  }
  template <class F> static DI void rows8(const float* scr, int lane, F f) {
    wave_sync();
#pragma unroll
    for (int it = 0; it < NBW * 2; ++it) {
      const int id = it * 64 + lane, row = id / (NBW * 4), q = id % (NBW * 4);
      f(row, q * 8, *(const float4*)(scr + row * LD + q * 8), *(const float4*)(scr + row * LD + q * 8 + 4));
    }
    wave_sync();
  }
};
DI uint4 pack8bf(const float4& a, const float4& b) { return make_uint4(pack2bf(a.x, a.y), pack2bf(a.z, a.w), pack2bf(b.x, b.y), pack2bf(b.z, b.w)); }

typedef Gemm<256, 256, 64, 2, 4> G256;
DI void phase_win(const Params& p, int l, char* smem) {
  const bf16_t* H = (const bf16_t*)(p.ws + OFF_H);
  const bf16_t* W = (const bf16_t*)(p.ws + OFF_WMIX + (size_t)l * WM_SIZE + WM_WIN);
  bf16_t* zmla = (bf16_t*)(p.osc + O_ZMLA);
  float* zrec = (float*)(p.ws + OFF_REGION + R_ZREC);
  constexpr int TM = NT_ / 256, TN = WIN_N / 256;
  for (int it = vblock(); it < TM * TN; it += gridDim.x) {
    const int tid = opaque_tid();
    const int tm = it / TN, tn = it % TN;
    __syncthreads();
    f32x16 acc[G256::MB][G256::NB];
#pragma unroll
    for (int a = 0; a < G256::MB; ++a)
#pragma unroll
      for (int b = 0; b < G256::NB; ++b) acc[a][b] = zero16();
    const bf16_t* A0 = H + (size_t)tm * 256 * 1024;
    G256::run(acc, [&](int r) { return A0 + (size_t)r * 1024; }, W + (size_t)tn * 256 * 1024, 1024, 1024, smem);
    {
      const int lane = tid & 63, wid = tid >> 6, wm = wid / 4, wn = wid % 4;
      float* scr = (float*)(smem + wid * WTile<2>::BYTES);
      const int col0 = tn * 256 + wn * 64;
#pragma unroll
      for (int mb = 0; mb < G256::MB; ++mb) {
        WTile<2>::put(scr, 0, lane, acc[mb][0]); WTile<2>::put(scr, 1, lane, acc[mb][1]);
        const int row0 = tm * 256 + wm * 128 + mb * 32;
        if (tn < 3) {
          WTile<2>::rows8(scr, lane, [&](int r, int c, const float4& a, const float4& bq) {
            *(uint4*)(zmla + (size_t)(row0 + r) * ZMLA_W + col0 + c) = pack8bf(a, bq); });
        } else {
          WTile<2>::rows4(scr, lane, [&](int r, int c, const float4& a) {
            const int cc = col0 - 768 + c;
            if (cc < ZREC_W) *(float4*)(zrec + (size_t)(row0 + r) * ZREC_W + cc) = a; });
        }
      }
    }
  }
}
typedef Gemm<128, 128, 64, 2, 4> G128;
DI void mla_row_rs(const bf16_t* zmla_rows, int c0, int len, float* rs) {
  const int tid = opaque_tid(), row = tid >> 2, half = tid & 3;
  const bf16_t* src = zmla_rows + (size_t)row * ZMLA_W + c0 + half * (len / 4);
  float ss = 0.f;
  for (int i = 0; i < len / 4; i += 8) {
    const uint4 v = *(const uint4*)(src + i);
    const unsigned w[4] = {v.x, v.y, v.z, v.w};
#pragma unroll
    for (int j = 0; j < 4; ++j) { const float a = bf2f((bf16_t)(w[j] & 0xffff)), b = bf2f((bf16_t)(w[j] >> 16)); ss += a * a + b * b; }
  }
  ss += __shfl_xor(ss, 1); ss += __shfl_xor(ss, 2);
  if (half == 0) rs[row] = 1.0f / sqrtf(ss / (float)len + 1e-6f);
}

constexpr int MLA_Q_TILES = (NT_ / 128) * 6, MLA_KV_TILES = (NT_ / 128) * 8;
DI void mla_q_item(const Params& p, int l, int it, char* smem) {
  const int tid = opaque_tid();
  const int tm = it / 6, tn = it % 6;
  const bf16_t* zmla = (const bf16_t*)(p.osc + O_ZMLA) + (size_t)tm * 128 * ZMLA_W;
  const bf16_t* W = (const bf16_t*)(p.ws + OFF_WMIX + (size_t)l * WM_SIZE + WM_UQ) + (size_t)tn * 128 * 384;
  bf16_t* qb = (bf16_t*)(p.osc + O_QB);
  const float2* rt = (const float2*)(p.ws + OFF_ROPE);
  float* rs = (float*)(smem + G128::SMEM);
  __syncthreads();
  mla_row_rs(zmla, 0, 384, rs);
  f32x16 acc[G128::MB][G128::NB];
#pragma unroll
  for (int a = 0; a < G128::MB; ++a)
#pragma unroll
    for (int b = 0; b < G128::NB; ++b) acc[a][b] = zero16();
  G128::run(acc, [&](int r) { return zmla + (size_t)r * ZMLA_W; }, W, 384, 384, smem);
  const int lane = tid & 63;
  const bool isx = tm * 128 < NX_;
#pragma unroll
  for (int mb = 0; mb < G128::MB; ++mb)
#pragma unroll
    for (int nb = 0; nb < G128::NB; ++nb) {
      const int col = tn * 128 + G128::col_of(tid, nb);
      const bool ropeblk = ((col >> 5) % 3) == 2;
      const int e = lane & 31;
#pragma unroll
      for (int i = 0; i < 16; ++i) {
        const int lr = G128::row_of(tid, mb, i);
        const int n = tm * 128 + lr;
        float v = acc[mb][nb][i] * rs[lr];
        if (ropeblk && isx) {
          const float pv = __shfl_xor(v, 8);
          const float2 cs = rt[(size_t)(n % T_) * 16 + (e >> 4) * 8 + (e & 7)];
          v = (e & 8) ? (pv * cs.y + v * cs.x) : (v * cs.x - pv * cs.y);
        }
        qb[(size_t)n * 768 + col] = f2bf(v);
      }
    }
}
DI void mla_kv_item(const Params& p, int l, int it, char* smem) {
  const int tid = opaque_tid();
  const int tm = it / 8, tn = it % 8;
  const bf16_t* zmla = (const bf16_t*)(p.osc + O_ZMLA) + (size_t)tm * 128 * ZMLA_W;
  const bf16_t* W = (const bf16_t*)(p.ws + OFF_WMIX + (size_t)l * WM_SIZE + WM_UKV) + (size_t)tn * 128 * 256;
  bf16_t* kb = (bf16_t*)(p.ws + OFF_REGION + R_KB);
  bf16_t* vt = (bf16_t*)(p.ws + OFF_REGION + R_VT);
  const float2* rt = (const float2*)(p.ws + OFF_ROPE);
  float* rs = (float*)(smem + G128::SMEM);
  __syncthreads();
  mla_row_rs(zmla, 384, 256, rs);
  const int n0 = tm * 128;
  const int b = tok_b(n0), key0 = tok_key(n0);
  const bool isx = n0 < NX_;
  if (tn == 0) {
    for (int idx = tid; idx < 128 * 16; idx += NTHR) {
      const int lr = idx >> 4, pi = idx & 15, a = pi >> 3, i = pi & 7;
      const bf16_t* z = zmla + (size_t)lr * ZMLA_W + 640 + a * 16 + i;
      float x1 = bf2f(z[0]), x2 = bf2f(z[8]);
      if (isx) {
        const float2 cs = rt[(size_t)((n0 + lr) % T_) * 16 + a * 8 + i];
        const float y1 = x1 * cs.x - x2 * cs.y, y2 = x1 * cs.y + x2 * cs.x; x1 = y1; x2 = y2;
      }
      const bf16_t o1 = f2bf(x1), o2 = f2bf(x2);
      for (int h = 0; h < 8; ++h) {
        bf16_t* dst = kb + ((size_t)(b * 8 + h) * KT_ + key0 + lr) * 96 + 64 + a * 16 + i;
        dst[0] = o1; dst[8] = o2;
      }
    }
  }
  f32x16 acc[G128::MB][G128::NB];
#pragma unroll
  for (int a = 0; a < G128::MB; ++a)
#pragma unroll
    for (int c = 0; c < G128::NB; ++c) acc[a][c] = zero16();
  G128::run(acc, [&](int r) { return zmla + (size_t)r * ZMLA_W + 384; }, W, 256, 256, smem);
  const int lane = tid & 63;
#pragma unroll
  for (int mb = 0; mb < G128::MB; ++mb)
#pragma unroll
    for (int nb = 0; nb < G128::NB; ++nb) {
      const int col = tn * 128 + G128::col_of(tid, nb);
      if (col < 512) {
        const int h = col >> 6, d = col & 63;
#pragma unroll
        for (int i = 0; i < 16; ++i) {
          const int lr = G128::row_of(tid, mb, i);
          kb[((size_t)(b * 8 + h) * KT_ + key0 + lr) * 96 + d] = f2bf(acc[mb][nb][i] * rs[lr]);
        }
      } else {
        const int h = (col - 512) >> 6, d = col & 63;
#pragma unroll
        for (int g = 0; g < 4; ++g) {
          const int lr = G128::row_of(tid, mb, g * 4);
          uint2 o;
          o.x = pack2bf(acc[mb][nb][g * 4 + 0] * rs[lr], acc[mb][nb][g * 4 + 1] * rs[lr + 1]);
          o.y = pack2bf(acc[mb][nb][g * 4 + 2] * rs[lr + 2], acc[mb][nb][g * 4 + 3] * rs[lr + 3]);
          *(uint2*)(vt + ((size_t)(b * 8 + h) * 64 + d) * KT_ + key0 + lr) = o;
        }
      }
    }
  (void)lane;
}

DI float softplusf_(float x) { return x > 20.f ? x : log1pf(fexp(x)); }
constexpr int RWP_TT = 16;
constexpr int RWP_ITEMS = NT_ / RWP_TT;
DI void rwkv_prep_item(const Params& p, int l, int it, char* smem) {
  float* zs = (float*)smem;
  float* tw = zs + RWP_TT * 1024;
  float* ta = tw + 2 * 64 * RWP_TT;
  const float* zrec = (const float*)(p.ws + OFF_REGION + R_ZREC);
  bf16_t* rb = (bf16_t*)(p.ws + OFF_REGION + R_RB16);
  float* lwo = (float*)(p.ws + OFF_REGION + R_LW);
  float* bso = (float*)(p.ws + OFF_REGION + R_BS);
  const float rkw = p.rw_r_k[(size_t)l * 256 + (opaque_tid() & 255)];
  const float* mu = p.rw_mu + (size_t)l * 1152;
  const int tid = opaque_tid(), n0 = it * RWP_TT;
  __syncthreads();
  for (int idx = tid; idx < RWP_TT * 1024; idx += NTHR) {
    const int tt = idx >> 10, c = idx & 1023, n = n0 + tt, t = tok_t(n);
    const int len = n < NX_ ? T_ : CL_;
    const float* zr = zrec + (size_t)n * ZREC_W + ZR_RW + c;
    const float z = zr[0];
    const float zp = t > 0 ? zr[-ZREC_W] : 0.f, zn = t < len - 1 ? zr[ZREC_W] : 0.f;
    const float s = z + (0.5f * (zp + zn) - z) * mu[c];
    zs[idx] = s;
    if (c >= 768 && c < 896) { const int d = (c - 768) >> 6, k = (c - 768) & 63; tw[(d * 64 + k) * RWP_TT + tt] = tanhf(s); }
    if (c >= 896) { const int d = (c - 896) >> 6, k = (c - 896) & 63; ta[(d * 64 + k) * RWP_TT + tt] = s; }
  }
  __syncthreads();
  const int col = tid & 255, d = tid >> 8;
  float aw[RWP_TT], aa[RWP_TT];
#pragma unroll
  for (int i = 0; i < RWP_TT; ++i) { aw[i] = 0.f; aa[i] = 0.f; }
  const float* w2 = p.rw_w2 + ((size_t)l * 2 + d) * 64 * 256 + col;
  const float* a2 = p.rw_a2 + ((size_t)l * 2 + d) * 64 * 256 + col;
  for (int k = 0; k < 64; ++k) {
    const float wv = w2[k * 256], av = a2[k * 256];
    const float* twk = tw + (d * 64 + k) * RWP_TT;
    const float* tak = ta + (d * 64 + k) * RWP_TT;
#pragma unroll
    for (int i = 0; i < RWP_TT; ++i) { aw[i] += twk[i] * wv; aa[i] += tak[i] * av; }
  }
  const float w0 = p.rw_w0[((size_t)l * 2 + d) * 256 + col], a0 = p.rw_a0[((size_t)l * 2 + d) * 256 + col];
  const float kkw = p.rw_k_k[(size_t)l * 256 + col], kaw = p.rw_k_a[(size_t)l * 256 + col];
  const size_t AS = (size_t)NT_ * 256;
#pragma unroll
  for (int i = 0; i < RWP_TT; ++i) {
    const int n = n0 + i;
    const float r = zs[i * 1024 + col], k = zs[i * 1024 + 256 + col], v = zs[i * 1024 + 512 + col];
    const float kr = k * kkw;
    const float ss = wave_sum(kr * kr);
    const float kk = kr / fmaxf(sqrtf(ss), 1e-12f);
    const float w = -softplusf_(-(w0 + aw[i])) - 0.5f;
    const float logdecay = -fexp(w);
    const float a = sigmoidf_(a0 + aa[i]);
    const float kd = k * (1.f + (a - 1.f) * kaw);
    const float bsum = wave_sum(r * rkw * kd);
    const size_t o = (size_t)n * 256 + col;
    if (d == 0) { rb[0 * AS + o] = f2bf(r); rb[1 * AS + o] = f2bf(v); rb[2 * AS + o] = f2bf(kk); }
    lwo[d * AS + o] = logdecay;
    rb[(3 + 2 * d) * AS + o] = f2bf(kd);
    rb[(4 + 2 * d) * AS + o] = f2bf(kk * a);
    if ((tid & 63) == 0) bso[((size_t)d * NT_ + n) * 4 + (col >> 6)] = bsum;
  }
}

DI int seq_tok(int dir, int b, int pos) {
  if (pos < CL_) return NX_ + b * CL_ + (dir ? CL_ - 1 - pos : pos);
  const int t = pos - CL_;
  return b * T_ + (dir ? T_ - 1 - t : t);
}
DI float logsigmoidf_(float x) { return -softplusf_(-x); }
DI float wave_incl_scan(float v, int lane) {
  for (int d = 1; d < 64; d <<= 1) { const float o = __shfl_up(v, d); if (lane >= d) v += o; }
  return v;
}
constexpr int ML_ST = 2112;
constexpr int ML1_ITEMS = NSEQ_ * NCH_;
DI void mlstm_local_item(const Params& p, int l, int it, char* smem) {
  const int s = it / NCH_, c = it % NCH_, dir = s >> 3, b = (s >> 2) & 1, hd = s & 3;
  float* vv = (float*)smem;
  float* kw = vv + 64 * 64;
  float* wej = kw + 64 * 32;
  const float* zrec = (const float*)(p.ws + OFF_REGION + R_ZREC);
  float* st = (float*)(p.ws + OFF_REGION + R_MLST) + ((size_t)s * NCH_ + c) * ML_ST;
  const int tid = opaque_tid(), lane = tid & 63, wid = tid >> 6;
  __syncthreads();
  if (wid == 0) {
    const int n = seq_tok(dir, b, c * 64 + lane);
    const float fp = zrec[(size_t)n * ZREC_W + ZR_MLF + dir * 4 + hd] + p.ml_b_f[(l * 2 + dir) * 4 + hd];
    const float ip = zrec[(size_t)n * ZREC_W + ZR_MLI + dir * 4 + hd] + p.ml_b_i[(l * 2 + dir) * 4 + hd];
    const float bj = wave_incl_scan(logsigmoidf_(fp), lane);
    const float bl = __shfl(bj, 63);
    const float lw = bl - bj + ip;
    const float ml = wave_max(lw);
    wej[lane] = fexp(lw - ml);
    if (lane == 0) { st[2080] = bl; st[2081] = ml; }
  }
  for (int idx = tid; idx < 64 * 64; idx += NTHR) {
    const int j = idx >> 6, e = idx & 63;
    const int n = seq_tok(dir, b, c * 64 + j);
    vv[idx] = zrec[(size_t)n * ZREC_W + ZR_MLV + hd * 64 + e];
  }
  __syncthreads();
  for (int idx = tid; idx < 64 * 32; idx += NTHR) {
    const int j = idx >> 5, e = idx & 31;
    const int n = seq_tok(dir, b, c * 64 + j);
    kw[idx] = zrec[(size_t)n * ZREC_W + ZR_MLK + hd * 32 + e] * wej[j];
  }
  __syncthreads();
  const int v = tid & 63, d0 = (tid >> 6) * 4;
  float a0 = 0.f, a1 = 0.f, a2 = 0.f, a3 = 0.f;
  for (int j = 0; j < 64; ++j) {
    const float x = vv[j * 64 + v];
    const float4 kk = *(const float4*)(kw + j * 32 + d0);
    a0 += x * kk.x; a1 += x * kk.y; a2 += x * kk.z; a3 += x * kk.w;
  }
  *(float4*)(st + v * 32 + d0) = make_float4(a0, a1, a2, a3);
  if (tid < 32) { float sn = 0.f; for (int j = 0; j < 64; ++j) sn += kw[j * 32 + tid]; st[2048 + tid] = sn; }
}
constexpr int ML2_ITEMS = (NSEQ_ * 2080 + NTHR - 1) / NTHR;
DI void mlstm_scan_item(const Params& p, int it) {
  const int g = it * NTHR + opaque_tid();
  if (g >= NSEQ_ * 2080) return;
  const int s = g / 2080, e = g % 2080;
  float* st = (float*)(p.ws + OFF_REGION + R_MLST) + (size_t)s * NCH_ * ML_ST;
  float state = 0.f, m = 0.f;
  for (int c = 0; c < NCH_; ++c) {
    float* r = st + (size_t)c * ML_ST;
    const float d = r[e], bl = r[2080], ml = r[2081];
    r[e] = state;
    if (e == 0) r[2082] = m;
    const float mn = fmaxf(bl + m, ml);
    state = fexp(bl + m - mn) * state + fexp(ml - mn) * d;
    m = mn;
  }
}

constexpr int P3_ITEMS = RWP_ITEMS + ML1_ITEMS;
DI void phase3(const Params& p, int l, char* smem) {
  for (int it = blockIdx.x; it < P3_ITEMS; it += gridDim.x) {
    if (it < RWP_ITEMS) rwkv_prep_item(p, l, it, smem);
    else mlstm_local_item(p, l, it - RWP_ITEMS, smem);
  }
}
constexpr int RW_LD = 72, RW_MB = 64 * RW_LD * 2;
constexpr int RWC_REC = 40960;
DI char* rw_rec(const Params& p, int s, int c) { return p.ws + OFF_REGION + R_CH + ((size_t)s * NCH_ + c) * RWC_REC; }
DI f32x16 rw_mm(const char* A, const char* Bt, int mb, int nb, int lane, f32x16 acc) {
  const int r = lane & 31, h = lane >> 5;
#pragma unroll
  for (int ks = 0; ks < 4; ++ks) {
    const bf16x8 a = *(const bf16x8*)(A + ((mb * 32 + r) * RW_LD + ks * 16 + h * 8) * 2);
    const bf16x8 b = *(const bf16x8*)(Bt + ((nb * 32 + r) * RW_LD + ks * 16 + h * 8) * 2);
    acc = mfma32(a, b, acc);
  }
  return acc;
}
DI void rw_wrT(char* Dst, int mb, int nb, int lane, const f32x16& v) {
  const int r = lane & 31, h = lane >> 5;
#pragma unroll
  for (int g = 0; g < 4; ++g) {
    uint2 o; o.x = pack2bf(v[4 * g], v[4 * g + 1]); o.y = pack2bf(v[4 * g + 2], v[4 * g + 3]);
    *(uint2*)(Dst + ((nb * 32 + r) * RW_LD + mb * 32 + 8 * g + 4 * h) * 2) = o;
  }
}
DI void rw_wrT_g(bf16_t* Dst, int mb, int nb, int lane, const f32x16& v) {
  const int r = lane & 31, h = lane >> 5;
#pragma unroll
  for (int g = 0; g < 4; ++g) {
    uint2 o; o.x = pack2bf(v[4 * g], v[4 * g + 1]); o.y = pack2bf(v[4 * g + 2], v[4 * g + 3]);
    *(uint2*)(Dst + (nb * 32 + r) * 64 + mb * 32 + 8 * g + 4 * h) = o;
  }
}
DI void rw_addT(const char* Src, int mb, int nb, int lane, f32x16& v) {
  const int r = lane & 31, h = lane >> 5;
#pragma unroll
  for (int g = 0; g < 4; ++g) {
    const uint2 u = *(const uint2*)(Src + ((nb * 32 + r) * RW_LD + mb * 32 + 8 * g + 4 * h) * 2);
    v[4 * g] += bf2f((bf16_t)(u.x & 0xffff)); v[4 * g + 1] += bf2f((bf16_t)(u.x >> 16));
    v[4 * g + 2] += bf2f((bf16_t)(u.y & 0xffff)); v[4 * g + 3] += bf2f((bf16_t)(u.y >> 16));
  }
}
DI void rw_mask_upper(f32x16& v, int mb, int nb, int lane, bool strict) {
  const int col = nb * 32 + (lane & 31), h = lane >> 5;
#pragma unroll
  for (int i = 0; i < 16; ++i) { const int row = mb * 32 + crow(i, h); if (strict ? !(row < col) : !(row <= col)) v[i] = 0.f; }
}
DI void rw_mask_lower_strict(f32x16& v, int mb, int nb, int lane) {
  const int col = nb * 32 + (lane & 31), h = lane >> 5;
#pragma unroll
  for (int i = 0; i < 16; ++i) { const int row = mb * 32 + crow(i, h); if (!(col < row)) v[i] = 0.f; }
}

constexpr int RW1_ITEMS = NSEQ_ * NCH_;
DI void rw_chunk_item(const Params& p, int it, char* smem) {
  const int s = it / NCH_, c = it % NCH_, dir = s >> 3, b = (s >> 2) & 1, hd = s & 3;
  const int tid = opaque_tid(), lane = tid & 63, wid = tid >> 6;
  const bf16_t* rb = (const bf16_t*)(p.ws + OFF_REGION + R_RB16);
  const float* lwg = (const float*)(p.ws + OFF_REGION + R_LW) + (size_t)dir * NT_ * 256;
  const size_t AS = (size_t)NT_ * 256;
  char* const At = smem + 0 * RW_MB; char* const Bt_ = smem + 1 * RW_MB; char* const Kt = smem + 2 * RW_MB; char* const Rt = smem + 3 * RW_MB;
  char* const Aj = smem + 4 * RW_MB; char* const Bj = smem + 5 * RW_MB; char* const Kj = smem + 6 * RW_MB; char* const Vi = smem + 7 * RW_MB;
  char* const QA = smem + 8 * RW_MB; char* const QTA = smem + 9 * RW_MB; char* const GA = smem + 10 * RW_MB;
  char* const Mka = smem + 11 * RW_MB; char* const MbrT = smem + 12 * RW_MB; char* const MkrT = smem + 13 * RW_MB;
  char* const QB = At; char* const QTB = Bt_; char* const GB = Kt;
  float* const cs = (float*)(smem + 8 * RW_MB);
  float* const gC = (float*)(smem + 14 * RW_MB);
  char* rec = rw_rec(p, s, c);
  __syncthreads();
  const int t = tid >> 3, j8 = (tid & 7) * 8;
  const int n = seq_tok(dir, b, c * 64 + t);
  {
    const float4 l0 = *(const float4*)(lwg + (size_t)n * 256 + hd * 64 + j8), l1 = *(const float4*)(lwg + (size_t)n * 256 + hd * 64 + j8 + 4);
    float* d = cs + t * 65 + j8;
    d[0] = l0.x; d[1] = l0.y; d[2] = l0.z; d[3] = l0.w; d[4] = l1.x; d[5] = l1.y; d[6] = l1.z; d[7] = l1.w;
  }
  __syncthreads();
  if (tid < 64) { float a = 0.f; for (int tt = 0; tt < 64; ++tt) { a += cs[tt * 65 + tid]; cs[tt * 65 + tid] = a; } gC[tid] = fexp(a); }
  __syncthreads();
  {
    const size_t o = (size_t)n * 256 + hd * 64 + j8;
    const uint4 ukk = *(const uint4*)(rb + 2 * AS + o), ubb = *(const uint4*)(rb + (4 + 2 * dir) * AS + o), ukd = *(const uint4*)(rb + (3 + 2 * dir) * AS + o);
    const uint4 ur = *(const uint4*)(rb + 0 * AS + o), uv = *(const uint4*)(rb + 1 * AS + o);
    const unsigned akk[4] = {ukk.x, ukk.y, ukk.z, ukk.w}, abb[4] = {ubb.x, ubb.y, ubb.z, ubb.w}, akd[4] = {ukd.x, ukd.y, ukd.z, ukd.w};
    const unsigned ar[4] = {ur.x, ur.y, ur.z, ur.w}, av[4] = {uv.x, uv.y, uv.z, uv.w};
    unsigned oa[4], ob[4], ok[4], orr[4];
#pragma unroll
    for (int q = 0; q < 4; ++q) {
      float fa[2], fb[2], fk[2], fr[2];
#pragma unroll
      for (int e = 0; e < 2; ++e) {
        const int j = j8 + 2 * q + e;
        const float cst = cs[t * 65 + j], csp = t > 0 ? cs[(t - 1) * 65 + j] : 0.f;
        const float g = fexp(cst), gp = fexp(csp), gi = fexp(-cst);
        const int sh = 16 * e;
        fa[e] = -bf2f((bf16_t)((akk[q] >> sh) & 0xffff)) * gp;
        fb[e] = bf2f((bf16_t)((abb[q] >> sh) & 0xffff)) * gi;
        fk[e] = bf2f((bf16_t)((akd[q] >> sh) & 0xffff)) * gi;
        fr[e] = bf2f((bf16_t)((ar[q] >> sh) & 0xffff)) * g;
        *(bf16_t*)(Aj + (j * RW_LD + t) * 2) = f2bf(fa[e]);
        *(bf16_t*)(Bj + (j * RW_LD + t) * 2) = f2bf(fb[e]);
        *(bf16_t*)(Kj + (j * RW_LD + t) * 2) = f2bf(fk[e]);
        *(bf16_t*)(Vi + (j * RW_LD + t) * 2) = (bf16_t)((av[q] >> sh) & 0xffff);
      }
      oa[q] = pack2bf(fa[0], fa[1]); ob[q] = pack2bf(fb[0], fb[1]); ok[q] = pack2bf(fk[0], fk[1]); orr[q] = pack2bf(fr[0], fr[1]);
    }
    *(uint4*)(At + (t * RW_LD + j8) * 2) = make_uint4(oa[0], oa[1], oa[2], oa[3]);
    *(uint4*)(Bt_ + (t * RW_LD + j8) * 2) = make_uint4(ob[0], ob[1], ob[2], ob[3]);
    *(uint4*)(Kt + (t * RW_LD + j8) * 2) = make_uint4(ok[0], ok[1], ok[2], ok[3]);
    *(uint4*)(Rt + (t * RW_LD + j8) * 2) = make_uint4(orr[0], orr[1], orr[2], orr[3]);
  }
  __syncthreads();
  {
    const int prod = wid >> 2, mb = (wid >> 1) & 1, nb = wid & 1;
    f32x16 acc = zero16();
    if (prod == 0) {
      if (!(mb == 1 && nb == 0)) acc = rw_mm(Bt_, At, mb, nb, lane, acc);
      rw_mask_upper(acc, mb, nb, lane, true);
      rw_wrT(QA, mb, nb, lane, acc);
      if (mb == nb) {
        const int col = nb * 32 + (lane & 31), h = lane >> 5;
#pragma unroll
        for (int i = 0; i < 16; ++i) if (mb * 32 + crow(i, h) == col) acc[i] += 1.f;
      }
      rw_wrT(GA, mb, nb, lane, acc);
    } else {
      if (!(mb == 0 && nb == 1)) acc = rw_mm(At, Bt_, mb, nb, lane, acc);
      rw_mask_lower_strict(acc, mb, nb, lane);
      rw_wrT(QTA, mb, nb, lane, acc);
    }
  }
  for (int blk = wid; blk < 12; blk += 8) {
    const int prod = blk >> 2, mb = (blk >> 1) & 1, nb = blk & 1;
    f32x16 acc = zero16();
    if (prod == 0) {
      acc = rw_mm(At, Kt, mb, nb, lane, acc); rw_mask_lower_strict(acc, mb, nb, lane); rw_wrT(Mka, mb, nb, lane, acc);
    } else if (prod == 1) {
      acc = rw_mm(Bt_, Rt, mb, nb, lane, acc); rw_mask_upper(acc, mb, nb, lane, false); rw_wrT(MbrT, mb, nb, lane, acc);
    } else {
      acc = rw_mm(Kt, Rt, mb, nb, lane, acc); rw_mask_upper(acc, mb, nb, lane, false); rw_wrT(MkrT, mb, nb, lane, acc);
    }
  }
  __syncthreads();
#define RW_SQ(Q_, Qt_, Qn_, Qtn_, blk) { const int pr_ = (blk) >> 2, mb_ = ((blk) >> 1) & 1, nb_ = (blk) & 1; f32x16 acc_ = zero16(); \
    if (pr_ == 0) { acc_ = rw_mm(Q_, Qt_, mb_, nb_, lane, acc_); rw_wrT(Qtn_, mb_, nb_, lane, acc_); } \
    else { acc_ = rw_mm(Qt_, Q_, mb_, nb_, lane, acc_); rw_wrT(Qn_, mb_, nb_, lane, acc_); } }
#define RW_GUP(Qt_, G_, Gn_, blk) { const int mb_ = ((blk) >> 1) & 1, nb_ = (blk) & 1; f32x16 acc_ = zero16(); \
    rw_addT(G_, mb_, nb_, lane, acc_); acc_ = rw_mm(Qt_, G_, mb_, nb_, lane, acc_); rw_wrT(Gn_, mb_, nb_, lane, acc_); }
  RW_SQ(QA, QTA, QB, QTB, wid);
  __syncthreads();
  for (int blk = wid; blk < 12; blk += 8) { if (blk < 8) { RW_SQ(QB, QTB, QA, QTA, blk); } else { RW_GUP(QTB, GA, GB, blk - 8); } }
  __syncthreads();
  for (int blk = wid; blk < 12; blk += 8) { if (blk < 8) { RW_SQ(QA, QTA, QB, QTB, blk); } else { RW_GUP(QTA, GB, GA, blk - 8); } }
  __syncthreads();
  for (int blk = wid; blk < 12; blk += 8) { if (blk < 8) { RW_SQ(QB, QTB, QA, QTA, blk); } else { RW_GUP(QTB, GA, GB, blk - 8); } }
  __syncthreads();
  for (int blk = wid; blk < 12; blk += 8) { if (blk < 8) { RW_SQ(QA, QTA, QB, QTB, blk); } else { RW_GUP(QTA, GB, GA, blk - 8); } }
  __syncthreads();
  if (wid < 4) { RW_GUP(QTB, GA, GB, wid); }
  __syncthreads();
  {
    const int prod = wid >> 2, mb = (wid >> 1) & 1, nb = wid & 1;
    f32x16 acc = zero16();
    acc = rw_mm(GB, prod == 0 ? Mka : Aj, mb, nb, lane, acc);
    rw_wrT(prod == 0 ? QA : QTA, mb, nb, lane, acc);
  }
  __syncthreads();
  char* const X1 = QA; char* const X2 = QTA; char* const QpT = At;
  for (int blk = wid; blk < 16; blk += 8) {
    const int prod = blk >> 2, mb = (blk >> 1) & 1, nb = blk & 1;
    f32x16 acc = zero16();
    if (prod == 0) {
      rw_addT(MkrT, mb, nb, lane, acc); acc = rw_mm(X1, MbrT, mb, nb, lane, acc); rw_mask_upper(acc, mb, nb, lane, false);
      rw_wrT_g((bf16_t*)(rec + 8192), mb, nb, lane, acc);
    } else if (prod == 1) {
      rw_addT(Rt, mb, nb, lane, acc); acc = rw_mm(X2, MbrT, mb, nb, lane, acc);
      rw_wrT_g((bf16_t*)(rec), mb, nb, lane, acc);
    } else if (prod == 2) {
      acc = rw_mm(X2, Bj, mb, nb, lane, acc);
      const int col = nb * 32 + (lane & 31), h = lane >> 5; const float gc = gC[col];
#pragma unroll
      for (int i = 0; i < 16; ++i) { if (mb * 32 + crow(i, h) == col) acc[i] += 1.f; acc[i] *= gc; }
      rw_wrT_g((bf16_t*)(rec + 16384), mb, nb, lane, acc);
    } else {
      rw_addT(Kj, mb, nb, lane, acc); acc = rw_mm(X1, Bj, mb, nb, lane, acc);
      const float gc = gC[nb * 32 + (lane & 31)];
#pragma unroll
      for (int i = 0; i < 16; ++i) acc[i] *= gc;
      rw_wrT(QpT, mb, nb, lane, acc);
    }
  }
  __syncthreads();
  if (wid < 4) {
    const int mb = (wid >> 1) & 1, nb = wid & 1, r = lane & 31, h = lane >> 5;
    f32x16 acc = zero16();
    acc = rw_mm(QpT, Vi, mb, nb, lane, acc);
    float* dq = (float*)(rec + 24576);
#pragma unroll
    for (int g = 0; g < 4; ++g)
      *(float4*)(dq + (nb * 32 + r) * 64 + mb * 32 + 8 * g + 4 * h) = make_float4(acc[4 * g], acc[4 * g + 1], acc[4 * g + 2], acc[4 * g + 3]);
  }
}

constexpr int RW2_ITEMS = NSEQ_;
constexpr int RW2_DQLD = 68;
constexpr int RW2_STAGE = RW_MB + 64 * RW2_DQLD * 4;
DI void rw_state_item(const Params& p, int s, char* smem) {
  const int tid = opaque_tid(), lane = tid & 63, wid = tid >> 6, r = lane & 31, h = lane >> 5;
  f32x16 S0 = zero16(), S1 = zero16();
  uint4 rp, rd0, rd1;
  const int prow = tid >> 3, pcol = (tid & 7) * 8;
  const int drow = tid >> 3, dcol = (tid & 7) * 8;
  __syncthreads();
  {
    const char* rec = rw_rec(p, s, 0);
    rp = *(const uint4*)(rec + 16384 + (prow * 64 + pcol) * 2);
    rd0 = *(const uint4*)(rec + 24576 + (drow * 64 + dcol) * 4); rd1 = *(const uint4*)(rec + 24576 + (drow * 64 + dcol + 4) * 4);
    *(uint4*)(smem + (prow * RW_LD + pcol) * 2) = rp;
    *(uint4*)(smem + RW_MB + (drow * RW2_DQLD + dcol) * 4) = rd0; *(uint4*)(smem + RW_MB + (drow * RW2_DQLD + dcol + 4) * 4) = rd1;
  }
  __syncthreads();
  for (int c = 0; c < NCH_; ++c) {
    const bool more = c + 1 < NCH_;
    if (more) {
      const char* rec = rw_rec(p, s, c + 1);
      rp = *(const uint4*)(rec + 16384 + (prow * 64 + pcol) * 2);
      rd0 = *(const uint4*)(rec + 24576 + (drow * 64 + dcol) * 4); rd1 = *(const uint4*)(rec + 24576 + (drow * 64 + dcol + 4) * 4);
    }
    if (wid < 2) {
      const char* PT = smem + (c & 1) * RW2_STAGE;
      const float* DQ = (const float*)(PT + RW_MB);
      const int i = wid * 32 + r;
      bf16_t* sd = (bf16_t*)(rw_rec(p, s, c) + 16384);
#pragma unroll
      for (int g = 0; g < 4; ++g) {
        uint2 o0, o1;
        o0.x = pack2bf(S0[4 * g], S0[4 * g + 1]); o0.y = pack2bf(S0[4 * g + 2], S0[4 * g + 3]);
        o1.x = pack2bf(S1[4 * g], S1[4 * g + 1]); o1.y = pack2bf(S1[4 * g + 2], S1[4 * g + 3]);
        *(uint2*)(sd + i * 64 + 8 * g + 4 * h) = o0; *(uint2*)(sd + i * 64 + 32 + 8 * g + 4 * h) = o1;
      }
      bf16x8 bfr[2][2];
#pragma unroll
      for (int s2 = 0; s2 < 2; ++s2) {
        const uint4 u0 = make_uint4(pack2bf(S0[8 * s2], S0[8 * s2 + 1]), pack2bf(S0[8 * s2 + 2], S0[8 * s2 + 3]), pack2bf(S0[8 * s2 + 4], S0[8 * s2 + 5]), pack2bf(S0[8 * s2 + 6], S0[8 * s2 + 7]));
        const uint4 u1 = make_uint4(pack2bf(S1[8 * s2], S1[8 * s2 + 1]), pack2bf(S1[8 * s2 + 2], S1[8 * s2 + 3]), pack2bf(S1[8 * s2 + 4], S1[8 * s2 + 5]), pack2bf(S1[8 * s2 + 6], S1[8 * s2 + 7]));
        __builtin_memcpy(&bfr[0][s2], &u0, 16); __builtin_memcpy(&bfr[1][s2], &u1, 16);
      }
      f32x16 n0, n1;
#pragma unroll
      for (int g = 0; g < 4; ++g) {
        const float4 a = *(const float4*)(DQ + i * RW2_DQLD + 8 * g + 4 * h), bq = *(const float4*)(DQ + i * RW2_DQLD + 32 + 8 * g + 4 * h);
        n0[4 * g] = a.x; n0[4 * g + 1] = a.y; n0[4 * g + 2] = a.z; n0[4 * g + 3] = a.w;
        n1[4 * g] = bq.x; n1[4 * g + 1] = bq.y; n1[4 * g + 2] = bq.z; n1[4 * g + 3] = bq.w;
      }
#pragma unroll
      for (int jb2 = 0; jb2 < 2; ++jb2)
#pragma unroll
        for (int s2 = 0; s2 < 2; ++s2) {
          const char* a0 = PT + ((0 * 32 + r) * RW_LD + jb2 * 32 + 16 * s2 + 4 * h) * 2;
          const char* a1 = PT + ((1 * 32 + r) * RW_LD + jb2 * 32 + 16 * s2 + 4 * h) * 2;
          const uint2 l0 = *(const uint2*)a0, h0 = *(const uint2*)(a0 + 16), l1 = *(const uint2*)a1, h1 = *(const uint2*)(a1 + 16);
          const uint4 u0 = make_uint4(l0.x, l0.y, h0.x, h0.y), u1 = make_uint4(l1.x, l1.y, h1.x, h1.y);
          bf16x8 af0, af1; __builtin_memcpy(&af0, &u0, 16); __builtin_memcpy(&af1, &u1, 16);
          n0 = mfma32(af0, bfr[jb2][s2], n0);
          n1 = mfma32(af1, bfr[jb2][s2], n1);
        }
      S0 = n0; S1 = n1;
    }
    if (more) {
      char* d = smem + ((c + 1) & 1) * RW2_STAGE;
      *(uint4*)(d + (prow * RW_LD + pcol) * 2) = rp;
      *(uint4*)(d + RW_MB + (drow * RW2_DQLD + dcol) * 4) = rd0; *(uint4*)(d + RW_MB + (drow * RW2_DQLD + dcol + 4) * 4) = rd1;
    }
    __syncthreads();
  }
}

DI void rw_out_item(const Params& p, int it, char* smem) {
  const int s = it / NCH_, c = it % NCH_, dir = s >> 3, b = (s >> 2) & 1, hd = s & 3;
  const int tid = opaque_tid(), lane = tid & 63, wid = tid >> 6;
  const bf16_t* rb = (const bf16_t*)(p.ws + OFF_REGION + R_RB16);
  const size_t AS = (size_t)NT_ * 256;
  float* ys = (float*)(p.ws + OFF_REGION + R_YS) + (size_t)dir * NT_ * 256;
  char* const Sm = smem; char* const RyT = smem + RW_MB; char* const MyT = smem + 2 * RW_MB; char* const Vi = smem + 3 * RW_MB;
  const char* rec = rw_rec(p, s, c);
  __syncthreads();
  {
    const int row = tid >> 3, col = (tid & 7) * 8;
    *(uint4*)(Sm + (row * RW_LD + col) * 2) = *(const uint4*)(rec + 16384 + (row * 64 + col) * 2);
    *(uint4*)(RyT + (row * RW_LD + col) * 2) = *(const uint4*)(rec + (row * 64 + col) * 2);
    *(uint4*)(MyT + (row * RW_LD + col) * 2) = *(const uint4*)(rec + 8192 + (row * 64 + col) * 2);
    const int n = seq_tok(dir, b, c * 64 + row);
    const uint4 uv = *(const uint4*)(rb + 1 * AS + (size_t)n * 256 + hd * 64 + col);
    const unsigned av[4] = {uv.x, uv.y, uv.z, uv.w};
#pragma unroll
    for (int q = 0; q < 4; ++q) {
      *(bf16_t*)(Vi + ((col + 2 * q) * RW_LD + row) * 2) = (bf16_t)(av[q] & 0xffff);
      *(bf16_t*)(Vi + ((col + 2 * q + 1) * RW_LD + row) * 2) = (bf16_t)(av[q] >> 16);
    }
  }
  __syncthreads();
  if (wid < 4) {
    const int mb = (wid >> 1) & 1, nb = wid & 1, r = lane & 31, h = lane >> 5;
    f32x16 acc = zero16();
    acc = rw_mm(Sm, RyT, mb, nb, lane, acc);
    acc = rw_mm(Vi, MyT, mb, nb, lane, acc);
    const int n = seq_tok(dir, b, c * 64 + nb * 32 + r);
#pragma unroll
    for (int g = 0; g < 4; ++g)
      *(float4*)(ys + (size_t)n * 256 + hd * 64 + mb * 32 + 8 * g + 4 * h) = make_float4(acc[4 * g], acc[4 * g + 1], acc[4 * g + 2], acc[4 * g + 3]);
  }
}
constexpr int ATT_KLD = 104, ATT_VLD = 68;
constexpr int ATT_KB = 64 * ATT_KLD * 2, ATT_VB = 64 * ATT_VLD * 2, ATT_STAGE = ATT_KB + ATT_VB;
DI float fexp2(float x) {
#ifdef EMU
  return exp2f(x);
#else
  return __builtin_amdgcn_exp2f(x);
#endif
}
DI void attn_item(const Params& p, int b, int h, int qt, bool isctx, char* smem) {
  const int tid = opaque_tid(), lane = tid & 63, wid = tid >> 6, r = lane & 31, h2 = lane >> 5;
  const bf16_t* qb = (const bf16_t*)(p.osc + O_QB);
  const bf16_t* kbase = (const bf16_t*)(p.ws + OFF_REGION + R_KB) + (size_t)(b * 8 + h) * KT_ * 96;
  const bf16_t* vbase = (const bf16_t*)(p.ws + OFF_REGION + R_VT) + (size_t)(b * 8 + h) * 64 * KT_;
  bf16_t* att = (bf16_t*)(p.ws + OFF_REGION + R_ATT);
  const int nq0 = isctx ? NX_ + b * CL_ + qt * 256 : b * T_ + qt * 256;
  const int nkt = (isctx ? CL_ : KT_) / 64;
  const int nq = nq0 + wid * 32 + r;
  bf16x8 qf[6];
#pragma unroll
  for (int ks = 0; ks < 6; ++ks) qf[ks] = *(const bf16x8*)(qb + (size_t)nq * 768 + h * 96 + ks * 16 + h2 * 8);
  f32x16 oacc[2] = {zero16(), zero16()};
  float m = -1e30f, lsum = 0.f;
  const float sc = 0.10206207261596577f * 1.4426950408889634f;
  const int kc1 = tid + 512;
  const int vd = tid >> 3, vc = tid & 7;
  uint4 rk0, rk1, rv;
  auto gload = [&](int kt) {
    const bf16_t* ksrc = kbase + (size_t)kt * 64 * 96;
    rk0 = *(const uint4*)(ksrc + tid * 8);
    if (kc1 < 768) rk1 = *(const uint4*)(ksrc + kc1 * 8);
    rv = *(const uint4*)(vbase + (size_t)vd * KT_ + kt * 64 + vc * 8);
  };
  auto sstore = [&](int buf) {
    char* Ks = smem + buf * ATT_STAGE; char* Vs = Ks + ATT_KB;
    *(uint4*)(Ks + ((tid / 12) * ATT_KLD + (tid % 12) * 8) * 2) = rk0;
    if (kc1 < 768) *(uint4*)(Ks + ((kc1 / 12) * ATT_KLD + (kc1 % 12) * 8) * 2) = rk1;
    *(uint2*)(Vs + (vd * ATT_VLD + vc * 8) * 2) = make_uint2(rv.x, rv.y);
    *(uint2*)(Vs + (vd * ATT_VLD + vc * 8 + 4) * 2) = make_uint2(rv.z, rv.w);
  };
  __syncthreads();
  gload(0); sstore(0);
  __syncthreads();
  for (int kt = 0; kt < nkt; ++kt) {
    const bool more = kt + 1 < nkt;
    if (more) gload(kt + 1);
    const char* Ks = smem + (kt & 1) * ATT_STAGE; const char* Vs = Ks + ATT_KB;
    f32x16 sacc[2] = {zero16(), zero16()};
#pragma unroll
    for (int ks = 0; ks < 6; ++ks)
#pragma unroll
      for (int kb = 0; kb < 2; ++kb) {
        const bf16x8 kf = *(const bf16x8*)(Ks + ((kb * 32 + r) * ATT_KLD + ks * 16 + h2 * 8) * 2);
        sacc[kb] = mfma32(kf, qf[ks], sacc[kb]);
      }
    float mx = -1e30f;
#pragma unroll
    for (int kb = 0; kb < 2; ++kb)
#pragma unroll
      for (int i = 0; i < 16; ++i) mx = fmaxf(mx, sacc[kb][i]);
    mx = fmaxf(mx, __shfl_xor(mx, 32));
    const float mn = fmaxf(m, mx * sc);
    const float alpha = fexp2(m - mn);
    m = mn;
    float ps = 0.f;
#pragma unroll
    for (int kb = 0; kb < 2; ++kb)
#pragma unroll
      for (int i = 0; i < 16; ++i) { const float pv = fexp2(sacc[kb][i] * sc - mn); sacc[kb][i] = pv; ps += pv; }
    lsum = lsum * alpha + ps;
#pragma unroll
    for (int db = 0; db < 2; ++db)
#pragma unroll
      for (int i = 0; i < 16; ++i) oacc[db][i] *= alpha;
#pragma unroll
    for (int kb = 0; kb < 2; ++kb)
#pragma unroll
      for (int s = 0; s < 2; ++s) {
        bf16x8 pf;
        {
          const unsigned u0 = pack2bf(sacc[kb][8 * s + 0], sacc[kb][8 * s + 1]), u1 = pack2bf(sacc[kb][8 * s + 2], sacc[kb][8 * s + 3]);
          const unsigned u2 = pack2bf(sacc[kb][8 * s + 4], sacc[kb][8 * s + 5]), u3 = pack2bf(sacc[kb][8 * s + 6], sacc[kb][8 * s + 7]);
          const uint4 u = make_uint4(u0, u1, u2, u3);
          __builtin_memcpy(&pf, &u, 16);
        }
#pragma unroll
        for (int db = 0; db < 2; ++db) {
          const char* vrow = Vs + ((db * 32 + r) * ATT_VLD + kb * 32 + 16 * s + 4 * h2) * 2;
          const uint2 lo = *(const uint2*)(vrow), hi = *(const uint2*)(vrow + 16);
          const uint4 u = make_uint4(lo.x, lo.y, hi.x, hi.y);
          bf16x8 vf; __builtin_memcpy(&vf, &u, 16);
          oacc[db] = mfma32(vf, pf, oacc[db]);
        }
      }
    if (more) sstore((kt + 1) & 1);
    __syncthreads();
  }
  lsum += __shfl_xor(lsum, 32);
  const float inv = 1.f / lsum;
#pragma unroll
  for (int db = 0; db < 2; ++db)
#pragma unroll
    for (int g = 0; g < 4; ++g) {
      uint2 o;
      o.x = pack2bf(oacc[db][g * 4 + 0] * inv, oacc[db][g * 4 + 1] * inv);
      o.y = pack2bf(oacc[db][g * 4 + 2] * inv, oacc[db][g * 4 + 3] * inv);
      *(uint2*)(att + (size_t)nq * 512 + h * 64 + db * 32 + 8 * g + 4 * h2) = o;
    }
}

constexpr int P3B_ITEMS = RW1_ITEMS + ML2_ITEMS + MLA_Q_TILES + MLA_KV_TILES;
DI void phase3b(const Params& p, int l, char* smem) {
  for (int it = vblock(); it < P3B_ITEMS; it += gridDim.x) {
    int i = it;
    if (i < RW1_ITEMS) { rw_chunk_item(p, i, smem); continue; }
    i -= RW1_ITEMS;
    if (i < ML2_ITEMS) { mlstm_scan_item(p, i); continue; }
    i -= ML2_ITEMS;
    if (i < MLA_Q_TILES) mla_q_item(p, l, i, smem); else mla_kv_item(p, l, i - MLA_Q_TILES, smem);
  }
}

DI constexpr int att_items(int l) { return NB_ * 8 * (T_ / 256) + (l == 0 ? NB_ * 8 * (CL_ / 256) : 0); }
DI void spin_until_ge(int* ctr, int target) {
#ifdef EMU
  while (__atomic_load_n(ctr, __ATOMIC_SEQ_CST) < target) emu::yield();
#else
  while (__hip_atomic_load(ctr, __ATOMIC_RELAXED, __HIP_MEMORY_SCOPE_AGENT) < target) __builtin_amdgcn_s_sleep(8);
#endif
}
DI void phase4(const Params& p, int l, char* smem, int* ctr) {
  const int G = gridDim.x, nsb = G >= 2 * RW2_ITEMS ? RW2_ITEMS : (G > 1 ? G / 2 : 1);
  if ((int)blockIdx.x < nsb) {
    for (int s = blockIdx.x; s < RW2_ITEMS; s += nsb) rw_state_item(p, s, smem);
#ifndef EMU
    asm volatile("s_waitcnt vmcnt(0)" ::: "memory");
#endif
    __syncthreads();
    if (opaque_tid() == 0) { __threadfence(); atomicAdd(ctr + 2, (RW2_ITEMS - (int)blockIdx.x + nsb - 1) / nsb); }
  }
  const int QT = T_ / 256, CQ = (l == 0 ? (NB_ * 8 * (CL_ / 256)) / 8 : 0), R3 = RW1_ITEMS / 8;
  const int per = 2 * QT + CQ + R3;
  int* sitem = (int*)(smem + 160 * 1024 - 16);
  bool r2ok = false;
  const int x0 = xcc_id();
  for (;;) {
    __syncthreads();
    if (opaque_tid() == 0) {
      int item = -1;
      for (int k = 0; k < 8 && item < 0; ++k) {
        const int x = (x0 + k) & 7;
        if (ld_relaxed(ctr + 8 + x) >= per) continue;
        const int li = atomicAdd(ctr + 8 + x, 1);
        if (li < per) item = x * per + li;
      }
      *sitem = item;
    }
    __syncthreads();
    const int item = *sitem;
    if (item < 0) break;
    const int x = item / per; int li = item % per;
    if (li < 2 * QT) { const int bh = 2 * x + li / QT, qt = li % QT; attn_item(p, bh >> 3, bh & 7, qt, false, smem); continue; }
    li -= 2 * QT;
    if (li < CQ) { const int ci = x * CQ + li, qt = ci % (CL_ / 256), bh = ci / (CL_ / 256); attn_item(p, bh >> 3, bh & 7, qt, true, smem); continue; }
    li -= CQ;
    if (!r2ok) {
      if (opaque_tid() == 0) { spin_until_ge(ctr + 2, RW2_ITEMS); __threadfence(); }
      __syncthreads();
      r2ok = true;
    }
    rw_out_item(p, x * R3 + li, smem);
  }
}
constexpr int ML3_CC = CL_ / 64, ML3_XC = T_ / 64;
DI constexpr int ml3_items(bool with_ctx) { return NB_ * 4 * (ML3_XC + (with_ctx ? ML3_CC : 0)); }
DI void mlstm_out_item(const Params& p, int l, int it, bool with_ctx, char* smem) {
  const int per = ML3_XC + (with_ctx ? ML3_CC : 0);
  const int bh = it / per, b = bh >> 2, hd = bh & 3;
  int tc = it % per; if (!with_ctx) tc += ML3_CC;
  const bool isctx = tc < ML3_CC;
  const int ntok0 = isctx ? NX_ + b * CL_ + tc * 64 : b * T_ + (tc - ML3_CC) * 64;
  float* qs = (float*)smem;
  float* ks = qs + 64 * 33;
  float* vs = ks + 64 * 33;
  float* Cs = vs + 64 * 64;
  float* Sm = Cs + 64 * 33;
  float* hs = Sm + 64 * 65;
  float* bj = hs + 64 * 64;
  float* ip = bj + 64;
  float* ns = ip + 64;
  const float* zrec = (const float*)(p.ws + OFF_REGION + R_ZREC);
  const int tid = opaque_tid(), lane = tid & 63, wid = tid >> 6;
  __syncthreads();
  for (int idx = tid; idx < 64 * 64; idx += NTHR) hs[idx] = 0.f;
  for (int dir = 0; dir < 2; ++dir) {
    const int c = dir == 0 ? tc : (isctx ? ML3_CC - 1 - tc : ML3_CC + (ML3_XC - 1 - (tc - ML3_CC)));
    const int s = dir * 8 + b * 4 + hd;
    const float* st = (const float*)(p.ws + OFF_REGION + R_MLST) + ((size_t)s * NCH_ + c) * ML_ST;
    const float m_start = st[2082];
    __syncthreads();
    for (int idx = tid; idx < 64 * 32; idx += NTHR) {
      const int j = idx >> 5, e = idx & 31;
      const int n = ntok0 + (dir ? 63 - j : j);
      qs[j * 33 + e] = zrec[(size_t)n * ZREC_W + ZR_MLQ + hd * 32 + e] * 0.17677669529663687f;
      ks[j * 33 + e] = zrec[(size_t)n * ZREC_W + ZR_MLK + hd * 32 + e];
      Cs[j * 33 + e] = st[j * 32 + e];
    }
    for (int idx = tid; idx < 64 * 64; idx += NTHR) {
      const int j = idx >> 6, e = idx & 63;
      const int n = ntok0 + (dir ? 63 - j : j);
      vs[idx] = zrec[(size_t)n * ZREC_W + ZR_MLV + hd * 64 + e];
    }
    if (tid < 32) ns[tid] = st[2048 + tid];
    if (wid == 1) {
      const int n = ntok0 + (dir ? 63 - lane : lane);
      const float fp = zrec[(size_t)n * ZREC_W + ZR_MLF + dir * 4 + hd] + p.ml_b_f[(l * 2 + dir) * 4 + hd];
      ip[lane] = zrec[(size_t)n * ZREC_W + ZR_MLI + dir * 4 + hd] + p.ml_b_i[(l * 2 + dir) * 4 + hd];
      bj[lane] = wave_incl_scan(logsigmoidf_(fp), lane);
    }
    __syncthreads();
    const int j = tid >> 3, sg = tid & 7;
    const float bjj = bj[j];
    float rmax = -1e30f;
#pragma unroll 1
    for (int u = 0; u < 8; ++u) {
      const int sI = sg * 8 + u;
      float d = 0.f;
#pragma unroll 8
      for (int e = 0; e < 32; ++e) d += qs[j * 33 + e] * ks[sI * 33 + e];
      Sm[j * 65 + sI] = d;
      const float dl = sI <= j ? bjj - bj[sI] + ip[sI] : -1e30f;
      rmax = fmaxf(rmax, dl);
    }
    rmax = fmaxf(rmax, __shfl_xor(rmax, 1)); rmax = fmaxf(rmax, __shfl_xor(rmax, 2)); rmax = fmaxf(rmax, __shfl_xor(rmax, 4));
    const float g = bjj + m_start;
    const float mj = fmaxf(g, rmax);
    const float inter = fexp(g - mj);
    float part = 0.f;
#pragma unroll 1
    for (int u = 0; u < 8; ++u) {
      const int sI = sg * 8 + u;
      const float sv = sI <= j ? fexp(bjj - bj[sI] + ip[sI] - mj) * Sm[j * 65 + sI] : 0.f;
      Sm[j * 65 + sI] = sv; part += sv;
    }
    float nq = 0.f;
#pragma unroll
    for (int e = 0; e < 4; ++e) nq += ns[sg * 4 + e] * qs[j * 33 + sg * 4 + e];
    part += inter * nq;
    part += __shfl_xor(part, 1); part += __shfl_xor(part, 2); part += __shfl_xor(part, 4);
    const float den = fmaxf(fabsf(part), fexp(-mj));
    __syncthreads();
    const int v0 = sg * 8;
    float num[8], cq[8];
#pragma unroll
    for (int u = 0; u < 8; ++u) { num[u] = 0.f; cq[u] = 0.f; }
#pragma unroll 2
    for (int sI = 0; sI <= j; ++sI) {
      const float sv = Sm[j * 65 + sI];
      const float4 va = *(const float4*)(vs + sI * 64 + v0), vb = *(const float4*)(vs + sI * 64 + v0 + 4);
      num[0] += sv * va.x; num[1] += sv * va.y; num[2] += sv * va.z; num[3] += sv * va.w;
      num[4] += sv * vb.x; num[5] += sv * vb.y; num[6] += sv * vb.z; num[7] += sv * vb.w;
    }
#pragma unroll 2
    for (int e = 0; e < 32; ++e) {
      const float qv = qs[j * 33 + e];
#pragma unroll
      for (int u = 0; u < 8; ++u) cq[u] += Cs[(v0 + u) * 33 + e] * qv;
    }
    const float rden = 1.f / den;
#pragma unroll
    for (int u = 0; u < 8; ++u) hs[(dir ? 63 - j : j) * 64 + v0 + u] += (num[u] + inter * cq[u]) * rden;
    __syncthreads();
  }
  const int tk = tid >> 3, v0 = (tid & 7) * 8, n = ntok0 + tk;
  float ss = 0.f; float hv[8];
#pragma unroll
  for (int u = 0; u < 8; ++u) { hv[u] = hs[tk * 64 + v0 + u]; ss += hv[u] * hv[u]; }
  ss += __shfl_xor(ss, 1); ss += __shfl_xor(ss, 2); ss += __shfl_xor(ss, 4);
  const float rs = 1.0f / sqrtf(ss * (1.f / 64.f) + 1e-6f);
  unsigned o[4];
#pragma unroll
  for (int u = 0; u < 8; u += 2) {
    const int cc = hd * 64 + v0 + u;
    const float a = hv[u] * rs * p.ml_g_norm[l * 256 + cc] * sigmoidf_(zrec[(size_t)n * ZREC_W + ZR_MLO + cc]);
    const float bq = hv[u + 1] * rs * p.ml_g_norm[l * 256 + cc + 1] * sigmoidf_(zrec[(size_t)n * ZREC_W + ZR_MLO + cc + 1]);
    o[u >> 1] = pack2bf(a, bq);
  }
  bf16_t* mlo = (bf16_t*)(p.ws + OFF_REGION + R_MLO);
  *(uint4*)(mlo + (size_t)n * 256 + hd * 64 + v0) = make_uint4(o[0], o[1], o[2], o[3]);
}

DI constexpr int rwo_items(bool with_ctx) { return (with_ctx ? NT_ : NX_) / 16; }
DI void rwkv_out_item(const Params& p, int l, int it, char* smem) {
  float* sg = (float*)smem;
  const float* zrec = (const float*)(p.ws + OFF_REGION + R_ZREC);
  const bf16_t* rb = (const bf16_t*)(p.ws + OFF_REGION + R_RB16);
  const float* bso = (const float*)(p.ws + OFF_REGION + R_BS);
  const float* ys = (const float*)(p.ws + OFF_REGION + R_YS);
  bf16_t* rwo = (bf16_t*)(p.ws + OFF_REGION + R_RWO);
  const float* mu = p.rw_mu + (size_t)l * 1152;
  const int tid = opaque_tid(), n0 = it * 16;
  __syncthreads();
  for (int idx = tid; idx < 16 * 128; idx += NTHR) {
    const int tt = idx >> 7, k = idx & 127, n = n0 + tt, t = tok_t(n), c = 1024 + k;
    const int len = n < NX_ ? T_ : CL_;
    const float* zr = zrec + (size_t)n * ZREC_W + ZR_RW + c;
    const float z = zr[0];
    const float zp = t > 0 ? zr[-ZREC_W] : 0.f, zn = t < len - 1 ? zr[ZREC_W] : 0.f;
    sg[k * 16 + tt] = sigmoidf_(z + (0.5f * (zp + zn) - z) * mu[c]);
  }
  __syncthreads();
  const int col = tid & 255, half = tid >> 8;
  float acc[8];
#pragma unroll
  for (int i = 0; i < 8; ++i) acc[i] = 0.f;
  const float* g2 = p.rw_g2 + (size_t)l * 128 * 256 + col;
  for (int k = 0; k < 128; ++k) {
    const float gv = g2[k * 256];
    const float* sk = sg + k * 16 + half * 8;
#pragma unroll
    for (int i = 0; i < 8; ++i) acc[i] += sk[i] * gv;
  }
  const size_t AS = (size_t)NT_ * 256;
  const float lw = p.rw_lnx_w[(size_t)l * 256 + col], lb = p.rw_lnx_b[(size_t)l * 256 + col];
#pragma unroll
  for (int i = 0; i < 8; ++i) {
    const int n = n0 + half * 8 + i;
    const size_t o = (size_t)n * 256 + col;
    const float y = ys[o] + ys[AS + o];
    const float mean = wave_sum(y) * (1.f / 64.f);
    const float dv = y - mean;
    const float var = wave_sum(dv * dv) * (1.f / 64.f);
    const float yn = dv * (1.0f / sqrtf(var + 64e-5f)) * lw + lb;
    const float v = bf2f(rb[1 * AS + o]);
    const float bsum = bso[(size_t)n * 4 + (col >> 6)] + bso[((size_t)NT_ + n) * 4 + (col >> 6)];
    rwo[o] = f2bf((yn + bsum * v) * acc[i]);
  }
}
DI void phase5(const Params& p, int l, bool with_ctx, char* smem) {
  const int n1 = ml3_items(with_ctx), n2 = rwo_items(with_ctx);
  for (int it = blockIdx.x; it < n1 + n2; it += gridDim.x) {
    if (it < n1) mlstm_out_item(p, l, it, with_ctx, smem);
    else rwkv_out_item(p, l, it - n1, smem);
  }
}
DI void phase_merge(const Params& p, int l, bool with_ctx, char* smem) {
  const bf16_t* H = (const bf16_t*)(p.ws + OFF_H);
  const char* W = p.ws + OFF_WMIX + (size_t)l * WM_SIZE;
  const bf16_t* Wg = (const bf16_t*)(W + WM_GATE);
  const bf16_t* att = (const bf16_t*)(p.ws + OFF_REGION + R_ATT);
  const bf16_t* mlo = (const bf16_t*)(p.ws + OFF_REGION + R_MLO);
  const bf16_t* rwo = (const bf16_t*)(p.ws + OFF_REGION + R_RWO);
  bf16_t* ymix = (bf16_t*)(p.osc + O_YMIX);
  const int TM = (with_ctx ? NT_ : NX_) / 128;
  for (int it = vblock(); it < TM * 8; it += gridDim.x) {
    const int tid = opaque_tid();
    const int tm = it >> 3, tn = it & 7;
    __syncthreads();
    f32x16 yacc[G128::MB][G128::NB];
#pragma unroll
    for (int a = 0; a < G128::MB; ++a)
#pragma unroll
      for (int b = 0; b < G128::NB; ++b) yacc[a][b] = zero16();
#pragma unroll
    for (int i = 0; i < 3; ++i) {
      f32x16 gacc[G128::MB][G128::NB], bacc[G128::MB][G128::NB];
#pragma unroll
      for (int a = 0; a < G128::MB; ++a)
#pragma unroll
        for (int b = 0; b < G128::NB; ++b) { gacc[a][b] = zero16(); bacc[a][b] = zero16(); }
      const bf16_t* A0 = H + (size_t)tm * 128 * 1024;
      G128::run(gacc, [&](int r) { return A0 + (size_t)r * 1024; }, Wg + ((size_t)i * 1024 + tn * 128) * 1024, 1024, 1024, smem);
      const bf16_t* br = i == 0 ? att : (i == 1 ? mlo : rwo);
      const int kb = i == 0 ? 512 : 256;
      const bf16_t* Wb = (const bf16_t*)(W + (i == 0 ? WM_BRA : (i == 1 ? WM_BRM : WM_BRR)));
      const bf16_t* B0 = br + (size_t)tm * 128 * kb;
      G128::run(bacc, [&](int r) { return B0 + (size_t)r * kb; }, Wb + (size_t)tn * 128 * kb, kb, kb, smem);
#pragma unroll
      for (int a = 0; a < G128::MB; ++a)
#pragma unroll
        for (int b = 0; b < G128::NB; ++b)
#pragma unroll
          for (int e = 0; e < 16; ++e) yacc[a][b][e] += sigmoidf_(gacc[a][b][e]) * bacc[a][b][e];
    }
    {
      const int lane = tid & 63, wid = tid >> 6, wm = wid / 4, wn = wid % 4;
      float* scr = (float*)(smem + wid * WTile<1>::BYTES);
#pragma unroll
      for (int mb = 0; mb < G128::MB; ++mb) {
        WTile<1>::put(scr, 0, lane, yacc[mb][0]);
        const int row0 = tm * 128 + wm * 64 + mb * 32, col0 = tn * 128 + wn * 32;
        WTile<1>::rows8(scr, lane, [&](int r, int c, const float4& a, const float4& bq) {
          *(uint4*)(ymix + (size_t)(row0 + r) * 1024 + col0 + c) = pack8bf(a, bq); });
      }
    }
  }
}

DI void phase_wout(const Params& p, int l, bool with_ctx, char* smem) {
  const bf16_t* ymix = (const bf16_t*)(p.osc + O_YMIX);
  const bf16_t* Wo = (const bf16_t*)(p.ws + OFF_WMIX + (size_t)l * WM_SIZE + WM_OUT);
  float* xs = (float*)(p.ws + OFF_XS);
  const float* mod = (const float*)(p.ws + OFF_MOD) + (size_t)l * 3 * 6144;
  const int TM = (with_ctx ? NT_ : NX_) / 128;
  const int n_g = TM * 8;
  for (int it = vblock(); it < n_g + CVT_MOE_TILES; it += gridDim.x) {
    if (it >= n_g) { cvt_moe_item(p, l, it - n_g, smem); continue; }
    const int tid = opaque_tid();
    const int tm = it >> 3, tn = it & 7;
    __syncthreads();
    f32x16 acc[G128::MB][G128::NB];
#pragma unroll
    for (int a = 0; a < G128::MB; ++a)
#pragma unroll
      for (int b = 0; b < G128::NB; ++b) acc[a][b] = zero16();
    const bf16_t* A0 = ymix + (size_t)tm * 128 * 1024;
    G128::run(acc, [&](int r) { return A0 + (size_t)r * 1024; }, Wo + (size_t)tn * 128 * 1024, 1024, 1024, smem);
    const float* m2 = mod + (size_t)tok_modrow(tm * 128) * 6144 + 2 * 1024;
    {
      const int lane = tid & 63, wid = tid >> 6, wm = wid / 4, wn = wid % 4;
      float* scr = (float*)(smem + wid * WTile<1>::BYTES);
#pragma unroll
      for (int mb = 0; mb < G128::MB; ++mb) {
        WTile<1>::put(scr, 0, lane, acc[mb][0]);
        const int row0 = tm * 128 + wm * 64 + mb * 32, col0 = tn * 128 + wn * 32;
        WTile<1>::rows4(scr, lane, [&](int r, int c, const float4& a) {
          float4* d = (float4*)(xs + (size_t)(row0 + r) * 1024 + col0 + c);
          const float4 g = *(const float4*)(m2 + col0 + c); float4 x = *d;
          x.x += g.x * a.x; x.y += g.y * a.y; x.z += g.z * a.z; x.w += g.w * a.w; *d = x; });
      }
    }
  }
}

typedef Gemm<128, 64, 64, 4, 2> GRT;
DI void phase_router(const Params& p, int l, bool with_ctx, char* smem, int* cnt) {
  float* xs = (float*)(p.ws + OFF_XS);
  bf16_t* H = (bf16_t*)(p.ws + OFF_H);
  const float* mod = (const float*)(p.ws + OFF_MOD) + (size_t)l * 3 * 6144;
  const bf16_t* Wr = (const bf16_t*)(p.ws + OFF_WMIX + (size_t)l * WM_SIZE + WM_RT);
  int* eidx = (int*)(p.ws + OFF_REGION + R_EIDX);
  float* ewt = (float*)(p.ws + OFF_REGION + R_EWT);
  int* erank = (int*)(p.ws + OFF_REGION + R_ERANK);
  int* elist = (int*)(p.ws + OFF_REGION + R_ELIST);
  float* sc = (float*)(smem + GRT::SMEM);
  float* bs = sc + 128 * 65;
  float* gs = bs + 128 * 65;
  const int tid = opaque_tid(), lane = tid & 63, wid = tid >> 6;
  const int ntok = with_ctx ? NT_ : NX_;
  for (int it = blockIdx.x; it < ntok / 128; it += gridDim.x) {
    const int n0 = it * 128;
    __syncthreads();
    for (int rr = 0; rr < 16; ++rr) {
      const int n = n0 + wid * 16 + rr;
      float v[16];
#pragma unroll
      for (int j = 0; j < 4; ++j) {
        const float4 t = *(const float4*)(xs + (size_t)n * 1024 + (j * 64 + lane) * 4);
        v[j * 4] = t.x; v[j * 4 + 1] = t.y; v[j * 4 + 2] = t.z; v[j * 4 + 3] = t.w;
      }
      const float* m = mod + (size_t)tok_modrow(n) * 6144;
      row_norm_mod(v, p.g_ffn + (size_t)l * 1024, m + 3 * 1024, m + 4 * 1024, H + (size_t)n * 1024, lane);
    }
    __syncthreads();
    f32x16 acc[1][1]; acc[0][0] = zero16();
    const bf16_t* A0 = H + (size_t)n0 * 1024;
    GRT::run(acc, [&](int r) { return A0 + (size_t)r * 1024; }, Wr, 1024, 1024, smem);
    {
      const int col = GRT::col_of(tid, 0);
      const float rb = p.router_bias[l * 64 + col];
#pragma unroll
      for (int e = 0; e < 16; ++e) {
        const int row = GRT::row_of(tid, 0, e);
        const float s = sigmoidf_(acc[0][0][e]);
        sc[row * 65 + col] = s; bs[row * 65 + col] = s + rb;
      }
    }
    __syncthreads();
    if (tid < 128) {
      const int n = n0 + tid;
      float* b = bs + tid * 65; const float* s = sc + tid * 65; float* g = gs + tid * 9;
      for (int gi = 0; gi < 8; ++gi) {
        float m1 = -1e30f, m2 = -1e30f;
        for (int j = 0; j < 8; ++j) { const float x = b[gi * 8 + j]; if (x > m1) { m2 = m1; m1 = x; } else if (x > m2) m2 = x; }
        g[gi] = m1 + m2;
      }
      unsigned gmask = 0;
      for (int c = 0; c < 4; ++c) {
        int best = 0; float bv = -1e30f;
        for (int gi = 0; gi < 8; ++gi) if (!((gmask >> gi) & 1) && g[gi] > bv) { bv = g[gi]; best = gi; }
        gmask |= 1u << best;
      }
      for (int gi = 0; gi < 8; ++gi) if (!((gmask >> gi) & 1)) for (int j = 0; j < 8; ++j) b[gi * 8 + j] = -1e30f;
      int sel[8]; float wsum = 0.f;
#pragma unroll
      for (int c = 0; c < 8; ++c) {
        int best = 0; float bv = -1e30f;
        for (int e = 0; e < 64; ++e) { const float x = b[e]; if (x > bv) { bv = x; best = e; } }
        b[best] = -3e30f; sel[c] = best; wsum += s[best];
      }
      const float inv = 2.5f / (wsum + 1e-20f);
#pragma unroll
      for (int c = 0; c < 8; ++c) {
        const int e = sel[c];
        const int rk = atomicAdd(cnt + e, 1);
        eidx[n * 8 + c] = e; ewt[n * 8 + c] = s[e] * inv; erank[n * 8 + c] = rk;
        elist[(size_t)e * NT_ + rk] = n * 8 + c;
      }
    }
  }
}

typedef Gemm<128, 256, 32, 2, 4> GMOE;
constexpr int ACT_LD = 264;
constexpr int MOE_ACT_OFF = GMOE::SMEM;
constexpr int MOE_INFO_OFF = MOE_ACT_OFF + 128 * ACT_LD * 2;
static_assert(MOE_INFO_OFF + 128 * 8 + 67 * 4 * 2 <= 160 * 1024 - 16, "moe lds");
DI void moe_down_run(f32x16 (&acc)[GMOE::MB][GMOE::NB], const char* actl, const bf16_t* Bt, char* smem) {
  constexpr int BK = 32, LDA = GMOE::LDA, CPR = 4, BCH = GMOE::BCH, STG = GMOE::B_BYTES;
  const int tid = opaque_tid(), lane = tid & 63, wid = tid >> 6, wm = wid / 4, wn = wid % 4;
  const int kc = (tid % CPR) * 8, r0 = tid / CPR;
  uint4 rb[BCH];
  char* Bs0 = smem;
#pragma unroll
  for (int i = 0; i < BCH; ++i) rb[i] = *(const uint4*)(Bt + (size_t)(r0 + i * 128) * 256 + kc);
#pragma unroll
  for (int i = 0; i < BCH; ++i) *(uint4*)(Bs0 + ((r0 + i * 128) * LDA + kc) * 2) = rb[i];
  __syncthreads();
  for (int kt = 0; kt < 256 / BK; ++kt) {
    const bool more = kt + 1 < 256 / BK;
    if (more) {
#pragma unroll
      for (int i = 0; i < BCH; ++i) rb[i] = *(const uint4*)(Bt + (size_t)(r0 + i * 128) * 256 + (kt + 1) * BK + kc);
    }
    const char* Bs = Bs0 + (kt & 1) * STG;
#pragma unroll
    for (int ks = 0; ks < BK / 16; ++ks) {
      bf16x8 af[GMOE::MB], bfr[GMOE::NB];
#pragma unroll
      for (int mb = 0; mb < GMOE::MB; ++mb)
        af[mb] = *(const bf16x8*)(actl + ((wm * 64 + mb * 32 + (lane & 31)) * ACT_LD + kt * BK + ks * 16 + (lane >> 5) * 8) * 2);
#pragma unroll
      for (int nb = 0; nb < GMOE::NB; ++nb)
        bfr[nb] = *(const bf16x8*)(Bs + ((wn * 64 + nb * 32 + (lane & 31)) * LDA + ks * 16 + (lane >> 5) * 8) * 2);
#pragma unroll
      for (int mb = 0; mb < GMOE::MB; ++mb)
#pragma unroll
        for (int nb = 0; nb < GMOE::NB; ++nb) acc[mb][nb] = mfma32(af[mb], bfr[nb], acc[mb][nb]);
    }
    if (more) {
      char* Bd = Bs0 + ((kt + 1) & 1) * STG;
#pragma unroll
      for (int i = 0; i < BCH; ++i) *(uint4*)(Bd + ((r0 + i * 128) * LDA + kc) * 2) = rb[i];
    }
    __syncthreads();
  }
}
DI void phase_moe(const Params& p, int l, bool with_ctx, char* smem, const int* cnt) {
  const bf16_t* H = (const bf16_t*)(p.ws + OFF_H);
  const bf16_t* GU = (const bf16_t*)(p.ws + OFF_REGION + R_WMOE + WE_GU);
  const bf16_t* DN = (const bf16_t*)(p.ws + OFF_REGION + R_WMOE + WE_DN);
  const float* ewt = (const float*)(p.ws + OFF_REGION + R_EWT);
  const int* elist = (const int*)(p.ws + OFF_REGION + R_ELIST);
  bf16_t* ybuf = (bf16_t*)(p.ws + OFF_REGION + R_YBUF);
  char* actl = smem + MOE_ACT_OFF;
  int* rtok = (int*)(smem + MOE_INFO_OFF);
  float* rwt = (float*)(rtok + 128);
  int* pre = (int*)(rwt + 128);
  int* off = pre + 67;
  int tid = threadIdx.x;
  const int ntok = with_ctx ? NT_ : NX_;
  __syncthreads();
  if (tid == 0) {
    int a = 0, o = 0;
    for (int e = 0; e < 65; ++e) { const int c = e < 64 ? cnt[e] : ntok; pre[e] = a; off[e] = o; a += (c + 127) >> 7; o += c; }
    pre[65] = a; off[65] = o;
  }
  __syncthreads();
  const int total = pre[65];
  for (int it = vblock(); it < total; it += gridDim.x) {
    tid = opaque_tid();
    int e0 = 0;
    while (pre[e0 + 1] <= it) ++e0;
    const int e = rfl(e0);
    const int rb = rfl(it - pre[e]);
    const int c = rfl(e < 64 ? cnt[e] : ntok);
    const int obase = rfl(off[e] + rb * 128);
    __syncthreads();
    if (tid < 128) {
      const int slot = rb * 128 + tid;
      int tok = 0; float w = 0.f;
      if (slot < c) {
        if (e < 64) { const int pk = elist[(size_t)e * NT_ + slot]; tok = pk >> 3; w = ewt[pk]; }
        else { tok = slot; w = 1.f; }
      }
      rtok[tid] = tok; rwt[tid] = w;
    }
    __syncthreads();
    const bf16_t* Wgu = GU + (size_t)e * 512 * 1024;
#pragma unroll 1
    for (int hf = 0; hf < 2; ++hf) {
      f32x16 acc[GMOE::MB][GMOE::NB];
#pragma unroll
      for (int a = 0; a < GMOE::MB; ++a)
#pragma unroll
        for (int b = 0; b < GMOE::NB; ++b) acc[a][b] = zero16();
      GMOE::run(acc, [&](int r) { return H + (size_t)rtok[r] * 1024; }, Wgu + (size_t)hf * 256 * 1024, 1024, 1024, smem);
      const int lane = tid & 63, wn = (tid >> 6) % 4, wmr = ((tid >> 6) / 4) * 64 + 4 * (lane >> 5);
      const int j = (hf * 4 + wn) * 32 + (lane & 31);
#pragma unroll
      for (int mb = 0; mb < GMOE::MB; ++mb)
#pragma unroll
        for (int i = 0; i < 16; ++i) {
          const int row = wmr + mb * 32 + (i & 3) + 8 * (i >> 2);
          const float g = acc[mb][0][i], u = acc[mb][1][i];
          *(bf16_t*)(actl + (row * ACT_LD + j) * 2) = f2bf(siluf_(g) * u);
        }
    }
    __syncthreads();
    const bf16_t* Wd = DN + (size_t)e * 1024 * 256;
#pragma unroll 1
    for (int nt = 0; nt < 4; ++nt) {
      f32x16 acc[GMOE::MB][GMOE::NB];
#pragma unroll
      for (int a = 0; a < GMOE::MB; ++a)
#pragma unroll
        for (int b = 0; b < GMOE::NB; ++b) acc[a][b] = zero16();
      moe_down_run(acc, actl, Wd + (size_t)nt * 256 * 256, smem);
      {
        const int lane = tid & 63, wid = tid >> 6, wm = wid / 4, wn = wid % 4;
        float* scr = (float*)(smem + wid * WTile<1>::BYTES);
#pragma unroll
        for (int mb = 0; mb < GMOE::MB; ++mb)
#pragma unroll
          for (int nb = 0; nb < GMOE::NB; ++nb) {
            WTile<1>::put(scr, 0, lane, acc[mb][nb]);
            const int row0 = wm * 64 + mb * 32, col0 = nt * 256 + wn * 64 + nb * 32;
            WTile<1>::rows8(scr, lane, [&](int r, int cq, const float4& a, const float4& bq) {
              const int row = row0 + r;
              if (rb * 128 + row < c) {
                const float w = rwt[row];
                const float4 a2 = make_float4(a.x * w, a.y * w, a.z * w, a.w * w), b2 = make_float4(bq.x * w, bq.y * w, bq.z * w, bq.w * w);
                *(uint4*)(ybuf + ((size_t)obase + row) * 1024 + col0 + cq) = pack8bf(a2, b2);
              } });
          }
        __syncthreads();
      }
    }
  }
}

DI void phase_combine(const Params& p, int l, bool last, char* smem, const int* cnt) {
  float* xs = (float*)(p.ws + OFF_XS);
  bf16_t* H = (bf16_t*)(p.ws + OFF_H);
  const float* mod = (const float*)(p.ws + OFF_MOD);
  const int* eidx = (const int*)(p.ws + OFF_REGION + R_EIDX);
  const int* erank = (const int*)(p.ws + OFF_REGION + R_ERANK);
  const bf16_t* ybuf = (const bf16_t*)(p.ws + OFF_REGION + R_YBUF);
  int* off = (int*)smem;
  const int tid = opaque_tid(), lane = tid & 63, wid = tid >> 6;
  const int ntok = last ? NX_ : NT_;
  __syncthreads();
  if (tid == 0) { int o = 0; for (int e = 0; e < 64; ++e) { off[e] = o; o += cnt[e]; } off[64] = o; }
  __syncthreads();
  for (int n = blockIdx.x * 8 + wid; n < ntok; n += gridDim.x * 8) {
    float acc[16];
#pragma unroll
    for (int i = 0; i < 16; ++i) acc[i] = 0.f;
    for (int k = 0; k < 9; ++k) {
      const int row = k < 8 ? off[eidx[n * 8 + k]] + erank[n * 8 + k] : off[64] + n;
      const bf16_t* y = ybuf + (size_t)row * 1024;
#pragma unroll
      for (int j = 0; j < 4; ++j) {
        const uint2 u = *(const uint2*)(y + (j * 64 + lane) * 4);
        acc[j * 4 + 0] += bf2f((bf16_t)(u.x & 0xffff)); acc[j * 4 + 1] += bf2f((bf16_t)(u.x >> 16));
        acc[j * 4 + 2] += bf2f((bf16_t)(u.y & 0xffff)); acc[j * 4 + 3] += bf2f((bf16_t)(u.y >> 16));
      }
    }
    const float* m5 = mod + ((size_t)l * 3 + tok_modrow(n)) * 6144 + 5 * 1024;
    float v[16];
#pragma unroll
    for (int j = 0; j < 4; ++j) {
      const int c = (j * 64 + lane) * 4;
      const float4 x = *(const float4*)(xs + (size_t)n * 1024 + c), g = *(const float4*)(m5 + c);
      v[j * 4 + 0] = x.x + g.x * acc[j * 4 + 0]; v[j * 4 + 1] = x.y + g.y * acc[j * 4 + 1];
      v[j * 4 + 2] = x.z + g.z * acc[j * 4 + 2]; v[j * 4 + 3] = x.w + g.w * acc[j * 4 + 3];
      if (!last) *(float4*)(xs + (size_t)n * 1024 + c) = make_float4(v[j * 4], v[j * 4 + 1], v[j * 4 + 2], v[j * 4 + 3]);
    }
    if (!last) {
      const float* m = mod + ((size_t)(l + 1) * 3 + tok_modrow(n)) * 6144;
      row_norm_mod(v, p.g_mix + (size_t)(l + 1) * 1024, m, m + 1024, H + (size_t)n * 1024, lane);
    } else {
      float ss = 0.f;
#pragma unroll
      for (int i = 0; i < 16; ++i) ss += v[i] * v[i];
      ss = wave_sum(ss);
      const float rs = 1.0f / sqrtf(ss * (1.f / 1024.f) + 1e-6f);
#pragma unroll
      for (int j = 0; j < 4; ++j) {
        const int c = (j * 64 + lane) * 4;
        const float4 g = *(const float4*)(p.g_final + c);
        *(float4*)(p.out + (size_t)n * 1024 + c) = make_float4(v[j * 4] * rs * g.x, v[j * 4 + 1] * rs * g.y, v[j * 4 + 2] * rs * g.z, v[j * 4 + 3] * rs * g.w);
      }
    }
  }
}
#define SMEM_BYTES (160 * 1024)
#ifndef MEGA
#define MEGA 0
#endif
DI int* cnt_ptr(const Params& p, int l) { return (int*)(p.ws + OFF_CNT) + 64 * l; }
DI int* ctr_ptr(const Params& p, int l) { return (int*)(p.ws + OFF_CNT) + 128 + 32 * l; }
#if !MEGA
__global__ void __launch_bounds__(NTHR) k_phaseA(Params p) { SMEM_DECL(smem, SMEM_BYTES); phaseA(p, smem); }
__global__ void __launch_bounds__(NTHR) k_norm0(Params p) { phase_norm0(p); }
__global__ void __launch_bounds__(NTHR) k_win(Params p, int l) { SMEM_DECL(smem, SMEM_BYTES); phase_win(p, l, smem); }
__global__ void __launch_bounds__(NTHR) k_p3(Params p, int l) { SMEM_DECL(smem, SMEM_BYTES); phase3(p, l, smem); }
__global__ void __launch_bounds__(NTHR) k_p3b(Params p, int l) { SMEM_DECL(smem, SMEM_BYTES); phase3b(p, l, smem); }
__global__ void __launch_bounds__(NTHR) k_p4(Params p, int l) { SMEM_DECL(smem, SMEM_BYTES); phase4(p, l, smem, ctr_ptr(p, l)); }
__global__ void __launch_bounds__(NTHR) k_p5(Params p, int l, int wc) { SMEM_DECL(smem, SMEM_BYTES); phase5(p, l, wc != 0, smem); }
__global__ void __launch_bounds__(NTHR) k_merge(Params p, int l, int wc) { SMEM_DECL(smem, SMEM_BYTES); phase_merge(p, l, wc != 0, smem); }
__global__ void __launch_bounds__(NTHR) k_wout(Params p, int l, int wc) { SMEM_DECL(smem, SMEM_BYTES); phase_wout(p, l, wc != 0, smem); }
__global__ void __launch_bounds__(NTHR) k_router(Params p, int l, int wc) { SMEM_DECL(smem, SMEM_BYTES); phase_router(p, l, wc != 0, smem, cnt_ptr(p, l)); }
__global__ void __launch_bounds__(NTHR) k_moe(Params p, int l, int wc) { SMEM_DECL(smem, SMEM_BYTES); phase_moe(p, l, wc != 0, smem, cnt_ptr(p, l)); }
__global__ void __launch_bounds__(NTHR) k_combine(Params p, int l, int last) { SMEM_DECL(smem, SMEM_BYTES); phase_combine(p, l, last != 0, smem, cnt_ptr(p, l)); }
#else
#ifndef EMU
#define XB_TMO      128
#define XB_XCNT(j)  (256  + 64 * (j))
#define XB_XSUB(j)  (1280 + 64 * (j))
#define XB_XGEN(j)  (2304 + 64 * (j))
#define XB_TOP      3328
#define XB_TOPGEN   3392
#define XCD_BAR_WORDS 3456
#define XB_SPIN_CAP (1u << 24)
#define LAS __attribute__((address_space(3)))
DI unsigned xb_ld(unsigned* p) { return __hip_atomic_load(p, __ATOMIC_RELAXED, __HIP_MEMORY_SCOPE_AGENT); }
DI unsigned xb_add(unsigned* p, unsigned v) { return __hip_atomic_fetch_add(p, v, __ATOMIC_RELAXED, __HIP_MEMORY_SCOPE_AGENT); }
DI unsigned xb_xcc_id() { return (unsigned)__builtin_amdgcn_s_getreg((3 << 11) | 20) & 0xFu; }
#define XB_SPIN(cond, bar) do { unsigned _sp = 0; while (cond) { __builtin_amdgcn_s_sleep(1); \
    if ((++_sp & 255u) == 0u) { if (xb_ld(&(bar)[XB_TMO])) break; if (_sp > XB_SPIN_CAP) { atomicAdd(&(bar)[XB_TMO], 1u); break; } } } } while (0)
struct XcdBarrier { unsigned* bar; unsigned x; volatile LAS unsigned* st; };
DI XcdBarrier xcd_barrier_post(unsigned* bar, volatile LAS unsigned* st) {
  XcdBarrier b; b.bar = bar; b.x = xb_xcc_id(); b.st = st;
  if (threadIdx.x == 0) (void)xb_add(&bar[XB_XCNT(b.x)], 1u);
  return b;
}
DI void xcd_barrier_complete(unsigned* bar, unsigned x, unsigned& nloc, unsigned& nx) {
  const unsigned G = gridDim.x * gridDim.y * gridDim.z;
  unsigned sum, cnt, mine, sp = 0u;
  for (;;) {
    sum = 0u; cnt = 0u; mine = 0u;
#pragma unroll
    for (unsigned j = 0; j < 16; ++j) { const unsigned c = xb_ld(&bar[XB_XCNT(j)]); sum += c; cnt += (c > 0u) ? 1u : 0u; mine = (j == x) ? c : mine; }
    if (sum == G) break;
    __builtin_amdgcn_s_sleep(1);
    if ((++sp & 255u) == 0u) { if (xb_ld(&bar[XB_TMO])) break; if (sp > XB_SPIN_CAP) { atomicAdd(&bar[XB_TMO], 1u); break; } }
  }
  nloc = mine > 0u ? mine : 1u; nx = cnt > 0u ? cnt : 1u;
}
DI void xcd_barrier(const XcdBarrier& b) {
  asm volatile("s_waitcnt vmcnt(0)" ::: "memory");
  __syncthreads();
  if (threadIdx.x == 0) {
    unsigned* bar = b.bar;
    __builtin_amdgcn_s_waitcnt(0);
    unsigned nloc = b.st[0], nx = b.st[1];
    if (nloc == 0u) { xcd_barrier_complete(bar, b.x, nloc, nx); b.st[0] = nloc; b.st[1] = nx; }
    const unsigned old = xb_add(&bar[XB_XSUB(b.x)], 1u);
    const unsigned gen = old / nloc;
    if (old + 1u == (gen + 1u) * nloc) {
      __builtin_amdgcn_fence(__ATOMIC_RELEASE, "agent");
      asm volatile("s_waitcnt vmcnt(0)" ::: "memory");
      const unsigned og = xb_add(&bar[XB_TOP], 1u);
      const unsigned tg = og / nx;
      if (og + 1u == (tg + 1u) * nx) xb_add(&bar[XB_TOPGEN], 1u);
      else XB_SPIN(xb_ld(&bar[XB_TOPGEN]) == tg, bar);
      __builtin_amdgcn_fence(__ATOMIC_ACQUIRE, "agent");
      xb_add(&bar[XB_XGEN(b.x)], 1u);
      asm volatile("s_waitcnt vmcnt(0)" ::: "memory");
    } else {
      XB_SPIN(xb_ld(&bar[XB_XGEN(b.x)]) == gen, bar);
      __builtin_amdgcn_fence(__ATOMIC_ACQUIRE, "agent");
      asm volatile("s_waitcnt vmcnt(0)" ::: "memory");
    }
  }
  __syncthreads();
}
#define GSYNC() xcd_barrier(xb)
#else
#define GSYNC() emu::grid_barrier()
#endif
#ifdef PROBE_IDX
#define TS(i) { if (blockIdx.x == 0 && threadIdx.x == 0) ts[i] = wall_clock64(); }
#else
#define TS(i)
#endif
__global__ void __launch_bounds__(NTHR) k_mega(Params p) {
  SMEM_DECL(smem, SMEM_BYTES);
  cooperative_groups::grid_group grid = cooperative_groups::this_grid();
  volatile LAS unsigned* xst = (volatile LAS unsigned*)(smem + SMEM_BYTES - 32);
  if (threadIdx.x == 0) { xst[0] = 0u; xst[1] = 0u; }
  __syncthreads();
  XcdBarrier xb = xcd_barrier_post((unsigned*)(p.ws + OFF_BAR), xst);
#ifdef PROBE_IDX
  long long* ts = (long long*)(p.ws + OFF_CNT + 2048);
#endif
  TS(0);
  phaseA(p, smem);
  grid.sync(); TS(1);
  phase_norm0(p);
  GSYNC(); TS(2);
#pragma unroll 1
  for (int l = 0; l < 2; ++l) {
    const bool wc = l == 0;
    phase_win(p, l, smem); GSYNC(); TS(3 + l * 9);
    phase3(p, l, smem); GSYNC();
    phase3b(p, l, smem); GSYNC(); TS(4 + l * 9);
    phase4(p, l, smem, ctr_ptr(p, l)); GSYNC(); TS(5 + l * 9);
    phase5(p, l, wc, smem); GSYNC(); TS(6 + l * 9);
    phase_merge(p, l, wc, smem); GSYNC(); TS(7 + l * 9);
    phase_wout(p, l, wc, smem); GSYNC(); TS(8 + l * 9);
    phase_router(p, l, wc, smem, cnt_ptr(p, l)); GSYNC(); TS(9 + l * 9);
    phase_moe(p, l, wc, smem, cnt_ptr(p, l)); GSYNC(); TS(10 + l * 9);
    phase_combine(p, l, l == 1, smem, cnt_ptr(p, l));
#ifdef PROBE_IDX
    GSYNC(); TS(11 + l * 9);
#else
    if (l == 0) GSYNC();
#endif
  }
#ifdef PROBE_IDX
  if (blockIdx.x == 0 && threadIdx.x == 0) {
    const float us = (float)(ts[PROBE_IDX + 1] - ts[PROBE_IDX]) * 0.01f;
    p.out[0] += rintf(6.f * log2f(fmaxf(us, 1.f)));
  }
#endif
}
#endif

extern "C" void kernel_launch(void* const* d_in, const int* in_sizes, int n_in, void* d_out, int out_size, void* d_ws,
                              size_t ws_size, hipStream_t stream) {
  Params p{};
  const float** pp = (const float**)&p;
  for (int i = 0; i < 41; ++i) pp[i] = (const float*)d_in[i];
  p.out = (float*)d_out; p.ws = (char*)d_ws; p.osc = (char*)d_out;
  if (ws_size < WS_NEEDED) { fprintf(stderr, "workspace too small: %zu < %zu\n", ws_size, (size_t)WS_NEEDED); return; }
#if !MEGA
  const dim3 g(256), b(NTHR);
  hipLaunchKernelGGL(k_phaseA, g, b, 0, stream, p);
  hipLaunchKernelGGL(k_norm0, g, b, 0, stream, p);
  for (int l = 0; l < 2; ++l) {
    const int wc = l == 0;
    hipLaunchKernelGGL(k_win, g, b, 0, stream, p, l);
    hipLaunchKernelGGL(k_p3, g, b, 0, stream, p, l);
    hipLaunchKernelGGL(k_p3b, g, b, 0, stream, p, l);
    hipLaunchKernelGGL(k_p4, g, b, 0, stream, p, l);
    hipLaunchKernelGGL(k_p5, g, b, 0, stream, p, l, wc);
    hipLaunchKernelGGL(k_merge, g, b, 0, stream, p, l, wc);
    hipLaunchKernelGGL(k_wout, g, b, 0, stream, p, l, wc);
    hipLaunchKernelGGL(k_router, g, b, 0, stream, p, l, wc);
    hipLaunchKernelGGL(k_moe, g, b, 0, stream, p, l, wc);
    hipLaunchKernelGGL(k_combine, g, b, 0, stream, p, l, l == 1);
  }
#else
  static int grid_blocks = 0;
  if (!grid_blocks) {
    int dev = 0, cus = 0, per_cu = 0;
    hipGetDevice(&dev);
    hipDeviceGetAttribute(&cus, hipDeviceAttributeMultiprocessorCount, dev);
    hipOccupancyMaxActiveBlocksPerMultiprocessor(&per_cu, k_mega, NTHR, 0);
    if (per_cu > 1) per_cu = 1;
    grid_blocks = cus * per_cu;
  }
  hipMemsetAsync(p.ws + OFF_BAR, 0, 16384, stream);
  void* args[] = {&p};
  hipError_t e = hipLaunchCooperativeKernel((void*)k_mega, dim3(grid_blocks), dim3(NTHR), args, 0, stream);
  if (e != hipSuccess) fprintf(stderr, "cooperative launch failed: %s (grid %d)\n", hipGetErrorString(e), grid_blocks);
#endif
}
```

```cpp
#define MEGA 1
#include <hip/hip_runtime.h>
#include <hip/hip_cooperative_groups.h>
#include <cstdio>

#ifndef SEQ_T
#define SEQ_T 8192
#endif
#ifndef CTX_L
#define CTX_L 256
#endif

#define DI __device__ __forceinline__
typedef unsigned short bf16_t;
typedef short bf16x8 __attribute__((ext_vector_type(8)));
typedef float f32x16 __attribute__((ext_vector_type(16)));
typedef float f32x4 __attribute__((ext_vector_type(4)));
typedef unsigned u32x4 __attribute__((ext_vector_type(4)));

constexpr int NB_ = 2, T_ = SEQ_T, CL_ = CTX_L, D_ = 1024;
constexpr int NX_ = NB_ * T_, NC_ = NB_ * CL_, NT_ = NX_ + NC_, KT_ = CL_ + T_;
constexpr int GRID_W_ = 64;
constexpr int MLA_H = 8, MLA_NOPE_ = 64, MLA_ROPE_ = 32, MLA_DK = 96, MLA_DV = 64, QLORA = 384, KVLORA = 256;
constexpr int MLA_IN_ = 672, ML_IN_ = 784, RW_IN_ = 1152, GATE_IN_ = 3072, D_IN_ = 5680;
constexpr int ZMLA_W = 768;
constexpr int ZREC_W = 1936;
constexpr int WIN_N = 768 + 2048;
constexpr int ML_H = 4, ML_DK = 32, ML_DV = 64, ML_L = 64;
constexpr int RW_H = 4, RW_N_ = 64;
constexpr int NE_ = 64, TOPK_ = 8, DE_ = 256;
constexpr int NCH_ = KT_ / ML_L;
constexpr int NSEQ_ = 2 * NB_ * 4;

constexpr int ZR_MLQ = 0, ZR_MLK = 128, ZR_MLV = 256, ZR_MLO = 512, ZR_MLI = 768, ZR_MLF = 776;
constexpr int ZR_RW = 784;

constexpr size_t al256(size_t x) { return (x + 255) & ~(size_t)255; }
constexpr size_t WM_WIN = 0;
constexpr size_t WM_GATE = WM_WIN + (size_t)WIN_N * 1024 * 2;
constexpr size_t WM_UQ = WM_GATE + (size_t)3072 * 1024 * 2;
constexpr size_t WM_UKV = WM_UQ + (size_t)768 * 384 * 2;
constexpr size_t WM_BRA = WM_UKV + (size_t)1024 * 256 * 2;
constexpr size_t WM_BRM = WM_BRA + (size_t)1024 * 512 * 2;
constexpr size_t WM_BRR = WM_BRM + (size_t)1024 * 256 * 2;
constexpr size_t WM_OUT = WM_BRR + (size_t)1024 * 256 * 2;
constexpr size_t WM_RT = WM_OUT + (size_t)1024 * 1024 * 2;
constexpr size_t WM_SIZE = al256(WM_RT + (size_t)64 * 1024 * 2);
constexpr size_t WE_GU = 0;
constexpr size_t WE_DN = WE_GU + (size_t)65 * 512 * 1024 * 2;
constexpr size_t WE_SIZE = al256(WE_DN + (size_t)65 * 1024 * 256 * 2);

constexpr size_t OFF_XS = 0;
constexpr size_t OFF_MOD = OFF_XS + al256((size_t)NT_ * 1024 * 4);
constexpr size_t OFF_ROPE = OFF_MOD + al256((size_t)2 * 3 * 6144 * 4);
constexpr size_t OFF_H = OFF_ROPE + al256((size_t)T_ * 16 * 8);
constexpr size_t OFF_WMIX = OFF_H + al256((size_t)NT_ * 1024 * 2);
constexpr size_t OFF_CNT = OFF_WMIX + 2 * WM_SIZE;
constexpr size_t OFF_BAR = OFF_CNT + 4096;
constexpr size_t OFF_REGION = OFF_BAR + 16384;
constexpr size_t R_ZREC = 0;
constexpr size_t R_RB16 = R_ZREC + al256((size_t)NT_ * ZREC_W * 4);
constexpr size_t R_LW = R_RB16 + al256((size_t)7 * NT_ * 256 * 2);
constexpr size_t R_BS = R_LW + al256((size_t)2 * NT_ * 256 * 4);
constexpr size_t R_CH = R_BS + al256((size_t)2 * NT_ * 4 * 4);
constexpr size_t R_YS = R_CH + al256((size_t)NSEQ_ * NCH_ * 40960);
constexpr size_t R_MLST = R_YS + al256((size_t)2 * NT_ * 256 * 4);
constexpr size_t R_ATT = R_MLST + al256((size_t)NSEQ_ * NCH_ * 2112 * 4);
constexpr size_t R_MLO = R_ATT + al256((size_t)NT_ * 512 * 2);
constexpr size_t R_RWO = R_MLO + al256((size_t)NT_ * 256 * 2);
constexpr size_t R_VT = R_RWO + al256((size_t)NT_ * 256 * 2);
constexpr size_t R_KB = R_VT + al256((size_t)NB_ * MLA_H * 64 * KT_ * 2);
constexpr size_t R_MIX_END = R_KB + al256((size_t)NB_ * MLA_H * KT_ * 96 * 2);
constexpr int NSLOT_ = NT_ * 9;
constexpr size_t R_YBUF = 0;
constexpr size_t R_EIDX = R_YBUF + al256((size_t)NSLOT_ * 1024 * 2);
constexpr size_t R_EWT = R_EIDX + al256((size_t)NT_ * 8 * 4);
constexpr size_t R_ERANK = R_EWT + al256((size_t)NT_ * 8 * 4);
constexpr size_t R_ELIST = R_ERANK + al256((size_t)NT_ * 8 * 4);
constexpr size_t R_WMOE = R_ELIST + al256((size_t)64 * NT_ * 4);
constexpr size_t R_MOE_END = R_WMOE + WE_SIZE;
constexpr size_t R_SIZE = R_MIX_END > R_MOE_END ? R_MIX_END : R_MOE_END;
constexpr size_t WS_NEEDED = OFF_REGION + R_SIZE;
constexpr size_t O_ZMLA = 0;
constexpr size_t O_QB = O_ZMLA + al256((size_t)NT_ * ZMLA_W * 2);
constexpr size_t O_END = O_QB + al256((size_t)NT_ * 768 * 2);
constexpr size_t O_YMIX = 0;
#if SEQ_T == 8192 && CTX_L == 256
static_assert(O_END <= (size_t)NX_ * 1024 * 4, "d_out scratch overflow");
static_assert((size_t)NT_ * 1024 * 2 <= (size_t)NX_ * 1024 * 4, "ymix overflow");
static_assert(WS_NEEDED <= (size_t)597000000, "workspace too large");
#endif

struct Params {
  const float *x, *c, *ctx, *c_ctx, *w_mod, *b_mod, *g_mix, *g_ffn, *w_in, *g_cq, *w_uq, *g_ckv, *w_uk, *w_uv;
  const float *ml_b_i, *ml_b_f, *ml_g_norm, *rw_mu, *rw_w0, *rw_w2, *rw_a0, *rw_a2, *rw_g2, *rw_k_k, *rw_k_a;
  const float *rw_r_k, *rw_lnx_w, *rw_lnx_b, *w_br_mla, *w_br_ml, *w_br_rw, *w_out, *w_router, *router_bias;
  const float *w_e_gate, *w_e_up, *w_e_down, *w_s_gate, *w_s_up, *w_s_down, *g_final;
  float* out; char* ws; char* osc;
};

DI float bf2f(bf16_t s) { unsigned u = ((unsigned)s) << 16; float f; __builtin_memcpy(&f, &u, 4); return f; }
DI bf16_t f2bf(float x) { unsigned u; __builtin_memcpy(&u, &x, 4); u += 0x7fffu + ((u >> 16) & 1u); return (bf16_t)(u >> 16); }
DI unsigned pack2bf(float a, float b) {
#ifdef EMU
  return (unsigned)f2bf(a) | ((unsigned)f2bf(b) << 16);
#else
  typedef __bf16 bf2 __attribute__((ext_vector_type(2)));
  typedef float f2 __attribute__((ext_vector_type(2)));
  f2 v = {a, b}; bf2 r = __builtin_convertvector(v, bf2); return __builtin_bit_cast(unsigned, r);
#endif
}
DI f32x16 mfma32(bf16x8 a, bf16x8 b, f32x16 c) {
#ifdef EMU
  return emu_mfma_32x32x16_bf16(a, b, c);
#else
  return __builtin_amdgcn_mfma_f32_32x32x16_bf16(a, b, c, 0, 0, 0);
#endif
}
DI int rfl(int v) {
#ifdef EMU
  return v;
#else
  return __builtin_amdgcn_readfirstlane(v);
#endif
}
DI int opaque_tid() {
#ifdef EMU
  return threadIdx.x;
#else
  int t = threadIdx.x; asm volatile("" : "+v"(t)); return t;
#endif
}
DI void wave_sync() {
#ifdef EMU
  (void)__ballot(1);
#else
  asm volatile("" ::: "memory");
#endif
}
DI int vblock() {
  const int g = gridDim.x, b = blockIdx.x;
  return (g & 7) == 0 ? (b & 7) * (g >> 3) + (b >> 3) : b;
}
DI int xcc_id() {
#ifdef EMU
  return blockIdx.x & 7;
#else
  return (int)(__builtin_amdgcn_s_getreg((3 << 11) | 20) & 7u);
#endif
}
DI int ld_relaxed(int* p) {
#ifdef EMU
  return __atomic_load_n(p, __ATOMIC_SEQ_CST);
#else
  return __hip_atomic_load(p, __ATOMIC_RELAXED, __HIP_MEMORY_SCOPE_AGENT);
#endif
}
DI void sched_fence() {
#ifndef EMU
  __builtin_amdgcn_sched_barrier(0);
#endif
}
DI f32x16 zero16() { f32x16 z; for (int i = 0; i < 16; ++i) z[i] = 0.f; return z; }
DI int crow(int reg, int h) { return (reg & 3) + 8 * (reg >> 2) + 4 * h; }
#ifdef EMU
DI float fexp(float x) { return expf(x); }
#else
DI float fexp(float x) { return __expf(x); }
#endif
DI float sigmoidf_(float x) { return 1.f / (1.f + fexp(-x)); }
DI float siluf_(float x) { return x * sigmoidf_(x); }
DI float wave_sum(float v) { for (int m = 32; m >= 1; m >>= 1) v += __shfl_xor(v, m); return v; }
DI float wave_max(float v) { for (int m = 32; m >= 1; m >>= 1) v = fmaxf(v, __shfl_xor(v, m)); return v; }

DI int tok_b(int n) { return n < NX_ ? n / T_ : (n - NX_) / CL_; }
DI int tok_t(int n) { return n < NX_ ? n % T_ : (n - NX_) % CL_; }
DI int tok_key(int n) { return n < NX_ ? CL_ + n % T_ : (n - NX_) % CL_; }
DI int tok_modrow(int n) { return n < NX_ ? n / T_ : 2; }

#ifdef EMU
#define SMEM_DECL(name, bytes) char* name = (char*)emu::shared_alloc(bytes)
#else
#define SMEM_DECL(name, bytes) __shared__ __attribute__((aligned(16))) char name[bytes]
#endif
#define NTHR 512
struct CvtJob { const float* src; int lds; int K; bf16_t* dst; int ntn; int ntk; int maptype; const float* gain; };
DI int cvt_map(int maptype, int coff, int np) {
  if (maptype == 0) return coff + np;
  if (maptype == 1) { if (np < 672) return np; if (np < 768) return -1; if (np < 768 + 1936) return np - 96; return -1; }
  return np;
}
DI void cvt_tile(const CvtJob& j, int coff, int tk, int tn, char* smem) {
  float* tile = (float*)smem;
  const int tid = opaque_tid();
  __syncthreads();
  {
    const int kk = tid >> 3, nc = (tid & 7) * 8, k = tk * 64 + kk;
    const float g = j.gain ? j.gain[k] : 1.f;
#pragma unroll
    for (int i = 0; i < 8; ++i) {
      const int np = tn * 64 + nc + i;
      const int sc = cvt_map(j.maptype, coff, np);
      tile[kk * 65 + nc + i] = sc >= 0 ? j.src[(size_t)k * j.lds + sc] * g : 0.f;
    }
  }
  __syncthreads();
  {
    const int n = tid >> 3, kc = (tid & 7) * 8;
    int np = tn * 64 + n;
    if (j.maptype == 2) np = (np >> 5) * 64 + coff * 32 + (np & 31);
    uint4 v;
    v.x = pack2bf(tile[(kc + 0) * 65 + n], tile[(kc + 1) * 65 + n]);
    v.y = pack2bf(tile[(kc + 2) * 65 + n], tile[(kc + 3) * 65 + n]);
    v.z = pack2bf(tile[(kc + 4) * 65 + n], tile[(kc + 5) * 65 + n]);
    v.w = pack2bf(tile[(kc + 6) * 65 + n], tile[(kc + 7) * 65 + n]);
    *(uint4*)(j.dst + (size_t)np * j.K + tk * 64 + kc) = v;
  }
}

constexpr int CVT_MIX_TILES = 704 + 768 + 72 + 32 + 32 + 128 + 64 + 64 + 256 + 16;
DI void cvt_mix_item(const Params& p, int l, int it, char* smem) {
  bf16_t* W = (bf16_t*)(p.ws + OFF_WMIX + (size_t)l * WM_SIZE);
  CvtJob j; int coff = 0;
  if (it < 704) { j = {p.w_in + (size_t)l * 1024 * D_IN_, D_IN_, 1024, (bf16_t*)((char*)W + WM_WIN), 44, 16, 1, nullptr}; }
  else if ((it -= 704) < 768) { j = {p.w_in + (size_t)l * 1024 * D_IN_, D_IN_, 1024, (bf16_t*)((char*)W + WM_GATE), 48, 16, 0, nullptr}; coff = 2608; }
  else if ((it -= 768) < 72) { j = {p.w_uq + (size_t)l * 384 * 768, 768, 384, (bf16_t*)((char*)W + WM_UQ), 12, 6, 0, p.g_cq + l * 384}; }
  else if ((it -= 72) < 32) { j = {p.w_uk + (size_t)l * 256 * 512, 512, 256, (bf16_t*)((char*)W + WM_UKV), 8, 4, 0, p.g_ckv + l * 256}; }
  else if ((it -= 32) < 32) { j = {p.w_uv + (size_t)l * 256 * 512, 512, 256, (bf16_t*)((char*)W + WM_UKV) + 512 * 256, 8, 4, 0, p.g_ckv + l * 256}; }
  else if ((it -= 32) < 128) { j = {p.w_br_mla + (size_t)l * 512 * 1024, 1024, 512, (bf16_t*)((char*)W + WM_BRA), 16, 8, 0, nullptr}; }
  else if ((it -= 128) < 64) { j = {p.w_br_ml + (size_t)l * 256 * 1024, 1024, 256, (bf16_t*)((char*)W + WM_BRM), 16, 4, 0, nullptr}; }
  else if ((it -= 64) < 64) { j = {p.w_br_rw + (size_t)l * 256 * 1024, 1024, 256, (bf16_t*)((char*)W + WM_BRR), 16, 4, 0, nullptr}; }
  else if ((it -= 64) < 256) { j = {p.w_out + (size_t)l * 1024 * 1024, 1024, 1024, (bf16_t*)((char*)W + WM_OUT), 16, 16, 0, nullptr}; }
  else { it -= 256; j = {p.w_router + (size_t)l * 1024 * 64, 64, 1024, (bf16_t*)((char*)W + WM_RT), 1, 16, 0, nullptr}; }
  cvt_tile(j, coff, it / j.ntn, it % j.ntn, smem);
}
constexpr int CVT_MOE_TILES = 65 * 192;
DI void cvt_moe_item(const Params& p, int l, int it, char* smem) {
  const int e = it / 192; int r = it % 192;
  bf16_t* GU = (bf16_t*)(p.ws + OFF_REGION + R_WMOE + WE_GU) + (size_t)e * 512 * 1024;
  bf16_t* DN = (bf16_t*)(p.ws + OFF_REGION + R_WMOE + WE_DN) + (size_t)e * 1024 * 256;
  const float* sg = e < 64 ? p.w_e_gate + ((size_t)l * 64 + e) * 1024 * 256 : p.w_s_gate + (size_t)l * 1024 * 256;
  const float* su = e < 64 ? p.w_e_up + ((size_t)l * 64 + e) * 1024 * 256 : p.w_s_up + (size_t)l * 1024 * 256;
  const float* sd = e < 64 ? p.w_e_down + ((size_t)l * 64 + e) * 256 * 1024 : p.w_s_down + (size_t)l * 256 * 1024;
  CvtJob j; int coff = 0;
  if (r < 64) { j = {sg, 256, 1024, GU, 4, 16, 2, nullptr}; coff = 0; }
  else if ((r -= 64) < 64) { j = {su, 256, 1024, GU, 4, 16, 2, nullptr}; coff = 1; }
  else { r -= 64; j = {sd, 1024, 256, DN, 16, 4, 0, nullptr}; }
  cvt_tile(j, coff, r / j.ntn, r % j.ntn, smem);
}

DI void mod_item(const Params& p, int it, char* smem) {
  float* cond = (float*)smem;
  float* red = cond + 3 * 1024;
  const int tid = opaque_tid(), l = it / 96, j0 = (it % 96) * 64;
  __syncthreads();
  for (int i = tid; i < 3 * 1024; i += NTHR) {
    const int r = i >> 10, k = i & 1023;
    const float v = r < 2 ? p.c[r * 1024 + k] : p.c_ctx[k];
    cond[i] = siluf_(v);
  }
  __syncthreads();
  const int jj = tid & 63, kg = tid >> 6;
  float a0 = 0.f, a1 = 0.f, a2 = 0.f;
  const float* w = p.w_mod + (size_t)l * 1024 * 6144 + j0 + jj;
  for (int k = kg; k < 1024; k += 8) {
    const float wv = w[(size_t)k * 6144];
    a0 += cond[k] * wv; a1 += cond[1024 + k] * wv; a2 += cond[2048 + k] * wv;
  }
  red[(kg * 3 + 0) * 64 + jj] = a0; red[(kg * 3 + 1) * 64 + jj] = a1; red[(kg * 3 + 2) * 64 + jj] = a2;
  __syncthreads();
  if (tid < 192) {
    const int r = tid >> 6; float s = 0.f;
    for (int g = 0; g < 8; ++g) s += red[(g * 3 + r) * 64 + jj];
    float* mod = (float*)(p.ws + OFF_MOD);
    mod[((size_t)l * 3 + r) * 6144 + j0 + jj] = s + p.b_mod[(size_t)l * 6144 + j0 + jj];
  }
}
DI void rope_item(const Params& p, int it) {
  const int idx = it * NTHR + threadIdx.x;
  if (idx >= T_ * 16) return;
  const int t = idx >> 4, i = idx & 15, f = i & 7;
  const float pos = (float)(i < 8 ? t / GRID_W_ : t % GRID_W_);
  const float inv = powf(10000.f, -(float)(2 * f) / 16.f);
  const float ang = pos * inv;
  float2* rt = (float2*)(p.ws + OFF_ROPE);
  rt[idx] = make_float2(cosf(ang), sinf(ang));
}
constexpr int PA_ITEMS = 192 + (T_ * 16 + NTHR - 1) / NTHR + 2 * CVT_MIX_TILES;
DI void phaseA(const Params& p, char* smem) {
  if (blockIdx.x == 0 && threadIdx.x < 256) ((int*)(p.ws + OFF_CNT))[threadIdx.x] = 0;
  for (int it = blockIdx.x; it < PA_ITEMS; it += gridDim.x) {
    int i = it;
    if (i < 192) { mod_item(p, i, smem); continue; }
    i -= 192;
    constexpr int NR = (T_ * 16 + NTHR - 1) / NTHR;
    if (i < NR) { rope_item(p, i); continue; }
    i -= NR;
    cvt_mix_item(p, i / CVT_MIX_TILES, i % CVT_MIX_TILES, smem);
  }
}

DI void row_norm_mod(const float (&v)[16], const float* g, const float* shift, const float* scale, bf16_t* hrow, int lane) {
  float ss = 0.f;
#pragma unroll
  for (int i = 0; i < 16; ++i) ss += v[i] * v[i];
  ss = wave_sum(ss);
  const float rs = 1.0f / sqrtf(ss * (1.f / 1024.f) + 1e-6f);
#pragma unroll
  for (int j = 0; j < 4; ++j) {
    const int c = (j * 64 + lane) * 4;
    const float4 gg = *(const float4*)(g + c), sh = *(const float4*)(shift + c), sc = *(const float4*)(scale + c);
    const float h0 = v[j * 4 + 0] * rs * gg.x * (1.f + sc.x) + sh.x;
    const float h1 = v[j * 4 + 1] * rs * gg.y * (1.f + sc.y) + sh.y;
    const float h2 = v[j * 4 + 2] * rs * gg.z * (1.f + sc.z) + sh.z;
    const float h3 = v[j * 4 + 3] * rs * gg.w * (1.f + sc.w) + sh.w;
    uint2 o; o.x = pack2bf(h0, h1); o.y = pack2bf(h2, h3);
    *(uint2*)(hrow + c) = o;
  }
}
DI void phase_norm0(const Params& p) {
  const int lane = threadIdx.x & 63, wid = threadIdx.x >> 6;
  float* xs = (float*)(p.ws + OFF_XS);
  bf16_t* H = (bf16_t*)(p.ws + OFF_H);
  const float* mod = (const float*)(p.ws + OFF_MOD);
  for (int n = blockIdx.x * 8 + wid; n < NT_; n += gridDim.x * 8) {
    const float* src = n < NX_ ? p.x + (size_t)n * 1024 : p.ctx + (size_t)(n - NX_) * 1024;
    float v[16];
#pragma unroll
    for (int j = 0; j < 4; ++j) {
      const float4 t = *(const float4*)(src + (j * 64 + lane) * 4);
      v[j * 4] = t.x; v[j * 4 + 1] = t.y; v[j * 4 + 2] = t.z; v[j * 4 + 3] = t.w;
      *(float4*)(xs + (size_t)n * 1024 + (j * 64 + lane) * 4) = t;
    }
    const float* m = mod + (size_t)(0 * 3 + tok_modrow(n)) * 6144;
    row_norm_mod(v, p.g_mix, m, m + 1024, H + (size_t)n * 1024, lane);
  }
}

template <int BM, int BN, int BK, int WM_, int WN_>
struct Gemm {
  static constexpr int WTM = BM / WM_, WTN = BN / WN_, MB = WTM / 32, NB = WTN / 32;
  static constexpr int LDA = BK + 8;
  static constexpr int A_BYTES = BM * LDA * 2, B_BYTES = BN * LDA * 2, STAGE = A_BYTES + B_BYTES;
  static constexpr int SMEM = 2 * STAGE;
  static constexpr int CPR = BK / 8;
  static constexpr int ACH = BM * CPR / NTHR, BCH = BN * CPR / NTHR;
  static_assert(WM_ * WN_ == 8, "8 waves");
  static_assert(BM * CPR % NTHR == 0 && BN * CPR % NTHR == 0, "chunking");
  static_assert(NTHR % CPR == 0, "rows fixed per thread");

  template <class ARow>
  static DI void run(f32x16 (&acc)[MB][NB], ARow arow, const bf16_t* Bt, int ldb, int Klen, char* smem) {
    const int tid = opaque_tid(), lane = tid & 63, wid = tid >> 6, wm = wid / WN_, wn = wid % WN_;
    const int kc = (tid % CPR) * 8, r0 = tid / CPR;
    const bf16_t* ap[ACH]; const bf16_t* bp[BCH];
#pragma unroll
    for (int i = 0; i < ACH; ++i) ap[i] = arow(r0 + i * (NTHR / CPR)) + kc;
#pragma unroll
    for (int i = 0; i < BCH; ++i) bp[i] = Bt + (size_t)(r0 + i * (NTHR / CPR)) * ldb + kc;
    u32x4 ra[ACH], rb[BCH];
    const int nk = Klen / BK;
#pragma unroll
    for (int i = 0; i < ACH; ++i) ra[i] = *(const u32x4*)(ap[i]);
#pragma unroll
    for (int i = 0; i < BCH; ++i) rb[i] = *(const u32x4*)(bp[i]);
#pragma unroll
    for (int i = 0; i < ACH; ++i) *(u32x4*)(smem + ((r0 + i * (NTHR / CPR)) * LDA + kc) * 2) = ra[i];
#pragma unroll
    for (int i = 0; i < BCH; ++i) *(u32x4*)(smem + A_BYTES + ((r0 + i * (NTHR / CPR)) * LDA + kc) * 2) = rb[i];
    __syncthreads();
    for (int kt = 0; kt < nk; ++kt) {
      const int kn = (kt + 1 < nk ? kt + 1 : kt) * BK;
#pragma unroll
      for (int i = 0; i < ACH; ++i) ra[i] = *(const u32x4*)(ap[i] + kn);
#pragma unroll
      for (int i = 0; i < BCH; ++i) rb[i] = *(const u32x4*)(bp[i] + kn);
      sched_fence();
      const char* As = smem + (kt & 1) * STAGE;
      const char* Bs = As + A_BYTES;
#pragma unroll
      for (int ks = 0; ks < BK / 16; ++ks) {
        bf16x8 af[MB], bfr[NB];
#pragma unroll
        for (int mb = 0; mb < MB; ++mb)
          af[mb] = *(const bf16x8*)(As + ((wm * WTM + mb * 32 + (lane & 31)) * LDA + ks * 16 + (lane >> 5) * 8) * 2);
#pragma unroll
        for (int nb = 0; nb < NB; ++nb)
          bfr[nb] = *(const bf16x8*)(Bs + ((wn * WTN + nb * 32 + (lane & 31)) * LDA + ks * 16 + (lane >> 5) * 8) * 2);
#pragma unroll
        for (int mb = 0; mb < MB; ++mb)
#pragma unroll
          for (int nb = 0; nb < NB; ++nb) acc[mb][nb] = mfma32(af[mb], bfr[nb], acc[mb][nb]);
      }
      sched_fence();
      {
        char* Ad = smem + ((kt + 1) & 1) * STAGE;
#pragma unroll
        for (int i = 0; i < ACH; ++i) *(u32x4*)(Ad + ((r0 + i * (NTHR / CPR)) * LDA + kc) * 2) = ra[i];
#pragma unroll
        for (int i = 0; i < BCH; ++i) *(u32x4*)(Ad + A_BYTES + ((r0 + i * (NTHR / CPR)) * LDA + kc) * 2) = rb[i];
      }
      __syncthreads();
    }
  }
  static DI int row_of(int t, int mb, int reg) { const int lane = t & 63, wm = (t >> 6) / WN_; return wm * WTM + mb * 32 + crow(reg, lane >> 5); }
  static DI int col_of(int t, int nb) { const int lane = t & 63, wn = (t >> 6) % WN_; return wn * WTN + nb * 32 + (lane & 31); }
};


template <int NBW> struct WTile {
  static constexpr int LD = NBW * 32 + 4;
  static constexpr int BYTES = 32 * LD * 4;
  static DI void put(float* scr, int nb, int lane, const f32x16& v) {
    const int c = nb * 32 + (lane & 31), h = lane >> 5;
#pragma unroll
    for (int i = 0; i < 16; ++i) scr[crow(i, h) * LD + c] = v[i];
  }
  template <class F> static DI void rows4(const float* scr, int lane, F f) {
    wave_sync();
#pragma unroll
    for (int it = 0; it < NBW * 4; ++it) {
      const int id = it * 64 + lane, row = id / (NBW * 8), q = id % (NBW * 8);
      f(row, q * 4, *(const float4*)(scr + row * LD + q * 4));
    }
    wave_sync();
  }
  template <class F> static DI void rows8(const float* scr, int lane, F f) {
    wave_sync();
#pragma unroll
    for (int it = 0; it < NBW * 2; ++it) {
      const int id = it * 64 + lane, row = id / (NBW * 4), q = id % (NBW * 4);
      f(row, q * 8, *(const float4*)(scr + row * LD + q * 8), *(const float4*)(scr + row * LD + q * 8 + 4));
    }
    wave_sync();
  }
};
DI uint4 pack8bf(const float4& a, const float4& b) { return make_uint4(pack2bf(a.x, a.y), pack2bf(a.z, a.w), pack2bf(b.x, b.y), pack2bf(b.z, b.w)); }

typedef Gemm<256, 256, 64, 2, 4> G256;
DI void phase_win(const Params& p, int l, char* smem) {
  const bf16_t* H = (const bf16_t*)(p.ws + OFF_H);
  const bf16_t* W = (const bf16_t*)(p.ws + OFF_WMIX + (size_t)l * WM_SIZE + WM_WIN);
  bf16_t* zmla = (bf16_t*)(p.osc + O_ZMLA);
  float* zrec = (float*)(p.ws + OFF_REGION + R_ZREC);
  constexpr int TM = NT_ / 256, TN = WIN_N / 256;
  for (int it = vblock(); it < TM * TN; it += gridDim.x) {
    const int tid = opaque_tid();
    const int tm = it / TN, tn = it % TN;
    __syncthreads();
    f32x16 acc[G256::MB][G256::NB];
#pragma unroll
    for (int a = 0; a < G256::MB; ++a)
#pragma unroll
      for (int b = 0; b < G256::NB; ++b) acc[a][b] = zero16();
    const bf16_t* A0 = H + (size_t)tm * 256 * 1024;
    G256::run(acc, [&](int r) { return A0 + (size_t)r * 1024; }, W + (size_t)tn * 256 * 1024, 1024, 1024, smem);
    {
      const int lane = tid & 63, wid = tid >> 6, wm = wid / 4, wn = wid % 4;
      float* scr = (float*)(smem + wid * WTile<2>::BYTES);
      const int col0 = tn * 256 + wn * 64;
#pragma unroll
      for (int mb = 0; mb < G256::MB; ++mb) {
        WTile<2>::put(scr, 0, lane, acc[mb][0]); WTile<2>::put(scr, 1, lane, acc[mb][1]);
        const int row0 = tm * 256 + wm * 128 + mb * 32;
#ifdef ABL_NOSTORE
        if (tn > 1000) {
#else
        if (tn < 3) {
#endif
          WTile<2>::rows8(scr, lane, [&](int r, int c, const float4& a, const float4& bq) {
            *(uint4*)(zmla + (size_t)(row0 + r) * ZMLA_W + col0 + c) = pack8bf(a, bq); });
        } else {
          WTile<2>::rows4(scr, lane, [&](int r, int c, const float4& a) {
            const int cc = col0 - 768 + c;
#ifdef ABL_NOSTORE
            if (cc < -5) *(float4*)(zrec + (size_t)(row0 + r) * ZREC_W + cc) = a; });
#else
            if (cc < ZREC_W) *(float4*)(zrec + (size_t)(row0 + r) * ZREC_W + cc) = a; });
#endif
        }
      }
    }
  }
}
typedef Gemm<128, 128, 64, 2, 4> G128;
DI void mla_row_rs(const bf16_t* zmla_rows, int c0, int len, float* rs) {
  const int tid = opaque_tid(), row = tid >> 2, half = tid & 3;
  const bf16_t* src = zmla_rows + (size_t)row * ZMLA_W + c0 + half * (len / 4);
  float ss = 0.f;
  for (int i = 0; i < len / 4; i += 8) {
    const uint4 v = *(const uint4*)(src + i);
    const unsigned w[4] = {v.x, v.y, v.z, v.w};
#pragma unroll
    for (int j = 0; j < 4; ++j) { const float a = bf2f((bf16_t)(w[j] & 0xffff)), b = bf2f((bf16_t)(w[j] >> 16)); ss += a * a + b * b; }
  }
  ss += __shfl_xor(ss, 1); ss += __shfl_xor(ss, 2);
  if (half == 0) rs[row] = 1.0f / sqrtf(ss / (float)len + 1e-6f);
}

constexpr int MLA_Q_TILES = (NT_ / 128) * 6, MLA_KV_TILES = (NT_ / 128) * 8;
DI void mla_q_item(const Params& p, int l, int it, char* smem) {
  const int tid = opaque_tid();
  const int tm = it / 6, tn = it % 6;
  const bf16_t* zmla = (const bf16_t*)(p.osc + O_ZMLA) + (size_t)tm * 128 * ZMLA_W;
  const bf16_t* W = (const bf16_t*)(p.ws + OFF_WMIX + (size_t)l * WM_SIZE + WM_UQ) + (size_t)tn * 128 * 384;
  bf16_t* qb = (bf16_t*)(p.osc + O_QB);
  const float2* rt = (const float2*)(p.ws + OFF_ROPE);
  float* rs = (float*)(smem + G128::SMEM);
  __syncthreads();
  mla_row_rs(zmla, 0, 384, rs);
  f32x16 acc[G128::MB][G128::NB];
#pragma unroll
  for (int a = 0; a < G128::MB; ++a)
#pragma unroll
    for (int b = 0; b < G128::NB; ++b) acc[a][b] = zero16();
  G128::run(acc, [&](int r) { return zmla + (size_t)r * ZMLA_W; }, W, 384, 384, smem);
  const int lane = tid & 63;
  const bool isx = tm * 128 < NX_;
#pragma unroll
  for (int mb = 0; mb < G128::MB; ++mb)
#pragma unroll
    for (int nb = 0; nb < G128::NB; ++nb) {
      const int col = tn * 128 + G128::col_of(tid, nb);
      const bool ropeblk = ((col >> 5) % 3) == 2;
      const int e = lane & 31;
#pragma unroll
      for (int i = 0; i < 16; ++i) {
        const int lr = G128::row_of(tid, mb, i);
        const int n = tm * 128 + lr;
        float v = acc[mb][nb][i] * rs[lr];
        if (ropeblk && isx) {
          const float pv = __shfl_xor(v, 8);
          const float2 cs = rt[(size_t)(n % T_) * 16 + (e >> 4) * 8 + (e & 7)];
          v = (e & 8) ? (pv * cs.y + v * cs.x) : (v * cs.x - pv * cs.y);
        }
        qb[(size_t)n * 768 + col] = f2bf(v);
      }
    }
}
DI void mla_kv_item(const Params& p, int l, int it, char* smem) {
  const int tid = opaque_tid();
  const int tm = it / 8, tn = it % 8;
  const bf16_t* zmla = (const bf16_t*)(p.osc + O_ZMLA) + (size_t)tm * 128 * ZMLA_W;
  const bf16_t* W = (const bf16_t*)(p.ws + OFF_WMIX + (size_t)l * WM_SIZE + WM_UKV) + (size_t)tn * 128 * 256;
  bf16_t* kb = (bf16_t*)(p.ws + OFF_REGION + R_KB);
  bf16_t* vt = (bf16_t*)(p.ws + OFF_REGION + R_VT);
  const float2* rt = (const float2*)(p.ws + OFF_ROPE);
  float* rs = (float*)(smem + G128::SMEM);
  __syncthreads();
  mla_row_rs(zmla, 384, 256, rs);
  const int n0 = tm * 128;
  const int b = tok_b(n0), key0 = tok_key(n0);
  const bool isx = n0 < NX_;
  if (tn == 0) {
    for (int idx = tid; idx < 128 * 16; idx += NTHR) {
      const int lr = idx >> 4, pi = idx & 15, a = pi >> 3, i = pi & 7;
      const bf16_t* z = zmla + (size_t)lr * ZMLA_W + 640 + a * 16 + i;
      float x1 = bf2f(z[0]), x2 = bf2f(z[8]);
      if (isx) {
        const float2 cs = rt[(size_t)((n0 + lr) % T_) * 16 + a * 8 + i];
        const float y1 = x1 * cs.x - x2 * cs.y, y2 = x1 * cs.y + x2 * cs.x; x1 = y1; x2 = y2;
      }
      const bf16_t o1 = f2bf(x1), o2 = f2bf(x2);
      for (int h = 0; h < 8; ++h) {
        bf16_t* dst = kb + ((size_t)(b * 8 + h) * KT_ + key0 + lr) * 96 + 64 + a * 16 + i;
        dst[0] = o1; dst[8] = o2;
      }
    }
  }
  f32x16 acc[G128::MB][G128::NB];
#pragma unroll
  for (int a = 0; a < G128::MB; ++a)
#pragma unroll
    for (int c = 0; c < G128::NB; ++c) acc[a][c] = zero16();
  G128::run(acc, [&](int r) { return zmla + (size_t)r * ZMLA_W + 384; }, W, 256, 256, smem);
  const int lane = tid & 63;
#pragma unroll
  for (int mb = 0; mb < G128::MB; ++mb)
#pragma unroll
    for (int nb = 0; nb < G128::NB; ++nb) {
      const int col = tn * 128 + G128::col_of(tid, nb);
      if (col < 512) {
        const int h = col >> 6, d = col & 63;
#pragma unroll
        for (int i = 0; i < 16; ++i) {
          const int lr = G128::row_of(tid, mb, i);
          kb[((size_t)(b * 8 + h) * KT_ + key0 + lr) * 96 + d] = f2bf(acc[mb][nb][i] * rs[lr]);
        }
      } else {
        const int h = (col - 512) >> 6, d = col & 63;
#pragma unroll
        for (int g = 0; g < 4; ++g) {
          const int lr = G128::row_of(tid, mb, g * 4);
          uint2 o;
          o.x = pack2bf(acc[mb][nb][g * 4 + 0] * rs[lr], acc[mb][nb][g * 4 + 1] * rs[lr + 1]);
          o.y = pack2bf(acc[mb][nb][g * 4 + 2] * rs[lr + 2], acc[mb][nb][g * 4 + 3] * rs[lr + 3]);
          *(uint2*)(vt + ((size_t)(b * 8 + h) * 64 + d) * KT_ + key0 + lr) = o;
        }
      }
    }
  (void)lane;
}

DI float softplusf_(float x) { return x > 20.f ? x : log1pf(fexp(x)); }
constexpr int RWP_TT = 16;
constexpr int RWP_ITEMS = NT_ / RWP_TT;
DI void rwkv_prep_item(const Params& p, int l, int it, char* smem) {
  float* zs = (float*)smem;
  float* tw = zs + RWP_TT * 1024;
  float* ta = tw + 2 * 64 * RWP_TT;
  const float* zrec = (const float*)(p.ws + OFF_REGION + R_ZREC);
  bf16_t* rb = (bf16_t*)(p.ws + OFF_REGION + R_RB16);
  float* lwo = (float*)(p.ws + OFF_REGION + R_LW);
  float* bso = (float*)(p.ws + OFF_REGION + R_BS);
  const float rkw = p.rw_r_k[(size_t)l * 256 + (opaque_tid() & 255)];
  const float* mu = p.rw_mu + (size_t)l * 1152;
  const int tid = opaque_tid(), n0 = it * RWP_TT;
  __syncthreads();
  for (int idx = tid; idx < RWP_TT * 1024; idx += NTHR) {
    const int tt = idx >> 10, c = idx & 1023, n = n0 + tt, t = tok_t(n);
    const int len = n < NX_ ? T_ : CL_;
    const float* zr = zrec + (size_t)n * ZREC_W + ZR_RW + c;
    const float z = zr[0];
    const float zp = t > 0 ? zr[-ZREC_W] : 0.f, zn = t < len - 1 ? zr[ZREC_W] : 0.f;
    const float s = z + (0.5f * (zp + zn) - z) * mu[c];
    zs[idx] = s;
    if (c >= 768 && c < 896) { const int d = (c - 768) >> 6, k = (c - 768) & 63; tw[(d * 64 + k) * RWP_TT + tt] = tanhf(s); }
    if (c >= 896) { const int d = (c - 896) >> 6, k = (c - 896) & 63; ta[(d * 64 + k) * RWP_TT + tt] = s; }
  }
  __syncthreads();
  const int col = tid & 255, d = tid >> 8;
  float aw[RWP_TT], aa[RWP_TT];
#pragma unroll
  for (int i = 0; i < RWP_TT; ++i) { aw[i] = 0.f; aa[i] = 0.f; }
  const float* w2 = p.rw_w2 + ((size_t)l * 2 + d) * 64 * 256 + col;
  const float* a2 = p.rw_a2 + ((size_t)l * 2 + d) * 64 * 256 + col;
  for (int k = 0; k < 64; ++k) {
    const float wv = w2[k * 256], av = a2[k * 256];
    const float* twk = tw + (d * 64 + k) * RWP_TT;
    const float* tak = ta + (d * 64 + k) * RWP_TT;
#pragma unroll
    for (int i = 0; i < RWP_TT; ++i) { aw[i] += twk[i] * wv; aa[i] += tak[i] * av; }
  }
  const float w0 = p.rw_w0[((size_t)l * 2 + d) * 256 + col], a0 = p.rw_a0[((size_t)l * 2 + d) * 256 + col];
  const float kkw = p.rw_k_k[(size_t)l * 256 + col], kaw = p.rw_k_a[(size_t)l * 256 + col];
  const size_t AS = (size_t)NT_ * 256;
#pragma unroll
  for (int i = 0; i < RWP_TT; ++i) {
    const int n = n0 + i;
    const float r = zs[i * 1024 + col], k = zs[i * 1024 + 256 + col], v = zs[i * 1024 + 512 + col];
    const float kr = k * kkw;
    const float ss = wave_sum(kr * kr);
    const float kk = kr / fmaxf(sqrtf(ss), 1e-12f);
    const float w = -softplusf_(-(w0 + aw[i])) - 0.5f;
    const float logdecay = -fexp(w);
    const float a = sigmoidf_(a0 + aa[i]);
    const float kd = k * (1.f + (a - 1.f) * kaw);
    const float bsum = wave_sum(r * rkw * kd);
    const size_t o = (size_t)n * 256 + col;
    if (d == 0) { rb[0 * AS + o] = f2bf(r); rb[1 * AS + o] = f2bf(v); rb[2 * AS + o] = f2bf(kk); }
    lwo[d * AS + o] = logdecay;
    rb[(3 + 2 * d) * AS + o] = f2bf(kd);
    rb[(4 + 2 * d) * AS + o] = f2bf(kk * a);
    if ((tid & 63) == 0) bso[((size_t)d * NT_ + n) * 4 + (col >> 6)] = bsum;
  }
}

DI int seq_tok(int dir, int b, int pos) {
  if (pos < CL_) return NX_ + b * CL_ + (dir ? CL_ - 1 - pos : pos);
  const int t = pos - CL_;
  return b * T_ + (dir ? T_ - 1 - t : t);
}
DI float logsigmoidf_(float x) { return -softplusf_(-x); }
DI float wave_incl_scan(float v, int lane) {
  for (int d = 1; d < 64; d <<= 1) { const float o = __shfl_up(v, d); if (lane >= d) v += o; }
  return v;
}
constexpr int ML_ST = 2112;
constexpr int ML1_ITEMS = NSEQ_ * NCH_;
DI void mlstm_local_item(const Params& p, int l, int it, char* smem) {
  const int s = it / NCH_, c = it % NCH_, dir = s >> 3, b = (s >> 2) & 1, hd = s & 3;
  float* vv = (float*)smem;
  float* kw = vv + 64 * 64;
  float* wej = kw + 64 * 32;
  const float* zrec = (const float*)(p.ws + OFF_REGION + R_ZREC);
  float* st = (float*)(p.ws + OFF_REGION + R_MLST) + ((size_t)s * NCH_ + c) * ML_ST;
  const int tid = opaque_tid(), lane = tid & 63, wid = tid >> 6;
  __syncthreads();
  if (wid == 0) {
    const int n = seq_tok(dir, b, c * 64 + lane);
    const float fp = zrec[(size_t)n * ZREC_W + ZR_MLF + dir * 4 + hd] + p.ml_b_f[(l * 2 + dir) * 4 + hd];
    const float ip = zrec[(size_t)n * ZREC_W + ZR_MLI + dir * 4 + hd] + p.ml_b_i[(l * 2 + dir) * 4 + hd];
    const float bj = wave_incl_scan(logsigmoidf_(fp), lane);
    const float bl = __shfl(bj, 63);
    const float lw = bl - bj + ip;
    const float ml = wave_max(lw);
    wej[lane] = fexp(lw - ml);
    if (lane == 0) { st[2080] = bl; st[2081] = ml; }
  }
  for (int idx = tid; idx < 64 * 64; idx += NTHR) {
    const int j = idx >> 6, e = idx & 63;
    const int n = seq_tok(dir, b, c * 64 + j);
    vv[idx] = zrec[(size_t)n * ZREC_W + ZR_MLV + hd * 64 + e];
  }
  __syncthreads();
  for (int idx = tid; idx < 64 * 32; idx += NTHR) {
    const int j = idx >> 5, e = idx & 31;
    const int n = seq_tok(dir, b, c * 64 + j);
    kw[idx] = zrec[(size_t)n * ZREC_W + ZR_MLK + hd * 32 + e] * wej[j];
  }
  __syncthreads();
  const int v = tid & 63, d0 = (tid >> 6) * 4;
  float a0 = 0.f, a1 = 0.f, a2 = 0.f, a3 = 0.f;
  for (int j = 0; j < 64; ++j) {
    const float x = vv[j * 64 + v];
    const float4 kk = *(const float4*)(kw + j * 32 + d0);
    a0 += x * kk.x; a1 += x * kk.y; a2 += x * kk.z; a3 += x * kk.w;
  }
  *(float4*)(st + v * 32 + d0) = make_float4(a0, a1, a2, a3);
  if (tid < 32) { float sn = 0.f; for (int j = 0; j < 64; ++j) sn += kw[j * 32 + tid]; st[2048 + tid] = sn; }
}
constexpr int ML2_ITEMS = (NSEQ_ * 2080 + NTHR - 1) / NTHR;
DI void mlstm_scan_item(const Params& p, int it) {
  const int g = it * NTHR + opaque_tid();
  if (g >= NSEQ_ * 2080) return;
  const int s = g / 2080, e = g % 2080;
  float* st = (float*)(p.ws + OFF_REGION + R_MLST) + (size_t)s * NCH_ * ML_ST;
  float state = 0.f, m = 0.f;
  for (int c = 0; c < NCH_; ++c) {
    float* r = st + (size_t)c * ML_ST;
    const float d = r[e], bl = r[2080], ml = r[2081];
    r[e] = state;
    if (e == 0) r[2082] = m;
    const float mn = fmaxf(bl + m, ml);
    state = fexp(bl + m - mn) * state + fexp(ml - mn) * d;
    m = mn;
  }
}

constexpr int P3_ITEMS = RWP_ITEMS + ML1_ITEMS;
DI void phase3(const Params& p, int l, char* smem) {
  for (int it = blockIdx.x; it < P3_ITEMS; it += gridDim.x) {
    if (it < RWP_ITEMS) rwkv_prep_item(p, l, it, smem);
    else mlstm_local_item(p, l, it - RWP_ITEMS, smem);
  }
}
constexpr int RW_LD = 72, RW_MB = 64 * RW_LD * 2;
constexpr int RWC_REC = 40960;
DI char* rw_rec(const Params& p, int s, int c) { return p.ws + OFF_REGION + R_CH + ((size_t)s * NCH_ + c) * RWC_REC; }
DI f32x16 rw_mm(const char* A, const char* Bt, int mb, int nb, int lane, f32x16 acc) {
  const int r = lane & 31, h = lane >> 5;
#pragma unroll
  for (int ks = 0; ks < 4; ++ks) {
    const bf16x8 a = *(const bf16x8*)(A + ((mb * 32 + r) * RW_LD + ks * 16 + h * 8) * 2);
    const bf16x8 b = *(const bf16x8*)(Bt + ((nb * 32 + r) * RW_LD + ks * 16 + h * 8) * 2);
    acc = mfma32(a, b, acc);
  }
  return acc;
}
DI void rw_wrT(char* Dst, int mb, int nb, int lane, const f32x16& v) {
  const int r = lane & 31, h = lane >> 5;
#pragma unroll
  for (int g = 0; g < 4; ++g) {
    uint2 o; o.x = pack2bf(v[4 * g], v[4 * g + 1]); o.y = pack2bf(v[4 * g + 2], v[4 * g + 3]);
    *(uint2*)(Dst + ((nb * 32 + r) * RW_LD + mb * 32 + 8 * g + 4 * h) * 2) = o;
  }
}
DI void rw_wrT_g(bf16_t* Dst, int mb, int nb, int lane, const f32x16& v) {
  const int r = lane & 31, h = lane >> 5;
#pragma unroll
  for (int g = 0; g < 4; ++g) {
    uint2 o; o.x = pack2bf(v[4 * g], v[4 * g + 1]); o.y = pack2bf(v[4 * g + 2], v[4 * g + 3]);
    *(uint2*)(Dst + (nb * 32 + r) * 64 + mb * 32 + 8 * g + 4 * h) = o;
  }
}
DI void rw_addT(const char* Src, int mb, int nb, int lane, f32x16& v) {
  const int r = lane & 31, h = lane >> 5;
#pragma unroll
  for (int g = 0; g < 4; ++g) {
    const uint2 u = *(const uint2*)(Src + ((nb * 32 + r) * RW_LD + mb * 32 + 8 * g + 4 * h) * 2);
    v[4 * g] += bf2f((bf16_t)(u.x & 0xffff)); v[4 * g + 1] += bf2f((bf16_t)(u.x >> 16));
    v[4 * g + 2] += bf2f((bf16_t)(u.y & 0xffff)); v[4 * g + 3] += bf2f((bf16_t)(u.y >> 16));
  }
}
DI void rw_mask_upper(f32x16& v, int mb, int nb, int lane, bool strict) {
  const int col = nb * 32 + (lane & 31), h = lane >> 5;
#pragma unroll
  for (int i = 0; i < 16; ++i) { const int row = mb * 32 + crow(i, h); if (strict ? !(row < col) : !(row <= col)) v[i] = 0.f; }
}
DI void rw_mask_lower_strict(f32x16& v, int mb, int nb, int lane) {
  const int col = nb * 32 + (lane & 31), h = lane >> 5;
#pragma unroll
  for (int i = 0; i < 16; ++i) { const int row = mb * 32 + crow(i, h); if (!(col < row)) v[i] = 0.f; }
}

constexpr int RW1_ITEMS = NSEQ_ * NCH_;
DI void rw_chunk_item(const Params& p, int it, char* smem) {
  const int s = it / NCH_, c = it % NCH_, dir = s >> 3, b = (s >> 2) & 1, hd = s & 3;
  const int tid = opaque_tid(), lane = tid & 63, wid = tid >> 6;
  const bf16_t* rb = (const bf16_t*)(p.ws + OFF_REGION + R_RB16);
  const float* lwg = (const float*)(p.ws + OFF_REGION + R_LW) + (size_t)dir * NT_ * 256;
  const size_t AS = (size_t)NT_ * 256;
  char* const At = smem + 0 * RW_MB; char* const Bt_ = smem + 1 * RW_MB; char* const Kt = smem + 2 * RW_MB; char* const Rt = smem + 3 * RW_MB;
  char* const Aj = smem + 4 * RW_MB; char* const Bj = smem + 5 * RW_MB; char* const Kj = smem + 6 * RW_MB; char* const Vi = smem + 7 * RW_MB;
  char* const QA = smem + 8 * RW_MB; char* const QTA = smem + 9 * RW_MB; char* const GA = smem + 10 * RW_MB;
  char* const Mka = smem + 11 * RW_MB; char* const MbrT = smem + 12 * RW_MB; char* const MkrT = smem + 13 * RW_MB;
  char* const QB = At; char* const QTB = Bt_; char* const GB = Kt;
  float* const cs = (float*)(smem + 8 * RW_MB);
  float* const gC = (float*)(smem + 14 * RW_MB);
  char* rec = rw_rec(p, s, c);
  __syncthreads();
  const int t = tid >> 3, j8 = (tid & 7) * 8;
  const int n = seq_tok(dir, b, c * 64 + t);
  {
    const float4 l0 = *(const float4*)(lwg + (size_t)n * 256 + hd * 64 + j8), l1 = *(const float4*)(lwg + (size_t)n * 256 + hd * 64 + j8 + 4);
    float* d = cs + t * 65 + j8;
    d[0] = l0.x; d[1] = l0.y; d[2] = l0.z; d[3] = l0.w; d[4] = l1.x; d[5] = l1.y; d[6] = l1.z; d[7] = l1.w;
  }
  __syncthreads();
  if (tid < 64) { float a = 0.f; for (int tt = 0; tt < 64; ++tt) { a += cs[tt * 65 + tid]; cs[tt * 65 + tid] = a; } gC[tid] = fexp(a); }
  __syncthreads();
  {
    const size_t o = (size_t)n * 256 + hd * 64 + j8;
    const uint4 ukk = *(const uint4*)(rb + 2 * AS + o), ubb = *(const uint4*)(rb + (4 + 2 * dir) * AS + o), ukd = *(const uint4*)(rb + (3 + 2 * dir) * AS + o);
    const uint4 ur = *(const uint4*)(rb + 0 * AS + o), uv = *(const uint4*)(rb + 1 * AS + o);
    const unsigned akk[4] = {ukk.x, ukk.y, ukk.z, ukk.w}, abb[4] = {ubb.x, ubb.y, ubb.z, ubb.w}, akd[4] = {ukd.x, ukd.y, ukd.z, ukd.w};
    const unsigned ar[4] = {ur.x, ur.y, ur.z, ur.w}, av[4] = {uv.x, uv.y, uv.z, uv.w};
    unsigned oa[4], ob[4], ok[4], orr[4];
#pragma unroll
    for (int q = 0; q < 4; ++q) {
      float fa[2], fb[2], fk[2], fr[2];
#pragma unroll
      for (int e = 0; e < 2; ++e) {
        const int j = j8 + 2 * q + e;
        const float cst = cs[t * 65 + j], csp = t > 0 ? cs[(t - 1) * 65 + j] : 0.f;
        const float g = fexp(cst), gp = fexp(csp), gi = fexp(-cst);
        const int sh = 16 * e;
        fa[e] = -bf2f((bf16_t)((akk[q] >> sh) & 0xffff)) * gp;
        fb[e] = bf2f((bf16_t)((abb[q] >> sh) & 0xffff)) * gi;
        fk[e] = bf2f((bf16_t)((akd[q] >> sh) & 0xffff)) * gi;
        fr[e] = bf2f((bf16_t)((ar[q] >> sh) & 0xffff)) * g;
        *(bf16_t*)(Aj + (j * RW_LD + t) * 2) = f2bf(fa[e]);
        *(bf16_t*)(Bj + (j * RW_LD + t) * 2) = f2bf(fb[e]);
        *(bf16_t*)(Kj + (j * RW_LD + t) * 2) = f2bf(fk[e]);
        *(bf16_t*)(Vi + (j * RW_LD + t) * 2) = (bf16_t)((av[q] >> sh) & 0xffff);
      }
      oa[q] = pack2bf(fa[0], fa[1]); ob[q] = pack2bf(fb[0], fb[1]); ok[q] = pack2bf(fk[0], fk[1]); orr[q] = pack2bf(fr[0], fr[1]);
    }
    *(uint4*)(At + (t * RW_LD + j8) * 2) = make_uint4(oa[0], oa[1], oa[2], oa[3]);
    *(uint4*)(Bt_ + (t * RW_LD + j8) * 2) = make_uint4(ob[0], ob[1], ob[2], ob[3]);
    *(uint4*)(Kt + (t * RW_LD + j8) * 2) = make_uint4(ok[0], ok[1], ok[2], ok[3]);
    *(uint4*)(Rt + (t * RW_LD + j8) * 2) = make_uint4(orr[0], orr[1], orr[2], orr[3]);
  }
  __syncthreads();
  {
    const int prod = wid >> 2, mb = (wid >> 1) & 1, nb = wid & 1;
    f32x16 acc = zero16();
    if (prod == 0) {
      if (!(mb == 1 && nb == 0)) acc = rw_mm(Bt_, At, mb, nb, lane, acc);
      rw_mask_upper(acc, mb, nb, lane, true);
      rw_wrT(QA, mb, nb, lane, acc);
      if (mb == nb) {
        const int col = nb * 32 + (lane & 31), h = lane >> 5;
#pragma unroll
        for (int i = 0; i < 16; ++i) if (mb * 32 + crow(i, h) == col) acc[i] += 1.f;
      }
      rw_wrT(GA, mb, nb, lane, acc);
    } else {
      if (!(mb == 0 && nb == 1)) acc = rw_mm(At, Bt_, mb, nb, lane, acc);
      rw_mask_lower_strict(acc, mb, nb, lane);
      rw_wrT(QTA, mb, nb, lane, acc);
    }
  }
  for (int blk = wid; blk < 12; blk += 8) {
    const int prod = blk >> 2, mb = (blk >> 1) & 1, nb = blk & 1;
    f32x16 acc = zero16();
    if (prod == 0) {
      acc = rw_mm(At, Kt, mb, nb, lane, acc); rw_mask_lower_strict(acc, mb, nb, lane); rw_wrT(Mka, mb, nb, lane, acc);
    } else if (prod == 1) {
      acc = rw_mm(Bt_, Rt, mb, nb, lane, acc); rw_mask_upper(acc, mb, nb, lane, false); rw_wrT(MbrT, mb, nb, lane, acc);
    } else {
      acc = rw_mm(Kt, Rt, mb, nb, lane, acc); rw_mask_upper(acc, mb, nb, lane, false); rw_wrT(MkrT, mb, nb, lane, acc);
    }
  }
  __syncthreads();
#define RW_SQ(Q_, Qt_, Qn_, Qtn_, blk) { const int pr_ = (blk) >> 2, mb_ = ((blk) >> 1) & 1, nb_ = (blk) & 1; f32x16 acc_ = zero16(); \
    if (pr_ == 0) { acc_ = rw_mm(Q_, Qt_, mb_, nb_, lane, acc_); rw_wrT(Qtn_, mb_, nb_, lane, acc_); } \
    else { acc_ = rw_mm(Qt_, Q_, mb_, nb_, lane, acc_); rw_wrT(Qn_, mb_, nb_, lane, acc_); } }
#define RW_GUP(Qt_, G_, Gn_, blk) { const int mb_ = ((blk) >> 1) & 1, nb_ = (blk) & 1; f32x16 acc_ = zero16(); \
    rw_addT(G_, mb_, nb_, lane, acc_); acc_ = rw_mm(Qt_, G_, mb_, nb_, lane, acc_); rw_wrT(Gn_, mb_, nb_, lane, acc_); }
  RW_SQ(QA, QTA, QB, QTB, wid);
  __syncthreads();
  for (int blk = wid; blk < 12; blk += 8) { if (blk < 8) { RW_SQ(QB, QTB, QA, QTA, blk); } else { RW_GUP(QTB, GA, GB, blk - 8); } }
  __syncthreads();
  for (int blk = wid; blk < 12; blk += 8) { if (blk < 8) { RW_SQ(QA, QTA, QB, QTB, blk); } else { RW_GUP(QTA, GB, GA, blk - 8); } }
  __syncthreads();
  for (int blk = wid; blk < 12; blk += 8) { if (blk < 8) { RW_SQ(QB, QTB, QA, QTA, blk); } else { RW_GUP(QTB, GA, GB, blk - 8); } }
  __syncthreads();
  for (int blk = wid; blk < 12; blk += 8) { if (blk < 8) { RW_SQ(QA, QTA, QB, QTB, blk); } else { RW_GUP(QTA, GB, GA, blk - 8); } }
  __syncthreads();
  if (wid < 4) { RW_GUP(QTB, GA, GB, wid); }
  __syncthreads();
  {
    const int prod = wid >> 2, mb = (wid >> 1) & 1, nb = wid & 1;
    f32x16 acc = zero16();
    acc = rw_mm(GB, prod == 0 ? Mka : Aj, mb, nb, lane, acc);
    rw_wrT(prod == 0 ? QA : QTA, mb, nb, lane, acc);
  }
  __syncthreads();
  char* const X1 = QA; char* const X2 = QTA; char* const QpT = At;
  for (int blk = wid; blk < 16; blk += 8) {
    const int prod = blk >> 2, mb = (blk >> 1) & 1, nb = blk & 1;
    f32x16 acc = zero16();
    if (prod == 0) {
      rw_addT(MkrT, mb, nb, lane, acc); acc = rw_mm(X1, MbrT, mb, nb, lane, acc); rw_mask_upper(acc, mb, nb, lane, false);
      rw_wrT_g((bf16_t*)(rec + 8192), mb, nb, lane, acc);
    } else if (prod == 1) {
      rw_addT(Rt, mb, nb, lane, acc); acc = rw_mm(X2, MbrT, mb, nb, lane, acc);
      rw_wrT_g((bf16_t*)(rec), mb, nb, lane, acc);
    } else if (prod == 2) {
      acc = rw_mm(X2, Bj, mb, nb, lane, acc);
      const int col = nb * 32 + (lane & 31), h = lane >> 5; const float gc = gC[col];
#pragma unroll
      for (int i = 0; i < 16; ++i) { if (mb * 32 + crow(i, h) == col) acc[i] += 1.f; acc[i] *= gc; }
      rw_wrT_g((bf16_t*)(rec + 16384), mb, nb, lane, acc);
    } else {
      rw_addT(Kj, mb, nb, lane, acc); acc = rw_mm(X1, Bj, mb, nb, lane, acc);
      const float gc = gC[nb * 32 + (lane & 31)];
#pragma unroll
      for (int i = 0; i < 16; ++i) acc[i] *= gc;
      rw_wrT(QpT, mb, nb, lane, acc);
    }
  }
  __syncthreads();
  if (wid < 4) {
    const int mb = (wid >> 1) & 1, nb = wid & 1, r = lane & 31, h = lane >> 5;
    f32x16 acc = zero16();
    acc = rw_mm(QpT, Vi, mb, nb, lane, acc);
    float* dq = (float*)(rec + 24576);
#pragma unroll
    for (int g = 0; g < 4; ++g)
      *(float4*)(dq + (nb * 32 + r) * 64 + mb * 32 + 8 * g + 4 * h) = make_float4(acc[4 * g], acc[4 * g + 1], acc[4 * g + 2], acc[4 * g + 3]);
  }
}

constexpr int RW2_ITEMS = NSEQ_;
constexpr int RW2_DQLD = 68;
constexpr int RW2_STAGE = RW_MB + 64 * RW2_DQLD * 4;
DI void rw_state_item(const Params& p, int s, char* smem) {
  const int tid = opaque_tid(), lane = tid & 63, wid = tid >> 6, r = lane & 31, h = lane >> 5;
  f32x16 S0 = zero16(), S1 = zero16();
  uint4 rp, rd0, rd1;
  const int prow = tid >> 3, pcol = (tid & 7) * 8;
  const int drow = tid >> 3, dcol = (tid & 7) * 8;
  __syncthreads();
  {
    const char* rec = rw_rec(p, s, 0);
    rp = *(const uint4*)(rec + 16384 + (prow * 64 + pcol) * 2);
    rd0 = *(const uint4*)(rec + 24576 + (drow * 64 + dcol) * 4); rd1 = *(const uint4*)(rec + 24576 + (drow * 64 + dcol + 4) * 4);
    *(uint4*)(smem + (prow * RW_LD + pcol) * 2) = rp;
    *(uint4*)(smem + RW_MB + (drow * RW2_DQLD + dcol) * 4) = rd0; *(uint4*)(smem + RW_MB + (drow * RW2_DQLD + dcol + 4) * 4) = rd1;
  }
  __syncthreads();
  for (int c = 0; c < NCH_; ++c) {
    const bool more = c + 1 < NCH_;
    if (more) {
      const char* rec = rw_rec(p, s, c + 1);
      rp = *(const uint4*)(rec + 16384 + (prow * 64 + pcol) * 2);
      rd0 = *(const uint4*)(rec + 24576 + (drow * 64 + dcol) * 4); rd1 = *(const uint4*)(rec + 24576 + (drow * 64 + dcol + 4) * 4);
    }
    sched_fence();
    if (wid < 2) {
      const char* PT = smem + (c & 1) * RW2_STAGE;
      const float* DQ = (const float*)(PT + RW_MB);
      const int i = wid * 32 + r;
      bf16_t* sd = (bf16_t*)(rw_rec(p, s, c) + 16384);
#pragma unroll
      for (int g = 0; g < 4; ++g) {
        uint2 o0, o1;
        o0.x = pack2bf(S0[4 * g], S0[4 * g + 1]); o0.y = pack2bf(S0[4 * g + 2], S0[4 * g + 3]);
        o1.x = pack2bf(S1[4 * g], S1[4 * g + 1]); o1.y = pack2bf(S1[4 * g + 2], S1[4 * g + 3]);
        *(uint2*)(sd + i * 64 + 8 * g + 4 * h) = o0; *(uint2*)(sd + i * 64 + 32 + 8 * g + 4 * h) = o1;
      }
      bf16x8 bfr[2][2];
#pragma unroll
      for (int s2 = 0; s2 < 2; ++s2) {
        const uint4 u0 = make_uint4(pack2bf(S0[8 * s2], S0[8 * s2 + 1]), pack2bf(S0[8 * s2 + 2], S0[8 * s2 + 3]), pack2bf(S0[8 * s2 + 4], S0[8 * s2 + 5]), pack2bf(S0[8 * s2 + 6], S0[8 * s2 + 7]));
        const uint4 u1 = make_uint4(pack2bf(S1[8 * s2], S1[8 * s2 + 1]), pack2bf(S1[8 * s2 + 2], S1[8 * s2 + 3]), pack2bf(S1[8 * s2 + 4], S1[8 * s2 + 5]), pack2bf(S1[8 * s2 + 6], S1[8 * s2 + 7]));
        __builtin_memcpy(&bfr[0][s2], &u0, 16); __builtin_memcpy(&bfr[1][s2], &u1, 16);
      }
      f32x16 n0, n1;
#pragma unroll
      for (int g = 0; g < 4; ++g) {
        const float4 a = *(const float4*)(DQ + i * RW2_DQLD + 8 * g + 4 * h), bq = *(const float4*)(DQ + i * RW2_DQLD + 32 + 8 * g + 4 * h);
        n0[4 * g] = a.x; n0[4 * g + 1] = a.y; n0[4 * g + 2] = a.z; n0[4 * g + 3] = a.w;
        n1[4 * g] = bq.x; n1[4 * g + 1] = bq.y; n1[4 * g + 2] = bq.z; n1[4 * g + 3] = bq.w;
      }
#pragma unroll
      for (int jb2 = 0; jb2 < 2; ++jb2)
#pragma unroll
        for (int s2 = 0; s2 < 2; ++s2) {
          const char* a0 = PT + ((0 * 32 + r) * RW_LD + jb2 * 32 + 16 * s2 + 4 * h) * 2;
          const char* a1 = PT + ((1 * 32 + r) * RW_LD + jb2 * 32 + 16 * s2 + 4 * h) * 2;
          const uint2 l0 = *(const uint2*)a0, h0 = *(const uint2*)(a0 + 16), l1 = *(const uint2*)a1, h1 = *(const uint2*)(a1 + 16);
          const uint4 u0 = make_uint4(l0.x, l0.y, h0.x, h0.y), u1 = make_uint4(l1.x, l1.y, h1.x, h1.y);
          bf16x8 af0, af1; __builtin_memcpy(&af0, &u0, 16); __builtin_memcpy(&af1, &u1, 16);
          n0 = mfma32(af0, bfr[jb2][s2], n0);
          n1 = mfma32(af1, bfr[jb2][s2], n1);
        }
      S0 = n0; S1 = n1;
    }
    if (more) {
      char* d = smem + ((c + 1) & 1) * RW2_STAGE;
      *(uint4*)(d + (prow * RW_LD + pcol) * 2) = rp;
      *(uint4*)(d + RW_MB + (drow * RW2_DQLD + dcol) * 4) = rd0; *(uint4*)(d + RW_MB + (drow * RW2_DQLD + dcol + 4) * 4) = rd1;
    }
    __syncthreads();
  }
}

DI void rw_out_item(const Params& p, int it, char* smem) {
  const int s = it / NCH_, c = it % NCH_, dir = s >> 3, b = (s >> 2) & 1, hd = s & 3;
  const int tid = opaque_tid(), lane = tid & 63, wid = tid >> 6;
  const bf16_t* rb = (const bf16_t*)(p.ws + OFF_REGION + R_RB16);
  const size_t AS = (size_t)NT_ * 256;
  float* ys = (float*)(p.ws + OFF_REGION + R_YS) + (size_t)dir * NT_ * 256;
  char* const Sm = smem; char* const RyT = smem + RW_MB; char* const MyT = smem + 2 * RW_MB; char* const Vi = smem + 3 * RW_MB;
  const char* rec = rw_rec(p, s, c);
  __syncthreads();
  {
    const int row = tid >> 3, col = (tid & 7) * 8;
    *(uint4*)(Sm + (row * RW_LD + col) * 2) = *(const uint4*)(rec + 16384 + (row * 64 + col) * 2);
    *(uint4*)(RyT + (row * RW_LD + col) * 2) = *(const uint4*)(rec + (row * 64 + col) * 2);
    *(uint4*)(MyT + (row * RW_LD + col) * 2) = *(const uint4*)(rec + 8192 + (row * 64 + col) * 2);
    const int n = seq_tok(dir, b, c * 64 + row);
    const uint4 uv = *(const uint4*)(rb + 1 * AS + (size_t)n * 256 + hd * 64 + col);
    const unsigned av[4] = {uv.x, uv.y, uv.z, uv.w};
#pragma unroll
    for (int q = 0; q < 4; ++q) {
      *(bf16_t*)(Vi + ((col + 2 * q) * RW_LD + row) * 2) = (bf16_t)(av[q] & 0xffff);
      *(bf16_t*)(Vi + ((col + 2 * q + 1) * RW_LD + row) * 2) = (bf16_t)(av[q] >> 16);
    }
  }
  __syncthreads();
  if (wid < 4) {
    const int mb = (wid >> 1) & 1, nb = wid & 1, r = lane & 31, h = lane >> 5;
    f32x16 acc = zero16();
    acc = rw_mm(Sm, RyT, mb, nb, lane, acc);
    acc = rw_mm(Vi, MyT, mb, nb, lane, acc);
    const int n = seq_tok(dir, b, c * 64 + nb * 32 + r);
#pragma unroll
    for (int g = 0; g < 4; ++g)
      *(float4*)(ys + (size_t)n * 256 + hd * 64 + mb * 32 + 8 * g + 4 * h) = make_float4(acc[4 * g], acc[4 * g + 1], acc[4 * g + 2], acc[4 * g + 3]);
  }
}
constexpr int ATT_KLD = 104, ATT_VLD = 68;
constexpr int ATT_KB = 64 * ATT_KLD * 2, ATT_VB = 64 * ATT_VLD * 2, ATT_STAGE = ATT_KB + ATT_VB;
DI float fexp2(float x) {
#ifdef EMU
  return exp2f(x);
#else
  return __builtin_amdgcn_exp2f(x);
#endif
}
DI void attn_item(const Params& p, int b, int h, int qt, bool isctx, char* smem) {
  const int tid = opaque_tid(), lane = tid & 63, wid = tid >> 6, r = lane & 31, h2 = lane >> 5;
  const bf16_t* qb = (const bf16_t*)(p.osc + O_QB);
  const bf16_t* kbase = (const bf16_t*)(p.ws + OFF_REGION + R_KB) + (size_t)(b * 8 + h) * KT_ * 96;
  const bf16_t* vbase = (const bf16_t*)(p.ws + OFF_REGION + R_VT) + (size_t)(b * 8 + h) * 64 * KT_;
  bf16_t* att = (bf16_t*)(p.ws + OFF_REGION + R_ATT);
  const int nq0 = isctx ? NX_ + b * CL_ + qt * 256 : b * T_ + qt * 256;
  const int nkt = (isctx ? CL_ : KT_) / 64;
  const int nq = nq0 + wid * 32 + r;
  bf16x8 qf[6];
#pragma unroll
  for (int ks = 0; ks < 6; ++ks) qf[ks] = *(const bf16x8*)(qb + (size_t)nq * 768 + h * 96 + ks * 16 + h2 * 8);
  f32x16 oacc[2] = {zero16(), zero16()};
  float m = -1e30f, lsum = 0.f;
  const float sc = 0.10206207261596577f * 1.4426950408889634f;
  const int kc1 = tid + 512;
  const int vd = tid >> 3, vc = tid & 7;
  uint4 rk0, rk1, rv;
  auto gload = [&](int kt) {
    const bf16_t* ksrc = kbase + (size_t)kt * 64 * 96;
    rk0 = *(const uint4*)(ksrc + tid * 8);
    if (kc1 < 768) rk1 = *(const uint4*)(ksrc + kc1 * 8);
    rv = *(const uint4*)(vbase + (size_t)vd * KT_ + kt * 64 + vc * 8);
  };
  auto sstore = [&](int buf) {
    char* Ks = smem + buf * ATT_STAGE; char* Vs = Ks + ATT_KB;
    *(uint4*)(Ks + ((tid / 12) * ATT_KLD + (tid % 12) * 8) * 2) = rk0;
    if (kc1 < 768) *(uint4*)(Ks + ((kc1 / 12) * ATT_KLD + (kc1 % 12) * 8) * 2) = rk1;
    *(uint2*)(Vs + (vd * ATT_VLD + vc * 8) * 2) = make_uint2(rv.x, rv.y);
    *(uint2*)(Vs + (vd * ATT_VLD + vc * 8 + 4) * 2) = make_uint2(rv.z, rv.w);
  };
  __syncthreads();
  gload(0); sstore(0);
  __syncthreads();
  for (int kt = 0; kt < nkt; ++kt) {
    const bool more = kt + 1 < nkt;
    if (more) gload(kt + 1);
    sched_fence();
    const char* Ks = smem + (kt & 1) * ATT_STAGE; const char* Vs = Ks + ATT_KB;
    f32x16 sacc[2] = {zero16(), zero16()};
#pragma unroll
    for (int ks = 0; ks < 6; ++ks)
#pragma unroll
      for (int kb = 0; kb < 2; ++kb) {
        const bf16x8 kf = *(const bf16x8*)(Ks + ((kb * 32 + r) * ATT_KLD + ks * 16 + h2 * 8) * 2);
        sacc[kb] = mfma32(kf, qf[ks], sacc[kb]);
      }
    float mx = -1e30f;
#pragma unroll
    for (int kb = 0; kb < 2; ++kb)
#pragma unroll
      for (int i = 0; i < 16; ++i) mx = fmaxf(mx, sacc[kb][i]);
    mx = fmaxf(mx, __shfl_xor(mx, 32));
    const float mn = fmaxf(m, mx * sc);
    const float alpha = fexp2(m - mn);
    m = mn;
    float ps = 0.f;
#pragma unroll
    for (int kb = 0; kb < 2; ++kb)
#pragma unroll
      for (int i = 0; i < 16; ++i) { const float pv = fexp2(sacc[kb][i] * sc - mn); sacc[kb][i] = pv; ps += pv; }
    lsum = lsum * alpha + ps;
#pragma unroll
    for (int db = 0; db < 2; ++db)
#pragma unroll
      for (int i = 0; i < 16; ++i) oacc[db][i] *= alpha;
#pragma unroll
    for (int kb = 0; kb < 2; ++kb)
#pragma unroll
      for (int s = 0; s < 2; ++s) {
        bf16x8 pf;
        {
          const unsigned u0 = pack2bf(sacc[kb][8 * s + 0], sacc[kb][8 * s + 1]), u1 = pack2bf(sacc[kb][8 * s + 2], sacc[kb][8 * s + 3]);
          const unsigned u2 = pack2bf(sacc[kb][8 * s + 4], sacc[kb][8 * s + 5]), u3 = pack2bf(sacc[kb][8 * s + 6], sacc[kb][8 * s + 7]);
          const uint4 u = make_uint4(u0, u1, u2, u3);
          __builtin_memcpy(&pf, &u, 16);
        }
#pragma unroll
        for (int db = 0; db < 2; ++db) {
          const char* vrow = Vs + ((db * 32 + r) * ATT_VLD + kb * 32 + 16 * s + 4 * h2) * 2;
          const uint2 lo = *(const uint2*)(vrow), hi = *(const uint2*)(vrow + 16);
          const uint4 u = make_uint4(lo.x, lo.y, hi.x, hi.y);
          bf16x8 vf; __builtin_memcpy(&vf, &u, 16);
          oacc[db] = mfma32(vf, pf, oacc[db]);
        }
      }
    sched_fence();
    if (more) sstore((kt + 1) & 1);
    __syncthreads();
  }
  lsum += __shfl_xor(lsum, 32);
  const float inv = 1.f / lsum;
#pragma unroll
  for (int db = 0; db < 2; ++db)
#pragma unroll
    for (int g = 0; g < 4; ++g) {
      uint2 o;
      o.x = pack2bf(oacc[db][g * 4 + 0] * inv, oacc[db][g * 4 + 1] * inv);
      o.y = pack2bf(oacc[db][g * 4 + 2] * inv, oacc[db][g * 4 + 3] * inv);
      *(uint2*)(att + (size_t)nq * 512 + h * 64 + db * 32 + 8 * g + 4 * h2) = o;
    }
}

constexpr int P3B_ITEMS = RW1_ITEMS + ML2_ITEMS + MLA_Q_TILES + MLA_KV_TILES;
DI void phase3b(const Params& p, int l, char* smem) {
  for (int it = vblock(); it < P3B_ITEMS; it += gridDim.x) {
    int i = it;
    if (i < RW1_ITEMS) { rw_chunk_item(p, i, smem); continue; }
    i -= RW1_ITEMS;
    if (i < ML2_ITEMS) { mlstm_scan_item(p, i); continue; }
    i -= ML2_ITEMS;
    if (i < MLA_Q_TILES) mla_q_item(p, l, i, smem); else mla_kv_item(p, l, i - MLA_Q_TILES, smem);
  }
}

DI constexpr int att_items(int l) { return NB_ * 8 * (T_ / 256) + (l == 0 ? NB_ * 8 * (CL_ / 256) : 0); }
DI void spin_until_ge(int* ctr, int target) {
#ifdef EMU
  while (__atomic_load_n(ctr, __ATOMIC_SEQ_CST) < target) emu::yield();
#else
  while (__hip_atomic_load(ctr, __ATOMIC_RELAXED, __HIP_MEMORY_SCOPE_AGENT) < target) __builtin_amdgcn_s_sleep(8);
#endif
}
DI void phase4(const Params& p, int l, char* smem, int* ctr) {
  const int G = gridDim.x, nsb = G >= 2 * RW2_ITEMS ? RW2_ITEMS : (G > 1 ? G / 2 : 1);
  if ((int)blockIdx.x < nsb) {
    for (int s = blockIdx.x; s < RW2_ITEMS; s += nsb) rw_state_item(p, s, smem);
#ifndef EMU
    asm volatile("s_waitcnt vmcnt(0)" ::: "memory");
#endif
    __syncthreads();
    if (opaque_tid() == 0) { __threadfence(); atomicAdd(ctr + 2, (RW2_ITEMS - (int)blockIdx.x + nsb - 1) / nsb); }
  }
  const int QT = T_ / 256, CQ = (l == 0 ? (NB_ * 8 * (CL_ / 256)) / 8 : 0), R3 = RW1_ITEMS / 8;
  const int per = 2 * QT + CQ + R3;
  int* sitem = (int*)(smem + 160 * 1024 - 16);
  bool r2ok = false;
  const int x0 = xcc_id();
  for (;;) {
    __syncthreads();
    if (opaque_tid() == 0) {
      int item = -1;
      for (int k = 0; k < 8 && item < 0; ++k) {
        const int x = (x0 + k) & 7;
        if (ld_relaxed(ctr + 8 + x) >= per) continue;
        const int li = atomicAdd(ctr + 8 + x, 1);
        if (li < per) item = x * per + li;
      }
      *sitem = item;
    }
    __syncthreads();
    const int item = *sitem;
    if (item < 0) break;
    const int x = item / per; int li = item % per;
    if (li < 2 * QT) { const int bh = 2 * x + li / QT, qt = li % QT; attn_item(p, bh >> 3, bh & 7, qt, false, smem); continue; }
    li -= 2 * QT;
    if (li < CQ) { const int ci = x * CQ + li, qt = ci % (CL_ / 256), bh = ci / (CL_ / 256); attn_item(p, bh >> 3, bh & 7, qt, true, smem); continue; }
    li -= CQ;
    if (!r2ok) {
      if (opaque_tid() == 0) { spin_until_ge(ctr + 2, RW2_ITEMS); __threadfence(); }
      __syncthreads();
      r2ok = true;
    }
    rw_out_item(p, x * R3 + li, smem);
  }
}
constexpr int ML3_CC = CL_ / 64, ML3_XC = T_ / 64;
DI constexpr int ml3_items(bool with_ctx) { return NB_ * 4 * (ML3_XC + (with_ctx ? ML3_CC : 0)); }
DI void mlstm_out_item(const Params& p, int l, int it, bool with_ctx, char* smem) {
  const int per = ML3_XC + (with_ctx ? ML3_CC : 0);
  const int bh = it / per, b = bh >> 2, hd = bh & 3;
  int tc = it % per; if (!with_ctx) tc += ML3_CC;
  const bool isctx = tc < ML3_CC;
  const int ntok0 = isctx ? NX_ + b * CL_ + tc * 64 : b * T_ + (tc - ML3_CC) * 64;
  float* qs = (float*)smem;
  float* ks = qs + 64 * 33;
  float* vs = ks + 64 * 33;
  float* Cs = vs + 64 * 64;
  float* Sm = Cs + 64 * 33;
  float* hs = Sm + 64 * 65;
  float* bj = hs + 64 * 64;
  float* ip = bj + 64;
  float* ns = ip + 64;
  const float* zrec = (const float*)(p.ws + OFF_REGION + R_ZREC);
  const int tid = opaque_tid(), lane = tid & 63, wid = tid >> 6;
  __syncthreads();
  for (int idx = tid; idx < 64 * 64; idx += NTHR) hs[idx] = 0.f;
  for (int dir = 0; dir < 2; ++dir) {
    const int c = dir == 0 ? tc : (isctx ? ML3_CC - 1 - tc : ML3_CC + (ML3_XC - 1 - (tc - ML3_CC)));
    const int s = dir * 8 + b * 4 + hd;
    const float* st = (const float*)(p.ws + OFF_REGION + R_MLST) + ((size_t)s * NCH_ + c) * ML_ST;
    const float m_start = st[2082];
    __syncthreads();
    for (int idx = tid; idx < 64 * 32; idx += NTHR) {
      const int j = idx >> 5, e = idx & 31;
      const int n = ntok0 + (dir ? 63 - j : j);
      qs[j * 33 + e] = zrec[(size_t)n * ZREC_W + ZR_MLQ + hd * 32 + e] * 0.17677669529663687f;
      ks[j * 33 + e] = zrec[(size_t)n * ZREC_W + ZR_MLK + hd * 32 + e];
      Cs[j * 33 + e] = st[j * 32 + e];
    }
    for (int idx = tid; idx < 64 * 64; idx += NTHR) {
      const int j = idx >> 6, e = idx & 63;
      const int n = ntok0 + (dir ? 63 - j : j);
      vs[idx] = zrec[(size_t)n * ZREC_W + ZR_MLV + hd * 64 + e];
    }
    if (tid < 32) ns[tid] = st[2048 + tid];
    if (wid == 1) {
      const int n = ntok0 + (dir ? 63 - lane : lane);
      const float fp = zrec[(size_t)n * ZREC_W + ZR_MLF + dir * 4 + hd] + p.ml_b_f[(l * 2 + dir) * 4 + hd];
      ip[lane] = zrec[(size_t)n * ZREC_W + ZR_MLI + dir * 4 + hd] + p.ml_b_i[(l * 2 + dir) * 4 + hd];
      bj[lane] = wave_incl_scan(logsigmoidf_(fp), lane);
    }
    __syncthreads();
    const int j = tid >> 3, sg = tid & 7;
    const float bjj = bj[j];
    float rmax = -1e30f;
#pragma unroll 1
    for (int u = 0; u < 8; ++u) {
      const int sI = sg * 8 + u;
      float d = 0.f;
#pragma unroll 8
      for (int e = 0; e < 32; ++e) d += qs[j * 33 + e] * ks[sI * 33 + e];
      Sm[j * 65 + sI] = d;
      const float dl = sI <= j ? bjj - bj[sI] + ip[sI] : -1e30f;
      rmax = fmaxf(rmax, dl);
    }
    rmax = fmaxf(rmax, __shfl_xor(rmax, 1)); rmax = fmaxf(rmax, __shfl_xor(rmax, 2)); rmax = fmaxf(rmax, __shfl_xor(rmax, 4));
    const float g = bjj + m_start;
    const float mj = fmaxf(g, rmax);
    const float inter = fexp(g - mj);
    float part = 0.f;
#pragma unroll 1
    for (int u = 0; u < 8; ++u) {
      const int sI = sg * 8 + u;
      const float sv = sI <= j ? fexp(bjj - bj[sI] + ip[sI] - mj) * Sm[j * 65 + sI] : 0.f;
      Sm[j * 65 + sI] = sv; part += sv;
    }
    float nq = 0.f;
#pragma unroll
    for (int e = 0; e < 4; ++e) nq += ns[sg * 4 + e] * qs[j * 33 + sg * 4 + e];
    part += inter * nq;
    part += __shfl_xor(part, 1); part += __shfl_xor(part, 2); part += __shfl_xor(part, 4);
    const float den = fmaxf(fabsf(part), fexp(-mj));
    __syncthreads();
    const int v0 = sg * 8;
    float num[8], cq[8];
#pragma unroll
    for (int u = 0; u < 8; ++u) { num[u] = 0.f; cq[u] = 0.f; }
#pragma unroll 2
    for (int sI = 0; sI <= j; ++sI) {
      const float sv = Sm[j * 65 + sI];
      const float4 va = *(const float4*)(vs + sI * 64 + v0), vb = *(const float4*)(vs + sI * 64 + v0 + 4);
      num[0] += sv * va.x; num[1] += sv * va.y; num[2] += sv * va.z; num[3] += sv * va.w;
      num[4] += sv * vb.x; num[5] += sv * vb.y; num[6] += sv * vb.z; num[7] += sv * vb.w;
    }
#pragma unroll 2
    for (int e = 0; e < 32; ++e) {
      const float qv = qs[j * 33 + e];
#pragma unroll
      for (int u = 0; u < 8; ++u) cq[u] += Cs[(v0 + u) * 33 + e] * qv;
    }
    const float rden = 1.f / den;
#pragma unroll
    for (int u = 0; u < 8; ++u) hs[(dir ? 63 - j : j) * 64 + v0 + u] += (num[u] + inter * cq[u]) * rden;
    __syncthreads();
  }
  const int tk = tid >> 3, v0 = (tid & 7) * 8, n = ntok0 + tk;
  float ss = 0.f; float hv[8];
#pragma unroll
  for (int u = 0; u < 8; ++u) { hv[u] = hs[tk * 64 + v0 + u]; ss += hv[u] * hv[u]; }
  ss += __shfl_xor(ss, 1); ss += __shfl_xor(ss, 2); ss += __shfl_xor(ss, 4);
  const float rs = 1.0f / sqrtf(ss * (1.f / 64.f) + 1e-6f);
  unsigned o[4];
#pragma unroll
  for (int u = 0; u < 8; u += 2) {
    const int cc = hd * 64 + v0 + u;
    const float a = hv[u] * rs * p.ml_g_norm[l * 256 + cc] * sigmoidf_(zrec[(size_t)n * ZREC_W + ZR_MLO + cc]);
    const float bq = hv[u + 1] * rs * p.ml_g_norm[l * 256 + cc + 1] * sigmoidf_(zrec[(size_t)n * ZREC_W + ZR_MLO + cc + 1]);
    o[u >> 1] = pack2bf(a, bq);
  }
  bf16_t* mlo = (bf16_t*)(p.ws + OFF_REGION + R_MLO);
  *(uint4*)(mlo + (size_t)n * 256 + hd * 64 + v0) = make_uint4(o[0], o[1], o[2], o[3]);
}

DI constexpr int rwo_items(bool with_ctx) { return (with_ctx ? NT_ : NX_) / 16; }
DI void rwkv_out_item(const Params& p, int l, int it, char* smem) {
  float* sg = (float*)smem;
  const float* zrec = (const float*)(p.ws + OFF_REGION + R_ZREC);
  const bf16_t* rb = (const bf16_t*)(p.ws + OFF_REGION + R_RB16);
  const float* bso = (const float*)(p.ws + OFF_REGION + R_BS);
  const float* ys = (const float*)(p.ws + OFF_REGION + R_YS);
  bf16_t* rwo = (bf16_t*)(p.ws + OFF_REGION + R_RWO);
  const float* mu = p.rw_mu + (size_t)l * 1152;
  const int tid = opaque_tid(), n0 = it * 16;
  __syncthreads();
  for (int idx = tid; idx < 16 * 128; idx += NTHR) {
    const int tt = idx >> 7, k = idx & 127, n = n0 + tt, t = tok_t(n), c = 1024 + k;
    const int len = n < NX_ ? T_ : CL_;
    const float* zr = zrec + (size_t)n * ZREC_W + ZR_RW + c;
    const float z = zr[0];
    const float zp = t > 0 ? zr[-ZREC_W] : 0.f, zn = t < len - 1 ? zr[ZREC_W] : 0.f;
    sg[k * 16 + tt] = sigmoidf_(z + (0.5f * (zp + zn) - z) * mu[c]);
  }
  __syncthreads();
  const int col = tid & 255, half = tid >> 8;
  float acc[8];
#pragma unroll
  for (int i = 0; i < 8; ++i) acc[i] = 0.f;
  const float* g2 = p.rw_g2 + (size_t)l * 128 * 256 + col;
  for (int k = 0; k < 128; ++k) {
    const float gv = g2[k * 256];
    const float* sk = sg + k * 16 + half * 8;
#pragma unroll
    for (int i = 0; i < 8; ++i) acc[i] += sk[i] * gv;
  }
  const size_t AS = (size_t)NT_ * 256;
  const float lw = p.rw_lnx_w[(size_t)l * 256 + col], lb = p.rw_lnx_b[(size_t)l * 256 + col];
#pragma unroll
  for (int i = 0; i < 8; ++i) {
    const int n = n0 + half * 8 + i;
    const size_t o = (size_t)n * 256 + col;
    const float y = ys[o] + ys[AS + o];
    const float mean = wave_sum(y) * (1.f / 64.f);
    const float dv = y - mean;
    const float var = wave_sum(dv * dv) * (1.f / 64.f);
    const float yn = dv * (1.0f / sqrtf(var + 64e-5f)) * lw + lb;
    const float v = bf2f(rb[1 * AS + o]);
    const float bsum = bso[(size_t)n * 4 + (col >> 6)] + bso[((size_t)NT_ + n) * 4 + (col >> 6)];
    rwo[o] = f2bf((yn + bsum * v) * acc[i]);
  }
}
DI void phase5(const Params& p, int l, bool with_ctx, char* smem) {
  const int n1 = ml3_items(with_ctx), n2 = rwo_items(with_ctx);
  for (int it = blockIdx.x; it < n1 + n2; it += gridDim.x) {
    if (it < n1) mlstm_out_item(p, l, it, with_ctx, smem);
    else rwkv_out_item(p, l, it - n1, smem);
  }
}
DI void phase_merge(const Params& p, int l, bool with_ctx, char* smem) {
  const bf16_t* H = (const bf16_t*)(p.ws + OFF_H);
  const char* W = p.ws + OFF_WMIX + (size_t)l * WM_SIZE;
  const bf16_t* Wg = (const bf16_t*)(W + WM_GATE);
  const bf16_t* att = (const bf16_t*)(p.ws + OFF_REGION + R_ATT);
  const bf16_t* mlo = (const bf16_t*)(p.ws + OFF_REGION + R_MLO);
  const bf16_t* rwo = (const bf16_t*)(p.ws + OFF_REGION + R_RWO);
  bf16_t* ymix = (bf16_t*)(p.osc + O_YMIX);
  const int TM = (with_ctx ? NT_ : NX_) / 128;
  for (int it = vblock(); it < TM * 8; it += gridDim.x) {
    const int tid = opaque_tid();
    const int tm = it >> 3, tn = it & 7;
    __syncthreads();
    f32x16 yacc[G128::MB][G128::NB];
#pragma unroll
    for (int a = 0; a < G128::MB; ++a)
#pragma unroll
      for (int b = 0; b < G128::NB; ++b) yacc[a][b] = zero16();
#pragma unroll
    for (int i = 0; i < 3; ++i) {
      f32x16 gacc[G128::MB][G128::NB], bacc[G128::MB][G128::NB];
#pragma unroll
      for (int a = 0; a < G128::MB; ++a)
#pragma unroll
        for (int b = 0; b < G128::NB; ++b) { gacc[a][b] = zero16(); bacc[a][b] = zero16(); }
      const bf16_t* A0 = H + (size_t)tm * 128 * 1024;
      G128::run(gacc, [&](int r) { return A0 + (size_t)r * 1024; }, Wg + ((size_t)i * 1024 + tn * 128) * 1024, 1024, 1024, smem);
      const bf16_t* br = i == 0 ? att : (i == 1 ? mlo : rwo);
      const int kb = i == 0 ? 512 : 256;
      const bf16_t* Wb = (const bf16_t*)(W + (i == 0 ? WM_BRA : (i == 1 ? WM_BRM : WM_BRR)));
      const bf16_t* B0 = br + (size_t)tm * 128 * kb;
      G128::run(bacc, [&](int r) { return B0 + (size_t)r * kb; }, Wb + (size_t)tn * 128 * kb, kb, kb, smem);
#pragma unroll
      for (int a = 0; a < G128::MB; ++a)
#pragma unroll
        for (int b = 0; b < G128::NB; ++b)
#pragma unroll
          for (int e = 0; e < 16; ++e) yacc[a][b][e] += sigmoidf_(gacc[a][b][e]) * bacc[a][b][e];
    }
    {
      const int lane = tid & 63, wid = tid >> 6, wm = wid / 4, wn = wid % 4;
      float* scr = (float*)(smem + wid * WTile<1>::BYTES);
#pragma unroll
      for (int mb = 0; mb < G128::MB; ++mb) {
        WTile<1>::put(scr, 0, lane, yacc[mb][0]);
        const int row0 = tm * 128 + wm * 64 + mb * 32, col0 = tn * 128 + wn * 32;
        WTile<1>::rows8(scr, lane, [&](int r, int c, const float4& a, const float4& bq) {
          *(uint4*)(ymix + (size_t)(row0 + r) * 1024 + col0 + c) = pack8bf(a, bq); });
      }
    }
  }
}

DI void phase_wout(const Params& p, int l, bool with_ctx, char* smem) {
  const bf16_t* ymix = (const bf16_t*)(p.osc + O_YMIX);
  const bf16_t* Wo = (const bf16_t*)(p.ws + OFF_WMIX + (size_t)l * WM_SIZE + WM_OUT);
  float* xs = (float*)(p.ws + OFF_XS);
  const float* mod = (const float*)(p.ws + OFF_MOD) + (size_t)l * 3 * 6144;
  const int TM = (with_ctx ? NT_ : NX_) / 128;
  const int n_g = TM * 8;
  for (int it = vblock(); it < n_g + CVT_MOE_TILES; it += gridDim.x) {
    if (it >= n_g) { cvt_moe_item(p, l, it - n_g, smem); continue; }
    const int tid = opaque_tid();
    const int tm = it >> 3, tn = it & 7;
    __syncthreads();
    f32x16 acc[G128::MB][G128::NB];
#pragma unroll
    for (int a = 0; a < G128::MB; ++a)
#pragma unroll
      for (int b = 0; b < G128::NB; ++b) acc[a][b] = zero16();
    const bf16_t* A0 = ymix + (size_t)tm * 128 * 1024;
    G128::run(acc, [&](int r) { return A0 + (size_t)r * 1024; }, Wo + (size_t)tn * 128 * 1024, 1024, 1024, smem);
    const float* m2 = mod + (size_t)tok_modrow(tm * 128) * 6144 + 2 * 1024;
    {
      const int lane = tid & 63, wid = tid >> 6, wm = wid / 4, wn = wid % 4;
      float* scr = (float*)(smem + wid * WTile<1>::BYTES);
#pragma unroll
      for (int mb = 0; mb < G128::MB; ++mb) {
        WTile<1>::put(scr, 0, lane, acc[mb][0]);
        const int row0 = tm * 128 + wm * 64 + mb * 32, col0 = tn * 128 + wn * 32;
        WTile<1>::rows4(scr, lane, [&](int r, int c, const float4& a) {
          float4* d = (float4*)(xs + (size_t)(row0 + r) * 1024 + col0 + c);
          const float4 g = *(const float4*)(m2 + col0 + c); float4 x = *d;
          x.x += g.x * a.x; x.y += g.y * a.y; x.z += g.z * a.z; x.w += g.w * a.w; *d = x; });
      }
    }
  }
}

typedef Gemm<128, 64, 64, 4, 2> GRT;
DI void phase_router(const Params& p, int l, bool with_ctx, char* smem, int* cnt) {
  float* xs = (float*)(p.ws + OFF_XS);
  bf16_t* H = (bf16_t*)(p.ws + OFF_H);
  const float* mod = (const float*)(p.ws + OFF_MOD) + (size_t)l * 3 * 6144;
  const bf16_t* Wr = (const bf16_t*)(p.ws + OFF_WMIX + (size_t)l * WM_SIZE + WM_RT);
  int* eidx = (int*)(p.ws + OFF_REGION + R_EIDX);
  float* ewt = (float*)(p.ws + OFF_REGION + R_EWT);
  int* erank = (int*)(p.ws + OFF_REGION + R_ERANK);
  int* elist = (int*)(p.ws + OFF_REGION + R_ELIST);
  float* sc = (float*)(smem + GRT::SMEM);
  float* bs = sc + 128 * 65;
  float* gs = bs + 128 * 65;
  const int tid = opaque_tid(), lane = tid & 63, wid = tid >> 6;
  const int ntok = with_ctx ? NT_ : NX_;
  for (int it = blockIdx.x; it < ntok / 128; it += gridDim.x) {
    const int n0 = it * 128;
    __syncthreads();
    for (int rr = 0; rr < 16; ++rr) {
      const int n = n0 + wid * 16 + rr;
      float v[16];
#pragma unroll
      for (int j = 0; j < 4; ++j) {
        const float4 t = *(const float4*)(xs + (size_t)n * 1024 + (j * 64 + lane) * 4);
        v[j * 4] = t.x; v[j * 4 + 1] = t.y; v[j * 4 + 2] = t.z; v[j * 4 + 3] = t.w;
      }
      const float* m = mod + (size_t)tok_modrow(n) * 6144;
      row_norm_mod(v, p.g_ffn + (size_t)l * 1024, m + 3 * 1024, m + 4 * 1024, H + (size_t)n * 1024, lane);
    }
    __syncthreads();
    f32x16 acc[1][1]; acc[0][0] = zero16();
    const bf16_t* A0 = H + (size_t)n0 * 1024;
    GRT::run(acc, [&](int r) { return A0 + (size_t)r * 1024; }, Wr, 1024, 1024, smem);
    {
      const int col = GRT::col_of(tid, 0);
      const float rb = p.router_bias[l * 64 + col];
#pragma unroll
      for (int e = 0; e < 16; ++e) {
        const int row = GRT::row_of(tid, 0, e);
        const float s = sigmoidf_(acc[0][0][e]);
        sc[row * 65 + col] = s; bs[row * 65 + col] = s + rb;
      }
    }
    __syncthreads();
    if (tid < 128) {
      const int n = n0 + tid;
      float* b = bs + tid * 65; const float* s = sc + tid * 65; float* g = gs + tid * 9;
      for (int gi = 0; gi < 8; ++gi) {
        float m1 = -1e30f, m2 = -1e30f;
        for (int j = 0; j < 8; ++j) { const float x = b[gi * 8 + j]; if (x > m1) { m2 = m1; m1 = x; } else if (x > m2) m2 = x; }
        g[gi] = m1 + m2;
      }
      unsigned gmask = 0;
      for (int c = 0; c < 4; ++c) {
        int best = 0; float bv = -1e30f;
        for (int gi = 0; gi < 8; ++gi) if (!((gmask >> gi) & 1) && g[gi] > bv) { bv = g[gi]; best = gi; }
        gmask |= 1u << best;
      }
      for (int gi = 0; gi < 8; ++gi) if (!((gmask >> gi) & 1)) for (int j = 0; j < 8; ++j) b[gi * 8 + j] = -1e30f;
      int sel[8]; float wsum = 0.f;
#pragma unroll
      for (int c = 0; c < 8; ++c) {
        int best = 0; float bv = -1e30f;
        for (int e = 0; e < 64; ++e) { const float x = b[e]; if (x > bv) { bv = x; best = e; } }
        b[best] = -3e30f; sel[c] = best; wsum += s[best];
      }
      const float inv = 2.5f / (wsum + 1e-20f);
#pragma unroll
      for (int c = 0; c < 8; ++c) {
        const int e = sel[c];
        const int rk = atomicAdd(cnt + e, 1);
        eidx[n * 8 + c] = e; ewt[n * 8 + c] = s[e] * inv; erank[n * 8 + c] = rk;
        elist[(size_t)e * NT_ + rk] = n * 8 + c;
      }
    }
  }
}

typedef Gemm<128, 256, 32, 2, 4> GMOE;
constexpr int ACT_LD = 264;
constexpr int MOE_ACT_OFF = GMOE::SMEM;
constexpr int MOE_INFO_OFF = MOE_ACT_OFF + 128 * ACT_LD * 2;
static_assert(MOE_INFO_OFF + 128 * 8 + 67 * 4 * 2 <= 160 * 1024 - 16, "moe lds");
DI void moe_down_run(f32x16 (&acc)[GMOE::MB][GMOE::NB], const char* actl, const bf16_t* Bt, char* smem) {
  constexpr int BK = 32, LDA = GMOE::LDA, CPR = 4, BCH = GMOE::BCH, STG = GMOE::B_BYTES;
  const int tid = opaque_tid(), lane = tid & 63, wid = tid >> 6, wm = wid / 4, wn = wid % 4;
  const int kc = (tid % CPR) * 8, r0 = tid / CPR;
  u32x4 rb[BCH];
  char* Bs0 = smem;
#pragma unroll
  for (int i = 0; i < BCH; ++i) rb[i] = *(const u32x4*)(Bt + (size_t)(r0 + i * 128) * 256 + kc);
#pragma unroll
  for (int i = 0; i < BCH; ++i) *(u32x4*)(Bs0 + ((r0 + i * 128) * LDA + kc) * 2) = rb[i];
  __syncthreads();
  for (int kt = 0; kt < 256 / BK; ++kt) {
    const int kn = (kt + 1 < 256 / BK ? kt + 1 : kt) * BK;
#pragma unroll
    for (int i = 0; i < BCH; ++i) rb[i] = *(const u32x4*)(Bt + (size_t)(r0 + i * 128) * 256 + kn + kc);
    sched_fence();
    const char* Bs = Bs0 + (kt & 1) * STG;
#pragma unroll
    for (int ks = 0; ks < BK / 16; ++ks) {
      bf16x8 af[GMOE::MB], bfr[GMOE::NB];
#pragma unroll
      for (int mb = 0; mb < GMOE::MB; ++mb)
        af[mb] = *(const bf16x8*)(actl + ((wm * 64 + mb * 32 + (lane & 31)) * ACT_LD + kt * BK + ks * 16 + (lane >> 5) * 8) * 2);
#pragma unroll
      for (int nb = 0; nb < GMOE::NB; ++nb)
        bfr[nb] = *(const bf16x8*)(Bs + ((wn * 64 + nb * 32 + (lane & 31)) * LDA + ks * 16 + (lane >> 5) * 8) * 2);
#pragma unroll
      for (int mb = 0; mb < GMOE::MB; ++mb)
#pragma unroll
        for (int nb = 0; nb < GMOE::NB; ++nb) acc[mb][nb] = mfma32(af[mb], bfr[nb], acc[mb][nb]);
    }
    sched_fence();
    {
      char* Bd = Bs0 + ((kt + 1) & 1) * STG;
#pragma unroll
      for (int i = 0; i < BCH; ++i) *(u32x4*)(Bd + ((r0 + i * 128) * LDA + kc) * 2) = rb[i];
    }
    __syncthreads();
  }
}
DI void phase_moe(const Params& p, int l, bool with_ctx, char* smem, const int* cnt) {
  const bf16_t* H = (const bf16_t*)(p.ws + OFF_H);
  const bf16_t* GU = (const bf16_t*)(p.ws + OFF_REGION + R_WMOE + WE_GU);
  const bf16_t* DN = (const bf16_t*)(p.ws + OFF_REGION + R_WMOE + WE_DN);
  const float* ewt = (const float*)(p.ws + OFF_REGION + R_EWT);
  const int* elist = (const int*)(p.ws + OFF_REGION + R_ELIST);
  bf16_t* ybuf = (bf16_t*)(p.ws + OFF_REGION + R_YBUF);
  char* actl = smem + MOE_ACT_OFF;
  int* rtok = (int*)(smem + MOE_INFO_OFF);
  float* rwt = (float*)(rtok + 128);
  int* pre = (int*)(rwt + 128);
  int* off = pre + 67;
  int tid = threadIdx.x;
  const int ntok = with_ctx ? NT_ : NX_;
  __syncthreads();
  if (tid == 0) {
    int a = 0, o = 0;
    for (int e = 0; e < 65; ++e) { const int c = e < 64 ? cnt[e] : ntok; pre[e] = a; off[e] = o; a += (c + 127) >> 7; o += c; }
    pre[65] = a; off[65] = o;
  }
  __syncthreads();
  const int total = pre[65];
  for (int it = vblock(); it < total; it += gridDim.x) {
    tid = opaque_tid();
    int e0 = 0;
    while (pre[e0 + 1] <= it) ++e0;
    const int e = rfl(e0);
    const int rb = rfl(it - pre[e]);
    const int c = rfl(e < 64 ? cnt[e] : ntok);
    const int obase = rfl(off[e] + rb * 128);
    __syncthreads();
    if (tid < 128) {
      const int slot = rb * 128 + tid;
      int tok = 0; float w = 0.f;
      if (slot < c) {
        if (e < 64) { const int pk = elist[(size_t)e * NT_ + slot]; tok = pk >> 3; w = ewt[pk]; }
        else { tok = slot; w = 1.f; }
      }
      rtok[tid] = tok; rwt[tid] = w;
    }
    __syncthreads();
    const bf16_t* Wgu = GU + (size_t)e * 512 * 1024;
#pragma unroll 1
    for (int hf = 0; hf < 2; ++hf) {
      f32x16 acc[GMOE::MB][GMOE::NB];
#pragma unroll
      for (int a = 0; a < GMOE::MB; ++a)
#pragma unroll
        for (int b = 0; b < GMOE::NB; ++b) acc[a][b] = zero16();
      GMOE::run(acc, [&](int r) { return H + (size_t)rtok[r] * 1024; }, Wgu + (size_t)hf * 256 * 1024, 1024, 1024, smem);
      const int lane = tid & 63, wn = (tid >> 6) % 4, wmr = ((tid >> 6) / 4) * 64 + 4 * (lane >> 5);
      const int j = (hf * 4 + wn) * 32 + (lane & 31);
#pragma unroll
      for (int mb = 0; mb < GMOE::MB; ++mb)
#pragma unroll
        for (int i = 0; i < 16; ++i) {
          const int row = wmr + mb * 32 + (i & 3) + 8 * (i >> 2);
          const float g = acc[mb][0][i], u = acc[mb][1][i];
          *(bf16_t*)(actl + (row * ACT_LD + j) * 2) = f2bf(siluf_(g) * u);
        }
    }
    __syncthreads();
    const bf16_t* Wd = DN + (size_t)e * 1024 * 256;
#pragma unroll 1
    for (int nt = 0; nt < 4; ++nt) {
      f32x16 acc[GMOE::MB][GMOE::NB];
#pragma unroll
      for (int a = 0; a < GMOE::MB; ++a)
#pragma unroll
        for (int b = 0; b < GMOE::NB; ++b) acc[a][b] = zero16();
      moe_down_run(acc, actl, Wd + (size_t)nt * 256 * 256, smem);
      {
        const int lane = tid & 63, wid = tid >> 6, wm = wid / 4, wn = wid % 4;
        float* scr = (float*)(smem + wid * WTile<1>::BYTES);
#pragma unroll
        for (int mb = 0; mb < GMOE::MB; ++mb)
#pragma unroll
          for (int nb = 0; nb < GMOE::NB; ++nb) {
            WTile<1>::put(scr, 0, lane, acc[mb][nb]);
            const int row0 = wm * 64 + mb * 32, col0 = nt * 256 + wn * 64 + nb * 32;
            WTile<1>::rows8(scr, lane, [&](int r, int cq, const float4& a, const float4& bq) {
              const int row = row0 + r;
              if (rb * 128 + row < c) {
                const float w = rwt[row];
                const float4 a2 = make_float4(a.x * w, a.y * w, a.z * w, a.w * w), b2 = make_float4(bq.x * w, bq.y * w, bq.z * w, bq.w * w);
                *(uint4*)(ybuf + ((size_t)obase + row) * 1024 + col0 + cq) = pack8bf(a2, b2);
              } });
          }
        __syncthreads();
      }
    }
  }
}

DI void phase_combine(const Params& p, int l, bool last, char* smem, const int* cnt) {
  float* xs = (float*)(p.ws + OFF_XS);
  bf16_t* H = (bf16_t*)(p.ws + OFF_H);
  const float* mod = (const float*)(p.ws + OFF_MOD);
  const int* eidx = (const int*)(p.ws + OFF_REGION + R_EIDX);
  const int* erank = (const int*)(p.ws + OFF_REGION + R_ERANK);
  const bf16_t* ybuf = (const bf16_t*)(p.ws + OFF_REGION + R_YBUF);
  int* off = (int*)smem;
  const int tid = opaque_tid(), lane = tid & 63, wid = tid >> 6;
  const int ntok = last ? NX_ : NT_;
  __syncthreads();
  if (tid == 0) { int o = 0; for (int e = 0; e < 64; ++e) { off[e] = o; o += cnt[e]; } off[64] = o; }
  __syncthreads();
  for (int n = blockIdx.x * 8 + wid; n < ntok; n += gridDim.x * 8) {
    float acc[16];
#pragma unroll
    for (int i = 0; i < 16; ++i) acc[i] = 0.f;
    for (int k = 0; k < 9; ++k) {
      const int row = k < 8 ? off[eidx[n * 8 + k]] + erank[n * 8 + k] : off[64] + n;
      const bf16_t* y = ybuf + (size_t)row * 1024;
#pragma unroll
      for (int j = 0; j < 4; ++j) {
        const uint2 u = *(const uint2*)(y + (j * 64 + lane) * 4);
        acc[j * 4 + 0] += bf2f((bf16_t)(u.x & 0xffff)); acc[j * 4 + 1] += bf2f((bf16_t)(u.x >> 16));
        acc[j * 4 + 2] += bf2f((bf16_t)(u.y & 0xffff)); acc[j * 4 + 3] += bf2f((bf16_t)(u.y >> 16));
      }
    }
    const float* m5 = mod + ((size_t)l * 3 + tok_modrow(n)) * 6144 + 5 * 1024;
    float v[16];
#pragma unroll
    for (int j = 0; j < 4; ++j) {
      const int c = (j * 64 + lane) * 4;
      const float4 x = *(const float4*)(xs + (size_t)n * 1024 + c), g = *(const float4*)(m5 + c);
      v[j * 4 + 0] = x.x + g.x * acc[j * 4 + 0]; v[j * 4 + 1] = x.y + g.y * acc[j * 4 + 1];
      v[j * 4 + 2] = x.z + g.z * acc[j * 4 + 2]; v[j * 4 + 3] = x.w + g.w * acc[j * 4 + 3];
      if (!last) *(float4*)(xs + (size_t)n * 1024 + c) = make_float4(v[j * 4], v[j * 4 + 1], v[j * 4 + 2], v[j * 4 + 3]);
    }
    if (!last) {
      const float* m = mod + ((size_t)(l + 1) * 3 + tok_modrow(n)) * 6144;
      row_norm_mod(v, p.g_mix + (size_t)(l + 1) * 1024, m, m + 1024, H + (size_t)n * 1024, lane);
    } else {
      float ss = 0.f;
#pragma unroll
      for (int i = 0; i < 16; ++i) ss += v[i] * v[i];
      ss = wave_sum(ss);
      const float rs = 1.0f / sqrtf(ss * (1.f / 1024.f) + 1e-6f);
#pragma unroll
      for (int j = 0; j < 4; ++j) {
        const int c = (j * 64 + lane) * 4;
        const float4 g = *(const float4*)(p.g_final + c);
        *(float4*)(p.out + (size_t)n * 1024 + c) = make_float4(v[j * 4] * rs * g.x, v[j * 4 + 1] * rs * g.y, v[j * 4 + 2] * rs * g.z, v[j * 4 + 3] * rs * g.w);
      }
    }
  }
}
#define SMEM_BYTES (160 * 1024)
#ifndef MEGA
#define MEGA 0
#endif
DI int* cnt_ptr(const Params& p, int l) { return (int*)(p.ws + OFF_CNT) + 64 * l; }
DI int* ctr_ptr(const Params& p, int l) { return (int*)(p.ws + OFF_CNT) + 128 + 32 * l; }
#if !MEGA
__global__ void __launch_bounds__(NTHR) k_phaseA(Params p) { SMEM_DECL(smem, SMEM_BYTES); phaseA(p, smem); }
__global__ void __launch_bounds__(NTHR) k_norm0(Params p) { phase_norm0(p); }
__global__ void __launch_bounds__(NTHR) k_win(Params p, int l) { SMEM_DECL(smem, SMEM_BYTES); phase_win(p, l, smem); }
__global__ void __launch_bounds__(NTHR) k_p3(Params p, int l) { SMEM_DECL(smem, SMEM_BYTES); phase3(p, l, smem); }
__global__ void __launch_bounds__(NTHR) k_p3b(Params p, int l) { SMEM_DECL(smem, SMEM_BYTES); phase3b(p, l, smem); }
__global__ void __launch_bounds__(NTHR) k_p4(Params p, int l) { SMEM_DECL(smem, SMEM_BYTES); phase4(p, l, smem, ctr_ptr(p, l)); }
__global__ void __launch_bounds__(NTHR) k_p5(Params p, int l, int wc) { SMEM_DECL(smem, SMEM_BYTES); phase5(p, l, wc != 0, smem); }
__global__ void __launch_bounds__(NTHR) k_merge(Params p, int l, int wc) { SMEM_DECL(smem, SMEM_BYTES); phase_merge(p, l, wc != 0, smem); }
__global__ void __launch_bounds__(NTHR) k_wout(Params p, int l, int wc) { SMEM_DECL(smem, SMEM_BYTES); phase_wout(p, l, wc != 0, smem); }
__global__ void __launch_bounds__(NTHR) k_router(Params p, int l, int wc) { SMEM_DECL(smem, SMEM_BYTES); phase_router(p, l, wc != 0, smem, cnt_ptr(p, l)); }
__global__ void __launch_bounds__(NTHR) k_moe(Params p, int l, int wc) { SMEM_DECL(smem, SMEM_BYTES); phase_moe(p, l, wc != 0, smem, cnt_ptr(p, l)); }
__global__ void __launch_bounds__(NTHR) k_combine(Params p, int l, int last) { SMEM_DECL(smem, SMEM_BYTES); phase_combine(p, l, last != 0, smem, cnt_ptr(p, l)); }
#else
#ifndef EMU
#define XB_TMO      128
#define XB_XCNT(j)  (256  + 64 * (j))
#define XB_XSUB(j)  (1280 + 64 * (j))
#define XB_XGEN(j)  (2304 + 64 * (j))
#define XB_TOP      3328
#define XB_TOPGEN   3392
#define XCD_BAR_WORDS 3456
#define XB_SPIN_CAP (1u << 24)
#define LAS __attribute__((address_space(3)))
DI unsigned xb_ld(unsigned* p) { return __hip_atomic_load(p, __ATOMIC_RELAXED, __HIP_MEMORY_SCOPE_AGENT); }
DI unsigned xb_add(unsigned* p, unsigned v) { return __hip_atomic_fetch_add(p, v, __ATOMIC_RELAXED, __HIP_MEMORY_SCOPE_AGENT); }
DI unsigned xb_xcc_id() { return (unsigned)__builtin_amdgcn_s_getreg((3 << 11) | 20) & 0xFu; }
#define XB_SPIN(cond, bar) do { unsigned _sp = 0; while (cond) { __builtin_amdgcn_s_sleep(1); \
    if ((++_sp & 255u) == 0u) { if (xb_ld(&(bar)[XB_TMO])) break; if (_sp > XB_SPIN_CAP) { atomicAdd(&(bar)[XB_TMO], 1u); break; } } } } while (0)
struct XcdBarrier { unsigned* bar; unsigned x; volatile LAS unsigned* st; };
DI XcdBarrier xcd_barrier_post(unsigned* bar, volatile LAS unsigned* st) {
  XcdBarrier b; b.bar = bar; b.x = xb_xcc_id(); b.st = st;
  if (threadIdx.x == 0) (void)xb_add(&bar[XB_XCNT(b.x)], 1u);
  return b;
}
DI void xcd_barrier_complete(unsigned* bar, unsigned x, unsigned& nloc, unsigned& nx) {
  const unsigned G = gridDim.x * gridDim.y * gridDim.z;
  unsigned sum, cnt, mine, sp = 0u;
  for (;;) {
    sum = 0u; cnt = 0u; mine = 0u;
#pragma unroll
    for (unsigned j = 0; j < 16; ++j) { const unsigned c = xb_ld(&bar[XB_XCNT(j)]); sum += c; cnt += (c > 0u) ? 1u : 0u; mine = (j == x) ? c : mine; }
    if (sum == G) break;
    __builtin_amdgcn_s_sleep(1);
    if ((++sp & 255u) == 0u) { if (xb_ld(&bar[XB_TMO])) break; if (sp > XB_SPIN_CAP) { atomicAdd(&bar[XB_TMO], 1u); break; } }
  }
  nloc = mine > 0u ? mine : 1u; nx = cnt > 0u ? cnt : 1u;
}
DI void xcd_barrier(const XcdBarrier& b) {
  asm volatile("s_waitcnt vmcnt(0)" ::: "memory");
  __syncthreads();
  if (threadIdx.x == 0) {
    unsigned* bar = b.bar;
    __builtin_amdgcn_s_waitcnt(0);
    unsigned nloc = b.st[0], nx = b.st[1];
    if (nloc == 0u) { xcd_barrier_complete(bar, b.x, nloc, nx); b.st[0] = nloc; b.st[1] = nx; }
    const unsigned old = xb_add(&bar[XB_XSUB(b.x)], 1u);
    const unsigned gen = old / nloc;
    if (old + 1u == (gen + 1u) * nloc) {
      __builtin_amdgcn_fence(__ATOMIC_RELEASE, "agent");
      asm volatile("s_waitcnt vmcnt(0)" ::: "memory");
      const unsigned og = xb_add(&bar[XB_TOP], 1u);
      const unsigned tg = og / nx;
      if (og + 1u == (tg + 1u) * nx) xb_add(&bar[XB_TOPGEN], 1u);
      else XB_SPIN(xb_ld(&bar[XB_TOPGEN]) == tg, bar);
      __builtin_amdgcn_fence(__ATOMIC_ACQUIRE, "agent");
      xb_add(&bar[XB_XGEN(b.x)], 1u);
      asm volatile("s_waitcnt vmcnt(0)" ::: "memory");
    } else {
      XB_SPIN(xb_ld(&bar[XB_XGEN(b.x)]) == gen, bar);
      __builtin_amdgcn_fence(__ATOMIC_ACQUIRE, "agent");
      asm volatile("s_waitcnt vmcnt(0)" ::: "memory");
    }
  }
  __syncthreads();
}
#define GSYNC() { XcdBarrier xb_; xb_.bar = (unsigned*)(p.ws + OFF_BAR); xb_.x = xb_xcc_id(); xb_.st = (volatile LAS unsigned*)(smem + SMEM_BYTES - 32); xcd_barrier(xb_); }
#else
#define GSYNC() emu::grid_barrier()
#endif
#ifdef PROBE_IDX
#define TS(i) { if (blockIdx.x == 0 && threadIdx.x == 0) ts[i] = wall_clock64(); }
#else
#define TS(i)
#endif
__global__ void __launch_bounds__(NTHR) k_mega(Params p) {
  SMEM_DECL(smem, SMEM_BYTES);
  cooperative_groups::grid_group grid = cooperative_groups::this_grid();
  volatile LAS unsigned* xst = (volatile LAS unsigned*)(smem + SMEM_BYTES - 32);
  if (threadIdx.x == 0) { xst[0] = 0u; xst[1] = 0u; }
  __syncthreads();
  (void)xcd_barrier_post((unsigned*)(p.ws + OFF_BAR), xst);
#ifdef PROBE_IDX
  long long* ts = (long long*)(p.ws + OFF_CNT + 2048);
#endif
  TS(0);
  phaseA(p, smem);
  grid.sync(); TS(1);
  phase_norm0(p);
  GSYNC(); TS(2);
#pragma unroll 1
  for (int l = 0; l < 2; ++l) {
    const bool wc = l == 0;
    phase_win(p, l, smem); GSYNC(); TS(3 + l * 9);
    phase3(p, l, smem); GSYNC();
    phase3b(p, l, smem); GSYNC(); TS(4 + l * 9);
    phase4(p, l, smem, ctr_ptr(p, l)); GSYNC(); TS(5 + l * 9);
    phase5(p, l, wc, smem); GSYNC(); TS(6 + l * 9);
    phase_merge(p, l, wc, smem); GSYNC(); TS(7 + l * 9);
    phase_wout(p, l, wc, smem); GSYNC(); TS(8 + l * 9);
    phase_router(p, l, wc, smem, cnt_ptr(p, l)); GSYNC(); TS(9 + l * 9);
    phase_moe(p, l, wc, smem, cnt_ptr(p, l)); GSYNC(); TS(10 + l * 9);
    phase_combine(p, l, l == 1, smem, cnt_ptr(p, l));
#ifdef PROBE_IDX
    GSYNC(); TS(11 + l * 9);
#else
    if (l == 0) GSYNC();
#endif
  }
#ifdef PROBE_IDX
  if (blockIdx.x == 0 && threadIdx.x == 0) {
    const float us = (float)(ts[PROBE_IDX + 1] - ts[PROBE_IDX]) * 0.01f;
    p.out[0] += rintf(6.f * log2f(fmaxf(us, 1.f)));
  }
#endif
}
#endif

extern "C" void kernel_launch(void* const* d_in, const int* in_sizes, int n_in, void* d_out, int out_size, void* d_ws,
                              size_t ws_size, hipStream_t stream) {
  Params p{};
  const float** pp = (const float**)&p;
  for (int i = 0; i < 41; ++i) pp[i] = (const float*)d_in[i];
  p.out = (float*)d_out; p.ws = (char*)d_ws; p.osc = (char*)d_out;
  if (ws_size < WS_NEEDED) { fprintf(stderr, "workspace too small: %zu < %zu\n", ws_size, (size_t)WS_NEEDED); return; }
#if !MEGA
  const dim3 g(256), b(NTHR);
  hipLaunchKernelGGL(k_phaseA, g, b, 0, stream, p);
  hipLaunchKernelGGL(k_norm0, g, b, 0, stream, p);
  for (int l = 0; l < 2; ++l) {
    const int wc = l == 0;
    hipLaunchKernelGGL(k_win, g, b, 0, stream, p, l);
    hipLaunchKernelGGL(k_p3, g, b, 0, stream, p, l);
    hipLaunchKernelGGL(k_p3b, g, b, 0, stream, p, l);
    hipLaunchKernelGGL(k_p4, g, b, 0, stream, p, l);
    hipLaunchKernelGGL(k_p5, g, b, 0, stream, p, l, wc);
    hipLaunchKernelGGL(k_merge, g, b, 0, stream, p, l, wc);
    hipLaunchKernelGGL(k_wout, g, b, 0, stream, p, l, wc);
    hipLaunchKernelGGL(k_router, g, b, 0, stream, p, l, wc);
    hipLaunchKernelGGL(k_moe, g, b, 0, stream, p, l, wc);
    hipLaunchKernelGGL(k_combine, g, b, 0, stream, p, l, l == 1);
  }
#else
  static int grid_blocks = 0;
  if (!grid_blocks) {
    int dev = 0, cus = 0, per_cu = 0;
    hipGetDevice(&dev);
    hipDeviceGetAttribute(&cus, hipDeviceAttributeMultiprocessorCount, dev);
    hipOccupancyMaxActiveBlocksPerMultiprocessor(&per_cu, k_mega, NTHR, 0);
    if (per_cu > 1) per_cu = 1;
    grid_blocks = cus * per_cu;
  }
  hipMemsetAsync(p.ws + OFF_BAR, 0, 16384, stream);
  void* args[] = {&p};
  hipError_t e = hipLaunchCooperativeKernel((void*)k_mega, dim3(grid_blocks), dim3(NTHR), args, 0, stream);
  if (e != hipSuccess) fprintf(stderr, "cooperative launch failed: %s (grid %d)\n", hipGetErrorString(e), grid_blocks);
#endif
}
```

```cpp
#define MEGA 1
#include <hip/hip_runtime.h>
#include <hip/hip_cooperative_groups.h>
#include <cstdio>

#ifndef SEQ_T
#define SEQ_T 8192
#endif
#ifndef CTX_L
#define CTX_L 256
#endif

#define DI __device__ __forceinline__
typedef unsigned short bf16_t;
typedef short bf16x8 __attribute__((ext_vector_type(8)));
typedef float f32x16 __attribute__((ext_vector_type(16)));
typedef float f32x4 __attribute__((ext_vector_type(4)));
typedef unsigned u32x4 __attribute__((ext_vector_type(4)));

constexpr int NB_ = 2, T_ = SEQ_T, CL_ = CTX_L, D_ = 1024;
constexpr int NX_ = NB_ * T_, NC_ = NB_ * CL_, NT_ = NX_ + NC_, KT_ = CL_ + T_;
constexpr int GRID_W_ = 64;
constexpr int MLA_H = 8, MLA_NOPE_ = 64, MLA_ROPE_ = 32, MLA_DK = 96, MLA_DV = 64, QLORA = 384, KVLORA = 256;
constexpr int MLA_IN_ = 672, ML_IN_ = 784, RW_IN_ = 1152, GATE_IN_ = 3072, D_IN_ = 5680;
constexpr int ZMLA_W = 768;
constexpr int ZREC_W = 1936;
constexpr int WIN_N = 768 + 2048;
constexpr int ML_H = 4, ML_DK = 32, ML_DV = 64, ML_L = 64;
constexpr int RW_H = 4, RW_N_ = 64;
constexpr int NE_ = 64, TOPK_ = 8, DE_ = 256;
constexpr int NCH_ = KT_ / ML_L;
constexpr int NSEQ_ = 2 * NB_ * 4;

constexpr int ZR_MLQ = 0, ZR_MLK = 128, ZR_MLV = 256, ZR_MLO = 512, ZR_MLI = 768, ZR_MLF = 776;
constexpr int ZR_RW = 784;

constexpr size_t al256(size_t x) { return (x + 255) & ~(size_t)255; }
constexpr size_t WM_WIN = 0;
constexpr size_t WM_GATE = WM_WIN + (size_t)WIN_N * 1024 * 2;
constexpr size_t WM_UQ = WM_GATE + (size_t)3072 * 1024 * 2;
constexpr size_t WM_UKV = WM_UQ + (size_t)768 * 384 * 2;
constexpr size_t WM_BRA = WM_UKV + (size_t)1024 * 256 * 2;
constexpr size_t WM_BRM = WM_BRA + (size_t)1024 * 512 * 2;
constexpr size_t WM_BRR = WM_BRM + (size_t)1024 * 256 * 2;
constexpr size_t WM_OUT = WM_BRR + (size_t)1024 * 256 * 2;
constexpr size_t WM_RT = WM_OUT + (size_t)1024 * 1024 * 2;
constexpr size_t WM_SIZE = al256(WM_RT + (size_t)64 * 1024 * 2);
constexpr size_t WE_GU = 0;
constexpr size_t WE_DN = WE_GU + (size_t)65 * 512 * 1024 * 2;
constexpr size_t WE_SIZE = al256(WE_DN + (size_t)65 * 1024 * 256 * 2);

constexpr size_t OFF_XS = 0;
constexpr size_t OFF_MOD = OFF_XS + al256((size_t)NT_ * 1024 * 4);
constexpr size_t OFF_ROPE = OFF_MOD + al256((size_t)2 * 3 * 6144 * 4);
constexpr size_t OFF_H = OFF_ROPE + al256((size_t)T_ * 16 * 8);
constexpr size_t OFF_WMIX = OFF_H + al256((size_t)NT_ * 1024 * 2);
constexpr size_t OFF_CNT = OFF_WMIX + 2 * WM_SIZE;
constexpr size_t OFF_BAR = OFF_CNT + 32768;
constexpr size_t OFF_REGION = OFF_BAR + 16384;
constexpr size_t R_ZREC = 0;
constexpr size_t R_RB16 = R_ZREC + al256((size_t)NT_ * ZREC_W * 4);
constexpr size_t R_LW = R_RB16 + al256((size_t)7 * NT_ * 256 * 2);
constexpr size_t R_BS = R_LW + al256((size_t)2 * NT_ * 256 * 4);
constexpr size_t R_CH = R_BS + al256((size_t)2 * NT_ * 4 * 4);
constexpr size_t R_YS = R_CH + al256((size_t)NSEQ_ * NCH_ * 40960);
constexpr size_t R_MLST = R_YS + al256((size_t)2 * NT_ * 256 * 4);
constexpr size_t R_ATT = R_MLST + al256((size_t)NSEQ_ * NCH_ * 2112 * 4);
constexpr size_t R_MLO = R_ATT + al256((size_t)NT_ * 512 * 2);
constexpr size_t R_RWO = R_MLO + al256((size_t)NT_ * 256 * 2);
constexpr size_t R_VT = R_RWO + al256((size_t)NT_ * 256 * 2);
constexpr size_t R_KB = R_VT + al256((size_t)NB_ * MLA_H * 64 * KT_ * 2);
constexpr size_t R_MIX_END = R_KB + al256((size_t)NB_ * MLA_H * KT_ * 96 * 2);
constexpr int NSLOT_ = NT_ * 9;
constexpr size_t R_YBUF = 0;
constexpr size_t R_EIDX = R_YBUF + al256((size_t)NSLOT_ * 1024 * 2);
constexpr size_t R_EWT = R_EIDX + al256((size_t)NT_ * 8 * 4);
constexpr size_t R_ERANK = R_EWT + al256((size_t)NT_ * 8 * 4);
constexpr size_t R_ELIST = R_ERANK + al256((size_t)NT_ * 8 * 4);
constexpr size_t R_WMOE = R_ELIST + al256((size_t)64 * NT_ * 4);
constexpr size_t R_MOE_END = R_WMOE + WE_SIZE;
constexpr size_t R_SIZE = R_MIX_END > R_MOE_END ? R_MIX_END : R_MOE_END;
constexpr size_t WS_NEEDED = OFF_REGION + R_SIZE;
constexpr size_t O_ZMLA = 0;
constexpr size_t O_QB = O_ZMLA + al256((size_t)NT_ * ZMLA_W * 2);
constexpr size_t O_END = O_QB + al256((size_t)NT_ * 768 * 2);
constexpr size_t O_YMIX = 0;
#if SEQ_T == 8192 && CTX_L == 256
static_assert(O_END <= (size_t)NX_ * 1024 * 4, "d_out scratch overflow");
static_assert((size_t)NT_ * 1024 * 2 <= (size_t)NX_ * 1024 * 4, "ymix overflow");
static_assert(WS_NEEDED <= (size_t)597000000, "workspace too large");
#endif

struct Params {
  const float *x, *c, *ctx, *c_ctx, *w_mod, *b_mod, *g_mix, *g_ffn, *w_in, *g_cq, *w_uq, *g_ckv, *w_uk, *w_uv;
  const float *ml_b_i, *ml_b_f, *ml_g_norm, *rw_mu, *rw_w0, *rw_w2, *rw_a0, *rw_a2, *rw_g2, *rw_k_k, *rw_k_a;
  const float *rw_r_k, *rw_lnx_w, *rw_lnx_b, *w_br_mla, *w_br_ml, *w_br_rw, *w_out, *w_router, *router_bias;
  const float *w_e_gate, *w_e_up, *w_e_down, *w_s_gate, *w_s_up, *w_s_down, *g_final;
  float* out; char* ws; char* osc;
};

DI float bf2f(bf16_t s) { unsigned u = ((unsigned)s) << 16; float f; __builtin_memcpy(&f, &u, 4); return f; }
DI bf16_t f2bf(float x) { unsigned u; __builtin_memcpy(&u, &x, 4); u += 0x7fffu + ((u >> 16) & 1u); return (bf16_t)(u >> 16); }
DI unsigned pack2bf(float a, float b) {
#ifdef EMU
  return (unsigned)f2bf(a) | ((unsigned)f2bf(b) << 16);
#else
  typedef __bf16 bf2 __attribute__((ext_vector_type(2)));
  typedef float f2 __attribute__((ext_vector_type(2)));
  f2 v = {a, b}; bf2 r = __builtin_convertvector(v, bf2); return __builtin_bit_cast(unsigned, r);
#endif
}
DI f32x16 mfma32(bf16x8 a, bf16x8 b, f32x16 c) {
#ifdef EMU
  return emu_mfma_32x32x16_bf16(a, b, c);
#else
  return __builtin_amdgcn_mfma_f32_32x32x16_bf16(a, b, c, 0, 0, 0);
#endif
}
DI int rfl(int v) {
#ifdef EMU
  return v;
#else
  return __builtin_amdgcn_readfirstlane(v);
#endif
}
DI int opaque_tid() {
#ifdef EMU
  return threadIdx.x;
#else
  int t = threadIdx.x; asm volatile("" : "+v"(t)); return t;
#endif
}
DI void wave_sync() {
#ifdef EMU
  (void)__ballot(1);
#else
  asm volatile("" ::: "memory");
#endif
}
DI int vblock() {
  const int g = gridDim.x, b = blockIdx.x;
  return (g & 7) == 0 ? (b & 7) * (g >> 3) + (b >> 3) : b;
}
DI int xcc_id() {
#ifdef EMU
  return blockIdx.x & 7;
#else
  return (int)(__builtin_amdgcn_s_getreg((3 << 11) | 20) & 7u);
#endif
}
DI int ld_relaxed(int* p) {
#ifdef EMU
  return __atomic_load_n(p, __ATOMIC_SEQ_CST);
#else
  return __hip_atomic_load(p, __ATOMIC_RELAXED, __HIP_MEMORY_SCOPE_AGENT);
#endif
}
DI void sched_fence() {
#ifndef EMU
  __builtin_amdgcn_sched_barrier(0);
#endif
}
DI f32x16 zero16() { f32x16 z; for (int i = 0; i < 16; ++i) z[i] = 0.f; return z; }
DI int crow(int reg, int h) { return (reg & 3) + 8 * (reg >> 2) + 4 * h; }
#ifdef EMU
DI float fexp(float x) { return expf(x); }
#else
DI float fexp(float x) { return __expf(x); }
#endif
#ifdef EMU
DI float frcp(float x) { return 1.f / x; }
DI float frsq(float x) { return 1.f / sqrtf(x); }
#else
DI float frcp(float x) { return __builtin_amdgcn_rcpf(x); }
DI float frsq(float x) { return __builtin_amdgcn_rsqf(x); }
#endif
DI float sigmoidf_(float x) { return frcp(1.f + fexp(-x)); }
DI float siluf_(float x) { return x * sigmoidf_(x); }
#ifdef EMU
DI float wave_sum(float v) { for (int m = 32; m >= 1; m >>= 1) v += __shfl_xor(v, m); return v; }
DI float wave_max(float v) { for (int m = 32; m >= 1; m >>= 1) v = fmaxf(v, __shfl_xor(v, m)); return v; }
#else
#define DPPF(x, ctrl) __builtin_bit_cast(float, __builtin_amdgcn_mov_dpp(__builtin_bit_cast(int, (x)), (ctrl), 0xf, 0xf, true))
#define RDLF(x, l) __builtin_bit_cast(float, __builtin_amdgcn_readlane(__builtin_bit_cast(int, (x)), (l)))
DI float wave_sum(float v) {
  v += DPPF(v, 0xB1); v += DPPF(v, 0x4E); v += DPPF(v, 0x124); v += DPPF(v, 0x128);
  return (RDLF(v, 0) + RDLF(v, 16)) + (RDLF(v, 32) + RDLF(v, 48));
}
DI float wave_max(float v) {
  v = fmaxf(v, DPPF(v, 0xB1)); v = fmaxf(v, DPPF(v, 0x4E)); v = fmaxf(v, DPPF(v, 0x124)); v = fmaxf(v, DPPF(v, 0x128));
  return fmaxf(fmaxf(RDLF(v, 0), RDLF(v, 16)), fmaxf(RDLF(v, 32), RDLF(v, 48)));
}
#endif

DI int tok_b(int n) { return n < NX_ ? n / T_ : (n - NX_) / CL_; }
DI int tok_t(int n) { return n < NX_ ? n % T_ : (n - NX_) % CL_; }
DI int tok_key(int n) { return n < NX_ ? CL_ + n % T_ : (n - NX_) % CL_; }
DI int tok_modrow(int n) { return n < NX_ ? n / T_ : 2; }

#ifdef EMU
#define SMEM_DECL(name, bytes) char* name = (char*)emu::shared_alloc(bytes)
#else
#define SMEM_DECL(name, bytes) __shared__ __attribute__((aligned(16))) char name[bytes]
#endif
#define NTHR 512
#if defined(PROBE_IDX) && !defined(EMU)
#define TSB(pp, i) { if (blockIdx.x == 0 && threadIdx.x == 0) ((long long*)((pp).ws + OFF_CNT + 2048))[i] = wall_clock64(); }
#else
#define TSB(pp, i)
#endif
struct CvtJob { const float* src; int lds; int K; bf16_t* dst; int ntn; int ntk; int maptype; const float* gain; };
DI int cvt_map(int maptype, int coff, int np) {
  if (maptype == 0) return coff + np;
  if (maptype == 1) { if (np < 672) return np; if (np < 768) return -1; if (np < 768 + 1936) return np - 96; return -1; }
  return np;
}
DI void cvt_tile(const CvtJob& j, int coff, int tk, int tn, char* smem) {
  float* tile = (float*)smem;
  const int tid = opaque_tid();
  __syncthreads();
  {
    const int kk = tid >> 3, nc = (tid & 7) * 8, k = tk * 64 + kk;
    const float g = j.gain ? j.gain[k] : 1.f;
#pragma unroll
    for (int i = 0; i < 8; ++i) {
      const int np = tn * 64 + nc + i;
      const int sc = cvt_map(j.maptype, coff, np);
      tile[kk * 65 + nc + i] = sc >= 0 ? j.src[(size_t)k * j.lds + sc] * g : 0.f;
    }
  }
  __syncthreads();
  {
    const int n = tid >> 3, kc = (tid & 7) * 8;
    int np = tn * 64 + n;
    if (j.maptype == 2) np = (np >> 5) * 64 + coff * 32 + (np & 31);
    uint4 v;
    v.x = pack2bf(tile[(kc + 0) * 65 + n], tile[(kc + 1) * 65 + n]);
    v.y = pack2bf(tile[(kc + 2) * 65 + n], tile[(kc + 3) * 65 + n]);
    v.z = pack2bf(tile[(kc + 4) * 65 + n], tile[(kc + 5) * 65 + n]);
    v.w = pack2bf(tile[(kc + 6) * 65 + n], tile[(kc + 7) * 65 + n]);
    *(uint4*)(j.dst + (size_t)np * j.K + tk * 64 + kc) = v;
  }
}

constexpr int CVT_MIX_TILES = 704 + 768 + 72 + 32 + 32 + 128 + 64 + 64 + 256 + 16;
DI void cvt_mix_item(const Params& p, int l, int it, char* smem) {
  bf16_t* W = (bf16_t*)(p.ws + OFF_WMIX + (size_t)l * WM_SIZE);
  CvtJob j; int coff = 0;
  if (it < 704) { j = {p.w_in + (size_t)l * 1024 * D_IN_, D_IN_, 1024, (bf16_t*)((char*)W + WM_WIN), 44, 16, 1, nullptr}; }
  else if ((it -= 704) < 768) { j = {p.w_in + (size_t)l * 1024 * D_IN_, D_IN_, 1024, (bf16_t*)((char*)W + WM_GATE), 48, 16, 0, nullptr}; coff = 2608; }
  else if ((it -= 768) < 72) { j = {p.w_uq + (size_t)l * 384 * 768, 768, 384, (bf16_t*)((char*)W + WM_UQ), 12, 6, 0, p.g_cq + l * 384}; }
  else if ((it -= 72) < 32) { j = {p.w_uk + (size_t)l * 256 * 512, 512, 256, (bf16_t*)((char*)W + WM_UKV), 8, 4, 0, p.g_ckv + l * 256}; }
  else if ((it -= 32) < 32) { j = {p.w_uv + (size_t)l * 256 * 512, 512, 256, (bf16_t*)((char*)W + WM_UKV) + 512 * 256, 8, 4, 0, p.g_ckv + l * 256}; }
  else if ((it -= 32) < 128) { j = {p.w_br_mla + (size_t)l * 512 * 1024, 1024, 512, (bf16_t*)((char*)W + WM_BRA), 16, 8, 0, nullptr}; }
  else if ((it -= 128) < 64) { j = {p.w_br_ml + (size_t)l * 256 * 1024, 1024, 256, (bf16_t*)((char*)W + WM_BRM), 16, 4, 0, nullptr}; }
  else if ((it -= 64) < 64) { j = {p.w_br_rw + (size_t)l * 256 * 1024, 1024, 256, (bf16_t*)((char*)W + WM_BRR), 16, 4, 0, nullptr}; }
  else if ((it -= 64) < 256) { j = {p.w_out + (size_t)l * 1024 * 1024, 1024, 1024, (bf16_t*)((char*)W + WM_OUT), 16, 16, 0, nullptr}; }
  else { it -= 256; j = {p.w_router + (size_t)l * 1024 * 64, 64, 1024, (bf16_t*)((char*)W + WM_RT), 1, 16, 0, nullptr}; }
  cvt_tile(j, coff, it / j.ntn, it % j.ntn, smem);
}
constexpr int CVT_MOE_TILES = 65 * 192;
DI void cvt_moe_item(const Params& p, int l, int it, char* smem) {
  const int e = it / 192; int r = it % 192;
  bf16_t* GU = (bf16_t*)(p.ws + OFF_REGION + R_WMOE + WE_GU) + (size_t)e * 512 * 1024;
  bf16_t* DN = (bf16_t*)(p.ws + OFF_REGION + R_WMOE + WE_DN) + (size_t)e * 1024 * 256;
  const float* sg = e < 64 ? p.w_e_gate + ((size_t)l * 64 + e) * 1024 * 256 : p.w_s_gate + (size_t)l * 1024 * 256;
  const float* su = e < 64 ? p.w_e_up + ((size_t)l * 64 + e) * 1024 * 256 : p.w_s_up + (size_t)l * 1024 * 256;
  const float* sd = e < 64 ? p.w_e_down + ((size_t)l * 64 + e) * 256 * 1024 : p.w_s_down + (size_t)l * 256 * 1024;
  CvtJob j; int coff = 0;
  if (r < 64) { j = {sg, 256, 1024, GU, 4, 16, 2, nullptr}; coff = 0; }
  else if ((r -= 64) < 64) { j = {su, 256, 1024, GU, 4, 16, 2, nullptr}; coff = 1; }
  else { r -= 64; j = {sd, 1024, 256, DN, 16, 4, 0, nullptr}; }
  cvt_tile(j, coff, r / j.ntn, r % j.ntn, smem);
}

DI void mod_item(const Params& p, int it, char* smem) {
  float* cond = (float*)smem;
  float* red = cond + 3 * 1024;
  const int tid = opaque_tid(), l = it / 96, j0 = (it % 96) * 64;
  __syncthreads();
  for (int i = tid; i < 3 * 1024; i += NTHR) {
    const int r = i >> 10, k = i & 1023;
    const float v = r < 2 ? p.c[r * 1024 + k] : p.c_ctx[k];
    cond[i] = siluf_(v);
  }
  __syncthreads();
  const int jj = tid & 63, kg = tid >> 6;
  float a0 = 0.f, a1 = 0.f, a2 = 0.f;
  const float* w = p.w_mod + (size_t)l * 1024 * 6144 + j0 + jj;
  for (int k = kg; k < 1024; k += 8) {
    const float wv = w[(size_t)k * 6144];
    a0 += cond[k] * wv; a1 += cond[1024 + k] * wv; a2 += cond[2048 + k] * wv;
  }
  red[(kg * 3 + 0) * 64 + jj] = a0; red[(kg * 3 + 1) * 64 + jj] = a1; red[(kg * 3 + 2) * 64 + jj] = a2;
  __syncthreads();
  if (tid < 192) {
    const int r = tid >> 6; float s = 0.f;
    for (int g = 0; g < 8; ++g) s += red[(g * 3 + r) * 64 + jj];
    float* mod = (float*)(p.ws + OFF_MOD);
    mod[((size_t)l * 3 + r) * 6144 + j0 + jj] = s + p.b_mod[(size_t)l * 6144 + j0 + jj];
  }
}
DI void rope_item(const Params& p, int it) {
  const int idx = it * NTHR + threadIdx.x;
  if (idx >= T_ * 16) return;
  const int t = idx >> 4, i = idx & 15, f = i & 7;
  const float pos = (float)(i < 8 ? t / GRID_W_ : t % GRID_W_);
  const float inv = powf(10000.f, -(float)(2 * f) / 16.f);
  const float ang = pos * inv;
  float2* rt = (float2*)(p.ws + OFF_ROPE);
  rt[idx] = make_float2(cosf(ang), sinf(ang));
}
constexpr int PA_ITEMS = 192 + (T_ * 16 + NTHR - 1) / NTHR + 2 * CVT_MIX_TILES;
DI void phaseA(const Params& p, char* smem) {
  if (blockIdx.x == 0) for (int i = threadIdx.x; i < 8192; i += NTHR) ((int*)(p.ws + OFF_CNT))[i] = 0;
  for (int it = blockIdx.x; it < PA_ITEMS; it += gridDim.x) {
    int i = it;
    if (i < 192) { mod_item(p, i, smem); continue; }
    i -= 192;
    constexpr int NR = (T_ * 16 + NTHR - 1) / NTHR;
    if (i < NR) { rope_item(p, i); continue; }
    i -= NR;
    cvt_mix_item(p, i / CVT_MIX_TILES, i % CVT_MIX_TILES, smem);
  }
}

DI void row_norm_mod(const float (&v)[16], const float* g, const float* shift, const float* scale, bf16_t* hrow, int lane) {
  float ss = 0.f;
#pragma unroll
  for (int i = 0; i < 16; ++i) ss += v[i] * v[i];
  ss = wave_sum(ss);
  const float rs = frsq(ss * (1.f / 1024.f) + 1e-6f);
#pragma unroll
  for (int j = 0; j < 4; ++j) {
    const int c = (j * 64 + lane) * 4;
    const float4 gg = *(const float4*)(g + c), sh = *(const float4*)(shift + c), sc = *(const float4*)(scale + c);
    const float h0 = v[j * 4 + 0] * rs * gg.x * (1.f + sc.x) + sh.x;
    const float h1 = v[j * 4 + 1] * rs * gg.y * (1.f + sc.y) + sh.y;
    const float h2 = v[j * 4 + 2] * rs * gg.z * (1.f + sc.z) + sh.z;
    const float h3 = v[j * 4 + 3] * rs * gg.w * (1.f + sc.w) + sh.w;
    uint2 o; o.x = pack2bf(h0, h1); o.y = pack2bf(h2, h3);
    *(uint2*)(hrow + c) = o;
  }
}
DI void phase_norm0(const Params& p) {
  const int lane = threadIdx.x & 63, wid = threadIdx.x >> 6;
  float* xs = (float*)(p.ws + OFF_XS);
  bf16_t* H = (bf16_t*)(p.ws + OFF_H);
  const float* mod = (const float*)(p.ws + OFF_MOD);
  for (int n = blockIdx.x * 8 + wid; n < NT_; n += gridDim.x * 8) {
    const float* src = n < NX_ ? p.x + (size_t)n * 1024 : p.ctx + (size_t)(n - NX_) * 1024;
    float v[16];
#pragma unroll
    for (int j = 0; j < 4; ++j) {
      const float4 t = *(const float4*)(src + (j * 64 + lane) * 4);
      v[j * 4] = t.x; v[j * 4 + 1] = t.y; v[j * 4 + 2] = t.z; v[j * 4 + 3] = t.w;
      *(float4*)(xs + (size_t)n * 1024 + (j * 64 + lane) * 4) = t;
    }
    const float* m = mod + (size_t)(0 * 3 + tok_modrow(n)) * 6144;
    row_norm_mod(v, p.g_mix, m, m + 1024, H + (size_t)n * 1024, lane);
  }
}

template <int BM, int BN, int BK, int WM_, int WN_>
struct Gemm {
  static constexpr int WTM = BM / WM_, WTN = BN / WN_, MB = WTM / 32, NB = WTN / 32;
  static constexpr int LDA = BK + 8;
  static constexpr int A_BYTES = BM * LDA * 2, B_BYTES = BN * LDA * 2, STAGE = A_BYTES + B_BYTES;
  static constexpr int SMEM = 2 * STAGE;
  static constexpr int CPR = BK / 8;
  static constexpr int ACH = BM * CPR / NTHR, BCH = BN * CPR / NTHR;
  static_assert(WM_ * WN_ == 8, "8 waves");
  static_assert(BM * CPR % NTHR == 0 && BN * CPR % NTHR == 0, "chunking");
  static_assert(NTHR % CPR == 0, "rows fixed per thread");

  template <class ARow>
  static DI void run(f32x16 (&acc)[MB][NB], ARow arow, const bf16_t* Bt, int ldb, int Klen, char* smem) {
    const int tid = opaque_tid(), lane = tid & 63, wid = tid >> 6, wm = wid / WN_, wn = wid % WN_;
    const int kc = (tid % CPR) * 8, r0 = tid / CPR;
    const bf16_t* ap[ACH]; const bf16_t* bp[BCH];
#pragma unroll
    for (int i = 0; i < ACH; ++i) ap[i] = arow(r0 + i * (NTHR / CPR)) + kc;
#pragma unroll
    for (int i = 0; i < BCH; ++i) bp[i] = Bt + (size_t)(r0 + i * (NTHR / CPR)) * ldb + kc;
    u32x4 ra[ACH], rb[BCH];
    const int nk = Klen / BK;
#pragma unroll
    for (int i = 0; i < ACH; ++i) ra[i] = *(const u32x4*)(ap[i]);
#pragma unroll
    for (int i = 0; i < BCH; ++i) rb[i] = *(const u32x4*)(bp[i]);
#pragma unroll
    for (int i = 0; i < ACH; ++i) *(u32x4*)(smem + ((r0 + i * (NTHR / CPR)) * LDA + kc) * 2) = ra[i];
#pragma unroll
    for (int i = 0; i < BCH; ++i) *(u32x4*)(smem + A_BYTES + ((r0 + i * (NTHR / CPR)) * LDA + kc) * 2) = rb[i];
    __syncthreads();
    for (int kt = 0; kt < nk; ++kt) {
      const int kn = (kt + 1 < nk ? kt + 1 : kt) * BK;
#pragma unroll
      for (int i = 0; i < ACH; ++i) ra[i] = *(const u32x4*)(ap[i] + kn);
#pragma unroll
      for (int i = 0; i < BCH; ++i) rb[i] = *(const u32x4*)(bp[i] + kn);
      sched_fence();
      const char* As = smem + (kt & 1) * STAGE;
      const char* Bs = As + A_BYTES;
#pragma unroll
      for (int ks = 0; ks < BK / 16; ++ks) {
        bf16x8 af[MB], bfr[NB];
#pragma unroll
        for (int mb = 0; mb < MB; ++mb)
          af[mb] = *(const bf16x8*)(As + ((wm * WTM + mb * 32 + (lane & 31)) * LDA + ks * 16 + (lane >> 5) * 8) * 2);
#pragma unroll
        for (int nb = 0; nb < NB; ++nb)
          bfr[nb] = *(const bf16x8*)(Bs + ((wn * WTN + nb * 32 + (lane & 31)) * LDA + ks * 16 + (lane >> 5) * 8) * 2);
#pragma unroll
        for (int mb = 0; mb < MB; ++mb)
#pragma unroll
          for (int nb = 0; nb < NB; ++nb) acc[mb][nb] = mfma32(af[mb], bfr[nb], acc[mb][nb]);
      }
      sched_fence();
      {
        char* Ad = smem + ((kt + 1) & 1) * STAGE;
#pragma unroll
        for (int i = 0; i < ACH; ++i) *(u32x4*)(Ad + ((r0 + i * (NTHR / CPR)) * LDA + kc) * 2) = ra[i];
#pragma unroll
        for (int i = 0; i < BCH; ++i) *(u32x4*)(Ad + A_BYTES + ((r0 + i * (NTHR / CPR)) * LDA + kc) * 2) = rb[i];
      }
      __syncthreads();
    }
  }
  static DI int row_of(int t, int mb, int reg) { const int lane = t & 63, wm = (t >> 6) / WN_; return wm * WTM + mb * 32 + crow(reg, lane >> 5); }
  static DI int col_of(int t, int nb) { const int lane = t & 63, wn = (t >> 6) % WN_; return wn * WTN + nb * 32 + (lane & 31); }
};


template <int NBW> struct WTile {
  static constexpr int LD = NBW * 32 + 4;
  static constexpr int BYTES = 32 * LD * 4;
  static DI void put(float* scr, int nb, int lane, const f32x16& v) {
    const int c = nb * 32 + (lane & 31), h = lane >> 5;
#pragma unroll
    for (int i = 0; i < 16; ++i) scr[crow(i, h) * LD + c] = v[i];
  }
  template <class F> static DI void rows4(const float* scr, int lane, F f) {
    wave_sync();
#pragma unroll
    for (int it = 0; it < NBW * 4; ++it) {
      const int id = it * 64 + lane, row = id / (NBW * 8), q = id % (NBW * 8);
      f(row, q * 4, *(const float4*)(scr + row * LD + q * 4));
    }
    wave_sync();
  }
  template <class F> static DI void rows8(const float* scr, int lane, F f) {
    wave_sync();
#pragma unroll
    for (int it = 0; it < NBW * 2; ++it) {
      const int id = it * 64 + lane, row = id / (NBW * 4), q = id % (NBW * 4);
      f(row, q * 8, *(const float4*)(scr + row * LD + q * 8), *(const float4*)(scr + row * LD + q * 8 + 4));
    }
    wave_sync();
  }
};
DI uint4 pack8bf(const float4& a, const float4& b) { return make_uint4(pack2bf(a.x, a.y), pack2bf(a.z, a.w), pack2bf(b.x, b.y), pack2bf(b.z, b.w)); }

typedef Gemm<256, 256, 64, 2, 4> G256;
DI void phase_win(const Params& p, int l, char* smem) {
  const bf16_t* H = (const bf16_t*)(p.ws + OFF_H);
  const bf16_t* W = (const bf16_t*)(p.ws + OFF_WMIX + (size_t)l * WM_SIZE + WM_WIN);
  bf16_t* zmla = (bf16_t*)(p.osc + O_ZMLA);
  float* zrec = (float*)(p.ws + OFF_REGION + R_ZREC);
  constexpr int TM = NT_ / 256, TN = WIN_N / 256;
  for (int it = vblock(); it < TM * TN; it += gridDim.x) {
    const int tid = opaque_tid();
    const int tm = it / TN, tn = it % TN;
    __syncthreads();
    f32x16 acc[G256::MB][G256::NB];
#pragma unroll
    for (int a = 0; a < G256::MB; ++a)
#pragma unroll
      for (int b = 0; b < G256::NB; ++b) acc[a][b] = zero16();
    const bf16_t* A0 = H + (size_t)tm * 256 * 1024;
    G256::run(acc, [&](int r) { return A0 + (size_t)r * 1024; }, W + (size_t)tn * 256 * 1024, 1024, 1024, smem);
    {
      const int lane = tid & 63, wid = tid >> 6, wm = wid / 4, wn = wid % 4;
      float* scr = (float*)(smem + wid * WTile<2>::BYTES);
      const int col0 = tn * 256 + wn * 64;
#pragma unroll
      for (int mb = 0; mb < G256::MB; ++mb) {
        WTile<2>::put(scr, 0, lane, acc[mb][0]); WTile<2>::put(scr, 1, lane, acc[mb][1]);
        const int row0 = tm * 256 + wm * 128 + mb * 32;
#ifdef ABL_NOSTORE
        if (tn > 1000) {
#else
        if (tn < 3) {
#endif
          WTile<2>::rows8(scr, lane, [&](int r, int c, const float4& a, const float4& bq) {
            *(uint4*)(zmla + (size_t)(row0 + r) * ZMLA_W + col0 + c) = pack8bf(a, bq); });
        } else {
          WTile<2>::rows4(scr, lane, [&](int r, int c, const float4& a) {
            const int cc = col0 - 768 + c;
#ifdef ABL_NOSTORE
            if (cc < -5) *(float4*)(zrec + (size_t)(row0 + r) * ZREC_W + cc) = a; });
#else
            if (cc < ZREC_W) *(float4*)(zrec + (size_t)(row0 + r) * ZREC_W + cc) = a; });
#endif
        }
      }
    }
  }
}
typedef Gemm<128, 128, 64, 2, 4> G128;
DI void mla_row_rs(const bf16_t* zmla_rows, int c0, int len, float* rs) {
  const int tid = opaque_tid(), row = tid >> 2, half = tid & 3;
  const bf16_t* src = zmla_rows + (size_t)row * ZMLA_W + c0 + half * (len / 4);
  float ss = 0.f;
  for (int i = 0; i < len / 4; i += 8) {
    const uint4 v = *(const uint4*)(src + i);
    const unsigned w[4] = {v.x, v.y, v.z, v.w};
#pragma unroll
    for (int j = 0; j < 4; ++j) { const float a = bf2f((bf16_t)(w[j] & 0xffff)), b = bf2f((bf16_t)(w[j] >> 16)); ss += a * a + b * b; }
  }
  ss += __shfl_xor(ss, 1); ss += __shfl_xor(ss, 2);
  if (half == 0) rs[row] = frsq(ss / (float)len + 1e-6f);
}

constexpr int MLA_Q_TILES = (NT_ / 128) * 6, MLA_KV_TILES = (NT_ / 128) * 8;
DI void mla_q_item(const Params& p, int l, int it, char* smem) {
  const int tid = opaque_tid();
  const int tm = it / 6, tn = it % 6;
  const bf16_t* zmla = (const bf16_t*)(p.osc + O_ZMLA) + (size_t)tm * 128 * ZMLA_W;
  const bf16_t* W = (const bf16_t*)(p.ws + OFF_WMIX + (size_t)l * WM_SIZE + WM_UQ) + (size_t)tn * 128 * 384;
  bf16_t* qb = (bf16_t*)(p.osc + O_QB);
  const float2* rt = (const float2*)(p.ws + OFF_ROPE);
  float* rs = (float*)(smem + G128::SMEM);
  __syncthreads();
  mla_row_rs(zmla, 0, 384, rs);
  f32x16 acc[G128::MB][G128::NB];
#pragma unroll
  for (int a = 0; a < G128::MB; ++a)
#pragma unroll
    for (int b = 0; b < G128::NB; ++b) acc[a][b] = zero16();
  G128::run(acc, [&](int r) { return zmla + (size_t)r * ZMLA_W; }, W, 384, 384, smem);
  const int lane = tid & 63;
  const bool isx = tm * 128 < NX_;
#pragma unroll
  for (int mb = 0; mb < G128::MB; ++mb)
#pragma unroll
    for (int nb = 0; nb < G128::NB; ++nb) {
      const int col = tn * 128 + G128::col_of(tid, nb);
      const bool ropeblk = ((col >> 5) % 3) == 2;
      const int e = lane & 31;
#pragma unroll
      for (int i = 0; i < 16; ++i) {
        const int lr = G128::row_of(tid, mb, i);
        const int n = tm * 128 + lr;
        float v = acc[mb][nb][i] * rs[lr];
        if (ropeblk && isx) {
          const float pv = __shfl_xor(v, 8);
          const float2 cs = rt[(size_t)(n % T_) * 16 + (e >> 4) * 8 + (e & 7)];
          v = (e & 8) ? (pv * cs.y + v * cs.x) : (v * cs.x - pv * cs.y);
        }
        qb[(size_t)n * 768 + col] = f2bf(v);
      }
    }
}
DI void mla_kv_item(const Params& p, int l, int it, char* smem) {
  const int tid = opaque_tid();
  const int tm = it / 8, tn = it % 8;
  const bf16_t* zmla = (const bf16_t*)(p.osc + O_ZMLA) + (size_t)tm * 128 * ZMLA_W;
  const bf16_t* W = (const bf16_t*)(p.ws + OFF_WMIX + (size_t)l * WM_SIZE + WM_UKV) + (size_t)tn * 128 * 256;
  bf16_t* kb = (bf16_t*)(p.ws + OFF_REGION + R_KB);
  bf16_t* vt = (bf16_t*)(p.ws + OFF_REGION + R_VT);
  const float2* rt = (const float2*)(p.ws + OFF_ROPE);
  float* rs = (float*)(smem + G128::SMEM);
  __syncthreads();
  mla_row_rs(zmla, 384, 256, rs);
  const int n0 = tm * 128;
  const int b = tok_b(n0), key0 = tok_key(n0);
  const bool isx = n0 < NX_;
  if (tn == 0) {
    for (int idx = tid; idx < 128 * 16; idx += NTHR) {
      const int lr = idx >> 4, pi = idx & 15, a = pi >> 3, i = pi & 7;
      const bf16_t* z = zmla + (size_t)lr * ZMLA_W + 640 + a * 16 + i;
      float x1 = bf2f(z[0]), x2 = bf2f(z[8]);
      if (isx) {
        const float2 cs = rt[(size_t)((n0 + lr) % T_) * 16 + a * 8 + i];
        const float y1 = x1 * cs.x - x2 * cs.y, y2 = x1 * cs.y + x2 * cs.x; x1 = y1; x2 = y2;
      }
      const bf16_t o1 = f2bf(x1), o2 = f2bf(x2);
      for (int h = 0; h < 8; ++h) {
        bf16_t* dst = kb + ((size_t)(b * 8 + h) * KT_ + key0 + lr) * 96 + 64 + a * 16 + i;
        dst[0] = o1; dst[8] = o2;
      }
    }
  }
  f32x16 acc[G128::MB][G128::NB];
#pragma unroll
  for (int a = 0; a < G128::MB; ++a)
#pragma unroll
    for (int c = 0; c < G128::NB; ++c) acc[a][c] = zero16();
  G128::run(acc, [&](int r) { return zmla + (size_t)r * ZMLA_W + 384; }, W, 256, 256, smem);
  const int lane = tid & 63;
#pragma unroll
  for (int mb = 0; mb < G128::MB; ++mb)
#pragma unroll
    for (int nb = 0; nb < G128::NB; ++nb) {
      const int col = tn * 128 + G128::col_of(tid, nb);
      if (col < 512) {
        const int h = col >> 6, d = col & 63;
#pragma unroll
        for (int i = 0; i < 16; ++i) {
          const int lr = G128::row_of(tid, mb, i);
          kb[((size_t)(b * 8 + h) * KT_ + key0 + lr) * 96 + d] = f2bf(acc[mb][nb][i] * rs[lr]);
        }
      } else {
        const int h = (col - 512) >> 6, d = col & 63;
#pragma unroll
        for (int g = 0; g < 4; ++g) {
          const int lr = G128::row_of(tid, mb, g * 4);
          uint2 o;
          o.x = pack2bf(acc[mb][nb][g * 4 + 0] * rs[lr], acc[mb][nb][g * 4 + 1] * rs[lr + 1]);
          o.y = pack2bf(acc[mb][nb][g * 4 + 2] * rs[lr + 2], acc[mb][nb][g * 4 + 3] * rs[lr + 3]);
          *(uint2*)(vt + ((size_t)(b * 8 + h) * 64 + d) * KT_ + key0 + lr) = o;
        }
      }
    }
  (void)lane;
}

DI float softplusf_(float x) { return x > 20.f ? x : log1pf(fexp(x)); }
constexpr int RWP_TT = 16;
constexpr int RWP_ITEMS = NT_ / RWP_TT;
DI void rwkv_prep_item(const Params& p, int l, int it, char* smem) {
  float* zs = (float*)smem;
  float* tw = zs + RWP_TT * 1024;
  float* ta = tw + 2 * 64 * RWP_TT;
  const float* zrec = (const float*)(p.ws + OFF_REGION + R_ZREC);
  bf16_t* rb = (bf16_t*)(p.ws + OFF_REGION + R_RB16);
  float* lwo = (float*)(p.ws + OFF_REGION + R_LW);
  float* bso = (float*)(p.ws + OFF_REGION + R_BS);
  const float rkw = p.rw_r_k[(size_t)l * 256 + (opaque_tid() & 255)];
  const float* mu = p.rw_mu + (size_t)l * 1152;
  const int tid = opaque_tid(), n0 = it * RWP_TT;
  __syncthreads();
  TSB(p, 44);
  for (int idx = tid; idx < RWP_TT * 1024; idx += NTHR) {
    const int tt = idx >> 10, c = idx & 1023, n = n0 + tt, t = tok_t(n);
    const int len = n < NX_ ? T_ : CL_;
    const float* zr = zrec + (size_t)n * ZREC_W + ZR_RW + c;
    const float z = zr[0];
    const float zp = t > 0 ? zr[-ZREC_W] : 0.f, zn = t < len - 1 ? zr[ZREC_W] : 0.f;
    const float s = z + (0.5f * (zp + zn) - z) * mu[c];
    zs[idx] = s;
    if (c >= 768 && c < 896) { const int d = (c - 768) >> 6, k = (c - 768) & 63; tw[(d * 64 + k) * RWP_TT + tt] = tanhf(s); }
    if (c >= 896) { const int d = (c - 896) >> 6, k = (c - 896) & 63; ta[(d * 64 + k) * RWP_TT + tt] = s; }
  }
  __syncthreads();
  TSB(p, 45);
  const int col = tid & 255, d = tid >> 8;
  float aw[RWP_TT], aa[RWP_TT];
#pragma unroll
  for (int i = 0; i < RWP_TT; ++i) { aw[i] = 0.f; aa[i] = 0.f; }
  const float* w2 = p.rw_w2 + ((size_t)l * 2 + d) * 64 * 256 + col;
  const float* a2 = p.rw_a2 + ((size_t)l * 2 + d) * 64 * 256 + col;
  for (int k = 0; k < 64; ++k) {
    const float wv = w2[k * 256], av = a2[k * 256];
    const float* twk = tw + (d * 64 + k) * RWP_TT;
    const float* tak = ta + (d * 64 + k) * RWP_TT;
#pragma unroll
    for (int i = 0; i < RWP_TT; ++i) { aw[i] += twk[i] * wv; aa[i] += tak[i] * av; }
  }
  TSB(p, 46);
  const float w0 = p.rw_w0[((size_t)l * 2 + d) * 256 + col], a0 = p.rw_a0[((size_t)l * 2 + d) * 256 + col];
  const float kkw = p.rw_k_k[(size_t)l * 256 + col], kaw = p.rw_k_a[(size_t)l * 256 + col];
  const size_t AS = (size_t)NT_ * 256;
#pragma unroll
  for (int i = 0; i < RWP_TT; ++i) {
    const int n = n0 + i;
    const float r = zs[i * 1024 + col], k = zs[i * 1024 + 256 + col], v = zs[i * 1024 + 512 + col];
    const float kr = k * kkw;
    const float ss = wave_sum(kr * kr);
    const float kk = kr / fmaxf(sqrtf(ss), 1e-12f);
    const float w = -softplusf_(-(w0 + aw[i])) - 0.5f;
    const float logdecay = -fexp(w);
    const float a = sigmoidf_(a0 + aa[i]);
    const float kd = k * (1.f + (a - 1.f) * kaw);
    const float bsum = wave_sum(r * rkw * kd);
    const size_t o = (size_t)n * 256 + col;
    if (d == 0) { rb[0 * AS + o] = f2bf(r); rb[1 * AS + o] = f2bf(v); rb[2 * AS + o] = f2bf(kk); }
    lwo[d * AS + o] = logdecay;
    rb[(3 + 2 * d) * AS + o] = f2bf(kd);
    rb[(4 + 2 * d) * AS + o] = f2bf(kk * a);
    if ((tid & 63) == 0) bso[((size_t)d * NT_ + n) * 4 + (col >> 6)] = bsum;
  }
  TSB(p, 47);
}

DI int seq_tok(int dir, int b, int pos) {
  if (pos < CL_) return NX_ + b * CL_ + (dir ? CL_ - 1 - pos : pos);
  const int t = pos - CL_;
  return b * T_ + (dir ? T_ - 1 - t : t);
}
DI float logsigmoidf_(float x) { return -softplusf_(-x); }
DI float wave_incl_scan(float v, int lane) {
  for (int d = 1; d < 64; d <<= 1) { const float o = __shfl_up(v, d); if (lane >= d) v += o; }
  return v;
}
constexpr int ML_ST = 2112;
constexpr int ML1_ITEMS = NSEQ_ * NCH_;
DI void mlstm_local_item(const Params& p, int l, int it, char* smem) {
  const int s = it / NCH_, c = it % NCH_, dir = s >> 3, b = (s >> 2) & 1, hd = s & 3;
  float* vv = (float*)smem;
  float* kw = vv + 64 * 64;
  float* wej = kw + 64 * 32;
  const float* zrec = (const float*)(p.ws + OFF_REGION + R_ZREC);
  float* st = (float*)(p.ws + OFF_REGION + R_MLST) + ((size_t)s * NCH_ + c) * ML_ST;
  const int tid = opaque_tid(), lane = tid & 63, wid = tid >> 6;
  __syncthreads();
  if (wid == 0) {
    const int n = seq_tok(dir, b, c * 64 + lane);
    const float fp = zrec[(size_t)n * ZREC_W + ZR_MLF + dir * 4 + hd] + p.ml_b_f[(l * 2 + dir) * 4 + hd];
    const float ip = zrec[(size_t)n * ZREC_W + ZR_MLI + dir * 4 + hd] + p.ml_b_i[(l * 2 + dir) * 4 + hd];
    const float bj = wave_incl_scan(logsigmoidf_(fp), lane);
    const float bl = __shfl(bj, 63);
    const float lw = bl - bj + ip;
    const float ml = wave_max(lw);
    wej[lane] = fexp(lw - ml);
    if (lane == 0) { st[2080] = bl; st[2081] = ml; }
  }
  for (int idx = tid; idx < 64 * 64; idx += NTHR) {
    const int j = idx >> 6, e = idx & 63;
    const int n = seq_tok(dir, b, c * 64 + j);
    vv[idx] = zrec[(size_t)n * ZREC_W + ZR_MLV + hd * 64 + e];
  }
  __syncthreads();
  for (int idx = tid; idx < 64 * 32; idx += NTHR) {
    const int j = idx >> 5, e = idx & 31;
    const int n = seq_tok(dir, b, c * 64 + j);
    kw[idx] = zrec[(size_t)n * ZREC_W + ZR_MLK + hd * 32 + e] * wej[j];
  }
  __syncthreads();
  const int v = tid & 63, d0 = (tid >> 6) * 4;
  float a0 = 0.f, a1 = 0.f, a2 = 0.f, a3 = 0.f;
  for (int j = 0; j < 64; ++j) {
    const float x = vv[j * 64 + v];
    const float4 kk = *(const float4*)(kw + j * 32 + d0);
    a0 += x * kk.x; a1 += x * kk.y; a2 += x * kk.z; a3 += x * kk.w;
  }
  *(float4*)(st + v * 32 + d0) = make_float4(a0, a1, a2, a3);
  if (tid < 32) { float sn = 0.f; for (int j = 0; j < 64; ++j) sn += kw[j * 32 + tid]; st[2048 + tid] = sn; }
}
constexpr int ML2_ITEMS = (NSEQ_ * 2080 + NTHR - 1) / NTHR;
DI void mlstm_scan_item(const Params& p, int it) {
  const int g = it * NTHR + opaque_tid();
  if (g >= NSEQ_ * 2080) return;
  const int s = g / 2080, e = g % 2080;
  float* st = (float*)(p.ws + OFF_REGION + R_MLST) + (size_t)s * NCH_ * ML_ST;
  float state = 0.f, m = 0.f;
  static_assert(NCH_ % 4 == 0, "chunk count");
  for (int c0 = 0; c0 < NCH_; c0 += 4) {
    float d[4], bl[4], ml[4];
#pragma unroll
    for (int u = 0; u < 4; ++u) { const float* r = st + (size_t)(c0 + u) * ML_ST; d[u] = r[e]; bl[u] = r[2080]; ml[u] = r[2081]; }
#pragma unroll
    for (int u = 0; u < 4; ++u) {
      float* r = st + (size_t)(c0 + u) * ML_ST;
      r[e] = state;
      if (e == 0) r[2082] = m;
      const float mn = fmaxf(bl[u] + m, ml[u]);
      state = fexp(bl[u] + m - mn) * state + fexp(ml[u] - mn) * d[u];
      m = mn;
    }
  }
}

constexpr int P3_ITEMS = RWP_ITEMS + ML1_ITEMS;
DI void phase3(const Params& p, int l, char* smem) {
  for (int it = blockIdx.x; it < P3_ITEMS; it += gridDim.x) {
    if (it < RWP_ITEMS) rwkv_prep_item(p, l, it, smem);
    else mlstm_local_item(p, l, it - RWP_ITEMS, smem);
  }
}
constexpr int RW_LD = 72, RW_MB = 64 * RW_LD * 2;
constexpr int RWC_REC = 40960;
DI char* rw_rec(const Params& p, int s, int c) { return p.ws + OFF_REGION + R_CH + ((size_t)s * NCH_ + c) * RWC_REC; }
DI f32x16 rw_mm(const char* A, const char* Bt, int mb, int nb, int lane, f32x16 acc) {
  const int r = lane & 31, h = lane >> 5;
#pragma unroll
  for (int ks = 0; ks < 4; ++ks) {
    const bf16x8 a = *(const bf16x8*)(A + ((mb * 32 + r) * RW_LD + ks * 16 + h * 8) * 2);
    const bf16x8 b = *(const bf16x8*)(Bt + ((nb * 32 + r) * RW_LD + ks * 16 + h * 8) * 2);
    acc = mfma32(a, b, acc);
  }
  return acc;
}
DI void rw_wrT(char* Dst, int mb, int nb, int lane, const f32x16& v) {
  const int r = lane & 31, h = lane >> 5;
#pragma unroll
  for (int g = 0; g < 4; ++g) {
    uint2 o; o.x = pack2bf(v[4 * g], v[4 * g + 1]); o.y = pack2bf(v[4 * g + 2], v[4 * g + 3]);
    *(uint2*)(Dst + ((nb * 32 + r) * RW_LD + mb * 32 + 8 * g + 4 * h) * 2) = o;
  }
}
DI void rw_wrT_g(bf16_t* Dst, int mb, int nb, int lane, const f32x16& v) {
  const int r = lane & 31, h = lane >> 5;
#pragma unroll
  for (int g = 0; g < 4; ++g) {
    uint2 o; o.x = pack2bf(v[4 * g], v[4 * g + 1]); o.y = pack2bf(v[4 * g + 2], v[4 * g + 3]);
    *(uint2*)(Dst + (nb * 32 + r) * 64 + mb * 32 + 8 * g + 4 * h) = o;
  }
}
DI void rw_addT(const char* Src, int mb, int nb, int lane, f32x16& v) {
  const int r = lane & 31, h = lane >> 5;
#pragma unroll
  for (int g = 0; g < 4; ++g) {
    const uint2 u = *(const uint2*)(Src + ((nb * 32 + r) * RW_LD + mb * 32 + 8 * g + 4 * h) * 2);
    v[4 * g] += bf2f((bf16_t)(u.x & 0xffff)); v[4 * g + 1] += bf2f((bf16_t)(u.x >> 16));
    v[4 * g + 2] += bf2f((bf16_t)(u.y & 0xffff)); v[4 * g + 3] += bf2f((bf16_t)(u.y >> 16));
  }
}
DI void rw_mask_upper(f32x16& v, int mb, int nb, int lane, bool strict) {
  const int col = nb * 32 + (lane & 31), h = lane >> 5;
#pragma unroll
  for (int i = 0; i < 16; ++i) { const int row = mb * 32 + crow(i, h); if (strict ? !(row < col) : !(row <= col)) v[i] = 0.f; }
}
DI void rw_mask_lower_strict(f32x16& v, int mb, int nb, int lane) {
  const int col = nb * 32 + (lane & 31), h = lane >> 5;
#pragma unroll
  for (int i = 0; i < 16; ++i) { const int row = mb * 32 + crow(i, h); if (!(col < row)) v[i] = 0.f; }
}

constexpr int RW1_ITEMS = NSEQ_ * NCH_;
DI void rw_chunk_item(const Params& p, int it, char* smem) {
  const int s = it / NCH_, c = it % NCH_, dir = s >> 3, b = (s >> 2) & 1, hd = s & 3;
  const int tid = opaque_tid(), lane = tid & 63, wid = tid >> 6;
  const bf16_t* rb = (const bf16_t*)(p.ws + OFF_REGION + R_RB16);
  const float* lwg = (const float*)(p.ws + OFF_REGION + R_LW) + (size_t)dir * NT_ * 256;
  const size_t AS = (size_t)NT_ * 256;
  char* const At = smem + 0 * RW_MB; char* const Bt_ = smem + 1 * RW_MB; char* const Kt = smem + 2 * RW_MB; char* const Rt = smem + 3 * RW_MB;
  char* const Aj = smem + 4 * RW_MB; char* const Bj = smem + 5 * RW_MB; char* const Kj = smem + 6 * RW_MB; char* const Vi = smem + 7 * RW_MB;
  char* const QA = smem + 8 * RW_MB; char* const QTA = smem + 9 * RW_MB; char* const GA = smem + 10 * RW_MB;
  char* const Mka = smem + 11 * RW_MB; char* const MbrT = smem + 12 * RW_MB; char* const MkrT = smem + 13 * RW_MB;
  char* const QB = At; char* const QTB = Bt_; char* const GB = Kt;
  float* const cs = (float*)(smem + 8 * RW_MB);
  float* const gC = (float*)(smem + 14 * RW_MB);
  char* rec = rw_rec(p, s, c);
  __syncthreads();
  const int t = tid >> 3, j8 = (tid & 7) * 8;
  const int n = seq_tok(dir, b, c * 64 + t);
  {
    const float4 l0 = *(const float4*)(lwg + (size_t)n * 256 + hd * 64 + j8), l1 = *(const float4*)(lwg + (size_t)n * 256 + hd * 64 + j8 + 4);
    float* d = cs + t * 65 + j8;
    d[0] = l0.x; d[1] = l0.y; d[2] = l0.z; d[3] = l0.w; d[4] = l1.x; d[5] = l1.y; d[6] = l1.z; d[7] = l1.w;
  }
  __syncthreads();
  if (tid < 64) { float a = 0.f; for (int tt = 0; tt < 64; ++tt) { a += cs[tt * 65 + tid]; cs[tt * 65 + tid] = a; } gC[tid] = fexp(a); }
  __syncthreads();
  {
    const size_t o = (size_t)n * 256 + hd * 64 + j8;
    const uint4 ukk = *(const uint4*)(rb + 2 * AS + o), ubb = *(const uint4*)(rb + (4 + 2 * dir) * AS + o), ukd = *(const uint4*)(rb + (3 + 2 * dir) * AS + o);
    const uint4 ur = *(const uint4*)(rb + 0 * AS + o), uv = *(const uint4*)(rb + 1 * AS + o);
    const unsigned akk[4] = {ukk.x, ukk.y, ukk.z, ukk.w}, abb[4] = {ubb.x, ubb.y, ubb.z, ubb.w}, akd[4] = {ukd.x, ukd.y, ukd.z, ukd.w};
    const unsigned ar[4] = {ur.x, ur.y, ur.z, ur.w}, av[4] = {uv.x, uv.y, uv.z, uv.w};
    unsigned oa[4], ob[4], ok[4], orr[4];
#pragma unroll
    for (int q = 0; q < 4; ++q) {
      float fa[2], fb[2], fk[2], fr[2];
#pragma unroll
      for (int e = 0; e < 2; ++e) {
        const int j = j8 + 2 * q + e;
        const float cst = cs[t * 65 + j], csp = t > 0 ? cs[(t - 1) * 65 + j] : 0.f;
        const float g = fexp(cst), gp = fexp(csp), gi = fexp(-cst);
        const int sh = 16 * e;
        fa[e] = -bf2f((bf16_t)((akk[q] >> sh) & 0xffff)) * gp;
        fb[e] = bf2f((bf16_t)((abb[q] >> sh) & 0xffff)) * gi;
        fk[e] = bf2f((bf16_t)((akd[q] >> sh) & 0xffff)) * gi;
        fr[e] = bf2f((bf16_t)((ar[q] >> sh) & 0xffff)) * g;
        *(bf16_t*)(Aj + (j * RW_LD + t) * 2) = f2bf(fa[e]);
        *(bf16_t*)(Bj + (j * RW_LD + t) * 2) = f2bf(fb[e]);
        *(bf16_t*)(Kj + (j * RW_LD + t) * 2) = f2bf(fk[e]);
        *(bf16_t*)(Vi + (j * RW_LD + t) * 2) = (bf16_t)((av[q] >> sh) & 0xffff);
      }
      oa[q] = pack2bf(fa[0], fa[1]); ob[q] = pack2bf(fb[0], fb[1]); ok[q] = pack2bf(fk[0], fk[1]); orr[q] = pack2bf(fr[0], fr[1]);
    }
    *(uint4*)(At + (t * RW_LD + j8) * 2) = make_uint4(oa[0], oa[1], oa[2], oa[3]);
    *(uint4*)(Bt_ + (t * RW_LD + j8) * 2) = make_uint4(ob[0], ob[1], ob[2], ob[3]);
    *(uint4*)(Kt + (t * RW_LD + j8) * 2) = make_uint4(ok[0], ok[1], ok[2], ok[3]);
    *(uint4*)(Rt + (t * RW_LD + j8) * 2) = make_uint4(orr[0], orr[1], orr[2], orr[3]);
  }
  __syncthreads();
  {
    const int prod = wid >> 2, mb = (wid >> 1) & 1, nb = wid & 1;
    f32x16 acc = zero16();
    if (prod == 0) {
      if (!(mb == 1 && nb == 0)) acc = rw_mm(Bt_, At, mb, nb, lane, acc);
      rw_mask_upper(acc, mb, nb, lane, true);
      rw_wrT(QA, mb, nb, lane, acc);
      if (mb == nb) {
        const int col = nb * 32 + (lane & 31), h = lane >> 5;
#pragma unroll
        for (int i = 0; i < 16; ++i) if (mb * 32 + crow(i, h) == col) acc[i] += 1.f;
      }
      rw_wrT(GA, mb, nb, lane, acc);
    } else {
      if (!(mb == 0 && nb == 1)) acc = rw_mm(At, Bt_, mb, nb, lane, acc);
      rw_mask_lower_strict(acc, mb, nb, lane);
      rw_wrT(QTA, mb, nb, lane, acc);
    }
  }
  for (int blk = wid; blk < 12; blk += 8) {
    const int prod = blk >> 2, mb = (blk >> 1) & 1, nb = blk & 1;
    f32x16 acc = zero16();
    if (prod == 0) {
      acc = rw_mm(At, Kt, mb, nb, lane, acc); rw_mask_lower_strict(acc, mb, nb, lane); rw_wrT(Mka, mb, nb, lane, acc);
    } else if (prod == 1) {
      acc = rw_mm(Bt_, Rt, mb, nb, lane, acc); rw_mask_upper(acc, mb, nb, lane, false); rw_wrT(MbrT, mb, nb, lane, acc);
    } else {
      acc = rw_mm(Kt, Rt, mb, nb, lane, acc); rw_mask_upper(acc, mb, nb, lane, false); rw_wrT(MkrT, mb, nb, lane, acc);
    }
  }
  __syncthreads();
#define RW_SQ(Q_, Qt_, Qn_, Qtn_, blk) { const int pr_ = (blk) >> 2, mb_ = ((blk) >> 1) & 1, nb_ = (blk) & 1; f32x16 acc_ = zero16(); \
    if (pr_ == 0) { acc_ = rw_mm(Q_, Qt_, mb_, nb_, lane, acc_); rw_wrT(Qtn_, mb_, nb_, lane, acc_); } \
    else { acc_ = rw_mm(Qt_, Q_, mb_, nb_, lane, acc_); rw_wrT(Qn_, mb_, nb_, lane, acc_); } }
#define RW_GUP(Qt_, G_, Gn_, blk) { const int mb_ = ((blk) >> 1) & 1, nb_ = (blk) & 1; f32x16 acc_ = zero16(); \
    rw_addT(G_, mb_, nb_, lane, acc_); acc_ = rw_mm(Qt_, G_, mb_, nb_, lane, acc_); rw_wrT(Gn_, mb_, nb_, lane, acc_); }
  RW_SQ(QA, QTA, QB, QTB, wid);
  __syncthreads();
  for (int blk = wid; blk < 12; blk += 8) { if (blk < 8) { RW_SQ(QB, QTB, QA, QTA, blk); } else { RW_GUP(QTB, GA, GB, blk - 8); } }
  __syncthreads();
  for (int blk = wid; blk < 12; blk += 8) { if (blk < 8) { RW_SQ(QA, QTA, QB, QTB, blk); } else { RW_GUP(QTA, GB, GA, blk - 8); } }
  __syncthreads();
  for (int blk = wid; blk < 12; blk += 8) { if (blk < 8) { RW_SQ(QB, QTB, QA, QTA, blk); } else { RW_GUP(QTB, GA, GB, blk - 8); } }
  __syncthreads();
  for (int blk = wid; blk < 12; blk += 8) { if (blk < 8) { RW_SQ(QA, QTA, QB, QTB, blk); } else { RW_GUP(QTA, GB, GA, blk - 8); } }
  __syncthreads();
  if (wid < 4) { RW_GUP(QTB, GA, GB, wid); }
  __syncthreads();
  {
    const int prod = wid >> 2, mb = (wid >> 1) & 1, nb = wid & 1;
    f32x16 acc = zero16();
    acc = rw_mm(GB, prod == 0 ? Mka : Aj, mb, nb, lane, acc);
    rw_wrT(prod == 0 ? QA : QTA, mb, nb, lane, acc);
  }
  __syncthreads();
  char* const X1 = QA; char* const X2 = QTA; char* const QpT = At;
  for (int blk = wid; blk < 16; blk += 8) {
    const int prod = blk >> 2, mb = (blk >> 1) & 1, nb = blk & 1;
    f32x16 acc = zero16();
    if (prod == 0) {
      rw_addT(MkrT, mb, nb, lane, acc); acc = rw_mm(X1, MbrT, mb, nb, lane, acc); rw_mask_upper(acc, mb, nb, lane, false);
      rw_wrT_g((bf16_t*)(rec + 8192), mb, nb, lane, acc);
    } else if (prod == 1) {
      rw_addT(Rt, mb, nb, lane, acc); acc = rw_mm(X2, MbrT, mb, nb, lane, acc);
      rw_wrT_g((bf16_t*)(rec), mb, nb, lane, acc);
    } else if (prod == 2) {
      acc = rw_mm(X2, Bj, mb, nb, lane, acc);
      const int col = nb * 32 + (lane & 31), h = lane >> 5; const float gc = gC[col];
#pragma unroll
      for (int i = 0; i < 16; ++i) { if (mb * 32 + crow(i, h) == col) acc[i] += 1.f; acc[i] *= gc; }
      rw_wrT_g((bf16_t*)(rec + 16384), mb, nb, lane, acc);
    } else {
      rw_addT(Kj, mb, nb, lane, acc); acc = rw_mm(X1, Bj, mb, nb, lane, acc);
      const float gc = gC[nb * 32 + (lane & 31)];
#pragma unroll
      for (int i = 0; i < 16; ++i) acc[i] *= gc;
      rw_wrT(QpT, mb, nb, lane, acc);
    }
  }
  __syncthreads();
  if (wid < 4) {
    const int mb = (wid >> 1) & 1, nb = wid & 1, r = lane & 31, h = lane >> 5;
    f32x16 acc = zero16();
    acc = rw_mm(QpT, Vi, mb, nb, lane, acc);
    float* dq = (float*)(rec + 24576);
#pragma unroll
    for (int g = 0; g < 4; ++g)
      *(float4*)(dq + (nb * 32 + r) * 64 + mb * 32 + 8 * g + 4 * h) = make_float4(acc[4 * g], acc[4 * g + 1], acc[4 * g + 2], acc[4 * g + 3]);
  }
}

constexpr int RW2_ITEMS = NSEQ_;
constexpr int RW2_DQLD = 68;
constexpr int RW2_STAGE = RW_MB + 64 * RW2_DQLD * 4;
DI void rw_state_item(const Params& p, int s, char* smem) {
  const int tid = opaque_tid(), lane = tid & 63, wid = tid >> 6, r = lane & 31, h = lane >> 5;
  f32x16 S0 = zero16(), S1 = zero16();
  uint4 rp, rd0, rd1;
  const int prow = tid >> 3, pcol = (tid & 7) * 8;
  const int drow = tid >> 3, dcol = (tid & 7) * 8;
  __syncthreads();
  {
    const char* rec = rw_rec(p, s, 0);
    rp = *(const uint4*)(rec + 16384 + (prow * 64 + pcol) * 2);
    rd0 = *(const uint4*)(rec + 24576 + (drow * 64 + dcol) * 4); rd1 = *(const uint4*)(rec + 24576 + (drow * 64 + dcol + 4) * 4);
    *(uint4*)(smem + (prow * RW_LD + pcol) * 2) = rp;
    *(uint4*)(smem + RW_MB + (drow * RW2_DQLD + dcol) * 4) = rd0; *(uint4*)(smem + RW_MB + (drow * RW2_DQLD + dcol + 4) * 4) = rd1;
  }
  __syncthreads();
  for (int c = 0; c < NCH_; ++c) {
    const bool more = c + 1 < NCH_;
    if (more) {
      const char* rec = rw_rec(p, s, c + 1);
      rp = *(const uint4*)(rec + 16384 + (prow * 64 + pcol) * 2);
      rd0 = *(const uint4*)(rec + 24576 + (drow * 64 + dcol) * 4); rd1 = *(const uint4*)(rec + 24576 + (drow * 64 + dcol + 4) * 4);
    }
    sched_fence();
    if (wid < 2) {
      const char* PT = smem + (c & 1) * RW2_STAGE;
      const float* DQ = (const float*)(PT + RW_MB);
      const int i = wid * 32 + r;
      bf16_t* sd = (bf16_t*)(rw_rec(p, s, c) + 16384);
#pragma unroll
      for (int g = 0; g < 4; ++g) {
        uint2 o0, o1;
        o0.x = pack2bf(S0[4 * g], S0[4 * g + 1]); o0.y = pack2bf(S0[4 * g + 2], S0[4 * g + 3]);
        o1.x = pack2bf(S1[4 * g], S1[4 * g + 1]); o1.y = pack2bf(S1[4 * g + 2], S1[4 * g + 3]);
        *(uint2*)(sd + i * 64 + 8 * g + 4 * h) = o0; *(uint2*)(sd + i * 64 + 32 + 8 * g + 4 * h) = o1;
      }
      bf16x8 bfr[2][2];
#pragma unroll
      for (int s2 = 0; s2 < 2; ++s2) {
        const uint4 u0 = make_uint4(pack2bf(S0[8 * s2], S0[8 * s2 + 1]), pack2bf(S0[8 * s2 + 2], S0[8 * s2 + 3]), pack2bf(S0[8 * s2 + 4], S0[8 * s2 + 5]), pack2bf(S0[8 * s2 + 6], S0[8 * s2 + 7]));
        const uint4 u1 = make_uint4(pack2bf(S1[8 * s2], S1[8 * s2 + 1]), pack2bf(S1[8 * s2 + 2], S1[8 * s2 + 3]), pack2bf(S1[8 * s2 + 4], S1[8 * s2 + 5]), pack2bf(S1[8 * s2 + 6], S1[8 * s2 + 7]));
        __builtin_memcpy(&bfr[0][s2], &u0, 16); __builtin_memcpy(&bfr[1][s2], &u1, 16);
      }
      f32x16 n0, n1;
#pragma unroll
      for (int g = 0; g < 4; ++g) {
        const float4 a = *(const float4*)(DQ + i * RW2_DQLD + 8 * g + 4 * h), bq = *(const float4*)(DQ + i * RW2_DQLD + 32 + 8 * g + 4 * h);
        n0[4 * g] = a.x; n0[4 * g + 1] = a.y; n0[4 * g + 2] = a.z; n0[4 * g + 3] = a.w;
        n1[4 * g] = bq.x; n1[4 * g + 1] = bq.y; n1[4 * g + 2] = bq.z; n1[4 * g + 3] = bq.w;
      }
#pragma unroll
      for (int jb2 = 0; jb2 < 2; ++jb2)
#pragma unroll
        for (int s2 = 0; s2 < 2; ++s2) {
          const char* a0 = PT + ((0 * 32 + r) * RW_LD + jb2 * 32 + 16 * s2 + 4 * h) * 2;
          const char* a1 = PT + ((1 * 32 + r) * RW_LD + jb2 * 32 + 16 * s2 + 4 * h) * 2;
          const uint2 l0 = *(const uint2*)a0, h0 = *(const uint2*)(a0 + 16), l1 = *(const uint2*)a1, h1 = *(const uint2*)(a1 + 16);
          const uint4 u0 = make_uint4(l0.x, l0.y, h0.x, h0.y), u1 = make_uint4(l1.x, l1.y, h1.x, h1.y);
          bf16x8 af0, af1; __builtin_memcpy(&af0, &u0, 16); __builtin_memcpy(&af1, &u1, 16);
          n0 = mfma32(af0, bfr[jb2][s2], n0);
          n1 = mfma32(af1, bfr[jb2][s2], n1);
        }
      S0 = n0; S1 = n1;
    }
    if (more) {
      char* d = smem + ((c + 1) & 1) * RW2_STAGE;
      *(uint4*)(d + (prow * RW_LD + pcol) * 2) = rp;
      *(uint4*)(d + RW_MB + (drow * RW2_DQLD + dcol) * 4) = rd0; *(uint4*)(d + RW_MB + (drow * RW2_DQLD + dcol + 4) * 4) = rd1;
    }
    __syncthreads();
  }
}

DI void rw_out_item(const Params& p, int it, char* smem) {
  const int s = it / NCH_, c = it % NCH_, dir = s >> 3, b = (s >> 2) & 1, hd = s & 3;
  const int tid = opaque_tid(), lane = tid & 63, wid = tid >> 6;
  const bf16_t* rb = (const bf16_t*)(p.ws + OFF_REGION + R_RB16);
  const size_t AS = (size_t)NT_ * 256;
  float* ys = (float*)(p.ws + OFF_REGION + R_YS) + (size_t)dir * NT_ * 256;
  char* const Sm = smem; char* const RyT = smem + RW_MB; char* const MyT = smem + 2 * RW_MB; char* const Vi = smem + 3 * RW_MB;
  const char* rec = rw_rec(p, s, c);
  __syncthreads();
  {
    const int row = tid >> 3, col = (tid & 7) * 8;
    *(uint4*)(Sm + (row * RW_LD + col) * 2) = *(const uint4*)(rec + 16384 + (row * 64 + col) * 2);
    *(uint4*)(RyT + (row * RW_LD + col) * 2) = *(const uint4*)(rec + (row * 64 + col) * 2);
    *(uint4*)(MyT + (row * RW_LD + col) * 2) = *(const uint4*)(rec + 8192 + (row * 64 + col) * 2);
    const int n = seq_tok(dir, b, c * 64 + row);
    const uint4 uv = *(const uint4*)(rb + 1 * AS + (size_t)n * 256 + hd * 64 + col);
    const unsigned av[4] = {uv.x, uv.y, uv.z, uv.w};
#pragma unroll
    for (int q = 0; q < 4; ++q) {
      *(bf16_t*)(Vi + ((col + 2 * q) * RW_LD + row) * 2) = (bf16_t)(av[q] & 0xffff);
      *(bf16_t*)(Vi + ((col + 2 * q + 1) * RW_LD + row) * 2) = (bf16_t)(av[q] >> 16);
    }
  }
  __syncthreads();
  if (wid < 4) {
    const int mb = (wid >> 1) & 1, nb = wid & 1, r = lane & 31, h = lane >> 5;
    f32x16 acc = zero16();
    acc = rw_mm(Sm, RyT, mb, nb, lane, acc);
    acc = rw_mm(Vi, MyT, mb, nb, lane, acc);
    const int n = seq_tok(dir, b, c * 64 + nb * 32 + r);
#pragma unroll
    for (int g = 0; g < 4; ++g)
      *(float4*)(ys + (size_t)n * 256 + hd * 64 + mb * 32 + 8 * g + 4 * h) = make_float4(acc[4 * g], acc[4 * g + 1], acc[4 * g + 2], acc[4 * g + 3]);
  }
}
constexpr int ATT_KLD = 104, ATT_VLD = 68;
constexpr int ATT_KB = 64 * ATT_KLD * 2, ATT_VB = 64 * ATT_VLD * 2, ATT_STAGE = ATT_KB + ATT_VB;
DI float fexp2(float x) {
#ifdef EMU
  return exp2f(x);
#else
  return __builtin_amdgcn_exp2f(x);
#endif
}
DI void attn_item(const Params& p, int b, int h, int qt, bool isctx, char* smem) {
  const int tid = opaque_tid(), lane = tid & 63, wid = tid >> 6, r = lane & 31, h2 = lane >> 5;
  const bf16_t* qb = (const bf16_t*)(p.osc + O_QB);
  const bf16_t* kbase = (const bf16_t*)(p.ws + OFF_REGION + R_KB) + (size_t)(b * 8 + h) * KT_ * 96;
  const bf16_t* vbase = (const bf16_t*)(p.ws + OFF_REGION + R_VT) + (size_t)(b * 8 + h) * 64 * KT_;
  bf16_t* att = (bf16_t*)(p.ws + OFF_REGION + R_ATT);
  const int nq0 = isctx ? NX_ + b * CL_ + qt * 256 : b * T_ + qt * 256;
  const int nkt = (isctx ? CL_ : KT_) / 64;
  const int nq = nq0 + wid * 32 + r;
  bf16x8 qf[6];
#pragma unroll
  for (int ks = 0; ks < 6; ++ks) qf[ks] = *(const bf16x8*)(qb + (size_t)nq * 768 + h * 96 + ks * 16 + h2 * 8);
  f32x16 oacc[2] = {zero16(), zero16()};
  float m = -1e30f, lsum = 0.f;
  const float sc = 0.10206207261596577f * 1.4426950408889634f;
  const int kc1 = tid + 512;
  const int vd = tid >> 3, vc = tid & 7;
  uint4 rk0, rk1, rv;
  auto gload = [&](int kt) {
    const bf16_t* ksrc = kbase + (size_t)kt * 64 * 96;
    rk0 = *(const uint4*)(ksrc + tid * 8);
    if (kc1 < 768) rk1 = *(const uint4*)(ksrc + kc1 * 8);
    rv = *(const uint4*)(vbase + (size_t)vd * KT_ + kt * 64 + vc * 8);
  };
  auto sstore = [&](int buf) {
    char* Ks = smem + buf * ATT_STAGE; char* Vs = Ks + ATT_KB;
    *(uint4*)(Ks + ((tid / 12) * ATT_KLD + (tid % 12) * 8) * 2) = rk0;
    if (kc1 < 768) *(uint4*)(Ks + ((kc1 / 12) * ATT_KLD + (kc1 % 12) * 8) * 2) = rk1;
    *(uint2*)(Vs + (vd * ATT_VLD + vc * 8) * 2) = make_uint2(rv.x, rv.y);
    *(uint2*)(Vs + (vd * ATT_VLD + vc * 8 + 4) * 2) = make_uint2(rv.z, rv.w);
  };
  __syncthreads();
  gload(0); sstore(0);
  __syncthreads();
  for (int kt = 0; kt < nkt; ++kt) {
    const bool more = kt + 1 < nkt;
    if (more) gload(kt + 1);
    sched_fence();
    const char* Ks = smem + (kt & 1) * ATT_STAGE; const char* Vs = Ks + ATT_KB;
    f32x16 sacc[2] = {zero16(), zero16()};
#pragma unroll
    for (int ks = 0; ks < 6; ++ks)
#pragma unroll
      for (int kb = 0; kb < 2; ++kb) {
        const bf16x8 kf = *(const bf16x8*)(Ks + ((kb * 32 + r) * ATT_KLD + ks * 16 + h2 * 8) * 2);
        sacc[kb] = mfma32(kf, qf[ks], sacc[kb]);
      }
    float mx = -1e30f;
#pragma unroll
    for (int kb = 0; kb < 2; ++kb)
#pragma unroll
      for (int i = 0; i < 16; ++i) mx = fmaxf(mx, sacc[kb][i]);
    mx = fmaxf(mx, __shfl_xor(mx, 32));
    const float mn = fmaxf(m, mx * sc);
    const float alpha = fexp2(m - mn);
    m = mn;
    float ps = 0.f;
#pragma unroll
    for (int kb = 0; kb < 2; ++kb)
#pragma unroll
      for (int i = 0; i < 16; ++i) { const float pv = fexp2(sacc[kb][i] * sc - mn); sacc[kb][i] = pv; ps += pv; }
    lsum = lsum * alpha + ps;
#pragma unroll
    for (int db = 0; db < 2; ++db)
#pragma unroll
      for (int i = 0; i < 16; ++i) oacc[db][i] *= alpha;
#pragma unroll
    for (int kb = 0; kb < 2; ++kb)
#pragma unroll
      for (int s = 0; s < 2; ++s) {
        bf16x8 pf;
        {
          const unsigned u0 = pack2bf(sacc[kb][8 * s + 0], sacc[kb][8 * s + 1]), u1 = pack2bf(sacc[kb][8 * s + 2], sacc[kb][8 * s + 3]);
          const unsigned u2 = pack2bf(sacc[kb][8 * s + 4], sacc[kb][8 * s + 5]), u3 = pack2bf(sacc[kb][8 * s + 6], sacc[kb][8 * s + 7]);
          const uint4 u = make_uint4(u0, u1, u2, u3);
          __builtin_memcpy(&pf, &u, 16);
        }
#pragma unroll
        for (int db = 0; db < 2; ++db) {
          const char* vrow = Vs + ((db * 32 + r) * ATT_VLD + kb * 32 + 16 * s + 4 * h2) * 2;
          const uint2 lo = *(const uint2*)(vrow), hi = *(const uint2*)(vrow + 16);
          const uint4 u = make_uint4(lo.x, lo.y, hi.x, hi.y);
          bf16x8 vf; __builtin_memcpy(&vf, &u, 16);
          oacc[db] = mfma32(vf, pf, oacc[db]);
        }
      }
    sched_fence();
    if (more) sstore((kt + 1) & 1);
    __syncthreads();
  }
  lsum += __shfl_xor(lsum, 32);
  const float inv = 1.f / lsum;
#pragma unroll
  for (int db = 0; db < 2; ++db)
#pragma unroll
    for (int g = 0; g < 4; ++g) {
      uint2 o;
      o.x = pack2bf(oacc[db][g * 4 + 0] * inv, oacc[db][g * 4 + 1] * inv);
      o.y = pack2bf(oacc[db][g * 4 + 2] * inv, oacc[db][g * 4 + 3] * inv);
      *(uint2*)(att + (size_t)nq * 512 + h * 64 + db * 32 + 8 * g + 4 * h2) = o;
    }
}

constexpr int P3B_ITEMS = RW1_ITEMS + ML2_ITEMS + MLA_Q_TILES + MLA_KV_TILES;
DI void phase3b(const Params& p, int l, char* smem) {
  for (int it = vblock(); it < P3B_ITEMS; it += gridDim.x) {
    int i = it;
    if (i < RW1_ITEMS) { rw_chunk_item(p, i, smem); continue; }
    i -= RW1_ITEMS;
    if (i < ML2_ITEMS) { mlstm_scan_item(p, i); continue; }
    i -= ML2_ITEMS;
    if (i < MLA_Q_TILES) mla_q_item(p, l, i, smem); else mla_kv_item(p, l, i - MLA_Q_TILES, smem);
  }
}

DI constexpr int att_items(int l) { return NB_ * 8 * (T_ / 256) + (l == 0 ? NB_ * 8 * (CL_ / 256) : 0); }
DI void spin_until_ge(int* ctr, int target) {
#ifdef EMU
  while (__atomic_load_n(ctr, __ATOMIC_SEQ_CST) < target) emu::yield();
#else
  while (__hip_atomic_load(ctr, __ATOMIC_RELAXED, __HIP_MEMORY_SCOPE_AGENT) < target) __builtin_amdgcn_s_sleep(8);
#endif
}
DI void phase4(const Params& p, int l, char* smem, int* ctr) {
  const int G = gridDim.x, nsb = G >= 2 * RW2_ITEMS ? RW2_ITEMS : (G > 1 ? G / 2 : 1);
  if ((int)blockIdx.x < nsb) {
    for (int s = blockIdx.x; s < RW2_ITEMS; s += nsb) rw_state_item(p, s, smem);
#ifndef EMU
    asm volatile("s_waitcnt vmcnt(0)" ::: "memory");
#endif
    __syncthreads();
    if (opaque_tid() == 0) { __threadfence(); atomicAdd(ctr + 2, (RW2_ITEMS - (int)blockIdx.x + nsb - 1) / nsb); }
  }
  const int QT = T_ / 256, CQ = (l == 0 ? (NB_ * 8 * (CL_ / 256)) / 8 : 0), R3 = RW1_ITEMS / 8;
  const int per = 2 * QT + CQ + R3;
  int* sitem = (int*)(smem + 160 * 1024 - 16);
  bool r2ok = false;
  const int x0 = xcc_id();
  for (;;) {
    __syncthreads();
    if (opaque_tid() == 0) {
      int item = -1;
      for (int k = 0; k < 8 && item < 0; ++k) {
        const int x = (x0 + k) & 7;
        if (ld_relaxed(ctr + 8 + x) >= per) continue;
        const int li = atomicAdd(ctr + 8 + x, 1);
        if (li < per) item = x * per + li;
      }
      *sitem = item;
    }
    __syncthreads();
    const int item = *sitem;
    if (item < 0) break;
    const int x = item / per; int li = item % per;
    if (li < 2 * QT) { const int bh = 2 * x + li / QT, qt = li % QT; attn_item(p, bh >> 3, bh & 7, qt, false, smem); continue; }
    li -= 2 * QT;
    if (li < CQ) { const int ci = x * CQ + li, qt = ci % (CL_ / 256), bh = ci / (CL_ / 256); attn_item(p, bh >> 3, bh & 7, qt, true, smem); continue; }
    li -= CQ;
    if (!r2ok) {
      if (opaque_tid() == 0) { spin_until_ge(ctr + 2, RW2_ITEMS); __threadfence(); }
      __syncthreads();
      r2ok = true;
    }
    rw_out_item(p, x * R3 + li, smem);
  }
}
constexpr int ML3_CC = CL_ / 64, ML3_XC = T_ / 64;
DI constexpr int ml3_items(bool with_ctx) { return NB_ * 4 * (ML3_XC + (with_ctx ? ML3_CC : 0)); }
DI void mlstm_out_item(const Params& p, int l, int it, bool with_ctx, char* smem) {
  const int per = ML3_XC + (with_ctx ? ML3_CC : 0);
  const int bh = it / per, b = bh >> 2, hd = bh & 3;
  int tc = it % per; if (!with_ctx) tc += ML3_CC;
  const bool isctx = tc < ML3_CC;
  const int ntok0 = isctx ? NX_ + b * CL_ + tc * 64 : b * T_ + (tc - ML3_CC) * 64;
  float* qs = (float*)smem;
  float* ks = qs + 64 * 33;
  float* vs = ks + 64 * 33;
  float* Cs = vs + 64 * 64;
  float* Sm = Cs + 64 * 33;
  float* hs = Sm + 64 * 65;
  float* bj = hs + 64 * 64;
  float* ip = bj + 64;
  float* ns = ip + 64;
  const float* zrec = (const float*)(p.ws + OFF_REGION + R_ZREC);
  const int tid = opaque_tid(), lane = tid & 63, wid = tid >> 6;
  __syncthreads();
  for (int idx = tid; idx < 64 * 64; idx += NTHR) hs[idx] = 0.f;
  for (int dir = 0; dir < 2; ++dir) {
    const int c = dir == 0 ? tc : (isctx ? ML3_CC - 1 - tc : ML3_CC + (ML3_XC - 1 - (tc - ML3_CC)));
    const int s = dir * 8 + b * 4 + hd;
    const float* st = (const float*)(p.ws + OFF_REGION + R_MLST) + ((size_t)s * NCH_ + c) * ML_ST;
    const float m_start = st[2082];
    __syncthreads();
    for (int idx = tid; idx < 64 * 32; idx += NTHR) {
      const int j = idx >> 5, e = idx & 31;
      const int n = ntok0 + (dir ? 63 - j : j);
      qs[j * 33 + e] = zrec[(size_t)n * ZREC_W + ZR_MLQ + hd * 32 + e] * 0.17677669529663687f;
      ks[j * 33 + e] = zrec[(size_t)n * ZREC_W + ZR_MLK + hd * 32 + e];
      Cs[j * 33 + e] = st[j * 32 + e];
    }
    for (int idx = tid; idx < 64 * 64; idx += NTHR) {
      const int j = idx >> 6, e = idx & 63;
      const int n = ntok0 + (dir ? 63 - j : j);
      vs[idx] = zrec[(size_t)n * ZREC_W + ZR_MLV + hd * 64 + e];
    }
    if (tid < 32) ns[tid] = st[2048 + tid];
    if (wid == 1) {
      const int n = ntok0 + (dir ? 63 - lane : lane);
      const float fp = zrec[(size_t)n * ZREC_W + ZR_MLF + dir * 4 + hd] + p.ml_b_f[(l * 2 + dir) * 4 + hd];
      ip[lane] = zrec[(size_t)n * ZREC_W + ZR_MLI + dir * 4 + hd] + p.ml_b_i[(l * 2 + dir) * 4 + hd];
      bj[lane] = wave_incl_scan(logsigmoidf_(fp), lane);
    }
    __syncthreads();
    const int j = tid >> 3, sg = tid & 7;
    const float bjj = bj[j];
    float rmax = -1e30f;
#pragma unroll 1
    for (int u = 0; u < 8; ++u) {
      const int sI = sg * 8 + u;
      float d = 0.f;
#pragma unroll 8
      for (int e = 0; e < 32; ++e) d += qs[j * 33 + e] * ks[sI * 33 + e];
      Sm[j * 65 + sI] = d;
      const float dl = sI <= j ? bjj - bj[sI] + ip[sI] : -1e30f;
      rmax = fmaxf(rmax, dl);
    }
    rmax = fmaxf(rmax, __shfl_xor(rmax, 1)); rmax = fmaxf(rmax, __shfl_xor(rmax, 2)); rmax = fmaxf(rmax, __shfl_xor(rmax, 4));
    const float g = bjj + m_start;
    const float mj = fmaxf(g, rmax);
    const float inter = fexp(g - mj);
    float part = 0.f;
#pragma unroll 1
    for (int u = 0; u < 8; ++u) {
      const int sI = sg * 8 + u;
      const float sv = sI <= j ? fexp(bjj - bj[sI] + ip[sI] - mj) * Sm[j * 65 + sI] : 0.f;
      Sm[j * 65 + sI] = sv; part += sv;
    }
    float nq = 0.f;
#pragma unroll
    for (int e = 0; e < 4; ++e) nq += ns[sg * 4 + e] * qs[j * 33 + sg * 4 + e];
    part += inter * nq;
    part += __shfl_xor(part, 1); part += __shfl_xor(part, 2); part += __shfl_xor(part, 4);
    const float den = fmaxf(fabsf(part), fexp(-mj));
    __syncthreads();
    const int v0 = sg * 8;
    float num[8], cq[8];
#pragma unroll
    for (int u = 0; u < 8; ++u) { num[u] = 0.f; cq[u] = 0.f; }
#pragma unroll 2
    for (int sI = 0; sI <= j; ++sI) {
      const float sv = Sm[j * 65 + sI];
      const float4 va = *(const float4*)(vs + sI * 64 + v0), vb = *(const float4*)(vs + sI * 64 + v0 + 4);
      num[0] += sv * va.x; num[1] += sv * va.y; num[2] += sv * va.z; num[3] += sv * va.w;
      num[4] += sv * vb.x; num[5] += sv * vb.y; num[6] += sv * vb.z; num[7] += sv * vb.w;
    }
#pragma unroll 2
    for (int e = 0; e < 32; ++e) {
      const float qv = qs[j * 33 + e];
#pragma unroll
      for (int u = 0; u < 8; ++u) cq[u] += Cs[(v0 + u) * 33 + e] * qv;
    }
    const float rden = 1.f / den;
#pragma unroll
    for (int u = 0; u < 8; ++u) hs[(dir ? 63 - j : j) * 64 + v0 + u] += (num[u] + inter * cq[u]) * rden;
    __syncthreads();
  }
  const int tk = tid >> 3, v0 = (tid & 7) * 8, n = ntok0 + tk;
  float ss = 0.f; float hv[8];
#pragma unroll
  for (int u = 0; u < 8; ++u) { hv[u] = hs[tk * 64 + v0 + u]; ss += hv[u] * hv[u]; }
  ss += __shfl_xor(ss, 1); ss += __shfl_xor(ss, 2); ss += __shfl_xor(ss, 4);
  const float rs = frsq(ss * (1.f / 64.f) + 1e-6f);
  unsigned o[4];
#pragma unroll
  for (int u = 0; u < 8; u += 2) {
    const int cc = hd * 64 + v0 + u;
    const float a = hv[u] * rs * p.ml_g_norm[l * 256 + cc] * sigmoidf_(zrec[(size_t)n * ZREC_W + ZR_MLO + cc]);
    const float bq = hv[u + 1] * rs * p.ml_g_norm[l * 256 + cc + 1] * sigmoidf_(zrec[(size_t)n * ZREC_W + ZR_MLO + cc + 1]);
    o[u >> 1] = pack2bf(a, bq);
  }
  bf16_t* mlo = (bf16_t*)(p.ws + OFF_REGION + R_MLO);
  *(uint4*)(mlo + (size_t)n * 256 + hd * 64 + v0) = make_uint4(o[0], o[1], o[2], o[3]);
}

DI constexpr int rwo_items(bool with_ctx) { return (with_ctx ? NT_ : NX_) / 16; }
DI void rwkv_out_item(const Params& p, int l, int it, char* smem) {
  float* sg = (float*)smem;
  const float* zrec = (const float*)(p.ws + OFF_REGION + R_ZREC);
  const bf16_t* rb = (const bf16_t*)(p.ws + OFF_REGION + R_RB16);
  const float* bso = (const float*)(p.ws + OFF_REGION + R_BS);
  const float* ys = (const float*)(p.ws + OFF_REGION + R_YS);
  bf16_t* rwo = (bf16_t*)(p.ws + OFF_REGION + R_RWO);
  const float* mu = p.rw_mu + (size_t)l * 1152;
  const int tid = opaque_tid(), n0 = it * 16;
  __syncthreads();
  for (int idx = tid; idx < 16 * 128; idx += NTHR) {
    const int tt = idx >> 7, k = idx & 127, n = n0 + tt, t = tok_t(n), c = 1024 + k;
    const int len = n < NX_ ? T_ : CL_;
    const float* zr = zrec + (size_t)n * ZREC_W + ZR_RW + c;
    const float z = zr[0];
    const float zp = t > 0 ? zr[-ZREC_W] : 0.f, zn = t < len - 1 ? zr[ZREC_W] : 0.f;
    sg[k * 16 + tt] = sigmoidf_(z + (0.5f * (zp + zn) - z) * mu[c]);
  }
  __syncthreads();
  const int col = tid & 255, half = tid >> 8;
  float acc[8];
#pragma unroll
  for (int i = 0; i < 8; ++i) acc[i] = 0.f;
  const float* g2 = p.rw_g2 + (size_t)l * 128 * 256 + col;
  for (int k = 0; k < 128; ++k) {
    const float gv = g2[k * 256];
    const float* sk = sg + k * 16 + half * 8;
#pragma unroll
    for (int i = 0; i < 8; ++i) acc[i] += sk[i] * gv;
  }
  const size_t AS = (size_t)NT_ * 256;
  const float lw = p.rw_lnx_w[(size_t)l * 256 + col], lb = p.rw_lnx_b[(size_t)l * 256 + col];
#pragma unroll
  for (int i = 0; i < 8; ++i) {
    const int n = n0 + half * 8 + i;
    const size_t o = (size_t)n * 256 + col;
    const float y = ys[o] + ys[AS + o];
    const float mean = wave_sum(y) * (1.f / 64.f);
    const float dv = y - mean;
    const float var = wave_sum(dv * dv) * (1.f / 64.f);
    const float yn = dv * (frsq(var + 64e-5f)) * lw + lb;
    const float v = bf2f(rb[1 * AS + o]);
    const float bsum = bso[(size_t)n * 4 + (col >> 6)] + bso[((size_t)NT_ + n) * 4 + (col >> 6)];
    rwo[o] = f2bf((yn + bsum * v) * acc[i]);
  }
}
DI void phase5(const Params& p, int l, bool with_ctx, char* smem) {
  const int n1 = ml3_items(with_ctx), n2 = rwo_items(with_ctx);
  for (int it = blockIdx.x; it < n1 + n2; it += gridDim.x) {
    if (it < n1) mlstm_out_item(p, l, it, with_ctx, smem);
    else rwkv_out_item(p, l, it - n1, smem);
  }
}
DI void phase_merge(const Params& p, int l, bool with_ctx, char* smem) {
  const bf16_t* H = (const bf16_t*)(p.ws + OFF_H);
  const char* W = p.ws + OFF_WMIX + (size_t)l * WM_SIZE;
  const bf16_t* Wg = (const bf16_t*)(W + WM_GATE);
  const bf16_t* att = (const bf16_t*)(p.ws + OFF_REGION + R_ATT);
  const bf16_t* mlo = (const bf16_t*)(p.ws + OFF_REGION + R_MLO);
  const bf16_t* rwo = (const bf16_t*)(p.ws + OFF_REGION + R_RWO);
  bf16_t* ymix = (bf16_t*)(p.osc + O_YMIX);
  const int TM = (with_ctx ? NT_ : NX_) / 128;
  for (int it = vblock(); it < TM * 8; it += gridDim.x) {
    const int tid = opaque_tid();
    const int tm = it >> 3, tn = it & 7;
    __syncthreads();
    f32x16 yacc[G128::MB][G128::NB];
#pragma unroll
    for (int a = 0; a < G128::MB; ++a)
#pragma unroll
      for (int b = 0; b < G128::NB; ++b) yacc[a][b] = zero16();
#pragma unroll
    for (int i = 0; i < 3; ++i) {
      f32x16 gacc[G128::MB][G128::NB], bacc[G128::MB][G128::NB];
#pragma unroll
      for (int a = 0; a < G128::MB; ++a)
#pragma unroll
        for (int b = 0; b < G128::NB; ++b) { gacc[a][b] = zero16(); bacc[a][b] = zero16(); }
      const bf16_t* A0 = H + (size_t)tm * 128 * 1024;
      G128::run(gacc, [&](int r) { return A0 + (size_t)r * 1024; }, Wg + ((size_t)i * 1024 + tn * 128) * 1024, 1024, 1024, smem);
      const bf16_t* br = i == 0 ? att : (i == 1 ? mlo : rwo);
      const int kb = i == 0 ? 512 : 256;
      const bf16_t* Wb = (const bf16_t*)(W + (i == 0 ? WM_BRA : (i == 1 ? WM_BRM : WM_BRR)));
      const bf16_t* B0 = br + (size_t)tm * 128 * kb;
      G128::run(bacc, [&](int r) { return B0 + (size_t)r * kb; }, Wb + (size_t)tn * 128 * kb, kb, kb, smem);
#pragma unroll
      for (int a = 0; a < G128::MB; ++a)
#pragma unroll
        for (int b = 0; b < G128::NB; ++b)
#pragma unroll
          for (int e = 0; e < 16; ++e) yacc[a][b][e] += sigmoidf_(gacc[a][b][e]) * bacc[a][b][e];
    }
    {
      const int lane = tid & 63, wid = tid >> 6, wm = wid / 4, wn = wid % 4;
      float* scr = (float*)(smem + wid * WTile<1>::BYTES);
#pragma unroll
      for (int mb = 0; mb < G128::MB; ++mb) {
        WTile<1>::put(scr, 0, lane, yacc[mb][0]);
        const int row0 = tm * 128 + wm * 64 + mb * 32, col0 = tn * 128 + wn * 32;
        WTile<1>::rows8(scr, lane, [&](int r, int c, const float4& a, const float4& bq) {
          *(uint4*)(ymix + (size_t)(row0 + r) * 1024 + col0 + c) = pack8bf(a, bq); });
      }
    }
  }
}

DI void phase_wout(const Params& p, int l, bool with_ctx, char* smem) {
  const bf16_t* ymix = (const bf16_t*)(p.osc + O_YMIX);
  const bf16_t* Wo = (const bf16_t*)(p.ws + OFF_WMIX + (size_t)l * WM_SIZE + WM_OUT);
  float* xs = (float*)(p.ws + OFF_XS);
  const float* mod = (const float*)(p.ws + OFF_MOD) + (size_t)l * 3 * 6144;
  const int TM = (with_ctx ? NT_ : NX_) / 128;
  const int n_g = TM * 8;
  for (int it = vblock(); it < n_g + CVT_MOE_TILES; it += gridDim.x) {
    if (it >= n_g) { cvt_moe_item(p, l, it - n_g, smem); continue; }
    const int tid = opaque_tid();
    const int tm = it >> 3, tn = it & 7;
    __syncthreads();
    f32x16 acc[G128::MB][G128::NB];
#pragma unroll
    for (int a = 0; a < G128::MB; ++a)
#pragma unroll
      for (int b = 0; b < G128::NB; ++b) acc[a][b] = zero16();
    const bf16_t* A0 = ymix + (size_t)tm * 128 * 1024;
    G128::run(acc, [&](int r) { return A0 + (size_t)r * 1024; }, Wo + (size_t)tn * 128 * 1024, 1024, 1024, smem);
    const float* m2 = mod + (size_t)tok_modrow(tm * 128) * 6144 + 2 * 1024;
    {
      const int lane = tid & 63, wid = tid >> 6, wm = wid / 4, wn = wid % 4;
      float* scr = (float*)(smem + wid * WTile<1>::BYTES);
#pragma unroll
      for (int mb = 0; mb < G128::MB; ++mb) {
        WTile<1>::put(scr, 0, lane, acc[mb][0]);
        const int row0 = tm * 128 + wm * 64 + mb * 32, col0 = tn * 128 + wn * 32;
        WTile<1>::rows4(scr, lane, [&](int r, int c, const float4& a) {
          float4* d = (float4*)(xs + (size_t)(row0 + r) * 1024 + col0 + c);
          const float4 g = *(const float4*)(m2 + col0 + c); float4 x = *d;
          x.x += g.x * a.x; x.y += g.y * a.y; x.z += g.z * a.z; x.w += g.w * a.w; *d = x; });
      }
    }
  }
}

typedef Gemm<128, 64, 64, 4, 2> GRT;
DI void phase_router(const Params& p, int l, bool with_ctx, char* smem, int* cnt) {
  float* xs = (float*)(p.ws + OFF_XS);
  bf16_t* H = (bf16_t*)(p.ws + OFF_H);
  const float* mod = (const float*)(p.ws + OFF_MOD) + (size_t)l * 3 * 6144;
  const bf16_t* Wr = (const bf16_t*)(p.ws + OFF_WMIX + (size_t)l * WM_SIZE + WM_RT);
  int* eidx = (int*)(p.ws + OFF_REGION + R_EIDX);
  float* ewt = (float*)(p.ws + OFF_REGION + R_EWT);
  int* erank = (int*)(p.ws + OFF_REGION + R_ERANK);
  int* elist = (int*)(p.ws + OFF_REGION + R_ELIST);
  float* sc = (float*)(smem + GRT::SMEM);
  float* bs = sc + 128 * 65;
  float* gs = bs + 128 * 65;
  int* lcnt = (int*)(gs + 128 * 9);
  int* lbase = lcnt + 64;
  const int tid = opaque_tid(), lane = tid & 63, wid = tid >> 6;
  const int ntok = with_ctx ? NT_ : NX_;
  for (int it = blockIdx.x; it < ntok / 128; it += gridDim.x) {
    const int n0 = it * 128;
    __syncthreads();
    TSB(p, 40);
    if (tid < 64) lcnt[tid] = 0;
#pragma unroll 1
    for (int r4 = 0; r4 < 16; r4 += 4) {
      float v[4][16];
#pragma unroll
      for (int u = 0; u < 4; ++u) {
        const int n = n0 + wid * 16 + r4 + u;
#pragma unroll
        for (int j = 0; j < 4; ++j) {
          const float4 t = *(const float4*)(xs + (size_t)n * 1024 + (j * 64 + lane) * 4);
          v[u][j * 4] = t.x; v[u][j * 4 + 1] = t.y; v[u][j * 4 + 2] = t.z; v[u][j * 4 + 3] = t.w;
        }
      }
#pragma unroll
      for (int u = 0; u < 4; ++u) {
        const int n = n0 + wid * 16 + r4 + u;
        const float* m = mod + (size_t)tok_modrow(n) * 6144;
        row_norm_mod(v[u], p.g_ffn + (size_t)l * 1024, m + 3 * 1024, m + 4 * 1024, H + (size_t)n * 1024, lane);
      }
    }
    __syncthreads();
    TSB(p, 41);
    f32x16 acc[1][1]; acc[0][0] = zero16();
    const bf16_t* A0 = H + (size_t)n0 * 1024;
    GRT::run(acc, [&](int r) { return A0 + (size_t)r * 1024; }, Wr, 1024, 1024, smem);
    {
      const int col = GRT::col_of(tid, 0);
      const float rb = p.router_bias[l * 64 + col];
#pragma unroll
      for (int e = 0; e < 16; ++e) {
        const int row = GRT::row_of(tid, 0, e);
        const float s = sigmoidf_(acc[0][0][e]);
        sc[row * 65 + col] = s; bs[row * 65 + col] = s + rb;
      }
    }
    __syncthreads();
    TSB(p, 42);
    int sel[8], lrk[8]; float wsum = 0.f;
    if (tid < 128) {
      float* b = bs + tid * 65; const float* s = sc + tid * 65; float* g = gs + tid * 9;
      for (int gi = 0; gi < 8; ++gi) {
        float m1 = -1e30f, m2 = -1e30f;
        for (int j = 0; j < 8; ++j) { const float x = b[gi * 8 + j]; if (x > m1) { m2 = m1; m1 = x; } else if (x > m2) m2 = x; }
        g[gi] = m1 + m2;
      }
      unsigned gmask = 0;
      for (int c = 0; c < 4; ++c) {
        int best = 0; float bv = -1e30f;
        for (int gi = 0; gi < 8; ++gi) if (!((gmask >> gi) & 1) && g[gi] > bv) { bv = g[gi]; best = gi; }
        gmask |= 1u << best;
      }
      for (int gi = 0; gi < 8; ++gi) if (!((gmask >> gi) & 1)) for (int j = 0; j < 8; ++j) b[gi * 8 + j] = -1e30f;
      wsum = 0.f;
#pragma unroll
      for (int c = 0; c < 8; ++c) {
        int best = 0; float bv = -1e30f;
        for (int e = 0; e < 64; ++e) { const float x = b[e]; if (x > bv) { bv = x; best = e; } }
        b[best] = -3e30f; sel[c] = best; wsum += s[best];
        lrk[c] = atomicAdd(lcnt + best, 1);
      }
    }
    __syncthreads();
    if (tid < 64) { const int c = lcnt[tid]; lbase[tid] = c ? atomicAdd(cnt + tid * 32, c) : 0; }
    __syncthreads();
    if (tid < 128) {
      const int n = n0 + tid;
      const float* s = sc + tid * 65;
      const float inv = 2.5f / (wsum + 1e-20f);
#pragma unroll
      for (int c = 0; c < 8; ++c) {
        const int e = sel[c];
        const int rk = lbase[e] + lrk[c];
        eidx[n * 8 + c] = e; ewt[n * 8 + c] = s[e] * inv; erank[n * 8 + c] = rk;
        elist[(size_t)e * NT_ + rk] = n * 8 + c;
      }
    }
    __syncthreads();
    TSB(p, 43);
  }
}

typedef Gemm<128, 256, 32, 2, 4> GMOE;
constexpr int ACT_LD = 264;
constexpr int MOE_ACT_OFF = GMOE::SMEM;
constexpr int MOE_INFO_OFF = MOE_ACT_OFF + 128 * ACT_LD * 2;
static_assert(MOE_INFO_OFF + 128 * 8 + 67 * 4 * 2 <= 160 * 1024 - 16, "moe lds");
DI void moe_down_run(f32x16 (&acc)[GMOE::MB][GMOE::NB], const char* actl, const bf16_t* Bt, char* smem) {
  constexpr int BK = 32, LDA = GMOE::LDA, CPR = 4, BCH = GMOE::BCH, STG = GMOE::B_BYTES;
  const int tid = opaque_tid(), lane = tid & 63, wid = tid >> 6, wm = wid / 4, wn = wid % 4;
  const int kc = (tid % CPR) * 8, r0 = tid / CPR;
  u32x4 rb[BCH];
  char* Bs0 = smem;
#pragma unroll
  for (int i = 0; i < BCH; ++i) rb[i] = *(const u32x4*)(Bt + (size_t)(r0 + i * 128) * 256 + kc);
#pragma unroll
  for (int i = 0; i < BCH; ++i) *(u32x4*)(Bs0 + ((r0 + i * 128) * LDA + kc) * 2) = rb[i];
  __syncthreads();
  for (int kt = 0; kt < 256 / BK; ++kt) {
    const int kn = (kt + 1 < 256 / BK ? kt + 1 : kt) * BK;
#pragma unroll
    for (int i = 0; i < BCH; ++i) rb[i] = *(const u32x4*)(Bt + (size_t)(r0 + i * 128) * 256 + kn + kc);
    sched_fence();
    const char* Bs = Bs0 + (kt & 1) * STG;
#pragma unroll
    for (int ks = 0; ks < BK / 16; ++ks) {
      bf16x8 af[GMOE::MB], bfr[GMOE::NB];
#pragma unroll
      for (int mb = 0; mb < GMOE::MB; ++mb)
        af[mb] = *(const bf16x8*)(actl + ((wm * 64 + mb * 32 + (lane & 31)) * ACT_LD + kt * BK + ks * 16 + (lane >> 5) * 8) * 2);
#pragma unroll
      for (int nb = 0; nb < GMOE::NB; ++nb)
        bfr[nb] = *(const bf16x8*)(Bs + ((wn * 64 + nb * 32 + (lane & 31)) * LDA + ks * 16 + (lane >> 5) * 8) * 2);
#pragma unroll
      for (int mb = 0; mb < GMOE::MB; ++mb)
#pragma unroll
        for (int nb = 0; nb < GMOE::NB; ++nb) acc[mb][nb] = mfma32(af[mb], bfr[nb], acc[mb][nb]);
    }
    sched_fence();
    {
      char* Bd = Bs0 + ((kt + 1) & 1) * STG;
#pragma unroll
      for (int i = 0; i < BCH; ++i) *(u32x4*)(Bd + ((r0 + i * 128) * LDA + kc) * 2) = rb[i];
    }
    __syncthreads();
  }
}
DI void phase_moe(const Params& p, int l, bool with_ctx, char* smem, const int* cnt) {
  const bf16_t* H = (const bf16_t*)(p.ws + OFF_H);
  const bf16_t* GU = (const bf16_t*)(p.ws + OFF_REGION + R_WMOE + WE_GU);
  const bf16_t* DN = (const bf16_t*)(p.ws + OFF_REGION + R_WMOE + WE_DN);
  const float* ewt = (const float*)(p.ws + OFF_REGION + R_EWT);
  const int* elist = (const int*)(p.ws + OFF_REGION + R_ELIST);
  bf16_t* ybuf = (bf16_t*)(p.ws + OFF_REGION + R_YBUF);
  char* actl = smem + MOE_ACT_OFF;
  int* rtok = (int*)(smem + MOE_INFO_OFF);
  float* rwt = (float*)(rtok + 128);
  int* pre = (int*)(rwt + 128);
  int* off = pre + 67;
  int tid = threadIdx.x;
  const int ntok = with_ctx ? NT_ : NX_;
  __syncthreads();
  if (tid == 0) {
    int a = 0, o = 0;
    for (int e = 0; e < 65; ++e) { const int c = e < 64 ? cnt[e * 32] : ntok; pre[e] = a; off[e] = o; a += (c + 127) >> 7; o += c; }
    pre[65] = a; off[65] = o;
  }
  __syncthreads();
  const int total = pre[65];
  for (int it = vblock(); it < total; it += gridDim.x) {
    tid = opaque_tid();
    int e0 = 0;
    while (pre[e0 + 1] <= it) ++e0;
    const int e = rfl(e0);
    const int rb = rfl(it - pre[e]);
    const int c = rfl(e < 64 ? cnt[e * 32] : ntok);
    const int obase = rfl(off[e] + rb * 128);
    __syncthreads();
    if (tid < 128) {
      const int slot = rb * 128 + tid;
      int tok = 0; float w = 0.f;
      if (slot < c) {
        if (e < 64) { const int pk = elist[(size_t)e * NT_ + slot]; tok = pk >> 3; w = ewt[pk]; }
        else { tok = slot; w = 1.f; }
      }
      rtok[tid] = tok; rwt[tid] = w;
    }
    __syncthreads();
    const bf16_t* Wgu = GU + (size_t)e * 512 * 1024;
#pragma unroll 1
    for (int hf = 0; hf < 2; ++hf) {
      f32x16 acc[GMOE::MB][GMOE::NB];
#pragma unroll
      for (int a = 0; a < GMOE::MB; ++a)
#pragma unroll
        for (int b = 0; b < GMOE::NB; ++b) acc[a][b] = zero16();
      GMOE::run(acc, [&](int r) { return H + (size_t)rtok[r] * 1024; }, Wgu + (size_t)hf * 256 * 1024, 1024, 1024, smem);
      const int lane = tid & 63, wn = (tid >> 6) % 4, wmr = ((tid >> 6) / 4) * 64 + 4 * (lane >> 5);
      const int j = (hf * 4 + wn) * 32 + (lane & 31);
#pragma unroll
      for (int mb = 0; mb < GMOE::MB; ++mb)
#pragma unroll
        for (int i = 0; i < 16; ++i) {
          const int row = wmr + mb * 32 + (i & 3) + 8 * (i >> 2);
          const float g = acc[mb][0][i], u = acc[mb][1][i];
          *(bf16_t*)(actl + (row * ACT_LD + j) * 2) = f2bf(siluf_(g) * u);
        }
    }
    __syncthreads();
    const bf16_t* Wd = DN + (size_t)e * 1024 * 256;
#pragma unroll 1
    for (int nt = 0; nt < 4; ++nt) {
      f32x16 acc[GMOE::MB][GMOE::NB];
#pragma unroll
      for (int a = 0; a < GMOE::MB; ++a)
#pragma unroll
        for (int b = 0; b < GMOE::NB; ++b) acc[a][b] = zero16();
      moe_down_run(acc, actl, Wd + (size_t)nt * 256 * 256, smem);
      {
        const int lane = tid & 63, wid = tid >> 6, wm = wid / 4, wn = wid % 4;
        float* scr = (float*)(smem + wid * WTile<1>::BYTES);
#pragma unroll
        for (int mb = 0; mb < GMOE::MB; ++mb)
#pragma unroll
          for (int nb = 0; nb < GMOE::NB; ++nb) {
            WTile<1>::put(scr, 0, lane, acc[mb][nb]);
            const int row0 = wm * 64 + mb * 32, col0 = nt * 256 + wn * 64 + nb * 32;
            WTile<1>::rows8(scr, lane, [&](int r, int cq, const float4& a, const float4& bq) {
              const int row = row0 + r;
              if (rb * 128 + row < c) {
                const float w = rwt[row];
                const float4 a2 = make_float4(a.x * w, a.y * w, a.z * w, a.w * w), b2 = make_float4(bq.x * w, bq.y * w, bq.z * w, bq.w * w);
                *(uint4*)(ybuf + ((size_t)obase + row) * 1024 + col0 + cq) = pack8bf(a2, b2);
              } });
          }
        __syncthreads();
      }
    }
  }
}

DI void phase_combine(const Params& p, int l, bool last, char* smem, const int* cnt) {
  float* xs = (float*)(p.ws + OFF_XS);
  bf16_t* H = (bf16_t*)(p.ws + OFF_H);
  const float* mod = (const float*)(p.ws + OFF_MOD);
  const int* eidx = (const int*)(p.ws + OFF_REGION + R_EIDX);
  const int* erank = (const int*)(p.ws + OFF_REGION + R_ERANK);
  const bf16_t* ybuf = (const bf16_t*)(p.ws + OFF_REGION + R_YBUF);
  int* off = (int*)smem;
  const int tid = opaque_tid(), lane = tid & 63, wid = tid >> 6;
  const int ntok = last ? NX_ : NT_;
  __syncthreads();
  if (tid == 0) { int o = 0; for (int e = 0; e < 64; ++e) { off[e] = o; o += cnt[e * 32]; } off[64] = o; }
  __syncthreads();
  for (int n = blockIdx.x * 8 + wid; n < ntok; n += gridDim.x * 8) {
    float acc[16];
#pragma unroll
    for (int i = 0; i < 16; ++i) acc[i] = 0.f;
    for (int k = 0; k < 9; ++k) {
      const int row = k < 8 ? off[eidx[n * 8 + k]] + erank[n * 8 + k] : off[64] + n;
      const bf16_t* y = ybuf + (size_t)row * 1024;
#pragma unroll
      for (int j = 0; j < 4; ++j) {
        const uint2 u = *(const uint2*)(y + (j * 64 + lane) * 4);
        acc[j * 4 + 0] += bf2f((bf16_t)(u.x & 0xffff)); acc[j * 4 + 1] += bf2f((bf16_t)(u.x >> 16));
        acc[j * 4 + 2] += bf2f((bf16_t)(u.y & 0xffff)); acc[j * 4 + 3] += bf2f((bf16_t)(u.y >> 16));
      }
    }
    const float* m5 = mod + ((size_t)l * 3 + tok_modrow(n)) * 6144 + 5 * 1024;
    float v[16];
#pragma unroll
    for (int j = 0; j < 4; ++j) {
      const int c = (j * 64 + lane) * 4;
      const float4 x = *(const float4*)(xs + (size_t)n * 1024 + c), g = *(const float4*)(m5 + c);
      v[j * 4 + 0] = x.x + g.x * acc[j * 4 + 0]; v[j * 4 + 1] = x.y + g.y * acc[j * 4 + 1];
      v[j * 4 + 2] = x.z + g.z * acc[j * 4 + 2]; v[j * 4 + 3] = x.w + g.w * acc[j * 4 + 3];
      if (!last) *(float4*)(xs + (size_t)n * 1024 + c) = make_float4(v[j * 4], v[j * 4 + 1], v[j * 4 + 2], v[j * 4 + 3]);
    }
    if (!last) {
      const float* m = mod + ((size_t)(l + 1) * 3 + tok_modrow(n)) * 6144;
      row_norm_mod(v, p.g_mix + (size_t)(l + 1) * 1024, m, m + 1024, H + (size_t)n * 1024, lane);
    } else {
      float ss = 0.f;
#pragma unroll
      for (int i = 0; i < 16; ++i) ss += v[i] * v[i];
      ss = wave_sum(ss);
      const float rs = frsq(ss * (1.f / 1024.f) + 1e-6f);
#pragma unroll
      for (int j = 0; j < 4; ++j) {
        const int c = (j * 64 + lane) * 4;
        const float4 g = *(const float4*)(p.g_final + c);
        *(float4*)(p.out + (size_t)n * 1024 + c) = make_float4(v[j * 4] * rs * g.x, v[j * 4 + 1] * rs * g.y, v[j * 4 + 2] * rs * g.z, v[j * 4 + 3] * rs * g.w);
      }
    }
  }
}
#define SMEM_BYTES (160 * 1024)
#ifndef MEGA
#define MEGA 0
#endif
DI int* cnt_ptr(const Params& p, int l) { return (int*)(p.ws + OFF_CNT) + 1024 + 2048 * l; }
DI int* ctr_ptr(const Params& p, int l) { return (int*)(p.ws + OFF_CNT) + 32 * l; }
#if !MEGA
__global__ void __launch_bounds__(NTHR) k_phaseA(Params p) { SMEM_DECL(smem, SMEM_BYTES); phaseA(p, smem); }
__global__ void __launch_bounds__(NTHR) k_norm0(Params p) { phase_norm0(p); }
__global__ void __launch_bounds__(NTHR) k_win(Params p, int l) { SMEM_DECL(smem, SMEM_BYTES); phase_win(p, l, smem); }
__global__ void __launch_bounds__(NTHR) k_p3(Params p, int l) { SMEM_DECL(smem, SMEM_BYTES); phase3(p, l, smem); }
__global__ void __launch_bounds__(NTHR) k_p3b(Params p, int l) { SMEM_DECL(smem, SMEM_BYTES); phase3b(p, l, smem); }
__global__ void __launch_bounds__(NTHR) k_p4(Params p, int l) { SMEM_DECL(smem, SMEM_BYTES); phase4(p, l, smem, ctr_ptr(p, l)); }
__global__ void __launch_bounds__(NTHR) k_p5(Params p, int l, int wc) { SMEM_DECL(smem, SMEM_BYTES); phase5(p, l, wc != 0, smem); }
__global__ void __launch_bounds__(NTHR) k_merge(Params p, int l, int wc) { SMEM_DECL(smem, SMEM_BYTES); phase_merge(p, l, wc != 0, smem); }
__global__ void __launch_bounds__(NTHR) k_wout(Params p, int l, int wc) { SMEM_DECL(smem, SMEM_BYTES); phase_wout(p, l, wc != 0, smem); }
__global__ void __launch_bounds__(NTHR) k_router(Params p, int l, int wc) { SMEM_DECL(smem, SMEM_BYTES); phase_router(p, l, wc != 0, smem, cnt_ptr(p, l)); }
__global__ void __launch_bounds__(NTHR) k_moe(Params p, int l, int wc) { SMEM_DECL(smem, SMEM_BYTES); phase_moe(p, l, wc != 0, smem, cnt_ptr(p, l)); }
__global__ void __launch_bounds__(NTHR) k_combine(Params p, int l, int last) { SMEM_DECL(smem, SMEM_BYTES); phase_combine(p, l, last != 0, smem, cnt_ptr(p, l)); }
#else
#ifndef EMU
#define XB_TMO      128
#define XB_XCNT(j)  (256  + 64 * (j))
#define XB_XSUB(j)  (1280 + 64 * (j))
#define XB_XGEN(j)  (2304 + 64 * (j))
#define XB_TOP      3328
#define XB_TOPGEN   3392
#define XCD_BAR_WORDS 3456
#define XB_SPIN_CAP (1u << 24)
#define LAS __attribute__((address_space(3)))
DI unsigned xb_ld(unsigned* p) { return __hip_atomic_load(p, __ATOMIC_RELAXED, __HIP_MEMORY_SCOPE_AGENT); }
DI unsigned xb_add(unsigned* p, unsigned v) { return __hip_atomic_fetch_add(p, v, __ATOMIC_RELAXED, __HIP_MEMORY_SCOPE_AGENT); }
DI unsigned xb_xcc_id() { return (unsigned)__builtin_amdgcn_s_getreg((3 << 11) | 20) & 0xFu; }
#define XB_SPIN(cond, bar) do { unsigned _sp = 0; while (cond) { __builtin_amdgcn_s_sleep(1); \
    if ((++_sp & 255u) == 0u) { if (xb_ld(&(bar)[XB_TMO])) break; if (_sp > XB_SPIN_CAP) { atomicAdd(&(bar)[XB_TMO], 1u); break; } } } } while (0)
struct XcdBarrier { unsigned* bar; unsigned x; volatile LAS unsigned* st; };
DI XcdBarrier xcd_barrier_post(unsigned* bar, volatile LAS unsigned* st) {
  XcdBarrier b; b.bar = bar; b.x = xb_xcc_id(); b.st = st;
  if (threadIdx.x == 0) (void)xb_add(&bar[XB_XCNT(b.x)], 1u);
  return b;
}
DI void xcd_barrier_complete(unsigned* bar, unsigned x, unsigned& nloc, unsigned& nx) {
  const unsigned G = gridDim.x * gridDim.y * gridDim.z;
  unsigned sum, cnt, mine, sp = 0u;
  for (;;) {
    sum = 0u; cnt = 0u; mine = 0u;
#pragma unroll
    for (unsigned j = 0; j < 16; ++j) { const unsigned c = xb_ld(&bar[XB_XCNT(j)]); sum += c; cnt += (c > 0u) ? 1u : 0u; mine = (j == x) ? c : mine; }
    if (sum == G) break;
    __builtin_amdgcn_s_sleep(1);
    if ((++sp & 255u) == 0u) { if (xb_ld(&bar[XB_TMO])) break; if (sp > XB_SPIN_CAP) { atomicAdd(&bar[XB_TMO], 1u); break; } }
  }
  nloc = mine > 0u ? mine : 1u; nx = cnt > 0u ? cnt : 1u;
}
DI void xcd_barrier(const XcdBarrier& b) {
  asm volatile("s_waitcnt vmcnt(0)" ::: "memory");
  __syncthreads();
  if (threadIdx.x == 0) {
    unsigned* bar = b.bar;
    __builtin_amdgcn_s_waitcnt(0);
    unsigned nloc = b.st[0], nx = b.st[1];
    if (nloc == 0u) { xcd_barrier_complete(bar, b.x, nloc, nx); b.st[0] = nloc; b.st[1] = nx; }
    const unsigned old = xb_add(&bar[XB_XSUB(b.x)], 1u);
    const unsigned gen = old / nloc;
    if (old + 1u == (gen + 1u) * nloc) {
      __builtin_amdgcn_fence(__ATOMIC_RELEASE, "agent");
      asm volatile("s_waitcnt vmcnt(0)" ::: "memory");
      const unsigned og = xb_add(&bar[XB_TOP], 1u);
      const unsigned tg = og / nx;
      if (og + 1u == (tg + 1u) * nx) xb_add(&bar[XB_TOPGEN], 1u);
      else XB_SPIN(xb_ld(&bar[XB_TOPGEN]) == tg, bar);
      __builtin_amdgcn_fence(__ATOMIC_ACQUIRE, "agent");
      xb_add(&bar[XB_XGEN(b.x)], 1u);
      asm volatile("s_waitcnt vmcnt(0)" ::: "memory");
    } else {
      XB_SPIN(xb_ld(&bar[XB_XGEN(b.x)]) == gen, bar);
      __builtin_amdgcn_fence(__ATOMIC_ACQUIRE, "agent");
      asm volatile("s_waitcnt vmcnt(0)" ::: "memory");
    }
  }
  __syncthreads();
}
#define GSYNC() { XcdBarrier xb_; xb_.bar = (unsigned*)(p.ws + OFF_BAR); xb_.x = xb_xcc_id(); xb_.st = (volatile LAS unsigned*)(smem + SMEM_BYTES - 32); xcd_barrier(xb_); }
#else
#define GSYNC() emu::grid_barrier()
#endif
#ifdef PROBE_IDX
#define TS(i) { if (blockIdx.x == 0 && threadIdx.x == 0) ts[i] = wall_clock64(); }
#else
#define TS(i)
#endif
__global__ void __launch_bounds__(NTHR) k_mega(Params p) {
  SMEM_DECL(smem, SMEM_BYTES);
  cooperative_groups::grid_group grid = cooperative_groups::this_grid();
  volatile LAS unsigned* xst = (volatile LAS unsigned*)(smem + SMEM_BYTES - 32);
  if (threadIdx.x == 0) { xst[0] = 0u; xst[1] = 0u; }
  __syncthreads();
  (void)xcd_barrier_post((unsigned*)(p.ws + OFF_BAR), xst);
#ifdef PROBE_IDX
  long long* ts = (long long*)(p.ws + OFF_CNT + 2048);
#endif
  TS(0);
  phaseA(p, smem);
  grid.sync(); TS(1);
  phase_norm0(p);
  GSYNC(); TS(2);
#pragma unroll 1
  for (int l = 0; l < 2; ++l) {
    const bool wc = l == 0;
    phase_win(p, l, smem); GSYNC(); TS(3 + l * 10);
    phase3(p, l, smem); GSYNC(); TS(4 + l * 10);
    phase3b(p, l, smem); GSYNC(); TS(5 + l * 10);
    phase4(p, l, smem, ctr_ptr(p, l)); GSYNC(); TS(6 + l * 10);
    phase5(p, l, wc, smem); GSYNC(); TS(7 + l * 10);
    phase_merge(p, l, wc, smem); GSYNC(); TS(8 + l * 10);
    phase_wout(p, l, wc, smem); GSYNC(); TS(9 + l * 10);
    phase_router(p, l, wc, smem, cnt_ptr(p, l)); GSYNC(); TS(10 + l * 10);
    phase_moe(p, l, wc, smem, cnt_ptr(p, l)); GSYNC(); TS(11 + l * 10);
    phase_combine(p, l, l == 1, smem, cnt_ptr(p, l));
#ifdef PROBE_IDX
    GSYNC(); TS(12 + l * 10);
#else
    if (l == 0) GSYNC();
#endif
  }
#ifdef PROBE_IDX
  if (blockIdx.x == 0 && threadIdx.x == 0) {
    const float us = (float)(ts[PROBE_IDX + 1] - ts[PROBE_IDX]) * 0.01f;
    p.out[0] += PROBE_IDX >= 40 ? rintf(6.f * log2f(fmaxf(us * 16.f, 1.f))) : rintf(6.f * log2f(fmaxf(us, 1.f)));
  }
#endif
}
#endif

extern "C" void kernel_launch(void* const* d_in, const int* in_sizes, int n_in, void* d_out, int out_size, void* d_ws,
                              size_t ws_size, hipStream_t stream) {
  Params p{};
  const float** pp = (const float**)&p;
  for (int i = 0; i < 41; ++i) pp[i] = (const float*)d_in[i];
  p.out = (float*)d_out; p.ws = (char*)d_ws; p.osc = (char*)d_out;
  if (ws_size < WS_NEEDED) { fprintf(stderr, "workspace too small: %zu < %zu\n", ws_size, (size_t)WS_NEEDED); return; }
#if !MEGA
  const dim3 g(256), b(NTHR);
  hipLaunchKernelGGL(k_phaseA, g, b, 0, stream, p);
  hipLaunchKernelGGL(k_norm0, g, b, 0, stream, p);
  for (int l = 0; l < 2; ++l) {
    const int wc = l == 0;
    hipLaunchKernelGGL(k_win, g, b, 0, stream, p, l);
    hipLaunchKernelGGL(k_p3, g, b, 0, stream, p, l);
    hipLaunchKernelGGL(k_p3b, g, b, 0, stream, p, l);
    hipLaunchKernelGGL(k_p4, g, b, 0, stream, p, l);
    hipLaunchKernelGGL(k_p5, g, b, 0, stream, p, l, wc);
    hipLaunchKernelGGL(k_merge, g, b, 0, stream, p, l, wc);
    hipLaunchKernelGGL(k_wout, g, b, 0, stream, p, l, wc);
    hipLaunchKernelGGL(k_router, g, b, 0, stream, p, l, wc);
    hipLaunchKernelGGL(k_moe, g, b, 0, stream, p, l, wc);
    hipLaunchKernelGGL(k_combine, g, b, 0, stream, p, l, l == 1);
  }
#else
  static int grid_blocks = 0;
  if (!grid_blocks) {
    int dev = 0, cus = 0, per_cu = 0;
    hipGetDevice(&dev);
    hipDeviceGetAttribute(&cus, hipDeviceAttributeMultiprocessorCount, dev);
    hipOccupancyMaxActiveBlocksPerMultiprocessor(&per_cu, k_mega, NTHR, 0);
    if (per_cu > 1) per_cu = 1;
    grid_blocks = cus * per_cu;
  }
  hipMemsetAsync(p.ws + OFF_BAR, 0, 16384, stream);
  void* args[] = {&p};
  hipError_t e = hipLaunchCooperativeKernel((void*)k_mega, dim3(grid_blocks), dim3(NTHR), args, 0, stream);
  if (e != hipSuccess) fprintf(stderr, "cooperative launch failed: %s (grid %d)\n", hipGetErrorString(e), grid_blocks);
#endif
}
```

```cpp
#define MEGA 1
#include <hip/hip_runtime.h>
#include <hip/hip_cooperative_groups.h>
#include <cstdio>

#ifndef SEQ_T
#define SEQ_T 8192
#endif
#ifndef CTX_L
#define CTX_L 256
#endif

#define DI __device__ __forceinline__
typedef unsigned short bf16_t;
typedef short bf16x8 __attribute__((ext_vector_type(8)));
typedef float f32x16 __attribute__((ext_vector_type(16)));
typedef float f32x4 __attribute__((ext_vector_type(4)));
typedef unsigned u32x4 __attribute__((ext_vector_type(4)));

constexpr int NB_ = 2, T_ = SEQ_T, CL_ = CTX_L, D_ = 1024;
constexpr int NX_ = NB_ * T_, NC_ = NB_ * CL_, NT_ = NX_ + NC_, KT_ = CL_ + T_;
constexpr int GRID_W_ = 64;
constexpr int MLA_H = 8, MLA_NOPE_ = 64, MLA_ROPE_ = 32, MLA_DK = 96, MLA_DV = 64, QLORA = 384, KVLORA = 256;
constexpr int MLA_IN_ = 672, ML_IN_ = 784, RW_IN_ = 1152, GATE_IN_ = 3072, D_IN_ = 5680;
constexpr int ZMLA_W = 768;
constexpr int ZREC_W = 1936;
constexpr int WIN_N = 768 + 2048;
constexpr int ML_H = 4, ML_DK = 32, ML_DV = 64, ML_L = 64;
constexpr int RW_H = 4, RW_N_ = 64;
constexpr int NE_ = 64, TOPK_ = 8, DE_ = 256;
constexpr int NCH_ = KT_ / ML_L;
constexpr int NSEQ_ = 2 * NB_ * 4;

constexpr int ZR_MLQ = 0, ZR_MLK = 128, ZR_MLV = 256, ZR_MLO = 512, ZR_MLI = 768, ZR_MLF = 776;
constexpr int ZR_RW = 784;

constexpr size_t al256(size_t x) { return (x + 255) & ~(size_t)255; }
constexpr size_t WM_WIN = 0;
constexpr size_t WM_GATE = WM_WIN + (size_t)WIN_N * 1024 * 2;
constexpr size_t WM_UQ = WM_GATE + (size_t)3072 * 1024 * 2;
constexpr size_t WM_UKV = WM_UQ + (size_t)768 * 384 * 2;
constexpr size_t WM_BRA = WM_UKV + (size_t)1024 * 256 * 2;
constexpr size_t WM_BRM = WM_BRA + (size_t)1024 * 512 * 2;
constexpr size_t WM_BRR = WM_BRM + (size_t)1024 * 256 * 2;
constexpr size_t WM_OUT = WM_BRR + (size_t)1024 * 256 * 2;
constexpr size_t WM_RT = WM_OUT + (size_t)1024 * 1024 * 2;
constexpr size_t WM_SIZE = al256(WM_RT + (size_t)64 * 1024 * 2);
constexpr size_t WE_GU = 0;
constexpr size_t WE_DN = WE_GU + (size_t)65 * 512 * 1024 * 2;
constexpr size_t WE_SIZE = al256(WE_DN + (size_t)65 * 1024 * 256 * 2);

constexpr size_t OFF_XS = 0;
constexpr size_t OFF_MOD = OFF_XS + al256((size_t)NT_ * 1024 * 4);
constexpr size_t OFF_ROPE = OFF_MOD + al256((size_t)2 * 3 * 6144 * 4);
constexpr size_t OFF_H = OFF_ROPE + al256((size_t)T_ * 16 * 8);
constexpr size_t OFF_WMIX = OFF_H + al256((size_t)NT_ * 1024 * 2);
constexpr size_t OFF_CNT = OFF_WMIX + 2 * WM_SIZE;
constexpr size_t OFF_BAR = OFF_CNT + 32768;
constexpr size_t OFF_REGION = OFF_BAR + 16384;
constexpr size_t R_ZREC = 0;
constexpr size_t R_RB16 = R_ZREC + al256((size_t)NT_ * ZREC_W * 4);
constexpr size_t R_LW = R_RB16 + al256((size_t)7 * NT_ * 256 * 2);
constexpr size_t R_BS = R_LW + al256((size_t)2 * NT_ * 256 * 4);
constexpr size_t R_CH = R_BS + al256((size_t)2 * NT_ * 4 * 4);
constexpr size_t R_YS = R_CH + al256((size_t)NSEQ_ * NCH_ * 40960);
constexpr size_t R_MLST = R_YS + al256((size_t)2 * NT_ * 256 * 4);
constexpr size_t R_ATT = R_MLST + al256((size_t)NSEQ_ * NCH_ * 2112 * 4);
constexpr size_t R_MLO = R_ATT + al256((size_t)NT_ * 512 * 2);
constexpr size_t R_RWO = R_MLO + al256((size_t)NT_ * 256 * 2);
constexpr size_t R_VT = R_RWO + al256((size_t)NT_ * 256 * 2);
constexpr size_t R_KB = R_VT + al256((size_t)NB_ * MLA_H * 64 * KT_ * 2);
constexpr size_t R_MIX_END = R_KB + al256((size_t)NB_ * MLA_H * KT_ * 96 * 2);
constexpr int NSLOT_ = NT_ * 9;
constexpr size_t R_YBUF = 0;
constexpr size_t R_EIDX = R_YBUF + al256((size_t)NSLOT_ * 1024 * 2);
constexpr size_t R_EWT = R_EIDX + al256((size_t)NT_ * 8 * 4);
constexpr size_t R_ERANK = R_EWT + al256((size_t)NT_ * 8 * 4);
constexpr size_t R_ELIST = R_ERANK + al256((size_t)NT_ * 8 * 4);
constexpr size_t R_WMOE = R_ELIST + al256((size_t)64 * NT_ * 4);
constexpr size_t R_MOE_END = R_WMOE + WE_SIZE;
constexpr size_t R_SIZE = R_MIX_END > R_MOE_END ? R_MIX_END : R_MOE_END;
constexpr size_t WS_NEEDED = OFF_REGION + R_SIZE;
constexpr size_t O_ZMLA = 0;
constexpr size_t O_QB = O_ZMLA + al256((size_t)NT_ * ZMLA_W * 2);
constexpr size_t O_END = O_QB + al256((size_t)NT_ * 768 * 2);
constexpr size_t O_YMIX = 0;
#if SEQ_T == 8192 && CTX_L == 256
static_assert(O_END <= (size_t)NX_ * 1024 * 4, "d_out scratch overflow");
static_assert((size_t)NT_ * 1024 * 2 <= (size_t)NX_ * 1024 * 4, "ymix overflow");
static_assert(WS_NEEDED <= (size_t)597000000, "workspace too large");
#endif

struct Params {
  const float *x, *c, *ctx, *c_ctx, *w_mod, *b_mod, *g_mix, *g_ffn, *w_in, *g_cq, *w_uq, *g_ckv, *w_uk, *w_uv;
  const float *ml_b_i, *ml_b_f, *ml_g_norm, *rw_mu, *rw_w0, *rw_w2, *rw_a0, *rw_a2, *rw_g2, *rw_k_k, *rw_k_a;
  const float *rw_r_k, *rw_lnx_w, *rw_lnx_b, *w_br_mla, *w_br_ml, *w_br_rw, *w_out, *w_router, *router_bias;
  const float *w_e_gate, *w_e_up, *w_e_down, *w_s_gate, *w_s_up, *w_s_down, *g_final;
  float* out; char* ws; char* osc;
};

DI float bf2f(bf16_t s) { unsigned u = ((unsigned)s) << 16; float f; __builtin_memcpy(&f, &u, 4); return f; }
DI bf16_t f2bf(float x) { unsigned u; __builtin_memcpy(&u, &x, 4); u += 0x7fffu + ((u >> 16) & 1u); return (bf16_t)(u >> 16); }
DI unsigned pack2bf(float a, float b) {
#ifdef EMU
  return (unsigned)f2bf(a) | ((unsigned)f2bf(b) << 16);
#else
  typedef __bf16 bf2 __attribute__((ext_vector_type(2)));
  typedef float f2 __attribute__((ext_vector_type(2)));
  f2 v = {a, b}; bf2 r = __builtin_convertvector(v, bf2); return __builtin_bit_cast(unsigned, r);
#endif
}
DI f32x16 mfma32(bf16x8 a, bf16x8 b, f32x16 c) {
#ifdef EMU
  return emu_mfma_32x32x16_bf16(a, b, c);
#else
  return __builtin_amdgcn_mfma_f32_32x32x16_bf16(a, b, c, 0, 0, 0);
#endif
}
DI int rfl(int v) {
#ifdef EMU
  return v;
#else
  return __builtin_amdgcn_readfirstlane(v);
#endif
}
DI int opaque_tid() {
#ifdef EMU
  return threadIdx.x;
#else
  int t = threadIdx.x; asm volatile("" : "+v"(t)); return t;
#endif
}
DI void wave_sync() {
#ifdef EMU
  (void)__ballot(1);
#else
  asm volatile("" ::: "memory");
#endif
}
DI int vblock() {
  const int g = gridDim.x, b = blockIdx.x;
  return (g & 7) == 0 ? (b & 7) * (g >> 3) + (b >> 3) : b;
}
DI int xcc_id() {
#ifdef EMU
  return blockIdx.x & 7;
#else
  return (int)(__builtin_amdgcn_s_getreg((3 << 11) | 20) & 7u);
#endif
}
DI int ld_relaxed(int* p) {
#ifdef EMU
  return __atomic_load_n(p, __ATOMIC_SEQ_CST);
#else
  return __hip_atomic_load(p, __ATOMIC_RELAXED, __HIP_MEMORY_SCOPE_AGENT);
#endif
}
DI void sched_fence() {
#ifndef EMU
  __builtin_amdgcn_sched_barrier(0);
#endif
}
DI f32x16 zero16() { f32x16 z; for (int i = 0; i < 16; ++i) z[i] = 0.f; return z; }
DI int crow(int reg, int h) { return (reg & 3) + 8 * (reg >> 2) + 4 * h; }
#ifdef EMU
DI float fexp(float x) { return expf(x); }
#else
DI float fexp(float x) { return __expf(x); }
#endif
#ifdef EMU
DI float frcp(float x) { return 1.f / x; }
DI float frsq(float x) { return 1.f / sqrtf(x); }
#else
DI float frcp(float x) { return __builtin_amdgcn_rcpf(x); }
DI float frsq(float x) { return __builtin_amdgcn_rsqf(x); }
#endif
DI float sigmoidf_(float x) { return frcp(1.f + fexp(-x)); }
DI float siluf_(float x) { return x * sigmoidf_(x); }
#ifdef EMU
DI float wave_sum(float v) { for (int m = 32; m >= 1; m >>= 1) v += __shfl_xor(v, m); return v; }
DI float wave_max(float v) { for (int m = 32; m >= 1; m >>= 1) v = fmaxf(v, __shfl_xor(v, m)); return v; }
#else
#define DPPF(x, ctrl) __builtin_bit_cast(float, __builtin_amdgcn_mov_dpp(__builtin_bit_cast(int, (x)), (ctrl), 0xf, 0xf, true))
#define RDLF(x, l) __builtin_bit_cast(float, __builtin_amdgcn_readlane(__builtin_bit_cast(int, (x)), (l)))
DI float wave_sum(float v) {
  v += DPPF(v, 0xB1); v += DPPF(v, 0x4E); v += DPPF(v, 0x124); v += DPPF(v, 0x128);
  return (RDLF(v, 0) + RDLF(v, 16)) + (RDLF(v, 32) + RDLF(v, 48));
}
DI float wave_max(float v) {
  v = fmaxf(v, DPPF(v, 0xB1)); v = fmaxf(v, DPPF(v, 0x4E)); v = fmaxf(v, DPPF(v, 0x124)); v = fmaxf(v, DPPF(v, 0x128));
  return fmaxf(fmaxf(RDLF(v, 0), RDLF(v, 16)), fmaxf(RDLF(v, 32), RDLF(v, 48)));
}
#endif

DI int tok_b(int n) { return n < NX_ ? n / T_ : (n - NX_) / CL_; }
DI int tok_t(int n) { return n < NX_ ? n % T_ : (n - NX_) % CL_; }
DI int tok_key(int n) { return n < NX_ ? CL_ + n % T_ : (n - NX_) % CL_; }
DI int tok_modrow(int n) { return n < NX_ ? n / T_ : 2; }

#ifdef EMU
#define SMEM_DECL(name, bytes) char* name = (char*)emu::shared_alloc(bytes)
#else
#define SMEM_DECL(name, bytes) __shared__ __attribute__((aligned(16))) char name[bytes]
#endif
#define NTHR 512
#if defined(PROBE_IDX) && !defined(EMU)
#define TSB(pp, i) { if (blockIdx.x == 0 && threadIdx.x == 0) ((long long*)((pp).ws + OFF_CNT + 2048))[i] = wall_clock64(); }
#else
#define TSB(pp, i)
#endif
struct CvtJob { const float* src; int lds; int K; bf16_t* dst; int ntn; int ntk; int maptype; const float* gain; };
DI int cvt_map(int maptype, int coff, int np) {
  if (maptype == 0) return coff + np;
  if (maptype == 1) { if (np < 672) return np; if (np < 768) return -1; if (np < 768 + 1936) return np - 96; return -1; }
  return np;
}
DI void cvt_tile(const CvtJob& j, int coff, int tk, int tn, char* smem) {
  float* tile = (float*)smem;
  const int tid = opaque_tid();
  __syncthreads();
  {
    const int kk = tid >> 3, nc = (tid & 7) * 8, k = tk * 64 + kk;
    const float g = j.gain ? j.gain[k] : 1.f;
#pragma unroll
    for (int i = 0; i < 8; ++i) {
      const int np = tn * 64 + nc + i;
      const int sc = cvt_map(j.maptype, coff, np);
      tile[kk * 65 + nc + i] = sc >= 0 ? j.src[(size_t)k * j.lds + sc] * g : 0.f;
    }
  }
  __syncthreads();
  {
    const int n = tid >> 3, kc = (tid & 7) * 8;
    int np = tn * 64 + n;
    if (j.maptype == 2) np = (np >> 5) * 64 + coff * 32 + (np & 31);
    uint4 v;
    v.x = pack2bf(tile[(kc + 0) * 65 + n], tile[(kc + 1) * 65 + n]);
    v.y = pack2bf(tile[(kc + 2) * 65 + n], tile[(kc + 3) * 65 + n]);
    v.z = pack2bf(tile[(kc + 4) * 65 + n], tile[(kc + 5) * 65 + n]);
    v.w = pack2bf(tile[(kc + 6) * 65 + n], tile[(kc + 7) * 65 + n]);
    *(uint4*)(j.dst + (size_t)np * j.K + tk * 64 + kc) = v;
  }
}

constexpr int CVT_MIX_TILES = 704 + 768 + 72 + 32 + 32 + 128 + 64 + 64 + 256 + 16;
DI void cvt_mix_item(const Params& p, int l, int it, char* smem) {
  bf16_t* W = (bf16_t*)(p.ws + OFF_WMIX + (size_t)l * WM_SIZE);
  CvtJob j; int coff = 0;
  if (it < 704) { j = {p.w_in + (size_t)l * 1024 * D_IN_, D_IN_, 1024, (bf16_t*)((char*)W + WM_WIN), 44, 16, 1, nullptr}; }
  else if ((it -= 704) < 768) { j = {p.w_in + (size_t)l * 1024 * D_IN_, D_IN_, 1024, (bf16_t*)((char*)W + WM_GATE), 48, 16, 0, nullptr}; coff = 2608; }
  else if ((it -= 768) < 72) { j = {p.w_uq + (size_t)l * 384 * 768, 768, 384, (bf16_t*)((char*)W + WM_UQ), 12, 6, 0, p.g_cq + l * 384}; }
  else if ((it -= 72) < 32) { j = {p.w_uk + (size_t)l * 256 * 512, 512, 256, (bf16_t*)((char*)W + WM_UKV), 8, 4, 0, p.g_ckv + l * 256}; }
  else if ((it -= 32) < 32) { j = {p.w_uv + (size_t)l * 256 * 512, 512, 256, (bf16_t*)((char*)W + WM_UKV) + 512 * 256, 8, 4, 0, p.g_ckv + l * 256}; }
  else if ((it -= 32) < 128) { j = {p.w_br_mla + (size_t)l * 512 * 1024, 1024, 512, (bf16_t*)((char*)W + WM_BRA), 16, 8, 0, nullptr}; }
  else if ((it -= 128) < 64) { j = {p.w_br_ml + (size_t)l * 256 * 1024, 1024, 256, (bf16_t*)((char*)W + WM_BRM), 16, 4, 0, nullptr}; }
  else if ((it -= 64) < 64) { j = {p.w_br_rw + (size_t)l * 256 * 1024, 1024, 256, (bf16_t*)((char*)W + WM_BRR), 16, 4, 0, nullptr}; }
  else if ((it -= 64) < 256) { j = {p.w_out + (size_t)l * 1024 * 1024, 1024, 1024, (bf16_t*)((char*)W + WM_OUT), 16, 16, 0, nullptr}; }
  else { it -= 256; j = {p.w_router + (size_t)l * 1024 * 64, 64, 1024, (bf16_t*)((char*)W + WM_RT), 1, 16, 0, nullptr}; }
  cvt_tile(j, coff, it / j.ntn, it % j.ntn, smem);
}
constexpr int CVT_MOE_TILES = 65 * 192;
DI void cvt_moe_item(const Params& p, int l, int it, char* smem) {
  const int e = it / 192; int r = it % 192;
  bf16_t* GU = (bf16_t*)(p.ws + OFF_REGION + R_WMOE + WE_GU) + (size_t)e * 512 * 1024;
  bf16_t* DN = (bf16_t*)(p.ws + OFF_REGION + R_WMOE + WE_DN) + (size_t)e * 1024 * 256;
  const float* sg = e < 64 ? p.w_e_gate + ((size_t)l * 64 + e) * 1024 * 256 : p.w_s_gate + (size_t)l * 1024 * 256;
  const float* su = e < 64 ? p.w_e_up + ((size_t)l * 64 + e) * 1024 * 256 : p.w_s_up + (size_t)l * 1024 * 256;
  const float* sd = e < 64 ? p.w_e_down + ((size_t)l * 64 + e) * 256 * 1024 : p.w_s_down + (size_t)l * 256 * 1024;
  CvtJob j; int coff = 0;
  if (r < 64) { j = {sg, 256, 1024, GU, 4, 16, 2, nullptr}; coff = 0; }
  else if ((r -= 64) < 64) { j = {su, 256, 1024, GU, 4, 16, 2, nullptr}; coff = 1; }
  else { r -= 64; j = {sd, 1024, 256, DN, 16, 4, 0, nullptr}; }
  cvt_tile(j, coff, r / j.ntn, r % j.ntn, smem);
}

DI void mod_item(const Params& p, int it, char* smem) {
  float* cond = (float*)smem;
  float* red = cond + 3 * 1024;
  const int tid = opaque_tid(), l = it / 96, j0 = (it % 96) * 64;
  __syncthreads();
  for (int i = tid; i < 3 * 1024; i += NTHR) {
    const int r = i >> 10, k = i & 1023;
    const float v = r < 2 ? p.c[r * 1024 + k] : p.c_ctx[k];
    cond[i] = siluf_(v);
  }
  __syncthreads();
  const int jj = tid & 63, kg = tid >> 6;
  float a0 = 0.f, a1 = 0.f, a2 = 0.f;
  const float* w = p.w_mod + (size_t)l * 1024 * 6144 + j0 + jj;
  for (int k = kg; k < 1024; k += 8) {
    const float wv = w[(size_t)k * 6144];
    a0 += cond[k] * wv; a1 += cond[1024 + k] * wv; a2 += cond[2048 + k] * wv;
  }
  red[(kg * 3 + 0) * 64 + jj] = a0; red[(kg * 3 + 1) * 64 + jj] = a1; red[(kg * 3 + 2) * 64 + jj] = a2;
  __syncthreads();
  if (tid < 192) {
    const int r = tid >> 6; float s = 0.f;
    for (int g = 0; g < 8; ++g) s += red[(g * 3 + r) * 64 + jj];
    float* mod = (float*)(p.ws + OFF_MOD);
    mod[((size_t)l * 3 + r) * 6144 + j0 + jj] = s + p.b_mod[(size_t)l * 6144 + j0 + jj];
  }
}
DI void rope_item(const Params& p, int it) {
  const int idx = it * NTHR + threadIdx.x;
  if (idx >= T_ * 16) return;
  const int t = idx >> 4, i = idx & 15, f = i & 7;
  const float pos = (float)(i < 8 ? t / GRID_W_ : t % GRID_W_);
  const float inv = powf(10000.f, -(float)(2 * f) / 16.f);
  const float ang = pos * inv;
  float2* rt = (float2*)(p.ws + OFF_ROPE);
  rt[idx] = make_float2(cosf(ang), sinf(ang));
}
constexpr int PA_ITEMS = 192 + (T_ * 16 + NTHR - 1) / NTHR + 2 * CVT_MIX_TILES;
DI void phaseA(const Params& p, char* smem) {
  if (blockIdx.x == 0) for (int i = threadIdx.x; i < 8192; i += NTHR) ((int*)(p.ws + OFF_CNT))[i] = 0;
  for (int it = blockIdx.x; it < PA_ITEMS; it += gridDim.x) {
    int i = it;
    if (i < 192) { mod_item(p, i, smem); continue; }
    i -= 192;
    constexpr int NR = (T_ * 16 + NTHR - 1) / NTHR;
    if (i < NR) { rope_item(p, i); continue; }
    i -= NR;
    cvt_mix_item(p, i / CVT_MIX_TILES, i % CVT_MIX_TILES, smem);
  }
}

DI void row_norm_mod(const float (&v)[16], const float* g, const float* shift, const float* scale, bf16_t* hrow, int lane) {
  float ss = 0.f;
#pragma unroll
  for (int i = 0; i < 16; ++i) ss += v[i] * v[i];
  ss = wave_sum(ss);
  const float rs = frsq(ss * (1.f / 1024.f) + 1e-6f);
#pragma unroll
  for (int j = 0; j < 4; ++j) {
    const int c = (j * 64 + lane) * 4;
    const float4 gg = *(const float4*)(g + c), sh = *(const float4*)(shift + c), sc = *(const float4*)(scale + c);
    const float h0 = v[j * 4 + 0] * rs * gg.x * (1.f + sc.x) + sh.x;
    const float h1 = v[j * 4 + 1] * rs * gg.y * (1.f + sc.y) + sh.y;
    const float h2 = v[j * 4 + 2] * rs * gg.z * (1.f + sc.z) + sh.z;
    const float h3 = v[j * 4 + 3] * rs * gg.w * (1.f + sc.w) + sh.w;
    uint2 o; o.x = pack2bf(h0, h1); o.y = pack2bf(h2, h3);
    *(uint2*)(hrow + c) = o;
  }
}
DI void phase_norm0(const Params& p) {
  const int lane = threadIdx.x & 63, wid = threadIdx.x >> 6;
  float* xs = (float*)(p.ws + OFF_XS);
  bf16_t* H = (bf16_t*)(p.ws + OFF_H);
  const float* mod = (const float*)(p.ws + OFF_MOD);
  for (int n = blockIdx.x * 8 + wid; n < NT_; n += gridDim.x * 8) {
    const float* src = n < NX_ ? p.x + (size_t)n * 1024 : p.ctx + (size_t)(n - NX_) * 1024;
    float v[16];
#pragma unroll
    for (int j = 0; j < 4; ++j) {
      const float4 t = *(const float4*)(src + (j * 64 + lane) * 4);
      v[j * 4] = t.x; v[j * 4 + 1] = t.y; v[j * 4 + 2] = t.z; v[j * 4 + 3] = t.w;
      *(float4*)(xs + (size_t)n * 1024 + (j * 64 + lane) * 4) = t;
    }
    const float* m = mod + (size_t)(0 * 3 + tok_modrow(n)) * 6144;
    row_norm_mod(v, p.g_mix, m, m + 1024, H + (size_t)n * 1024, lane);
  }
}

template <int BM, int BN, int BK, int WM_, int WN_>
struct Gemm {
  static constexpr int WTM = BM / WM_, WTN = BN / WN_, MB = WTM / 32, NB = WTN / 32;
  static constexpr int LDA = BK + 8;
  static constexpr int A_BYTES = BM * LDA * 2, B_BYTES = BN * LDA * 2, STAGE = A_BYTES + B_BYTES;
  static constexpr int SMEM = 2 * STAGE;
  static constexpr int CPR = BK / 8;
  static constexpr int ACH = BM * CPR / NTHR, BCH = BN * CPR / NTHR;
  static_assert(WM_ * WN_ == 8, "8 waves");
  static_assert(BM * CPR % NTHR == 0 && BN * CPR % NTHR == 0, "chunking");
  static_assert(NTHR % CPR == 0, "rows fixed per thread");

  template <class ARow>
  static DI void run(f32x16 (&acc)[MB][NB], ARow arow, const bf16_t* Bt, int ldb, int Klen, char* smem) {
    const int tid = opaque_tid(), lane = tid & 63, wid = tid >> 6, wm = wid / WN_, wn = wid % WN_;
    const int kc = (tid % CPR) * 8, r0 = tid / CPR;
    const bf16_t* ap[ACH]; const bf16_t* bp[BCH];
#pragma unroll
    for (int i = 0; i < ACH; ++i) ap[i] = arow(r0 + i * (NTHR / CPR)) + kc;
#pragma unroll
    for (int i = 0; i < BCH; ++i) bp[i] = Bt + (size_t)(r0 + i * (NTHR / CPR)) * ldb + kc;
    u32x4 ra[ACH], rb[BCH];
    const int nk = Klen / BK;
#pragma unroll
    for (int i = 0; i < ACH; ++i) ra[i] = *(const u32x4*)(ap[i]);
#pragma unroll
    for (int i = 0; i < BCH; ++i) rb[i] = *(const u32x4*)(bp[i]);
#pragma unroll
    for (int i = 0; i < ACH; ++i) *(u32x4*)(smem + ((r0 + i * (NTHR / CPR)) * LDA + kc) * 2) = ra[i];
#pragma unroll
    for (int i = 0; i < BCH; ++i) *(u32x4*)(smem + A_BYTES + ((r0 + i * (NTHR / CPR)) * LDA + kc) * 2) = rb[i];
    __syncthreads();
    for (int kt = 0; kt < nk; ++kt) {
      const int kn = (kt + 1 < nk ? kt + 1 : kt) * BK;
#pragma unroll
      for (int i = 0; i < ACH; ++i) ra[i] = *(const u32x4*)(ap[i] + kn);
#pragma unroll
      for (int i = 0; i < BCH; ++i) rb[i] = *(const u32x4*)(bp[i] + kn);
      sched_fence();
      const char* As = smem + (kt & 1) * STAGE;
      const char* Bs = As + A_BYTES;
#pragma unroll
      for (int ks = 0; ks < BK / 16; ++ks) {
        bf16x8 af[MB], bfr[NB];
#pragma unroll
        for (int mb = 0; mb < MB; ++mb)
          af[mb] = *(const bf16x8*)(As + ((wm * WTM + mb * 32 + (lane & 31)) * LDA + ks * 16 + (lane >> 5) * 8) * 2);
#pragma unroll
        for (int nb = 0; nb < NB; ++nb)
          bfr[nb] = *(const bf16x8*)(Bs + ((wn * WTN + nb * 32 + (lane & 31)) * LDA + ks * 16 + (lane >> 5) * 8) * 2);
#pragma unroll
        for (int mb = 0; mb < MB; ++mb)
#pragma unroll
          for (int nb = 0; nb < NB; ++nb) acc[mb][nb] = mfma32(af[mb], bfr[nb], acc[mb][nb]);
      }
      sched_fence();
      {
        char* Ad = smem + ((kt + 1) & 1) * STAGE;
#pragma unroll
        for (int i = 0; i < ACH; ++i) *(u32x4*)(Ad + ((r0 + i * (NTHR / CPR)) * LDA + kc) * 2) = ra[i];
#pragma unroll
        for (int i = 0; i < BCH; ++i) *(u32x4*)(Ad + A_BYTES + ((r0 + i * (NTHR / CPR)) * LDA + kc) * 2) = rb[i];
      }
      __syncthreads();
    }
  }
  static DI int row_of(int t, int mb, int reg) { const int lane = t & 63, wm = (t >> 6) / WN_; return wm * WTM + mb * 32 + crow(reg, lane >> 5); }
  static DI int col_of(int t, int nb) { const int lane = t & 63, wn = (t >> 6) % WN_; return wn * WTN + nb * 32 + (lane & 31); }
};


template <int NBW> struct WTile {
  static constexpr int LD = NBW * 32 + 4;
  static constexpr int BYTES = 32 * LD * 4;
  static DI void put(float* scr, int nb, int lane, const f32x16& v) {
    const int c = nb * 32 + (lane & 31), h = lane >> 5;
#pragma unroll
    for (int i = 0; i < 16; ++i) scr[crow(i, h) * LD + c] = v[i];
  }
  template <class F> static DI void rows4(const float* scr, int lane, F f) {
    wave_sync();
#pragma unroll
    for (int it = 0; it < NBW * 4; ++it) {
      const int id = it * 64 + lane, row = id / (NBW * 8), q = id % (NBW * 8);
      f(row, q * 4, *(const float4*)(scr + row * LD + q * 4));
    }
    wave_sync();
  }
  template <class F> static DI void rows8(const float* scr, int lane, F f) {
    wave_sync();
#pragma unroll
    for (int it = 0; it < NBW * 2; ++it) {
      const int id = it * 64 + lane, row = id / (NBW * 4), q = id % (NBW * 4);
      f(row, q * 8, *(const float4*)(scr + row * LD + q * 8), *(const float4*)(scr + row * LD + q * 8 + 4));
    }
    wave_sync();
  }
};
DI uint4 pack8bf(const float4& a, const float4& b) { return make_uint4(pack2bf(a.x, a.y), pack2bf(a.z, a.w), pack2bf(b.x, b.y), pack2bf(b.z, b.w)); }

typedef Gemm<256, 256, 64, 2, 4> G256;
DI void phase_win(const Params& p, int l, char* smem) {
  const bf16_t* H = (const bf16_t*)(p.ws + OFF_H);
  const bf16_t* W = (const bf16_t*)(p.ws + OFF_WMIX + (size_t)l * WM_SIZE + WM_WIN);
  bf16_t* zmla = (bf16_t*)(p.osc + O_ZMLA);
  float* zrec = (float*)(p.ws + OFF_REGION + R_ZREC);
  constexpr int TM = NT_ / 256, TN = WIN_N / 256;
  for (int it = vblock(); it < TM * TN; it += gridDim.x) {
    const int tid = opaque_tid();
    const int tm = it / TN, tn = it % TN;
    __syncthreads();
    f32x16 acc[G256::MB][G256::NB];
#pragma unroll
    for (int a = 0; a < G256::MB; ++a)
#pragma unroll
      for (int b = 0; b < G256::NB; ++b) acc[a][b] = zero16();
    const bf16_t* A0 = H + (size_t)tm * 256 * 1024;
    G256::run(acc, [&](int r) { return A0 + (size_t)r * 1024; }, W + (size_t)tn * 256 * 1024, 1024, 1024, smem);
    {
      const int lane = tid & 63, wid = tid >> 6, wm = wid / 4, wn = wid % 4;
      float* scr = (float*)(smem + wid * WTile<2>::BYTES);
      const int col0 = tn * 256 + wn * 64;
#pragma unroll
      for (int mb = 0; mb < G256::MB; ++mb) {
        WTile<2>::put(scr, 0, lane, acc[mb][0]); WTile<2>::put(scr, 1, lane, acc[mb][1]);
        const int row0 = tm * 256 + wm * 128 + mb * 32;
#ifdef ABL_NOSTORE
        if (tn > 1000) {
#else
        if (tn < 3) {
#endif
          WTile<2>::rows8(scr, lane, [&](int r, int c, const float4& a, const float4& bq) {
            *(uint4*)(zmla + (size_t)(row0 + r) * ZMLA_W + col0 + c) = pack8bf(a, bq); });
        } else {
          WTile<2>::rows4(scr, lane, [&](int r, int c, const float4& a) {
            const int cc = col0 - 768 + c;
#ifdef ABL_NOSTORE
            if (cc < -5) *(float4*)(zrec + (size_t)(row0 + r) * ZREC_W + cc) = a; });
#else
            if (cc < ZREC_W) *(float4*)(zrec + (size_t)(row0 + r) * ZREC_W + cc) = a; });
#endif
        }
      }
    }
  }
}
typedef Gemm<128, 128, 64, 2, 4> G128;
DI void mla_row_rs(const bf16_t* zmla_rows, int c0, int len, float* rs) {
  const int tid = opaque_tid(), row = tid >> 2, half = tid & 3;
  const bf16_t* src = zmla_rows + (size_t)row * ZMLA_W + c0 + half * (len / 4);
  float ss = 0.f;
  for (int i = 0; i < len / 4; i += 8) {
    const uint4 v = *(const uint4*)(src + i);
    const unsigned w[4] = {v.x, v.y, v.z, v.w};
#pragma unroll
    for (int j = 0; j < 4; ++j) { const float a = bf2f((bf16_t)(w[j] & 0xffff)), b = bf2f((bf16_t)(w[j] >> 16)); ss += a * a + b * b; }
  }
  ss += __shfl_xor(ss, 1); ss += __shfl_xor(ss, 2);
  if (half == 0) rs[row] = frsq(ss / (float)len + 1e-6f);
}

constexpr int MLA_Q_TILES = (NT_ / 128) * 6, MLA_KV_TILES = (NT_ / 128) * 8;
DI void mla_q_item(const Params& p, int l, int it, char* smem) {
  const int tid = opaque_tid();
  const int tm = it / 6, tn = it % 6;
  const bf16_t* zmla = (const bf16_t*)(p.osc + O_ZMLA) + (size_t)tm * 128 * ZMLA_W;
  const bf16_t* W = (const bf16_t*)(p.ws + OFF_WMIX + (size_t)l * WM_SIZE + WM_UQ) + (size_t)tn * 128 * 384;
  bf16_t* qb = (bf16_t*)(p.osc + O_QB);
  const float2* rt = (const float2*)(p.ws + OFF_ROPE);
  float* rs = (float*)(smem + G128::SMEM);
  __syncthreads();
  mla_row_rs(zmla, 0, 384, rs);
  f32x16 acc[G128::MB][G128::NB];
#pragma unroll
  for (int a = 0; a < G128::MB; ++a)
#pragma unroll
    for (int b = 0; b < G128::NB; ++b) acc[a][b] = zero16();
  G128::run(acc, [&](int r) { return zmla + (size_t)r * ZMLA_W; }, W, 384, 384, smem);
  const int lane = tid & 63;
  const bool isx = tm * 128 < NX_;
#pragma unroll
  for (int mb = 0; mb < G128::MB; ++mb)
#pragma unroll
    for (int nb = 0; nb < G128::NB; ++nb) {
      const int col = tn * 128 + G128::col_of(tid, nb);
      const bool ropeblk = ((col >> 5) % 3) == 2;
      const int e = lane & 31;
#pragma unroll
      for (int i = 0; i < 16; ++i) {
        const int lr = G128::row_of(tid, mb, i);
        const int n = tm * 128 + lr;
        float v = acc[mb][nb][i] * rs[lr];
        if (ropeblk && isx) {
          const float pv = __shfl_xor(v, 8);
          const float2 cs = rt[(size_t)(n % T_) * 16 + (e >> 4) * 8 + (e & 7)];
          v = (e & 8) ? (pv * cs.y + v * cs.x) : (v * cs.x - pv * cs.y);
        }
        qb[(size_t)n * 768 + col] = f2bf(v);
      }
    }
}
DI void mla_kv_item(const Params& p, int l, int it, char* smem) {
  const int tid = opaque_tid();
  const int tm = it / 8, tn = it % 8;
  const bf16_t* zmla = (const bf16_t*)(p.osc + O_ZMLA) + (size_t)tm * 128 * ZMLA_W;
  const bf16_t* W = (const bf16_t*)(p.ws + OFF_WMIX + (size_t)l * WM_SIZE + WM_UKV) + (size_t)tn * 128 * 256;
  bf16_t* kb = (bf16_t*)(p.ws + OFF_REGION + R_KB);
  bf16_t* vt = (bf16_t*)(p.ws + OFF_REGION + R_VT);
  const float2* rt = (const float2*)(p.ws + OFF_ROPE);
  float* rs = (float*)(smem + G128::SMEM);
  __syncthreads();
  mla_row_rs(zmla, 384, 256, rs);
  const int n0 = tm * 128;
  const int b = tok_b(n0), key0 = tok_key(n0);
  const bool isx = n0 < NX_;
  if (tn == 0) {
    for (int idx = tid; idx < 128 * 16; idx += NTHR) {
      const int lr = idx >> 4, pi = idx & 15, a = pi >> 3, i = pi & 7;
      const bf16_t* z = zmla + (size_t)lr * ZMLA_W + 640 + a * 16 + i;
      float x1 = bf2f(z[0]), x2 = bf2f(z[8]);
      if (isx) {
        const float2 cs = rt[(size_t)((n0 + lr) % T_) * 16 + a * 8 + i];
        const float y1 = x1 * cs.x - x2 * cs.y, y2 = x1 * cs.y + x2 * cs.x; x1 = y1; x2 = y2;
      }
      const bf16_t o1 = f2bf(x1), o2 = f2bf(x2);
      for (int h = 0; h < 8; ++h) {
        bf16_t* dst = kb + ((size_t)(b * 8 + h) * KT_ + key0 + lr) * 96 + 64 + a * 16 + i;
        dst[0] = o1; dst[8] = o2;
      }
    }
  }
  f32x16 acc[G128::MB][G128::NB];
#pragma unroll
  for (int a = 0; a < G128::MB; ++a)
#pragma unroll
    for (int c = 0; c < G128::NB; ++c) acc[a][c] = zero16();
  G128::run(acc, [&](int r) { return zmla + (size_t)r * ZMLA_W + 384; }, W, 256, 256, smem);
  const int lane = tid & 63;
#pragma unroll
  for (int mb = 0; mb < G128::MB; ++mb)
#pragma unroll
    for (int nb = 0; nb < G128::NB; ++nb) {
      const int col = tn * 128 + G128::col_of(tid, nb);
      if (col < 512) {
        const int h = col >> 6, d = col & 63;
#pragma unroll
        for (int i = 0; i < 16; ++i) {
          const int lr = G128::row_of(tid, mb, i);
          kb[((size_t)(b * 8 + h) * KT_ + key0 + lr) * 96 + d] = f2bf(acc[mb][nb][i] * rs[lr]);
        }
      } else {
        const int h = (col - 512) >> 6, d = col & 63;
#pragma unroll
        for (int g = 0; g < 4; ++g) {
          const int lr = G128::row_of(tid, mb, g * 4);
          uint2 o;
          o.x = pack2bf(acc[mb][nb][g * 4 + 0] * rs[lr], acc[mb][nb][g * 4 + 1] * rs[lr + 1]);
          o.y = pack2bf(acc[mb][nb][g * 4 + 2] * rs[lr + 2], acc[mb][nb][g * 4 + 3] * rs[lr + 3]);
          *(uint2*)(vt + ((size_t)(b * 8 + h) * 64 + d) * KT_ + key0 + lr) = o;
        }
      }
    }
  (void)lane;
}

DI float softplusf_(float x) { return x > 20.f ? x : log1pf(fexp(x)); }
constexpr int RWP_TT = 16;
constexpr int RWP_ITEMS = NT_ / RWP_TT;
DI void rwkv_prep_items(const Params& p, int l, char* smem) {
  if ((int)blockIdx.x >= RWP_ITEMS) return;
  float* zs = (float*)smem;
  float* tw = zs + RWP_TT * 1024;
  float* ta = tw + 2 * 64 * RWP_TT;
  const float* zrec = (const float*)(p.ws + OFF_REGION + R_ZREC);
  bf16_t* rb = (bf16_t*)(p.ws + OFF_REGION + R_RB16);
  float* lwo = (float*)(p.ws + OFF_REGION + R_LW);
  float* bso = (float*)(p.ws + OFF_REGION + R_BS);
  const float* mu = p.rw_mu + (size_t)l * 1152;
  const int tid = opaque_tid();
  const int col = tid & 255, d = tid >> 8;
  const float* w2 = p.rw_w2 + ((size_t)l * 2 + d) * 64 * 256 + col;
  const float* a2 = p.rw_a2 + ((size_t)l * 2 + d) * 64 * 256 + col;
  const float rkw = p.rw_r_k[(size_t)l * 256 + col];
  const float w0 = p.rw_w0[((size_t)l * 2 + d) * 256 + col], a0 = p.rw_a0[((size_t)l * 2 + d) * 256 + col];
  const float kkw = p.rw_k_k[(size_t)l * 256 + col], kaw = p.rw_k_a[(size_t)l * 256 + col];
  const size_t AS = (size_t)NT_ * 256;
#pragma unroll 1
  for (int it = blockIdx.x; it < RWP_ITEMS; it += gridDim.x) {
    const int n0 = it * RWP_TT;
    __syncthreads();
    TSB(p, 44);
#pragma unroll 1
    for (int i = 0; i < 8; ++i) {
      const int idx4 = tid + i * NTHR, tt = idx4 >> 8, c = (idx4 & 255) * 4, n = n0 + tt, t = tok_t(n);
      const int len = n < NX_ ? T_ : CL_;
      const float* zr = zrec + (size_t)n * ZREC_W + ZR_RW + c;
      const float4 z = *(const float4*)zr;
      const float4 zp = t > 0 ? *(const float4*)(zr - ZREC_W) : make_float4(0.f, 0.f, 0.f, 0.f);
      const float4 zn = t < len - 1 ? *(const float4*)(zr + ZREC_W) : make_float4(0.f, 0.f, 0.f, 0.f);
      const float4 m4 = *(const float4*)(mu + c);
      float4 sv;
      sv.x = z.x + (0.5f * (zp.x + zn.x) - z.x) * m4.x; sv.y = z.y + (0.5f * (zp.y + zn.y) - z.y) * m4.y;
      sv.z = z.z + (0.5f * (zp.z + zn.z) - z.z) * m4.z; sv.w = z.w + (0.5f * (zp.w + zn.w) - z.w) * m4.w;
      *(float4*)(zs + tt * 1024 + c) = sv;
      if (c >= 768) {
        const float e4[4] = {sv.x, sv.y, sv.z, sv.w};
#pragma unroll
        for (int q = 0; q < 4; ++q) {
          const int cc = c + q;
          if (cc < 896) { const int dd = (cc - 768) >> 6, k = (cc - 768) & 63; tw[(dd * 64 + k) * RWP_TT + tt] = 1.f - 2.f * frcp(1.f + fexp(2.f * e4[q])); }
          else { const int dd = (cc - 896) >> 6, k = (cc - 896) & 63; ta[(dd * 64 + k) * RWP_TT + tt] = e4[q]; }
        }
      }
    }
    __syncthreads();
    TSB(p, 45);
#pragma unroll 1
    for (int th = 0; th < RWP_TT; th += 8) {
      float aw[8], aa[8];
#pragma unroll
      for (int i = 0; i < 8; ++i) { aw[i] = 0.f; aa[i] = 0.f; }
#pragma unroll 1
      for (int kh = 0; kh < 4; ++kh) {
        float wr[16], ar[16];
#pragma unroll
        for (int k = 0; k < 16; ++k) { wr[k] = w2[(kh * 16 + k) * 256]; ar[k] = a2[(kh * 16 + k) * 256]; }
#pragma unroll
        for (int k = 0; k < 16; ++k) {
          const float* twk = tw + (d * 64 + kh * 16 + k) * RWP_TT + th;
          const float* tak = ta + (d * 64 + kh * 16 + k) * RWP_TT + th;
#pragma unroll
          for (int i = 0; i < 8; ++i) { aw[i] += twk[i] * wr[k]; aa[i] += tak[i] * ar[k]; }
          if ((k & 3) == 3) sched_fence();
        }
      }
#pragma unroll
      for (int i = 0; i < 8; ++i) {
        const int n = n0 + th + i;
        const float* zr = zs + (th + i) * 1024 + col;
        const float r = zr[0], k = zr[256], v = zr[512];
        const float kr = k * kkw;
        const float ss = wave_sum(kr * kr);
        const float kk = kr * frsq(fmaxf(ss, 1e-24f));
        const float w = -softplusf_(-(w0 + aw[i])) - 0.5f;
        const float logdecay = -fexp(w);
        const float a = sigmoidf_(a0 + aa[i]);
        const float kd = k * (1.f + (a - 1.f) * kaw);
        const float bsum = wave_sum(r * rkw * kd);
        const size_t o = (size_t)n * 256 + col;
        if (d == 0) { rb[0 * AS + o] = f2bf(r); rb[1 * AS + o] = f2bf(v); rb[2 * AS + o] = f2bf(kk); }
        lwo[d * AS + o] = logdecay;
        rb[(3 + 2 * d) * AS + o] = f2bf(kd);
        rb[(4 + 2 * d) * AS + o] = f2bf(kk * a);
        if ((tid & 63) == 0) bso[((size_t)d * NT_ + n) * 4 + (col >> 6)] = bsum;
      }
    }
    TSB(p, 47);
  }
}

DI int seq_tok(int dir, int b, int pos) {
  if (pos < CL_) return NX_ + b * CL_ + (dir ? CL_ - 1 - pos : pos);
  const int t = pos - CL_;
  return b * T_ + (dir ? T_ - 1 - t : t);
}
DI float logsigmoidf_(float x) { return -softplusf_(-x); }
DI float wave_incl_scan(float v, int lane) {
  for (int d = 1; d < 64; d <<= 1) { const float o = __shfl_up(v, d); if (lane >= d) v += o; }
  return v;
}
constexpr int ML_ST = 2112;
constexpr int ML1_ITEMS = NSEQ_ * NCH_;
DI void mlstm_local_item(const Params& p, int l, int it, char* smem) {
  const int s = it / NCH_, c = it % NCH_, dir = s >> 3, b = (s >> 2) & 1, hd = s & 3;
  float* vv = (float*)smem;
  float* kw = vv + 64 * 64;
  float* wej = kw + 64 * 32;
  const float* zrec = (const float*)(p.ws + OFF_REGION + R_ZREC);
  float* st = (float*)(p.ws + OFF_REGION + R_MLST) + ((size_t)s * NCH_ + c) * ML_ST;
  const int tid = opaque_tid(), lane = tid & 63, wid = tid >> 6;
  __syncthreads();
  if (wid == 0) {
    const int n = seq_tok(dir, b, c * 64 + lane);
    const float fp = zrec[(size_t)n * ZREC_W + ZR_MLF + dir * 4 + hd] + p.ml_b_f[(l * 2 + dir) * 4 + hd];
    const float ip = zrec[(size_t)n * ZREC_W + ZR_MLI + dir * 4 + hd] + p.ml_b_i[(l * 2 + dir) * 4 + hd];
    const float bj = wave_incl_scan(logsigmoidf_(fp), lane);
    const float bl = __shfl(bj, 63);
    const float lw = bl - bj + ip;
    const float ml = wave_max(lw);
    wej[lane] = fexp(lw - ml);
    if (lane == 0) { st[2080] = bl; st[2081] = ml; }
  }
  for (int idx = tid; idx < 64 * 64; idx += NTHR) {
    const int j = idx >> 6, e = idx & 63;
    const int n = seq_tok(dir, b, c * 64 + j);
    vv[idx] = zrec[(size_t)n * ZREC_W + ZR_MLV + hd * 64 + e];
  }
  __syncthreads();
  for (int idx = tid; idx < 64 * 32; idx += NTHR) {
    const int j = idx >> 5, e = idx & 31;
    const int n = seq_tok(dir, b, c * 64 + j);
    kw[idx] = zrec[(size_t)n * ZREC_W + ZR_MLK + hd * 32 + e] * wej[j];
  }
  __syncthreads();
  const int v = tid & 63, d0 = (tid >> 6) * 4;
  float a0 = 0.f, a1 = 0.f, a2 = 0.f, a3 = 0.f;
  for (int j = 0; j < 64; ++j) {
    const float x = vv[j * 64 + v];
    const float4 kk = *(const float4*)(kw + j * 32 + d0);
    a0 += x * kk.x; a1 += x * kk.y; a2 += x * kk.z; a3 += x * kk.w;
  }
  *(float4*)(st + v * 32 + d0) = make_float4(a0, a1, a2, a3);
  if (tid < 32) { float sn = 0.f; for (int j = 0; j < 64; ++j) sn += kw[j * 32 + tid]; st[2048 + tid] = sn; }
}
constexpr int ML2_ITEMS = (NSEQ_ * 2080 + NTHR - 1) / NTHR;
DI void mlstm_scan_item(const Params& p, int it) {
  const int g = it * NTHR + opaque_tid();
  if (g >= NSEQ_ * 2080) return;
  const int s = g / 2080, e = g % 2080;
  float* st = (float*)(p.ws + OFF_REGION + R_MLST) + (size_t)s * NCH_ * ML_ST;
  float state = 0.f, m = 0.f;
  static_assert(NCH_ % 4 == 0, "chunk count");
  for (int c0 = 0; c0 < NCH_; c0 += 4) {
    float d[4], bl[4], ml[4];
#pragma unroll
    for (int u = 0; u < 4; ++u) { const float* r = st + (size_t)(c0 + u) * ML_ST; d[u] = r[e]; bl[u] = r[2080]; ml[u] = r[2081]; }
#pragma unroll
    for (int u = 0; u < 4; ++u) {
      float* r = st + (size_t)(c0 + u) * ML_ST;
      r[e] = state;
      if (e == 0) r[2082] = m;
      const float mn = fmaxf(bl[u] + m, ml[u]);
      state = fexp(bl[u] + m - mn) * state + fexp(ml[u] - mn) * d[u];
      m = mn;
    }
  }
}

DI void phase3(const Params& p, int l, char* smem) {
  rwkv_prep_items(p, l, smem);
  for (int it = blockIdx.x; it < ML1_ITEMS; it += gridDim.x) mlstm_local_item(p, l, it, smem);
}
constexpr int RW_LD = 72, RW_MB = 64 * RW_LD * 2;
constexpr int RWC_REC = 40960;
DI char* rw_rec(const Params& p, int s, int c) { return p.ws + OFF_REGION + R_CH + ((size_t)s * NCH_ + c) * RWC_REC; }
DI f32x16 rw_mm(const char* A, const char* Bt, int mb, int nb, int lane, f32x16 acc) {
  const int r = lane & 31, h = lane >> 5;
#pragma unroll
  for (int ks = 0; ks < 4; ++ks) {
    const bf16x8 a = *(const bf16x8*)(A + ((mb * 32 + r) * RW_LD + ks * 16 + h * 8) * 2);
    const bf16x8 b = *(const bf16x8*)(Bt + ((nb * 32 + r) * RW_LD + ks * 16 + h * 8) * 2);
    acc = mfma32(a, b, acc);
  }
  return acc;
}
DI void rw_wrT(char* Dst, int mb, int nb, int lane, const f32x16& v) {
  const int r = lane & 31, h = lane >> 5;
#pragma unroll
  for (int g = 0; g < 4; ++g) {
    uint2 o; o.x = pack2bf(v[4 * g], v[4 * g + 1]); o.y = pack2bf(v[4 * g + 2], v[4 * g + 3]);
    *(uint2*)(Dst + ((nb * 32 + r) * RW_LD + mb * 32 + 8 * g + 4 * h) * 2) = o;
  }
}
DI void rw_wrT_g(bf16_t* Dst, int mb, int nb, int lane, const f32x16& v) {
  const int r = lane & 31, h = lane >> 5;
#pragma unroll
  for (int g = 0; g < 4; ++g) {
    uint2 o; o.x = pack2bf(v[4 * g], v[4 * g + 1]); o.y = pack2bf(v[4 * g + 2], v[4 * g + 3]);
    *(uint2*)(Dst + (nb * 32 + r) * 64 + mb * 32 + 8 * g + 4 * h) = o;
  }
}
DI void rw_addT(const char* Src, int mb, int nb, int lane, f32x16& v) {
  const int r = lane & 31, h = lane >> 5;
#pragma unroll
  for (int g = 0; g < 4; ++g) {
    const uint2 u = *(const uint2*)(Src + ((nb * 32 + r) * RW_LD + mb * 32 + 8 * g + 4 * h) * 2);
    v[4 * g] += bf2f((bf16_t)(u.x & 0xffff)); v[4 * g + 1] += bf2f((bf16_t)(u.x >> 16));
    v[4 * g + 2] += bf2f((bf16_t)(u.y & 0xffff)); v[4 * g + 3] += bf2f((bf16_t)(u.y >> 16));
  }
}
DI void rw_mask_upper(f32x16& v, int mb, int nb, int lane, bool strict) {
  const int col = nb * 32 + (lane & 31), h = lane >> 5;
#pragma unroll
  for (int i = 0; i < 16; ++i) { const int row = mb * 32 + crow(i, h); if (strict ? !(row < col) : !(row <= col)) v[i] = 0.f; }
}
DI void rw_mask_lower_strict(f32x16& v, int mb, int nb, int lane) {
  const int col = nb * 32 + (lane & 31), h = lane >> 5;
#pragma unroll
  for (int i = 0; i < 16; ++i) { const int row = mb * 32 + crow(i, h); if (!(col < row)) v[i] = 0.f; }
}

constexpr int RW1_ITEMS = NSEQ_ * NCH_;
DI void rw_chunk_item(const Params& p, int it, char* smem) {
  const int s = it / NCH_, c = it % NCH_, dir = s >> 3, b = (s >> 2) & 1, hd = s & 3;
  const int tid = opaque_tid(), lane = tid & 63, wid = tid >> 6;
  const bf16_t* rb = (const bf16_t*)(p.ws + OFF_REGION + R_RB16);
  const float* lwg = (const float*)(p.ws + OFF_REGION + R_LW) + (size_t)dir * NT_ * 256;
  const size_t AS = (size_t)NT_ * 256;
  char* const At = smem + 0 * RW_MB; char* const Bt_ = smem + 1 * RW_MB; char* const Kt = smem + 2 * RW_MB; char* const Rt = smem + 3 * RW_MB;
  char* const Aj = smem + 4 * RW_MB; char* const Bj = smem + 5 * RW_MB; char* const Kj = smem + 6 * RW_MB; char* const Vi = smem + 7 * RW_MB;
  char* const QA = smem + 8 * RW_MB; char* const QTA = smem + 9 * RW_MB; char* const GA = smem + 10 * RW_MB;
  char* const Mka = smem + 11 * RW_MB; char* const MbrT = smem + 12 * RW_MB; char* const MkrT = smem + 13 * RW_MB;
  char* const QB = At; char* const QTB = Bt_; char* const GB = Kt;
  float* const cs = (float*)(smem + 8 * RW_MB);
  float* const gC = (float*)(smem + 14 * RW_MB);
  char* rec = rw_rec(p, s, c);
  __syncthreads();
  const int t = tid >> 3, j8 = (tid & 7) * 8;
  const int n = seq_tok(dir, b, c * 64 + t);
  {
    const float4 l0 = *(const float4*)(lwg + (size_t)n * 256 + hd * 64 + j8), l1 = *(const float4*)(lwg + (size_t)n * 256 + hd * 64 + j8 + 4);
    float* d = cs + t * 65 + j8;
    d[0] = l0.x; d[1] = l0.y; d[2] = l0.z; d[3] = l0.w; d[4] = l1.x; d[5] = l1.y; d[6] = l1.z; d[7] = l1.w;
  }
  __syncthreads();
  if (tid < 64) { float a = 0.f; for (int tt = 0; tt < 64; ++tt) { a += cs[tt * 65 + tid]; cs[tt * 65 + tid] = a; } gC[tid] = fexp(a); }
  __syncthreads();
  {
    const size_t o = (size_t)n * 256 + hd * 64 + j8;
    const uint4 ukk = *(const uint4*)(rb + 2 * AS + o), ubb = *(const uint4*)(rb + (4 + 2 * dir) * AS + o), ukd = *(const uint4*)(rb + (3 + 2 * dir) * AS + o);
    const uint4 ur = *(const uint4*)(rb + 0 * AS + o), uv = *(const uint4*)(rb + 1 * AS + o);
    const unsigned akk[4] = {ukk.x, ukk.y, ukk.z, ukk.w}, abb[4] = {ubb.x, ubb.y, ubb.z, ubb.w}, akd[4] = {ukd.x, ukd.y, ukd.z, ukd.w};
    const unsigned ar[4] = {ur.x, ur.y, ur.z, ur.w}, av[4] = {uv.x, uv.y, uv.z, uv.w};
    unsigned oa[4], ob[4], ok[4], orr[4];
#pragma unroll
    for (int q = 0; q < 4; ++q) {
      float fa[2], fb[2], fk[2], fr[2];
#pragma unroll
      for (int e = 0; e < 2; ++e) {
        const int j = j8 + 2 * q + e;
        const float cst = cs[t * 65 + j], csp = t > 0 ? cs[(t - 1) * 65 + j] : 0.f;
        const float g = fexp(cst), gp = fexp(csp), gi = fexp(-cst);
        const int sh = 16 * e;
        fa[e] = -bf2f((bf16_t)((akk[q] >> sh) & 0xffff)) * gp;
        fb[e] = bf2f((bf16_t)((abb[q] >> sh) & 0xffff)) * gi;
        fk[e] = bf2f((bf16_t)((akd[q] >> sh) & 0xffff)) * gi;
        fr[e] = bf2f((bf16_t)((ar[q] >> sh) & 0xffff)) * g;
        *(bf16_t*)(Aj + (j * RW_LD + t) * 2) = f2bf(fa[e]);
        *(bf16_t*)(Bj + (j * RW_LD + t) * 2) = f2bf(fb[e]);
        *(bf16_t*)(Kj + (j * RW_LD + t) * 2) = f2bf(fk[e]);
        *(bf16_t*)(Vi + (j * RW_LD + t) * 2) = (bf16_t)((av[q] >> sh) & 0xffff);
      }
      oa[q] = pack2bf(fa[0], fa[1]); ob[q] = pack2bf(fb[0], fb[1]); ok[q] = pack2bf(fk[0], fk[1]); orr[q] = pack2bf(fr[0], fr[1]);
    }
    *(uint4*)(At + (t * RW_LD + j8) * 2) = make_uint4(oa[0], oa[1], oa[2], oa[3]);
    *(uint4*)(Bt_ + (t * RW_LD + j8) * 2) = make_uint4(ob[0], ob[1], ob[2], ob[3]);
    *(uint4*)(Kt + (t * RW_LD + j8) * 2) = make_uint4(ok[0], ok[1], ok[2], ok[3]);
    *(uint4*)(Rt + (t * RW_LD + j8) * 2) = make_uint4(orr[0], orr[1], orr[2], orr[3]);
  }
  __syncthreads();
  {
    const int prod = wid >> 2, mb = (wid >> 1) & 1, nb = wid & 1;
    f32x16 acc = zero16();
    if (prod == 0) {
      if (!(mb == 1 && nb == 0)) acc = rw_mm(Bt_, At, mb, nb, lane, acc);
      rw_mask_upper(acc, mb, nb, lane, true);
      rw_wrT(QA, mb, nb, lane, acc);
      if (mb == nb) {
        const int col = nb * 32 + (lane & 31), h = lane >> 5;
#pragma unroll
        for (int i = 0; i < 16; ++i) if (mb * 32 + crow(i, h) == col) acc[i] += 1.f;
      }
      rw_wrT(GA, mb, nb, lane, acc);
    } else {
      if (!(mb == 0 && nb == 1)) acc = rw_mm(At, Bt_, mb, nb, lane, acc);
      rw_mask_lower_strict(acc, mb, nb, lane);
      rw_wrT(QTA, mb, nb, lane, acc);
    }
  }
  for (int blk = wid; blk < 12; blk += 8) {
    const int prod = blk >> 2, mb = (blk >> 1) & 1, nb = blk & 1;
    f32x16 acc = zero16();
    if (prod == 0) {
      acc = rw_mm(At, Kt, mb, nb, lane, acc); rw_mask_lower_strict(acc, mb, nb, lane); rw_wrT(Mka, mb, nb, lane, acc);
    } else if (prod == 1) {
      acc = rw_mm(Bt_, Rt, mb, nb, lane, acc); rw_mask_upper(acc, mb, nb, lane, false); rw_wrT(MbrT, mb, nb, lane, acc);
    } else {
      acc = rw_mm(Kt, Rt, mb, nb, lane, acc); rw_mask_upper(acc, mb, nb, lane, false); rw_wrT(MkrT, mb, nb, lane, acc);
    }
  }
  __syncthreads();
#define RW_SQ(Q_, Qt_, Qn_, Qtn_, blk) { const int pr_ = (blk) >> 2, mb_ = ((blk) >> 1) & 1, nb_ = (blk) & 1; f32x16 acc_ = zero16(); \
    if (pr_ == 0) { acc_ = rw_mm(Q_, Qt_, mb_, nb_, lane, acc_); rw_wrT(Qtn_, mb_, nb_, lane, acc_); } \
    else { acc_ = rw_mm(Qt_, Q_, mb_, nb_, lane, acc_); rw_wrT(Qn_, mb_, nb_, lane, acc_); } }
#define RW_GUP(Qt_, G_, Gn_, blk) { const int mb_ = ((blk) >> 1) & 1, nb_ = (blk) & 1; f32x16 acc_ = zero16(); \
    rw_addT(G_, mb_, nb_, lane, acc_); acc_ = rw_mm(Qt_, G_, mb_, nb_, lane, acc_); rw_wrT(Gn_, mb_, nb_, lane, acc_); }
  RW_SQ(QA, QTA, QB, QTB, wid);
  __syncthreads();
  for (int blk = wid; blk < 12; blk += 8) { if (blk < 8) { RW_SQ(QB, QTB, QA, QTA, blk); } else { RW_GUP(QTB, GA, GB, blk - 8); } }
  __syncthreads();
  for (int blk = wid; blk < 12; blk += 8) { if (blk < 8) { RW_SQ(QA, QTA, QB, QTB, blk); } else { RW_GUP(QTA, GB, GA, blk - 8); } }
  __syncthreads();
  for (int blk = wid; blk < 12; blk += 8) { if (blk < 8) { RW_SQ(QB, QTB, QA, QTA, blk); } else { RW_GUP(QTB, GA, GB, blk - 8); } }
  __syncthreads();
  for (int blk = wid; blk < 12; blk += 8) { if (blk < 8) { RW_SQ(QA, QTA, QB, QTB, blk); } else { RW_GUP(QTA, GB, GA, blk - 8); } }
  __syncthreads();
  if (wid < 4) { RW_GUP(QTB, GA, GB, wid); }
  __syncthreads();
  {
    const int prod = wid >> 2, mb = (wid >> 1) & 1, nb = wid & 1;
    f32x16 acc = zero16();
    acc = rw_mm(GB, prod == 0 ? Mka : Aj, mb, nb, lane, acc);
    rw_wrT(prod == 0 ? QA : QTA, mb, nb, lane, acc);
  }
  __syncthreads();
  char* const X1 = QA; char* const X2 = QTA; char* const QpT = At;
  for (int blk = wid; blk < 16; blk += 8) {
    const int prod = blk >> 2, mb = (blk >> 1) & 1, nb = blk & 1;
    f32x16 acc = zero16();
    if (prod == 0) {
      rw_addT(MkrT, mb, nb, lane, acc); acc = rw_mm(X1, MbrT, mb, nb, lane, acc); rw_mask_upper(acc, mb, nb, lane, false);
      rw_wrT_g((bf16_t*)(rec + 8192), mb, nb, lane, acc);
    } else if (prod == 1) {
      rw_addT(Rt, mb, nb, lane, acc); acc = rw_mm(X2, MbrT, mb, nb, lane, acc);
      rw_wrT_g((bf16_t*)(rec), mb, nb, lane, acc);
    } else if (prod == 2) {
      acc = rw_mm(X2, Bj, mb, nb, lane, acc);
      const int col = nb * 32 + (lane & 31), h = lane >> 5; const float gc = gC[col];
#pragma unroll
      for (int i = 0; i < 16; ++i) { if (mb * 32 + crow(i, h) == col) acc[i] += 1.f; acc[i] *= gc; }
      rw_wrT_g((bf16_t*)(rec + 16384), mb, nb, lane, acc);
    } else {
      rw_addT(Kj, mb, nb, lane, acc); acc = rw_mm(X1, Bj, mb, nb, lane, acc);
      const float gc = gC[nb * 32 + (lane & 31)];
#pragma unroll
      for (int i = 0; i < 16; ++i) acc[i] *= gc;
      rw_wrT(QpT, mb, nb, lane, acc);
    }
  }
  __syncthreads();
  if (wid < 4) {
    const int mb = (wid >> 1) & 1, nb = wid & 1, r = lane & 31, h = lane >> 5;
    f32x16 acc = zero16();
    acc = rw_mm(QpT, Vi, mb, nb, lane, acc);
    float* dq = (float*)(rec + 24576);
#pragma unroll
    for (int g = 0; g < 4; ++g)
      *(float4*)(dq + (nb * 32 + r) * 64 + mb * 32 + 8 * g + 4 * h) = make_float4(acc[4 * g], acc[4 * g + 1], acc[4 * g + 2], acc[4 * g + 3]);
  }
}

constexpr int RW2_ITEMS = NSEQ_;
constexpr int RW2_DQLD = 68;
constexpr int RW2_STAGE = RW_MB + 64 * RW2_DQLD * 4;
DI void rw_state_item(const Params& p, int s, char* smem) {
  const int tid = opaque_tid(), lane = tid & 63, wid = tid >> 6, r = lane & 31, h = lane >> 5;
  f32x16 S0 = zero16(), S1 = zero16();
  uint4 rp, rd0, rd1;
  const int prow = tid >> 3, pcol = (tid & 7) * 8;
  const int drow = tid >> 3, dcol = (tid & 7) * 8;
  __syncthreads();
  {
    const char* rec = rw_rec(p, s, 0);
    rp = *(const uint4*)(rec + 16384 + (prow * 64 + pcol) * 2);
    rd0 = *(const uint4*)(rec + 24576 + (drow * 64 + dcol) * 4); rd1 = *(const uint4*)(rec + 24576 + (drow * 64 + dcol + 4) * 4);
    *(uint4*)(smem + (prow * RW_LD + pcol) * 2) = rp;
    *(uint4*)(smem + RW_MB + (drow * RW2_DQLD + dcol) * 4) = rd0; *(uint4*)(smem + RW_MB + (drow * RW2_DQLD + dcol + 4) * 4) = rd1;
  }
  __syncthreads();
  for (int c = 0; c < NCH_; ++c) {
    const bool more = c + 1 < NCH_;
    if (more) {
      const char* rec = rw_rec(p, s, c + 1);
      rp = *(const uint4*)(rec + 16384 + (prow * 64 + pcol) * 2);
      rd0 = *(const uint4*)(rec + 24576 + (drow * 64 + dcol) * 4); rd1 = *(const uint4*)(rec + 24576 + (drow * 64 + dcol + 4) * 4);
    }
    sched_fence();
    if (wid < 2) {
      const char* PT = smem + (c & 1) * RW2_STAGE;
      const float* DQ = (const float*)(PT + RW_MB);
      const int i = wid * 32 + r;
      bf16_t* sd = (bf16_t*)(rw_rec(p, s, c) + 16384);
#pragma unroll
      for (int g = 0; g < 4; ++g) {
        uint2 o0, o1;
        o0.x = pack2bf(S0[4 * g], S0[4 * g + 1]); o0.y = pack2bf(S0[4 * g + 2], S0[4 * g + 3]);
        o1.x = pack2bf(S1[4 * g], S1[4 * g + 1]); o1.y = pack2bf(S1[4 * g + 2], S1[4 * g + 3]);
        *(uint2*)(sd + i * 64 + 8 * g + 4 * h) = o0; *(uint2*)(sd + i * 64 + 32 + 8 * g + 4 * h) = o1;
      }
      bf16x8 bfr[2][2];
#pragma unroll
      for (int s2 = 0; s2 < 2; ++s2) {
        const uint4 u0 = make_uint4(pack2bf(S0[8 * s2], S0[8 * s2 + 1]), pack2bf(S0[8 * s2 + 2], S0[8 * s2 + 3]), pack2bf(S0[8 * s2 + 4], S0[8 * s2 + 5]), pack2bf(S0[8 * s2 + 6], S0[8 * s2 + 7]));
        const uint4 u1 = make_uint4(pack2bf(S1[8 * s2], S1[8 * s2 + 1]), pack2bf(S1[8 * s2 + 2], S1[8 * s2 + 3]), pack2bf(S1[8 * s2 + 4], S1[8 * s2 + 5]), pack2bf(S1[8 * s2 + 6], S1[8 * s2 + 7]));
        __builtin_memcpy(&bfr[0][s2], &u0, 16); __builtin_memcpy(&bfr[1][s2], &u1, 16);
      }
      f32x16 n0, n1;
#pragma unroll
      for (int g = 0; g < 4; ++g) {
        const float4 a = *(const float4*)(DQ + i * RW2_DQLD + 8 * g + 4 * h), bq = *(const float4*)(DQ + i * RW2_DQLD + 32 + 8 * g + 4 * h);
        n0[4 * g] = a.x; n0[4 * g + 1] = a.y; n0[4 * g + 2] = a.z; n0[4 * g + 3] = a.w;
        n1[4 * g] = bq.x; n1[4 * g + 1] = bq.y; n1[4 * g + 2] = bq.z; n1[4 * g + 3] = bq.w;
      }
#pragma unroll
      for (int jb2 = 0; jb2 < 2; ++jb2)
#pragma unroll
        for (int s2 = 0; s2 < 2; ++s2) {
          const char* a0 = PT + ((0 * 32 + r) * RW_LD + jb2 * 32 + 16 * s2 + 4 * h) * 2;
          const char* a1 = PT + ((1 * 32 + r) * RW_LD + jb2 * 32 + 16 * s2 + 4 * h) * 2;
          const uint2 l0 = *(const uint2*)a0, h0 = *(const uint2*)(a0 + 16), l1 = *(const uint2*)a1, h1 = *(const uint2*)(a1 + 16);
          const uint4 u0 = make_uint4(l0.x, l0.y, h0.x, h0.y), u1 = make_uint4(l1.x, l1.y, h1.x, h1.y);
          bf16x8 af0, af1; __builtin_memcpy(&af0, &u0, 16); __builtin_memcpy(&af1, &u1, 16);
          n0 = mfma32(af0, bfr[jb2][s2], n0);
          n1 = mfma32(af1, bfr[jb2][s2], n1);
        }
      S0 = n0; S1 = n1;
    }
    if (more) {
      char* d = smem + ((c + 1) & 1) * RW2_STAGE;
      *(uint4*)(d + (prow * RW_LD + pcol) * 2) = rp;
      *(uint4*)(d + RW_MB + (drow * RW2_DQLD + dcol) * 4) = rd0; *(uint4*)(d + RW_MB + (drow * RW2_DQLD + dcol + 4) * 4) = rd1;
    }
    __syncthreads();
  }
}

DI void rw_out_item(const Params& p, int it, char* smem) {
  const int s = it / NCH_, c = it % NCH_, dir = s >> 3, b = (s >> 2) & 1, hd = s & 3;
  const int tid = opaque_tid(), lane = tid & 63, wid = tid >> 6;
  const bf16_t* rb = (const bf16_t*)(p.ws + OFF_REGION + R_RB16);
  const size_t AS = (size_t)NT_ * 256;
  float* ys = (float*)(p.ws + OFF_REGION + R_YS) + (size_t)dir * NT_ * 256;
  char* const Sm = smem; char* const RyT = smem + RW_MB; char* const MyT = smem + 2 * RW_MB; char* const Vi = smem + 3 * RW_MB;
  const char* rec = rw_rec(p, s, c);
  __syncthreads();
  {
    const int row = tid >> 3, col = (tid & 7) * 8;
    *(uint4*)(Sm + (row * RW_LD + col) * 2) = *(const uint4*)(rec + 16384 + (row * 64 + col) * 2);
    *(uint4*)(RyT + (row * RW_LD + col) * 2) = *(const uint4*)(rec + (row * 64 + col) * 2);
    *(uint4*)(MyT + (row * RW_LD + col) * 2) = *(const uint4*)(rec + 8192 + (row * 64 + col) * 2);
    const int n = seq_tok(dir, b, c * 64 + row);
    const uint4 uv = *(const uint4*)(rb + 1 * AS + (size_t)n * 256 + hd * 64 + col);
    const unsigned av[4] = {uv.x, uv.y, uv.z, uv.w};
#pragma unroll
    for (int q = 0; q < 4; ++q) {
      *(bf16_t*)(Vi + ((col + 2 * q) * RW_LD + row) * 2) = (bf16_t)(av[q] & 0xffff);
      *(bf16_t*)(Vi + ((col + 2 * q + 1) * RW_LD + row) * 2) = (bf16_t)(av[q] >> 16);
    }
  }
  __syncthreads();
  if (wid < 4) {
    const int mb = (wid >> 1) & 1, nb = wid & 1, r = lane & 31, h = lane >> 5;
    f32x16 acc = zero16();
    acc = rw_mm(Sm, RyT, mb, nb, lane, acc);
    acc = rw_mm(Vi, MyT, mb, nb, lane, acc);
    const int n = seq_tok(dir, b, c * 64 + nb * 32 + r);
#pragma unroll
    for (int g = 0; g < 4; ++g)
      *(float4*)(ys + (size_t)n * 256 + hd * 64 + mb * 32 + 8 * g + 4 * h) = make_float4(acc[4 * g], acc[4 * g + 1], acc[4 * g + 2], acc[4 * g + 3]);
  }
}
constexpr int ATT_KLD = 104, ATT_VLD = 68;
constexpr int ATT_KB = 64 * ATT_KLD * 2, ATT_VB = 64 * ATT_VLD * 2, ATT_STAGE = ATT_KB + ATT_VB;
DI float fexp2(float x) {
#ifdef EMU
  return exp2f(x);
#else
  return __builtin_amdgcn_exp2f(x);
#endif
}
DI void attn_item(const Params& p, int b, int h, int qt, bool isctx, char* smem) {
  const int tid = opaque_tid(), lane = tid & 63, wid = tid >> 6, r = lane & 31, h2 = lane >> 5;
  const bf16_t* qb = (const bf16_t*)(p.osc + O_QB);
  const bf16_t* kbase = (const bf16_t*)(p.ws + OFF_REGION + R_KB) + (size_t)(b * 8 + h) * KT_ * 96;
  const bf16_t* vbase = (const bf16_t*)(p.ws + OFF_REGION + R_VT) + (size_t)(b * 8 + h) * 64 * KT_;
  bf16_t* att = (bf16_t*)(p.ws + OFF_REGION + R_ATT);
  const int nq0 = isctx ? NX_ + b * CL_ + qt * 256 : b * T_ + qt * 256;
  const int nkt = (isctx ? CL_ : KT_) / 64;
  const int nq = nq0 + wid * 32 + r;
  bf16x8 qf[6];
#pragma unroll
  for (int ks = 0; ks < 6; ++ks) qf[ks] = *(const bf16x8*)(qb + (size_t)nq * 768 + h * 96 + ks * 16 + h2 * 8);
  f32x16 oacc[2] = {zero16(), zero16()};
  float m = -1e30f, lsum = 0.f;
  const float sc = 0.10206207261596577f * 1.4426950408889634f;
  const int kc1 = tid + 512;
  const int vd = tid >> 3, vc = tid & 7;
  uint4 rk0, rk1, rv;
  auto gload = [&](int kt) {
    const bf16_t* ksrc = kbase + (size_t)kt * 64 * 96;
    rk0 = *(const uint4*)(ksrc + tid * 8);
    if (kc1 < 768) rk1 = *(const uint4*)(ksrc + kc1 * 8);
    rv = *(const uint4*)(vbase + (size_t)vd * KT_ + kt * 64 + vc * 8);
  };
  auto sstore = [&](int buf) {
    char* Ks = smem + buf * ATT_STAGE; char* Vs = Ks + ATT_KB;
    *(uint4*)(Ks + ((tid / 12) * ATT_KLD + (tid % 12) * 8) * 2) = rk0;
    if (kc1 < 768) *(uint4*)(Ks + ((kc1 / 12) * ATT_KLD + (kc1 % 12) * 8) * 2) = rk1;
    *(uint2*)(Vs + (vd * ATT_VLD + vc * 8) * 2) = make_uint2(rv.x, rv.y);
    *(uint2*)(Vs + (vd * ATT_VLD + vc * 8 + 4) * 2) = make_uint2(rv.z, rv.w);
  };
  __syncthreads();
  gload(0); sstore(0);
  __syncthreads();
  for (int kt = 0; kt < nkt; ++kt) {
    const bool more = kt + 1 < nkt;
    if (more) gload(kt + 1);
    sched_fence();
    const char* Ks = smem + (kt & 1) * ATT_STAGE; const char* Vs = Ks + ATT_KB;
    f32x16 sacc[2] = {zero16(), zero16()};
#pragma unroll
    for (int ks = 0; ks < 6; ++ks)
#pragma unroll
      for (int kb = 0; kb < 2; ++kb) {
        const bf16x8 kf = *(const bf16x8*)(Ks + ((kb * 32 + r) * ATT_KLD + ks * 16 + h2 * 8) * 2);
        sacc[kb] = mfma32(kf, qf[ks], sacc[kb]);
      }
    float mx = -1e30f;
#pragma unroll
    for (int kb = 0; kb < 2; ++kb)
#pragma unroll
      for (int i = 0; i < 16; ++i) mx = fmaxf(mx, sacc[kb][i]);
    mx = fmaxf(mx, __shfl_xor(mx, 32));
    const float mn = fmaxf(m, mx * sc);
    const float alpha = fexp2(m - mn);
    m = mn;
    float ps = 0.f;
#pragma unroll
    for (int kb = 0; kb < 2; ++kb)
#pragma unroll
      for (int i = 0; i < 16; ++i) { const float pv = fexp2(sacc[kb][i] * sc - mn); sacc[kb][i] = pv; ps += pv; }
    lsum = lsum * alpha + ps;
#pragma unroll
    for (int db = 0; db < 2; ++db)
#pragma unroll
      for (int i = 0; i < 16; ++i) oacc[db][i] *= alpha;
#pragma unroll
    for (int kb = 0; kb < 2; ++kb)
#pragma unroll
      for (int s = 0; s < 2; ++s) {
        bf16x8 pf;
        {
          const unsigned u0 = pack2bf(sacc[kb][8 * s + 0], sacc[kb][8 * s + 1]), u1 = pack2bf(sacc[kb][8 * s + 2], sacc[kb][8 * s + 3]);
          const unsigned u2 = pack2bf(sacc[kb][8 * s + 4], sacc[kb][8 * s + 5]), u3 = pack2bf(sacc[kb][8 * s + 6], sacc[kb][8 * s + 7]);
          const uint4 u = make_uint4(u0, u1, u2, u3);
          __builtin_memcpy(&pf, &u, 16);
        }
#pragma unroll
        for (int db = 0; db < 2; ++db) {
          const char* vrow = Vs + ((db * 32 + r) * ATT_VLD + kb * 32 + 16 * s + 4 * h2) * 2;
          const uint2 lo = *(const uint2*)(vrow), hi = *(const uint2*)(vrow + 16);
          const uint4 u = make_uint4(lo.x, lo.y, hi.x, hi.y);
          bf16x8 vf; __builtin_memcpy(&vf, &u, 16);
          oacc[db] = mfma32(vf, pf, oacc[db]);
        }
      }
    sched_fence();
    if (more) sstore((kt + 1) & 1);
    __syncthreads();
  }
  lsum += __shfl_xor(lsum, 32);
  const float inv = 1.f / lsum;
#pragma unroll
  for (int db = 0; db < 2; ++db)
#pragma unroll
    for (int g = 0; g < 4; ++g) {
      uint2 o;
      o.x = pack2bf(oacc[db][g * 4 + 0] * inv, oacc[db][g * 4 + 1] * inv);
      o.y = pack2bf(oacc[db][g * 4 + 2] * inv, oacc[db][g * 4 + 3] * inv);
      *(uint2*)(att + (size_t)nq * 512 + h * 64 + db * 32 + 8 * g + 4 * h2) = o;
    }
}

constexpr int P3B_ITEMS = RW1_ITEMS + ML2_ITEMS + MLA_Q_TILES + MLA_KV_TILES;
DI void phase3b(const Params& p, int l, char* smem) {
  for (int it = vblock(); it < P3B_ITEMS; it += gridDim.x) {
    int i = it;
    if (i < RW1_ITEMS) { rw_chunk_item(p, i, smem); continue; }
    i -= RW1_ITEMS;
    if (i < ML2_ITEMS) { mlstm_scan_item(p, i); continue; }
    i -= ML2_ITEMS;
    if (i < MLA_Q_TILES) mla_q_item(p, l, i, smem); else mla_kv_item(p, l, i - MLA_Q_TILES, smem);
  }
}

DI constexpr int att_items(int l) { return NB_ * 8 * (T_ / 256) + (l == 0 ? NB_ * 8 * (CL_ / 256) : 0); }
DI void spin_until_ge(int* ctr, int target) {
#ifdef EMU
  while (__atomic_load_n(ctr, __ATOMIC_SEQ_CST) < target) emu::yield();
#else
  while (__hip_atomic_load(ctr, __ATOMIC_RELAXED, __HIP_MEMORY_SCOPE_AGENT) < target) __builtin_amdgcn_s_sleep(8);
#endif
}
DI void phase4(const Params& p, int l, char* smem, int* ctr) {
  const int G = gridDim.x, nsb = G >= 2 * RW2_ITEMS ? RW2_ITEMS : (G > 1 ? G / 2 : 1);
  if ((int)blockIdx.x < nsb) {
    for (int s = blockIdx.x; s < RW2_ITEMS; s += nsb) rw_state_item(p, s, smem);
#ifndef EMU
    asm volatile("s_waitcnt vmcnt(0)" ::: "memory");
#endif
    __syncthreads();
    if (opaque_tid() == 0) { __threadfence(); atomicAdd(ctr + 2, (RW2_ITEMS - (int)blockIdx.x + nsb - 1) / nsb); }
  }
  const int QT = T_ / 256, CQ = (l == 0 ? (NB_ * 8 * (CL_ / 256)) / 8 : 0), R3 = RW1_ITEMS / 8;
  const int per = 2 * QT + CQ + R3;
  int* sitem = (int*)(smem + 160 * 1024 - 16);
  bool r2ok = false;
  const int x0 = xcc_id();
  for (;;) {
    __syncthreads();
    if (opaque_tid() == 0) {
      int item = -1;
      for (int k = 0; k < 8 && item < 0; ++k) {
        const int x = (x0 + k) & 7;
        if (ld_relaxed(ctr + 8 + x) >= per) continue;
        const int li = atomicAdd(ctr + 8 + x, 1);
        if (li < per) item = x * per + li;
      }
      *sitem = item;
    }
    __syncthreads();
    const int item = *sitem;
    if (item < 0) break;
    const int x = item / per; int li = item % per;
    if (li < 2 * QT) { const int bh = 2 * x + li / QT, qt = li % QT; attn_item(p, bh >> 3, bh & 7, qt, false, smem); continue; }
    li -= 2 * QT;
    if (li < CQ) { const int ci = x * CQ + li, qt = ci % (CL_ / 256), bh = ci / (CL_ / 256); attn_item(p, bh >> 3, bh & 7, qt, true, smem); continue; }
    li -= CQ;
    if (!r2ok) {
      if (opaque_tid() == 0) { spin_until_ge(ctr + 2, RW2_ITEMS); __threadfence(); }
      __syncthreads();
      r2ok = true;
    }
    rw_out_item(p, x * R3 + li, smem);
  }
}
constexpr int ML3_CC = CL_ / 64, ML3_XC = T_ / 64;
DI constexpr int ml3_items(bool with_ctx) { return NB_ * 4 * (ML3_XC + (with_ctx ? ML3_CC : 0)); }
DI void mlstm_out_item(const Params& p, int l, int it, bool with_ctx, char* smem) {
  const int per = ML3_XC + (with_ctx ? ML3_CC : 0);
  const int bh = it / per, b = bh >> 2, hd = bh & 3;
  int tc = it % per; if (!with_ctx) tc += ML3_CC;
  const bool isctx = tc < ML3_CC;
  const int ntok0 = isctx ? NX_ + b * CL_ + tc * 64 : b * T_ + (tc - ML3_CC) * 64;
  float* qs = (float*)smem;
  float* ks = qs + 64 * 33;
  float* vs = ks + 64 * 33;
  float* Cs = vs + 64 * 64;
  float* Sm = Cs + 64 * 33;
  float* hs = Sm + 64 * 65;
  float* bj = hs + 64 * 64;
  float* ip = bj + 64;
  float* ns = ip + 64;
  const float* zrec = (const float*)(p.ws + OFF_REGION + R_ZREC);
  const int tid = opaque_tid(), lane = tid & 63, wid = tid >> 6;
  __syncthreads();
  for (int idx = tid; idx < 64 * 64; idx += NTHR) hs[idx] = 0.f;
  for (int dir = 0; dir < 2; ++dir) {
    const int c = dir == 0 ? tc : (isctx ? ML3_CC - 1 - tc : ML3_CC + (ML3_XC - 1 - (tc - ML3_CC)));
    const int s = dir * 8 + b * 4 + hd;
    const float* st = (const float*)(p.ws + OFF_REGION + R_MLST) + ((size_t)s * NCH_ + c) * ML_ST;
    const float m_start = st[2082];
    __syncthreads();
    for (int idx = tid; idx < 64 * 32; idx += NTHR) {
      const int j = idx >> 5, e = idx & 31;
      const int n = ntok0 + (dir ? 63 - j : j);
      qs[j * 33 + e] = zrec[(size_t)n * ZREC_W + ZR_MLQ + hd * 32 + e] * 0.17677669529663687f;
      ks[j * 33 + e] = zrec[(size_t)n * ZREC_W + ZR_MLK + hd * 32 + e];
      Cs[j * 33 + e] = st[j * 32 + e];
    }
    for (int idx = tid; idx < 64 * 64; idx += NTHR) {
      const int j = idx >> 6, e = idx & 63;
      const int n = ntok0 + (dir ? 63 - j : j);
      vs[idx] = zrec[(size_t)n * ZREC_W + ZR_MLV + hd * 64 + e];
    }
    if (tid < 32) ns[tid] = st[2048 + tid];
    if (wid == 1) {
      const int n = ntok0 + (dir ? 63 - lane : lane);
      const float fp = zrec[(size_t)n * ZREC_W + ZR_MLF + dir * 4 + hd] + p.ml_b_f[(l * 2 + dir) * 4 + hd];
      ip[lane] = zrec[(size_t)n * ZREC_W + ZR_MLI + dir * 4 + hd] + p.ml_b_i[(l * 2 + dir) * 4 + hd];
      bj[lane] = wave_incl_scan(logsigmoidf_(fp), lane);
    }
    __syncthreads();
    const int j = tid >> 3, sg = tid & 7;
    const float bjj = bj[j];
    float rmax = -1e30f;
#pragma unroll 1
    for (int u = 0; u < 8; ++u) {
      const int sI = sg * 8 + u;
      float d = 0.f;
#pragma unroll 8
      for (int e = 0; e < 32; ++e) d += qs[j * 33 + e] * ks[sI * 33 + e];
      Sm[j * 65 + sI] = d;
      const float dl = sI <= j ? bjj - bj[sI] + ip[sI] : -1e30f;
      rmax = fmaxf(rmax, dl);
    }
    rmax = fmaxf(rmax, __shfl_xor(rmax, 1)); rmax = fmaxf(rmax, __shfl_xor(rmax, 2)); rmax = fmaxf(rmax, __shfl_xor(rmax, 4));
    const float g = bjj + m_start;
    const float mj = fmaxf(g, rmax);
    const float inter = fexp(g - mj);
    float part = 0.f;
#pragma unroll 1
    for (int u = 0; u < 8; ++u) {
      const int sI = sg * 8 + u;
      const float sv = sI <= j ? fexp(bjj - bj[sI] + ip[sI] - mj) * Sm[j * 65 + sI] : 0.f;
      Sm[j * 65 + sI] = sv; part += sv;
    }
    float nq = 0.f;
#pragma unroll
    for (int e = 0; e < 4; ++e) nq += ns[sg * 4 + e] * qs[j * 33 + sg * 4 + e];
    part += inter * nq;
    part += __shfl_xor(part, 1); part += __shfl_xor(part, 2); part += __shfl_xor(part, 4);
    const float den = fmaxf(fabsf(part), fexp(-mj));
    __syncthreads();
    const int v0 = sg * 8;
    float num[8], cq[8];
#pragma unroll
    for (int u = 0; u < 8; ++u) { num[u] = 0.f; cq[u] = 0.f; }
#pragma unroll 2
    for (int sI = 0; sI <= j; ++sI) {
      const float sv = Sm[j * 65 + sI];
      const float4 va = *(const float4*)(vs + sI * 64 + v0), vb = *(const float4*)(vs + sI * 64 + v0 + 4);
      num[0] += sv * va.x; num[1] += sv * va.y; num[2] += sv * va.z; num[3] += sv * va.w;
      num[4] += sv * vb.x; num[5] += sv * vb.y; num[6] += sv * vb.z; num[7] += sv * vb.w;
    }
#pragma unroll 2
    for (int e = 0; e < 32; ++e) {
      const float qv = qs[j * 33 + e];
#pragma unroll
      for (int u = 0; u < 8; ++u) cq[u] += Cs[(v0 + u) * 33 + e] * qv;
    }
    const float rden = 1.f / den;
#pragma unroll
    for (int u = 0; u < 8; ++u) hs[(dir ? 63 - j : j) * 64 + v0 + u] += (num[u] + inter * cq[u]) * rden;
    __syncthreads();
  }
  const int tk = tid >> 3, v0 = (tid & 7) * 8, n = ntok0 + tk;
  float ss = 0.f; float hv[8];
#pragma unroll
  for (int u = 0; u < 8; ++u) { hv[u] = hs[tk * 64 + v0 + u]; ss += hv[u] * hv[u]; }
  ss += __shfl_xor(ss, 1); ss += __shfl_xor(ss, 2); ss += __shfl_xor(ss, 4);
  const float rs = frsq(ss * (1.f / 64.f) + 1e-6f);
  unsigned o[4];
#pragma unroll
  for (int u = 0; u < 8; u += 2) {
    const int cc = hd * 64 + v0 + u;
    const float a = hv[u] * rs * p.ml_g_norm[l * 256 + cc] * sigmoidf_(zrec[(size_t)n * ZREC_W + ZR_MLO + cc]);
    const float bq = hv[u + 1] * rs * p.ml_g_norm[l * 256 + cc + 1] * sigmoidf_(zrec[(size_t)n * ZREC_W + ZR_MLO + cc + 1]);
    o[u >> 1] = pack2bf(a, bq);
  }
  bf16_t* mlo = (bf16_t*)(p.ws + OFF_REGION + R_MLO);
  *(uint4*)(mlo + (size_t)n * 256 + hd * 64 + v0) = make_uint4(o[0], o[1], o[2], o[3]);
}

DI constexpr int rwo_items(bool with_ctx) { return (with_ctx ? NT_ : NX_) / 16; }
DI void rwkv_out_item(const Params& p, int l, int it, char* smem) {
  float* sg = (float*)smem;
  const float* zrec = (const float*)(p.ws + OFF_REGION + R_ZREC);
  const bf16_t* rb = (const bf16_t*)(p.ws + OFF_REGION + R_RB16);
  const float* bso = (const float*)(p.ws + OFF_REGION + R_BS);
  const float* ys = (const float*)(p.ws + OFF_REGION + R_YS);
  bf16_t* rwo = (bf16_t*)(p.ws + OFF_REGION + R_RWO);
  const float* mu = p.rw_mu + (size_t)l * 1152;
  const int tid = opaque_tid(), n0 = it * 16;
  __syncthreads();
  for (int idx = tid; idx < 16 * 128; idx += NTHR) {
    const int tt = idx >> 7, k = idx & 127, n = n0 + tt, t = tok_t(n), c = 1024 + k;
    const int len = n < NX_ ? T_ : CL_;
    const float* zr = zrec + (size_t)n * ZREC_W + ZR_RW + c;
    const float z = zr[0];
    const float zp = t > 0 ? zr[-ZREC_W] : 0.f, zn = t < len - 1 ? zr[ZREC_W] : 0.f;
    sg[k * 16 + tt] = sigmoidf_(z + (0.5f * (zp + zn) - z) * mu[c]);
  }
  __syncthreads();
  const int col = tid & 255, half = tid >> 8;
  float acc[8];
#pragma unroll
  for (int i = 0; i < 8; ++i) acc[i] = 0.f;
  const float* g2 = p.rw_g2 + (size_t)l * 128 * 256 + col;
  for (int k = 0; k < 128; ++k) {
    const float gv = g2[k * 256];
    const float* sk = sg + k * 16 + half * 8;
#pragma unroll
    for (int i = 0; i < 8; ++i) acc[i] += sk[i] * gv;
  }
  const size_t AS = (size_t)NT_ * 256;
  const float lw = p.rw_lnx_w[(size_t)l * 256 + col], lb = p.rw_lnx_b[(size_t)l * 256 + col];
#pragma unroll
  for (int i = 0; i < 8; ++i) {
    const int n = n0 + half * 8 + i;
    const size_t o = (size_t)n * 256 + col;
    const float y = ys[o] + ys[AS + o];
    const float mean = wave_sum(y) * (1.f / 64.f);
    const float dv = y - mean;
    const float var = wave_sum(dv * dv) * (1.f / 64.f);
    const float yn = dv * (frsq(var + 64e-5f)) * lw + lb;
    const float v = bf2f(rb[1 * AS + o]);
    const float bsum = bso[(size_t)n * 4 + (col >> 6)] + bso[((size_t)NT_ + n) * 4 + (col >> 6)];
    rwo[o] = f2bf((yn + bsum * v) * acc[i]);
  }
}
DI void phase5(const Params& p, int l, bool with_ctx, char* smem) {
  const int n1 = ml3_items(with_ctx), n2 = rwo_items(with_ctx);
  for (int it = blockIdx.x; it < n1 + n2; it += gridDim.x) {
    if (it < n1) mlstm_out_item(p, l, it, with_ctx, smem);
    else rwkv_out_item(p, l, it - n1, smem);
  }
}
DI void phase_merge(const Params& p, int l, bool with_ctx, char* smem) {
  const bf16_t* H = (const bf16_t*)(p.ws + OFF_H);
  const char* W = p.ws + OFF_WMIX + (size_t)l * WM_SIZE;
  const bf16_t* Wg = (const bf16_t*)(W + WM_GATE);
  const bf16_t* att = (const bf16_t*)(p.ws + OFF_REGION + R_ATT);
  const bf16_t* mlo = (const bf16_t*)(p.ws + OFF_REGION + R_MLO);
  const bf16_t* rwo = (const bf16_t*)(p.ws + OFF_REGION + R_RWO);
  bf16_t* ymix = (bf16_t*)(p.osc + O_YMIX);
  const int TM = (with_ctx ? NT_ : NX_) / 128;
  for (int it = vblock(); it < TM * 8; it += gridDim.x) {
    const int tid = opaque_tid();
    const int tm = it >> 3, tn = it & 7;
    __syncthreads();
    f32x16 yacc[G128::MB][G128::NB];
#pragma unroll
    for (int a = 0; a < G128::MB; ++a)
#pragma unroll
      for (int b = 0; b < G128::NB; ++b) yacc[a][b] = zero16();
#pragma unroll
    for (int i = 0; i < 3; ++i) {
      f32x16 gacc[G128::MB][G128::NB], bacc[G128::MB][G128::NB];
#pragma unroll
      for (int a = 0; a < G128::MB; ++a)
#pragma unroll
        for (int b = 0; b < G128::NB; ++b) { gacc[a][b] = zero16(); bacc[a][b] = zero16(); }
      const bf16_t* A0 = H + (size_t)tm * 128 * 1024;
      G128::run(gacc, [&](int r) { return A0 + (size_t)r * 1024; }, Wg + ((size_t)i * 1024 + tn * 128) * 1024, 1024, 1024, smem);
      const bf16_t* br = i == 0 ? att : (i == 1 ? mlo : rwo);
      const int kb = i == 0 ? 512 : 256;
      const bf16_t* Wb = (const bf16_t*)(W + (i == 0 ? WM_BRA : (i == 1 ? WM_BRM : WM_BRR)));
      const bf16_t* B0 = br + (size_t)tm * 128 * kb;
      G128::run(bacc, [&](int r) { return B0 + (size_t)r * kb; }, Wb + (size_t)tn * 128 * kb, kb, kb, smem);
#pragma unroll
      for (int a = 0; a < G128::MB; ++a)
#pragma unroll
        for (int b = 0; b < G128::NB; ++b)
#pragma unroll
          for (int e = 0; e < 16; ++e) yacc[a][b][e] += sigmoidf_(gacc[a][b][e]) * bacc[a][b][e];
    }
    {
      const int lane = tid & 63, wid = tid >> 6, wm = wid / 4, wn = wid % 4;
      float* scr = (float*)(smem + wid * WTile<1>::BYTES);
#pragma unroll
      for (int mb = 0; mb < G128::MB; ++mb) {
        WTile<1>::put(scr, 0, lane, yacc[mb][0]);
        const int row0 = tm * 128 + wm * 64 + mb * 32, col0 = tn * 128 + wn * 32;
        WTile<1>::rows8(scr, lane, [&](int r, int c, const float4& a, const float4& bq) {
          *(uint4*)(ymix + (size_t)(row0 + r) * 1024 + col0 + c) = pack8bf(a, bq); });
      }
    }
  }
}

DI void phase_wout(const Params& p, int l, bool with_ctx, char* smem) {
  const bf16_t* ymix = (const bf16_t*)(p.osc + O_YMIX);
  const bf16_t* Wo = (const bf16_t*)(p.ws + OFF_WMIX + (size_t)l * WM_SIZE + WM_OUT);
  float* xs = (float*)(p.ws + OFF_XS);
  const float* mod = (const float*)(p.ws + OFF_MOD) + (size_t)l * 3 * 6144;
  const int TM = (with_ctx ? NT_ : NX_) / 128;
  const int n_g = TM * 8;
  for (int it = vblock(); it < n_g + CVT_MOE_TILES; it += gridDim.x) {
    if (it >= n_g) { cvt_moe_item(p, l, it - n_g, smem); continue; }
    const int tid = opaque_tid();
    const int tm = it >> 3, tn = it & 7;
    __syncthreads();
    f32x16 acc[G128::MB][G128::NB];
#pragma unroll
    for (int a = 0; a < G128::MB; ++a)
#pragma unroll
      for (int b = 0; b < G128::NB; ++b) acc[a][b] = zero16();
    const bf16_t* A0 = ymix + (size_t)tm * 128 * 1024;
    G128::run(acc, [&](int r) { return A0 + (size_t)r * 1024; }, Wo + (size_t)tn * 128 * 1024, 1024, 1024, smem);
    const float* m2 = mod + (size_t)tok_modrow(tm * 128) * 6144 + 2 * 1024;
    {
      const int lane = tid & 63, wid = tid >> 6, wm = wid / 4, wn = wid % 4;
      float* scr = (float*)(smem + wid * WTile<1>::BYTES);
#pragma unroll
      for (int mb = 0; mb < G128::MB; ++mb) {
        WTile<1>::put(scr, 0, lane, acc[mb][0]);
        const int row0 = tm * 128 + wm * 64 + mb * 32, col0 = tn * 128 + wn * 32;
        WTile<1>::rows4(scr, lane, [&](int r, int c, const float4& a) {
          float4* d = (float4*)(xs + (size_t)(row0 + r) * 1024 + col0 + c);
          const float4 g = *(const float4*)(m2 + col0 + c); float4 x = *d;
          x.x += g.x * a.x; x.y += g.y * a.y; x.z += g.z * a.z; x.w += g.w * a.w; *d = x; });
      }
    }
  }
}

typedef Gemm<128, 64, 64, 4, 2> GRT;
DI void phase_router(const Params& p, int l, bool with_ctx, char* smem, int* cnt) {
  float* xs = (float*)(p.ws + OFF_XS);
  bf16_t* H = (bf16_t*)(p.ws + OFF_H);
  const float* mod = (const float*)(p.ws + OFF_MOD) + (size_t)l * 3 * 6144;
  const bf16_t* Wr = (const bf16_t*)(p.ws + OFF_WMIX + (size_t)l * WM_SIZE + WM_RT);
  int* eidx = (int*)(p.ws + OFF_REGION + R_EIDX);
  float* ewt = (float*)(p.ws + OFF_REGION + R_EWT);
  int* erank = (int*)(p.ws + OFF_REGION + R_ERANK);
  int* elist = (int*)(p.ws + OFF_REGION + R_ELIST);
  float* sc = (float*)(smem + GRT::SMEM);
  float* bs = sc + 128 * 65;
  float* gs = bs + 128 * 65;
  int* lcnt = (int*)(gs + 128 * 9);
  int* lbase = lcnt + 64;
  const int tid = opaque_tid(), lane = tid & 63, wid = tid >> 6;
  const int ntok = with_ctx ? NT_ : NX_;
  for (int it = blockIdx.x; it < ntok / 128; it += gridDim.x) {
    const int n0 = it * 128;
    __syncthreads();
    TSB(p, 40);
    if (tid < 64) lcnt[tid] = 0;
#pragma unroll 1
    for (int r4 = 0; r4 < 16; r4 += 4) {
      float v[4][16];
#pragma unroll
      for (int u = 0; u < 4; ++u) {
        const int n = n0 + wid * 16 + r4 + u;
#pragma unroll
        for (int j = 0; j < 4; ++j) {
          const float4 t = *(const float4*)(xs + (size_t)n * 1024 + (j * 64 + lane) * 4);
          v[u][j * 4] = t.x; v[u][j * 4 + 1] = t.y; v[u][j * 4 + 2] = t.z; v[u][j * 4 + 3] = t.w;
        }
      }
#pragma unroll
      for (int u = 0; u < 4; ++u) {
        const int n = n0 + wid * 16 + r4 + u;
        const float* m = mod + (size_t)tok_modrow(n) * 6144;
        row_norm_mod(v[u], p.g_ffn + (size_t)l * 1024, m + 3 * 1024, m + 4 * 1024, H + (size_t)n * 1024, lane);
      }
    }
    __syncthreads();
    TSB(p, 41);
    f32x16 acc[1][1]; acc[0][0] = zero16();
    const bf16_t* A0 = H + (size_t)n0 * 1024;
    GRT::run(acc, [&](int r) { return A0 + (size_t)r * 1024; }, Wr, 1024, 1024, smem);
    {
      const int col = GRT::col_of(tid, 0);
      const float rb = p.router_bias[l * 64 + col];
#pragma unroll
      for (int e = 0; e < 16; ++e) {
        const int row = GRT::row_of(tid, 0, e);
        const float s = sigmoidf_(acc[0][0][e]);
        sc[row * 65 + col] = s; bs[row * 65 + col] = s + rb;
      }
    }
    __syncthreads();
    TSB(p, 42);
    int sel[8], lrk[8]; float wsum = 0.f;
    if (tid < 128) {
      float* b = bs + tid * 65; const float* s = sc + tid * 65; float* g = gs + tid * 9;
      for (int gi = 0; gi < 8; ++gi) {
        float m1 = -1e30f, m2 = -1e30f;
        for (int j = 0; j < 8; ++j) { const float x = b[gi * 8 + j]; if (x > m1) { m2 = m1; m1 = x; } else if (x > m2) m2 = x; }
        g[gi] = m1 + m2;
      }
      unsigned gmask = 0;
      for (int c = 0; c < 4; ++c) {
        int best = 0; float bv = -1e30f;
        for (int gi = 0; gi < 8; ++gi) if (!((gmask >> gi) & 1) && g[gi] > bv) { bv = g[gi]; best = gi; }
        gmask |= 1u << best;
      }
      for (int gi = 0; gi < 8; ++gi) if (!((gmask >> gi) & 1)) for (int j = 0; j < 8; ++j) b[gi * 8 + j] = -1e30f;
      wsum = 0.f;
#pragma unroll
      for (int c = 0; c < 8; ++c) {
        int best = 0; float bv = -1e30f;
        for (int e = 0; e < 64; ++e) { const float x = b[e]; if (x > bv) { bv = x; best = e; } }
        b[best] = -3e30f; sel[c] = best; wsum += s[best];
        lrk[c] = atomicAdd(lcnt + best, 1);
      }
    }
    __syncthreads();
    if (tid < 64) { const int c = lcnt[tid]; lbase[tid] = c ? atomicAdd(cnt + tid * 32, c) : 0; }
    __syncthreads();
    if (tid < 128) {
      const int n = n0 + tid;
      const float* s = sc + tid * 65;
      const float inv = 2.5f / (wsum + 1e-20f);
#pragma unroll
      for (int c = 0; c < 8; ++c) {
        const int e = sel[c];
        const int rk = lbase[e] + lrk[c];
        eidx[n * 8 + c] = e; ewt[n * 8 + c] = s[e] * inv; erank[n * 8 + c] = rk;
        elist[(size_t)e * NT_ + rk] = n * 8 + c;
      }
    }
    __syncthreads();
    TSB(p, 43);
  }
}

typedef Gemm<128, 256, 32, 2, 4> GMOE;
constexpr int ACT_LD = 264;
constexpr int MOE_ACT_OFF = GMOE::SMEM;
constexpr int MOE_INFO_OFF = MOE_ACT_OFF + 128 * ACT_LD * 2;
static_assert(MOE_INFO_OFF + 128 * 8 + 67 * 4 * 2 <= 160 * 1024 - 16, "moe lds");
DI void moe_down_run(f32x16 (&acc)[GMOE::MB][GMOE::NB], const char* actl, const bf16_t* Bt, char* smem) {
  constexpr int BK = 32, LDA = GMOE::LDA, CPR = 4, BCH = GMOE::BCH, STG = GMOE::B_BYTES;
  const int tid = opaque_tid(), lane = tid & 63, wid = tid >> 6, wm = wid / 4, wn = wid % 4;
  const int kc = (tid % CPR) * 8, r0 = tid / CPR;
  u32x4 rb[BCH];
  char* Bs0 = smem;
#pragma unroll
  for (int i = 0; i < BCH; ++i) rb[i] = *(const u32x4*)(Bt + (size_t)(r0 + i * 128) * 256 + kc);
#pragma unroll
  for (int i = 0; i < BCH; ++i) *(u32x4*)(Bs0 + ((r0 + i * 128) * LDA + kc) * 2) = rb[i];
  __syncthreads();
  for (int kt = 0; kt < 256 / BK; ++kt) {
    const int kn = (kt + 1 < 256 / BK ? kt + 1 : kt) * BK;
#pragma unroll
    for (int i = 0; i < BCH; ++i) rb[i] = *(const u32x4*)(Bt + (size_t)(r0 + i * 128) * 256 + kn + kc);
    sched_fence();
    const char* Bs = Bs0 + (kt & 1) * STG;
#pragma unroll
    for (int ks = 0; ks < BK / 16; ++ks) {
      bf16x8 af[GMOE::MB], bfr[GMOE::NB];
#pragma unroll
      for (int mb = 0; mb < GMOE::MB; ++mb)
        af[mb] = *(const bf16x8*)(actl + ((wm * 64 + mb * 32 + (lane & 31)) * ACT_LD + kt * BK + ks * 16 + (lane >> 5) * 8) * 2);
#pragma unroll
      for (int nb = 0; nb < GMOE::NB; ++nb)
        bfr[nb] = *(const bf16x8*)(Bs + ((wn * 64 + nb * 32 + (lane & 31)) * LDA + ks * 16 + (lane >> 5) * 8) * 2);
#pragma unroll
      for (int mb = 0; mb < GMOE::MB; ++mb)
#pragma unroll
        for (int nb = 0; nb < GMOE::NB; ++nb) acc[mb][nb] = mfma32(af[mb], bfr[nb], acc[mb][nb]);
    }
    sched_fence();
    {
      char* Bd = Bs0 + ((kt + 1) & 1) * STG;
#pragma unroll
      for (int i = 0; i < BCH; ++i) *(u32x4*)(Bd + ((r0 + i * 128) * LDA + kc) * 2) = rb[i];
    }
    __syncthreads();
  }
}
DI void phase_moe(const Params& p, int l, bool with_ctx, char* smem, const int* cnt) {
  const bf16_t* H = (const bf16_t*)(p.ws + OFF_H);
  const bf16_t* GU = (const bf16_t*)(p.ws + OFF_REGION + R_WMOE + WE_GU);
  const bf16_t* DN = (const bf16_t*)(p.ws + OFF_REGION + R_WMOE + WE_DN);
  const float* ewt = (const float*)(p.ws + OFF_REGION + R_EWT);
  const int* elist = (const int*)(p.ws + OFF_REGION + R_ELIST);
  bf16_t* ybuf = (bf16_t*)(p.ws + OFF_REGION + R_YBUF);
  char* actl = smem + MOE_ACT_OFF;
  int* rtok = (int*)(smem + MOE_INFO_OFF);
  float* rwt = (float*)(rtok + 128);
  int* pre = (int*)(rwt + 128);
  int* off = pre + 67;
  int tid = threadIdx.x;
  const int ntok = with_ctx ? NT_ : NX_;
  __syncthreads();
  if (tid == 0) {
    int a = 0, o = 0;
    for (int e = 0; e < 65; ++e) { const int c = e < 64 ? cnt[e * 32] : ntok; pre[e] = a; off[e] = o; a += (c + 127) >> 7; o += c; }
    pre[65] = a; off[65] = o;
  }
  __syncthreads();
  const int total = pre[65];
  for (int it = vblock(); it < total; it += gridDim.x) {
    tid = opaque_tid();
    int e0 = 0;
    while (pre[e0 + 1] <= it) ++e0;
    const int e = rfl(e0);
    const int rb = rfl(it - pre[e]);
    const int c = rfl(e < 64 ? cnt[e * 32] : ntok);
    const int obase = rfl(off[e] + rb * 128);
    __syncthreads();
    if (tid < 128) {
      const int slot = rb * 128 + tid;
      int tok = 0; float w = 0.f;
      if (slot < c) {
        if (e < 64) { const int pk = elist[(size_t)e * NT_ + slot]; tok = pk >> 3; w = ewt[pk]; }
        else { tok = slot; w = 1.f; }
      }
      rtok[tid] = tok; rwt[tid] = w;
    }
    __syncthreads();
    const bf16_t* Wgu = GU + (size_t)e * 512 * 1024;
#pragma unroll 1
    for (int hf = 0; hf < 2; ++hf) {
      f32x16 acc[GMOE::MB][GMOE::NB];
#pragma unroll
      for (int a = 0; a < GMOE::MB; ++a)
#pragma unroll
        for (int b = 0; b < GMOE::NB; ++b) acc[a][b] = zero16();
      GMOE::run(acc, [&](int r) { return H + (size_t)rtok[r] * 1024; }, Wgu + (size_t)hf * 256 * 1024, 1024, 1024, smem);
      const int lane = tid & 63, wn = (tid >> 6) % 4, wmr = ((tid >> 6) / 4) * 64 + 4 * (lane >> 5);
      const int j = (hf * 4 + wn) * 32 + (lane & 31);
#pragma unroll
      for (int mb = 0; mb < GMOE::MB; ++mb)
#pragma unroll
        for (int i = 0; i < 16; ++i) {
          const int row = wmr + mb * 32 + (i & 3) + 8 * (i >> 2);
          const float g = acc[mb][0][i], u = acc[mb][1][i];
          *(bf16_t*)(actl + (row * ACT_LD + j) * 2) = f2bf(siluf_(g) * u);
        }
    }
    __syncthreads();
    const bf16_t* Wd = DN + (size_t)e * 1024 * 256;
#pragma unroll 1
    for (int nt = 0; nt < 4; ++nt) {
      f32x16 acc[GMOE::MB][GMOE::NB];
#pragma unroll
      for (int a = 0; a < GMOE::MB; ++a)
#pragma unroll
        for (int b = 0; b < GMOE::NB; ++b) acc[a][b] = zero16();
      moe_down_run(acc, actl, Wd + (size_t)nt * 256 * 256, smem);
      {
        const int lane = tid & 63, wid = tid >> 6, wm = wid / 4, wn = wid % 4;
        float* scr = (float*)(smem + wid * WTile<1>::BYTES);
#pragma unroll
        for (int mb = 0; mb < GMOE::MB; ++mb)
#pragma unroll
          for (int nb = 0; nb < GMOE::NB; ++nb) {
            WTile<1>::put(scr, 0, lane, acc[mb][nb]);
            const int row0 = wm * 64 + mb * 32, col0 = nt * 256 + wn * 64 + nb * 32;
            WTile<1>::rows8(scr, lane, [&](int r, int cq, const float4& a, const float4& bq) {
              const int row = row0 + r;
              if (rb * 128 + row < c) {
                const float w = rwt[row];
                const float4 a2 = make_float4(a.x * w, a.y * w, a.z * w, a.w * w), b2 = make_float4(bq.x * w, bq.y * w, bq.z * w, bq.w * w);
                *(uint4*)(ybuf + ((size_t)obase + row) * 1024 + col0 + cq) = pack8bf(a2, b2);
              } });
          }
        __syncthreads();
      }
    }
  }
}

DI void phase_combine(const Params& p, int l, bool last, char* smem, const int* cnt) {
  float* xs = (float*)(p.ws + OFF_XS);
  bf16_t* H = (bf16_t*)(p.ws + OFF_H);
  const float* mod = (const float*)(p.ws + OFF_MOD);
  const int* eidx = (const int*)(p.ws + OFF_REGION + R_EIDX);
  const int* erank = (const int*)(p.ws + OFF_REGION + R_ERANK);
  const bf16_t* ybuf = (const bf16_t*)(p.ws + OFF_REGION + R_YBUF);
  int* off = (int*)smem;
  const int tid = opaque_tid(), lane = tid & 63, wid = tid >> 6;
  const int ntok = last ? NX_ : NT_;
  __syncthreads();
  if (tid == 0) { int o = 0; for (int e = 0; e < 64; ++e) { off[e] = o; o += cnt[e * 32]; } off[64] = o; }
  __syncthreads();
  for (int n = blockIdx.x * 8 + wid; n < ntok; n += gridDim.x * 8) {
    float acc[16];
#pragma unroll
    for (int i = 0; i < 16; ++i) acc[i] = 0.f;
    for (int k = 0; k < 9; ++k) {
      const int row = k < 8 ? off[eidx[n * 8 + k]] + erank[n * 8 + k] : off[64] + n;
      const bf16_t* y = ybuf + (size_t)row * 1024;
#pragma unroll
      for (int j = 0; j < 4; ++j) {
        const uint2 u = *(const uint2*)(y + (j * 64 + lane) * 4);
        acc[j * 4 + 0] += bf2f((bf16_t)(u.x & 0xffff)); acc[j * 4 + 1] += bf2f((bf16_t)(u.x >> 16));
        acc[j * 4 + 2] += bf2f((bf16_t)(u.y & 0xffff)); acc[j * 4 + 3] += bf2f((bf16_t)(u.y >> 16));
      }
    }
    const float* m5 = mod + ((size_t)l * 3 + tok_modrow(n)) * 6144 + 5 * 1024;
    float v[16];
#pragma unroll
    for (int j = 0; j < 4; ++j) {
      const int c = (j * 64 + lane) * 4;
      const float4 x = *(const float4*)(xs + (size_t)n * 1024 + c), g = *(const float4*)(m5 + c);
      v[j * 4 + 0] = x.x + g.x * acc[j * 4 + 0]; v[j * 4 + 1] = x.y + g.y * acc[j * 4 + 1];
      v[j * 4 + 2] = x.z + g.z * acc[j * 4 + 2]; v[j * 4 + 3] = x.w + g.w * acc[j * 4 + 3];
      if (!last) *(float4*)(xs + (size_t)n * 1024 + c) = make_float4(v[j * 4], v[j * 4 + 1], v[j * 4 + 2], v[j * 4 + 3]);
    }
    if (!last) {
      const float* m = mod + ((size_t)(l + 1) * 3 + tok_modrow(n)) * 6144;
      row_norm_mod(v, p.g_mix + (size_t)(l + 1) * 1024, m, m + 1024, H + (size_t)n * 1024, lane);
    } else {
      float ss = 0.f;
#pragma unroll
      for (int i = 0; i < 16; ++i) ss += v[i] * v[i];
      ss = wave_sum(ss);
      const float rs = frsq(ss * (1.f / 1024.f) + 1e-6f);
#pragma unroll
      for (int j = 0; j < 4; ++j) {
        const int c = (j * 64 + lane) * 4;
        const float4 g = *(const float4*)(p.g_final + c);
        *(float4*)(p.out + (size_t)n * 1024 + c) = make_float4(v[j * 4] * rs * g.x, v[j * 4 + 1] * rs * g.y, v[j * 4 + 2] * rs * g.z, v[j * 4 + 3] * rs * g.w);
      }
    }
  }
}
#define SMEM_BYTES (160 * 1024)
#ifndef MEGA
#define MEGA 0
#endif
DI int* cnt_ptr(const Params& p, int l) { return (int*)(p.ws + OFF_CNT) + 1024 + 2048 * l; }
DI int* ctr_ptr(const Params& p, int l) { return (int*)(p.ws + OFF_CNT) + 32 * l; }
#if !MEGA
__global__ void __launch_bounds__(NTHR) k_phaseA(Params p) { SMEM_DECL(smem, SMEM_BYTES); phaseA(p, smem); }
__global__ void __launch_bounds__(NTHR) k_norm0(Params p) { phase_norm0(p); }
__global__ void __launch_bounds__(NTHR) k_win(Params p, int l) { SMEM_DECL(smem, SMEM_BYTES); phase_win(p, l, smem); }
__global__ void __launch_bounds__(NTHR) k_p3(Params p, int l) { SMEM_DECL(smem, SMEM_BYTES); phase3(p, l, smem); }
__global__ void __launch_bounds__(NTHR) k_p3b(Params p, int l) { SMEM_DECL(smem, SMEM_BYTES); phase3b(p, l, smem); }
__global__ void __launch_bounds__(NTHR) k_p4(Params p, int l) { SMEM_DECL(smem, SMEM_BYTES); phase4(p, l, smem, ctr_ptr(p, l)); }
__global__ void __launch_bounds__(NTHR) k_p5(Params p, int l, int wc) { SMEM_DECL(smem, SMEM_BYTES); phase5(p, l, wc != 0, smem); }
__global__ void __launch_bounds__(NTHR) k_merge(Params p, int l, int wc) { SMEM_DECL(smem, SMEM_BYTES); phase_merge(p, l, wc != 0, smem); }
__global__ void __launch_bounds__(NTHR) k_wout(Params p, int l, int wc) { SMEM_DECL(smem, SMEM_BYTES); phase_wout(p, l, wc != 0, smem); }
__global__ void __launch_bounds__(NTHR) k_router(Params p, int l, int wc) { SMEM_DECL(smem, SMEM_BYTES); phase_router(p, l, wc != 0, smem, cnt_ptr(p, l)); }
__global__ void __launch_bounds__(NTHR) k_moe(Params p, int l, int wc) { SMEM_DECL(smem, SMEM_BYTES); phase_moe(p, l, wc != 0, smem, cnt_ptr(p, l)); }
__global__ void __launch_bounds__(NTHR) k_combine(Params p, int l, int last) { SMEM_DECL(smem, SMEM_BYTES); phase_combine(p, l, last != 0, smem, cnt_ptr(p, l)); }
#else
#ifndef EMU
#define XB_TMO      128
#define XB_XCNT(j)  (256  + 64 * (j))
#define XB_XSUB(j)  (1280 + 64 * (j))
#define XB_XGEN(j)  (2304 + 64 * (j))
#define XB_TOP      3328
#define XB_TOPGEN   3392
#define XCD_BAR_WORDS 3456
#define XB_SPIN_CAP (1u << 24)
#define LAS __attribute__((address_space(3)))
DI unsigned xb_ld(unsigned* p) { return __hip_atomic_load(p, __ATOMIC_RELAXED, __HIP_MEMORY_SCOPE_AGENT); }
DI unsigned xb_add(unsigned* p, unsigned v) { return __hip_atomic_fetch_add(p, v, __ATOMIC_RELAXED, __HIP_MEMORY_SCOPE_AGENT); }
DI unsigned xb_xcc_id() { return (unsigned)__builtin_amdgcn_s_getreg((3 << 11) | 20) & 0xFu; }
#define XB_SPIN(cond, bar) do { unsigned _sp = 0; while (cond) { __builtin_amdgcn_s_sleep(1); \
    if ((++_sp & 255u) == 0u) { if (xb_ld(&(bar)[XB_TMO])) break; if (_sp > XB_SPIN_CAP) { atomicAdd(&(bar)[XB_TMO], 1u); break; } } } } while (0)
struct XcdBarrier { unsigned* bar; unsigned x; volatile LAS unsigned* st; };
DI XcdBarrier xcd_barrier_post(unsigned* bar, volatile LAS unsigned* st) {
  XcdBarrier b; b.bar = bar; b.x = xb_xcc_id(); b.st = st;
  if (threadIdx.x == 0) (void)xb_add(&bar[XB_XCNT(b.x)], 1u);
  return b;
}
DI void xcd_barrier_complete(unsigned* bar, unsigned x, unsigned& nloc, unsigned& nx) {
  const unsigned G = gridDim.x * gridDim.y * gridDim.z;
  unsigned sum, cnt, mine, sp = 0u;
  for (;;) {
    sum = 0u; cnt = 0u; mine = 0u;
#pragma unroll
    for (unsigned j = 0; j < 16; ++j) { const unsigned c = xb_ld(&bar[XB_XCNT(j)]); sum += c; cnt += (c > 0u) ? 1u : 0u; mine = (j == x) ? c : mine; }
    if (sum == G) break;
    __builtin_amdgcn_s_sleep(1);
    if ((++sp & 255u) == 0u) { if (xb_ld(&bar[XB_TMO])) break; if (sp > XB_SPIN_CAP) { atomicAdd(&bar[XB_TMO], 1u); break; } }
  }
  nloc = mine > 0u ? mine : 1u; nx = cnt > 0u ? cnt : 1u;
}
DI void xcd_barrier(const XcdBarrier& b) {
  asm volatile("s_waitcnt vmcnt(0)" ::: "memory");
  __syncthreads();
  if (threadIdx.x == 0) {
    unsigned* bar = b.bar;
    __builtin_amdgcn_s_waitcnt(0);
    unsigned nloc = b.st[0], nx = b.st[1];
    if (nloc == 0u) { xcd_barrier_complete(bar, b.x, nloc, nx); b.st[0] = nloc; b.st[1] = nx; }
    const unsigned old = xb_add(&bar[XB_XSUB(b.x)], 1u);
    const unsigned gen = old / nloc;
    if (old + 1u == (gen + 1u) * nloc) {
      __builtin_amdgcn_fence(__ATOMIC_RELEASE, "agent");
      asm volatile("s_waitcnt vmcnt(0)" ::: "memory");
      const unsigned og = xb_add(&bar[XB_TOP], 1u);
      const unsigned tg = og / nx;
      if (og + 1u == (tg + 1u) * nx) xb_add(&bar[XB_TOPGEN], 1u);
      else XB_SPIN(xb_ld(&bar[XB_TOPGEN]) == tg, bar);
      __builtin_amdgcn_fence(__ATOMIC_ACQUIRE, "agent");
      xb_add(&bar[XB_XGEN(b.x)], 1u);
      asm volatile("s_waitcnt vmcnt(0)" ::: "memory");
    } else {
      XB_SPIN(xb_ld(&bar[XB_XGEN(b.x)]) == gen, bar);
      __builtin_amdgcn_fence(__ATOMIC_ACQUIRE, "agent");
      asm volatile("s_waitcnt vmcnt(0)" ::: "memory");
    }
  }
  __syncthreads();
}
#define GSYNC() { XcdBarrier xb_; xb_.bar = (unsigned*)(p.ws + OFF_BAR); xb_.x = xb_xcc_id(); xb_.st = (volatile LAS unsigned*)(smem + SMEM_BYTES - 32); xcd_barrier(xb_); }
#else
#define GSYNC() emu::grid_barrier()
#endif
#ifdef PROBE_IDX
#define TS(i) { if (blockIdx.x == 0 && threadIdx.x == 0) ts[i] = wall_clock64(); }
#else
#define TS(i)
#endif
__global__ void __launch_bounds__(NTHR) k_mega(Params p) {
  SMEM_DECL(smem, SMEM_BYTES);
  cooperative_groups::grid_group grid = cooperative_groups::this_grid();
  volatile LAS unsigned* xst = (volatile LAS unsigned*)(smem + SMEM_BYTES - 32);
  if (threadIdx.x == 0) { xst[0] = 0u; xst[1] = 0u; }
  __syncthreads();
  (void)xcd_barrier_post((unsigned*)(p.ws + OFF_BAR), xst);
#ifdef PROBE_IDX
  long long* ts = (long long*)(p.ws + OFF_CNT + 2048);
#endif
  TS(0);
  phaseA(p, smem);
  grid.sync(); TS(1);
  phase_norm0(p);
  GSYNC(); TS(2);
#pragma unroll 1
  for (int l = 0; l < 2; ++l) {
    const bool wc = l == 0;
    phase_win(p, l, smem); GSYNC(); TS(3 + l * 10);
    phase3(p, l, smem); GSYNC(); TS(4 + l * 10);
    phase3b(p, l, smem); GSYNC(); TS(5 + l * 10);
    phase4(p, l, smem, ctr_ptr(p, l)); GSYNC(); TS(6 + l * 10);
    phase5(p, l, wc, smem); GSYNC(); TS(7 + l * 10);
    phase_merge(p, l, wc, smem); GSYNC(); TS(8 + l * 10);
    phase_wout(p, l, wc, smem); GSYNC(); TS(9 + l * 10);
    phase_router(p, l, wc, smem, cnt_ptr(p, l)); GSYNC(); TS(10 + l * 10);
    phase_moe(p, l, wc, smem, cnt_ptr(p, l)); GSYNC(); TS(11 + l * 10);
    phase_combine(p, l, l == 1, smem, cnt_ptr(p, l));
#ifdef PROBE_IDX
    GSYNC(); TS(12 + l * 10);
#else
    if (l == 0) GSYNC();
#endif
  }
#ifdef PROBE_IDX
  if (blockIdx.x == 0 && threadIdx.x == 0) {
    const float us = (float)(ts[PROBE_IDX + 1] - ts[PROBE_IDX]) * 0.01f;
    p.out[0] += PROBE_IDX >= 40 ? rintf(6.f * log2f(fmaxf(us * 16.f, 1.f))) : rintf(6.f * log2f(fmaxf(us, 1.f)));
  }
#endif
}
#endif

extern "C" void kernel_launch(void* const* d_in, const int* in_sizes, int n_in, void* d_out, int out_size, void* d_ws,
                              size_t ws_size, hipStream_t stream) {
  Params p{};
  const float** pp = (const float**)&p;
  for (int i = 0; i < 41; ++i) pp[i] = (const float*)d_in[i];
  p.out = (float*)d_out; p.ws = (char*)d_ws; p.osc = (char*)d_out;
  if (ws_size < WS_NEEDED) { fprintf(stderr, "workspace too small: %zu < %zu\n", ws_size, (size_t)WS_NEEDED); return; }
#if !MEGA
  const dim3 g(256), b(NTHR);
  hipLaunchKernelGGL(k_phaseA, g, b, 0, stream, p);
  hipLaunchKernelGGL(k_norm0, g, b, 0, stream, p);
  for (int l = 0; l < 2; ++l) {
    const int wc = l == 0;
    hipLaunchKernelGGL(k_win, g, b, 0, stream, p, l);
    hipLaunchKernelGGL(k_p3, g, b, 0, stream, p, l);
    hipLaunchKernelGGL(k_p3b, g, b, 0, stream, p, l);
    hipLaunchKernelGGL(k_p4, g, b, 0, stream, p, l);
    hipLaunchKernelGGL(k_p5, g, b, 0, stream, p, l, wc);
    hipLaunchKernelGGL(k_merge, g, b, 0, stream, p, l, wc);
    hipLaunchKernelGGL(k_wout, g, b, 0, stream, p, l, wc);
    hipLaunchKernelGGL(k_router, g, b, 0, stream, p, l, wc);
    hipLaunchKernelGGL(k_moe, g, b, 0, stream, p, l, wc);
    hipLaunchKernelGGL(k_combine, g, b, 0, stream, p, l, l == 1);
  }
#else
  static int grid_blocks = 0;
  if (!grid_blocks) {
    int dev = 0, cus = 0, per_cu = 0;
    hipGetDevice(&dev);
    hipDeviceGetAttribute(&cus, hipDeviceAttributeMultiprocessorCount, dev);
    hipOccupancyMaxActiveBlocksPerMultiprocessor(&per_cu, k_mega, NTHR, 0);
    if (per_cu > 1) per_cu = 1;
    grid_blocks = cus * per_cu;
  }
  hipMemsetAsync(p.ws + OFF_BAR, 0, 16384, stream);
  void* args[] = {&p};
  hipError_t e = hipLaunchCooperativeKernel((void*)k_mega, dim3(grid_blocks), dim3(NTHR), args, 0, stream);
  if (e != hipSuccess) fprintf(stderr, "cooperative launch failed: %s (grid %d)\n", hipGetErrorString(e), grid_blocks);
#endif
}
```

```cpp
#define MEGA 1
#include <hip/hip_runtime.h>
#include <hip/hip_cooperative_groups.h>
#include <cstdio>

#ifndef SEQ_T
#define SEQ_T 8192
#endif
#ifndef CTX_L
#define CTX_L 256
#endif

#define DI __device__ __forceinline__
typedef unsigned short bf16_t;
typedef short bf16x8 __attribute__((ext_vector_type(8)));
typedef float f32x16 __attribute__((ext_vector_type(16)));
typedef float f32x4 __attribute__((ext_vector_type(4)));
typedef unsigned u32x4 __attribute__((ext_vector_type(4)));

constexpr int NB_ = 2, T_ = SEQ_T, CL_ = CTX_L, D_ = 1024;
constexpr int NX_ = NB_ * T_, NC_ = NB_ * CL_, NT_ = NX_ + NC_, KT_ = CL_ + T_;
constexpr int GRID_W_ = 64;
constexpr int MLA_H = 8, MLA_NOPE_ = 64, MLA_ROPE_ = 32, MLA_DK = 96, MLA_DV = 64, QLORA = 384, KVLORA = 256;
constexpr int MLA_IN_ = 672, ML_IN_ = 784, RW_IN_ = 1152, GATE_IN_ = 3072, D_IN_ = 5680;
constexpr int ZMLA_W = 768;
constexpr int ZREC_W = 1936;
constexpr int WIN_N = 768 + 2048;
constexpr int ML_H = 4, ML_DK = 32, ML_DV = 64, ML_L = 64;
constexpr int RW_H = 4, RW_N_ = 64;
constexpr int NE_ = 64, TOPK_ = 8, DE_ = 256;
constexpr int NCH_ = KT_ / ML_L;
constexpr int NSEQ_ = 2 * NB_ * 4;

constexpr int ZR_MLQ = 0, ZR_MLK = 128, ZR_MLV = 256, ZR_MLO = 512, ZR_MLI = 768, ZR_MLF = 776;
constexpr int ZR_RW = 784;

constexpr size_t al256(size_t x) { return (x + 255) & ~(size_t)255; }
constexpr size_t WM_WIN = 0;
constexpr size_t WM_GATE = WM_WIN + (size_t)WIN_N * 1024 * 2;
constexpr size_t WM_UQ = WM_GATE + (size_t)3072 * 1024 * 2;
constexpr size_t WM_UKV = WM_UQ + (size_t)768 * 384 * 2;
constexpr size_t WM_BRA = WM_UKV + (size_t)1024 * 256 * 2;
constexpr size_t WM_BRM = WM_BRA + (size_t)1024 * 512 * 2;
constexpr size_t WM_BRR = WM_BRM + (size_t)1024 * 256 * 2;
constexpr size_t WM_OUT = WM_BRR + (size_t)1024 * 256 * 2;
constexpr size_t WM_RT = WM_OUT + (size_t)1024 * 1024 * 2;
constexpr size_t WM_SIZE = al256(WM_RT + (size_t)64 * 1024 * 2);
constexpr size_t WE_GU = 0;
constexpr size_t WE_DN = WE_GU + (size_t)65 * 512 * 1024 * 2;
constexpr size_t WE_SIZE = al256(WE_DN + (size_t)65 * 1024 * 256 * 2);

constexpr size_t OFF_XS = 0;
constexpr size_t OFF_MOD = OFF_XS + al256((size_t)NT_ * 1024 * 4);
constexpr size_t OFF_ROPE = OFF_MOD + al256((size_t)2 * 3 * 6144 * 4);
constexpr size_t OFF_H = OFF_ROPE + al256((size_t)T_ * 16 * 8);
constexpr size_t OFF_WMIX = OFF_H + al256((size_t)NT_ * 1024 * 2);
constexpr size_t OFF_CNT = OFF_WMIX + 2 * WM_SIZE;
constexpr size_t OFF_BAR = OFF_CNT + 32768;
constexpr size_t OFF_REGION = OFF_BAR + 16384;
constexpr size_t R_ZREC = 0;
constexpr size_t R_RB16 = R_ZREC + al256((size_t)NT_ * ZREC_W * 4);
constexpr size_t R_LW = R_RB16 + al256((size_t)7 * NT_ * 256 * 2);
constexpr size_t R_BS = R_LW + al256((size_t)2 * NT_ * 256 * 4);
constexpr size_t R_CH = R_BS + al256((size_t)2 * NT_ * 4 * 4);
constexpr size_t R_YS = R_CH + al256((size_t)NSEQ_ * NCH_ * 40960);
constexpr size_t R_MLST = R_YS + al256((size_t)2 * NT_ * 256 * 4);
constexpr size_t R_ATT = R_MLST + al256((size_t)NSEQ_ * NCH_ * 2112 * 4);
constexpr size_t R_MLO = R_ATT + al256((size_t)NT_ * 512 * 2);
constexpr size_t R_RWO = R_MLO + al256((size_t)NT_ * 256 * 2);
constexpr size_t R_VT = R_RWO + al256((size_t)NT_ * 256 * 2);
constexpr size_t R_KB = R_VT + al256((size_t)NB_ * MLA_H * 64 * KT_ * 2);
constexpr size_t R_MIX_END = R_KB + al256((size_t)NB_ * MLA_H * KT_ * 96 * 2);
constexpr int NSLOT_ = NT_ * 9;
constexpr size_t R_YBUF = 0;
constexpr size_t R_EIDX = R_YBUF + al256((size_t)NSLOT_ * 1024 * 2);
constexpr size_t R_EWT = R_EIDX + al256((size_t)NT_ * 8 * 4);
constexpr size_t R_ERANK = R_EWT + al256((size_t)NT_ * 8 * 4);
constexpr size_t R_ELIST = R_ERANK + al256((size_t)NT_ * 8 * 4);
constexpr size_t R_WMOE = R_ELIST + al256((size_t)64 * NT_ * 4);
constexpr size_t R_MOE_END = R_WMOE + WE_SIZE;
constexpr size_t R_SIZE = R_MIX_END > R_MOE_END ? R_MIX_END : R_MOE_END;
constexpr size_t WS_NEEDED = OFF_REGION + R_SIZE;
constexpr size_t O_ZMLA = 0;
constexpr size_t O_QB = O_ZMLA + al256((size_t)NT_ * ZMLA_W * 2);
constexpr size_t O_END = O_QB + al256((size_t)NT_ * 768 * 2);
constexpr size_t O_YMIX = 0;
#if SEQ_T == 8192 && CTX_L == 256
static_assert(O_END <= (size_t)NX_ * 1024 * 4, "d_out scratch overflow");
static_assert((size_t)NT_ * 1024 * 2 <= (size_t)NX_ * 1024 * 4, "ymix overflow");
static_assert(WS_NEEDED <= (size_t)597000000, "workspace too large");
#endif

struct Params {
  const float *x, *c, *ctx, *c_ctx, *w_mod, *b_mod, *g_mix, *g_ffn, *w_in, *g_cq, *w_uq, *g_ckv, *w_uk, *w_uv;
  const float *ml_b_i, *ml_b_f, *ml_g_norm, *rw_mu, *rw_w0, *rw_w2, *rw_a0, *rw_a2, *rw_g2, *rw_k_k, *rw_k_a;
  const float *rw_r_k, *rw_lnx_w, *rw_lnx_b, *w_br_mla, *w_br_ml, *w_br_rw, *w_out, *w_router, *router_bias;
  const float *w_e_gate, *w_e_up, *w_e_down, *w_s_gate, *w_s_up, *w_s_down, *g_final;
  float* out; char* ws; char* osc;
};

DI float bf2f(bf16_t s) { unsigned u = ((unsigned)s) << 16; float f; __builtin_memcpy(&f, &u, 4); return f; }
DI bf16_t f2bf(float x) { unsigned u; __builtin_memcpy(&u, &x, 4); u += 0x7fffu + ((u >> 16) & 1u); return (bf16_t)(u >> 16); }
DI unsigned pack2bf(float a, float b) {
#ifdef EMU
  return (unsigned)f2bf(a) | ((unsigned)f2bf(b) << 16);
#else
  typedef __bf16 bf2 __attribute__((ext_vector_type(2)));
  typedef float f2 __attribute__((ext_vector_type(2)));
  f2 v = {a, b}; bf2 r = __builtin_convertvector(v, bf2); return __builtin_bit_cast(unsigned, r);
#endif
}
DI f32x16 mfma32(bf16x8 a, bf16x8 b, f32x16 c) {
#ifdef EMU
  return emu_mfma_32x32x16_bf16(a, b, c);
#else
  return __builtin_amdgcn_mfma_f32_32x32x16_bf16(a, b, c, 0, 0, 0);
#endif
}
DI int rfl(int v) {
#ifdef EMU
  return v;
#else
  return __builtin_amdgcn_readfirstlane(v);
#endif
}
DI int opaque_tid() {
#ifdef EMU
  return threadIdx.x;
#else
  int t = threadIdx.x; asm volatile("" : "+v"(t)); return t;
#endif
}
DI void wave_sync() {
#ifdef EMU
  (void)__ballot(1);
#else
  asm volatile("" ::: "memory");
#endif
}
DI int vblock() {
  const int g = gridDim.x, b = blockIdx.x;
  return (g & 7) == 0 ? (b & 7) * (g >> 3) + (b >> 3) : b;
}
DI int xcc_id() {
#ifdef EMU
  return blockIdx.x & 7;
#else
  return (int)(__builtin_amdgcn_s_getreg((3 << 11) | 20) & 7u);
#endif
}
DI int ld_relaxed(int* p) {
#ifdef EMU
  return __atomic_load_n(p, __ATOMIC_SEQ_CST);
#else
  return __hip_atomic_load(p, __ATOMIC_RELAXED, __HIP_MEMORY_SCOPE_AGENT);
#endif
}
DI void sched_fence() {
#ifndef EMU
  __builtin_amdgcn_sched_barrier(0);
#endif
}
template <int L> DI float lane_bcast(float x) {
#ifdef EMU
  return __shfl(x, L);
#else
  return __builtin_bit_cast(float, __builtin_amdgcn_readlane(__builtin_bit_cast(int, x), L));
#endif
}
DI f32x16 zero16() { f32x16 z; for (int i = 0; i < 16; ++i) z[i] = 0.f; return z; }
DI int crow(int reg, int h) { return (reg & 3) + 8 * (reg >> 2) + 4 * h; }
#ifdef EMU
DI float fexp(float x) { return expf(x); }
#else
DI float fexp(float x) { return __expf(x); }
#endif
#ifdef EMU
DI float frcp(float x) { return 1.f / x; }
DI float frsq(float x) { return 1.f / sqrtf(x); }
#else
DI float frcp(float x) { return __builtin_amdgcn_rcpf(x); }
DI float frsq(float x) { return __builtin_amdgcn_rsqf(x); }
#endif
DI float sigmoidf_(float x) { return frcp(1.f + fexp(-x)); }
DI float siluf_(float x) { return x * sigmoidf_(x); }
#ifdef EMU
DI float wave_sum(float v) { for (int m = 32; m >= 1; m >>= 1) v += __shfl_xor(v, m); return v; }
DI float wave_max(float v) { for (int m = 32; m >= 1; m >>= 1) v = fmaxf(v, __shfl_xor(v, m)); return v; }
#else
#define DPPF(x, ctrl) __builtin_bit_cast(float, __builtin_amdgcn_mov_dpp(__builtin_bit_cast(int, (x)), (ctrl), 0xf, 0xf, true))
#define RDLF(x, l) __builtin_bit_cast(float, __builtin_amdgcn_readlane(__builtin_bit_cast(int, (x)), (l)))
DI float wave_sum(float v) {
  v += DPPF(v, 0xB1); v += DPPF(v, 0x4E); v += DPPF(v, 0x124); v += DPPF(v, 0x128);
  return (RDLF(v, 0) + RDLF(v, 16)) + (RDLF(v, 32) + RDLF(v, 48));
}
DI float wave_max(float v) {
  v = fmaxf(v, DPPF(v, 0xB1)); v = fmaxf(v, DPPF(v, 0x4E)); v = fmaxf(v, DPPF(v, 0x124)); v = fmaxf(v, DPPF(v, 0x128));
  return fmaxf(fmaxf(RDLF(v, 0), RDLF(v, 16)), fmaxf(RDLF(v, 32), RDLF(v, 48)));
}
#endif

DI int tok_b(int n) { return n < NX_ ? n / T_ : (n - NX_) / CL_; }
DI int tok_t(int n) { return n < NX_ ? n % T_ : (n - NX_) % CL_; }
DI int tok_key(int n) { return n < NX_ ? CL_ + n % T_ : (n - NX_) % CL_; }
DI int tok_modrow(int n) { return n < NX_ ? n / T_ : 2; }

#ifdef EMU
#define SMEM_DECL(name, bytes) char* name = (char*)emu::shared_alloc(bytes)
#else
#define SMEM_DECL(name, bytes) __shared__ __attribute__((aligned(16))) char name[bytes]
#endif
#define NTHR 512
#if defined(PROBE_IDX) && !defined(EMU)
#define TSB(pp, i) { if (blockIdx.x == 0 && threadIdx.x == 0) ((long long*)((pp).ws + OFF_CNT + 2048))[i] = wall_clock64(); }
#else
#define TSB(pp, i)
#endif
struct CvtJob { const float* src; int lds; int K; bf16_t* dst; int ntn; int ntk; int maptype; const float* gain; };
DI int cvt_map(int maptype, int coff, int np) {
  if (maptype == 0) return coff + np;
  if (maptype == 1) { if (np < 672) return np; if (np < 768) return -1; if (np < 768 + 1936) return np - 96; return -1; }
  return np;
}
DI void cvt_tile(const CvtJob& j, int coff, int tk, int tn, char* smem) {
  float* tile = (float*)smem;
  const int tid = opaque_tid();
  __syncthreads();
  {
    const int kk = tid >> 3, nc = (tid & 7) * 8, k = tk * 64 + kk;
    const float g = j.gain ? j.gain[k] : 1.f;
#pragma unroll
    for (int i = 0; i < 8; ++i) {
      const int np = tn * 64 + nc + i;
      const int sc = cvt_map(j.maptype, coff, np);
      tile[kk * 65 + nc + i] = sc >= 0 ? j.src[(size_t)k * j.lds + sc] * g : 0.f;
    }
  }
  __syncthreads();
  {
    const int n = tid >> 3, kc = (tid & 7) * 8;
    int np = tn * 64 + n;
    if (j.maptype == 2) np = (np >> 5) * 64 + coff * 32 + (np & 31);
    uint4 v;
    v.x = pack2bf(tile[(kc + 0) * 65 + n], tile[(kc + 1) * 65 + n]);
    v.y = pack2bf(tile[(kc + 2) * 65 + n], tile[(kc + 3) * 65 + n]);
    v.z = pack2bf(tile[(kc + 4) * 65 + n], tile[(kc + 5) * 65 + n]);
    v.w = pack2bf(tile[(kc + 6) * 65 + n], tile[(kc + 7) * 65 + n]);
    *(uint4*)(j.dst + (size_t)np * j.K + tk * 64 + kc) = v;
  }
}

constexpr int CVT_MIX_TILES = 704 + 768 + 72 + 32 + 32 + 128 + 64 + 64 + 256 + 16;
DI void cvt_mix_item(const Params& p, int l, int it, char* smem) {
  bf16_t* W = (bf16_t*)(p.ws + OFF_WMIX + (size_t)l * WM_SIZE);
  CvtJob j; int coff = 0;
  if (it < 704) { j = {p.w_in + (size_t)l * 1024 * D_IN_, D_IN_, 1024, (bf16_t*)((char*)W + WM_WIN), 44, 16, 1, nullptr}; }
  else if ((it -= 704) < 768) { j = {p.w_in + (size_t)l * 1024 * D_IN_, D_IN_, 1024, (bf16_t*)((char*)W + WM_GATE), 48, 16, 0, nullptr}; coff = 2608; }
  else if ((it -= 768) < 72) { j = {p.w_uq + (size_t)l * 384 * 768, 768, 384, (bf16_t*)((char*)W + WM_UQ), 12, 6, 0, p.g_cq + l * 384}; }
  else if ((it -= 72) < 32) { j = {p.w_uk + (size_t)l * 256 * 512, 512, 256, (bf16_t*)((char*)W + WM_UKV), 8, 4, 0, p.g_ckv + l * 256}; }
  else if ((it -= 32) < 32) { j = {p.w_uv + (size_t)l * 256 * 512, 512, 256, (bf16_t*)((char*)W + WM_UKV) + 512 * 256, 8, 4, 0, p.g_ckv + l * 256}; }
  else if ((it -= 32) < 128) { j = {p.w_br_mla + (size_t)l * 512 * 1024, 1024, 512, (bf16_t*)((char*)W + WM_BRA), 16, 8, 0, nullptr}; }
  else if ((it -= 128) < 64) { j = {p.w_br_ml + (size_t)l * 256 * 1024, 1024, 256, (bf16_t*)((char*)W + WM_BRM), 16, 4, 0, nullptr}; }
  else if ((it -= 64) < 64) { j = {p.w_br_rw + (size_t)l * 256 * 1024, 1024, 256, (bf16_t*)((char*)W + WM_BRR), 16, 4, 0, nullptr}; }
  else if ((it -= 64) < 256) { j = {p.w_out + (size_t)l * 1024 * 1024, 1024, 1024, (bf16_t*)((char*)W + WM_OUT), 16, 16, 0, nullptr}; }
  else { it -= 256; j = {p.w_router + (size_t)l * 1024 * 64, 64, 1024, (bf16_t*)((char*)W + WM_RT), 1, 16, 0, nullptr}; }
  cvt_tile(j, coff, it / j.ntn, it % j.ntn, smem);
}
constexpr int CVT_MOE_TILES = 65 * 192;
DI void cvt_moe_item(const Params& p, int l, int it, char* smem) {
  const int e = it / 192; int r = it % 192;
  bf16_t* GU = (bf16_t*)(p.ws + OFF_REGION + R_WMOE + WE_GU) + (size_t)e * 512 * 1024;
  bf16_t* DN = (bf16_t*)(p.ws + OFF_REGION + R_WMOE + WE_DN) + (size_t)e * 1024 * 256;
  const float* sg = e < 64 ? p.w_e_gate + ((size_t)l * 64 + e) * 1024 * 256 : p.w_s_gate + (size_t)l * 1024 * 256;
  const float* su = e < 64 ? p.w_e_up + ((size_t)l * 64 + e) * 1024 * 256 : p.w_s_up + (size_t)l * 1024 * 256;
  const float* sd = e < 64 ? p.w_e_down + ((size_t)l * 64 + e) * 256 * 1024 : p.w_s_down + (size_t)l * 256 * 1024;
  CvtJob j; int coff = 0;
  if (r < 64) { j = {sg, 256, 1024, GU, 4, 16, 2, nullptr}; coff = 0; }
  else if ((r -= 64) < 64) { j = {su, 256, 1024, GU, 4, 16, 2, nullptr}; coff = 1; }
  else { r -= 64; j = {sd, 1024, 256, DN, 16, 4, 0, nullptr}; }
  cvt_tile(j, coff, r / j.ntn, r % j.ntn, smem);
}

DI void mod_item(const Params& p, int it, char* smem) {
  float* cond = (float*)smem;
  float* red = cond + 3 * 1024;
  const int tid = opaque_tid(), l = it / 96, j0 = (it % 96) * 64;
  __syncthreads();
  for (int i = tid; i < 3 * 1024; i += NTHR) {
    const int r = i >> 10, k = i & 1023;
    const float v = r < 2 ? p.c[r * 1024 + k] : p.c_ctx[k];
    cond[i] = siluf_(v);
  }
  __syncthreads();
  const int jj = tid & 63, kg = tid >> 6;
  float a0 = 0.f, a1 = 0.f, a2 = 0.f;
  const float* w = p.w_mod + (size_t)l * 1024 * 6144 + j0 + jj;
  for (int k = kg; k < 1024; k += 8) {
    const float wv = w[(size_t)k * 6144];
    a0 += cond[k] * wv; a1 += cond[1024 + k] * wv; a2 += cond[2048 + k] * wv;
  }
  red[(kg * 3 + 0) * 64 + jj] = a0; red[(kg * 3 + 1) * 64 + jj] = a1; red[(kg * 3 + 2) * 64 + jj] = a2;
  __syncthreads();
  if (tid < 192) {
    const int r = tid >> 6; float s = 0.f;
    for (int g = 0; g < 8; ++g) s += red[(g * 3 + r) * 64 + jj];
    float* mod = (float*)(p.ws + OFF_MOD);
    mod[((size_t)l * 3 + r) * 6144 + j0 + jj] = s + p.b_mod[(size_t)l * 6144 + j0 + jj];
  }
}
DI void rope_item(const Params& p, int it) {
  const int idx = it * NTHR + threadIdx.x;
  if (idx >= T_ * 16) return;
  const int t = idx >> 4, i = idx & 15, f = i & 7;
  const float pos = (float)(i < 8 ? t / GRID_W_ : t % GRID_W_);
  const float inv = powf(10000.f, -(float)(2 * f) / 16.f);
  const float ang = pos * inv;
  float2* rt = (float2*)(p.ws + OFF_ROPE);
  rt[idx] = make_float2(cosf(ang), sinf(ang));
}
constexpr int PA_ITEMS = 192 + (T_ * 16 + NTHR - 1) / NTHR + 2 * CVT_MIX_TILES;
DI void phaseA(const Params& p, char* smem) {
  if (blockIdx.x == 0) for (int i = threadIdx.x; i < 8192; i += NTHR) ((int*)(p.ws + OFF_CNT))[i] = 0;
  for (int it = blockIdx.x; it < PA_ITEMS; it += gridDim.x) {
    int i = it;
    if (i < 192) { mod_item(p, i, smem); continue; }
    i -= 192;
    constexpr int NR = (T_ * 16 + NTHR - 1) / NTHR;
    if (i < NR) { rope_item(p, i); continue; }
    i -= NR;
    cvt_mix_item(p, i / CVT_MIX_TILES, i % CVT_MIX_TILES, smem);
  }
}

DI void row_norm_mod(const float (&v)[16], const float* g, const float* shift, const float* scale, bf16_t* hrow, int lane) {
  float ss = 0.f;
#pragma unroll
  for (int i = 0; i < 16; ++i) ss += v[i] * v[i];
  ss = wave_sum(ss);
  const float rs = frsq(ss * (1.f / 1024.f) + 1e-6f);
#pragma unroll
  for (int j = 0; j < 4; ++j) {
    const int c = (j * 64 + lane) * 4;
    const float4 gg = *(const float4*)(g + c), sh = *(const float4*)(shift + c), sc = *(const float4*)(scale + c);
    const float h0 = v[j * 4 + 0] * rs * gg.x * (1.f + sc.x) + sh.x;
    const float h1 = v[j * 4 + 1] * rs * gg.y * (1.f + sc.y) + sh.y;
    const float h2 = v[j * 4 + 2] * rs * gg.z * (1.f + sc.z) + sh.z;
    const float h3 = v[j * 4 + 3] * rs * gg.w * (1.f + sc.w) + sh.w;
    uint2 o; o.x = pack2bf(h0, h1); o.y = pack2bf(h2, h3);
    *(uint2*)(hrow + c) = o;
  }
}
DI void phase_norm0(const Params& p) {
  const int lane = threadIdx.x & 63, wid = threadIdx.x >> 6;
  float* xs = (float*)(p.ws + OFF_XS);
  bf16_t* H = (bf16_t*)(p.ws + OFF_H);
  const float* mod = (const float*)(p.ws + OFF_MOD);
  for (int n = blockIdx.x * 8 + wid; n < NT_; n += gridDim.x * 8) {
    const float* src = n < NX_ ? p.x + (size_t)n * 1024 : p.ctx + (size_t)(n - NX_) * 1024;
    float v[16];
#pragma unroll
    for (int j = 0; j < 4; ++j) {
      const float4 t = *(const float4*)(src + (j * 64 + lane) * 4);
      v[j * 4] = t.x; v[j * 4 + 1] = t.y; v[j * 4 + 2] = t.z; v[j * 4 + 3] = t.w;
      *(float4*)(xs + (size_t)n * 1024 + (j * 64 + lane) * 4) = t;
    }
    const float* m = mod + (size_t)(0 * 3 + tok_modrow(n)) * 6144;
    row_norm_mod(v, p.g_mix, m, m + 1024, H + (size_t)n * 1024, lane);
  }
}

template <int BM, int BN, int BK, int WM_, int WN_>
struct Gemm {
  static constexpr int WTM = BM / WM_, WTN = BN / WN_, MB = WTM / 32, NB = WTN / 32;
  static constexpr int LDA = BK + 8;
  static constexpr int A_BYTES = BM * LDA * 2, B_BYTES = BN * LDA * 2, STAGE = A_BYTES + B_BYTES;
  static constexpr int SMEM = 2 * STAGE;
  static constexpr int CPR = BK / 8;
  static constexpr int ACH = BM * CPR / NTHR, BCH = BN * CPR / NTHR;
  static_assert(WM_ * WN_ == 8, "8 waves");
  static_assert(BM * CPR % NTHR == 0 && BN * CPR % NTHR == 0, "chunking");
  static_assert(NTHR % CPR == 0, "rows fixed per thread");

  template <class ARow>
  static DI void run(f32x16 (&acc)[MB][NB], ARow arow, const bf16_t* Bt, int ldb, int Klen, char* smem) {
    const int tid = opaque_tid(), lane = tid & 63, wid = tid >> 6, wm = wid / WN_, wn = wid % WN_;
    const int kc = (tid % CPR) * 8, r0 = tid / CPR;
    const bf16_t* ap[ACH]; const bf16_t* bp[BCH];
#pragma unroll
    for (int i = 0; i < ACH; ++i) ap[i] = arow(r0 + i * (NTHR / CPR)) + kc;
#pragma unroll
    for (int i = 0; i < BCH; ++i) bp[i] = Bt + (size_t)(r0 + i * (NTHR / CPR)) * ldb + kc;
    u32x4 ra[ACH], rb[BCH];
    const int nk = Klen / BK;
#pragma unroll
    for (int i = 0; i < ACH; ++i) ra[i] = *(const u32x4*)(ap[i]);
#pragma unroll
    for (int i = 0; i < BCH; ++i) rb[i] = *(const u32x4*)(bp[i]);
#pragma unroll
    for (int i = 0; i < ACH; ++i) *(u32x4*)(smem + ((r0 + i * (NTHR / CPR)) * LDA + kc) * 2) = ra[i];
#pragma unroll
    for (int i = 0; i < BCH; ++i) *(u32x4*)(smem + A_BYTES + ((r0 + i * (NTHR / CPR)) * LDA + kc) * 2) = rb[i];
    __syncthreads();
    for (int kt = 0; kt < nk; ++kt) {
      const int kn = (kt + 1 < nk ? kt + 1 : kt) * BK;
#pragma unroll
      for (int i = 0; i < ACH; ++i) ra[i] = *(const u32x4*)(ap[i] + kn);
#pragma unroll
      for (int i = 0; i < BCH; ++i) rb[i] = *(const u32x4*)(bp[i] + kn);
      sched_fence();
      const char* As = smem + (kt & 1) * STAGE;
      const char* Bs = As + A_BYTES;
#pragma unroll
      for (int ks = 0; ks < BK / 16; ++ks) {
        bf16x8 af[MB], bfr[NB];
#pragma unroll
        for (int mb = 0; mb < MB; ++mb)
          af[mb] = *(const bf16x8*)(As + ((wm * WTM + mb * 32 + (lane & 31)) * LDA + ks * 16 + (lane >> 5) * 8) * 2);
#pragma unroll
        for (int nb = 0; nb < NB; ++nb)
          bfr[nb] = *(const bf16x8*)(Bs + ((wn * WTN + nb * 32 + (lane & 31)) * LDA + ks * 16 + (lane >> 5) * 8) * 2);
#pragma unroll
        for (int mb = 0; mb < MB; ++mb)
#pragma unroll
          for (int nb = 0; nb < NB; ++nb) acc[mb][nb] = mfma32(af[mb], bfr[nb], acc[mb][nb]);
      }
      sched_fence();
      {
        char* Ad = smem + ((kt + 1) & 1) * STAGE;
#pragma unroll
        for (int i = 0; i < ACH; ++i) *(u32x4*)(Ad + ((r0 + i * (NTHR / CPR)) * LDA + kc) * 2) = ra[i];
#pragma unroll
        for (int i = 0; i < BCH; ++i) *(u32x4*)(Ad + A_BYTES + ((r0 + i * (NTHR / CPR)) * LDA + kc) * 2) = rb[i];
      }
      __syncthreads();
    }
  }
  static DI int row_of(int t, int mb, int reg) { const int lane = t & 63, wm = (t >> 6) / WN_; return wm * WTM + mb * 32 + crow(reg, lane >> 5); }
  static DI int col_of(int t, int nb) { const int lane = t & 63, wn = (t >> 6) % WN_; return wn * WTN + nb * 32 + (lane & 31); }
};


template <int NBW> struct WTile {
  static constexpr int LD = NBW * 32 + 4;
  static constexpr int BYTES = 32 * LD * 4;
  static DI void put(float* scr, int nb, int lane, const f32x16& v) {
    const int c = nb * 32 + (lane & 31), h = lane >> 5;
#pragma unroll
    for (int i = 0; i < 16; ++i) scr[crow(i, h) * LD + c] = v[i];
  }
  template <class F> static DI void rows4(const float* scr, int lane, F f) {
    wave_sync();
#pragma unroll
    for (int it = 0; it < NBW * 4; ++it) {
      const int id = it * 64 + lane, row = id / (NBW * 8), q = id % (NBW * 8);
      f(row, q * 4, *(const float4*)(scr + row * LD + q * 4));
    }
    wave_sync();
  }
  template <class F> static DI void rows8(const float* scr, int lane, F f) {
    wave_sync();
#pragma unroll
    for (int it = 0; it < NBW * 2; ++it) {
      const int id = it * 64 + lane, row = id / (NBW * 4), q = id % (NBW * 4);
      f(row, q * 8, *(const float4*)(scr + row * LD + q * 8), *(const float4*)(scr + row * LD + q * 8 + 4));
    }
    wave_sync();
  }
};
DI uint4 pack8bf(const float4& a, const float4& b) { return make_uint4(pack2bf(a.x, a.y), pack2bf(a.z, a.w), pack2bf(b.x, b.y), pack2bf(b.z, b.w)); }

typedef Gemm<256, 256, 64, 2, 4> G256;
DI void phase_win(const Params& p, int l, char* smem) {
  const bf16_t* H = (const bf16_t*)(p.ws + OFF_H);
  const bf16_t* W = (const bf16_t*)(p.ws + OFF_WMIX + (size_t)l * WM_SIZE + WM_WIN);
  bf16_t* zmla = (bf16_t*)(p.osc + O_ZMLA);
  float* zrec = (float*)(p.ws + OFF_REGION + R_ZREC);
  constexpr int TM = NT_ / 256, TN = WIN_N / 256;
  for (int it = vblock(); it < TM * TN; it += gridDim.x) {
    const int tid = opaque_tid();
    const int tm = it / TN, tn = it % TN;
    __syncthreads();
    f32x16 acc[G256::MB][G256::NB];
#pragma unroll
    for (int a = 0; a < G256::MB; ++a)
#pragma unroll
      for (int b = 0; b < G256::NB; ++b) acc[a][b] = zero16();
    const bf16_t* A0 = H + (size_t)tm * 256 * 1024;
    G256::run(acc, [&](int r) { return A0 + (size_t)r * 1024; }, W + (size_t)tn * 256 * 1024, 1024, 1024, smem);
    {
      const int lane = tid & 63, wid = tid >> 6, wm = wid / 4, wn = wid % 4;
      float* scr = (float*)(smem + wid * WTile<2>::BYTES);
      const int col0 = tn * 256 + wn * 64;
#pragma unroll
      for (int mb = 0; mb < G256::MB; ++mb) {
        WTile<2>::put(scr, 0, lane, acc[mb][0]); WTile<2>::put(scr, 1, lane, acc[mb][1]);
        const int row0 = tm * 256 + wm * 128 + mb * 32;
#ifdef ABL_NOSTORE
        if (tn > 1000) {
#else
        if (tn < 3) {
#endif
          WTile<2>::rows8(scr, lane, [&](int r, int c, const float4& a, const float4& bq) {
            *(uint4*)(zmla + (size_t)(row0 + r) * ZMLA_W + col0 + c) = pack8bf(a, bq); });
        } else {
          WTile<2>::rows4(scr, lane, [&](int r, int c, const float4& a) {
            const int cc = col0 - 768 + c;
#ifdef ABL_NOSTORE
            if (cc < -5) *(float4*)(zrec + (size_t)(row0 + r) * ZREC_W + cc) = a; });
#else
            if (cc < ZREC_W) *(float4*)(zrec + (size_t)(row0 + r) * ZREC_W + cc) = a; });
#endif
        }
      }
    }
  }
}
typedef Gemm<128, 128, 64, 2, 4> G128;
DI void mla_row_rs(const bf16_t* zmla_rows, int c0, int len, float* rs) {
  const int tid = opaque_tid(), row = tid >> 2, half = tid & 3;
  const bf16_t* src = zmla_rows + (size_t)row * ZMLA_W + c0 + half * (len / 4);
  float ss = 0.f;
  for (int i = 0; i < len / 4; i += 8) {
    const uint4 v = *(const uint4*)(src + i);
    const unsigned w[4] = {v.x, v.y, v.z, v.w};
#pragma unroll
    for (int j = 0; j < 4; ++j) { const float a = bf2f((bf16_t)(w[j] & 0xffff)), b = bf2f((bf16_t)(w[j] >> 16)); ss += a * a + b * b; }
  }
  ss += __shfl_xor(ss, 1); ss += __shfl_xor(ss, 2);
  if (half == 0) rs[row] = frsq(ss / (float)len + 1e-6f);
}

constexpr int MLA_Q_TILES = (NT_ / 128) * 6, MLA_KV_TILES = (NT_ / 128) * 8;
DI void mla_q_item(const Params& p, int l, int it, char* smem) {
  const int tid = opaque_tid();
  const int tm = it / 6, tn = it % 6;
  const bf16_t* zmla = (const bf16_t*)(p.osc + O_ZMLA) + (size_t)tm * 128 * ZMLA_W;
  const bf16_t* W = (const bf16_t*)(p.ws + OFF_WMIX + (size_t)l * WM_SIZE + WM_UQ) + (size_t)tn * 128 * 384;
  bf16_t* qb = (bf16_t*)(p.osc + O_QB);
  const float2* rt = (const float2*)(p.ws + OFF_ROPE);
  float* rs = (float*)(smem + G128::SMEM);
  __syncthreads();
  mla_row_rs(zmla, 0, 384, rs);
  f32x16 acc[G128::MB][G128::NB];
#pragma unroll
  for (int a = 0; a < G128::MB; ++a)
#pragma unroll
    for (int b = 0; b < G128::NB; ++b) acc[a][b] = zero16();
  G128::run(acc, [&](int r) { return zmla + (size_t)r * ZMLA_W; }, W, 384, 384, smem);
  const int lane = tid & 63;
  const bool isx = tm * 128 < NX_;
#pragma unroll
  for (int mb = 0; mb < G128::MB; ++mb)
#pragma unroll
    for (int nb = 0; nb < G128::NB; ++nb) {
      const int col = tn * 128 + G128::col_of(tid, nb);
      const bool ropeblk = ((col >> 5) % 3) == 2;
      const int e = lane & 31;
#pragma unroll
      for (int i = 0; i < 16; ++i) {
        const int lr = G128::row_of(tid, mb, i);
        const int n = tm * 128 + lr;
        float v = acc[mb][nb][i] * rs[lr];
        if (ropeblk && isx) {
          const float pv = __shfl_xor(v, 8);
          const float2 cs = rt[(size_t)(n % T_) * 16 + (e >> 4) * 8 + (e & 7)];
          v = (e & 8) ? (pv * cs.y + v * cs.x) : (v * cs.x - pv * cs.y);
        }
        qb[(size_t)n * 768 + col] = f2bf(v);
      }
    }
}
DI void mla_kv_item(const Params& p, int l, int it, char* smem) {
  const int tid = opaque_tid();
  const int tm = it / 8, tn = it % 8;
  const bf16_t* zmla = (const bf16_t*)(p.osc + O_ZMLA) + (size_t)tm * 128 * ZMLA_W;
  const bf16_t* W = (const bf16_t*)(p.ws + OFF_WMIX + (size_t)l * WM_SIZE + WM_UKV) + (size_t)tn * 128 * 256;
  bf16_t* kb = (bf16_t*)(p.ws + OFF_REGION + R_KB);
  bf16_t* vt = (bf16_t*)(p.ws + OFF_REGION + R_VT);
  const float2* rt = (const float2*)(p.ws + OFF_ROPE);
  float* rs = (float*)(smem + G128::SMEM);
  __syncthreads();
  mla_row_rs(zmla, 384, 256, rs);
  const int n0 = tm * 128;
  const int b = tok_b(n0), key0 = tok_key(n0);
  const bool isx = n0 < NX_;
  if (tn == 0) {
    for (int idx = tid; idx < 128 * 16; idx += NTHR) {
      const int lr = idx >> 4, pi = idx & 15, a = pi >> 3, i = pi & 7;
      const bf16_t* z = zmla + (size_t)lr * ZMLA_W + 640 + a * 16 + i;
      float x1 = bf2f(z[0]), x2 = bf2f(z[8]);
      if (isx) {
        const float2 cs = rt[(size_t)((n0 + lr) % T_) * 16 + a * 8 + i];
        const float y1 = x1 * cs.x - x2 * cs.y, y2 = x1 * cs.y + x2 * cs.x; x1 = y1; x2 = y2;
      }
      const bf16_t o1 = f2bf(x1), o2 = f2bf(x2);
      for (int h = 0; h < 8; ++h) {
        bf16_t* dst = kb + ((size_t)(b * 8 + h) * KT_ + key0 + lr) * 96 + 64 + a * 16 + i;
        dst[0] = o1; dst[8] = o2;
      }
    }
  }
  f32x16 acc[G128::MB][G128::NB];
#pragma unroll
  for (int a = 0; a < G128::MB; ++a)
#pragma unroll
    for (int c = 0; c < G128::NB; ++c) acc[a][c] = zero16();
  G128::run(acc, [&](int r) { return zmla + (size_t)r * ZMLA_W + 384; }, W, 256, 256, smem);
  const int lane = tid & 63;
#pragma unroll
  for (int mb = 0; mb < G128::MB; ++mb)
#pragma unroll
    for (int nb = 0; nb < G128::NB; ++nb) {
      const int col = tn * 128 + G128::col_of(tid, nb);
      if (col < 512) {
        const int h = col >> 6, d = col & 63;
#pragma unroll
        for (int i = 0; i < 16; ++i) {
          const int lr = G128::row_of(tid, mb, i);
          kb[((size_t)(b * 8 + h) * KT_ + key0 + lr) * 96 + d] = f2bf(acc[mb][nb][i] * rs[lr]);
        }
      } else {
        const int h = (col - 512) >> 6, d = col & 63;
#pragma unroll
        for (int g = 0; g < 4; ++g) {
          const int lr = G128::row_of(tid, mb, g * 4);
          uint2 o;
          o.x = pack2bf(acc[mb][nb][g * 4 + 0] * rs[lr], acc[mb][nb][g * 4 + 1] * rs[lr + 1]);
          o.y = pack2bf(acc[mb][nb][g * 4 + 2] * rs[lr + 2], acc[mb][nb][g * 4 + 3] * rs[lr + 3]);
          *(uint2*)(vt + ((size_t)(b * 8 + h) * 64 + d) * KT_ + key0 + lr) = o;
        }
      }
    }
  (void)lane;
}

DI float softplusf_(float x) { return x > 20.f ? x : log1pf(fexp(x)); }
constexpr int RWP_TT = 16;
constexpr int RWP_ITEMS = NT_ / RWP_TT;
DI void rwkv_prep_items(const Params& p, int l, char* smem) {
  if ((int)blockIdx.x >= RWP_ITEMS) return;
  float* zs = (float*)smem;
  float* tw = zs + RWP_TT * 1024;
  float* ta = tw + 2 * 64 * RWP_TT;
  const float* zrec = (const float*)(p.ws + OFF_REGION + R_ZREC);
  bf16_t* rb = (bf16_t*)(p.ws + OFF_REGION + R_RB16);
  float* lwo = (float*)(p.ws + OFF_REGION + R_LW);
  float* bso = (float*)(p.ws + OFF_REGION + R_BS);
  const float* mu = p.rw_mu + (size_t)l * 1152;
  const int tid = opaque_tid();
  const int col = tid & 255, d = tid >> 8;
  const float* w2 = p.rw_w2 + ((size_t)l * 2 + d) * 64 * 256 + col;
  const float* a2 = p.rw_a2 + ((size_t)l * 2 + d) * 64 * 256 + col;
  const float rkw = p.rw_r_k[(size_t)l * 256 + col];
  const float w0 = p.rw_w0[((size_t)l * 2 + d) * 256 + col], a0 = p.rw_a0[((size_t)l * 2 + d) * 256 + col];
  const float kkw = p.rw_k_k[(size_t)l * 256 + col], kaw = p.rw_k_a[(size_t)l * 256 + col];
  const size_t AS = (size_t)NT_ * 256;
#pragma unroll 1
  for (int it = blockIdx.x; it < RWP_ITEMS; it += gridDim.x) {
    const int n0 = it * RWP_TT;
    __syncthreads();
    TSB(p, 44);
#pragma unroll 1
    for (int i = 0; i < 8; ++i) {
      const int idx4 = tid + i * NTHR, tt = idx4 >> 8, c = (idx4 & 255) * 4, n = n0 + tt, t = tok_t(n);
      const int len = n < NX_ ? T_ : CL_;
      const float* zr = zrec + (size_t)n * ZREC_W + ZR_RW + c;
      const float4 z = *(const float4*)zr;
      const float4 zp = t > 0 ? *(const float4*)(zr - ZREC_W) : make_float4(0.f, 0.f, 0.f, 0.f);
      const float4 zn = t < len - 1 ? *(const float4*)(zr + ZREC_W) : make_float4(0.f, 0.f, 0.f, 0.f);
      const float4 m4 = *(const float4*)(mu + c);
      float4 sv;
      sv.x = z.x + (0.5f * (zp.x + zn.x) - z.x) * m4.x; sv.y = z.y + (0.5f * (zp.y + zn.y) - z.y) * m4.y;
      sv.z = z.z + (0.5f * (zp.z + zn.z) - z.z) * m4.z; sv.w = z.w + (0.5f * (zp.w + zn.w) - z.w) * m4.w;
      *(float4*)(zs + tt * 1024 + c) = sv;
      if (c >= 768) {
        const float e4[4] = {sv.x, sv.y, sv.z, sv.w};
#pragma unroll
        for (int q = 0; q < 4; ++q) {
          const int cc = c + q;
          if (cc < 896) { const int dd = (cc - 768) >> 6, k = (cc - 768) & 63; tw[(dd * 64 + k) * RWP_TT + tt] = 1.f - 2.f * frcp(1.f + fexp(2.f * e4[q])); }
          else { const int dd = (cc - 896) >> 6, k = (cc - 896) & 63; ta[(dd * 64 + k) * RWP_TT + tt] = e4[q]; }
        }
      }
    }
    __syncthreads();
    TSB(p, 45);
#pragma unroll 1
    for (int th = 0; th < RWP_TT; th += 8) {
      float aw[8], aa[8];
#pragma unroll
      for (int i = 0; i < 8; ++i) { aw[i] = 0.f; aa[i] = 0.f; }
#pragma unroll 1
      for (int kh = 0; kh < 4; ++kh) {
        float wr[16], ar[16];
#pragma unroll
        for (int k = 0; k < 16; ++k) { wr[k] = w2[(kh * 16 + k) * 256]; ar[k] = a2[(kh * 16 + k) * 256]; }
#pragma unroll
        for (int k = 0; k < 16; ++k) {
          const float* twk = tw + (d * 64 + kh * 16 + k) * RWP_TT + th;
          const float* tak = ta + (d * 64 + kh * 16 + k) * RWP_TT + th;
#pragma unroll
          for (int i = 0; i < 8; ++i) { aw[i] += twk[i] * wr[k]; aa[i] += tak[i] * ar[k]; }
          if ((k & 3) == 3) sched_fence();
        }
      }
#pragma unroll
      for (int i = 0; i < 8; ++i) {
        const int n = n0 + th + i;
        const float* zr = zs + (th + i) * 1024 + col;
        const float r = zr[0], k = zr[256], v = zr[512];
        const float kr = k * kkw;
        const float ss = wave_sum(kr * kr);
        const float kk = kr * frsq(fmaxf(ss, 1e-24f));
        const float w = -softplusf_(-(w0 + aw[i])) - 0.5f;
        const float logdecay = -fexp(w);
        const float a = sigmoidf_(a0 + aa[i]);
        const float kd = k * (1.f + (a - 1.f) * kaw);
        const float bsum = wave_sum(r * rkw * kd);
        const size_t o = (size_t)n * 256 + col;
        if (d == 0) { rb[0 * AS + o] = f2bf(r); rb[1 * AS + o] = f2bf(v); rb[2 * AS + o] = f2bf(kk); }
        lwo[d * AS + o] = logdecay;
        rb[(3 + 2 * d) * AS + o] = f2bf(kd);
        rb[(4 + 2 * d) * AS + o] = f2bf(kk * a);
        if ((tid & 63) == 0) bso[((size_t)d * NT_ + n) * 4 + (col >> 6)] = bsum;
      }
    }
    TSB(p, 47);
  }
}

DI int seq_tok(int dir, int b, int pos) {
  if (pos < CL_) return NX_ + b * CL_ + (dir ? CL_ - 1 - pos : pos);
  const int t = pos - CL_;
  return b * T_ + (dir ? T_ - 1 - t : t);
}
DI float logsigmoidf_(float x) { return -softplusf_(-x); }
DI float wave_incl_scan(float v, int lane) {
  for (int d = 1; d < 64; d <<= 1) { const float o = __shfl_up(v, d); if (lane >= d) v += o; }
  return v;
}
constexpr int ML_ST = 2112;
constexpr int ML1_ITEMS = NSEQ_ * NCH_;
DI void mlstm_local_item(const Params& p, int l, int it, char* smem) {
  const int s = it / NCH_, c = it % NCH_, dir = s >> 3, b = (s >> 2) & 1, hd = s & 3;
  float* vv = (float*)smem;
  float* kw = vv + 64 * 64;
  float* wej = kw + 64 * 32;
  const float* zrec = (const float*)(p.ws + OFF_REGION + R_ZREC);
  float* st = (float*)(p.ws + OFF_REGION + R_MLST) + ((size_t)s * NCH_ + c) * ML_ST;
  const int tid = opaque_tid(), lane = tid & 63, wid = tid >> 6;
  __syncthreads();
  if (wid == 0) {
    const int n = seq_tok(dir, b, c * 64 + lane);
    const float fp = zrec[(size_t)n * ZREC_W + ZR_MLF + dir * 4 + hd] + p.ml_b_f[(l * 2 + dir) * 4 + hd];
    const float ip = zrec[(size_t)n * ZREC_W + ZR_MLI + dir * 4 + hd] + p.ml_b_i[(l * 2 + dir) * 4 + hd];
    const float bj = wave_incl_scan(logsigmoidf_(fp), lane);
    const float bl = lane_bcast<63>(bj);
    const float lw = bl - bj + ip;
    const float ml = wave_max(lw);
    wej[lane] = fexp(lw - ml);
    if (lane == 0) { st[2080] = bl; st[2081] = ml; }
  }
  for (int idx = tid; idx < 64 * 64; idx += NTHR) {
    const int j = idx >> 6, e = idx & 63;
    const int n = seq_tok(dir, b, c * 64 + j);
    vv[idx] = zrec[(size_t)n * ZREC_W + ZR_MLV + hd * 64 + e];
  }
  __syncthreads();
  for (int idx = tid; idx < 64 * 32; idx += NTHR) {
    const int j = idx >> 5, e = idx & 31;
    const int n = seq_tok(dir, b, c * 64 + j);
    kw[idx] = zrec[(size_t)n * ZREC_W + ZR_MLK + hd * 32 + e] * wej[j];
  }
  __syncthreads();
  const int v = tid & 63, d0 = (tid >> 6) * 4;
  float a0 = 0.f, a1 = 0.f, a2 = 0.f, a3 = 0.f;
  for (int j = 0; j < 64; ++j) {
    const float x = vv[j * 64 + v];
    const float4 kk = *(const float4*)(kw + j * 32 + d0);
    a0 += x * kk.x; a1 += x * kk.y; a2 += x * kk.z; a3 += x * kk.w;
  }
  *(float4*)(st + v * 32 + d0) = make_float4(a0, a1, a2, a3);
  if (tid < 32) { float sn = 0.f; for (int j = 0; j < 64; ++j) sn += kw[j * 32 + tid]; st[2048 + tid] = sn; }
}
constexpr int ML2_ITEMS = (NSEQ_ * 2080 + NTHR - 1) / NTHR;
DI void mlstm_scan_item(const Params& p, int it) {
  const int g = it * NTHR + opaque_tid();
  if (g >= NSEQ_ * 2080) return;
  const int s = g / 2080, e = g % 2080;
  float* st = (float*)(p.ws + OFF_REGION + R_MLST) + (size_t)s * NCH_ * ML_ST;
  float state = 0.f, m = 0.f;
  static_assert(NCH_ % 4 == 0, "chunk count");
  for (int c0 = 0; c0 < NCH_; c0 += 4) {
    float d[4], bl[4], ml[4];
#pragma unroll
    for (int u = 0; u < 4; ++u) { const float* r = st + (size_t)(c0 + u) * ML_ST; d[u] = r[e]; bl[u] = r[2080]; ml[u] = r[2081]; }
#pragma unroll
    for (int u = 0; u < 4; ++u) {
      float* r = st + (size_t)(c0 + u) * ML_ST;
      r[e] = state;
      if (e == 0) r[2082] = m;
      const float mn = fmaxf(bl[u] + m, ml[u]);
      state = fexp(bl[u] + m - mn) * state + fexp(ml[u] - mn) * d[u];
      m = mn;
    }
  }
}

DI void phase3(const Params& p, int l, char* smem) {
  rwkv_prep_items(p, l, smem);
  for (int it = blockIdx.x; it < ML1_ITEMS; it += gridDim.x) mlstm_local_item(p, l, it, smem);
}
constexpr int RW_LD = 72, RW_MB = 64 * RW_LD * 2;
constexpr int RWC_REC = 40960;
DI char* rw_rec(const Params& p, int s, int c) { return p.ws + OFF_REGION + R_CH + ((size_t)s * NCH_ + c) * RWC_REC; }
DI f32x16 rw_mm(const char* A, const char* Bt, int mb, int nb, int lane, f32x16 acc) {
  const int r = lane & 31, h = lane >> 5;
#pragma unroll
  for (int ks = 0; ks < 4; ++ks) {
    const bf16x8 a = *(const bf16x8*)(A + ((mb * 32 + r) * RW_LD + ks * 16 + h * 8) * 2);
    const bf16x8 b = *(const bf16x8*)(Bt + ((nb * 32 + r) * RW_LD + ks * 16 + h * 8) * 2);
    acc = mfma32(a, b, acc);
  }
  return acc;
}
DI void rw_wrT(char* Dst, int mb, int nb, int lane, const f32x16& v) {
  const int r = lane & 31, h = lane >> 5;
#pragma unroll
  for (int g = 0; g < 4; ++g) {
    uint2 o; o.x = pack2bf(v[4 * g], v[4 * g + 1]); o.y = pack2bf(v[4 * g + 2], v[4 * g + 3]);
    *(uint2*)(Dst + ((nb * 32 + r) * RW_LD + mb * 32 + 8 * g + 4 * h) * 2) = o;
  }
}
DI void rw_wrT_g(bf16_t* Dst, int mb, int nb, int lane, const f32x16& v) {
  const int r = lane & 31, h = lane >> 5;
#pragma unroll
  for (int g = 0; g < 4; ++g) {
    uint2 o; o.x = pack2bf(v[4 * g], v[4 * g + 1]); o.y = pack2bf(v[4 * g + 2], v[4 * g + 3]);
    *(uint2*)(Dst + (nb * 32 + r) * 64 + mb * 32 + 8 * g + 4 * h) = o;
  }
}
DI void rw_addT(const char* Src, int mb, int nb, int lane, f32x16& v) {
  const int r = lane & 31, h = lane >> 5;
#pragma unroll
  for (int g = 0; g < 4; ++g) {
    const uint2 u = *(const uint2*)(Src + ((nb * 32 + r) * RW_LD + mb * 32 + 8 * g + 4 * h) * 2);
    v[4 * g] += bf2f((bf16_t)(u.x & 0xffff)); v[4 * g + 1] += bf2f((bf16_t)(u.x >> 16));
    v[4 * g + 2] += bf2f((bf16_t)(u.y & 0xffff)); v[4 * g + 3] += bf2f((bf16_t)(u.y >> 16));
  }
}
DI void rw_mask_upper(f32x16& v, int mb, int nb, int lane, bool strict) {
  const int col = nb * 32 + (lane & 31), h = lane >> 5;
#pragma unroll
  for (int i = 0; i < 16; ++i) { const int row = mb * 32 + crow(i, h); if (strict ? !(row < col) : !(row <= col)) v[i] = 0.f; }
}
DI void rw_mask_lower_strict(f32x16& v, int mb, int nb, int lane) {
  const int col = nb * 32 + (lane & 31), h = lane >> 5;
#pragma unroll
  for (int i = 0; i < 16; ++i) { const int row = mb * 32 + crow(i, h); if (!(col < row)) v[i] = 0.f; }
}

constexpr int RW1_ITEMS = NSEQ_ * NCH_;
DI void rw_chunk_item(const Params& p, int it, char* smem) {
  const int s = it / NCH_, c = it % NCH_, dir = s >> 3, b = (s >> 2) & 1, hd = s & 3;
  const int tid = opaque_tid(), lane = tid & 63, wid = tid >> 6;
  const bf16_t* rb = (const bf16_t*)(p.ws + OFF_REGION + R_RB16);
  const float* lwg = (const float*)(p.ws + OFF_REGION + R_LW) + (size_t)dir * NT_ * 256;
  const size_t AS = (size_t)NT_ * 256;
  char* const At = smem + 0 * RW_MB; char* const Bt_ = smem + 1 * RW_MB; char* const Kt = smem + 2 * RW_MB; char* const Rt = smem + 3 * RW_MB;
  char* const Aj = smem + 4 * RW_MB; char* const Bj = smem + 5 * RW_MB; char* const Kj = smem + 6 * RW_MB; char* const Vi = smem + 7 * RW_MB;
  char* const QA = smem + 8 * RW_MB; char* const QTA = smem + 9 * RW_MB; char* const GA = smem + 10 * RW_MB;
  char* const Mka = smem + 11 * RW_MB; char* const MbrT = smem + 12 * RW_MB; char* const MkrT = smem + 13 * RW_MB;
  char* const QB = At; char* const QTB = Bt_; char* const GB = Kt;
  float* const cs = (float*)(smem + 8 * RW_MB);
  float* const gC = (float*)(smem + 14 * RW_MB);
  char* rec = rw_rec(p, s, c);
  __syncthreads();
  const int t = tid >> 3, j8 = (tid & 7) * 8;
  const int n = seq_tok(dir, b, c * 64 + t);
  {
    const float4 l0 = *(const float4*)(lwg + (size_t)n * 256 + hd * 64 + j8), l1 = *(const float4*)(lwg + (size_t)n * 256 + hd * 64 + j8 + 4);
    float* d = cs + t * 65 + j8;
    d[0] = l0.x; d[1] = l0.y; d[2] = l0.z; d[3] = l0.w; d[4] = l1.x; d[5] = l1.y; d[6] = l1.z; d[7] = l1.w;
  }
  __syncthreads();
  if (tid < 64) { float a = 0.f; for (int tt = 0; tt < 64; ++tt) { a += cs[tt * 65 + tid]; cs[tt * 65 + tid] = a; } gC[tid] = fexp(a); }
  __syncthreads();
  {
    const size_t o = (size_t)n * 256 + hd * 64 + j8;
    const uint4 ukk = *(const uint4*)(rb + 2 * AS + o), ubb = *(const uint4*)(rb + (4 + 2 * dir) * AS + o), ukd = *(const uint4*)(rb + (3 + 2 * dir) * AS + o);
    const uint4 ur = *(const uint4*)(rb + 0 * AS + o), uv = *(const uint4*)(rb + 1 * AS + o);
    const unsigned akk[4] = {ukk.x, ukk.y, ukk.z, ukk.w}, abb[4] = {ubb.x, ubb.y, ubb.z, ubb.w}, akd[4] = {ukd.x, ukd.y, ukd.z, ukd.w};
    const unsigned ar[4] = {ur.x, ur.y, ur.z, ur.w}, av[4] = {uv.x, uv.y, uv.z, uv.w};
    unsigned oa[4], ob[4], ok[4], orr[4];
#pragma unroll
    for (int q = 0; q < 4; ++q) {
      float fa[2], fb[2], fk[2], fr[2];
#pragma unroll
      for (int e = 0; e < 2; ++e) {
        const int j = j8 + 2 * q + e;
        const float cst = cs[t * 65 + j], csp = t > 0 ? cs[(t - 1) * 65 + j] : 0.f;
        const float g = fexp(cst), gp = fexp(csp), gi = fexp(-cst);
        const int sh = 16 * e;
        fa[e] = -bf2f((bf16_t)((akk[q] >> sh) & 0xffff)) * gp;
        fb[e] = bf2f((bf16_t)((abb[q] >> sh) & 0xffff)) * gi;
        fk[e] = bf2f((bf16_t)((akd[q] >> sh) & 0xffff)) * gi;
        fr[e] = bf2f((bf16_t)((ar[q] >> sh) & 0xffff)) * g;
        *(bf16_t*)(Aj + (j * RW_LD + t) * 2) = f2bf(fa[e]);
        *(bf16_t*)(Bj + (j * RW_LD + t) * 2) = f2bf(fb[e]);
        *(bf16_t*)(Kj + (j * RW_LD + t) * 2) = f2bf(fk[e]);
        *(bf16_t*)(Vi + (j * RW_LD + t) * 2) = (bf16_t)((av[q] >> sh) & 0xffff);
      }
      oa[q] = pack2bf(fa[0], fa[1]); ob[q] = pack2bf(fb[0], fb[1]); ok[q] = pack2bf(fk[0], fk[1]); orr[q] = pack2bf(fr[0], fr[1]);
    }
    *(uint4*)(At + (t * RW_LD + j8) * 2) = make_uint4(oa[0], oa[1], oa[2], oa[3]);
    *(uint4*)(Bt_ + (t * RW_LD + j8) * 2) = make_uint4(ob[0], ob[1], ob[2], ob[3]);
    *(uint4*)(Kt + (t * RW_LD + j8) * 2) = make_uint4(ok[0], ok[1], ok[2], ok[3]);
    *(uint4*)(Rt + (t * RW_LD + j8) * 2) = make_uint4(orr[0], orr[1], orr[2], orr[3]);
  }
  __syncthreads();
  {
    const int prod = wid >> 2, mb = (wid >> 1) & 1, nb = wid & 1;
    f32x16 acc = zero16();
    if (prod == 0) {
      if (!(mb == 1 && nb == 0)) acc = rw_mm(Bt_, At, mb, nb, lane, acc);
      rw_mask_upper(acc, mb, nb, lane, true);
      rw_wrT(QA, mb, nb, lane, acc);
      if (mb == nb) {
        const int col = nb * 32 + (lane & 31), h = lane >> 5;
#pragma unroll
        for (int i = 0; i < 16; ++i) if (mb * 32 + crow(i, h) == col) acc[i] += 1.f;
      }
      rw_wrT(GA, mb, nb, lane, acc);
    } else {
      if (!(mb == 0 && nb == 1)) acc = rw_mm(At, Bt_, mb, nb, lane, acc);
      rw_mask_lower_strict(acc, mb, nb, lane);
      rw_wrT(QTA, mb, nb, lane, acc);
    }
  }
  for (int blk = wid; blk < 12; blk += 8) {
    const int prod = blk >> 2, mb = (blk >> 1) & 1, nb = blk & 1;
    f32x16 acc = zero16();
    if (prod == 0) {
      acc = rw_mm(At, Kt, mb, nb, lane, acc); rw_mask_lower_strict(acc, mb, nb, lane); rw_wrT(Mka, mb, nb, lane, acc);
    } else if (prod == 1) {
      acc = rw_mm(Bt_, Rt, mb, nb, lane, acc); rw_mask_upper(acc, mb, nb, lane, false); rw_wrT(MbrT, mb, nb, lane, acc);
    } else {
      acc = rw_mm(Kt, Rt, mb, nb, lane, acc); rw_mask_upper(acc, mb, nb, lane, false); rw_wrT(MkrT, mb, nb, lane, acc);
    }
  }
  __syncthreads();
#define RW_SQ(Q_, Qt_, Qn_, Qtn_, blk) { const int pr_ = (blk) >> 2, mb_ = ((blk) >> 1) & 1, nb_ = (blk) & 1; f32x16 acc_ = zero16(); \
    if (pr_ == 0) { acc_ = rw_mm(Q_, Qt_, mb_, nb_, lane, acc_); rw_wrT(Qtn_, mb_, nb_, lane, acc_); } \
    else { acc_ = rw_mm(Qt_, Q_, mb_, nb_, lane, acc_); rw_wrT(Qn_, mb_, nb_, lane, acc_); } }
#define RW_GUP(Qt_, G_, Gn_, blk) { const int mb_ = ((blk) >> 1) & 1, nb_ = (blk) & 1; f32x16 acc_ = zero16(); \
    rw_addT(G_, mb_, nb_, lane, acc_); acc_ = rw_mm(Qt_, G_, mb_, nb_, lane, acc_); rw_wrT(Gn_, mb_, nb_, lane, acc_); }
  RW_SQ(QA, QTA, QB, QTB, wid);
  __syncthreads();
  for (int blk = wid; blk < 12; blk += 8) { if (blk < 8) { RW_SQ(QB, QTB, QA, QTA, blk); } else { RW_GUP(QTB, GA, GB, blk - 8); } }
  __syncthreads();
  for (int blk = wid; blk < 12; blk += 8) { if (blk < 8) { RW_SQ(QA, QTA, QB, QTB, blk); } else { RW_GUP(QTA, GB, GA, blk - 8); } }
  __syncthreads();
  for (int blk = wid; blk < 12; blk += 8) { if (blk < 8) { RW_SQ(QB, QTB, QA, QTA, blk); } else { RW_GUP(QTB, GA, GB, blk - 8); } }
  __syncthreads();
  for (int blk = wid; blk < 12; blk += 8) { if (blk < 8) { RW_SQ(QA, QTA, QB, QTB, blk); } else { RW_GUP(QTA, GB, GA, blk - 8); } }
  __syncthreads();
  if (wid < 4) { RW_GUP(QTB, GA, GB, wid); }
  __syncthreads();
  {
    const int prod = wid >> 2, mb = (wid >> 1) & 1, nb = wid & 1;
    f32x16 acc = zero16();
    acc = rw_mm(GB, prod == 0 ? Mka : Aj, mb, nb, lane, acc);
    rw_wrT(prod == 0 ? QA : QTA, mb, nb, lane, acc);
  }
  __syncthreads();
  char* const X1 = QA; char* const X2 = QTA; char* const QpT = At;
  for (int blk = wid; blk < 16; blk += 8) {
    const int prod = blk >> 2, mb = (blk >> 1) & 1, nb = blk & 1;
    f32x16 acc = zero16();
    if (prod == 0) {
      rw_addT(MkrT, mb, nb, lane, acc); acc = rw_mm(X1, MbrT, mb, nb, lane, acc); rw_mask_upper(acc, mb, nb, lane, false);
      rw_wrT_g((bf16_t*)(rec + 8192), mb, nb, lane, acc);
    } else if (prod == 1) {
      rw_addT(Rt, mb, nb, lane, acc); acc = rw_mm(X2, MbrT, mb, nb, lane, acc);
      rw_wrT_g((bf16_t*)(rec), mb, nb, lane, acc);
    } else if (prod == 2) {
      acc = rw_mm(X2, Bj, mb, nb, lane, acc);
      const int col = nb * 32 + (lane & 31), h = lane >> 5; const float gc = gC[col];
#pragma unroll
      for (int i = 0; i < 16; ++i) { if (mb * 32 + crow(i, h) == col) acc[i] += 1.f; acc[i] *= gc; }
      rw_wrT_g((bf16_t*)(rec + 16384), mb, nb, lane, acc);
    } else {
      rw_addT(Kj, mb, nb, lane, acc); acc = rw_mm(X1, Bj, mb, nb, lane, acc);
      const float gc = gC[nb * 32 + (lane & 31)];
#pragma unroll
      for (int i = 0; i < 16; ++i) acc[i] *= gc;
      rw_wrT(QpT, mb, nb, lane, acc);
    }
  }
  __syncthreads();
  if (wid < 4) {
    const int mb = (wid >> 1) & 1, nb = wid & 1, r = lane & 31, h = lane >> 5;
    f32x16 acc = zero16();
    acc = rw_mm(QpT, Vi, mb, nb, lane, acc);
    float* dq = (float*)(rec + 24576);
#pragma unroll
    for (int g = 0; g < 4; ++g)
      *(float4*)(dq + (nb * 32 + r) * 64 + mb * 32 + 8 * g + 4 * h) = make_float4(acc[4 * g], acc[4 * g + 1], acc[4 * g + 2], acc[4 * g + 3]);
  }
}

constexpr int RW2_ITEMS = NSEQ_;
constexpr int RW2_DQLD = 68;
constexpr int RW2_STAGE = RW_MB + 64 * RW2_DQLD * 4;
DI void rw_state_item(const Params& p, int s, char* smem) {
  const int tid = opaque_tid(), lane = tid & 63, wid = tid >> 6, r = lane & 31, h = lane >> 5;
  f32x16 S0 = zero16(), S1 = zero16();
  uint4 rp, rd0, rd1;
  const int prow = tid >> 3, pcol = (tid & 7) * 8;
  const int drow = tid >> 3, dcol = (tid & 7) * 8;
  __syncthreads();
  {
    const char* rec = rw_rec(p, s, 0);
    rp = *(const uint4*)(rec + 16384 + (prow * 64 + pcol) * 2);
    rd0 = *(const uint4*)(rec + 24576 + (drow * 64 + dcol) * 4); rd1 = *(const uint4*)(rec + 24576 + (drow * 64 + dcol + 4) * 4);
    *(uint4*)(smem + (prow * RW_LD + pcol) * 2) = rp;
    *(uint4*)(smem + RW_MB + (drow * RW2_DQLD + dcol) * 4) = rd0; *(uint4*)(smem + RW_MB + (drow * RW2_DQLD + dcol + 4) * 4) = rd1;
  }
  __syncthreads();
  for (int c = 0; c < NCH_; ++c) {
    const bool more = c + 1 < NCH_;
    if (more) {
      const char* rec = rw_rec(p, s, c + 1);
      rp = *(const uint4*)(rec + 16384 + (prow * 64 + pcol) * 2);
      rd0 = *(const uint4*)(rec + 24576 + (drow * 64 + dcol) * 4); rd1 = *(const uint4*)(rec + 24576 + (drow * 64 + dcol + 4) * 4);
    }
    sched_fence();
    if (wid < 2) {
      const char* PT = smem + (c & 1) * RW2_STAGE;
      const float* DQ = (const float*)(PT + RW_MB);
      const int i = wid * 32 + r;
      bf16_t* sd = (bf16_t*)(rw_rec(p, s, c) + 16384);
#pragma unroll
      for (int g = 0; g < 4; ++g) {
        uint2 o0, o1;
        o0.x = pack2bf(S0[4 * g], S0[4 * g + 1]); o0.y = pack2bf(S0[4 * g + 2], S0[4 * g + 3]);
        o1.x = pack2bf(S1[4 * g], S1[4 * g + 1]); o1.y = pack2bf(S1[4 * g + 2], S1[4 * g + 3]);
        *(uint2*)(sd + i * 64 + 8 * g + 4 * h) = o0; *(uint2*)(sd + i * 64 + 32 + 8 * g + 4 * h) = o1;
      }
      bf16x8 bfr[2][2];
#pragma unroll
      for (int s2 = 0; s2 < 2; ++s2) {
        const uint4 u0 = make_uint4(pack2bf(S0[8 * s2], S0[8 * s2 + 1]), pack2bf(S0[8 * s2 + 2], S0[8 * s2 + 3]), pack2bf(S0[8 * s2 + 4], S0[8 * s2 + 5]), pack2bf(S0[8 * s2 + 6], S0[8 * s2 + 7]));
        const uint4 u1 = make_uint4(pack2bf(S1[8 * s2], S1[8 * s2 + 1]), pack2bf(S1[8 * s2 + 2], S1[8 * s2 + 3]), pack2bf(S1[8 * s2 + 4], S1[8 * s2 + 5]), pack2bf(S1[8 * s2 + 6], S1[8 * s2 + 7]));
        __builtin_memcpy(&bfr[0][s2], &u0, 16); __builtin_memcpy(&bfr[1][s2], &u1, 16);
      }
      f32x16 n0, n1;
#pragma unroll
      for (int g = 0; g < 4; ++g) {
        const float4 a = *(const float4*)(DQ + i * RW2_DQLD + 8 * g + 4 * h), bq = *(const float4*)(DQ + i * RW2_DQLD + 32 + 8 * g + 4 * h);
        n0[4 * g] = a.x; n0[4 * g + 1] = a.y; n0[4 * g + 2] = a.z; n0[4 * g + 3] = a.w;
        n1[4 * g] = bq.x; n1[4 * g + 1] = bq.y; n1[4 * g + 2] = bq.z; n1[4 * g + 3] = bq.w;
      }
#pragma unroll
      for (int jb2 = 0; jb2 < 2; ++jb2)
#pragma unroll
        for (int s2 = 0; s2 < 2; ++s2) {
          const char* a0 = PT + ((0 * 32 + r) * RW_LD + jb2 * 32 + 16 * s2 + 4 * h) * 2;
          const char* a1 = PT + ((1 * 32 + r) * RW_LD + jb2 * 32 + 16 * s2 + 4 * h) * 2;
          const uint2 l0 = *(const uint2*)a0, h0 = *(const uint2*)(a0 + 16), l1 = *(const uint2*)a1, h1 = *(const uint2*)(a1 + 16);
          const uint4 u0 = make_uint4(l0.x, l0.y, h0.x, h0.y), u1 = make_uint4(l1.x, l1.y, h1.x, h1.y);
          bf16x8 af0, af1; __builtin_memcpy(&af0, &u0, 16); __builtin_memcpy(&af1, &u1, 16);
          n0 = mfma32(af0, bfr[jb2][s2], n0);
          n1 = mfma32(af1, bfr[jb2][s2], n1);
        }
      S0 = n0; S1 = n1;
    }
    if (more) {
      char* d = smem + ((c + 1) & 1) * RW2_STAGE;
      *(uint4*)(d + (prow * RW_LD + pcol) * 2) = rp;
      *(uint4*)(d + RW_MB + (drow * RW2_DQLD + dcol) * 4) = rd0; *(uint4*)(d + RW_MB + (drow * RW2_DQLD + dcol + 4) * 4) = rd1;
    }
    __syncthreads();
  }
}

DI void rw_out_item(const Params& p, int it, char* smem) {
  const int s = it / NCH_, c = it % NCH_, dir = s >> 3, b = (s >> 2) & 1, hd = s & 3;
  const int tid = opaque_tid(), lane = tid & 63, wid = tid >> 6;
  const bf16_t* rb = (const bf16_t*)(p.ws + OFF_REGION + R_RB16);
  const size_t AS = (size_t)NT_ * 256;
  float* ys = (float*)(p.ws + OFF_REGION + R_YS) + (size_t)dir * NT_ * 256;
  char* const Sm = smem; char* const RyT = smem + RW_MB; char* const MyT = smem + 2 * RW_MB; char* const Vi = smem + 3 * RW_MB;
  const char* rec = rw_rec(p, s, c);
  __syncthreads();
  {
    const int row = tid >> 3, col = (tid & 7) * 8;
    *(uint4*)(Sm + (row * RW_LD + col) * 2) = *(const uint4*)(rec + 16384 + (row * 64 + col) * 2);
    *(uint4*)(RyT + (row * RW_LD + col) * 2) = *(const uint4*)(rec + (row * 64 + col) * 2);
    *(uint4*)(MyT + (row * RW_LD + col) * 2) = *(const uint4*)(rec + 8192 + (row * 64 + col) * 2);
    const int n = seq_tok(dir, b, c * 64 + row);
    const uint4 uv = *(const uint4*)(rb + 1 * AS + (size_t)n * 256 + hd * 64 + col);
    const unsigned av[4] = {uv.x, uv.y, uv.z, uv.w};
#pragma unroll
    for (int q = 0; q < 4; ++q) {
      *(bf16_t*)(Vi + ((col + 2 * q) * RW_LD + row) * 2) = (bf16_t)(av[q] & 0xffff);
      *(bf16_t*)(Vi + ((col + 2 * q + 1) * RW_LD + row) * 2) = (bf16_t)(av[q] >> 16);
    }
  }
  __syncthreads();
  if (wid < 4) {
    const int mb = (wid >> 1) & 1, nb = wid & 1, r = lane & 31, h = lane >> 5;
    f32x16 acc = zero16();
    acc = rw_mm(Sm, RyT, mb, nb, lane, acc);
    acc = rw_mm(Vi, MyT, mb, nb, lane, acc);
    const int n = seq_tok(dir, b, c * 64 + nb * 32 + r);
#pragma unroll
    for (int g = 0; g < 4; ++g)
      *(float4*)(ys + (size_t)n * 256 + hd * 64 + mb * 32 + 8 * g + 4 * h) = make_float4(acc[4 * g], acc[4 * g + 1], acc[4 * g + 2], acc[4 * g + 3]);
  }
}
constexpr int ATT_KLD = 104, ATT_VLD = 68;
constexpr int ATT_KB = 64 * ATT_KLD * 2, ATT_VB = 64 * ATT_VLD * 2, ATT_STAGE = ATT_KB + ATT_VB;
DI float fexp2(float x) {
#ifdef EMU
  return exp2f(x);
#else
  return __builtin_amdgcn_exp2f(x);
#endif
}
#ifdef ABL_NOPV
#define ABL_PV_BEGIN if (t > 100000) {
#define ABL_PV_END }
#else
#define ABL_PV_BEGIN
#define ABL_PV_END
#endif
#ifdef ABL_NOLOAD
#define ABL_LOADS(tk, tv)
#else
#define ABL_LOADS(tk, tv) ATT_LOADK(tk); ATT_LOADV(tv);
#endif
#ifdef ABL_NOEXP
#define ABL_EXP(x) (x)
#else
#define ABL_EXP(x) fexp2(x)
#endif
constexpr int ATT_LDS = 2 * ATT_KB + 2 * ATT_VB;
DI void attn_item(const Params& p, int b, int h, int qt, bool isctx, char* smem) {
  const int tid = opaque_tid(), lane = tid & 63, wid = tid >> 6, r = lane & 31, h2 = lane >> 5;
  const bf16_t* qb = (const bf16_t*)(p.osc + O_QB);
  const bf16_t* kbase = (const bf16_t*)(p.ws + OFF_REGION + R_KB) + (size_t)(b * 8 + h) * KT_ * 96;
  const bf16_t* vbase = (const bf16_t*)(p.ws + OFF_REGION + R_VT) + (size_t)(b * 8 + h) * 64 * KT_;
  bf16_t* att = (bf16_t*)(p.ws + OFF_REGION + R_ATT);
  const int nq0 = isctx ? NX_ + b * CL_ + qt * 256 : b * T_ + qt * 256;
  const int nkt = (isctx ? CL_ : KT_) / 64;
  const int nq = nq0 + wid * 32 + r;
  bf16x8 qf[6];
#pragma unroll
  for (int ks = 0; ks < 6; ++ks) qf[ks] = *(const bf16x8*)(qb + (size_t)nq * 768 + h * 96 + ks * 16 + h2 * 8);
  f32x16 oacc[2] = {zero16(), zero16()};
  float m = -1e30f, lsum = 0.f;
  const float sc = 0.10206207261596577f * 1.4426950408889634f;
  char* const Kst = smem;
  char* const Vst = smem + 2 * ATT_KB;
  const int kc1 = tid + 512, vd = tid >> 3, vc = tid & 7;
  const int ko0 = ((tid / 12) * ATT_KLD + (tid % 12) * 8) * 2, ko1 = ((kc1 / 12) * ATT_KLD + (kc1 % 12) * 8) * 2;
  const int vo = (vd * ATT_VLD + vc * 8) * 2;
  u32x4 rk0, rk1 = {0u, 0u, 0u, 0u}, rv;
#define ATT_LOADK(kt_) { const bf16_t* ksrc_ = kbase + (size_t)(kt_) * 64 * 96; rk0 = *(const u32x4*)(ksrc_ + tid * 8); if (kc1 < 768) rk1 = *(const u32x4*)(ksrc_ + kc1 * 8); }
#define ATT_LOADV(kt_) { rv = *(const u32x4*)(vbase + (size_t)vd * KT_ + (kt_) * 64 + vc * 8); }
#define ATT_STOREK(st_) { char* d_ = Kst + (st_) * ATT_KB; *(u32x4*)(d_ + ko0) = rk0; if (kc1 < 768) *(u32x4*)(d_ + ko1) = rk1; }
#define ATT_STOREV(st_) { char* d_ = Vst + (st_) * ATT_VB; *(uint2*)(d_ + vo) = make_uint2(rv[0], rv[1]); *(uint2*)(d_ + vo + 8) = make_uint2(rv[2], rv[3]); }
#define ATT_QK(dst_, st_) { const char* Ks_ = Kst + (st_) * ATT_KB; dst_[0] = zero16(); dst_[1] = zero16(); \
    _Pragma("unroll") for (int ks = 0; ks < 6; ++ks) _Pragma("unroll") for (int kb = 0; kb < 2; ++kb) { \
      const bf16x8 kf_ = *(const bf16x8*)(Ks_ + ((kb * 32 + r) * ATT_KLD + ks * 16 + h2 * 8) * 2); dst_[kb] = mfma32(kf_, qf[ks], dst_[kb]); } }
  __syncthreads();
  ATT_LOADK(0); ATT_LOADV(0); ATT_STOREK(0); ATT_STOREV(0);
  ATT_LOADK(1); ATT_STOREK(1);
  __syncthreads();
  f32x16 sA[2], sB[2];
  ATT_QK(sA, 0);
#define ATT_SMPV(cur_, t) { \
    float mx = -1e30f; \
    _Pragma("unroll") for (int kb = 0; kb < 2; ++kb) _Pragma("unroll") for (int i = 0; i < 16; ++i) mx = fmaxf(mx, cur_[kb][i]); \
    mx = fmaxf(mx, __shfl_xor(mx, 32)); \
    const float mn = fmaxf(m, mx * sc); \
    if (__ballot(mn > m) != 0ull) { \
      const float alpha = fexp2(m - mn); \
      _Pragma("unroll") for (int db = 0; db < 2; ++db) _Pragma("unroll") for (int i = 0; i < 16; ++i) oacc[db][i] *= alpha; \
      lsum *= alpha; m = mn; } \
    _Pragma("unroll") for (int kb = 0; kb < 2; ++kb) _Pragma("unroll") for (int i = 0; i < 16; ++i) cur_[kb][i] = ABL_EXP(cur_[kb][i] * sc - m); \
    { float ps0 = 0.f, ps1 = 0.f; _Pragma("unroll") for (int i = 0; i < 16; ++i) { ps0 += cur_[0][i]; ps1 += cur_[1][i]; } lsum += ps0 + ps1; } \
    const char* Vs = Vst + ((t) & 1) * ATT_VB; \
    _Pragma("unroll") for (int kb = 0; kb < 2; ++kb) _Pragma("unroll") for (int s2 = 0; s2 < 2; ++s2) { \
      bf16x8 pf; { const u32x4 u = {pack2bf(cur_[kb][8 * s2 + 0], cur_[kb][8 * s2 + 1]), pack2bf(cur_[kb][8 * s2 + 2], cur_[kb][8 * s2 + 3]), \
                                    pack2bf(cur_[kb][8 * s2 + 4], cur_[kb][8 * s2 + 5]), pack2bf(cur_[kb][8 * s2 + 6], cur_[kb][8 * s2 + 7])}; __builtin_memcpy(&pf, &u, 16); } \
      ABL_PV_BEGIN \
      _Pragma("unroll") for (int db = 0; db < 2; ++db) { \
        const char* vrow = Vs + ((db * 32 + r) * ATT_VLD + kb * 32 + 16 * s2 + 4 * h2) * 2; \
        const uint2 lo = *(const uint2*)(vrow), hi = *(const uint2*)(vrow + 16); \
        const u32x4 u = {lo.x, lo.y, hi.x, hi.y}; bf16x8 vf; __builtin_memcpy(&vf, &u, 16); \
        oacc[db] = mfma32(vf, pf, oacc[db]); } ABL_PV_END } }
#define ATT_STEP(cur_, nxt_, t_) { \
    const int t = (t_); \
    const int tk = t + 2 < nkt ? t + 2 : nkt - 1, tv = t + 1 < nkt ? t + 1 : nkt - 1; \
    ABL_LOADS(tk, tv) \
    sched_fence(); \
    if (first_half) { ATT_QK(nxt_, (t + 1) & 1); sched_fence(); ATT_SMPV(cur_, t); } \
    else { ATT_SMPV(cur_, t); sched_fence(); ATT_QK(nxt_, (t + 1) & 1); } \
    sched_fence(); \
    ATT_STOREK(t & 1); ATT_STOREV((t + 1) & 1); \
    __syncthreads(); }
  const bool first_half = rfl(wid) < 4;
  for (int t0 = 0; t0 < nkt; t0 += 2) {
    ATT_STEP(sA, sB, t0);
    ATT_STEP(sB, sA, t0 + 1);
  }
  lsum += __shfl_xor(lsum, 32);
  const float inv = 1.f / lsum;
#pragma unroll
  for (int db = 0; db < 2; ++db)
#pragma unroll
    for (int g = 0; g < 4; ++g) {
      uint2 o;
      o.x = pack2bf(oacc[db][g * 4 + 0] * inv, oacc[db][g * 4 + 1] * inv);
      o.y = pack2bf(oacc[db][g * 4 + 2] * inv, oacc[db][g * 4 + 3] * inv);
      *(uint2*)(att + (size_t)nq * 512 + h * 64 + db * 32 + 8 * g + 4 * h2) = o;
    }
}

constexpr int P3B_ITEMS = RW1_ITEMS + ML2_ITEMS + MLA_Q_TILES + MLA_KV_TILES;
DI void phase3b(const Params& p, int l, char* smem) {
  for (int it = vblock(); it < P3B_ITEMS; it += gridDim.x) {
    int i = it;
    if (i < RW1_ITEMS) { rw_chunk_item(p, i, smem); continue; }
    i -= RW1_ITEMS;
    if (i < ML2_ITEMS) { mlstm_scan_item(p, i); continue; }
    i -= ML2_ITEMS;
    if (i < MLA_Q_TILES) mla_q_item(p, l, i, smem); else mla_kv_item(p, l, i - MLA_Q_TILES, smem);
  }
}

DI constexpr int att_items(int l) { return NB_ * 8 * (T_ / 256) + (l == 0 ? NB_ * 8 * (CL_ / 256) : 0); }
DI void spin_until_ge(int* ctr, int target) {
#ifdef EMU
  while (__atomic_load_n(ctr, __ATOMIC_SEQ_CST) < target) emu::yield();
#else
  while (__hip_atomic_load(ctr, __ATOMIC_RELAXED, __HIP_MEMORY_SCOPE_AGENT) < target) __builtin_amdgcn_s_sleep(8);
#endif
}
DI void phase4(const Params& p, int l, char* smem, int* ctr) {
  const int G = gridDim.x, nsb = G >= 2 * RW2_ITEMS ? RW2_ITEMS : (G > 1 ? G / 2 : 1);
  TSB(p, 50);
  if ((int)blockIdx.x < nsb) {
    for (int s = blockIdx.x; s < RW2_ITEMS; s += nsb) rw_state_item(p, s, smem);
#ifndef EMU
    asm volatile("s_waitcnt vmcnt(0)" ::: "memory");
#endif
    __syncthreads();
    if (opaque_tid() == 0) { __threadfence(); atomicAdd(ctr + 2, (RW2_ITEMS - (int)blockIdx.x + nsb - 1) / nsb); }
    TSB(p, 51);
  }
  const int QT = T_ / 256, CQ = (l == 0 ? (NB_ * 8 * (CL_ / 256)) / 8 : 0), R3 = RW1_ITEMS / 8;
  const int per = 2 * QT + CQ + R3;
  int* sitem = (int*)(smem + 160 * 1024 - 16);
  bool r2ok = false;
  const int x0 = xcc_id();
  for (;;) {
    __syncthreads();
    if (opaque_tid() == 0) {
      int item = -1;
      for (int k = 0; k < 8 && item < 0; ++k) {
        const int x = (x0 + k) & 7;
        if (ld_relaxed(ctr + 8 + x) >= per) continue;
        const int li = atomicAdd(ctr + 8 + x, 1);
        if (li < per) item = x * per + li;
      }
      *sitem = item;
    }
    __syncthreads();
    const int item = *sitem;
    if (item < 0) break;
    const int x = item / per; int li = item % per;
    if (li < 2 * QT) { const int bh = 2 * x + li / QT, qt = li % QT; TSB(p, 54); attn_item(p, bh >> 3, bh & 7, qt, false, smem); TSB(p, 55); continue; }
    li -= 2 * QT;
    if (li < CQ) { const int ci = x * CQ + li, qt = ci % (CL_ / 256), bh = ci / (CL_ / 256); attn_item(p, bh >> 3, bh & 7, qt, true, smem); continue; }
    li -= CQ;
    if (!r2ok) {
      if (opaque_tid() == 0) { spin_until_ge(ctr + 2, RW2_ITEMS); __threadfence(); }
      __syncthreads();
      r2ok = true;
      TSB(p, 52);
    }
    rw_out_item(p, x * R3 + li, smem);
  }
  TSB(p, 53);
}
constexpr int ML3_CC = CL_ / 64, ML3_XC = T_ / 64;
DI constexpr int ml3_items(bool with_ctx) { return NB_ * 4 * (ML3_XC + (with_ctx ? ML3_CC : 0)); }
template <int KS> DI f32x16 ml_mm(const char* A, const char* Bt, int mb, int nb, int lane, f32x16 acc) {
  const int r = lane & 31, h = lane >> 5;
#pragma unroll
  for (int ks = 0; ks < KS; ++ks) {
    const bf16x8 a = *(const bf16x8*)(A + ((mb * 32 + r) * RW_LD + ks * 16 + h * 8) * 2);
    const bf16x8 b = *(const bf16x8*)(Bt + ((nb * 32 + r) * RW_LD + ks * 16 + h * 8) * 2);
    acc = mfma32(a, b, acc);
  }
  return acc;
}
DI float wave_incl_scan_max(float v, int lane) {
  for (int d = 1; d < 64; d <<= 1) { const float o = __shfl_up(v, d); if (lane >= d) v = fmaxf(v, o); }
  return v;
}
DI void mlstm_out_item(const Params& p, int l, int it, bool with_ctx, char* smem) {
  const int per = ML3_XC + (with_ctx ? ML3_CC : 0);
  const int bh = it / per, b = bh >> 2, hd = bh & 3;
  int tc = it % per; if (!with_ctx) tc += ML3_CC;
  const bool isctx = tc < ML3_CC;
  const int ntok0 = isctx ? NX_ + b * CL_ + tc * 64 : b * T_ + (tc - ML3_CC) * 64;
  char* const Qm = smem;
  char* const Km = smem + 1 * RW_MB;
  char* const Qp = smem + 2 * RW_MB;
  char* const Vi = smem + 3 * RW_MB;
  char* const Pp = smem + 4 * RW_MB;
  char* const Cm = smem + 5 * RW_MB;
  float* const hs = (float*)(smem + 6 * RW_MB);
  float* const ga = hs + 64 * 64;
  float* const denp = ga + 5 * 64;
  float* const nsv = denp + 128;
  const float* zrec = (const float*)(p.ws + OFF_REGION + R_ZREC);
  const int tid = opaque_tid(), lane = tid & 63, wid = tid >> 6;
  __syncthreads();
  for (int idx = tid; idx < 64 * 64; idx += NTHR) hs[idx] = 0.f;
#pragma unroll 1
  for (int dir = 0; dir < 2; ++dir) {
    const int c = dir == 0 ? tc : (isctx ? ML3_CC - 1 - tc : ML3_CC + (ML3_XC - 1 - (tc - ML3_CC)));
    const int s = dir * 8 + b * 4 + hd;
    const float* st = (const float*)(p.ws + OFF_REGION + R_MLST) + ((size_t)s * NCH_ + c) * ML_ST;
    const float m_start = st[2082];
    __syncthreads();
    {
      const int j = tid >> 3, pt = tid & 7;
      const int n = ntok0 + (dir ? 63 - j : j);
      const float* zr = zrec + (size_t)n * ZREC_W;
      const float4 q4 = *(const float4*)(zr + ZR_MLQ + hd * 32 + pt * 4), k4 = *(const float4*)(zr + ZR_MLK + hd * 32 + pt * 4);
      const float4 c4 = *(const float4*)(st + j * 32 + pt * 4);
      const float4 va = *(const float4*)(zr + ZR_MLV + hd * 64 + pt * 8), vb = *(const float4*)(zr + ZR_MLV + hd * 64 + pt * 8 + 4);
      const float qs = 0.17677669529663687f;
      const float q0 = q4.x * qs, q1 = q4.y * qs, q2 = q4.z * qs, q3 = q4.w * qs;
      *(uint2*)(Qm + (j * RW_LD + pt * 4) * 2) = make_uint2(pack2bf(q0, q1), pack2bf(q2, q3));
      *(uint2*)(Km + (j * RW_LD + pt * 4) * 2) = make_uint2(pack2bf(k4.x, k4.y), pack2bf(k4.z, k4.w));
      *(uint2*)(Cm + (j * RW_LD + pt * 4) * 2) = make_uint2(pack2bf(c4.x, c4.y), pack2bf(c4.z, c4.w));
      const float vv[8] = {va.x, va.y, va.z, va.w, vb.x, vb.y, vb.z, vb.w};
#pragma unroll
      for (int u = 0; u < 8; ++u) *(bf16_t*)(Vi + ((pt * 8 + u) * RW_LD + j) * 2) = f2bf(vv[u]);
      if (tid < 32) nsv[tid] = st[2048 + tid];
      const float4 n4 = *(const float4*)(st + 2048 + pt * 4);
      float nq = n4.x * q0 + n4.y * q1 + n4.z * q2 + n4.w * q3;
      nq += __shfl_xor(nq, 1); nq += __shfl_xor(nq, 2); nq += __shfl_xor(nq, 4);
      if (pt == 0) ga[4 * 64 + j] = nq;
    }
    if (wid == 0) {
      const int n = ntok0 + (dir ? 63 - lane : lane);
      const float fp = zrec[(size_t)n * ZREC_W + ZR_MLF + dir * 4 + hd] + p.ml_b_f[(l * 2 + dir) * 4 + hd];
      const float ipre = zrec[(size_t)n * ZREC_W + ZR_MLI + dir * 4 + hd] + p.ml_b_i[(l * 2 + dir) * 4 + hd];
      const float bj = wave_incl_scan(logsigmoidf_(fp), lane);
      const float g = ipre - bj;
      const float pm = wave_incl_scan_max(g, lane);
      const float c0 = wave_max(g);
      const float mj = fmaxf(bj + m_start, bj + pm);
      ga[0 * 64 + lane] = fexp(g - c0);
      ga[1 * 64 + lane] = fexp(fminf(bj + c0 - mj, 80.f));
      ga[2 * 64 + lane] = fexp(bj + m_start - mj);
      ga[3 * 64 + lane] = fexp(fminf(-mj, 80.f));
    }
    __syncthreads();
    if (wid < 4) {
      const int mb = wid >> 1, nb = wid & 1, r = lane & 31, h = lane >> 5;
      f32x16 acc = zero16();
      if (!(mb == 1 && nb == 0)) acc = ml_mm<2>(Km, Qm, mb, nb, lane, acc);
      rw_mask_upper(acc, mb, nb, lane, false);
      const float al = ga[1 * 64 + nb * 32 + r];
      float csum = 0.f;
#pragma unroll
      for (int i = 0; i < 16; ++i) { acc[i] *= ga[0 * 64 + mb * 32 + crow(i, h)] * al; csum += acc[i]; }
      csum += __shfl_xor(csum, 32);
      if (h == 0) denp[mb * 64 + nb * 32 + r] = csum;
      rw_wrT(Pp, mb, nb, lane, acc);
    } else {
      const int t2 = tid - 256, j = t2 >> 2, d8 = (t2 & 3) * 8;
      const float in = ga[2 * 64 + j];
      const uint4 u = *(const uint4*)(Qm + (j * RW_LD + d8) * 2);
      const unsigned w[4] = {u.x, u.y, u.z, u.w};
      unsigned o[4];
#pragma unroll
      for (int q = 0; q < 4; ++q) o[q] = pack2bf(bf2f((bf16_t)(w[q] & 0xffff)) * in, bf2f((bf16_t)(w[q] >> 16)) * in);
      *(uint4*)(Qp + (j * RW_LD + d8) * 2) = make_uint4(o[0], o[1], o[2], o[3]);
    }
    __syncthreads();
    if (wid < 4) {
      const int mb = wid >> 1, nb = wid & 1, r = lane & 31, h = lane >> 5;
      f32x16 acc = zero16();
      acc = ml_mm<4>(Vi, Pp, mb, nb, lane, acc);
      acc = ml_mm<2>(Cm, Qp, mb, nb, lane, acc);
      const int j = nb * 32 + r;
      const float den = denp[j] + denp[64 + j] + ga[2 * 64 + j] * ga[4 * 64 + j];
      const float rden = frcp(fmaxf(fabsf(den), ga[3 * 64 + j]));
      float* hrow = hs + (dir ? 63 - j : j) * 64 + mb * 32 + 4 * h;
#pragma unroll
      for (int g4 = 0; g4 < 4; ++g4) {
        float4 o = *(float4*)(hrow + 8 * g4);
        o.x += acc[4 * g4] * rden; o.y += acc[4 * g4 + 1] * rden; o.z += acc[4 * g4 + 2] * rden; o.w += acc[4 * g4 + 3] * rden;
        *(float4*)(hrow + 8 * g4) = o;
      }
    }
  }
  __syncthreads();
  const int tk = tid >> 3, v0 = (tid & 7) * 8, n = ntok0 + tk;
  float ss = 0.f; float hv[8];
#pragma unroll
  for (int u = 0; u < 8; ++u) { hv[u] = hs[tk * 64 + v0 + u]; ss += hv[u] * hv[u]; }
  ss += __shfl_xor(ss, 1); ss += __shfl_xor(ss, 2); ss += __shfl_xor(ss, 4);
  const float rs = frsq(ss * (1.f / 64.f) + 1e-6f);
  unsigned o[4];
#pragma unroll
  for (int u = 0; u < 8; u += 2) {
    const int cc = hd * 64 + v0 + u;
    const float a = hv[u] * rs * p.ml_g_norm[l * 256 + cc] * sigmoidf_(zrec[(size_t)n * ZREC_W + ZR_MLO + cc]);
    const float bq = hv[u + 1] * rs * p.ml_g_norm[l * 256 + cc + 1] * sigmoidf_(zrec[(size_t)n * ZREC_W + ZR_MLO + cc + 1]);
    o[u >> 1] = pack2bf(a, bq);
  }
  bf16_t* mlo = (bf16_t*)(p.ws + OFF_REGION + R_MLO);
  *(uint4*)(mlo + (size_t)n * 256 + hd * 64 + v0) = make_uint4(o[0], o[1], o[2], o[3]);
}

DI constexpr int rwo_items(bool with_ctx) { return (with_ctx ? NT_ : NX_) / 16; }
DI void rwkv_out_item(const Params& p, int l, int it, char* smem) {
  float* sg = (float*)smem;
  const float* zrec = (const float*)(p.ws + OFF_REGION + R_ZREC);
  const bf16_t* rb = (const bf16_t*)(p.ws + OFF_REGION + R_RB16);
  const float* bso = (const float*)(p.ws + OFF_REGION + R_BS);
  const float* ys = (const float*)(p.ws + OFF_REGION + R_YS);
  bf16_t* rwo = (bf16_t*)(p.ws + OFF_REGION + R_RWO);
  const float* mu = p.rw_mu + (size_t)l * 1152;
  const int tid = opaque_tid(), n0 = it * 16;
  __syncthreads();
  for (int idx = tid; idx < 16 * 128; idx += NTHR) {
    const int tt = idx >> 7, k = idx & 127, n = n0 + tt, t = tok_t(n), c = 1024 + k;
    const int len = n < NX_ ? T_ : CL_;
    const float* zr = zrec + (size_t)n * ZREC_W + ZR_RW + c;
    const float z = zr[0];
    const float zp = t > 0 ? zr[-ZREC_W] : 0.f, zn = t < len - 1 ? zr[ZREC_W] : 0.f;
    sg[k * 16 + tt] = sigmoidf_(z + (0.5f * (zp + zn) - z) * mu[c]);
  }
  __syncthreads();
  const int col = tid & 255, half = tid >> 8;
  float acc[8];
#pragma unroll
  for (int i = 0; i < 8; ++i) acc[i] = 0.f;
  const float* g2 = p.rw_g2 + (size_t)l * 128 * 256 + col;
  for (int k = 0; k < 128; ++k) {
    const float gv = g2[k * 256];
    const float* sk = sg + k * 16 + half * 8;
#pragma unroll
    for (int i = 0; i < 8; ++i) acc[i] += sk[i] * gv;
  }
  const size_t AS = (size_t)NT_ * 256;
  const float lw = p.rw_lnx_w[(size_t)l * 256 + col], lb = p.rw_lnx_b[(size_t)l * 256 + col];
#pragma unroll
  for (int i = 0; i < 8; ++i) {
    const int n = n0 + half * 8 + i;
    const size_t o = (size_t)n * 256 + col;
    const float y = ys[o] + ys[AS + o];
    const float mean = wave_sum(y) * (1.f / 64.f);
    const float dv = y - mean;
    const float var = wave_sum(dv * dv) * (1.f / 64.f);
    const float yn = dv * (frsq(var + 64e-5f)) * lw + lb;
    const float v = bf2f(rb[1 * AS + o]);
    const float bsum = bso[(size_t)n * 4 + (col >> 6)] + bso[((size_t)NT_ + n) * 4 + (col >> 6)];
    rwo[o] = f2bf((yn + bsum * v) * acc[i]);
  }
}
DI void phase5(const Params& p, int l, bool with_ctx, char* smem) {
  const int n1 = ml3_items(with_ctx), n2 = rwo_items(with_ctx);
  for (int it = blockIdx.x; it < n1 + n2; it += gridDim.x) {
    if (it < n1) mlstm_out_item(p, l, it, with_ctx, smem);
    else rwkv_out_item(p, l, it - n1, smem);
  }
}
DI void phase_merge(const Params& p, int l, bool with_ctx, char* smem) {
  const bf16_t* H = (const bf16_t*)(p.ws + OFF_H);
  const char* W = p.ws + OFF_WMIX + (size_t)l * WM_SIZE;
  const bf16_t* Wg = (const bf16_t*)(W + WM_GATE);
  const bf16_t* att = (const bf16_t*)(p.ws + OFF_REGION + R_ATT);
  const bf16_t* mlo = (const bf16_t*)(p.ws + OFF_REGION + R_MLO);
  const bf16_t* rwo = (const bf16_t*)(p.ws + OFF_REGION + R_RWO);
  bf16_t* ymix = (bf16_t*)(p.osc + O_YMIX);
  const int TM = (with_ctx ? NT_ : NX_) / 128;
  for (int it = vblock(); it < TM * 8; it += gridDim.x) {
    const int tid = opaque_tid();
    const int tm = it >> 3, tn = it & 7;
    __syncthreads();
    f32x16 yacc[G128::MB][G128::NB];
#pragma unroll
    for (int a = 0; a < G128::MB; ++a)
#pragma unroll
      for (int b = 0; b < G128::NB; ++b) yacc[a][b] = zero16();
#pragma unroll
    for (int i = 0; i < 3; ++i) {
      f32x16 gacc[G128::MB][G128::NB], bacc[G128::MB][G128::NB];
#pragma unroll
      for (int a = 0; a < G128::MB; ++a)
#pragma unroll
        for (int b = 0; b < G128::NB; ++b) { gacc[a][b] = zero16(); bacc[a][b] = zero16(); }
      const bf16_t* A0 = H + (size_t)tm * 128 * 1024;
      G128::run(gacc, [&](int r) { return A0 + (size_t)r * 1024; }, Wg + ((size_t)i * 1024 + tn * 128) * 1024, 1024, 1024, smem);
      const bf16_t* br = i == 0 ? att : (i == 1 ? mlo : rwo);
      const int kb = i == 0 ? 512 : 256;
      const bf16_t* Wb = (const bf16_t*)(W + (i == 0 ? WM_BRA : (i == 1 ? WM_BRM : WM_BRR)));
      const bf16_t* B0 = br + (size_t)tm * 128 * kb;
      G128::run(bacc, [&](int r) { return B0 + (size_t)r * kb; }, Wb + (size_t)tn * 128 * kb, kb, kb, smem);
#pragma unroll
      for (int a = 0; a < G128::MB; ++a)
#pragma unroll
        for (int b = 0; b < G128::NB; ++b)
#pragma unroll
          for (int e = 0; e < 16; ++e) yacc[a][b][e] += sigmoidf_(gacc[a][b][e]) * bacc[a][b][e];
    }
    {
      const int lane = tid & 63, wid = tid >> 6, wm = wid / 4, wn = wid % 4;
      float* scr = (float*)(smem + wid * WTile<1>::BYTES);
#pragma unroll
      for (int mb = 0; mb < G128::MB; ++mb) {
        WTile<1>::put(scr, 0, lane, yacc[mb][0]);
        const int row0 = tm * 128 + wm * 64 + mb * 32, col0 = tn * 128 + wn * 32;
        WTile<1>::rows8(scr, lane, [&](int r, int c, const float4& a, const float4& bq) {
          *(uint4*)(ymix + (size_t)(row0 + r) * 1024 + col0 + c) = pack8bf(a, bq); });
      }
    }
  }
}

DI void phase_wout(const Params& p, int l, bool with_ctx, char* smem) {
  const bf16_t* ymix = (const bf16_t*)(p.osc + O_YMIX);
  const bf16_t* Wo = (const bf16_t*)(p.ws + OFF_WMIX + (size_t)l * WM_SIZE + WM_OUT);
  float* xs = (float*)(p.ws + OFF_XS);
  const float* mod = (const float*)(p.ws + OFF_MOD) + (size_t)l * 3 * 6144;
  const int TM = (with_ctx ? NT_ : NX_) / 128;
  const int n_g = TM * 8;
  for (int it = vblock(); it < n_g + CVT_MOE_TILES; it += gridDim.x) {
    if (it >= n_g) { cvt_moe_item(p, l, it - n_g, smem); continue; }
    const int tid = opaque_tid();
    const int tm = it >> 3, tn = it & 7;
    __syncthreads();
    f32x16 acc[G128::MB][G128::NB];
#pragma unroll
    for (int a = 0; a < G128::MB; ++a)
#pragma unroll
      for (int b = 0; b < G128::NB; ++b) acc[a][b] = zero16();
    const bf16_t* A0 = ymix + (size_t)tm * 128 * 1024;
    G128::run(acc, [&](int r) { return A0 + (size_t)r * 1024; }, Wo + (size_t)tn * 128 * 1024, 1024, 1024, smem);
    const float* m2 = mod + (size_t)tok_modrow(tm * 128) * 6144 + 2 * 1024;
    {
      const int lane = tid & 63, wid = tid >> 6, wm = wid / 4, wn = wid % 4;
      float* scr = (float*)(smem + wid * WTile<1>::BYTES);
#pragma unroll
      for (int mb = 0; mb < G128::MB; ++mb) {
        WTile<1>::put(scr, 0, lane, acc[mb][0]);
        const int row0 = tm * 128 + wm * 64 + mb * 32, col0 = tn * 128 + wn * 32;
        WTile<1>::rows4(scr, lane, [&](int r, int c, const float4& a) {
          float4* d = (float4*)(xs + (size_t)(row0 + r) * 1024 + col0 + c);
          const float4 g = *(const float4*)(m2 + col0 + c); float4 x = *d;
          x.x += g.x * a.x; x.y += g.y * a.y; x.z += g.z * a.z; x.w += g.w * a.w; *d = x; });
      }
    }
  }
}

typedef Gemm<128, 64, 64, 4, 2> GRT;
DI void phase_router(const Params& p, int l, bool with_ctx, char* smem, int* cnt) {
  float* xs = (float*)(p.ws + OFF_XS);
  bf16_t* H = (bf16_t*)(p.ws + OFF_H);
  const float* mod = (const float*)(p.ws + OFF_MOD) + (size_t)l * 3 * 6144;
  const bf16_t* Wr = (const bf16_t*)(p.ws + OFF_WMIX + (size_t)l * WM_SIZE + WM_RT);
  int* eidx = (int*)(p.ws + OFF_REGION + R_EIDX);
  float* ewt = (float*)(p.ws + OFF_REGION + R_EWT);
  int* erank = (int*)(p.ws + OFF_REGION + R_ERANK);
  int* elist = (int*)(p.ws + OFF_REGION + R_ELIST);
  float* sc = (float*)(smem + GRT::SMEM);
  float* bs = sc + 128 * 65;
  float* gs = bs + 128 * 65;
  int* lcnt = (int*)(gs + 128 * 9);
  int* lbase = lcnt + 64;
  const int tid = opaque_tid(), lane = tid & 63, wid = tid >> 6;
  const int ntok = with_ctx ? NT_ : NX_;
  for (int it = blockIdx.x; it < ntok / 128; it += gridDim.x) {
    const int n0 = it * 128;
    __syncthreads();
    TSB(p, 40);
    if (tid < 64) lcnt[tid] = 0;
#pragma unroll 1
    for (int r4 = 0; r4 < 16; r4 += 4) {
      float v[4][16];
#pragma unroll
      for (int u = 0; u < 4; ++u) {
        const int n = n0 + wid * 16 + r4 + u;
#pragma unroll
        for (int j = 0; j < 4; ++j) {
          const float4 t = *(const float4*)(xs + (size_t)n * 1024 + (j * 64 + lane) * 4);
          v[u][j * 4] = t.x; v[u][j * 4 + 1] = t.y; v[u][j * 4 + 2] = t.z; v[u][j * 4 + 3] = t.w;
        }
      }
#pragma unroll
      for (int u = 0; u < 4; ++u) {
        const int n = n0 + wid * 16 + r4 + u;
        const float* m = mod + (size_t)tok_modrow(n) * 6144;
        row_norm_mod(v[u], p.g_ffn + (size_t)l * 1024, m + 3 * 1024, m + 4 * 1024, H + (size_t)n * 1024, lane);
      }
    }
    __syncthreads();
    TSB(p, 41);
    f32x16 acc[1][1]; acc[0][0] = zero16();
    const bf16_t* A0 = H + (size_t)n0 * 1024;
    GRT::run(acc, [&](int r) { return A0 + (size_t)r * 1024; }, Wr, 1024, 1024, smem);
    {
      const int col = GRT::col_of(tid, 0);
      const float rb = p.router_bias[l * 64 + col];
#pragma unroll
      for (int e = 0; e < 16; ++e) {
        const int row = GRT::row_of(tid, 0, e);
        const float s = sigmoidf_(acc[0][0][e]);
        sc[row * 65 + col] = s; bs[row * 65 + col] = s + rb;
      }
    }
    __syncthreads();
    TSB(p, 42);
    int sel[8], lrk[8]; float wsum = 0.f;
    if (tid < 128) {
      float* b = bs + tid * 65; const float* s = sc + tid * 65; float* g = gs + tid * 9;
      for (int gi = 0; gi < 8; ++gi) {
        float m1 = -1e30f, m2 = -1e30f;
        for (int j = 0; j < 8; ++j) { const float x = b[gi * 8 + j]; if (x > m1) { m2 = m1; m1 = x; } else if (x > m2) m2 = x; }
        g[gi] = m1 + m2;
      }
      unsigned gmask = 0;
      for (int c = 0; c < 4; ++c) {
        int best = 0; float bv = -1e30f;
        for (int gi = 0; gi < 8; ++gi) if (!((gmask >> gi) & 1) && g[gi] > bv) { bv = g[gi]; best = gi; }
        gmask |= 1u << best;
      }
      for (int gi = 0; gi < 8; ++gi) if (!((gmask >> gi) & 1)) for (int j = 0; j < 8; ++j) b[gi * 8 + j] = -1e30f;
      wsum = 0.f;
#pragma unroll
      for (int c = 0; c < 8; ++c) {
        int best = 0; float bv = -1e30f;
        for (int e = 0; e < 64; ++e) { const float x = b[e]; if (x > bv) { bv = x; best = e; } }
        b[best] = -3e30f; sel[c] = best; wsum += s[best];
        lrk[c] = atomicAdd(lcnt + best, 1);
      }
    }
    __syncthreads();
    if (tid < 64) { const int c = lcnt[tid]; lbase[tid] = c ? atomicAdd(cnt + tid * 32, c) : 0; }
    __syncthreads();
    if (tid < 128) {
      const int n = n0 + tid;
      const float* s = sc + tid * 65;
      const float inv = 2.5f / (wsum + 1e-20f);
#pragma unroll
      for (int c = 0; c < 8; ++c) {
        const int e = sel[c];
        const int rk = lbase[e] + lrk[c];
        eidx[n * 8 + c] = e; ewt[n * 8 + c] = s[e] * inv; erank[n * 8 + c] = rk;
        elist[(size_t)e * NT_ + rk] = n * 8 + c;
      }
    }
    __syncthreads();
    TSB(p, 43);
  }
}

typedef Gemm<128, 256, 32, 2, 4> GMOE;
constexpr int ACT_LD = 264;
constexpr int MOE_ACT_OFF = GMOE::SMEM;
constexpr int MOE_INFO_OFF = MOE_ACT_OFF + 128 * ACT_LD * 2;
static_assert(MOE_INFO_OFF + 128 * 8 + 67 * 4 * 2 <= 160 * 1024 - 16, "moe lds");
DI void moe_down_run(f32x16 (&acc)[GMOE::MB][GMOE::NB], const char* actl, const bf16_t* Bt, char* smem) {
  constexpr int BK = 32, LDA = GMOE::LDA, CPR = 4, BCH = GMOE::BCH, STG = GMOE::B_BYTES;
  const int tid = opaque_tid(), lane = tid & 63, wid = tid >> 6, wm = wid / 4, wn = wid % 4;
  const int kc = (tid % CPR) * 8, r0 = tid / CPR;
  u32x4 rb[BCH];
  char* Bs0 = smem;
#pragma unroll
  for (int i = 0; i < BCH; ++i) rb[i] = *(const u32x4*)(Bt + (size_t)(r0 + i * 128) * 256 + kc);
#pragma unroll
  for (int i = 0; i < BCH; ++i) *(u32x4*)(Bs0 + ((r0 + i * 128) * LDA + kc) * 2) = rb[i];
  __syncthreads();
  for (int kt = 0; kt < 256 / BK; ++kt) {
    const int kn = (kt + 1 < 256 / BK ? kt + 1 : kt) * BK;
#pragma unroll
    for (int i = 0; i < BCH; ++i) rb[i] = *(const u32x4*)(Bt + (size_t)(r0 + i * 128) * 256 + kn + kc);
    sched_fence();
    const char* Bs = Bs0 + (kt & 1) * STG;
#pragma unroll
    for (int ks = 0; ks < BK / 16; ++ks) {
      bf16x8 af[GMOE::MB], bfr[GMOE::NB];
#pragma unroll
      for (int mb = 0; mb < GMOE::MB; ++mb)
        af[mb] = *(const bf16x8*)(actl + ((wm * 64 + mb * 32 + (lane & 31)) * ACT_LD + kt * BK + ks * 16 + (lane >> 5) * 8) * 2);
#pragma unroll
      for (int nb = 0; nb < GMOE::NB; ++nb)
        bfr[nb] = *(const bf16x8*)(Bs + ((wn * 64 + nb * 32 + (lane & 31)) * LDA + ks * 16 + (lane >> 5) * 8) * 2);
#pragma unroll
      for (int mb = 0; mb < GMOE::MB; ++mb)
#pragma unroll
        for (int nb = 0; nb < GMOE::NB; ++nb) acc[mb][nb] = mfma32(af[mb], bfr[nb], acc[mb][nb]);
    }
    sched_fence();
    {
      char* Bd = Bs0 + ((kt + 1) & 1) * STG;
#pragma unroll
      for (int i = 0; i < BCH; ++i) *(u32x4*)(Bd + ((r0 + i * 128) * LDA + kc) * 2) = rb[i];
    }
    __syncthreads();
  }
}
DI void phase_moe(const Params& p, int l, bool with_ctx, char* smem, const int* cnt) {
  const bf16_t* H = (const bf16_t*)(p.ws + OFF_H);
  const bf16_t* GU = (const bf16_t*)(p.ws + OFF_REGION + R_WMOE + WE_GU);
  const bf16_t* DN = (const bf16_t*)(p.ws + OFF_REGION + R_WMOE + WE_DN);
  const float* ewt = (const float*)(p.ws + OFF_REGION + R_EWT);
  const int* elist = (const int*)(p.ws + OFF_REGION + R_ELIST);
  bf16_t* ybuf = (bf16_t*)(p.ws + OFF_REGION + R_YBUF);
  char* actl = smem + MOE_ACT_OFF;
  int* rtok = (int*)(smem + MOE_INFO_OFF);
  float* rwt = (float*)(rtok + 128);
  int* pre = (int*)(rwt + 128);
  int* off = pre + 67;
  int tid = threadIdx.x;
  const int ntok = with_ctx ? NT_ : NX_;
  __syncthreads();
  if (tid == 0) {
    int a = 0, o = 0;
    for (int e = 0; e < 65; ++e) { const int c = e < 64 ? cnt[e * 32] : ntok; pre[e] = a; off[e] = o; a += (c + 127) >> 7; o += c; }
    pre[65] = a; off[65] = o;
  }
  __syncthreads();
  const int total = pre[65];
  for (int it = vblock(); it < total; it += gridDim.x) {
    tid = opaque_tid();
    int e0 = 0;
    while (pre[e0 + 1] <= it) ++e0;
    const int e = rfl(e0);
    const int rb = rfl(it - pre[e]);
    const int c = rfl(e < 64 ? cnt[e * 32] : ntok);
    const int obase = rfl(off[e] + rb * 128);
    __syncthreads();
    if (tid < 128) {
      const int slot = rb * 128 + tid;
      int tok = 0; float w = 0.f;
      if (slot < c) {
        if (e < 64) { const int pk = elist[(size_t)e * NT_ + slot]; tok = pk >> 3; w = ewt[pk]; }
        else { tok = slot; w = 1.f; }
      }
      rtok[tid] = tok; rwt[tid] = w;
    }
    __syncthreads();
    const bf16_t* Wgu = GU + (size_t)e * 512 * 1024;
#pragma unroll 1
    for (int hf = 0; hf < 2; ++hf) {
      f32x16 acc[GMOE::MB][GMOE::NB];
#pragma unroll
      for (int a = 0; a < GMOE::MB; ++a)
#pragma unroll
        for (int b = 0; b < GMOE::NB; ++b) acc[a][b] = zero16();
      GMOE::run(acc, [&](int r) { return H + (size_t)rtok[r] * 1024; }, Wgu + (size_t)hf * 256 * 1024, 1024, 1024, smem);
      const int lane = tid & 63, wn = (tid >> 6) % 4, wmr = ((tid >> 6) / 4) * 64 + 4 * (lane >> 5);
      const int j = (hf * 4 + wn) * 32 + (lane & 31);
#pragma unroll
      for (int mb = 0; mb < GMOE::MB; ++mb)
#pragma unroll
        for (int i = 0; i < 16; ++i) {
          const int row = wmr + mb * 32 + (i & 3) + 8 * (i >> 2);
          const float g = acc[mb][0][i], u = acc[mb][1][i];
          *(bf16_t*)(actl + (row * ACT_LD + j) * 2) = f2bf(siluf_(g) * u);
        }
    }
    __syncthreads();
    const bf16_t* Wd = DN + (size_t)e * 1024 * 256;
#pragma unroll 1
    for (int nt = 0; nt < 4; ++nt) {
      f32x16 acc[GMOE::MB][GMOE::NB];
#pragma unroll
      for (int a = 0; a < GMOE::MB; ++a)
#pragma unroll
        for (int b = 0; b < GMOE::NB; ++b) acc[a][b] = zero16();
      moe_down_run(acc, actl, Wd + (size_t)nt * 256 * 256, smem);
      {
        const int lane = tid & 63, wid = tid >> 6, wm = wid / 4, wn = wid % 4;
        float* scr = (float*)(smem + wid * WTile<1>::BYTES);
#pragma unroll
        for (int mb = 0; mb < GMOE::MB; ++mb)
#pragma unroll
          for (int nb = 0; nb < GMOE::NB; ++nb) {
            WTile<1>::put(scr, 0, lane, acc[mb][nb]);
            const int row0 = wm * 64 + mb * 32, col0 = nt * 256 + wn * 64 + nb * 32;
            WTile<1>::rows8(scr, lane, [&](int r, int cq, const float4& a, const float4& bq) {
              const int row = row0 + r;
              if (rb * 128 + row < c) {
                const float w = rwt[row];
                const float4 a2 = make_float4(a.x * w, a.y * w, a.z * w, a.w * w), b2 = make_float4(bq.x * w, bq.y * w, bq.z * w, bq.w * w);
                *(uint4*)(ybuf + ((size_t)obase + row) * 1024 + col0 + cq) = pack8bf(a2, b2);
              } });
          }
        __syncthreads();
      }
    }
  }
}

DI void phase_combine(const Params& p, int l, bool last, char* smem, const int* cnt) {
  float* xs = (float*)(p.ws + OFF_XS);
  bf16_t* H = (bf16_t*)(p.ws + OFF_H);
  const float* mod = (const float*)(p.ws + OFF_MOD);
  const int* eidx = (const int*)(p.ws + OFF_REGION + R_EIDX);
  const int* erank = (const int*)(p.ws + OFF_REGION + R_ERANK);
  const bf16_t* ybuf = (const bf16_t*)(p.ws + OFF_REGION + R_YBUF);
  int* off = (int*)smem;
  const int tid = opaque_tid(), lane = tid & 63, wid = tid >> 6;
  const int ntok = last ? NX_ : NT_;
  __syncthreads();
  if (tid == 0) { int o = 0; for (int e = 0; e < 64; ++e) { off[e] = o; o += cnt[e * 32]; } off[64] = o; }
  __syncthreads();
  for (int n = blockIdx.x * 8 + wid; n < ntok; n += gridDim.x * 8) {
    float acc[16];
#pragma unroll
    for (int i = 0; i < 16; ++i) acc[i] = 0.f;
    for (int k = 0; k < 9; ++k) {
      const int row = k < 8 ? off[eidx[n * 8 + k]] + erank[n * 8 + k] : off[64] + n;
      const bf16_t* y = ybuf + (size_t)row * 1024;
#pragma unroll
      for (int j = 0; j < 4; ++j) {
        const uint2 u = *(const uint2*)(y + (j * 64 + lane) * 4);
        acc[j * 4 + 0] += bf2f((bf16_t)(u.x & 0xffff)); acc[j * 4 + 1] += bf2f((bf16_t)(u.x >> 16));
        acc[j * 4 + 2] += bf2f((bf16_t)(u.y & 0xffff)); acc[j * 4 + 3] += bf2f((bf16_t)(u.y >> 16));
      }
    }
    const float* m5 = mod + ((size_t)l * 3 + tok_modrow(n)) * 6144 + 5 * 1024;
    float v[16];
#pragma unroll
    for (int j = 0; j < 4; ++j) {
      const int c = (j * 64 + lane) * 4;
      const float4 x = *(const float4*)(xs + (size_t)n * 1024 + c), g = *(const float4*)(m5 + c);
      v[j * 4 + 0] = x.x + g.x * acc[j * 4 + 0]; v[j * 4 + 1] = x.y + g.y * acc[j * 4 + 1];
      v[j * 4 + 2] = x.z + g.z * acc[j * 4 + 2]; v[j * 4 + 3] = x.w + g.w * acc[j * 4 + 3];
      if (!last) *(float4*)(xs + (size_t)n * 1024 + c) = make_float4(v[j * 4], v[j * 4 + 1], v[j * 4 + 2], v[j * 4 + 3]);
    }
    if (!last) {
      const float* m = mod + ((size_t)(l + 1) * 3 + tok_modrow(n)) * 6144;
      row_norm_mod(v, p.g_mix + (size_t)(l + 1) * 1024, m, m + 1024, H + (size_t)n * 1024, lane);
    } else {
      float ss = 0.f;
#pragma unroll
      for (int i = 0; i < 16; ++i) ss += v[i] * v[i];
      ss = wave_sum(ss);
      const float rs = frsq(ss * (1.f / 1024.f) + 1e-6f);
#pragma unroll
      for (int j = 0; j < 4; ++j) {
        const int c = (j * 64 + lane) * 4;
        const float4 g = *(const float4*)(p.g_final + c);
        *(float4*)(p.out + (size_t)n * 1024 + c) = make_float4(v[j * 4] * rs * g.x, v[j * 4 + 1] * rs * g.y, v[j * 4 + 2] * rs * g.z, v[j * 4 + 3] * rs * g.w);
      }
    }
  }
}
#define SMEM_BYTES (160 * 1024)
#ifndef MEGA
#define MEGA 0
#endif
DI int* cnt_ptr(const Params& p, int l) { return (int*)(p.ws + OFF_CNT) + 1024 + 2048 * l; }
DI int* ctr_ptr(const Params& p, int l) { return (int*)(p.ws + OFF_CNT) + 32 * l; }
#if !MEGA
__global__ void __launch_bounds__(NTHR) k_phaseA(Params p) { SMEM_DECL(smem, SMEM_BYTES); phaseA(p, smem); }
__global__ void __launch_bounds__(NTHR) k_norm0(Params p) { phase_norm0(p); }
__global__ void __launch_bounds__(NTHR) k_win(Params p, int l) { SMEM_DECL(smem, SMEM_BYTES); phase_win(p, l, smem); }
__global__ void __launch_bounds__(NTHR) k_p3(Params p, int l) { SMEM_DECL(smem, SMEM_BYTES); phase3(p, l, smem); }
__global__ void __launch_bounds__(NTHR) k_p3b(Params p, int l) { SMEM_DECL(smem, SMEM_BYTES); phase3b(p, l, smem); }
__global__ void __launch_bounds__(NTHR) k_p4(Params p, int l) { SMEM_DECL(smem, SMEM_BYTES); phase4(p, l, smem, ctr_ptr(p, l)); }
__global__ void __launch_bounds__(NTHR) k_p5(Params p, int l, int wc) { SMEM_DECL(smem, SMEM_BYTES); phase5(p, l, wc != 0, smem); }
__global__ void __launch_bounds__(NTHR) k_merge(Params p, int l, int wc) { SMEM_DECL(smem, SMEM_BYTES); phase_merge(p, l, wc != 0, smem); }
__global__ void __launch_bounds__(NTHR) k_wout(Params p, int l, int wc) { SMEM_DECL(smem, SMEM_BYTES); phase_wout(p, l, wc != 0, smem); }
__global__ void __launch_bounds__(NTHR) k_router(Params p, int l, int wc) { SMEM_DECL(smem, SMEM_BYTES); phase_router(p, l, wc != 0, smem, cnt_ptr(p, l)); }
__global__ void __launch_bounds__(NTHR) k_moe(Params p, int l, int wc) { SMEM_DECL(smem, SMEM_BYTES); phase_moe(p, l, wc != 0, smem, cnt_ptr(p, l)); }
__global__ void __launch_bounds__(NTHR) k_combine(Params p, int l, int last) { SMEM_DECL(smem, SMEM_BYTES); phase_combine(p, l, last != 0, smem, cnt_ptr(p, l)); }
#else
#ifndef EMU
#define XB_TMO      128
#define XB_XCNT(j)  (256  + 64 * (j))
#define XB_XSUB(j)  (1280 + 64 * (j))
#define XB_XGEN(j)  (2304 + 64 * (j))
#define XB_TOP      3328
#define XB_TOPGEN   3392
#define XCD_BAR_WORDS 3456
#define XB_SPIN_CAP (1u << 24)
#define LAS __attribute__((address_space(3)))
DI unsigned xb_ld(unsigned* p) { return __hip_atomic_load(p, __ATOMIC_RELAXED, __HIP_MEMORY_SCOPE_AGENT); }
DI unsigned xb_add(unsigned* p, unsigned v) { return __hip_atomic_fetch_add(p, v, __ATOMIC_RELAXED, __HIP_MEMORY_SCOPE_AGENT); }
DI unsigned xb_xcc_id() { return (unsigned)__builtin_amdgcn_s_getreg((3 << 11) | 20) & 0xFu; }
#define XB_SPIN(cond, bar) do { unsigned _sp = 0; while (cond) { __builtin_amdgcn_s_sleep(1); \
    if ((++_sp & 255u) == 0u) { if (xb_ld(&(bar)[XB_TMO])) break; if (_sp > XB_SPIN_CAP) { atomicAdd(&(bar)[XB_TMO], 1u); break; } } } } while (0)
struct XcdBarrier { unsigned* bar; unsigned x; volatile LAS unsigned* st; };
DI XcdBarrier xcd_barrier_post(unsigned* bar, volatile LAS unsigned* st) {
  XcdBarrier b; b.bar = bar; b.x = xb_xcc_id(); b.st = st;
  if (threadIdx.x == 0) (void)xb_add(&bar[XB_XCNT(b.x)], 1u);
  return b;
}
DI void xcd_barrier_complete(unsigned* bar, unsigned x, unsigned& nloc, unsigned& nx) {
  const unsigned G = gridDim.x * gridDim.y * gridDim.z;
  unsigned sum, cnt, mine, sp = 0u;
  for (;;) {
    sum = 0u; cnt = 0u; mine = 0u;
#pragma unroll
    for (unsigned j = 0; j < 16; ++j) { const unsigned c = xb_ld(&bar[XB_XCNT(j)]); sum += c; cnt += (c > 0u) ? 1u : 0u; mine = (j == x) ? c : mine; }
    if (sum == G) break;
    __builtin_amdgcn_s_sleep(1);
    if ((++sp & 255u) == 0u) { if (xb_ld(&bar[XB_TMO])) break; if (sp > XB_SPIN_CAP) { atomicAdd(&bar[XB_TMO], 1u); break; } }
  }
  nloc = mine > 0u ? mine : 1u; nx = cnt > 0u ? cnt : 1u;
}
DI void xcd_barrier(const XcdBarrier& b) {
  asm volatile("s_waitcnt vmcnt(0)" ::: "memory");
  __syncthreads();
  if (threadIdx.x == 0) {
    unsigned* bar = b.bar;
    __builtin_amdgcn_s_waitcnt(0);
    unsigned nloc = b.st[0], nx = b.st[1];
    if (nloc == 0u) { xcd_barrier_complete(bar, b.x, nloc, nx); b.st[0] = nloc; b.st[1] = nx; }
    const unsigned old = xb_add(&bar[XB_XSUB(b.x)], 1u);
    const unsigned gen = old / nloc;
    if (old + 1u == (gen + 1u) * nloc) {
      __builtin_amdgcn_fence(__ATOMIC_RELEASE, "agent");
      asm volatile("s_waitcnt vmcnt(0)" ::: "memory");
      const unsigned og = xb_add(&bar[XB_TOP], 1u);
      const unsigned tg = og / nx;
      if (og + 1u == (tg + 1u) * nx) xb_add(&bar[XB_TOPGEN], 1u);
      else XB_SPIN(xb_ld(&bar[XB_TOPGEN]) == tg, bar);
      __builtin_amdgcn_fence(__ATOMIC_ACQUIRE, "agent");
      xb_add(&bar[XB_XGEN(b.x)], 1u);
      asm volatile("s_waitcnt vmcnt(0)" ::: "memory");
    } else {
      XB_SPIN(xb_ld(&bar[XB_XGEN(b.x)]) == gen, bar);
      __builtin_amdgcn_fence(__ATOMIC_ACQUIRE, "agent");
      asm volatile("s_waitcnt vmcnt(0)" ::: "memory");
    }
  }
  __syncthreads();
}
#define GSYNC() { XcdBarrier xb_; xb_.bar = (unsigned*)(p.ws + OFF_BAR); xb_.x = xb_xcc_id(); xb_.st = (volatile LAS unsigned*)(smem + SMEM_BYTES - 32); xcd_barrier(xb_); }
#else
#define GSYNC() emu::grid_barrier()
#endif
#ifdef PROBE_IDX
#define TS(i) { if (blockIdx.x == 0 && threadIdx.x == 0) ts[i] = wall_clock64(); }
#else
#define TS(i)
#endif
__global__ void __launch_bounds__(NTHR) k_mega(Params p) {
  SMEM_DECL(smem, SMEM_BYTES);
  cooperative_groups::grid_group grid = cooperative_groups::this_grid();
  volatile LAS unsigned* xst = (volatile LAS unsigned*)(smem + SMEM_BYTES - 32);
  if (threadIdx.x == 0) { xst[0] = 0u; xst[1] = 0u; }
  __syncthreads();
  (void)xcd_barrier_post((unsigned*)(p.ws + OFF_BAR), xst);
#ifdef PROBE_IDX
  long long* ts = (long long*)(p.ws + OFF_CNT + 2048);
#endif
  TS(0);
  phaseA(p, smem);
  grid.sync(); TS(1);
  phase_norm0(p);
  GSYNC(); TS(2);
#pragma unroll 1
  for (int l = 0; l < 2; ++l) {
    const bool wc = l == 0;
    phase_win(p, l, smem); GSYNC(); TS(3 + l * 10);
    phase3(p, l, smem); GSYNC(); TS(4 + l * 10);
    phase3b(p, l, smem); GSYNC(); TS(5 + l * 10);
    phase4(p, l, smem, ctr_ptr(p, l)); GSYNC(); TS(6 + l * 10);
    phase5(p, l, wc, smem); GSYNC(); TS(7 + l * 10);
    phase_merge(p, l, wc, smem); GSYNC(); TS(8 + l * 10);
    phase_wout(p, l, wc, smem); GSYNC(); TS(9 + l * 10);
    phase_router(p, l, wc, smem, cnt_ptr(p, l)); GSYNC(); TS(10 + l * 10);
    phase_moe(p, l, wc, smem, cnt_ptr(p, l)); GSYNC(); TS(11 + l * 10);
    phase_combine(p, l, l == 1, smem, cnt_ptr(p, l));
#ifdef PROBE_IDX
    GSYNC(); TS(12 + l * 10);
#else
    if (l == 0) GSYNC();
#endif
  }
#ifdef PROBE_IDX
  if (blockIdx.x == 0 && threadIdx.x == 0) {
    const float us = (float)(ts[PROBE_IDX + 1] - ts[PROBE_IDX]) * 0.01f;
    p.out[0] += PROBE_IDX >= 40 ? rintf(6.f * log2f(fmaxf(us * 16.f, 1.f))) : rintf(6.f * log2f(fmaxf(us, 1.f)));
  }
#endif
}
#endif

extern "C" void kernel_launch(void* const* d_in, const int* in_sizes, int n_in, void* d_out, int out_size, void* d_ws,
                              size_t ws_size, hipStream_t stream) {
  Params p{};
  const float** pp = (const float**)&p;
  for (int i = 0; i < 41; ++i) pp[i] = (const float*)d_in[i];
  p.out = (float*)d_out; p.ws = (char*)d_ws; p.osc = (char*)d_out;
  if (ws_size < WS_NEEDED) { fprintf(stderr, "workspace too small: %zu < %zu\n", ws_size, (size_t)WS_NEEDED); return; }
#if !MEGA
  const dim3 g(256), b(NTHR);
  hipLaunchKernelGGL(k_phaseA, g, b, 0, stream, p);
  hipLaunchKernelGGL(k_norm0, g, b, 0, stream, p);
  for (int l = 0; l < 2; ++l) {
    const int wc = l == 0;
    hipLaunchKernelGGL(k_win, g, b, 0, stream, p, l);
    hipLaunchKernelGGL(k_p3, g, b, 0, stream, p, l);
    hipLaunchKernelGGL(k_p3b, g, b, 0, stream, p, l);
    hipLaunchKernelGGL(k_p4, g, b, 0, stream, p, l);
    hipLaunchKernelGGL(k_p5, g, b, 0, stream, p, l, wc);
    hipLaunchKernelGGL(k_merge, g, b, 0, stream, p, l, wc);
    hipLaunchKernelGGL(k_wout, g, b, 0, stream, p, l, wc);
    hipLaunchKernelGGL(k_router, g, b, 0, stream, p, l, wc);
    hipLaunchKernelGGL(k_moe, g, b, 0, stream, p, l, wc);
    hipLaunchKernelGGL(k_combine, g, b, 0, stream, p, l, l == 1);
  }
#else
  static int grid_blocks = 0;
  if (!grid_blocks) {
    int dev = 0, cus = 0, per_cu = 0;
    hipGetDevice(&dev);
    hipDeviceGetAttribute(&cus, hipDeviceAttributeMultiprocessorCount, dev);
    hipOccupancyMaxActiveBlocksPerMultiprocessor(&per_cu, k_mega, NTHR, 0);
    if (per_cu > 1) per_cu = 1;
    grid_blocks = cus * per_cu;
  }
  hipMemsetAsync(p.ws + OFF_BAR, 0, 16384, stream);
  void* args[] = {&p};
  hipError_t e = hipLaunchCooperativeKernel((void*)k_mega, dim3(grid_blocks), dim3(NTHR), args, 0, stream);
  if (e != hipSuccess) fprintf(stderr, "cooperative launch failed: %s (grid %d)\n", hipGetErrorString(e), grid_blocks);
#endif
}
```

```cpp
#define MEGA 1
#include <hip/hip_runtime.h>
#include <hip/hip_cooperative_groups.h>
#include <cstdio>

#ifndef SEQ_T
#define SEQ_T 8192
#endif
#ifndef CTX_L
#define CTX_L 256
#endif

#define DI __device__ __forceinline__
typedef unsigned short bf16_t;
typedef short bf16x8 __attribute__((ext_vector_type(8)));
typedef float f32x16 __attribute__((ext_vector_type(16)));
typedef float f32x4 __attribute__((ext_vector_type(4)));
typedef unsigned u32x4 __attribute__((ext_vector_type(4)));

constexpr int NB_ = 2, T_ = SEQ_T, CL_ = CTX_L, D_ = 1024;
constexpr int NX_ = NB_ * T_, NC_ = NB_ * CL_, NT_ = NX_ + NC_, KT_ = CL_ + T_;
constexpr int GRID_W_ = 64;
constexpr int MLA_H = 8, MLA_NOPE_ = 64, MLA_ROPE_ = 32, MLA_DK = 96, MLA_DV = 64, QLORA = 384, KVLORA = 256;
constexpr int MLA_IN_ = 672, ML_IN_ = 784, RW_IN_ = 1152, GATE_IN_ = 3072, D_IN_ = 5680;
constexpr int ZMLA_W = 768;
constexpr int ZREC_W = 1936;
constexpr int WIN_N = 768 + 2048;
constexpr int ML_H = 4, ML_DK = 32, ML_DV = 64, ML_L = 64;
constexpr int RW_H = 4, RW_N_ = 64;
constexpr int NE_ = 64, TOPK_ = 8, DE_ = 256;
constexpr int NCH_ = KT_ / ML_L;
constexpr int NSEQ_ = 2 * NB_ * 4;

constexpr int ZR_MLQ = 0, ZR_MLK = 128, ZR_MLV = 256, ZR_MLO = 512, ZR_MLI = 768, ZR_MLF = 776;
constexpr int ZR_RW = 784;

constexpr size_t al256(size_t x) { return (x + 255) & ~(size_t)255; }
constexpr size_t WM_WIN = 0;
constexpr size_t WM_GATE = WM_WIN + (size_t)WIN_N * 1024 * 2;
constexpr size_t WM_UQ = WM_GATE + (size_t)3072 * 1024 * 2;
constexpr size_t WM_UKV = WM_UQ + (size_t)768 * 384 * 2;
constexpr size_t WM_BRA = WM_UKV + (size_t)1024 * 256 * 2;
constexpr size_t WM_BRM = WM_BRA + (size_t)1024 * 512 * 2;
constexpr size_t WM_BRR = WM_BRM + (size_t)1024 * 256 * 2;
constexpr size_t WM_OUT = WM_BRR + (size_t)1024 * 256 * 2;
constexpr size_t WM_RT = WM_OUT + (size_t)1024 * 1024 * 2;
constexpr size_t WM_SIZE = al256(WM_RT + (size_t)64 * 1024 * 2);
constexpr size_t WE_GU = 0;
constexpr size_t WE_DN = WE_GU + (size_t)65 * 512 * 1024 * 2;
constexpr size_t WE_SIZE = al256(WE_DN + (size_t)65 * 1024 * 256 * 2);

constexpr size_t OFF_XS = 0;
constexpr size_t OFF_MOD = OFF_XS + al256((size_t)NT_ * 1024 * 4);
constexpr size_t OFF_ROPE = OFF_MOD + al256((size_t)2 * 3 * 6144 * 4);
constexpr size_t OFF_H = OFF_ROPE + al256((size_t)T_ * 16 * 8);
constexpr size_t OFF_WMIX = OFF_H + al256((size_t)NT_ * 1024 * 2);
constexpr size_t OFF_CNT = OFF_WMIX + 2 * WM_SIZE;
constexpr size_t OFF_BAR = OFF_CNT + 32768;
constexpr size_t OFF_REGION = OFF_BAR + 16384;
constexpr size_t R_ZREC = 0;
constexpr size_t R_RB16 = R_ZREC + al256((size_t)NT_ * ZREC_W * 4);
constexpr size_t R_LW = R_RB16 + al256((size_t)7 * NT_ * 256 * 2);
constexpr size_t R_BS = R_LW + al256((size_t)2 * NT_ * 256 * 4);
constexpr size_t R_CH = R_BS + al256((size_t)2 * NT_ * 4 * 4);
constexpr size_t R_YS = R_CH + al256((size_t)NSEQ_ * NCH_ * 40960);
constexpr size_t R_MLST = R_YS + al256((size_t)2 * NT_ * 256 * 4);
constexpr size_t R_ATT = R_MLST + al256((size_t)NSEQ_ * NCH_ * 2112 * 4);
constexpr size_t R_MLO = R_ATT + al256((size_t)NT_ * 512 * 2);
constexpr size_t R_RWO = R_MLO + al256((size_t)NT_ * 256 * 2);
constexpr size_t R_VT = R_RWO + al256((size_t)NT_ * 256 * 2);
constexpr size_t R_KB = R_VT + al256((size_t)NB_ * MLA_H * 64 * KT_ * 2);
constexpr size_t R_MIX_END = R_KB + al256((size_t)NB_ * MLA_H * KT_ * 96 * 2);
constexpr int NSLOT_ = NT_ * 9;
constexpr size_t R_YBUF = 0;
constexpr size_t R_EIDX = R_YBUF + al256((size_t)NSLOT_ * 1024 * 2);
constexpr size_t R_EWT = R_EIDX + al256((size_t)NT_ * 8 * 4);
constexpr size_t R_ERANK = R_EWT + al256((size_t)NT_ * 8 * 4);
constexpr size_t R_ELIST = R_ERANK + al256((size_t)NT_ * 8 * 4);
constexpr size_t R_WMOE = R_ELIST + al256((size_t)64 * NT_ * 4);
constexpr size_t R_MOE_END = R_WMOE + WE_SIZE;
constexpr size_t R_SIZE = R_MIX_END > R_MOE_END ? R_MIX_END : R_MOE_END;
constexpr size_t WS_NEEDED = OFF_REGION + R_SIZE;
constexpr size_t O_ZMLA = 0;
constexpr size_t O_QB = O_ZMLA + al256((size_t)NT_ * ZMLA_W * 2);
constexpr size_t O_END = O_QB + al256((size_t)NT_ * 768 * 2);
constexpr size_t O_YMIX = 0;
#if SEQ_T == 8192 && CTX_L == 256
static_assert(O_END <= (size_t)NX_ * 1024 * 4, "d_out scratch overflow");
static_assert((size_t)NT_ * 1024 * 2 <= (size_t)NX_ * 1024 * 4, "ymix overflow");
static_assert(WS_NEEDED <= (size_t)597000000, "workspace too large");
#endif

struct Params {
  const float *x, *c, *ctx, *c_ctx, *w_mod, *b_mod, *g_mix, *g_ffn, *w_in, *g_cq, *w_uq, *g_ckv, *w_uk, *w_uv;
  const float *ml_b_i, *ml_b_f, *ml_g_norm, *rw_mu, *rw_w0, *rw_w2, *rw_a0, *rw_a2, *rw_g2, *rw_k_k, *rw_k_a;
  const float *rw_r_k, *rw_lnx_w, *rw_lnx_b, *w_br_mla, *w_br_ml, *w_br_rw, *w_out, *w_router, *router_bias;
  const float *w_e_gate, *w_e_up, *w_e_down, *w_s_gate, *w_s_up, *w_s_down, *g_final;
  float* out; char* ws; char* osc;
};

DI float bf2f(bf16_t s) { unsigned u = ((unsigned)s) << 16; float f; __builtin_memcpy(&f, &u, 4); return f; }
DI bf16_t f2bf(float x) { unsigned u; __builtin_memcpy(&u, &x, 4); u += 0x7fffu + ((u >> 16) & 1u); return (bf16_t)(u >> 16); }
DI unsigned pack2bf(float a, float b) {
#ifdef EMU
  return (unsigned)f2bf(a) | ((unsigned)f2bf(b) << 16);
#else
  typedef __bf16 bf2 __attribute__((ext_vector_type(2)));
  typedef float f2 __attribute__((ext_vector_type(2)));
  f2 v = {a, b}; bf2 r = __builtin_convertvector(v, bf2); return __builtin_bit_cast(unsigned, r);
#endif
}
DI f32x16 mfma32(bf16x8 a, bf16x8 b, f32x16 c) {
#ifdef EMU
  return emu_mfma_32x32x16_bf16(a, b, c);
#else
  return __builtin_amdgcn_mfma_f32_32x32x16_bf16(a, b, c, 0, 0, 0);
#endif
}
DI int rfl(int v) {
#ifdef EMU
  return v;
#else
  return __builtin_amdgcn_readfirstlane(v);
#endif
}
DI int opaque_tid() {
#ifdef EMU
  return threadIdx.x;
#else
  int t = threadIdx.x; asm volatile("" : "+v"(t)); return t;
#endif
}
DI void wave_sync() {
#ifdef EMU
  (void)__ballot(1);
#else
  asm volatile("" ::: "memory");
#endif
}
DI int vblock() {
  const int g = gridDim.x, b = blockIdx.x;
  return (g & 7) == 0 ? (b & 7) * (g >> 3) + (b >> 3) : b;
}
DI int xcc_id() {
#ifdef EMU
  return blockIdx.x & 7;
#else
  return (int)(__builtin_amdgcn_s_getreg((3 << 11) | 20) & 7u);
#endif
}
DI int ld_relaxed(int* p) {
#ifdef EMU
  return __atomic_load_n(p, __ATOMIC_SEQ_CST);
#else
  return __hip_atomic_load(p, __ATOMIC_RELAXED, __HIP_MEMORY_SCOPE_AGENT);
#endif
}
DI void sched_fence() {
#ifndef EMU
  __builtin_amdgcn_sched_barrier(0);
#endif
}
template <int L> DI float lane_bcast(float x) {
#ifdef EMU
  return __shfl(x, L);
#else
  return __builtin_bit_cast(float, __builtin_amdgcn_readlane(__builtin_bit_cast(int, x), L));
#endif
}
DI f32x16 zero16() { f32x16 z; for (int i = 0; i < 16; ++i) z[i] = 0.f; return z; }
DI int crow(int reg, int h) { return (reg & 3) + 8 * (reg >> 2) + 4 * h; }
#ifdef EMU
DI float fexp(float x) { return expf(x); }
#else
DI float fexp(float x) { return __expf(x); }
#endif
#ifdef EMU
DI float frcp(float x) { return 1.f / x; }
DI float frsq(float x) { return 1.f / sqrtf(x); }
#else
DI float frcp(float x) { return __builtin_amdgcn_rcpf(x); }
DI float frsq(float x) { return __builtin_amdgcn_rsqf(x); }
#endif
DI float sigmoidf_(float x) { return frcp(1.f + fexp(-x)); }
DI float siluf_(float x) { return x * sigmoidf_(x); }
#ifdef EMU
DI float wave_sum(float v) { for (int m = 32; m >= 1; m >>= 1) v += __shfl_xor(v, m); return v; }
DI float wave_max(float v) { for (int m = 32; m >= 1; m >>= 1) v = fmaxf(v, __shfl_xor(v, m)); return v; }
#else
#define DPPF(x, ctrl) __builtin_bit_cast(float, __builtin_amdgcn_mov_dpp(__builtin_bit_cast(int, (x)), (ctrl), 0xf, 0xf, true))
#define RDLF(x, l) __builtin_bit_cast(float, __builtin_amdgcn_readlane(__builtin_bit_cast(int, (x)), (l)))
DI float wave_sum(float v) {
  v += DPPF(v, 0xB1); v += DPPF(v, 0x4E); v += DPPF(v, 0x124); v += DPPF(v, 0x128);
  return (RDLF(v, 0) + RDLF(v, 16)) + (RDLF(v, 32) + RDLF(v, 48));
}
DI float wave_max(float v) {
  v = fmaxf(v, DPPF(v, 0xB1)); v = fmaxf(v, DPPF(v, 0x4E)); v = fmaxf(v, DPPF(v, 0x124)); v = fmaxf(v, DPPF(v, 0x128));
  return fmaxf(fmaxf(RDLF(v, 0), RDLF(v, 16)), fmaxf(RDLF(v, 32), RDLF(v, 48)));
}
#endif

DI int tok_b(int n) { return n < NX_ ? n / T_ : (n - NX_) / CL_; }
DI int tok_t(int n) { return n < NX_ ? n % T_ : (n - NX_) % CL_; }
DI int tok_key(int n) { return n < NX_ ? CL_ + n % T_ : (n - NX_) % CL_; }
DI int tok_modrow(int n) { return n < NX_ ? n / T_ : 2; }

#ifdef EMU
#define SMEM_DECL(name, bytes) char* name = (char*)emu::shared_alloc(bytes)
#else
#define SMEM_DECL(name, bytes) __shared__ __attribute__((aligned(16))) char name[bytes]
#endif
#define NTHR 512
#if defined(PROBE_IDX) && !defined(EMU)
#define TSB(pp, i) { if (blockIdx.x == 0 && threadIdx.x == 0) ((long long*)((pp).ws + OFF_CNT + 2048))[i] = wall_clock64(); }
#else
#define TSB(pp, i)
#endif
struct CvtJob { const float* src; int lds; int K; bf16_t* dst; int ntn; int ntk; int maptype; const float* gain; };
DI int cvt_map(int maptype, int coff, int np) {
  if (maptype == 0) return coff + np;
  if (maptype == 1) { if (np < 672) return np; if (np < 768) return -1; if (np < 768 + 1936) return np - 96; return -1; }
  return np;
}
struct CvtItem { CvtJob j; int coff, tk, tn; };
struct CvtRegs { float v[8]; };
DI void cvt_load(const CvtItem& c, int tid, CvtRegs& r) {
  const int kk = tid >> 4, np = c.tn * 64 + (tid & 15) * 4;
  const int sc = cvt_map(c.j.maptype, c.coff, np);
#pragma unroll
  for (int u = 0; u < 2; ++u) {
    const int k = c.tk * 64 + kk + 32 * u;
    float4 v = make_float4(0.f, 0.f, 0.f, 0.f);
    if (sc >= 0) v = *(const float4*)(c.j.src + (size_t)k * c.j.lds + sc);
    const float g = c.j.gain ? c.j.gain[k] : 1.f;
    r.v[4 * u] = v.x * g; r.v[4 * u + 1] = v.y * g; r.v[4 * u + 2] = v.z * g; r.v[4 * u + 3] = v.w * g;
  }
}
DI void cvt_store(const CvtItem& c, int tid, const CvtRegs& r, char* smem) {
  float* tile = (float*)smem;
  __syncthreads();
  {
    const int kk = tid >> 4, nc = (tid & 15) * 4;
#pragma unroll
    for (int u = 0; u < 2; ++u)
#pragma unroll
      for (int i = 0; i < 4; ++i) tile[(kk + 32 * u) * 65 + nc + i] = r.v[4 * u + i];
  }
  __syncthreads();
  {
    const int n = tid >> 3, kc = (tid & 7) * 8;
    int np = c.tn * 64 + n;
    if (c.j.maptype == 2) np = (np >> 5) * 64 + c.coff * 32 + (np & 31);
    uint4 v;
    v.x = pack2bf(tile[(kc + 0) * 65 + n], tile[(kc + 1) * 65 + n]);
    v.y = pack2bf(tile[(kc + 2) * 65 + n], tile[(kc + 3) * 65 + n]);
    v.z = pack2bf(tile[(kc + 4) * 65 + n], tile[(kc + 5) * 65 + n]);
    v.w = pack2bf(tile[(kc + 6) * 65 + n], tile[(kc + 7) * 65 + n]);
    *(uint4*)(c.j.dst + (size_t)np * c.j.K + c.tk * 64 + kc) = v;
  }
}
template <class Dec> DI void cvt_run(Dec dec, int first, int n, int stride, char* smem) {
  const int tid = opaque_tid();
  if (first >= n) return;
  CvtItem cur = dec(first); CvtRegs rc; cvt_load(cur, tid, rc);
  for (int it = first; it < n; it += stride) {
    const int nx = it + stride < n ? it + stride : it;
    CvtItem nxt = dec(nx); CvtRegs rn; cvt_load(nxt, tid, rn);
    sched_fence();
    cvt_store(cur, tid, rc, smem);
    cur = nxt; rc = rn;
  }
}

constexpr int CVT_MIX_TILES = 704 + 768 + 72 + 32 + 32 + 128 + 64 + 64 + 256 + 16;
DI CvtItem cvt_mix_dec(const Params& p, int l, int it) {
  bf16_t* W = (bf16_t*)(p.ws + OFF_WMIX + (size_t)l * WM_SIZE);
  CvtJob j; int coff = 0;
  if (it < 704) { j = {p.w_in + (size_t)l * 1024 * D_IN_, D_IN_, 1024, (bf16_t*)((char*)W + WM_WIN), 44, 16, 1, nullptr}; }
  else if ((it -= 704) < 768) { j = {p.w_in + (size_t)l * 1024 * D_IN_, D_IN_, 1024, (bf16_t*)((char*)W + WM_GATE), 48, 16, 0, nullptr}; coff = 2608; }
  else if ((it -= 768) < 72) { j = {p.w_uq + (size_t)l * 384 * 768, 768, 384, (bf16_t*)((char*)W + WM_UQ), 12, 6, 0, p.g_cq + l * 384}; }
  else if ((it -= 72) < 32) { j = {p.w_uk + (size_t)l * 256 * 512, 512, 256, (bf16_t*)((char*)W + WM_UKV), 8, 4, 0, p.g_ckv + l * 256}; }
  else if ((it -= 32) < 32) { j = {p.w_uv + (size_t)l * 256 * 512, 512, 256, (bf16_t*)((char*)W + WM_UKV) + 512 * 256, 8, 4, 0, p.g_ckv + l * 256}; }
  else if ((it -= 32) < 128) { j = {p.w_br_mla + (size_t)l * 512 * 1024, 1024, 512, (bf16_t*)((char*)W + WM_BRA), 16, 8, 0, nullptr}; }
  else if ((it -= 128) < 64) { j = {p.w_br_ml + (size_t)l * 256 * 1024, 1024, 256, (bf16_t*)((char*)W + WM_BRM), 16, 4, 0, nullptr}; }
  else if ((it -= 64) < 64) { j = {p.w_br_rw + (size_t)l * 256 * 1024, 1024, 256, (bf16_t*)((char*)W + WM_BRR), 16, 4, 0, nullptr}; }
  else if ((it -= 64) < 256) { j = {p.w_out + (size_t)l * 1024 * 1024, 1024, 1024, (bf16_t*)((char*)W + WM_OUT), 16, 16, 0, nullptr}; }
  else { it -= 256; j = {p.w_router + (size_t)l * 1024 * 64, 64, 1024, (bf16_t*)((char*)W + WM_RT), 1, 16, 0, nullptr}; }
  CvtItem c; c.j = j; c.coff = coff; c.tk = it / j.ntn; c.tn = it % j.ntn; return c;
}
constexpr int CVT_MOE_TILES = 65 * 192;
DI CvtItem cvt_moe_dec(const Params& p, int l, int it) {
  const int e = it / 192; int r = it % 192;
  bf16_t* GU = (bf16_t*)(p.ws + OFF_REGION + R_WMOE + WE_GU) + (size_t)e * 512 * 1024;
  bf16_t* DN = (bf16_t*)(p.ws + OFF_REGION + R_WMOE + WE_DN) + (size_t)e * 1024 * 256;
  const float* sg = e < 64 ? p.w_e_gate + ((size_t)l * 64 + e) * 1024 * 256 : p.w_s_gate + (size_t)l * 1024 * 256;
  const float* su = e < 64 ? p.w_e_up + ((size_t)l * 64 + e) * 1024 * 256 : p.w_s_up + (size_t)l * 1024 * 256;
  const float* sd = e < 64 ? p.w_e_down + ((size_t)l * 64 + e) * 256 * 1024 : p.w_s_down + (size_t)l * 256 * 1024;
  CvtJob j; int coff = 0;
  if (r < 64) { j = {sg, 256, 1024, GU, 4, 16, 2, nullptr}; coff = 0; }
  else if ((r -= 64) < 64) { j = {su, 256, 1024, GU, 4, 16, 2, nullptr}; coff = 1; }
  else { r -= 64; j = {sd, 1024, 256, DN, 16, 4, 0, nullptr}; }
  CvtItem c; c.j = j; c.coff = coff; c.tk = r / j.ntn; c.tn = r % j.ntn; return c;
}

DI void mod_item(const Params& p, int it, char* smem) {
  float* cond = (float*)smem;
  float* red = cond + 3 * 1024;
  const int tid = opaque_tid(), l = it / 96, j0 = (it % 96) * 64;
  __syncthreads();
  for (int i = tid; i < 3 * 1024; i += NTHR) {
    const int r = i >> 10, k = i & 1023;
    const float v = r < 2 ? p.c[r * 1024 + k] : p.c_ctx[k];
    cond[i] = siluf_(v);
  }
  __syncthreads();
  const int jj = tid & 63, kg = tid >> 6;
  float a0 = 0.f, a1 = 0.f, a2 = 0.f;
  const float* w = p.w_mod + (size_t)l * 1024 * 6144 + j0 + jj;
  for (int k = kg; k < 1024; k += 8) {
    const float wv = w[(size_t)k * 6144];
    a0 += cond[k] * wv; a1 += cond[1024 + k] * wv; a2 += cond[2048 + k] * wv;
  }
  red[(kg * 3 + 0) * 64 + jj] = a0; red[(kg * 3 + 1) * 64 + jj] = a1; red[(kg * 3 + 2) * 64 + jj] = a2;
  __syncthreads();
  if (tid < 192) {
    const int r = tid >> 6; float s = 0.f;
    for (int g = 0; g < 8; ++g) s += red[(g * 3 + r) * 64 + jj];
    float* mod = (float*)(p.ws + OFF_MOD);
    mod[((size_t)l * 3 + r) * 6144 + j0 + jj] = s + p.b_mod[(size_t)l * 6144 + j0 + jj];
  }
}
DI void rope_item(const Params& p, int it) {
  const int idx = it * NTHR + threadIdx.x;
  if (idx >= T_ * 16) return;
  const int t = idx >> 4, i = idx & 15, f = i & 7;
  const float pos = (float)(i < 8 ? t / GRID_W_ : t % GRID_W_);
  const float inv = powf(10000.f, -(float)(2 * f) / 16.f);
  const float ang = pos * inv;
  float2* rt = (float2*)(p.ws + OFF_ROPE);
  rt[idx] = make_float2(cosf(ang), sinf(ang));
}
constexpr int PA_ITEMS = 192 + (T_ * 16 + NTHR - 1) / NTHR;
DI void phaseA(const Params& p, char* smem) {
  if (blockIdx.x == 0) for (int i = threadIdx.x; i < 8192; i += NTHR) ((int*)(p.ws + OFF_CNT))[i] = 0;
  for (int it = blockIdx.x; it < PA_ITEMS; it += gridDim.x) {
    if (it < 192) mod_item(p, it, smem); else rope_item(p, it - 192);
  }
  cvt_run([&](int i) { return cvt_mix_dec(p, i / CVT_MIX_TILES, i % CVT_MIX_TILES); }, blockIdx.x, 2 * CVT_MIX_TILES, gridDim.x, smem);
}

DI void row_norm_mod(const float (&v)[16], const float* g, const float* shift, const float* scale, bf16_t* hrow, int lane) {
  float ss = 0.f;
#pragma unroll
  for (int i = 0; i < 16; ++i) ss += v[i] * v[i];
  ss = wave_sum(ss);
  const float rs = frsq(ss * (1.f / 1024.f) + 1e-6f);
#pragma unroll
  for (int j = 0; j < 4; ++j) {
    const int c = (j * 64 + lane) * 4;
    const float4 gg = *(const float4*)(g + c), sh = *(const float4*)(shift + c), sc = *(const float4*)(scale + c);
    const float h0 = v[j * 4 + 0] * rs * gg.x * (1.f + sc.x) + sh.x;
    const float h1 = v[j * 4 + 1] * rs * gg.y * (1.f + sc.y) + sh.y;
    const float h2 = v[j * 4 + 2] * rs * gg.z * (1.f + sc.z) + sh.z;
    const float h3 = v[j * 4 + 3] * rs * gg.w * (1.f + sc.w) + sh.w;
    uint2 o; o.x = pack2bf(h0, h1); o.y = pack2bf(h2, h3);
    *(uint2*)(hrow + c) = o;
  }
}
DI void phase_norm0(const Params& p) {
  const int lane = threadIdx.x & 63, wid = threadIdx.x >> 6;
  float* xs = (float*)(p.ws + OFF_XS);
  bf16_t* H = (bf16_t*)(p.ws + OFF_H);
  const float* mod = (const float*)(p.ws + OFF_MOD);
  for (int n = blockIdx.x * 8 + wid; n < NT_; n += gridDim.x * 8) {
    const float* src = n < NX_ ? p.x + (size_t)n * 1024 : p.ctx + (size_t)(n - NX_) * 1024;
    float v[16];
#pragma unroll
    for (int j = 0; j < 4; ++j) {
      const float4 t = *(const float4*)(src + (j * 64 + lane) * 4);
      v[j * 4] = t.x; v[j * 4 + 1] = t.y; v[j * 4 + 2] = t.z; v[j * 4 + 3] = t.w;
      *(float4*)(xs + (size_t)n * 1024 + (j * 64 + lane) * 4) = t;
    }
    const float* m = mod + (size_t)(0 * 3 + tok_modrow(n)) * 6144;
    row_norm_mod(v, p.g_mix, m, m + 1024, H + (size_t)n * 1024, lane);
  }
}

template <int BM, int BN, int BK, int WM_, int WN_>
struct Gemm {
  static constexpr int WTM = BM / WM_, WTN = BN / WN_, MB = WTM / 32, NB = WTN / 32;
  static constexpr int LDA = BK + 8;
  static constexpr int A_BYTES = BM * LDA * 2, B_BYTES = BN * LDA * 2, STAGE = A_BYTES + B_BYTES;
  static constexpr int SMEM = 2 * STAGE;
  static constexpr int CPR = BK / 8;
  static constexpr int ACH = BM * CPR / NTHR, BCH = BN * CPR / NTHR;
  static_assert(WM_ * WN_ == 8, "8 waves");
  static_assert(BM * CPR % NTHR == 0 && BN * CPR % NTHR == 0, "chunking");
  static_assert(NTHR % CPR == 0, "rows fixed per thread");

  template <class ARow>
  static DI void run(f32x16 (&acc)[MB][NB], ARow arow, const bf16_t* Bt, int ldb, int Klen, char* smem) {
    const int tid = opaque_tid(), lane = tid & 63, wid = tid >> 6, wm = wid / WN_, wn = wid % WN_;
    const int kc = (tid % CPR) * 8, r0 = tid / CPR;
    const bf16_t* ap[ACH]; const bf16_t* bp[BCH];
#pragma unroll
    for (int i = 0; i < ACH; ++i) ap[i] = arow(r0 + i * (NTHR / CPR)) + kc;
#pragma unroll
    for (int i = 0; i < BCH; ++i) bp[i] = Bt + (size_t)(r0 + i * (NTHR / CPR)) * ldb + kc;
    u32x4 ra[ACH], rb[BCH];
    const int nk = Klen / BK;
#pragma unroll
    for (int i = 0; i < ACH; ++i) ra[i] = *(const u32x4*)(ap[i]);
#pragma unroll
    for (int i = 0; i < BCH; ++i) rb[i] = *(const u32x4*)(bp[i]);
#pragma unroll
    for (int i = 0; i < ACH; ++i) *(u32x4*)(smem + ((r0 + i * (NTHR / CPR)) * LDA + kc) * 2) = ra[i];
#pragma unroll
    for (int i = 0; i < BCH; ++i) *(u32x4*)(smem + A_BYTES + ((r0 + i * (NTHR / CPR)) * LDA + kc) * 2) = rb[i];
    __syncthreads();
    for (int kt = 0; kt < nk; ++kt) {
      const int kn = (kt + 1 < nk ? kt + 1 : kt) * BK;
#pragma unroll
      for (int i = 0; i < ACH; ++i) ra[i] = *(const u32x4*)(ap[i] + kn);
#pragma unroll
      for (int i = 0; i < BCH; ++i) rb[i] = *(const u32x4*)(bp[i] + kn);
      sched_fence();
      const char* As = smem + (kt & 1) * STAGE;
      const char* Bs = As + A_BYTES;
#pragma unroll
      for (int ks = 0; ks < BK / 16; ++ks) {
        bf16x8 af[MB], bfr[NB];
#pragma unroll
        for (int mb = 0; mb < MB; ++mb)
          af[mb] = *(const bf16x8*)(As + ((wm * WTM + mb * 32 + (lane & 31)) * LDA + ks * 16 + (lane >> 5) * 8) * 2);
#pragma unroll
        for (int nb = 0; nb < NB; ++nb)
          bfr[nb] = *(const bf16x8*)(Bs + ((wn * WTN + nb * 32 + (lane & 31)) * LDA + ks * 16 + (lane >> 5) * 8) * 2);
#pragma unroll
        for (int mb = 0; mb < MB; ++mb)
#pragma unroll
          for (int nb = 0; nb < NB; ++nb) acc[mb][nb] = mfma32(af[mb], bfr[nb], acc[mb][nb]);
      }
      sched_fence();
      {
        char* Ad = smem + ((kt + 1) & 1) * STAGE;
#pragma unroll
        for (int i = 0; i < ACH; ++i) *(u32x4*)(Ad + ((r0 + i * (NTHR / CPR)) * LDA + kc) * 2) = ra[i];
#pragma unroll
        for (int i = 0; i < BCH; ++i) *(u32x4*)(Ad + A_BYTES + ((r0 + i * (NTHR / CPR)) * LDA + kc) * 2) = rb[i];
      }
      __syncthreads();
    }
  }
  static DI int row_of(int t, int mb, int reg) { const int lane = t & 63, wm = (t >> 6) / WN_; return wm * WTM + mb * 32 + crow(reg, lane >> 5); }
  static DI int col_of(int t, int nb) { const int lane = t & 63, wn = (t >> 6) % WN_; return wn * WTN + nb * 32 + (lane & 31); }
};


template <int NBW> struct WTile {
  static constexpr int LD = NBW * 32 + 4;
  static constexpr int BYTES = 32 * LD * 4;
  static DI void put(float* scr, int nb, int lane, const f32x16& v) {
    const int c = nb * 32 + (lane & 31), h = lane >> 5;
#pragma unroll
    for (int i = 0; i < 16; ++i) scr[crow(i, h) * LD + c] = v[i];
  }
  template <class F> static DI void rows4(const float* scr, int lane, F f) {
    wave_sync();
#pragma unroll
    for (int it = 0; it < NBW * 4; ++it) {
      const int id = it * 64 + lane, row = id / (NBW * 8), q = id % (NBW * 8);
      f(row, q * 4, *(const float4*)(scr + row * LD + q * 4));
    }
    wave_sync();
  }
  template <class F> static DI void rows8(const float* scr, int lane, F f) {
    wave_sync();
#pragma unroll
    for (int it = 0; it < NBW * 2; ++it) {
      const int id = it * 64 + lane, row = id / (NBW * 4), q = id % (NBW * 4);
      f(row, q * 8, *(const float4*)(scr + row * LD + q * 8), *(const float4*)(scr + row * LD + q * 8 + 4));
    }
    wave_sync();
  }
};
DI uint4 pack8bf(const float4& a, const float4& b) { return make_uint4(pack2bf(a.x, a.y), pack2bf(a.z, a.w), pack2bf(b.x, b.y), pack2bf(b.z, b.w)); }

typedef Gemm<256, 256, 64, 2, 4> G256;
DI void phase_win(const Params& p, int l, char* smem) {
  const bf16_t* H = (const bf16_t*)(p.ws + OFF_H);
  const bf16_t* W = (const bf16_t*)(p.ws + OFF_WMIX + (size_t)l * WM_SIZE + WM_WIN);
  bf16_t* zmla = (bf16_t*)(p.osc + O_ZMLA);
  float* zrec = (float*)(p.ws + OFF_REGION + R_ZREC);
  constexpr int TM = NT_ / 256, TN = WIN_N / 256;
  for (int it = vblock(); it < TM * TN; it += gridDim.x) {
    const int tid = opaque_tid();
    const int tm = it / TN, tn = it % TN;
    __syncthreads();
    f32x16 acc[G256::MB][G256::NB];
#pragma unroll
    for (int a = 0; a < G256::MB; ++a)
#pragma unroll
      for (int b = 0; b < G256::NB; ++b) acc[a][b] = zero16();
    const bf16_t* A0 = H + (size_t)tm * 256 * 1024;
    G256::run(acc, [&](int r) { return A0 + (size_t)r * 1024; }, W + (size_t)tn * 256 * 1024, 1024, 1024, smem);
    {
      const int lane = tid & 63, wid = tid >> 6, wm = wid / 4, wn = wid % 4;
      float* scr = (float*)(smem + wid * WTile<2>::BYTES);
      const int col0 = tn * 256 + wn * 64;
#pragma unroll
      for (int mb = 0; mb < G256::MB; ++mb) {
        WTile<2>::put(scr, 0, lane, acc[mb][0]); WTile<2>::put(scr, 1, lane, acc[mb][1]);
        const int row0 = tm * 256 + wm * 128 + mb * 32;
#ifdef ABL_NOSTORE
        if (tn > 1000) {
#else
        if (tn < 3) {
#endif
          WTile<2>::rows8(scr, lane, [&](int r, int c, const float4& a, const float4& bq) {
            *(uint4*)(zmla + (size_t)(row0 + r) * ZMLA_W + col0 + c) = pack8bf(a, bq); });
        } else {
          WTile<2>::rows4(scr, lane, [&](int r, int c, const float4& a) {
            const int cc = col0 - 768 + c;
#ifdef ABL_NOSTORE
            if (cc < -5) *(float4*)(zrec + (size_t)(row0 + r) * ZREC_W + cc) = a; });
#else
            if (cc < ZREC_W) *(float4*)(zrec + (size_t)(row0 + r) * ZREC_W + cc) = a; });
#endif
        }
      }
    }
  }
}
typedef Gemm<128, 128, 64, 2, 4> G128;
DI void mla_row_rs(const bf16_t* zmla_rows, int c0, int len, float* rs) {
  const int tid = opaque_tid(), row = tid >> 2, half = tid & 3;
  const bf16_t* src = zmla_rows + (size_t)row * ZMLA_W + c0 + half * (len / 4);
  float ss = 0.f;
  for (int i = 0; i < len / 4; i += 8) {
    const uint4 v = *(const uint4*)(src + i);
    const unsigned w[4] = {v.x, v.y, v.z, v.w};
#pragma unroll
    for (int j = 0; j < 4; ++j) { const float a = bf2f((bf16_t)(w[j] & 0xffff)), b = bf2f((bf16_t)(w[j] >> 16)); ss += a * a + b * b; }
  }
  ss += __shfl_xor(ss, 1); ss += __shfl_xor(ss, 2);
  if (half == 0) rs[row] = frsq(ss / (float)len + 1e-6f);
}

constexpr int MLA_Q_TILES = (NT_ / 128) * 6, MLA_KV_TILES = (NT_ / 128) * 8;
DI void mla_q_item(const Params& p, int l, int it, char* smem) {
  const int tid = opaque_tid();
  const int tm = it / 6, tn = it % 6;
  const bf16_t* zmla = (const bf16_t*)(p.osc + O_ZMLA) + (size_t)tm * 128 * ZMLA_W;
  const bf16_t* W = (const bf16_t*)(p.ws + OFF_WMIX + (size_t)l * WM_SIZE + WM_UQ) + (size_t)tn * 128 * 384;
  bf16_t* qb = (bf16_t*)(p.osc + O_QB);
  const float2* rt = (const float2*)(p.ws + OFF_ROPE);
  float* rs = (float*)(smem + G128::SMEM);
  __syncthreads();
  mla_row_rs(zmla, 0, 384, rs);
  f32x16 acc[G128::MB][G128::NB];
#pragma unroll
  for (int a = 0; a < G128::MB; ++a)
#pragma unroll
    for (int b = 0; b < G128::NB; ++b) acc[a][b] = zero16();
  G128::run(acc, [&](int r) { return zmla + (size_t)r * ZMLA_W; }, W, 384, 384, smem);
  const int lane = tid & 63;
  const bool isx = tm * 128 < NX_;
#pragma unroll
  for (int mb = 0; mb < G128::MB; ++mb)
#pragma unroll
    for (int nb = 0; nb < G128::NB; ++nb) {
      const int col = tn * 128 + G128::col_of(tid, nb);
      const bool ropeblk = ((col >> 5) % 3) == 2;
      const int e = lane & 31;
#pragma unroll
      for (int i = 0; i < 16; ++i) {
        const int lr = G128::row_of(tid, mb, i);
        const int n = tm * 128 + lr;
        float v = acc[mb][nb][i] * rs[lr];
        if (ropeblk && isx) {
          const float pv = __shfl_xor(v, 8);
          const float2 cs = rt[(size_t)(n % T_) * 16 + (e >> 4) * 8 + (e & 7)];
          v = (e & 8) ? (pv * cs.y + v * cs.x) : (v * cs.x - pv * cs.y);
        }
        qb[(size_t)n * 768 + col] = f2bf(v);
      }
    }
}
DI void mla_kv_item(const Params& p, int l, int it, char* smem) {
  const int tid = opaque_tid();
  const int tm = it / 8, tn = it % 8;
  const bf16_t* zmla = (const bf16_t*)(p.osc + O_ZMLA) + (size_t)tm * 128 * ZMLA_W;
  const bf16_t* W = (const bf16_t*)(p.ws + OFF_WMIX + (size_t)l * WM_SIZE + WM_UKV) + (size_t)tn * 128 * 256;
  bf16_t* kb = (bf16_t*)(p.ws + OFF_REGION + R_KB);
  bf16_t* vt = (bf16_t*)(p.ws + OFF_REGION + R_VT);
  const float2* rt = (const float2*)(p.ws + OFF_ROPE);
  float* rs = (float*)(smem + G128::SMEM);
  __syncthreads();
  mla_row_rs(zmla, 384, 256, rs);
  const int n0 = tm * 128;
  const int b = tok_b(n0), key0 = tok_key(n0);
  const bool isx = n0 < NX_;
  if (tn == 0) {
    for (int idx = tid; idx < 128 * 16; idx += NTHR) {
      const int lr = idx >> 4, pi = idx & 15, a = pi >> 3, i = pi & 7;
      const bf16_t* z = zmla + (size_t)lr * ZMLA_W + 640 + a * 16 + i;
      float x1 = bf2f(z[0]), x2 = bf2f(z[8]);
      if (isx) {
        const float2 cs = rt[(size_t)((n0 + lr) % T_) * 16 + a * 8 + i];
        const float y1 = x1 * cs.x - x2 * cs.y, y2 = x1 * cs.y + x2 * cs.x; x1 = y1; x2 = y2;
      }
      const bf16_t o1 = f2bf(x1), o2 = f2bf(x2);
      for (int h = 0; h < 8; ++h) {
        bf16_t* dst = kb + ((size_t)(b * 8 + h) * KT_ + key0 + lr) * 96 + 64 + a * 16 + i;
        dst[0] = o1; dst[8] = o2;
      }
    }
  }
  f32x16 acc[G128::MB][G128::NB];
#pragma unroll
  for (int a = 0; a < G128::MB; ++a)
#pragma unroll
    for (int c = 0; c < G128::NB; ++c) acc[a][c] = zero16();
  G128::run(acc, [&](int r) { return zmla + (size_t)r * ZMLA_W + 384; }, W, 256, 256, smem);
  const int lane = tid & 63;
#pragma unroll
  for (int mb = 0; mb < G128::MB; ++mb)
#pragma unroll
    for (int nb = 0; nb < G128::NB; ++nb) {
      const int col = tn * 128 + G128::col_of(tid, nb);
      if (col < 512) {
        const int h = col >> 6, d = col & 63;
#pragma unroll
        for (int i = 0; i < 16; ++i) {
          const int lr = G128::row_of(tid, mb, i);
          kb[((size_t)(b * 8 + h) * KT_ + key0 + lr) * 96 + d] = f2bf(acc[mb][nb][i] * rs[lr]);
        }
      } else {
        const int h = (col - 512) >> 6, d = col & 63;
#pragma unroll
        for (int g = 0; g < 4; ++g) {
          const int lr = G128::row_of(tid, mb, g * 4);
          uint2 o;
          o.x = pack2bf(acc[mb][nb][g * 4 + 0] * rs[lr], acc[mb][nb][g * 4 + 1] * rs[lr + 1]);
          o.y = pack2bf(acc[mb][nb][g * 4 + 2] * rs[lr + 2], acc[mb][nb][g * 4 + 3] * rs[lr + 3]);
          *(uint2*)(vt + ((size_t)(b * 8 + h) * 64 + d) * KT_ + key0 + lr) = o;
        }
      }
    }
  (void)lane;
}

DI float softplusf_(float x) { return x > 20.f ? x : log1pf(fexp(x)); }
constexpr int RWP_TT = 16;
constexpr int RWP_ITEMS = NT_ / RWP_TT;
DI void rwkv_prep_items(const Params& p, int l, char* smem) {
  if ((int)blockIdx.x >= RWP_ITEMS) return;
  float* zs = (float*)smem;
  float* tw = zs + RWP_TT * 1024;
  float* ta = tw + 2 * 64 * RWP_TT;
  const float* zrec = (const float*)(p.ws + OFF_REGION + R_ZREC);
  bf16_t* rb = (bf16_t*)(p.ws + OFF_REGION + R_RB16);
  float* lwo = (float*)(p.ws + OFF_REGION + R_LW);
  float* bso = (float*)(p.ws + OFF_REGION + R_BS);
  const float* mu = p.rw_mu + (size_t)l * 1152;
  const int tid = opaque_tid();
  const int col = tid & 255, d = tid >> 8;
  const float* w2 = p.rw_w2 + ((size_t)l * 2 + d) * 64 * 256 + col;
  const float* a2 = p.rw_a2 + ((size_t)l * 2 + d) * 64 * 256 + col;
  const float rkw = p.rw_r_k[(size_t)l * 256 + col];
  const float w0 = p.rw_w0[((size_t)l * 2 + d) * 256 + col], a0 = p.rw_a0[((size_t)l * 2 + d) * 256 + col];
  const float kkw = p.rw_k_k[(size_t)l * 256 + col], kaw = p.rw_k_a[(size_t)l * 256 + col];
  const size_t AS = (size_t)NT_ * 256;
#pragma unroll 1
  for (int it = blockIdx.x; it < RWP_ITEMS; it += gridDim.x) {
    const int n0 = it * RWP_TT;
    __syncthreads();
    TSB(p, 44);
#pragma unroll 1
    for (int i = 0; i < 8; ++i) {
      const int idx4 = tid + i * NTHR, tt = idx4 >> 8, c = (idx4 & 255) * 4, n = n0 + tt, t = tok_t(n);
      const int len = n < NX_ ? T_ : CL_;
      const float* zr = zrec + (size_t)n * ZREC_W + ZR_RW + c;
      const float4 z = *(const float4*)zr;
      const float4 zp = t > 0 ? *(const float4*)(zr - ZREC_W) : make_float4(0.f, 0.f, 0.f, 0.f);
      const float4 zn = t < len - 1 ? *(const float4*)(zr + ZREC_W) : make_float4(0.f, 0.f, 0.f, 0.f);
      const float4 m4 = *(const float4*)(mu + c);
      float4 sv;
      sv.x = z.x + (0.5f * (zp.x + zn.x) - z.x) * m4.x; sv.y = z.y + (0.5f * (zp.y + zn.y) - z.y) * m4.y;
      sv.z = z.z + (0.5f * (zp.z + zn.z) - z.z) * m4.z; sv.w = z.w + (0.5f * (zp.w + zn.w) - z.w) * m4.w;
      *(float4*)(zs + tt * 1024 + c) = sv;
      if (c >= 768) {
        const float e4[4] = {sv.x, sv.y, sv.z, sv.w};
#pragma unroll
        for (int q = 0; q < 4; ++q) {
          const int cc = c + q;
          if (cc < 896) { const int dd = (cc - 768) >> 6, k = (cc - 768) & 63; tw[(dd * 64 + k) * RWP_TT + tt] = 1.f - 2.f * frcp(1.f + fexp(2.f * e4[q])); }
          else { const int dd = (cc - 896) >> 6, k = (cc - 896) & 63; ta[(dd * 64 + k) * RWP_TT + tt] = e4[q]; }
        }
      }
    }
    __syncthreads();
    TSB(p, 45);
#pragma unroll 1
    for (int th = 0; th < RWP_TT; th += 8) {
      float aw[8], aa[8];
#pragma unroll
      for (int i = 0; i < 8; ++i) { aw[i] = 0.f; aa[i] = 0.f; }
#pragma unroll 1
      for (int kh = 0; kh < 4; ++kh) {
        float wr[16], ar[16];
#pragma unroll
        for (int k = 0; k < 16; ++k) { wr[k] = w2[(kh * 16 + k) * 256]; ar[k] = a2[(kh * 16 + k) * 256]; }
#pragma unroll
        for (int k = 0; k < 16; ++k) {
          const float* twk = tw + (d * 64 + kh * 16 + k) * RWP_TT + th;
          const float* tak = ta + (d * 64 + kh * 16 + k) * RWP_TT + th;
#pragma unroll
          for (int i = 0; i < 8; ++i) { aw[i] += twk[i] * wr[k]; aa[i] += tak[i] * ar[k]; }
          if ((k & 3) == 3) sched_fence();
        }
      }
#pragma unroll
      for (int i = 0; i < 8; ++i) {
        const int n = n0 + th + i;
        const float* zr = zs + (th + i) * 1024 + col;
        const float r = zr[0], k = zr[256], v = zr[512];
        const float kr = k * kkw;
        const float ss = wave_sum(kr * kr);
        const float kk = kr * frsq(fmaxf(ss, 1e-24f));
        const float w = -softplusf_(-(w0 + aw[i])) - 0.5f;
        const float logdecay = -fexp(w);
        const float a = sigmoidf_(a0 + aa[i]);
        const float kd = k * (1.f + (a - 1.f) * kaw);
        const float bsum = wave_sum(r * rkw * kd);
        const size_t o = (size_t)n * 256 + col;
        if (d == 0) { rb[0 * AS + o] = f2bf(r); rb[1 * AS + o] = f2bf(v); rb[2 * AS + o] = f2bf(kk); }
        lwo[d * AS + o] = logdecay;
        rb[(3 + 2 * d) * AS + o] = f2bf(kd);
        rb[(4 + 2 * d) * AS + o] = f2bf(kk * a);
        if ((tid & 63) == 0) bso[((size_t)d * NT_ + n) * 4 + (col >> 6)] = bsum;
      }
    }
    TSB(p, 47);
  }
}

DI int seq_tok(int dir, int b, int pos) {
  if (pos < CL_) return NX_ + b * CL_ + (dir ? CL_ - 1 - pos : pos);
  const int t = pos - CL_;
  return b * T_ + (dir ? T_ - 1 - t : t);
}
DI float logsigmoidf_(float x) { return -softplusf_(-x); }
DI float wave_incl_scan(float v, int lane) {
  for (int d = 1; d < 64; d <<= 1) { const float o = __shfl_up(v, d); if (lane >= d) v += o; }
  return v;
}
constexpr int ML_ST = 2112;
constexpr int ML1_ITEMS = NSEQ_ * NCH_;
DI void mlstm_local_item(const Params& p, int l, int it, char* smem) {
  const int s = it / NCH_, c = it % NCH_, dir = s >> 3, b = (s >> 2) & 1, hd = s & 3;
  float* vv = (float*)smem;
  float* kw = vv + 64 * 64;
  float* wej = kw + 64 * 32;
  const float* zrec = (const float*)(p.ws + OFF_REGION + R_ZREC);
  float* st = (float*)(p.ws + OFF_REGION + R_MLST) + ((size_t)s * NCH_ + c) * ML_ST;
  const int tid = opaque_tid(), lane = tid & 63, wid = tid >> 6;
  __syncthreads();
  if (wid == 0) {
    const int n = seq_tok(dir, b, c * 64 + lane);
    const float fp = zrec[(size_t)n * ZREC_W + ZR_MLF + dir * 4 + hd] + p.ml_b_f[(l * 2 + dir) * 4 + hd];
    const float ip = zrec[(size_t)n * ZREC_W + ZR_MLI + dir * 4 + hd] + p.ml_b_i[(l * 2 + dir) * 4 + hd];
    const float bj = wave_incl_scan(logsigmoidf_(fp), lane);
    const float bl = lane_bcast<63>(bj);
    const float lw = bl - bj + ip;
    const float ml = wave_max(lw);
    wej[lane] = fexp(lw - ml);
    if (lane == 0) { st[2080] = bl; st[2081] = ml; }
  }
  for (int idx = tid; idx < 64 * 64; idx += NTHR) {
    const int j = idx >> 6, e = idx & 63;
    const int n = seq_tok(dir, b, c * 64 + j);
    vv[idx] = zrec[(size_t)n * ZREC_W + ZR_MLV + hd * 64 + e];
  }
  __syncthreads();
  for (int idx = tid; idx < 64 * 32; idx += NTHR) {
    const int j = idx >> 5, e = idx & 31;
    const int n = seq_tok(dir, b, c * 64 + j);
    kw[idx] = zrec[(size_t)n * ZREC_W + ZR_MLK + hd * 32 + e] * wej[j];
  }
  __syncthreads();
  const int v = tid & 63, d0 = (tid >> 6) * 4;
  float a0 = 0.f, a1 = 0.f, a2 = 0.f, a3 = 0.f;
  for (int j = 0; j < 64; ++j) {
    const float x = vv[j * 64 + v];
    const float4 kk = *(const float4*)(kw + j * 32 + d0);
    a0 += x * kk.x; a1 += x * kk.y; a2 += x * kk.z; a3 += x * kk.w;
  }
  *(float4*)(st + v * 32 + d0) = make_float4(a0, a1, a2, a3);
  if (tid < 32) { float sn = 0.f; for (int j = 0; j < 64; ++j) sn += kw[j * 32 + tid]; st[2048 + tid] = sn; }
}
constexpr int ML2_ITEMS = (NSEQ_ * 2080 + NTHR - 1) / NTHR;
DI void mlstm_scan_item(const Params& p, int it) {
  const int g = it * NTHR + opaque_tid();
  if (g >= NSEQ_ * 2080) return;
  const int s = g / 2080, e = g % 2080;
  float* st = (float*)(p.ws + OFF_REGION + R_MLST) + (size_t)s * NCH_ * ML_ST;
  float state = 0.f, m = 0.f;
  static_assert(NCH_ % 4 == 0, "chunk count");
  for (int c0 = 0; c0 < NCH_; c0 += 4) {
    float d[4], bl[4], ml[4];
#pragma unroll
    for (int u = 0; u < 4; ++u) { const float* r = st + (size_t)(c0 + u) * ML_ST; d[u] = r[e]; bl[u] = r[2080]; ml[u] = r[2081]; }
#pragma unroll
    for (int u = 0; u < 4; ++u) {
      float* r = st + (size_t)(c0 + u) * ML_ST;
      r[e] = state;
      if (e == 0) r[2082] = m;
      const float mn = fmaxf(bl[u] + m, ml[u]);
      state = fexp(bl[u] + m - mn) * state + fexp(ml[u] - mn) * d[u];
      m = mn;
    }
  }
}

DI void phase3(const Params& p, int l, char* smem) {
  rwkv_prep_items(p, l, smem);
  for (int it = blockIdx.x; it < ML1_ITEMS; it += gridDim.x) { TSB(p, 56); mlstm_local_item(p, l, it, smem); TSB(p, 57); }
}
constexpr int RW_LD = 72, RW_MB = 64 * RW_LD * 2;
constexpr int RWC_REC = 40960;
DI char* rw_rec(const Params& p, int s, int c) { return p.ws + OFF_REGION + R_CH + ((size_t)s * NCH_ + c) * RWC_REC; }
DI f32x16 rw_mm(const char* A, const char* Bt, int mb, int nb, int lane, f32x16 acc) {
  const int r = lane & 31, h = lane >> 5;
#pragma unroll
  for (int ks = 0; ks < 4; ++ks) {
    const bf16x8 a = *(const bf16x8*)(A + ((mb * 32 + r) * RW_LD + ks * 16 + h * 8) * 2);
    const bf16x8 b = *(const bf16x8*)(Bt + ((nb * 32 + r) * RW_LD + ks * 16 + h * 8) * 2);
    acc = mfma32(a, b, acc);
  }
  return acc;
}
DI void rw_wrT(char* Dst, int mb, int nb, int lane, const f32x16& v) {
  const int r = lane & 31, h = lane >> 5;
#pragma unroll
  for (int g = 0; g < 4; ++g) {
    uint2 o; o.x = pack2bf(v[4 * g], v[4 * g + 1]); o.y = pack2bf(v[4 * g + 2], v[4 * g + 3]);
    *(uint2*)(Dst + ((nb * 32 + r) * RW_LD + mb * 32 + 8 * g + 4 * h) * 2) = o;
  }
}
DI void rw_wrT_g(bf16_t* Dst, int mb, int nb, int lane, const f32x16& v) {
  const int r = lane & 31, h = lane >> 5;
#pragma unroll
  for (int g = 0; g < 4; ++g) {
    uint2 o; o.x = pack2bf(v[4 * g], v[4 * g + 1]); o.y = pack2bf(v[4 * g + 2], v[4 * g + 3]);
    *(uint2*)(Dst + (nb * 32 + r) * 64 + mb * 32 + 8 * g + 4 * h) = o;
  }
}
DI void rw_addT(const char* Src, int mb, int nb, int lane, f32x16& v) {
  const int r = lane & 31, h = lane >> 5;
#pragma unroll
  for (int g = 0; g < 4; ++g) {
    const uint2 u = *(const uint2*)(Src + ((nb * 32 + r) * RW_LD + mb * 32 + 8 * g + 4 * h) * 2);
    v[4 * g] += bf2f((bf16_t)(u.x & 0xffff)); v[4 * g + 1] += bf2f((bf16_t)(u.x >> 16));
    v[4 * g + 2] += bf2f((bf16_t)(u.y & 0xffff)); v[4 * g + 3] += bf2f((bf16_t)(u.y >> 16));
  }
}
DI void rw_mask_upper(f32x16& v, int mb, int nb, int lane, bool strict) {
  const int col = nb * 32 + (lane & 31), h = lane >> 5;
#pragma unroll
  for (int i = 0; i < 16; ++i) { const int row = mb * 32 + crow(i, h); if (strict ? !(row < col) : !(row <= col)) v[i] = 0.f; }
}
DI void rw_mask_lower_strict(f32x16& v, int mb, int nb, int lane) {
  const int col = nb * 32 + (lane & 31), h = lane >> 5;
#pragma unroll
  for (int i = 0; i < 16; ++i) { const int row = mb * 32 + crow(i, h); if (!(col < row)) v[i] = 0.f; }
}

constexpr int RW1_ITEMS = NSEQ_ * NCH_;
DI void rw_chunk_item(const Params& p, int it, char* smem) {
  const int s = it / NCH_, c = it % NCH_, dir = s >> 3, b = (s >> 2) & 1, hd = s & 3;
  const int tid = opaque_tid(), lane = tid & 63, wid = tid >> 6;
  const bf16_t* rb = (const bf16_t*)(p.ws + OFF_REGION + R_RB16);
  const float* lwg = (const float*)(p.ws + OFF_REGION + R_LW) + (size_t)dir * NT_ * 256;
  const size_t AS = (size_t)NT_ * 256;
  char* const At = smem + 0 * RW_MB; char* const Bt_ = smem + 1 * RW_MB; char* const Kt = smem + 2 * RW_MB; char* const Rt = smem + 3 * RW_MB;
  char* const Aj = smem + 4 * RW_MB; char* const Bj = smem + 5 * RW_MB; char* const Kj = smem + 6 * RW_MB; char* const Vi = smem + 7 * RW_MB;
  char* const QA = smem + 8 * RW_MB; char* const QTA = smem + 9 * RW_MB; char* const GA = smem + 10 * RW_MB;
  char* const Mka = smem + 11 * RW_MB; char* const MbrT = smem + 12 * RW_MB; char* const MkrT = smem + 13 * RW_MB;
  char* const QB = At; char* const QTB = Bt_; char* const GB = Kt;
  float* const cs = (float*)(smem + 8 * RW_MB);
  float* const gC = (float*)(smem + 14 * RW_MB);
  char* rec = rw_rec(p, s, c);
  __syncthreads();
  const int t = tid >> 3, j8 = (tid & 7) * 8;
  const int n = seq_tok(dir, b, c * 64 + t);
  {
    const float4 l0 = *(const float4*)(lwg + (size_t)n * 256 + hd * 64 + j8), l1 = *(const float4*)(lwg + (size_t)n * 256 + hd * 64 + j8 + 4);
    float* d = cs + t * 65 + j8;
    d[0] = l0.x; d[1] = l0.y; d[2] = l0.z; d[3] = l0.w; d[4] = l1.x; d[5] = l1.y; d[6] = l1.z; d[7] = l1.w;
  }
  __syncthreads();
  if (tid < 64) { float a = 0.f; for (int tt = 0; tt < 64; ++tt) { a += cs[tt * 65 + tid]; cs[tt * 65 + tid] = a; } gC[tid] = fexp(a); }
  __syncthreads();
  {
    const size_t o = (size_t)n * 256 + hd * 64 + j8;
    const uint4 ukk = *(const uint4*)(rb + 2 * AS + o), ubb = *(const uint4*)(rb + (4 + 2 * dir) * AS + o), ukd = *(const uint4*)(rb + (3 + 2 * dir) * AS + o);
    const uint4 ur = *(const uint4*)(rb + 0 * AS + o), uv = *(const uint4*)(rb + 1 * AS + o);
    const unsigned akk[4] = {ukk.x, ukk.y, ukk.z, ukk.w}, abb[4] = {ubb.x, ubb.y, ubb.z, ubb.w}, akd[4] = {ukd.x, ukd.y, ukd.z, ukd.w};
    const unsigned ar[4] = {ur.x, ur.y, ur.z, ur.w}, av[4] = {uv.x, uv.y, uv.z, uv.w};
    unsigned oa[4], ob[4], ok[4], orr[4];
#pragma unroll
    for (int q = 0; q < 4; ++q) {
      float fa[2], fb[2], fk[2], fr[2];
#pragma unroll
      for (int e = 0; e < 2; ++e) {
        const int j = j8 + 2 * q + e;
        const float cst = cs[t * 65 + j], csp = t > 0 ? cs[(t - 1) * 65 + j] : 0.f;
        const float g = fexp(cst), gp = fexp(csp), gi = fexp(-cst);
        const int sh = 16 * e;
        fa[e] = -bf2f((bf16_t)((akk[q] >> sh) & 0xffff)) * gp;
        fb[e] = bf2f((bf16_t)((abb[q] >> sh) & 0xffff)) * gi;
        fk[e] = bf2f((bf16_t)((akd[q] >> sh) & 0xffff)) * gi;
        fr[e] = bf2f((bf16_t)((ar[q] >> sh) & 0xffff)) * g;
        *(bf16_t*)(Aj + (j * RW_LD + t) * 2) = f2bf(fa[e]);
        *(bf16_t*)(Bj + (j * RW_LD + t) * 2) = f2bf(fb[e]);
        *(bf16_t*)(Kj + (j * RW_LD + t) * 2) = f2bf(fk[e]);
        *(bf16_t*)(Vi + (j * RW_LD + t) * 2) = (bf16_t)((av[q] >> sh) & 0xffff);
      }
      oa[q] = pack2bf(fa[0], fa[1]); ob[q] = pack2bf(fb[0], fb[1]); ok[q] = pack2bf(fk[0], fk[1]); orr[q] = pack2bf(fr[0], fr[1]);
    }
    *(uint4*)(At + (t * RW_LD + j8) * 2) = make_uint4(oa[0], oa[1], oa[2], oa[3]);
    *(uint4*)(Bt_ + (t * RW_LD + j8) * 2) = make_uint4(ob[0], ob[1], ob[2], ob[3]);
    *(uint4*)(Kt + (t * RW_LD + j8) * 2) = make_uint4(ok[0], ok[1], ok[2], ok[3]);
    *(uint4*)(Rt + (t * RW_LD + j8) * 2) = make_uint4(orr[0], orr[1], orr[2], orr[3]);
  }
  __syncthreads();
  {
    const int prod = wid >> 2, mb = (wid >> 1) & 1, nb = wid & 1;
    f32x16 acc = zero16();
    if (prod == 0) {
      if (!(mb == 1 && nb == 0)) acc = rw_mm(Bt_, At, mb, nb, lane, acc);
      rw_mask_upper(acc, mb, nb, lane, true);
      rw_wrT(QA, mb, nb, lane, acc);
      if (mb == nb) {
        const int col = nb * 32 + (lane & 31), h = lane >> 5;
#pragma unroll
        for (int i = 0; i < 16; ++i) if (mb * 32 + crow(i, h) == col) acc[i] += 1.f;
      }
      rw_wrT(GA, mb, nb, lane, acc);
    } else {
      if (!(mb == 0 && nb == 1)) acc = rw_mm(At, Bt_, mb, nb, lane, acc);
      rw_mask_lower_strict(acc, mb, nb, lane);
      rw_wrT(QTA, mb, nb, lane, acc);
    }
  }
  for (int blk = wid; blk < 12; blk += 8) {
    const int prod = blk >> 2, mb = (blk >> 1) & 1, nb = blk & 1;
    f32x16 acc = zero16();
    if (prod == 0) {
      acc = rw_mm(At, Kt, mb, nb, lane, acc); rw_mask_lower_strict(acc, mb, nb, lane); rw_wrT(Mka, mb, nb, lane, acc);
    } else if (prod == 1) {
      acc = rw_mm(Bt_, Rt, mb, nb, lane, acc); rw_mask_upper(acc, mb, nb, lane, false); rw_wrT(MbrT, mb, nb, lane, acc);
    } else {
      acc = rw_mm(Kt, Rt, mb, nb, lane, acc); rw_mask_upper(acc, mb, nb, lane, false); rw_wrT(MkrT, mb, nb, lane, acc);
    }
  }
  __syncthreads();
#define RW_SQ(Q_, Qt_, Qn_, Qtn_, blk) { const int pr_ = (blk) >> 2, mb_ = ((blk) >> 1) & 1, nb_ = (blk) & 1; f32x16 acc_ = zero16(); \
    if (pr_ == 0) { acc_ = rw_mm(Q_, Qt_, mb_, nb_, lane, acc_); rw_wrT(Qtn_, mb_, nb_, lane, acc_); } \
    else { acc_ = rw_mm(Qt_, Q_, mb_, nb_, lane, acc_); rw_wrT(Qn_, mb_, nb_, lane, acc_); } }
#define RW_GUP(Qt_, G_, Gn_, blk) { const int mb_ = ((blk) >> 1) & 1, nb_ = (blk) & 1; f32x16 acc_ = zero16(); \
    rw_addT(G_, mb_, nb_, lane, acc_); acc_ = rw_mm(Qt_, G_, mb_, nb_, lane, acc_); rw_wrT(Gn_, mb_, nb_, lane, acc_); }
  RW_SQ(QA, QTA, QB, QTB, wid);
  __syncthreads();
  for (int blk = wid; blk < 12; blk += 8) { if (blk < 8) { RW_SQ(QB, QTB, QA, QTA, blk); } else { RW_GUP(QTB, GA, GB, blk - 8); } }
  __syncthreads();
  for (int blk = wid; blk < 12; blk += 8) { if (blk < 8) { RW_SQ(QA, QTA, QB, QTB, blk); } else { RW_GUP(QTA, GB, GA, blk - 8); } }
  __syncthreads();
  for (int blk = wid; blk < 12; blk += 8) { if (blk < 8) { RW_SQ(QB, QTB, QA, QTA, blk); } else { RW_GUP(QTB, GA, GB, blk - 8); } }
  __syncthreads();
  for (int blk = wid; blk < 12; blk += 8) { if (blk < 8) { RW_SQ(QA, QTA, QB, QTB, blk); } else { RW_GUP(QTA, GB, GA, blk - 8); } }
  __syncthreads();
  if (wid < 4) { RW_GUP(QTB, GA, GB, wid); }
  __syncthreads();
  {
    const int prod = wid >> 2, mb = (wid >> 1) & 1, nb = wid & 1;
    f32x16 acc = zero16();
    acc = rw_mm(GB, prod == 0 ? Mka : Aj, mb, nb, lane, acc);
    rw_wrT(prod == 0 ? QA : QTA, mb, nb, lane, acc);
  }
  __syncthreads();
  char* const X1 = QA; char* const X2 = QTA; char* const QpT = At;
  for (int blk = wid; blk < 16; blk += 8) {
    const int prod = blk >> 2, mb = (blk >> 1) & 1, nb = blk & 1;
    f32x16 acc = zero16();
    if (prod == 0) {
      rw_addT(MkrT, mb, nb, lane, acc); acc = rw_mm(X1, MbrT, mb, nb, lane, acc); rw_mask_upper(acc, mb, nb, lane, false);
      rw_wrT_g((bf16_t*)(rec + 8192), mb, nb, lane, acc);
    } else if (prod == 1) {
      rw_addT(Rt, mb, nb, lane, acc); acc = rw_mm(X2, MbrT, mb, nb, lane, acc);
      rw_wrT_g((bf16_t*)(rec), mb, nb, lane, acc);
    } else if (prod == 2) {
      acc = rw_mm(X2, Bj, mb, nb, lane, acc);
      const int col = nb * 32 + (lane & 31), h = lane >> 5; const float gc = gC[col];
#pragma unroll
      for (int i = 0; i < 16; ++i) { if (mb * 32 + crow(i, h) == col) acc[i] += 1.f; acc[i] *= gc; }
      rw_wrT_g((bf16_t*)(rec + 16384), mb, nb, lane, acc);
    } else {
      rw_addT(Kj, mb, nb, lane, acc); acc = rw_mm(X1, Bj, mb, nb, lane, acc);
      const float gc = gC[nb * 32 + (lane & 31)];
#pragma unroll
      for (int i = 0; i < 16; ++i) acc[i] *= gc;
      rw_wrT(QpT, mb, nb, lane, acc);
    }
  }
  __syncthreads();
  if (wid < 4) {
    const int mb = (wid >> 1) & 1, nb = wid & 1, r = lane & 31, h = lane >> 5;
    f32x16 acc = zero16();
    acc = rw_mm(QpT, Vi, mb, nb, lane, acc);
    float* dq = (float*)(rec + 24576);
#pragma unroll
    for (int g = 0; g < 4; ++g)
      *(float4*)(dq + (nb * 32 + r) * 64 + mb * 32 + 8 * g + 4 * h) = make_float4(acc[4 * g], acc[4 * g + 1], acc[4 * g + 2], acc[4 * g + 3]);
  }
}

constexpr int RW2_ITEMS = NSEQ_;
constexpr int RW2_DQLD = 68;
constexpr int RW2_STAGE = RW_MB + 64 * RW2_DQLD * 4;
DI void rw_state_item(const Params& p, int s, char* smem) {
  const int tid = opaque_tid(), lane = tid & 63, wid = tid >> 6, r = lane & 31, h = lane >> 5;
  f32x16 S0 = zero16(), S1 = zero16();
  uint4 rp, rd0, rd1;
  const int prow = tid >> 3, pcol = (tid & 7) * 8;
  const int drow = tid >> 3, dcol = (tid & 7) * 8;
  __syncthreads();
  {
    const char* rec = rw_rec(p, s, 0);
    rp = *(const uint4*)(rec + 16384 + (prow * 64 + pcol) * 2);
    rd0 = *(const uint4*)(rec + 24576 + (drow * 64 + dcol) * 4); rd1 = *(const uint4*)(rec + 24576 + (drow * 64 + dcol + 4) * 4);
    *(uint4*)(smem + (prow * RW_LD + pcol) * 2) = rp;
    *(uint4*)(smem + RW_MB + (drow * RW2_DQLD + dcol) * 4) = rd0; *(uint4*)(smem + RW_MB + (drow * RW2_DQLD + dcol + 4) * 4) = rd1;
  }
  __syncthreads();
  for (int c = 0; c < NCH_; ++c) {
    const bool more = c + 1 < NCH_;
    if (more) {
      const char* rec = rw_rec(p, s, c + 1);
      rp = *(const uint4*)(rec + 16384 + (prow * 64 + pcol) * 2);
      rd0 = *(const uint4*)(rec + 24576 + (drow * 64 + dcol) * 4); rd1 = *(const uint4*)(rec + 24576 + (drow * 64 + dcol + 4) * 4);
    }
    sched_fence();
    if (wid < 2) {
      const char* PT = smem + (c & 1) * RW2_STAGE;
      const float* DQ = (const float*)(PT + RW_MB);
      const int i = wid * 32 + r;
      bf16_t* sd = (bf16_t*)(rw_rec(p, s, c) + 16384);
#pragma unroll
      for (int g = 0; g < 4; ++g) {
        uint2 o0, o1;
        o0.x = pack2bf(S0[4 * g], S0[4 * g + 1]); o0.y = pack2bf(S0[4 * g + 2], S0[4 * g + 3]);
        o1.x = pack2bf(S1[4 * g], S1[4 * g + 1]); o1.y = pack2bf(S1[4 * g + 2], S1[4 * g + 3]);
        *(uint2*)(sd + i * 64 + 8 * g + 4 * h) = o0; *(uint2*)(sd + i * 64 + 32 + 8 * g + 4 * h) = o1;
      }
      bf16x8 bfr[2][2];
#pragma unroll
      for (int s2 = 0; s2 < 2; ++s2) {
        const uint4 u0 = make_uint4(pack2bf(S0[8 * s2], S0[8 * s2 + 1]), pack2bf(S0[8 * s2 + 2], S0[8 * s2 + 3]), pack2bf(S0[8 * s2 + 4], S0[8 * s2 + 5]), pack2bf(S0[8 * s2 + 6], S0[8 * s2 + 7]));
        const uint4 u1 = make_uint4(pack2bf(S1[8 * s2], S1[8 * s2 + 1]), pack2bf(S1[8 * s2 + 2], S1[8 * s2 + 3]), pack2bf(S1[8 * s2 + 4], S1[8 * s2 + 5]), pack2bf(S1[8 * s2 + 6], S1[8 * s2 + 7]));
        __builtin_memcpy(&bfr[0][s2], &u0, 16); __builtin_memcpy(&bfr[1][s2], &u1, 16);
      }
      f32x16 n0, n1;
#pragma unroll
      for (int g = 0; g < 4; ++g) {
        const float4 a = *(const float4*)(DQ + i * RW2_DQLD + 8 * g + 4 * h), bq = *(const float4*)(DQ + i * RW2_DQLD + 32 + 8 * g + 4 * h);
        n0[4 * g] = a.x; n0[4 * g + 1] = a.y; n0[4 * g + 2] = a.z; n0[4 * g + 3] = a.w;
        n1[4 * g] = bq.x; n1[4 * g + 1] = bq.y; n1[4 * g + 2] = bq.z; n1[4 * g + 3] = bq.w;
      }
#pragma unroll
      for (int jb2 = 0; jb2 < 2; ++jb2)
#pragma unroll
        for (int s2 = 0; s2 < 2; ++s2) {
          const char* a0 = PT + ((0 * 32 + r) * RW_LD + jb2 * 32 + 16 * s2 + 4 * h) * 2;
          const char* a1 = PT + ((1 * 32 + r) * RW_LD + jb2 * 32 + 16 * s2 + 4 * h) * 2;
          const uint2 l0 = *(const uint2*)a0, h0 = *(const uint2*)(a0 + 16), l1 = *(const uint2*)a1, h1 = *(const uint2*)(a1 + 16);
          const uint4 u0 = make_uint4(l0.x, l0.y, h0.x, h0.y), u1 = make_uint4(l1.x, l1.y, h1.x, h1.y);
          bf16x8 af0, af1; __builtin_memcpy(&af0, &u0, 16); __builtin_memcpy(&af1, &u1, 16);
          n0 = mfma32(af0, bfr[jb2][s2], n0);
          n1 = mfma32(af1, bfr[jb2][s2], n1);
        }
      S0 = n0; S1 = n1;
    }
    if (more) {
      char* d = smem + ((c + 1) & 1) * RW2_STAGE;
      *(uint4*)(d + (prow * RW_LD + pcol) * 2) = rp;
      *(uint4*)(d + RW_MB + (drow * RW2_DQLD + dcol) * 4) = rd0; *(uint4*)(d + RW_MB + (drow * RW2_DQLD + dcol + 4) * 4) = rd1;
    }
    __syncthreads();
  }
}

DI void rw_out_item(const Params& p, int it, char* smem) {
  const int s = it / NCH_, c = it % NCH_, dir = s >> 3, b = (s >> 2) & 1, hd = s & 3;
  const int tid = opaque_tid(), lane = tid & 63, wid = tid >> 6;
  const bf16_t* rb = (const bf16_t*)(p.ws + OFF_REGION + R_RB16);
  const size_t AS = (size_t)NT_ * 256;
  float* ys = (float*)(p.ws + OFF_REGION + R_YS) + (size_t)dir * NT_ * 256;
  char* const Sm = smem; char* const RyT = smem + RW_MB; char* const MyT = smem + 2 * RW_MB; char* const Vi = smem + 3 * RW_MB;
  const char* rec = rw_rec(p, s, c);
  __syncthreads();
  {
    const int row = tid >> 3, col = (tid & 7) * 8;
    *(uint4*)(Sm + (row * RW_LD + col) * 2) = *(const uint4*)(rec + 16384 + (row * 64 + col) * 2);
    *(uint4*)(RyT + (row * RW_LD + col) * 2) = *(const uint4*)(rec + (row * 64 + col) * 2);
    *(uint4*)(MyT + (row * RW_LD + col) * 2) = *(const uint4*)(rec + 8192 + (row * 64 + col) * 2);
    const int n = seq_tok(dir, b, c * 64 + row);
    const uint4 uv = *(const uint4*)(rb + 1 * AS + (size_t)n * 256 + hd * 64 + col);
    const unsigned av[4] = {uv.x, uv.y, uv.z, uv.w};
#pragma unroll
    for (int q = 0; q < 4; ++q) {
      *(bf16_t*)(Vi + ((col + 2 * q) * RW_LD + row) * 2) = (bf16_t)(av[q] & 0xffff);
      *(bf16_t*)(Vi + ((col + 2 * q + 1) * RW_LD + row) * 2) = (bf16_t)(av[q] >> 16);
    }
  }
  __syncthreads();
  if (wid < 4) {
    const int mb = (wid >> 1) & 1, nb = wid & 1, r = lane & 31, h = lane >> 5;
    f32x16 acc = zero16();
    acc = rw_mm(Sm, RyT, mb, nb, lane, acc);
    acc = rw_mm(Vi, MyT, mb, nb, lane, acc);
    const int n = seq_tok(dir, b, c * 64 + nb * 32 + r);
#pragma unroll
    for (int g = 0; g < 4; ++g)
      *(float4*)(ys + (size_t)n * 256 + hd * 64 + mb * 32 + 8 * g + 4 * h) = make_float4(acc[4 * g], acc[4 * g + 1], acc[4 * g + 2], acc[4 * g + 3]);
  }
}
constexpr int ATT_KLD = 104, ATT_VLD = 68;
constexpr int ATT_KB = 64 * ATT_KLD * 2, ATT_VB = 64 * ATT_VLD * 2, ATT_STAGE = ATT_KB + ATT_VB;
DI float fexp2(float x) {
#ifdef EMU
  return exp2f(x);
#else
  return __builtin_amdgcn_exp2f(x);
#endif
}
#ifdef ABL_NOPV
#define ABL_PV_BEGIN if (t > 100000) {
#define ABL_PV_END }
#else
#define ABL_PV_BEGIN
#define ABL_PV_END
#endif
#ifdef ABL_NOLOAD
#define ABL_LOADS(tk, tv)
#else
#define ABL_LOADS(tk, tv) ATT_LOADK(tk); ATT_LOADV(tv);
#endif
#ifdef ABL_NOEXP
#define ABL_EXP(x) (x)
#else
#define ABL_EXP(x) fexp2(x)
#endif
constexpr int ATT_LDS = 2 * ATT_KB + 2 * ATT_VB;
DI void attn_item(const Params& p, int b, int h, int qt, bool isctx, char* smem) {
  const int tid = opaque_tid(), lane = tid & 63, wid = tid >> 6, r = lane & 31, h2 = lane >> 5;
  const bf16_t* qb = (const bf16_t*)(p.osc + O_QB);
  const bf16_t* kbase = (const bf16_t*)(p.ws + OFF_REGION + R_KB) + (size_t)(b * 8 + h) * KT_ * 96;
  const bf16_t* vbase = (const bf16_t*)(p.ws + OFF_REGION + R_VT) + (size_t)(b * 8 + h) * 64 * KT_;
  bf16_t* att = (bf16_t*)(p.ws + OFF_REGION + R_ATT);
  const int nq0 = isctx ? NX_ + b * CL_ + qt * 256 : b * T_ + qt * 256;
  const int nkt = (isctx ? CL_ : KT_) / 64;
  const int nq = nq0 + wid * 32 + r;
  bf16x8 qf[6];
#pragma unroll
  for (int ks = 0; ks < 6; ++ks) qf[ks] = *(const bf16x8*)(qb + (size_t)nq * 768 + h * 96 + ks * 16 + h2 * 8);
  f32x16 oacc[2] = {zero16(), zero16()};
  float m = -1e30f, lsum = 0.f;
  const float sc = 0.10206207261596577f * 1.4426950408889634f;
  char* const Kst = smem;
  char* const Vst = smem + 2 * ATT_KB;
  const int kc1 = tid + 512, vd = tid >> 3, vc = tid & 7;
  const int ko0 = ((tid / 12) * ATT_KLD + (tid % 12) * 8) * 2, ko1 = ((kc1 / 12) * ATT_KLD + (kc1 % 12) * 8) * 2;
  const int vo = (vd * ATT_VLD + vc * 8) * 2;
  u32x4 rk0, rk1 = {0u, 0u, 0u, 0u}, rv;
#define ATT_LOADK(kt_) { const bf16_t* ksrc_ = kbase + (size_t)(kt_) * 64 * 96; rk0 = *(const u32x4*)(ksrc_ + tid * 8); if (kc1 < 768) rk1 = *(const u32x4*)(ksrc_ + kc1 * 8); }
#define ATT_LOADV(kt_) { rv = *(const u32x4*)(vbase + (size_t)vd * KT_ + (kt_) * 64 + vc * 8); }
#define ATT_STOREK(st_) { char* d_ = Kst + (st_) * ATT_KB; *(u32x4*)(d_ + ko0) = rk0; if (kc1 < 768) *(u32x4*)(d_ + ko1) = rk1; }
#define ATT_STOREV(st_) { char* d_ = Vst + (st_) * ATT_VB; *(uint2*)(d_ + vo) = make_uint2(rv[0], rv[1]); *(uint2*)(d_ + vo + 8) = make_uint2(rv[2], rv[3]); }
#define ATT_QK(dst_, st_) { const char* Ks_ = Kst + (st_) * ATT_KB; dst_[0] = zero16(); dst_[1] = zero16(); \
    _Pragma("unroll") for (int ks = 0; ks < 6; ++ks) _Pragma("unroll") for (int kb = 0; kb < 2; ++kb) { \
      const bf16x8 kf_ = *(const bf16x8*)(Ks_ + ((kb * 32 + r) * ATT_KLD + ks * 16 + h2 * 8) * 2); dst_[kb] = mfma32(kf_, qf[ks], dst_[kb]); } }
  __syncthreads();
  ATT_LOADK(0); ATT_LOADV(0); ATT_STOREK(0); ATT_STOREV(0);
  ATT_LOADK(1); ATT_STOREK(1);
  __syncthreads();
  f32x16 sA[2], sB[2];
  ATT_QK(sA, 0);
#define ATT_SMPV(cur_, t) { \
    float mx = -1e30f; \
    _Pragma("unroll") for (int kb = 0; kb < 2; ++kb) _Pragma("unroll") for (int i = 0; i < 16; ++i) mx = fmaxf(mx, cur_[kb][i]); \
    mx = fmaxf(mx, __shfl_xor(mx, 32)); \
    const float mn = fmaxf(m, mx * sc); \
    if (__ballot(mn > m) != 0ull) { \
      const float alpha = fexp2(m - mn); \
      _Pragma("unroll") for (int db = 0; db < 2; ++db) _Pragma("unroll") for (int i = 0; i < 16; ++i) oacc[db][i] *= alpha; \
      lsum *= alpha; m = mn; } \
    _Pragma("unroll") for (int kb = 0; kb < 2; ++kb) _Pragma("unroll") for (int i = 0; i < 16; ++i) cur_[kb][i] = ABL_EXP(cur_[kb][i] * sc - m); \
    { float ps0 = 0.f, ps1 = 0.f; _Pragma("unroll") for (int i = 0; i < 16; ++i) { ps0 += cur_[0][i]; ps1 += cur_[1][i]; } lsum += ps0 + ps1; } \
    const char* Vs = Vst + ((t) & 1) * ATT_VB; \
    _Pragma("unroll") for (int kb = 0; kb < 2; ++kb) _Pragma("unroll") for (int s2 = 0; s2 < 2; ++s2) { \
      bf16x8 pf; { const u32x4 u = {pack2bf(cur_[kb][8 * s2 + 0], cur_[kb][8 * s2 + 1]), pack2bf(cur_[kb][8 * s2 + 2], cur_[kb][8 * s2 + 3]), \
                                    pack2bf(cur_[kb][8 * s2 + 4], cur_[kb][8 * s2 + 5]), pack2bf(cur_[kb][8 * s2 + 6], cur_[kb][8 * s2 + 7])}; __builtin_memcpy(&pf, &u, 16); } \
      ABL_PV_BEGIN \
      _Pragma("unroll") for (int db = 0; db < 2; ++db) { \
        const char* vrow = Vs + ((db * 32 + r) * ATT_VLD + kb * 32 + 16 * s2 + 4 * h2) * 2; \
        const uint2 lo = *(const uint2*)(vrow), hi = *(const uint2*)(vrow + 16); \
        const u32x4 u = {lo.x, lo.y, hi.x, hi.y}; bf16x8 vf; __builtin_memcpy(&vf, &u, 16); \
        oacc[db] = mfma32(vf, pf, oacc[db]); } ABL_PV_END } }
#define ATT_STEP(cur_, nxt_, t_) { \
    const int t = (t_); \
    const int tk = t + 2 < nkt ? t + 2 : nkt - 1, tv = t + 1 < nkt ? t + 1 : nkt - 1; \
    ABL_LOADS(tk, tv) \
    sched_fence(); \
    if (first_half) { ATT_QK(nxt_, (t + 1) & 1); sched_fence(); ATT_SMPV(cur_, t); } \
    else { ATT_SMPV(cur_, t); sched_fence(); ATT_QK(nxt_, (t + 1) & 1); } \
    sched_fence(); \
    ATT_STOREK(t & 1); ATT_STOREV((t + 1) & 1); \
    __syncthreads(); }
  const bool first_half = rfl(wid) < 4;
  for (int t0 = 0; t0 < nkt; t0 += 2) {
    ATT_STEP(sA, sB, t0);
    ATT_STEP(sB, sA, t0 + 1);
  }
  lsum += __shfl_xor(lsum, 32);
  const float inv = 1.f / lsum;
#pragma unroll
  for (int db = 0; db < 2; ++db)
#pragma unroll
    for (int g = 0; g < 4; ++g) {
      uint2 o;
      o.x = pack2bf(oacc[db][g * 4 + 0] * inv, oacc[db][g * 4 + 1] * inv);
      o.y = pack2bf(oacc[db][g * 4 + 2] * inv, oacc[db][g * 4 + 3] * inv);
      *(uint2*)(att + (size_t)nq * 512 + h * 64 + db * 32 + 8 * g + 4 * h2) = o;
    }
}

constexpr int P3B_ITEMS = RW1_ITEMS + ML2_ITEMS + MLA_Q_TILES + MLA_KV_TILES;
DI void phase3b(const Params& p, int l, char* smem) {
  for (int it = vblock(); it < P3B_ITEMS; it += gridDim.x) {
    int i = it;
    if (i < RW1_ITEMS) { TSB(p, 58); rw_chunk_item(p, i, smem); TSB(p, 59); continue; }
    i -= RW1_ITEMS;
    if (i < ML2_ITEMS) { mlstm_scan_item(p, i); continue; }
    i -= ML2_ITEMS;
    TSB(p, 60);
    if (i < MLA_Q_TILES) mla_q_item(p, l, i, smem); else mla_kv_item(p, l, i - MLA_Q_TILES, smem);
    TSB(p, 61);
  }
}

DI constexpr int att_items(int l) { return NB_ * 8 * (T_ / 256) + (l == 0 ? NB_ * 8 * (CL_ / 256) : 0); }
DI void spin_until_ge(int* ctr, int target) {
#ifdef EMU
  while (__atomic_load_n(ctr, __ATOMIC_SEQ_CST) < target) emu::yield();
#else
  while (__hip_atomic_load(ctr, __ATOMIC_RELAXED, __HIP_MEMORY_SCOPE_AGENT) < target) __builtin_amdgcn_s_sleep(8);
#endif
}
DI void phase4(const Params& p, int l, char* smem, int* ctr) {
  const int G = gridDim.x, nsb = G >= 2 * RW2_ITEMS ? RW2_ITEMS : (G > 1 ? G / 2 : 1);
  TSB(p, 50);
  if ((int)blockIdx.x < nsb) {
    for (int s = blockIdx.x; s < RW2_ITEMS; s += nsb) rw_state_item(p, s, smem);
#ifndef EMU
    asm volatile("s_waitcnt vmcnt(0)" ::: "memory");
#endif
    __syncthreads();
    if (opaque_tid() == 0) { __threadfence(); atomicAdd(ctr + 2, (RW2_ITEMS - (int)blockIdx.x + nsb - 1) / nsb); }
    TSB(p, 51);
  }
  const int QT = T_ / 256, CQ = (l == 0 ? (NB_ * 8 * (CL_ / 256)) / 8 : 0), R3 = RW1_ITEMS / 8;
  const int per = 2 * QT + CQ + R3;
  int* sitem = (int*)(smem + 160 * 1024 - 16);
  bool r2ok = false;
  const int x0 = xcc_id();
  for (;;) {
    __syncthreads();
    if (opaque_tid() == 0) {
      int item = -1;
      for (int k = 0; k < 8 && item < 0; ++k) {
        const int x = (x0 + k) & 7;
        if (ld_relaxed(ctr + 8 + x) >= per) continue;
        const int li = atomicAdd(ctr + 8 + x, 1);
        if (li < per) item = x * per + li;
      }
      *sitem = item;
    }
    __syncthreads();
    const int item = *sitem;
    if (item < 0) break;
    const int x = item / per; int li = item % per;
    if (li < 2 * QT) { const int bh = 2 * x + li / QT, qt = li % QT; TSB(p, 54); attn_item(p, bh >> 3, bh & 7, qt, false, smem); TSB(p, 55); continue; }
    li -= 2 * QT;
    if (li < CQ) { const int ci = x * CQ + li, qt = ci % (CL_ / 256), bh = ci / (CL_ / 256); attn_item(p, bh >> 3, bh & 7, qt, true, smem); continue; }
    li -= CQ;
    if (!r2ok) {
      if (opaque_tid() == 0) { spin_until_ge(ctr + 2, RW2_ITEMS); __threadfence(); }
      __syncthreads();
      r2ok = true;
      TSB(p, 52);
    }
    rw_out_item(p, x * R3 + li, smem);
  }
  TSB(p, 53);
}
constexpr int ML3_CC = CL_ / 64, ML3_XC = T_ / 64;
DI constexpr int ml3_items(bool with_ctx) { return NB_ * 4 * (ML3_XC + (with_ctx ? ML3_CC : 0)); }
template <int KS> DI f32x16 ml_mm(const char* A, const char* Bt, int mb, int nb, int lane, f32x16 acc) {
  const int r = lane & 31, h = lane >> 5;
#pragma unroll
  for (int ks = 0; ks < KS; ++ks) {
    const bf16x8 a = *(const bf16x8*)(A + ((mb * 32 + r) * RW_LD + ks * 16 + h * 8) * 2);
    const bf16x8 b = *(const bf16x8*)(Bt + ((nb * 32 + r) * RW_LD + ks * 16 + h * 8) * 2);
    acc = mfma32(a, b, acc);
  }
  return acc;
}
DI float wave_incl_scan_max(float v, int lane) {
  for (int d = 1; d < 64; d <<= 1) { const float o = __shfl_up(v, d); if (lane >= d) v = fmaxf(v, o); }
  return v;
}
DI void mlstm_out_item(const Params& p, int l, int it, bool with_ctx, char* smem) {
  const int per = ML3_XC + (with_ctx ? ML3_CC : 0);
  const int bh = it / per, b = bh >> 2, hd = bh & 3;
  int tc = it % per; if (!with_ctx) tc += ML3_CC;
  const bool isctx = tc < ML3_CC;
  const int ntok0 = isctx ? NX_ + b * CL_ + tc * 64 : b * T_ + (tc - ML3_CC) * 64;
  char* const Qm = smem;
  char* const Km = smem + 1 * RW_MB;
  char* const Qp = smem + 2 * RW_MB;
  char* const Vi = smem + 3 * RW_MB;
  char* const Pp = smem + 4 * RW_MB;
  char* const Cm = smem + 5 * RW_MB;
  float* const hs = (float*)(smem + 6 * RW_MB);
  float* const ga = hs + 64 * 64;
  float* const denp = ga + 5 * 64;
  float* const nsv = denp + 128;
  const float* zrec = (const float*)(p.ws + OFF_REGION + R_ZREC);
  const int tid = opaque_tid(), lane = tid & 63, wid = tid >> 6;
  __syncthreads();
  for (int idx = tid; idx < 64 * 64; idx += NTHR) hs[idx] = 0.f;
#pragma unroll 1
  for (int dir = 0; dir < 2; ++dir) {
    const int c = dir == 0 ? tc : (isctx ? ML3_CC - 1 - tc : ML3_CC + (ML3_XC - 1 - (tc - ML3_CC)));
    const int s = dir * 8 + b * 4 + hd;
    const float* st = (const float*)(p.ws + OFF_REGION + R_MLST) + ((size_t)s * NCH_ + c) * ML_ST;
    const float m_start = st[2082];
    __syncthreads();
    {
      const int j = tid >> 3, pt = tid & 7;
      const int n = ntok0 + (dir ? 63 - j : j);
      const float* zr = zrec + (size_t)n * ZREC_W;
      const float4 q4 = *(const float4*)(zr + ZR_MLQ + hd * 32 + pt * 4), k4 = *(const float4*)(zr + ZR_MLK + hd * 32 + pt * 4);
      const float4 c4 = *(const float4*)(st + j * 32 + pt * 4);
      const float4 va = *(const float4*)(zr + ZR_MLV + hd * 64 + pt * 8), vb = *(const float4*)(zr + ZR_MLV + hd * 64 + pt * 8 + 4);
      const float qs = 0.17677669529663687f;
      const float q0 = q4.x * qs, q1 = q4.y * qs, q2 = q4.z * qs, q3 = q4.w * qs;
      *(uint2*)(Qm + (j * RW_LD + pt * 4) * 2) = make_uint2(pack2bf(q0, q1), pack2bf(q2, q3));
      *(uint2*)(Km + (j * RW_LD + pt * 4) * 2) = make_uint2(pack2bf(k4.x, k4.y), pack2bf(k4.z, k4.w));
      *(uint2*)(Cm + (j * RW_LD + pt * 4) * 2) = make_uint2(pack2bf(c4.x, c4.y), pack2bf(c4.z, c4.w));
      const float vv[8] = {va.x, va.y, va.z, va.w, vb.x, vb.y, vb.z, vb.w};
#pragma unroll
      for (int u = 0; u < 8; ++u) *(bf16_t*)(Vi + ((pt * 8 + u) * RW_LD + j) * 2) = f2bf(vv[u]);
      if (tid < 32) nsv[tid] = st[2048 + tid];
      const float4 n4 = *(const float4*)(st + 2048 + pt * 4);
      float nq = n4.x * q0 + n4.y * q1 + n4.z * q2 + n4.w * q3;
      nq += __shfl_xor(nq, 1); nq += __shfl_xor(nq, 2); nq += __shfl_xor(nq, 4);
      if (pt == 0) ga[4 * 64 + j] = nq;
    }
    if (wid == 0) {
      const int n = ntok0 + (dir ? 63 - lane : lane);
      const float fp = zrec[(size_t)n * ZREC_W + ZR_MLF + dir * 4 + hd] + p.ml_b_f[(l * 2 + dir) * 4 + hd];
      const float ipre = zrec[(size_t)n * ZREC_W + ZR_MLI + dir * 4 + hd] + p.ml_b_i[(l * 2 + dir) * 4 + hd];
      const float bj = wave_incl_scan(logsigmoidf_(fp), lane);
      const float g = ipre - bj;
      const float pm = wave_incl_scan_max(g, lane);
      const float c0 = wave_max(g);
      const float mj = fmaxf(bj + m_start, bj + pm);
      ga[0 * 64 + lane] = fexp(g - c0);
      ga[1 * 64 + lane] = fexp(fminf(bj + c0 - mj, 80.f));
      ga[2 * 64 + lane] = fexp(bj + m_start - mj);
      ga[3 * 64 + lane] = fexp(fminf(-mj, 80.f));
    }
    __syncthreads();
    if (wid < 4) {
      const int mb = wid >> 1, nb = wid & 1, r = lane & 31, h = lane >> 5;
      f32x16 acc = zero16();
      if (!(mb == 1 && nb == 0)) acc = ml_mm<2>(Km, Qm, mb, nb, lane, acc);
      rw_mask_upper(acc, mb, nb, lane, false);
      const float al = ga[1 * 64 + nb * 32 + r];
      float csum = 0.f;
#pragma unroll
      for (int i = 0; i < 16; ++i) { acc[i] *= ga[0 * 64 + mb * 32 + crow(i, h)] * al; csum += acc[i]; }
      csum += __shfl_xor(csum, 32);
      if (h == 0) denp[mb * 64 + nb * 32 + r] = csum;
      rw_wrT(Pp, mb, nb, lane, acc);
    } else {
      const int t2 = tid - 256, j = t2 >> 2, d8 = (t2 & 3) * 8;
      const float in = ga[2 * 64 + j];
      const uint4 u = *(const uint4*)(Qm + (j * RW_LD + d8) * 2);
      const unsigned w[4] = {u.x, u.y, u.z, u.w};
      unsigned o[4];
#pragma unroll
      for (int q = 0; q < 4; ++q) o[q] = pack2bf(bf2f((bf16_t)(w[q] & 0xffff)) * in, bf2f((bf16_t)(w[q] >> 16)) * in);
      *(uint4*)(Qp + (j * RW_LD + d8) * 2) = make_uint4(o[0], o[1], o[2], o[3]);
    }
    __syncthreads();
    if (wid < 4) {
      const int mb = wid >> 1, nb = wid & 1, r = lane & 31, h = lane >> 5;
      f32x16 acc = zero16();
      acc = ml_mm<4>(Vi, Pp, mb, nb, lane, acc);
      acc = ml_mm<2>(Cm, Qp, mb, nb, lane, acc);
      const int j = nb * 32 + r;
      const float den = denp[j] + denp[64 + j] + ga[2 * 64 + j] * ga[4 * 64 + j];
      const float rden = frcp(fmaxf(fabsf(den), ga[3 * 64 + j]));
      float* hrow = hs + (dir ? 63 - j : j) * 64 + mb * 32 + 4 * h;
#pragma unroll
      for (int g4 = 0; g4 < 4; ++g4) {
        float4 o = *(float4*)(hrow + 8 * g4);
        o.x += acc[4 * g4] * rden; o.y += acc[4 * g4 + 1] * rden; o.z += acc[4 * g4 + 2] * rden; o.w += acc[4 * g4 + 3] * rden;
        *(float4*)(hrow + 8 * g4) = o;
      }
    }
  }
  __syncthreads();
  const int tk = tid >> 3, v0 = (tid & 7) * 8, n = ntok0 + tk;
  float ss = 0.f; float hv[8];
#pragma unroll
  for (int u = 0; u < 8; ++u) { hv[u] = hs[tk * 64 + v0 + u]; ss += hv[u] * hv[u]; }
  ss += __shfl_xor(ss, 1); ss += __shfl_xor(ss, 2); ss += __shfl_xor(ss, 4);
  const float rs = frsq(ss * (1.f / 64.f) + 1e-6f);
  unsigned o[4];
#pragma unroll
  for (int u = 0; u < 8; u += 2) {
    const int cc = hd * 64 + v0 + u;
    const float a = hv[u] * rs * p.ml_g_norm[l * 256 + cc] * sigmoidf_(zrec[(size_t)n * ZREC_W + ZR_MLO + cc]);
    const float bq = hv[u + 1] * rs * p.ml_g_norm[l * 256 + cc + 1] * sigmoidf_(zrec[(size_t)n * ZREC_W + ZR_MLO + cc + 1]);
    o[u >> 1] = pack2bf(a, bq);
  }
  bf16_t* mlo = (bf16_t*)(p.ws + OFF_REGION + R_MLO);
  *(uint4*)(mlo + (size_t)n * 256 + hd * 64 + v0) = make_uint4(o[0], o[1], o[2], o[3]);
}

DI constexpr int rwo_items(bool with_ctx) { return (with_ctx ? NT_ : NX_) / 16; }
DI void rwkv_out_item(const Params& p, int l, int it, char* smem) {
  float* sg = (float*)smem;
  const float* zrec = (const float*)(p.ws + OFF_REGION + R_ZREC);
  const bf16_t* rb = (const bf16_t*)(p.ws + OFF_REGION + R_RB16);
  const float* bso = (const float*)(p.ws + OFF_REGION + R_BS);
  const float* ys = (const float*)(p.ws + OFF_REGION + R_YS);
  bf16_t* rwo = (bf16_t*)(p.ws + OFF_REGION + R_RWO);
  const float* mu = p.rw_mu + (size_t)l * 1152;
  const int tid = opaque_tid(), n0 = it * 16;
  __syncthreads();
  {
    const int tt = tid >> 5, k4 = (tid & 31) * 4, n = n0 + tt, t = tok_t(n), c = 1024 + k4;
    const int len = n < NX_ ? T_ : CL_;
    const float* zr = zrec + (size_t)n * ZREC_W + ZR_RW + c;
    const float4 z = *(const float4*)zr;
    const float4 zp = t > 0 ? *(const float4*)(zr - ZREC_W) : make_float4(0.f, 0.f, 0.f, 0.f);
    const float4 zn = t < len - 1 ? *(const float4*)(zr + ZREC_W) : make_float4(0.f, 0.f, 0.f, 0.f);
    const float4 m4 = *(const float4*)(mu + c);
    sg[(k4 + 0) * 16 + tt] = sigmoidf_(z.x + (0.5f * (zp.x + zn.x) - z.x) * m4.x);
    sg[(k4 + 1) * 16 + tt] = sigmoidf_(z.y + (0.5f * (zp.y + zn.y) - z.y) * m4.y);
    sg[(k4 + 2) * 16 + tt] = sigmoidf_(z.z + (0.5f * (zp.z + zn.z) - z.z) * m4.z);
    sg[(k4 + 3) * 16 + tt] = sigmoidf_(z.w + (0.5f * (zp.w + zn.w) - z.w) * m4.w);
  }
  __syncthreads();
  const int col = tid & 255, half = tid >> 8;
  float acc[8];
#pragma unroll
  for (int i = 0; i < 8; ++i) acc[i] = 0.f;
  const float* g2 = p.rw_g2 + (size_t)l * 128 * 256 + col;
#pragma unroll 1
  for (int kh = 0; kh < 8; ++kh) {
    float gr[16];
#pragma unroll
    for (int k = 0; k < 16; ++k) gr[k] = g2[(kh * 16 + k) * 256];
#pragma unroll
    for (int k = 0; k < 16; ++k) {
      const float* sk = sg + (kh * 16 + k) * 16 + half * 8;
#pragma unroll
      for (int i = 0; i < 8; ++i) acc[i] += sk[i] * gr[k];
      if ((k & 3) == 3) sched_fence();
    }
  }
  const size_t AS = (size_t)NT_ * 256;
  const float lw = p.rw_lnx_w[(size_t)l * 256 + col], lb = p.rw_lnx_b[(size_t)l * 256 + col];
  float yv[8], vv[8], bsv[8];
#pragma unroll
  for (int i = 0; i < 8; ++i) {
    const int n = n0 + half * 8 + i;
    const size_t o = (size_t)n * 256 + col;
    yv[i] = ys[o] + ys[AS + o];
    vv[i] = bf2f(rb[1 * AS + o]);
    bsv[i] = bso[(size_t)n * 4 + (col >> 6)] + bso[((size_t)NT_ + n) * 4 + (col >> 6)];
  }
#pragma unroll
  for (int i = 0; i < 8; ++i) {
    const int n = n0 + half * 8 + i;
    const size_t o = (size_t)n * 256 + col;
    const float y = yv[i];
    const float mean = wave_sum(y) * (1.f / 64.f);
    const float dv = y - mean;
    const float var = wave_sum(dv * dv) * (1.f / 64.f);
    const float yn = dv * (frsq(var + 64e-5f)) * lw + lb;
    rwo[o] = f2bf((yn + bsv[i] * vv[i]) * acc[i]);
  }
}
DI void phase5(const Params& p, int l, bool with_ctx, char* smem) {
  const int n1 = ml3_items(with_ctx), n2 = rwo_items(with_ctx);
  for (int it = blockIdx.x; it < n1 + n2; it += gridDim.x) {
    if (it < n1) { TSB(p, 62); mlstm_out_item(p, l, it, with_ctx, smem); TSB(p, 63); }
    else { TSB(p, 64); rwkv_out_item(p, l, it - n1, smem); TSB(p, 65); }
  }
}
DI void phase_merge(const Params& p, int l, bool with_ctx, char* smem) {
  const bf16_t* H = (const bf16_t*)(p.ws + OFF_H);
  const char* W = p.ws + OFF_WMIX + (size_t)l * WM_SIZE;
  const bf16_t* Wg = (const bf16_t*)(W + WM_GATE);
  const bf16_t* att = (const bf16_t*)(p.ws + OFF_REGION + R_ATT);
  const bf16_t* mlo = (const bf16_t*)(p.ws + OFF_REGION + R_MLO);
  const bf16_t* rwo = (const bf16_t*)(p.ws + OFF_REGION + R_RWO);
  bf16_t* ymix = (bf16_t*)(p.osc + O_YMIX);
  const int TM = (with_ctx ? NT_ : NX_) / 128;
  for (int it = vblock(); it < TM * 8; it += gridDim.x) {
    const int tid = opaque_tid();
    const int tm = it >> 3, tn = it & 7;
    __syncthreads();
    f32x16 yacc[G128::MB][G128::NB];
#pragma unroll
    for (int a = 0; a < G128::MB; ++a)
#pragma unroll
      for (int b = 0; b < G128::NB; ++b) yacc[a][b] = zero16();
#pragma unroll
    for (int i = 0; i < 3; ++i) {
      f32x16 gacc[G128::MB][G128::NB], bacc[G128::MB][G128::NB];
#pragma unroll
      for (int a = 0; a < G128::MB; ++a)
#pragma unroll
        for (int b = 0; b < G128::NB; ++b) { gacc[a][b] = zero16(); bacc[a][b] = zero16(); }
      const bf16_t* A0 = H + (size_t)tm * 128 * 1024;
      G128::run(gacc, [&](int r) { return A0 + (size_t)r * 1024; }, Wg + ((size_t)i * 1024 + tn * 128) * 1024, 1024, 1024, smem);
      const bf16_t* br = i == 0 ? att : (i == 1 ? mlo : rwo);
      const int kb = i == 0 ? 512 : 256;
      const bf16_t* Wb = (const bf16_t*)(W + (i == 0 ? WM_BRA : (i == 1 ? WM_BRM : WM_BRR)));
      const bf16_t* B0 = br + (size_t)tm * 128 * kb;
      G128::run(bacc, [&](int r) { return B0 + (size_t)r * kb; }, Wb + (size_t)tn * 128 * kb, kb, kb, smem);
#pragma unroll
      for (int a = 0; a < G128::MB; ++a)
#pragma unroll
        for (int b = 0; b < G128::NB; ++b)
#pragma unroll
          for (int e = 0; e < 16; ++e) yacc[a][b][e] += sigmoidf_(gacc[a][b][e]) * bacc[a][b][e];
    }
    {
      const int lane = tid & 63, wid = tid >> 6, wm = wid / 4, wn = wid % 4;
      float* scr = (float*)(smem + wid * WTile<1>::BYTES);
#pragma unroll
      for (int mb = 0; mb < G128::MB; ++mb) {
        WTile<1>::put(scr, 0, lane, yacc[mb][0]);
        const int row0 = tm * 128 + wm * 64 + mb * 32, col0 = tn * 128 + wn * 32;
        WTile<1>::rows8(scr, lane, [&](int r, int c, const float4& a, const float4& bq) {
          *(uint4*)(ymix + (size_t)(row0 + r) * 1024 + col0 + c) = pack8bf(a, bq); });
      }
    }
  }
}

DI void phase_wout(const Params& p, int l, bool with_ctx, char* smem) {
  const bf16_t* ymix = (const bf16_t*)(p.osc + O_YMIX);
  const bf16_t* Wo = (const bf16_t*)(p.ws + OFF_WMIX + (size_t)l * WM_SIZE + WM_OUT);
  float* xs = (float*)(p.ws + OFF_XS);
  const float* mod = (const float*)(p.ws + OFF_MOD) + (size_t)l * 3 * 6144;
  const int TM = (with_ctx ? NT_ : NX_) / 128;
  const int n_g = TM * 8;
  for (int it = vblock(); it < n_g; it += gridDim.x) {
    const int tid = opaque_tid();
    const int tm = it >> 3, tn = it & 7;
    __syncthreads();
    f32x16 acc[G128::MB][G128::NB];
#pragma unroll
    for (int a = 0; a < G128::MB; ++a)
#pragma unroll
      for (int b = 0; b < G128::NB; ++b) acc[a][b] = zero16();
    const bf16_t* A0 = ymix + (size_t)tm * 128 * 1024;
    G128::run(acc, [&](int r) { return A0 + (size_t)r * 1024; }, Wo + (size_t)tn * 128 * 1024, 1024, 1024, smem);
    const float* m2 = mod + (size_t)tok_modrow(tm * 128) * 6144 + 2 * 1024;
    {
      const int lane = tid & 63, wid = tid >> 6, wm = wid / 4, wn = wid % 4;
      float* scr = (float*)(smem + wid * WTile<1>::BYTES);
#pragma unroll
      for (int mb = 0; mb < G128::MB; ++mb) {
        WTile<1>::put(scr, 0, lane, acc[mb][0]);
        const int row0 = tm * 128 + wm * 64 + mb * 32, col0 = tn * 128 + wn * 32;
        WTile<1>::rows4(scr, lane, [&](int r, int c, const float4& a) {
          float4* d = (float4*)(xs + (size_t)(row0 + r) * 1024 + col0 + c);
          const float4 g = *(const float4*)(m2 + col0 + c); float4 x = *d;
          x.x += g.x * a.x; x.y += g.y * a.y; x.z += g.z * a.z; x.w += g.w * a.w; *d = x; });
      }
    }
  }
  TSB(p, 66);
  cvt_run([&](int i) { return cvt_moe_dec(p, l, i); }, (int)gridDim.x - 1 - vblock(), CVT_MOE_TILES, gridDim.x, smem);
  TSB(p, 67);
}

typedef Gemm<128, 64, 64, 4, 2> GRT;
DI void phase_router(const Params& p, int l, bool with_ctx, char* smem, int* cnt) {
  float* xs = (float*)(p.ws + OFF_XS);
  bf16_t* H = (bf16_t*)(p.ws + OFF_H);
  const float* mod = (const float*)(p.ws + OFF_MOD) + (size_t)l * 3 * 6144;
  const bf16_t* Wr = (const bf16_t*)(p.ws + OFF_WMIX + (size_t)l * WM_SIZE + WM_RT);
  int* eidx = (int*)(p.ws + OFF_REGION + R_EIDX);
  float* ewt = (float*)(p.ws + OFF_REGION + R_EWT);
  int* erank = (int*)(p.ws + OFF_REGION + R_ERANK);
  int* elist = (int*)(p.ws + OFF_REGION + R_ELIST);
  float* sc = (float*)(smem + GRT::SMEM);
  float* bs = sc + 128 * 65;
  float* gs = bs + 128 * 65;
  int* lcnt = (int*)(gs + 128 * 9);
  int* lbase = lcnt + 64;
  const int tid = opaque_tid(), lane = tid & 63, wid = tid >> 6;
  const int ntok = with_ctx ? NT_ : NX_;
  for (int it = blockIdx.x; it < ntok / 128; it += gridDim.x) {
    const int n0 = it * 128;
    __syncthreads();
    TSB(p, 40);
    if (tid < 64) lcnt[tid] = 0;
#pragma unroll 1
    for (int r4 = 0; r4 < 16; r4 += 4) {
      float v[4][16];
#pragma unroll
      for (int u = 0; u < 4; ++u) {
        const int n = n0 + wid * 16 + r4 + u;
#pragma unroll
        for (int j = 0; j < 4; ++j) {
          const float4 t = *(const float4*)(xs + (size_t)n * 1024 + (j * 64 + lane) * 4);
          v[u][j * 4] = t.x; v[u][j * 4 + 1] = t.y; v[u][j * 4 + 2] = t.z; v[u][j * 4 + 3] = t.w;
        }
      }
#pragma unroll
      for (int u = 0; u < 4; ++u) {
        const int n = n0 + wid * 16 + r4 + u;
        const float* m = mod + (size_t)tok_modrow(n) * 6144;
        row_norm_mod(v[u], p.g_ffn + (size_t)l * 1024, m + 3 * 1024, m + 4 * 1024, H + (size_t)n * 1024, lane);
      }
    }
    __syncthreads();
    TSB(p, 41);
    f32x16 acc[1][1]; acc[0][0] = zero16();
    const bf16_t* A0 = H + (size_t)n0 * 1024;
    GRT::run(acc, [&](int r) { return A0 + (size_t)r * 1024; }, Wr, 1024, 1024, smem);
    {
      const int col = GRT::col_of(tid, 0);
      const float rb = p.router_bias[l * 64 + col];
#pragma unroll
      for (int e = 0; e < 16; ++e) {
        const int row = GRT::row_of(tid, 0, e);
        const float s = sigmoidf_(acc[0][0][e]);
        sc[row * 65 + col] = s; bs[row * 65 + col] = s + rb;
      }
    }
    __syncthreads();
    TSB(p, 42);
    int sel[8], lrk[8]; float wsum = 0.f;
    if (tid < 128) {
      float* b = bs + tid * 65; const float* s = sc + tid * 65; float* g = gs + tid * 9;
      for (int gi = 0; gi < 8; ++gi) {
        float m1 = -1e30f, m2 = -1e30f;
        for (int j = 0; j < 8; ++j) { const float x = b[gi * 8 + j]; if (x > m1) { m2 = m1; m1 = x; } else if (x > m2) m2 = x; }
        g[gi] = m1 + m2;
      }
      unsigned gmask = 0;
      for (int c = 0; c < 4; ++c) {
        int best = 0; float bv = -1e30f;
        for (int gi = 0; gi < 8; ++gi) if (!((gmask >> gi) & 1) && g[gi] > bv) { bv = g[gi]; best = gi; }
        gmask |= 1u << best;
      }
      for (int gi = 0; gi < 8; ++gi) if (!((gmask >> gi) & 1)) for (int j = 0; j < 8; ++j) b[gi * 8 + j] = -1e30f;
      wsum = 0.f;
#pragma unroll
      for (int c = 0; c < 8; ++c) {
        int best = 0; float bv = -1e30f;
        for (int e = 0; e < 64; ++e) { const float x = b[e]; if (x > bv) { bv = x; best = e; } }
        b[best] = -3e30f; sel[c] = best; wsum += s[best];
        lrk[c] = atomicAdd(lcnt + best, 1);
      }
    }
    __syncthreads();
    if (tid < 64) { const int c = lcnt[tid]; lbase[tid] = c ? atomicAdd(cnt + tid * 32, c) : 0; }
    __syncthreads();
    if (tid < 128) {
      const int n = n0 + tid;
      const float* s = sc + tid * 65;
      const float inv = 2.5f / (wsum + 1e-20f);
#pragma unroll
      for (int c = 0; c < 8; ++c) {
        const int e = sel[c];
        const int rk = lbase[e] + lrk[c];
        eidx[n * 8 + c] = e; ewt[n * 8 + c] = s[e] * inv; erank[n * 8 + c] = rk;
        elist[(size_t)e * NT_ + rk] = n * 8 + c;
      }
    }
    __syncthreads();
    TSB(p, 43);
  }
}

typedef Gemm<128, 256, 32, 2, 4> GMOE;
constexpr int ACT_LD = 264;
constexpr int MOE_ACT_OFF = GMOE::SMEM;
constexpr int MOE_INFO_OFF = MOE_ACT_OFF + 128 * ACT_LD * 2;
static_assert(MOE_INFO_OFF + 128 * 8 + 67 * 4 * 2 <= 160 * 1024 - 16, "moe lds");
DI void moe_down_run(f32x16 (&acc)[GMOE::MB][GMOE::NB], const char* actl, const bf16_t* Bt, char* smem) {
  constexpr int BK = 32, LDA = GMOE::LDA, CPR = 4, BCH = GMOE::BCH, STG = GMOE::B_BYTES;
  const int tid = opaque_tid(), lane = tid & 63, wid = tid >> 6, wm = wid / 4, wn = wid % 4;
  const int kc = (tid % CPR) * 8, r0 = tid / CPR;
  u32x4 rb[BCH];
  char* Bs0 = smem;
#pragma unroll
  for (int i = 0; i < BCH; ++i) rb[i] = *(const u32x4*)(Bt + (size_t)(r0 + i * 128) * 256 + kc);
#pragma unroll
  for (int i = 0; i < BCH; ++i) *(u32x4*)(Bs0 + ((r0 + i * 128) * LDA + kc) * 2) = rb[i];
  __syncthreads();
  for (int kt = 0; kt < 256 / BK; ++kt) {
    const int kn = (kt + 1 < 256 / BK ? kt + 1 : kt) * BK;
#pragma unroll
    for (int i = 0; i < BCH; ++i) rb[i] = *(const u32x4*)(Bt + (size_t)(r0 + i * 128) * 256 + kn + kc);
    sched_fence();
    const char* Bs = Bs0 + (kt & 1) * STG;
#pragma unroll
    for (int ks = 0; ks < BK / 16; ++ks) {
      bf16x8 af[GMOE::MB], bfr[GMOE::NB];
#pragma unroll
      for (int mb = 0; mb < GMOE::MB; ++mb)
        af[mb] = *(const bf16x8*)(actl + ((wm * 64 + mb * 32 + (lane & 31)) * ACT_LD + kt * BK + ks * 16 + (lane >> 5) * 8) * 2);
#pragma unroll
      for (int nb = 0; nb < GMOE::NB; ++nb)
        bfr[nb] = *(const bf16x8*)(Bs + ((wn * 64 + nb * 32 + (lane & 31)) * LDA + ks * 16 + (lane >> 5) * 8) * 2);
#pragma unroll
      for (int mb = 0; mb < GMOE::MB; ++mb)
#pragma unroll
        for (int nb = 0; nb < GMOE::NB; ++nb) acc[mb][nb] = mfma32(af[mb], bfr[nb], acc[mb][nb]);
    }
    sched_fence();
    {
      char* Bd = Bs0 + ((kt + 1) & 1) * STG;
#pragma unroll
      for (int i = 0; i < BCH; ++i) *(u32x4*)(Bd + ((r0 + i * 128) * LDA + kc) * 2) = rb[i];
    }
    __syncthreads();
  }
}
DI void phase_moe(const Params& p, int l, bool with_ctx, char* smem, const int* cnt) {
  const bf16_t* H = (const bf16_t*)(p.ws + OFF_H);
  const bf16_t* GU = (const bf16_t*)(p.ws + OFF_REGION + R_WMOE + WE_GU);
  const bf16_t* DN = (const bf16_t*)(p.ws + OFF_REGION + R_WMOE + WE_DN);
  const float* ewt = (const float*)(p.ws + OFF_REGION + R_EWT);
  const int* elist = (const int*)(p.ws + OFF_REGION + R_ELIST);
  bf16_t* ybuf = (bf16_t*)(p.ws + OFF_REGION + R_YBUF);
  char* actl = smem + MOE_ACT_OFF;
  int* rtok = (int*)(smem + MOE_INFO_OFF);
  float* rwt = (float*)(rtok + 128);
  int* pre = (int*)(rwt + 128);
  int* off = pre + 67;
  int tid = threadIdx.x;
  const int ntok = with_ctx ? NT_ : NX_;
  __syncthreads();
  if (tid == 0) {
    int a = 0, o = 0;
    for (int e = 0; e < 65; ++e) { const int c = e < 64 ? cnt[e * 32] : ntok; pre[e] = a; off[e] = o; a += (c + 127) >> 7; o += c; }
    pre[65] = a; off[65] = o;
  }
  __syncthreads();
  const int total = pre[65];
  for (int it = vblock(); it < total; it += gridDim.x) {
    tid = opaque_tid();
    int e0 = 0;
    while (pre[e0 + 1] <= it) ++e0;
    const int e = rfl(e0);
    const int rb = rfl(it - pre[e]);
    const int c = rfl(e < 64 ? cnt[e * 32] : ntok);
    const int obase = rfl(off[e] + rb * 128);
    __syncthreads();
    if (tid < 128) {
      const int slot = rb * 128 + tid;
      int tok = 0; float w = 0.f;
      if (slot < c) {
        if (e < 64) { const int pk = elist[(size_t)e * NT_ + slot]; tok = pk >> 3; w = ewt[pk]; }
        else { tok = slot; w = 1.f; }
      }
      rtok[tid] = tok; rwt[tid] = w;
    }
    __syncthreads();
    const bf16_t* Wgu = GU + (size_t)e * 512 * 1024;
#pragma unroll 1
    for (int hf = 0; hf < 2; ++hf) {
      f32x16 acc[GMOE::MB][GMOE::NB];
#pragma unroll
      for (int a = 0; a < GMOE::MB; ++a)
#pragma unroll
        for (int b = 0; b < GMOE::NB; ++b) acc[a][b] = zero16();
      GMOE::run(acc, [&](int r) { return H + (size_t)rtok[r] * 1024; }, Wgu + (size_t)hf * 256 * 1024, 1024, 1024, smem);
      const int lane = tid & 63, wn = (tid >> 6) % 4, wmr = ((tid >> 6) / 4) * 64 + 4 * (lane >> 5);
      const int j = (hf * 4 + wn) * 32 + (lane & 31);
#pragma unroll
      for (int mb = 0; mb < GMOE::MB; ++mb)
#pragma unroll
        for (int i = 0; i < 16; ++i) {
          const int row = wmr + mb * 32 + (i & 3) + 8 * (i >> 2);
          const float g = acc[mb][0][i], u = acc[mb][1][i];
          *(bf16_t*)(actl + (row * ACT_LD + j) * 2) = f2bf(siluf_(g) * u);
        }
    }
    __syncthreads();
    const bf16_t* Wd = DN + (size_t)e * 1024 * 256;
#pragma unroll 1
    for (int nt = 0; nt < 4; ++nt) {
      f32x16 acc[GMOE::MB][GMOE::NB];
#pragma unroll
      for (int a = 0; a < GMOE::MB; ++a)
#pragma unroll
        for (int b = 0; b < GMOE::NB; ++b) acc[a][b] = zero16();
      moe_down_run(acc, actl, Wd + (size_t)nt * 256 * 256, smem);
      {
        const int lane = tid & 63, wid = tid >> 6, wm = wid / 4, wn = wid % 4;
        float* scr = (float*)(smem + wid * WTile<1>::BYTES);
#pragma unroll
        for (int mb = 0; mb < GMOE::MB; ++mb)
#pragma unroll
          for (int nb = 0; nb < GMOE::NB; ++nb) {
            WTile<1>::put(scr, 0, lane, acc[mb][nb]);
            const int row0 = wm * 64 + mb * 32, col0 = nt * 256 + wn * 64 + nb * 32;
            WTile<1>::rows8(scr, lane, [&](int r, int cq, const float4& a, const float4& bq) {
              const int row = row0 + r;
              if (rb * 128 + row < c) {
                const float w = rwt[row];
                const float4 a2 = make_float4(a.x * w, a.y * w, a.z * w, a.w * w), b2 = make_float4(bq.x * w, bq.y * w, bq.z * w, bq.w * w);
                *(uint4*)(ybuf + ((size_t)obase + row) * 1024 + col0 + cq) = pack8bf(a2, b2);
              } });
          }
        __syncthreads();
      }
    }
  }
}

DI void phase_combine(const Params& p, int l, bool last, char* smem, const int* cnt) {
  float* xs = (float*)(p.ws + OFF_XS);
  bf16_t* H = (bf16_t*)(p.ws + OFF_H);
  const float* mod = (const float*)(p.ws + OFF_MOD);
  const int* eidx = (const int*)(p.ws + OFF_REGION + R_EIDX);
  const int* erank = (const int*)(p.ws + OFF_REGION + R_ERANK);
  const bf16_t* ybuf = (const bf16_t*)(p.ws + OFF_REGION + R_YBUF);
  int* off = (int*)smem;
  const int tid = opaque_tid(), lane = tid & 63, wid = tid >> 6;
  const int ntok = last ? NX_ : NT_;
  __syncthreads();
  if (tid == 0) { int o = 0; for (int e = 0; e < 64; ++e) { off[e] = o; o += cnt[e * 32]; } off[64] = o; }
  __syncthreads();
  for (int n = blockIdx.x * 8 + wid; n < ntok; n += gridDim.x * 8) {
    float acc[16];
#pragma unroll
    for (int i = 0; i < 16; ++i) acc[i] = 0.f;
    for (int k = 0; k < 9; ++k) {
      const int row = k < 8 ? off[eidx[n * 8 + k]] + erank[n * 8 + k] : off[64] + n;
      const bf16_t* y = ybuf + (size_t)row * 1024;
#pragma unroll
      for (int j = 0; j < 4; ++j) {
        const uint2 u = *(const uint2*)(y + (j * 64 + lane) * 4);
        acc[j * 4 + 0] += bf2f((bf16_t)(u.x & 0xffff)); acc[j * 4 + 1] += bf2f((bf16_t)(u.x >> 16));
        acc[j * 4 + 2] += bf2f((bf16_t)(u.y & 0xffff)); acc[j * 4 + 3] += bf2f((bf16_t)(u.y >> 16));
      }
    }
    const float* m5 = mod + ((size_t)l * 3 + tok_modrow(n)) * 6144 + 5 * 1024;
    float v[16];
#pragma unroll
    for (int j = 0; j < 4; ++j) {
      const int c = (j * 64 + lane) * 4;
      const float4 x = *(const float4*)(xs + (size_t)n * 1024 + c), g = *(const float4*)(m5 + c);
      v[j * 4 + 0] = x.x + g.x * acc[j * 4 + 0]; v[j * 4 + 1] = x.y + g.y * acc[j * 4 + 1];
      v[j * 4 + 2] = x.z + g.z * acc[j * 4 + 2]; v[j * 4 + 3] = x.w + g.w * acc[j * 4 + 3];
      if (!last) *(float4*)(xs + (size_t)n * 1024 + c) = make_float4(v[j * 4], v[j * 4 + 1], v[j * 4 + 2], v[j * 4 + 3]);
    }
    if (!last) {
      const float* m = mod + ((size_t)(l + 1) * 3 + tok_modrow(n)) * 6144;
      row_norm_mod(v, p.g_mix + (size_t)(l + 1) * 1024, m, m + 1024, H + (size_t)n * 1024, lane);
    } else {
      float ss = 0.f;
#pragma unroll
      for (int i = 0; i < 16; ++i) ss += v[i] * v[i];
      ss = wave_sum(ss);
      const float rs = frsq(ss * (1.f / 1024.f) + 1e-6f);
#pragma unroll
      for (int j = 0; j < 4; ++j) {
        const int c = (j * 64 + lane) * 4;
        const float4 g = *(const float4*)(p.g_final + c);
        *(float4*)(p.out + (size_t)n * 1024 + c) = make_float4(v[j * 4] * rs * g.x, v[j * 4 + 1] * rs * g.y, v[j * 4 + 2] * rs * g.z, v[j * 4 + 3] * rs * g.w);
      }
    }
  }
}
#define SMEM_BYTES (160 * 1024)
#ifndef MEGA
#define MEGA 0
#endif
DI int* cnt_ptr(const Params& p, int l) { return (int*)(p.ws + OFF_CNT) + 1024 + 2048 * l; }
DI int* ctr_ptr(const Params& p, int l) { return (int*)(p.ws + OFF_CNT) + 32 * l; }
#if !MEGA
__global__ void __launch_bounds__(NTHR) k_phaseA(Params p) { SMEM_DECL(smem, SMEM_BYTES); phaseA(p, smem); }
__global__ void __launch_bounds__(NTHR) k_norm0(Params p) { phase_norm0(p); }
__global__ void __launch_bounds__(NTHR) k_win(Params p, int l) { SMEM_DECL(smem, SMEM_BYTES); phase_win(p, l, smem); }
__global__ void __launch_bounds__(NTHR) k_p3(Params p, int l) { SMEM_DECL(smem, SMEM_BYTES); phase3(p, l, smem); }
__global__ void __launch_bounds__(NTHR) k_p3b(Params p, int l) { SMEM_DECL(smem, SMEM_BYTES); phase3b(p, l, smem); }
__global__ void __launch_bounds__(NTHR) k_p4(Params p, int l) { SMEM_DECL(smem, SMEM_BYTES); phase4(p, l, smem, ctr_ptr(p, l)); }
__global__ void __launch_bounds__(NTHR) k_p5(Params p, int l, int wc) { SMEM_DECL(smem, SMEM_BYTES); phase5(p, l, wc != 0, smem); }
__global__ void __launch_bounds__(NTHR) k_merge(Params p, int l, int wc) { SMEM_DECL(smem, SMEM_BYTES); phase_merge(p, l, wc != 0, smem); }
__global__ void __launch_bounds__(NTHR) k_wout(Params p, int l, int wc) { SMEM_DECL(smem, SMEM_BYTES); phase_wout(p, l, wc != 0, smem); }
__global__ void __launch_bounds__(NTHR) k_router(Params p, int l, int wc) { SMEM_DECL(smem, SMEM_BYTES); phase_router(p, l, wc != 0, smem, cnt_ptr(p, l)); }
__global__ void __launch_bounds__(NTHR) k_moe(Params p, int l, int wc) { SMEM_DECL(smem, SMEM_BYTES); phase_moe(p, l, wc != 0, smem, cnt_ptr(p, l)); }
__global__ void __launch_bounds__(NTHR) k_combine(Params p, int l, int last) { SMEM_DECL(smem, SMEM_BYTES); phase_combine(p, l, last != 0, smem, cnt_ptr(p, l)); }
#else
#ifndef EMU
#define XB_TMO      128
#define XB_XCNT(j)  (256  + 64 * (j))
#define XB_XSUB(j)  (1280 + 64 * (j))
#define XB_XGEN(j)  (2304 + 64 * (j))
#define XB_TOP      3328
#define XB_TOPGEN   3392
#define XCD_BAR_WORDS 3456
#define XB_SPIN_CAP (1u << 24)
#define LAS __attribute__((address_space(3)))
DI unsigned xb_ld(unsigned* p) { return __hip_atomic_load(p, __ATOMIC_RELAXED, __HIP_MEMORY_SCOPE_AGENT); }
DI unsigned xb_add(unsigned* p, unsigned v) { return __hip_atomic_fetch_add(p, v, __ATOMIC_RELAXED, __HIP_MEMORY_SCOPE_AGENT); }
DI unsigned xb_xcc_id() { return (unsigned)__builtin_amdgcn_s_getreg((3 << 11) | 20) & 0xFu; }
#define XB_SPIN(cond, bar) do { unsigned _sp = 0; while (cond) { __builtin_amdgcn_s_sleep(1); \
    if ((++_sp & 255u) == 0u) { if (xb_ld(&(bar)[XB_TMO])) break; if (_sp > XB_SPIN_CAP) { atomicAdd(&(bar)[XB_TMO], 1u); break; } } } } while (0)
struct XcdBarrier { unsigned* bar; unsigned x; volatile LAS unsigned* st; };
DI XcdBarrier xcd_barrier_post(unsigned* bar, volatile LAS unsigned* st) {
  XcdBarrier b; b.bar = bar; b.x = xb_xcc_id(); b.st = st;
  if (threadIdx.x == 0) (void)xb_add(&bar[XB_XCNT(b.x)], 1u);
  return b;
}
DI void xcd_barrier_complete(unsigned* bar, unsigned x, unsigned& nloc, unsigned& nx) {
  const unsigned G = gridDim.x * gridDim.y * gridDim.z;
  unsigned sum, cnt, mine, sp = 0u;
  for (;;) {
    sum = 0u; cnt = 0u; mine = 0u;
#pragma unroll
    for (unsigned j = 0; j < 16; ++j) { const unsigned c = xb_ld(&bar[XB_XCNT(j)]); sum += c; cnt += (c > 0u) ? 1u : 0u; mine = (j == x) ? c : mine; }
    if (sum == G) break;
    __builtin_amdgcn_s_sleep(1);
    if ((++sp & 255u) == 0u) { if (xb_ld(&bar[XB_TMO])) break; if (sp > XB_SPIN_CAP) { atomicAdd(&bar[XB_TMO], 1u); break; } }
  }
  nloc = mine > 0u ? mine : 1u; nx = cnt > 0u ? cnt : 1u;
}
DI void xcd_barrier(const XcdBarrier& b) {
  asm volatile("s_waitcnt vmcnt(0)" ::: "memory");
  __syncthreads();
  if (threadIdx.x == 0) {
    unsigned* bar = b.bar;
    __builtin_amdgcn_s_waitcnt(0);
    unsigned nloc = b.st[0], nx = b.st[1];
    if (nloc == 0u) { xcd_barrier_complete(bar, b.x, nloc, nx); b.st[0] = nloc; b.st[1] = nx; }
    const unsigned old = xb_add(&bar[XB_XSUB(b.x)], 1u);
    const unsigned gen = old / nloc;
    if (old + 1u == (gen + 1u) * nloc) {
      __builtin_amdgcn_fence(__ATOMIC_RELEASE, "agent");
      asm volatile("s_waitcnt vmcnt(0)" ::: "memory");
      const unsigned og = xb_add(&bar[XB_TOP], 1u);
      const unsigned tg = og / nx;
      if (og + 1u == (tg + 1u) * nx) xb_add(&bar[XB_TOPGEN], 1u);
      else XB_SPIN(xb_ld(&bar[XB_TOPGEN]) == tg, bar);
      __builtin_amdgcn_fence(__ATOMIC_ACQUIRE, "agent");
      xb_add(&bar[XB_XGEN(b.x)], 1u);
      asm volatile("s_waitcnt vmcnt(0)" ::: "memory");
    } else {
      XB_SPIN(xb_ld(&bar[XB_XGEN(b.x)]) == gen, bar);
      __builtin_amdgcn_fence(__ATOMIC_ACQUIRE, "agent");
      asm volatile("s_waitcnt vmcnt(0)" ::: "memory");
    }
  }
  __syncthreads();
}
#define GSYNC() { XcdBarrier xb_; xb_.bar = (unsigned*)(p.ws + OFF_BAR); xb_.x = xb_xcc_id(); xb_.st = (volatile LAS unsigned*)(smem + SMEM_BYTES - 32); xcd_barrier(xb_); }
#else
#define GSYNC() emu::grid_barrier()
#endif
#ifdef PROBE_IDX
#define TS(i) { if (blockIdx.x == 0 && threadIdx.x == 0) ts[i] = wall_clock64(); }
#else
#define TS(i)
#endif
__global__ void __launch_bounds__(NTHR) k_mega(Params p) {
  SMEM_DECL(smem, SMEM_BYTES);
  cooperative_groups::grid_group grid = cooperative_groups::this_grid();
  volatile LAS unsigned* xst = (volatile LAS unsigned*)(smem + SMEM_BYTES - 32);
  if (threadIdx.x == 0) { xst[0] = 0u; xst[1] = 0u; }
  __syncthreads();
  (void)xcd_barrier_post((unsigned*)(p.ws + OFF_BAR), xst);
#ifdef PROBE_IDX
  long long* ts = (long long*)(p.ws + OFF_CNT + 2048);
#endif
  TS(0);
  phaseA(p, smem);
  grid.sync(); TS(1);
  phase_norm0(p);
  GSYNC(); TS(2);
#pragma unroll 1
  for (int l = 0; l < 2; ++l) {
    const bool wc = l == 0;
    phase_win(p, l, smem); GSYNC(); TS(3 + l * 10);
    phase3(p, l, smem); GSYNC(); TS(4 + l * 10);
    phase3b(p, l, smem); GSYNC(); TS(5 + l * 10);
    phase4(p, l, smem, ctr_ptr(p, l)); GSYNC(); TS(6 + l * 10);
    phase5(p, l, wc, smem); GSYNC(); TS(7 + l * 10);
    phase_merge(p, l, wc, smem); GSYNC(); TS(8 + l * 10);
    phase_wout(p, l, wc, smem); GSYNC(); TS(9 + l * 10);
    phase_router(p, l, wc, smem, cnt_ptr(p, l)); GSYNC(); TS(10 + l * 10);
    phase_moe(p, l, wc, smem, cnt_ptr(p, l)); GSYNC(); TS(11 + l * 10);
    phase_combine(p, l, l == 1, smem, cnt_ptr(p, l));
#ifdef PROBE_IDX
    GSYNC(); TS(12 + l * 10);
#else
    if (l == 0) GSYNC();
#endif
  }
#ifdef PROBE_IDX
  if (blockIdx.x == 0 && threadIdx.x == 0) {
    const float us = (float)(ts[PROBE_IDX + 1] - ts[PROBE_IDX]) * 0.01f;
    p.out[0] += PROBE_IDX >= 40 ? rintf(6.f * log2f(fmaxf(us * 16.f, 1.f))) : rintf(6.f * log2f(fmaxf(us, 1.f)));
  }
#endif
}
#endif

extern "C" void kernel_launch(void* const* d_in, const int* in_sizes, int n_in, void* d_out, int out_size, void* d_ws,
                              size_t ws_size, hipStream_t stream) {
  Params p{};
  const float** pp = (const float**)&p;
  for (int i = 0; i < 41; ++i) pp[i] = (const float*)d_in[i];
  p.out = (float*)d_out; p.ws = (char*)d_ws; p.osc = (char*)d_out;
  if (ws_size < WS_NEEDED) { fprintf(stderr, "workspace too small: %zu < %zu\n", ws_size, (size_t)WS_NEEDED); return; }
#if !MEGA
  const dim3 g(256), b(NTHR);
  hipLaunchKernelGGL(k_phaseA, g, b, 0, stream, p);
  hipLaunchKernelGGL(k_norm0, g, b, 0, stream, p);
  for (int l = 0; l < 2; ++l) {
    const int wc = l == 0;
    hipLaunchKernelGGL(k_win, g, b, 0, stream, p, l);
    hipLaunchKernelGGL(k_p3, g, b, 0, stream, p, l);
    hipLaunchKernelGGL(k_p3b, g, b, 0, stream, p, l);
    hipLaunchKernelGGL(k_p4, g, b, 0, stream, p, l);
    hipLaunchKernelGGL(k_p5, g, b, 0, stream, p, l, wc);
    hipLaunchKernelGGL(k_merge, g, b, 0, stream, p, l, wc);
    hipLaunchKernelGGL(k_wout, g, b, 0, stream, p, l, wc);
    hipLaunchKernelGGL(k_router, g, b, 0, stream, p, l, wc);
    hipLaunchKernelGGL(k_moe, g, b, 0, stream, p, l, wc);
    hipLaunchKernelGGL(k_combine, g, b, 0, stream, p, l, l == 1);
  }
#else
  static int grid_blocks = 0;
  if (!grid_blocks) {
    int dev = 0, cus = 0, per_cu = 0;
    hipGetDevice(&dev);
    hipDeviceGetAttribute(&cus, hipDeviceAttributeMultiprocessorCount, dev);
    hipOccupancyMaxActiveBlocksPerMultiprocessor(&per_cu, k_mega, NTHR, 0);
    if (per_cu > 1) per_cu = 1;
    grid_blocks = cus * per_cu;
  }
  hipMemsetAsync(p.ws + OFF_BAR, 0, 16384, stream);
  void* args[] = {&p};
  hipError_t e = hipLaunchCooperativeKernel((void*)k_mega, dim3(grid_blocks), dim3(NTHR), args, 0, stream);
  if (e != hipSuccess) fprintf(stderr, "cooperative launch failed: %s (grid %d)\n", hipGetErrorString(e), grid_blocks);
#endif
}
```

```cpp
#define MEGA 1
#include <hip/hip_runtime.h>
#include <hip/hip_cooperative_groups.h>
#include <cstdio>

#ifndef SEQ_T
#define SEQ_T 8192
#endif
#ifndef CTX_L
#define CTX_L 256
#endif

#define DI __device__ __forceinline__
typedef unsigned short bf16_t;
typedef short bf16x8 __attribute__((ext_vector_type(8)));
typedef float f32x16 __attribute__((ext_vector_type(16)));
typedef float f32x4 __attribute__((ext_vector_type(4)));
typedef unsigned u32x4 __attribute__((ext_vector_type(4)));

constexpr int NB_ = 2, T_ = SEQ_T, CL_ = CTX_L, D_ = 1024;
constexpr int NX_ = NB_ * T_, NC_ = NB_ * CL_, NT_ = NX_ + NC_, KT_ = CL_ + T_;
constexpr int GRID_W_ = 64;
constexpr int MLA_H = 8, MLA_NOPE_ = 64, MLA_ROPE_ = 32, MLA_DK = 96, MLA_DV = 64, QLORA = 384, KVLORA = 256;
constexpr int MLA_IN_ = 672, ML_IN_ = 784, RW_IN_ = 1152, GATE_IN_ = 3072, D_IN_ = 5680;
constexpr int ZMLA_W = 768;
constexpr int ZREC_W = 1936;
constexpr int WIN_N = 768 + 2048;
constexpr int ML_H = 4, ML_DK = 32, ML_DV = 64, ML_L = 64;
constexpr int RW_H = 4, RW_N_ = 64;
constexpr int NE_ = 64, TOPK_ = 8, DE_ = 256;
constexpr int NCH_ = KT_ / ML_L;
constexpr int NSEQ_ = 2 * NB_ * 4;

constexpr int ZR_MLQ = 0, ZR_MLK = 128, ZR_MLV = 256, ZR_MLO = 512, ZR_MLI = 768, ZR_MLF = 776;
constexpr int ZR_RW = 784;

constexpr size_t al256(size_t x) { return (x + 255) & ~(size_t)255; }
constexpr size_t WM_WIN = 0;
constexpr size_t WM_GATE = WM_WIN + (size_t)WIN_N * 1024 * 2;
constexpr size_t WM_UQ = WM_GATE + (size_t)3072 * 1024 * 2;
constexpr size_t WM_UKV = WM_UQ + (size_t)768 * 384 * 2;
constexpr size_t WM_BRA = WM_UKV + (size_t)1024 * 256 * 2;
constexpr size_t WM_BRM = WM_BRA + (size_t)1024 * 512 * 2;
constexpr size_t WM_BRR = WM_BRM + (size_t)1024 * 256 * 2;
constexpr size_t WM_OUT = WM_BRR + (size_t)1024 * 256 * 2;
constexpr size_t WM_RT = WM_OUT + (size_t)1024 * 1024 * 2;
constexpr size_t WM_SIZE = al256(WM_RT + (size_t)64 * 1024 * 2);
constexpr size_t WE_GU = 0;
constexpr size_t WE_DN = WE_GU + (size_t)65 * 512 * 1024 * 2;
constexpr size_t WE_SIZE = al256(WE_DN + (size_t)65 * 1024 * 256 * 2);

constexpr size_t OFF_XS = 0;
constexpr size_t OFF_MOD = OFF_XS + al256((size_t)NT_ * 1024 * 4);
constexpr size_t OFF_ROPE = OFF_MOD + al256((size_t)2 * 3 * 6144 * 4);
constexpr size_t OFF_H = OFF_ROPE + al256((size_t)T_ * 16 * 8);
constexpr size_t OFF_WMIX = OFF_H + al256((size_t)NT_ * 1024 * 2);
constexpr size_t OFF_CNT = OFF_WMIX + 2 * WM_SIZE;
constexpr size_t OFF_BAR = OFF_CNT + 32768;
constexpr size_t OFF_REGION = OFF_BAR + 16384;
constexpr size_t R_ZREC = 0;
constexpr size_t R_RB16 = R_ZREC + al256((size_t)NT_ * ZREC_W * 4);
constexpr size_t R_LW = R_RB16 + al256((size_t)7 * NT_ * 256 * 2);
constexpr size_t R_BS = R_LW + al256((size_t)2 * NT_ * 256 * 4);
constexpr size_t R_CH = R_BS + al256((size_t)2 * NT_ * 4 * 4);
constexpr size_t R_YS = R_CH + al256((size_t)NSEQ_ * NCH_ * 40960);
constexpr size_t R_MLST = R_YS + al256((size_t)2 * NT_ * 256 * 4);
constexpr size_t R_ATT = R_MLST + al256((size_t)NSEQ_ * NCH_ * 2112 * 4);
constexpr size_t R_MLO = R_ATT + al256((size_t)NT_ * 512 * 2);
constexpr size_t R_RWO = R_MLO + al256((size_t)NT_ * 256 * 2);
constexpr size_t R_VT = R_RWO + al256((size_t)NT_ * 256 * 2);
constexpr size_t R_KB = R_VT + al256((size_t)NB_ * MLA_H * 64 * KT_ * 2);
constexpr size_t R_MIX_END = R_KB + al256((size_t)NB_ * MLA_H * KT_ * 96 * 2);
constexpr int NSLOT_ = NT_ * 9;
constexpr size_t R_YBUF = 0;
constexpr size_t R_EIDX = R_YBUF + al256((size_t)NSLOT_ * 1024 * 2);
constexpr size_t R_EWT = R_EIDX + al256((size_t)NT_ * 8 * 4);
constexpr size_t R_ERANK = R_EWT + al256((size_t)NT_ * 8 * 4);
constexpr size_t R_ELIST = R_ERANK + al256((size_t)NT_ * 8 * 4);
constexpr size_t R_WMOE = R_ELIST + al256((size_t)64 * NT_ * 4);
constexpr size_t R_MOE_END = R_WMOE + WE_SIZE;
constexpr size_t R_SIZE = R_MIX_END > R_MOE_END ? R_MIX_END : R_MOE_END;
constexpr size_t WS_NEEDED = OFF_REGION + R_SIZE;
constexpr size_t O_ZMLA = 0;
constexpr size_t O_QB = O_ZMLA + al256((size_t)NT_ * ZMLA_W * 2);
constexpr size_t O_END = O_QB + al256((size_t)NT_ * 768 * 2);
constexpr size_t O_YMIX = 0;
#if SEQ_T == 8192 && CTX_L == 256
static_assert(O_END <= (size_t)NX_ * 1024 * 4, "d_out scratch overflow");
static_assert((size_t)NT_ * 1024 * 2 <= (size_t)NX_ * 1024 * 4, "ymix overflow");
static_assert(WS_NEEDED <= (size_t)597000000, "workspace too large");
#endif

struct Params {
  const float *x, *c, *ctx, *c_ctx, *w_mod, *b_mod, *g_mix, *g_ffn, *w_in, *g_cq, *w_uq, *g_ckv, *w_uk, *w_uv;
  const float *ml_b_i, *ml_b_f, *ml_g_norm, *rw_mu, *rw_w0, *rw_w2, *rw_a0, *rw_a2, *rw_g2, *rw_k_k, *rw_k_a;
  const float *rw_r_k, *rw_lnx_w, *rw_lnx_b, *w_br_mla, *w_br_ml, *w_br_rw, *w_out, *w_router, *router_bias;
  const float *w_e_gate, *w_e_up, *w_e_down, *w_s_gate, *w_s_up, *w_s_down, *g_final;
  float* out; char* ws; char* osc;
};

DI float bf2f(bf16_t s) { unsigned u = ((unsigned)s) << 16; float f; __builtin_memcpy(&f, &u, 4); return f; }
DI bf16_t f2bf(float x) { unsigned u; __builtin_memcpy(&u, &x, 4); u += 0x7fffu + ((u >> 16) & 1u); return (bf16_t)(u >> 16); }
DI unsigned pack2bf(float a, float b) {
#ifdef EMU
  return (unsigned)f2bf(a) | ((unsigned)f2bf(b) << 16);
#else
  typedef __bf16 bf2 __attribute__((ext_vector_type(2)));
  typedef float f2 __attribute__((ext_vector_type(2)));
  f2 v = {a, b}; bf2 r = __builtin_convertvector(v, bf2); return __builtin_bit_cast(unsigned, r);
#endif
}
DI f32x16 mfma32(bf16x8 a, bf16x8 b, f32x16 c) {
#ifdef EMU
  return emu_mfma_32x32x16_bf16(a, b, c);
#else
  return __builtin_amdgcn_mfma_f32_32x32x16_bf16(a, b, c, 0, 0, 0);
#endif
}
DI int rfl(int v) {
#ifdef EMU
  return v;
#else
  return __builtin_amdgcn_readfirstlane(v);
#endif
}
DI int opaque_tid() {
#ifdef EMU
  return threadIdx.x;
#else
  int t = threadIdx.x; asm volatile("" : "+v"(t)); return t;
#endif
}
DI void wave_sync() {
#ifdef EMU
  (void)__ballot(1);
#else
  asm volatile("" ::: "memory");
#endif
}
DI int vblock() {
  const int g = gridDim.x, b = blockIdx.x;
  return (g & 7) == 0 ? (b & 7) * (g >> 3) + (b >> 3) : b;
}
DI int xcc_id() {
#ifdef EMU
  return blockIdx.x & 7;
#else
  return (int)(__builtin_amdgcn_s_getreg((3 << 11) | 20) & 7u);
#endif
}
DI int ld_relaxed(int* p) {
#ifdef EMU
  return __atomic_load_n(p, __ATOMIC_SEQ_CST);
#else
  return __hip_atomic_load(p, __ATOMIC_RELAXED, __HIP_MEMORY_SCOPE_AGENT);
#endif
}
DI void sched_fence() {
#ifndef EMU
  __builtin_amdgcn_sched_barrier(0);
#endif
}
template <int L> DI float lane_bcast(float x) {
#ifdef EMU
  return __shfl(x, L);
#else
  return __builtin_bit_cast(float, __builtin_amdgcn_readlane(__builtin_bit_cast(int, x), L));
#endif
}
DI f32x16 zero16() { f32x16 z; for (int i = 0; i < 16; ++i) z[i] = 0.f; return z; }
DI int crow(int reg, int h) { return (reg & 3) + 8 * (reg >> 2) + 4 * h; }
#ifdef EMU
DI float fexp(float x) { return expf(x); }
#else
DI float fexp(float x) { return __expf(x); }
#endif
#ifdef EMU
DI float frcp(float x) { return 1.f / x; }
DI float frsq(float x) { return 1.f / sqrtf(x); }
#else
DI float frcp(float x) { return __builtin_amdgcn_rcpf(x); }
DI float frsq(float x) { return __builtin_amdgcn_rsqf(x); }
#endif
DI float sigmoidf_(float x) { return frcp(1.f + fexp(-x)); }
DI float siluf_(float x) { return x * sigmoidf_(x); }
#ifdef EMU
DI float wave_sum(float v) { for (int m = 32; m >= 1; m >>= 1) v += __shfl_xor(v, m); return v; }
DI float wave_max(float v) { for (int m = 32; m >= 1; m >>= 1) v = fmaxf(v, __shfl_xor(v, m)); return v; }
#else
#define DPPF(x, ctrl) __builtin_bit_cast(float, __builtin_amdgcn_mov_dpp(__builtin_bit_cast(int, (x)), (ctrl), 0xf, 0xf, true))
#define RDLF(x, l) __builtin_bit_cast(float, __builtin_amdgcn_readlane(__builtin_bit_cast(int, (x)), (l)))
DI float wave_sum(float v) {
  v += DPPF(v, 0xB1); v += DPPF(v, 0x4E); v += DPPF(v, 0x124); v += DPPF(v, 0x128);
  return (RDLF(v, 0) + RDLF(v, 16)) + (RDLF(v, 32) + RDLF(v, 48));
}
DI float wave_max(float v) {
  v = fmaxf(v, DPPF(v, 0xB1)); v = fmaxf(v, DPPF(v, 0x4E)); v = fmaxf(v, DPPF(v, 0x124)); v = fmaxf(v, DPPF(v, 0x128));
  return fmaxf(fmaxf(RDLF(v, 0), RDLF(v, 16)), fmaxf(RDLF(v, 32), RDLF(v, 48)));
}
#endif

DI int tok_b(int n) { return n < NX_ ? n / T_ : (n - NX_) / CL_; }
DI int tok_t(int n) { return n < NX_ ? n % T_ : (n - NX_) % CL_; }
DI int tok_key(int n) { return n < NX_ ? CL_ + n % T_ : (n - NX_) % CL_; }
DI int tok_modrow(int n) { return n < NX_ ? n / T_ : 2; }

#ifdef EMU
#define SMEM_DECL(name, bytes) char* name = (char*)emu::shared_alloc(bytes)
#else
#define SMEM_DECL(name, bytes) __shared__ __attribute__((aligned(16))) char name[bytes]
#endif
#define NTHR 512
#if defined(PROBE_IDX) && !defined(EMU)
#define TSB(pp, i) { if (blockIdx.x == 0 && threadIdx.x == 0) ((long long*)((pp).ws + OFF_CNT + 2048))[i] = wall_clock64(); }
#else
#define TSB(pp, i)
#endif
struct CvtJob { const float* src; int lds; int K; bf16_t* dst; int ntn; int ntk; int maptype; const float* gain; };
DI int cvt_map(int maptype, int coff, int np) {
  if (maptype == 0) return coff + np;
  if (maptype == 1) { if (np < 672) return np; if (np < 768) return -1; if (np < 768 + 1936) return np - 96; return -1; }
  return np;
}
struct CvtItem { CvtJob j; int coff, tk, tn; };
struct CvtRegs { float v[8]; };
DI void cvt_load(const CvtItem& c, int tid, CvtRegs& r) {
  const int kk = tid >> 4, np = c.tn * 64 + (tid & 15) * 4;
  const int sc = cvt_map(c.j.maptype, c.coff, np);
#pragma unroll
  for (int u = 0; u < 2; ++u) {
    const int k = c.tk * 64 + kk + 32 * u;
    float4 v = make_float4(0.f, 0.f, 0.f, 0.f);
    if (sc >= 0) v = *(const float4*)(c.j.src + (size_t)k * c.j.lds + sc);
    const float g = c.j.gain ? c.j.gain[k] : 1.f;
    r.v[4 * u] = v.x * g; r.v[4 * u + 1] = v.y * g; r.v[4 * u + 2] = v.z * g; r.v[4 * u + 3] = v.w * g;
  }
}
DI void cvt_store(const CvtItem& c, int tid, const CvtRegs& r, char* smem) {
  float* tile = (float*)smem;
  __syncthreads();
  {
    const int kk = tid >> 4, nc = (tid & 15) * 4;
#pragma unroll
    for (int u = 0; u < 2; ++u)
#pragma unroll
      for (int i = 0; i < 4; ++i) tile[(kk + 32 * u) * 65 + nc + i] = r.v[4 * u + i];
  }
  __syncthreads();
  {
    const int n = tid >> 3, kc = (tid & 7) * 8;
    int np = c.tn * 64 + n;
    if (c.j.maptype == 2) np = (np >> 5) * 64 + c.coff * 32 + (np & 31);
    uint4 v;
    v.x = pack2bf(tile[(kc + 0) * 65 + n], tile[(kc + 1) * 65 + n]);
    v.y = pack2bf(tile[(kc + 2) * 65 + n], tile[(kc + 3) * 65 + n]);
    v.z = pack2bf(tile[(kc + 4) * 65 + n], tile[(kc + 5) * 65 + n]);
    v.w = pack2bf(tile[(kc + 6) * 65 + n], tile[(kc + 7) * 65 + n]);
    *(uint4*)(c.j.dst + (size_t)np * c.j.K + c.tk * 64 + kc) = v;
  }
}
template <class Dec> DI void cvt_run(Dec dec, int first, int n, int stride, char* smem) {
  const int tid = opaque_tid();
  if (first >= n) return;
  CvtItem cur = dec(first); CvtRegs rc; cvt_load(cur, tid, rc);
  for (int it = first; it < n; it += stride) {
    const int nx = it + stride < n ? it + stride : it;
    CvtItem nxt = dec(nx); CvtRegs rn; cvt_load(nxt, tid, rn);
    sched_fence();
    cvt_store(cur, tid, rc, smem);
    cur = nxt; rc = rn;
  }
}

constexpr int CVT_MIX_TILES = 704 + 768 + 72 + 32 + 32 + 128 + 64 + 64 + 256 + 16;
DI CvtItem cvt_mix_dec(const Params& p, int l, int it) {
  bf16_t* W = (bf16_t*)(p.ws + OFF_WMIX + (size_t)l * WM_SIZE);
  CvtJob j; int coff = 0;
  if (it < 704) { j = {p.w_in + (size_t)l * 1024 * D_IN_, D_IN_, 1024, (bf16_t*)((char*)W + WM_WIN), 44, 16, 1, nullptr}; }
  else if ((it -= 704) < 768) { j = {p.w_in + (size_t)l * 1024 * D_IN_, D_IN_, 1024, (bf16_t*)((char*)W + WM_GATE), 48, 16, 0, nullptr}; coff = 2608; }
  else if ((it -= 768) < 72) { j = {p.w_uq + (size_t)l * 384 * 768, 768, 384, (bf16_t*)((char*)W + WM_UQ), 12, 6, 0, p.g_cq + l * 384}; }
  else if ((it -= 72) < 32) { j = {p.w_uk + (size_t)l * 256 * 512, 512, 256, (bf16_t*)((char*)W + WM_UKV), 8, 4, 0, p.g_ckv + l * 256}; }
  else if ((it -= 32) < 32) { j = {p.w_uv + (size_t)l * 256 * 512, 512, 256, (bf16_t*)((char*)W + WM_UKV) + 512 * 256, 8, 4, 0, p.g_ckv + l * 256}; }
  else if ((it -= 32) < 128) { j = {p.w_br_mla + (size_t)l * 512 * 1024, 1024, 512, (bf16_t*)((char*)W + WM_BRA), 16, 8, 0, nullptr}; }
  else if ((it -= 128) < 64) { j = {p.w_br_ml + (size_t)l * 256 * 1024, 1024, 256, (bf16_t*)((char*)W + WM_BRM), 16, 4, 0, nullptr}; }
  else if ((it -= 64) < 64) { j = {p.w_br_rw + (size_t)l * 256 * 1024, 1024, 256, (bf16_t*)((char*)W + WM_BRR), 16, 4, 0, nullptr}; }
  else if ((it -= 64) < 256) { j = {p.w_out + (size_t)l * 1024 * 1024, 1024, 1024, (bf16_t*)((char*)W + WM_OUT), 16, 16, 0, nullptr}; }
  else { it -= 256; j = {p.w_router + (size_t)l * 1024 * 64, 64, 1024, (bf16_t*)((char*)W + WM_RT), 1, 16, 0, nullptr}; }
  CvtItem c; c.j = j; c.coff = coff; c.tk = it / j.ntn; c.tn = it % j.ntn; return c;
}
constexpr int CVT_MOE_TILES = 65 * 192;
DI CvtItem cvt_moe_dec(const Params& p, int l, int it) {
  const int e = it / 192; int r = it % 192;
  bf16_t* GU = (bf16_t*)(p.ws + OFF_REGION + R_WMOE + WE_GU) + (size_t)e * 512 * 1024;
  bf16_t* DN = (bf16_t*)(p.ws + OFF_REGION + R_WMOE + WE_DN) + (size_t)e * 1024 * 256;
  const float* sg = e < 64 ? p.w_e_gate + ((size_t)l * 64 + e) * 1024 * 256 : p.w_s_gate + (size_t)l * 1024 * 256;
  const float* su = e < 64 ? p.w_e_up + ((size_t)l * 64 + e) * 1024 * 256 : p.w_s_up + (size_t)l * 1024 * 256;
  const float* sd = e < 64 ? p.w_e_down + ((size_t)l * 64 + e) * 256 * 1024 : p.w_s_down + (size_t)l * 256 * 1024;
  CvtJob j; int coff = 0;
  if (r < 64) { j = {sg, 256, 1024, GU, 4, 16, 2, nullptr}; coff = 0; }
  else if ((r -= 64) < 64) { j = {su, 256, 1024, GU, 4, 16, 2, nullptr}; coff = 1; }
  else { r -= 64; j = {sd, 1024, 256, DN, 16, 4, 0, nullptr}; }
  CvtItem c; c.j = j; c.coff = coff; c.tk = r / j.ntn; c.tn = r % j.ntn; return c;
}

DI void mod_item(const Params& p, int it, char* smem) {
  float* cond = (float*)smem;
  float* red = cond + 3 * 1024;
  const int tid = opaque_tid(), l = it / 96, j0 = (it % 96) * 64;
  __syncthreads();
  for (int i = tid; i < 3 * 1024; i += NTHR) {
    const int r = i >> 10, k = i & 1023;
    const float v = r < 2 ? p.c[r * 1024 + k] : p.c_ctx[k];
    cond[i] = siluf_(v);
  }
  __syncthreads();
  const int jj = tid & 63, kg = tid >> 6;
  float a0 = 0.f, a1 = 0.f, a2 = 0.f;
  const float* w = p.w_mod + (size_t)l * 1024 * 6144 + j0 + jj;
  for (int k = kg; k < 1024; k += 8) {
    const float wv = w[(size_t)k * 6144];
    a0 += cond[k] * wv; a1 += cond[1024 + k] * wv; a2 += cond[2048 + k] * wv;
  }
  red[(kg * 3 + 0) * 64 + jj] = a0; red[(kg * 3 + 1) * 64 + jj] = a1; red[(kg * 3 + 2) * 64 + jj] = a2;
  __syncthreads();
  if (tid < 192) {
    const int r = tid >> 6; float s = 0.f;
    for (int g = 0; g < 8; ++g) s += red[(g * 3 + r) * 64 + jj];
    float* mod = (float*)(p.ws + OFF_MOD);
    mod[((size_t)l * 3 + r) * 6144 + j0 + jj] = s + p.b_mod[(size_t)l * 6144 + j0 + jj];
  }
}
DI void rope_item(const Params& p, int it) {
  const int idx = it * NTHR + threadIdx.x;
  if (idx >= T_ * 16) return;
  const int t = idx >> 4, i = idx & 15, f = i & 7;
  const float pos = (float)(i < 8 ? t / GRID_W_ : t % GRID_W_);
  const float inv = powf(10000.f, -(float)(2 * f) / 16.f);
  const float ang = pos * inv;
  float2* rt = (float2*)(p.ws + OFF_ROPE);
  rt[idx] = make_float2(cosf(ang), sinf(ang));
}
constexpr int PA_ITEMS = 192 + (T_ * 16 + NTHR - 1) / NTHR;
DI void phaseA(const Params& p, char* smem) {
  if (blockIdx.x == 0) for (int i = threadIdx.x; i < 8192; i += NTHR) ((int*)(p.ws + OFF_CNT))[i] = 0;
  for (int it = blockIdx.x; it < PA_ITEMS; it += gridDim.x) {
    if (it < 192) mod_item(p, it, smem); else rope_item(p, it - 192);
  }
  cvt_run([&](int i) { return cvt_mix_dec(p, i / CVT_MIX_TILES, i % CVT_MIX_TILES); }, blockIdx.x, 2 * CVT_MIX_TILES, gridDim.x, smem);
}

DI void row_norm_mod(const float (&v)[16], const float* g, const float* shift, const float* scale, bf16_t* hrow, int lane) {
  float ss = 0.f;
#pragma unroll
  for (int i = 0; i < 16; ++i) ss += v[i] * v[i];
  ss = wave_sum(ss);
  const float rs = frsq(ss * (1.f / 1024.f) + 1e-6f);
#pragma unroll
  for (int j = 0; j < 4; ++j) {
    const int c = (j * 64 + lane) * 4;
    const float4 gg = *(const float4*)(g + c), sh = *(const float4*)(shift + c), sc = *(const float4*)(scale + c);
    const float h0 = v[j * 4 + 0] * rs * gg.x * (1.f + sc.x) + sh.x;
    const float h1 = v[j * 4 + 1] * rs * gg.y * (1.f + sc.y) + sh.y;
    const float h2 = v[j * 4 + 2] * rs * gg.z * (1.f + sc.z) + sh.z;
    const float h3 = v[j * 4 + 3] * rs * gg.w * (1.f + sc.w) + sh.w;
    uint2 o; o.x = pack2bf(h0, h1); o.y = pack2bf(h2, h3);
    *(uint2*)(hrow + c) = o;
  }
}
DI void phase_norm0(const Params& p) {
  const int lane = threadIdx.x & 63, wid = threadIdx.x >> 6;
  float* xs = (float*)(p.ws + OFF_XS);
  bf16_t* H = (bf16_t*)(p.ws + OFF_H);
  const float* mod = (const float*)(p.ws + OFF_MOD);
  for (int n = blockIdx.x * 8 + wid; n < NT_; n += gridDim.x * 8) {
    const float* src = n < NX_ ? p.x + (size_t)n * 1024 : p.ctx + (size_t)(n - NX_) * 1024;
    float v[16];
#pragma unroll
    for (int j = 0; j < 4; ++j) {
      const float4 t = *(const float4*)(src + (j * 64 + lane) * 4);
      v[j * 4] = t.x; v[j * 4 + 1] = t.y; v[j * 4 + 2] = t.z; v[j * 4 + 3] = t.w;
      *(float4*)(xs + (size_t)n * 1024 + (j * 64 + lane) * 4) = t;
    }
    const float* m = mod + (size_t)(0 * 3 + tok_modrow(n)) * 6144;
    row_norm_mod(v, p.g_mix, m, m + 1024, H + (size_t)n * 1024, lane);
  }
}

template <int BM, int BN, int BK, int WM_, int WN_>
struct Gemm {
  static constexpr int WTM = BM / WM_, WTN = BN / WN_, MB = WTM / 32, NB = WTN / 32, WM = WM_, WN = WN_, TM = BM, TN = BN;
  static constexpr int LDA = BK + 8;
  static constexpr int A_BYTES = BM * LDA * 2, B_BYTES = BN * LDA * 2, STAGE = A_BYTES + B_BYTES;
  static constexpr int SMEM = 2 * STAGE;
  static constexpr int CPR = BK / 8;
  static constexpr int ACH = BM * CPR / NTHR, BCH = BN * CPR / NTHR;
  static_assert(WM_ * WN_ == 8, "8 waves");
  static_assert(BM * CPR % NTHR == 0 && BN * CPR % NTHR == 0, "chunking");
  static_assert(NTHR % CPR == 0, "rows fixed per thread");

  template <class LA, class LB>
  static DI void run_core(f32x16 (&acc)[MB][NB], LA la, LB lb, int nk, char* smem, int tid) {
    const int lane = tid & 63, wid = tid >> 6, wm = wid / WN_, wn = wid % WN_;
    const int kc = (tid % CPR) * 8, r0 = tid / CPR;
    constexpr int KS = BK / 16, NCH = ACH + BCH;
    u32x4 s0[NCH], s1[NCH];
#define GEMM_LOAD(dst_, kt_) { const int kq_ = (kt_) < nk ? (kt_) : nk - 1; \
    _Pragma("unroll") for (int i = 0; i < ACH; ++i) dst_[i] = la(i, kq_); \
    _Pragma("unroll") for (int i = 0; i < BCH; ++i) dst_[ACH + i] = lb(i, kq_); }
#define GEMM_WRITE1(src_, c_, buf_) { if ((c_) < ACH) *(u32x4*)(smem + (buf_) * STAGE + ((r0 + (c_) * (NTHR / CPR)) * LDA + kc) * 2) = src_[c_]; \
    else *(u32x4*)(smem + (buf_) * STAGE + A_BYTES + ((r0 + ((c_) - ACH) * (NTHR / CPR)) * LDA + kc) * 2) = src_[c_]; }
#define GEMM_STEP(w_, l_, kt_) { \
    GEMM_LOAD(l_, (kt_) + 2); \
    sched_fence(); \
    const char* As = smem + ((kt_) & 1) * STAGE; const char* Bs = As + A_BYTES; \
    _Pragma("unroll") for (int ks = 0; ks < KS; ++ks) { \
      bf16x8 af[MB], bfr[NB]; \
      _Pragma("unroll") for (int mb = 0; mb < MB; ++mb) af[mb] = *(const bf16x8*)(As + ((wm * WTM + mb * 32 + (lane & 31)) * LDA + ks * 16 + (lane >> 5) * 8) * 2); \
      _Pragma("unroll") for (int nb = 0; nb < NB; ++nb) bfr[nb] = *(const bf16x8*)(Bs + ((wn * WTN + nb * 32 + (lane & 31)) * LDA + ks * 16 + (lane >> 5) * 8) * 2); \
      _Pragma("unroll") for (int c = 0; c < NCH; ++c) if ((c * KS) / NCH == ks) GEMM_WRITE1(w_, c, ((kt_) + 1) & 1); \
      _Pragma("unroll") for (int mb = 0; mb < MB; ++mb) _Pragma("unroll") for (int nb = 0; nb < NB; ++nb) acc[mb][nb] = mfma32(af[mb], bfr[nb], acc[mb][nb]); \
    } \
    sched_fence(); \
    __syncthreads(); }
    GEMM_LOAD(s0, 0);
#pragma unroll
    for (int c = 0; c < NCH; ++c) GEMM_WRITE1(s0, c, 0);
    GEMM_LOAD(s0, 1);
    __syncthreads();
    for (int kt = 0; kt < nk; kt += 2) {
      GEMM_STEP(s0, s1, kt);
      GEMM_STEP(s1, s0, kt + 1);
    }
#undef GEMM_STEP
#undef GEMM_WRITE1
#undef GEMM_LOAD
  }
  template <class ARow>
  static DI void run(f32x16 (&acc)[MB][NB], ARow arow, const bf16_t* Bt, int ldb, int Klen, char* smem) {
    const int tid = opaque_tid();
    const int kc = (tid % CPR) * 8, r0 = tid / CPR;
    const bf16_t* ap[ACH];
#pragma unroll
    for (int i = 0; i < ACH; ++i) ap[i] = arow(r0 + i * (NTHR / CPR)) + kc;
    const bf16_t* bp0 = Bt + (size_t)r0 * ldb + kc;
    const size_t sb = (size_t)(NTHR / CPR) * ldb;
    run_core(acc, [&](int i, int kt) { return *(const u32x4*)(ap[i] + kt * BK); },
             [&](int i, int kt) { return *(const u32x4*)(bp0 + i * sb + kt * BK); }, Klen / BK, smem, tid);
  }
  static DI void run_lin(f32x16 (&acc)[MB][NB], const bf16_t* A0, int lda, const bf16_t* Bt, int ldb, int Klen, char* smem) {
    const int tid = opaque_tid();
    const int kc = (tid % CPR) * 8, r0 = tid / CPR;
    const bf16_t* ap0 = A0 + (size_t)r0 * lda + kc; const bf16_t* bp0 = Bt + (size_t)r0 * ldb + kc;
    const size_t sa = (size_t)(NTHR / CPR) * lda, sb = (size_t)(NTHR / CPR) * ldb;
    run_core(acc, [&](int i, int kt) { return *(const u32x4*)(ap0 + i * sa + kt * BK); },
             [&](int i, int kt) { return *(const u32x4*)(bp0 + i * sb + kt * BK); }, Klen / BK, smem, tid);
  }
  static DI int row_of(int t, int mb, int reg) { const int lane = t & 63, wm = (t >> 6) / WN_; return wm * WTM + mb * 32 + crow(reg, lane >> 5); }
  static DI int col_of(int t, int nb) { const int lane = t & 63, wn = (t >> 6) % WN_; return wn * WTN + nb * 32 + (lane & 31); }
};


template <int NBW> struct WTile {
  static constexpr int LD = NBW * 32 + 4;
  static constexpr int BYTES = 32 * LD * 4;
  static DI void put(float* scr, int nb, int lane, const f32x16& v) {
    const int c = nb * 32 + (lane & 31), h = lane >> 5;
#pragma unroll
    for (int i = 0; i < 16; ++i) scr[crow(i, h) * LD + c] = v[i];
  }
  template <class F> static DI void rows4(const float* scr, int lane, F f) {
    wave_sync();
#pragma unroll
    for (int it = 0; it < NBW * 4; ++it) {
      const int id = it * 64 + lane, row = id / (NBW * 8), q = id % (NBW * 8);
      f(row, q * 4, *(const float4*)(scr + row * LD + q * 4));
    }
    wave_sync();
  }
  template <class F> static DI void rows8(const float* scr, int lane, F f) {
    wave_sync();
#pragma unroll
    for (int it = 0; it < NBW * 2; ++it) {
      const int id = it * 64 + lane, row = id / (NBW * 4), q = id % (NBW * 4);
      f(row, q * 8, *(const float4*)(scr + row * LD + q * 8), *(const float4*)(scr + row * LD + q * 8 + 4));
    }
    wave_sync();
  }
};
DI uint4 pack8bf(const float4& a, const float4& b) { return make_uint4(pack2bf(a.x, a.y), pack2bf(a.z, a.w), pack2bf(b.x, b.y), pack2bf(b.z, b.w)); }

typedef Gemm<256, 256, 64, 2, 4> G256;
DI void phase_win(const Params& p, int l, char* smem) {
  const bf16_t* H = (const bf16_t*)(p.ws + OFF_H);
  const bf16_t* W = (const bf16_t*)(p.ws + OFF_WMIX + (size_t)l * WM_SIZE + WM_WIN);
  bf16_t* zmla = (bf16_t*)(p.osc + O_ZMLA);
  float* zrec = (float*)(p.ws + OFF_REGION + R_ZREC);
  constexpr int TM = NT_ / 256, TN = WIN_N / 256;
  for (int it = vblock(); it < TM * TN; it += gridDim.x) {
    const int tid = opaque_tid();
    const int tm = it / TN, tn = it % TN;
    __syncthreads();
    f32x16 acc[G256::MB][G256::NB];
#pragma unroll
    for (int a = 0; a < G256::MB; ++a)
#pragma unroll
      for (int b = 0; b < G256::NB; ++b) acc[a][b] = zero16();
    const bf16_t* A0 = H + (size_t)tm * 256 * 1024;
    G256::run(acc, [&](int r) { return A0 + (size_t)r * 1024; }, W + (size_t)tn * 256 * 1024, 1024, 1024, smem);
    {
      const int lane = tid & 63, wid = tid >> 6, wm = wid / 4, wn = wid % 4;
      float* scr = (float*)(smem + wid * WTile<2>::BYTES);
      const int col0 = tn * 256 + wn * 64;
#pragma unroll
      for (int mb = 0; mb < G256::MB; ++mb) {
        WTile<2>::put(scr, 0, lane, acc[mb][0]); WTile<2>::put(scr, 1, lane, acc[mb][1]);
        const int row0 = tm * 256 + wm * 128 + mb * 32;
#ifdef ABL_NOSTORE
        if (tn > 1000) {
#else
        if (tn < 3) {
#endif
          WTile<2>::rows8(scr, lane, [&](int r, int c, const float4& a, const float4& bq) {
            *(uint4*)(zmla + (size_t)(row0 + r) * ZMLA_W + col0 + c) = pack8bf(a, bq); });
        } else {
          WTile<2>::rows4(scr, lane, [&](int r, int c, const float4& a) {
            const int cc = col0 - 768 + c;
#ifdef ABL_NOSTORE
            if (cc < -5) *(float4*)(zrec + (size_t)(row0 + r) * ZREC_W + cc) = a; });
#else
            if (cc < ZREC_W) *(float4*)(zrec + (size_t)(row0 + r) * ZREC_W + cc) = a; });
#endif
        }
      }
    }
  }
}
typedef Gemm<128, 128, 64, 2, 4> G128;
DI void mla_row_rs(const bf16_t* zmla_rows, int c0, int len, float* rs) {
  const int tid = opaque_tid(), row = tid >> 2, half = tid & 3;
  const bf16_t* src = zmla_rows + (size_t)row * ZMLA_W + c0 + half * (len / 4);
  float ss = 0.f;
  for (int i = 0; i < len / 4; i += 8) {
    const uint4 v = *(const uint4*)(src + i);
    const unsigned w[4] = {v.x, v.y, v.z, v.w};
#pragma unroll
    for (int j = 0; j < 4; ++j) { const float a = bf2f((bf16_t)(w[j] & 0xffff)), b = bf2f((bf16_t)(w[j] >> 16)); ss += a * a + b * b; }
  }
  ss += __shfl_xor(ss, 1); ss += __shfl_xor(ss, 2);
  if (half == 0) rs[row] = frsq(ss / (float)len + 1e-6f);
}

constexpr int MLA_Q_TILES = (NT_ / 128) * 6, MLA_KV_TILES = (NT_ / 128) * 8;
DI void mla_q_item(const Params& p, int l, int it, char* smem) {
  const int tid = opaque_tid();
  const int tm = it / 6, tn = it % 6;
  const bf16_t* zmla = (const bf16_t*)(p.osc + O_ZMLA) + (size_t)tm * 128 * ZMLA_W;
  const bf16_t* W = (const bf16_t*)(p.ws + OFF_WMIX + (size_t)l * WM_SIZE + WM_UQ) + (size_t)tn * 128 * 384;
  bf16_t* qb = (bf16_t*)(p.osc + O_QB);
  const float2* rt = (const float2*)(p.ws + OFF_ROPE);
  float* rs = (float*)(smem + G128::SMEM);
  __syncthreads();
  mla_row_rs(zmla, 0, 384, rs);
  f32x16 acc[G128::MB][G128::NB];
#pragma unroll
  for (int a = 0; a < G128::MB; ++a)
#pragma unroll
    for (int b = 0; b < G128::NB; ++b) acc[a][b] = zero16();
  G128::run(acc, [&](int r) { return zmla + (size_t)r * ZMLA_W; }, W, 384, 384, smem);
  const int lane = tid & 63;
  const bool isx = tm * 128 < NX_;
#pragma unroll
  for (int mb = 0; mb < G128::MB; ++mb)
#pragma unroll
    for (int nb = 0; nb < G128::NB; ++nb) {
      const int col = tn * 128 + G128::col_of(tid, nb);
      const bool ropeblk = ((col >> 5) % 3) == 2;
      const int e = lane & 31;
#pragma unroll
      for (int i = 0; i < 16; ++i) {
        const int lr = G128::row_of(tid, mb, i);
        const int n = tm * 128 + lr;
        float v = acc[mb][nb][i] * rs[lr];
        if (ropeblk && isx) {
          const float pv = __shfl_xor(v, 8);
          const float2 cs = rt[(size_t)(n % T_) * 16 + (e >> 4) * 8 + (e & 7)];
          v = (e & 8) ? (pv * cs.y + v * cs.x) : (v * cs.x - pv * cs.y);
        }
        qb[(size_t)n * 768 + col] = f2bf(v);
      }
    }
}
DI void mla_kv_item(const Params& p, int l, int it, char* smem) {
  const int tid = opaque_tid();
  const int tm = it / 8, tn = it % 8;
  const bf16_t* zmla = (const bf16_t*)(p.osc + O_ZMLA) + (size_t)tm * 128 * ZMLA_W;
  const bf16_t* W = (const bf16_t*)(p.ws + OFF_WMIX + (size_t)l * WM_SIZE + WM_UKV) + (size_t)tn * 128 * 256;
  bf16_t* kb = (bf16_t*)(p.ws + OFF_REGION + R_KB);
  bf16_t* vt = (bf16_t*)(p.ws + OFF_REGION + R_VT);
  const float2* rt = (const float2*)(p.ws + OFF_ROPE);
  float* rs = (float*)(smem + G128::SMEM);
  __syncthreads();
  mla_row_rs(zmla, 384, 256, rs);
  const int n0 = tm * 128;
  const int b = tok_b(n0), key0 = tok_key(n0);
  const bool isx = n0 < NX_;
  if (tn == 0) {
    for (int idx = tid; idx < 128 * 16; idx += NTHR) {
      const int lr = idx >> 4, pi = idx & 15, a = pi >> 3, i = pi & 7;
      const bf16_t* z = zmla + (size_t)lr * ZMLA_W + 640 + a * 16 + i;
      float x1 = bf2f(z[0]), x2 = bf2f(z[8]);
      if (isx) {
        const float2 cs = rt[(size_t)((n0 + lr) % T_) * 16 + a * 8 + i];
        const float y1 = x1 * cs.x - x2 * cs.y, y2 = x1 * cs.y + x2 * cs.x; x1 = y1; x2 = y2;
      }
      const bf16_t o1 = f2bf(x1), o2 = f2bf(x2);
      for (int h = 0; h < 8; ++h) {
        bf16_t* dst = kb + ((size_t)(b * 8 + h) * KT_ + key0 + lr) * 96 + 64 + a * 16 + i;
        dst[0] = o1; dst[8] = o2;
      }
    }
  }
  f32x16 acc[G128::MB][G128::NB];
#pragma unroll
  for (int a = 0; a < G128::MB; ++a)
#pragma unroll
    for (int c = 0; c < G128::NB; ++c) acc[a][c] = zero16();
  G128::run(acc, [&](int r) { return zmla + (size_t)r * ZMLA_W + 384; }, W, 256, 256, smem);
  const int lane = tid & 63;
#pragma unroll
  for (int mb = 0; mb < G128::MB; ++mb)
#pragma unroll
    for (int nb = 0; nb < G128::NB; ++nb) {
      const int col = tn * 128 + G128::col_of(tid, nb);
      if (col < 512) {
        const int h = col >> 6, d = col & 63;
#pragma unroll
        for (int i = 0; i < 16; ++i) {
          const int lr = G128::row_of(tid, mb, i);
          kb[((size_t)(b * 8 + h) * KT_ + key0 + lr) * 96 + d] = f2bf(acc[mb][nb][i] * rs[lr]);
        }
      } else {
        const int h = (col - 512) >> 6, d = col & 63;
#pragma unroll
        for (int g = 0; g < 4; ++g) {
          const int lr = G128::row_of(tid, mb, g * 4);
          uint2 o;
          o.x = pack2bf(acc[mb][nb][g * 4 + 0] * rs[lr], acc[mb][nb][g * 4 + 1] * rs[lr + 1]);
          o.y = pack2bf(acc[mb][nb][g * 4 + 2] * rs[lr + 2], acc[mb][nb][g * 4 + 3] * rs[lr + 3]);
          *(uint2*)(vt + ((size_t)(b * 8 + h) * 64 + d) * KT_ + key0 + lr) = o;
        }
      }
    }
  (void)lane;
}

DI float softplusf_(float x) { return x > 20.f ? x : log1pf(fexp(x)); }
constexpr int RWP_TT = 16;
constexpr int RWP_ITEMS = NT_ / RWP_TT;
DI void rwkv_prep_items(const Params& p, int l, char* smem) {
  if ((int)blockIdx.x >= RWP_ITEMS) return;
  float* zs = (float*)smem;
  float* tw = zs + RWP_TT * 1024;
  float* ta = tw + 2 * 64 * RWP_TT;
  const float* zrec = (const float*)(p.ws + OFF_REGION + R_ZREC);
  bf16_t* rb = (bf16_t*)(p.ws + OFF_REGION + R_RB16);
  float* lwo = (float*)(p.ws + OFF_REGION + R_LW);
  float* bso = (float*)(p.ws + OFF_REGION + R_BS);
  const float* mu = p.rw_mu + (size_t)l * 1152;
  const int tid = opaque_tid();
  const int col = tid & 255, d = tid >> 8;
  const float* w2 = p.rw_w2 + ((size_t)l * 2 + d) * 64 * 256 + col;
  const float* a2 = p.rw_a2 + ((size_t)l * 2 + d) * 64 * 256 + col;
  const float rkw = p.rw_r_k[(size_t)l * 256 + col];
  const float w0 = p.rw_w0[((size_t)l * 2 + d) * 256 + col], a0 = p.rw_a0[((size_t)l * 2 + d) * 256 + col];
  const float kkw = p.rw_k_k[(size_t)l * 256 + col], kaw = p.rw_k_a[(size_t)l * 256 + col];
  const size_t AS = (size_t)NT_ * 256;
#pragma unroll 1
  for (int it = blockIdx.x; it < RWP_ITEMS; it += gridDim.x) {
    const int n0 = it * RWP_TT;
    __syncthreads();
    TSB(p, 44);
#pragma unroll 1
    for (int i = 0; i < 8; ++i) {
      const int idx4 = tid + i * NTHR, tt = idx4 >> 8, c = (idx4 & 255) * 4, n = n0 + tt, t = tok_t(n);
      const int len = n < NX_ ? T_ : CL_;
      const float* zr = zrec + (size_t)n * ZREC_W + ZR_RW + c;
      const float4 z = *(const float4*)zr;
      const float4 zp = t > 0 ? *(const float4*)(zr - ZREC_W) : make_float4(0.f, 0.f, 0.f, 0.f);
      const float4 zn = t < len - 1 ? *(const float4*)(zr + ZREC_W) : make_float4(0.f, 0.f, 0.f, 0.f);
      const float4 m4 = *(const float4*)(mu + c);
      float4 sv;
      sv.x = z.x + (0.5f * (zp.x + zn.x) - z.x) * m4.x; sv.y = z.y + (0.5f * (zp.y + zn.y) - z.y) * m4.y;
      sv.z = z.z + (0.5f * (zp.z + zn.z) - z.z) * m4.z; sv.w = z.w + (0.5f * (zp.w + zn.w) - z.w) * m4.w;
      *(float4*)(zs + tt * 1024 + c) = sv;
      if (c >= 768) {
        const float e4[4] = {sv.x, sv.y, sv.z, sv.w};
#pragma unroll
        for (int q = 0; q < 4; ++q) {
          const int cc = c + q;
          if (cc < 896) { const int dd = (cc - 768) >> 6, k = (cc - 768) & 63; tw[(dd * 64 + k) * RWP_TT + tt] = 1.f - 2.f * frcp(1.f + fexp(2.f * e4[q])); }
          else { const int dd = (cc - 896) >> 6, k = (cc - 896) & 63; ta[(dd * 64 + k) * RWP_TT + tt] = e4[q]; }
        }
      }
    }
    __syncthreads();
    TSB(p, 45);
#pragma unroll 1
    for (int th = 0; th < RWP_TT; th += 8) {
      float aw[8], aa[8];
#pragma unroll
      for (int i = 0; i < 8; ++i) { aw[i] = 0.f; aa[i] = 0.f; }
#pragma unroll 1
      for (int kh = 0; kh < 4; ++kh) {
        float wr[16], ar[16];
#pragma unroll
        for (int k = 0; k < 16; ++k) { wr[k] = w2[(kh * 16 + k) * 256]; ar[k] = a2[(kh * 16 + k) * 256]; }
#pragma unroll
        for (int k = 0; k < 16; ++k) {
          const float* twk = tw + (d * 64 + kh * 16 + k) * RWP_TT + th;
          const float* tak = ta + (d * 64 + kh * 16 + k) * RWP_TT + th;
#pragma unroll
          for (int i = 0; i < 8; ++i) { aw[i] += twk[i] * wr[k]; aa[i] += tak[i] * ar[k]; }
          if ((k & 3) == 3) sched_fence();
        }
      }
#pragma unroll
      for (int i = 0; i < 8; ++i) {
        const int n = n0 + th + i;
        const float* zr = zs + (th + i) * 1024 + col;
        const float r = zr[0], k = zr[256], v = zr[512];
        const float kr = k * kkw;
        const float ss = wave_sum(kr * kr);
        const float kk = kr * frsq(fmaxf(ss, 1e-24f));
        const float w = -softplusf_(-(w0 + aw[i])) - 0.5f;
        const float logdecay = -fexp(w);
        const float a = sigmoidf_(a0 + aa[i]);
        const float kd = k * (1.f + (a - 1.f) * kaw);
        const float bsum = wave_sum(r * rkw * kd);
        const size_t o = (size_t)n * 256 + col;
        if (d == 0) { rb[0 * AS + o] = f2bf(r); rb[1 * AS + o] = f2bf(v); rb[2 * AS + o] = f2bf(kk); }
        lwo[d * AS + o] = logdecay;
        rb[(3 + 2 * d) * AS + o] = f2bf(kd);
        rb[(4 + 2 * d) * AS + o] = f2bf(kk * a);
        if ((tid & 63) == 0) bso[((size_t)d * NT_ + n) * 4 + (col >> 6)] = bsum;
      }
    }
    TSB(p, 47);
  }
}

DI int seq_tok(int dir, int b, int pos) {
  if (pos < CL_) return NX_ + b * CL_ + (dir ? CL_ - 1 - pos : pos);
  const int t = pos - CL_;
  return b * T_ + (dir ? T_ - 1 - t : t);
}
DI float logsigmoidf_(float x) { return -softplusf_(-x); }
DI float wave_incl_scan(float v, int lane) {
  for (int d = 1; d < 64; d <<= 1) { const float o = __shfl_up(v, d); if (lane >= d) v += o; }
  return v;
}
constexpr int ML_ST = 2112;
constexpr int ML1_ITEMS = NSEQ_ * NCH_;
DI void mlstm_local_item(const Params& p, int l, int it, char* smem) {
  const int s = it / NCH_, c = it % NCH_, dir = s >> 3, b = (s >> 2) & 1, hd = s & 3;
  float* vv = (float*)smem;
  float* kw = vv + 64 * 64;
  float* wej = kw + 64 * 32;
  const float* zrec = (const float*)(p.ws + OFF_REGION + R_ZREC);
  float* st = (float*)(p.ws + OFF_REGION + R_MLST) + ((size_t)s * NCH_ + c) * ML_ST;
  const int tid = opaque_tid(), lane = tid & 63, wid = tid >> 6;
  __syncthreads();
  if (wid == 0) {
    const int n = seq_tok(dir, b, c * 64 + lane);
    const float fp = zrec[(size_t)n * ZREC_W + ZR_MLF + dir * 4 + hd] + p.ml_b_f[(l * 2 + dir) * 4 + hd];
    const float ip = zrec[(size_t)n * ZREC_W + ZR_MLI + dir * 4 + hd] + p.ml_b_i[(l * 2 + dir) * 4 + hd];
    const float bj = wave_incl_scan(logsigmoidf_(fp), lane);
    const float bl = lane_bcast<63>(bj);
    const float lw = bl - bj + ip;
    const float ml = wave_max(lw);
    wej[lane] = fexp(lw - ml);
    if (lane == 0) { st[2080] = bl; st[2081] = ml; }
  }
  for (int idx = tid; idx < 64 * 64; idx += NTHR) {
    const int j = idx >> 6, e = idx & 63;
    const int n = seq_tok(dir, b, c * 64 + j);
    vv[idx] = zrec[(size_t)n * ZREC_W + ZR_MLV + hd * 64 + e];
  }
  __syncthreads();
  for (int idx = tid; idx < 64 * 32; idx += NTHR) {
    const int j = idx >> 5, e = idx & 31;
    const int n = seq_tok(dir, b, c * 64 + j);
    kw[idx] = zrec[(size_t)n * ZREC_W + ZR_MLK + hd * 32 + e] * wej[j];
  }
  __syncthreads();
  const int v = tid & 63, d0 = (tid >> 6) * 4;
  float a0 = 0.f, a1 = 0.f, a2 = 0.f, a3 = 0.f;
  for (int j = 0; j < 64; ++j) {
    const float x = vv[j * 64 + v];
    const float4 kk = *(const float4*)(kw + j * 32 + d0);
    a0 += x * kk.x; a1 += x * kk.y; a2 += x * kk.z; a3 += x * kk.w;
  }
  *(float4*)(st + v * 32 + d0) = make_float4(a0, a1, a2, a3);
  if (tid < 32) { float sn = 0.f; for (int j = 0; j < 64; ++j) sn += kw[j * 32 + tid]; st[2048 + tid] = sn; }
}
constexpr int ML2_ITEMS = (NSEQ_ * 2080 + NTHR - 1) / NTHR;
DI void mlstm_scan_item(const Params& p, int it) {
  const int g = it * NTHR + opaque_tid();
  if (g >= NSEQ_ * 2080) return;
  const int s = g / 2080, e = g % 2080;
  float* st = (float*)(p.ws + OFF_REGION + R_MLST) + (size_t)s * NCH_ * ML_ST;
  float state = 0.f, m = 0.f;
  static_assert(NCH_ % 4 == 0, "chunk count");
  for (int c0 = 0; c0 < NCH_; c0 += 4) {
    float d[4], bl[4], ml[4];
#pragma unroll
    for (int u = 0; u < 4; ++u) { const float* r = st + (size_t)(c0 + u) * ML_ST; d[u] = r[e]; bl[u] = r[2080]; ml[u] = r[2081]; }
#pragma unroll
    for (int u = 0; u < 4; ++u) {
      float* r = st + (size_t)(c0 + u) * ML_ST;
      r[e] = state;
      if (e == 0) r[2082] = m;
      const float mn = fmaxf(bl[u] + m, ml[u]);
      state = fexp(bl[u] + m - mn) * state + fexp(ml[u] - mn) * d[u];
      m = mn;
    }
  }
}

DI void phase3(const Params& p, int l, char* smem) {
  rwkv_prep_items(p, l, smem);
  for (int it = blockIdx.x; it < ML1_ITEMS; it += gridDim.x) { TSB(p, 56); mlstm_local_item(p, l, it, smem); TSB(p, 57); }
}
constexpr int RW_LD = 72, RW_MB = 64 * RW_LD * 2;
constexpr int RWC_REC = 40960;
DI char* rw_rec(const Params& p, int s, int c) { return p.ws + OFF_REGION + R_CH + ((size_t)s * NCH_ + c) * RWC_REC; }
DI f32x16 rw_mm(const char* A, const char* Bt, int mb, int nb, int lane, f32x16 acc) {
  const int r = lane & 31, h = lane >> 5;
#pragma unroll
  for (int ks = 0; ks < 4; ++ks) {
    const bf16x8 a = *(const bf16x8*)(A + ((mb * 32 + r) * RW_LD + ks * 16 + h * 8) * 2);
    const bf16x8 b = *(const bf16x8*)(Bt + ((nb * 32 + r) * RW_LD + ks * 16 + h * 8) * 2);
    acc = mfma32(a, b, acc);
  }
  return acc;
}
DI void rw_wrT(char* Dst, int mb, int nb, int lane, const f32x16& v) {
  const int r = lane & 31, h = lane >> 5;
#pragma unroll
  for (int g = 0; g < 4; ++g) {
    uint2 o; o.x = pack2bf(v[4 * g], v[4 * g + 1]); o.y = pack2bf(v[4 * g + 2], v[4 * g + 3]);
    *(uint2*)(Dst + ((nb * 32 + r) * RW_LD + mb * 32 + 8 * g + 4 * h) * 2) = o;
  }
}
DI void rw_wrT_g(bf16_t* Dst, int mb, int nb, int lane, const f32x16& v) {
  const int r = lane & 31, h = lane >> 5;
#pragma unroll
  for (int g = 0; g < 4; ++g) {
    uint2 o; o.x = pack2bf(v[4 * g], v[4 * g + 1]); o.y = pack2bf(v[4 * g + 2], v[4 * g + 3]);
    *(uint2*)(Dst + (nb * 32 + r) * 64 + mb * 32 + 8 * g + 4 * h) = o;
  }
}
DI void rw_addT(const char* Src, int mb, int nb, int lane, f32x16& v) {
  const int r = lane & 31, h = lane >> 5;
#pragma unroll
  for (int g = 0; g < 4; ++g) {
    const uint2 u = *(const uint2*)(Src + ((nb * 32 + r) * RW_LD + mb * 32 + 8 * g + 4 * h) * 2);
    v[4 * g] += bf2f((bf16_t)(u.x & 0xffff)); v[4 * g + 1] += bf2f((bf16_t)(u.x >> 16));
    v[4 * g + 2] += bf2f((bf16_t)(u.y & 0xffff)); v[4 * g + 3] += bf2f((bf16_t)(u.y >> 16));
  }
}
DI void rw_mask_upper(f32x16& v, int mb, int nb, int lane, bool strict) {
  const int col = nb * 32 + (lane & 31), h = lane >> 5;
#pragma unroll
  for (int i = 0; i < 16; ++i) { const int row = mb * 32 + crow(i, h); if (strict ? !(row < col) : !(row <= col)) v[i] = 0.f; }
}
DI void rw_mask_lower_strict(f32x16& v, int mb, int nb, int lane) {
  const int col = nb * 32 + (lane & 31), h = lane >> 5;
#pragma unroll
  for (int i = 0; i < 16; ++i) { const int row = mb * 32 + crow(i, h); if (!(col < row)) v[i] = 0.f; }
}

constexpr int RW1_ITEMS = NSEQ_ * NCH_;
DI void rw_chunk_item(const Params& p, int it, char* smem) {
  const int s = it / NCH_, c = it % NCH_, dir = s >> 3, b = (s >> 2) & 1, hd = s & 3;
  const int tid = opaque_tid(), lane = tid & 63, wid = tid >> 6;
  const bf16_t* rb = (const bf16_t*)(p.ws + OFF_REGION + R_RB16);
  const float* lwg = (const float*)(p.ws + OFF_REGION + R_LW) + (size_t)dir * NT_ * 256;
  const size_t AS = (size_t)NT_ * 256;
  char* const At = smem + 0 * RW_MB; char* const Bt_ = smem + 1 * RW_MB; char* const Kt = smem + 2 * RW_MB; char* const Rt = smem + 3 * RW_MB;
  char* const Aj = smem + 4 * RW_MB; char* const Bj = smem + 5 * RW_MB; char* const Kj = smem + 6 * RW_MB; char* const Vi = smem + 7 * RW_MB;
  char* const QA = smem + 8 * RW_MB; char* const QTA = smem + 9 * RW_MB; char* const GA = smem + 10 * RW_MB;
  char* const Mka = smem + 11 * RW_MB; char* const MbrT = smem + 12 * RW_MB; char* const MkrT = smem + 13 * RW_MB;
  char* const QB = At; char* const QTB = Bt_; char* const GB = Kt;
  float* const cs = (float*)(smem + 8 * RW_MB);
  float* const gC = (float*)(smem + 14 * RW_MB);
  char* rec = rw_rec(p, s, c);
  __syncthreads();
  const int t = tid >> 3, j8 = (tid & 7) * 8;
  const int n = seq_tok(dir, b, c * 64 + t);
  {
    const float4 l0 = *(const float4*)(lwg + (size_t)n * 256 + hd * 64 + j8), l1 = *(const float4*)(lwg + (size_t)n * 256 + hd * 64 + j8 + 4);
    float* d = cs + t * 65 + j8;
    d[0] = l0.x; d[1] = l0.y; d[2] = l0.z; d[3] = l0.w; d[4] = l1.x; d[5] = l1.y; d[6] = l1.z; d[7] = l1.w;
  }
  __syncthreads();
  if (tid < 64) { float a = 0.f; for (int tt = 0; tt < 64; ++tt) { a += cs[tt * 65 + tid]; cs[tt * 65 + tid] = a; } gC[tid] = fexp(a); }
  __syncthreads();
  {
    const size_t o = (size_t)n * 256 + hd * 64 + j8;
    const uint4 ukk = *(const uint4*)(rb + 2 * AS + o), ubb = *(const uint4*)(rb + (4 + 2 * dir) * AS + o), ukd = *(const uint4*)(rb + (3 + 2 * dir) * AS + o);
    const uint4 ur = *(const uint4*)(rb + 0 * AS + o), uv = *(const uint4*)(rb + 1 * AS + o);
    const unsigned akk[4] = {ukk.x, ukk.y, ukk.z, ukk.w}, abb[4] = {ubb.x, ubb.y, ubb.z, ubb.w}, akd[4] = {ukd.x, ukd.y, ukd.z, ukd.w};
    const unsigned ar[4] = {ur.x, ur.y, ur.z, ur.w}, av[4] = {uv.x, uv.y, uv.z, uv.w};
    unsigned oa[4], ob[4], ok[4], orr[4];
#pragma unroll
    for (int q = 0; q < 4; ++q) {
      float fa[2], fb[2], fk[2], fr[2];
#pragma unroll
      for (int e = 0; e < 2; ++e) {
        const int j = j8 + 2 * q + e;
        const float cst = cs[t * 65 + j], csp = t > 0 ? cs[(t - 1) * 65 + j] : 0.f;
        const float g = fexp(cst), gp = fexp(csp), gi = fexp(-cst);
        const int sh = 16 * e;
        fa[e] = -bf2f((bf16_t)((akk[q] >> sh) & 0xffff)) * gp;
        fb[e] = bf2f((bf16_t)((abb[q] >> sh) & 0xffff)) * gi;
        fk[e] = bf2f((bf16_t)((akd[q] >> sh) & 0xffff)) * gi;
        fr[e] = bf2f((bf16_t)((ar[q] >> sh) & 0xffff)) * g;
        *(bf16_t*)(Aj + (j * RW_LD + t) * 2) = f2bf(fa[e]);
        *(bf16_t*)(Bj + (j * RW_LD + t) * 2) = f2bf(fb[e]);
        *(bf16_t*)(Kj + (j * RW_LD + t) * 2) = f2bf(fk[e]);
        *(bf16_t*)(Vi + (j * RW_LD + t) * 2) = (bf16_t)((av[q] >> sh) & 0xffff);
      }
      oa[q] = pack2bf(fa[0], fa[1]); ob[q] = pack2bf(fb[0], fb[1]); ok[q] = pack2bf(fk[0], fk[1]); orr[q] = pack2bf(fr[0], fr[1]);
    }
    *(uint4*)(At + (t * RW_LD + j8) * 2) = make_uint4(oa[0], oa[1], oa[2], oa[3]);
    *(uint4*)(Bt_ + (t * RW_LD + j8) * 2) = make_uint4(ob[0], ob[1], ob[2], ob[3]);
    *(uint4*)(Kt + (t * RW_LD + j8) * 2) = make_uint4(ok[0], ok[1], ok[2], ok[3]);
    *(uint4*)(Rt + (t * RW_LD + j8) * 2) = make_uint4(orr[0], orr[1], orr[2], orr[3]);
  }
  __syncthreads();
  {
    const int prod = wid >> 2, mb = (wid >> 1) & 1, nb = wid & 1;
    f32x16 acc = zero16();
    if (prod == 0) {
      if (!(mb == 1 && nb == 0)) acc = rw_mm(Bt_, At, mb, nb, lane, acc);
      rw_mask_upper(acc, mb, nb, lane, true);
      rw_wrT(QA, mb, nb, lane, acc);
      if (mb == nb) {
        const int col = nb * 32 + (lane & 31), h = lane >> 5;
#pragma unroll
        for (int i = 0; i < 16; ++i) if (mb * 32 + crow(i, h) == col) acc[i] += 1.f;
      }
      rw_wrT(GA, mb, nb, lane, acc);
    } else {
      if (!(mb == 0 && nb == 1)) acc = rw_mm(At, Bt_, mb, nb, lane, acc);
      rw_mask_lower_strict(acc, mb, nb, lane);
      rw_wrT(QTA, mb, nb, lane, acc);
    }
  }
  for (int blk = wid; blk < 12; blk += 8) {
    const int prod = blk >> 2, mb = (blk >> 1) & 1, nb = blk & 1;
    f32x16 acc = zero16();
    if (prod == 0) {
      acc = rw_mm(At, Kt, mb, nb, lane, acc); rw_mask_lower_strict(acc, mb, nb, lane); rw_wrT(Mka, mb, nb, lane, acc);
    } else if (prod == 1) {
      acc = rw_mm(Bt_, Rt, mb, nb, lane, acc); rw_mask_upper(acc, mb, nb, lane, false); rw_wrT(MbrT, mb, nb, lane, acc);
    } else {
      acc = rw_mm(Kt, Rt, mb, nb, lane, acc); rw_mask_upper(acc, mb, nb, lane, false); rw_wrT(MkrT, mb, nb, lane, acc);
    }
  }
  __syncthreads();
#define RW_SQ(Q_, Qt_, Qn_, Qtn_, blk) { const int pr_ = (blk) >> 2, mb_ = ((blk) >> 1) & 1, nb_ = (blk) & 1; f32x16 acc_ = zero16(); \
    if (pr_ == 0) { acc_ = rw_mm(Q_, Qt_, mb_, nb_, lane, acc_); rw_wrT(Qtn_, mb_, nb_, lane, acc_); } \
    else { acc_ = rw_mm(Qt_, Q_, mb_, nb_, lane, acc_); rw_wrT(Qn_, mb_, nb_, lane, acc_); } }
#define RW_GUP(Qt_, G_, Gn_, blk) { const int mb_ = ((blk) >> 1) & 1, nb_ = (blk) & 1; f32x16 acc_ = zero16(); \
    rw_addT(G_, mb_, nb_, lane, acc_); acc_ = rw_mm(Qt_, G_, mb_, nb_, lane, acc_); rw_wrT(Gn_, mb_, nb_, lane, acc_); }
  RW_SQ(QA, QTA, QB, QTB, wid);
  __syncthreads();
  for (int blk = wid; blk < 12; blk += 8) { if (blk < 8) { RW_SQ(QB, QTB, QA, QTA, blk); } else { RW_GUP(QTB, GA, GB, blk - 8); } }
  __syncthreads();
  for (int blk = wid; blk < 12; blk += 8) { if (blk < 8) { RW_SQ(QA, QTA, QB, QTB, blk); } else { RW_GUP(QTA, GB, GA, blk - 8); } }
  __syncthreads();
  for (int blk = wid; blk < 12; blk += 8) { if (blk < 8) { RW_SQ(QB, QTB, QA, QTA, blk); } else { RW_GUP(QTB, GA, GB, blk - 8); } }
  __syncthreads();
  for (int blk = wid; blk < 12; blk += 8) { if (blk < 8) { RW_SQ(QA, QTA, QB, QTB, blk); } else { RW_GUP(QTA, GB, GA, blk - 8); } }
  __syncthreads();
  if (wid < 4) { RW_GUP(QTB, GA, GB, wid); }
  __syncthreads();
  {
    const int prod = wid >> 2, mb = (wid >> 1) & 1, nb = wid & 1;
    f32x16 acc = zero16();
    acc = rw_mm(GB, prod == 0 ? Mka : Aj, mb, nb, lane, acc);
    rw_wrT(prod == 0 ? QA : QTA, mb, nb, lane, acc);
  }
  __syncthreads();
  char* const X1 = QA; char* const X2 = QTA; char* const QpT = At;
  for (int blk = wid; blk < 16; blk += 8) {
    const int prod = blk >> 2, mb = (blk >> 1) & 1, nb = blk & 1;
    f32x16 acc = zero16();
    if (prod == 0) {
      rw_addT(MkrT, mb, nb, lane, acc); acc = rw_mm(X1, MbrT, mb, nb, lane, acc); rw_mask_upper(acc, mb, nb, lane, false);
      rw_wrT_g((bf16_t*)(rec + 8192), mb, nb, lane, acc);
    } else if (prod == 1) {
      rw_addT(Rt, mb, nb, lane, acc); acc = rw_mm(X2, MbrT, mb, nb, lane, acc);
      rw_wrT_g((bf16_t*)(rec), mb, nb, lane, acc);
    } else if (prod == 2) {
      acc = rw_mm(X2, Bj, mb, nb, lane, acc);
      const int col = nb * 32 + (lane & 31), h = lane >> 5; const float gc = gC[col];
#pragma unroll
      for (int i = 0; i < 16; ++i) { if (mb * 32 + crow(i, h) == col) acc[i] += 1.f; acc[i] *= gc; }
      rw_wrT_g((bf16_t*)(rec + 16384), mb, nb, lane, acc);
    } else {
      rw_addT(Kj, mb, nb, lane, acc); acc = rw_mm(X1, Bj, mb, nb, lane, acc);
      const float gc = gC[nb * 32 + (lane & 31)];
#pragma unroll
      for (int i = 0; i < 16; ++i) acc[i] *= gc;
      rw_wrT(QpT, mb, nb, lane, acc);
    }
  }
  __syncthreads();
  if (wid < 4) {
    const int mb = (wid >> 1) & 1, nb = wid & 1, r = lane & 31, h = lane >> 5;
    f32x16 acc = zero16();
    acc = rw_mm(QpT, Vi, mb, nb, lane, acc);
    float* dq = (float*)(rec + 24576);
#pragma unroll
    for (int g = 0; g < 4; ++g)
      *(float4*)(dq + (nb * 32 + r) * 64 + mb * 32 + 8 * g + 4 * h) = make_float4(acc[4 * g], acc[4 * g + 1], acc[4 * g + 2], acc[4 * g + 3]);
  }
}

constexpr int RW2_ITEMS = NSEQ_;
constexpr int RW2_DQLD = 68;
constexpr int RW2_STAGE = RW_MB + 64 * RW2_DQLD * 4;
constexpr int RW2_GRP = 2;
static_assert(NCH_ % RW2_GRP == 0, "chunk groups");
DI void rw_state_item(const Params& p, int s, char* smem) {
  const int tid = opaque_tid(), lane = tid & 63, wid = tid >> 6, r = lane & 31, h = lane >> 5;
  f32x16 S0 = zero16(), S1 = zero16();
  u32x4 rp[RW2_GRP], rd0[RW2_GRP], rd1[RW2_GRP];
  const int prow = tid >> 3, pcol = (tid & 7) * 8;
#define RW2_LOAD(g_) { _Pragma("unroll") for (int u = 0; u < RW2_GRP; ++u) { const char* rec_ = rw_rec(p, s, (g_) * RW2_GRP + u); \
    rp[u] = *(const u32x4*)(rec_ + 16384 + (prow * 64 + pcol) * 2); \
    rd0[u] = *(const u32x4*)(rec_ + 24576 + (prow * 64 + pcol) * 4); rd1[u] = *(const u32x4*)(rec_ + 24576 + (prow * 64 + pcol + 4) * 4); } }
#define RW2_STORE(buf_) { _Pragma("unroll") for (int u = 0; u < RW2_GRP; ++u) { char* d_ = smem + ((buf_) * RW2_GRP + u) * RW2_STAGE; \
    *(u32x4*)(d_ + (prow * RW_LD + pcol) * 2) = rp[u]; \
    *(u32x4*)(d_ + RW_MB + (prow * RW2_DQLD + pcol) * 4) = rd0[u]; *(u32x4*)(d_ + RW_MB + (prow * RW2_DQLD + pcol + 4) * 4) = rd1[u]; } }
  __syncthreads();
  RW2_LOAD(0); RW2_STORE(0);
  __syncthreads();
  constexpr int NG = NCH_ / RW2_GRP;
  for (int g = 0; g < NG; ++g) {
    { const int gn = g + 1 < NG ? g + 1 : g; RW2_LOAD(gn); }
    sched_fence();
    if (wid < 2) {
#pragma unroll
      for (int u = 0; u < RW2_GRP; ++u) {
        const int c = g * RW2_GRP + u;
        const char* PT = smem + ((g & 1) * RW2_GRP + u) * RW2_STAGE;
        const float* DQ = (const float*)(PT + RW_MB);
        const int i = wid * 32 + r;
        bf16_t* sd = (bf16_t*)(rw_rec(p, s, c) + 16384);
#pragma unroll
        for (int q = 0; q < 4; ++q) {
          uint2 o0, o1;
          o0.x = pack2bf(S0[4 * q], S0[4 * q + 1]); o0.y = pack2bf(S0[4 * q + 2], S0[4 * q + 3]);
          o1.x = pack2bf(S1[4 * q], S1[4 * q + 1]); o1.y = pack2bf(S1[4 * q + 2], S1[4 * q + 3]);
          *(uint2*)(sd + i * 64 + 8 * q + 4 * h) = o0; *(uint2*)(sd + i * 64 + 32 + 8 * q + 4 * h) = o1;
        }
        bf16x8 bfr[2][2];
#pragma unroll
        for (int s2 = 0; s2 < 2; ++s2) {
          const u32x4 u0 = {pack2bf(S0[8 * s2], S0[8 * s2 + 1]), pack2bf(S0[8 * s2 + 2], S0[8 * s2 + 3]), pack2bf(S0[8 * s2 + 4], S0[8 * s2 + 5]), pack2bf(S0[8 * s2 + 6], S0[8 * s2 + 7])};
          const u32x4 u1 = {pack2bf(S1[8 * s2], S1[8 * s2 + 1]), pack2bf(S1[8 * s2 + 2], S1[8 * s2 + 3]), pack2bf(S1[8 * s2 + 4], S1[8 * s2 + 5]), pack2bf(S1[8 * s2 + 6], S1[8 * s2 + 7])};
          __builtin_memcpy(&bfr[0][s2], &u0, 16); __builtin_memcpy(&bfr[1][s2], &u1, 16);
        }
        f32x16 n0, n1;
#pragma unroll
        for (int q = 0; q < 4; ++q) {
          const float4 a = *(const float4*)(DQ + i * RW2_DQLD + 8 * q + 4 * h), bq = *(const float4*)(DQ + i * RW2_DQLD + 32 + 8 * q + 4 * h);
          n0[4 * q] = a.x; n0[4 * q + 1] = a.y; n0[4 * q + 2] = a.z; n0[4 * q + 3] = a.w;
          n1[4 * q] = bq.x; n1[4 * q + 1] = bq.y; n1[4 * q + 2] = bq.z; n1[4 * q + 3] = bq.w;
        }
#pragma unroll
        for (int jb2 = 0; jb2 < 2; ++jb2)
#pragma unroll
          for (int s2 = 0; s2 < 2; ++s2) {
            const char* a0 = PT + ((0 * 32 + r) * RW_LD + jb2 * 32 + 16 * s2 + 4 * h) * 2;
            const char* a1 = PT + ((1 * 32 + r) * RW_LD + jb2 * 32 + 16 * s2 + 4 * h) * 2;
            const uint2 l0 = *(const uint2*)a0, h0 = *(const uint2*)(a0 + 16), l1 = *(const uint2*)a1, h1 = *(const uint2*)(a1 + 16);
            const u32x4 u0 = {l0.x, l0.y, h0.x, h0.y}, u1 = {l1.x, l1.y, h1.x, h1.y};
            bf16x8 af0, af1; __builtin_memcpy(&af0, &u0, 16); __builtin_memcpy(&af1, &u1, 16);
            n0 = mfma32(af0, bfr[jb2][s2], n0);
            n1 = mfma32(af1, bfr[jb2][s2], n1);
          }
        S0 = n0; S1 = n1;
      }
    }
    sched_fence();
    RW2_STORE((g + 1) & 1);
    __syncthreads();
  }
}

DI void rw_out_item(const Params& p, int it, char* smem) {
  const int s = it / NCH_, c = it % NCH_, dir = s >> 3, b = (s >> 2) & 1, hd = s & 3;
  const int tid = opaque_tid(), lane = tid & 63, wid = tid >> 6;
  const bf16_t* rb = (const bf16_t*)(p.ws + OFF_REGION + R_RB16);
  const size_t AS = (size_t)NT_ * 256;
  float* ys = (float*)(p.ws + OFF_REGION + R_YS) + (size_t)dir * NT_ * 256;
  char* const Sm = smem; char* const RyT = smem + RW_MB; char* const MyT = smem + 2 * RW_MB; char* const Vi = smem + 3 * RW_MB;
  const char* rec = rw_rec(p, s, c);
  __syncthreads();
  {
    const int row = tid >> 3, col = (tid & 7) * 8;
    *(uint4*)(Sm + (row * RW_LD + col) * 2) = *(const uint4*)(rec + 16384 + (row * 64 + col) * 2);
    *(uint4*)(RyT + (row * RW_LD + col) * 2) = *(const uint4*)(rec + (row * 64 + col) * 2);
    *(uint4*)(MyT + (row * RW_LD + col) * 2) = *(const uint4*)(rec + 8192 + (row * 64 + col) * 2);
    const int n = seq_tok(dir, b, c * 64 + row);
    const uint4 uv = *(const uint4*)(rb + 1 * AS + (size_t)n * 256 + hd * 64 + col);
    const unsigned av[4] = {uv.x, uv.y, uv.z, uv.w};
#pragma unroll
    for (int q = 0; q < 4; ++q) {
      *(bf16_t*)(Vi + ((col + 2 * q) * RW_LD + row) * 2) = (bf16_t)(av[q] & 0xffff);
      *(bf16_t*)(Vi + ((col + 2 * q + 1) * RW_LD + row) * 2) = (bf16_t)(av[q] >> 16);
    }
  }
  __syncthreads();
  if (wid < 4) {
    const int mb = (wid >> 1) & 1, nb = wid & 1, r = lane & 31, h = lane >> 5;
    f32x16 acc = zero16();
    acc = rw_mm(Sm, RyT, mb, nb, lane, acc);
    acc = rw_mm(Vi, MyT, mb, nb, lane, acc);
    const int n = seq_tok(dir, b, c * 64 + nb * 32 + r);
#pragma unroll
    for (int g = 0; g < 4; ++g)
      *(float4*)(ys + (size_t)n * 256 + hd * 64 + mb * 32 + 8 * g + 4 * h) = make_float4(acc[4 * g], acc[4 * g + 1], acc[4 * g + 2], acc[4 * g + 3]);
  }
}
constexpr int ATT_KLD = 104, ATT_VLD = 68;
constexpr int ATT_KB = 64 * ATT_KLD * 2, ATT_VB = 64 * ATT_VLD * 2, ATT_STAGE = ATT_KB + ATT_VB;
DI float fexp2(float x) {
#ifdef EMU
  return exp2f(x);
#else
  return __builtin_amdgcn_exp2f(x);
#endif
}
#ifdef ABL_NOPV
#define ABL_PV_BEGIN if (t > 100000) {
#define ABL_PV_END }
#else
#define ABL_PV_BEGIN
#define ABL_PV_END
#endif
#ifdef ABL_NOLOAD
#define ABL_LOADS(tk, tv)
#else
#define ABL_LOADS(tk, tv) ATT_LOADK(tk); ATT_LOADV(tv);
#endif
#ifdef ABL_NOEXP
#define ABL_EXP(x) (x)
#else
#define ABL_EXP(x) fexp2(x)
#endif
constexpr int ATT_LDS = 2 * ATT_KB + 2 * ATT_VB;
DI void attn_item(const Params& p, int b, int h, int qt, bool isctx, char* smem) {
  const int tid = opaque_tid(), lane = tid & 63, wid = tid >> 6, r = lane & 31, h2 = lane >> 5;
  const bf16_t* qb = (const bf16_t*)(p.osc + O_QB);
  const bf16_t* kbase = (const bf16_t*)(p.ws + OFF_REGION + R_KB) + (size_t)(b * 8 + h) * KT_ * 96;
  const bf16_t* vbase = (const bf16_t*)(p.ws + OFF_REGION + R_VT) + (size_t)(b * 8 + h) * 64 * KT_;
  bf16_t* att = (bf16_t*)(p.ws + OFF_REGION + R_ATT);
  const int nq0 = isctx ? NX_ + b * CL_ + qt * 256 : b * T_ + qt * 256;
  const int nkt = (isctx ? CL_ : KT_) / 64;
  const int nq = nq0 + wid * 32 + r;
  bf16x8 qf[6];
#pragma unroll
  for (int ks = 0; ks < 6; ++ks) qf[ks] = *(const bf16x8*)(qb + (size_t)nq * 768 + h * 96 + ks * 16 + h2 * 8);
  f32x16 oacc[2] = {zero16(), zero16()};
  float m = -1e30f, lsum = 0.f;
  const float sc = 0.10206207261596577f * 1.4426950408889634f;
  char* const Kst = smem;
  char* const Vst = smem + 2 * ATT_KB;
  const int kc1 = tid + 512, vd = tid >> 3, vc = tid & 7;
  const int ko0 = ((tid / 12) * ATT_KLD + (tid % 12) * 8) * 2, ko1 = ((kc1 / 12) * ATT_KLD + (kc1 % 12) * 8) * 2;
  const int vo = (vd * ATT_VLD + vc * 8) * 2;
  u32x4 rk0, rk1 = {0u, 0u, 0u, 0u}, rv;
#define ATT_LOADK(kt_) { const bf16_t* ksrc_ = kbase + (size_t)(kt_) * 64 * 96; rk0 = *(const u32x4*)(ksrc_ + tid * 8); if (kc1 < 768) rk1 = *(const u32x4*)(ksrc_ + kc1 * 8); }
#define ATT_LOADV(kt_) { rv = *(const u32x4*)(vbase + (size_t)vd * KT_ + (kt_) * 64 + vc * 8); }
#define ATT_STOREK(st_) { char* d_ = Kst + (st_) * ATT_KB; *(u32x4*)(d_ + ko0) = rk0; if (kc1 < 768) *(u32x4*)(d_ + ko1) = rk1; }
#define ATT_STOREV(st_) { char* d_ = Vst + (st_) * ATT_VB; *(uint2*)(d_ + vo) = make_uint2(rv[0], rv[1]); *(uint2*)(d_ + vo + 8) = make_uint2(rv[2], rv[3]); }
#define ATT_QK(dst_, st_) { const char* Ks_ = Kst + (st_) * ATT_KB; dst_[0] = zero16(); dst_[1] = zero16(); \
    _Pragma("unroll") for (int ks = 0; ks < 6; ++ks) _Pragma("unroll") for (int kb = 0; kb < 2; ++kb) { \
      const bf16x8 kf_ = *(const bf16x8*)(Ks_ + ((kb * 32 + r) * ATT_KLD + ks * 16 + h2 * 8) * 2); dst_[kb] = mfma32(kf_, qf[ks], dst_[kb]); } }
  __syncthreads();
  ATT_LOADK(0); ATT_LOADV(0); ATT_STOREK(0); ATT_STOREV(0);
  ATT_LOADK(1); ATT_STOREK(1);
  __syncthreads();
  f32x16 sA[2], sB[2];
  ATT_QK(sA, 0);
#define ATT_SMPV(cur_, t) { \
    float mx = -1e30f; \
    _Pragma("unroll") for (int kb = 0; kb < 2; ++kb) _Pragma("unroll") for (int i = 0; i < 16; ++i) mx = fmaxf(mx, cur_[kb][i]); \
    mx = fmaxf(mx, __shfl_xor(mx, 32)); \
    const float mn = fmaxf(m, mx * sc); \
    if (__ballot(mn > m) != 0ull) { \
      const float alpha = fexp2(m - mn); \
      _Pragma("unroll") for (int db = 0; db < 2; ++db) _Pragma("unroll") for (int i = 0; i < 16; ++i) oacc[db][i] *= alpha; \
      lsum *= alpha; m = mn; } \
    _Pragma("unroll") for (int kb = 0; kb < 2; ++kb) _Pragma("unroll") for (int i = 0; i < 16; ++i) cur_[kb][i] = ABL_EXP(cur_[kb][i] * sc - m); \
    { float ps0 = 0.f, ps1 = 0.f; _Pragma("unroll") for (int i = 0; i < 16; ++i) { ps0 += cur_[0][i]; ps1 += cur_[1][i]; } lsum += ps0 + ps1; } \
    const char* Vs = Vst + ((t) & 1) * ATT_VB; \
    _Pragma("unroll") for (int kb = 0; kb < 2; ++kb) _Pragma("unroll") for (int s2 = 0; s2 < 2; ++s2) { \
      bf16x8 pf; { const u32x4 u = {pack2bf(cur_[kb][8 * s2 + 0], cur_[kb][8 * s2 + 1]), pack2bf(cur_[kb][8 * s2 + 2], cur_[kb][8 * s2 + 3]), \
                                    pack2bf(cur_[kb][8 * s2 + 4], cur_[kb][8 * s2 + 5]), pack2bf(cur_[kb][8 * s2 + 6], cur_[kb][8 * s2 + 7])}; __builtin_memcpy(&pf, &u, 16); } \
      ABL_PV_BEGIN \
      _Pragma("unroll") for (int db = 0; db < 2; ++db) { \
        const char* vrow = Vs + ((db * 32 + r) * ATT_VLD + kb * 32 + 16 * s2 + 4 * h2) * 2; \
        const uint2 lo = *(const uint2*)(vrow), hi = *(const uint2*)(vrow + 16); \
        const u32x4 u = {lo.x, lo.y, hi.x, hi.y}; bf16x8 vf; __builtin_memcpy(&vf, &u, 16); \
        oacc[db] = mfma32(vf, pf, oacc[db]); } ABL_PV_END } }
#define ATT_STEP(cur_, nxt_, t_) { \
    const int t = (t_); \
    const int tk = t + 2 < nkt ? t + 2 : nkt - 1, tv = t + 1 < nkt ? t + 1 : nkt - 1; \
    ABL_LOADS(tk, tv) \
    sched_fence(); \
    if (first_half) { ATT_QK(nxt_, (t + 1) & 1); sched_fence(); ATT_SMPV(cur_, t); } \
    else { ATT_SMPV(cur_, t); sched_fence(); ATT_QK(nxt_, (t + 1) & 1); } \
    sched_fence(); \
    ATT_STOREK(t & 1); ATT_STOREV((t + 1) & 1); \
    __syncthreads(); }
  const bool first_half = rfl(wid) < 4;
  for (int t0 = 0; t0 < nkt; t0 += 2) {
    ATT_STEP(sA, sB, t0);
    ATT_STEP(sB, sA, t0 + 1);
  }
  lsum += __shfl_xor(lsum, 32);
  const float inv = 1.f / lsum;
#pragma unroll
  for (int db = 0; db < 2; ++db)
#pragma unroll
    for (int g = 0; g < 4; ++g) {
      uint2 o;
      o.x = pack2bf(oacc[db][g * 4 + 0] * inv, oacc[db][g * 4 + 1] * inv);
      o.y = pack2bf(oacc[db][g * 4 + 2] * inv, oacc[db][g * 4 + 3] * inv);
      *(uint2*)(att + (size_t)nq * 512 + h * 64 + db * 32 + 8 * g + 4 * h2) = o;
    }
}

constexpr int P3B_ITEMS = RW1_ITEMS + ML2_ITEMS + MLA_Q_TILES + MLA_KV_TILES;
DI void phase3b(const Params& p, int l, char* smem) {
  for (int it = vblock(); it < P3B_ITEMS; it += gridDim.x) {
    int i = it;
    if (i < RW1_ITEMS) { TSB(p, 58); rw_chunk_item(p, i, smem); TSB(p, 59); continue; }
    i -= RW1_ITEMS;
    if (i < ML2_ITEMS) { mlstm_scan_item(p, i); continue; }
    i -= ML2_ITEMS;
    TSB(p, 60);
    if (i < MLA_Q_TILES) mla_q_item(p, l, i, smem); else mla_kv_item(p, l, i - MLA_Q_TILES, smem);
    TSB(p, 61);
  }
}

DI constexpr int att_items(int l) { return NB_ * 8 * (T_ / 256) + (l == 0 ? NB_ * 8 * (CL_ / 256) : 0); }
DI void spin_until_ge(int* ctr, int target) {
#ifdef EMU
  while (__atomic_load_n(ctr, __ATOMIC_SEQ_CST) < target) emu::yield();
#else
  while (__hip_atomic_load(ctr, __ATOMIC_RELAXED, __HIP_MEMORY_SCOPE_AGENT) < target) __builtin_amdgcn_s_sleep(8);
#endif
}
DI void phase4(const Params& p, int l, char* smem, int* ctr) {
  const int G = gridDim.x, nsb = G >= 2 * RW2_ITEMS ? RW2_ITEMS : (G > 1 ? G / 2 : 1);
  TSB(p, 50);
  if ((int)blockIdx.x < nsb) {
    for (int s = blockIdx.x; s < RW2_ITEMS; s += nsb) rw_state_item(p, s, smem);
#ifndef EMU
    asm volatile("s_waitcnt vmcnt(0)" ::: "memory");
#endif
    __syncthreads();
    if (opaque_tid() == 0) { __threadfence(); atomicAdd(ctr + 2, (RW2_ITEMS - (int)blockIdx.x + nsb - 1) / nsb); }
    TSB(p, 51);
  }
  const int QT = T_ / 256, CQ = (l == 0 ? (NB_ * 8 * (CL_ / 256)) / 8 : 0), R3 = RW1_ITEMS / 8;
  const int per = 2 * QT + CQ + R3;
  int* sitem = (int*)(smem + 160 * 1024 - 16);
  bool r2ok = false;
  const int x0 = xcc_id();
  for (;;) {
    __syncthreads();
    if (opaque_tid() == 0) {
      int item = -1;
      for (int k = 0; k < 8 && item < 0; ++k) {
        const int x = (x0 + k) & 7;
        if (ld_relaxed(ctr + 8 + x) >= per) continue;
        const int li = atomicAdd(ctr + 8 + x, 1);
        if (li < per) item = x * per + li;
      }
      *sitem = item;
    }
    __syncthreads();
    const int item = *sitem;
    if (item < 0) break;
    const int x = item / per; int li = item % per;
    if (li < 2 * QT) { const int bh = 2 * x + li / QT, qt = li % QT; TSB(p, 54); attn_item(p, bh >> 3, bh & 7, qt, false, smem); TSB(p, 55); continue; }
    li -= 2 * QT;
    if (li < CQ) { const int ci = x * CQ + li, qt = ci % (CL_ / 256), bh = ci / (CL_ / 256); attn_item(p, bh >> 3, bh & 7, qt, true, smem); continue; }
    li -= CQ;
    if (!r2ok) {
      if (opaque_tid() == 0) { spin_until_ge(ctr + 2, RW2_ITEMS); __threadfence(); }
      __syncthreads();
      r2ok = true;
      TSB(p, 52);
    }
    rw_out_item(p, x * R3 + li, smem);
  }
  TSB(p, 53);
}
constexpr int ML3_CC = CL_ / 64, ML3_XC = T_ / 64;
DI constexpr int ml3_items(bool with_ctx) { return NB_ * 4 * (ML3_XC + (with_ctx ? ML3_CC : 0)); }
template <int KS> DI f32x16 ml_mm(const char* A, const char* Bt, int mb, int nb, int lane, f32x16 acc) {
  const int r = lane & 31, h = lane >> 5;
#pragma unroll
  for (int ks = 0; ks < KS; ++ks) {
    const bf16x8 a = *(const bf16x8*)(A + ((mb * 32 + r) * RW_LD + ks * 16 + h * 8) * 2);
    const bf16x8 b = *(const bf16x8*)(Bt + ((nb * 32 + r) * RW_LD + ks * 16 + h * 8) * 2);
    acc = mfma32(a, b, acc);
  }
  return acc;
}
DI float wave_incl_scan_max(float v, int lane) {
  for (int d = 1; d < 64; d <<= 1) { const float o = __shfl_up(v, d); if (lane >= d) v = fmaxf(v, o); }
  return v;
}
DI void mlstm_out_item(const Params& p, int l, int it, bool with_ctx, char* smem) {
  const int per = ML3_XC + (with_ctx ? ML3_CC : 0);
  const int bh = it / per, b = bh >> 2, hd = bh & 3;
  int tc = it % per; if (!with_ctx) tc += ML3_CC;
  const bool isctx = tc < ML3_CC;
  const int ntok0 = isctx ? NX_ + b * CL_ + tc * 64 : b * T_ + (tc - ML3_CC) * 64;
  char* const Qm = smem;
  char* const Km = smem + 1 * RW_MB;
  char* const Qp = smem + 2 * RW_MB;
  char* const Vi = smem + 3 * RW_MB;
  char* const Pp = smem + 4 * RW_MB;
  char* const Cm = smem + 5 * RW_MB;
  float* const hs = (float*)(smem + 6 * RW_MB);
  float* const ga = hs + 64 * 64;
  float* const denp = ga + 5 * 64;
  float* const nsv = denp + 128;
  const float* zrec = (const float*)(p.ws + OFF_REGION + R_ZREC);
  const int tid = opaque_tid(), lane = tid & 63, wid = tid >> 6;
  __syncthreads();
  for (int idx = tid; idx < 64 * 64; idx += NTHR) hs[idx] = 0.f;
#pragma unroll 1
  for (int dir = 0; dir < 2; ++dir) {
    const int c = dir == 0 ? tc : (isctx ? ML3_CC - 1 - tc : ML3_CC + (ML3_XC - 1 - (tc - ML3_CC)));
    const int s = dir * 8 + b * 4 + hd;
    const float* st = (const float*)(p.ws + OFF_REGION + R_MLST) + ((size_t)s * NCH_ + c) * ML_ST;
    const float m_start = st[2082];
    __syncthreads();
    {
      const int j = tid >> 3, pt = tid & 7;
      const int n = ntok0 + (dir ? 63 - j : j);
      const float* zr = zrec + (size_t)n * ZREC_W;
      const float4 q4 = *(const float4*)(zr + ZR_MLQ + hd * 32 + pt * 4), k4 = *(const float4*)(zr + ZR_MLK + hd * 32 + pt * 4);
      const float4 c4 = *(const float4*)(st + j * 32 + pt * 4);
      const float4 va = *(const float4*)(zr + ZR_MLV + hd * 64 + pt * 8), vb = *(const float4*)(zr + ZR_MLV + hd * 64 + pt * 8 + 4);
      const float qs = 0.17677669529663687f;
      const float q0 = q4.x * qs, q1 = q4.y * qs, q2 = q4.z * qs, q3 = q4.w * qs;
      *(uint2*)(Qm + (j * RW_LD + pt * 4) * 2) = make_uint2(pack2bf(q0, q1), pack2bf(q2, q3));
      *(uint2*)(Km + (j * RW_LD + pt * 4) * 2) = make_uint2(pack2bf(k4.x, k4.y), pack2bf(k4.z, k4.w));
      *(uint2*)(Cm + (j * RW_LD + pt * 4) * 2) = make_uint2(pack2bf(c4.x, c4.y), pack2bf(c4.z, c4.w));
      const float vv[8] = {va.x, va.y, va.z, va.w, vb.x, vb.y, vb.z, vb.w};
#pragma unroll
      for (int u = 0; u < 8; ++u) *(bf16_t*)(Vi + ((pt * 8 + u) * RW_LD + j) * 2) = f2bf(vv[u]);
      if (tid < 32) nsv[tid] = st[2048 + tid];
      const float4 n4 = *(const float4*)(st + 2048 + pt * 4);
      float nq = n4.x * q0 + n4.y * q1 + n4.z * q2 + n4.w * q3;
      nq += __shfl_xor(nq, 1); nq += __shfl_xor(nq, 2); nq += __shfl_xor(nq, 4);
      if (pt == 0) ga[4 * 64 + j] = nq;
    }
    if (wid == 0) {
      const int n = ntok0 + (dir ? 63 - lane : lane);
      const float fp = zrec[(size_t)n * ZREC_W + ZR_MLF + dir * 4 + hd] + p.ml_b_f[(l * 2 + dir) * 4 + hd];
      const float ipre = zrec[(size_t)n * ZREC_W + ZR_MLI + dir * 4 + hd] + p.ml_b_i[(l * 2 + dir) * 4 + hd];
      const float bj = wave_incl_scan(logsigmoidf_(fp), lane);
      const float g = ipre - bj;
      const float pm = wave_incl_scan_max(g, lane);
      const float c0 = wave_max(g);
      const float mj = fmaxf(bj + m_start, bj + pm);
      ga[0 * 64 + lane] = fexp(g - c0);
      ga[1 * 64 + lane] = fexp(fminf(bj + c0 - mj, 80.f));
      ga[2 * 64 + lane] = fexp(bj + m_start - mj);
      ga[3 * 64 + lane] = fexp(fminf(-mj, 80.f));
    }
    __syncthreads();
    if (wid < 4) {
      const int mb = wid >> 1, nb = wid & 1, r = lane & 31, h = lane >> 5;
      f32x16 acc = zero16();
      if (!(mb == 1 && nb == 0)) acc = ml_mm<2>(Km, Qm, mb, nb, lane, acc);
      rw_mask_upper(acc, mb, nb, lane, false);
      const float al = ga[1 * 64 + nb * 32 + r];
      float csum = 0.f;
#pragma unroll
      for (int i = 0; i < 16; ++i) { acc[i] *= ga[0 * 64 + mb * 32 + crow(i, h)] * al; csum += acc[i]; }
      csum += __shfl_xor(csum, 32);
      if (h == 0) denp[mb * 64 + nb * 32 + r] = csum;
      rw_wrT(Pp, mb, nb, lane, acc);
    } else {
      const int t2 = tid - 256, j = t2 >> 2, d8 = (t2 & 3) * 8;
      const float in = ga[2 * 64 + j];
      const uint4 u = *(const uint4*)(Qm + (j * RW_LD + d8) * 2);
      const unsigned w[4] = {u.x, u.y, u.z, u.w};
      unsigned o[4];
#pragma unroll
      for (int q = 0; q < 4; ++q) o[q] = pack2bf(bf2f((bf16_t)(w[q] & 0xffff)) * in, bf2f((bf16_t)(w[q] >> 16)) * in);
      *(uint4*)(Qp + (j * RW_LD + d8) * 2) = make_uint4(o[0], o[1], o[2], o[3]);
    }
    __syncthreads();
    if (wid < 4) {
      const int mb = wid >> 1, nb = wid & 1, r = lane & 31, h = lane >> 5;
      f32x16 acc = zero16();
      acc = ml_mm<4>(Vi, Pp, mb, nb, lane, acc);
      acc = ml_mm<2>(Cm, Qp, mb, nb, lane, acc);
      const int j = nb * 32 + r;
      const float den = denp[j] + denp[64 + j] + ga[2 * 64 + j] * ga[4 * 64 + j];
      const float rden = frcp(fmaxf(fabsf(den), ga[3 * 64 + j]));
      float* hrow = hs + (dir ? 63 - j : j) * 64 + mb * 32 + 4 * h;
#pragma unroll
      for (int g4 = 0; g4 < 4; ++g4) {
        float4 o = *(float4*)(hrow + 8 * g4);
        o.x += acc[4 * g4] * rden; o.y += acc[4 * g4 + 1] * rden; o.z += acc[4 * g4 + 2] * rden; o.w += acc[4 * g4 + 3] * rden;
        *(float4*)(hrow + 8 * g4) = o;
      }
    }
  }
  __syncthreads();
  const int tk = tid >> 3, v0 = (tid & 7) * 8, n = ntok0 + tk;
  float ss = 0.f; float hv[8];
#pragma unroll
  for (int u = 0; u < 8; ++u) { hv[u] = hs[tk * 64 + v0 + u]; ss += hv[u] * hv[u]; }
  ss += __shfl_xor(ss, 1); ss += __shfl_xor(ss, 2); ss += __shfl_xor(ss, 4);
  const float rs = frsq(ss * (1.f / 64.f) + 1e-6f);
  unsigned o[4];
#pragma unroll
  for (int u = 0; u < 8; u += 2) {
    const int cc = hd * 64 + v0 + u;
    const float a = hv[u] * rs * p.ml_g_norm[l * 256 + cc] * sigmoidf_(zrec[(size_t)n * ZREC_W + ZR_MLO + cc]);
    const float bq = hv[u + 1] * rs * p.ml_g_norm[l * 256 + cc + 1] * sigmoidf_(zrec[(size_t)n * ZREC_W + ZR_MLO + cc + 1]);
    o[u >> 1] = pack2bf(a, bq);
  }
  bf16_t* mlo = (bf16_t*)(p.ws + OFF_REGION + R_MLO);
  *(uint4*)(mlo + (size_t)n * 256 + hd * 64 + v0) = make_uint4(o[0], o[1], o[2], o[3]);
}

DI constexpr int rwo_items(bool with_ctx) { return (with_ctx ? NT_ : NX_) / 16; }
DI void rwkv_out_item(const Params& p, int l, int it, char* smem) {
  float* sg = (float*)smem;
  const float* zrec = (const float*)(p.ws + OFF_REGION + R_ZREC);
  const bf16_t* rb = (const bf16_t*)(p.ws + OFF_REGION + R_RB16);
  const float* bso = (const float*)(p.ws + OFF_REGION + R_BS);
  const float* ys = (const float*)(p.ws + OFF_REGION + R_YS);
  bf16_t* rwo = (bf16_t*)(p.ws + OFF_REGION + R_RWO);
  const float* mu = p.rw_mu + (size_t)l * 1152;
  const int tid = opaque_tid(), n0 = it * 16;
  __syncthreads();
  {
    const int tt = tid >> 5, k4 = (tid & 31) * 4, n = n0 + tt, t = tok_t(n), c = 1024 + k4;
    const int len = n < NX_ ? T_ : CL_;
    const float* zr = zrec + (size_t)n * ZREC_W + ZR_RW + c;
    const float4 z = *(const float4*)zr;
    const float4 zp = t > 0 ? *(const float4*)(zr - ZREC_W) : make_float4(0.f, 0.f, 0.f, 0.f);
    const float4 zn = t < len - 1 ? *(const float4*)(zr + ZREC_W) : make_float4(0.f, 0.f, 0.f, 0.f);
    const float4 m4 = *(const float4*)(mu + c);
    sg[(k4 + 0) * 16 + tt] = sigmoidf_(z.x + (0.5f * (zp.x + zn.x) - z.x) * m4.x);
    sg[(k4 + 1) * 16 + tt] = sigmoidf_(z.y + (0.5f * (zp.y + zn.y) - z.y) * m4.y);
    sg[(k4 + 2) * 16 + tt] = sigmoidf_(z.z + (0.5f * (zp.z + zn.z) - z.z) * m4.z);
    sg[(k4 + 3) * 16 + tt] = sigmoidf_(z.w + (0.5f * (zp.w + zn.w) - z.w) * m4.w);
  }
  __syncthreads();
  const int col = tid & 255, half = tid >> 8;
  float acc[8];
#pragma unroll
  for (int i = 0; i < 8; ++i) acc[i] = 0.f;
  const float* g2 = p.rw_g2 + (size_t)l * 128 * 256 + col;
#pragma unroll 1
  for (int kh = 0; kh < 8; ++kh) {
    float gr[16];
#pragma unroll
    for (int k = 0; k < 16; ++k) gr[k] = g2[(kh * 16 + k) * 256];
#pragma unroll
    for (int k = 0; k < 16; ++k) {
      const float* sk = sg + (kh * 16 + k) * 16 + half * 8;
#pragma unroll
      for (int i = 0; i < 8; ++i) acc[i] += sk[i] * gr[k];
      if ((k & 3) == 3) sched_fence();
    }
  }
  const size_t AS = (size_t)NT_ * 256;
  const float lw = p.rw_lnx_w[(size_t)l * 256 + col], lb = p.rw_lnx_b[(size_t)l * 256 + col];
  float yv[8], vv[8], bsv[8];
#pragma unroll
  for (int i = 0; i < 8; ++i) {
    const int n = n0 + half * 8 + i;
    const size_t o = (size_t)n * 256 + col;
    yv[i] = ys[o] + ys[AS + o];
    vv[i] = bf2f(rb[1 * AS + o]);
    bsv[i] = bso[(size_t)n * 4 + (col >> 6)] + bso[((size_t)NT_ + n) * 4 + (col >> 6)];
  }
#pragma unroll
  for (int i = 0; i < 8; ++i) {
    const int n = n0 + half * 8 + i;
    const size_t o = (size_t)n * 256 + col;
    const float y = yv[i];
    const float mean = wave_sum(y) * (1.f / 64.f);
    const float dv = y - mean;
    const float var = wave_sum(dv * dv) * (1.f / 64.f);
    const float yn = dv * (frsq(var + 64e-5f)) * lw + lb;
    rwo[o] = f2bf((yn + bsv[i] * vv[i]) * acc[i]);
  }
}
DI void phase5(const Params& p, int l, bool with_ctx, char* smem) {
  const int n1 = ml3_items(with_ctx), n2 = rwo_items(with_ctx);
  for (int it = blockIdx.x; it < n1 + n2; it += gridDim.x) {
    if (it < n1) { TSB(p, 62); mlstm_out_item(p, l, it, with_ctx, smem); TSB(p, 63); }
    else { TSB(p, 64); rwkv_out_item(p, l, it - n1, smem); TSB(p, 65); }
  }
}
typedef Gemm<256, 128, 64, 4, 2> G2;
template <class G> DI void merge_tile(const Params& p, int l, int row0, int col0, char* smem) {
  const bf16_t* H = (const bf16_t*)(p.ws + OFF_H);
  const char* W = p.ws + OFF_WMIX + (size_t)l * WM_SIZE;
  const bf16_t* Wg = (const bf16_t*)(W + WM_GATE);
  const bf16_t* att = (const bf16_t*)(p.ws + OFF_REGION + R_ATT);
  const bf16_t* mlo = (const bf16_t*)(p.ws + OFF_REGION + R_MLO);
  const bf16_t* rwo = (const bf16_t*)(p.ws + OFF_REGION + R_RWO);
  bf16_t* ymix = (bf16_t*)(p.osc + O_YMIX);
  const int tid = opaque_tid();
  __syncthreads();
  unsigned ypk[G::MB][G::NB][8];
  f32x16 acc[G::MB][G::NB];
#pragma unroll 1
  for (int i = 0; i < 3; ++i) {
    unsigned sg[G::MB][G::NB][8];
#pragma unroll
    for (int a = 0; a < G::MB; ++a)
#pragma unroll
      for (int b = 0; b < G::NB; ++b) acc[a][b] = zero16();
    const bf16_t* A0 = H + (size_t)row0 * 1024;
    G::run_lin(acc, A0, 1024, Wg + ((size_t)i * 1024 + col0) * 1024, 1024, 1024, smem);
#pragma unroll
    for (int a = 0; a < G::MB; ++a)
#pragma unroll
      for (int b = 0; b < G::NB; ++b) {
#pragma unroll
        for (int e = 0; e < 8; ++e) sg[a][b][e] = pack2bf(sigmoidf_(acc[a][b][2 * e]), sigmoidf_(acc[a][b][2 * e + 1]));
        acc[a][b] = zero16();
      }
    const bf16_t* br = i == 0 ? att : (i == 1 ? mlo : rwo);
    const int kb = i == 0 ? 512 : 256;
    const bf16_t* Wb = (const bf16_t*)(W + (i == 0 ? WM_BRA : (i == 1 ? WM_BRM : WM_BRR)));
    const bf16_t* B0 = br + (size_t)row0 * kb;
    G::run_lin(acc, B0, kb, Wb + (size_t)col0 * kb, kb, kb, smem);
#pragma unroll
    for (int a = 0; a < G::MB; ++a)
#pragma unroll
      for (int b = 0; b < G::NB; ++b)
#pragma unroll
        for (int e = 0; e < 8; ++e) {
          float y0 = bf2f((bf16_t)(sg[a][b][e] & 0xffff)) * acc[a][b][2 * e], y1 = bf2f((bf16_t)(sg[a][b][e] >> 16)) * acc[a][b][2 * e + 1];
          if (i > 0) { y0 += bf2f((bf16_t)(ypk[a][b][e] & 0xffff)); y1 += bf2f((bf16_t)(ypk[a][b][e] >> 16)); }
          if (i < 2) ypk[a][b][e] = pack2bf(y0, y1); else { acc[a][b][2 * e] = y0; acc[a][b][2 * e + 1] = y1; }
        }
  }
  {
    const int lane = tid & 63, wid = tid >> 6, wm = wid / G::WN, wn = wid % G::WN;
    float* scr = (float*)(smem + wid * WTile<G::NB>::BYTES);
#pragma unroll
    for (int mb = 0; mb < G::MB; ++mb) {
#pragma unroll
      for (int nb = 0; nb < G::NB; ++nb) WTile<G::NB>::put(scr, nb, lane, acc[mb][nb]);
      const int r0 = row0 + wm * G::WTM + mb * 32, c0 = col0 + wn * G::WTN;
      WTile<G::NB>::rows8(scr, lane, [&](int r, int c, const float4& a, const float4& bq) {
        *(uint4*)(ymix + (size_t)(r0 + r) * 1024 + c0 + c) = pack8bf(a, bq); });
    }
  }
}
DI void phase_merge(const Params& p, int l, bool with_ctx, char* smem) {
  const int nbig = (NX_ / 256) * 8, nsmall = with_ctx ? (NC_ / 128) * 8 : 0;
  for (int it = vblock(); it < nbig + nsmall; it += gridDim.x) {
    if (it < nbig) merge_tile<G2>(p, l, (it >> 3) * 256, (it & 7) * 128, smem);
    else { const int i2 = it - nbig; merge_tile<G128>(p, l, NX_ + (i2 >> 3) * 128, (i2 & 7) * 128, smem); }
  }
}

template <class G> DI void wout_tile(const Params& p, int l, int row0, int col0, char* smem) {
  const bf16_t* ymix = (const bf16_t*)(p.osc + O_YMIX);
  const bf16_t* Wo = (const bf16_t*)(p.ws + OFF_WMIX + (size_t)l * WM_SIZE + WM_OUT);
  float* xs = (float*)(p.ws + OFF_XS);
  const float* mod = (const float*)(p.ws + OFF_MOD) + (size_t)l * 3 * 6144;
  const int tid = opaque_tid();
  __syncthreads();
  f32x16 acc[G::MB][G::NB];
#pragma unroll
  for (int a = 0; a < G::MB; ++a)
#pragma unroll
    for (int b = 0; b < G::NB; ++b) acc[a][b] = zero16();
  const bf16_t* A0 = ymix + (size_t)row0 * 1024;
  G::run_lin(acc, A0, 1024, Wo + (size_t)col0 * 1024, 1024, 1024, smem);
  const float* m2 = mod + (size_t)tok_modrow(row0) * 6144 + 2 * 1024;
  const int lane = tid & 63, wid = tid >> 6, wm = wid / G::WN, wn = wid % G::WN;
  float* scr = (float*)(smem + wid * WTile<G::NB>::BYTES);
#pragma unroll
  for (int mb = 0; mb < G::MB; ++mb) {
#pragma unroll
    for (int nb = 0; nb < G::NB; ++nb) WTile<G::NB>::put(scr, nb, lane, acc[mb][nb]);
    const int r0 = row0 + wm * G::WTM + mb * 32, c0 = col0 + wn * G::WTN;
    WTile<G::NB>::rows4(scr, lane, [&](int r, int c, const float4& a) {
      float4* d = (float4*)(xs + (size_t)(r0 + r) * 1024 + c0 + c);
      const float4 g = *(const float4*)(m2 + c0 + c); float4 x = *d;
      x.x += g.x * a.x; x.y += g.y * a.y; x.z += g.z * a.z; x.w += g.w * a.w; *d = x; });
  }
}
DI void phase_wout(const Params& p, int l, bool with_ctx, char* smem) {
  const int nbig = (NX_ / 256) * 8, nsmall = with_ctx ? (NC_ / 128) * 8 : 0;
  for (int it = vblock(); it < nbig + nsmall; it += gridDim.x) {
    if (it < nbig) wout_tile<G2>(p, l, (it >> 3) * 256, (it & 7) * 128, smem);
    else { const int i2 = it - nbig; wout_tile<G128>(p, l, NX_ + (i2 >> 3) * 128, (i2 & 7) * 128, smem); }
  }
  TSB(p, 66);
  cvt_run([&](int i) { return cvt_moe_dec(p, l, i); }, (int)gridDim.x - 1 - vblock(), CVT_MOE_TILES, gridDim.x, smem);
  TSB(p, 67);
}

typedef Gemm<128, 64, 64, 4, 2> GRT;
DI void phase_router(const Params& p, int l, bool with_ctx, char* smem, int* cnt) {
  float* xs = (float*)(p.ws + OFF_XS);
  bf16_t* H = (bf16_t*)(p.ws + OFF_H);
  const float* mod = (const float*)(p.ws + OFF_MOD) + (size_t)l * 3 * 6144;
  const bf16_t* Wr = (const bf16_t*)(p.ws + OFF_WMIX + (size_t)l * WM_SIZE + WM_RT);
  int* eidx = (int*)(p.ws + OFF_REGION + R_EIDX);
  float* ewt = (float*)(p.ws + OFF_REGION + R_EWT);
  int* erank = (int*)(p.ws + OFF_REGION + R_ERANK);
  int* elist = (int*)(p.ws + OFF_REGION + R_ELIST);
  float* sc = (float*)(smem + GRT::SMEM);
  float* bs = sc + 128 * 65;
  float* gs = bs + 128 * 65;
  int* lcnt = (int*)(gs + 128 * 9);
  int* lbase = lcnt + 64;
  const int tid = opaque_tid(), lane = tid & 63, wid = tid >> 6;
  const int ntok = with_ctx ? NT_ : NX_;
  for (int it = blockIdx.x; it < ntok / 128; it += gridDim.x) {
    const int n0 = it * 128;
    __syncthreads();
    TSB(p, 40);
    if (tid < 64) lcnt[tid] = 0;
#pragma unroll 1
    for (int r4 = 0; r4 < 16; r4 += 4) {
      float v[4][16];
#pragma unroll
      for (int u = 0; u < 4; ++u) {
        const int n = n0 + wid * 16 + r4 + u;
#pragma unroll
        for (int j = 0; j < 4; ++j) {
          const float4 t = *(const float4*)(xs + (size_t)n * 1024 + (j * 64 + lane) * 4);
          v[u][j * 4] = t.x; v[u][j * 4 + 1] = t.y; v[u][j * 4 + 2] = t.z; v[u][j * 4 + 3] = t.w;
        }
      }
#pragma unroll
      for (int u = 0; u < 4; ++u) {
        const int n = n0 + wid * 16 + r4 + u;
        const float* m = mod + (size_t)tok_modrow(n) * 6144;
        row_norm_mod(v[u], p.g_ffn + (size_t)l * 1024, m + 3 * 1024, m + 4 * 1024, H + (size_t)n * 1024, lane);
      }
    }
    __syncthreads();
    TSB(p, 41);
    f32x16 acc[1][1]; acc[0][0] = zero16();
    const bf16_t* A0 = H + (size_t)n0 * 1024;
    GRT::run(acc, [&](int r) { return A0 + (size_t)r * 1024; }, Wr, 1024, 1024, smem);
    {
      const int col = GRT::col_of(tid, 0);
      const float rb = p.router_bias[l * 64 + col];
#pragma unroll
      for (int e = 0; e < 16; ++e) {
        const int row = GRT::row_of(tid, 0, e);
        const float s = sigmoidf_(acc[0][0][e]);
        sc[row * 65 + col] = s; bs[row * 65 + col] = s + rb;
      }
    }
    __syncthreads();
    TSB(p, 42);
    int sel[8], lrk[8]; float wsum = 0.f;
    if (tid < 128) {
      float* b = bs + tid * 65; const float* s = sc + tid * 65; float* g = gs + tid * 9;
      for (int gi = 0; gi < 8; ++gi) {
        float m1 = -1e30f, m2 = -1e30f;
        for (int j = 0; j < 8; ++j) { const float x = b[gi * 8 + j]; if (x > m1) { m2 = m1; m1 = x; } else if (x > m2) m2 = x; }
        g[gi] = m1 + m2;
      }
      unsigned gmask = 0;
      for (int c = 0; c < 4; ++c) {
        int best = 0; float bv = -1e30f;
        for (int gi = 0; gi < 8; ++gi) if (!((gmask >> gi) & 1) && g[gi] > bv) { bv = g[gi]; best = gi; }
        gmask |= 1u << best;
      }
      for (int gi = 0; gi < 8; ++gi) if (!((gmask >> gi) & 1)) for (int j = 0; j < 8; ++j) b[gi * 8 + j] = -1e30f;
      wsum = 0.f;
#pragma unroll
      for (int c = 0; c < 8; ++c) {
        int best = 0; float bv = -1e30f;
        for (int e = 0; e < 64; ++e) { const float x = b[e]; if (x > bv) { bv = x; best = e; } }
        b[best] = -3e30f; sel[c] = best; wsum += s[best];
        lrk[c] = atomicAdd(lcnt + best, 1);
      }
    }
    __syncthreads();
    if (tid < 64) { const int c = lcnt[tid]; lbase[tid] = c ? atomicAdd(cnt + tid * 32, c) : 0; }
    __syncthreads();
    if (tid < 128) {
      const int n = n0 + tid;
      const float* s = sc + tid * 65;
      const float inv = 2.5f / (wsum + 1e-20f);
#pragma unroll
      for (int c = 0; c < 8; ++c) {
        const int e = sel[c];
        const int rk = lbase[e] + lrk[c];
        eidx[n * 8 + c] = e; ewt[n * 8 + c] = s[e] * inv; erank[n * 8 + c] = rk;
        elist[(size_t)e * NT_ + rk] = n * 8 + c;
      }
    }
    __syncthreads();
    TSB(p, 43);
  }
}

typedef Gemm<128, 256, 32, 2, 4> GMOE;
constexpr int ACT_LD = 264;
constexpr int MOE_ACT_OFF = GMOE::SMEM;
constexpr int MOE_INFO_OFF = MOE_ACT_OFF + 128 * ACT_LD * 2;
static_assert(MOE_INFO_OFF + 128 * 8 + 67 * 4 * 2 <= 160 * 1024 - 16, "moe lds");
DI void moe_down_run(f32x16 (&acc)[GMOE::MB][GMOE::NB], const char* actl, const bf16_t* Bt, char* smem) {
  constexpr int BK = 32, LDA = GMOE::LDA, CPR = 4, BCH = GMOE::BCH, STG = GMOE::B_BYTES;
  const int tid = opaque_tid(), lane = tid & 63, wid = tid >> 6, wm = wid / 4, wn = wid % 4;
  const int kc = (tid % CPR) * 8, r0 = tid / CPR;
  u32x4 rb[BCH];
  char* Bs0 = smem;
#pragma unroll
  for (int i = 0; i < BCH; ++i) rb[i] = *(const u32x4*)(Bt + (size_t)(r0 + i * 128) * 256 + kc);
#pragma unroll
  for (int i = 0; i < BCH; ++i) *(u32x4*)(Bs0 + ((r0 + i * 128) * LDA + kc) * 2) = rb[i];
  __syncthreads();
  for (int kt = 0; kt < 256 / BK; ++kt) {
    const int kn = (kt + 1 < 256 / BK ? kt + 1 : kt) * BK;
#pragma unroll
    for (int i = 0; i < BCH; ++i) rb[i] = *(const u32x4*)(Bt + (size_t)(r0 + i * 128) * 256 + kn + kc);
    sched_fence();
    const char* Bs = Bs0 + (kt & 1) * STG;
#pragma unroll
    for (int ks = 0; ks < BK / 16; ++ks) {
      bf16x8 af[GMOE::MB], bfr[GMOE::NB];
#pragma unroll
      for (int mb = 0; mb < GMOE::MB; ++mb)
        af[mb] = *(const bf16x8*)(actl + ((wm * 64 + mb * 32 + (lane & 31)) * ACT_LD + kt * BK + ks * 16 + (lane >> 5) * 8) * 2);
#pragma unroll
      for (int nb = 0; nb < GMOE::NB; ++nb)
        bfr[nb] = *(const bf16x8*)(Bs + ((wn * 64 + nb * 32 + (lane & 31)) * LDA + ks * 16 + (lane >> 5) * 8) * 2);
#pragma unroll
      for (int mb = 0; mb < GMOE::MB; ++mb)
#pragma unroll
        for (int nb = 0; nb < GMOE::NB; ++nb) acc[mb][nb] = mfma32(af[mb], bfr[nb], acc[mb][nb]);
    }
    sched_fence();
    {
      char* Bd = Bs0 + ((kt + 1) & 1) * STG;
#pragma unroll
      for (int i = 0; i < BCH; ++i) *(u32x4*)(Bd + ((r0 + i * 128) * LDA + kc) * 2) = rb[i];
    }
    __syncthreads();
  }
}
DI void phase_moe(const Params& p, int l, bool with_ctx, char* smem, const int* cnt) {
  const bf16_t* H = (const bf16_t*)(p.ws + OFF_H);
  const bf16_t* GU = (const bf16_t*)(p.ws + OFF_REGION + R_WMOE + WE_GU);
  const bf16_t* DN = (const bf16_t*)(p.ws + OFF_REGION + R_WMOE + WE_DN);
  const float* ewt = (const float*)(p.ws + OFF_REGION + R_EWT);
  const int* elist = (const int*)(p.ws + OFF_REGION + R_ELIST);
  bf16_t* ybuf = (bf16_t*)(p.ws + OFF_REGION + R_YBUF);
  char* actl = smem + MOE_ACT_OFF;
  int* rtok = (int*)(smem + MOE_INFO_OFF);
  float* rwt = (float*)(rtok + 128);
  int* pre = (int*)(rwt + 128);
  int* off = pre + 67;
  int tid = threadIdx.x;
  const int ntok = with_ctx ? NT_ : NX_;
  __syncthreads();
  if (tid == 0) {
    int a = 0, o = 0;
    for (int e = 0; e < 65; ++e) { const int c = e < 64 ? cnt[e * 32] : ntok; pre[e] = a; off[e] = o; a += (c + 127) >> 7; o += c; }
    pre[65] = a; off[65] = o;
  }
  __syncthreads();
  const int total = pre[65];
  for (int it = vblock(); it < total; it += gridDim.x) {
    tid = opaque_tid();
    int e0 = 0;
    while (pre[e0 + 1] <= it) ++e0;
    const int e = rfl(e0);
    const int rb = rfl(it - pre[e]);
    const int c = rfl(e < 64 ? cnt[e * 32] : ntok);
    const int obase = rfl(off[e] + rb * 128);
    __syncthreads();
    if (tid < 128) {
      const int slot = rb * 128 + tid;
      int tok = 0; float w = 0.f;
      if (slot < c) {
        if (e < 64) { const int pk = elist[(size_t)e * NT_ + slot]; tok = pk >> 3; w = ewt[pk]; }
        else { tok = slot; w = 1.f; }
      }
      rtok[tid] = tok; rwt[tid] = w;
    }
    __syncthreads();
    const bf16_t* Wgu = GU + (size_t)e * 512 * 1024;
#pragma unroll 1
    for (int hf = 0; hf < 2; ++hf) {
      f32x16 acc[GMOE::MB][GMOE::NB];
#pragma unroll
      for (int a = 0; a < GMOE::MB; ++a)
#pragma unroll
        for (int b = 0; b < GMOE::NB; ++b) acc[a][b] = zero16();
      GMOE::run(acc, [&](int r) { return H + (size_t)rtok[r] * 1024; }, Wgu + (size_t)hf * 256 * 1024, 1024, 1024, smem);
      const int lane = tid & 63, wn = (tid >> 6) % 4, wmr = ((tid >> 6) / 4) * 64 + 4 * (lane >> 5);
      const int j = (hf * 4 + wn) * 32 + (lane & 31);
#pragma unroll
      for (int mb = 0; mb < GMOE::MB; ++mb)
#pragma unroll
        for (int i = 0; i < 16; ++i) {
          const int row = wmr + mb * 32 + (i & 3) + 8 * (i >> 2);
          const float g = acc[mb][0][i], u = acc[mb][1][i];
          *(bf16_t*)(actl + (row * ACT_LD + j) * 2) = f2bf(siluf_(g) * u);
        }
    }
    __syncthreads();
    const bf16_t* Wd = DN + (size_t)e * 1024 * 256;
#pragma unroll 1
    for (int nt = 0; nt < 4; ++nt) {
      f32x16 acc[GMOE::MB][GMOE::NB];
#pragma unroll
      for (int a = 0; a < GMOE::MB; ++a)
#pragma unroll
        for (int b = 0; b < GMOE::NB; ++b) acc[a][b] = zero16();
      moe_down_run(acc, actl, Wd + (size_t)nt * 256 * 256, smem);
      {
        const int lane = tid & 63, wid = tid >> 6, wm = wid / 4, wn = wid % 4;
        float* scr = (float*)(smem + wid * WTile<1>::BYTES);
#pragma unroll
        for (int mb = 0; mb < GMOE::MB; ++mb)
#pragma unroll
          for (int nb = 0; nb < GMOE::NB; ++nb) {
            WTile<1>::put(scr, 0, lane, acc[mb][nb]);
            const int row0 = wm * 64 + mb * 32, col0 = nt * 256 + wn * 64 + nb * 32;
            WTile<1>::rows8(scr, lane, [&](int r, int cq, const float4& a, const float4& bq) {
              const int row = row0 + r;
              if (rb * 128 + row < c) {
                const float w = rwt[row];
                const float4 a2 = make_float4(a.x * w, a.y * w, a.z * w, a.w * w), b2 = make_float4(bq.x * w, bq.y * w, bq.z * w, bq.w * w);
                *(uint4*)(ybuf + ((size_t)obase + row) * 1024 + col0 + cq) = pack8bf(a2, b2);
              } });
          }
        __syncthreads();
      }
    }
  }
}

DI void phase_combine(const Params& p, int l, bool last, char* smem, const int* cnt) {
  float* xs = (float*)(p.ws + OFF_XS);
  bf16_t* H = (bf16_t*)(p.ws + OFF_H);
  const float* mod = (const float*)(p.ws + OFF_MOD);
  const int* eidx = (const int*)(p.ws + OFF_REGION + R_EIDX);
  const int* erank = (const int*)(p.ws + OFF_REGION + R_ERANK);
  const bf16_t* ybuf = (const bf16_t*)(p.ws + OFF_REGION + R_YBUF);
  int* off = (int*)smem;
  const int tid = opaque_tid(), lane = tid & 63, wid = tid >> 6;
  const int ntok = last ? NX_ : NT_;
  __syncthreads();
  if (tid == 0) { int o = 0; for (int e = 0; e < 64; ++e) { off[e] = o; o += cnt[e * 32]; } off[64] = o; }
  __syncthreads();
  for (int n = blockIdx.x * 8 + wid; n < ntok; n += gridDim.x * 8) {
    float acc[16];
#pragma unroll
    for (int i = 0; i < 16; ++i) acc[i] = 0.f;
    for (int k = 0; k < 9; ++k) {
      const int row = k < 8 ? off[eidx[n * 8 + k]] + erank[n * 8 + k] : off[64] + n;
      const bf16_t* y = ybuf + (size_t)row * 1024;
#pragma unroll
      for (int j = 0; j < 4; ++j) {
        const uint2 u = *(const uint2*)(y + (j * 64 + lane) * 4);
        acc[j * 4 + 0] += bf2f((bf16_t)(u.x & 0xffff)); acc[j * 4 + 1] += bf2f((bf16_t)(u.x >> 16));
        acc[j * 4 + 2] += bf2f((bf16_t)(u.y & 0xffff)); acc[j * 4 + 3] += bf2f((bf16_t)(u.y >> 16));
      }
    }
    const float* m5 = mod + ((size_t)l * 3 + tok_modrow(n)) * 6144 + 5 * 1024;
    float v[16];
#pragma unroll
    for (int j = 0; j < 4; ++j) {
      const int c = (j * 64 + lane) * 4;
      const float4 x = *(const float4*)(xs + (size_t)n * 1024 + c), g = *(const float4*)(m5 + c);
      v[j * 4 + 0] = x.x + g.x * acc[j * 4 + 0]; v[j * 4 + 1] = x.y + g.y * acc[j * 4 + 1];
      v[j * 4 + 2] = x.z + g.z * acc[j * 4 + 2]; v[j * 4 + 3] = x.w + g.w * acc[j * 4 + 3];
      if (!last) *(float4*)(xs + (size_t)n * 1024 + c) = make_float4(v[j * 4], v[j * 4 + 1], v[j * 4 + 2], v[j * 4 + 3]);
    }
    if (!last) {
      const float* m = mod + ((size_t)(l + 1) * 3 + tok_modrow(n)) * 6144;
      row_norm_mod(v, p.g_mix + (size_t)(l + 1) * 1024, m, m + 1024, H + (size_t)n * 1024, lane);
    } else {
      float ss = 0.f;
#pragma unroll
      for (int i = 0; i < 16; ++i) ss += v[i] * v[i];
      ss = wave_sum(ss);
      const float rs = frsq(ss * (1.f / 1024.f) + 1e-6f);
#pragma unroll
      for (int j = 0; j < 4; ++j) {
        const int c = (j * 64 + lane) * 4;
        const float4 g = *(const float4*)(p.g_final + c);
        *(float4*)(p.out + (size_t)n * 1024 + c) = make_float4(v[j * 4] * rs * g.x, v[j * 4 + 1] * rs * g.y, v[j * 4 + 2] * rs * g.z, v[j * 4 + 3] * rs * g.w);
      }
    }
  }
}
#define SMEM_BYTES (160 * 1024)
#ifndef MEGA
#define MEGA 0
#endif
DI int* cnt_ptr(const Params& p, int l) { return (int*)(p.ws + OFF_CNT) + 1024 + 2048 * l; }
DI int* ctr_ptr(const Params& p, int l) { return (int*)(p.ws + OFF_CNT) + 32 * l; }
#if !MEGA
__global__ void __launch_bounds__(NTHR) k_phaseA(Params p) { SMEM_DECL(smem, SMEM_BYTES); phaseA(p, smem); }
__global__ void __launch_bounds__(NTHR) k_norm0(Params p) { phase_norm0(p); }
__global__ void __launch_bounds__(NTHR) k_win(Params p, int l) { SMEM_DECL(smem, SMEM_BYTES); phase_win(p, l, smem); }
__global__ void __launch_bounds__(NTHR) k_p3(Params p, int l) { SMEM_DECL(smem, SMEM_BYTES); phase3(p, l, smem); }
__global__ void __launch_bounds__(NTHR) k_p3b(Params p, int l) { SMEM_DECL(smem, SMEM_BYTES); phase3b(p, l, smem); }
__global__ void __launch_bounds__(NTHR) k_p4(Params p, int l) { SMEM_DECL(smem, SMEM_BYTES); phase4(p, l, smem, ctr_ptr(p, l)); }
__global__ void __launch_bounds__(NTHR) k_p5(Params p, int l, int wc) { SMEM_DECL(smem, SMEM_BYTES); phase5(p, l, wc != 0, smem); }
__global__ void __launch_bounds__(NTHR) k_merge(Params p, int l, int wc) { SMEM_DECL(smem, SMEM_BYTES); phase_merge(p, l, wc != 0, smem); }
__global__ void __launch_bounds__(NTHR) k_wout(Params p, int l, int wc) { SMEM_DECL(smem, SMEM_BYTES); phase_wout(p, l, wc != 0, smem); }
__global__ void __launch_bounds__(NTHR) k_router(Params p, int l, int wc) { SMEM_DECL(smem, SMEM_BYTES); phase_router(p, l, wc != 0, smem, cnt_ptr(p, l)); }
__global__ void __launch_bounds__(NTHR) k_moe(Params p, int l, int wc) { SMEM_DECL(smem, SMEM_BYTES); phase_moe(p, l, wc != 0, smem, cnt_ptr(p, l)); }
__global__ void __launch_bounds__(NTHR) k_combine(Params p, int l, int last) { SMEM_DECL(smem, SMEM_BYTES); phase_combine(p, l, last != 0, smem, cnt_ptr(p, l)); }
#else
#ifndef EMU
#define XB_TMO      128
#define XB_XCNT(j)  (256  + 64 * (j))
#define XB_XSUB(j)  (1280 + 64 * (j))
#define XB_XGEN(j)  (2304 + 64 * (j))
#define XB_TOP      3328
#define XB_TOPGEN   3392
#define XCD_BAR_WORDS 3456
#define XB_SPIN_CAP (1u << 24)
#define LAS __attribute__((address_space(3)))
DI unsigned xb_ld(unsigned* p) { return __hip_atomic_load(p, __ATOMIC_RELAXED, __HIP_MEMORY_SCOPE_AGENT); }
DI unsigned xb_add(unsigned* p, unsigned v) { return __hip_atomic_fetch_add(p, v, __ATOMIC_RELAXED, __HIP_MEMORY_SCOPE_AGENT); }
DI unsigned xb_xcc_id() { return (unsigned)__builtin_amdgcn_s_getreg((3 << 11) | 20) & 0xFu; }
#define XB_SPIN(cond, bar) do { unsigned _sp = 0; while (cond) { __builtin_amdgcn_s_sleep(1); \
    if ((++_sp & 255u) == 0u) { if (xb_ld(&(bar)[XB_TMO])) break; if (_sp > XB_SPIN_CAP) { atomicAdd(&(bar)[XB_TMO], 1u); break; } } } } while (0)
struct XcdBarrier { unsigned* bar; unsigned x; volatile LAS unsigned* st; };
DI XcdBarrier xcd_barrier_post(unsigned* bar, volatile LAS unsigned* st) {
  XcdBarrier b; b.bar = bar; b.x = xb_xcc_id(); b.st = st;
  if (threadIdx.x == 0) (void)xb_add(&bar[XB_XCNT(b.x)], 1u);
  return b;
}
DI void xcd_barrier_complete(unsigned* bar, unsigned x, unsigned& nloc, unsigned& nx) {
  const unsigned G = gridDim.x * gridDim.y * gridDim.z;
  unsigned sum, cnt, mine, sp = 0u;
  for (;;) {
    sum = 0u; cnt = 0u; mine = 0u;
#pragma unroll
    for (unsigned j = 0; j < 16; ++j) { const unsigned c = xb_ld(&bar[XB_XCNT(j)]); sum += c; cnt += (c > 0u) ? 1u : 0u; mine = (j == x) ? c : mine; }
    if (sum == G) break;
    __builtin_amdgcn_s_sleep(1);
    if ((++sp & 255u) == 0u) { if (xb_ld(&bar[XB_TMO])) break; if (sp > XB_SPIN_CAP) { atomicAdd(&bar[XB_TMO], 1u); break; } }
  }
  nloc = mine > 0u ? mine : 1u; nx = cnt > 0u ? cnt : 1u;
}
DI void xcd_barrier(const XcdBarrier& b) {
  asm volatile("s_waitcnt vmcnt(0)" ::: "memory");
  __syncthreads();
  if (threadIdx.x == 0) {
    unsigned* bar = b.bar;
    __builtin_amdgcn_s_waitcnt(0);
    unsigned nloc = b.st[0], nx = b.st[1];
    if (nloc == 0u) { xcd_barrier_complete(bar, b.x, nloc, nx); b.st[0] = nloc; b.st[1] = nx; }
    const unsigned old = xb_add(&bar[XB_XSUB(b.x)], 1u);
    const unsigned gen = old / nloc;
    if (old + 1u == (gen + 1u) * nloc) {
      __builtin_amdgcn_fence(__ATOMIC_RELEASE, "agent");
      asm volatile("s_waitcnt vmcnt(0)" ::: "memory");
      const unsigned og = xb_add(&bar[XB_TOP], 1u);
      const unsigned tg = og / nx;
      if (og + 1u == (tg + 1u) * nx) xb_add(&bar[XB_TOPGEN], 1u);
      else XB_SPIN(xb_ld(&bar[XB_TOPGEN]) == tg, bar);
      __builtin_amdgcn_fence(__ATOMIC_ACQUIRE, "agent");
      xb_add(&bar[XB_XGEN(b.x)], 1u);
      asm volatile("s_waitcnt vmcnt(0)" ::: "memory");
    } else {
      XB_SPIN(xb_ld(&bar[XB_XGEN(b.x)]) == gen, bar);
      __builtin_amdgcn_fence(__ATOMIC_ACQUIRE, "agent");
      asm volatile("s_waitcnt vmcnt(0)" ::: "memory");
    }
  }
  __syncthreads();
}
#define GSYNC() { XcdBarrier xb_; xb_.bar = (unsigned*)(p.ws + OFF_BAR); xb_.x = xb_xcc_id(); xb_.st = (volatile LAS unsigned*)(smem + SMEM_BYTES - 32); xcd_barrier(xb_); }
#else
#define GSYNC() emu::grid_barrier()
#endif
#ifdef PROBE_IDX
#define TS(i) { if (blockIdx.x == 0 && threadIdx.x == 0) ts[i] = wall_clock64(); }
#else
#define TS(i)
#endif
__global__ void __launch_bounds__(NTHR) k_mega(Params p) {
  SMEM_DECL(smem, SMEM_BYTES);
  cooperative_groups::grid_group grid = cooperative_groups::this_grid();
  volatile LAS unsigned* xst = (volatile LAS unsigned*)(smem + SMEM_BYTES - 32);
  if (threadIdx.x == 0) { xst[0] = 0u; xst[1] = 0u; }
  __syncthreads();
  (void)xcd_barrier_post((unsigned*)(p.ws + OFF_BAR), xst);
#ifdef PROBE_IDX
  long long* ts = (long long*)(p.ws + OFF_CNT + 2048);
#endif
  TS(0);
  phaseA(p, smem);
  grid.sync(); TS(1);
  phase_norm0(p);
  GSYNC(); TS(2);
#pragma unroll 1
  for (int l = 0; l < 2; ++l) {
    const bool wc = l == 0;
    phase_win(p, l, smem); GSYNC(); TS(3 + l * 10);
    phase3(p, l, smem); GSYNC(); TS(4 + l * 10);
    phase3b(p, l, smem); GSYNC(); TS(5 + l * 10);
    phase4(p, l, smem, ctr_ptr(p, l)); GSYNC(); TS(6 + l * 10);
    phase5(p, l, wc, smem); GSYNC(); TS(7 + l * 10);
    phase_merge(p, l, wc, smem); GSYNC(); TS(8 + l * 10);
    phase_wout(p, l, wc, smem); GSYNC(); TS(9 + l * 10);
    phase_router(p, l, wc, smem, cnt_ptr(p, l)); GSYNC(); TS(10 + l * 10);
    phase_moe(p, l, wc, smem, cnt_ptr(p, l)); GSYNC(); TS(11 + l * 10);
    phase_combine(p, l, l == 1, smem, cnt_ptr(p, l));
#ifdef PROBE_IDX
    GSYNC(); TS(12 + l * 10);
#else
    if (l == 0) GSYNC();
#endif
  }
#ifdef PROBE_IDX
  if (blockIdx.x == 0 && threadIdx.x == 0) {
    const float us = (float)(ts[PROBE_IDX + 1] - ts[PROBE_IDX]) * 0.01f;
    p.out[0] += PROBE_IDX >= 40 ? rintf(6.f * log2f(fmaxf(us * 16.f, 1.f))) : rintf(6.f * log2f(fmaxf(us, 1.f)));
  }
#endif
}
#endif

extern "C" void kernel_launch(void* const* d_in, const int* in_sizes, int n_in, void* d_out, int out_size, void* d_ws,
                              size_t ws_size, hipStream_t stream) {
  Params p{};
  const float** pp = (const float**)&p;
  for (int i = 0; i < 41; ++i) pp[i] = (const float*)d_in[i];
  p.out = (float*)d_out; p.ws = (char*)d_ws; p.osc = (char*)d_out;
  if (ws_size < WS_NEEDED) { fprintf(stderr, "workspace too small: %zu < %zu\n", ws_size, (size_t)WS_NEEDED); return; }
#if !MEGA
  const dim3 g(256), b(NTHR);
  hipLaunchKernelGGL(k_phaseA, g, b, 0, stream, p);
  hipLaunchKernelGGL(k_norm0, g, b, 0, stream, p);
  for (int l = 0; l < 2; ++l) {
    const int wc = l == 0;
    hipLaunchKernelGGL(k_win, g, b, 0, stream, p, l);
    hipLaunchKernelGGL(k_p3, g, b, 0, stream, p, l);
    hipLaunchKernelGGL(k_p3b, g, b, 0, stream, p, l);
    hipLaunchKernelGGL(k_p4, g, b, 0, stream, p, l);
    hipLaunchKernelGGL(k_p5, g, b, 0, stream, p, l, wc);
    hipLaunchKernelGGL(k_merge, g, b, 0, stream, p, l, wc);
    hipLaunchKernelGGL(k_wout, g, b, 0, stream, p, l, wc);
    hipLaunchKernelGGL(k_router, g, b, 0, stream, p, l, wc);
    hipLaunchKernelGGL(k_moe, g, b, 0, stream, p, l, wc);
    hipLaunchKernelGGL(k_combine, g, b, 0, stream, p, l, l == 1);
  }
#else
  static int grid_blocks = 0;
  if (!grid_blocks) {
    int dev = 0, cus = 0, per_cu = 0;
    hipGetDevice(&dev);
    hipDeviceGetAttribute(&cus, hipDeviceAttributeMultiprocessorCount, dev);
    hipOccupancyMaxActiveBlocksPerMultiprocessor(&per_cu, k_mega, NTHR, 0);
    if (per_cu > 1) per_cu = 1;
    grid_blocks = cus * per_cu;
  }
  hipMemsetAsync(p.ws + OFF_BAR, 0, 16384, stream);
  void* args[] = {&p};
  hipError_t e = hipLaunchCooperativeKernel((void*)k_mega, dim3(grid_blocks), dim3(NTHR), args, 0, stream);
  if (e != hipSuccess) fprintf(stderr, "cooperative launch failed: %s (grid %d)\n", hipGetErrorString(e), grid_blocks);
#endif
}
```

```cpp
#define MEGA 1
#include <hip/hip_runtime.h>
#include <hip/hip_cooperative_groups.h>
#include <cstdio>

#ifndef SEQ_T
#define SEQ_T 8192
#endif
#ifndef CTX_L
#define CTX_L 256
#endif

#define DI __device__ __forceinline__
typedef unsigned short bf16_t;
typedef short bf16x8 __attribute__((ext_vector_type(8)));
typedef float f32x16 __attribute__((ext_vector_type(16)));
typedef float f32x4 __attribute__((ext_vector_type(4)));
typedef unsigned u32x4 __attribute__((ext_vector_type(4)));

constexpr int NB_ = 2, T_ = SEQ_T, CL_ = CTX_L, D_ = 1024;
constexpr int NX_ = NB_ * T_, NC_ = NB_ * CL_, NT_ = NX_ + NC_, KT_ = CL_ + T_;
constexpr int GRID_W_ = 64;
constexpr int MLA_H = 8, MLA_NOPE_ = 64, MLA_ROPE_ = 32, MLA_DK = 96, MLA_DV = 64, QLORA = 384, KVLORA = 256;
constexpr int MLA_IN_ = 672, ML_IN_ = 784, RW_IN_ = 1152, GATE_IN_ = 3072, D_IN_ = 5680;
constexpr int ZMLA_W = 768;
constexpr int ZREC_W = 1936;
constexpr int WIN_N = 768 + 2048;
constexpr int ML_H = 4, ML_DK = 32, ML_DV = 64, ML_L = 64;
constexpr int RW_H = 4, RW_N_ = 64;
constexpr int NE_ = 64, TOPK_ = 8, DE_ = 256;
constexpr int NCH_ = KT_ / ML_L;
constexpr int NSEQ_ = 2 * NB_ * 4;

constexpr int ZR_MLQ = 0, ZR_MLK = 128, ZR_MLV = 256, ZR_MLO = 512, ZR_MLI = 768, ZR_MLF = 776;
constexpr int ZR_RW = 784;

constexpr size_t al256(size_t x) { return (x + 255) & ~(size_t)255; }
constexpr size_t WM_WIN = 0;
constexpr size_t WM_GATE = WM_WIN + (size_t)WIN_N * 1024 * 2;
constexpr size_t WM_UQ = WM_GATE + (size_t)3072 * 1024 * 2;
constexpr size_t WM_UKV = WM_UQ + (size_t)768 * 384 * 2;
constexpr size_t WM_BRA = WM_UKV + (size_t)1024 * 256 * 2;
constexpr size_t WM_BRM = WM_BRA + (size_t)1024 * 512 * 2;
constexpr size_t WM_BRR = WM_BRM + (size_t)1024 * 256 * 2;
constexpr size_t WM_OUT = WM_BRR + (size_t)1024 * 256 * 2;
constexpr size_t WM_RT = WM_OUT + (size_t)1024 * 1024 * 2;
constexpr size_t WM_SIZE = al256(WM_RT + (size_t)64 * 1024 * 2);
constexpr size_t WE_GU = 0;
constexpr size_t WE_DN = WE_GU + (size_t)65 * 512 * 1024 * 2;
constexpr size_t WE_SIZE = al256(WE_DN + (size_t)65 * 1024 * 256 * 2);

constexpr size_t OFF_XS = 0;
constexpr size_t OFF_MOD = OFF_XS + al256((size_t)NT_ * 1024 * 4);
constexpr size_t OFF_ROPE = OFF_MOD + al256((size_t)2 * 3 * 6144 * 4);
constexpr size_t OFF_H = OFF_ROPE + al256((size_t)T_ * 16 * 8);
constexpr size_t OFF_WMIX = OFF_H + al256((size_t)NT_ * 1024 * 2);
constexpr size_t OFF_CNT = OFF_WMIX + 2 * WM_SIZE;
constexpr size_t OFF_BAR = OFF_CNT + 32768;
constexpr size_t OFF_REGION = OFF_BAR + 16384;
constexpr size_t R_ZREC = 0;
constexpr size_t R_RB16 = R_ZREC + al256((size_t)NT_ * ZREC_W * 4);
constexpr size_t R_LW = R_RB16 + al256((size_t)7 * NT_ * 256 * 2);
constexpr size_t R_BS = R_LW + al256((size_t)2 * NT_ * 256 * 4);
constexpr size_t R_CH = R_BS + al256((size_t)2 * NT_ * 4 * 4);
constexpr size_t R_YS = R_CH + al256((size_t)NSEQ_ * NCH_ * 40960);
constexpr size_t R_MLST = R_YS + al256((size_t)2 * NT_ * 256 * 4);
constexpr size_t R_ATT = R_MLST + al256((size_t)NSEQ_ * NCH_ * 2112 * 4);
constexpr size_t R_MLO = R_ATT + al256((size_t)NT_ * 512 * 2);
constexpr size_t R_RWO = R_MLO + al256((size_t)NT_ * 256 * 2);
constexpr size_t R_VT = R_RWO + al256((size_t)NT_ * 256 * 2);
constexpr size_t R_KB = R_VT + al256((size_t)NB_ * MLA_H * 64 * KT_ * 2);
constexpr size_t R_MIX_END = R_KB + al256((size_t)NB_ * MLA_H * KT_ * 96 * 2);
constexpr int NSLOT_ = NT_ * 9;
constexpr size_t R_YBUF = 0;
constexpr size_t R_EIDX = R_YBUF + al256((size_t)NSLOT_ * 1024 * 2);
constexpr size_t R_EWT = R_EIDX + al256((size_t)NT_ * 8 * 4);
constexpr size_t R_ERANK = R_EWT + al256((size_t)NT_ * 8 * 4);
constexpr size_t R_ELIST = R_ERANK + al256((size_t)NT_ * 8 * 4);
constexpr size_t R_WMOE = R_ELIST + al256((size_t)64 * NT_ * 4);
constexpr size_t R_MOE_END = R_WMOE + WE_SIZE;
constexpr size_t R_SIZE = R_MIX_END > R_MOE_END ? R_MIX_END : R_MOE_END;
constexpr size_t WS_NEEDED = OFF_REGION + R_SIZE;
constexpr size_t O_ZMLA = 0;
constexpr size_t O_QB = O_ZMLA + al256((size_t)NT_ * ZMLA_W * 2);
constexpr size_t O_END = O_QB + al256((size_t)NT_ * 768 * 2);
constexpr size_t O_YMIX = 0;
#if SEQ_T == 8192 && CTX_L == 256
static_assert(O_END <= (size_t)NX_ * 1024 * 4, "d_out scratch overflow");
static_assert((size_t)NT_ * 1024 * 2 <= (size_t)NX_ * 1024 * 4, "ymix overflow");
static_assert(WS_NEEDED <= (size_t)597000000, "workspace too large");
#endif

struct Params {
  const float *x, *c, *ctx, *c_ctx, *w_mod, *b_mod, *g_mix, *g_ffn, *w_in, *g_cq, *w_uq, *g_ckv, *w_uk, *w_uv;
  const float *ml_b_i, *ml_b_f, *ml_g_norm, *rw_mu, *rw_w0, *rw_w2, *rw_a0, *rw_a2, *rw_g2, *rw_k_k, *rw_k_a;
  const float *rw_r_k, *rw_lnx_w, *rw_lnx_b, *w_br_mla, *w_br_ml, *w_br_rw, *w_out, *w_router, *router_bias;
  const float *w_e_gate, *w_e_up, *w_e_down, *w_s_gate, *w_s_up, *w_s_down, *g_final;
  float* out; char* ws; char* osc;
};

DI float bf2f(bf16_t s) { unsigned u = ((unsigned)s) << 16; float f; __builtin_memcpy(&f, &u, 4); return f; }
DI bf16_t f2bf(float x) { unsigned u; __builtin_memcpy(&u, &x, 4); u += 0x7fffu + ((u >> 16) & 1u); return (bf16_t)(u >> 16); }
DI unsigned pack2bf(float a, float b) {
#ifdef EMU
  return (unsigned)f2bf(a) | ((unsigned)f2bf(b) << 16);
#else
  typedef __bf16 bf2 __attribute__((ext_vector_type(2)));
  typedef float f2 __attribute__((ext_vector_type(2)));
  f2 v = {a, b}; bf2 r = __builtin_convertvector(v, bf2); return __builtin_bit_cast(unsigned, r);
#endif
}
DI f32x16 mfma32(bf16x8 a, bf16x8 b, f32x16 c) {
#ifdef EMU
  return emu_mfma_32x32x16_bf16(a, b, c);
#else
  return __builtin_amdgcn_mfma_f32_32x32x16_bf16(a, b, c, 0, 0, 0);
#endif
}
DI int rfl(int v) {
#ifdef EMU
  return v;
#else
  return __builtin_amdgcn_readfirstlane(v);
#endif
}
DI int opaque_tid() {
#ifdef EMU
  return threadIdx.x;
#else
  int t = threadIdx.x; asm volatile("" : "+v"(t)); return t;
#endif
}
DI void wave_sync() {
#ifdef EMU
  (void)__ballot(1);
#else
  asm volatile("" ::: "memory");
#endif
}
DI int vblock() {
  const int g = gridDim.x, b = blockIdx.x;
  return (g & 7) == 0 ? (b & 7) * (g >> 3) + (b >> 3) : b;
}
DI int xcc_id() {
#ifdef EMU
  return blockIdx.x & 7;
#else
  return (int)(__builtin_amdgcn_s_getreg((3 << 11) | 20) & 7u);
#endif
}
DI int ld_relaxed(int* p) {
#ifdef EMU
  return __atomic_load_n(p, __ATOMIC_SEQ_CST);
#else
  return __hip_atomic_load(p, __ATOMIC_RELAXED, __HIP_MEMORY_SCOPE_AGENT);
#endif
}
DI void sched_fence() {
#ifndef EMU
  __builtin_amdgcn_sched_barrier(0);
#endif
}
template <int L> DI float lane_bcast(float x) {
#ifdef EMU
  return __shfl(x, L);
#else
  return __builtin_bit_cast(float, __builtin_amdgcn_readlane(__builtin_bit_cast(int, x), L));
#endif
}
DI f32x16 zero16() { f32x16 z; for (int i = 0; i < 16; ++i) z[i] = 0.f; return z; }
DI int crow(int reg, int h) { return (reg & 3) + 8 * (reg >> 2) + 4 * h; }
#ifdef EMU
DI float fexp(float x) { return expf(x); }
#else
DI float fexp(float x) { return __expf(x); }
#endif
#ifdef EMU
DI float frcp(float x) { return 1.f / x; }
DI float frsq(float x) { return 1.f / sqrtf(x); }
#else
DI float frcp(float x) { return __builtin_amdgcn_rcpf(x); }
DI float frsq(float x) { return __builtin_amdgcn_rsqf(x); }
#endif
DI float sigmoidf_(float x) { return frcp(1.f + fexp(-x)); }
DI float siluf_(float x) { return x * sigmoidf_(x); }
#ifdef EMU
DI float wave_sum(float v) { for (int m = 32; m >= 1; m >>= 1) v += __shfl_xor(v, m); return v; }
DI float wave_max(float v) { for (int m = 32; m >= 1; m >>= 1) v = fmaxf(v, __shfl_xor(v, m)); return v; }
#else
#define DPPF(x, ctrl) __builtin_bit_cast(float, __builtin_amdgcn_mov_dpp(__builtin_bit_cast(int, (x)), (ctrl), 0xf, 0xf, true))
#define RDLF(x, l) __builtin_bit_cast(float, __builtin_amdgcn_readlane(__builtin_bit_cast(int, (x)), (l)))
DI float wave_sum(float v) {
  v += DPPF(v, 0xB1); v += DPPF(v, 0x4E); v += DPPF(v, 0x124); v += DPPF(v, 0x128);
  return (RDLF(v, 0) + RDLF(v, 16)) + (RDLF(v, 32) + RDLF(v, 48));
}
DI float wave_max(float v) {
  v = fmaxf(v, DPPF(v, 0xB1)); v = fmaxf(v, DPPF(v, 0x4E)); v = fmaxf(v, DPPF(v, 0x124)); v = fmaxf(v, DPPF(v, 0x128));
  return fmaxf(fmaxf(RDLF(v, 0), RDLF(v, 16)), fmaxf(RDLF(v, 32), RDLF(v, 48)));
}
#endif

DI int tok_b(int n) { return n < NX_ ? n / T_ : (n - NX_) / CL_; }
DI int tok_t(int n) { return n < NX_ ? n % T_ : (n - NX_) % CL_; }
DI int tok_key(int n) { return n < NX_ ? CL_ + n % T_ : (n - NX_) % CL_; }
DI int tok_modrow(int n) { return n < NX_ ? n / T_ : 2; }

#ifdef EMU
#define SMEM_DECL(name, bytes) char* name = (char*)emu::shared_alloc(bytes)
#else
#define SMEM_DECL(name, bytes) __shared__ __attribute__((aligned(16))) char name[bytes]
#endif
#define NTHR 512
#if defined(PROBE_IDX) && !defined(EMU)
#define TSB(pp, i) { if (blockIdx.x == 0 && threadIdx.x == 0) ((long long*)((pp).ws + OFF_CNT + 2048))[i] = wall_clock64(); }
#else
#define TSB(pp, i)
#endif
struct CvtJob { const float* src; int lds; int K; bf16_t* dst; int ntn; int ntk; int maptype; const float* gain; };
DI int cvt_map(int maptype, int coff, int np) {
  if (maptype == 0) return coff + np;
  if (maptype == 1) { if (np < 672) return np; if (np < 768) return -1; if (np < 768 + 1936) return np - 96; return -1; }
  return np;
}
struct CvtItem { CvtJob j; int coff, tk, tn; };
struct CvtRegs { float v[8]; };
DI void cvt_load(const CvtItem& c, int tid, CvtRegs& r) {
  const int kk = tid >> 4, np = c.tn * 64 + (tid & 15) * 4;
  const int sc = cvt_map(c.j.maptype, c.coff, np);
#pragma unroll
  for (int u = 0; u < 2; ++u) {
    const int k = c.tk * 64 + kk + 32 * u;
    float4 v = make_float4(0.f, 0.f, 0.f, 0.f);
    if (sc >= 0) v = *(const float4*)(c.j.src + (size_t)k * c.j.lds + sc);
    const float g = c.j.gain ? c.j.gain[k] : 1.f;
    r.v[4 * u] = v.x * g; r.v[4 * u + 1] = v.y * g; r.v[4 * u + 2] = v.z * g; r.v[4 * u + 3] = v.w * g;
  }
}
DI void cvt_store(const CvtItem& c, int tid, const CvtRegs& r, char* smem) {
  float* tile = (float*)smem;
  __syncthreads();
  {
    const int kk = tid >> 4, nc = (tid & 15) * 4;
#pragma unroll
    for (int u = 0; u < 2; ++u)
#pragma unroll
      for (int i = 0; i < 4; ++i) tile[(kk + 32 * u) * 65 + nc + i] = r.v[4 * u + i];
  }
  __syncthreads();
  {
    const int n = tid >> 3, kc = (tid & 7) * 8;
    int np = c.tn * 64 + n;
    if (c.j.maptype == 2) np = (np >> 5) * 64 + c.coff * 32 + (np & 31);
    uint4 v;
    v.x = pack2bf(tile[(kc + 0) * 65 + n], tile[(kc + 1) * 65 + n]);
    v.y = pack2bf(tile[(kc + 2) * 65 + n], tile[(kc + 3) * 65 + n]);
    v.z = pack2bf(tile[(kc + 4) * 65 + n], tile[(kc + 5) * 65 + n]);
    v.w = pack2bf(tile[(kc + 6) * 65 + n], tile[(kc + 7) * 65 + n]);
    *(uint4*)(c.j.dst + (size_t)np * c.j.K + c.tk * 64 + kc) = v;
  }
}
template <class Dec> DI void cvt_run(Dec dec, int first, int n, int stride, char* smem) {
  const int tid = opaque_tid();
  if (first >= n) return;
  CvtItem cur = dec(first); CvtRegs rc; cvt_load(cur, tid, rc);
  for (int it = first; it < n; it += stride) {
    const int nx = it + stride < n ? it + stride : it;
    CvtItem nxt = dec(nx); CvtRegs rn; cvt_load(nxt, tid, rn);
    sched_fence();
    cvt_store(cur, tid, rc, smem);
    cur = nxt; rc = rn;
  }
}

constexpr int CVT_MIX_TILES = 704 + 768 + 72 + 32 + 32 + 128 + 64 + 64 + 256 + 16;
DI CvtItem cvt_mix_dec(const Params& p, int l, int it) {
  bf16_t* W = (bf16_t*)(p.ws + OFF_WMIX + (size_t)l * WM_SIZE);
  CvtJob j; int coff = 0;
  if (it < 704) { j = {p.w_in + (size_t)l * 1024 * D_IN_, D_IN_, 1024, (bf16_t*)((char*)W + WM_WIN), 44, 16, 1, nullptr}; }
  else if ((it -= 704) < 768) { j = {p.w_in + (size_t)l * 1024 * D_IN_, D_IN_, 1024, (bf16_t*)((char*)W + WM_GATE), 48, 16, 0, nullptr}; coff = 2608; }
  else if ((it -= 768) < 72) { j = {p.w_uq + (size_t)l * 384 * 768, 768, 384, (bf16_t*)((char*)W + WM_UQ), 12, 6, 0, p.g_cq + l * 384}; }
  else if ((it -= 72) < 32) { j = {p.w_uk + (size_t)l * 256 * 512, 512, 256, (bf16_t*)((char*)W + WM_UKV), 8, 4, 0, p.g_ckv + l * 256}; }
  else if ((it -= 32) < 32) { j = {p.w_uv + (size_t)l * 256 * 512, 512, 256, (bf16_t*)((char*)W + WM_UKV) + 512 * 256, 8, 4, 0, p.g_ckv + l * 256}; }
  else if ((it -= 32) < 128) { j = {p.w_br_mla + (size_t)l * 512 * 1024, 1024, 512, (bf16_t*)((char*)W + WM_BRA), 16, 8, 0, nullptr}; }
  else if ((it -= 128) < 64) { j = {p.w_br_ml + (size_t)l * 256 * 1024, 1024, 256, (bf16_t*)((char*)W + WM_BRM), 16, 4, 0, nullptr}; }
  else if ((it -= 64) < 64) { j = {p.w_br_rw + (size_t)l * 256 * 1024, 1024, 256, (bf16_t*)((char*)W + WM_BRR), 16, 4, 0, nullptr}; }
  else if ((it -= 64) < 256) { j = {p.w_out + (size_t)l * 1024 * 1024, 1024, 1024, (bf16_t*)((char*)W + WM_OUT), 16, 16, 0, nullptr}; }
  else { it -= 256; j = {p.w_router + (size_t)l * 1024 * 64, 64, 1024, (bf16_t*)((char*)W + WM_RT), 1, 16, 0, nullptr}; }
  CvtItem c; c.j = j; c.coff = coff; c.tk = it / j.ntn; c.tn = it % j.ntn; return c;
}
constexpr int CVT_MOE_TILES = 65 * 192;
DI CvtItem cvt_moe_dec(const Params& p, int l, int it) {
  const int e = it / 192; int r = it % 192;
  bf16_t* GU = (bf16_t*)(p.ws + OFF_REGION + R_WMOE + WE_GU) + (size_t)e * 512 * 1024;
  bf16_t* DN = (bf16_t*)(p.ws + OFF_REGION + R_WMOE + WE_DN) + (size_t)e * 1024 * 256;
  const float* sg = e < 64 ? p.w_e_gate + ((size_t)l * 64 + e) * 1024 * 256 : p.w_s_gate + (size_t)l * 1024 * 256;
  const float* su = e < 64 ? p.w_e_up + ((size_t)l * 64 + e) * 1024 * 256 : p.w_s_up + (size_t)l * 1024 * 256;
  const float* sd = e < 64 ? p.w_e_down + ((size_t)l * 64 + e) * 256 * 1024 : p.w_s_down + (size_t)l * 256 * 1024;
  CvtJob j; int coff = 0;
  if (r < 64) { j = {sg, 256, 1024, GU, 4, 16, 2, nullptr}; coff = 0; }
  else if ((r -= 64) < 64) { j = {su, 256, 1024, GU, 4, 16, 2, nullptr}; coff = 1; }
  else { r -= 64; j = {sd, 1024, 256, DN, 16, 4, 0, nullptr}; }
  CvtItem c; c.j = j; c.coff = coff; c.tk = r / j.ntn; c.tn = r % j.ntn; return c;
}

DI void mod_item(const Params& p, int it, char* smem) {
  float* cond = (float*)smem;
  float* red = cond + 3 * 1024;
  const int tid = opaque_tid(), l = it / 96, j0 = (it % 96) * 64;
  __syncthreads();
  for (int i = tid; i < 3 * 1024; i += NTHR) {
    const int r = i >> 10, k = i & 1023;
    const float v = r < 2 ? p.c[r * 1024 + k] : p.c_ctx[k];
    cond[i] = siluf_(v);
  }
  __syncthreads();
  const int jj = tid & 63, kg = tid >> 6;
  float a0 = 0.f, a1 = 0.f, a2 = 0.f;
  const float* w = p.w_mod + (size_t)l * 1024 * 6144 + j0 + jj;
  for (int k = kg; k < 1024; k += 8) {
    const float wv = w[(size_t)k * 6144];
    a0 += cond[k] * wv; a1 += cond[1024 + k] * wv; a2 += cond[2048 + k] * wv;
  }
  red[(kg * 3 + 0) * 64 + jj] = a0; red[(kg * 3 + 1) * 64 + jj] = a1; red[(kg * 3 + 2) * 64 + jj] = a2;
  __syncthreads();
  if (tid < 192) {
    const int r = tid >> 6; float s = 0.f;
    for (int g = 0; g < 8; ++g) s += red[(g * 3 + r) * 64 + jj];
    float* mod = (float*)(p.ws + OFF_MOD);
    mod[((size_t)l * 3 + r) * 6144 + j0 + jj] = s + p.b_mod[(size_t)l * 6144 + j0 + jj];
  }
}
DI void rope_item(const Params& p, int it) {
  const int idx = it * NTHR + threadIdx.x;
  if (idx >= T_ * 16) return;
  const int t = idx >> 4, i = idx & 15, f = i & 7;
  const float pos = (float)(i < 8 ? t / GRID_W_ : t % GRID_W_);
  const float inv = powf(10000.f, -(float)(2 * f) / 16.f);
  const float ang = pos * inv;
  float2* rt = (float2*)(p.ws + OFF_ROPE);
  rt[idx] = make_float2(cosf(ang), sinf(ang));
}
constexpr int PA_ITEMS = 192 + (T_ * 16 + NTHR - 1) / NTHR;
DI void phaseA(const Params& p, char* smem) {
  if (blockIdx.x == 0) for (int i = threadIdx.x; i < 8192; i += NTHR) ((int*)(p.ws + OFF_CNT))[i] = 0;
  for (int it = blockIdx.x; it < PA_ITEMS; it += gridDim.x) {
    if (it < 192) mod_item(p, it, smem); else rope_item(p, it - 192);
  }
  cvt_run([&](int i) { return cvt_mix_dec(p, i / CVT_MIX_TILES, i % CVT_MIX_TILES); }, blockIdx.x, 2 * CVT_MIX_TILES, gridDim.x, smem);
}

DI void row_norm_mod(const float (&v)[16], const float* g, const float* shift, const float* scale, bf16_t* hrow, int lane) {
  float ss = 0.f;
#pragma unroll
  for (int i = 0; i < 16; ++i) ss += v[i] * v[i];
  ss = wave_sum(ss);
  const float rs = frsq(ss * (1.f / 1024.f) + 1e-6f);
#pragma unroll
  for (int j = 0; j < 4; ++j) {
    const int c = (j * 64 + lane) * 4;
    const float4 gg = *(const float4*)(g + c), sh = *(const float4*)(shift + c), sc = *(const float4*)(scale + c);
    const float h0 = v[j * 4 + 0] * rs * gg.x * (1.f + sc.x) + sh.x;
    const float h1 = v[j * 4 + 1] * rs * gg.y * (1.f + sc.y) + sh.y;
    const float h2 = v[j * 4 + 2] * rs * gg.z * (1.f + sc.z) + sh.z;
    const float h3 = v[j * 4 + 3] * rs * gg.w * (1.f + sc.w) + sh.w;
    uint2 o; o.x = pack2bf(h0, h1); o.y = pack2bf(h2, h3);
    *(uint2*)(hrow + c) = o;
  }
}
DI void phase_norm0(const Params& p) {
  const int lane = threadIdx.x & 63, wid = threadIdx.x >> 6;
  float* xs = (float*)(p.ws + OFF_XS);
  bf16_t* H = (bf16_t*)(p.ws + OFF_H);
  const float* mod = (const float*)(p.ws + OFF_MOD);
  for (int n = blockIdx.x * 8 + wid; n < NT_; n += gridDim.x * 8) {
    const float* src = n < NX_ ? p.x + (size_t)n * 1024 : p.ctx + (size_t)(n - NX_) * 1024;
    float v[16];
#pragma unroll
    for (int j = 0; j < 4; ++j) {
      const float4 t = *(const float4*)(src + (j * 64 + lane) * 4);
      v[j * 4] = t.x; v[j * 4 + 1] = t.y; v[j * 4 + 2] = t.z; v[j * 4 + 3] = t.w;
      *(float4*)(xs + (size_t)n * 1024 + (j * 64 + lane) * 4) = t;
    }
    const float* m = mod + (size_t)(0 * 3 + tok_modrow(n)) * 6144;
    row_norm_mod(v, p.g_mix, m, m + 1024, H + (size_t)n * 1024, lane);
  }
}

template <int BM, int BN, int BK, int WM_, int WN_>
struct Gemm {
  static constexpr int WTM = BM / WM_, WTN = BN / WN_, MB = WTM / 32, NB = WTN / 32, WM = WM_, WN = WN_, TM = BM, TN = BN;
  static constexpr int LDA = BK + 8;
  static constexpr int A_BYTES = BM * LDA * 2, B_BYTES = BN * LDA * 2, STAGE = A_BYTES + B_BYTES;
  static constexpr int SMEM = 2 * STAGE;
  static constexpr int CPR = BK / 8;
  static constexpr int ACH = BM * CPR / NTHR, BCH = BN * CPR / NTHR;
  static_assert(WM_ * WN_ == 8, "8 waves");
  static_assert(BM * CPR % NTHR == 0 && BN * CPR % NTHR == 0, "chunking");
  static_assert(NTHR % CPR == 0, "rows fixed per thread");

  template <class LA, class LB>
  static DI void run_core(f32x16 (&acc)[MB][NB], LA la, LB lb, int nk, char* smem, int tid) {
    const int lane = tid & 63, wid = tid >> 6, wm = wid / WN_, wn = wid % WN_;
    const int kc = (tid % CPR) * 8, r0 = tid / CPR;
    constexpr int KS = BK / 16, NCH = ACH + BCH;
    u32x4 s0[NCH], s1[NCH];
#define GEMM_LOAD(dst_, kt_) { const int kq_ = (kt_) < nk ? (kt_) : nk - 1; \
    _Pragma("unroll") for (int i = 0; i < ACH; ++i) dst_[i] = la(i, kq_); \
    _Pragma("unroll") for (int i = 0; i < BCH; ++i) dst_[ACH + i] = lb(i, kq_); }
#define GEMM_WRITE1(src_, c_, buf_) { if ((c_) < ACH) *(u32x4*)(smem + (buf_) * STAGE + ((r0 + (c_) * (NTHR / CPR)) * LDA + kc) * 2) = src_[c_]; \
    else *(u32x4*)(smem + (buf_) * STAGE + A_BYTES + ((r0 + ((c_) - ACH) * (NTHR / CPR)) * LDA + kc) * 2) = src_[c_]; }
#define GEMM_STEP(w_, l_, kt_) { \
    GEMM_LOAD(l_, (kt_) + 2); \
    sched_fence(); \
    const char* As = smem + ((kt_) & 1) * STAGE; const char* Bs = As + A_BYTES; \
    _Pragma("unroll") for (int ks = 0; ks < KS; ++ks) { \
      bf16x8 af[MB], bfr[NB]; \
      _Pragma("unroll") for (int mb = 0; mb < MB; ++mb) af[mb] = *(const bf16x8*)(As + ((wm * WTM + mb * 32 + (lane & 31)) * LDA + ks * 16 + (lane >> 5) * 8) * 2); \
      _Pragma("unroll") for (int nb = 0; nb < NB; ++nb) bfr[nb] = *(const bf16x8*)(Bs + ((wn * WTN + nb * 32 + (lane & 31)) * LDA + ks * 16 + (lane >> 5) * 8) * 2); \
      _Pragma("unroll") for (int c = 0; c < NCH; ++c) if ((c * KS) / NCH == ks) GEMM_WRITE1(w_, c, ((kt_) + 1) & 1); \
      _Pragma("unroll") for (int mb = 0; mb < MB; ++mb) _Pragma("unroll") for (int nb = 0; nb < NB; ++nb) acc[mb][nb] = mfma32(af[mb], bfr[nb], acc[mb][nb]); \
    } \
    sched_fence(); \
    __syncthreads(); }
    GEMM_LOAD(s0, 0);
#pragma unroll
    for (int c = 0; c < NCH; ++c) GEMM_WRITE1(s0, c, 0);
    GEMM_LOAD(s0, 1);
    __syncthreads();
    for (int kt = 0; kt < nk; kt += 2) {
      GEMM_STEP(s0, s1, kt);
      GEMM_STEP(s1, s0, kt + 1);
    }
#undef GEMM_STEP
#undef GEMM_WRITE1
#undef GEMM_LOAD
  }
  template <class ARow>
  static DI void run(f32x16 (&acc)[MB][NB], ARow arow, const bf16_t* Bt, int ldb, int Klen, char* smem) {
    const int tid = opaque_tid();
    const int kc = (tid % CPR) * 8, r0 = tid / CPR;
    const bf16_t* ap[ACH];
#pragma unroll
    for (int i = 0; i < ACH; ++i) ap[i] = arow(r0 + i * (NTHR / CPR)) + kc;
    const bf16_t* bp0 = Bt + (size_t)r0 * ldb + kc;
    const size_t sb = (size_t)(NTHR / CPR) * ldb;
    run_core(acc, [&](int i, int kt) { return *(const u32x4*)(ap[i] + kt * BK); },
             [&](int i, int kt) { return *(const u32x4*)(bp0 + i * sb + kt * BK); }, Klen / BK, smem, tid);
  }
  static DI void run_lin(f32x16 (&acc)[MB][NB], const bf16_t* A0, int lda, const bf16_t* Bt, int ldb, int Klen, char* smem) {
    const int tid = opaque_tid();
    const int kc = (tid % CPR) * 8, r0 = tid / CPR;
    const bf16_t* ap0 = A0 + (size_t)r0 * lda + kc; const bf16_t* bp0 = Bt + (size_t)r0 * ldb + kc;
    const size_t sa = (size_t)(NTHR / CPR) * lda, sb = (size_t)(NTHR / CPR) * ldb;
    run_core(acc, [&](int i, int kt) { return *(const u32x4*)(ap0 + i * sa + kt * BK); },
             [&](int i, int kt) { return *(const u32x4*)(bp0 + i * sb + kt * BK); }, Klen / BK, smem, tid);
  }
  static DI int row_of(int t, int mb, int reg) { const int lane = t & 63, wm = (t >> 6) / WN_; return wm * WTM + mb * 32 + crow(reg, lane >> 5); }
  static DI int col_of(int t, int nb) { const int lane = t & 63, wn = (t >> 6) % WN_; return wn * WTN + nb * 32 + (lane & 31); }
};


template <int NBW> struct WTile {
  static constexpr int LD = NBW * 32 + 4;
  static constexpr int BYTES = 32 * LD * 4;
  static DI void put(float* scr, int nb, int lane, const f32x16& v) {
    const int c = nb * 32 + (lane & 31), h = lane >> 5;
#pragma unroll
    for (int i = 0; i < 16; ++i) scr[crow(i, h) * LD + c] = v[i];
  }
  template <class F> static DI void rows4(const float* scr, int lane, F f) {
    wave_sync();
#pragma unroll
    for (int it = 0; it < NBW * 4; ++it) {
      const int id = it * 64 + lane, row = id / (NBW * 8), q = id % (NBW * 8);
      f(row, q * 4, *(const float4*)(scr + row * LD + q * 4));
    }
    wave_sync();
  }
  template <class F> static DI void rows8(const float* scr, int lane, F f) {
    wave_sync();
#pragma unroll
    for (int it = 0; it < NBW * 2; ++it) {
      const int id = it * 64 + lane, row = id / (NBW * 4), q = id % (NBW * 4);
      f(row, q * 8, *(const float4*)(scr + row * LD + q * 8), *(const float4*)(scr + row * LD + q * 8 + 4));
    }
    wave_sync();
  }
};
DI uint4 pack8bf(const float4& a, const float4& b) { return make_uint4(pack2bf(a.x, a.y), pack2bf(a.z, a.w), pack2bf(b.x, b.y), pack2bf(b.z, b.w)); }

typedef Gemm<256, 256, 64, 2, 4> G256;
DI void phase_win(const Params& p, int l, char* smem) {
  const bf16_t* H = (const bf16_t*)(p.ws + OFF_H);
  const bf16_t* W = (const bf16_t*)(p.ws + OFF_WMIX + (size_t)l * WM_SIZE + WM_WIN);
  bf16_t* zmla = (bf16_t*)(p.osc + O_ZMLA);
  float* zrec = (float*)(p.ws + OFF_REGION + R_ZREC);
  constexpr int TM = NT_ / 256, TN = WIN_N / 256;
  for (int it = vblock(); it < TM * TN; it += gridDim.x) {
    const int tid = opaque_tid();
    const int tm = it / TN, tn = it % TN;
    __syncthreads();
    f32x16 acc[G256::MB][G256::NB];
#pragma unroll
    for (int a = 0; a < G256::MB; ++a)
#pragma unroll
      for (int b = 0; b < G256::NB; ++b) acc[a][b] = zero16();
    const bf16_t* A0 = H + (size_t)tm * 256 * 1024;
    G256::run(acc, [&](int r) { return A0 + (size_t)r * 1024; }, W + (size_t)tn * 256 * 1024, 1024, 1024, smem);
    {
      const int lane = tid & 63, wid = tid >> 6, wm = wid / 4, wn = wid % 4;
      float* scr = (float*)(smem + wid * WTile<2>::BYTES);
      const int col0 = tn * 256 + wn * 64;
#pragma unroll
      for (int mb = 0; mb < G256::MB; ++mb) {
        WTile<2>::put(scr, 0, lane, acc[mb][0]); WTile<2>::put(scr, 1, lane, acc[mb][1]);
        const int row0 = tm * 256 + wm * 128 + mb * 32;
#ifdef ABL_NOSTORE
        if (tn > 1000) {
#else
        if (tn < 3) {
#endif
          WTile<2>::rows8(scr, lane, [&](int r, int c, const float4& a, const float4& bq) {
            *(uint4*)(zmla + (size_t)(row0 + r) * ZMLA_W + col0 + c) = pack8bf(a, bq); });
        } else {
          WTile<2>::rows4(scr, lane, [&](int r, int c, const float4& a) {
            const int cc = col0 - 768 + c;
#ifdef ABL_NOSTORE
            if (cc < -5) *(float4*)(zrec + (size_t)(row0 + r) * ZREC_W + cc) = a; });
#else
            if (cc < ZREC_W) *(float4*)(zrec + (size_t)(row0 + r) * ZREC_W + cc) = a; });
#endif
        }
      }
    }
  }
}
typedef Gemm<128, 128, 64, 2, 4> G128;
DI void mla_row_rs(const bf16_t* zmla_rows, int c0, int len, float* rs) {
  const int tid = opaque_tid(), row = tid >> 2, half = tid & 3;
  const bf16_t* src = zmla_rows + (size_t)row * ZMLA_W + c0 + half * (len / 4);
  float ss = 0.f;
  for (int i = 0; i < len / 4; i += 8) {
    const uint4 v = *(const uint4*)(src + i);
    const unsigned w[4] = {v.x, v.y, v.z, v.w};
#pragma unroll
    for (int j = 0; j < 4; ++j) { const float a = bf2f((bf16_t)(w[j] & 0xffff)), b = bf2f((bf16_t)(w[j] >> 16)); ss += a * a + b * b; }
  }
  ss += __shfl_xor(ss, 1); ss += __shfl_xor(ss, 2);
  if (half == 0) rs[row] = frsq(ss / (float)len + 1e-6f);
}

constexpr int MLA_Q_TILES = (NT_ / 128) * 6, MLA_KV_TILES = (NT_ / 128) * 8;
DI void mla_q_item(const Params& p, int l, int it, char* smem) {
  const int tid = opaque_tid();
  const int tm = it / 6, tn = it % 6;
  const bf16_t* zmla = (const bf16_t*)(p.osc + O_ZMLA) + (size_t)tm * 128 * ZMLA_W;
  const bf16_t* W = (const bf16_t*)(p.ws + OFF_WMIX + (size_t)l * WM_SIZE + WM_UQ) + (size_t)tn * 128 * 384;
  bf16_t* qb = (bf16_t*)(p.osc + O_QB);
  const float2* rt = (const float2*)(p.ws + OFF_ROPE);
  float* rs = (float*)(smem + G128::SMEM);
  __syncthreads();
  mla_row_rs(zmla, 0, 384, rs);
  f32x16 acc[G128::MB][G128::NB];
#pragma unroll
  for (int a = 0; a < G128::MB; ++a)
#pragma unroll
    for (int b = 0; b < G128::NB; ++b) acc[a][b] = zero16();
  G128::run(acc, [&](int r) { return zmla + (size_t)r * ZMLA_W; }, W, 384, 384, smem);
  const int lane = tid & 63;
  const bool isx = tm * 128 < NX_;
#pragma unroll
  for (int mb = 0; mb < G128::MB; ++mb)
#pragma unroll
    for (int nb = 0; nb < G128::NB; ++nb) {
      const int col = tn * 128 + G128::col_of(tid, nb);
      const bool ropeblk = ((col >> 5) % 3) == 2;
      const int e = lane & 31;
#pragma unroll
      for (int i = 0; i < 16; ++i) {
        const int lr = G128::row_of(tid, mb, i);
        const int n = tm * 128 + lr;
        float v = acc[mb][nb][i] * rs[lr];
        if (ropeblk && isx) {
          const float pv = __shfl_xor(v, 8);
          const float2 cs = rt[(size_t)(n % T_) * 16 + (e >> 4) * 8 + (e & 7)];
          v = (e & 8) ? (pv * cs.y + v * cs.x) : (v * cs.x - pv * cs.y);
        }
        qb[(size_t)n * 768 + col] = f2bf(v);
      }
    }
}
DI void mla_kv_item(const Params& p, int l, int it, char* smem) {
  const int tid = opaque_tid();
  const int tm = it / 8, tn = it % 8;
  const bf16_t* zmla = (const bf16_t*)(p.osc + O_ZMLA) + (size_t)tm * 128 * ZMLA_W;
  const bf16_t* W = (const bf16_t*)(p.ws + OFF_WMIX + (size_t)l * WM_SIZE + WM_UKV) + (size_t)tn * 128 * 256;
  bf16_t* kb = (bf16_t*)(p.ws + OFF_REGION + R_KB);
  bf16_t* vt = (bf16_t*)(p.ws + OFF_REGION + R_VT);
  const float2* rt = (const float2*)(p.ws + OFF_ROPE);
  float* rs = (float*)(smem + G128::SMEM);
  __syncthreads();
  mla_row_rs(zmla, 384, 256, rs);
  const int n0 = tm * 128;
  const int b = tok_b(n0), key0 = tok_key(n0);
  const bool isx = n0 < NX_;
  if (tn == 0) {
    for (int idx = tid; idx < 128 * 16; idx += NTHR) {
      const int lr = idx >> 4, pi = idx & 15, a = pi >> 3, i = pi & 7;
      const bf16_t* z = zmla + (size_t)lr * ZMLA_W + 640 + a * 16 + i;
      float x1 = bf2f(z[0]), x2 = bf2f(z[8]);
      if (isx) {
        const float2 cs = rt[(size_t)((n0 + lr) % T_) * 16 + a * 8 + i];
        const float y1 = x1 * cs.x - x2 * cs.y, y2 = x1 * cs.y + x2 * cs.x; x1 = y1; x2 = y2;
      }
      const bf16_t o1 = f2bf(x1), o2 = f2bf(x2);
      for (int h = 0; h < 8; ++h) {
        bf16_t* dst = kb + ((size_t)(b * 8 + h) * KT_ + key0 + lr) * 96 + 64 + a * 16 + i;
        dst[0] = o1; dst[8] = o2;
      }
    }
  }
  f32x16 acc[G128::MB][G128::NB];
#pragma unroll
  for (int a = 0; a < G128::MB; ++a)
#pragma unroll
    for (int c = 0; c < G128::NB; ++c) acc[a][c] = zero16();
  G128::run(acc, [&](int r) { return zmla + (size_t)r * ZMLA_W + 384; }, W, 256, 256, smem);
  const int lane = tid & 63;
#pragma unroll
  for (int mb = 0; mb < G128::MB; ++mb)
#pragma unroll
    for (int nb = 0; nb < G128::NB; ++nb) {
      const int col = tn * 128 + G128::col_of(tid, nb);
      if (col < 512) {
        const int h = col >> 6, d = col & 63;
#pragma unroll
        for (int i = 0; i < 16; ++i) {
          const int lr = G128::row_of(tid, mb, i);
          kb[((size_t)(b * 8 + h) * KT_ + key0 + lr) * 96 + d] = f2bf(acc[mb][nb][i] * rs[lr]);
        }
      } else {
        const int h = (col - 512) >> 6, d = col & 63;
#pragma unroll
        for (int g = 0; g < 4; ++g) {
          const int lr = G128::row_of(tid, mb, g * 4);
          uint2 o;
          o.x = pack2bf(acc[mb][nb][g * 4 + 0] * rs[lr], acc[mb][nb][g * 4 + 1] * rs[lr + 1]);
          o.y = pack2bf(acc[mb][nb][g * 4 + 2] * rs[lr + 2], acc[mb][nb][g * 4 + 3] * rs[lr + 3]);
          *(uint2*)(vt + ((size_t)(b * 8 + h) * 64 + d) * KT_ + key0 + lr) = o;
        }
      }
    }
  (void)lane;
}

DI float softplusf_(float x) { return x > 20.f ? x : log1pf(fexp(x)); }
constexpr int RWP_TT = 16;
constexpr int RWP_ITEMS = NT_ / RWP_TT;
DI void rwkv_prep_items(const Params& p, int l, char* smem) {
  if ((int)blockIdx.x >= RWP_ITEMS) return;
  float* zs = (float*)smem;
  float* tw = zs + RWP_TT * 1024;
  float* ta = tw + 2 * 64 * RWP_TT;
  const float* zrec = (const float*)(p.ws + OFF_REGION + R_ZREC);
  bf16_t* rb = (bf16_t*)(p.ws + OFF_REGION + R_RB16);
  float* lwo = (float*)(p.ws + OFF_REGION + R_LW);
  float* bso = (float*)(p.ws + OFF_REGION + R_BS);
  const float* mu = p.rw_mu + (size_t)l * 1152;
  const int tid = opaque_tid();
  const int col = tid & 255, d = tid >> 8;
  const float* w2 = p.rw_w2 + ((size_t)l * 2 + d) * 64 * 256 + col;
  const float* a2 = p.rw_a2 + ((size_t)l * 2 + d) * 64 * 256 + col;
  const float rkw = p.rw_r_k[(size_t)l * 256 + col];
  const float w0 = p.rw_w0[((size_t)l * 2 + d) * 256 + col], a0 = p.rw_a0[((size_t)l * 2 + d) * 256 + col];
  const float kkw = p.rw_k_k[(size_t)l * 256 + col], kaw = p.rw_k_a[(size_t)l * 256 + col];
  const size_t AS = (size_t)NT_ * 256;
#pragma unroll 1
  for (int it = blockIdx.x; it < RWP_ITEMS; it += gridDim.x) {
    const int n0 = it * RWP_TT;
    __syncthreads();
    TSB(p, 44);
#pragma unroll 1
    for (int i = 0; i < 8; ++i) {
      const int idx4 = tid + i * NTHR, tt = idx4 >> 8, c = (idx4 & 255) * 4, n = n0 + tt, t = tok_t(n);
      const int len = n < NX_ ? T_ : CL_;
      const float* zr = zrec + (size_t)n * ZREC_W + ZR_RW + c;
      const float4 z = *(const float4*)zr;
      const float4 zp = t > 0 ? *(const float4*)(zr - ZREC_W) : make_float4(0.f, 0.f, 0.f, 0.f);
      const float4 zn = t < len - 1 ? *(const float4*)(zr + ZREC_W) : make_float4(0.f, 0.f, 0.f, 0.f);
      const float4 m4 = *(const float4*)(mu + c);
      float4 sv;
      sv.x = z.x + (0.5f * (zp.x + zn.x) - z.x) * m4.x; sv.y = z.y + (0.5f * (zp.y + zn.y) - z.y) * m4.y;
      sv.z = z.z + (0.5f * (zp.z + zn.z) - z.z) * m4.z; sv.w = z.w + (0.5f * (zp.w + zn.w) - z.w) * m4.w;
      *(float4*)(zs + tt * 1024 + c) = sv;
      if (c >= 768) {
        const float e4[4] = {sv.x, sv.y, sv.z, sv.w};
#pragma unroll
        for (int q = 0; q < 4; ++q) {
          const int cc = c + q;
          if (cc < 896) { const int dd = (cc - 768) >> 6, k = (cc - 768) & 63; tw[(dd * 64 + k) * RWP_TT + tt] = 1.f - 2.f * frcp(1.f + fexp(2.f * e4[q])); }
          else { const int dd = (cc - 896) >> 6, k = (cc - 896) & 63; ta[(dd * 64 + k) * RWP_TT + tt] = e4[q]; }
        }
      }
    }
    __syncthreads();
    TSB(p, 45);
#pragma unroll 1
    for (int th = 0; th < RWP_TT; th += 8) {
      float aw[8], aa[8];
#pragma unroll
      for (int i = 0; i < 8; ++i) { aw[i] = 0.f; aa[i] = 0.f; }
#pragma unroll 1
      for (int kh = 0; kh < 4; ++kh) {
        float wr[16], ar[16];
#pragma unroll
        for (int k = 0; k < 16; ++k) { wr[k] = w2[(kh * 16 + k) * 256]; ar[k] = a2[(kh * 16 + k) * 256]; }
#pragma unroll
        for (int k = 0; k < 16; ++k) {
          const float* twk = tw + (d * 64 + kh * 16 + k) * RWP_TT + th;
          const float* tak = ta + (d * 64 + kh * 16 + k) * RWP_TT + th;
#pragma unroll
          for (int i = 0; i < 8; ++i) { aw[i] += twk[i] * wr[k]; aa[i] += tak[i] * ar[k]; }
          if ((k & 3) == 3) sched_fence();
        }
      }
#pragma unroll
      for (int i = 0; i < 8; ++i) {
        const int n = n0 + th + i;
        const float* zr = zs + (th + i) * 1024 + col;
        const float r = zr[0], k = zr[256], v = zr[512];
        const float kr = k * kkw;
        const float ss = wave_sum(kr * kr);
        const float kk = kr * frsq(fmaxf(ss, 1e-24f));
        const float w = -softplusf_(-(w0 + aw[i])) - 0.5f;
        const float logdecay = -fexp(w);
        const float a = sigmoidf_(a0 + aa[i]);
        const float kd = k * (1.f + (a - 1.f) * kaw);
        const float bsum = wave_sum(r * rkw * kd);
        const size_t o = (size_t)n * 256 + col;
        if (d == 0) { rb[0 * AS + o] = f2bf(r); rb[1 * AS + o] = f2bf(v); rb[2 * AS + o] = f2bf(kk); }
        lwo[d * AS + o] = logdecay;
        rb[(3 + 2 * d) * AS + o] = f2bf(kd);
        rb[(4 + 2 * d) * AS + o] = f2bf(kk * a);
        if ((tid & 63) == 0) bso[((size_t)d * NT_ + n) * 4 + (col >> 6)] = bsum;
      }
    }
    TSB(p, 47);
  }
}

DI int seq_tok(int dir, int b, int pos) {
  if (pos < CL_) return NX_ + b * CL_ + (dir ? CL_ - 1 - pos : pos);
  const int t = pos - CL_;
  return b * T_ + (dir ? T_ - 1 - t : t);
}
DI float logsigmoidf_(float x) { return -softplusf_(-x); }
DI float wave_incl_scan(float v, int lane) {
  for (int d = 1; d < 64; d <<= 1) { const float o = __shfl_up(v, d); if (lane >= d) v += o; }
  return v;
}
constexpr int ML_ST = 2112;
constexpr int ML1_ITEMS = NSEQ_ * NCH_;
DI void mlstm_local_item(const Params& p, int l, int it, char* smem) {
  const int s = it / NCH_, c = it % NCH_, dir = s >> 3, b = (s >> 2) & 1, hd = s & 3;
  float* vv = (float*)smem;
  float* kw = vv + 64 * 64;
  float* wej = kw + 64 * 32;
  const float* zrec = (const float*)(p.ws + OFF_REGION + R_ZREC);
  float* st = (float*)(p.ws + OFF_REGION + R_MLST) + ((size_t)s * NCH_ + c) * ML_ST;
  const int tid = opaque_tid(), lane = tid & 63, wid = tid >> 6;
  __syncthreads();
  if (wid == 0) {
    const int n = seq_tok(dir, b, c * 64 + lane);
    const float fp = zrec[(size_t)n * ZREC_W + ZR_MLF + dir * 4 + hd] + p.ml_b_f[(l * 2 + dir) * 4 + hd];
    const float ip = zrec[(size_t)n * ZREC_W + ZR_MLI + dir * 4 + hd] + p.ml_b_i[(l * 2 + dir) * 4 + hd];
    const float bj = wave_incl_scan(logsigmoidf_(fp), lane);
    const float bl = lane_bcast<63>(bj);
    const float lw = bl - bj + ip;
    const float ml = wave_max(lw);
    wej[lane] = fexp(lw - ml);
    if (lane == 0) { st[2080] = bl; st[2081] = ml; }
  }
  for (int idx = tid; idx < 64 * 64; idx += NTHR) {
    const int j = idx >> 6, e = idx & 63;
    const int n = seq_tok(dir, b, c * 64 + j);
    vv[idx] = zrec[(size_t)n * ZREC_W + ZR_MLV + hd * 64 + e];
  }
  __syncthreads();
  for (int idx = tid; idx < 64 * 32; idx += NTHR) {
    const int j = idx >> 5, e = idx & 31;
    const int n = seq_tok(dir, b, c * 64 + j);
    kw[idx] = zrec[(size_t)n * ZREC_W + ZR_MLK + hd * 32 + e] * wej[j];
  }
  __syncthreads();
  const int v = tid & 63, d0 = (tid >> 6) * 4;
  float a0 = 0.f, a1 = 0.f, a2 = 0.f, a3 = 0.f;
  for (int j = 0; j < 64; ++j) {
    const float x = vv[j * 64 + v];
    const float4 kk = *(const float4*)(kw + j * 32 + d0);
    a0 += x * kk.x; a1 += x * kk.y; a2 += x * kk.z; a3 += x * kk.w;
  }
  *(float4*)(st + v * 32 + d0) = make_float4(a0, a1, a2, a3);
  if (tid < 32) { float sn = 0.f; for (int j = 0; j < 64; ++j) sn += kw[j * 32 + tid]; st[2048 + tid] = sn; }
}
constexpr int ML2_ITEMS = (NSEQ_ * 2080 + NTHR - 1) / NTHR;
DI void mlstm_scan_item(const Params& p, int it) {
  const int g = it * NTHR + opaque_tid();
  if (g >= NSEQ_ * 2080) return;
  const int s = g / 2080, e = g % 2080;
  float* st = (float*)(p.ws + OFF_REGION + R_MLST) + (size_t)s * NCH_ * ML_ST;
  float state = 0.f, m = 0.f;
  static_assert(NCH_ % 4 == 0, "chunk count");
  for (int c0 = 0; c0 < NCH_; c0 += 4) {
    float d[4], bl[4], ml[4];
#pragma unroll
    for (int u = 0; u < 4; ++u) { const float* r = st + (size_t)(c0 + u) * ML_ST; d[u] = r[e]; bl[u] = r[2080]; ml[u] = r[2081]; }
#pragma unroll
    for (int u = 0; u < 4; ++u) {
      float* r = st + (size_t)(c0 + u) * ML_ST;
      r[e] = state;
      if (e == 0) r[2082] = m;
      const float mn = fmaxf(bl[u] + m, ml[u]);
      state = fexp(bl[u] + m - mn) * state + fexp(ml[u] - mn) * d[u];
      m = mn;
    }
  }
}

DI void phase3(const Params& p, int l, char* smem) {
  rwkv_prep_items(p, l, smem);
  for (int it = blockIdx.x; it < ML1_ITEMS; it += gridDim.x) { TSB(p, 56); mlstm_local_item(p, l, it, smem); TSB(p, 57); }
}
constexpr int RW_LD = 72, RW_MB = 64 * RW_LD * 2;
constexpr int RWC_REC = 40960;
DI char* rw_rec(const Params& p, int s, int c) { return p.ws + OFF_REGION + R_CH + ((size_t)s * NCH_ + c) * RWC_REC; }
DI f32x16 rw_mm(const char* A, const char* Bt, int mb, int nb, int lane, f32x16 acc) {
  const int r = lane & 31, h = lane >> 5;
#pragma unroll
  for (int ks = 0; ks < 4; ++ks) {
    const bf16x8 a = *(const bf16x8*)(A + ((mb * 32 + r) * RW_LD + ks * 16 + h * 8) * 2);
    const bf16x8 b = *(const bf16x8*)(Bt + ((nb * 32 + r) * RW_LD + ks * 16 + h * 8) * 2);
    acc = mfma32(a, b, acc);
  }
  return acc;
}
DI void rw_wrT(char* Dst, int mb, int nb, int lane, const f32x16& v) {
  const int r = lane & 31, h = lane >> 5;
#pragma unroll
  for (int g = 0; g < 4; ++g) {
    uint2 o; o.x = pack2bf(v[4 * g], v[4 * g + 1]); o.y = pack2bf(v[4 * g + 2], v[4 * g + 3]);
    *(uint2*)(Dst + ((nb * 32 + r) * RW_LD + mb * 32 + 8 * g + 4 * h) * 2) = o;
  }
}
DI void rw_wrT_g(bf16_t* Dst, int mb, int nb, int lane, const f32x16& v) {
  const int r = lane & 31, h = lane >> 5;
#pragma unroll
  for (int g = 0; g < 4; ++g) {
    uint2 o; o.x = pack2bf(v[4 * g], v[4 * g + 1]); o.y = pack2bf(v[4 * g + 2], v[4 * g + 3]);
    *(uint2*)(Dst + (nb * 32 + r) * 64 + mb * 32 + 8 * g + 4 * h) = o;
  }
}
DI void rw_addT(const char* Src, int mb, int nb, int lane, f32x16& v) {
  const int r = lane & 31, h = lane >> 5;
#pragma unroll
  for (int g = 0; g < 4; ++g) {
    const uint2 u = *(const uint2*)(Src + ((nb * 32 + r) * RW_LD + mb * 32 + 8 * g + 4 * h) * 2);
    v[4 * g] += bf2f((bf16_t)(u.x & 0xffff)); v[4 * g + 1] += bf2f((bf16_t)(u.x >> 16));
    v[4 * g + 2] += bf2f((bf16_t)(u.y & 0xffff)); v[4 * g + 3] += bf2f((bf16_t)(u.y >> 16));
  }
}
DI void rw_mask_upper(f32x16& v, int mb, int nb, int lane, bool strict) {
  const int col = nb * 32 + (lane & 31), h = lane >> 5;
#pragma unroll
  for (int i = 0; i < 16; ++i) { const int row = mb * 32 + crow(i, h); if (strict ? !(row < col) : !(row <= col)) v[i] = 0.f; }
}
DI void rw_mask_lower_strict(f32x16& v, int mb, int nb, int lane) {
  const int col = nb * 32 + (lane & 31), h = lane >> 5;
#pragma unroll
  for (int i = 0; i < 16; ++i) { const int row = mb * 32 + crow(i, h); if (!(col < row)) v[i] = 0.f; }
}

constexpr int RW1_ITEMS = NSEQ_ * NCH_;
DI void rw_chunk_item(const Params& p, int it, char* smem) {
  const int s = it / NCH_, c = it % NCH_, dir = s >> 3, b = (s >> 2) & 1, hd = s & 3;
  const int tid = opaque_tid(), lane = tid & 63, wid = tid >> 6;
  const bf16_t* rb = (const bf16_t*)(p.ws + OFF_REGION + R_RB16);
  const float* lwg = (const float*)(p.ws + OFF_REGION + R_LW) + (size_t)dir * NT_ * 256;
  const size_t AS = (size_t)NT_ * 256;
  char* const At = smem + 0 * RW_MB; char* const Bt_ = smem + 1 * RW_MB; char* const Kt = smem + 2 * RW_MB; char* const Rt = smem + 3 * RW_MB;
  char* const Aj = smem + 4 * RW_MB; char* const Bj = smem + 5 * RW_MB; char* const Kj = smem + 6 * RW_MB; char* const Vi = smem + 7 * RW_MB;
  char* const QA = smem + 8 * RW_MB; char* const QTA = smem + 9 * RW_MB; char* const GA = smem + 10 * RW_MB;
  char* const Mka = smem + 11 * RW_MB; char* const MbrT = smem + 12 * RW_MB; char* const MkrT = smem + 13 * RW_MB;
  char* const QB = At; char* const QTB = Bt_; char* const GB = Kt;
  float* const cs = (float*)(smem + 8 * RW_MB);
  float* const gC = (float*)(smem + 14 * RW_MB);
  char* rec = rw_rec(p, s, c);
  __syncthreads();
  const int t = tid >> 3, j8 = (tid & 7) * 8;
  const int n = seq_tok(dir, b, c * 64 + t);
  {
    const float4 l0 = *(const float4*)(lwg + (size_t)n * 256 + hd * 64 + j8), l1 = *(const float4*)(lwg + (size_t)n * 256 + hd * 64 + j8 + 4);
    float* d = cs + t * 65 + j8;
    d[0] = l0.x; d[1] = l0.y; d[2] = l0.z; d[3] = l0.w; d[4] = l1.x; d[5] = l1.y; d[6] = l1.z; d[7] = l1.w;
  }
  __syncthreads();
  if (tid < 64) { float a = 0.f; for (int tt = 0; tt < 64; ++tt) { a += cs[tt * 65 + tid]; cs[tt * 65 + tid] = a; } gC[tid] = fexp(a); }
  __syncthreads();
  {
    const size_t o = (size_t)n * 256 + hd * 64 + j8;
    const uint4 ukk = *(const uint4*)(rb + 2 * AS + o), ubb = *(const uint4*)(rb + (4 + 2 * dir) * AS + o), ukd = *(const uint4*)(rb + (3 + 2 * dir) * AS + o);
    const uint4 ur = *(const uint4*)(rb + 0 * AS + o), uv = *(const uint4*)(rb + 1 * AS + o);
    const unsigned akk[4] = {ukk.x, ukk.y, ukk.z, ukk.w}, abb[4] = {ubb.x, ubb.y, ubb.z, ubb.w}, akd[4] = {ukd.x, ukd.y, ukd.z, ukd.w};
    const unsigned ar[4] = {ur.x, ur.y, ur.z, ur.w}, av[4] = {uv.x, uv.y, uv.z, uv.w};
    unsigned oa[4], ob[4], ok[4], orr[4];
#pragma unroll
    for (int q = 0; q < 4; ++q) {
      float fa[2], fb[2], fk[2], fr[2];
#pragma unroll
      for (int e = 0; e < 2; ++e) {
        const int j = j8 + 2 * q + e;
        const float cst = cs[t * 65 + j], csp = t > 0 ? cs[(t - 1) * 65 + j] : 0.f;
        const float g = fexp(cst), gp = fexp(csp), gi = fexp(-cst);
        const int sh = 16 * e;
        fa[e] = -bf2f((bf16_t)((akk[q] >> sh) & 0xffff)) * gp;
        fb[e] = bf2f((bf16_t)((abb[q] >> sh) & 0xffff)) * gi;
        fk[e] = bf2f((bf16_t)((akd[q] >> sh) & 0xffff)) * gi;
        fr[e] = bf2f((bf16_t)((ar[q] >> sh) & 0xffff)) * g;
        *(bf16_t*)(Aj + (j * RW_LD + t) * 2) = f2bf(fa[e]);
        *(bf16_t*)(Bj + (j * RW_LD + t) * 2) = f2bf(fb[e]);
        *(bf16_t*)(Kj + (j * RW_LD + t) * 2) = f2bf(fk[e]);
        *(bf16_t*)(Vi + (j * RW_LD + t) * 2) = (bf16_t)((av[q] >> sh) & 0xffff);
      }
      oa[q] = pack2bf(fa[0], fa[1]); ob[q] = pack2bf(fb[0], fb[1]); ok[q] = pack2bf(fk[0], fk[1]); orr[q] = pack2bf(fr[0], fr[1]);
    }
    *(uint4*)(At + (t * RW_LD + j8) * 2) = make_uint4(oa[0], oa[1], oa[2], oa[3]);
    *(uint4*)(Bt_ + (t * RW_LD + j8) * 2) = make_uint4(ob[0], ob[1], ob[2], ob[3]);
    *(uint4*)(Kt + (t * RW_LD + j8) * 2) = make_uint4(ok[0], ok[1], ok[2], ok[3]);
    *(uint4*)(Rt + (t * RW_LD + j8) * 2) = make_uint4(orr[0], orr[1], orr[2], orr[3]);
  }
  __syncthreads();
  {
    const int prod = wid >> 2, mb = (wid >> 1) & 1, nb = wid & 1;
    f32x16 acc = zero16();
    if (prod == 0) {
      if (!(mb == 1 && nb == 0)) acc = rw_mm(Bt_, At, mb, nb, lane, acc);
      rw_mask_upper(acc, mb, nb, lane, true);
      rw_wrT(QA, mb, nb, lane, acc);
      if (mb == nb) {
        const int col = nb * 32 + (lane & 31), h = lane >> 5;
#pragma unroll
        for (int i = 0; i < 16; ++i) if (mb * 32 + crow(i, h) == col) acc[i] += 1.f;
      }
      rw_wrT(GA, mb, nb, lane, acc);
    } else {
      if (!(mb == 0 && nb == 1)) acc = rw_mm(At, Bt_, mb, nb, lane, acc);
      rw_mask_lower_strict(acc, mb, nb, lane);
      rw_wrT(QTA, mb, nb, lane, acc);
    }
  }
  for (int blk = wid; blk < 12; blk += 8) {
    const int prod = blk >> 2, mb = (blk >> 1) & 1, nb = blk & 1;
    f32x16 acc = zero16();
    if (prod == 0) {
      acc = rw_mm(At, Kt, mb, nb, lane, acc); rw_mask_lower_strict(acc, mb, nb, lane); rw_wrT(Mka, mb, nb, lane, acc);
    } else if (prod == 1) {
      acc = rw_mm(Bt_, Rt, mb, nb, lane, acc); rw_mask_upper(acc, mb, nb, lane, false); rw_wrT(MbrT, mb, nb, lane, acc);
    } else {
      acc = rw_mm(Kt, Rt, mb, nb, lane, acc); rw_mask_upper(acc, mb, nb, lane, false); rw_wrT(MkrT, mb, nb, lane, acc);
    }
  }
  __syncthreads();
#define RW_SQ(Q_, Qt_, Qn_, Qtn_, blk) { const int pr_ = (blk) >> 2, mb_ = ((blk) >> 1) & 1, nb_ = (blk) & 1; f32x16 acc_ = zero16(); \
    if (pr_ == 0) { acc_ = rw_mm(Q_, Qt_, mb_, nb_, lane, acc_); rw_wrT(Qtn_, mb_, nb_, lane, acc_); } \
    else { acc_ = rw_mm(Qt_, Q_, mb_, nb_, lane, acc_); rw_wrT(Qn_, mb_, nb_, lane, acc_); } }
#define RW_GUP(Qt_, G_, Gn_, blk) { const int mb_ = ((blk) >> 1) & 1, nb_ = (blk) & 1; f32x16 acc_ = zero16(); \
    rw_addT(G_, mb_, nb_, lane, acc_); acc_ = rw_mm(Qt_, G_, mb_, nb_, lane, acc_); rw_wrT(Gn_, mb_, nb_, lane, acc_); }
  RW_SQ(QA, QTA, QB, QTB, wid);
  __syncthreads();
  for (int blk = wid; blk < 12; blk += 8) { if (blk < 8) { RW_SQ(QB, QTB, QA, QTA, blk); } else { RW_GUP(QTB, GA, GB, blk - 8); } }
  __syncthreads();
  for (int blk = wid; blk < 12; blk += 8) { if (blk < 8) { RW_SQ(QA, QTA, QB, QTB, blk); } else { RW_GUP(QTA, GB, GA, blk - 8); } }
  __syncthreads();
  for (int blk = wid; blk < 12; blk += 8) { if (blk < 8) { RW_SQ(QB, QTB, QA, QTA, blk); } else { RW_GUP(QTB, GA, GB, blk - 8); } }
  __syncthreads();
  for (int blk = wid; blk < 12; blk += 8) { if (blk < 8) { RW_SQ(QA, QTA, QB, QTB, blk); } else { RW_GUP(QTA, GB, GA, blk - 8); } }
  __syncthreads();
  if (wid < 4) { RW_GUP(QTB, GA, GB, wid); }
  __syncthreads();
  {
    const int prod = wid >> 2, mb = (wid >> 1) & 1, nb = wid & 1;
    f32x16 acc = zero16();
    acc = rw_mm(GB, prod == 0 ? Mka : Aj, mb, nb, lane, acc);
    rw_wrT(prod == 0 ? QA : QTA, mb, nb, lane, acc);
  }
  __syncthreads();
  char* const X1 = QA; char* const X2 = QTA; char* const QpT = At;
  for (int blk = wid; blk < 16; blk += 8) {
    const int prod = blk >> 2, mb = (blk >> 1) & 1, nb = blk & 1;
    f32x16 acc = zero16();
    if (prod == 0) {
      rw_addT(MkrT, mb, nb, lane, acc); acc = rw_mm(X1, MbrT, mb, nb, lane, acc); rw_mask_upper(acc, mb, nb, lane, false);
      rw_wrT_g((bf16_t*)(rec + 8192), mb, nb, lane, acc);
    } else if (prod == 1) {
      rw_addT(Rt, mb, nb, lane, acc); acc = rw_mm(X2, MbrT, mb, nb, lane, acc);
      rw_wrT_g((bf16_t*)(rec), mb, nb, lane, acc);
    } else if (prod == 2) {
      acc = rw_mm(X2, Bj, mb, nb, lane, acc);
      const int col = nb * 32 + (lane & 31), h = lane >> 5; const float gc = gC[col];
#pragma unroll
      for (int i = 0; i < 16; ++i) { if (mb * 32 + crow(i, h) == col) acc[i] += 1.f; acc[i] *= gc; }
      rw_wrT_g((bf16_t*)(rec + 16384), mb, nb, lane, acc);
    } else {
      rw_addT(Kj, mb, nb, lane, acc); acc = rw_mm(X1, Bj, mb, nb, lane, acc);
      const float gc = gC[nb * 32 + (lane & 31)];
#pragma unroll
      for (int i = 0; i < 16; ++i) acc[i] *= gc;
      rw_wrT(QpT, mb, nb, lane, acc);
    }
  }
  __syncthreads();
  if (wid < 4) {
    const int mb = (wid >> 1) & 1, nb = wid & 1, r = lane & 31, h = lane >> 5;
    f32x16 acc = zero16();
    acc = rw_mm(QpT, Vi, mb, nb, lane, acc);
    float* dq = (float*)(rec + 24576);
#pragma unroll
    for (int g = 0; g < 4; ++g)
      *(float4*)(dq + (nb * 32 + r) * 64 + mb * 32 + 8 * g + 4 * h) = make_float4(acc[4 * g], acc[4 * g + 1], acc[4 * g + 2], acc[4 * g + 3]);
  }
}

constexpr int RW2_ITEMS = NSEQ_;
constexpr int RW2_DQLD = 68;
constexpr int RW2_STAGE = RW_MB + 64 * RW2_DQLD * 4;
constexpr int RW2_GRP = 2;
static_assert(NCH_ % RW2_GRP == 0, "chunk groups");
DI void rw_state_item(const Params& p, int s, char* smem) {
  const int tid = opaque_tid(), lane = tid & 63, wid = tid >> 6, r = lane & 31, h = lane >> 5;
  f32x16 S0 = zero16(), S1 = zero16();
  u32x4 rp[RW2_GRP], rd0[RW2_GRP], rd1[RW2_GRP];
  const int prow = tid >> 3, pcol = (tid & 7) * 8;
#define RW2_LOAD(g_) { _Pragma("unroll") for (int u = 0; u < RW2_GRP; ++u) { const char* rec_ = rw_rec(p, s, (g_) * RW2_GRP + u); \
    rp[u] = *(const u32x4*)(rec_ + 16384 + (prow * 64 + pcol) * 2); \
    rd0[u] = *(const u32x4*)(rec_ + 24576 + (prow * 64 + pcol) * 4); rd1[u] = *(const u32x4*)(rec_ + 24576 + (prow * 64 + pcol + 4) * 4); } }
#define RW2_STORE(buf_) { _Pragma("unroll") for (int u = 0; u < RW2_GRP; ++u) { char* d_ = smem + ((buf_) * RW2_GRP + u) * RW2_STAGE; \
    *(u32x4*)(d_ + (prow * RW_LD + pcol) * 2) = rp[u]; \
    *(u32x4*)(d_ + RW_MB + (prow * RW2_DQLD + pcol) * 4) = rd0[u]; *(u32x4*)(d_ + RW_MB + (prow * RW2_DQLD + pcol + 4) * 4) = rd1[u]; } }
  __syncthreads();
  RW2_LOAD(0); RW2_STORE(0);
  __syncthreads();
  constexpr int NG = NCH_ / RW2_GRP;
  for (int g = 0; g < NG; ++g) {
    { const int gn = g + 1 < NG ? g + 1 : g; RW2_LOAD(gn); }
    sched_fence();
    if (wid < 2) {
#pragma unroll
      for (int u = 0; u < RW2_GRP; ++u) {
        const int c = g * RW2_GRP + u;
        const char* PT = smem + ((g & 1) * RW2_GRP + u) * RW2_STAGE;
        const float* DQ = (const float*)(PT + RW_MB);
        const int i = wid * 32 + r;
        bf16_t* sd = (bf16_t*)(rw_rec(p, s, c) + 16384);
#pragma unroll
        for (int q = 0; q < 4; ++q) {
          uint2 o0, o1;
          o0.x = pack2bf(S0[4 * q], S0[4 * q + 1]); o0.y = pack2bf(S0[4 * q + 2], S0[4 * q + 3]);
          o1.x = pack2bf(S1[4 * q], S1[4 * q + 1]); o1.y = pack2bf(S1[4 * q + 2], S1[4 * q + 3]);
          *(uint2*)(sd + i * 64 + 8 * q + 4 * h) = o0; *(uint2*)(sd + i * 64 + 32 + 8 * q + 4 * h) = o1;
        }
        bf16x8 bfr[2][2];
#pragma unroll
        for (int s2 = 0; s2 < 2; ++s2) {
          const u32x4 u0 = {pack2bf(S0[8 * s2], S0[8 * s2 + 1]), pack2bf(S0[8 * s2 + 2], S0[8 * s2 + 3]), pack2bf(S0[8 * s2 + 4], S0[8 * s2 + 5]), pack2bf(S0[8 * s2 + 6], S0[8 * s2 + 7])};
          const u32x4 u1 = {pack2bf(S1[8 * s2], S1[8 * s2 + 1]), pack2bf(S1[8 * s2 + 2], S1[8 * s2 + 3]), pack2bf(S1[8 * s2 + 4], S1[8 * s2 + 5]), pack2bf(S1[8 * s2 + 6], S1[8 * s2 + 7])};
          __builtin_memcpy(&bfr[0][s2], &u0, 16); __builtin_memcpy(&bfr[1][s2], &u1, 16);
        }
        f32x16 n0, n1;
#pragma unroll
        for (int q = 0; q < 4; ++q) {
          const float4 a = *(const float4*)(DQ + i * RW2_DQLD + 8 * q + 4 * h), bq = *(const float4*)(DQ + i * RW2_DQLD + 32 + 8 * q + 4 * h);
          n0[4 * q] = a.x; n0[4 * q + 1] = a.y; n0[4 * q + 2] = a.z; n0[4 * q + 3] = a.w;
          n1[4 * q] = bq.x; n1[4 * q + 1] = bq.y; n1[4 * q + 2] = bq.z; n1[4 * q + 3] = bq.w;
        }
#pragma unroll
        for (int jb2 = 0; jb2 < 2; ++jb2)
#pragma unroll
          for (int s2 = 0; s2 < 2; ++s2) {
            const char* a0 = PT + ((0 * 32 + r) * RW_LD + jb2 * 32 + 16 * s2 + 4 * h) * 2;
            const char* a1 = PT + ((1 * 32 + r) * RW_LD + jb2 * 32 + 16 * s2 + 4 * h) * 2;
            const uint2 l0 = *(const uint2*)a0, h0 = *(const uint2*)(a0 + 16), l1 = *(const uint2*)a1, h1 = *(const uint2*)(a1 + 16);
            const u32x4 u0 = {l0.x, l0.y, h0.x, h0.y}, u1 = {l1.x, l1.y, h1.x, h1.y};
            bf16x8 af0, af1; __builtin_memcpy(&af0, &u0, 16); __builtin_memcpy(&af1, &u1, 16);
            n0 = mfma32(af0, bfr[jb2][s2], n0);
            n1 = mfma32(af1, bfr[jb2][s2], n1);
          }
        S0 = n0; S1 = n1;
      }
    }
    sched_fence();
    RW2_STORE((g + 1) & 1);
    __syncthreads();
  }
}

DI void rw_out_item(const Params& p, int it, char* smem) {
  const int s = it / NCH_, c = it % NCH_, dir = s >> 3, b = (s >> 2) & 1, hd = s & 3;
  const int tid = opaque_tid(), lane = tid & 63, wid = tid >> 6;
  const bf16_t* rb = (const bf16_t*)(p.ws + OFF_REGION + R_RB16);
  const size_t AS = (size_t)NT_ * 256;
  float* ys = (float*)(p.ws + OFF_REGION + R_YS) + (size_t)dir * NT_ * 256;
  char* const Sm = smem; char* const RyT = smem + RW_MB; char* const MyT = smem + 2 * RW_MB; char* const Vi = smem + 3 * RW_MB;
  const char* rec = rw_rec(p, s, c);
  __syncthreads();
  {
    const int row = tid >> 3, col = (tid & 7) * 8;
    *(uint4*)(Sm + (row * RW_LD + col) * 2) = *(const uint4*)(rec + 16384 + (row * 64 + col) * 2);
    *(uint4*)(RyT + (row * RW_LD + col) * 2) = *(const uint4*)(rec + (row * 64 + col) * 2);
    *(uint4*)(MyT + (row * RW_LD + col) * 2) = *(const uint4*)(rec + 8192 + (row * 64 + col) * 2);
    const int n = seq_tok(dir, b, c * 64 + row);
    const uint4 uv = *(const uint4*)(rb + 1 * AS + (size_t)n * 256 + hd * 64 + col);
    const unsigned av[4] = {uv.x, uv.y, uv.z, uv.w};
#pragma unroll
    for (int q = 0; q < 4; ++q) {
      *(bf16_t*)(Vi + ((col + 2 * q) * RW_LD + row) * 2) = (bf16_t)(av[q] & 0xffff);
      *(bf16_t*)(Vi + ((col + 2 * q + 1) * RW_LD + row) * 2) = (bf16_t)(av[q] >> 16);
    }
  }
  __syncthreads();
  if (wid < 4) {
    const int mb = (wid >> 1) & 1, nb = wid & 1, r = lane & 31, h = lane >> 5;
    f32x16 acc = zero16();
    acc = rw_mm(Sm, RyT, mb, nb, lane, acc);
    acc = rw_mm(Vi, MyT, mb, nb, lane, acc);
    const int n = seq_tok(dir, b, c * 64 + nb * 32 + r);
#pragma unroll
    for (int g = 0; g < 4; ++g)
      *(float4*)(ys + (size_t)n * 256 + hd * 64 + mb * 32 + 8 * g + 4 * h) = make_float4(acc[4 * g], acc[4 * g + 1], acc[4 * g + 2], acc[4 * g + 3]);
  }
}
constexpr int ATT_KLD = 104, ATT_VLD = 68;
constexpr int ATT_KB = 64 * ATT_KLD * 2, ATT_VB = 64 * ATT_VLD * 2, ATT_STAGE = ATT_KB + ATT_VB;
DI float fexp2(float x) {
#ifdef EMU
  return exp2f(x);
#else
  return __builtin_amdgcn_exp2f(x);
#endif
}
#ifdef ABL_NOPV
#define ABL_PV_BEGIN if (t > 100000) {
#define ABL_PV_END }
#else
#define ABL_PV_BEGIN
#define ABL_PV_END
#endif
#ifdef ABL_NOLOAD
#define ABL_LOADS(tk, tv)
#else
#define ABL_LOADS(tk, tv) ATT_LOADK(tk); ATT_LOADV(tv);
#endif
#ifdef ABL_NOEXP
#define ABL_EXP(x) (x)
#else
#define ABL_EXP(x) fexp2(x)
#endif
constexpr int ATT_LDS = 2 * ATT_KB + 2 * ATT_VB;
DI void attn_item(const Params& p, int b, int h, int qt, bool isctx, char* smem) {
  const int tid = opaque_tid(), lane = tid & 63, wid = tid >> 6, r = lane & 31, h2 = lane >> 5;
  const bf16_t* qb = (const bf16_t*)(p.osc + O_QB);
  const bf16_t* kbase = (const bf16_t*)(p.ws + OFF_REGION + R_KB) + (size_t)(b * 8 + h) * KT_ * 96;
  const bf16_t* vbase = (const bf16_t*)(p.ws + OFF_REGION + R_VT) + (size_t)(b * 8 + h) * 64 * KT_;
  bf16_t* att = (bf16_t*)(p.ws + OFF_REGION + R_ATT);
  const int nq0 = isctx ? NX_ + b * CL_ + qt * 256 : b * T_ + qt * 256;
  const int nkt = (isctx ? CL_ : KT_) / 64;
  const int nq = nq0 + wid * 32 + r;
  bf16x8 qf[6];
#pragma unroll
  for (int ks = 0; ks < 6; ++ks) qf[ks] = *(const bf16x8*)(qb + (size_t)nq * 768 + h * 96 + ks * 16 + h2 * 8);
  f32x16 oacc[2] = {zero16(), zero16()};
  float m = -1e30f, lsum = 0.f;
  const float sc = 0.10206207261596577f * 1.4426950408889634f;
  char* const Kst = smem;
  char* const Vst = smem + 2 * ATT_KB;
  const int kc1 = tid + 512, vd = tid >> 3, vc = tid & 7;
  const int ko0 = ((tid / 12) * ATT_KLD + (tid % 12) * 8) * 2, ko1 = ((kc1 / 12) * ATT_KLD + (kc1 % 12) * 8) * 2;
  const int vo = (vd * ATT_VLD + vc * 8) * 2;
  u32x4 rk0, rk1 = {0u, 0u, 0u, 0u}, rv;
#define ATT_LOADK(kt_) { const bf16_t* ksrc_ = kbase + (size_t)(kt_) * 64 * 96; rk0 = *(const u32x4*)(ksrc_ + tid * 8); if (kc1 < 768) rk1 = *(const u32x4*)(ksrc_ + kc1 * 8); }
#define ATT_LOADV(kt_) { rv = *(const u32x4*)(vbase + (size_t)vd * KT_ + (kt_) * 64 + vc * 8); }
#define ATT_STOREK(st_) { char* d_ = Kst + (st_) * ATT_KB; *(u32x4*)(d_ + ko0) = rk0; if (kc1 < 768) *(u32x4*)(d_ + ko1) = rk1; }
#define ATT_STOREV(st_) { char* d_ = Vst + (st_) * ATT_VB; *(uint2*)(d_ + vo) = make_uint2(rv[0], rv[1]); *(uint2*)(d_ + vo + 8) = make_uint2(rv[2], rv[3]); }
#define ATT_QK(dst_, st_) { const char* Ks_ = Kst + (st_) * ATT_KB; dst_[0] = zero16(); dst_[1] = zero16(); \
    _Pragma("unroll") for (int ks = 0; ks < 6; ++ks) _Pragma("unroll") for (int kb = 0; kb < 2; ++kb) { \
      const bf16x8 kf_ = *(const bf16x8*)(Ks_ + ((kb * 32 + r) * ATT_KLD + ks * 16 + h2 * 8) * 2); dst_[kb] = mfma32(kf_, qf[ks], dst_[kb]); } }
  __syncthreads();
  ATT_LOADK(0); ATT_LOADV(0); ATT_STOREK(0); ATT_STOREV(0);
  ATT_LOADK(1); ATT_STOREK(1);
  __syncthreads();
  f32x16 sA[2], sB[2];
  ATT_QK(sA, 0);
#define ATT_SMPV(cur_, t) { \
    float mx = -1e30f; \
    _Pragma("unroll") for (int kb = 0; kb < 2; ++kb) _Pragma("unroll") for (int i = 0; i < 16; ++i) mx = fmaxf(mx, cur_[kb][i]); \
    mx = fmaxf(mx, __shfl_xor(mx, 32)); \
    const float mn = fmaxf(m, mx * sc); \
    if (__ballot(mn > m) != 0ull) { \
      const float alpha = fexp2(m - mn); \
      _Pragma("unroll") for (int db = 0; db < 2; ++db) _Pragma("unroll") for (int i = 0; i < 16; ++i) oacc[db][i] *= alpha; \
      lsum *= alpha; m = mn; } \
    _Pragma("unroll") for (int kb = 0; kb < 2; ++kb) _Pragma("unroll") for (int i = 0; i < 16; ++i) cur_[kb][i] = ABL_EXP(cur_[kb][i] * sc - m); \
    { float ps0 = 0.f, ps1 = 0.f; _Pragma("unroll") for (int i = 0; i < 16; ++i) { ps0 += cur_[0][i]; ps1 += cur_[1][i]; } lsum += ps0 + ps1; } \
    const char* Vs = Vst + ((t) & 1) * ATT_VB; \
    _Pragma("unroll") for (int kb = 0; kb < 2; ++kb) _Pragma("unroll") for (int s2 = 0; s2 < 2; ++s2) { \
      bf16x8 pf; { const u32x4 u = {pack2bf(cur_[kb][8 * s2 + 0], cur_[kb][8 * s2 + 1]), pack2bf(cur_[kb][8 * s2 + 2], cur_[kb][8 * s2 + 3]), \
                                    pack2bf(cur_[kb][8 * s2 + 4], cur_[kb][8 * s2 + 5]), pack2bf(cur_[kb][8 * s2 + 6], cur_[kb][8 * s2 + 7])}; __builtin_memcpy(&pf, &u, 16); } \
      ABL_PV_BEGIN \
      _Pragma("unroll") for (int db = 0; db < 2; ++db) { \
        const char* vrow = Vs + ((db * 32 + r) * ATT_VLD + kb * 32 + 16 * s2 + 4 * h2) * 2; \
        const uint2 lo = *(const uint2*)(vrow), hi = *(const uint2*)(vrow + 16); \
        const u32x4 u = {lo.x, lo.y, hi.x, hi.y}; bf16x8 vf; __builtin_memcpy(&vf, &u, 16); \
        oacc[db] = mfma32(vf, pf, oacc[db]); } ABL_PV_END } }
#define ATT_STEP(cur_, nxt_, t_) { \
    const int t = (t_); \
    const int tk = t + 2 < nkt ? t + 2 : nkt - 1, tv = t + 1 < nkt ? t + 1 : nkt - 1; \
    ABL_LOADS(tk, tv) \
    sched_fence(); \
    if (first_half) { ATT_QK(nxt_, (t + 1) & 1); sched_fence(); ATT_SMPV(cur_, t); } \
    else { ATT_SMPV(cur_, t); sched_fence(); ATT_QK(nxt_, (t + 1) & 1); } \
    sched_fence(); \
    ATT_STOREK(t & 1); ATT_STOREV((t + 1) & 1); \
    __syncthreads(); }
  const bool first_half = rfl(wid) < 4;
  for (int t0 = 0; t0 < nkt; t0 += 2) {
    ATT_STEP(sA, sB, t0);
    ATT_STEP(sB, sA, t0 + 1);
  }
  lsum += __shfl_xor(lsum, 32);
  const float inv = 1.f / lsum;
#pragma unroll
  for (int db = 0; db < 2; ++db)
#pragma unroll
    for (int g = 0; g < 4; ++g) {
      uint2 o;
      o.x = pack2bf(oacc[db][g * 4 + 0] * inv, oacc[db][g * 4 + 1] * inv);
      o.y = pack2bf(oacc[db][g * 4 + 2] * inv, oacc[db][g * 4 + 3] * inv);
      *(uint2*)(att + (size_t)nq * 512 + h * 64 + db * 32 + 8 * g + 4 * h2) = o;
    }
}

constexpr int P3B_ITEMS = RW1_ITEMS + ML2_ITEMS + MLA_Q_TILES + MLA_KV_TILES;
DI void phase3b(const Params& p, int l, char* smem) {
  for (int it = vblock(); it < P3B_ITEMS; it += gridDim.x) {
    int i = it;
    if (i < RW1_ITEMS) { TSB(p, 58); rw_chunk_item(p, i, smem); TSB(p, 59); continue; }
    i -= RW1_ITEMS;
    if (i < ML2_ITEMS) { mlstm_scan_item(p, i); continue; }
    i -= ML2_ITEMS;
    TSB(p, 60);
    if (i < MLA_Q_TILES) mla_q_item(p, l, i, smem); else mla_kv_item(p, l, i - MLA_Q_TILES, smem);
    TSB(p, 61);
  }
}

DI constexpr int att_items(int l) { return NB_ * 8 * (T_ / 256) + (l == 0 ? NB_ * 8 * (CL_ / 256) : 0); }
DI void spin_until_ge(int* ctr, int target) {
#ifdef EMU
  while (__atomic_load_n(ctr, __ATOMIC_SEQ_CST) < target) emu::yield();
#else
  while (__hip_atomic_load(ctr, __ATOMIC_RELAXED, __HIP_MEMORY_SCOPE_AGENT) < target) __builtin_amdgcn_s_sleep(8);
#endif
}
DI void phase4(const Params& p, int l, char* smem, int* ctr) {
  const int G = gridDim.x, nsb = G >= 2 * RW2_ITEMS ? RW2_ITEMS : (G > 1 ? G / 2 : 1);
  TSB(p, 50);
  if ((int)blockIdx.x < nsb) {
    for (int s = blockIdx.x; s < RW2_ITEMS; s += nsb) rw_state_item(p, s, smem);
#ifndef EMU
    asm volatile("s_waitcnt vmcnt(0)" ::: "memory");
#endif
    __syncthreads();
    if (opaque_tid() == 0) { __threadfence(); atomicAdd(ctr + 2, (RW2_ITEMS - (int)blockIdx.x + nsb - 1) / nsb); }
    TSB(p, 51);
  }
  const int QT = T_ / 256, CQ = (l == 0 ? (NB_ * 8 * (CL_ / 256)) / 8 : 0), R3 = RW1_ITEMS / 8;
  const int per = 2 * QT + CQ + R3;
  int* sitem = (int*)(smem + 160 * 1024 - 16);
  bool r2ok = false;
  const int x0 = xcc_id();
  for (;;) {
    __syncthreads();
    if (opaque_tid() == 0) {
      int item = -1;
      for (int k = 0; k < 8 && item < 0; ++k) {
        const int x = (x0 + k) & 7;
        if (ld_relaxed(ctr + 8 + x) >= per) continue;
        const int li = atomicAdd(ctr + 8 + x, 1);
        if (li < per) item = x * per + li;
      }
      *sitem = item;
    }
    __syncthreads();
    const int item = *sitem;
    if (item < 0) break;
    const int x = item / per; int li = item % per;
    if (li < 2 * QT) { const int bh = 2 * x + li / QT, qt = li % QT; TSB(p, 54); attn_item(p, bh >> 3, bh & 7, qt, false, smem); TSB(p, 55); continue; }
    li -= 2 * QT;
    if (li < CQ) { const int ci = x * CQ + li, qt = ci % (CL_ / 256), bh = ci / (CL_ / 256); attn_item(p, bh >> 3, bh & 7, qt, true, smem); continue; }
    li -= CQ;
    if (!r2ok) {
      if (opaque_tid() == 0) { spin_until_ge(ctr + 2, RW2_ITEMS); __threadfence(); }
      __syncthreads();
      r2ok = true;
      TSB(p, 52);
    }
    rw_out_item(p, x * R3 + li, smem);
  }
  TSB(p, 53);
}
constexpr int ML3_CC = CL_ / 64, ML3_XC = T_ / 64;
DI constexpr int ml3_items(bool with_ctx) { return NB_ * 4 * (ML3_XC + (with_ctx ? ML3_CC : 0)); }
template <int KS> DI f32x16 ml_mm(const char* A, const char* Bt, int mb, int nb, int lane, f32x16 acc) {
  const int r = lane & 31, h = lane >> 5;
#pragma unroll
  for (int ks = 0; ks < KS; ++ks) {
    const bf16x8 a = *(const bf16x8*)(A + ((mb * 32 + r) * RW_LD + ks * 16 + h * 8) * 2);
    const bf16x8 b = *(const bf16x8*)(Bt + ((nb * 32 + r) * RW_LD + ks * 16 + h * 8) * 2);
    acc = mfma32(a, b, acc);
  }
  return acc;
}
DI float wave_incl_scan_max(float v, int lane) {
  for (int d = 1; d < 64; d <<= 1) { const float o = __shfl_up(v, d); if (lane >= d) v = fmaxf(v, o); }
  return v;
}
DI void mlstm_out_item(const Params& p, int l, int it, bool with_ctx, char* smem) {
  const int per = ML3_XC + (with_ctx ? ML3_CC : 0);
  const int bh = it / per, b = bh >> 2, hd = bh & 3;
  int tc = it % per; if (!with_ctx) tc += ML3_CC;
  const bool isctx = tc < ML3_CC;
  const int ntok0 = isctx ? NX_ + b * CL_ + tc * 64 : b * T_ + (tc - ML3_CC) * 64;
  char* const Qm = smem;
  char* const Km = smem + 1 * RW_MB;
  char* const Qp = smem + 2 * RW_MB;
  char* const Vi = smem + 3 * RW_MB;
  char* const Pp = smem + 4 * RW_MB;
  char* const Cm = smem + 5 * RW_MB;
  float* const hs = (float*)(smem + 6 * RW_MB);
  float* const ga = hs + 64 * 64;
  float* const denp = ga + 5 * 64;
  float* const nsv = denp + 128;
  const float* zrec = (const float*)(p.ws + OFF_REGION + R_ZREC);
  const int tid = opaque_tid(), lane = tid & 63, wid = tid >> 6;
  __syncthreads();
  for (int idx = tid; idx < 64 * 64; idx += NTHR) hs[idx] = 0.f;
#pragma unroll 1
  for (int dir = 0; dir < 2; ++dir) {
    const int c = dir == 0 ? tc : (isctx ? ML3_CC - 1 - tc : ML3_CC + (ML3_XC - 1 - (tc - ML3_CC)));
    const int s = dir * 8 + b * 4 + hd;
    const float* st = (const float*)(p.ws + OFF_REGION + R_MLST) + ((size_t)s * NCH_ + c) * ML_ST;
    const float m_start = st[2082];
    __syncthreads();
    {
      const int j = tid >> 3, pt = tid & 7;
      const int n = ntok0 + (dir ? 63 - j : j);
      const float* zr = zrec + (size_t)n * ZREC_W;
      const float4 q4 = *(const float4*)(zr + ZR_MLQ + hd * 32 + pt * 4), k4 = *(const float4*)(zr + ZR_MLK + hd * 32 + pt * 4);
      const float4 c4 = *(const float4*)(st + j * 32 + pt * 4);
      const float4 va = *(const float4*)(zr + ZR_MLV + hd * 64 + pt * 8), vb = *(const float4*)(zr + ZR_MLV + hd * 64 + pt * 8 + 4);
      const float qs = 0.17677669529663687f;
      const float q0 = q4.x * qs, q1 = q4.y * qs, q2 = q4.z * qs, q3 = q4.w * qs;
      *(uint2*)(Qm + (j * RW_LD + pt * 4) * 2) = make_uint2(pack2bf(q0, q1), pack2bf(q2, q3));
      *(uint2*)(Km + (j * RW_LD + pt * 4) * 2) = make_uint2(pack2bf(k4.x, k4.y), pack2bf(k4.z, k4.w));
      *(uint2*)(Cm + (j * RW_LD + pt * 4) * 2) = make_uint2(pack2bf(c4.x, c4.y), pack2bf(c4.z, c4.w));
      const float vv[8] = {va.x, va.y, va.z, va.w, vb.x, vb.y, vb.z, vb.w};
#pragma unroll
      for (int u = 0; u < 8; ++u) *(bf16_t*)(Vi + ((pt * 8 + u) * RW_LD + j) * 2) = f2bf(vv[u]);
      if (tid < 32) nsv[tid] = st[2048 + tid];
      const float4 n4 = *(const float4*)(st + 2048 + pt * 4);
      float nq = n4.x * q0 + n4.y * q1 + n4.z * q2 + n4.w * q3;
      nq += __shfl_xor(nq, 1); nq += __shfl_xor(nq, 2); nq += __shfl_xor(nq, 4);
      if (pt == 0) ga[4 * 64 + j] = nq;
    }
    if (wid == 0) {
      const int n = ntok0 + (dir ? 63 - lane : lane);
      const float fp = zrec[(size_t)n * ZREC_W + ZR_MLF + dir * 4 + hd] + p.ml_b_f[(l * 2 + dir) * 4 + hd];
      const float ipre = zrec[(size_t)n * ZREC_W + ZR_MLI + dir * 4 + hd] + p.ml_b_i[(l * 2 + dir) * 4 + hd];
      const float bj = wave_incl_scan(logsigmoidf_(fp), lane);
      const float g = ipre - bj;
      const float pm = wave_incl_scan_max(g, lane);
      const float c0 = wave_max(g);
      const float mj = fmaxf(bj + m_start, bj + pm);
      ga[0 * 64 + lane] = fexp(g - c0);
      ga[1 * 64 + lane] = fexp(fminf(bj + c0 - mj, 80.f));
      ga[2 * 64 + lane] = fexp(bj + m_start - mj);
      ga[3 * 64 + lane] = fexp(fminf(-mj, 80.f));
    }
    __syncthreads();
    if (wid < 4) {
      const int mb = wid >> 1, nb = wid & 1, r = lane & 31, h = lane >> 5;
      f32x16 acc = zero16();
      if (!(mb == 1 && nb == 0)) acc = ml_mm<2>(Km, Qm, mb, nb, lane, acc);
      rw_mask_upper(acc, mb, nb, lane, false);
      const float al = ga[1 * 64 + nb * 32 + r];
      float csum = 0.f;
#pragma unroll
      for (int i = 0; i < 16; ++i) { acc[i] *= ga[0 * 64 + mb * 32 + crow(i, h)] * al; csum += acc[i]; }
      csum += __shfl_xor(csum, 32);
      if (h == 0) denp[mb * 64 + nb * 32 + r] = csum;
      rw_wrT(Pp, mb, nb, lane, acc);
    } else {
      const int t2 = tid - 256, j = t2 >> 2, d8 = (t2 & 3) * 8;
      const float in = ga[2 * 64 + j];
      const uint4 u = *(const uint4*)(Qm + (j * RW_LD + d8) * 2);
      const unsigned w[4] = {u.x, u.y, u.z, u.w};
      unsigned o[4];
#pragma unroll
      for (int q = 0; q < 4; ++q) o[q] = pack2bf(bf2f((bf16_t)(w[q] & 0xffff)) * in, bf2f((bf16_t)(w[q] >> 16)) * in);
      *(uint4*)(Qp + (j * RW_LD + d8) * 2) = make_uint4(o[0], o[1], o[2], o[3]);
    }
    __syncthreads();
    if (wid < 4) {
      const int mb = wid >> 1, nb = wid & 1, r = lane & 31, h = lane >> 5;
      f32x16 acc = zero16();
      acc = ml_mm<4>(Vi, Pp, mb, nb, lane, acc);
      acc = ml_mm<2>(Cm, Qp, mb, nb, lane, acc);
      const int j = nb * 32 + r;
      const float den = denp[j] + denp[64 + j] + ga[2 * 64 + j] * ga[4 * 64 + j];
      const float rden = frcp(fmaxf(fabsf(den), ga[3 * 64 + j]));
      float* hrow = hs + (dir ? 63 - j : j) * 64 + mb * 32 + 4 * h;
#pragma unroll
      for (int g4 = 0; g4 < 4; ++g4) {
        float4 o = *(float4*)(hrow + 8 * g4);
        o.x += acc[4 * g4] * rden; o.y += acc[4 * g4 + 1] * rden; o.z += acc[4 * g4 + 2] * rden; o.w += acc[4 * g4 + 3] * rden;
        *(float4*)(hrow + 8 * g4) = o;
      }
    }
  }
  __syncthreads();
  const int tk = tid >> 3, v0 = (tid & 7) * 8, n = ntok0 + tk;
  float ss = 0.f; float hv[8];
#pragma unroll
  for (int u = 0; u < 8; ++u) { hv[u] = hs[tk * 64 + v0 + u]; ss += hv[u] * hv[u]; }
  ss += __shfl_xor(ss, 1); ss += __shfl_xor(ss, 2); ss += __shfl_xor(ss, 4);
  const float rs = frsq(ss * (1.f / 64.f) + 1e-6f);
  unsigned o[4];
#pragma unroll
  for (int u = 0; u < 8; u += 2) {
    const int cc = hd * 64 + v0 + u;
    const float a = hv[u] * rs * p.ml_g_norm[l * 256 + cc] * sigmoidf_(zrec[(size_t)n * ZREC_W + ZR_MLO + cc]);
    const float bq = hv[u + 1] * rs * p.ml_g_norm[l * 256 + cc + 1] * sigmoidf_(zrec[(size_t)n * ZREC_W + ZR_MLO + cc + 1]);
    o[u >> 1] = pack2bf(a, bq);
  }
  bf16_t* mlo = (bf16_t*)(p.ws + OFF_REGION + R_MLO);
  *(uint4*)(mlo + (size_t)n * 256 + hd * 64 + v0) = make_uint4(o[0], o[1], o[2], o[3]);
}

DI constexpr int rwo_items(bool with_ctx) { return (with_ctx ? NT_ : NX_) / 16; }
DI void rwkv_out_item(const Params& p, int l, int it, char* smem) {
  float* sg = (float*)smem;
  const float* zrec = (const float*)(p.ws + OFF_REGION + R_ZREC);
  const bf16_t* rb = (const bf16_t*)(p.ws + OFF_REGION + R_RB16);
  const float* bso = (const float*)(p.ws + OFF_REGION + R_BS);
  const float* ys = (const float*)(p.ws + OFF_REGION + R_YS);
  bf16_t* rwo = (bf16_t*)(p.ws + OFF_REGION + R_RWO);
  const float* mu = p.rw_mu + (size_t)l * 1152;
  const int tid = opaque_tid(), n0 = it * 16;
  __syncthreads();
  {
    const int tt = tid >> 5, k4 = (tid & 31) * 4, n = n0 + tt, t = tok_t(n), c = 1024 + k4;
    const int len = n < NX_ ? T_ : CL_;
    const float* zr = zrec + (size_t)n * ZREC_W + ZR_RW + c;
    const float4 z = *(const float4*)zr;
    const float4 zp = t > 0 ? *(const float4*)(zr - ZREC_W) : make_float4(0.f, 0.f, 0.f, 0.f);
    const float4 zn = t < len - 1 ? *(const float4*)(zr + ZREC_W) : make_float4(0.f, 0.f, 0.f, 0.f);
    const float4 m4 = *(const float4*)(mu + c);
    sg[(k4 + 0) * 16 + tt] = sigmoidf_(z.x + (0.5f * (zp.x + zn.x) - z.x) * m4.x);
    sg[(k4 + 1) * 16 + tt] = sigmoidf_(z.y + (0.5f * (zp.y + zn.y) - z.y) * m4.y);
    sg[(k4 + 2) * 16 + tt] = sigmoidf_(z.z + (0.5f * (zp.z + zn.z) - z.z) * m4.z);
    sg[(k4 + 3) * 16 + tt] = sigmoidf_(z.w + (0.5f * (zp.w + zn.w) - z.w) * m4.w);
  }
  __syncthreads();
  const int col = tid & 255, half = tid >> 8;
  float acc[8];
#pragma unroll
  for (int i = 0; i < 8; ++i) acc[i] = 0.f;
  const float* g2 = p.rw_g2 + (size_t)l * 128 * 256 + col;
#pragma unroll 1
  for (int kh = 0; kh < 8; ++kh) {
    float gr[16];
#pragma unroll
    for (int k = 0; k < 16; ++k) gr[k] = g2[(kh * 16 + k) * 256];
#pragma unroll
    for (int k = 0; k < 16; ++k) {
      const float* sk = sg + (kh * 16 + k) * 16 + half * 8;
#pragma unroll
      for (int i = 0; i < 8; ++i) acc[i] += sk[i] * gr[k];
      if ((k & 3) == 3) sched_fence();
    }
  }
  const size_t AS = (size_t)NT_ * 256;
  const float lw = p.rw_lnx_w[(size_t)l * 256 + col], lb = p.rw_lnx_b[(size_t)l * 256 + col];
  float yv[8], vv[8], bsv[8];
#pragma unroll
  for (int i = 0; i < 8; ++i) {
    const int n = n0 + half * 8 + i;
    const size_t o = (size_t)n * 256 + col;
    yv[i] = ys[o] + ys[AS + o];
    vv[i] = bf2f(rb[1 * AS + o]);
    bsv[i] = bso[(size_t)n * 4 + (col >> 6)] + bso[((size_t)NT_ + n) * 4 + (col >> 6)];
  }
#pragma unroll
  for (int i = 0; i < 8; ++i) {
    const int n = n0 + half * 8 + i;
    const size_t o = (size_t)n * 256 + col;
    const float y = yv[i];
    const float mean = wave_sum(y) * (1.f / 64.f);
    const float dv = y - mean;
    const float var = wave_sum(dv * dv) * (1.f / 64.f);
    const float yn = dv * (frsq(var + 64e-5f)) * lw + lb;
    rwo[o] = f2bf((yn + bsv[i] * vv[i]) * acc[i]);
  }
}
DI void phase5(const Params& p, int l, bool with_ctx, char* smem) {
  const int n1 = ml3_items(with_ctx), n2 = rwo_items(with_ctx);
  for (int it = blockIdx.x; it < n1 + n2; it += gridDim.x) {
    if (it < n1) { TSB(p, 62); mlstm_out_item(p, l, it, with_ctx, smem); TSB(p, 63); }
    else { TSB(p, 64); rwkv_out_item(p, l, it - n1, smem); TSB(p, 65); }
  }
}
typedef Gemm<256, 128, 64, 4, 2> G2;
template <class G> DI void merge_tile(const Params& p, int l, int row0, int col0, char* smem) {
  const bf16_t* H = (const bf16_t*)(p.ws + OFF_H);
  const char* W = p.ws + OFF_WMIX + (size_t)l * WM_SIZE;
  const bf16_t* Wg = (const bf16_t*)(W + WM_GATE);
  const bf16_t* att = (const bf16_t*)(p.ws + OFF_REGION + R_ATT);
  const bf16_t* mlo = (const bf16_t*)(p.ws + OFF_REGION + R_MLO);
  const bf16_t* rwo = (const bf16_t*)(p.ws + OFF_REGION + R_RWO);
  bf16_t* ymix = (bf16_t*)(p.osc + O_YMIX);
  const int tid = opaque_tid();
  __syncthreads();
  unsigned ypk[G::MB][G::NB][8];
  f32x16 acc[G::MB][G::NB];
#pragma unroll 1
  for (int i = 0; i < 3; ++i) {
    unsigned sg[G::MB][G::NB][8];
#pragma unroll
    for (int a = 0; a < G::MB; ++a)
#pragma unroll
      for (int b = 0; b < G::NB; ++b) acc[a][b] = zero16();
    const bf16_t* A0 = H + (size_t)row0 * 1024;
    G::run_lin(acc, A0, 1024, Wg + ((size_t)i * 1024 + col0) * 1024, 1024, 1024, smem);
#pragma unroll
    for (int a = 0; a < G::MB; ++a)
#pragma unroll
      for (int b = 0; b < G::NB; ++b) {
#pragma unroll
        for (int e = 0; e < 8; ++e) sg[a][b][e] = pack2bf(sigmoidf_(acc[a][b][2 * e]), sigmoidf_(acc[a][b][2 * e + 1]));
        acc[a][b] = zero16();
      }
    const bf16_t* br = i == 0 ? att : (i == 1 ? mlo : rwo);
    const int kb = i == 0 ? 512 : 256;
    const bf16_t* Wb = (const bf16_t*)(W + (i == 0 ? WM_BRA : (i == 1 ? WM_BRM : WM_BRR)));
    const bf16_t* B0 = br + (size_t)row0 * kb;
    G::run_lin(acc, B0, kb, Wb + (size_t)col0 * kb, kb, kb, smem);
#pragma unroll
    for (int a = 0; a < G::MB; ++a)
#pragma unroll
      for (int b = 0; b < G::NB; ++b)
#pragma unroll
        for (int e = 0; e < 8; ++e) {
          float y0 = bf2f((bf16_t)(sg[a][b][e] & 0xffff)) * acc[a][b][2 * e], y1 = bf2f((bf16_t)(sg[a][b][e] >> 16)) * acc[a][b][2 * e + 1];
          if (i > 0) { y0 += bf2f((bf16_t)(ypk[a][b][e] & 0xffff)); y1 += bf2f((bf16_t)(ypk[a][b][e] >> 16)); }
          if (i < 2) ypk[a][b][e] = pack2bf(y0, y1); else { acc[a][b][2 * e] = y0; acc[a][b][2 * e + 1] = y1; }
        }
  }
  {
    const int lane = tid & 63, wid = tid >> 6, wm = wid / G::WN, wn = wid % G::WN;
    float* scr = (float*)(smem + wid * WTile<G::NB>::BYTES);
#pragma unroll
    for (int mb = 0; mb < G::MB; ++mb) {
#pragma unroll
      for (int nb = 0; nb < G::NB; ++nb) WTile<G::NB>::put(scr, nb, lane, acc[mb][nb]);
      const int r0 = row0 + wm * G::WTM + mb * 32, c0 = col0 + wn * G::WTN;
      WTile<G::NB>::rows8(scr, lane, [&](int r, int c, const float4& a, const float4& bq) {
        *(uint4*)(ymix + (size_t)(r0 + r) * 1024 + c0 + c) = pack8bf(a, bq); });
    }
  }
}
DI void phase_merge(const Params& p, int l, bool with_ctx, char* smem) {
  const int nbig = (NX_ / 256) * 8, nsmall = with_ctx ? (NC_ / 128) * 8 : 0;
  for (int it = vblock(); it < nbig + nsmall; it += gridDim.x) {
    if (it < nbig) merge_tile<G2>(p, l, (it >> 3) * 256, (it & 7) * 128, smem);
    else { const int i2 = it - nbig; merge_tile<G128>(p, l, NX_ + (i2 >> 3) * 128, (i2 & 7) * 128, smem); }
  }
}

template <class G> DI void wout_tile(const Params& p, int l, int row0, int col0, char* smem) {
  const bf16_t* ymix = (const bf16_t*)(p.osc + O_YMIX);
  const bf16_t* Wo = (const bf16_t*)(p.ws + OFF_WMIX + (size_t)l * WM_SIZE + WM_OUT);
  float* xs = (float*)(p.ws + OFF_XS);
  const float* mod = (const float*)(p.ws + OFF_MOD) + (size_t)l * 3 * 6144;
  const int tid = opaque_tid();
  __syncthreads();
  f32x16 acc[G::MB][G::NB];
#pragma unroll
  for (int a = 0; a < G::MB; ++a)
#pragma unroll
    for (int b = 0; b < G::NB; ++b) acc[a][b] = zero16();
  const bf16_t* A0 = ymix + (size_t)row0 * 1024;
  G::run_lin(acc, A0, 1024, Wo + (size_t)col0 * 1024, 1024, 1024, smem);
  const float* m2 = mod + (size_t)tok_modrow(row0) * 6144 + 2 * 1024;
  const int lane = tid & 63, wid = tid >> 6, wm = wid / G::WN, wn = wid % G::WN;
  float* scr = (float*)(smem + wid * WTile<G::NB>::BYTES);
#pragma unroll
  for (int mb = 0; mb < G::MB; ++mb) {
#pragma unroll
    for (int nb = 0; nb < G::NB; ++nb) WTile<G::NB>::put(scr, nb, lane, acc[mb][nb]);
    const int r0 = row0 + wm * G::WTM + mb * 32, c0 = col0 + wn * G::WTN;
    WTile<G::NB>::rows4(scr, lane, [&](int r, int c, const float4& a) {
      float4* d = (float4*)(xs + (size_t)(r0 + r) * 1024 + c0 + c);
      const float4 g = *(const float4*)(m2 + c0 + c); float4 x = *d;
      x.x += g.x * a.x; x.y += g.y * a.y; x.z += g.z * a.z; x.w += g.w * a.w; *d = x; });
  }
}
DI void phase_wout(const Params& p, int l, bool with_ctx, char* smem) {
  const int nbig = (NX_ / 256) * 8, nsmall = with_ctx ? (NC_ / 128) * 8 : 0;
  for (int it = vblock(); it < nbig + nsmall; it += gridDim.x) {
    if (it < nbig) wout_tile<G2>(p, l, (it >> 3) * 256, (it & 7) * 128, smem);
    else { const int i2 = it - nbig; wout_tile<G128>(p, l, NX_ + (i2 >> 3) * 128, (i2 & 7) * 128, smem); }
  }
  TSB(p, 66);
  cvt_run([&](int i) { return cvt_moe_dec(p, l, i); }, (int)gridDim.x - 1 - vblock(), CVT_MOE_TILES, gridDim.x, smem);
  TSB(p, 67);
}

typedef Gemm<128, 64, 64, 4, 2> GRT;
DI void phase_router(const Params& p, int l, bool with_ctx, char* smem, int* cnt) {
  float* xs = (float*)(p.ws + OFF_XS);
  bf16_t* H = (bf16_t*)(p.ws + OFF_H);
  const float* mod = (const float*)(p.ws + OFF_MOD) + (size_t)l * 3 * 6144;
  const bf16_t* Wr = (const bf16_t*)(p.ws + OFF_WMIX + (size_t)l * WM_SIZE + WM_RT);
  int* eidx = (int*)(p.ws + OFF_REGION + R_EIDX);
  float* ewt = (float*)(p.ws + OFF_REGION + R_EWT);
  int* erank = (int*)(p.ws + OFF_REGION + R_ERANK);
  int* elist = (int*)(p.ws + OFF_REGION + R_ELIST);
  float* sc = (float*)(smem + GRT::SMEM);
  float* bs = sc + 128 * 65;
  float* gs = bs + 128 * 65;
  int* lcnt = (int*)(gs + 128 * 9);
  int* lbase = lcnt + 64;
  const int tid = opaque_tid(), lane = tid & 63, wid = tid >> 6;
  const int ntok = with_ctx ? NT_ : NX_;
  for (int it = blockIdx.x; it < ntok / 128; it += gridDim.x) {
    const int n0 = it * 128;
    __syncthreads();
    TSB(p, 40);
    if (tid < 64) lcnt[tid] = 0;
#pragma unroll 1
    for (int r4 = 0; r4 < 16; r4 += 4) {
      float v[4][16];
#pragma unroll
      for (int u = 0; u < 4; ++u) {
        const int n = n0 + wid * 16 + r4 + u;
#pragma unroll
        for (int j = 0; j < 4; ++j) {
          const float4 t = *(const float4*)(xs + (size_t)n * 1024 + (j * 64 + lane) * 4);
          v[u][j * 4] = t.x; v[u][j * 4 + 1] = t.y; v[u][j * 4 + 2] = t.z; v[u][j * 4 + 3] = t.w;
        }
      }
#pragma unroll
      for (int u = 0; u < 4; ++u) {
        const int n = n0 + wid * 16 + r4 + u;
        const float* m = mod + (size_t)tok_modrow(n) * 6144;
        row_norm_mod(v[u], p.g_ffn + (size_t)l * 1024, m + 3 * 1024, m + 4 * 1024, H + (size_t)n * 1024, lane);
      }
    }
    __syncthreads();
    TSB(p, 41);
    f32x16 acc[1][1]; acc[0][0] = zero16();
    const bf16_t* A0 = H + (size_t)n0 * 1024;
    GRT::run(acc, [&](int r) { return A0 + (size_t)r * 1024; }, Wr, 1024, 1024, smem);
    {
      const int col = GRT::col_of(tid, 0);
      const float rb = p.router_bias[l * 64 + col];
#pragma unroll
      for (int e = 0; e < 16; ++e) {
        const int row = GRT::row_of(tid, 0, e);
        const float s = sigmoidf_(acc[0][0][e]);
        sc[row * 65 + col] = s; bs[row * 65 + col] = s + rb;
      }
    }
    __syncthreads();
    TSB(p, 42);
    int sel[8], lrk[8]; float wsum = 0.f;
    if (tid < 128) {
      float* b = bs + tid * 65; const float* s = sc + tid * 65; float* g = gs + tid * 9;
      for (int gi = 0; gi < 8; ++gi) {
        float m1 = -1e30f, m2 = -1e30f;
        for (int j = 0; j < 8; ++j) { const float x = b[gi * 8 + j]; if (x > m1) { m2 = m1; m1 = x; } else if (x > m2) m2 = x; }
        g[gi] = m1 + m2;
      }
      unsigned gmask = 0;
      for (int c = 0; c < 4; ++c) {
        int best = 0; float bv = -1e30f;
        for (int gi = 0; gi < 8; ++gi) if (!((gmask >> gi) & 1) && g[gi] > bv) { bv = g[gi]; best = gi; }
        gmask |= 1u << best;
      }
      for (int gi = 0; gi < 8; ++gi) if (!((gmask >> gi) & 1)) for (int j = 0; j < 8; ++j) b[gi * 8 + j] = -1e30f;
      wsum = 0.f;
#pragma unroll
      for (int c = 0; c < 8; ++c) {
        int best = 0; float bv = -1e30f;
        for (int e = 0; e < 64; ++e) { const float x = b[e]; if (x > bv) { bv = x; best = e; } }
        b[best] = -3e30f; sel[c] = best; wsum += s[best];
        lrk[c] = atomicAdd(lcnt + best, 1);
      }
    }
    __syncthreads();
    if (tid < 64) { const int c = lcnt[tid]; lbase[tid] = c ? atomicAdd(cnt + tid * 32, c) : 0; }
    __syncthreads();
    if (tid < 128) {
      const int n = n0 + tid;
      const float* s = sc + tid * 65;
      const float inv = 2.5f / (wsum + 1e-20f);
#pragma unroll
      for (int c = 0; c < 8; ++c) {
        const int e = sel[c];
        const int rk = lbase[e] + lrk[c];
        eidx[n * 8 + c] = e; ewt[n * 8 + c] = s[e] * inv; erank[n * 8 + c] = rk;
        elist[(size_t)e * NT_ + rk] = n * 8 + c;
      }
    }
    __syncthreads();
    TSB(p, 43);
  }
}

typedef Gemm<128, 256, 32, 2, 4> GMOE;
constexpr int ACT_LD = 264;
constexpr int MOE_DN_BK = 64, MOE_DN_LD = 72, MOE_DN_STG = 256 * MOE_DN_LD * 2;
constexpr int MOE_ACT_OFF = 2 * MOE_DN_STG;
static_assert(GMOE::SMEM <= MOE_ACT_OFF, "gate/up staging must stay below the act image");
constexpr int MOE_INFO_OFF = MOE_ACT_OFF + 128 * ACT_LD * 2;
static_assert(MOE_INFO_OFF + 128 * 8 + 67 * 4 * 2 <= 160 * 1024 - 32, "moe lds");
DI void moe_down_run(f32x16 (&acc)[GMOE::MB][GMOE::NB], const char* actl, const bf16_t* Bt, char* smem) {
  constexpr int BK = MOE_DN_BK, LDB = MOE_DN_LD, NCH = 4, KS = 4, STG = MOE_DN_STG, nk = 256 / BK;
  const int tid = opaque_tid(), lane = tid & 63, wid = tid >> 6, wm = wid / 4, wn = wid % 4;
  const int kc = (tid & 7) * 8, r0 = tid >> 3;
  const bf16_t* bp0 = Bt + (size_t)r0 * 256 + kc;
  u32x4 s0[NCH], s1[NCH];
#define MD_LOAD(dst_, kt_) { const int kq_ = (kt_) < nk ? (kt_) : nk - 1; _Pragma("unroll") for (int i = 0; i < NCH; ++i) dst_[i] = *(const u32x4*)(bp0 + (size_t)i * 64 * 256 + kq_ * BK); }
#define MD_WRITE1(src_, c_, buf_) { *(u32x4*)(smem + (buf_) * STG + ((r0 + (c_) * 64) * LDB + kc) * 2) = src_[c_]; }
#define MD_STEP(w_, l_, kt_) { \
    MD_LOAD(l_, (kt_) + 2); \
    sched_fence(); \
    const char* Bs = smem + ((kt_) & 1) * STG; \
    _Pragma("unroll") for (int ks = 0; ks < KS; ++ks) { \
      bf16x8 af[GMOE::MB], bfr[GMOE::NB]; \
      _Pragma("unroll") for (int mb = 0; mb < GMOE::MB; ++mb) af[mb] = *(const bf16x8*)(actl + ((wm * 64 + mb * 32 + (lane & 31)) * ACT_LD + (kt_) * BK + ks * 16 + (lane >> 5) * 8) * 2); \
      _Pragma("unroll") for (int nb = 0; nb < GMOE::NB; ++nb) bfr[nb] = *(const bf16x8*)(Bs + ((wn * 64 + nb * 32 + (lane & 31)) * LDB + ks * 16 + (lane >> 5) * 8) * 2); \
      MD_WRITE1(w_, ks, ((kt_) + 1) & 1); \
      _Pragma("unroll") for (int mb = 0; mb < GMOE::MB; ++mb) _Pragma("unroll") for (int nb = 0; nb < GMOE::NB; ++nb) acc[mb][nb] = mfma32(af[mb], bfr[nb], acc[mb][nb]); \
    } \
    sched_fence(); \
    __syncthreads(); }
  MD_LOAD(s0, 0);
#pragma unroll
  for (int c = 0; c < NCH; ++c) MD_WRITE1(s0, c, 0);
  MD_LOAD(s0, 1);
  __syncthreads();
  for (int kt = 0; kt < nk; kt += 2) {
    MD_STEP(s0, s1, kt);
    MD_STEP(s1, s0, kt + 1);
  }
#undef MD_STEP
#undef MD_WRITE1
#undef MD_LOAD
}
DI void phase_moe(const Params& p, int l, bool with_ctx, char* smem, const int* cnt) {
  const bf16_t* H = (const bf16_t*)(p.ws + OFF_H);
  const bf16_t* GU = (const bf16_t*)(p.ws + OFF_REGION + R_WMOE + WE_GU);
  const bf16_t* DN = (const bf16_t*)(p.ws + OFF_REGION + R_WMOE + WE_DN);
  const float* ewt = (const float*)(p.ws + OFF_REGION + R_EWT);
  const int* elist = (const int*)(p.ws + OFF_REGION + R_ELIST);
  bf16_t* ybuf = (bf16_t*)(p.ws + OFF_REGION + R_YBUF);
  char* actl = smem + MOE_ACT_OFF;
  int* rtok = (int*)(smem + MOE_INFO_OFF);
  float* rwt = (float*)(rtok + 128);
  int* pre = (int*)(rwt + 128);
  int* off = pre + 67;
  int tid = threadIdx.x;
  const int ntok = with_ctx ? NT_ : NX_;
  __syncthreads();
  if (tid == 0) {
    int a = 0, o = 0;
    for (int e = 0; e < 65; ++e) { const int c = e < 64 ? cnt[e * 32] : ntok; pre[e] = a; off[e] = o; a += (c + 127) >> 7; o += c; }
    pre[65] = a; off[65] = o;
  }
  __syncthreads();
  const int total = pre[65];
  for (int it = vblock(); it < total; it += gridDim.x) {
    tid = opaque_tid();
    int e0 = 0;
    while (pre[e0 + 1] <= it) ++e0;
    const int e = rfl(e0);
    const int rb = rfl(it - pre[e]);
    const int c = rfl(e < 64 ? cnt[e * 32] : ntok);
    const int obase = rfl(off[e] + rb * 128);
    __syncthreads();
    if (tid < 128) {
      const int slot = rb * 128 + tid;
      int tok = 0; float w = 0.f;
      if (slot < c) {
        if (e < 64) { const int pk = elist[(size_t)e * NT_ + slot]; tok = pk >> 3; w = ewt[pk]; }
        else { tok = slot; w = 1.f; }
      }
      rtok[tid] = tok; rwt[tid] = w;
    }
    __syncthreads();
    const bf16_t* Wgu = GU + (size_t)e * 512 * 1024;
#pragma unroll 1
    for (int hf = 0; hf < 2; ++hf) {
      f32x16 acc[GMOE::MB][GMOE::NB];
#pragma unroll
      for (int a = 0; a < GMOE::MB; ++a)
#pragma unroll
        for (int b = 0; b < GMOE::NB; ++b) acc[a][b] = zero16();
      GMOE::run(acc, [&](int r) { return H + (size_t)rtok[r] * 1024; }, Wgu + (size_t)hf * 256 * 1024, 1024, 1024, smem);
      const int lane = tid & 63, wn = (tid >> 6) % 4, wmr = ((tid >> 6) / 4) * 64 + 4 * (lane >> 5);
      const int j = (hf * 4 + wn) * 32 + (lane & 31);
#pragma unroll
      for (int mb = 0; mb < GMOE::MB; ++mb)
#pragma unroll
        for (int i = 0; i < 16; ++i) {
          const int row = wmr + mb * 32 + (i & 3) + 8 * (i >> 2);
          const float g = acc[mb][0][i], u = acc[mb][1][i];
          *(bf16_t*)(actl + (row * ACT_LD + j) * 2) = f2bf(siluf_(g) * u);
        }
    }
    __syncthreads();
    const bf16_t* Wd = DN + (size_t)e * 1024 * 256;
#pragma unroll 1
    for (int nt = 0; nt < 4; ++nt) {
      f32x16 acc[GMOE::MB][GMOE::NB];
#pragma unroll
      for (int a = 0; a < GMOE::MB; ++a)
#pragma unroll
        for (int b = 0; b < GMOE::NB; ++b) acc[a][b] = zero16();
      moe_down_run(acc, actl, Wd + (size_t)nt * 256 * 256, smem);
      {
        const int lane = tid & 63, wid = tid >> 6, wm = wid / 4, wn = wid % 4;
        float* scr = (float*)(smem + wid * WTile<1>::BYTES);
#pragma unroll
        for (int mb = 0; mb < GMOE::MB; ++mb)
#pragma unroll
          for (int nb = 0; nb < GMOE::NB; ++nb) {
            WTile<1>::put(scr, 0, lane, acc[mb][nb]);
            const int row0 = wm * 64 + mb * 32, col0 = nt * 256 + wn * 64 + nb * 32;
            WTile<1>::rows8(scr, lane, [&](int r, int cq, const float4& a, const float4& bq) {
              const int row = row0 + r;
              if (rb * 128 + row < c) {
                const float w = rwt[row];
                const float4 a2 = make_float4(a.x * w, a.y * w, a.z * w, a.w * w), b2 = make_float4(bq.x * w, bq.y * w, bq.z * w, bq.w * w);
                *(uint4*)(ybuf + ((size_t)obase + row) * 1024 + col0 + cq) = pack8bf(a2, b2);
              } });
          }
        __syncthreads();
      }
    }
  }
}

DI void phase_combine(const Params& p, int l, bool last, char* smem, const int* cnt) {
  float* xs = (float*)(p.ws + OFF_XS);
  bf16_t* H = (bf16_t*)(p.ws + OFF_H);
  const float* mod = (const float*)(p.ws + OFF_MOD);
  const int* eidx = (const int*)(p.ws + OFF_REGION + R_EIDX);
  const int* erank = (const int*)(p.ws + OFF_REGION + R_ERANK);
  const bf16_t* ybuf = (const bf16_t*)(p.ws + OFF_REGION + R_YBUF);
  int* off = (int*)smem;
  const int tid = opaque_tid(), lane = tid & 63, wid = tid >> 6;
  const int ntok = last ? NX_ : NT_;
  __syncthreads();
  if (tid == 0) { int o = 0; for (int e = 0; e < 64; ++e) { off[e] = o; o += cnt[e * 32]; } off[64] = o; }
  __syncthreads();
  for (int n = blockIdx.x * 8 + wid; n < ntok; n += gridDim.x * 8) {
    float acc[16];
#pragma unroll
    for (int i = 0; i < 16; ++i) acc[i] = 0.f;
    for (int k = 0; k < 9; ++k) {
      const int row = k < 8 ? off[eidx[n * 8 + k]] + erank[n * 8 + k] : off[64] + n;
      const bf16_t* y = ybuf + (size_t)row * 1024;
#pragma unroll
      for (int j = 0; j < 4; ++j) {
        const uint2 u = *(const uint2*)(y + (j * 64 + lane) * 4);
        acc[j * 4 + 0] += bf2f((bf16_t)(u.x & 0xffff)); acc[j * 4 + 1] += bf2f((bf16_t)(u.x >> 16));
        acc[j * 4 + 2] += bf2f((bf16_t)(u.y & 0xffff)); acc[j * 4 + 3] += bf2f((bf16_t)(u.y >> 16));
      }
    }
    const float* m5 = mod + ((size_t)l * 3 + tok_modrow(n)) * 6144 + 5 * 1024;
    float v[16];
#pragma unroll
    for (int j = 0; j < 4; ++j) {
      const int c = (j * 64 + lane) * 4;
      const float4 x = *(const float4*)(xs + (size_t)n * 1024 + c), g = *(const float4*)(m5 + c);
      v[j * 4 + 0] = x.x + g.x * acc[j * 4 + 0]; v[j * 4 + 1] = x.y + g.y * acc[j * 4 + 1];
      v[j * 4 + 2] = x.z + g.z * acc[j * 4 + 2]; v[j * 4 + 3] = x.w + g.w * acc[j * 4 + 3];
      if (!last) *(float4*)(xs + (size_t)n * 1024 + c) = make_float4(v[j * 4], v[j * 4 + 1], v[j * 4 + 2], v[j * 4 + 3]);
    }
    if (!last) {
      const float* m = mod + ((size_t)(l + 1) * 3 + tok_modrow(n)) * 6144;
      row_norm_mod(v, p.g_mix + (size_t)(l + 1) * 1024, m, m + 1024, H + (size_t)n * 1024, lane);
    } else {
      float ss = 0.f;
#pragma unroll
      for (int i = 0; i < 16; ++i) ss += v[i] * v[i];
      ss = wave_sum(ss);
      const float rs = frsq(ss * (1.f / 1024.f) + 1e-6f);
#pragma unroll
      for (int j = 0; j < 4; ++j) {
        const int c = (j * 64 + lane) * 4;
        const float4 g = *(const float4*)(p.g_final + c);
        *(float4*)(p.out + (size_t)n * 1024 + c) = make_float4(v[j * 4] * rs * g.x, v[j * 4 + 1] * rs * g.y, v[j * 4 + 2] * rs * g.z, v[j * 4 + 3] * rs * g.w);
      }
    }
  }
}
#define SMEM_BYTES (160 * 1024)
#ifndef MEGA
#define MEGA 0
#endif
DI int* cnt_ptr(const Params& p, int l) { return (int*)(p.ws + OFF_CNT) + 1024 + 2048 * l; }
DI int* ctr_ptr(const Params& p, int l) { return (int*)(p.ws + OFF_CNT) + 32 * l; }
#if !MEGA
__global__ void __launch_bounds__(NTHR) k_phaseA(Params p) { SMEM_DECL(smem, SMEM_BYTES); phaseA(p, smem); }
__global__ void __launch_bounds__(NTHR) k_norm0(Params p) { phase_norm0(p); }
__global__ void __launch_bounds__(NTHR) k_win(Params p, int l) { SMEM_DECL(smem, SMEM_BYTES); phase_win(p, l, smem); }
__global__ void __launch_bounds__(NTHR) k_p3(Params p, int l) { SMEM_DECL(smem, SMEM_BYTES); phase3(p, l, smem); }
__global__ void __launch_bounds__(NTHR) k_p3b(Params p, int l) { SMEM_DECL(smem, SMEM_BYTES); phase3b(p, l, smem); }
__global__ void __launch_bounds__(NTHR) k_p4(Params p, int l) { SMEM_DECL(smem, SMEM_BYTES); phase4(p, l, smem, ctr_ptr(p, l)); }
__global__ void __launch_bounds__(NTHR) k_p5(Params p, int l, int wc) { SMEM_DECL(smem, SMEM_BYTES); phase5(p, l, wc != 0, smem); }
__global__ void __launch_bounds__(NTHR) k_merge(Params p, int l, int wc) { SMEM_DECL(smem, SMEM_BYTES); phase_merge(p, l, wc != 0, smem); }
__global__ void __launch_bounds__(NTHR) k_wout(Params p, int l, int wc) { SMEM_DECL(smem, SMEM_BYTES); phase_wout(p, l, wc != 0, smem); }
__global__ void __launch_bounds__(NTHR) k_router(Params p, int l, int wc) { SMEM_DECL(smem, SMEM_BYTES); phase_router(p, l, wc != 0, smem, cnt_ptr(p, l)); }
__global__ void __launch_bounds__(NTHR) k_moe(Params p, int l, int wc) { SMEM_DECL(smem, SMEM_BYTES); phase_moe(p, l, wc != 0, smem, cnt_ptr(p, l)); }
__global__ void __launch_bounds__(NTHR) k_combine(Params p, int l, int last) { SMEM_DECL(smem, SMEM_BYTES); phase_combine(p, l, last != 0, smem, cnt_ptr(p, l)); }
#else
#ifndef EMU
#define XB_TMO      128
#define XB_XCNT(j)  (256  + 64 * (j))
#define XB_XSUB(j)  (1280 + 64 * (j))
#define XB_XGEN(j)  (2304 + 64 * (j))
#define XB_TOP      3328
#define XB_TOPGEN   3392
#define XCD_BAR_WORDS 3456
#define XB_SPIN_CAP (1u << 24)
#define LAS __attribute__((address_space(3)))
DI unsigned xb_ld(unsigned* p) { return __hip_atomic_load(p, __ATOMIC_RELAXED, __HIP_MEMORY_SCOPE_AGENT); }
DI unsigned xb_add(unsigned* p, unsigned v) { return __hip_atomic_fetch_add(p, v, __ATOMIC_RELAXED, __HIP_MEMORY_SCOPE_AGENT); }
DI unsigned xb_xcc_id() { return (unsigned)__builtin_amdgcn_s_getreg((3 << 11) | 20) & 0xFu; }
#define XB_SPIN(cond, bar) do { unsigned _sp = 0; while (cond) { __builtin_amdgcn_s_sleep(1); \
    if ((++_sp & 255u) == 0u) { if (xb_ld(&(bar)[XB_TMO])) break; if (_sp > XB_SPIN_CAP) { atomicAdd(&(bar)[XB_TMO], 1u); break; } } } } while (0)
struct XcdBarrier { unsigned* bar; unsigned x; volatile LAS unsigned* st; };
DI XcdBarrier xcd_barrier_post(unsigned* bar, volatile LAS unsigned* st) {
  XcdBarrier b; b.bar = bar; b.x = xb_xcc_id(); b.st = st;
  if (threadIdx.x == 0) (void)xb_add(&bar[XB_XCNT(b.x)], 1u);
  return b;
}
DI void xcd_barrier_complete(unsigned* bar, unsigned x, unsigned& nloc, unsigned& nx) {
  const unsigned G = gridDim.x * gridDim.y * gridDim.z;
  unsigned sum, cnt, mine, sp = 0u;
  for (;;) {
    sum = 0u; cnt = 0u; mine = 0u;
#pragma unroll
    for (unsigned j = 0; j < 16; ++j) { const unsigned c = xb_ld(&bar[XB_XCNT(j)]); sum += c; cnt += (c > 0u) ? 1u : 0u; mine = (j == x) ? c : mine; }
    if (sum == G) break;
    __builtin_amdgcn_s_sleep(1);
    if ((++sp & 255u) == 0u) { if (xb_ld(&bar[XB_TMO])) break; if (sp > XB_SPIN_CAP) { atomicAdd(&bar[XB_TMO], 1u); break; } }
  }
  nloc = mine > 0u ? mine : 1u; nx = cnt > 0u ? cnt : 1u;
}
DI void xcd_barrier(const XcdBarrier& b) {
  asm volatile("s_waitcnt vmcnt(0)" ::: "memory");
  __syncthreads();
  if (threadIdx.x == 0) {
    unsigned* bar = b.bar;
    __builtin_amdgcn_s_waitcnt(0);
    unsigned nloc = b.st[0], nx = b.st[1];
    if (nloc == 0u) { xcd_barrier_complete(bar, b.x, nloc, nx); b.st[0] = nloc; b.st[1] = nx; }
    const unsigned old = xb_add(&bar[XB_XSUB(b.x)], 1u);
    const unsigned gen = old / nloc;
    if (old + 1u == (gen + 1u) * nloc) {
      __builtin_amdgcn_fence(__ATOMIC_RELEASE, "agent");
      asm volatile("s_waitcnt vmcnt(0)" ::: "memory");
      const unsigned og = xb_add(&bar[XB_TOP], 1u);
      const unsigned tg = og / nx;
      if (og + 1u == (tg + 1u) * nx) xb_add(&bar[XB_TOPGEN], 1u);
      else XB_SPIN(xb_ld(&bar[XB_TOPGEN]) == tg, bar);
      __builtin_amdgcn_fence(__ATOMIC_ACQUIRE, "agent");
      xb_add(&bar[XB_XGEN(b.x)], 1u);
      asm volatile("s_waitcnt vmcnt(0)" ::: "memory");
    } else {
      XB_SPIN(xb_ld(&bar[XB_XGEN(b.x)]) == gen, bar);
      __builtin_amdgcn_fence(__ATOMIC_ACQUIRE, "agent");
      asm volatile("s_waitcnt vmcnt(0)" ::: "memory");
    }
  }
  __syncthreads();
}
#define GSYNC() { XcdBarrier xb_; xb_.bar = (unsigned*)(p.ws + OFF_BAR); xb_.x = xb_xcc_id(); xb_.st = (volatile LAS unsigned*)(smem + SMEM_BYTES - 32); xcd_barrier(xb_); }
#else
#define GSYNC() emu::grid_barrier()
#endif
#ifdef PROBE_IDX
#define TS(i) { if (blockIdx.x == 0 && threadIdx.x == 0) ts[i] = wall_clock64(); }
#else
#define TS(i)
#endif
__global__ void __launch_bounds__(NTHR) k_mega(Params p) {
  SMEM_DECL(smem, SMEM_BYTES);
  cooperative_groups::grid_group grid = cooperative_groups::this_grid();
  volatile LAS unsigned* xst = (volatile LAS unsigned*)(smem + SMEM_BYTES - 32);
  if (threadIdx.x == 0) { xst[0] = 0u; xst[1] = 0u; }
  __syncthreads();
  (void)xcd_barrier_post((unsigned*)(p.ws + OFF_BAR), xst);
#ifdef PROBE_IDX
  long long* ts = (long long*)(p.ws + OFF_CNT + 2048);
#endif
  TS(0);
  phaseA(p, smem);
  grid.sync(); TS(1);
  phase_norm0(p);
  GSYNC(); TS(2);
#pragma unroll 1
  for (int l = 0; l < 2; ++l) {
    const bool wc = l == 0;
    phase_win(p, l, smem); GSYNC(); TS(3 + l * 10);
    phase3(p, l, smem); GSYNC(); TS(4 + l * 10);
    phase3b(p, l, smem); GSYNC(); TS(5 + l * 10);
    phase4(p, l, smem, ctr_ptr(p, l)); GSYNC(); TS(6 + l * 10);
    phase5(p, l, wc, smem); GSYNC(); TS(7 + l * 10);
    phase_merge(p, l, wc, smem); GSYNC(); TS(8 + l * 10);
    phase_wout(p, l, wc, smem); GSYNC(); TS(9 + l * 10);
    phase_router(p, l, wc, smem, cnt_ptr(p, l)); GSYNC(); TS(10 + l * 10);
    phase_moe(p, l, wc, smem, cnt_ptr(p, l)); GSYNC(); TS(11 + l * 10);
    phase_combine(p, l, l == 1, smem, cnt_ptr(p, l));
#ifdef PROBE_IDX
    GSYNC(); TS(12 + l * 10);
#else
    if (l == 0) GSYNC();
#endif
  }
#ifdef PROBE_IDX
  if (blockIdx.x == 0 && threadIdx.x == 0) {
    const float us = (float)(ts[PROBE_IDX + 1] - ts[PROBE_IDX]) * 0.01f;
    p.out[0] += PROBE_IDX >= 40 ? rintf(6.f * log2f(fmaxf(us * 16.f, 1.f))) : rintf(6.f * log2f(fmaxf(us, 1.f)));
  }
#endif
}
#endif

extern "C" void kernel_launch(void* const* d_in, const int* in_sizes, int n_in, void* d_out, int out_size, void* d_ws,
                              size_t ws_size, hipStream_t stream) {
  Params p{};
  const float** pp = (const float**)&p;
  for (int i = 0; i < 41; ++i) pp[i] = (const float*)d_in[i];
  p.out = (float*)d_out; p.ws = (char*)d_ws; p.osc = (char*)d_out;
  if (ws_size < WS_NEEDED) { fprintf(stderr, "workspace too small: %zu < %zu\n", ws_size, (size_t)WS_NEEDED); return; }
#if !MEGA
  const dim3 g(256), b(NTHR);
  hipLaunchKernelGGL(k_phaseA, g, b, 0, stream, p);
  hipLaunchKernelGGL(k_norm0, g, b, 0, stream, p);
  for (int l = 0; l < 2; ++l) {
    const int wc = l == 0;
    hipLaunchKernelGGL(k_win, g, b, 0, stream, p, l);
    hipLaunchKernelGGL(k_p3, g, b, 0, stream, p, l);
    hipLaunchKernelGGL(k_p3b, g, b, 0, stream, p, l);
    hipLaunchKernelGGL(k_p4, g, b, 0, stream, p, l);
    hipLaunchKernelGGL(k_p5, g, b, 0, stream, p, l, wc);
    hipLaunchKernelGGL(k_merge, g, b, 0, stream, p, l, wc);
    hipLaunchKernelGGL(k_wout, g, b, 0, stream, p, l, wc);
    hipLaunchKernelGGL(k_router, g, b, 0, stream, p, l, wc);
    hipLaunchKernelGGL(k_moe, g, b, 0, stream, p, l, wc);
    hipLaunchKernelGGL(k_combine, g, b, 0, stream, p, l, l == 1);
  }
#else
  static int grid_blocks = 0;
  if (!grid_blocks) {
    int dev = 0, cus = 0, per_cu = 0;
    hipGetDevice(&dev);
    hipDeviceGetAttribute(&cus, hipDeviceAttributeMultiprocessorCount, dev);
    hipOccupancyMaxActiveBlocksPerMultiprocessor(&per_cu, k_mega, NTHR, 0);
    if (per_cu > 1) per_cu = 1;
    grid_blocks = cus * per_cu;
  }
  hipMemsetAsync(p.ws + OFF_BAR, 0, 16384, stream);
  void* args[] = {&p};
  hipError_t e = hipLaunchCooperativeKernel((void*)k_mega, dim3(grid_blocks), dim3(NTHR), args, 0, stream);
  if (e != hipSuccess) fprintf(stderr, "cooperative launch failed: %s (grid %d)\n", hipGetErrorString(e), grid_blocks);
#endif
}
```

```cpp
#define MEGA 1
#include <hip/hip_runtime.h>
#include <hip/hip_cooperative_groups.h>
#include <cstdio>

#ifndef SEQ_T
#define SEQ_T 8192
#endif
#ifndef CTX_L
#define CTX_L 256
#endif

#define DI __device__ __forceinline__
typedef unsigned short bf16_t;
typedef short bf16x8 __attribute__((ext_vector_type(8)));
typedef float f32x16 __attribute__((ext_vector_type(16)));
typedef float f32x4 __attribute__((ext_vector_type(4)));
typedef unsigned u32x4 __attribute__((ext_vector_type(4)));

constexpr int NB_ = 2, T_ = SEQ_T, CL_ = CTX_L, D_ = 1024;
constexpr int NX_ = NB_ * T_, NC_ = NB_ * CL_, NT_ = NX_ + NC_, KT_ = CL_ + T_;
constexpr int GRID_W_ = 64;
constexpr int MLA_H = 8, MLA_NOPE_ = 64, MLA_ROPE_ = 32, MLA_DK = 96, MLA_DV = 64, QLORA = 384, KVLORA = 256;
constexpr int MLA_IN_ = 672, ML_IN_ = 784, RW_IN_ = 1152, GATE_IN_ = 3072, D_IN_ = 5680;
constexpr int ZMLA_W = 768;
constexpr int ZREC_W = 1936;
constexpr int WIN_N = 768 + 2048;
constexpr int ML_H = 4, ML_DK = 32, ML_DV = 64, ML_L = 64;
constexpr int RW_H = 4, RW_N_ = 64;
constexpr int NE_ = 64, TOPK_ = 8, DE_ = 256;
constexpr int NCH_ = KT_ / ML_L;
constexpr int NSEQ_ = 2 * NB_ * 4;

constexpr int ZR_MLQ = 0, ZR_MLK = 128, ZR_MLV = 256, ZR_MLO = 512, ZR_MLI = 768, ZR_MLF = 776;
constexpr int ZR_RW = 784;

constexpr size_t al256(size_t x) { return (x + 255) & ~(size_t)255; }
constexpr size_t WM_WIN = 0;
constexpr size_t WM_GATE = WM_WIN + (size_t)WIN_N * 1024 * 2;
constexpr size_t WM_UQ = WM_GATE + (size_t)3072 * 1024 * 2;
constexpr size_t WM_UKV = WM_UQ + (size_t)768 * 384 * 2;
constexpr size_t WM_BRA = WM_UKV + (size_t)1024 * 256 * 2;
constexpr size_t WM_BRM = WM_BRA + (size_t)1024 * 512 * 2;
constexpr size_t WM_BRR = WM_BRM + (size_t)1024 * 256 * 2;
constexpr size_t WM_OUT = WM_BRR + (size_t)1024 * 256 * 2;
constexpr size_t WM_RT = WM_OUT + (size_t)1024 * 1024 * 2;
constexpr size_t WM_SIZE = al256(WM_RT + (size_t)64 * 1024 * 2);
constexpr size_t WE_GU = 0;
constexpr size_t WE_DN = WE_GU + (size_t)65 * 512 * 1024 * 2;
constexpr size_t WE_SIZE = al256(WE_DN + (size_t)65 * 1024 * 256 * 2);

constexpr size_t OFF_XS = 0;
constexpr size_t OFF_MOD = OFF_XS + al256((size_t)NT_ * 1024 * 4);
constexpr size_t OFF_ROPE = OFF_MOD + al256((size_t)2 * 3 * 6144 * 4);
constexpr size_t OFF_H = OFF_ROPE + al256((size_t)T_ * 16 * 8);
constexpr size_t OFF_WMIX = OFF_H + al256((size_t)NT_ * 1024 * 2);
constexpr size_t OFF_CNT = OFF_WMIX + 2 * WM_SIZE;
constexpr size_t OFF_BAR = OFF_CNT + 32768;
constexpr size_t OFF_REGION = OFF_BAR + 16384;
constexpr size_t R_ZREC = 0;
constexpr size_t R_RB16 = R_ZREC + al256((size_t)NT_ * ZREC_W * 4);
constexpr size_t R_LW = R_RB16 + al256((size_t)7 * NT_ * 256 * 2);
constexpr size_t R_BS = R_LW + al256((size_t)2 * NT_ * 256 * 4);
constexpr size_t R_CH = R_BS + al256((size_t)2 * NT_ * 4 * 4);
constexpr size_t R_YS = R_CH + al256((size_t)NSEQ_ * NCH_ * 40960);
constexpr size_t R_MLST = R_YS + al256((size_t)2 * NT_ * 256 * 4);
constexpr size_t R_ATT = R_MLST + al256((size_t)NSEQ_ * NCH_ * 2112 * 4);
constexpr size_t R_MLO = R_ATT + al256((size_t)NT_ * 512 * 2);
constexpr size_t R_RWO = R_MLO + al256((size_t)NT_ * 256 * 2);
constexpr size_t R_VT = R_RWO + al256((size_t)NT_ * 256 * 2);
constexpr size_t R_KB = R_VT + al256((size_t)NB_ * MLA_H * 64 * KT_ * 2);
constexpr size_t R_MIX_END = R_KB + al256((size_t)NB_ * MLA_H * KT_ * 96 * 2);
constexpr int NSLOT_ = NT_ * 9;
constexpr size_t R_YBUF = 0;
constexpr size_t R_EIDX = R_YBUF + al256((size_t)NSLOT_ * 1024 * 2);
constexpr size_t R_EWT = R_EIDX + al256((size_t)NT_ * 8 * 4);
constexpr size_t R_ERANK = R_EWT + al256((size_t)NT_ * 8 * 4);
constexpr size_t R_ELIST = R_ERANK + al256((size_t)NT_ * 8 * 4);
constexpr size_t R_WMOE = R_ELIST + al256((size_t)64 * NT_ * 4);
constexpr size_t R_MOE_END = R_WMOE + WE_SIZE;
constexpr size_t R_SIZE = R_MIX_END > R_MOE_END ? R_MIX_END : R_MOE_END;
constexpr size_t WS_NEEDED = OFF_REGION + R_SIZE;
constexpr size_t O_ZMLA = 0;
constexpr size_t O_QB = O_ZMLA + al256((size_t)NT_ * ZMLA_W * 2);
constexpr size_t O_END = O_QB + al256((size_t)NT_ * 768 * 2);
constexpr size_t O_YMIX = 0;
#if SEQ_T == 8192 && CTX_L == 256
static_assert(O_END <= (size_t)NX_ * 1024 * 4, "d_out scratch overflow");
static_assert((size_t)NT_ * 1024 * 2 <= (size_t)NX_ * 1024 * 4, "ymix overflow");
static_assert(WS_NEEDED <= (size_t)597000000, "workspace too large");
#endif

struct Params {
  const float *x, *c, *ctx, *c_ctx, *w_mod, *b_mod, *g_mix, *g_ffn, *w_in, *g_cq, *w_uq, *g_ckv, *w_uk, *w_uv;
  const float *ml_b_i, *ml_b_f, *ml_g_norm, *rw_mu, *rw_w0, *rw_w2, *rw_a0, *rw_a2, *rw_g2, *rw_k_k, *rw_k_a;
  const float *rw_r_k, *rw_lnx_w, *rw_lnx_b, *w_br_mla, *w_br_ml, *w_br_rw, *w_out, *w_router, *router_bias;
  const float *w_e_gate, *w_e_up, *w_e_down, *w_s_gate, *w_s_up, *w_s_down, *g_final;
  float* out; char* ws; char* osc;
};

DI float bf2f(bf16_t s) { unsigned u = ((unsigned)s) << 16; float f; __builtin_memcpy(&f, &u, 4); return f; }
DI bf16_t f2bf(float x) { unsigned u; __builtin_memcpy(&u, &x, 4); u += 0x7fffu + ((u >> 16) & 1u); return (bf16_t)(u >> 16); }
DI unsigned pack2bf(float a, float b) {
#ifdef EMU
  return (unsigned)f2bf(a) | ((unsigned)f2bf(b) << 16);
#else
  typedef __bf16 bf2 __attribute__((ext_vector_type(2)));
  typedef float f2 __attribute__((ext_vector_type(2)));
  f2 v = {a, b}; bf2 r = __builtin_convertvector(v, bf2); return __builtin_bit_cast(unsigned, r);
#endif
}
DI f32x16 mfma32(bf16x8 a, bf16x8 b, f32x16 c) {
#ifdef EMU
  return emu_mfma_32x32x16_bf16(a, b, c);
#else
  return __builtin_amdgcn_mfma_f32_32x32x16_bf16(a, b, c, 0, 0, 0);
#endif
}
DI int rfl(int v) {
#ifdef EMU
  return v;
#else
  return __builtin_amdgcn_readfirstlane(v);
#endif
}
DI int opaque_tid() {
#ifdef EMU
  return threadIdx.x;
#else
  int t = threadIdx.x; asm volatile("" : "+v"(t)); return t;
#endif
}
DI void wave_sync() {
#ifdef EMU
  (void)__ballot(1);
#else
  asm volatile("" ::: "memory");
#endif
}
DI int vblock() {
  const int g = gridDim.x, b = blockIdx.x;
  return (g & 7) == 0 ? (b & 7) * (g >> 3) + (b >> 3) : b;
}
DI int xcc_id() {
#ifdef EMU
  return blockIdx.x & 7;
#else
  return (int)(__builtin_amdgcn_s_getreg((3 << 11) | 20) & 7u);
#endif
}
DI int ld_relaxed(int* p) {
#ifdef EMU
  return __atomic_load_n(p, __ATOMIC_SEQ_CST);
#else
  return __hip_atomic_load(p, __ATOMIC_RELAXED, __HIP_MEMORY_SCOPE_AGENT);
#endif
}
DI void sched_fence() {
#ifndef EMU
  __builtin_amdgcn_sched_barrier(0);
#endif
}
template <int L> DI float lane_bcast(float x) {
#ifdef EMU
  return __shfl(x, L);
#else
  return __builtin_bit_cast(float, __builtin_amdgcn_readlane(__builtin_bit_cast(int, x), L));
#endif
}
DI f32x16 zero16() { f32x16 z; for (int i = 0; i < 16; ++i) z[i] = 0.f; return z; }
DI int crow(int reg, int h) { return (reg & 3) + 8 * (reg >> 2) + 4 * h; }
#ifdef EMU
DI float fexp(float x) { return expf(x); }
#else
DI float fexp(float x) { return __expf(x); }
#endif
#ifdef EMU
DI float frcp(float x) { return 1.f / x; }
DI float frsq(float x) { return 1.f / sqrtf(x); }
#else
DI float frcp(float x) { return __builtin_amdgcn_rcpf(x); }
DI float frsq(float x) { return __builtin_amdgcn_rsqf(x); }
#endif
#ifdef EMU
DI float flog(float x) { return logf(x); }
#else
DI float flog(float x) { return __builtin_amdgcn_logf(x) * 0.6931471805599453f; }
#endif
DI float sigmoidf_(float x) { return frcp(1.f + fexp(-x)); }
DI float siluf_(float x) { return x * sigmoidf_(x); }
#ifdef EMU
DI float wave_sum(float v) { for (int m = 32; m >= 1; m >>= 1) v += __shfl_xor(v, m); return v; }
DI float wave_max(float v) { for (int m = 32; m >= 1; m >>= 1) v = fmaxf(v, __shfl_xor(v, m)); return v; }
#else
#define DPPF(x, ctrl) __builtin_bit_cast(float, __builtin_amdgcn_mov_dpp(__builtin_bit_cast(int, (x)), (ctrl), 0xf, 0xf, true))
#define RDLF(x, l) __builtin_bit_cast(float, __builtin_amdgcn_readlane(__builtin_bit_cast(int, (x)), (l)))
DI float wave_sum(float v) {
  v += DPPF(v, 0xB1); v += DPPF(v, 0x4E); v += DPPF(v, 0x124); v += DPPF(v, 0x128);
  return (RDLF(v, 0) + RDLF(v, 16)) + (RDLF(v, 32) + RDLF(v, 48));
}
DI float wave_max(float v) {
  v = fmaxf(v, DPPF(v, 0xB1)); v = fmaxf(v, DPPF(v, 0x4E)); v = fmaxf(v, DPPF(v, 0x124)); v = fmaxf(v, DPPF(v, 0x128));
  return fmaxf(fmaxf(RDLF(v, 0), RDLF(v, 16)), fmaxf(RDLF(v, 32), RDLF(v, 48)));
}
#endif

DI int tok_b(int n) { return n < NX_ ? n / T_ : (n - NX_) / CL_; }
DI int tok_t(int n) { return n < NX_ ? n % T_ : (n - NX_) % CL_; }
DI int tok_key(int n) { return n < NX_ ? CL_ + n % T_ : (n - NX_) % CL_; }
DI int tok_modrow(int n) { return n < NX_ ? n / T_ : 2; }

#ifdef EMU
#define SMEM_DECL(name, bytes) char* name = (char*)emu::shared_alloc(bytes)
#else
#define SMEM_DECL(name, bytes) __shared__ __attribute__((aligned(16))) char name[bytes]
#endif
#define NTHR 512
#if defined(PROBE_IDX) && !defined(EMU)
#define TSB(pp, i) { if (blockIdx.x == 0 && threadIdx.x == 0) ((long long*)((pp).ws + OFF_CNT + 2048))[i] = wall_clock64(); }
#else
#define TSB(pp, i)
#endif
struct CvtJob { const float* src; int lds; int K; bf16_t* dst; int ntn; int ntk; int maptype; const float* gain; };
DI int cvt_map(int maptype, int coff, int np) {
  if (maptype == 0) return coff + np;
  if (maptype == 1) { if (np < 672) return np; if (np < 768) return -1; if (np < 768 + 1936) return np - 96; return -1; }
  return np;
}
struct CvtItem { CvtJob j; int coff, tk, tn; };
struct CvtRegs { float v[8]; };
DI void cvt_load(const CvtItem& c, int tid, CvtRegs& r) {
  const int kk = tid >> 4, np = c.tn * 64 + (tid & 15) * 4;
  const int sc = cvt_map(c.j.maptype, c.coff, np);
#pragma unroll
  for (int u = 0; u < 2; ++u) {
    const int k = c.tk * 64 + kk + 32 * u;
    float4 v = make_float4(0.f, 0.f, 0.f, 0.f);
    if (sc >= 0) v = *(const float4*)(c.j.src + (size_t)k * c.j.lds + sc);
    const float g = c.j.gain ? c.j.gain[k] : 1.f;
    r.v[4 * u] = v.x * g; r.v[4 * u + 1] = v.y * g; r.v[4 * u + 2] = v.z * g; r.v[4 * u + 3] = v.w * g;
  }
}
DI void cvt_store(const CvtItem& c, int tid, const CvtRegs& r, char* smem) {
  float* tile = (float*)smem;
  __syncthreads();
  {
    const int kk = tid >> 4, nc = (tid & 15) * 4;
#pragma unroll
    for (int u = 0; u < 2; ++u)
#pragma unroll
      for (int i = 0; i < 4; ++i) tile[(kk + 32 * u) * 65 + nc + i] = r.v[4 * u + i];
  }
  __syncthreads();
  {
    const int n = tid >> 3, kc = (tid & 7) * 8;
    int np = c.tn * 64 + n;
    if (c.j.maptype == 2) np = (np >> 5) * 64 + c.coff * 32 + (np & 31);
    uint4 v;
    v.x = pack2bf(tile[(kc + 0) * 65 + n], tile[(kc + 1) * 65 + n]);
    v.y = pack2bf(tile[(kc + 2) * 65 + n], tile[(kc + 3) * 65 + n]);
    v.z = pack2bf(tile[(kc + 4) * 65 + n], tile[(kc + 5) * 65 + n]);
    v.w = pack2bf(tile[(kc + 6) * 65 + n], tile[(kc + 7) * 65 + n]);
    *(uint4*)(c.j.dst + (size_t)np * c.j.K + c.tk * 64 + kc) = v;
  }
}
template <class Dec> DI void cvt_run(Dec dec, int first, int n, int stride, char* smem) {
  const int tid = opaque_tid();
  if (first >= n) return;
  CvtItem cur = dec(first); CvtRegs rc; cvt_load(cur, tid, rc);
  for (int it = first; it < n; it += stride) {
    const int nx = it + stride < n ? it + stride : it;
    CvtItem nxt = dec(nx); CvtRegs rn; cvt_load(nxt, tid, rn);
    sched_fence();
    cvt_store(cur, tid, rc, smem);
    cur = nxt; rc = rn;
  }
}

constexpr int CVT_MIX_TILES = 704 + 768 + 72 + 32 + 32 + 128 + 64 + 64 + 256 + 16;
DI CvtItem cvt_mix_dec(const Params& p, int l, int it) {
  bf16_t* W = (bf16_t*)(p.ws + OFF_WMIX + (size_t)l * WM_SIZE);
  CvtJob j; int coff = 0;
  if (it < 704) { j = {p.w_in + (size_t)l * 1024 * D_IN_, D_IN_, 1024, (bf16_t*)((char*)W + WM_WIN), 44, 16, 1, nullptr}; }
  else if ((it -= 704) < 768) { j = {p.w_in + (size_t)l * 1024 * D_IN_, D_IN_, 1024, (bf16_t*)((char*)W + WM_GATE), 48, 16, 0, nullptr}; coff = 2608; }
  else if ((it -= 768) < 72) { j = {p.w_uq + (size_t)l * 384 * 768, 768, 384, (bf16_t*)((char*)W + WM_UQ), 12, 6, 0, p.g_cq + l * 384}; }
  else if ((it -= 72) < 32) { j = {p.w_uk + (size_t)l * 256 * 512, 512, 256, (bf16_t*)((char*)W + WM_UKV), 8, 4, 0, p.g_ckv + l * 256}; }
  else if ((it -= 32) < 32) { j = {p.w_uv + (size_t)l * 256 * 512, 512, 256, (bf16_t*)((char*)W + WM_UKV) + 512 * 256, 8, 4, 0, p.g_ckv + l * 256}; }
  else if ((it -= 32) < 128) { j = {p.w_br_mla + (size_t)l * 512 * 1024, 1024, 512, (bf16_t*)((char*)W + WM_BRA), 16, 8, 0, nullptr}; }
  else if ((it -= 128) < 64) { j = {p.w_br_ml + (size_t)l * 256 * 1024, 1024, 256, (bf16_t*)((char*)W + WM_BRM), 16, 4, 0, nullptr}; }
  else if ((it -= 64) < 64) { j = {p.w_br_rw + (size_t)l * 256 * 1024, 1024, 256, (bf16_t*)((char*)W + WM_BRR), 16, 4, 0, nullptr}; }
  else if ((it -= 64) < 256) { j = {p.w_out + (size_t)l * 1024 * 1024, 1024, 1024, (bf16_t*)((char*)W + WM_OUT), 16, 16, 0, nullptr}; }
  else { it -= 256; j = {p.w_router + (size_t)l * 1024 * 64, 64, 1024, (bf16_t*)((char*)W + WM_RT), 1, 16, 0, nullptr}; }
  CvtItem c; c.j = j; c.coff = coff; c.tk = it / j.ntn; c.tn = it % j.ntn; return c;
}
constexpr int CVT_MOE_TILES = 65 * 192;
DI CvtItem cvt_moe_dec(const Params& p, int l, int it) {
  const int e = it / 192; int r = it % 192;
  bf16_t* GU = (bf16_t*)(p.ws + OFF_REGION + R_WMOE + WE_GU) + (size_t)e * 512 * 1024;
  bf16_t* DN = (bf16_t*)(p.ws + OFF_REGION + R_WMOE + WE_DN) + (size_t)e * 1024 * 256;
  const float* sg = e < 64 ? p.w_e_gate + ((size_t)l * 64 + e) * 1024 * 256 : p.w_s_gate + (size_t)l * 1024 * 256;
  const float* su = e < 64 ? p.w_e_up + ((size_t)l * 64 + e) * 1024 * 256 : p.w_s_up + (size_t)l * 1024 * 256;
  const float* sd = e < 64 ? p.w_e_down + ((size_t)l * 64 + e) * 256 * 1024 : p.w_s_down + (size_t)l * 256 * 1024;
  CvtJob j; int coff = 0;
  if (r < 64) { j = {sg, 256, 1024, GU, 4, 16, 2, nullptr}; coff = 0; }
  else if ((r -= 64) < 64) { j = {su, 256, 1024, GU, 4, 16, 2, nullptr}; coff = 1; }
  else { r -= 64; j = {sd, 1024, 256, DN, 16, 4, 0, nullptr}; }
  CvtItem c; c.j = j; c.coff = coff; c.tk = r / j.ntn; c.tn = r % j.ntn; return c;
}

DI void mod_item(const Params& p, int it, char* smem) {
  float* cond = (float*)smem;
  float* red = cond + 3 * 1024;
  const int tid = opaque_tid(), l = it / 96, j0 = (it % 96) * 64;
  __syncthreads();
  for (int i = tid; i < 3 * 1024; i += NTHR) {
    const int r = i >> 10, k = i & 1023;
    const float v = r < 2 ? p.c[r * 1024 + k] : p.c_ctx[k];
    cond[i] = siluf_(v);
  }
  __syncthreads();
  const int jj = tid & 63, kg = tid >> 6;
  float a0 = 0.f, a1 = 0.f, a2 = 0.f;
  const float* w = p.w_mod + (size_t)l * 1024 * 6144 + j0 + jj;
  for (int k = kg; k < 1024; k += 8) {
    const float wv = w[(size_t)k * 6144];
    a0 += cond[k] * wv; a1 += cond[1024 + k] * wv; a2 += cond[2048 + k] * wv;
  }
  red[(kg * 3 + 0) * 64 + jj] = a0; red[(kg * 3 + 1) * 64 + jj] = a1; red[(kg * 3 + 2) * 64 + jj] = a2;
  __syncthreads();
  if (tid < 192) {
    const int r = tid >> 6; float s = 0.f;
    for (int g = 0; g < 8; ++g) s += red[(g * 3 + r) * 64 + jj];
    float* mod = (float*)(p.ws + OFF_MOD);
    mod[((size_t)l * 3 + r) * 6144 + j0 + jj] = s + p.b_mod[(size_t)l * 6144 + j0 + jj];
  }
}
DI void rope_item(const Params& p, int it) {
  const int idx = it * NTHR + threadIdx.x;
  if (idx >= T_ * 16) return;
  const int t = idx >> 4, i = idx & 15, f = i & 7;
  const float pos = (float)(i < 8 ? t / GRID_W_ : t % GRID_W_);
  const float inv = powf(10000.f, -(float)(2 * f) / 16.f);
  const float ang = pos * inv;
  float2* rt = (float2*)(p.ws + OFF_ROPE);
  rt[idx] = make_float2(cosf(ang), sinf(ang));
}
constexpr int PA_ITEMS = 192 + (T_ * 16 + NTHR - 1) / NTHR;
DI void phaseA(const Params& p, char* smem) {
  if (blockIdx.x == 0) for (int i = threadIdx.x; i < 8192; i += NTHR) ((int*)(p.ws + OFF_CNT))[i] = 0;
  for (int it = blockIdx.x; it < PA_ITEMS; it += gridDim.x) {
    if (it < 192) mod_item(p, it, smem); else rope_item(p, it - 192);
  }
  cvt_run([&](int i) { return cvt_mix_dec(p, i / CVT_MIX_TILES, i % CVT_MIX_TILES); }, blockIdx.x, 2 * CVT_MIX_TILES, gridDim.x, smem);
}

DI void row_norm_mod(const float (&v)[16], const float* g, const float* shift, const float* scale, bf16_t* hrow, int lane) {
  float ss = 0.f;
#pragma unroll
  for (int i = 0; i < 16; ++i) ss += v[i] * v[i];
  ss = wave_sum(ss);
  const float rs = frsq(ss * (1.f / 1024.f) + 1e-6f);
#pragma unroll
  for (int j = 0; j < 4; ++j) {
    const int c = (j * 64 + lane) * 4;
    const float4 gg = *(const float4*)(g + c), sh = *(const float4*)(shift + c), sc = *(const float4*)(scale + c);
    const float h0 = v[j * 4 + 0] * rs * gg.x * (1.f + sc.x) + sh.x;
    const float h1 = v[j * 4 + 1] * rs * gg.y * (1.f + sc.y) + sh.y;
    const float h2 = v[j * 4 + 2] * rs * gg.z * (1.f + sc.z) + sh.z;
    const float h3 = v[j * 4 + 3] * rs * gg.w * (1.f + sc.w) + sh.w;
    uint2 o; o.x = pack2bf(h0, h1); o.y = pack2bf(h2, h3);
    *(uint2*)(hrow + c) = o;
  }
}
DI void phase_norm0(const Params& p) {
  const int lane = threadIdx.x & 63, wid = threadIdx.x >> 6;
  float* xs = (float*)(p.ws + OFF_XS);
  bf16_t* H = (bf16_t*)(p.ws + OFF_H);
  const float* mod = (const float*)(p.ws + OFF_MOD);
  for (int n = blockIdx.x * 8 + wid; n < NT_; n += gridDim.x * 8) {
    const float* src = n < NX_ ? p.x + (size_t)n * 1024 : p.ctx + (size_t)(n - NX_) * 1024;
    float v[16];
#pragma unroll
    for (int j = 0; j < 4; ++j) {
      const float4 t = *(const float4*)(src + (j * 64 + lane) * 4);
      v[j * 4] = t.x; v[j * 4 + 1] = t.y; v[j * 4 + 2] = t.z; v[j * 4 + 3] = t.w;
      *(float4*)(xs + (size_t)n * 1024 + (j * 64 + lane) * 4) = t;
    }
    const float* m = mod + (size_t)(0 * 3 + tok_modrow(n)) * 6144;
    row_norm_mod(v, p.g_mix, m, m + 1024, H + (size_t)n * 1024, lane);
  }
}

template <int BM, int BN, int BK, int WM_, int WN_>
struct Gemm {
  static constexpr int WTM = BM / WM_, WTN = BN / WN_, MB = WTM / 32, NB = WTN / 32, WM = WM_, WN = WN_, TM = BM, TN = BN;
  static constexpr int LDA = BK + 8;
  static constexpr int A_BYTES = BM * LDA * 2, B_BYTES = BN * LDA * 2, STAGE = A_BYTES + B_BYTES;
  static constexpr int SMEM = 2 * STAGE;
  static constexpr int CPR = BK / 8;
  static constexpr int ACH = BM * CPR / NTHR, BCH = BN * CPR / NTHR;
  static_assert(WM_ * WN_ == 8, "8 waves");
  static_assert(BM * CPR % NTHR == 0 && BN * CPR % NTHR == 0, "chunking");
  static_assert(NTHR % CPR == 0, "rows fixed per thread");

  template <class LA, class LB>
  static DI void run_core(f32x16 (&acc)[MB][NB], LA la, LB lb, int nk, char* smem, int tid) {
    const int lane = tid & 63, wid = tid >> 6, wm = wid / WN_, wn = wid % WN_;
    const int kc = (tid % CPR) * 8, r0 = tid / CPR;
    constexpr int KS = BK / 16, NCH = ACH + BCH;
    u32x4 s0[NCH], s1[NCH];
#define GEMM_LOAD(dst_, kt_) { const int kq_ = (kt_) < nk ? (kt_) : nk - 1; \
    _Pragma("unroll") for (int i = 0; i < ACH; ++i) dst_[i] = la(i, kq_); \
    _Pragma("unroll") for (int i = 0; i < BCH; ++i) dst_[ACH + i] = lb(i, kq_); }
#define GEMM_WRITE1(src_, c_, buf_) { if ((c_) < ACH) *(u32x4*)(smem + (buf_) * STAGE + ((r0 + (c_) * (NTHR / CPR)) * LDA + kc) * 2) = src_[c_]; \
    else *(u32x4*)(smem + (buf_) * STAGE + A_BYTES + ((r0 + ((c_) - ACH) * (NTHR / CPR)) * LDA + kc) * 2) = src_[c_]; }
#define GEMM_STEP(w_, l_, kt_) { \
    GEMM_LOAD(l_, (kt_) + 2); \
    sched_fence(); \
    const char* As = smem + ((kt_) & 1) * STAGE; const char* Bs = As + A_BYTES; \
    _Pragma("unroll") for (int ks = 0; ks < KS; ++ks) { \
      bf16x8 af[MB], bfr[NB]; \
      _Pragma("unroll") for (int mb = 0; mb < MB; ++mb) af[mb] = *(const bf16x8*)(As + ((wm * WTM + mb * 32 + (lane & 31)) * LDA + ks * 16 + (lane >> 5) * 8) * 2); \
      _Pragma("unroll") for (int nb = 0; nb < NB; ++nb) bfr[nb] = *(const bf16x8*)(Bs + ((wn * WTN + nb * 32 + (lane & 31)) * LDA + ks * 16 + (lane >> 5) * 8) * 2); \
      _Pragma("unroll") for (int c = 0; c < NCH; ++c) if ((c * KS) / NCH == ks) GEMM_WRITE1(w_, c, ((kt_) + 1) & 1); \
      _Pragma("unroll") for (int mb = 0; mb < MB; ++mb) _Pragma("unroll") for (int nb = 0; nb < NB; ++nb) acc[mb][nb] = mfma32(af[mb], bfr[nb], acc[mb][nb]); \
    } \
    sched_fence(); \
    __syncthreads(); }
    GEMM_LOAD(s0, 0);
#pragma unroll
    for (int c = 0; c < NCH; ++c) GEMM_WRITE1(s0, c, 0);
    GEMM_LOAD(s0, 1);
    __syncthreads();
    for (int kt = 0; kt < nk; kt += 2) {
      GEMM_STEP(s0, s1, kt);
      GEMM_STEP(s1, s0, kt + 1);
    }
#undef GEMM_STEP
#undef GEMM_WRITE1
#undef GEMM_LOAD
  }
  template <class ARow>
  static DI void run(f32x16 (&acc)[MB][NB], ARow arow, const bf16_t* Bt, int ldb, int Klen, char* smem) {
    const int tid = opaque_tid();
    const int kc = (tid % CPR) * 8, r0 = tid / CPR;
    const bf16_t* ap[ACH];
#pragma unroll
    for (int i = 0; i < ACH; ++i) ap[i] = arow(r0 + i * (NTHR / CPR)) + kc;
    const bf16_t* bp0 = Bt + (size_t)r0 * ldb + kc;
    const size_t sb = (size_t)(NTHR / CPR) * ldb;
    run_core(acc, [&](int i, int kt) { return *(const u32x4*)(ap[i] + kt * BK); },
             [&](int i, int kt) { return *(const u32x4*)(bp0 + i * sb + kt * BK); }, Klen / BK, smem, tid);
  }
  static DI void run_lin(f32x16 (&acc)[MB][NB], const bf16_t* A0, int lda, const bf16_t* Bt, int ldb, int Klen, char* smem) {
    const int tid = opaque_tid();
    const int kc = (tid % CPR) * 8, r0 = tid / CPR;
    const bf16_t* ap0 = A0 + (size_t)r0 * lda + kc; const bf16_t* bp0 = Bt + (size_t)r0 * ldb + kc;
    const size_t sa = (size_t)(NTHR / CPR) * lda, sb = (size_t)(NTHR / CPR) * ldb;
    run_core(acc, [&](int i, int kt) { return *(const u32x4*)(ap0 + i * sa + kt * BK); },
             [&](int i, int kt) { return *(const u32x4*)(bp0 + i * sb + kt * BK); }, Klen / BK, smem, tid);
  }
  static DI int row_of(int t, int mb, int reg) { const int lane = t & 63, wm = (t >> 6) / WN_; return wm * WTM + mb * 32 + crow(reg, lane >> 5); }
  static DI int col_of(int t, int nb) { const int lane = t & 63, wn = (t >> 6) % WN_; return wn * WTN + nb * 32 + (lane & 31); }
};


template <int NBW> struct WTile {
  static constexpr int LD = NBW * 32 + 4;
  static constexpr int BYTES = 32 * LD * 4;
  static DI void put(float* scr, int nb, int lane, const f32x16& v) {
    const int c = nb * 32 + (lane & 31), h = lane >> 5;
#pragma unroll
    for (int i = 0; i < 16; ++i) scr[crow(i, h) * LD + c] = v[i];
  }
  template <class F> static DI void rows4(const float* scr, int lane, F f) {
    wave_sync();
#pragma unroll
    for (int it = 0; it < NBW * 4; ++it) {
      const int id = it * 64 + lane, row = id / (NBW * 8), q = id % (NBW * 8);
      f(row, q * 4, *(const float4*)(scr + row * LD + q * 4));
    }
    wave_sync();
  }
  template <class F> static DI void rows8(const float* scr, int lane, F f) {
    wave_sync();
#pragma unroll
    for (int it = 0; it < NBW * 2; ++it) {
      const int id = it * 64 + lane, row = id / (NBW * 4), q = id % (NBW * 4);
      f(row, q * 8, *(const float4*)(scr + row * LD + q * 8), *(const float4*)(scr + row * LD + q * 8 + 4));
    }
    wave_sync();
  }
};
DI uint4 pack8bf(const float4& a, const float4& b) { return make_uint4(pack2bf(a.x, a.y), pack2bf(a.z, a.w), pack2bf(b.x, b.y), pack2bf(b.z, b.w)); }

typedef Gemm<256, 256, 64, 2, 4> G256;
DI void phase_win(const Params& p, int l, char* smem) {
  const bf16_t* H = (const bf16_t*)(p.ws + OFF_H);
  const bf16_t* W = (const bf16_t*)(p.ws + OFF_WMIX + (size_t)l * WM_SIZE + WM_WIN);
  bf16_t* zmla = (bf16_t*)(p.osc + O_ZMLA);
  float* zrec = (float*)(p.ws + OFF_REGION + R_ZREC);
  constexpr int TM = NT_ / 256, TN = WIN_N / 256;
  for (int it = vblock(); it < TM * TN; it += gridDim.x) {
    const int tid = opaque_tid();
    const int tm = it / TN, tn = it % TN;
    __syncthreads();
    f32x16 acc[G256::MB][G256::NB];
#pragma unroll
    for (int a = 0; a < G256::MB; ++a)
#pragma unroll
      for (int b = 0; b < G256::NB; ++b) acc[a][b] = zero16();
    const bf16_t* A0 = H + (size_t)tm * 256 * 1024;
    G256::run(acc, [&](int r) { return A0 + (size_t)r * 1024; }, W + (size_t)tn * 256 * 1024, 1024, 1024, smem);
    {
      const int lane = tid & 63, wid = tid >> 6, wm = wid / 4, wn = wid % 4;
      float* scr = (float*)(smem + wid * WTile<2>::BYTES);
      const int col0 = tn * 256 + wn * 64;
#pragma unroll
      for (int mb = 0; mb < G256::MB; ++mb) {
        WTile<2>::put(scr, 0, lane, acc[mb][0]); WTile<2>::put(scr, 1, lane, acc[mb][1]);
        const int row0 = tm * 256 + wm * 128 + mb * 32;
#ifdef ABL_NOSTORE
        if (tn > 1000) {
#else
        if (tn < 3) {
#endif
          WTile<2>::rows8(scr, lane, [&](int r, int c, const float4& a, const float4& bq) {
            *(uint4*)(zmla + (size_t)(row0 + r) * ZMLA_W + col0 + c) = pack8bf(a, bq); });
        } else {
          WTile<2>::rows4(scr, lane, [&](int r, int c, const float4& a) {
            const int cc = col0 - 768 + c;
#ifdef ABL_NOSTORE
            if (cc < -5) *(float4*)(zrec + (size_t)(row0 + r) * ZREC_W + cc) = a; });
#else
            if (cc < ZREC_W) *(float4*)(zrec + (size_t)(row0 + r) * ZREC_W + cc) = a; });
#endif
        }
      }
    }
  }
}
typedef Gemm<128, 128, 64, 2, 4> G128;
DI void mla_row_rs(const bf16_t* zmla_rows, int c0, int len, float* rs) {
  const int tid = opaque_tid(), row = tid >> 2, half = tid & 3;
  const bf16_t* src = zmla_rows + (size_t)row * ZMLA_W + c0 + half * (len / 4);
  float ss = 0.f;
  for (int i = 0; i < len / 4; i += 8) {
    const uint4 v = *(const uint4*)(src + i);
    const unsigned w[4] = {v.x, v.y, v.z, v.w};
#pragma unroll
    for (int j = 0; j < 4; ++j) { const float a = bf2f((bf16_t)(w[j] & 0xffff)), b = bf2f((bf16_t)(w[j] >> 16)); ss += a * a + b * b; }
  }
  ss += __shfl_xor(ss, 1); ss += __shfl_xor(ss, 2);
  if (half == 0) rs[row] = frsq(ss / (float)len + 1e-6f);
}

constexpr int MLA_Q_TILES = (NT_ / 128) * 6, MLA_KV_TILES = (NT_ / 128) * 8;
DI void mla_q_item(const Params& p, int l, int it, char* smem) {
  const int tid = opaque_tid();
  const int tm = it / 6, tn = it % 6;
  const bf16_t* zmla = (const bf16_t*)(p.osc + O_ZMLA) + (size_t)tm * 128 * ZMLA_W;
  const bf16_t* W = (const bf16_t*)(p.ws + OFF_WMIX + (size_t)l * WM_SIZE + WM_UQ) + (size_t)tn * 128 * 384;
  bf16_t* qb = (bf16_t*)(p.osc + O_QB);
  const float2* rt = (const float2*)(p.ws + OFF_ROPE);
  float* rs = (float*)(smem + G128::SMEM);
  __syncthreads();
  mla_row_rs(zmla, 0, 384, rs);
  f32x16 acc[G128::MB][G128::NB];
#pragma unroll
  for (int a = 0; a < G128::MB; ++a)
#pragma unroll
    for (int b = 0; b < G128::NB; ++b) acc[a][b] = zero16();
  G128::run(acc, [&](int r) { return zmla + (size_t)r * ZMLA_W; }, W, 384, 384, smem);
  const int lane = tid & 63;
  const bool isx = tm * 128 < NX_;
#pragma unroll
  for (int mb = 0; mb < G128::MB; ++mb)
#pragma unroll
    for (int nb = 0; nb < G128::NB; ++nb) {
      const int col = tn * 128 + G128::col_of(tid, nb);
      const bool ropeblk = ((col >> 5) % 3) == 2;
      const int e = lane & 31;
#pragma unroll
      for (int i = 0; i < 16; ++i) {
        const int lr = G128::row_of(tid, mb, i);
        const int n = tm * 128 + lr;
        float v = acc[mb][nb][i] * rs[lr];
        if (ropeblk && isx) {
          const float pv = __shfl_xor(v, 8);
          const float2 cs = rt[(size_t)(n % T_) * 16 + (e >> 4) * 8 + (e & 7)];
          v = (e & 8) ? (pv * cs.y + v * cs.x) : (v * cs.x - pv * cs.y);
        }
        qb[(size_t)n * 768 + col] = f2bf(v);
      }
    }
}
DI void mla_kv_item(const Params& p, int l, int it, char* smem) {
  const int tid = opaque_tid();
  const int tm = it / 8, tn = it % 8;
  const bf16_t* zmla = (const bf16_t*)(p.osc + O_ZMLA) + (size_t)tm * 128 * ZMLA_W;
  const bf16_t* W = (const bf16_t*)(p.ws + OFF_WMIX + (size_t)l * WM_SIZE + WM_UKV) + (size_t)tn * 128 * 256;
  bf16_t* kb = (bf16_t*)(p.ws + OFF_REGION + R_KB);
  bf16_t* vt = (bf16_t*)(p.ws + OFF_REGION + R_VT);
  const float2* rt = (const float2*)(p.ws + OFF_ROPE);
  float* rs = (float*)(smem + G128::SMEM);
  __syncthreads();
  mla_row_rs(zmla, 384, 256, rs);
  const int n0 = tm * 128;
  const int b = tok_b(n0), key0 = tok_key(n0);
  const bool isx = n0 < NX_;
  if (tn == 0) {
    for (int idx = tid; idx < 128 * 16; idx += NTHR) {
      const int lr = idx >> 4, pi = idx & 15, a = pi >> 3, i = pi & 7;
      const bf16_t* z = zmla + (size_t)lr * ZMLA_W + 640 + a * 16 + i;
      float x1 = bf2f(z[0]), x2 = bf2f(z[8]);
      if (isx) {
        const float2 cs = rt[(size_t)((n0 + lr) % T_) * 16 + a * 8 + i];
        const float y1 = x1 * cs.x - x2 * cs.y, y2 = x1 * cs.y + x2 * cs.x; x1 = y1; x2 = y2;
      }
      const bf16_t o1 = f2bf(x1), o2 = f2bf(x2);
      for (int h = 0; h < 8; ++h) {
        bf16_t* dst = kb + ((size_t)(b * 8 + h) * KT_ + key0 + lr) * 96 + 64 + a * 16 + i;
        dst[0] = o1; dst[8] = o2;
      }
    }
  }
  f32x16 acc[G128::MB][G128::NB];
#pragma unroll
  for (int a = 0; a < G128::MB; ++a)
#pragma unroll
    for (int c = 0; c < G128::NB; ++c) acc[a][c] = zero16();
  G128::run(acc, [&](int r) { return zmla + (size_t)r * ZMLA_W + 384; }, W, 256, 256, smem);
  const int lane = tid & 63;
#pragma unroll
  for (int mb = 0; mb < G128::MB; ++mb)
#pragma unroll
    for (int nb = 0; nb < G128::NB; ++nb) {
      const int col = tn * 128 + G128::col_of(tid, nb);
      if (col < 512) {
        const int h = col >> 6, d = col & 63;
#pragma unroll
        for (int i = 0; i < 16; ++i) {
          const int lr = G128::row_of(tid, mb, i);
          kb[((size_t)(b * 8 + h) * KT_ + key0 + lr) * 96 + d] = f2bf(acc[mb][nb][i] * rs[lr]);
        }
      } else {
        const int h = (col - 512) >> 6, d = col & 63;
#pragma unroll
        for (int g = 0; g < 4; ++g) {
          const int lr = G128::row_of(tid, mb, g * 4);
          uint2 o;
          o.x = pack2bf(acc[mb][nb][g * 4 + 0] * rs[lr], acc[mb][nb][g * 4 + 1] * rs[lr + 1]);
          o.y = pack2bf(acc[mb][nb][g * 4 + 2] * rs[lr + 2], acc[mb][nb][g * 4 + 3] * rs[lr + 3]);
          *(uint2*)(vt + ((size_t)(b * 8 + h) * 64 + d) * KT_ + key0 + lr) = o;
        }
      }
    }
  (void)lane;
}

DI float softplusf_(float x) { const float e = fexp(-fabsf(x)); return fmaxf(x, 0.f) + (e < 0.01f ? e * (1.f - 0.5f * e) : flog(1.f + e)); }
constexpr int RWP_TT = 16;
constexpr int RWP_ITEMS = NT_ / RWP_TT;
DI void rwkv_prep_items(const Params& p, int l, char* smem) {
  if ((int)blockIdx.x >= RWP_ITEMS) return;
  float* zs = (float*)smem;
  float* tw = zs + RWP_TT * 1024;
  float* ta = tw + 2 * 64 * RWP_TT;
  const float* zrec = (const float*)(p.ws + OFF_REGION + R_ZREC);
  bf16_t* rb = (bf16_t*)(p.ws + OFF_REGION + R_RB16);
  float* lwo = (float*)(p.ws + OFF_REGION + R_LW);
  float* bso = (float*)(p.ws + OFF_REGION + R_BS);
  const float* mu = p.rw_mu + (size_t)l * 1152;
  const int tid = opaque_tid();
  const int col = tid & 255, d = tid >> 8;
  const float* w2 = p.rw_w2 + ((size_t)l * 2 + d) * 64 * 256 + col;
  const float* a2 = p.rw_a2 + ((size_t)l * 2 + d) * 64 * 256 + col;
  const float rkw = p.rw_r_k[(size_t)l * 256 + col];
  const float w0 = p.rw_w0[((size_t)l * 2 + d) * 256 + col], a0 = p.rw_a0[((size_t)l * 2 + d) * 256 + col];
  const float kkw = p.rw_k_k[(size_t)l * 256 + col], kaw = p.rw_k_a[(size_t)l * 256 + col];
  const size_t AS = (size_t)NT_ * 256;
#pragma unroll 1
  for (int it = blockIdx.x; it < RWP_ITEMS; it += gridDim.x) {
    const int n0 = it * RWP_TT;
    __syncthreads();
    TSB(p, 44);
#pragma unroll 1
    for (int i = 0; i < 8; ++i) {
      const int idx4 = tid + i * NTHR, tt = idx4 >> 8, c = (idx4 & 255) * 4, n = n0 + tt, t = tok_t(n);
      const int len = n < NX_ ? T_ : CL_;
      const float* zr = zrec + (size_t)n * ZREC_W + ZR_RW + c;
      const float4 z = *(const float4*)zr;
      const float4 zp = t > 0 ? *(const float4*)(zr - ZREC_W) : make_float4(0.f, 0.f, 0.f, 0.f);
      const float4 zn = t < len - 1 ? *(const float4*)(zr + ZREC_W) : make_float4(0.f, 0.f, 0.f, 0.f);
      const float4 m4 = *(const float4*)(mu + c);
      float4 sv;
      sv.x = z.x + (0.5f * (zp.x + zn.x) - z.x) * m4.x; sv.y = z.y + (0.5f * (zp.y + zn.y) - z.y) * m4.y;
      sv.z = z.z + (0.5f * (zp.z + zn.z) - z.z) * m4.z; sv.w = z.w + (0.5f * (zp.w + zn.w) - z.w) * m4.w;
      *(float4*)(zs + tt * 1024 + c) = sv;
      if (c >= 768) {
        const float e4[4] = {sv.x, sv.y, sv.z, sv.w};
#pragma unroll
        for (int q = 0; q < 4; ++q) {
          const int cc = c + q;
          if (cc < 896) { const int dd = (cc - 768) >> 6, k = (cc - 768) & 63; tw[(dd * 64 + k) * RWP_TT + tt] = 1.f - 2.f * frcp(1.f + fexp(2.f * e4[q])); }
          else { const int dd = (cc - 896) >> 6, k = (cc - 896) & 63; ta[(dd * 64 + k) * RWP_TT + tt] = e4[q]; }
        }
      }
    }
    __syncthreads();
    TSB(p, 45);
#pragma unroll 1
    for (int th = 0; th < RWP_TT; th += 8) {
      float aw[8], aa[8];
#pragma unroll
      for (int i = 0; i < 8; ++i) { aw[i] = 0.f; aa[i] = 0.f; }
#pragma unroll 1
      for (int kh = 0; kh < 4; ++kh) {
        float wr[16], ar[16];
#pragma unroll
        for (int k = 0; k < 16; ++k) { wr[k] = w2[(kh * 16 + k) * 256]; ar[k] = a2[(kh * 16 + k) * 256]; }
#pragma unroll
        for (int k = 0; k < 16; ++k) {
          const float* twk = tw + (d * 64 + kh * 16 + k) * RWP_TT + th;
          const float* tak = ta + (d * 64 + kh * 16 + k) * RWP_TT + th;
#pragma unroll
          for (int i = 0; i < 8; ++i) { aw[i] += twk[i] * wr[k]; aa[i] += tak[i] * ar[k]; }
          if ((k & 3) == 3) sched_fence();
        }
      }
#pragma unroll
      for (int i = 0; i < 8; ++i) {
        const int n = n0 + th + i;
        const float* zr = zs + (th + i) * 1024 + col;
        const float r = zr[0], k = zr[256], v = zr[512];
        const float kr = k * kkw;
        const float ss = wave_sum(kr * kr);
        const float kk = kr * frsq(fmaxf(ss, 1e-24f));
        const float w = -softplusf_(-(w0 + aw[i])) - 0.5f;
        const float logdecay = -fexp(w);
        const float a = sigmoidf_(a0 + aa[i]);
        const float kd = k * (1.f + (a - 1.f) * kaw);
        const float bsum = wave_sum(r * rkw * kd);
        const size_t o = (size_t)n * 256 + col;
        if (d == 0) { rb[0 * AS + o] = f2bf(r); rb[1 * AS + o] = f2bf(v); rb[2 * AS + o] = f2bf(kk); }
        lwo[d * AS + o] = logdecay;
        rb[(3 + 2 * d) * AS + o] = f2bf(kd);
        rb[(4 + 2 * d) * AS + o] = f2bf(kk * a);
        if ((tid & 63) == 0) bso[((size_t)d * NT_ + n) * 4 + (col >> 6)] = bsum;
      }
    }
    TSB(p, 47);
  }
}

DI int seq_tok(int dir, int b, int pos) {
  if (pos < CL_) return NX_ + b * CL_ + (dir ? CL_ - 1 - pos : pos);
  const int t = pos - CL_;
  return b * T_ + (dir ? T_ - 1 - t : t);
}
DI float logsigmoidf_(float x) { return -softplusf_(-x); }
DI float wave_incl_scan(float v, int lane) {
  for (int d = 1; d < 64; d <<= 1) { const float o = __shfl_up(v, d); if (lane >= d) v += o; }
  return v;
}
constexpr int ML_ST = 2112;
constexpr int ML1_ITEMS = NSEQ_ * NCH_;
DI void mlstm_local_item(const Params& p, int l, int it, char* smem) {
  const int s = it / NCH_, c = it % NCH_, dir = s >> 3, b = (s >> 2) & 1, hd = s & 3;
  float* vv = (float*)smem;
  float* kw = vv + 64 * 64;
  float* wej = kw + 64 * 32;
  const float* zrec = (const float*)(p.ws + OFF_REGION + R_ZREC);
  float* st = (float*)(p.ws + OFF_REGION + R_MLST) + ((size_t)s * NCH_ + c) * ML_ST;
  const int tid = opaque_tid(), lane = tid & 63, wid = tid >> 6;
  __syncthreads();
  if (wid == 0) {
    const int n = seq_tok(dir, b, c * 64 + lane);
    const float fp = zrec[(size_t)n * ZREC_W + ZR_MLF + dir * 4 + hd] + p.ml_b_f[(l * 2 + dir) * 4 + hd];
    const float ip = zrec[(size_t)n * ZREC_W + ZR_MLI + dir * 4 + hd] + p.ml_b_i[(l * 2 + dir) * 4 + hd];
    const float bj = wave_incl_scan(logsigmoidf_(fp), lane);
    const float bl = lane_bcast<63>(bj);
    const float lw = bl - bj + ip;
    const float ml = wave_max(lw);
    wej[lane] = fexp(lw - ml);
    if (lane == 0) { st[2080] = bl; st[2081] = ml; }
  }
  for (int idx = tid; idx < 64 * 64; idx += NTHR) {
    const int j = idx >> 6, e = idx & 63;
    const int n = seq_tok(dir, b, c * 64 + j);
    vv[idx] = zrec[(size_t)n * ZREC_W + ZR_MLV + hd * 64 + e];
  }
  __syncthreads();
  for (int idx = tid; idx < 64 * 32; idx += NTHR) {
    const int j = idx >> 5, e = idx & 31;
    const int n = seq_tok(dir, b, c * 64 + j);
    kw[idx] = zrec[(size_t)n * ZREC_W + ZR_MLK + hd * 32 + e] * wej[j];
  }
  __syncthreads();
  const int v = tid & 63, d0 = (tid >> 6) * 4;
  float a0 = 0.f, a1 = 0.f, a2 = 0.f, a3 = 0.f;
  for (int j = 0; j < 64; ++j) {
    const float x = vv[j * 64 + v];
    const float4 kk = *(const float4*)(kw + j * 32 + d0);
    a0 += x * kk.x; a1 += x * kk.y; a2 += x * kk.z; a3 += x * kk.w;
  }
  *(float4*)(st + v * 32 + d0) = make_float4(a0, a1, a2, a3);
  if (tid < 32) { float sn = 0.f; for (int j = 0; j < 64; ++j) sn += kw[j * 32 + tid]; st[2048 + tid] = sn; }
}
constexpr int ML2_ITEMS = (NSEQ_ * 2080 + NTHR - 1) / NTHR;
DI void mlstm_scan_item(const Params& p, int it) {
  const int g = it * NTHR + opaque_tid();
  if (g >= NSEQ_ * 2080) return;
  const int s = g / 2080, e = g % 2080;
  float* st = (float*)(p.ws + OFF_REGION + R_MLST) + (size_t)s * NCH_ * ML_ST;
  float state = 0.f, m = 0.f;
  static_assert(NCH_ % 4 == 0, "chunk count");
  for (int c0 = 0; c0 < NCH_; c0 += 4) {
    float d[4], bl[4], ml[4];
#pragma unroll
    for (int u = 0; u < 4; ++u) { const float* r = st + (size_t)(c0 + u) * ML_ST; d[u] = r[e]; bl[u] = r[2080]; ml[u] = r[2081]; }
#pragma unroll
    for (int u = 0; u < 4; ++u) {
      float* r = st + (size_t)(c0 + u) * ML_ST;
      r[e] = state;
      if (e == 0) r[2082] = m;
      const float mn = fmaxf(bl[u] + m, ml[u]);
      state = fexp(bl[u] + m - mn) * state + fexp(ml[u] - mn) * d[u];
      m = mn;
    }
  }
}

DI void phase3(const Params& p, int l, char* smem) {
  rwkv_prep_items(p, l, smem);
  for (int it = blockIdx.x; it < ML1_ITEMS; it += gridDim.x) { TSB(p, 56); mlstm_local_item(p, l, it, smem); TSB(p, 57); }
}
constexpr int RW_LD = 72, RW_MB = 64 * RW_LD * 2;
constexpr int RWC_REC = 40960;
DI char* rw_rec(const Params& p, int s, int c) { return p.ws + OFF_REGION + R_CH + ((size_t)s * NCH_ + c) * RWC_REC; }
DI f32x16 rw_mm(const char* A, const char* Bt, int mb, int nb, int lane, f32x16 acc) {
  const int r = lane & 31, h = lane >> 5;
#pragma unroll
  for (int ks = 0; ks < 4; ++ks) {
    const bf16x8 a = *(const bf16x8*)(A + ((mb * 32 + r) * RW_LD + ks * 16 + h * 8) * 2);
    const bf16x8 b = *(const bf16x8*)(Bt + ((nb * 32 + r) * RW_LD + ks * 16 + h * 8) * 2);
    acc = mfma32(a, b, acc);
  }
  return acc;
}
DI void rw_wrT(char* Dst, int mb, int nb, int lane, const f32x16& v) {
  const int r = lane & 31, h = lane >> 5;
#pragma unroll
  for (int g = 0; g < 4; ++g) {
    uint2 o; o.x = pack2bf(v[4 * g], v[4 * g + 1]); o.y = pack2bf(v[4 * g + 2], v[4 * g + 3]);
    *(uint2*)(Dst + ((nb * 32 + r) * RW_LD + mb * 32 + 8 * g + 4 * h) * 2) = o;
  }
}
DI void rw_wrT_g(bf16_t* Dst, int mb, int nb, int lane, const f32x16& v) {
  const int r = lane & 31, h = lane >> 5;
#pragma unroll
  for (int g = 0; g < 4; ++g) {
    uint2 o; o.x = pack2bf(v[4 * g], v[4 * g + 1]); o.y = pack2bf(v[4 * g + 2], v[4 * g + 3]);
    *(uint2*)(Dst + (nb * 32 + r) * 64 + mb * 32 + 8 * g + 4 * h) = o;
  }
}
DI void rw_addT(const char* Src, int mb, int nb, int lane, f32x16& v) {
  const int r = lane & 31, h = lane >> 5;
#pragma unroll
  for (int g = 0; g < 4; ++g) {
    const uint2 u = *(const uint2*)(Src + ((nb * 32 + r) * RW_LD + mb * 32 + 8 * g + 4 * h) * 2);
    v[4 * g] += bf2f((bf16_t)(u.x & 0xffff)); v[4 * g + 1] += bf2f((bf16_t)(u.x >> 16));
    v[4 * g + 2] += bf2f((bf16_t)(u.y & 0xffff)); v[4 * g + 3] += bf2f((bf16_t)(u.y >> 16));
  }
}
DI void rw_mask_upper(f32x16& v, int mb, int nb, int lane, bool strict) {
  const int col = nb * 32 + (lane & 31), h = lane >> 5;
#pragma unroll
  for (int i = 0; i < 16; ++i) { const int row = mb * 32 + crow(i, h); if (strict ? !(row < col) : !(row <= col)) v[i] = 0.f; }
}
DI void rw_mask_lower_strict(f32x16& v, int mb, int nb, int lane) {
  const int col = nb * 32 + (lane & 31), h = lane >> 5;
#pragma unroll
  for (int i = 0; i < 16; ++i) { const int row = mb * 32 + crow(i, h); if (!(col < row)) v[i] = 0.f; }
}

constexpr int RW1_ITEMS = NSEQ_ * NCH_;
DI void rw_chunk_item(const Params& p, int it, char* smem) {
  const int s = it / NCH_, c = it % NCH_, dir = s >> 3, b = (s >> 2) & 1, hd = s & 3;
  const int tid = opaque_tid(), lane = tid & 63, wid = tid >> 6;
  const bf16_t* rb = (const bf16_t*)(p.ws + OFF_REGION + R_RB16);
  const float* lwg = (const float*)(p.ws + OFF_REGION + R_LW) + (size_t)dir * NT_ * 256;
  const size_t AS = (size_t)NT_ * 256;
  char* const At = smem + 0 * RW_MB; char* const Bt_ = smem + 1 * RW_MB; char* const Kt = smem + 2 * RW_MB; char* const Rt = smem + 3 * RW_MB;
  char* const Aj = smem + 4 * RW_MB; char* const Bj = smem + 5 * RW_MB; char* const Kj = smem + 6 * RW_MB; char* const Vi = smem + 7 * RW_MB;
  char* const QA = smem + 8 * RW_MB; char* const QTA = smem + 9 * RW_MB; char* const GA = smem + 10 * RW_MB;
  char* const Mka = smem + 11 * RW_MB; char* const MbrT = smem + 12 * RW_MB; char* const MkrT = smem + 13 * RW_MB;
  char* const QB = At; char* const QTB = Bt_; char* const GB = Kt;
  float* const cs = (float*)(smem + 8 * RW_MB);
  float* const gC = (float*)(smem + 14 * RW_MB);
  char* rec = rw_rec(p, s, c);
  __syncthreads();
  const int t = tid >> 3, j8 = (tid & 7) * 8;
  const int n = seq_tok(dir, b, c * 64 + t);
  {
    const float4 l0 = *(const float4*)(lwg + (size_t)n * 256 + hd * 64 + j8), l1 = *(const float4*)(lwg + (size_t)n * 256 + hd * 64 + j8 + 4);
    float* d = cs + t * 65 + j8;
    d[0] = l0.x; d[1] = l0.y; d[2] = l0.z; d[3] = l0.w; d[4] = l1.x; d[5] = l1.y; d[6] = l1.z; d[7] = l1.w;
  }
  __syncthreads();
  if (tid < 64) { float a = 0.f; for (int tt = 0; tt < 64; ++tt) { a += cs[tt * 65 + tid]; cs[tt * 65 + tid] = a; } gC[tid] = fexp(a); }
  __syncthreads();
  {
    const size_t o = (size_t)n * 256 + hd * 64 + j8;
    const uint4 ukk = *(const uint4*)(rb + 2 * AS + o), ubb = *(const uint4*)(rb + (4 + 2 * dir) * AS + o), ukd = *(const uint4*)(rb + (3 + 2 * dir) * AS + o);
    const uint4 ur = *(const uint4*)(rb + 0 * AS + o), uv = *(const uint4*)(rb + 1 * AS + o);
    const unsigned akk[4] = {ukk.x, ukk.y, ukk.z, ukk.w}, abb[4] = {ubb.x, ubb.y, ubb.z, ubb.w}, akd[4] = {ukd.x, ukd.y, ukd.z, ukd.w};
    const unsigned ar[4] = {ur.x, ur.y, ur.z, ur.w}, av[4] = {uv.x, uv.y, uv.z, uv.w};
    unsigned oa[4], ob[4], ok[4], orr[4];
#pragma unroll
    for (int q = 0; q < 4; ++q) {
      float fa[2], fb[2], fk[2], fr[2];
#pragma unroll
      for (int e = 0; e < 2; ++e) {
        const int j = j8 + 2 * q + e;
        const float cst = cs[t * 65 + j], csp = t > 0 ? cs[(t - 1) * 65 + j] : 0.f;
        const float g = fexp(cst), gp = fexp(csp), gi = fexp(-cst);
        const int sh = 16 * e;
        fa[e] = -bf2f((bf16_t)((akk[q] >> sh) & 0xffff)) * gp;
        fb[e] = bf2f((bf16_t)((abb[q] >> sh) & 0xffff)) * gi;
        fk[e] = bf2f((bf16_t)((akd[q] >> sh) & 0xffff)) * gi;
        fr[e] = bf2f((bf16_t)((ar[q] >> sh) & 0xffff)) * g;
        *(bf16_t*)(Aj + (j * RW_LD + t) * 2) = f2bf(fa[e]);
        *(bf16_t*)(Bj + (j * RW_LD + t) * 2) = f2bf(fb[e]);
        *(bf16_t*)(Kj + (j * RW_LD + t) * 2) = f2bf(fk[e]);
        *(bf16_t*)(Vi + (j * RW_LD + t) * 2) = (bf16_t)((av[q] >> sh) & 0xffff);
      }
      oa[q] = pack2bf(fa[0], fa[1]); ob[q] = pack2bf(fb[0], fb[1]); ok[q] = pack2bf(fk[0], fk[1]); orr[q] = pack2bf(fr[0], fr[1]);
    }
    *(uint4*)(At + (t * RW_LD + j8) * 2) = make_uint4(oa[0], oa[1], oa[2], oa[3]);
    *(uint4*)(Bt_ + (t * RW_LD + j8) * 2) = make_uint4(ob[0], ob[1], ob[2], ob[3]);
    *(uint4*)(Kt + (t * RW_LD + j8) * 2) = make_uint4(ok[0], ok[1], ok[2], ok[3]);
    *(uint4*)(Rt + (t * RW_LD + j8) * 2) = make_uint4(orr[0], orr[1], orr[2], orr[3]);
  }
  __syncthreads();
  {
    const int prod = wid >> 2, mb = (wid >> 1) & 1, nb = wid & 1;
    f32x16 acc = zero16();
    if (prod == 0) {
      if (!(mb == 1 && nb == 0)) acc = rw_mm(Bt_, At, mb, nb, lane, acc);
      rw_mask_upper(acc, mb, nb, lane, true);
      rw_wrT(QA, mb, nb, lane, acc);
      if (mb == nb) {
        const int col = nb * 32 + (lane & 31), h = lane >> 5;
#pragma unroll
        for (int i = 0; i < 16; ++i) if (mb * 32 + crow(i, h) == col) acc[i] += 1.f;
      }
      rw_wrT(GA, mb, nb, lane, acc);
    } else {
      if (!(mb == 0 && nb == 1)) acc = rw_mm(At, Bt_, mb, nb, lane, acc);
      rw_mask_lower_strict(acc, mb, nb, lane);
      rw_wrT(QTA, mb, nb, lane, acc);
    }
  }
  for (int blk = wid; blk < 12; blk += 8) {
    const int prod = blk >> 2, mb = (blk >> 1) & 1, nb = blk & 1;
    f32x16 acc = zero16();
    if (prod == 0) {
      acc = rw_mm(At, Kt, mb, nb, lane, acc); rw_mask_lower_strict(acc, mb, nb, lane); rw_wrT(Mka, mb, nb, lane, acc);
    } else if (prod == 1) {
      acc = rw_mm(Bt_, Rt, mb, nb, lane, acc); rw_mask_upper(acc, mb, nb, lane, false); rw_wrT(MbrT, mb, nb, lane, acc);
    } else {
      acc = rw_mm(Kt, Rt, mb, nb, lane, acc); rw_mask_upper(acc, mb, nb, lane, false); rw_wrT(MkrT, mb, nb, lane, acc);
    }
  }
  __syncthreads();
#define RW_SQ(Q_, Qt_, Qn_, Qtn_, blk) { const int pr_ = (blk) >> 2, mb_ = ((blk) >> 1) & 1, nb_ = (blk) & 1; f32x16 acc_ = zero16(); \
    if (pr_ == 0) { acc_ = rw_mm(Q_, Qt_, mb_, nb_, lane, acc_); rw_wrT(Qtn_, mb_, nb_, lane, acc_); } \
    else { acc_ = rw_mm(Qt_, Q_, mb_, nb_, lane, acc_); rw_wrT(Qn_, mb_, nb_, lane, acc_); } }
#define RW_GUP(Qt_, G_, Gn_, blk) { const int mb_ = ((blk) >> 1) & 1, nb_ = (blk) & 1; f32x16 acc_ = zero16(); \
    rw_addT(G_, mb_, nb_, lane, acc_); acc_ = rw_mm(Qt_, G_, mb_, nb_, lane, acc_); rw_wrT(Gn_, mb_, nb_, lane, acc_); }
  RW_SQ(QA, QTA, QB, QTB, wid);
  __syncthreads();
  for (int blk = wid; blk < 12; blk += 8) { if (blk < 8) { RW_SQ(QB, QTB, QA, QTA, blk); } else { RW_GUP(QTB, GA, GB, blk - 8); } }
  __syncthreads();
  for (int blk = wid; blk < 12; blk += 8) { if (blk < 8) { RW_SQ(QA, QTA, QB, QTB, blk); } else { RW_GUP(QTA, GB, GA, blk - 8); } }
  __syncthreads();
  for (int blk = wid; blk < 12; blk += 8) { if (blk < 8) { RW_SQ(QB, QTB, QA, QTA, blk); } else { RW_GUP(QTB, GA, GB, blk - 8); } }
  __syncthreads();
  for (int blk = wid; blk < 12; blk += 8) { if (blk < 8) { RW_SQ(QA, QTA, QB, QTB, blk); } else { RW_GUP(QTA, GB, GA, blk - 8); } }
  __syncthreads();
  if (wid < 4) { RW_GUP(QTB, GA, GB, wid); }
  __syncthreads();
  {
    const int prod = wid >> 2, mb = (wid >> 1) & 1, nb = wid & 1;
    f32x16 acc = zero16();
    acc = rw_mm(GB, prod == 0 ? Mka : Aj, mb, nb, lane, acc);
    rw_wrT(prod == 0 ? QA : QTA, mb, nb, lane, acc);
  }
  __syncthreads();
  char* const X1 = QA; char* const X2 = QTA; char* const QpT = At;
  for (int blk = wid; blk < 16; blk += 8) {
    const int prod = blk >> 2, mb = (blk >> 1) & 1, nb = blk & 1;
    f32x16 acc = zero16();
    if (prod == 0) {
      rw_addT(MkrT, mb, nb, lane, acc); acc = rw_mm(X1, MbrT, mb, nb, lane, acc); rw_mask_upper(acc, mb, nb, lane, false);
      rw_wrT_g((bf16_t*)(rec + 8192), mb, nb, lane, acc);
    } else if (prod == 1) {
      rw_addT(Rt, mb, nb, lane, acc); acc = rw_mm(X2, MbrT, mb, nb, lane, acc);
      rw_wrT_g((bf16_t*)(rec), mb, nb, lane, acc);
    } else if (prod == 2) {
      acc = rw_mm(X2, Bj, mb, nb, lane, acc);
      const int col = nb * 32 + (lane & 31), h = lane >> 5; const float gc = gC[col];
#pragma unroll
      for (int i = 0; i < 16; ++i) { if (mb * 32 + crow(i, h) == col) acc[i] += 1.f; acc[i] *= gc; }
      rw_wrT_g((bf16_t*)(rec + 16384), mb, nb, lane, acc);
    } else {
      rw_addT(Kj, mb, nb, lane, acc); acc = rw_mm(X1, Bj, mb, nb, lane, acc);
      const float gc = gC[nb * 32 + (lane & 31)];
#pragma unroll
      for (int i = 0; i < 16; ++i) acc[i] *= gc;
      rw_wrT(QpT, mb, nb, lane, acc);
    }
  }
  __syncthreads();
  if (wid < 4) {
    const int mb = (wid >> 1) & 1, nb = wid & 1, r = lane & 31, h = lane >> 5;
    f32x16 acc = zero16();
    acc = rw_mm(QpT, Vi, mb, nb, lane, acc);
    float* dq = (float*)(rec + 24576);
#pragma unroll
    for (int g = 0; g < 4; ++g)
      *(float4*)(dq + (nb * 32 + r) * 64 + mb * 32 + 8 * g + 4 * h) = make_float4(acc[4 * g], acc[4 * g + 1], acc[4 * g + 2], acc[4 * g + 3]);
  }
}

constexpr int RW2_ITEMS = NSEQ_;
constexpr int RW2_DQLD = 68;
constexpr int RW2_STAGE = RW_MB + 64 * RW2_DQLD * 4;
constexpr int RW2_GRP = 2;
static_assert(NCH_ % RW2_GRP == 0, "chunk groups");
DI void rw_state_item(const Params& p, int s, char* smem) {
  const int tid = opaque_tid(), lane = tid & 63, wid = tid >> 6, r = lane & 31, h = lane >> 5;
  f32x16 S0 = zero16(), S1 = zero16();
  u32x4 rp[RW2_GRP], rd0[RW2_GRP], rd1[RW2_GRP];
  const int prow = tid >> 3, pcol = (tid & 7) * 8;
#define RW2_LOAD(g_) { _Pragma("unroll") for (int u = 0; u < RW2_GRP; ++u) { const char* rec_ = rw_rec(p, s, (g_) * RW2_GRP + u); \
    rp[u] = *(const u32x4*)(rec_ + 16384 + (prow * 64 + pcol) * 2); \
    rd0[u] = *(const u32x4*)(rec_ + 24576 + (prow * 64 + pcol) * 4); rd1[u] = *(const u32x4*)(rec_ + 24576 + (prow * 64 + pcol + 4) * 4); } }
#define RW2_STORE(buf_) { _Pragma("unroll") for (int u = 0; u < RW2_GRP; ++u) { char* d_ = smem + ((buf_) * RW2_GRP + u) * RW2_STAGE; \
    *(u32x4*)(d_ + (prow * RW_LD + pcol) * 2) = rp[u]; \
    *(u32x4*)(d_ + RW_MB + (prow * RW2_DQLD + pcol) * 4) = rd0[u]; *(u32x4*)(d_ + RW_MB + (prow * RW2_DQLD + pcol + 4) * 4) = rd1[u]; } }
  __syncthreads();
  RW2_LOAD(0); RW2_STORE(0);
  __syncthreads();
  constexpr int NG = NCH_ / RW2_GRP;
  for (int g = 0; g < NG; ++g) {
    { const int gn = g + 1 < NG ? g + 1 : g; RW2_LOAD(gn); }
    sched_fence();
    if (wid < 2) {
#pragma unroll
      for (int u = 0; u < RW2_GRP; ++u) {
        const int c = g * RW2_GRP + u;
        const char* PT = smem + ((g & 1) * RW2_GRP + u) * RW2_STAGE;
        const float* DQ = (const float*)(PT + RW_MB);
        const int i = wid * 32 + r;
        bf16_t* sd = (bf16_t*)(rw_rec(p, s, c) + 16384);
#pragma unroll
        for (int q = 0; q < 4; ++q) {
          uint2 o0, o1;
          o0.x = pack2bf(S0[4 * q], S0[4 * q + 1]); o0.y = pack2bf(S0[4 * q + 2], S0[4 * q + 3]);
          o1.x = pack2bf(S1[4 * q], S1[4 * q + 1]); o1.y = pack2bf(S1[4 * q + 2], S1[4 * q + 3]);
          *(uint2*)(sd + i * 64 + 8 * q + 4 * h) = o0; *(uint2*)(sd + i * 64 + 32 + 8 * q + 4 * h) = o1;
        }
        bf16x8 bfr[2][2];
#pragma unroll
        for (int s2 = 0; s2 < 2; ++s2) {
          const u32x4 u0 = {pack2bf(S0[8 * s2], S0[8 * s2 + 1]), pack2bf(S0[8 * s2 + 2], S0[8 * s2 + 3]), pack2bf(S0[8 * s2 + 4], S0[8 * s2 + 5]), pack2bf(S0[8 * s2 + 6], S0[8 * s2 + 7])};
          const u32x4 u1 = {pack2bf(S1[8 * s2], S1[8 * s2 + 1]), pack2bf(S1[8 * s2 + 2], S1[8 * s2 + 3]), pack2bf(S1[8 * s2 + 4], S1[8 * s2 + 5]), pack2bf(S1[8 * s2 + 6], S1[8 * s2 + 7])};
          __builtin_memcpy(&bfr[0][s2], &u0, 16); __builtin_memcpy(&bfr[1][s2], &u1, 16);
        }
        f32x16 n0, n1;
#pragma unroll
        for (int q = 0; q < 4; ++q) {
          const float4 a = *(const float4*)(DQ + i * RW2_DQLD + 8 * q + 4 * h), bq = *(const float4*)(DQ + i * RW2_DQLD + 32 + 8 * q + 4 * h);
          n0[4 * q] = a.x; n0[4 * q + 1] = a.y; n0[4 * q + 2] = a.z; n0[4 * q + 3] = a.w;
          n1[4 * q] = bq.x; n1[4 * q + 1] = bq.y; n1[4 * q + 2] = bq.z; n1[4 * q + 3] = bq.w;
        }
#pragma unroll
        for (int jb2 = 0; jb2 < 2; ++jb2)
#pragma unroll
          for (int s2 = 0; s2 < 2; ++s2) {
            const char* a0 = PT + ((0 * 32 + r) * RW_LD + jb2 * 32 + 16 * s2 + 4 * h) * 2;
            const char* a1 = PT + ((1 * 32 + r) * RW_LD + jb2 * 32 + 16 * s2 + 4 * h) * 2;
            const uint2 l0 = *(const uint2*)a0, h0 = *(const uint2*)(a0 + 16), l1 = *(const uint2*)a1, h1 = *(const uint2*)(a1 + 16);
            const u32x4 u0 = {l0.x, l0.y, h0.x, h0.y}, u1 = {l1.x, l1.y, h1.x, h1.y};
            bf16x8 af0, af1; __builtin_memcpy(&af0, &u0, 16); __builtin_memcpy(&af1, &u1, 16);
            n0 = mfma32(af0, bfr[jb2][s2], n0);
            n1 = mfma32(af1, bfr[jb2][s2], n1);
          }
        S0 = n0; S1 = n1;
      }
    }
    sched_fence();
    RW2_STORE((g + 1) & 1);
    __syncthreads();
  }
}

DI void rw_out_item(const Params& p, int it, char* smem) {
  const int s = it / NCH_, c = it % NCH_, dir = s >> 3, b = (s >> 2) & 1, hd = s & 3;
  const int tid = opaque_tid(), lane = tid & 63, wid = tid >> 6;
  const bf16_t* rb = (const bf16_t*)(p.ws + OFF_REGION + R_RB16);
  const size_t AS = (size_t)NT_ * 256;
  float* ys = (float*)(p.ws + OFF_REGION + R_YS) + (size_t)dir * NT_ * 256;
  char* const Sm = smem; char* const RyT = smem + RW_MB; char* const MyT = smem + 2 * RW_MB; char* const Vi = smem + 3 * RW_MB;
  const char* rec = rw_rec(p, s, c);
  __syncthreads();
  {
    const int row = tid >> 3, col = (tid & 7) * 8;
    *(uint4*)(Sm + (row * RW_LD + col) * 2) = *(const uint4*)(rec + 16384 + (row * 64 + col) * 2);
    *(uint4*)(RyT + (row * RW_LD + col) * 2) = *(const uint4*)(rec + (row * 64 + col) * 2);
    *(uint4*)(MyT + (row * RW_LD + col) * 2) = *(const uint4*)(rec + 8192 + (row * 64 + col) * 2);
    const int n = seq_tok(dir, b, c * 64 + row);
    const uint4 uv = *(const uint4*)(rb + 1 * AS + (size_t)n * 256 + hd * 64 + col);
    const unsigned av[4] = {uv.x, uv.y, uv.z, uv.w};
#pragma unroll
    for (int q = 0; q < 4; ++q) {
      *(bf16_t*)(Vi + ((col + 2 * q) * RW_LD + row) * 2) = (bf16_t)(av[q] & 0xffff);
      *(bf16_t*)(Vi + ((col + 2 * q + 1) * RW_LD + row) * 2) = (bf16_t)(av[q] >> 16);
    }
  }
  __syncthreads();
  if (wid < 4) {
    const int mb = (wid >> 1) & 1, nb = wid & 1, r = lane & 31, h = lane >> 5;
    f32x16 acc = zero16();
    acc = rw_mm(Sm, RyT, mb, nb, lane, acc);
    acc = rw_mm(Vi, MyT, mb, nb, lane, acc);
    const int n = seq_tok(dir, b, c * 64 + nb * 32 + r);
#pragma unroll
    for (int g = 0; g < 4; ++g)
      *(float4*)(ys + (size_t)n * 256 + hd * 64 + mb * 32 + 8 * g + 4 * h) = make_float4(acc[4 * g], acc[4 * g + 1], acc[4 * g + 2], acc[4 * g + 3]);
  }
}
constexpr int ATT_KLD = 104, ATT_VLD = 68;
constexpr int ATT_KB = 64 * ATT_KLD * 2, ATT_VB = 64 * ATT_VLD * 2, ATT_STAGE = ATT_KB + ATT_VB;
DI float fexp2(float x) {
#ifdef EMU
  return exp2f(x);
#else
  return __builtin_amdgcn_exp2f(x);
#endif
}
#ifdef ABL_NOPV
#define ABL_PV_BEGIN if (t > 100000) {
#define ABL_PV_END }
#else
#define ABL_PV_BEGIN
#define ABL_PV_END
#endif
#define ABL_LOADS2(s_, tk, tv) ATT_LOADK(s_, tk); ATT_LOADV(s_, tv);
#ifdef ABL_NOEXP
#define ABL_EXP(x) (x)
#else
#define ABL_EXP(x) fexp2(x)
#endif
constexpr int ATT_LDS = 2 * ATT_KB + 2 * ATT_VB;
DI void attn_item(const Params& p, int b, int h, int qt, bool isctx, char* smem) {
  const int tid = opaque_tid(), lane = tid & 63, wid = tid >> 6, r = lane & 31, h2 = lane >> 5;
  const bf16_t* qb = (const bf16_t*)(p.osc + O_QB);
  const bf16_t* kbase = (const bf16_t*)(p.ws + OFF_REGION + R_KB) + (size_t)(b * 8 + h) * KT_ * 96;
  const bf16_t* vbase = (const bf16_t*)(p.ws + OFF_REGION + R_VT) + (size_t)(b * 8 + h) * 64 * KT_;
  bf16_t* att = (bf16_t*)(p.ws + OFF_REGION + R_ATT);
  const int nq0 = isctx ? NX_ + b * CL_ + qt * 256 : b * T_ + qt * 256;
  const int nkt = (isctx ? CL_ : KT_) / 64;
  const int nq = nq0 + wid * 32 + r;
  bf16x8 qf[6];
#pragma unroll
  for (int ks = 0; ks < 6; ++ks) qf[ks] = *(const bf16x8*)(qb + (size_t)nq * 768 + h * 96 + ks * 16 + h2 * 8);
  f32x16 oacc[2] = {zero16(), zero16()};
  float m = -1e30f, lsum = 0.f;
  const float sc = 0.10206207261596577f * 1.4426950408889634f;
  char* const Kst = smem;
  char* const Vst = smem + 2 * ATT_KB;
  const int kc1 = tid + 512, vd = tid >> 3, vc = tid & 7;
  const int ko0 = ((tid / 12) * ATT_KLD + (tid % 12) * 8) * 2, ko1 = ((kc1 / 12) * ATT_KLD + (kc1 % 12) * 8) * 2;
  const int vo = (vd * ATT_VLD + vc * 8) * 2;
  u32x4 ak0, ak1 = {0u, 0u, 0u, 0u}, av, bk0, bk1 = {0u, 0u, 0u, 0u}, bv;
#define ATT_LOADK(s_, kt_) { const bf16_t* ksrc_ = kbase + (size_t)(kt_) * 64 * 96; s_##k0 = *(const u32x4*)(ksrc_ + tid * 8); if (kc1 < 768) s_##k1 = *(const u32x4*)(ksrc_ + kc1 * 8); }
#define ATT_LOADV(s_, kt_) { s_##v = *(const u32x4*)(vbase + (size_t)vd * KT_ + (kt_) * 64 + vc * 8); }
#define ATT_STOREK(s_, st_) { char* d_ = Kst + (st_) * ATT_KB; *(u32x4*)(d_ + ko0) = s_##k0; if (kc1 < 768) *(u32x4*)(d_ + ko1) = s_##k1; }
#define ATT_STOREV(s_, st_) { char* d_ = Vst + (st_) * ATT_VB; *(uint2*)(d_ + vo) = make_uint2(s_##v[0], s_##v[1]); *(uint2*)(d_ + vo + 8) = make_uint2(s_##v[2], s_##v[3]); }
#define ATT_QK(dst_, st_) { const char* Ks_ = Kst + (st_) * ATT_KB; dst_[0] = zero16(); dst_[1] = zero16(); \
    _Pragma("unroll") for (int ks = 0; ks < 6; ++ks) _Pragma("unroll") for (int kb = 0; kb < 2; ++kb) { \
      const bf16x8 kf_ = *(const bf16x8*)(Ks_ + ((kb * 32 + r) * ATT_KLD + ks * 16 + h2 * 8) * 2); dst_[kb] = mfma32(kf_, qf[ks], dst_[kb]); } }
  __syncthreads();
  ATT_LOADK(a, 0); ATT_LOADV(a, 0); ATT_STOREK(a, 0); ATT_STOREV(a, 0);
  ATT_LOADK(a, 1); ATT_STOREK(a, 1);
  ATT_LOADK(a, (2 < nkt ? 2 : nkt - 1)); ATT_LOADV(a, 1);
  __syncthreads();
  f32x16 sA[2], sB[2];
  ATT_QK(sA, 0);
  __syncthreads();
#define ATT_SMPV(cur_, t) { \
    float mx = -1e30f; \
    _Pragma("unroll") for (int kb = 0; kb < 2; ++kb) _Pragma("unroll") for (int i = 0; i < 16; ++i) mx = fmaxf(mx, cur_[kb][i]); \
    mx = fmaxf(mx, __shfl_xor(mx, 32)); \
    const float mn = fmaxf(m, mx * sc); \
    if (__ballot(mn > m) != 0ull) { \
      const float alpha = fexp2(m - mn); \
      _Pragma("unroll") for (int db = 0; db < 2; ++db) _Pragma("unroll") for (int i = 0; i < 16; ++i) oacc[db][i] *= alpha; \
      lsum *= alpha; m = mn; } \
    _Pragma("unroll") for (int kb = 0; kb < 2; ++kb) _Pragma("unroll") for (int i = 0; i < 16; ++i) cur_[kb][i] = ABL_EXP(cur_[kb][i] * sc - m); \
    { float ps0 = 0.f, ps1 = 0.f; _Pragma("unroll") for (int i = 0; i < 16; ++i) { ps0 += cur_[0][i]; ps1 += cur_[1][i]; } lsum += ps0 + ps1; } \
    const char* Vs = Vst + ((t) & 1) * ATT_VB; \
    _Pragma("unroll") for (int kb = 0; kb < 2; ++kb) _Pragma("unroll") for (int s2 = 0; s2 < 2; ++s2) { \
      bf16x8 pf; { const u32x4 u = {pack2bf(cur_[kb][8 * s2 + 0], cur_[kb][8 * s2 + 1]), pack2bf(cur_[kb][8 * s2 + 2], cur_[kb][8 * s2 + 3]), \
                                    pack2bf(cur_[kb][8 * s2 + 4], cur_[kb][8 * s2 + 5]), pack2bf(cur_[kb][8 * s2 + 6], cur_[kb][8 * s2 + 7])}; __builtin_memcpy(&pf, &u, 16); } \
      ABL_PV_BEGIN \
      _Pragma("unroll") for (int db = 0; db < 2; ++db) { \
        const char* vrow = Vs + ((db * 32 + r) * ATT_VLD + kb * 32 + 16 * s2 + 4 * h2) * 2; \
        const uint2 lo = *(const uint2*)(vrow), hi = *(const uint2*)(vrow + 16); \
        const u32x4 u = {lo.x, lo.y, hi.x, hi.y}; bf16x8 vf; __builtin_memcpy(&vf, &u, 16); \
        oacc[db] = mfma32(vf, pf, oacc[db]); } ABL_PV_END } }
#define ATT_STEP(cur_, nxt_, t_, w_, l_) { \
    const int t = (t_); \
    const int tk = t + 3 < nkt ? t + 3 : nkt - 1, tv = t + 2 < nkt ? t + 2 : nkt - 1; \
    ABL_LOADS2(l_, tk, tv) \
    ATT_STOREK(w_, t & 1); ATT_STOREV(w_, (t + 1) & 1);        \
    sched_fence(); \
    if (first_half) { ATT_QK(nxt_, (t + 1) & 1); sched_fence(); ATT_SMPV(cur_, t); } \
    else { ATT_SMPV(cur_, t); sched_fence(); ATT_QK(nxt_, (t + 1) & 1); } \
    sched_fence(); \
    __syncthreads(); }
  const bool first_half = rfl(wid) < 4;
  for (int t0 = 0; t0 < nkt; t0 += 2) {
    ATT_STEP(sA, sB, t0, a, b);
    ATT_STEP(sB, sA, t0 + 1, b, a);
  }
  lsum += __shfl_xor(lsum, 32);
  const float inv = 1.f / lsum;
#pragma unroll
  for (int db = 0; db < 2; ++db)
#pragma unroll
    for (int g = 0; g < 4; ++g) {
      uint2 o;
      o.x = pack2bf(oacc[db][g * 4 + 0] * inv, oacc[db][g * 4 + 1] * inv);
      o.y = pack2bf(oacc[db][g * 4 + 2] * inv, oacc[db][g * 4 + 3] * inv);
      *(uint2*)(att + (size_t)nq * 512 + h * 64 + db * 32 + 8 * g + 4 * h2) = o;
    }
}

DI constexpr int att_items(int l) { return NB_ * 8 * (T_ / 256) + (l == 0 ? NB_ * 8 * (CL_ / 256) : 0); }
DI void spin_until_ge(int* ctr, int target) {
#ifdef EMU
  while (__atomic_load_n(ctr, __ATOMIC_SEQ_CST) < target) emu::yield();
#else
  while (__hip_atomic_load(ctr, __ATOMIC_RELAXED, __HIP_MEMORY_SCOPE_AGENT) < target) __builtin_amdgcn_s_sleep(8);
#endif
}
constexpr int P3B_ITEMS = RW1_ITEMS + ML2_ITEMS + MLA_Q_TILES + MLA_KV_TILES;
DI void phase3b(const Params& p, int l, char* smem, int* ctr) {
  for (int it = vblock(); it < P3B_ITEMS; it += gridDim.x) {
    int i = it;
    if (i < RW1_ITEMS) { TSB(p, 58); rw_chunk_item(p, i, smem); TSB(p, 59); continue; }
    i -= RW1_ITEMS;
    if (i < ML2_ITEMS) { mlstm_scan_item(p, i); continue; }
    i -= ML2_ITEMS;
    TSB(p, 60);
    if (i < MLA_Q_TILES) mla_q_item(p, l, i, smem); else mla_kv_item(p, l, i - MLA_Q_TILES, smem);
    TSB(p, 61);
  }
}

DI void phase4(const Params& p, int l, char* smem, int* ctr) {
  const int G = gridDim.x, nsb = G >= 2 * RW2_ITEMS ? RW2_ITEMS : (G > 1 ? G / 2 : 1);
  if ((int)blockIdx.x < nsb) {
    TSB(p, 50);
    for (int s = blockIdx.x; s < RW2_ITEMS; s += nsb) rw_state_item(p, s, smem);
#ifndef EMU
    asm volatile("s_waitcnt vmcnt(0)" ::: "memory");
#endif
    __syncthreads();
    if (opaque_tid() == 0) { __threadfence(); atomicAdd(ctr + 2, (RW2_ITEMS - (int)blockIdx.x + nsb - 1) / nsb); }
    TSB(p, 51);
  }
  const int QT = T_ / 256, CQ = (l == 0 ? (NB_ * 8 * (CL_ / 256)) / 8 : 0), R3 = RW1_ITEMS / 8;
  const int per = 2 * QT + CQ + R3;
  int* sitem = (int*)(smem + 160 * 1024 - 16);
  bool r2ok = false;
  const int x0 = xcc_id();
  for (;;) {
    __syncthreads();
    if (opaque_tid() == 0) {
      int item = -1;
      for (int k = 0; k < 8 && item < 0; ++k) {
        const int x = (x0 + k) & 7;
        if (ld_relaxed(ctr + 8 + x) >= per) continue;
        const int li = atomicAdd(ctr + 8 + x, 1);
        if (li < per) item = x * per + li;
      }
      *sitem = item;
    }
    __syncthreads();
    const int item = *sitem;
    if (item < 0) break;
    const int x = item / per; int li = item % per;
    if (li < 2 * QT) { const int bh = 2 * x + li / QT, qt = li % QT; TSB(p, 54); attn_item(p, bh >> 3, bh & 7, qt, false, smem); TSB(p, 55); continue; }
    li -= 2 * QT;
    if (li < CQ) { const int ci = x * CQ + li, qt = ci % (CL_ / 256), bh = ci / (CL_ / 256); attn_item(p, bh >> 3, bh & 7, qt, true, smem); continue; }
    li -= CQ;
    if (!r2ok) {
      if (opaque_tid() == 0) { spin_until_ge(ctr + 2, RW2_ITEMS); __threadfence(); }
      __syncthreads();
      r2ok = true;
    }
    rw_out_item(p, x * R3 + li, smem);
  }
}
constexpr int ML3_CC = CL_ / 64, ML3_XC = T_ / 64;
DI constexpr int ml3_items(bool with_ctx) { return NB_ * 4 * (ML3_XC + (with_ctx ? ML3_CC : 0)); }
template <int KS> DI f32x16 ml_mm(const char* A, const char* Bt, int mb, int nb, int lane, f32x16 acc) {
  const int r = lane & 31, h = lane >> 5;
#pragma unroll
  for (int ks = 0; ks < KS; ++ks) {
    const bf16x8 a = *(const bf16x8*)(A + ((mb * 32 + r) * RW_LD + ks * 16 + h * 8) * 2);
    const bf16x8 b = *(const bf16x8*)(Bt + ((nb * 32 + r) * RW_LD + ks * 16 + h * 8) * 2);
    acc = mfma32(a, b, acc);
  }
  return acc;
}
DI float wave_incl_scan_max(float v, int lane) {
  for (int d = 1; d < 64; d <<= 1) { const float o = __shfl_up(v, d); if (lane >= d) v = fmaxf(v, o); }
  return v;
}
DI void mlstm_out_item(const Params& p, int l, int it, bool with_ctx, char* smem) {
  const int per = ML3_XC + (with_ctx ? ML3_CC : 0);
  const int bh = it / per, b = bh >> 2, hd = bh & 3;
  int tc = it % per; if (!with_ctx) tc += ML3_CC;
  const bool isctx = tc < ML3_CC;
  const int ntok0 = isctx ? NX_ + b * CL_ + tc * 64 : b * T_ + (tc - ML3_CC) * 64;
  char* const Qm = smem;
  char* const Km = smem + 1 * RW_MB;
  char* const Qp = smem + 2 * RW_MB;
  char* const Vi = smem + 3 * RW_MB;
  char* const Pp = smem + 4 * RW_MB;
  char* const Cm = smem + 5 * RW_MB;
  float* const hs = (float*)(smem + 6 * RW_MB);
  float* const ga = hs + 64 * 64;
  float* const denp = ga + 5 * 64;
  float* const nsv = denp + 128;
  const float* zrec = (const float*)(p.ws + OFF_REGION + R_ZREC);
  const int tid = opaque_tid(), lane = tid & 63, wid = tid >> 6;
  __syncthreads();
  for (int idx = tid; idx < 64 * 64; idx += NTHR) hs[idx] = 0.f;
#pragma unroll 1
  for (int dir = 0; dir < 2; ++dir) {
    const int c = dir == 0 ? tc : (isctx ? ML3_CC - 1 - tc : ML3_CC + (ML3_XC - 1 - (tc - ML3_CC)));
    const int s = dir * 8 + b * 4 + hd;
    const float* st = (const float*)(p.ws + OFF_REGION + R_MLST) + ((size_t)s * NCH_ + c) * ML_ST;
    const float m_start = st[2082];
    __syncthreads();
    {
      const int j = tid >> 3, pt = tid & 7;
      const int n = ntok0 + (dir ? 63 - j : j);
      const float* zr = zrec + (size_t)n * ZREC_W;
      const float4 q4 = *(const float4*)(zr + ZR_MLQ + hd * 32 + pt * 4), k4 = *(const float4*)(zr + ZR_MLK + hd * 32 + pt * 4);
      const float4 c4 = *(const float4*)(st + j * 32 + pt * 4);
      const float4 va = *(const float4*)(zr + ZR_MLV + hd * 64 + pt * 8), vb = *(const float4*)(zr + ZR_MLV + hd * 64 + pt * 8 + 4);
      const float qs = 0.17677669529663687f;
      const float q0 = q4.x * qs, q1 = q4.y * qs, q2 = q4.z * qs, q3 = q4.w * qs;
      *(uint2*)(Qm + (j * RW_LD + pt * 4) * 2) = make_uint2(pack2bf(q0, q1), pack2bf(q2, q3));
      *(uint2*)(Km + (j * RW_LD + pt * 4) * 2) = make_uint2(pack2bf(k4.x, k4.y), pack2bf(k4.z, k4.w));
      *(uint2*)(Cm + (j * RW_LD + pt * 4) * 2) = make_uint2(pack2bf(c4.x, c4.y), pack2bf(c4.z, c4.w));
      const float vv[8] = {va.x, va.y, va.z, va.w, vb.x, vb.y, vb.z, vb.w};
#pragma unroll
      for (int u = 0; u < 8; ++u) *(bf16_t*)(Vi + ((pt * 8 + u) * RW_LD + j) * 2) = f2bf(vv[u]);
      if (tid < 32) nsv[tid] = st[2048 + tid];
      const float4 n4 = *(const float4*)(st + 2048 + pt * 4);
      float nq = n4.x * q0 + n4.y * q1 + n4.z * q2 + n4.w * q3;
      nq += __shfl_xor(nq, 1); nq += __shfl_xor(nq, 2); nq += __shfl_xor(nq, 4);
      if (pt == 0) ga[4 * 64 + j] = nq;
    }
    if (wid == 0) {
      const int n = ntok0 + (dir ? 63 - lane : lane);
      const float fp = zrec[(size_t)n * ZREC_W + ZR_MLF + dir * 4 + hd] + p.ml_b_f[(l * 2 + dir) * 4 + hd];
      const float ipre = zrec[(size_t)n * ZREC_W + ZR_MLI + dir * 4 + hd] + p.ml_b_i[(l * 2 + dir) * 4 + hd];
      const float bj = wave_incl_scan(logsigmoidf_(fp), lane);
      const float g = ipre - bj;
      const float pm = wave_incl_scan_max(g, lane);
      const float c0 = wave_max(g);
      const float mj = fmaxf(bj + m_start, bj + pm);
      ga[0 * 64 + lane] = fexp(g - c0);
      ga[1 * 64 + lane] = fexp(fminf(bj + c0 - mj, 80.f));
      ga[2 * 64 + lane] = fexp(bj + m_start - mj);
      ga[3 * 64 + lane] = fexp(fminf(-mj, 80.f));
    }
    __syncthreads();
    if (wid < 4) {
      const int mb = wid >> 1, nb = wid & 1, r = lane & 31, h = lane >> 5;
      f32x16 acc = zero16();
      if (!(mb == 1 && nb == 0)) acc = ml_mm<2>(Km, Qm, mb, nb, lane, acc);
      rw_mask_upper(acc, mb, nb, lane, false);
      const float al = ga[1 * 64 + nb * 32 + r];
      float csum = 0.f;
#pragma unroll
      for (int i = 0; i < 16; ++i) { acc[i] *= ga[0 * 64 + mb * 32 + crow(i, h)] * al; csum += acc[i]; }
      csum += __shfl_xor(csum, 32);
      if (h == 0) denp[mb * 64 + nb * 32 + r] = csum;
      rw_wrT(Pp, mb, nb, lane, acc);
    } else {
      const int t2 = tid - 256, j = t2 >> 2, d8 = (t2 & 3) * 8;
      const float in = ga[2 * 64 + j];
      const uint4 u = *(const uint4*)(Qm + (j * RW_LD + d8) * 2);
      const unsigned w[4] = {u.x, u.y, u.z, u.w};
      unsigned o[4];
#pragma unroll
      for (int q = 0; q < 4; ++q) o[q] = pack2bf(bf2f((bf16_t)(w[q] & 0xffff)) * in, bf2f((bf16_t)(w[q] >> 16)) * in);
      *(uint4*)(Qp + (j * RW_LD + d8) * 2) = make_uint4(o[0], o[1], o[2], o[3]);
    }
    __syncthreads();
    if (wid < 4) {
      const int mb = wid >> 1, nb = wid & 1, r = lane & 31, h = lane >> 5;
      f32x16 acc = zero16();
      acc = ml_mm<4>(Vi, Pp, mb, nb, lane, acc);
      acc = ml_mm<2>(Cm, Qp, mb, nb, lane, acc);
      const int j = nb * 32 + r;
      const float den = denp[j] + denp[64 + j] + ga[2 * 64 + j] * ga[4 * 64 + j];
      const float rden = frcp(fmaxf(fabsf(den), ga[3 * 64 + j]));
      float* hrow = hs + (dir ? 63 - j : j) * 64 + mb * 32 + 4 * h;
#pragma unroll
      for (int g4 = 0; g4 < 4; ++g4) {
        float4 o = *(float4*)(hrow + 8 * g4);
        o.x += acc[4 * g4] * rden; o.y += acc[4 * g4 + 1] * rden; o.z += acc[4 * g4 + 2] * rden; o.w += acc[4 * g4 + 3] * rden;
        *(float4*)(hrow + 8 * g4) = o;
      }
    }
  }
  __syncthreads();
  const int tk = tid >> 3, v0 = (tid & 7) * 8, n = ntok0 + tk;
  float ss = 0.f; float hv[8];
#pragma unroll
  for (int u = 0; u < 8; ++u) { hv[u] = hs[tk * 64 + v0 + u]; ss += hv[u] * hv[u]; }
  ss += __shfl_xor(ss, 1); ss += __shfl_xor(ss, 2); ss += __shfl_xor(ss, 4);
  const float rs = frsq(ss * (1.f / 64.f) + 1e-6f);
  unsigned o[4];
#pragma unroll
  for (int u = 0; u < 8; u += 2) {
    const int cc = hd * 64 + v0 + u;
    const float a = hv[u] * rs * p.ml_g_norm[l * 256 + cc] * sigmoidf_(zrec[(size_t)n * ZREC_W + ZR_MLO + cc]);
    const float bq = hv[u + 1] * rs * p.ml_g_norm[l * 256 + cc + 1] * sigmoidf_(zrec[(size_t)n * ZREC_W + ZR_MLO + cc + 1]);
    o[u >> 1] = pack2bf(a, bq);
  }
  bf16_t* mlo = (bf16_t*)(p.ws + OFF_REGION + R_MLO);
  *(uint4*)(mlo + (size_t)n * 256 + hd * 64 + v0) = make_uint4(o[0], o[1], o[2], o[3]);
}

DI constexpr int rwo_items(bool with_ctx) { return (with_ctx ? NT_ : NX_) / 16; }
DI void rwkv_out_item(const Params& p, int l, int it, char* smem) {
  float* sg = (float*)smem;
  const float* zrec = (const float*)(p.ws + OFF_REGION + R_ZREC);
  const bf16_t* rb = (const bf16_t*)(p.ws + OFF_REGION + R_RB16);
  const float* bso = (const float*)(p.ws + OFF_REGION + R_BS);
  const float* ys = (const float*)(p.ws + OFF_REGION + R_YS);
  bf16_t* rwo = (bf16_t*)(p.ws + OFF_REGION + R_RWO);
  const float* mu = p.rw_mu + (size_t)l * 1152;
  const int tid = opaque_tid(), n0 = it * 16;
  __syncthreads();
  {
    const int tt = tid >> 5, k4 = (tid & 31) * 4, n = n0 + tt, t = tok_t(n), c = 1024 + k4;
    const int len = n < NX_ ? T_ : CL_;
    const float* zr = zrec + (size_t)n * ZREC_W + ZR_RW + c;
    const float4 z = *(const float4*)zr;
    const float4 zp = t > 0 ? *(const float4*)(zr - ZREC_W) : make_float4(0.f, 0.f, 0.f, 0.f);
    const float4 zn = t < len - 1 ? *(const float4*)(zr + ZREC_W) : make_float4(0.f, 0.f, 0.f, 0.f);
    const float4 m4 = *(const float4*)(mu + c);
    sg[(k4 + 0) * 16 + tt] = sigmoidf_(z.x + (0.5f * (zp.x + zn.x) - z.x) * m4.x);
    sg[(k4 + 1) * 16 + tt] = sigmoidf_(z.y + (0.5f * (zp.y + zn.y) - z.y) * m4.y);
    sg[(k4 + 2) * 16 + tt] = sigmoidf_(z.z + (0.5f * (zp.z + zn.z) - z.z) * m4.z);
    sg[(k4 + 3) * 16 + tt] = sigmoidf_(z.w + (0.5f * (zp.w + zn.w) - z.w) * m4.w);
  }
  __syncthreads();
  const int col = tid & 255, half = tid >> 8;
  float acc[8];
#pragma unroll
  for (int i = 0; i < 8; ++i) acc[i] = 0.f;
  const float* g2 = p.rw_g2 + (size_t)l * 128 * 256 + col;
#pragma unroll 1
  for (int kh = 0; kh < 8; ++kh) {
    float gr[16];
#pragma unroll
    for (int k = 0; k < 16; ++k) gr[k] = g2[(kh * 16 + k) * 256];
#pragma unroll
    for (int k = 0; k < 16; ++k) {
      const float* sk = sg + (kh * 16 + k) * 16 + half * 8;
#pragma unroll
      for (int i = 0; i < 8; ++i) acc[i] += sk[i] * gr[k];
      if ((k & 3) == 3) sched_fence();
    }
  }
  const size_t AS = (size_t)NT_ * 256;
  const float lw = p.rw_lnx_w[(size_t)l * 256 + col], lb = p.rw_lnx_b[(size_t)l * 256 + col];
  float yv[8], vv[8], bsv[8];
#pragma unroll
  for (int i = 0; i < 8; ++i) {
    const int n = n0 + half * 8 + i;
    const size_t o = (size_t)n * 256 + col;
    yv[i] = ys[o] + ys[AS + o];
    vv[i] = bf2f(rb[1 * AS + o]);
    bsv[i] = bso[(size_t)n * 4 + (col >> 6)] + bso[((size_t)NT_ + n) * 4 + (col >> 6)];
  }
#pragma unroll
  for (int i = 0; i < 8; ++i) {
    const int n = n0 + half * 8 + i;
    const size_t o = (size_t)n * 256 + col;
    const float y = yv[i];
    const float mean = wave_sum(y) * (1.f / 64.f);
    const float dv = y - mean;
    const float var = wave_sum(dv * dv) * (1.f / 64.f);
    const float yn = dv * (frsq(var + 64e-5f)) * lw + lb;
    rwo[o] = f2bf((yn + bsv[i] * vv[i]) * acc[i]);
  }
}
DI void phase5(const Params& p, int l, bool with_ctx, char* smem) {
  const int n1 = ml3_items(with_ctx), n2 = rwo_items(with_ctx);
  for (int it = blockIdx.x; it < n1 + n2; it += gridDim.x) {
    if (it < n1) { TSB(p, 62); mlstm_out_item(p, l, it, with_ctx, smem); TSB(p, 63); }
    else { TSB(p, 64); rwkv_out_item(p, l, it - n1, smem); TSB(p, 65); }
  }
}
typedef Gemm<256, 128, 64, 4, 2> G2;
template <class G> DI void merge_tile(const Params& p, int l, int row0, int col0, char* smem) {
  const bf16_t* H = (const bf16_t*)(p.ws + OFF_H);
  const char* W = p.ws + OFF_WMIX + (size_t)l * WM_SIZE;
  const bf16_t* Wg = (const bf16_t*)(W + WM_GATE);
  const bf16_t* att = (const bf16_t*)(p.ws + OFF_REGION + R_ATT);
  const bf16_t* mlo = (const bf16_t*)(p.ws + OFF_REGION + R_MLO);
  const bf16_t* rwo = (const bf16_t*)(p.ws + OFF_REGION + R_RWO);
  bf16_t* ymix = (bf16_t*)(p.osc + O_YMIX);
  const int tid = opaque_tid();
  __syncthreads();
  unsigned ypk[G::MB][G::NB][8];
  f32x16 acc[G::MB][G::NB];
#pragma unroll 1
  for (int i = 0; i < 3; ++i) {
    unsigned sg[G::MB][G::NB][8];
#pragma unroll
    for (int a = 0; a < G::MB; ++a)
#pragma unroll
      for (int b = 0; b < G::NB; ++b) acc[a][b] = zero16();
    const bf16_t* A0 = H + (size_t)row0 * 1024;
    G::run_lin(acc, A0, 1024, Wg + ((size_t)i * 1024 + col0) * 1024, 1024, 1024, smem);
#pragma unroll
    for (int a = 0; a < G::MB; ++a)
#pragma unroll
      for (int b = 0; b < G::NB; ++b) {
#pragma unroll
        for (int e = 0; e < 8; ++e) sg[a][b][e] = pack2bf(sigmoidf_(acc[a][b][2 * e]), sigmoidf_(acc[a][b][2 * e + 1]));
        acc[a][b] = zero16();
      }
    const bf16_t* br = i == 0 ? att : (i == 1 ? mlo : rwo);
    const int kb = i == 0 ? 512 : 256;
    const bf16_t* Wb = (const bf16_t*)(W + (i == 0 ? WM_BRA : (i == 1 ? WM_BRM : WM_BRR)));
    const bf16_t* B0 = br + (size_t)row0 * kb;
    G::run_lin(acc, B0, kb, Wb + (size_t)col0 * kb, kb, kb, smem);
#pragma unroll
    for (int a = 0; a < G::MB; ++a)
#pragma unroll
      for (int b = 0; b < G::NB; ++b)
#pragma unroll
        for (int e = 0; e < 8; ++e) {
          float y0 = bf2f((bf16_t)(sg[a][b][e] & 0xffff)) * acc[a][b][2 * e], y1 = bf2f((bf16_t)(sg[a][b][e] >> 16)) * acc[a][b][2 * e + 1];
          if (i > 0) { y0 += bf2f((bf16_t)(ypk[a][b][e] & 0xffff)); y1 += bf2f((bf16_t)(ypk[a][b][e] >> 16)); }
          if (i < 2) ypk[a][b][e] = pack2bf(y0, y1); else { acc[a][b][2 * e] = y0; acc[a][b][2 * e + 1] = y1; }
        }
  }
  {
    const int lane = tid & 63, wid = tid >> 6, wm = wid / G::WN, wn = wid % G::WN;
    float* scr = (float*)(smem + wid * WTile<G::NB>::BYTES);
#pragma unroll
    for (int mb = 0; mb < G::MB; ++mb) {
#pragma unroll
      for (int nb = 0; nb < G::NB; ++nb) WTile<G::NB>::put(scr, nb, lane, acc[mb][nb]);
      const int r0 = row0 + wm * G::WTM + mb * 32, c0 = col0 + wn * G::WTN;
      WTile<G::NB>::rows8(scr, lane, [&](int r, int c, const float4& a, const float4& bq) {
        *(uint4*)(ymix + (size_t)(r0 + r) * 1024 + c0 + c) = pack8bf(a, bq); });
    }
  }
}
DI void phase_merge(const Params& p, int l, bool with_ctx, char* smem) {
  const int nbig = (NX_ / 256) * 8, nsmall = with_ctx ? (NC_ / 128) * 8 : 0;
  for (int it = vblock(); it < nbig + nsmall; it += gridDim.x) {
    if (it < nbig) merge_tile<G2>(p, l, (it >> 3) * 256, (it & 7) * 128, smem);
    else { const int i2 = it - nbig; merge_tile<G128>(p, l, NX_ + (i2 >> 3) * 128, (i2 & 7) * 128, smem); }
  }
}

template <class G> DI void wout_tile(const Params& p, int l, int row0, int col0, char* smem) {
  const bf16_t* ymix = (const bf16_t*)(p.osc + O_YMIX);
  const bf16_t* Wo = (const bf16_t*)(p.ws + OFF_WMIX + (size_t)l * WM_SIZE + WM_OUT);
  float* xs = (float*)(p.ws + OFF_XS);
  const float* mod = (const float*)(p.ws + OFF_MOD) + (size_t)l * 3 * 6144;
  const int tid = opaque_tid();
  __syncthreads();
  f32x16 acc[G::MB][G::NB];
#pragma unroll
  for (int a = 0; a < G::MB; ++a)
#pragma unroll
    for (int b = 0; b < G::NB; ++b) acc[a][b] = zero16();
  const bf16_t* A0 = ymix + (size_t)row0 * 1024;
  G::run_lin(acc, A0, 1024, Wo + (size_t)col0 * 1024, 1024, 1024, smem);
  const float* m2 = mod + (size_t)tok_modrow(row0) * 6144 + 2 * 1024;
  const int lane = tid & 63, wid = tid >> 6, wm = wid / G::WN, wn = wid % G::WN;
  float* scr = (float*)(smem + wid * WTile<G::NB>::BYTES);
#pragma unroll
  for (int mb = 0; mb < G::MB; ++mb) {
#pragma unroll
    for (int nb = 0; nb < G::NB; ++nb) WTile<G::NB>::put(scr, nb, lane, acc[mb][nb]);
    const int r0 = row0 + wm * G::WTM + mb * 32, c0 = col0 + wn * G::WTN;
    WTile<G::NB>::rows4(scr, lane, [&](int r, int c, const float4& a) {
      float4* d = (float4*)(xs + (size_t)(r0 + r) * 1024 + c0 + c);
      const float4 g = *(const float4*)(m2 + c0 + c); float4 x = *d;
      x.x += g.x * a.x; x.y += g.y * a.y; x.z += g.z * a.z; x.w += g.w * a.w; *d = x; });
  }
}
DI void phase_wout(const Params& p, int l, bool with_ctx, char* smem) {
  const int nbig = (NX_ / 256) * 8, nsmall = with_ctx ? (NC_ / 128) * 8 : 0;
  for (int it = vblock(); it < nbig + nsmall; it += gridDim.x) {
    if (it < nbig) wout_tile<G2>(p, l, (it >> 3) * 256, (it & 7) * 128, smem);
    else { const int i2 = it - nbig; wout_tile<G128>(p, l, NX_ + (i2 >> 3) * 128, (i2 & 7) * 128, smem); }
  }
  TSB(p, 66);
  cvt_run([&](int i) { return cvt_moe_dec(p, l, i); }, (int)gridDim.x - 1 - vblock(), CVT_MOE_TILES, gridDim.x, smem);
  TSB(p, 67);
}

typedef Gemm<128, 64, 64, 4, 2> GRT;
DI void phase_router(const Params& p, int l, bool with_ctx, char* smem, int* cnt) {
  float* xs = (float*)(p.ws + OFF_XS);
  bf16_t* H = (bf16_t*)(p.ws + OFF_H);
  const float* mod = (const float*)(p.ws + OFF_MOD) + (size_t)l * 3 * 6144;
  const bf16_t* Wr = (const bf16_t*)(p.ws + OFF_WMIX + (size_t)l * WM_SIZE + WM_RT);
  int* eidx = (int*)(p.ws + OFF_REGION + R_EIDX);
  float* ewt = (float*)(p.ws + OFF_REGION + R_EWT);
  int* erank = (int*)(p.ws + OFF_REGION + R_ERANK);
  int* elist = (int*)(p.ws + OFF_REGION + R_ELIST);
  float* sc = (float*)(smem + GRT::SMEM);
  float* bs = sc + 128 * 65;
  float* gs = bs + 128 * 65;
  int* lcnt = (int*)(gs + 128 * 9);
  int* lbase = lcnt + 64;
  const int tid = opaque_tid(), lane = tid & 63, wid = tid >> 6;
  const int ntok = with_ctx ? NT_ : NX_;
  for (int it = blockIdx.x; it < ntok / 128; it += gridDim.x) {
    const int n0 = it * 128;
    __syncthreads();
    TSB(p, 40);
    if (tid < 64) lcnt[tid] = 0;
#pragma unroll 1
    for (int r4 = 0; r4 < 16; r4 += 4) {
      float v[4][16];
#pragma unroll
      for (int u = 0; u < 4; ++u) {
        const int n = n0 + wid * 16 + r4 + u;
#pragma unroll
        for (int j = 0; j < 4; ++j) {
          const float4 t = *(const float4*)(xs + (size_t)n * 1024 + (j * 64 + lane) * 4);
          v[u][j * 4] = t.x; v[u][j * 4 + 1] = t.y; v[u][j * 4 + 2] = t.z; v[u][j * 4 + 3] = t.w;
        }
      }
#pragma unroll
      for (int u = 0; u < 4; ++u) {
        const int n = n0 + wid * 16 + r4 + u;
        const float* m = mod + (size_t)tok_modrow(n) * 6144;
        row_norm_mod(v[u], p.g_ffn + (size_t)l * 1024, m + 3 * 1024, m + 4 * 1024, H + (size_t)n * 1024, lane);
      }
    }
    __syncthreads();
    TSB(p, 41);
    f32x16 acc[1][1]; acc[0][0] = zero16();
    const bf16_t* A0 = H + (size_t)n0 * 1024;
    GRT::run(acc, [&](int r) { return A0 + (size_t)r * 1024; }, Wr, 1024, 1024, smem);
    {
      const int col = GRT::col_of(tid, 0);
      const float rb = p.router_bias[l * 64 + col];
#pragma unroll
      for (int e = 0; e < 16; ++e) {
        const int row = GRT::row_of(tid, 0, e);
        const float s = sigmoidf_(acc[0][0][e]);
        sc[row * 65 + col] = s; bs[row * 65 + col] = s + rb;
      }
    }
    __syncthreads();
    TSB(p, 42);
    int sel[8], lrk[8]; float wsum = 0.f;
    if (tid < 128) {
      float* b = bs + tid * 65; const float* s = sc + tid * 65; float* g = gs + tid * 9;
      for (int gi = 0; gi < 8; ++gi) {
        float m1 = -1e30f, m2 = -1e30f;
        for (int j = 0; j < 8; ++j) { const float x = b[gi * 8 + j]; if (x > m1) { m2 = m1; m1 = x; } else if (x > m2) m2 = x; }
        g[gi] = m1 + m2;
      }
      unsigned gmask = 0;
      for (int c = 0; c < 4; ++c) {
        int best = 0; float bv = -1e30f;
        for (int gi = 0; gi < 8; ++gi) if (!((gmask >> gi) & 1) && g[gi] > bv) { bv = g[gi]; best = gi; }
        gmask |= 1u << best;
      }
      for (int gi = 0; gi < 8; ++gi) if (!((gmask >> gi) & 1)) for (int j = 0; j < 8; ++j) b[gi * 8 + j] = -1e30f;
      wsum = 0.f;
#pragma unroll
      for (int c = 0; c < 8; ++c) {
        int best = 0; float bv = -1e30f;
        for (int e = 0; e < 64; ++e) { const float x = b[e]; if (x > bv) { bv = x; best = e; } }
        b[best] = -3e30f; sel[c] = best; wsum += s[best];
        lrk[c] = atomicAdd(lcnt + best, 1);
      }
    }
    __syncthreads();
    if (tid < 64) { const int c = lcnt[tid]; lbase[tid] = c ? atomicAdd(cnt + tid * 32, c) : 0; }
    __syncthreads();
    if (tid < 128) {
      const int n = n0 + tid;
      const float* s = sc + tid * 65;
      const float inv = 2.5f / (wsum + 1e-20f);
#pragma unroll
      for (int c = 0; c < 8; ++c) {
        const int e = sel[c];
        const int rk = lbase[e] + lrk[c];
        eidx[n * 8 + c] = e; ewt[n * 8 + c] = s[e] * inv; erank[n * 8 + c] = rk;
        elist[(size_t)e * NT_ + rk] = n * 8 + c;
      }
    }
    __syncthreads();
    TSB(p, 43);
  }
}

typedef Gemm<128, 256, 32, 2, 4> GMOE;
constexpr int ACT_LD = 264;
constexpr int MOE_DN_BK = 64, MOE_DN_LD = 72, MOE_DN_STG = 256 * MOE_DN_LD * 2;
constexpr int MOE_ACT_OFF = 2 * MOE_DN_STG;
static_assert(GMOE::SMEM <= MOE_ACT_OFF, "gate/up staging must stay below the act image");
constexpr int MOE_INFO_OFF = MOE_ACT_OFF + 128 * ACT_LD * 2;
static_assert(MOE_INFO_OFF + 128 * 8 + 67 * 4 * 2 <= 160 * 1024 - 32, "moe lds");
DI void moe_down_run(f32x16 (&acc)[GMOE::MB][GMOE::NB], const char* actl, const bf16_t* Bt, char* smem) {
  constexpr int BK = MOE_DN_BK, LDB = MOE_DN_LD, NCH = 4, KS = 4, STG = MOE_DN_STG, nk = 256 / BK;
  const int tid = opaque_tid(), lane = tid & 63, wid = tid >> 6, wm = wid / 4, wn = wid % 4;
  const int kc = (tid & 7) * 8, r0 = tid >> 3;
  const bf16_t* bp0 = Bt + (size_t)r0 * 256 + kc;
  u32x4 s0[NCH], s1[NCH];
#define MD_LOAD(dst_, kt_) { const int kq_ = (kt_) < nk ? (kt_) : nk - 1; _Pragma("unroll") for (int i = 0; i < NCH; ++i) dst_[i] = *(const u32x4*)(bp0 + (size_t)i * 64 * 256 + kq_ * BK); }
#define MD_WRITE1(src_, c_, buf_) { *(u32x4*)(smem + (buf_) * STG + ((r0 + (c_) * 64) * LDB + kc) * 2) = src_[c_]; }
#define MD_STEP(w_, l_, kt_) { \
    MD_LOAD(l_, (kt_) + 2); \
    sched_fence(); \
    const char* Bs = smem + ((kt_) & 1) * STG; \
    _Pragma("unroll") for (int ks = 0; ks < KS; ++ks) { \
      bf16x8 af[GMOE::MB], bfr[GMOE::NB]; \
      _Pragma("unroll") for (int mb = 0; mb < GMOE::MB; ++mb) af[mb] = *(const bf16x8*)(actl + ((wm * 64 + mb * 32 + (lane & 31)) * ACT_LD + (kt_) * BK + ks * 16 + (lane >> 5) * 8) * 2); \
      _Pragma("unroll") for (int nb = 0; nb < GMOE::NB; ++nb) bfr[nb] = *(const bf16x8*)(Bs + ((wn * 64 + nb * 32 + (lane & 31)) * LDB + ks * 16 + (lane >> 5) * 8) * 2); \
      MD_WRITE1(w_, ks, ((kt_) + 1) & 1); \
      _Pragma("unroll") for (int mb = 0; mb < GMOE::MB; ++mb) _Pragma("unroll") for (int nb = 0; nb < GMOE::NB; ++nb) acc[mb][nb] = mfma32(af[mb], bfr[nb], acc[mb][nb]); \
    } \
    sched_fence(); \
    __syncthreads(); }
  MD_LOAD(s0, 0);
#pragma unroll
  for (int c = 0; c < NCH; ++c) MD_WRITE1(s0, c, 0);
  MD_LOAD(s0, 1);
  __syncthreads();
  for (int kt = 0; kt < nk; kt += 2) {
    MD_STEP(s0, s1, kt);
    MD_STEP(s1, s0, kt + 1);
  }
#undef MD_STEP
#undef MD_WRITE1
#undef MD_LOAD
}
DI void phase_moe(const Params& p, int l, bool with_ctx, char* smem, const int* cnt) {
  const bf16_t* H = (const bf16_t*)(p.ws + OFF_H);
  const bf16_t* GU = (const bf16_t*)(p.ws + OFF_REGION + R_WMOE + WE_GU);
  const bf16_t* DN = (const bf16_t*)(p.ws + OFF_REGION + R_WMOE + WE_DN);
  const float* ewt = (const float*)(p.ws + OFF_REGION + R_EWT);
  const int* elist = (const int*)(p.ws + OFF_REGION + R_ELIST);
  bf16_t* ybuf = (bf16_t*)(p.ws + OFF_REGION + R_YBUF);
  char* actl = smem + MOE_ACT_OFF;
  int* rtok = (int*)(smem + MOE_INFO_OFF);
  float* rwt = (float*)(rtok + 128);
  int* pre = (int*)(rwt + 128);
  int* off = pre + 67;
  int tid = threadIdx.x;
  const int ntok = with_ctx ? NT_ : NX_;
  __syncthreads();
  if (tid == 0) {
    int a = 0, o = 0;
    for (int e = 0; e < 65; ++e) { const int c = e < 64 ? cnt[e * 32] : ntok; pre[e] = a; off[e] = o; a += (c + 127) >> 7; o += c; }
    pre[65] = a; off[65] = o;
  }
  __syncthreads();
  const int total = pre[65];
  for (int it = vblock(); it < total; it += gridDim.x) {
    tid = opaque_tid();
    int e0 = 0;
    while (pre[e0 + 1] <= it) ++e0;
    const int e = rfl(e0);
    const int rb = rfl(it - pre[e]);
    const int c = rfl(e < 64 ? cnt[e * 32] : ntok);
    const int obase = rfl(off[e] + rb * 128);
    __syncthreads();
    if (tid < 128) {
      const int slot = rb * 128 + tid;
      int tok = 0; float w = 0.f;
      if (slot < c) {
        if (e < 64) { const int pk = elist[(size_t)e * NT_ + slot]; tok = pk >> 3; w = ewt[pk]; }
        else { tok = slot; w = 1.f; }
      }
      rtok[tid] = tok; rwt[tid] = w;
    }
    __syncthreads();
    const bf16_t* Wgu = GU + (size_t)e * 512 * 1024;
#pragma unroll 1
    for (int hf = 0; hf < 2; ++hf) {
      f32x16 acc[GMOE::MB][GMOE::NB];
#pragma unroll
      for (int a = 0; a < GMOE::MB; ++a)
#pragma unroll
        for (int b = 0; b < GMOE::NB; ++b) acc[a][b] = zero16();
      GMOE::run(acc, [&](int r) { return H + (size_t)rtok[r] * 1024; }, Wgu + (size_t)hf * 256 * 1024, 1024, 1024, smem);
      const int lane = tid & 63, wn = (tid >> 6) % 4, wmr = ((tid >> 6) / 4) * 64 + 4 * (lane >> 5);
      const int j = (hf * 4 + wn) * 32 + (lane & 31);
#pragma unroll
      for (int mb = 0; mb < GMOE::MB; ++mb)
#pragma unroll
        for (int i = 0; i < 16; ++i) {
          const int row = wmr + mb * 32 + (i & 3) + 8 * (i >> 2);
          const float g = acc[mb][0][i], u = acc[mb][1][i];
          *(bf16_t*)(actl + (row * ACT_LD + j) * 2) = f2bf(siluf_(g) * u);
        }
    }
    __syncthreads();
    const bf16_t* Wd = DN + (size_t)e * 1024 * 256;
#pragma unroll 1
    for (int nt = 0; nt < 4; ++nt) {
      f32x16 acc[GMOE::MB][GMOE::NB];
#pragma unroll
      for (int a = 0; a < GMOE::MB; ++a)
#pragma unroll
        for (int b = 0; b < GMOE::NB; ++b) acc[a][b] = zero16();
      moe_down_run(acc, actl, Wd + (size_t)nt * 256 * 256, smem);
      {
        const int lane = tid & 63, wid = tid >> 6, wm = wid / 4, wn = wid % 4;
        float* scr = (float*)(smem + wid * WTile<1>::BYTES);
#pragma unroll
        for (int mb = 0; mb < GMOE::MB; ++mb)
#pragma unroll
          for (int nb = 0; nb < GMOE::NB; ++nb) {
            WTile<1>::put(scr, 0, lane, acc[mb][nb]);
            const int row0 = wm * 64 + mb * 32, col0 = nt * 256 + wn * 64 + nb * 32;
            WTile<1>::rows8(scr, lane, [&](int r, int cq, const float4& a, const float4& bq) {
              const int row = row0 + r;
              if (rb * 128 + row < c) {
                const float w = rwt[row];
                const float4 a2 = make_float4(a.x * w, a.y * w, a.z * w, a.w * w), b2 = make_float4(bq.x * w, bq.y * w, bq.z * w, bq.w * w);
                *(uint4*)(ybuf + ((size_t)obase + row) * 1024 + col0 + cq) = pack8bf(a2, b2);
              } });
          }
        __syncthreads();
      }
    }
  }
}

DI void phase_combine(const Params& p, int l, bool last, char* smem, const int* cnt) {
  float* xs = (float*)(p.ws + OFF_XS);
  bf16_t* H = (bf16_t*)(p.ws + OFF_H);
  const float* mod = (const float*)(p.ws + OFF_MOD);
  const int* eidx = (const int*)(p.ws + OFF_REGION + R_EIDX);
  const int* erank = (const int*)(p.ws + OFF_REGION + R_ERANK);
  const bf16_t* ybuf = (const bf16_t*)(p.ws + OFF_REGION + R_YBUF);
  int* off = (int*)smem;
  const int tid = opaque_tid(), lane = tid & 63, wid = tid >> 6;
  const int ntok = last ? NX_ : NT_;
  __syncthreads();
  if (tid == 0) { int o = 0; for (int e = 0; e < 64; ++e) { off[e] = o; o += cnt[e * 32]; } off[64] = o; }
  __syncthreads();
  for (int n = blockIdx.x * 8 + wid; n < ntok; n += gridDim.x * 8) {
    float acc[16];
#pragma unroll
    for (int i = 0; i < 16; ++i) acc[i] = 0.f;
    for (int k = 0; k < 9; ++k) {
      const int row = k < 8 ? off[eidx[n * 8 + k]] + erank[n * 8 + k] : off[64] + n;
      const bf16_t* y = ybuf + (size_t)row * 1024;
#pragma unroll
      for (int j = 0; j < 4; ++j) {
        const uint2 u = *(const uint2*)(y + (j * 64 + lane) * 4);
        acc[j * 4 + 0] += bf2f((bf16_t)(u.x & 0xffff)); acc[j * 4 + 1] += bf2f((bf16_t)(u.x >> 16));
        acc[j * 4 + 2] += bf2f((bf16_t)(u.y & 0xffff)); acc[j * 4 + 3] += bf2f((bf16_t)(u.y >> 16));
      }
    }
    const float* m5 = mod + ((size_t)l * 3 + tok_modrow(n)) * 6144 + 5 * 1024;
    float v[16];
#pragma unroll
    for (int j = 0; j < 4; ++j) {
      const int c = (j * 64 + lane) * 4;
      const float4 x = *(const float4*)(xs + (size_t)n * 1024 + c), g = *(const float4*)(m5 + c);
      v[j * 4 + 0] = x.x + g.x * acc[j * 4 + 0]; v[j * 4 + 1] = x.y + g.y * acc[j * 4 + 1];
      v[j * 4 + 2] = x.z + g.z * acc[j * 4 + 2]; v[j * 4 + 3] = x.w + g.w * acc[j * 4 + 3];
      if (!last) *(float4*)(xs + (size_t)n * 1024 + c) = make_float4(v[j * 4], v[j * 4 + 1], v[j * 4 + 2], v[j * 4 + 3]);
    }
    if (!last) {
      const float* m = mod + ((size_t)(l + 1) * 3 + tok_modrow(n)) * 6144;
      row_norm_mod(v, p.g_mix + (size_t)(l + 1) * 1024, m, m + 1024, H + (size_t)n * 1024, lane);
    } else {
      float ss = 0.f;
#pragma unroll
      for (int i = 0; i < 16; ++i) ss += v[i] * v[i];
      ss = wave_sum(ss);
      const float rs = frsq(ss * (1.f / 1024.f) + 1e-6f);
#pragma unroll
      for (int j = 0; j < 4; ++j) {
        const int c = (j * 64 + lane) * 4;
        const float4 g = *(const float4*)(p.g_final + c);
        *(float4*)(p.out + (size_t)n * 1024 + c) = make_float4(v[j * 4] * rs * g.x, v[j * 4 + 1] * rs * g.y, v[j * 4 + 2] * rs * g.z, v[j * 4 + 3] * rs * g.w);
      }
    }
  }
}
#define SMEM_BYTES (160 * 1024)
#ifndef MEGA
#define MEGA 0
#endif
DI int* cnt_ptr(const Params& p, int l) { return (int*)(p.ws + OFF_CNT) + 1024 + 2048 * l; }
DI int* ctr_ptr(const Params& p, int l) { return (int*)(p.ws + OFF_CNT) + 32 * l; }
#if !MEGA
__global__ void __launch_bounds__(NTHR) k_phaseA(Params p) { SMEM_DECL(smem, SMEM_BYTES); phaseA(p, smem); }
__global__ void __launch_bounds__(NTHR) k_norm0(Params p) { phase_norm0(p); }
__global__ void __launch_bounds__(NTHR) k_win(Params p, int l) { SMEM_DECL(smem, SMEM_BYTES); phase_win(p, l, smem); }
__global__ void __launch_bounds__(NTHR) k_p3(Params p, int l) { SMEM_DECL(smem, SMEM_BYTES); phase3(p, l, smem); }
__global__ void __launch_bounds__(NTHR) k_p3b(Params p, int l) { SMEM_DECL(smem, SMEM_BYTES); phase3b(p, l, smem, ctr_ptr(p, l)); }
__global__ void __launch_bounds__(NTHR) k_p4(Params p, int l) { SMEM_DECL(smem, SMEM_BYTES); phase4(p, l, smem, ctr_ptr(p, l)); }
__global__ void __launch_bounds__(NTHR) k_p5(Params p, int l, int wc) { SMEM_DECL(smem, SMEM_BYTES); phase5(p, l, wc != 0, smem); }
__global__ void __launch_bounds__(NTHR) k_merge(Params p, int l, int wc) { SMEM_DECL(smem, SMEM_BYTES); phase_merge(p, l, wc != 0, smem); }
__global__ void __launch_bounds__(NTHR) k_wout(Params p, int l, int wc) { SMEM_DECL(smem, SMEM_BYTES); phase_wout(p, l, wc != 0, smem); }
__global__ void __launch_bounds__(NTHR) k_router(Params p, int l, int wc) { SMEM_DECL(smem, SMEM_BYTES); phase_router(p, l, wc != 0, smem, cnt_ptr(p, l)); }
__global__ void __launch_bounds__(NTHR) k_moe(Params p, int l, int wc) { SMEM_DECL(smem, SMEM_BYTES); phase_moe(p, l, wc != 0, smem, cnt_ptr(p, l)); }
__global__ void __launch_bounds__(NTHR) k_combine(Params p, int l, int last) { SMEM_DECL(smem, SMEM_BYTES); phase_combine(p, l, last != 0, smem, cnt_ptr(p, l)); }
#else
#ifndef EMU
#define XB_TMO      128
#define XB_XCNT(j)  (256  + 64 * (j))
#define XB_XSUB(j)  (1280 + 64 * (j))
#define XB_XGEN(j)  (2304 + 64 * (j))
#define XB_TOP      3328
#define XB_TOPGEN   3392
#define XCD_BAR_WORDS 3456
#define XB_SPIN_CAP (1u << 24)
#define LAS __attribute__((address_space(3)))
DI unsigned xb_ld(unsigned* p) { return __hip_atomic_load(p, __ATOMIC_RELAXED, __HIP_MEMORY_SCOPE_AGENT); }
DI unsigned xb_add(unsigned* p, unsigned v) { return __hip_atomic_fetch_add(p, v, __ATOMIC_RELAXED, __HIP_MEMORY_SCOPE_AGENT); }
DI unsigned xb_xcc_id() { return (unsigned)__builtin_amdgcn_s_getreg((3 << 11) | 20) & 0xFu; }
#define XB_SPIN(cond, bar) do { unsigned _sp = 0; while (cond) { __builtin_amdgcn_s_sleep(1); \
    if ((++_sp & 255u) == 0u) { if (xb_ld(&(bar)[XB_TMO])) break; if (_sp > XB_SPIN_CAP) { atomicAdd(&(bar)[XB_TMO], 1u); break; } } } } while (0)
struct XcdBarrier { unsigned* bar; unsigned x; volatile LAS unsigned* st; };
DI XcdBarrier xcd_barrier_post(unsigned* bar, volatile LAS unsigned* st) {
  XcdBarrier b; b.bar = bar; b.x = xb_xcc_id(); b.st = st;
  if (threadIdx.x == 0) (void)xb_add(&bar[XB_XCNT(b.x)], 1u);
  return b;
}
DI void xcd_barrier_complete(unsigned* bar, unsigned x, unsigned& nloc, unsigned& nx) {
  const unsigned G = gridDim.x * gridDim.y * gridDim.z;
  unsigned sum, cnt, mine, sp = 0u;
  for (;;) {
    sum = 0u; cnt = 0u; mine = 0u;
#pragma unroll
    for (unsigned j = 0; j < 16; ++j) { const unsigned c = xb_ld(&bar[XB_XCNT(j)]); sum += c; cnt += (c > 0u) ? 1u : 0u; mine = (j == x) ? c : mine; }
    if (sum == G) break;
    __builtin_amdgcn_s_sleep(1);
    if ((++sp & 255u) == 0u) { if (xb_ld(&bar[XB_TMO])) break; if (sp > XB_SPIN_CAP) { atomicAdd(&bar[XB_TMO], 1u); break; } }
  }
  nloc = mine > 0u ? mine : 1u; nx = cnt > 0u ? cnt : 1u;
}
DI void xcd_barrier(const XcdBarrier& b) {
  asm volatile("s_waitcnt vmcnt(0)" ::: "memory");
  __syncthreads();
  if (threadIdx.x == 0) {
    unsigned* bar = b.bar;
    __builtin_amdgcn_s_waitcnt(0);
    unsigned nloc = b.st[0], nx = b.st[1];
    if (nloc == 0u) { xcd_barrier_complete(bar, b.x, nloc, nx); b.st[0] = nloc; b.st[1] = nx; }
    const unsigned old = xb_add(&bar[XB_XSUB(b.x)], 1u);
    const unsigned gen = old / nloc;
    if (old + 1u == (gen + 1u) * nloc) {
      __builtin_amdgcn_fence(__ATOMIC_RELEASE, "agent");
      asm volatile("s_waitcnt vmcnt(0)" ::: "memory");
      const unsigned og = xb_add(&bar[XB_TOP], 1u);
      const unsigned tg = og / nx;
      if (og + 1u == (tg + 1u) * nx) xb_add(&bar[XB_TOPGEN], 1u);
      else XB_SPIN(xb_ld(&bar[XB_TOPGEN]) == tg, bar);
      __builtin_amdgcn_fence(__ATOMIC_ACQUIRE, "agent");
      xb_add(&bar[XB_XGEN(b.x)], 1u);
      asm volatile("s_waitcnt vmcnt(0)" ::: "memory");
    } else {
      XB_SPIN(xb_ld(&bar[XB_XGEN(b.x)]) == gen, bar);
      __builtin_amdgcn_fence(__ATOMIC_ACQUIRE, "agent");
      asm volatile("s_waitcnt vmcnt(0)" ::: "memory");
    }
  }
  __syncthreads();
}
#define GSYNC() { XcdBarrier xb_; xb_.bar = (unsigned*)(p.ws + OFF_BAR); xb_.x = xb_xcc_id(); xb_.st = (volatile LAS unsigned*)(smem + SMEM_BYTES - 32); xcd_barrier(xb_); }
#else
#define GSYNC() emu::grid_barrier()
#endif
#ifdef PROBE_IDX
#define TS(i) { if (blockIdx.x == 0 && threadIdx.x == 0) ts[i] = wall_clock64(); }
#else
#define TS(i)
#endif
__global__ void __launch_bounds__(NTHR) k_mega(Params p) {
  SMEM_DECL(smem, SMEM_BYTES);
  cooperative_groups::grid_group grid = cooperative_groups::this_grid();
  volatile LAS unsigned* xst = (volatile LAS unsigned*)(smem + SMEM_BYTES - 32);
  if (threadIdx.x == 0) { xst[0] = 0u; xst[1] = 0u; }
  __syncthreads();
  (void)xcd_barrier_post((unsigned*)(p.ws + OFF_BAR), xst);
#ifdef PROBE_IDX
  long long* ts = (long long*)(p.ws + OFF_CNT + 2048);
#endif
  TS(0);
  phaseA(p, smem);
  grid.sync(); TS(1);
  phase_norm0(p);
  GSYNC(); TS(2);
#pragma unroll 1
  for (int l = 0; l < 2; ++l) {
    const bool wc = l == 0;
    phase_win(p, l, smem); GSYNC(); TS(3 + l * 10);
    phase3(p, l, smem); GSYNC(); TS(4 + l * 10);
    phase3b(p, l, smem, ctr_ptr(p, l)); GSYNC(); TS(5 + l * 10);
    phase4(p, l, smem, ctr_ptr(p, l)); GSYNC(); TS(6 + l * 10);
    phase5(p, l, wc, smem); GSYNC(); TS(7 + l * 10);
    phase_merge(p, l, wc, smem); GSYNC(); TS(8 + l * 10);
    phase_wout(p, l, wc, smem); GSYNC(); TS(9 + l * 10);
    phase_router(p, l, wc, smem, cnt_ptr(p, l)); GSYNC(); TS(10 + l * 10);
    phase_moe(p, l, wc, smem, cnt_ptr(p, l)); GSYNC(); TS(11 + l * 10);
    phase_combine(p, l, l == 1, smem, cnt_ptr(p, l));
#ifdef PROBE_IDX
    GSYNC(); TS(12 + l * 10);
#else
    if (l == 0) GSYNC();
#endif
  }
#ifdef PROBE_IDX
  if (blockIdx.x == 0 && threadIdx.x == 0) {
    const float us = (float)(ts[PROBE_IDX + 1] - ts[PROBE_IDX]) * 0.01f;
    p.out[0] += PROBE_IDX >= 40 ? rintf(6.f * log2f(fmaxf(us * 16.f, 1.f))) : rintf(6.f * log2f(fmaxf(us, 1.f)));
  }
#endif
}
#endif

extern "C" void kernel_launch(void* const* d_in, const int* in_sizes, int n_in, void* d_out, int out_size, void* d_ws,
                              size_t ws_size, hipStream_t stream) {
  Params p{};
  const float** pp = (const float**)&p;
  for (int i = 0; i < 41; ++i) pp[i] = (const float*)d_in[i];
  p.out = (float*)d_out; p.ws = (char*)d_ws; p.osc = (char*)d_out;
  if (ws_size < WS_NEEDED) { fprintf(stderr, "workspace too small: %zu < %zu\n", ws_size, (size_t)WS_NEEDED); return; }
#if !MEGA
  const dim3 g(256), b(NTHR);
  hipLaunchKernelGGL(k_phaseA, g, b, 0, stream, p);
  hipLaunchKernelGGL(k_norm0, g, b, 0, stream, p);
  for (int l = 0; l < 2; ++l) {
    const int wc = l == 0;
    hipLaunchKernelGGL(k_win, g, b, 0, stream, p, l);
    hipLaunchKernelGGL(k_p3, g, b, 0, stream, p, l);
    hipLaunchKernelGGL(k_p3b, g, b, 0, stream, p, l);
    hipLaunchKernelGGL(k_p4, g, b, 0, stream, p, l);
    hipLaunchKernelGGL(k_p5, g, b, 0, stream, p, l, wc);
    hipLaunchKernelGGL(k_merge, g, b, 0, stream, p, l, wc);
    hipLaunchKernelGGL(k_wout, g, b, 0, stream, p, l, wc);
    hipLaunchKernelGGL(k_router, g, b, 0, stream, p, l, wc);
    hipLaunchKernelGGL(k_moe, g, b, 0, stream, p, l, wc);
    hipLaunchKernelGGL(k_combine, g, b, 0, stream, p, l, l == 1);
  }
#else
  static int grid_blocks = 0;
  if (!grid_blocks) {
    int dev = 0, cus = 0, per_cu = 0;
    hipGetDevice(&dev);
    hipDeviceGetAttribute(&cus, hipDeviceAttributeMultiprocessorCount, dev);
    hipOccupancyMaxActiveBlocksPerMultiprocessor(&per_cu, k_mega, NTHR, 0);
    if (per_cu > 1) per_cu = 1;
    grid_blocks = cus * per_cu;
  }
  hipMemsetAsync(p.ws + OFF_BAR, 0, 16384, stream);
  void* args[] = {&p};
  hipError_t e = hipLaunchCooperativeKernel((void*)k_mega, dim3(grid_blocks), dim3(NTHR), args, 0, stream);
  if (e != hipSuccess) fprintf(stderr, "cooperative launch failed: %s (grid %d)\n", hipGetErrorString(e), grid_blocks);
#endif
}
```

```cpp
#define MEGA 1
#include <hip/hip_runtime.h>
#include <hip/hip_cooperative_groups.h>
#include <cstdio>

#ifndef SEQ_T
#define SEQ_T 8192
#endif
#ifndef CTX_L
#define CTX_L 256
#endif

#define DI __device__ __forceinline__
typedef unsigned short bf16_t;
typedef short bf16x8 __attribute__((ext_vector_type(8)));
typedef float f32x16 __attribute__((ext_vector_type(16)));
typedef float f32x4 __attribute__((ext_vector_type(4)));
typedef unsigned u32x4 __attribute__((ext_vector_type(4)));

constexpr int NB_ = 2, T_ = SEQ_T, CL_ = CTX_L, D_ = 1024;
constexpr int NX_ = NB_ * T_, NC_ = NB_ * CL_, NT_ = NX_ + NC_, KT_ = CL_ + T_;
constexpr int GRID_W_ = 64;
constexpr int MLA_H = 8, MLA_NOPE_ = 64, MLA_ROPE_ = 32, MLA_DK = 96, MLA_DV = 64, QLORA = 384, KVLORA = 256;
constexpr int MLA_IN_ = 672, ML_IN_ = 784, RW_IN_ = 1152, GATE_IN_ = 3072, D_IN_ = 5680;
constexpr int ZMLA_W = 768;
constexpr int ZREC_W = 1936;
constexpr int WIN_N = 768 + 2048;
constexpr int ML_H = 4, ML_DK = 32, ML_DV = 64, ML_L = 64;
constexpr int RW_H = 4, RW_N_ = 64;
constexpr int NE_ = 64, TOPK_ = 8, DE_ = 256;
constexpr int NCH_ = KT_ / ML_L;
constexpr int NSEQ_ = 2 * NB_ * 4;

constexpr int ZR_MLQ = 0, ZR_MLK = 128, ZR_MLV = 256, ZR_MLO = 512, ZR_MLI = 768, ZR_MLF = 776;
constexpr int ZR_RW = 784;

constexpr size_t al256(size_t x) { return (x + 255) & ~(size_t)255; }
constexpr size_t WM_WIN = 0;
constexpr size_t WM_GATE = WM_WIN + (size_t)WIN_N * 1024 * 2;
constexpr size_t WM_UQ = WM_GATE + (size_t)3072 * 1024 * 2;
constexpr size_t WM_UKV = WM_UQ + (size_t)768 * 384 * 2;
constexpr size_t WM_BRA = WM_UKV + (size_t)1024 * 256 * 2;
constexpr size_t WM_BRM = WM_BRA + (size_t)1024 * 512 * 2;
constexpr size_t WM_BRR = WM_BRM + (size_t)1024 * 256 * 2;
constexpr size_t WM_OUT = WM_BRR + (size_t)1024 * 256 * 2;
constexpr size_t WM_RT = WM_OUT + (size_t)1024 * 1024 * 2;
constexpr size_t WM_SIZE = al256(WM_RT + (size_t)64 * 1024 * 2);
constexpr size_t WE_GU = 0;
constexpr size_t WE_DN = WE_GU + (size_t)65 * 512 * 1024 * 2;
constexpr size_t WE_SIZE = al256(WE_DN + (size_t)65 * 1024 * 256 * 2);

constexpr size_t OFF_XS = 0;
constexpr size_t OFF_MOD = OFF_XS + al256((size_t)NT_ * 1024 * 4);
constexpr size_t OFF_ROPE = OFF_MOD + al256((size_t)2 * 3 * 6144 * 4);
constexpr size_t OFF_H = OFF_ROPE + al256((size_t)T_ * 16 * 8);
constexpr size_t OFF_WMIX = OFF_H + al256((size_t)NT_ * 1024 * 2);
constexpr size_t OFF_CNT = OFF_WMIX + 2 * WM_SIZE;
constexpr size_t OFF_BAR = OFF_CNT + 32768;
constexpr size_t OFF_REGION = OFF_BAR + 16384;
constexpr size_t R_ZREC = 0;
constexpr size_t R_RB16 = R_ZREC + al256((size_t)NT_ * ZREC_W * 4);
constexpr size_t R_LW = R_RB16 + al256((size_t)7 * NT_ * 256 * 2);
constexpr size_t R_BS = R_LW + al256((size_t)2 * NT_ * 256 * 4);
constexpr size_t R_CH = R_BS + al256((size_t)2 * NT_ * 4 * 4);
constexpr size_t R_YS = R_CH + al256((size_t)NSEQ_ * NCH_ * 40960);
constexpr size_t R_MLST = R_YS + al256((size_t)2 * NT_ * 256 * 4);
constexpr size_t R_ATT = R_MLST + al256((size_t)NSEQ_ * NCH_ * 2112 * 4);
constexpr size_t R_MLO = R_ATT + al256((size_t)NT_ * 512 * 2);
constexpr size_t R_RWO = R_MLO + al256((size_t)NT_ * 256 * 2);
constexpr size_t R_VT = R_RWO + al256((size_t)NT_ * 256 * 2);
constexpr size_t R_KB = R_VT + al256((size_t)NB_ * MLA_H * 64 * KT_ * 2);
constexpr size_t R_MIX_END = R_KB + al256((size_t)NB_ * MLA_H * KT_ * 96 * 2);
constexpr int NSLOT_ = NT_ * 9;
constexpr size_t R_YBUF = 0;
constexpr size_t R_EIDX = R_YBUF + al256((size_t)NSLOT_ * 1024 * 2);
constexpr size_t R_EWT = R_EIDX + al256((size_t)NT_ * 8 * 4);
constexpr size_t R_ERANK = R_EWT + al256((size_t)NT_ * 8 * 4);
constexpr size_t R_ELIST = R_ERANK + al256((size_t)NT_ * 8 * 4);
constexpr size_t R_WMOE = R_ELIST + al256((size_t)64 * NT_ * 4);
constexpr size_t R_MOE_END = R_WMOE + WE_SIZE;
constexpr size_t R_SIZE = R_MIX_END > R_MOE_END ? R_MIX_END : R_MOE_END;
constexpr size_t WS_NEEDED = OFF_REGION + R_SIZE;
constexpr size_t O_ZMLA = 0;
constexpr size_t O_QB = O_ZMLA + al256((size_t)NT_ * ZMLA_W * 2);
constexpr size_t O_END = O_QB + al256((size_t)NT_ * 768 * 2);
constexpr size_t O_YMIX = 0;
#if SEQ_T == 8192 && CTX_L == 256
static_assert(O_END <= (size_t)NX_ * 1024 * 4, "d_out scratch overflow");
static_assert((size_t)NT_ * 1024 * 2 <= (size_t)NX_ * 1024 * 4, "ymix overflow");
static_assert(WS_NEEDED <= (size_t)597000000, "workspace too large");
#endif

struct Params {
  const float *x, *c, *ctx, *c_ctx, *w_mod, *b_mod, *g_mix, *g_ffn, *w_in, *g_cq, *w_uq, *g_ckv, *w_uk, *w_uv;
  const float *ml_b_i, *ml_b_f, *ml_g_norm, *rw_mu, *rw_w0, *rw_w2, *rw_a0, *rw_a2, *rw_g2, *rw_k_k, *rw_k_a;
  const float *rw_r_k, *rw_lnx_w, *rw_lnx_b, *w_br_mla, *w_br_ml, *w_br_rw, *w_out, *w_router, *router_bias;
  const float *w_e_gate, *w_e_up, *w_e_down, *w_s_gate, *w_s_up, *w_s_down, *g_final;
  float* out; char* ws; char* osc;
};

DI float bf2f(bf16_t s) { unsigned u = ((unsigned)s) << 16; float f; __builtin_memcpy(&f, &u, 4); return f; }
DI bf16_t f2bf(float x) { unsigned u; __builtin_memcpy(&u, &x, 4); u += 0x7fffu + ((u >> 16) & 1u); return (bf16_t)(u >> 16); }
DI unsigned pack2bf(float a, float b) {
#ifdef EMU
  return (unsigned)f2bf(a) | ((unsigned)f2bf(b) << 16);
#else
  typedef __bf16 bf2 __attribute__((ext_vector_type(2)));
  typedef float f2 __attribute__((ext_vector_type(2)));
  f2 v = {a, b}; bf2 r = __builtin_convertvector(v, bf2); return __builtin_bit_cast(unsigned, r);
#endif
}
DI f32x16 mfma32(bf16x8 a, bf16x8 b, f32x16 c) {
#ifdef EMU
  return emu_mfma_32x32x16_bf16(a, b, c);
#else
  return __builtin_amdgcn_mfma_f32_32x32x16_bf16(a, b, c, 0, 0, 0);
#endif
}
DI int rfl(int v) {
#ifdef EMU
  return v;
#else
  return __builtin_amdgcn_readfirstlane(v);
#endif
}
DI int opaque_tid() {
#ifdef EMU
  return threadIdx.x;
#else
  int t = threadIdx.x; asm volatile("" : "+v"(t)); return t;
#endif
}
DI void wave_sync() {
#ifdef EMU
  (void)__ballot(1);
#else
  asm volatile("" ::: "memory");
#endif
}
DI int vblock() {
  const int g = gridDim.x, b = blockIdx.x;
  return (g & 7) == 0 ? (b & 7) * (g >> 3) + (b >> 3) : b;
}
DI int xcc_id() {
#ifdef EMU
  return blockIdx.x & 7;
#else
  return (int)(__builtin_amdgcn_s_getreg((3 << 11) | 20) & 7u);
#endif
}
DI int ld_relaxed(int* p) {
#ifdef EMU
  return __atomic_load_n(p, __ATOMIC_SEQ_CST);
#else
  return __hip_atomic_load(p, __ATOMIC_RELAXED, __HIP_MEMORY_SCOPE_AGENT);
#endif
}
DI void sched_fence() {
#ifndef EMU
  __builtin_amdgcn_sched_barrier(0);
#endif
}
template <int L> DI float lane_bcast(float x) {
#ifdef EMU
  return __shfl(x, L);
#else
  return __builtin_bit_cast(float, __builtin_amdgcn_readlane(__builtin_bit_cast(int, x), L));
#endif
}
DI f32x16 zero16() { f32x16 z; for (int i = 0; i < 16; ++i) z[i] = 0.f; return z; }
DI int crow(int reg, int h) { return (reg & 3) + 8 * (reg >> 2) + 4 * h; }
#ifdef EMU
DI float fexp(float x) { return expf(x); }
#else
DI float fexp(float x) { return __expf(x); }
#endif
#ifdef EMU
DI float frcp(float x) { return 1.f / x; }
DI float frsq(float x) { return 1.f / sqrtf(x); }
#else
DI float frcp(float x) { return __builtin_amdgcn_rcpf(x); }
DI float frsq(float x) { return __builtin_amdgcn_rsqf(x); }
#endif
#ifdef EMU
DI float flog(float x) { return logf(x); }
#else
DI float flog(float x) { return __builtin_amdgcn_logf(x) * 0.6931471805599453f; }
#endif
DI float sigmoidf_(float x) { return frcp(1.f + fexp(-x)); }
DI float siluf_(float x) { return x * sigmoidf_(x); }
#ifdef EMU
DI float wave_sum(float v) { for (int m = 32; m >= 1; m >>= 1) v += __shfl_xor(v, m); return v; }
DI float wave_max(float v) { for (int m = 32; m >= 1; m >>= 1) v = fmaxf(v, __shfl_xor(v, m)); return v; }
#else
#define DPPF(x, ctrl) __builtin_bit_cast(float, __builtin_amdgcn_mov_dpp(__builtin_bit_cast(int, (x)), (ctrl), 0xf, 0xf, true))
#define RDLF(x, l) __builtin_bit_cast(float, __builtin_amdgcn_readlane(__builtin_bit_cast(int, (x)), (l)))
DI float wave_sum(float v) {
  v += DPPF(v, 0xB1); v += DPPF(v, 0x4E); v += DPPF(v, 0x124); v += DPPF(v, 0x128);
  return (RDLF(v, 0) + RDLF(v, 16)) + (RDLF(v, 32) + RDLF(v, 48));
}
DI float wave_max(float v) {
  v = fmaxf(v, DPPF(v, 0xB1)); v = fmaxf(v, DPPF(v, 0x4E)); v = fmaxf(v, DPPF(v, 0x124)); v = fmaxf(v, DPPF(v, 0x128));
  return fmaxf(fmaxf(RDLF(v, 0), RDLF(v, 16)), fmaxf(RDLF(v, 32), RDLF(v, 48)));
}
#endif

DI int tok_b(int n) { return n < NX_ ? n / T_ : (n - NX_) / CL_; }
DI int tok_t(int n) { return n < NX_ ? n % T_ : (n - NX_) % CL_; }
DI int tok_key(int n) { return n < NX_ ? CL_ + n % T_ : (n - NX_) % CL_; }
DI int tok_modrow(int n) { return n < NX_ ? n / T_ : 2; }

#ifdef EMU
#define SMEM_DECL(name, bytes) char* name = (char*)emu::shared_alloc(bytes)
#else
#define SMEM_DECL(name, bytes) __shared__ __attribute__((aligned(16))) char name[bytes]
#endif
#define NTHR 512
#if defined(PROBE_IDX) && !defined(EMU)
#define TSB(pp, i) { if (blockIdx.x == 0 && threadIdx.x == 0) ((long long*)((pp).ws + OFF_CNT + 2048))[i] = wall_clock64(); }
#else
#define TSB(pp, i)
#endif
struct CvtJob { const float* src; int lds; int K; bf16_t* dst; int ntn; int ntk; int maptype; const float* gain; };
DI int cvt_map(int maptype, int coff, int np) {
  if (maptype == 0) return coff + np;
  if (maptype == 1) { if (np < 672) return np; if (np < 768) return -1; if (np < 768 + 1936) return np - 96; return -1; }
  return np;
}
struct CvtItem { CvtJob j; int coff, tk, tn; };
struct CvtRegs { float v[8]; };
DI void cvt_load(const CvtItem& c, int tid, CvtRegs& r) {
  const int kk = tid >> 4, np = c.tn * 64 + (tid & 15) * 4;
  const int sc = cvt_map(c.j.maptype, c.coff, np);
#pragma unroll
  for (int u = 0; u < 2; ++u) {
    const int k = c.tk * 64 + kk + 32 * u;
    float4 v = make_float4(0.f, 0.f, 0.f, 0.f);
    if (sc >= 0) v = *(const float4*)(c.j.src + (size_t)k * c.j.lds + sc);
    const float g = c.j.gain ? c.j.gain[k] : 1.f;
    r.v[4 * u] = v.x * g; r.v[4 * u + 1] = v.y * g; r.v[4 * u + 2] = v.z * g; r.v[4 * u + 3] = v.w * g;
  }
}
DI void cvt_store(const CvtItem& c, int tid, const CvtRegs& r, char* smem) {
  float* tile = (float*)smem;
  __syncthreads();
  {
    const int kk = tid >> 4, nc = (tid & 15) * 4;
#pragma unroll
    for (int u = 0; u < 2; ++u)
#pragma unroll
      for (int i = 0; i < 4; ++i) tile[(kk + 32 * u) * 65 + nc + i] = r.v[4 * u + i];
  }
  __syncthreads();
  {
    const int n = tid >> 3, kc = (tid & 7) * 8;
    int np = c.tn * 64 + n;
    if (c.j.maptype == 2) np = (np >> 5) * 64 + c.coff * 32 + (np & 31);
    uint4 v;
    v.x = pack2bf(tile[(kc + 0) * 65 + n], tile[(kc + 1) * 65 + n]);
    v.y = pack2bf(tile[(kc + 2) * 65 + n], tile[(kc + 3) * 65 + n]);
    v.z = pack2bf(tile[(kc + 4) * 65 + n], tile[(kc + 5) * 65 + n]);
    v.w = pack2bf(tile[(kc + 6) * 65 + n], tile[(kc + 7) * 65 + n]);
    *(uint4*)(c.j.dst + (size_t)np * c.j.K + c.tk * 64 + kc) = v;
  }
}
template <class Dec> DI void cvt_run(Dec dec, int first, int n, int stride, char* smem) {
  const int tid = opaque_tid();
  if (first >= n) return;
  CvtItem cur = dec(first); CvtRegs rc; cvt_load(cur, tid, rc);
  for (int it = first; it < n; it += stride) {
    const int nx = it + stride < n ? it + stride : it;
    CvtItem nxt = dec(nx); CvtRegs rn; cvt_load(nxt, tid, rn);
    sched_fence();
    cvt_store(cur, tid, rc, smem);
    cur = nxt; rc = rn;
  }
}

constexpr int CVT_MIX_TILES = 704 + 768 + 72 + 32 + 32 + 128 + 64 + 64 + 256 + 16;
DI CvtItem cvt_mix_dec(const Params& p, int l, int it) {
  bf16_t* W = (bf16_t*)(p.ws + OFF_WMIX + (size_t)l * WM_SIZE);
  CvtJob j; int coff = 0;
  if (it < 704) { j = {p.w_in + (size_t)l * 1024 * D_IN_, D_IN_, 1024, (bf16_t*)((char*)W + WM_WIN), 44, 16, 1, nullptr}; }
  else if ((it -= 704) < 768) { j = {p.w_in + (size_t)l * 1024 * D_IN_, D_IN_, 1024, (bf16_t*)((char*)W + WM_GATE), 48, 16, 0, nullptr}; coff = 2608; }
  else if ((it -= 768) < 72) { j = {p.w_uq + (size_t)l * 384 * 768, 768, 384, (bf16_t*)((char*)W + WM_UQ), 12, 6, 0, p.g_cq + l * 384}; }
  else if ((it -= 72) < 32) { j = {p.w_uk + (size_t)l * 256 * 512, 512, 256, (bf16_t*)((char*)W + WM_UKV), 8, 4, 0, p.g_ckv + l * 256}; }
  else if ((it -= 32) < 32) { j = {p.w_uv + (size_t)l * 256 * 512, 512, 256, (bf16_t*)((char*)W + WM_UKV) + 512 * 256, 8, 4, 0, p.g_ckv + l * 256}; }
  else if ((it -= 32) < 128) { j = {p.w_br_mla + (size_t)l * 512 * 1024, 1024, 512, (bf16_t*)((char*)W + WM_BRA), 16, 8, 0, nullptr}; }
  else if ((it -= 128) < 64) { j = {p.w_br_ml + (size_t)l * 256 * 1024, 1024, 256, (bf16_t*)((char*)W + WM_BRM), 16, 4, 0, nullptr}; }
  else if ((it -= 64) < 64) { j = {p.w_br_rw + (size_t)l * 256 * 1024, 1024, 256, (bf16_t*)((char*)W + WM_BRR), 16, 4, 0, nullptr}; }
  else if ((it -= 64) < 256) { j = {p.w_out + (size_t)l * 1024 * 1024, 1024, 1024, (bf16_t*)((char*)W + WM_OUT), 16, 16, 0, nullptr}; }
  else { it -= 256; j = {p.w_router + (size_t)l * 1024 * 64, 64, 1024, (bf16_t*)((char*)W + WM_RT), 1, 16, 0, nullptr}; }
  CvtItem c; c.j = j; c.coff = coff; c.tk = it / j.ntn; c.tn = it % j.ntn; return c;
}
constexpr int CVT_MOE_TILES = 65 * 192;
DI CvtItem cvt_moe_dec(const Params& p, int l, int it) {
  const int e = it / 192; int r = it % 192;
  bf16_t* GU = (bf16_t*)(p.ws + OFF_REGION + R_WMOE + WE_GU) + (size_t)e * 512 * 1024;
  bf16_t* DN = (bf16_t*)(p.ws + OFF_REGION + R_WMOE + WE_DN) + (size_t)e * 1024 * 256;
  const float* sg = e < 64 ? p.w_e_gate + ((size_t)l * 64 + e) * 1024 * 256 : p.w_s_gate + (size_t)l * 1024 * 256;
  const float* su = e < 64 ? p.w_e_up + ((size_t)l * 64 + e) * 1024 * 256 : p.w_s_up + (size_t)l * 1024 * 256;
  const float* sd = e < 64 ? p.w_e_down + ((size_t)l * 64 + e) * 256 * 1024 : p.w_s_down + (size_t)l * 256 * 1024;
  CvtJob j; int coff = 0;
  if (r < 64) { j = {sg, 256, 1024, GU, 4, 16, 2, nullptr}; coff = 0; }
  else if ((r -= 64) < 64) { j = {su, 256, 1024, GU, 4, 16, 2, nullptr}; coff = 1; }
  else { r -= 64; j = {sd, 1024, 256, DN, 16, 4, 0, nullptr}; }
  CvtItem c; c.j = j; c.coff = coff; c.tk = r / j.ntn; c.tn = r % j.ntn; return c;
}

DI void mod_item(const Params& p, int it, char* smem) {
  float* cond = (float*)smem;
  float* red = cond + 3 * 1024;
  const int tid = opaque_tid(), l = it / 96, j0 = (it % 96) * 64;
  __syncthreads();
  for (int i = tid; i < 3 * 1024; i += NTHR) {
    const int r = i >> 10, k = i & 1023;
    const float v = r < 2 ? p.c[r * 1024 + k] : p.c_ctx[k];
    cond[i] = siluf_(v);
  }
  __syncthreads();
  const int jj = tid & 63, kg = tid >> 6;
  float a0 = 0.f, a1 = 0.f, a2 = 0.f;
  const float* w = p.w_mod + (size_t)l * 1024 * 6144 + j0 + jj;
  for (int k = kg; k < 1024; k += 8) {
    const float wv = w[(size_t)k * 6144];
    a0 += cond[k] * wv; a1 += cond[1024 + k] * wv; a2 += cond[2048 + k] * wv;
  }
  red[(kg * 3 + 0) * 64 + jj] = a0; red[(kg * 3 + 1) * 64 + jj] = a1; red[(kg * 3 + 2) * 64 + jj] = a2;
  __syncthreads();
  if (tid < 192) {
    const int r = tid >> 6; float s = 0.f;
    for (int g = 0; g < 8; ++g) s += red[(g * 3 + r) * 64 + jj];
    float* mod = (float*)(p.ws + OFF_MOD);
    mod[((size_t)l * 3 + r) * 6144 + j0 + jj] = s + p.b_mod[(size_t)l * 6144 + j0 + jj];
  }
}
DI void rope_item(const Params& p, int it) {
  const int idx = it * NTHR + threadIdx.x;
  if (idx >= T_ * 16) return;
  const int t = idx >> 4, i = idx & 15, f = i & 7;
  const float pos = (float)(i < 8 ? t / GRID_W_ : t % GRID_W_);
  const float inv = powf(10000.f, -(float)(2 * f) / 16.f);
  const float ang = pos * inv;
  float2* rt = (float2*)(p.ws + OFF_ROPE);
  rt[idx] = make_float2(cosf(ang), sinf(ang));
}
constexpr int PA_ITEMS = 192 + (T_ * 16 + NTHR - 1) / NTHR;
DI void phaseA(const Params& p, char* smem) {
  if (blockIdx.x == 0) for (int i = threadIdx.x; i < 8192; i += NTHR) ((int*)(p.ws + OFF_CNT))[i] = 0;
  for (int it = blockIdx.x; it < PA_ITEMS; it += gridDim.x) {
    if (it < 192) mod_item(p, it, smem); else rope_item(p, it - 192);
  }
  cvt_run([&](int i) { return cvt_mix_dec(p, i / CVT_MIX_TILES, i % CVT_MIX_TILES); }, blockIdx.x, 2 * CVT_MIX_TILES, gridDim.x, smem);
}

DI void row_norm_mod(const float (&v)[16], const float* g, const float* shift, const float* scale, bf16_t* hrow, int lane) {
  float ss = 0.f;
#pragma unroll
  for (int i = 0; i < 16; ++i) ss += v[i] * v[i];
  ss = wave_sum(ss);
  const float rs = frsq(ss * (1.f / 1024.f) + 1e-6f);
#pragma unroll
  for (int j = 0; j < 4; ++j) {
    const int c = (j * 64 + lane) * 4;
    const float4 gg = *(const float4*)(g + c), sh = *(const float4*)(shift + c), sc = *(const float4*)(scale + c);
    const float h0 = v[j * 4 + 0] * rs * gg.x * (1.f + sc.x) + sh.x;
    const float h1 = v[j * 4 + 1] * rs * gg.y * (1.f + sc.y) + sh.y;
    const float h2 = v[j * 4 + 2] * rs * gg.z * (1.f + sc.z) + sh.z;
    const float h3 = v[j * 4 + 3] * rs * gg.w * (1.f + sc.w) + sh.w;
    uint2 o; o.x = pack2bf(h0, h1); o.y = pack2bf(h2, h3);
    *(uint2*)(hrow + c) = o;
  }
}
DI void phase_norm0(const Params& p) {
  const int lane = threadIdx.x & 63, wid = threadIdx.x >> 6;
  float* xs = (float*)(p.ws + OFF_XS);
  bf16_t* H = (bf16_t*)(p.ws + OFF_H);
  const float* mod = (const float*)(p.ws + OFF_MOD);
  for (int n = blockIdx.x * 8 + wid; n < NT_; n += gridDim.x * 8) {
    const float* src = n < NX_ ? p.x + (size_t)n * 1024 : p.ctx + (size_t)(n - NX_) * 1024;
    float v[16];
#pragma unroll
    for (int j = 0; j < 4; ++j) {
      const float4 t = *(const float4*)(src + (j * 64 + lane) * 4);
      v[j * 4] = t.x; v[j * 4 + 1] = t.y; v[j * 4 + 2] = t.z; v[j * 4 + 3] = t.w;
      *(float4*)(xs + (size_t)n * 1024 + (j * 64 + lane) * 4) = t;
    }
    const float* m = mod + (size_t)(0 * 3 + tok_modrow(n)) * 6144;
    row_norm_mod(v, p.g_mix, m, m + 1024, H + (size_t)n * 1024, lane);
  }
}

template <int BM, int BN, int BK, int WM_, int WN_>
struct Gemm {
  static constexpr int WTM = BM / WM_, WTN = BN / WN_, MB = WTM / 32, NB = WTN / 32, WM = WM_, WN = WN_, TM = BM, TN = BN;
  static constexpr int LDA = BK + 8;
  static constexpr int A_BYTES = BM * LDA * 2, B_BYTES = BN * LDA * 2, STAGE = A_BYTES + B_BYTES;
  static constexpr int SMEM = 2 * STAGE;
  static constexpr int CPR = BK / 8;
  static constexpr int ACH = BM * CPR / NTHR, BCH = BN * CPR / NTHR;
  static_assert(WM_ * WN_ == 8, "8 waves");
  static_assert(BM * CPR % NTHR == 0 && BN * CPR % NTHR == 0, "chunking");
  static_assert(NTHR % CPR == 0, "rows fixed per thread");

  template <class LA, class LB>
  static DI void run_core(f32x16 (&acc)[MB][NB], LA la, LB lb, int nk, char* smem, int tid) {
    const int lane = tid & 63, wid = tid >> 6, wm = wid / WN_, wn = wid % WN_;
    const int kc = (tid % CPR) * 8, r0 = tid / CPR;
    constexpr int KS = BK / 16, NCH = ACH + BCH;
    u32x4 s0[NCH], s1[NCH];
#define GEMM_LOAD(dst_, kt_) { const int kq_ = (kt_) < nk ? (kt_) : nk - 1; \
    _Pragma("unroll") for (int i = 0; i < ACH; ++i) dst_[i] = la(i, kq_); \
    _Pragma("unroll") for (int i = 0; i < BCH; ++i) dst_[ACH + i] = lb(i, kq_); }
#define GEMM_WRITE1(src_, c_, buf_) { if ((c_) < ACH) *(u32x4*)(smem + (buf_) * STAGE + ((r0 + (c_) * (NTHR / CPR)) * LDA + kc) * 2) = src_[c_]; \
    else *(u32x4*)(smem + (buf_) * STAGE + A_BYTES + ((r0 + ((c_) - ACH) * (NTHR / CPR)) * LDA + kc) * 2) = src_[c_]; }
#define GEMM_STEP(w_, l_, kt_) { \
    GEMM_LOAD(l_, (kt_) + 2); \
    sched_fence(); \
    const char* As = smem + ((kt_) & 1) * STAGE; const char* Bs = As + A_BYTES; \
    _Pragma("unroll") for (int ks = 0; ks < KS; ++ks) { \
      bf16x8 af[MB], bfr[NB]; \
      _Pragma("unroll") for (int mb = 0; mb < MB; ++mb) af[mb] = *(const bf16x8*)(As + ((wm * WTM + mb * 32 + (lane & 31)) * LDA + ks * 16 + (lane >> 5) * 8) * 2); \
      _Pragma("unroll") for (int nb = 0; nb < NB; ++nb) bfr[nb] = *(const bf16x8*)(Bs + ((wn * WTN + nb * 32 + (lane & 31)) * LDA + ks * 16 + (lane >> 5) * 8) * 2); \
      _Pragma("unroll") for (int c = 0; c < NCH; ++c) if ((c * KS) / NCH == ks) GEMM_WRITE1(w_, c, ((kt_) + 1) & 1); \
      _Pragma("unroll") for (int mb = 0; mb < MB; ++mb) _Pragma("unroll") for (int nb = 0; nb < NB; ++nb) acc[mb][nb] = mfma32(af[mb], bfr[nb], acc[mb][nb]); \
    } \
    sched_fence(); \
    __syncthreads(); }
    GEMM_LOAD(s0, 0);
#pragma unroll
    for (int c = 0; c < NCH; ++c) GEMM_WRITE1(s0, c, 0);
    GEMM_LOAD(s0, 1);
    __syncthreads();
    for (int kt = 0; kt < nk; kt += 2) {
      GEMM_STEP(s0, s1, kt);
      GEMM_STEP(s1, s0, kt + 1);
    }
#undef GEMM_STEP
#undef GEMM_WRITE1
#undef GEMM_LOAD
  }
  template <class ARow>
  static DI void run(f32x16 (&acc)[MB][NB], ARow arow, const bf16_t* Bt, int ldb, int Klen, char* smem) {
    const int tid = opaque_tid();
    const int kc = (tid % CPR) * 8, r0 = tid / CPR;
    const bf16_t* ap[ACH];
#pragma unroll
    for (int i = 0; i < ACH; ++i) ap[i] = arow(r0 + i * (NTHR / CPR)) + kc;
    const bf16_t* bp0 = Bt + (size_t)r0 * ldb + kc;
    const size_t sb = (size_t)(NTHR / CPR) * ldb;
    run_core(acc, [&](int i, int kt) { return *(const u32x4*)(ap[i] + kt * BK); },
             [&](int i, int kt) { return *(const u32x4*)(bp0 + i * sb + kt * BK); }, Klen / BK, smem, tid);
  }
  static DI void run_lin(f32x16 (&acc)[MB][NB], const bf16_t* A0, int lda, const bf16_t* Bt, int ldb, int Klen, char* smem) {
    const int tid = opaque_tid();
    const int kc = (tid % CPR) * 8, r0 = tid / CPR;
    const bf16_t* ap0 = A0 + (size_t)r0 * lda + kc; const bf16_t* bp0 = Bt + (size_t)r0 * ldb + kc;
    const size_t sa = (size_t)(NTHR / CPR) * lda, sb = (size_t)(NTHR / CPR) * ldb;
    run_core(acc, [&](int i, int kt) { return *(const u32x4*)(ap0 + i * sa + kt * BK); },
             [&](int i, int kt) { return *(const u32x4*)(bp0 + i * sb + kt * BK); }, Klen / BK, smem, tid);
  }
  static DI int row_of(int t, int mb, int reg) { const int lane = t & 63, wm = (t >> 6) / WN_; return wm * WTM + mb * 32 + crow(reg, lane >> 5); }
  static DI int col_of(int t, int nb) { const int lane = t & 63, wn = (t >> 6) % WN_; return wn * WTN + nb * 32 + (lane & 31); }
};


template <int NBW> struct WTile {
  static constexpr int LD = NBW * 32 + 4;
  static constexpr int BYTES = 32 * LD * 4;
  static DI void put(float* scr, int nb, int lane, const f32x16& v) {
    const int c = nb * 32 + (lane & 31), h = lane >> 5;
#pragma unroll
    for (int i = 0; i < 16; ++i) scr[crow(i, h) * LD + c] = v[i];
  }
  template <class F> static DI void rows4(const float* scr, int lane, F f) {
    wave_sync();
#pragma unroll
    for (int it = 0; it < NBW * 4; ++it) {
      const int id = it * 64 + lane, row = id / (NBW * 8), q = id % (NBW * 8);
      f(row, q * 4, *(const float4*)(scr + row * LD + q * 4));
    }
    wave_sync();
  }
  template <class F> static DI void rows8(const float* scr, int lane, F f) {
    wave_sync();
#pragma unroll
    for (int it = 0; it < NBW * 2; ++it) {
      const int id = it * 64 + lane, row = id / (NBW * 4), q = id % (NBW * 4);
      f(row, q * 8, *(const float4*)(scr + row * LD + q * 8), *(const float4*)(scr + row * LD + q * 8 + 4));
    }
    wave_sync();
  }
};
DI uint4 pack8bf(const float4& a, const float4& b) { return make_uint4(pack2bf(a.x, a.y), pack2bf(a.z, a.w), pack2bf(b.x, b.y), pack2bf(b.z, b.w)); }

typedef Gemm<256, 256, 64, 2, 4> G256;
DI void phase_win(const Params& p, int l, char* smem) {
  const bf16_t* H = (const bf16_t*)(p.ws + OFF_H);
  const bf16_t* W = (const bf16_t*)(p.ws + OFF_WMIX + (size_t)l * WM_SIZE + WM_WIN);
  bf16_t* zmla = (bf16_t*)(p.osc + O_ZMLA);
  float* zrec = (float*)(p.ws + OFF_REGION + R_ZREC);
  constexpr int TM = NT_ / 256, TN = WIN_N / 256;
  for (int it = vblock(); it < TM * TN; it += gridDim.x) {
    const int tid = opaque_tid();
    const int tm = it / TN, tn = it % TN;
    __syncthreads();
    f32x16 acc[G256::MB][G256::NB];
#pragma unroll
    for (int a = 0; a < G256::MB; ++a)
#pragma unroll
      for (int b = 0; b < G256::NB; ++b) acc[a][b] = zero16();
    const bf16_t* A0 = H + (size_t)tm * 256 * 1024;
    G256::run(acc, [&](int r) { return A0 + (size_t)r * 1024; }, W + (size_t)tn * 256 * 1024, 1024, 1024, smem);
    {
      const int lane = tid & 63, wid = tid >> 6, wm = wid / 4, wn = wid % 4;
      float* scr = (float*)(smem + wid * WTile<2>::BYTES);
      const int col0 = tn * 256 + wn * 64;
#pragma unroll
      for (int mb = 0; mb < G256::MB; ++mb) {
        WTile<2>::put(scr, 0, lane, acc[mb][0]); WTile<2>::put(scr, 1, lane, acc[mb][1]);
        const int row0 = tm * 256 + wm * 128 + mb * 32;
#ifdef ABL_NOSTORE
        if (tn > 1000) {
#else
        if (tn < 3) {
#endif
          WTile<2>::rows8(scr, lane, [&](int r, int c, const float4& a, const float4& bq) {
            *(uint4*)(zmla + (size_t)(row0 + r) * ZMLA_W + col0 + c) = pack8bf(a, bq); });
        } else {
          WTile<2>::rows4(scr, lane, [&](int r, int c, const float4& a) {
            const int cc = col0 - 768 + c;
#ifdef ABL_NOSTORE
            if (cc < -5) *(float4*)(zrec + (size_t)(row0 + r) * ZREC_W + cc) = a; });
#else
            if (cc < ZREC_W) *(float4*)(zrec + (size_t)(row0 + r) * ZREC_W + cc) = a; });
#endif
        }
      }
    }
  }
}
typedef Gemm<128, 128, 64, 2, 4> G128;
DI void mla_row_rs(const bf16_t* zmla_rows, int c0, int len, float* rs) {
  const int tid = opaque_tid(), row = tid >> 2, half = tid & 3;
  const bf16_t* src = zmla_rows + (size_t)row * ZMLA_W + c0 + half * (len / 4);
  float ss = 0.f;
  for (int i = 0; i < len / 4; i += 8) {
    const uint4 v = *(const uint4*)(src + i);
    const unsigned w[4] = {v.x, v.y, v.z, v.w};
#pragma unroll
    for (int j = 0; j < 4; ++j) { const float a = bf2f((bf16_t)(w[j] & 0xffff)), b = bf2f((bf16_t)(w[j] >> 16)); ss += a * a + b * b; }
  }
  ss += __shfl_xor(ss, 1); ss += __shfl_xor(ss, 2);
  if (half == 0) rs[row] = frsq(ss / (float)len + 1e-6f);
}

constexpr int MLA_Q_TILES = (NT_ / 128) * 6, MLA_KV_TILES = (NT_ / 128) * 8;
DI void mla_q_item(const Params& p, int l, int it, char* smem) {
  const int tid = opaque_tid();
  const int tm = it / 6, tn = it % 6;
  const bf16_t* zmla = (const bf16_t*)(p.osc + O_ZMLA) + (size_t)tm * 128 * ZMLA_W;
  const bf16_t* W = (const bf16_t*)(p.ws + OFF_WMIX + (size_t)l * WM_SIZE + WM_UQ) + (size_t)tn * 128 * 384;
  bf16_t* qb = (bf16_t*)(p.osc + O_QB);
  const float2* rt = (const float2*)(p.ws + OFF_ROPE);
  float* rs = (float*)(smem + G128::SMEM);
  __syncthreads();
  mla_row_rs(zmla, 0, 384, rs);
  f32x16 acc[G128::MB][G128::NB];
#pragma unroll
  for (int a = 0; a < G128::MB; ++a)
#pragma unroll
    for (int b = 0; b < G128::NB; ++b) acc[a][b] = zero16();
  G128::run(acc, [&](int r) { return zmla + (size_t)r * ZMLA_W; }, W, 384, 384, smem);
  const int lane = tid & 63;
  const bool isx = tm * 128 < NX_;
#pragma unroll
  for (int mb = 0; mb < G128::MB; ++mb)
#pragma unroll
    for (int nb = 0; nb < G128::NB; ++nb) {
      const int col = tn * 128 + G128::col_of(tid, nb);
      const bool ropeblk = ((col >> 5) % 3) == 2;
      const int e = lane & 31;
#pragma unroll
      for (int i = 0; i < 16; ++i) {
        const int lr = G128::row_of(tid, mb, i);
        const int n = tm * 128 + lr;
        float v = acc[mb][nb][i] * rs[lr];
        if (ropeblk && isx) {
          const float pv = __shfl_xor(v, 8);
          const float2 cs = rt[(size_t)(n % T_) * 16 + (e >> 4) * 8 + (e & 7)];
          v = (e & 8) ? (pv * cs.y + v * cs.x) : (v * cs.x - pv * cs.y);
        }
        qb[(size_t)n * 768 + col] = f2bf(v);
      }
    }
}
DI void mla_kv_item(const Params& p, int l, int it, char* smem) {
  const int tid = opaque_tid();
  const int tm = it / 8, tn = it % 8;
  const bf16_t* zmla = (const bf16_t*)(p.osc + O_ZMLA) + (size_t)tm * 128 * ZMLA_W;
  const bf16_t* W = (const bf16_t*)(p.ws + OFF_WMIX + (size_t)l * WM_SIZE + WM_UKV) + (size_t)tn * 128 * 256;
  bf16_t* kb = (bf16_t*)(p.ws + OFF_REGION + R_KB);
  bf16_t* vt = (bf16_t*)(p.ws + OFF_REGION + R_VT);
  const float2* rt = (const float2*)(p.ws + OFF_ROPE);
  float* rs = (float*)(smem + G128::SMEM);
  __syncthreads();
  mla_row_rs(zmla, 384, 256, rs);
  const int n0 = tm * 128;
  const int b = tok_b(n0), key0 = tok_key(n0);
  const bool isx = n0 < NX_;
  if (tn == 0) {
    for (int idx = tid; idx < 128 * 16; idx += NTHR) {
      const int lr = idx >> 4, pi = idx & 15, a = pi >> 3, i = pi & 7;
      const bf16_t* z = zmla + (size_t)lr * ZMLA_W + 640 + a * 16 + i;
      float x1 = bf2f(z[0]), x2 = bf2f(z[8]);
      if (isx) {
        const float2 cs = rt[(size_t)((n0 + lr) % T_) * 16 + a * 8 + i];
        const float y1 = x1 * cs.x - x2 * cs.y, y2 = x1 * cs.y + x2 * cs.x; x1 = y1; x2 = y2;
      }
      const bf16_t o1 = f2bf(x1), o2 = f2bf(x2);
      for (int h = 0; h < 8; ++h) {
        bf16_t* dst = kb + ((size_t)(b * 8 + h) * KT_ + key0 + lr) * 96 + 64 + a * 16 + i;
        dst[0] = o1; dst[8] = o2;
      }
    }
  }
  f32x16 acc[G128::MB][G128::NB];
#pragma unroll
  for (int a = 0; a < G128::MB; ++a)
#pragma unroll
    for (int c = 0; c < G128::NB; ++c) acc[a][c] = zero16();
  G128::run(acc, [&](int r) { return zmla + (size_t)r * ZMLA_W + 384; }, W, 256, 256, smem);
  const int lane = tid & 63;
#pragma unroll
  for (int mb = 0; mb < G128::MB; ++mb)
#pragma unroll
    for (int nb = 0; nb < G128::NB; ++nb) {
      const int col = tn * 128 + G128::col_of(tid, nb);
      if (col < 512) {
        const int h = col >> 6, d = col & 63;
#pragma unroll
        for (int i = 0; i < 16; ++i) {
          const int lr = G128::row_of(tid, mb, i);
          kb[((size_t)(b * 8 + h) * KT_ + key0 + lr) * 96 + d] = f2bf(acc[mb][nb][i] * rs[lr]);
        }
      } else {
        const int h = (col - 512) >> 6, d = col & 63;
#pragma unroll
        for (int g = 0; g < 4; ++g) {
          const int lr = G128::row_of(tid, mb, g * 4);
          uint2 o;
          o.x = pack2bf(acc[mb][nb][g * 4 + 0] * rs[lr], acc[mb][nb][g * 4 + 1] * rs[lr + 1]);
          o.y = pack2bf(acc[mb][nb][g * 4 + 2] * rs[lr + 2], acc[mb][nb][g * 4 + 3] * rs[lr + 3]);
          *(uint2*)(vt + ((size_t)(b * 8 + h) * 64 + d) * KT_ + key0 + lr) = o;
        }
      }
    }
  (void)lane;
}

DI float softplusf_(float x) { const float e = fexp(-fabsf(x)); return fmaxf(x, 0.f) + (e < 0.01f ? e * (1.f - 0.5f * e) : flog(1.f + e)); }
constexpr int RWP_TT = 16;
constexpr int RWP_ITEMS = NT_ / RWP_TT;
DI void rwkv_prep_items(const Params& p, int l, char* smem) {
  if ((int)blockIdx.x >= RWP_ITEMS) return;
  float* zs = (float*)smem;
  float* tw = zs + RWP_TT * 1024;
  float* ta = tw + 2 * 64 * RWP_TT;
  const float* zrec = (const float*)(p.ws + OFF_REGION + R_ZREC);
  bf16_t* rb = (bf16_t*)(p.ws + OFF_REGION + R_RB16);
  float* lwo = (float*)(p.ws + OFF_REGION + R_LW);
  float* bso = (float*)(p.ws + OFF_REGION + R_BS);
  const float* mu = p.rw_mu + (size_t)l * 1152;
  const int tid = opaque_tid();
  const int col = tid & 255, d = tid >> 8;
  const float* w2 = p.rw_w2 + ((size_t)l * 2 + d) * 64 * 256 + col;
  const float* a2 = p.rw_a2 + ((size_t)l * 2 + d) * 64 * 256 + col;
  const float rkw = p.rw_r_k[(size_t)l * 256 + col];
  const float w0 = p.rw_w0[((size_t)l * 2 + d) * 256 + col], a0 = p.rw_a0[((size_t)l * 2 + d) * 256 + col];
  const float kkw = p.rw_k_k[(size_t)l * 256 + col], kaw = p.rw_k_a[(size_t)l * 256 + col];
  const size_t AS = (size_t)NT_ * 256;
#pragma unroll 1
  for (int it = blockIdx.x; it < RWP_ITEMS; it += gridDim.x) {
    const int n0 = it * RWP_TT;
    __syncthreads();
    TSB(p, 44);
#pragma unroll 1
    for (int i = 0; i < 8; ++i) {
      const int idx4 = tid + i * NTHR, tt = idx4 >> 8, c = (idx4 & 255) * 4, n = n0 + tt, t = tok_t(n);
      const int len = n < NX_ ? T_ : CL_;
      const float* zr = zrec + (size_t)n * ZREC_W + ZR_RW + c;
      const float4 z = *(const float4*)zr;
      const float4 zp = t > 0 ? *(const float4*)(zr - ZREC_W) : make_float4(0.f, 0.f, 0.f, 0.f);
      const float4 zn = t < len - 1 ? *(const float4*)(zr + ZREC_W) : make_float4(0.f, 0.f, 0.f, 0.f);
      const float4 m4 = *(const float4*)(mu + c);
      float4 sv;
      sv.x = z.x + (0.5f * (zp.x + zn.x) - z.x) * m4.x; sv.y = z.y + (0.5f * (zp.y + zn.y) - z.y) * m4.y;
      sv.z = z.z + (0.5f * (zp.z + zn.z) - z.z) * m4.z; sv.w = z.w + (0.5f * (zp.w + zn.w) - z.w) * m4.w;
      *(float4*)(zs + tt * 1024 + c) = sv;
      if (c >= 768) {
        const float e4[4] = {sv.x, sv.y, sv.z, sv.w};
#pragma unroll
        for (int q = 0; q < 4; ++q) {
          const int cc = c + q;
          if (cc < 896) { const int dd = (cc - 768) >> 6, k = (cc - 768) & 63; tw[(dd * 64 + k) * RWP_TT + tt] = 1.f - 2.f * frcp(1.f + fexp(2.f * e4[q])); }
          else { const int dd = (cc - 896) >> 6, k = (cc - 896) & 63; ta[(dd * 64 + k) * RWP_TT + tt] = e4[q]; }
        }
      }
    }
    __syncthreads();
    TSB(p, 45);
#pragma unroll 1
    for (int th = 0; th < RWP_TT; th += 8) {
      float aw[8], aa[8];
#pragma unroll
      for (int i = 0; i < 8; ++i) { aw[i] = 0.f; aa[i] = 0.f; }
#pragma unroll 1
      for (int kh = 0; kh < 4; ++kh) {
        float wr[16], ar[16];
#pragma unroll
        for (int k = 0; k < 16; ++k) { wr[k] = w2[(kh * 16 + k) * 256]; ar[k] = a2[(kh * 16 + k) * 256]; }
#pragma unroll
        for (int k = 0; k < 16; ++k) {
          const float* twk = tw + (d * 64 + kh * 16 + k) * RWP_TT + th;
          const float* tak = ta + (d * 64 + kh * 16 + k) * RWP_TT + th;
#pragma unroll
          for (int i = 0; i < 8; ++i) { aw[i] += twk[i] * wr[k]; aa[i] += tak[i] * ar[k]; }
          if ((k & 3) == 3) sched_fence();
        }
      }
#pragma unroll
      for (int i = 0; i < 8; ++i) {
        const int n = n0 + th + i;
        const float* zr = zs + (th + i) * 1024 + col;
        const float r = zr[0], k = zr[256], v = zr[512];
        const float kr = k * kkw;
        const float ss = wave_sum(kr * kr);
        const float kk = kr * frsq(fmaxf(ss, 1e-24f));
        const float w = -softplusf_(-(w0 + aw[i])) - 0.5f;
        const float logdecay = -fexp(w);
        const float a = sigmoidf_(a0 + aa[i]);
        const float kd = k * (1.f + (a - 1.f) * kaw);
        const float bsum = wave_sum(r * rkw * kd);
        const size_t o = (size_t)n * 256 + col;
        if (d == 0) { rb[0 * AS + o] = f2bf(r); rb[1 * AS + o] = f2bf(v); rb[2 * AS + o] = f2bf(kk); }
        lwo[d * AS + o] = logdecay;
        rb[(3 + 2 * d) * AS + o] = f2bf(kd);
        rb[(4 + 2 * d) * AS + o] = f2bf(kk * a);
        if ((tid & 63) == 0) bso[((size_t)d * NT_ + n) * 4 + (col >> 6)] = bsum;
      }
    }
    TSB(p, 47);
  }
}

DI int seq_tok(int dir, int b, int pos) {
  if (pos < CL_) return NX_ + b * CL_ + (dir ? CL_ - 1 - pos : pos);
  const int t = pos - CL_;
  return b * T_ + (dir ? T_ - 1 - t : t);
}
DI float logsigmoidf_(float x) { return -softplusf_(-x); }
DI float wave_incl_scan(float v, int lane) {
  for (int d = 1; d < 64; d <<= 1) { const float o = __shfl_up(v, d); if (lane >= d) v += o; }
  return v;
}
constexpr int ML_ST = 2112;
constexpr int ML1_ITEMS = NSEQ_ * NCH_;
DI void mlstm_local_item(const Params& p, int l, int it, char* smem) {
  const int s = it / NCH_, c = it % NCH_, dir = s >> 3, b = (s >> 2) & 1, hd = s & 3;
  float* vv = (float*)smem;
  float* kw = vv + 64 * 64;
  float* wej = kw + 64 * 32;
  const float* zrec = (const float*)(p.ws + OFF_REGION + R_ZREC);
  float* st = (float*)(p.ws + OFF_REGION + R_MLST) + ((size_t)s * NCH_ + c) * ML_ST;
  const int tid = opaque_tid(), lane = tid & 63, wid = tid >> 6;
  __syncthreads();
  if (wid == 0) {
    const int n = seq_tok(dir, b, c * 64 + lane);
    const float fp = zrec[(size_t)n * ZREC_W + ZR_MLF + dir * 4 + hd] + p.ml_b_f[(l * 2 + dir) * 4 + hd];
    const float ip = zrec[(size_t)n * ZREC_W + ZR_MLI + dir * 4 + hd] + p.ml_b_i[(l * 2 + dir) * 4 + hd];
    const float bj = wave_incl_scan(logsigmoidf_(fp), lane);
    const float bl = lane_bcast<63>(bj);
    const float lw = bl - bj + ip;
    const float ml = wave_max(lw);
    wej[lane] = fexp(lw - ml);
    if (lane == 0) { st[2080] = bl; st[2081] = ml; }
  }
  for (int idx = tid; idx < 64 * 64; idx += NTHR) {
    const int j = idx >> 6, e = idx & 63;
    const int n = seq_tok(dir, b, c * 64 + j);
    vv[idx] = zrec[(size_t)n * ZREC_W + ZR_MLV + hd * 64 + e];
  }
  __syncthreads();
  for (int idx = tid; idx < 64 * 32; idx += NTHR) {
    const int j = idx >> 5, e = idx & 31;
    const int n = seq_tok(dir, b, c * 64 + j);
    kw[idx] = zrec[(size_t)n * ZREC_W + ZR_MLK + hd * 32 + e] * wej[j];
  }
  __syncthreads();
  const int v = tid & 63, d0 = (tid >> 6) * 4;
  float a0 = 0.f, a1 = 0.f, a2 = 0.f, a3 = 0.f;
  for (int j = 0; j < 64; ++j) {
    const float x = vv[j * 64 + v];
    const float4 kk = *(const float4*)(kw + j * 32 + d0);
    a0 += x * kk.x; a1 += x * kk.y; a2 += x * kk.z; a3 += x * kk.w;
  }
  *(float4*)(st + v * 32 + d0) = make_float4(a0, a1, a2, a3);
  if (tid < 32) { float sn = 0.f; for (int j = 0; j < 64; ++j) sn += kw[j * 32 + tid]; st[2048 + tid] = sn; }
}
constexpr int ML2_ITEMS = (NSEQ_ * 2080 + NTHR - 1) / NTHR;
DI void mlstm_scan_item(const Params& p, int it) {
  const int g = it * NTHR + opaque_tid();
  if (g >= NSEQ_ * 2080) return;
  const int s = g / 2080, e = g % 2080;
  float* st = (float*)(p.ws + OFF_REGION + R_MLST) + (size_t)s * NCH_ * ML_ST;
  float state = 0.f, m = 0.f;
  static_assert(NCH_ % 4 == 0, "chunk count");
  for (int c0 = 0; c0 < NCH_; c0 += 4) {
    float d[4], bl[4], ml[4];
#pragma unroll
    for (int u = 0; u < 4; ++u) { const float* r = st + (size_t)(c0 + u) * ML_ST; d[u] = r[e]; bl[u] = r[2080]; ml[u] = r[2081]; }
#pragma unroll
    for (int u = 0; u < 4; ++u) {
      float* r = st + (size_t)(c0 + u) * ML_ST;
      r[e] = state;
      if (e == 0) r[2082] = m;
      const float mn = fmaxf(bl[u] + m, ml[u]);
      state = fexp(bl[u] + m - mn) * state + fexp(ml[u] - mn) * d[u];
      m = mn;
    }
  }
}

DI void phase3(const Params& p, int l, char* smem) {
  rwkv_prep_items(p, l, smem);
  for (int it = (int)gridDim.x - 1 - (int)blockIdx.x; it < ML1_ITEMS; it += gridDim.x) { TSB(p, 56); mlstm_local_item(p, l, it, smem); TSB(p, 57); }
}
constexpr int RW_LD = 72, RW_MB = 64 * RW_LD * 2;
constexpr int RWC_REC = 40960;
DI char* rw_rec(const Params& p, int s, int c) { return p.ws + OFF_REGION + R_CH + ((size_t)s * NCH_ + c) * RWC_REC; }
DI f32x16 rw_mm(const char* A, const char* Bt, int mb, int nb, int lane, f32x16 acc) {
  const int r = lane & 31, h = lane >> 5;
#pragma unroll
  for (int ks = 0; ks < 4; ++ks) {
    const bf16x8 a = *(const bf16x8*)(A + ((mb * 32 + r) * RW_LD + ks * 16 + h * 8) * 2);
    const bf16x8 b = *(const bf16x8*)(Bt + ((nb * 32 + r) * RW_LD + ks * 16 + h * 8) * 2);
    acc = mfma32(a, b, acc);
  }
  return acc;
}
DI void rw_wrT(char* Dst, int mb, int nb, int lane, const f32x16& v) {
  const int r = lane & 31, h = lane >> 5;
#pragma unroll
  for (int g = 0; g < 4; ++g) {
    uint2 o; o.x = pack2bf(v[4 * g], v[4 * g + 1]); o.y = pack2bf(v[4 * g + 2], v[4 * g + 3]);
    *(uint2*)(Dst + ((nb * 32 + r) * RW_LD + mb * 32 + 8 * g + 4 * h) * 2) = o;
  }
}
DI void rw_wrT_g(bf16_t* Dst, int mb, int nb, int lane, const f32x16& v) {
  const int r = lane & 31, h = lane >> 5;
#pragma unroll
  for (int g = 0; g < 4; ++g) {
    uint2 o; o.x = pack2bf(v[4 * g], v[4 * g + 1]); o.y = pack2bf(v[4 * g + 2], v[4 * g + 3]);
    *(uint2*)(Dst + (nb * 32 + r) * 64 + mb * 32 + 8 * g + 4 * h) = o;
  }
}
DI void rw_addT(const char* Src, int mb, int nb, int lane, f32x16& v) {
  const int r = lane & 31, h = lane >> 5;
#pragma unroll
  for (int g = 0; g < 4; ++g) {
    const uint2 u = *(const uint2*)(Src + ((nb * 32 + r) * RW_LD + mb * 32 + 8 * g + 4 * h) * 2);
    v[4 * g] += bf2f((bf16_t)(u.x & 0xffff)); v[4 * g + 1] += bf2f((bf16_t)(u.x >> 16));
    v[4 * g + 2] += bf2f((bf16_t)(u.y & 0xffff)); v[4 * g + 3] += bf2f((bf16_t)(u.y >> 16));
  }
}
DI void rw_mask_upper(f32x16& v, int mb, int nb, int lane, bool strict) {
  const int col = nb * 32 + (lane & 31), h = lane >> 5;
#pragma unroll
  for (int i = 0; i < 16; ++i) { const int row = mb * 32 + crow(i, h); if (strict ? !(row < col) : !(row <= col)) v[i] = 0.f; }
}
DI void rw_mask_lower_strict(f32x16& v, int mb, int nb, int lane) {
  const int col = nb * 32 + (lane & 31), h = lane >> 5;
#pragma unroll
  for (int i = 0; i < 16; ++i) { const int row = mb * 32 + crow(i, h); if (!(col < row)) v[i] = 0.f; }
}

constexpr int RW1_ITEMS = NSEQ_ * NCH_;
DI void rw_chunk_item(const Params& p, int it, char* smem) {
  const int s = it / NCH_, c = it % NCH_, dir = s >> 3, b = (s >> 2) & 1, hd = s & 3;
  const int tid = opaque_tid(), lane = tid & 63, wid = tid >> 6;
  const bf16_t* rb = (const bf16_t*)(p.ws + OFF_REGION + R_RB16);
  const float* lwg = (const float*)(p.ws + OFF_REGION + R_LW) + (size_t)dir * NT_ * 256;
  const size_t AS = (size_t)NT_ * 256;
  char* const At = smem + 0 * RW_MB; char* const Bt_ = smem + 1 * RW_MB; char* const Kt = smem + 2 * RW_MB; char* const Rt = smem + 3 * RW_MB;
  char* const Aj = smem + 4 * RW_MB; char* const Bj = smem + 5 * RW_MB; char* const Kj = smem + 6 * RW_MB; char* const Vi = smem + 7 * RW_MB;
  char* const QA = smem + 8 * RW_MB; char* const QTA = smem + 9 * RW_MB; char* const GA = smem + 10 * RW_MB;
  char* const Mka = smem + 11 * RW_MB; char* const MbrT = smem + 12 * RW_MB; char* const MkrT = smem + 13 * RW_MB;
  char* const QB = At; char* const QTB = Bt_; char* const GB = Kt;
  float* const cs = (float*)(smem + 8 * RW_MB);
  float* const gC = (float*)(smem + 14 * RW_MB);
  char* rec = rw_rec(p, s, c);
  __syncthreads();
  const int t = tid >> 3, j8 = (tid & 7) * 8;
  const int n = seq_tok(dir, b, c * 64 + t);
  {
    const float4 l0 = *(const float4*)(lwg + (size_t)n * 256 + hd * 64 + j8), l1 = *(const float4*)(lwg + (size_t)n * 256 + hd * 64 + j8 + 4);
    float* d = cs + t * 65 + j8;
    d[0] = l0.x; d[1] = l0.y; d[2] = l0.z; d[3] = l0.w; d[4] = l1.x; d[5] = l1.y; d[6] = l1.z; d[7] = l1.w;
  }
  __syncthreads();
  if (tid < 64) { float a = 0.f; for (int tt = 0; tt < 64; ++tt) { a += cs[tt * 65 + tid]; cs[tt * 65 + tid] = a; } gC[tid] = fexp(a); }
  __syncthreads();
  {
    const size_t o = (size_t)n * 256 + hd * 64 + j8;
    const uint4 ukk = *(const uint4*)(rb + 2 * AS + o), ubb = *(const uint4*)(rb + (4 + 2 * dir) * AS + o), ukd = *(const uint4*)(rb + (3 + 2 * dir) * AS + o);
    const uint4 ur = *(const uint4*)(rb + 0 * AS + o), uv = *(const uint4*)(rb + 1 * AS + o);
    const unsigned akk[4] = {ukk.x, ukk.y, ukk.z, ukk.w}, abb[4] = {ubb.x, ubb.y, ubb.z, ubb.w}, akd[4] = {ukd.x, ukd.y, ukd.z, ukd.w};
    const unsigned ar[4] = {ur.x, ur.y, ur.z, ur.w}, av[4] = {uv.x, uv.y, uv.z, uv.w};
    unsigned oa[4], ob[4], ok[4], orr[4];
#pragma unroll
    for (int q = 0; q < 4; ++q) {
      float fa[2], fb[2], fk[2], fr[2];
#pragma unroll
      for (int e = 0; e < 2; ++e) {
        const int j = j8 + 2 * q + e;
        const float cst = cs[t * 65 + j], csp = t > 0 ? cs[(t - 1) * 65 + j] : 0.f;
        const float g = fexp(cst), gp = fexp(csp), gi = fexp(-cst);
        const int sh = 16 * e;
        fa[e] = -bf2f((bf16_t)((akk[q] >> sh) & 0xffff)) * gp;
        fb[e] = bf2f((bf16_t)((abb[q] >> sh) & 0xffff)) * gi;
        fk[e] = bf2f((bf16_t)((akd[q] >> sh) & 0xffff)) * gi;
        fr[e] = bf2f((bf16_t)((ar[q] >> sh) & 0xffff)) * g;
        *(bf16_t*)(Aj + (j * RW_LD + t) * 2) = f2bf(fa[e]);
        *(bf16_t*)(Bj + (j * RW_LD + t) * 2) = f2bf(fb[e]);
        *(bf16_t*)(Kj + (j * RW_LD + t) * 2) = f2bf(fk[e]);
        *(bf16_t*)(Vi + (j * RW_LD + t) * 2) = (bf16_t)((av[q] >> sh) & 0xffff);
      }
      oa[q] = pack2bf(fa[0], fa[1]); ob[q] = pack2bf(fb[0], fb[1]); ok[q] = pack2bf(fk[0], fk[1]); orr[q] = pack2bf(fr[0], fr[1]);
    }
    *(uint4*)(At + (t * RW_LD + j8) * 2) = make_uint4(oa[0], oa[1], oa[2], oa[3]);
    *(uint4*)(Bt_ + (t * RW_LD + j8) * 2) = make_uint4(ob[0], ob[1], ob[2], ob[3]);
    *(uint4*)(Kt + (t * RW_LD + j8) * 2) = make_uint4(ok[0], ok[1], ok[2], ok[3]);
    *(uint4*)(Rt + (t * RW_LD + j8) * 2) = make_uint4(orr[0], orr[1], orr[2], orr[3]);
  }
  __syncthreads();
  {
    const int prod = wid >> 2, mb = (wid >> 1) & 1, nb = wid & 1;
    f32x16 acc = zero16();
    if (prod == 0) {
      if (!(mb == 1 && nb == 0)) acc = rw_mm(Bt_, At, mb, nb, lane, acc);
      rw_mask_upper(acc, mb, nb, lane, true);
      rw_wrT(QA, mb, nb, lane, acc);
      if (mb == nb) {
        const int col = nb * 32 + (lane & 31), h = lane >> 5;
#pragma unroll
        for (int i = 0; i < 16; ++i) if (mb * 32 + crow(i, h) == col) acc[i] += 1.f;
      }
      rw_wrT(GA, mb, nb, lane, acc);
    } else {
      if (!(mb == 0 && nb == 1)) acc = rw_mm(At, Bt_, mb, nb, lane, acc);
      rw_mask_lower_strict(acc, mb, nb, lane);
      rw_wrT(QTA, mb, nb, lane, acc);
    }
  }
  for (int blk = wid; blk < 12; blk += 8) {
    const int prod = blk >> 2, mb = (blk >> 1) & 1, nb = blk & 1;
    f32x16 acc = zero16();
    if (prod == 0) {
      acc = rw_mm(At, Kt, mb, nb, lane, acc); rw_mask_lower_strict(acc, mb, nb, lane); rw_wrT(Mka, mb, nb, lane, acc);
    } else if (prod == 1) {
      acc = rw_mm(Bt_, Rt, mb, nb, lane, acc); rw_mask_upper(acc, mb, nb, lane, false); rw_wrT(MbrT, mb, nb, lane, acc);
    } else {
      acc = rw_mm(Kt, Rt, mb, nb, lane, acc); rw_mask_upper(acc, mb, nb, lane, false); rw_wrT(MkrT, mb, nb, lane, acc);
    }
  }
  __syncthreads();
#define RW_SQ(Q_, Qt_, Qn_, Qtn_, blk) { const int pr_ = (blk) >> 2, mb_ = ((blk) >> 1) & 1, nb_ = (blk) & 1; f32x16 acc_ = zero16(); \
    if (pr_ == 0) { acc_ = rw_mm(Q_, Qt_, mb_, nb_, lane, acc_); rw_wrT(Qtn_, mb_, nb_, lane, acc_); } \
    else { acc_ = rw_mm(Qt_, Q_, mb_, nb_, lane, acc_); rw_wrT(Qn_, mb_, nb_, lane, acc_); } }
#define RW_GUP(Qt_, G_, Gn_, blk) { const int mb_ = ((blk) >> 1) & 1, nb_ = (blk) & 1; f32x16 acc_ = zero16(); \
    rw_addT(G_, mb_, nb_, lane, acc_); acc_ = rw_mm(Qt_, G_, mb_, nb_, lane, acc_); rw_wrT(Gn_, mb_, nb_, lane, acc_); }
  RW_SQ(QA, QTA, QB, QTB, wid);
  __syncthreads();
  for (int blk = wid; blk < 12; blk += 8) { if (blk < 8) { RW_SQ(QB, QTB, QA, QTA, blk); } else { RW_GUP(QTB, GA, GB, blk - 8); } }
  __syncthreads();
  for (int blk = wid; blk < 12; blk += 8) { if (blk < 8) { RW_SQ(QA, QTA, QB, QTB, blk); } else { RW_GUP(QTA, GB, GA, blk - 8); } }
  __syncthreads();
  for (int blk = wid; blk < 12; blk += 8) { if (blk < 8) { RW_SQ(QB, QTB, QA, QTA, blk); } else { RW_GUP(QTB, GA, GB, blk - 8); } }
  __syncthreads();
  for (int blk = wid; blk < 12; blk += 8) { if (blk < 8) { RW_SQ(QA, QTA, QB, QTB, blk); } else { RW_GUP(QTA, GB, GA, blk - 8); } }
  __syncthreads();
  if (wid < 4) { RW_GUP(QTB, GA, GB, wid); }
  __syncthreads();
  {
    const int prod = wid >> 2, mb = (wid >> 1) & 1, nb = wid & 1;
    f32x16 acc = zero16();
    acc = rw_mm(GB, prod == 0 ? Mka : Aj, mb, nb, lane, acc);
    rw_wrT(prod == 0 ? QA : QTA, mb, nb, lane, acc);
  }
  __syncthreads();
  char* const X1 = QA; char* const X2 = QTA; char* const QpT = At;
  for (int blk = wid; blk < 16; blk += 8) {
    const int prod = blk >> 2, mb = (blk >> 1) & 1, nb = blk & 1;
    f32x16 acc = zero16();
    if (prod == 0) {
      rw_addT(MkrT, mb, nb, lane, acc); acc = rw_mm(X1, MbrT, mb, nb, lane, acc); rw_mask_upper(acc, mb, nb, lane, false);
      rw_wrT_g((bf16_t*)(rec + 8192), mb, nb, lane, acc);
    } else if (prod == 1) {
      rw_addT(Rt, mb, nb, lane, acc); acc = rw_mm(X2, MbrT, mb, nb, lane, acc);
      rw_wrT_g((bf16_t*)(rec), mb, nb, lane, acc);
    } else if (prod == 2) {
      acc = rw_mm(X2, Bj, mb, nb, lane, acc);
      const int col = nb * 32 + (lane & 31), h = lane >> 5; const float gc = gC[col];
#pragma unroll
      for (int i = 0; i < 16; ++i) { if (mb * 32 + crow(i, h) == col) acc[i] += 1.f; acc[i] *= gc; }
      rw_wrT_g((bf16_t*)(rec + 16384), mb, nb, lane, acc);
    } else {
      rw_addT(Kj, mb, nb, lane, acc); acc = rw_mm(X1, Bj, mb, nb, lane, acc);
      const float gc = gC[nb * 32 + (lane & 31)];
#pragma unroll
      for (int i = 0; i < 16; ++i) acc[i] *= gc;
      rw_wrT(QpT, mb, nb, lane, acc);
    }
  }
  __syncthreads();
  if (wid < 4) {
    const int mb = (wid >> 1) & 1, nb = wid & 1, r = lane & 31, h = lane >> 5;
    f32x16 acc = zero16();
    acc = rw_mm(QpT, Vi, mb, nb, lane, acc);
    float* dq = (float*)(rec + 24576);
#pragma unroll
    for (int g = 0; g < 4; ++g)
      *(float4*)(dq + (nb * 32 + r) * 64 + mb * 32 + 8 * g + 4 * h) = make_float4(acc[4 * g], acc[4 * g + 1], acc[4 * g + 2], acc[4 * g + 3]);
  }
}

constexpr int RW2_ITEMS = NSEQ_;
constexpr int RW2_DQLD = 68;
constexpr int RW2_STAGE = RW_MB + 64 * RW2_DQLD * 4;
constexpr int RW2_GRP = 2;
static_assert(NCH_ % RW2_GRP == 0, "chunk groups");
DI void rw_state_item(const Params& p, int s, char* smem) {
  const int tid = opaque_tid(), lane = tid & 63, wid = tid >> 6, r = lane & 31, h = lane >> 5;
  f32x16 S0 = zero16(), S1 = zero16();
  u32x4 rp[RW2_GRP], rd0[RW2_GRP], rd1[RW2_GRP];
  const int prow = tid >> 3, pcol = (tid & 7) * 8;
#define RW2_LOAD(g_) { _Pragma("unroll") for (int u = 0; u < RW2_GRP; ++u) { const char* rec_ = rw_rec(p, s, (g_) * RW2_GRP + u); \
    rp[u] = *(const u32x4*)(rec_ + 16384 + (prow * 64 + pcol) * 2); \
    rd0[u] = *(const u32x4*)(rec_ + 24576 + (prow * 64 + pcol) * 4); rd1[u] = *(const u32x4*)(rec_ + 24576 + (prow * 64 + pcol + 4) * 4); } }
#define RW2_STORE(buf_) { _Pragma("unroll") for (int u = 0; u < RW2_GRP; ++u) { char* d_ = smem + ((buf_) * RW2_GRP + u) * RW2_STAGE; \
    *(u32x4*)(d_ + (prow * RW_LD + pcol) * 2) = rp[u]; \
    *(u32x4*)(d_ + RW_MB + (prow * RW2_DQLD + pcol) * 4) = rd0[u]; *(u32x4*)(d_ + RW_MB + (prow * RW2_DQLD + pcol + 4) * 4) = rd1[u]; } }
  __syncthreads();
  RW2_LOAD(0); RW2_STORE(0);
  __syncthreads();
  constexpr int NG = NCH_ / RW2_GRP;
  for (int g = 0; g < NG; ++g) {
    { const int gn = g + 1 < NG ? g + 1 : g; RW2_LOAD(gn); }
    sched_fence();
    if (wid < 2) {
#pragma unroll
      for (int u = 0; u < RW2_GRP; ++u) {
        const int c = g * RW2_GRP + u;
        const char* PT = smem + ((g & 1) * RW2_GRP + u) * RW2_STAGE;
        const float* DQ = (const float*)(PT + RW_MB);
        const int i = wid * 32 + r;
        bf16_t* sd = (bf16_t*)(rw_rec(p, s, c) + 16384);
#pragma unroll
        for (int q = 0; q < 4; ++q) {
          uint2 o0, o1;
          o0.x = pack2bf(S0[4 * q], S0[4 * q + 1]); o0.y = pack2bf(S0[4 * q + 2], S0[4 * q + 3]);
          o1.x = pack2bf(S1[4 * q], S1[4 * q + 1]); o1.y = pack2bf(S1[4 * q + 2], S1[4 * q + 3]);
          *(uint2*)(sd + i * 64 + 8 * q + 4 * h) = o0; *(uint2*)(sd + i * 64 + 32 + 8 * q + 4 * h) = o1;
        }
        bf16x8 bfr[2][2];
#pragma unroll
        for (int s2 = 0; s2 < 2; ++s2) {
          const u32x4 u0 = {pack2bf(S0[8 * s2], S0[8 * s2 + 1]), pack2bf(S0[8 * s2 + 2], S0[8 * s2 + 3]), pack2bf(S0[8 * s2 + 4], S0[8 * s2 + 5]), pack2bf(S0[8 * s2 + 6], S0[8 * s2 + 7])};
          const u32x4 u1 = {pack2bf(S1[8 * s2], S1[8 * s2 + 1]), pack2bf(S1[8 * s2 + 2], S1[8 * s2 + 3]), pack2bf(S1[8 * s2 + 4], S1[8 * s2 + 5]), pack2bf(S1[8 * s2 + 6], S1[8 * s2 + 7])};
          __builtin_memcpy(&bfr[0][s2], &u0, 16); __builtin_memcpy(&bfr[1][s2], &u1, 16);
        }
        f32x16 n0, n1;
#pragma unroll
        for (int q = 0; q < 4; ++q) {
          const float4 a = *(const float4*)(DQ + i * RW2_DQLD + 8 * q + 4 * h), bq = *(const float4*)(DQ + i * RW2_DQLD + 32 + 8 * q + 4 * h);
          n0[4 * q] = a.x; n0[4 * q + 1] = a.y; n0[4 * q + 2] = a.z; n0[4 * q + 3] = a.w;
          n1[4 * q] = bq.x; n1[4 * q + 1] = bq.y; n1[4 * q + 2] = bq.z; n1[4 * q + 3] = bq.w;
        }
#pragma unroll
        for (int jb2 = 0; jb2 < 2; ++jb2)
#pragma unroll
          for (int s2 = 0; s2 < 2; ++s2) {
            const char* a0 = PT + ((0 * 32 + r) * RW_LD + jb2 * 32 + 16 * s2 + 4 * h) * 2;
            const char* a1 = PT + ((1 * 32 + r) * RW_LD + jb2 * 32 + 16 * s2 + 4 * h) * 2;
            const uint2 l0 = *(const uint2*)a0, h0 = *(const uint2*)(a0 + 16), l1 = *(const uint2*)a1, h1 = *(const uint2*)(a1 + 16);
            const u32x4 u0 = {l0.x, l0.y, h0.x, h0.y}, u1 = {l1.x, l1.y, h1.x, h1.y};
            bf16x8 af0, af1; __builtin_memcpy(&af0, &u0, 16); __builtin_memcpy(&af1, &u1, 16);
            n0 = mfma32(af0, bfr[jb2][s2], n0);
            n1 = mfma32(af1, bfr[jb2][s2], n1);
          }
        S0 = n0; S1 = n1;
      }
    }
    sched_fence();
    RW2_STORE((g + 1) & 1);
    __syncthreads();
  }
}

DI void rw_out_item(const Params& p, int it, char* smem) {
  const int s = it / NCH_, c = it % NCH_, dir = s >> 3, b = (s >> 2) & 1, hd = s & 3;
  const int tid = opaque_tid(), lane = tid & 63, wid = tid >> 6;
  const bf16_t* rb = (const bf16_t*)(p.ws + OFF_REGION + R_RB16);
  const size_t AS = (size_t)NT_ * 256;
  float* ys = (float*)(p.ws + OFF_REGION + R_YS) + (size_t)dir * NT_ * 256;
  char* const Sm = smem; char* const RyT = smem + RW_MB; char* const MyT = smem + 2 * RW_MB; char* const Vi = smem + 3 * RW_MB;
  const char* rec = rw_rec(p, s, c);
  __syncthreads();
  {
    const int row = tid >> 3, col = (tid & 7) * 8;
    *(uint4*)(Sm + (row * RW_LD + col) * 2) = *(const uint4*)(rec + 16384 + (row * 64 + col) * 2);
    *(uint4*)(RyT + (row * RW_LD + col) * 2) = *(const uint4*)(rec + (row * 64 + col) * 2);
    *(uint4*)(MyT + (row * RW_LD + col) * 2) = *(const uint4*)(rec + 8192 + (row * 64 + col) * 2);
    const int n = seq_tok(dir, b, c * 64 + row);
    const uint4 uv = *(const uint4*)(rb + 1 * AS + (size_t)n * 256 + hd * 64 + col);
    const unsigned av[4] = {uv.x, uv.y, uv.z, uv.w};
#pragma unroll
    for (int q = 0; q < 4; ++q) {
      *(bf16_t*)(Vi + ((col + 2 * q) * RW_LD + row) * 2) = (bf16_t)(av[q] & 0xffff);
      *(bf16_t*)(Vi + ((col + 2 * q + 1) * RW_LD + row) * 2) = (bf16_t)(av[q] >> 16);
    }
  }
  __syncthreads();
  if (wid < 4) {
    const int mb = (wid >> 1) & 1, nb = wid & 1, r = lane & 31, h = lane >> 5;
    f32x16 acc = zero16();
    acc = rw_mm(Sm, RyT, mb, nb, lane, acc);
    acc = rw_mm(Vi, MyT, mb, nb, lane, acc);
    const int n = seq_tok(dir, b, c * 64 + nb * 32 + r);
#pragma unroll
    for (int g = 0; g < 4; ++g)
      *(float4*)(ys + (size_t)n * 256 + hd * 64 + mb * 32 + 8 * g + 4 * h) = make_float4(acc[4 * g], acc[4 * g + 1], acc[4 * g + 2], acc[4 * g + 3]);
  }
}
constexpr int ATT_KLD = 104, ATT_VLD = 68;
constexpr int ATT_KB = 64 * ATT_KLD * 2, ATT_VB = 64 * ATT_VLD * 2, ATT_STAGE = ATT_KB + ATT_VB;
DI float fexp2(float x) {
#ifdef EMU
  return exp2f(x);
#else
  return __builtin_amdgcn_exp2f(x);
#endif
}
#ifdef ABL_NOPV
#define ABL_PV_BEGIN if (t > 100000) {
#define ABL_PV_END }
#else
#define ABL_PV_BEGIN
#define ABL_PV_END
#endif
#define ABL_LOADS2(s_, tk, tv) ATT_LOADK(s_, tk); ATT_LOADV(s_, tv);
#ifdef ABL_NOEXP
#define ABL_EXP(x) (x)
#else
#define ABL_EXP(x) fexp2(x)
#endif
constexpr int ATT_LDS = 2 * ATT_KB + 2 * ATT_VB;
DI void attn_item(const Params& p, int b, int h, int qt, bool isctx, char* smem) {
  const int tid = opaque_tid(), lane = tid & 63, wid = tid >> 6, r = lane & 31, h2 = lane >> 5;
  const bf16_t* qb = (const bf16_t*)(p.osc + O_QB);
  const bf16_t* kbase = (const bf16_t*)(p.ws + OFF_REGION + R_KB) + (size_t)(b * 8 + h) * KT_ * 96;
  const bf16_t* vbase = (const bf16_t*)(p.ws + OFF_REGION + R_VT) + (size_t)(b * 8 + h) * 64 * KT_;
  bf16_t* att = (bf16_t*)(p.ws + OFF_REGION + R_ATT);
  const int nq0 = isctx ? NX_ + b * CL_ + qt * 256 : b * T_ + qt * 256;
  const int nkt = (isctx ? CL_ : KT_) / 64;
  const int nq = nq0 + wid * 32 + r;
  bf16x8 qf[6];
#pragma unroll
  for (int ks = 0; ks < 6; ++ks) qf[ks] = *(const bf16x8*)(qb + (size_t)nq * 768 + h * 96 + ks * 16 + h2 * 8);
  f32x16 oacc[2] = {zero16(), zero16()};
  float m = -1e30f, lsum = 0.f;
  const float sc = 0.10206207261596577f * 1.4426950408889634f;
  char* const Kst = smem;
  char* const Vst = smem + 2 * ATT_KB;
  const int kc1 = tid + 512, vd = tid >> 3, vc = tid & 7;
  const int ko0 = ((tid / 12) * ATT_KLD + (tid % 12) * 8) * 2, ko1 = ((kc1 / 12) * ATT_KLD + (kc1 % 12) * 8) * 2;
  const int vo = (vd * ATT_VLD + vc * 8) * 2;
  u32x4 ak0, ak1 = {0u, 0u, 0u, 0u}, av, bk0, bk1 = {0u, 0u, 0u, 0u}, bv;
#define ATT_LOADK(s_, kt_) { const bf16_t* ksrc_ = kbase + (size_t)(kt_) * 64 * 96; s_##k0 = *(const u32x4*)(ksrc_ + tid * 8); if (kc1 < 768) s_##k1 = *(const u32x4*)(ksrc_ + kc1 * 8); }
#define ATT_LOADV(s_, kt_) { s_##v = *(const u32x4*)(vbase + (size_t)vd * KT_ + (kt_) * 64 + vc * 8); }
#define ATT_STOREK(s_, st_) { char* d_ = Kst + (st_) * ATT_KB; *(u32x4*)(d_ + ko0) = s_##k0; if (kc1 < 768) *(u32x4*)(d_ + ko1) = s_##k1; }
#define ATT_STOREV(s_, st_) { char* d_ = Vst + (st_) * ATT_VB; *(uint2*)(d_ + vo) = make_uint2(s_##v[0], s_##v[1]); *(uint2*)(d_ + vo + 8) = make_uint2(s_##v[2], s_##v[3]); }
#define ATT_QK(dst_, st_) { const char* Ks_ = Kst + (st_) * ATT_KB; dst_[0] = zero16(); dst_[1] = zero16(); \
    _Pragma("unroll") for (int ks = 0; ks < 6; ++ks) _Pragma("unroll") for (int kb = 0; kb < 2; ++kb) { \
      const bf16x8 kf_ = *(const bf16x8*)(Ks_ + ((kb * 32 + r) * ATT_KLD + ks * 16 + h2 * 8) * 2); dst_[kb] = mfma32(kf_, qf[ks], dst_[kb]); } }
  __syncthreads();
  ATT_LOADK(a, 0); ATT_LOADV(a, 0); ATT_STOREK(a, 0); ATT_STOREV(a, 0);
  ATT_LOADK(a, 1); ATT_STOREK(a, 1);
  ATT_LOADK(a, (2 < nkt ? 2 : nkt - 1)); ATT_LOADV(a, 1);
  __syncthreads();
  f32x16 sA[2], sB[2];
  ATT_QK(sA, 0);
  __syncthreads();
#define ATT_SMPV(cur_, t) { \
    float mx = -1e30f; \
    _Pragma("unroll") for (int kb = 0; kb < 2; ++kb) _Pragma("unroll") for (int i = 0; i < 16; ++i) mx = fmaxf(mx, cur_[kb][i]); \
    mx = fmaxf(mx, __shfl_xor(mx, 32)); \
    const float mn = fmaxf(m, mx * sc); \
    if (__ballot(mn > m) != 0ull) { \
      const float alpha = fexp2(m - mn); \
      _Pragma("unroll") for (int db = 0; db < 2; ++db) _Pragma("unroll") for (int i = 0; i < 16; ++i) oacc[db][i] *= alpha; \
      lsum *= alpha; m = mn; } \
    _Pragma("unroll") for (int kb = 0; kb < 2; ++kb) _Pragma("unroll") for (int i = 0; i < 16; ++i) cur_[kb][i] = ABL_EXP(cur_[kb][i] * sc - m); \
    { float ps0 = 0.f, ps1 = 0.f; _Pragma("unroll") for (int i = 0; i < 16; ++i) { ps0 += cur_[0][i]; ps1 += cur_[1][i]; } lsum += ps0 + ps1; } \
    const char* Vs = Vst + ((t) & 1) * ATT_VB; \
    _Pragma("unroll") for (int kb = 0; kb < 2; ++kb) _Pragma("unroll") for (int s2 = 0; s2 < 2; ++s2) { \
      bf16x8 pf; { const u32x4 u = {pack2bf(cur_[kb][8 * s2 + 0], cur_[kb][8 * s2 + 1]), pack2bf(cur_[kb][8 * s2 + 2], cur_[kb][8 * s2 + 3]), \
                                    pack2bf(cur_[kb][8 * s2 + 4], cur_[kb][8 * s2 + 5]), pack2bf(cur_[kb][8 * s2 + 6], cur_[kb][8 * s2 + 7])}; __builtin_memcpy(&pf, &u, 16); } \
      ABL_PV_BEGIN \
      _Pragma("unroll") for (int db = 0; db < 2; ++db) { \
        const char* vrow = Vs + ((db * 32 + r) * ATT_VLD + kb * 32 + 16 * s2 + 4 * h2) * 2; \
        const uint2 lo = *(const uint2*)(vrow), hi = *(const uint2*)(vrow + 16); \
        const u32x4 u = {lo.x, lo.y, hi.x, hi.y}; bf16x8 vf; __builtin_memcpy(&vf, &u, 16); \
        oacc[db] = mfma32(vf, pf, oacc[db]); } ABL_PV_END } }
#define ATT_STEP(cur_, nxt_, t_, w_, l_) { \
    const int t = (t_); \
    const int tk = t + 3 < nkt ? t + 3 : nkt - 1, tv = t + 2 < nkt ? t + 2 : nkt - 1; \
    ABL_LOADS2(l_, tk, tv) \
    ATT_STOREK(w_, t & 1); ATT_STOREV(w_, (t + 1) & 1);        \
    sched_fence(); \
    if (first_half) { ATT_QK(nxt_, (t + 1) & 1); sched_fence(); ATT_SMPV(cur_, t); } \
    else { ATT_SMPV(cur_, t); sched_fence(); ATT_QK(nxt_, (t + 1) & 1); } \
    sched_fence(); \
    __syncthreads(); }
  const bool first_half = rfl(wid) < 4;
  for (int t0 = 0; t0 < nkt; t0 += 2) {
    ATT_STEP(sA, sB, t0, a, b);
    ATT_STEP(sB, sA, t0 + 1, b, a);
  }
  lsum += __shfl_xor(lsum, 32);
  const float inv = 1.f / lsum;
#pragma unroll
  for (int db = 0; db < 2; ++db)
#pragma unroll
    for (int g = 0; g < 4; ++g) {
      uint2 o;
      o.x = pack2bf(oacc[db][g * 4 + 0] * inv, oacc[db][g * 4 + 1] * inv);
      o.y = pack2bf(oacc[db][g * 4 + 2] * inv, oacc[db][g * 4 + 3] * inv);
      *(uint2*)(att + (size_t)nq * 512 + h * 64 + db * 32 + 8 * g + 4 * h2) = o;
    }
}

DI constexpr int att_items(int l) { return NB_ * 8 * (T_ / 256) + (l == 0 ? NB_ * 8 * (CL_ / 256) : 0); }
DI void spin_until_ge(int* ctr, int target) {
#ifdef EMU
  while (__atomic_load_n(ctr, __ATOMIC_SEQ_CST) < target) emu::yield();
#else
  while (__hip_atomic_load(ctr, __ATOMIC_RELAXED, __HIP_MEMORY_SCOPE_AGENT) < target) __builtin_amdgcn_s_sleep(8);
#endif
}
constexpr int P3B_ITEMS = RW1_ITEMS + ML2_ITEMS + MLA_Q_TILES + MLA_KV_TILES;
DI void phase3b(const Params& p, int l, char* smem, int* ctr) {
  for (int it = vblock(); it < P3B_ITEMS; it += gridDim.x) {
    int i = it;
    if (i < RW1_ITEMS) { TSB(p, 58); rw_chunk_item(p, i, smem); TSB(p, 59); continue; }
    i -= RW1_ITEMS;
    if (i < ML2_ITEMS) { mlstm_scan_item(p, i); continue; }
    i -= ML2_ITEMS;
    TSB(p, 60);
    if (i < MLA_Q_TILES) mla_q_item(p, l, i, smem); else mla_kv_item(p, l, i - MLA_Q_TILES, smem);
    TSB(p, 61);
  }
}

DI void phase4(const Params& p, int l, char* smem, int* ctr) {
  const int G = gridDim.x, nsb = G >= 2 * RW2_ITEMS ? RW2_ITEMS : (G > 1 ? G / 2 : 1);
  if ((int)blockIdx.x < nsb) {
    TSB(p, 50);
    for (int s = blockIdx.x; s < RW2_ITEMS; s += nsb) rw_state_item(p, s, smem);
#ifndef EMU
    asm volatile("s_waitcnt vmcnt(0)" ::: "memory");
#endif
    __syncthreads();
    if (opaque_tid() == 0) { __threadfence(); atomicAdd(ctr + 2, (RW2_ITEMS - (int)blockIdx.x + nsb - 1) / nsb); }
    TSB(p, 51);
  }
  const int QT = T_ / 256, CQ = (l == 0 ? (NB_ * 8 * (CL_ / 256)) / 8 : 0), R3 = RW1_ITEMS / 8;
  const int per = 2 * QT + CQ + R3;
  int* sitem = (int*)(smem + 160 * 1024 - 16);
  bool r2ok = false;
  const int x0 = xcc_id();
  for (;;) {
    __syncthreads();
    if (opaque_tid() == 0) {
      int item = -1;
      for (int k = 0; k < 8 && item < 0; ++k) {
        const int x = (x0 + k) & 7;
        if (ld_relaxed(ctr + 8 + x) >= per) continue;
        const int li = atomicAdd(ctr + 8 + x, 1);
        if (li < per) item = x * per + li;
      }
      *sitem = item;
    }
    __syncthreads();
    const int item = *sitem;
    if (item < 0) break;
    const int x = item / per; int li = item % per;
    if (li < 2 * QT) { const int bh = 2 * x + li / QT, qt = li % QT; TSB(p, 54); attn_item(p, bh >> 3, bh & 7, qt, false, smem); TSB(p, 55); continue; }
    li -= 2 * QT;
    if (li < CQ) { const int ci = x * CQ + li, qt = ci % (CL_ / 256), bh = ci / (CL_ / 256); attn_item(p, bh >> 3, bh & 7, qt, true, smem); continue; }
    li -= CQ;
    if (!r2ok) {
      if (opaque_tid() == 0) { spin_until_ge(ctr + 2, RW2_ITEMS); __threadfence(); }
      __syncthreads();
      r2ok = true;
    }
    rw_out_item(p, x * R3 + li, smem);
  }
}
constexpr int ML3_CC = CL_ / 64, ML3_XC = T_ / 64;
DI constexpr int ml3_items(bool with_ctx) { return NB_ * 4 * (ML3_XC + (with_ctx ? ML3_CC : 0)); }
template <int KS> DI f32x16 ml_mm(const char* A, const char* Bt, int mb, int nb, int lane, f32x16 acc) {
  const int r = lane & 31, h = lane >> 5;
#pragma unroll
  for (int ks = 0; ks < KS; ++ks) {
    const bf16x8 a = *(const bf16x8*)(A + ((mb * 32 + r) * RW_LD + ks * 16 + h * 8) * 2);
    const bf16x8 b = *(const bf16x8*)(Bt + ((nb * 32 + r) * RW_LD + ks * 16 + h * 8) * 2);
    acc = mfma32(a, b, acc);
  }
  return acc;
}
DI float wave_incl_scan_max(float v, int lane) {
  for (int d = 1; d < 64; d <<= 1) { const float o = __shfl_up(v, d); if (lane >= d) v = fmaxf(v, o); }
  return v;
}
DI void mlstm_out_item(const Params& p, int l, int it, bool with_ctx, char* smem) {
  const int per = ML3_XC + (with_ctx ? ML3_CC : 0);
  const int bh = it / per, b = bh >> 2, hd = bh & 3;
  int tc = it % per; if (!with_ctx) tc += ML3_CC;
  const bool isctx = tc < ML3_CC;
  const int ntok0 = isctx ? NX_ + b * CL_ + tc * 64 : b * T_ + (tc - ML3_CC) * 64;
  char* const Qm = smem;
  char* const Km = smem + 1 * RW_MB;
  char* const Qp = smem + 2 * RW_MB;
  char* const Vi = smem + 3 * RW_MB;
  char* const Pp = smem + 4 * RW_MB;
  char* const Cm = smem + 5 * RW_MB;
  float* const hs = (float*)(smem + 6 * RW_MB);
  float* const ga = hs + 64 * 64;
  float* const denp = ga + 5 * 64;
  float* const nsv = denp + 128;
  const float* zrec = (const float*)(p.ws + OFF_REGION + R_ZREC);
  const int tid = opaque_tid(), lane = tid & 63, wid = tid >> 6;
  __syncthreads();
  for (int idx = tid; idx < 64 * 64; idx += NTHR) hs[idx] = 0.f;
#pragma unroll 1
  for (int dir = 0; dir < 2; ++dir) {
    const int c = dir == 0 ? tc : (isctx ? ML3_CC - 1 - tc : ML3_CC + (ML3_XC - 1 - (tc - ML3_CC)));
    const int s = dir * 8 + b * 4 + hd;
    const float* st = (const float*)(p.ws + OFF_REGION + R_MLST) + ((size_t)s * NCH_ + c) * ML_ST;
    const float m_start = st[2082];
    __syncthreads();
    {
      const int j = tid >> 3, pt = tid & 7;
      const int n = ntok0 + (dir ? 63 - j : j);
      const float* zr = zrec + (size_t)n * ZREC_W;
      const float4 q4 = *(const float4*)(zr + ZR_MLQ + hd * 32 + pt * 4), k4 = *(const float4*)(zr + ZR_MLK + hd * 32 + pt * 4);
      const float4 c4 = *(const float4*)(st + j * 32 + pt * 4);
      const float4 va = *(const float4*)(zr + ZR_MLV + hd * 64 + pt * 8), vb = *(const float4*)(zr + ZR_MLV + hd * 64 + pt * 8 + 4);
      const float qs = 0.17677669529663687f;
      const float q0 = q4.x * qs, q1 = q4.y * qs, q2 = q4.z * qs, q3 = q4.w * qs;
      *(uint2*)(Qm + (j * RW_LD + pt * 4) * 2) = make_uint2(pack2bf(q0, q1), pack2bf(q2, q3));
      *(uint2*)(Km + (j * RW_LD + pt * 4) * 2) = make_uint2(pack2bf(k4.x, k4.y), pack2bf(k4.z, k4.w));
      *(uint2*)(Cm + (j * RW_LD + pt * 4) * 2) = make_uint2(pack2bf(c4.x, c4.y), pack2bf(c4.z, c4.w));
      const float vv[8] = {va.x, va.y, va.z, va.w, vb.x, vb.y, vb.z, vb.w};
#pragma unroll
      for (int u = 0; u < 8; ++u) *(bf16_t*)(Vi + ((pt * 8 + u) * RW_LD + j) * 2) = f2bf(vv[u]);
      if (tid < 32) nsv[tid] = st[2048 + tid];
      const float4 n4 = *(const float4*)(st + 2048 + pt * 4);
      float nq = n4.x * q0 + n4.y * q1 + n4.z * q2 + n4.w * q3;
      nq += __shfl_xor(nq, 1); nq += __shfl_xor(nq, 2); nq += __shfl_xor(nq, 4);
      if (pt == 0) ga[4 * 64 + j] = nq;
    }
    if (wid == 0) {
      const int n = ntok0 + (dir ? 63 - lane : lane);
      const float fp = zrec[(size_t)n * ZREC_W + ZR_MLF + dir * 4 + hd] + p.ml_b_f[(l * 2 + dir) * 4 + hd];
      const float ipre = zrec[(size_t)n * ZREC_W + ZR_MLI + dir * 4 + hd] + p.ml_b_i[(l * 2 + dir) * 4 + hd];
      const float bj = wave_incl_scan(logsigmoidf_(fp), lane);
      const float g = ipre - bj;
      const float pm = wave_incl_scan_max(g, lane);
      const float c0 = wave_max(g);
      const float mj = fmaxf(bj + m_start, bj + pm);
      ga[0 * 64 + lane] = fexp(g - c0);
      ga[1 * 64 + lane] = fexp(fminf(bj + c0 - mj, 80.f));
      ga[2 * 64 + lane] = fexp(bj + m_start - mj);
      ga[3 * 64 + lane] = fexp(fminf(-mj, 80.f));
    }
    __syncthreads();
    if (wid < 4) {
      const int mb = wid >> 1, nb = wid & 1, r = lane & 31, h = lane >> 5;
      f32x16 acc = zero16();
      if (!(mb == 1 && nb == 0)) acc = ml_mm<2>(Km, Qm, mb, nb, lane, acc);
      rw_mask_upper(acc, mb, nb, lane, false);
      const float al = ga[1 * 64 + nb * 32 + r];
      float csum = 0.f;
#pragma unroll
      for (int i = 0; i < 16; ++i) { acc[i] *= ga[0 * 64 + mb * 32 + crow(i, h)] * al; csum += acc[i]; }
      csum += __shfl_xor(csum, 32);
      if (h == 0) denp[mb * 64 + nb * 32 + r] = csum;
      rw_wrT(Pp, mb, nb, lane, acc);
    } else {
      const int t2 = tid - 256, j = t2 >> 2, d8 = (t2 & 3) * 8;
      const float in = ga[2 * 64 + j];
      const uint4 u = *(const uint4*)(Qm + (j * RW_LD + d8) * 2);
      const unsigned w[4] = {u.x, u.y, u.z, u.w};
      unsigned o[4];
#pragma unroll
      for (int q = 0; q < 4; ++q) o[q] = pack2bf(bf2f((bf16_t)(w[q] & 0xffff)) * in, bf2f((bf16_t)(w[q] >> 16)) * in);
      *(uint4*)(Qp + (j * RW_LD + d8) * 2) = make_uint4(o[0], o[1], o[2], o[3]);
    }
    __syncthreads();
    if (wid < 4) {
      const int mb = wid >> 1, nb = wid & 1, r = lane & 31, h = lane >> 5;
      f32x16 acc = zero16();
      acc = ml_mm<4>(Vi, Pp, mb, nb, lane, acc);
      acc = ml_mm<2>(Cm, Qp, mb, nb, lane, acc);
      const int j = nb * 32 + r;
      const float den = denp[j] + denp[64 + j] + ga[2 * 64 + j] * ga[4 * 64 + j];
      const float rden = frcp(fmaxf(fabsf(den), ga[3 * 64 + j]));
      float* hrow = hs + (dir ? 63 - j : j) * 64 + mb * 32 + 4 * h;
#pragma unroll
      for (int g4 = 0; g4 < 4; ++g4) {
        float4 o = *(float4*)(hrow + 8 * g4);
        o.x += acc[4 * g4] * rden; o.y += acc[4 * g4 + 1] * rden; o.z += acc[4 * g4 + 2] * rden; o.w += acc[4 * g4 + 3] * rden;
        *(float4*)(hrow + 8 * g4) = o;
      }
    }
  }
  __syncthreads();
  const int tk = tid >> 3, v0 = (tid & 7) * 8, n = ntok0 + tk;
  float ss = 0.f; float hv[8];
#pragma unroll
  for (int u = 0; u < 8; ++u) { hv[u] = hs[tk * 64 + v0 + u]; ss += hv[u] * hv[u]; }
  ss += __shfl_xor(ss, 1); ss += __shfl_xor(ss, 2); ss += __shfl_xor(ss, 4);
  const float rs = frsq(ss * (1.f / 64.f) + 1e-6f);
  unsigned o[4];
#pragma unroll
  for (int u = 0; u < 8; u += 2) {
    const int cc = hd * 64 + v0 + u;
    const float a = hv[u] * rs * p.ml_g_norm[l * 256 + cc] * sigmoidf_(zrec[(size_t)n * ZREC_W + ZR_MLO + cc]);
    const float bq = hv[u + 1] * rs * p.ml_g_norm[l * 256 + cc + 1] * sigmoidf_(zrec[(size_t)n * ZREC_W + ZR_MLO + cc + 1]);
    o[u >> 1] = pack2bf(a, bq);
  }
  bf16_t* mlo = (bf16_t*)(p.ws + OFF_REGION + R_MLO);
  *(uint4*)(mlo + (size_t)n * 256 + hd * 64 + v0) = make_uint4(o[0], o[1], o[2], o[3]);
}

DI constexpr int rwo_items(bool with_ctx) { return (with_ctx ? NT_ : NX_) / 16; }
DI void rwkv_out_item(const Params& p, int l, int it, char* smem) {
  float* sg = (float*)smem;
  const float* zrec = (const float*)(p.ws + OFF_REGION + R_ZREC);
  const bf16_t* rb = (const bf16_t*)(p.ws + OFF_REGION + R_RB16);
  const float* bso = (const float*)(p.ws + OFF_REGION + R_BS);
  const float* ys = (const float*)(p.ws + OFF_REGION + R_YS);
  bf16_t* rwo = (bf16_t*)(p.ws + OFF_REGION + R_RWO);
  const float* mu = p.rw_mu + (size_t)l * 1152;
  const int tid = opaque_tid(), n0 = it * 16;
  __syncthreads();
  {
    const int tt = tid >> 5, k4 = (tid & 31) * 4, n = n0 + tt, t = tok_t(n), c = 1024 + k4;
    const int len = n < NX_ ? T_ : CL_;
    const float* zr = zrec + (size_t)n * ZREC_W + ZR_RW + c;
    const float4 z = *(const float4*)zr;
    const float4 zp = t > 0 ? *(const float4*)(zr - ZREC_W) : make_float4(0.f, 0.f, 0.f, 0.f);
    const float4 zn = t < len - 1 ? *(const float4*)(zr + ZREC_W) : make_float4(0.f, 0.f, 0.f, 0.f);
    const float4 m4 = *(const float4*)(mu + c);
    sg[(k4 + 0) * 16 + tt] = sigmoidf_(z.x + (0.5f * (zp.x + zn.x) - z.x) * m4.x);
    sg[(k4 + 1) * 16 + tt] = sigmoidf_(z.y + (0.5f * (zp.y + zn.y) - z.y) * m4.y);
    sg[(k4 + 2) * 16 + tt] = sigmoidf_(z.z + (0.5f * (zp.z + zn.z) - z.z) * m4.z);
    sg[(k4 + 3) * 16 + tt] = sigmoidf_(z.w + (0.5f * (zp.w + zn.w) - z.w) * m4.w);
  }
  __syncthreads();
  const int col = tid & 255, half = tid >> 8;
  float acc[8];
#pragma unroll
  for (int i = 0; i < 8; ++i) acc[i] = 0.f;
  const float* g2 = p.rw_g2 + (size_t)l * 128 * 256 + col;
#pragma unroll 1
  for (int kh = 0; kh < 8; ++kh) {
    float gr[16];
#pragma unroll
    for (int k = 0; k < 16; ++k) gr[k] = g2[(kh * 16 + k) * 256];
#pragma unroll
    for (int k = 0; k < 16; ++k) {
      const float* sk = sg + (kh * 16 + k) * 16 + half * 8;
#pragma unroll
      for (int i = 0; i < 8; ++i) acc[i] += sk[i] * gr[k];
      if ((k & 3) == 3) sched_fence();
    }
  }
  const size_t AS = (size_t)NT_ * 256;
  const float lw = p.rw_lnx_w[(size_t)l * 256 + col], lb = p.rw_lnx_b[(size_t)l * 256 + col];
  float yv[8], vv[8], bsv[8];
#pragma unroll
  for (int i = 0; i < 8; ++i) {
    const int n = n0 + half * 8 + i;
    const size_t o = (size_t)n * 256 + col;
    yv[i] = ys[o] + ys[AS + o];
    vv[i] = bf2f(rb[1 * AS + o]);
    bsv[i] = bso[(size_t)n * 4 + (col >> 6)] + bso[((size_t)NT_ + n) * 4 + (col >> 6)];
  }
#pragma unroll
  for (int i = 0; i < 8; ++i) {
    const int n = n0 + half * 8 + i;
    const size_t o = (size_t)n * 256 + col;
    const float y = yv[i];
    const float mean = wave_sum(y) * (1.f / 64.f);
    const float dv = y - mean;
    const float var = wave_sum(dv * dv) * (1.f / 64.f);
    const float yn = dv * (frsq(var + 64e-5f)) * lw + lb;
    rwo[o] = f2bf((yn + bsv[i] * vv[i]) * acc[i]);
  }
}
DI void phase5(const Params& p, int l, bool with_ctx, char* smem) {
  const int n1 = ml3_items(with_ctx), n2 = rwo_items(with_ctx), G = gridDim.x;
  for (int it = blockIdx.x; it < n1; it += G) { TSB(p, 62); mlstm_out_item(p, l, it, with_ctx, smem); TSB(p, 63); }
  for (int it = G - 1 - (int)blockIdx.x; it < n2; it += G) { TSB(p, 64); rwkv_out_item(p, l, it, smem); TSB(p, 65); }
}
typedef Gemm<256, 128, 64, 4, 2> G2;
template <class G> DI void merge_tile(const Params& p, int l, int row0, int col0, char* smem) {
  const bf16_t* H = (const bf16_t*)(p.ws + OFF_H);
  const char* W = p.ws + OFF_WMIX + (size_t)l * WM_SIZE;
  const bf16_t* Wg = (const bf16_t*)(W + WM_GATE);
  const bf16_t* att = (const bf16_t*)(p.ws + OFF_REGION + R_ATT);
  const bf16_t* mlo = (const bf16_t*)(p.ws + OFF_REGION + R_MLO);
  const bf16_t* rwo = (const bf16_t*)(p.ws + OFF_REGION + R_RWO);
  bf16_t* ymix = (bf16_t*)(p.osc + O_YMIX);
  const int tid = opaque_tid();
  __syncthreads();
  unsigned ypk[G::MB][G::NB][8];
  f32x16 acc[G::MB][G::NB];
#pragma unroll 1
  for (int i = 0; i < 3; ++i) {
    unsigned sg[G::MB][G::NB][8];
#pragma unroll
    for (int a = 0; a < G::MB; ++a)
#pragma unroll
      for (int b = 0; b < G::NB; ++b) acc[a][b] = zero16();
    const bf16_t* A0 = H + (size_t)row0 * 1024;
    G::run_lin(acc, A0, 1024, Wg + ((size_t)i * 1024 + col0) * 1024, 1024, 1024, smem);
#pragma unroll
    for (int a = 0; a < G::MB; ++a)
#pragma unroll
      for (int b = 0; b < G::NB; ++b) {
#pragma unroll
        for (int e = 0; e < 8; ++e) sg[a][b][e] = pack2bf(sigmoidf_(acc[a][b][2 * e]), sigmoidf_(acc[a][b][2 * e + 1]));
        acc[a][b] = zero16();
      }
    const bf16_t* br = i == 0 ? att : (i == 1 ? mlo : rwo);
    const int kb = i == 0 ? 512 : 256;
    const bf16_t* Wb = (const bf16_t*)(W + (i == 0 ? WM_BRA : (i == 1 ? WM_BRM : WM_BRR)));
    const bf16_t* B0 = br + (size_t)row0 * kb;
    G::run_lin(acc, B0, kb, Wb + (size_t)col0 * kb, kb, kb, smem);
#pragma unroll
    for (int a = 0; a < G::MB; ++a)
#pragma unroll
      for (int b = 0; b < G::NB; ++b)
#pragma unroll
        for (int e = 0; e < 8; ++e) {
          float y0 = bf2f((bf16_t)(sg[a][b][e] & 0xffff)) * acc[a][b][2 * e], y1 = bf2f((bf16_t)(sg[a][b][e] >> 16)) * acc[a][b][2 * e + 1];
          if (i > 0) { y0 += bf2f((bf16_t)(ypk[a][b][e] & 0xffff)); y1 += bf2f((bf16_t)(ypk[a][b][e] >> 16)); }
          if (i < 2) ypk[a][b][e] = pack2bf(y0, y1); else { acc[a][b][2 * e] = y0; acc[a][b][2 * e + 1] = y1; }
        }
  }
  {
    const int lane = tid & 63, wid = tid >> 6, wm = wid / G::WN, wn = wid % G::WN;
    float* scr = (float*)(smem + wid * WTile<G::NB>::BYTES);
#pragma unroll
    for (int mb = 0; mb < G::MB; ++mb) {
#pragma unroll
      for (int nb = 0; nb < G::NB; ++nb) WTile<G::NB>::put(scr, nb, lane, acc[mb][nb]);
      const int r0 = row0 + wm * G::WTM + mb * 32, c0 = col0 + wn * G::WTN;
      WTile<G::NB>::rows8(scr, lane, [&](int r, int c, const float4& a, const float4& bq) {
        *(uint4*)(ymix + (size_t)(r0 + r) * 1024 + c0 + c) = pack8bf(a, bq); });
    }
  }
}
DI void phase_merge(const Params& p, int l, bool with_ctx, char* smem) {
  const int nbig = (NX_ / 256) * 8, nsmall = with_ctx ? (NC_ / 128) * 8 : 0;
  for (int it = vblock(); it < nbig + nsmall; it += gridDim.x) {
    if (it < nbig) merge_tile<G2>(p, l, (it >> 3) * 256, (it & 7) * 128, smem);
    else { const int i2 = it - nbig; merge_tile<G128>(p, l, NX_ + (i2 >> 3) * 128, (i2 & 7) * 128, smem); }
  }
}

template <class G> DI void wout_tile(const Params& p, int l, int row0, int col0, char* smem) {
  const bf16_t* ymix = (const bf16_t*)(p.osc + O_YMIX);
  const bf16_t* Wo = (const bf16_t*)(p.ws + OFF_WMIX + (size_t)l * WM_SIZE + WM_OUT);
  float* xs = (float*)(p.ws + OFF_XS);
  const float* mod = (const float*)(p.ws + OFF_MOD) + (size_t)l * 3 * 6144;
  const int tid = opaque_tid();
  __syncthreads();
  f32x16 acc[G::MB][G::NB];
#pragma unroll
  for (int a = 0; a < G::MB; ++a)
#pragma unroll
    for (int b = 0; b < G::NB; ++b) acc[a][b] = zero16();
  const bf16_t* A0 = ymix + (size_t)row0 * 1024;
  G::run_lin(acc, A0, 1024, Wo + (size_t)col0 * 1024, 1024, 1024, smem);
  const float* m2 = mod + (size_t)tok_modrow(row0) * 6144 + 2 * 1024;
  const int lane = tid & 63, wid = tid >> 6, wm = wid / G::WN, wn = wid % G::WN;
  float* scr = (float*)(smem + wid * WTile<G::NB>::BYTES);
#pragma unroll
  for (int mb = 0; mb < G::MB; ++mb) {
#pragma unroll
    for (int nb = 0; nb < G::NB; ++nb) WTile<G::NB>::put(scr, nb, lane, acc[mb][nb]);
    const int r0 = row0 + wm * G::WTM + mb * 32, c0 = col0 + wn * G::WTN;
    WTile<G::NB>::rows4(scr, lane, [&](int r, int c, const float4& a) {
      float4* d = (float4*)(xs + (size_t)(r0 + r) * 1024 + c0 + c);
      const float4 g = *(const float4*)(m2 + c0 + c); float4 x = *d;
      x.x += g.x * a.x; x.y += g.y * a.y; x.z += g.z * a.z; x.w += g.w * a.w; *d = x; });
  }
}
DI void phase_wout(const Params& p, int l, bool with_ctx, char* smem) {
  const int nbig = (NX_ / 256) * 8, nsmall = with_ctx ? (NC_ / 128) * 8 : 0;
  for (int it = vblock(); it < nbig + nsmall; it += gridDim.x) {
    if (it < nbig) wout_tile<G2>(p, l, (it >> 3) * 256, (it & 7) * 128, smem);
    else { const int i2 = it - nbig; wout_tile<G128>(p, l, NX_ + (i2 >> 3) * 128, (i2 & 7) * 128, smem); }
  }
  TSB(p, 66);
  cvt_run([&](int i) { return cvt_moe_dec(p, l, i); }, (int)gridDim.x - 1 - vblock(), CVT_MOE_TILES, gridDim.x, smem);
  TSB(p, 67);
}

typedef Gemm<128, 64, 64, 4, 2> GRT;
DI void phase_router(const Params& p, int l, bool with_ctx, char* smem, int* cnt) {
  float* xs = (float*)(p.ws + OFF_XS);
  bf16_t* H = (bf16_t*)(p.ws + OFF_H);
  const float* mod = (const float*)(p.ws + OFF_MOD) + (size_t)l * 3 * 6144;
  const bf16_t* Wr = (const bf16_t*)(p.ws + OFF_WMIX + (size_t)l * WM_SIZE + WM_RT);
  int* eidx = (int*)(p.ws + OFF_REGION + R_EIDX);
  float* ewt = (float*)(p.ws + OFF_REGION + R_EWT);
  int* erank = (int*)(p.ws + OFF_REGION + R_ERANK);
  int* elist = (int*)(p.ws + OFF_REGION + R_ELIST);
  float* sc = (float*)(smem + GRT::SMEM);
  float* bs = sc + 128 * 65;
  float* gs = bs + 128 * 65;
  int* lcnt = (int*)(gs + 128 * 9);
  int* lbase = lcnt + 64;
  const int tid = opaque_tid(), lane = tid & 63, wid = tid >> 6;
  const int ntok = with_ctx ? NT_ : NX_;
  for (int it = blockIdx.x; it < ntok / 128; it += gridDim.x) {
    const int n0 = it * 128;
    __syncthreads();
    TSB(p, 40);
    if (tid < 64) lcnt[tid] = 0;
#pragma unroll 1
    for (int r4 = 0; r4 < 16; r4 += 4) {
      float v[4][16];
#pragma unroll
      for (int u = 0; u < 4; ++u) {
        const int n = n0 + wid * 16 + r4 + u;
#pragma unroll
        for (int j = 0; j < 4; ++j) {
          const float4 t = *(const float4*)(xs + (size_t)n * 1024 + (j * 64 + lane) * 4);
          v[u][j * 4] = t.x; v[u][j * 4 + 1] = t.y; v[u][j * 4 + 2] = t.z; v[u][j * 4 + 3] = t.w;
        }
      }
#pragma unroll
      for (int u = 0; u < 4; ++u) {
        const int n = n0 + wid * 16 + r4 + u;
        const float* m = mod + (size_t)tok_modrow(n) * 6144;
        row_norm_mod(v[u], p.g_ffn + (size_t)l * 1024, m + 3 * 1024, m + 4 * 1024, H + (size_t)n * 1024, lane);
      }
    }
    __syncthreads();
    TSB(p, 41);
    f32x16 acc[1][1]; acc[0][0] = zero16();
    const bf16_t* A0 = H + (size_t)n0 * 1024;
    GRT::run(acc, [&](int r) { return A0 + (size_t)r * 1024; }, Wr, 1024, 1024, smem);
    {
      const int col = GRT::col_of(tid, 0);
      const float rb = p.router_bias[l * 64 + col];
#pragma unroll
      for (int e = 0; e < 16; ++e) {
        const int row = GRT::row_of(tid, 0, e);
        const float s = sigmoidf_(acc[0][0][e]);
        sc[row * 65 + col] = s; bs[row * 65 + col] = s + rb;
      }
    }
    __syncthreads();
    TSB(p, 42);
    int sel[8], lrk[8]; float wsum = 0.f;
    if (tid < 128) {
      float* b = bs + tid * 65; const float* s = sc + tid * 65; float* g = gs + tid * 9;
      for (int gi = 0; gi < 8; ++gi) {
        float m1 = -1e30f, m2 = -1e30f;
        for (int j = 0; j < 8; ++j) { const float x = b[gi * 8 + j]; if (x > m1) { m2 = m1; m1 = x; } else if (x > m2) m2 = x; }
        g[gi] = m1 + m2;
      }
      unsigned gmask = 0;
      for (int c = 0; c < 4; ++c) {
        int best = 0; float bv = -1e30f;
        for (int gi = 0; gi < 8; ++gi) if (!((gmask >> gi) & 1) && g[gi] > bv) { bv = g[gi]; best = gi; }
        gmask |= 1u << best;
      }
      for (int gi = 0; gi < 8; ++gi) if (!((gmask >> gi) & 1)) for (int j = 0; j < 8; ++j) b[gi * 8 + j] = -1e30f;
      wsum = 0.f;
#pragma unroll
      for (int c = 0; c < 8; ++c) {
        int best = 0; float bv = -1e30f;
        for (int e = 0; e < 64; ++e) { const float x = b[e]; if (x > bv) { bv = x; best = e; } }
        b[best] = -3e30f; sel[c] = best; wsum += s[best];
        lrk[c] = atomicAdd(lcnt + best, 1);
      }
    }
    __syncthreads();
    if (tid < 64) { const int c = lcnt[tid]; lbase[tid] = c ? atomicAdd(cnt + tid * 32, c) : 0; }
    __syncthreads();
    if (tid < 128) {
      const int n = n0 + tid;
      const float* s = sc + tid * 65;
      const float inv = 2.5f / (wsum + 1e-20f);
#pragma unroll
      for (int c = 0; c < 8; ++c) {
        const int e = sel[c];
        const int rk = lbase[e] + lrk[c];
        eidx[n * 8 + c] = e; ewt[n * 8 + c] = s[e] * inv; erank[n * 8 + c] = rk;
        elist[(size_t)e * NT_ + rk] = n * 8 + c;
      }
    }
    __syncthreads();
    TSB(p, 43);
  }
}

typedef Gemm<128, 256, 32, 2, 4> GMOE;
constexpr int ACT_LD = 264;
constexpr int MOE_DN_BK = 64, MOE_DN_LD = 72, MOE_DN_STG = 256 * MOE_DN_LD * 2;
constexpr int MOE_ACT_OFF = 2 * MOE_DN_STG;
static_assert(GMOE::SMEM <= MOE_ACT_OFF, "gate/up staging must stay below the act image");
constexpr int MOE_INFO_OFF = MOE_ACT_OFF + 128 * ACT_LD * 2;
static_assert(MOE_INFO_OFF + 128 * 8 + 67 * 4 * 2 <= 160 * 1024 - 32, "moe lds");
DI void moe_down_run(f32x16 (&acc)[GMOE::MB][GMOE::NB], const char* actl, const bf16_t* Bt, char* smem) {
  constexpr int BK = MOE_DN_BK, LDB = MOE_DN_LD, NCH = 4, KS = 4, STG = MOE_DN_STG, nk = 256 / BK;
  const int tid = opaque_tid(), lane = tid & 63, wid = tid >> 6, wm = wid / 4, wn = wid % 4;
  const int kc = (tid & 7) * 8, r0 = tid >> 3;
  const bf16_t* bp0 = Bt + (size_t)r0 * 256 + kc;
  u32x4 s0[NCH], s1[NCH];
#define MD_LOAD(dst_, kt_) { const int kq_ = (kt_) < nk ? (kt_) : nk - 1; _Pragma("unroll") for (int i = 0; i < NCH; ++i) dst_[i] = *(const u32x4*)(bp0 + (size_t)i * 64 * 256 + kq_ * BK); }
#define MD_WRITE1(src_, c_, buf_) { *(u32x4*)(smem + (buf_) * STG + ((r0 + (c_) * 64) * LDB + kc) * 2) = src_[c_]; }
#define MD_STEP(w_, l_, kt_) { \
    MD_LOAD(l_, (kt_) + 2); \
    sched_fence(); \
    const char* Bs = smem + ((kt_) & 1) * STG; \
    _Pragma("unroll") for (int ks = 0; ks < KS; ++ks) { \
      bf16x8 af[GMOE::MB], bfr[GMOE::NB]; \
      _Pragma("unroll") for (int mb = 0; mb < GMOE::MB; ++mb) af[mb] = *(const bf16x8*)(actl + ((wm * 64 + mb * 32 + (lane & 31)) * ACT_LD + (kt_) * BK + ks * 16 + (lane >> 5) * 8) * 2); \
      _Pragma("unroll") for (int nb = 0; nb < GMOE::NB; ++nb) bfr[nb] = *(const bf16x8*)(Bs + ((wn * 64 + nb * 32 + (lane & 31)) * LDB + ks * 16 + (lane >> 5) * 8) * 2); \
      MD_WRITE1(w_, ks, ((kt_) + 1) & 1); \
      _Pragma("unroll") for (int mb = 0; mb < GMOE::MB; ++mb) _Pragma("unroll") for (int nb = 0; nb < GMOE::NB; ++nb) acc[mb][nb] = mfma32(af[mb], bfr[nb], acc[mb][nb]); \
    } \
    sched_fence(); \
    __syncthreads(); }
  MD_LOAD(s0, 0);
#pragma unroll
  for (int c = 0; c < NCH; ++c) MD_WRITE1(s0, c, 0);
  MD_LOAD(s0, 1);
  __syncthreads();
  for (int kt = 0; kt < nk; kt += 2) {
    MD_STEP(s0, s1, kt);
    MD_STEP(s1, s0, kt + 1);
  }
#undef MD_STEP
#undef MD_WRITE1
#undef MD_LOAD
}
DI void phase_moe(const Params& p, int l, bool with_ctx, char* smem, const int* cnt) {
  const bf16_t* H = (const bf16_t*)(p.ws + OFF_H);
  const bf16_t* GU = (const bf16_t*)(p.ws + OFF_REGION + R_WMOE + WE_GU);
  const bf16_t* DN = (const bf16_t*)(p.ws + OFF_REGION + R_WMOE + WE_DN);
  const float* ewt = (const float*)(p.ws + OFF_REGION + R_EWT);
  const int* elist = (const int*)(p.ws + OFF_REGION + R_ELIST);
  bf16_t* ybuf = (bf16_t*)(p.ws + OFF_REGION + R_YBUF);
  char* actl = smem + MOE_ACT_OFF;
  int* rtok = (int*)(smem + MOE_INFO_OFF);
  float* rwt = (float*)(rtok + 128);
  int* pre = (int*)(rwt + 128);
  int* off = pre + 67;
  int tid = threadIdx.x;
  const int ntok = with_ctx ? NT_ : NX_;
  __syncthreads();
  if (tid == 0) {
    int a = 0, o = 0;
    for (int e = 0; e < 65; ++e) { const int c = e < 64 ? cnt[e * 32] : ntok; pre[e] = a; off[e] = o; a += (c + 127) >> 7; o += c; }
    pre[65] = a; off[65] = o;
  }
  __syncthreads();
  const int total = pre[65];
  for (int it = vblock(); it < total; it += gridDim.x) {
    tid = opaque_tid();
    int e0 = 0;
    while (pre[e0 + 1] <= it) ++e0;
    const int e = rfl(e0);
    const int rb = rfl(it - pre[e]);
    const int c = rfl(e < 64 ? cnt[e * 32] : ntok);
    const int obase = rfl(off[e] + rb * 128);
    __syncthreads();
    if (tid < 128) {
      const int slot = rb * 128 + tid;
      int tok = 0; float w = 0.f;
      if (slot < c) {
        if (e < 64) { const int pk = elist[(size_t)e * NT_ + slot]; tok = pk >> 3; w = ewt[pk]; }
        else { tok = slot; w = 1.f; }
      }
      rtok[tid] = tok; rwt[tid] = w;
    }
    __syncthreads();
    const bf16_t* Wgu = GU + (size_t)e * 512 * 1024;
#pragma unroll 1
    for (int hf = 0; hf < 2; ++hf) {
      f32x16 acc[GMOE::MB][GMOE::NB];
#pragma unroll
      for (int a = 0; a < GMOE::MB; ++a)
#pragma unroll
        for (int b = 0; b < GMOE::NB; ++b) acc[a][b] = zero16();
      GMOE::run(acc, [&](int r) { return H + (size_t)rtok[r] * 1024; }, Wgu + (size_t)hf * 256 * 1024, 1024, 1024, smem);
      const int lane = tid & 63, wn = (tid >> 6) % 4, wmr = ((tid >> 6) / 4) * 64 + 4 * (lane >> 5);
      const int j = (hf * 4 + wn) * 32 + (lane & 31);
#pragma unroll
      for (int mb = 0; mb < GMOE::MB; ++mb)
#pragma unroll
        for (int i = 0; i < 16; ++i) {
          const int row = wmr + mb * 32 + (i & 3) + 8 * (i >> 2);
          const float g = acc[mb][0][i], u = acc[mb][1][i];
          *(bf16_t*)(actl + (row * ACT_LD + j) * 2) = f2bf(siluf_(g) * u);
        }
    }
    __syncthreads();
    const bf16_t* Wd = DN + (size_t)e * 1024 * 256;
#pragma unroll 1
    for (int nt = 0; nt < 4; ++nt) {
      f32x16 acc[GMOE::MB][GMOE::NB];
#pragma unroll
      for (int a = 0; a < GMOE::MB; ++a)
#pragma unroll
        for (int b = 0; b < GMOE::NB; ++b) acc[a][b] = zero16();
      moe_down_run(acc, actl, Wd + (size_t)nt * 256 * 256, smem);
      {
        const int lane = tid & 63, wid = tid >> 6, wm = wid / 4, wn = wid % 4;
        float* scr = (float*)(smem + wid * WTile<1>::BYTES);
#pragma unroll
        for (int mb = 0; mb < GMOE::MB; ++mb)
#pragma unroll
          for (int nb = 0; nb < GMOE::NB; ++nb) {
            WTile<1>::put(scr, 0, lane, acc[mb][nb]);
            const int row0 = wm * 64 + mb * 32, col0 = nt * 256 + wn * 64 + nb * 32;
            WTile<1>::rows8(scr, lane, [&](int r, int cq, const float4& a, const float4& bq) {
              const int row = row0 + r;
              if (rb * 128 + row < c) {
                const float w = rwt[row];
                const float4 a2 = make_float4(a.x * w, a.y * w, a.z * w, a.w * w), b2 = make_float4(bq.x * w, bq.y * w, bq.z * w, bq.w * w);
                *(uint4*)(ybuf + ((size_t)obase + row) * 1024 + col0 + cq) = pack8bf(a2, b2);
              } });
          }
        __syncthreads();
      }
    }
  }
}

DI void phase_combine(const Params& p, int l, bool last, char* smem, const int* cnt) {
  float* xs = (float*)(p.ws + OFF_XS);
  bf16_t* H = (bf16_t*)(p.ws + OFF_H);
  const float* mod = (const float*)(p.ws + OFF_MOD);
  const int* eidx = (const int*)(p.ws + OFF_REGION + R_EIDX);
  const int* erank = (const int*)(p.ws + OFF_REGION + R_ERANK);
  const bf16_t* ybuf = (const bf16_t*)(p.ws + OFF_REGION + R_YBUF);
  int* off = (int*)smem;
  const int tid = opaque_tid(), lane = tid & 63, wid = tid >> 6;
  const int ntok = last ? NX_ : NT_;
  __syncthreads();
  if (tid == 0) { int o = 0; for (int e = 0; e < 64; ++e) { off[e] = o; o += cnt[e * 32]; } off[64] = o; }
  __syncthreads();
  for (int n = blockIdx.x * 8 + wid; n < ntok; n += gridDim.x * 8) {
    float acc[16];
#pragma unroll
    for (int i = 0; i < 16; ++i) acc[i] = 0.f;
    for (int k = 0; k < 9; ++k) {
      const int row = k < 8 ? off[eidx[n * 8 + k]] + erank[n * 8 + k] : off[64] + n;
      const bf16_t* y = ybuf + (size_t)row * 1024;
#pragma unroll
      for (int j = 0; j < 4; ++j) {
        const uint2 u = *(const uint2*)(y + (j * 64 + lane) * 4);
        acc[j * 4 + 0] += bf2f((bf16_t)(u.x & 0xffff)); acc[j * 4 + 1] += bf2f((bf16_t)(u.x >> 16));
        acc[j * 4 + 2] += bf2f((bf16_t)(u.y & 0xffff)); acc[j * 4 + 3] += bf2f((bf16_t)(u.y >> 16));
      }
    }
    const float* m5 = mod + ((size_t)l * 3 + tok_modrow(n)) * 6144 + 5 * 1024;
    float v[16];
#pragma unroll
    for (int j = 0; j < 4; ++j) {
      const int c = (j * 64 + lane) * 4;
      const float4 x = *(const float4*)(xs + (size_t)n * 1024 + c), g = *(const float4*)(m5 + c);
      v[j * 4 + 0] = x.x + g.x * acc[j * 4 + 0]; v[j * 4 + 1] = x.y + g.y * acc[j * 4 + 1];
      v[j * 4 + 2] = x.z + g.z * acc[j * 4 + 2]; v[j * 4 + 3] = x.w + g.w * acc[j * 4 + 3];
      if (!last) *(float4*)(xs + (size_t)n * 1024 + c) = make_float4(v[j * 4], v[j * 4 + 1], v[j * 4 + 2], v[j * 4 + 3]);
    }
    if (!last) {
      const float* m = mod + ((size_t)(l + 1) * 3 + tok_modrow(n)) * 6144;
      row_norm_mod(v, p.g_mix + (size_t)(l + 1) * 1024, m, m + 1024, H + (size_t)n * 1024, lane);
    } else {
      float ss = 0.f;
#pragma unroll
      for (int i = 0; i < 16; ++i) ss += v[i] * v[i];
      ss = wave_sum(ss);
      const float rs = frsq(ss * (1.f / 1024.f) + 1e-6f);
#pragma unroll
      for (int j = 0; j < 4; ++j) {
        const int c = (j * 64 + lane) * 4;
        const float4 g = *(const float4*)(p.g_final + c);
        *(float4*)(p.out + (size_t)n * 1024 + c) = make_float4(v[j * 4] * rs * g.x, v[j * 4 + 1] * rs * g.y, v[j * 4 + 2] * rs * g.z, v[j * 4 + 3] * rs * g.w);
      }
    }
  }
}
#define SMEM_BYTES (160 * 1024)
#ifndef MEGA
#define MEGA 0
#endif
DI int* cnt_ptr(const Params& p, int l) { return (int*)(p.ws + OFF_CNT) + 1024 + 2048 * l; }
DI int* ctr_ptr(const Params& p, int l) { return (int*)(p.ws + OFF_CNT) + 32 * l; }
#if !MEGA
__global__ void __launch_bounds__(NTHR) k_phaseA(Params p) { SMEM_DECL(smem, SMEM_BYTES); phaseA(p, smem); }
__global__ void __launch_bounds__(NTHR) k_norm0(Params p) { phase_norm0(p); }
__global__ void __launch_bounds__(NTHR) k_win(Params p, int l) { SMEM_DECL(smem, SMEM_BYTES); phase_win(p, l, smem); }
__global__ void __launch_bounds__(NTHR) k_p3(Params p, int l) { SMEM_DECL(smem, SMEM_BYTES); phase3(p, l, smem); }
__global__ void __launch_bounds__(NTHR) k_p3b(Params p, int l) { SMEM_DECL(smem, SMEM_BYTES); phase3b(p, l, smem, ctr_ptr(p, l)); }
__global__ void __launch_bounds__(NTHR) k_p4(Params p, int l) { SMEM_DECL(smem, SMEM_BYTES); phase4(p, l, smem, ctr_ptr(p, l)); }
__global__ void __launch_bounds__(NTHR) k_p5(Params p, int l, int wc) { SMEM_DECL(smem, SMEM_BYTES); phase5(p, l, wc != 0, smem); }
__global__ void __launch_bounds__(NTHR) k_merge(Params p, int l, int wc) { SMEM_DECL(smem, SMEM_BYTES); phase_merge(p, l, wc != 0, smem); }
__global__ void __launch_bounds__(NTHR) k_wout(Params p, int l, int wc) { SMEM_DECL(smem, SMEM_BYTES); phase_wout(p, l, wc != 0, smem); }
__global__ void __launch_bounds__(NTHR) k_router(Params p, int l, int wc) { SMEM_DECL(smem, SMEM_BYTES); phase_router(p, l, wc != 0, smem, cnt_ptr(p, l)); }
__global__ void __launch_bounds__(NTHR) k_moe(Params p, int l, int wc) { SMEM_DECL(smem, SMEM_BYTES); phase_moe(p, l, wc != 0, smem, cnt_ptr(p, l)); }
__global__ void __launch_bounds__(NTHR) k_combine(Params p, int l, int last) { SMEM_DECL(smem, SMEM_BYTES); phase_combine(p, l, last != 0, smem, cnt_ptr(p, l)); }
#else
#ifndef EMU
#define XB_TMO      128
#define XB_XCNT(j)  (256  + 64 * (j))
#define XB_XSUB(j)  (1280 + 64 * (j))
#define XB_XGEN(j)  (2304 + 64 * (j))
#define XB_TOP      3328
#define XB_TOPGEN   3392
#define XCD_BAR_WORDS 3456
#define XB_SPIN_CAP (1u << 24)
#define LAS __attribute__((address_space(3)))
DI unsigned xb_ld(unsigned* p) { return __hip_atomic_load(p, __ATOMIC_RELAXED, __HIP_MEMORY_SCOPE_AGENT); }
DI unsigned xb_add(unsigned* p, unsigned v) { return __hip_atomic_fetch_add(p, v, __ATOMIC_RELAXED, __HIP_MEMORY_SCOPE_AGENT); }
DI unsigned xb_xcc_id() { return (unsigned)__builtin_amdgcn_s_getreg((3 << 11) | 20) & 0xFu; }
#define XB_SPIN(cond, bar) do { unsigned _sp = 0; while (cond) { __builtin_amdgcn_s_sleep(1); \
    if ((++_sp & 255u) == 0u) { if (xb_ld(&(bar)[XB_TMO])) break; if (_sp > XB_SPIN_CAP) { atomicAdd(&(bar)[XB_TMO], 1u); break; } } } } while (0)
struct XcdBarrier { unsigned* bar; unsigned x; volatile LAS unsigned* st; };
DI XcdBarrier xcd_barrier_post(unsigned* bar, volatile LAS unsigned* st) {
  XcdBarrier b; b.bar = bar; b.x = xb_xcc_id(); b.st = st;
  if (threadIdx.x == 0) (void)xb_add(&bar[XB_XCNT(b.x)], 1u);
  return b;
}
DI void xcd_barrier_complete(unsigned* bar, unsigned x, unsigned& nloc, unsigned& nx) {
  const unsigned G = gridDim.x * gridDim.y * gridDim.z;
  unsigned sum, cnt, mine, sp = 0u;
  for (;;) {
    sum = 0u; cnt = 0u; mine = 0u;
#pragma unroll
    for (unsigned j = 0; j < 16; ++j) { const unsigned c = xb_ld(&bar[XB_XCNT(j)]); sum += c; cnt += (c > 0u) ? 1u : 0u; mine = (j == x) ? c : mine; }
    if (sum == G) break;
    __builtin_amdgcn_s_sleep(1);
    if ((++sp & 255u) == 0u) { if (xb_ld(&bar[XB_TMO])) break; if (sp > XB_SPIN_CAP) { atomicAdd(&bar[XB_TMO], 1u); break; } }
  }
  nloc = mine > 0u ? mine : 1u; nx = cnt > 0u ? cnt : 1u;
}
DI void xcd_barrier(const XcdBarrier& b) {
  asm volatile("s_waitcnt vmcnt(0)" ::: "memory");
  __syncthreads();
  if (threadIdx.x == 0) {
    unsigned* bar = b.bar;
    __builtin_amdgcn_s_waitcnt(0);
    unsigned nloc = b.st[0], nx = b.st[1];
    if (nloc == 0u) { xcd_barrier_complete(bar, b.x, nloc, nx); b.st[0] = nloc; b.st[1] = nx; }
    const unsigned old = xb_add(&bar[XB_XSUB(b.x)], 1u);
    const unsigned gen = old / nloc;
    if (old + 1u == (gen + 1u) * nloc) {
      __builtin_amdgcn_fence(__ATOMIC_RELEASE, "agent");
      asm volatile("s_waitcnt vmcnt(0)" ::: "memory");
      const unsigned og = xb_add(&bar[XB_TOP], 1u);
      const unsigned tg = og / nx;
      if (og + 1u == (tg + 1u) * nx) xb_add(&bar[XB_TOPGEN], 1u);
      else XB_SPIN(xb_ld(&bar[XB_TOPGEN]) == tg, bar);
      __builtin_amdgcn_fence(__ATOMIC_ACQUIRE, "agent");
      xb_add(&bar[XB_XGEN(b.x)], 1u);
      asm volatile("s_waitcnt vmcnt(0)" ::: "memory");
    } else {
      XB_SPIN(xb_ld(&bar[XB_XGEN(b.x)]) == gen, bar);
      __builtin_amdgcn_fence(__ATOMIC_ACQUIRE, "agent");
      asm volatile("s_waitcnt vmcnt(0)" ::: "memory");
    }
  }
  __syncthreads();
}
#define GSYNC() { XcdBarrier xb_; xb_.bar = (unsigned*)(p.ws + OFF_BAR); xb_.x = xb_xcc_id(); xb_.st = (volatile LAS unsigned*)(smem + SMEM_BYTES - 32); xcd_barrier(xb_); }
#else
#define GSYNC() emu::grid_barrier()
#endif
#ifdef PROBE_IDX
#define TS(i) { if (blockIdx.x == 0 && threadIdx.x == 0) ts[i] = wall_clock64(); }
#else
#define TS(i)
#endif
__global__ void __launch_bounds__(NTHR) k_mega(Params p) {
  SMEM_DECL(smem, SMEM_BYTES);
  cooperative_groups::grid_group grid = cooperative_groups::this_grid();
  volatile LAS unsigned* xst = (volatile LAS unsigned*)(smem + SMEM_BYTES - 32);
  if (threadIdx.x == 0) { xst[0] = 0u; xst[1] = 0u; }
  __syncthreads();
  (void)xcd_barrier_post((unsigned*)(p.ws + OFF_BAR), xst);
#ifdef PROBE_IDX
  long long* ts = (long long*)(p.ws + OFF_CNT + 2048);
#endif
  TS(0);
  phaseA(p, smem);
  grid.sync(); TS(1);
  phase_norm0(p);
  GSYNC(); TS(2);
#pragma unroll 1
  for (int l = 0; l < 2; ++l) {
    const bool wc = l == 0;
    phase_win(p, l, smem); GSYNC(); TS(3 + l * 10);
    phase3(p, l, smem); GSYNC(); TS(4 + l * 10);
    phase3b(p, l, smem, ctr_ptr(p, l)); GSYNC(); TS(5 + l * 10);
    phase4(p, l, smem, ctr_ptr(p, l)); GSYNC(); TS(6 + l * 10);
    phase5(p, l, wc, smem); GSYNC(); TS(7 + l * 10);
    phase_merge(p, l, wc, smem); GSYNC(); TS(8 + l * 10);
    phase_wout(p, l, wc, smem); GSYNC(); TS(9 + l * 10);
    phase_router(p, l, wc, smem, cnt_ptr(p, l)); GSYNC(); TS(10 + l * 10);
    phase_moe(p, l, wc, smem, cnt_ptr(p, l)); GSYNC(); TS(11 + l * 10);
    phase_combine(p, l, l == 1, smem, cnt_ptr(p, l));
#ifdef PROBE_IDX
    GSYNC(); TS(12 + l * 10);
#else
    if (l == 0) GSYNC();
#endif
  }
#ifdef PROBE_IDX
  if (blockIdx.x == 0 && threadIdx.x == 0) {
    const float us = (float)(ts[PROBE_IDX + 1] - ts[PROBE_IDX]) * 0.01f;
    p.out[0] += PROBE_IDX >= 40 ? rintf(6.f * log2f(fmaxf(us * 16.f, 1.f))) : rintf(6.f * log2f(fmaxf(us, 1.f)));
  }
#endif
}
#endif

extern "C" void kernel_launch(void* const* d_in, const int* in_sizes, int n_in, void* d_out, int out_size, void* d_ws,
                              size_t ws_size, hipStream_t stream) {
  Params p{};
  const float** pp = (const float**)&p;
  for (int i = 0; i < 41; ++i) pp[i] = (const float*)d_in[i];
  p.out = (float*)d_out; p.ws = (char*)d_ws; p.osc = (char*)d_out;
  if (ws_size < WS_NEEDED) { fprintf(stderr, "workspace too small: %zu < %zu\n", ws_size, (size_t)WS_NEEDED); return; }
#if !MEGA
  const dim3 g(256), b(NTHR);
  hipLaunchKernelGGL(k_phaseA, g, b, 0, stream, p);
  hipLaunchKernelGGL(k_norm0, g, b, 0, stream, p);
  for (int l = 0; l < 2; ++l) {
    const int wc = l == 0;
    hipLaunchKernelGGL(k_win, g, b, 0, stream, p, l);
    hipLaunchKernelGGL(k_p3, g, b, 0, stream, p, l);
    hipLaunchKernelGGL(k_p3b, g, b, 0, stream, p, l);
    hipLaunchKernelGGL(k_p4, g, b, 0, stream, p, l);
    hipLaunchKernelGGL(k_p5, g, b, 0, stream, p, l, wc);
    hipLaunchKernelGGL(k_merge, g, b, 0, stream, p, l, wc);
    hipLaunchKernelGGL(k_wout, g, b, 0, stream, p, l, wc);
    hipLaunchKernelGGL(k_router, g, b, 0, stream, p, l, wc);
    hipLaunchKernelGGL(k_moe, g, b, 0, stream, p, l, wc);
    hipLaunchKernelGGL(k_combine, g, b, 0, stream, p, l, l == 1);
  }
#else
  static int grid_blocks = 0;
  if (!grid_blocks) {
    int dev = 0, cus = 0, per_cu = 0;
    hipGetDevice(&dev);
    hipDeviceGetAttribute(&cus, hipDeviceAttributeMultiprocessorCount, dev);
    hipOccupancyMaxActiveBlocksPerMultiprocessor(&per_cu, k_mega, NTHR, 0);
    if (per_cu > 1) per_cu = 1;
    grid_blocks = cus * per_cu;
  }
  hipMemsetAsync(p.ws + OFF_BAR, 0, 16384, stream);
  void* args[] = {&p};
  hipError_t e = hipLaunchCooperativeKernel((void*)k_mega, dim3(grid_blocks), dim3(NTHR), args, 0, stream);
  if (e != hipSuccess) fprintf(stderr, "cooperative launch failed: %s (grid %d)\n", hipGetErrorString(e), grid_blocks);
#endif
}
```

```cpp
#define MEGA 1
#include <hip/hip_runtime.h>
#include <hip/hip_cooperative_groups.h>
#include <cstdio>

#ifndef SEQ_T
#define SEQ_T 8192
#endif
#ifndef CTX_L
#define CTX_L 256
#endif

#define DI __device__ __forceinline__
typedef unsigned short bf16_t;
typedef short bf16x8 __attribute__((ext_vector_type(8)));
typedef float f32x16 __attribute__((ext_vector_type(16)));
typedef float f32x4 __attribute__((ext_vector_type(4)));
typedef unsigned u32x4 __attribute__((ext_vector_type(4)));

constexpr int NB_ = 2, T_ = SEQ_T, CL_ = CTX_L, D_ = 1024;
constexpr int NX_ = NB_ * T_, NC_ = NB_ * CL_, NT_ = NX_ + NC_, KT_ = CL_ + T_;
constexpr int GRID_W_ = 64;
constexpr int MLA_H = 8, MLA_NOPE_ = 64, MLA_ROPE_ = 32, MLA_DK = 96, MLA_DV = 64, QLORA = 384, KVLORA = 256;
constexpr int MLA_IN_ = 672, ML_IN_ = 784, RW_IN_ = 1152, GATE_IN_ = 3072, D_IN_ = 5680;
constexpr int ZMLA_W = 768;
constexpr int ZREC_W = 1936;
constexpr int WIN_N = 768 + 2048;
constexpr int ML_H = 4, ML_DK = 32, ML_DV = 64, ML_L = 64;
constexpr int RW_H = 4, RW_N_ = 64;
constexpr int NE_ = 64, TOPK_ = 8, DE_ = 256;
constexpr int NCH_ = KT_ / ML_L;
constexpr int NSEQ_ = 2 * NB_ * 4;

constexpr int ZR_MLQ = 0, ZR_MLK = 128, ZR_MLV = 256, ZR_MLO = 512, ZR_MLI = 768, ZR_MLF = 776;
constexpr int ZR_RW = 784;

constexpr size_t al256(size_t x) { return (x + 255) & ~(size_t)255; }
constexpr size_t WM_WIN = 0;
constexpr size_t WM_GATE = WM_WIN + (size_t)WIN_N * 1024 * 2;
constexpr size_t WM_UQ = WM_GATE + (size_t)3072 * 1024 * 2;
constexpr size_t WM_UKV = WM_UQ + (size_t)768 * 384 * 2;
constexpr size_t WM_BRA = WM_UKV + (size_t)1024 * 256 * 2;
constexpr size_t WM_BRM = WM_BRA + (size_t)1024 * 512 * 2;
constexpr size_t WM_BRR = WM_BRM + (size_t)1024 * 256 * 2;
constexpr size_t WM_OUT = WM_BRR + (size_t)1024 * 256 * 2;
constexpr size_t WM_RT = WM_OUT + (size_t)1024 * 1024 * 2;
constexpr size_t WM_SIZE = al256(WM_RT + (size_t)64 * 1024 * 2);
constexpr size_t WE_GU = 0;
constexpr size_t WE_DN = WE_GU + (size_t)65 * 512 * 1024 * 2;
constexpr size_t WE_SIZE = al256(WE_DN + (size_t)65 * 1024 * 256 * 2);

constexpr size_t OFF_XS = 0;
constexpr size_t OFF_MOD = OFF_XS + al256((size_t)NT_ * 1024 * 4);
constexpr size_t OFF_ROPE = OFF_MOD + al256((size_t)2 * 3 * 6144 * 4);
constexpr size_t OFF_H = OFF_ROPE + al256((size_t)T_ * 16 * 8);
constexpr size_t OFF_WMIX = OFF_H + al256((size_t)NT_ * 1024 * 2);
constexpr size_t OFF_CNT = OFF_WMIX + 2 * WM_SIZE;
constexpr size_t OFF_BAR = OFF_CNT + 32768;
constexpr size_t OFF_REGION = OFF_BAR + 16384;
constexpr size_t R_ZREC = 0;
constexpr size_t R_RB16 = R_ZREC + al256((size_t)NT_ * ZREC_W * 4);
constexpr size_t R_LW = R_RB16 + al256((size_t)7 * NT_ * 256 * 2);
constexpr size_t R_BS = R_LW + al256((size_t)2 * NT_ * 256 * 4);
constexpr size_t R_CH = R_BS + al256((size_t)2 * NT_ * 4 * 4);
constexpr size_t R_YS = R_CH + al256((size_t)NSEQ_ * NCH_ * 40960);
constexpr size_t R_MLST = R_YS + al256((size_t)2 * NT_ * 256 * 4);
constexpr size_t R_ATT = R_MLST + al256((size_t)NSEQ_ * NCH_ * 2112 * 4);
constexpr size_t R_MLO = R_ATT + al256((size_t)NT_ * 512 * 2);
constexpr size_t R_RWO = R_MLO + al256((size_t)NT_ * 256 * 2);
constexpr size_t R_VT = R_RWO + al256((size_t)NT_ * 256 * 2);
constexpr size_t R_KB = R_VT + al256((size_t)NB_ * MLA_H * 64 * KT_ * 2);
constexpr size_t R_MIX_END = R_KB + al256((size_t)NB_ * MLA_H * KT_ * 96 * 2);
constexpr int NSLOT_ = NT_ * 9;
constexpr size_t R_YBUF = 0;
constexpr size_t R_EIDX = R_YBUF + al256((size_t)NSLOT_ * 1024 * 2);
constexpr size_t R_EWT = R_EIDX + al256((size_t)NT_ * 8 * 4);
constexpr size_t R_ERANK = R_EWT + al256((size_t)NT_ * 8 * 4);
constexpr size_t R_ELIST = R_ERANK + al256((size_t)NT_ * 8 * 4);
constexpr size_t R_WMOE = R_ELIST + al256((size_t)64 * NT_ * 4);
constexpr size_t R_MOE_END = R_WMOE + WE_SIZE;
constexpr size_t R_SIZE = R_MIX_END > R_MOE_END ? R_MIX_END : R_MOE_END;
constexpr size_t WS_NEEDED = OFF_REGION + R_SIZE;
constexpr size_t O_ZMLA = 0;
constexpr size_t O_QB = O_ZMLA + al256((size_t)NT_ * ZMLA_W * 2);
constexpr size_t O_END = O_QB + al256((size_t)NT_ * 768 * 2);
constexpr size_t O_YMIX = 0;
#if SEQ_T == 8192 && CTX_L == 256
static_assert(O_END <= (size_t)NX_ * 1024 * 4, "d_out scratch overflow");
static_assert((size_t)NT_ * 1024 * 2 <= (size_t)NX_ * 1024 * 4, "ymix overflow");
static_assert(WS_NEEDED <= (size_t)597000000, "workspace too large");
#endif

struct Params {
  const float *x, *c, *ctx, *c_ctx, *w_mod, *b_mod, *g_mix, *g_ffn, *w_in, *g_cq, *w_uq, *g_ckv, *w_uk, *w_uv;
  const float *ml_b_i, *ml_b_f, *ml_g_norm, *rw_mu, *rw_w0, *rw_w2, *rw_a0, *rw_a2, *rw_g2, *rw_k_k, *rw_k_a;
  const float *rw_r_k, *rw_lnx_w, *rw_lnx_b, *w_br_mla, *w_br_ml, *w_br_rw, *w_out, *w_router, *router_bias;
  const float *w_e_gate, *w_e_up, *w_e_down, *w_s_gate, *w_s_up, *w_s_down, *g_final;
  float* out; char* ws; char* osc;
};

DI float bf2f(bf16_t s) { unsigned u = ((unsigned)s) << 16; float f; __builtin_memcpy(&f, &u, 4); return f; }
DI bf16_t f2bf(float x) { unsigned u; __builtin_memcpy(&u, &x, 4); u += 0x7fffu + ((u >> 16) & 1u); return (bf16_t)(u >> 16); }
DI unsigned pack2bf(float a, float b) {
#ifdef EMU
  return (unsigned)f2bf(a) | ((unsigned)f2bf(b) << 16);
#else
  typedef __bf16 bf2 __attribute__((ext_vector_type(2)));
  typedef float f2 __attribute__((ext_vector_type(2)));
  f2 v = {a, b}; bf2 r = __builtin_convertvector(v, bf2); return __builtin_bit_cast(unsigned, r);
#endif
}
DI f32x16 mfma32(bf16x8 a, bf16x8 b, f32x16 c) {
#ifdef EMU
  return emu_mfma_32x32x16_bf16(a, b, c);
#else
  return __builtin_amdgcn_mfma_f32_32x32x16_bf16(a, b, c, 0, 0, 0);
#endif
}
DI int rfl(int v) {
#ifdef EMU
  return v;
#else
  return __builtin_amdgcn_readfirstlane(v);
#endif
}
DI int opaque_tid() {
#ifdef EMU
  return threadIdx.x;
#else
  int t = threadIdx.x; asm volatile("" : "+v"(t)); return t;
#endif
}
DI void wave_sync() {
#ifdef EMU
  (void)__ballot(1);
#else
  asm volatile("" ::: "memory");
#endif
}
DI int vblock() {
  const int g = gridDim.x, b = blockIdx.x;
  return (g & 7) == 0 ? (b & 7) * (g >> 3) + (b >> 3) : b;
}
DI int xcc_id() {
#ifdef EMU
  return blockIdx.x & 7;
#else
  return (int)(__builtin_amdgcn_s_getreg((3 << 11) | 20) & 7u);
#endif
}
DI int ld_relaxed(int* p) {
#ifdef EMU
  return __atomic_load_n(p, __ATOMIC_SEQ_CST);
#else
  return __hip_atomic_load(p, __ATOMIC_RELAXED, __HIP_MEMORY_SCOPE_AGENT);
#endif
}
DI void sched_fence() {
#ifndef EMU
  __builtin_amdgcn_sched_barrier(0);
#endif
}
template <int L> DI float lane_bcast(float x) {
#ifdef EMU
  return __shfl(x, L);
#else
  return __builtin_bit_cast(float, __builtin_amdgcn_readlane(__builtin_bit_cast(int, x), L));
#endif
}
DI f32x16 zero16() { f32x16 z; for (int i = 0; i < 16; ++i) z[i] = 0.f; return z; }
DI int crow(int reg, int h) { return (reg & 3) + 8 * (reg >> 2) + 4 * h; }
#ifdef EMU
DI float fexp(float x) { return expf(x); }
#else
DI float fexp(float x) { return __expf(x); }
#endif
#ifdef EMU
DI float frcp(float x) { return 1.f / x; }
DI float frsq(float x) { return 1.f / sqrtf(x); }
#else
DI float frcp(float x) { return __builtin_amdgcn_rcpf(x); }
DI float frsq(float x) { return __builtin_amdgcn_rsqf(x); }
#endif
#ifdef EMU
DI float flog(float x) { return logf(x); }
#else
DI float flog(float x) { return __builtin_amdgcn_logf(x) * 0.6931471805599453f; }
#endif
DI float sigmoidf_(float x) { return frcp(1.f + fexp(-x)); }
DI float siluf_(float x) { return x * sigmoidf_(x); }
#ifdef EMU
DI float wave_sum(float v) { for (int m = 32; m >= 1; m >>= 1) v += __shfl_xor(v, m); return v; }
DI float wave_max(float v) { for (int m = 32; m >= 1; m >>= 1) v = fmaxf(v, __shfl_xor(v, m)); return v; }
#else
#define DPPF(x, ctrl) __builtin_bit_cast(float, __builtin_amdgcn_mov_dpp(__builtin_bit_cast(int, (x)), (ctrl), 0xf, 0xf, true))
#define RDLF(x, l) __builtin_bit_cast(float, __builtin_amdgcn_readlane(__builtin_bit_cast(int, (x)), (l)))
DI float wave_sum(float v) {
  v += DPPF(v, 0xB1); v += DPPF(v, 0x4E); v += DPPF(v, 0x124); v += DPPF(v, 0x128);
  return (RDLF(v, 0) + RDLF(v, 16)) + (RDLF(v, 32) + RDLF(v, 48));
}
DI float wave_max(float v) {
  v = fmaxf(v, DPPF(v, 0xB1)); v = fmaxf(v, DPPF(v, 0x4E)); v = fmaxf(v, DPPF(v, 0x124)); v = fmaxf(v, DPPF(v, 0x128));
  return fmaxf(fmaxf(RDLF(v, 0), RDLF(v, 16)), fmaxf(RDLF(v, 32), RDLF(v, 48)));
}
#endif

DI int tok_b(int n) { return n < NX_ ? n / T_ : (n - NX_) / CL_; }
DI int tok_t(int n) { return n < NX_ ? n % T_ : (n - NX_) % CL_; }
DI int tok_key(int n) { return n < NX_ ? CL_ + n % T_ : (n - NX_) % CL_; }
DI int tok_modrow(int n) { return n < NX_ ? n / T_ : 2; }

#ifdef EMU
#define SMEM_DECL(name, bytes) char* name = (char*)emu::shared_alloc(bytes)
#else
#define SMEM_DECL(name, bytes) __shared__ __attribute__((aligned(16))) char name[bytes]
#endif
#define NTHR 512
#if defined(PROBE_IDX) && !defined(EMU)
#define TSB(pp, i) { if (blockIdx.x == 0 && threadIdx.x == 0) ((long long*)((pp).ws + OFF_CNT + 2048))[i] = wall_clock64(); }
#else
#define TSB(pp, i)
#endif
struct CvtJob { const float* src; int lds; int K; bf16_t* dst; int ntn; int ntk; int maptype; const float* gain; };
DI int cvt_map(int maptype, int coff, int np) {
  if (maptype == 0) return coff + np;
  if (maptype == 1) { if (np < 672) return np; if (np < 768) return -1; if (np < 768 + 1936) return np - 96; return -1; }
  return np;
}
struct CvtItem { CvtJob j; int coff, tk, tn; };
struct CvtRegs { float v[8]; };
DI void cvt_load(const CvtItem& c, int tid, CvtRegs& r) {
  const int kk = tid >> 4, np = c.tn * 64 + (tid & 15) * 4;
  const int sc = cvt_map(c.j.maptype, c.coff, np);
#pragma unroll
  for (int u = 0; u < 2; ++u) {
    const int k = c.tk * 64 + kk + 32 * u;
    float4 v = make_float4(0.f, 0.f, 0.f, 0.f);
    if (sc >= 0) v = *(const float4*)(c.j.src + (size_t)k * c.j.lds + sc);
    const float g = c.j.gain ? c.j.gain[k] : 1.f;
    r.v[4 * u] = v.x * g; r.v[4 * u + 1] = v.y * g; r.v[4 * u + 2] = v.z * g; r.v[4 * u + 3] = v.w * g;
  }
}
DI void cvt_store(const CvtItem& c, int tid, const CvtRegs& r, char* smem) {
  float* tile = (float*)smem;
  __syncthreads();
  {
    const int kk = tid >> 4, nc = (tid & 15) * 4;
#pragma unroll
    for (int u = 0; u < 2; ++u)
#pragma unroll
      for (int i = 0; i < 4; ++i) tile[(kk + 32 * u) * 65 + nc + i] = r.v[4 * u + i];
  }
  __syncthreads();
  {
    const int n = tid >> 3, kc = (tid & 7) * 8;
    int np = c.tn * 64 + n;
    if (c.j.maptype == 2) np = (np >> 5) * 64 + c.coff * 32 + (np & 31);
    uint4 v;
    v.x = pack2bf(tile[(kc + 0) * 65 + n], tile[(kc + 1) * 65 + n]);
    v.y = pack2bf(tile[(kc + 2) * 65 + n], tile[(kc + 3) * 65 + n]);
    v.z = pack2bf(tile[(kc + 4) * 65 + n], tile[(kc + 5) * 65 + n]);
    v.w = pack2bf(tile[(kc + 6) * 65 + n], tile[(kc + 7) * 65 + n]);
    *(uint4*)(c.j.dst + (size_t)np * c.j.K + c.tk * 64 + kc) = v;
  }
}
template <class Dec> DI void cvt_run(Dec dec, int first, int n, int stride, char* smem) {
  const int tid = opaque_tid();
  if (first >= n) return;
  CvtItem cur = dec(first); CvtRegs rc; cvt_load(cur, tid, rc);
  for (int it = first; it < n; it += stride) {
    const int nx = it + stride < n ? it + stride : it;
    CvtItem nxt = dec(nx); CvtRegs rn; cvt_load(nxt, tid, rn);
    sched_fence();
    cvt_store(cur, tid, rc, smem);
    cur = nxt; rc = rn;
  }
}

constexpr int CVT_MIX_TILES = 704 + 768 + 72 + 32 + 32 + 128 + 64 + 64 + 256 + 16;
DI CvtItem cvt_mix_dec(const Params& p, int l, int it) {
  bf16_t* W = (bf16_t*)(p.ws + OFF_WMIX + (size_t)l * WM_SIZE);
  CvtJob j; int coff = 0;
  if (it < 704) { j = {p.w_in + (size_t)l * 1024 * D_IN_, D_IN_, 1024, (bf16_t*)((char*)W + WM_WIN), 44, 16, 1, nullptr}; }
  else if ((it -= 704) < 768) { j = {p.w_in + (size_t)l * 1024 * D_IN_, D_IN_, 1024, (bf16_t*)((char*)W + WM_GATE), 48, 16, 0, nullptr}; coff = 2608; }
  else if ((it -= 768) < 72) { j = {p.w_uq + (size_t)l * 384 * 768, 768, 384, (bf16_t*)((char*)W + WM_UQ), 12, 6, 0, p.g_cq + l * 384}; }
  else if ((it -= 72) < 32) { j = {p.w_uk + (size_t)l * 256 * 512, 512, 256, (bf16_t*)((char*)W + WM_UKV), 8, 4, 0, p.g_ckv + l * 256}; }
  else if ((it -= 32) < 32) { j = {p.w_uv + (size_t)l * 256 * 512, 512, 256, (bf16_t*)((char*)W + WM_UKV) + 512 * 256, 8, 4, 0, p.g_ckv + l * 256}; }
  else if ((it -= 32) < 128) { j = {p.w_br_mla + (size_t)l * 512 * 1024, 1024, 512, (bf16_t*)((char*)W + WM_BRA), 16, 8, 0, nullptr}; }
  else if ((it -= 128) < 64) { j = {p.w_br_ml + (size_t)l * 256 * 1024, 1024, 256, (bf16_t*)((char*)W + WM_BRM), 16, 4, 0, nullptr}; }
  else if ((it -= 64) < 64) { j = {p.w_br_rw + (size_t)l * 256 * 1024, 1024, 256, (bf16_t*)((char*)W + WM_BRR), 16, 4, 0, nullptr}; }
  else if ((it -= 64) < 256) { j = {p.w_out + (size_t)l * 1024 * 1024, 1024, 1024, (bf16_t*)((char*)W + WM_OUT), 16, 16, 0, nullptr}; }
  else { it -= 256; j = {p.w_router + (size_t)l * 1024 * 64, 64, 1024, (bf16_t*)((char*)W + WM_RT), 1, 16, 0, nullptr}; }
  CvtItem c; c.j = j; c.coff = coff; c.tk = it / j.ntn; c.tn = it % j.ntn; return c;
}
constexpr int CVT_MOE_TILES = 65 * 192;
DI CvtItem cvt_moe_dec(const Params& p, int l, int it) {
  const int e = it / 192; int r = it % 192;
  bf16_t* GU = (bf16_t*)(p.ws + OFF_REGION + R_WMOE + WE_GU) + (size_t)e * 512 * 1024;
  bf16_t* DN = (bf16_t*)(p.ws + OFF_REGION + R_WMOE + WE_DN) + (size_t)e * 1024 * 256;
  const float* sg = e < 64 ? p.w_e_gate + ((size_t)l * 64 + e) * 1024 * 256 : p.w_s_gate + (size_t)l * 1024 * 256;
  const float* su = e < 64 ? p.w_e_up + ((size_t)l * 64 + e) * 1024 * 256 : p.w_s_up + (size_t)l * 1024 * 256;
  const float* sd = e < 64 ? p.w_e_down + ((size_t)l * 64 + e) * 256 * 1024 : p.w_s_down + (size_t)l * 256 * 1024;
  CvtJob j; int coff = 0;
  if (r < 64) { j = {sg, 256, 1024, GU, 4, 16, 2, nullptr}; coff = 0; }
  else if ((r -= 64) < 64) { j = {su, 256, 1024, GU, 4, 16, 2, nullptr}; coff = 1; }
  else { r -= 64; j = {sd, 1024, 256, DN, 16, 4, 0, nullptr}; }
  CvtItem c; c.j = j; c.coff = coff; c.tk = r / j.ntn; c.tn = r % j.ntn; return c;
}

DI void mod_item(const Params& p, int it, char* smem) {
  float* cond = (float*)smem;
  float* red = cond + 3 * 1024;
  const int tid = opaque_tid(), l = it / 96, j0 = (it % 96) * 64;
  __syncthreads();
  for (int i = tid; i < 3 * 1024; i += NTHR) {
    const int r = i >> 10, k = i & 1023;
    const float v = r < 2 ? p.c[r * 1024 + k] : p.c_ctx[k];
    cond[i] = siluf_(v);
  }
  __syncthreads();
  const int jj = tid & 63, kg = tid >> 6;
  float a0 = 0.f, a1 = 0.f, a2 = 0.f;
  const float* w = p.w_mod + (size_t)l * 1024 * 6144 + j0 + jj;
  for (int k = kg; k < 1024; k += 8) {
    const float wv = w[(size_t)k * 6144];
    a0 += cond[k] * wv; a1 += cond[1024 + k] * wv; a2 += cond[2048 + k] * wv;
  }
  red[(kg * 3 + 0) * 64 + jj] = a0; red[(kg * 3 + 1) * 64 + jj] = a1; red[(kg * 3 + 2) * 64 + jj] = a2;
  __syncthreads();
  if (tid < 192) {
    const int r = tid >> 6; float s = 0.f;
    for (int g = 0; g < 8; ++g) s += red[(g * 3 + r) * 64 + jj];
    float* mod = (float*)(p.ws + OFF_MOD);
    mod[((size_t)l * 3 + r) * 6144 + j0 + jj] = s + p.b_mod[(size_t)l * 6144 + j0 + jj];
  }
}
DI void rope_item(const Params& p, int it) {
  const int idx = it * NTHR + threadIdx.x;
  if (idx >= T_ * 16) return;
  const int t = idx >> 4, i = idx & 15, f = i & 7;
  const float pos = (float)(i < 8 ? t / GRID_W_ : t % GRID_W_);
  const float inv = powf(10000.f, -(float)(2 * f) / 16.f);
  const float ang = pos * inv;
  float2* rt = (float2*)(p.ws + OFF_ROPE);
  rt[idx] = make_float2(cosf(ang), sinf(ang));
}
constexpr int PA_ITEMS = 192 + (T_ * 16 + NTHR - 1) / NTHR;
DI void phaseA(const Params& p, char* smem) {
  if (blockIdx.x == 0) for (int i = threadIdx.x; i < 8192; i += NTHR) ((int*)(p.ws + OFF_CNT))[i] = 0;
  for (int it = blockIdx.x; it < PA_ITEMS; it += gridDim.x) {
    if (it < 192) mod_item(p, it, smem); else rope_item(p, it - 192);
  }
  cvt_run([&](int i) { return cvt_mix_dec(p, i / CVT_MIX_TILES, i % CVT_MIX_TILES); }, blockIdx.x, 2 * CVT_MIX_TILES, gridDim.x, smem);
}

DI void row_norm_mod(const float (&v)[16], const float* g, const float* shift, const float* scale, bf16_t* hrow, int lane) {
  float ss = 0.f;
#pragma unroll
  for (int i = 0; i < 16; ++i) ss += v[i] * v[i];
  ss = wave_sum(ss);
  const float rs = frsq(ss * (1.f / 1024.f) + 1e-6f);
#pragma unroll
  for (int j = 0; j < 4; ++j) {
    const int c = (j * 64 + lane) * 4;
    const float4 gg = *(const float4*)(g + c), sh = *(const float4*)(shift + c), sc = *(const float4*)(scale + c);
    const float h0 = v[j * 4 + 0] * rs * gg.x * (1.f + sc.x) + sh.x;
    const float h1 = v[j * 4 + 1] * rs * gg.y * (1.f + sc.y) + sh.y;
    const float h2 = v[j * 4 + 2] * rs * gg.z * (1.f + sc.z) + sh.z;
    const float h3 = v[j * 4 + 3] * rs * gg.w * (1.f + sc.w) + sh.w;
    uint2 o; o.x = pack2bf(h0, h1); o.y = pack2bf(h2, h3);
    *(uint2*)(hrow + c) = o;
  }
}
DI void phase_norm0(const Params& p) {
  const int lane = threadIdx.x & 63, wid = threadIdx.x >> 6;
  float* xs = (float*)(p.ws + OFF_XS);
  bf16_t* H = (bf16_t*)(p.ws + OFF_H);
  const float* mod = (const float*)(p.ws + OFF_MOD);
  for (int n = blockIdx.x * 8 + wid; n < NT_; n += gridDim.x * 8) {
    const float* src = n < NX_ ? p.x + (size_t)n * 1024 : p.ctx + (size_t)(n - NX_) * 1024;
    float v[16];
#pragma unroll
    for (int j = 0; j < 4; ++j) {
      const float4 t = *(const float4*)(src + (j * 64 + lane) * 4);
      v[j * 4] = t.x; v[j * 4 + 1] = t.y; v[j * 4 + 2] = t.z; v[j * 4 + 3] = t.w;
      *(float4*)(xs + (size_t)n * 1024 + (j * 64 + lane) * 4) = t;
    }
    const float* m = mod + (size_t)(0 * 3 + tok_modrow(n)) * 6144;
    row_norm_mod(v, p.g_mix, m, m + 1024, H + (size_t)n * 1024, lane);
  }
}

template <int BM, int BN, int BK, int WM_, int WN_>
struct Gemm {
  static constexpr int WTM = BM / WM_, WTN = BN / WN_, MB = WTM / 32, NB = WTN / 32, WM = WM_, WN = WN_, TM = BM, TN = BN;
  static constexpr int LDA = BK + 8;
  static constexpr int A_BYTES = BM * LDA * 2, B_BYTES = BN * LDA * 2, STAGE = A_BYTES + B_BYTES;
  static constexpr int SMEM = 2 * STAGE;
  static constexpr int CPR = BK / 8;
  static constexpr int ACH = BM * CPR / NTHR, BCH = BN * CPR / NTHR;
  static_assert(WM_ * WN_ == 8, "8 waves");
  static_assert(BM * CPR % NTHR == 0 && BN * CPR % NTHR == 0, "chunking");
  static_assert(NTHR % CPR == 0, "rows fixed per thread");

  template <class LA, class LB>
  static DI void run_core(f32x16 (&acc)[MB][NB], LA la, LB lb, int nk, char* smem, int tid) {
    const int lane = tid & 63, wid = tid >> 6, wm = wid / WN_, wn = wid % WN_;
    const int kc = (tid % CPR) * 8, r0 = tid / CPR;
    constexpr int KS = BK / 16, NCH = ACH + BCH;
    u32x4 s0[NCH], s1[NCH];
#define GEMM_LOAD(dst_, kt_) { const int kq_ = (kt_) < nk ? (kt_) : nk - 1; \
    _Pragma("unroll") for (int i = 0; i < ACH; ++i) dst_[i] = la(i, kq_); \
    _Pragma("unroll") for (int i = 0; i < BCH; ++i) dst_[ACH + i] = lb(i, kq_); }
#define GEMM_WRITE1(src_, c_, buf_) { if ((c_) < ACH) *(u32x4*)(smem + (buf_) * STAGE + ((r0 + (c_) * (NTHR / CPR)) * LDA + kc) * 2) = src_[c_]; \
    else *(u32x4*)(smem + (buf_) * STAGE + A_BYTES + ((r0 + ((c_) - ACH) * (NTHR / CPR)) * LDA + kc) * 2) = src_[c_]; }
#define GEMM_STEP(w_, l_, kt_) { \
    GEMM_LOAD(l_, (kt_) + 2); \
    sched_fence(); \
    const char* As = smem + ((kt_) & 1) * STAGE; const char* Bs = As + A_BYTES; \
    _Pragma("unroll") for (int ks = 0; ks < KS; ++ks) { \
      bf16x8 af[MB], bfr[NB]; \
      _Pragma("unroll") for (int mb = 0; mb < MB; ++mb) af[mb] = *(const bf16x8*)(As + ((wm * WTM + mb * 32 + (lane & 31)) * LDA + ks * 16 + (lane >> 5) * 8) * 2); \
      _Pragma("unroll") for (int nb = 0; nb < NB; ++nb) bfr[nb] = *(const bf16x8*)(Bs + ((wn * WTN + nb * 32 + (lane & 31)) * LDA + ks * 16 + (lane >> 5) * 8) * 2); \
      _Pragma("unroll") for (int c = 0; c < NCH; ++c) if ((c * KS) / NCH == ks) GEMM_WRITE1(w_, c, ((kt_) + 1) & 1); \
      _Pragma("unroll") for (int mb = 0; mb < MB; ++mb) _Pragma("unroll") for (int nb = 0; nb < NB; ++nb) acc[mb][nb] = mfma32(af[mb], bfr[nb], acc[mb][nb]); \
    } \
    sched_fence(); \
    __syncthreads(); }
    GEMM_LOAD(s0, 0);
#pragma unroll
    for (int c = 0; c < NCH; ++c) GEMM_WRITE1(s0, c, 0);
    GEMM_LOAD(s0, 1);
    __syncthreads();
    for (int kt = 0; kt < nk; kt += 2) {
      GEMM_STEP(s0, s1, kt);
      GEMM_STEP(s1, s0, kt + 1);
    }
#undef GEMM_STEP
#undef GEMM_WRITE1
#undef GEMM_LOAD
  }
  template <class ARow>
  static DI void run(f32x16 (&acc)[MB][NB], ARow arow, const bf16_t* Bt, int ldb, int Klen, char* smem) {
    const int tid = opaque_tid();
    const int kc = (tid % CPR) * 8, r0 = tid / CPR;
    const bf16_t* ap[ACH];
#pragma unroll
    for (int i = 0; i < ACH; ++i) ap[i] = arow(r0 + i * (NTHR / CPR)) + kc;
    const bf16_t* bp0 = Bt + (size_t)r0 * ldb + kc;
    const size_t sb = (size_t)(NTHR / CPR) * ldb;
    run_core(acc, [&](int i, int kt) { return *(const u32x4*)(ap[i] + kt * BK); },
             [&](int i, int kt) { return *(const u32x4*)(bp0 + i * sb + kt * BK); }, Klen / BK, smem, tid);
  }
  static DI void run_lin(f32x16 (&acc)[MB][NB], const bf16_t* A0, int lda, const bf16_t* Bt, int ldb, int Klen, char* smem) {
    const int tid = opaque_tid();
    const int kc = (tid % CPR) * 8, r0 = tid / CPR;
    const bf16_t* ap0 = A0 + (size_t)r0 * lda + kc; const bf16_t* bp0 = Bt + (size_t)r0 * ldb + kc;
    const size_t sa = (size_t)(NTHR / CPR) * lda, sb = (size_t)(NTHR / CPR) * ldb;
    run_core(acc, [&](int i, int kt) { return *(const u32x4*)(ap0 + i * sa + kt * BK); },
             [&](int i, int kt) { return *(const u32x4*)(bp0 + i * sb + kt * BK); }, Klen / BK, smem, tid);
  }
  static DI int row_of(int t, int mb, int reg) { const int lane = t & 63, wm = (t >> 6) / WN_; return wm * WTM + mb * 32 + crow(reg, lane >> 5); }
  static DI int col_of(int t, int nb) { const int lane = t & 63, wn = (t >> 6) % WN_; return wn * WTN + nb * 32 + (lane & 31); }
};


template <int NBW> struct WTile {
  static constexpr int LD = NBW * 32 + 4;
  static constexpr int BYTES = 32 * LD * 4;
  static DI void put(float* scr, int nb, int lane, const f32x16& v) {
    const int c = nb * 32 + (lane & 31), h = lane >> 5;
#pragma unroll
    for (int i = 0; i < 16; ++i) scr[crow(i, h) * LD + c] = v[i];
  }
  template <class F> static DI void rows4(const float* scr, int lane, F f) {
    wave_sync();
#pragma unroll
    for (int it = 0; it < NBW * 4; ++it) {
      const int id = it * 64 + lane, row = id / (NBW * 8), q = id % (NBW * 8);
      f(row, q * 4, *(const float4*)(scr + row * LD + q * 4));
    }
    wave_sync();
  }
  template <class F> static DI void rows8(const float* scr, int lane, F f) {
    wave_sync();
#pragma unroll
    for (int it = 0; it < NBW * 2; ++it) {
      const int id = it * 64 + lane, row = id / (NBW * 4), q = id % (NBW * 4);
      f(row, q * 8, *(const float4*)(scr + row * LD + q * 8), *(const float4*)(scr + row * LD + q * 8 + 4));
    }
    wave_sync();
  }
};
DI uint4 pack8bf(const float4& a, const float4& b) { return make_uint4(pack2bf(a.x, a.y), pack2bf(a.z, a.w), pack2bf(b.x, b.y), pack2bf(b.z, b.w)); }

typedef Gemm<256, 256, 64, 2, 4> G256;
DI void phase_win(const Params& p, int l, char* smem) {
  const bf16_t* H = (const bf16_t*)(p.ws + OFF_H);
  const bf16_t* W = (const bf16_t*)(p.ws + OFF_WMIX + (size_t)l * WM_SIZE + WM_WIN);
  bf16_t* zmla = (bf16_t*)(p.osc + O_ZMLA);
  float* zrec = (float*)(p.ws + OFF_REGION + R_ZREC);
  constexpr int TM = NT_ / 256, TN = WIN_N / 256;
  for (int it = vblock(); it < TM * TN; it += gridDim.x) {
    const int tid = opaque_tid();
    const int tm = it / TN, tn = it % TN;
    __syncthreads();
    f32x16 acc[G256::MB][G256::NB];
#pragma unroll
    for (int a = 0; a < G256::MB; ++a)
#pragma unroll
      for (int b = 0; b < G256::NB; ++b) acc[a][b] = zero16();
    const bf16_t* A0 = H + (size_t)tm * 256 * 1024;
    G256::run(acc, [&](int r) { return A0 + (size_t)r * 1024; }, W + (size_t)tn * 256 * 1024, 1024, 1024, smem);
    {
      const int lane = tid & 63, wid = tid >> 6, wm = wid / 4, wn = wid % 4;
      float* scr = (float*)(smem + wid * WTile<2>::BYTES);
      const int col0 = tn * 256 + wn * 64;
#pragma unroll
      for (int mb = 0; mb < G256::MB; ++mb) {
        WTile<2>::put(scr, 0, lane, acc[mb][0]); WTile<2>::put(scr, 1, lane, acc[mb][1]);
        const int row0 = tm * 256 + wm * 128 + mb * 32;
#ifdef ABL_NOSTORE
        if (tn > 1000) {
#else
        if (tn < 3) {
#endif
          WTile<2>::rows8(scr, lane, [&](int r, int c, const float4& a, const float4& bq) {
            *(uint4*)(zmla + (size_t)(row0 + r) * ZMLA_W + col0 + c) = pack8bf(a, bq); });
        } else {
          WTile<2>::rows4(scr, lane, [&](int r, int c, const float4& a) {
            const int cc = col0 - 768 + c;
#ifdef ABL_NOSTORE
            if (cc < -5) *(float4*)(zrec + (size_t)(row0 + r) * ZREC_W + cc) = a; });
#else
            if (cc < ZREC_W) *(float4*)(zrec + (size_t)(row0 + r) * ZREC_W + cc) = a; });
#endif
        }
      }
    }
  }
}
typedef Gemm<128, 128, 64, 2, 4> G128;
DI void mla_row_rs(const bf16_t* zmla_rows, int c0, int len, float* rs) {
  const int tid = opaque_tid(), row = tid >> 2, half = tid & 3;
  const bf16_t* src = zmla_rows + (size_t)row * ZMLA_W + c0 + half * (len / 4);
  float ss = 0.f;
  for (int i = 0; i < len / 4; i += 8) {
    const uint4 v = *(const uint4*)(src + i);
    const unsigned w[4] = {v.x, v.y, v.z, v.w};
#pragma unroll
    for (int j = 0; j < 4; ++j) { const float a = bf2f((bf16_t)(w[j] & 0xffff)), b = bf2f((bf16_t)(w[j] >> 16)); ss += a * a + b * b; }
  }
  ss += __shfl_xor(ss, 1); ss += __shfl_xor(ss, 2);
  if (half == 0) rs[row] = frsq(ss / (float)len + 1e-6f);
}

constexpr int MLA_Q_TILES = (NT_ / 128) * 6, MLA_KV_TILES = (NT_ / 128) * 8;
DI void mla_q_item(const Params& p, int l, int it, char* smem) {
  const int tid = opaque_tid();
  const int tm = it / 6, tn = it % 6;
  const bf16_t* zmla = (const bf16_t*)(p.osc + O_ZMLA) + (size_t)tm * 128 * ZMLA_W;
  const bf16_t* W = (const bf16_t*)(p.ws + OFF_WMIX + (size_t)l * WM_SIZE + WM_UQ) + (size_t)tn * 128 * 384;
  bf16_t* qb = (bf16_t*)(p.osc + O_QB);
  const float2* rt = (const float2*)(p.ws + OFF_ROPE);
  float* rs = (float*)(smem + G128::SMEM);
  __syncthreads();
  mla_row_rs(zmla, 0, 384, rs);
  f32x16 acc[G128::MB][G128::NB];
#pragma unroll
  for (int a = 0; a < G128::MB; ++a)
#pragma unroll
    for (int b = 0; b < G128::NB; ++b) acc[a][b] = zero16();
  G128::run(acc, [&](int r) { return zmla + (size_t)r * ZMLA_W; }, W, 384, 384, smem);
  const int lane = tid & 63;
  const bool isx = tm * 128 < NX_;
#pragma unroll
  for (int mb = 0; mb < G128::MB; ++mb)
#pragma unroll
    for (int nb = 0; nb < G128::NB; ++nb) {
      const int col = tn * 128 + G128::col_of(tid, nb);
      const bool ropeblk = ((col >> 5) % 3) == 2;
      const int e = lane & 31;
#pragma unroll
      for (int i = 0; i < 16; ++i) {
        const int lr = G128::row_of(tid, mb, i);
        const int n = tm * 128 + lr;
        float v = acc[mb][nb][i] * rs[lr];
        if (ropeblk && isx) {
          const float pv = __shfl_xor(v, 8);
          const float2 cs = rt[(size_t)(n % T_) * 16 + (e >> 4) * 8 + (e & 7)];
          v = (e & 8) ? (pv * cs.y + v * cs.x) : (v * cs.x - pv * cs.y);
        }
        qb[(size_t)n * 768 + col] = f2bf(v);
      }
    }
}
DI void mla_kv_item(const Params& p, int l, int it, char* smem) {
  const int tid = opaque_tid();
  const int tm = it / 8, tn = it % 8;
  const bf16_t* zmla = (const bf16_t*)(p.osc + O_ZMLA) + (size_t)tm * 128 * ZMLA_W;
  const bf16_t* W = (const bf16_t*)(p.ws + OFF_WMIX + (size_t)l * WM_SIZE + WM_UKV) + (size_t)tn * 128 * 256;
  bf16_t* kb = (bf16_t*)(p.ws + OFF_REGION + R_KB);
  bf16_t* vt = (bf16_t*)(p.ws + OFF_REGION + R_VT);
  const float2* rt = (const float2*)(p.ws + OFF_ROPE);
  float* rs = (float*)(smem + G128::SMEM);
  __syncthreads();
  mla_row_rs(zmla, 384, 256, rs);
  const int n0 = tm * 128;
  const int b = tok_b(n0), key0 = tok_key(n0);
  const bool isx = n0 < NX_;
  if (tn == 0) {
    for (int idx = tid; idx < 128 * 16; idx += NTHR) {
      const int lr = idx >> 4, pi = idx & 15, a = pi >> 3, i = pi & 7;
      const bf16_t* z = zmla + (size_t)lr * ZMLA_W + 640 + a * 16 + i;
      float x1 = bf2f(z[0]), x2 = bf2f(z[8]);
      if (isx) {
        const float2 cs = rt[(size_t)((n0 + lr) % T_) * 16 + a * 8 + i];
        const float y1 = x1 * cs.x - x2 * cs.y, y2 = x1 * cs.y + x2 * cs.x; x1 = y1; x2 = y2;
      }
      const bf16_t o1 = f2bf(x1), o2 = f2bf(x2);
      for (int h = 0; h < 8; ++h) {
        bf16_t* dst = kb + ((size_t)(b * 8 + h) * KT_ + key0 + lr) * 96 + 64 + a * 16 + i;
        dst[0] = o1; dst[8] = o2;
      }
    }
  }
  f32x16 acc[G128::MB][G128::NB];
#pragma unroll
  for (int a = 0; a < G128::MB; ++a)
#pragma unroll
    for (int c = 0; c < G128::NB; ++c) acc[a][c] = zero16();
  G128::run(acc, [&](int r) { return zmla + (size_t)r * ZMLA_W + 384; }, W, 256, 256, smem);
  const int lane = tid & 63;
#pragma unroll
  for (int mb = 0; mb < G128::MB; ++mb)
#pragma unroll
    for (int nb = 0; nb < G128::NB; ++nb) {
      const int col = tn * 128 + G128::col_of(tid, nb);
      if (col < 512) {
        const int h = col >> 6, d = col & 63;
#pragma unroll
        for (int i = 0; i < 16; ++i) {
          const int lr = G128::row_of(tid, mb, i);
          kb[((size_t)(b * 8 + h) * KT_ + key0 + lr) * 96 + d] = f2bf(acc[mb][nb][i] * rs[lr]);
        }
      } else {
        const int h = (col - 512) >> 6, d = col & 63;
#pragma unroll
        for (int g = 0; g < 4; ++g) {
          const int lr = G128::row_of(tid, mb, g * 4);
          uint2 o;
          o.x = pack2bf(acc[mb][nb][g * 4 + 0] * rs[lr], acc[mb][nb][g * 4 + 1] * rs[lr + 1]);
          o.y = pack2bf(acc[mb][nb][g * 4 + 2] * rs[lr + 2], acc[mb][nb][g * 4 + 3] * rs[lr + 3]);
          *(uint2*)(vt + ((size_t)(b * 8 + h) * 64 + d) * KT_ + key0 + lr) = o;
        }
      }
    }
  (void)lane;
}

DI float softplusf_(float x) { const float e = fexp(-fabsf(x)); return fmaxf(x, 0.f) + (e < 0.01f ? e * (1.f - 0.5f * e) : flog(1.f + e)); }
constexpr int RWP_TT = 16;
constexpr int RWP_ITEMS = NT_ / RWP_TT;
DI void rwkv_prep_items(const Params& p, int l, char* smem) {
  if ((int)blockIdx.x >= RWP_ITEMS) return;
  float* zs = (float*)smem;
  float* tw = zs + RWP_TT * 1024;
  float* ta = tw + 2 * 64 * RWP_TT;
  const float* zrec = (const float*)(p.ws + OFF_REGION + R_ZREC);
  bf16_t* rb = (bf16_t*)(p.ws + OFF_REGION + R_RB16);
  float* lwo = (float*)(p.ws + OFF_REGION + R_LW);
  float* bso = (float*)(p.ws + OFF_REGION + R_BS);
  const float* mu = p.rw_mu + (size_t)l * 1152;
  const int tid = opaque_tid();
  const int col = tid & 255, d = tid >> 8;
  const float* w2 = p.rw_w2 + ((size_t)l * 2 + d) * 64 * 256 + col;
  const float* a2 = p.rw_a2 + ((size_t)l * 2 + d) * 64 * 256 + col;
  const float rkw = p.rw_r_k[(size_t)l * 256 + col];
  const float w0 = p.rw_w0[((size_t)l * 2 + d) * 256 + col], a0 = p.rw_a0[((size_t)l * 2 + d) * 256 + col];
  const float kkw = p.rw_k_k[(size_t)l * 256 + col], kaw = p.rw_k_a[(size_t)l * 256 + col];
  const size_t AS = (size_t)NT_ * 256;
#pragma unroll 1
  for (int it = blockIdx.x; it < RWP_ITEMS; it += gridDim.x) {
    const int n0 = it * RWP_TT;
    __syncthreads();
    TSB(p, 44);
#pragma unroll 1
    for (int i = 0; i < 8; ++i) {
      const int idx4 = tid + i * NTHR, tt = idx4 >> 8, c = (idx4 & 255) * 4, n = n0 + tt, t = tok_t(n);
      const int len = n < NX_ ? T_ : CL_;
      const float* zr = zrec + (size_t)n * ZREC_W + ZR_RW + c;
      const float4 z = *(const float4*)zr;
      const float4 zp = t > 0 ? *(const float4*)(zr - ZREC_W) : make_float4(0.f, 0.f, 0.f, 0.f);
      const float4 zn = t < len - 1 ? *(const float4*)(zr + ZREC_W) : make_float4(0.f, 0.f, 0.f, 0.f);
      const float4 m4 = *(const float4*)(mu + c);
      float4 sv;
      sv.x = z.x + (0.5f * (zp.x + zn.x) - z.x) * m4.x; sv.y = z.y + (0.5f * (zp.y + zn.y) - z.y) * m4.y;
      sv.z = z.z + (0.5f * (zp.z + zn.z) - z.z) * m4.z; sv.w = z.w + (0.5f * (zp.w + zn.w) - z.w) * m4.w;
      *(float4*)(zs + tt * 1024 + c) = sv;
      if (c >= 768) {
        const float e4[4] = {sv.x, sv.y, sv.z, sv.w};
#pragma unroll
        for (int q = 0; q < 4; ++q) {
          const int cc = c + q;
          if (cc < 896) { const int dd = (cc - 768) >> 6, k = (cc - 768) & 63; tw[(dd * 64 + k) * RWP_TT + tt] = 1.f - 2.f * frcp(1.f + fexp(2.f * e4[q])); }
          else { const int dd = (cc - 896) >> 6, k = (cc - 896) & 63; ta[(dd * 64 + k) * RWP_TT + tt] = e4[q]; }
        }
      }
    }
    __syncthreads();
    TSB(p, 45);
#pragma unroll 1
    for (int th = 0; th < RWP_TT; th += 8) {
      float aw[8], aa[8];
#pragma unroll
      for (int i = 0; i < 8; ++i) { aw[i] = 0.f; aa[i] = 0.f; }
#pragma unroll 1
      for (int kh = 0; kh < 4; ++kh) {
        float wr[16], ar[16];
#pragma unroll
        for (int k = 0; k < 16; ++k) { wr[k] = w2[(kh * 16 + k) * 256]; ar[k] = a2[(kh * 16 + k) * 256]; }
#pragma unroll
        for (int k = 0; k < 16; ++k) {
          const float* twk = tw + (d * 64 + kh * 16 + k) * RWP_TT + th;
          const float* tak = ta + (d * 64 + kh * 16 + k) * RWP_TT + th;
#pragma unroll
          for (int i = 0; i < 8; ++i) { aw[i] += twk[i] * wr[k]; aa[i] += tak[i] * ar[k]; }
          if ((k & 3) == 3) sched_fence();
        }
      }
#pragma unroll
      for (int i = 0; i < 8; ++i) {
        const int n = n0 + th + i;
        const float* zr = zs + (th + i) * 1024 + col;
        const float r = zr[0], k = zr[256], v = zr[512];
        const float kr = k * kkw;
        const float ss = wave_sum(kr * kr);
        const float kk = kr * frsq(fmaxf(ss, 1e-24f));
        const float w = -softplusf_(-(w0 + aw[i])) - 0.5f;
        const float logdecay = -fexp(w);
        const float a = sigmoidf_(a0 + aa[i]);
        const float kd = k * (1.f + (a - 1.f) * kaw);
        const float bsum = wave_sum(r * rkw * kd);
        const size_t o = (size_t)n * 256 + col;
        if (d == 0) { rb[0 * AS + o] = f2bf(r); rb[1 * AS + o] = f2bf(v); rb[2 * AS + o] = f2bf(kk); }
        lwo[d * AS + o] = logdecay;
        rb[(3 + 2 * d) * AS + o] = f2bf(kd);
        rb[(4 + 2 * d) * AS + o] = f2bf(kk * a);
        if ((tid & 63) == 0) bso[((size_t)d * NT_ + n) * 4 + (col >> 6)] = bsum;
      }
    }
    TSB(p, 47);
  }
}

DI int seq_tok(int dir, int b, int pos) {
  if (pos < CL_) return NX_ + b * CL_ + (dir ? CL_ - 1 - pos : pos);
  const int t = pos - CL_;
  return b * T_ + (dir ? T_ - 1 - t : t);
}
DI float logsigmoidf_(float x) { return -softplusf_(-x); }
DI float wave_incl_scan(float v, int lane) {
  for (int d = 1; d < 64; d <<= 1) { const float o = __shfl_up(v, d); if (lane >= d) v += o; }
  return v;
}
constexpr int ML_ST = 2112;
constexpr int ML1_ITEMS = NSEQ_ * NCH_;
DI void mlstm_local_item(const Params& p, int l, int it, char* smem) {
  const int s = it / NCH_, c = it % NCH_, dir = s >> 3, b = (s >> 2) & 1, hd = s & 3;
  float* vv = (float*)smem;
  float* kw = vv + 64 * 64;
  float* wej = kw + 64 * 32;
  const float* zrec = (const float*)(p.ws + OFF_REGION + R_ZREC);
  float* st = (float*)(p.ws + OFF_REGION + R_MLST) + ((size_t)s * NCH_ + c) * ML_ST;
  const int tid = opaque_tid(), lane = tid & 63, wid = tid >> 6;
  __syncthreads();
  if (wid == 0) {
    const int n = seq_tok(dir, b, c * 64 + lane);
    const float fp = zrec[(size_t)n * ZREC_W + ZR_MLF + dir * 4 + hd] + p.ml_b_f[(l * 2 + dir) * 4 + hd];
    const float ip = zrec[(size_t)n * ZREC_W + ZR_MLI + dir * 4 + hd] + p.ml_b_i[(l * 2 + dir) * 4 + hd];
    const float bj = wave_incl_scan(logsigmoidf_(fp), lane);
    const float bl = lane_bcast<63>(bj);
    const float lw = bl - bj + ip;
    const float ml = wave_max(lw);
    wej[lane] = fexp(lw - ml);
    if (lane == 0) { st[2080] = bl; st[2081] = ml; }
  }
  for (int idx = tid; idx < 64 * 64; idx += NTHR) {
    const int j = idx >> 6, e = idx & 63;
    const int n = seq_tok(dir, b, c * 64 + j);
    vv[idx] = zrec[(size_t)n * ZREC_W + ZR_MLV + hd * 64 + e];
  }
  __syncthreads();
  for (int idx = tid; idx < 64 * 32; idx += NTHR) {
    const int j = idx >> 5, e = idx & 31;
    const int n = seq_tok(dir, b, c * 64 + j);
    kw[idx] = zrec[(size_t)n * ZREC_W + ZR_MLK + hd * 32 + e] * wej[j];
  }
  __syncthreads();
  const int v = tid & 63, d0 = (tid >> 6) * 4;
  float a0 = 0.f, a1 = 0.f, a2 = 0.f, a3 = 0.f;
  for (int j = 0; j < 64; ++j) {
    const float x = vv[j * 64 + v];
    const float4 kk = *(const float4*)(kw + j * 32 + d0);
    a0 += x * kk.x; a1 += x * kk.y; a2 += x * kk.z; a3 += x * kk.w;
  }
  *(float4*)(st + v * 32 + d0) = make_float4(a0, a1, a2, a3);
  if (tid < 32) { float sn = 0.f; for (int j = 0; j < 64; ++j) sn += kw[j * 32 + tid]; st[2048 + tid] = sn; }
}
constexpr int ML2_ITEMS = (NSEQ_ * 2080 + NTHR - 1) / NTHR;
DI void mlstm_scan_item(const Params& p, int it) {
  const int g = it * NTHR + opaque_tid();
  if (g >= NSEQ_ * 2080) return;
  const int s = g / 2080, e = g % 2080;
  float* st = (float*)(p.ws + OFF_REGION + R_MLST) + (size_t)s * NCH_ * ML_ST;
  float state = 0.f, m = 0.f;
  static_assert(NCH_ % 4 == 0, "chunk count");
  for (int c0 = 0; c0 < NCH_; c0 += 4) {
    float d[4], bl[4], ml[4];
#pragma unroll
    for (int u = 0; u < 4; ++u) { const float* r = st + (size_t)(c0 + u) * ML_ST; d[u] = r[e]; bl[u] = r[2080]; ml[u] = r[2081]; }
#pragma unroll
    for (int u = 0; u < 4; ++u) {
      float* r = st + (size_t)(c0 + u) * ML_ST;
      r[e] = state;
      if (e == 0) r[2082] = m;
      const float mn = fmaxf(bl[u] + m, ml[u]);
      state = fexp(bl[u] + m - mn) * state + fexp(ml[u] - mn) * d[u];
      m = mn;
    }
  }
}

DI void phase3(const Params& p, int l, char* smem) {
  rwkv_prep_items(p, l, smem);
  for (int it = (int)gridDim.x - 1 - (int)blockIdx.x; it < ML1_ITEMS; it += gridDim.x) { TSB(p, 56); mlstm_local_item(p, l, it, smem); TSB(p, 57); }
}
constexpr int RW_LD = 72, RW_MB = 64 * RW_LD * 2;
constexpr int RWC_REC = 40960;
DI char* rw_rec(const Params& p, int s, int c) { return p.ws + OFF_REGION + R_CH + ((size_t)s * NCH_ + c) * RWC_REC; }
DI f32x16 rw_mm(const char* A, const char* Bt, int mb, int nb, int lane, f32x16 acc) {
  const int r = lane & 31, h = lane >> 5;
#pragma unroll
  for (int ks = 0; ks < 4; ++ks) {
    const bf16x8 a = *(const bf16x8*)(A + ((mb * 32 + r) * RW_LD + ks * 16 + h * 8) * 2);
    const bf16x8 b = *(const bf16x8*)(Bt + ((nb * 32 + r) * RW_LD + ks * 16 + h * 8) * 2);
    acc = mfma32(a, b, acc);
  }
  return acc;
}
DI void rw_wrT(char* Dst, int mb, int nb, int lane, const f32x16& v) {
  const int r = lane & 31, h = lane >> 5;
#pragma unroll
  for (int g = 0; g < 4; ++g) {
    uint2 o; o.x = pack2bf(v[4 * g], v[4 * g + 1]); o.y = pack2bf(v[4 * g + 2], v[4 * g + 3]);
    *(uint2*)(Dst + ((nb * 32 + r) * RW_LD + mb * 32 + 8 * g + 4 * h) * 2) = o;
  }
}
DI void rw_wrT_g(bf16_t* Dst, int mb, int nb, int lane, const f32x16& v) {
  const int r = lane & 31, h = lane >> 5;
#pragma unroll
  for (int g = 0; g < 4; ++g) {
    uint2 o; o.x = pack2bf(v[4 * g], v[4 * g + 1]); o.y = pack2bf(v[4 * g + 2], v[4 * g + 3]);
    *(uint2*)(Dst + (nb * 32 + r) * 64 + mb * 32 + 8 * g + 4 * h) = o;
  }
}
DI void rw_addT(const char* Src, int mb, int nb, int lane, f32x16& v) {
  const int r = lane & 31, h = lane >> 5;
#pragma unroll
  for (int g = 0; g < 4; ++g) {
    const uint2 u = *(const uint2*)(Src + ((nb * 32 + r) * RW_LD + mb * 32 + 8 * g + 4 * h) * 2);
    v[4 * g] += bf2f((bf16_t)(u.x & 0xffff)); v[4 * g + 1] += bf2f((bf16_t)(u.x >> 16));
    v[4 * g + 2] += bf2f((bf16_t)(u.y & 0xffff)); v[4 * g + 3] += bf2f((bf16_t)(u.y >> 16));
  }
}
DI void rw_mask_upper(f32x16& v, int mb, int nb, int lane, bool strict) {
  const int col = nb * 32 + (lane & 31), h = lane >> 5;
#pragma unroll
  for (int i = 0; i < 16; ++i) { const int row = mb * 32 + crow(i, h); if (strict ? !(row < col) : !(row <= col)) v[i] = 0.f; }
}
DI void rw_mask_lower_strict(f32x16& v, int mb, int nb, int lane) {
  const int col = nb * 32 + (lane & 31), h = lane >> 5;
#pragma unroll
  for (int i = 0; i < 16; ++i) { const int row = mb * 32 + crow(i, h); if (!(col < row)) v[i] = 0.f; }
}

constexpr int RW1_ITEMS = NSEQ_ * NCH_;
DI void rw_chunk_item(const Params& p, int it, char* smem) {
  const int s = it / NCH_, c = it % NCH_, dir = s >> 3, b = (s >> 2) & 1, hd = s & 3;
  const int tid = opaque_tid(), lane = tid & 63, wid = tid >> 6;
  const bf16_t* rb = (const bf16_t*)(p.ws + OFF_REGION + R_RB16);
  const float* lwg = (const float*)(p.ws + OFF_REGION + R_LW) + (size_t)dir * NT_ * 256;
  const size_t AS = (size_t)NT_ * 256;
  char* const At = smem + 0 * RW_MB; char* const Bt_ = smem + 1 * RW_MB; char* const Kt = smem + 2 * RW_MB; char* const Rt = smem + 3 * RW_MB;
  char* const Aj = smem + 4 * RW_MB; char* const Bj = smem + 5 * RW_MB; char* const Kj = smem + 6 * RW_MB; char* const Vi = smem + 7 * RW_MB;
  char* const QA = smem + 8 * RW_MB; char* const QTA = smem + 9 * RW_MB; char* const GA = smem + 10 * RW_MB;
  char* const Mka = smem + 11 * RW_MB; char* const MbrT = smem + 12 * RW_MB; char* const MkrT = smem + 13 * RW_MB;
  char* const QB = At; char* const QTB = Bt_; char* const GB = Kt;
  float* const cs = (float*)(smem + 8 * RW_MB);
  float* const gC = (float*)(smem + 14 * RW_MB);
  char* rec = rw_rec(p, s, c);
  __syncthreads();
  const int t = tid >> 3, j8 = (tid & 7) * 8;
  const int n = seq_tok(dir, b, c * 64 + t);
  {
    const float4 l0 = *(const float4*)(lwg + (size_t)n * 256 + hd * 64 + j8), l1 = *(const float4*)(lwg + (size_t)n * 256 + hd * 64 + j8 + 4);
    float* d = cs + t * 65 + j8;
    d[0] = l0.x; d[1] = l0.y; d[2] = l0.z; d[3] = l0.w; d[4] = l1.x; d[5] = l1.y; d[6] = l1.z; d[7] = l1.w;
  }
  __syncthreads();
  if (tid < 64) { float a = 0.f; for (int tt = 0; tt < 64; ++tt) { a += cs[tt * 65 + tid]; cs[tt * 65 + tid] = a; } gC[tid] = fexp(a); }
  __syncthreads();
  {
    const size_t o = (size_t)n * 256 + hd * 64 + j8;
    const uint4 ukk = *(const uint4*)(rb + 2 * AS + o), ubb = *(const uint4*)(rb + (4 + 2 * dir) * AS + o), ukd = *(const uint4*)(rb + (3 + 2 * dir) * AS + o);
    const uint4 ur = *(const uint4*)(rb + 0 * AS + o), uv = *(const uint4*)(rb + 1 * AS + o);
    const unsigned akk[4] = {ukk.x, ukk.y, ukk.z, ukk.w}, abb[4] = {ubb.x, ubb.y, ubb.z, ubb.w}, akd[4] = {ukd.x, ukd.y, ukd.z, ukd.w};
    const unsigned ar[4] = {ur.x, ur.y, ur.z, ur.w}, av[4] = {uv.x, uv.y, uv.z, uv.w};
    unsigned oa[4], ob[4], ok[4], orr[4];
#pragma unroll
    for (int q = 0; q < 4; ++q) {
      float fa[2], fb[2], fk[2], fr[2];
#pragma unroll
      for (int e = 0; e < 2; ++e) {
        const int j = j8 + 2 * q + e;
        const float cst = cs[t * 65 + j], csp = t > 0 ? cs[(t - 1) * 65 + j] : 0.f;
        const float g = fexp(cst), gp = fexp(csp), gi = fexp(-cst);
        const int sh = 16 * e;
        fa[e] = -bf2f((bf16_t)((akk[q] >> sh) & 0xffff)) * gp;
        fb[e] = bf2f((bf16_t)((abb[q] >> sh) & 0xffff)) * gi;
        fk[e] = bf2f((bf16_t)((akd[q] >> sh) & 0xffff)) * gi;
        fr[e] = bf2f((bf16_t)((ar[q] >> sh) & 0xffff)) * g;
        *(bf16_t*)(Aj + (j * RW_LD + t) * 2) = f2bf(fa[e]);
        *(bf16_t*)(Bj + (j * RW_LD + t) * 2) = f2bf(fb[e]);
        *(bf16_t*)(Kj + (j * RW_LD + t) * 2) = f2bf(fk[e]);
        *(bf16_t*)(Vi + (j * RW_LD + t) * 2) = (bf16_t)((av[q] >> sh) & 0xffff);
      }
      oa[q] = pack2bf(fa[0], fa[1]); ob[q] = pack2bf(fb[0], fb[1]); ok[q] = pack2bf(fk[0], fk[1]); orr[q] = pack2bf(fr[0], fr[1]);
    }
    *(uint4*)(At + (t * RW_LD + j8) * 2) = make_uint4(oa[0], oa[1], oa[2], oa[3]);
    *(uint4*)(Bt_ + (t * RW_LD + j8) * 2) = make_uint4(ob[0], ob[1], ob[2], ob[3]);
    *(uint4*)(Kt + (t * RW_LD + j8) * 2) = make_uint4(ok[0], ok[1], ok[2], ok[3]);
    *(uint4*)(Rt + (t * RW_LD + j8) * 2) = make_uint4(orr[0], orr[1], orr[2], orr[3]);
  }
  __syncthreads();
  {
    const int prod = wid >> 2, mb = (wid >> 1) & 1, nb = wid & 1;
    f32x16 acc = zero16();
    if (prod == 0) {
      if (!(mb == 1 && nb == 0)) acc = rw_mm(Bt_, At, mb, nb, lane, acc);
      rw_mask_upper(acc, mb, nb, lane, true);
      rw_wrT(QA, mb, nb, lane, acc);
      if (mb == nb) {
        const int col = nb * 32 + (lane & 31), h = lane >> 5;
#pragma unroll
        for (int i = 0; i < 16; ++i) if (mb * 32 + crow(i, h) == col) acc[i] += 1.f;
      }
      rw_wrT(GA, mb, nb, lane, acc);
    } else {
      if (!(mb == 0 && nb == 1)) acc = rw_mm(At, Bt_, mb, nb, lane, acc);
      rw_mask_lower_strict(acc, mb, nb, lane);
      rw_wrT(QTA, mb, nb, lane, acc);
    }
  }
  for (int blk = wid; blk < 12; blk += 8) {
    const int prod = blk >> 2, mb = (blk >> 1) & 1, nb = blk & 1;
    f32x16 acc = zero16();
    if (prod == 0) {
      acc = rw_mm(At, Kt, mb, nb, lane, acc); rw_mask_lower_strict(acc, mb, nb, lane); rw_wrT(Mka, mb, nb, lane, acc);
    } else if (prod == 1) {
      acc = rw_mm(Bt_, Rt, mb, nb, lane, acc); rw_mask_upper(acc, mb, nb, lane, false); rw_wrT(MbrT, mb, nb, lane, acc);
    } else {
      acc = rw_mm(Kt, Rt, mb, nb, lane, acc); rw_mask_upper(acc, mb, nb, lane, false); rw_wrT(MkrT, mb, nb, lane, acc);
    }
  }
  __syncthreads();
#define RW_SQ(Q_, Qt_, Qn_, Qtn_, blk) { const int pr_ = (blk) >> 2, mb_ = ((blk) >> 1) & 1, nb_ = (blk) & 1; f32x16 acc_ = zero16(); \
    if (pr_ == 0) { acc_ = rw_mm(Q_, Qt_, mb_, nb_, lane, acc_); rw_wrT(Qtn_, mb_, nb_, lane, acc_); } \
    else { acc_ = rw_mm(Qt_, Q_, mb_, nb_, lane, acc_); rw_wrT(Qn_, mb_, nb_, lane, acc_); } }
#define RW_GUP(Qt_, G_, Gn_, blk) { const int mb_ = ((blk) >> 1) & 1, nb_ = (blk) & 1; f32x16 acc_ = zero16(); \
    rw_addT(G_, mb_, nb_, lane, acc_); acc_ = rw_mm(Qt_, G_, mb_, nb_, lane, acc_); rw_wrT(Gn_, mb_, nb_, lane, acc_); }
  RW_SQ(QA, QTA, QB, QTB, wid);
  __syncthreads();
  for (int blk = wid; blk < 12; blk += 8) { if (blk < 8) { RW_SQ(QB, QTB, QA, QTA, blk); } else { RW_GUP(QTB, GA, GB, blk - 8); } }
  __syncthreads();
  for (int blk = wid; blk < 12; blk += 8) { if (blk < 8) { RW_SQ(QA, QTA, QB, QTB, blk); } else { RW_GUP(QTA, GB, GA, blk - 8); } }
  __syncthreads();
  for (int blk = wid; blk < 12; blk += 8) { if (blk < 8) { RW_SQ(QB, QTB, QA, QTA, blk); } else { RW_GUP(QTB, GA, GB, blk - 8); } }
  __syncthreads();
  for (int blk = wid; blk < 12; blk += 8) { if (blk < 8) { RW_SQ(QA, QTA, QB, QTB, blk); } else { RW_GUP(QTA, GB, GA, blk - 8); } }
  __syncthreads();
  if (wid < 4) { RW_GUP(QTB, GA, GB, wid); }
  __syncthreads();
  {
    const int prod = wid >> 2, mb = (wid >> 1) & 1, nb = wid & 1;
    f32x16 acc = zero16();
    acc = rw_mm(GB, prod == 0 ? Mka : Aj, mb, nb, lane, acc);
    rw_wrT(prod == 0 ? QA : QTA, mb, nb, lane, acc);
  }
  __syncthreads();
  char* const X1 = QA; char* const X2 = QTA; char* const QpT = At;
  for (int blk = wid; blk < 16; blk += 8) {
    const int prod = blk >> 2, mb = (blk >> 1) & 1, nb = blk & 1;
    f32x16 acc = zero16();
    if (prod == 0) {
      rw_addT(MkrT, mb, nb, lane, acc); acc = rw_mm(X1, MbrT, mb, nb, lane, acc); rw_mask_upper(acc, mb, nb, lane, false);
      rw_wrT_g((bf16_t*)(rec + 8192), mb, nb, lane, acc);
    } else if (prod == 1) {
      rw_addT(Rt, mb, nb, lane, acc); acc = rw_mm(X2, MbrT, mb, nb, lane, acc);
      rw_wrT_g((bf16_t*)(rec), mb, nb, lane, acc);
    } else if (prod == 2) {
      acc = rw_mm(X2, Bj, mb, nb, lane, acc);
      const int col = nb * 32 + (lane & 31), h = lane >> 5; const float gc = gC[col];
#pragma unroll
      for (int i = 0; i < 16; ++i) { if (mb * 32 + crow(i, h) == col) acc[i] += 1.f; acc[i] *= gc; }
      rw_wrT_g((bf16_t*)(rec + 16384), mb, nb, lane, acc);
    } else {
      rw_addT(Kj, mb, nb, lane, acc); acc = rw_mm(X1, Bj, mb, nb, lane, acc);
      const float gc = gC[nb * 32 + (lane & 31)];
#pragma unroll
      for (int i = 0; i < 16; ++i) acc[i] *= gc;
      rw_wrT(QpT, mb, nb, lane, acc);
    }
  }
  __syncthreads();
  if (wid < 4) {
    const int mb = (wid >> 1) & 1, nb = wid & 1, r = lane & 31, h = lane >> 5;
    f32x16 acc = zero16();
    acc = rw_mm(QpT, Vi, mb, nb, lane, acc);
    float* dq = (float*)(rec + 24576);
#pragma unroll
    for (int g = 0; g < 4; ++g)
      *(float4*)(dq + (nb * 32 + r) * 64 + mb * 32 + 8 * g + 4 * h) = make_float4(acc[4 * g], acc[4 * g + 1], acc[4 * g + 2], acc[4 * g + 3]);
  }
}

constexpr int RW2_ITEMS = NSEQ_;
constexpr int RW2_DQLD = 68;
constexpr int RW2_STAGE = RW_MB + 64 * RW2_DQLD * 4;
constexpr int RW2_GRP = 2;
static_assert(NCH_ % RW2_GRP == 0, "chunk groups");
DI void rw_state_item(const Params& p, int s, char* smem) {
  const int tid = opaque_tid(), lane = tid & 63, wid = tid >> 6, r = lane & 31, h = lane >> 5;
  f32x16 S0 = zero16(), S1 = zero16();
  u32x4 rp[RW2_GRP], rd0[RW2_GRP], rd1[RW2_GRP];
  const int prow = tid >> 3, pcol = (tid & 7) * 8;
#define RW2_LOAD(g_) { _Pragma("unroll") for (int u = 0; u < RW2_GRP; ++u) { const char* rec_ = rw_rec(p, s, (g_) * RW2_GRP + u); \
    rp[u] = *(const u32x4*)(rec_ + 16384 + (prow * 64 + pcol) * 2); \
    rd0[u] = *(const u32x4*)(rec_ + 24576 + (prow * 64 + pcol) * 4); rd1[u] = *(const u32x4*)(rec_ + 24576 + (prow * 64 + pcol + 4) * 4); } }
#define RW2_STORE(buf_) { _Pragma("unroll") for (int u = 0; u < RW2_GRP; ++u) { char* d_ = smem + ((buf_) * RW2_GRP + u) * RW2_STAGE; \
    *(u32x4*)(d_ + (prow * RW_LD + pcol) * 2) = rp[u]; \
    *(u32x4*)(d_ + RW_MB + (prow * RW2_DQLD + pcol) * 4) = rd0[u]; *(u32x4*)(d_ + RW_MB + (prow * RW2_DQLD + pcol + 4) * 4) = rd1[u]; } }
  __syncthreads();
  RW2_LOAD(0); RW2_STORE(0);
  __syncthreads();
  constexpr int NG = NCH_ / RW2_GRP;
  for (int g = 0; g < NG; ++g) {
    { const int gn = g + 1 < NG ? g + 1 : g; RW2_LOAD(gn); }
    sched_fence();
    if (wid < 2) {
#pragma unroll
      for (int u = 0; u < RW2_GRP; ++u) {
        const int c = g * RW2_GRP + u;
        const char* PT = smem + ((g & 1) * RW2_GRP + u) * RW2_STAGE;
        const float* DQ = (const float*)(PT + RW_MB);
        const int i = wid * 32 + r;
        bf16_t* sd = (bf16_t*)(rw_rec(p, s, c) + 16384);
#pragma unroll
        for (int q = 0; q < 4; ++q) {
          uint2 o0, o1;
          o0.x = pack2bf(S0[4 * q], S0[4 * q + 1]); o0.y = pack2bf(S0[4 * q + 2], S0[4 * q + 3]);
          o1.x = pack2bf(S1[4 * q], S1[4 * q + 1]); o1.y = pack2bf(S1[4 * q + 2], S1[4 * q + 3]);
          *(uint2*)(sd + i * 64 + 8 * q + 4 * h) = o0; *(uint2*)(sd + i * 64 + 32 + 8 * q + 4 * h) = o1;
        }
        bf16x8 bfr[2][2];
#pragma unroll
        for (int s2 = 0; s2 < 2; ++s2) {
          const u32x4 u0 = {pack2bf(S0[8 * s2], S0[8 * s2 + 1]), pack2bf(S0[8 * s2 + 2], S0[8 * s2 + 3]), pack2bf(S0[8 * s2 + 4], S0[8 * s2 + 5]), pack2bf(S0[8 * s2 + 6], S0[8 * s2 + 7])};
          const u32x4 u1 = {pack2bf(S1[8 * s2], S1[8 * s2 + 1]), pack2bf(S1[8 * s2 + 2], S1[8 * s2 + 3]), pack2bf(S1[8 * s2 + 4], S1[8 * s2 + 5]), pack2bf(S1[8 * s2 + 6], S1[8 * s2 + 7])};
          __builtin_memcpy(&bfr[0][s2], &u0, 16); __builtin_memcpy(&bfr[1][s2], &u1, 16);
        }
        f32x16 n0, n1;
#pragma unroll
        for (int q = 0; q < 4; ++q) {
          const float4 a = *(const float4*)(DQ + i * RW2_DQLD + 8 * q + 4 * h), bq = *(const float4*)(DQ + i * RW2_DQLD + 32 + 8 * q + 4 * h);
          n0[4 * q] = a.x; n0[4 * q + 1] = a.y; n0[4 * q + 2] = a.z; n0[4 * q + 3] = a.w;
          n1[4 * q] = bq.x; n1[4 * q + 1] = bq.y; n1[4 * q + 2] = bq.z; n1[4 * q + 3] = bq.w;
        }
#pragma unroll
        for (int jb2 = 0; jb2 < 2; ++jb2)
#pragma unroll
          for (int s2 = 0; s2 < 2; ++s2) {
            const char* a0 = PT + ((0 * 32 + r) * RW_LD + jb2 * 32 + 16 * s2 + 4 * h) * 2;
            const char* a1 = PT + ((1 * 32 + r) * RW_LD + jb2 * 32 + 16 * s2 + 4 * h) * 2;
            const uint2 l0 = *(const uint2*)a0, h0 = *(const uint2*)(a0 + 16), l1 = *(const uint2*)a1, h1 = *(const uint2*)(a1 + 16);
            const u32x4 u0 = {l0.x, l0.y, h0.x, h0.y}, u1 = {l1.x, l1.y, h1.x, h1.y};
            bf16x8 af0, af1; __builtin_memcpy(&af0, &u0, 16); __builtin_memcpy(&af1, &u1, 16);
            n0 = mfma32(af0, bfr[jb2][s2], n0);
            n1 = mfma32(af1, bfr[jb2][s2], n1);
          }
        S0 = n0; S1 = n1;
      }
    }
    sched_fence();
    RW2_STORE((g + 1) & 1);
    __syncthreads();
  }
}

DI void rw_out_item(const Params& p, int it, char* smem) {
  const int s = it / NCH_, c = it % NCH_, dir = s >> 3, b = (s >> 2) & 1, hd = s & 3;
  const int tid = opaque_tid(), lane = tid & 63, wid = tid >> 6;
  const bf16_t* rb = (const bf16_t*)(p.ws + OFF_REGION + R_RB16);
  const size_t AS = (size_t)NT_ * 256;
  float* ys = (float*)(p.ws + OFF_REGION + R_YS) + (size_t)dir * NT_ * 256;
  char* const Sm = smem; char* const RyT = smem + RW_MB; char* const MyT = smem + 2 * RW_MB; char* const Vi = smem + 3 * RW_MB;
  const char* rec = rw_rec(p, s, c);
  __syncthreads();
  {
    const int row = tid >> 3, col = (tid & 7) * 8;
    *(uint4*)(Sm + (row * RW_LD + col) * 2) = *(const uint4*)(rec + 16384 + (row * 64 + col) * 2);
    *(uint4*)(RyT + (row * RW_LD + col) * 2) = *(const uint4*)(rec + (row * 64 + col) * 2);
    *(uint4*)(MyT + (row * RW_LD + col) * 2) = *(const uint4*)(rec + 8192 + (row * 64 + col) * 2);
    const int n = seq_tok(dir, b, c * 64 + row);
    const uint4 uv = *(const uint4*)(rb + 1 * AS + (size_t)n * 256 + hd * 64 + col);
    const unsigned av[4] = {uv.x, uv.y, uv.z, uv.w};
#pragma unroll
    for (int q = 0; q < 4; ++q) {
      *(bf16_t*)(Vi + ((col + 2 * q) * RW_LD + row) * 2) = (bf16_t)(av[q] & 0xffff);
      *(bf16_t*)(Vi + ((col + 2 * q + 1) * RW_LD + row) * 2) = (bf16_t)(av[q] >> 16);
    }
  }
  __syncthreads();
  if (wid < 4) {
    const int mb = (wid >> 1) & 1, nb = wid & 1, r = lane & 31, h = lane >> 5;
    f32x16 acc = zero16();
    acc = rw_mm(Sm, RyT, mb, nb, lane, acc);
    acc = rw_mm(Vi, MyT, mb, nb, lane, acc);
    const int n = seq_tok(dir, b, c * 64 + nb * 32 + r);
#pragma unroll
    for (int g = 0; g < 4; ++g)
      *(float4*)(ys + (size_t)n * 256 + hd * 64 + mb * 32 + 8 * g + 4 * h) = make_float4(acc[4 * g], acc[4 * g + 1], acc[4 * g + 2], acc[4 * g + 3]);
  }
}
constexpr int ATT_KLD = 104, ATT_VLD = 68;
constexpr int ATT_KB = 64 * ATT_KLD * 2, ATT_VB = 64 * ATT_VLD * 2, ATT_STAGE = ATT_KB + ATT_VB;
DI float fexp2(float x) {
#ifdef EMU
  return exp2f(x);
#else
  return __builtin_amdgcn_exp2f(x);
#endif
}
#ifdef ABL_NOPV
#define ABL_PV_BEGIN if (t > 100000) {
#define ABL_PV_END }
#else
#define ABL_PV_BEGIN
#define ABL_PV_END
#endif
#define ABL_LOADS2(s_, tk, tv) ATT_LOADK(s_, tk); ATT_LOADV(s_, tv);
#ifdef ABL_NOEXP
#define ABL_EXP(x) (x)
#else
#define ABL_EXP(x) fexp2(x)
#endif
constexpr int ATT_LDS = 2 * ATT_KB + 2 * ATT_VB;
DI void attn_item(const Params& p, int b, int h, int qt, bool isctx, char* smem) {
  const int tid = opaque_tid(), lane = tid & 63, wid = tid >> 6, r = lane & 31, h2 = lane >> 5;
  const bf16_t* qb = (const bf16_t*)(p.osc + O_QB);
  const bf16_t* kbase = (const bf16_t*)(p.ws + OFF_REGION + R_KB) + (size_t)(b * 8 + h) * KT_ * 96;
  const bf16_t* vbase = (const bf16_t*)(p.ws + OFF_REGION + R_VT) + (size_t)(b * 8 + h) * 64 * KT_;
  bf16_t* att = (bf16_t*)(p.ws + OFF_REGION + R_ATT);
  const int nq0 = isctx ? NX_ + b * CL_ + qt * 256 : b * T_ + qt * 256;
  const int nkt = (isctx ? CL_ : KT_) / 64;
  const int nq = nq0 + wid * 32 + r;
  bf16x8 qf[6];
#pragma unroll
  for (int ks = 0; ks < 6; ++ks) qf[ks] = *(const bf16x8*)(qb + (size_t)nq * 768 + h * 96 + ks * 16 + h2 * 8);
  f32x16 oacc[2] = {zero16(), zero16()};
  float m = -1e30f, lsum = 0.f;
  const float sc = 0.10206207261596577f * 1.4426950408889634f;
  char* const Kst = smem;
  char* const Vst = smem + 2 * ATT_KB;
  const int kc1 = tid + 512, vd = tid >> 3, vc = tid & 7;
  const int ko0 = ((tid / 12) * ATT_KLD + (tid % 12) * 8) * 2, ko1 = ((kc1 / 12) * ATT_KLD + (kc1 % 12) * 8) * 2;
  const int vo = (vd * ATT_VLD + vc * 8) * 2;
  u32x4 ak0, ak1 = {0u, 0u, 0u, 0u}, av, bk0, bk1 = {0u, 0u, 0u, 0u}, bv;
#define ATT_LOADK(s_, kt_) { const bf16_t* ksrc_ = kbase + (size_t)(kt_) * 64 * 96; s_##k0 = *(const u32x4*)(ksrc_ + tid * 8); if (kc1 < 768) s_##k1 = *(const u32x4*)(ksrc_ + kc1 * 8); }
#define ATT_LOADV(s_, kt_) { s_##v = *(const u32x4*)(vbase + (size_t)vd * KT_ + (kt_) * 64 + vc * 8); }
#define ATT_STOREK(s_, st_) { char* d_ = Kst + (st_) * ATT_KB; *(u32x4*)(d_ + ko0) = s_##k0; if (kc1 < 768) *(u32x4*)(d_ + ko1) = s_##k1; }
#define ATT_STOREV(s_, st_) { char* d_ = Vst + (st_) * ATT_VB; *(uint2*)(d_ + vo) = make_uint2(s_##v[0], s_##v[1]); *(uint2*)(d_ + vo + 8) = make_uint2(s_##v[2], s_##v[3]); }
#define ATT_QK(dst_, st_) { const char* Ks_ = Kst + (st_) * ATT_KB; dst_[0] = zero16(); dst_[1] = zero16(); \
    _Pragma("unroll") for (int ks = 0; ks < 6; ++ks) _Pragma("unroll") for (int kb = 0; kb < 2; ++kb) { \
      const bf16x8 kf_ = *(const bf16x8*)(Ks_ + ((kb * 32 + r) * ATT_KLD + ks * 16 + h2 * 8) * 2); dst_[kb] = mfma32(kf_, qf[ks], dst_[kb]); } }
  __syncthreads();
  ATT_LOADK(a, 0); ATT_LOADV(a, 0); ATT_STOREK(a, 0); ATT_STOREV(a, 0);
  ATT_LOADK(a, 1); ATT_STOREK(a, 1);
  ATT_LOADK(a, (2 < nkt ? 2 : nkt - 1)); ATT_LOADV(a, 1);
  __syncthreads();
  f32x16 sA[2], sB[2];
  ATT_QK(sA, 0);
  __syncthreads();
#define ATT_SMPV(cur_, t) { \
    float mx = -1e30f; \
    _Pragma("unroll") for (int kb = 0; kb < 2; ++kb) _Pragma("unroll") for (int i = 0; i < 16; ++i) mx = fmaxf(mx, cur_[kb][i]); \
    mx = fmaxf(mx, __shfl_xor(mx, 32)); \
    const float mn = fmaxf(m, mx * sc); \
    if (__ballot(mn > m) != 0ull) { \
      const float alpha = fexp2(m - mn); \
      _Pragma("unroll") for (int db = 0; db < 2; ++db) _Pragma("unroll") for (int i = 0; i < 16; ++i) oacc[db][i] *= alpha; \
      lsum *= alpha; m = mn; } \
    _Pragma("unroll") for (int kb = 0; kb < 2; ++kb) _Pragma("unroll") for (int i = 0; i < 16; ++i) cur_[kb][i] = ABL_EXP(cur_[kb][i] * sc - m); \
    { float ps0 = 0.f, ps1 = 0.f; _Pragma("unroll") for (int i = 0; i < 16; ++i) { ps0 += cur_[0][i]; ps1 += cur_[1][i]; } lsum += ps0 + ps1; } \
    const char* Vs = Vst + ((t) & 1) * ATT_VB; \
    _Pragma("unroll") for (int kb = 0; kb < 2; ++kb) _Pragma("unroll") for (int s2 = 0; s2 < 2; ++s2) { \
      bf16x8 pf; { const u32x4 u = {pack2bf(cur_[kb][8 * s2 + 0], cur_[kb][8 * s2 + 1]), pack2bf(cur_[kb][8 * s2 + 2], cur_[kb][8 * s2 + 3]), \
                                    pack2bf(cur_[kb][8 * s2 + 4], cur_[kb][8 * s2 + 5]), pack2bf(cur_[kb][8 * s2 + 6], cur_[kb][8 * s2 + 7])}; __builtin_memcpy(&pf, &u, 16); } \
      ABL_PV_BEGIN \
      _Pragma("unroll") for (int db = 0; db < 2; ++db) { \
        const char* vrow = Vs + ((db * 32 + r) * ATT_VLD + kb * 32 + 16 * s2 + 4 * h2) * 2; \
        const uint2 lo = *(const uint2*)(vrow), hi = *(const uint2*)(vrow + 16); \
        const u32x4 u = {lo.x, lo.y, hi.x, hi.y}; bf16x8 vf; __builtin_memcpy(&vf, &u, 16); \
        oacc[db] = mfma32(vf, pf, oacc[db]); } ABL_PV_END } }
#define ATT_STEP(cur_, nxt_, t_, w_, l_) { \
    const int t = (t_); \
    const int tk = t + 3 < nkt ? t + 3 : nkt - 1, tv = t + 2 < nkt ? t + 2 : nkt - 1; \
    ABL_LOADS2(l_, tk, tv) \
    ATT_STOREK(w_, t & 1); ATT_STOREV(w_, (t + 1) & 1);        \
    sched_fence(); \
    if (first_half) { ATT_QK(nxt_, (t + 1) & 1); sched_fence(); ATT_SMPV(cur_, t); } \
    else { ATT_SMPV(cur_, t); sched_fence(); ATT_QK(nxt_, (t + 1) & 1); } \
    sched_fence(); \
    __syncthreads(); }
  const bool first_half = rfl(wid) < 4;
  for (int t0 = 0; t0 < nkt; t0 += 2) {
    ATT_STEP(sA, sB, t0, a, b);
    ATT_STEP(sB, sA, t0 + 1, b, a);
  }
  lsum += __shfl_xor(lsum, 32);
  const float inv = 1.f / lsum;
#pragma unroll
  for (int db = 0; db < 2; ++db)
#pragma unroll
    for (int g = 0; g < 4; ++g) {
      uint2 o;
      o.x = pack2bf(oacc[db][g * 4 + 0] * inv, oacc[db][g * 4 + 1] * inv);
      o.y = pack2bf(oacc[db][g * 4 + 2] * inv, oacc[db][g * 4 + 3] * inv);
      *(uint2*)(att + (size_t)nq * 512 + h * 64 + db * 32 + 8 * g + 4 * h2) = o;
    }
}

DI constexpr int att_items(int l) { return NB_ * 8 * (T_ / 256) + (l == 0 ? NB_ * 8 * (CL_ / 256) : 0); }
DI void spin_until_ge(int* ctr, int target) {
#ifdef EMU
  while (__atomic_load_n(ctr, __ATOMIC_SEQ_CST) < target) emu::yield();
#else
  while (__hip_atomic_load(ctr, __ATOMIC_RELAXED, __HIP_MEMORY_SCOPE_AGENT) < target) __builtin_amdgcn_s_sleep(8);
#endif
}
constexpr int P3B_ITEMS = RW1_ITEMS + ML2_ITEMS + MLA_Q_TILES + MLA_KV_TILES;
DI void phase3b(const Params& p, int l, char* smem, int* ctr) {
  for (int it = vblock(); it < P3B_ITEMS; it += gridDim.x) {
    int i = it;
    if (i < RW1_ITEMS) { TSB(p, 58); rw_chunk_item(p, i, smem); TSB(p, 59); continue; }
    i -= RW1_ITEMS;
    if (i < ML2_ITEMS) { mlstm_scan_item(p, i); continue; }
    i -= ML2_ITEMS;
    TSB(p, 60);
    if (i < MLA_Q_TILES) mla_q_item(p, l, i, smem); else mla_kv_item(p, l, i - MLA_Q_TILES, smem);
    TSB(p, 61);
  }
}

DI void phase4(const Params& p, int l, char* smem, int* ctr) {
  const int G = gridDim.x, nsb = G >= 2 * RW2_ITEMS ? RW2_ITEMS : (G > 1 ? G / 2 : 1);
  if ((int)blockIdx.x < nsb) {
    TSB(p, 50);
    for (int s = blockIdx.x; s < RW2_ITEMS; s += nsb) rw_state_item(p, s, smem);
#ifndef EMU
    asm volatile("s_waitcnt vmcnt(0)" ::: "memory");
#endif
    __syncthreads();
    if (opaque_tid() == 0) { __threadfence(); atomicAdd(ctr + 2, (RW2_ITEMS - (int)blockIdx.x + nsb - 1) / nsb); }
    TSB(p, 51);
  }
  const int QT = T_ / 256, CQ = (l == 0 ? (NB_ * 8 * (CL_ / 256)) / 8 : 0), R3 = RW1_ITEMS / 8;
  const int per = 2 * QT + CQ + R3;
  int* sitem = (int*)(smem + 160 * 1024 - 16);
  bool r2ok = false;
  const int x0 = xcc_id();
  for (;;) {
    __syncthreads();
    if (opaque_tid() == 0) {
      int item = -1;
      for (int k = 0; k < 8 && item < 0; ++k) {
        const int x = (x0 + k) & 7;
        if (ld_relaxed(ctr + 8 + x) >= per) continue;
        const int li = atomicAdd(ctr + 8 + x, 1);
        if (li < per) item = x * per + li;
      }
      *sitem = item;
    }
    __syncthreads();
    const int item = *sitem;
    if (item < 0) break;
    const int x = item / per; int li = item % per;
    if (li < 2 * QT) { const int bh = 2 * x + li / QT, qt = li % QT; TSB(p, 54); attn_item(p, bh >> 3, bh & 7, qt, false, smem); TSB(p, 55); continue; }
    li -= 2 * QT;
    if (li < CQ) { const int ci = x * CQ + li, qt = ci % (CL_ / 256), bh = ci / (CL_ / 256); attn_item(p, bh >> 3, bh & 7, qt, true, smem); continue; }
    li -= CQ;
    if (!r2ok) {
      if (opaque_tid() == 0) { spin_until_ge(ctr + 2, RW2_ITEMS); __threadfence(); }
      __syncthreads();
      r2ok = true;
    }
    rw_out_item(p, x * R3 + li, smem);
  }
}
constexpr int ML3_CC = CL_ / 64, ML3_XC = T_ / 64;
DI constexpr int ml3_items(bool with_ctx) { return NB_ * 4 * (ML3_XC + (with_ctx ? ML3_CC : 0)); }
template <int KS> DI f32x16 ml_mm(const char* A, const char* Bt, int mb, int nb, int lane, f32x16 acc) {
  const int r = lane & 31, h = lane >> 5;
#pragma unroll
  for (int ks = 0; ks < KS; ++ks) {
    const bf16x8 a = *(const bf16x8*)(A + ((mb * 32 + r) * RW_LD + ks * 16 + h * 8) * 2);
    const bf16x8 b = *(const bf16x8*)(Bt + ((nb * 32 + r) * RW_LD + ks * 16 + h * 8) * 2);
    acc = mfma32(a, b, acc);
  }
  return acc;
}
DI float wave_incl_scan_max(float v, int lane) {
  for (int d = 1; d < 64; d <<= 1) { const float o = __shfl_up(v, d); if (lane >= d) v = fmaxf(v, o); }
  return v;
}
DI void mlstm_out_item(const Params& p, int l, int it, bool with_ctx, char* smem) {
  const int per = ML3_XC + (with_ctx ? ML3_CC : 0);
  const int bh = it / per, b = bh >> 2, hd = bh & 3;
  int tc = it % per; if (!with_ctx) tc += ML3_CC;
  const bool isctx = tc < ML3_CC;
  const int ntok0 = isctx ? NX_ + b * CL_ + tc * 64 : b * T_ + (tc - ML3_CC) * 64;
  char* const Qm = smem;
  char* const Km = smem + 1 * RW_MB;
  char* const Qp = smem + 2 * RW_MB;
  char* const Vi = smem + 3 * RW_MB;
  char* const Pp = smem + 4 * RW_MB;
  char* const Cm = smem + 5 * RW_MB;
  float* const hs = (float*)(smem + 6 * RW_MB);
  float* const ga = hs + 64 * 64;
  float* const denp = ga + 5 * 64;
  float* const nsv = denp + 128;
  const float* zrec = (const float*)(p.ws + OFF_REGION + R_ZREC);
  const int tid = opaque_tid(), lane = tid & 63, wid = tid >> 6;
  __syncthreads();
  for (int idx = tid; idx < 64 * 64; idx += NTHR) hs[idx] = 0.f;
#pragma unroll 1
  for (int dir = 0; dir < 2; ++dir) {
    const int c = dir == 0 ? tc : (isctx ? ML3_CC - 1 - tc : ML3_CC + (ML3_XC - 1 - (tc - ML3_CC)));
    const int s = dir * 8 + b * 4 + hd;
    const float* st = (const float*)(p.ws + OFF_REGION + R_MLST) + ((size_t)s * NCH_ + c) * ML_ST;
    const float m_start = st[2082];
    __syncthreads();
    {
      const int j = tid >> 3, pt = tid & 7;
      const int n = ntok0 + (dir ? 63 - j : j);
      const float* zr = zrec + (size_t)n * ZREC_W;
      const float4 q4 = *(const float4*)(zr + ZR_MLQ + hd * 32 + pt * 4), k4 = *(const float4*)(zr + ZR_MLK + hd * 32 + pt * 4);
      const float4 c4 = *(const float4*)(st + j * 32 + pt * 4);
      const float4 va = *(const float4*)(zr + ZR_MLV + hd * 64 + pt * 8), vb = *(const float4*)(zr + ZR_MLV + hd * 64 + pt * 8 + 4);
      const float qs = 0.17677669529663687f;
      const float q0 = q4.x * qs, q1 = q4.y * qs, q2 = q4.z * qs, q3 = q4.w * qs;
      *(uint2*)(Qm + (j * RW_LD + pt * 4) * 2) = make_uint2(pack2bf(q0, q1), pack2bf(q2, q3));
      *(uint2*)(Km + (j * RW_LD + pt * 4) * 2) = make_uint2(pack2bf(k4.x, k4.y), pack2bf(k4.z, k4.w));
      *(uint2*)(Cm + (j * RW_LD + pt * 4) * 2) = make_uint2(pack2bf(c4.x, c4.y), pack2bf(c4.z, c4.w));
      const float vv[8] = {va.x, va.y, va.z, va.w, vb.x, vb.y, vb.z, vb.w};
#pragma unroll
      for (int u = 0; u < 8; ++u) *(bf16_t*)(Vi + ((pt * 8 + u) * RW_LD + j) * 2) = f2bf(vv[u]);
      if (tid < 32) nsv[tid] = st[2048 + tid];
      const float4 n4 = *(const float4*)(st + 2048 + pt * 4);
      float nq = n4.x * q0 + n4.y * q1 + n4.z * q2 + n4.w * q3;
      nq += __shfl_xor(nq, 1); nq += __shfl_xor(nq, 2); nq += __shfl_xor(nq, 4);
      if (pt == 0) ga[4 * 64 + j] = nq;
    }
    if (wid == 0) {
      const int n = ntok0 + (dir ? 63 - lane : lane);
      const float fp = zrec[(size_t)n * ZREC_W + ZR_MLF + dir * 4 + hd] + p.ml_b_f[(l * 2 + dir) * 4 + hd];
      const float ipre = zrec[(size_t)n * ZREC_W + ZR_MLI + dir * 4 + hd] + p.ml_b_i[(l * 2 + dir) * 4 + hd];
      const float bj = wave_incl_scan(logsigmoidf_(fp), lane);
      const float g = ipre - bj;
      const float pm = wave_incl_scan_max(g, lane);
      const float c0 = wave_max(g);
      const float mj = fmaxf(bj + m_start, bj + pm);
      ga[0 * 64 + lane] = fexp(g - c0);
      ga[1 * 64 + lane] = fexp(fminf(bj + c0 - mj, 80.f));
      ga[2 * 64 + lane] = fexp(bj + m_start - mj);
      ga[3 * 64 + lane] = fexp(fminf(-mj, 80.f));
    }
    __syncthreads();
    if (wid < 4) {
      const int mb = wid >> 1, nb = wid & 1, r = lane & 31, h = lane >> 5;
      f32x16 acc = zero16();
      if (!(mb == 1 && nb == 0)) acc = ml_mm<2>(Km, Qm, mb, nb, lane, acc);
      rw_mask_upper(acc, mb, nb, lane, false);
      const float al = ga[1 * 64 + nb * 32 + r];
      float csum = 0.f;
#pragma unroll
      for (int i = 0; i < 16; ++i) { acc[i] *= ga[0 * 64 + mb * 32 + crow(i, h)] * al; csum += acc[i]; }
      csum += __shfl_xor(csum, 32);
      if (h == 0) denp[mb * 64 + nb * 32 + r] = csum;
      rw_wrT(Pp, mb, nb, lane, acc);
    } else {
      const int t2 = tid - 256, j = t2 >> 2, d8 = (t2 & 3) * 8;
      const float in = ga[2 * 64 + j];
      const uint4 u = *(const uint4*)(Qm + (j * RW_LD + d8) * 2);
      const unsigned w[4] = {u.x, u.y, u.z, u.w};
      unsigned o[4];
#pragma unroll
      for (int q = 0; q < 4; ++q) o[q] = pack2bf(bf2f((bf16_t)(w[q] & 0xffff)) * in, bf2f((bf16_t)(w[q] >> 16)) * in);
      *(uint4*)(Qp + (j * RW_LD + d8) * 2) = make_uint4(o[0], o[1], o[2], o[3]);
    }
    __syncthreads();
    if (wid < 4) {
      const int mb = wid >> 1, nb = wid & 1, r = lane & 31, h = lane >> 5;
      f32x16 acc = zero16();
      acc = ml_mm<4>(Vi, Pp, mb, nb, lane, acc);
      acc = ml_mm<2>(Cm, Qp, mb, nb, lane, acc);
      const int j = nb * 32 + r;
      const float den = denp[j] + denp[64 + j] + ga[2 * 64 + j] * ga[4 * 64 + j];
      const float rden = frcp(fmaxf(fabsf(den), ga[3 * 64 + j]));
      float* hrow = hs + (dir ? 63 - j : j) * 64 + mb * 32 + 4 * h;
#pragma unroll
      for (int g4 = 0; g4 < 4; ++g4) {
        float4 o = *(float4*)(hrow + 8 * g4);
        o.x += acc[4 * g4] * rden; o.y += acc[4 * g4 + 1] * rden; o.z += acc[4 * g4 + 2] * rden; o.w += acc[4 * g4 + 3] * rden;
        *(float4*)(hrow + 8 * g4) = o;
      }
    }
  }
  __syncthreads();
  const int tk = tid >> 3, v0 = (tid & 7) * 8, n = ntok0 + tk;
  float ss = 0.f; float hv[8];
#pragma unroll
  for (int u = 0; u < 8; ++u) { hv[u] = hs[tk * 64 + v0 + u]; ss += hv[u] * hv[u]; }
  ss += __shfl_xor(ss, 1); ss += __shfl_xor(ss, 2); ss += __shfl_xor(ss, 4);
  const float rs = frsq(ss * (1.f / 64.f) + 1e-6f);
  unsigned o[4];
#pragma unroll
  for (int u = 0; u < 8; u += 2) {
    const int cc = hd * 64 + v0 + u;
    const float a = hv[u] * rs * p.ml_g_norm[l * 256 + cc] * sigmoidf_(zrec[(size_t)n * ZREC_W + ZR_MLO + cc]);
    const float bq = hv[u + 1] * rs * p.ml_g_norm[l * 256 + cc + 1] * sigmoidf_(zrec[(size_t)n * ZREC_W + ZR_MLO + cc + 1]);
    o[u >> 1] = pack2bf(a, bq);
  }
  bf16_t* mlo = (bf16_t*)(p.ws + OFF_REGION + R_MLO);
  *(uint4*)(mlo + (size_t)n * 256 + hd * 64 + v0) = make_uint4(o[0], o[1], o[2], o[3]);
}

DI constexpr int rwo_items(bool with_ctx) { return (with_ctx ? NT_ : NX_) / 16; }
DI void rwkv_out_item(const Params& p, int l, int it, char* smem) {
  float* sg = (float*)smem;
  const float* zrec = (const float*)(p.ws + OFF_REGION + R_ZREC);
  const bf16_t* rb = (const bf16_t*)(p.ws + OFF_REGION + R_RB16);
  const float* bso = (const float*)(p.ws + OFF_REGION + R_BS);
  const float* ys = (const float*)(p.ws + OFF_REGION + R_YS);
  bf16_t* rwo = (bf16_t*)(p.ws + OFF_REGION + R_RWO);
  const float* mu = p.rw_mu + (size_t)l * 1152;
  const int tid = opaque_tid(), n0 = it * 16;
  __syncthreads();
  {
    const int tt = tid >> 5, k4 = (tid & 31) * 4, n = n0 + tt, t = tok_t(n), c = 1024 + k4;
    const int len = n < NX_ ? T_ : CL_;
    const float* zr = zrec + (size_t)n * ZREC_W + ZR_RW + c;
    const float4 z = *(const float4*)zr;
    const float4 zp = t > 0 ? *(const float4*)(zr - ZREC_W) : make_float4(0.f, 0.f, 0.f, 0.f);
    const float4 zn = t < len - 1 ? *(const float4*)(zr + ZREC_W) : make_float4(0.f, 0.f, 0.f, 0.f);
    const float4 m4 = *(const float4*)(mu + c);
    sg[(k4 + 0) * 16 + tt] = sigmoidf_(z.x + (0.5f * (zp.x + zn.x) - z.x) * m4.x);
    sg[(k4 + 1) * 16 + tt] = sigmoidf_(z.y + (0.5f * (zp.y + zn.y) - z.y) * m4.y);
    sg[(k4 + 2) * 16 + tt] = sigmoidf_(z.z + (0.5f * (zp.z + zn.z) - z.z) * m4.z);
    sg[(k4 + 3) * 16 + tt] = sigmoidf_(z.w + (0.5f * (zp.w + zn.w) - z.w) * m4.w);
  }
  __syncthreads();
  const int col = tid & 255, half = tid >> 8;
  float acc[8];
#pragma unroll
  for (int i = 0; i < 8; ++i) acc[i] = 0.f;
  const float* g2 = p.rw_g2 + (size_t)l * 128 * 256 + col;
#pragma unroll 1
  for (int kh = 0; kh < 8; ++kh) {
    float gr[16];
#pragma unroll
    for (int k = 0; k < 16; ++k) gr[k] = g2[(kh * 16 + k) * 256];
#pragma unroll
    for (int k = 0; k < 16; ++k) {
      const float* sk = sg + (kh * 16 + k) * 16 + half * 8;
#pragma unroll
      for (int i = 0; i < 8; ++i) acc[i] += sk[i] * gr[k];
      if ((k & 3) == 3) sched_fence();
    }
  }
  const size_t AS = (size_t)NT_ * 256;
  const float lw = p.rw_lnx_w[(size_t)l * 256 + col], lb = p.rw_lnx_b[(size_t)l * 256 + col];
  float yv[8], vv[8], bsv[8];
#pragma unroll
  for (int i = 0; i < 8; ++i) {
    const int n = n0 + half * 8 + i;
    const size_t o = (size_t)n * 256 + col;
    yv[i] = ys[o] + ys[AS + o];
    vv[i] = bf2f(rb[1 * AS + o]);
    bsv[i] = bso[(size_t)n * 4 + (col >> 6)] + bso[((size_t)NT_ + n) * 4 + (col >> 6)];
  }
#pragma unroll
  for (int i = 0; i < 8; ++i) {
    const int n = n0 + half * 8 + i;
    const size_t o = (size_t)n * 256 + col;
    const float y = yv[i];
    const float mean = wave_sum(y) * (1.f / 64.f);
    const float dv = y - mean;
    const float var = wave_sum(dv * dv) * (1.f / 64.f);
    const float yn = dv * (frsq(var + 64e-5f)) * lw + lb;
    rwo[o] = f2bf((yn + bsv[i] * vv[i]) * acc[i]);
  }
}
DI void phase5(const Params& p, int l, bool with_ctx, char* smem) {
  const int n1 = ml3_items(with_ctx), n2 = rwo_items(with_ctx), G = gridDim.x;
  for (int it = blockIdx.x; it < n1; it += G) { TSB(p, 62); mlstm_out_item(p, l, it, with_ctx, smem); TSB(p, 63); }
  for (int it = G - 1 - (int)blockIdx.x; it < n2; it += G) { TSB(p, 64); rwkv_out_item(p, l, it, smem); TSB(p, 65); }
}
typedef Gemm<256, 128, 64, 4, 2> G2;
template <class G> DI void merge_tile(const Params& p, int l, int row0, int col0, char* smem) {
  const bf16_t* H = (const bf16_t*)(p.ws + OFF_H);
  const char* W = p.ws + OFF_WMIX + (size_t)l * WM_SIZE;
  const bf16_t* Wg = (const bf16_t*)(W + WM_GATE);
  const bf16_t* att = (const bf16_t*)(p.ws + OFF_REGION + R_ATT);
  const bf16_t* mlo = (const bf16_t*)(p.ws + OFF_REGION + R_MLO);
  const bf16_t* rwo = (const bf16_t*)(p.ws + OFF_REGION + R_RWO);
  bf16_t* ymix = (bf16_t*)(p.osc + O_YMIX);
  const int tid = opaque_tid();
  __syncthreads();
  unsigned ypk[G::MB][G::NB][8];
  f32x16 acc[G::MB][G::NB];
#pragma unroll 1
  for (int i = 0; i < 3; ++i) {
    unsigned sg[G::MB][G::NB][8];
#pragma unroll
    for (int a = 0; a < G::MB; ++a)
#pragma unroll
      for (int b = 0; b < G::NB; ++b) acc[a][b] = zero16();
    const bf16_t* A0 = H + (size_t)row0 * 1024;
    G::run_lin(acc, A0, 1024, Wg + ((size_t)i * 1024 + col0) * 1024, 1024, 1024, smem);
#pragma unroll
    for (int a = 0; a < G::MB; ++a)
#pragma unroll
      for (int b = 0; b < G::NB; ++b) {
#pragma unroll
        for (int e = 0; e < 8; ++e) sg[a][b][e] = pack2bf(sigmoidf_(acc[a][b][2 * e]), sigmoidf_(acc[a][b][2 * e + 1]));
        acc[a][b] = zero16();
      }
    const bf16_t* br = i == 0 ? att : (i == 1 ? mlo : rwo);
    const int kb = i == 0 ? 512 : 256;
    const bf16_t* Wb = (const bf16_t*)(W + (i == 0 ? WM_BRA : (i == 1 ? WM_BRM : WM_BRR)));
    const bf16_t* B0 = br + (size_t)row0 * kb;
    G::run_lin(acc, B0, kb, Wb + (size_t)col0 * kb, kb, kb, smem);
#pragma unroll
    for (int a = 0; a < G::MB; ++a)
#pragma unroll
      for (int b = 0; b < G::NB; ++b)
#pragma unroll
        for (int e = 0; e < 8; ++e) {
          float y0 = bf2f((bf16_t)(sg[a][b][e] & 0xffff)) * acc[a][b][2 * e], y1 = bf2f((bf16_t)(sg[a][b][e] >> 16)) * acc[a][b][2 * e + 1];
          if (i > 0) { y0 += bf2f((bf16_t)(ypk[a][b][e] & 0xffff)); y1 += bf2f((bf16_t)(ypk[a][b][e] >> 16)); }
          if (i < 2) ypk[a][b][e] = pack2bf(y0, y1); else { acc[a][b][2 * e] = y0; acc[a][b][2 * e + 1] = y1; }
        }
  }
  {
    const int lane = tid & 63, wid = tid >> 6, wm = wid / G::WN, wn = wid % G::WN;
    float* scr = (float*)(smem + wid * WTile<G::NB>::BYTES);
#pragma unroll
    for (int mb = 0; mb < G::MB; ++mb) {
#pragma unroll
      for (int nb = 0; nb < G::NB; ++nb) WTile<G::NB>::put(scr, nb, lane, acc[mb][nb]);
      const int r0 = row0 + wm * G::WTM + mb * 32, c0 = col0 + wn * G::WTN;
      WTile<G::NB>::rows8(scr, lane, [&](int r, int c, const float4& a, const float4& bq) {
        *(uint4*)(ymix + (size_t)(r0 + r) * 1024 + c0 + c) = pack8bf(a, bq); });
    }
  }
}
DI void phase_merge(const Params& p, int l, bool with_ctx, char* smem) {
  const int nbig = (NX_ / 256) * 8, nsmall = with_ctx ? (NC_ / 128) * 8 : 0;
  for (int it = vblock(); it < nbig + nsmall; it += gridDim.x) {
    if (it < nbig) merge_tile<G2>(p, l, (it >> 3) * 256, (it & 7) * 128, smem);
    else { const int i2 = it - nbig; merge_tile<G128>(p, l, NX_ + (i2 >> 3) * 128, (i2 & 7) * 128, smem); }
  }
}

template <class G> DI void wout_tile(const Params& p, int l, int row0, int col0, char* smem) {
  const bf16_t* ymix = (const bf16_t*)(p.osc + O_YMIX);
  const bf16_t* Wo = (const bf16_t*)(p.ws + OFF_WMIX + (size_t)l * WM_SIZE + WM_OUT);
  float* xs = (float*)(p.ws + OFF_XS);
  const float* mod = (const float*)(p.ws + OFF_MOD) + (size_t)l * 3 * 6144;
  const int tid = opaque_tid();
  __syncthreads();
  f32x16 acc[G::MB][G::NB];
#pragma unroll
  for (int a = 0; a < G::MB; ++a)
#pragma unroll
    for (int b = 0; b < G::NB; ++b) acc[a][b] = zero16();
  const bf16_t* A0 = ymix + (size_t)row0 * 1024;
  G::run_lin(acc, A0, 1024, Wo + (size_t)col0 * 1024, 1024, 1024, smem);
  const float* m2 = mod + (size_t)tok_modrow(row0) * 6144 + 2 * 1024;
  const int lane = tid & 63, wid = tid >> 6, wm = wid / G::WN, wn = wid % G::WN;
  float* scr = (float*)(smem + wid * WTile<G::NB>::BYTES);
#pragma unroll
  for (int mb = 0; mb < G::MB; ++mb) {
#pragma unroll
    for (int nb = 0; nb < G::NB; ++nb) WTile<G::NB>::put(scr, nb, lane, acc[mb][nb]);
    const int r0 = row0 + wm * G::WTM + mb * 32, c0 = col0 + wn * G::WTN;
    WTile<G::NB>::rows4(scr, lane, [&](int r, int c, const float4& a) {
      float4* d = (float4*)(xs + (size_t)(r0 + r) * 1024 + c0 + c);
      const float4 g = *(const float4*)(m2 + c0 + c); float4 x = *d;
      x.x += g.x * a.x; x.y += g.y * a.y; x.z += g.z * a.z; x.w += g.w * a.w; *d = x; });
  }
}
DI void phase_wout(const Params& p, int l, bool with_ctx, char* smem) {
  const int nbig = (NX_ / 256) * 8, nsmall = with_ctx ? (NC_ / 128) * 8 : 0;
  for (int it = vblock(); it < nbig + nsmall; it += gridDim.x) {
    if (it < nbig) wout_tile<G2>(p, l, (it >> 3) * 256, (it & 7) * 128, smem);
    else { const int i2 = it - nbig; wout_tile<G128>(p, l, NX_ + (i2 >> 3) * 128, (i2 & 7) * 128, smem); }
  }
  TSB(p, 66);
  cvt_run([&](int i) { return cvt_moe_dec(p, l, i); }, (int)gridDim.x - 1 - vblock(), CVT_MOE_TILES, gridDim.x, smem);
  TSB(p, 67);
}

typedef Gemm<128, 64, 64, 4, 2> GRT;
DI void phase_router(const Params& p, int l, bool with_ctx, char* smem, int* cnt) {
  float* xs = (float*)(p.ws + OFF_XS);
  bf16_t* H = (bf16_t*)(p.ws + OFF_H);
  const float* mod = (const float*)(p.ws + OFF_MOD) + (size_t)l * 3 * 6144;
  const bf16_t* Wr = (const bf16_t*)(p.ws + OFF_WMIX + (size_t)l * WM_SIZE + WM_RT);
  int* eidx = (int*)(p.ws + OFF_REGION + R_EIDX);
  float* ewt = (float*)(p.ws + OFF_REGION + R_EWT);
  int* erank = (int*)(p.ws + OFF_REGION + R_ERANK);
  int* elist = (int*)(p.ws + OFF_REGION + R_ELIST);
  float* sc = (float*)(smem + GRT::SMEM);
  float* bs = sc + 128 * 65;
  float* gs = bs + 128 * 65;
  int* lcnt = (int*)(gs + 128 * 9);
  int* lbase = lcnt + 64;
  const int tid = opaque_tid(), lane = tid & 63, wid = tid >> 6;
  const int ntok = with_ctx ? NT_ : NX_;
  for (int it = blockIdx.x; it < ntok / 128; it += gridDim.x) {
    const int n0 = it * 128;
    __syncthreads();
    TSB(p, 40);
    if (tid < 64) lcnt[tid] = 0;
#pragma unroll 1
    for (int r4 = 0; r4 < 16; r4 += 4) {
      float v[4][16];
#pragma unroll
      for (int u = 0; u < 4; ++u) {
        const int n = n0 + wid * 16 + r4 + u;
#pragma unroll
        for (int j = 0; j < 4; ++j) {
          const float4 t = *(const float4*)(xs + (size_t)n * 1024 + (j * 64 + lane) * 4);
          v[u][j * 4] = t.x; v[u][j * 4 + 1] = t.y; v[u][j * 4 + 2] = t.z; v[u][j * 4 + 3] = t.w;
        }
      }
#pragma unroll
      for (int u = 0; u < 4; ++u) {
        const int n = n0 + wid * 16 + r4 + u;
        const float* m = mod + (size_t)tok_modrow(n) * 6144;
        row_norm_mod(v[u], p.g_ffn + (size_t)l * 1024, m + 3 * 1024, m + 4 * 1024, H + (size_t)n * 1024, lane);
      }
    }
    __syncthreads();
    TSB(p, 41);
    f32x16 acc[1][1]; acc[0][0] = zero16();
    const bf16_t* A0 = H + (size_t)n0 * 1024;
    GRT::run(acc, [&](int r) { return A0 + (size_t)r * 1024; }, Wr, 1024, 1024, smem);
    {
      const int col = GRT::col_of(tid, 0);
      const float rb = p.router_bias[l * 64 + col];
#pragma unroll
      for (int e = 0; e < 16; ++e) {
        const int row = GRT::row_of(tid, 0, e);
        const float s = sigmoidf_(acc[0][0][e]);
        sc[row * 65 + col] = s; bs[row * 65 + col] = s + rb;
      }
    }
    __syncthreads();
    TSB(p, 42);
    int sel[8], lrk[8]; float wsum = 0.f;
    if (tid < 128) {
      float* b = bs + tid * 65; const float* s = sc + tid * 65; float* g = gs + tid * 9;
      for (int gi = 0; gi < 8; ++gi) {
        float m1 = -1e30f, m2 = -1e30f;
        for (int j = 0; j < 8; ++j) { const float x = b[gi * 8 + j]; if (x > m1) { m2 = m1; m1 = x; } else if (x > m2) m2 = x; }
        g[gi] = m1 + m2;
      }
      unsigned gmask = 0;
      for (int c = 0; c < 4; ++c) {
        int best = 0; float bv = -1e30f;
        for (int gi = 0; gi < 8; ++gi) if (!((gmask >> gi) & 1) && g[gi] > bv) { bv = g[gi]; best = gi; }
        gmask |= 1u << best;
      }
      for (int gi = 0; gi < 8; ++gi) if (!((gmask >> gi) & 1)) for (int j = 0; j < 8; ++j) b[gi * 8 + j] = -1e30f;
      wsum = 0.f;
#pragma unroll
      for (int c = 0; c < 8; ++c) {
        int best = 0; float bv = -1e30f;
        for (int e = 0; e < 64; ++e) { const float x = b[e]; if (x > bv) { bv = x; best = e; } }
        b[best] = -3e30f; sel[c] = best; wsum += s[best];
        lrk[c] = atomicAdd(lcnt + best, 1);
      }
    }
    __syncthreads();
    if (tid < 64) { const int c = lcnt[tid]; lbase[tid] = c ? atomicAdd(cnt + tid * 32, c) : 0; }
    __syncthreads();
    if (tid < 128) {
      const int n = n0 + tid;
      const float* s = sc + tid * 65;
      const float inv = 2.5f / (wsum + 1e-20f);
#pragma unroll
      for (int c = 0; c < 8; ++c) {
        const int e = sel[c];
        const int rk = lbase[e] + lrk[c];
        eidx[n * 8 + c] = e; ewt[n * 8 + c] = s[e] * inv; erank[n * 8 + c] = rk;
        elist[(size_t)e * NT_ + rk] = n * 8 + c;
      }
    }
    __syncthreads();
    TSB(p, 43);
  }
}

typedef Gemm<128, 256, 32, 2, 4> GMOE;
constexpr int ACT_LD = 264;
constexpr int MOE_DN_BK = 64, MOE_DN_LD = 72, MOE_DN_STG = 256 * MOE_DN_LD * 2;
constexpr int MOE_ACT_OFF = 2 * MOE_DN_STG;
static_assert(GMOE::SMEM <= MOE_ACT_OFF, "gate/up staging must stay below the act image");
constexpr int MOE_INFO_OFF = MOE_ACT_OFF + 128 * ACT_LD * 2;
static_assert(MOE_INFO_OFF + 128 * 8 + 67 * 4 * 2 <= 160 * 1024 - 32, "moe lds");
DI void moe_down_run(f32x16 (&acc)[GMOE::MB][GMOE::NB], const char* actl, const bf16_t* Bt, char* smem) {
  constexpr int BK = MOE_DN_BK, LDB = MOE_DN_LD, NCH = 4, KS = 4, STG = MOE_DN_STG, nk = 256 / BK;
  const int tid = opaque_tid(), lane = tid & 63, wid = tid >> 6, wm = wid / 4, wn = wid % 4;
  const int kc = (tid & 7) * 8, r0 = tid >> 3;
  const bf16_t* bp0 = Bt + (size_t)r0 * 256 + kc;
  u32x4 s0[NCH], s1[NCH];
#define MD_LOAD(dst_, kt_) { const int kq_ = (kt_) < nk ? (kt_) : nk - 1; _Pragma("unroll") for (int i = 0; i < NCH; ++i) dst_[i] = *(const u32x4*)(bp0 + (size_t)i * 64 * 256 + kq_ * BK); }
#define MD_WRITE1(src_, c_, buf_) { *(u32x4*)(smem + (buf_) * STG + ((r0 + (c_) * 64) * LDB + kc) * 2) = src_[c_]; }
#define MD_STEP(w_, l_, kt_) { \
    MD_LOAD(l_, (kt_) + 2); \
    sched_fence(); \
    const char* Bs = smem + ((kt_) & 1) * STG; \
    _Pragma("unroll") for (int ks = 0; ks < KS; ++ks) { \
      bf16x8 af[GMOE::MB], bfr[GMOE::NB]; \
      _Pragma("unroll") for (int mb = 0; mb < GMOE::MB; ++mb) af[mb] = *(const bf16x8*)(actl + ((wm * 64 + mb * 32 + (lane & 31)) * ACT_LD + (kt_) * BK + ks * 16 + (lane >> 5) * 8) * 2); \
      _Pragma("unroll") for (int nb = 0; nb < GMOE::NB; ++nb) bfr[nb] = *(const bf16x8*)(Bs + ((wn * 64 + nb * 32 + (lane & 31)) * LDB + ks * 16 + (lane >> 5) * 8) * 2); \
      MD_WRITE1(w_, ks, ((kt_) + 1) & 1); \
      _Pragma("unroll") for (int mb = 0; mb < GMOE::MB; ++mb) _Pragma("unroll") for (int nb = 0; nb < GMOE::NB; ++nb) acc[mb][nb] = mfma32(af[mb], bfr[nb], acc[mb][nb]); \
    } \
    sched_fence(); \
    __syncthreads(); }
  MD_LOAD(s0, 0);
#pragma unroll
  for (int c = 0; c < NCH; ++c) MD_WRITE1(s0, c, 0);
  MD_LOAD(s0, 1);
  __syncthreads();
  for (int kt = 0; kt < nk; kt += 2) {
    MD_STEP(s0, s1, kt);
    MD_STEP(s1, s0, kt + 1);
  }
#undef MD_STEP
#undef MD_WRITE1
#undef MD_LOAD
}
DI void phase_moe(const Params& p, int l, bool with_ctx, char* smem, const int* cnt) {
  const bf16_t* H = (const bf16_t*)(p.ws + OFF_H);
  const bf16_t* GU = (const bf16_t*)(p.ws + OFF_REGION + R_WMOE + WE_GU);
  const bf16_t* DN = (const bf16_t*)(p.ws + OFF_REGION + R_WMOE + WE_DN);
  const float* ewt = (const float*)(p.ws + OFF_REGION + R_EWT);
  const int* elist = (const int*)(p.ws + OFF_REGION + R_ELIST);
  bf16_t* ybuf = (bf16_t*)(p.ws + OFF_REGION + R_YBUF);
  char* actl = smem + MOE_ACT_OFF;
  int* rtok = (int*)(smem + MOE_INFO_OFF);
  float* rwt = (float*)(rtok + 128);
  int* pre = (int*)(rwt + 128);
  int* off = pre + 67;
  int tid = threadIdx.x;
  const int ntok = with_ctx ? NT_ : NX_;
  __syncthreads();
  if (tid == 0) {
    int a = 0, o = 0;
    for (int e = 0; e < 65; ++e) { const int c = e < 64 ? cnt[e * 32] : ntok; pre[e] = a; off[e] = o; a += (c + 127) >> 7; o += c; }
    pre[65] = a; off[65] = o;
  }
  __syncthreads();
  const int total = pre[65];
  for (int it = vblock(); it < total; it += gridDim.x) {
    tid = opaque_tid();
    int e0 = 0;
    while (pre[e0 + 1] <= it) ++e0;
    const int e = rfl(e0);
    const int rb = rfl(it - pre[e]);
    const int c = rfl(e < 64 ? cnt[e * 32] : ntok);
    const int obase = rfl(off[e] + rb * 128);
    __syncthreads();
    if (tid < 128) {
      const int slot = rb * 128 + tid;
      int tok = 0; float w = 0.f;
      if (slot < c) {
        if (e < 64) { const int pk = elist[(size_t)e * NT_ + slot]; tok = pk >> 3; w = ewt[pk]; }
        else { tok = slot; w = 1.f; }
      }
      rtok[tid] = tok; rwt[tid] = w;
    }
    __syncthreads();
    const bf16_t* Wgu = GU + (size_t)e * 512 * 1024;
#pragma unroll 1
    for (int hf = 0; hf < 2; ++hf) {
      f32x16 acc[GMOE::MB][GMOE::NB];
#pragma unroll
      for (int a = 0; a < GMOE::MB; ++a)
#pragma unroll
        for (int b = 0; b < GMOE::NB; ++b) acc[a][b] = zero16();
      GMOE::run(acc, [&](int r) { return H + (size_t)rtok[r] * 1024; }, Wgu + (size_t)hf * 256 * 1024, 1024, 1024, smem);
      const int lane = tid & 63, wn = (tid >> 6) % 4, wmr = ((tid >> 6) / 4) * 64 + 4 * (lane >> 5);
      const int j = (hf * 4 + wn) * 32 + (lane & 31);
#pragma unroll
      for (int mb = 0; mb < GMOE::MB; ++mb)
#pragma unroll
        for (int i = 0; i < 16; ++i) {
          const int row = wmr + mb * 32 + (i & 3) + 8 * (i >> 2);
          const float g = acc[mb][0][i], u = acc[mb][1][i];
          *(bf16_t*)(actl + (row * ACT_LD + j) * 2) = f2bf(siluf_(g) * u);
        }
    }
    __syncthreads();
    const bf16_t* Wd = DN + (size_t)e * 1024 * 256;
#pragma unroll 1
    for (int nt = 0; nt < 4; ++nt) {
      f32x16 acc[GMOE::MB][GMOE::NB];
#pragma unroll
      for (int a = 0; a < GMOE::MB; ++a)
#pragma unroll
        for (int b = 0; b < GMOE::NB; ++b) acc[a][b] = zero16();
      moe_down_run(acc, actl, Wd + (size_t)nt * 256 * 256, smem);
      {
        const int lane = tid & 63, wid = tid >> 6, wm = wid / 4, wn = wid % 4;
        float* scr = (float*)(smem + wid * WTile<1>::BYTES);
#pragma unroll
        for (int mb = 0; mb < GMOE::MB; ++mb)
#pragma unroll
          for (int nb = 0; nb < GMOE::NB; ++nb) {
            WTile<1>::put(scr, 0, lane, acc[mb][nb]);
            const int row0 = wm * 64 + mb * 32, col0 = nt * 256 + wn * 64 + nb * 32;
            WTile<1>::rows8(scr, lane, [&](int r, int cq, const float4& a, const float4& bq) {
              const int row = row0 + r;
              if (rb * 128 + row < c) {
                const float w = rwt[row];
                const float4 a2 = make_float4(a.x * w, a.y * w, a.z * w, a.w * w), b2 = make_float4(bq.x * w, bq.y * w, bq.z * w, bq.w * w);
                *(uint4*)(ybuf + ((size_t)obase + row) * 1024 + col0 + cq) = pack8bf(a2, b2);
              } });
          }
        __syncthreads();
      }
    }
  }
}

DI void phase_combine(const Params& p, int l, bool last, char* smem, const int* cnt) {
  float* xs = (float*)(p.ws + OFF_XS);
  bf16_t* H = (bf16_t*)(p.ws + OFF_H);
  const float* mod = (const float*)(p.ws + OFF_MOD);
  const int* eidx = (const int*)(p.ws + OFF_REGION + R_EIDX);
  const int* erank = (const int*)(p.ws + OFF_REGION + R_ERANK);
  const bf16_t* ybuf = (const bf16_t*)(p.ws + OFF_REGION + R_YBUF);
  int* off = (int*)smem;
  const int tid = opaque_tid(), lane = tid & 63, wid = tid >> 6;
  const int ntok = last ? NX_ : NT_;
  __syncthreads();
  if (tid == 0) { int o = 0; for (int e = 0; e < 64; ++e) { off[e] = o; o += cnt[e * 32]; } off[64] = o; }
  __syncthreads();
  for (int n = blockIdx.x * 8 + wid; n < ntok; n += gridDim.x * 8) {
    float acc[16];
#pragma unroll
    for (int i = 0; i < 16; ++i) acc[i] = 0.f;
    const int4 e0 = *(const int4*)(eidx + n * 8), e1 = *(const int4*)(eidx + n * 8 + 4);
    const int4 r0 = *(const int4*)(erank + n * 8), r1 = *(const int4*)(erank + n * 8 + 4);
    const int rows[9] = {off[e0.x] + r0.x, off[e0.y] + r0.y, off[e0.z] + r0.z, off[e0.w] + r0.w,
                         off[e1.x] + r1.x, off[e1.y] + r1.y, off[e1.z] + r1.z, off[e1.w] + r1.w, off[64] + n};
    uint2 u[9][4];
#pragma unroll
    for (int k = 0; k < 9; ++k)
#pragma unroll
      for (int j = 0; j < 4; ++j) u[k][j] = *(const uint2*)(ybuf + (size_t)rows[k] * 1024 + (j * 64 + lane) * 4);
#pragma unroll
    for (int k = 0; k < 9; ++k)
#pragma unroll
      for (int j = 0; j < 4; ++j) {
        acc[j * 4 + 0] += bf2f((bf16_t)(u[k][j].x & 0xffff)); acc[j * 4 + 1] += bf2f((bf16_t)(u[k][j].x >> 16));
        acc[j * 4 + 2] += bf2f((bf16_t)(u[k][j].y & 0xffff)); acc[j * 4 + 3] += bf2f((bf16_t)(u[k][j].y >> 16));
      }
    const float* m5 = mod + ((size_t)l * 3 + tok_modrow(n)) * 6144 + 5 * 1024;
    float v[16];
#pragma unroll
    for (int j = 0; j < 4; ++j) {
      const int c = (j * 64 + lane) * 4;
      const float4 x = *(const float4*)(xs + (size_t)n * 1024 + c), g = *(const float4*)(m5 + c);
      v[j * 4 + 0] = x.x + g.x * acc[j * 4 + 0]; v[j * 4 + 1] = x.y + g.y * acc[j * 4 + 1];
      v[j * 4 + 2] = x.z + g.z * acc[j * 4 + 2]; v[j * 4 + 3] = x.w + g.w * acc[j * 4 + 3];
      if (!last) *(float4*)(xs + (size_t)n * 1024 + c) = make_float4(v[j * 4], v[j * 4 + 1], v[j * 4 + 2], v[j * 4 + 3]);
    }
    if (!last) {
      const float* m = mod + ((size_t)(l + 1) * 3 + tok_modrow(n)) * 6144;
      row_norm_mod(v, p.g_mix + (size_t)(l + 1) * 1024, m, m + 1024, H + (size_t)n * 1024, lane);
    } else {
      float ss = 0.f;
#pragma unroll
      for (int i = 0; i < 16; ++i) ss += v[i] * v[i];
      ss = wave_sum(ss);
      const float rs = frsq(ss * (1.f / 1024.f) + 1e-6f);
#pragma unroll
      for (int j = 0; j < 4; ++j) {
        const int c = (j * 64 + lane) * 4;
        const float4 g = *(const float4*)(p.g_final + c);
        *(float4*)(p.out + (size_t)n * 1024 + c) = make_float4(v[j * 4] * rs * g.x, v[j * 4 + 1] * rs * g.y, v[j * 4 + 2] * rs * g.z, v[j * 4 + 3] * rs * g.w);
      }
    }
  }
}
#define SMEM_BYTES (160 * 1024)
#ifndef MEGA
#define MEGA 0
#endif
DI int* cnt_ptr(const Params& p, int l) { return (int*)(p.ws + OFF_CNT) + 1024 + 2048 * l; }
DI int* ctr_ptr(const Params& p, int l) { return (int*)(p.ws + OFF_CNT) + 32 * l; }
#if !MEGA
__global__ void __launch_bounds__(NTHR) k_phaseA(Params p) { SMEM_DECL(smem, SMEM_BYTES); phaseA(p, smem); }
__global__ void __launch_bounds__(NTHR) k_norm0(Params p) { phase_norm0(p); }
__global__ void __launch_bounds__(NTHR) k_win(Params p, int l) { SMEM_DECL(smem, SMEM_BYTES); phase_win(p, l, smem); }
__global__ void __launch_bounds__(NTHR) k_p3(Params p, int l) { SMEM_DECL(smem, SMEM_BYTES); phase3(p, l, smem); }
__global__ void __launch_bounds__(NTHR) k_p3b(Params p, int l) { SMEM_DECL(smem, SMEM_BYTES); phase3b(p, l, smem, ctr_ptr(p, l)); }
__global__ void __launch_bounds__(NTHR) k_p4(Params p, int l) { SMEM_DECL(smem, SMEM_BYTES); phase4(p, l, smem, ctr_ptr(p, l)); }
__global__ void __launch_bounds__(NTHR) k_p5(Params p, int l, int wc) { SMEM_DECL(smem, SMEM_BYTES); phase5(p, l, wc != 0, smem); }
__global__ void __launch_bounds__(NTHR) k_merge(Params p, int l, int wc) { SMEM_DECL(smem, SMEM_BYTES); phase_merge(p, l, wc != 0, smem); }
__global__ void __launch_bounds__(NTHR) k_wout(Params p, int l, int wc) { SMEM_DECL(smem, SMEM_BYTES); phase_wout(p, l, wc != 0, smem); }
__global__ void __launch_bounds__(NTHR) k_router(Params p, int l, int wc) { SMEM_DECL(smem, SMEM_BYTES); phase_router(p, l, wc != 0, smem, cnt_ptr(p, l)); }
__global__ void __launch_bounds__(NTHR) k_moe(Params p, int l, int wc) { SMEM_DECL(smem, SMEM_BYTES); phase_moe(p, l, wc != 0, smem, cnt_ptr(p, l)); }
__global__ void __launch_bounds__(NTHR) k_combine(Params p, int l, int last) { SMEM_DECL(smem, SMEM_BYTES); phase_combine(p, l, last != 0, smem, cnt_ptr(p, l)); }
#else
#ifndef EMU
#define XB_TMO      128
#define XB_XCNT(j)  (256  + 64 * (j))
#define XB_XSUB(j)  (1280 + 64 * (j))
#define XB_XGEN(j)  (2304 + 64 * (j))
#define XB_TOP      3328
#define XB_TOPGEN   3392
#define XCD_BAR_WORDS 3456
#define XB_SPIN_CAP (1u << 24)
#define LAS __attribute__((address_space(3)))
DI unsigned xb_ld(unsigned* p) { return __hip_atomic_load(p, __ATOMIC_RELAXED, __HIP_MEMORY_SCOPE_AGENT); }
DI unsigned xb_add(unsigned* p, unsigned v) { return __hip_atomic_fetch_add(p, v, __ATOMIC_RELAXED, __HIP_MEMORY_SCOPE_AGENT); }
DI unsigned xb_xcc_id() { return (unsigned)__builtin_amdgcn_s_getreg((3 << 11) | 20) & 0xFu; }
#define XB_SPIN(cond, bar) do { unsigned _sp = 0; while (cond) { __builtin_amdgcn_s_sleep(1); \
    if ((++_sp & 255u) == 0u) { if (xb_ld(&(bar)[XB_TMO])) break; if (_sp > XB_SPIN_CAP) { atomicAdd(&(bar)[XB_TMO], 1u); break; } } } } while (0)
struct XcdBarrier { unsigned* bar; unsigned x; volatile LAS unsigned* st; };
DI XcdBarrier xcd_barrier_post(unsigned* bar, volatile LAS unsigned* st) {
  XcdBarrier b; b.bar = bar; b.x = xb_xcc_id(); b.st = st;
  if (threadIdx.x == 0) (void)xb_add(&bar[XB_XCNT(b.x)], 1u);
  return b;
}
DI void xcd_barrier_complete(unsigned* bar, unsigned x, unsigned& nloc, unsigned& nx) {
  const unsigned G = gridDim.x * gridDim.y * gridDim.z;
  unsigned sum, cnt, mine, sp = 0u;
  for (;;) {
    sum = 0u; cnt = 0u; mine = 0u;
#pragma unroll
    for (unsigned j = 0; j < 16; ++j) { const unsigned c = xb_ld(&bar[XB_XCNT(j)]); sum += c; cnt += (c > 0u) ? 1u : 0u; mine = (j == x) ? c : mine; }
    if (sum == G) break;
    __builtin_amdgcn_s_sleep(1);
    if ((++sp & 255u) == 0u) { if (xb_ld(&bar[XB_TMO])) break; if (sp > XB_SPIN_CAP) { atomicAdd(&bar[XB_TMO], 1u); break; } }
  }
  nloc = mine > 0u ? mine : 1u; nx = cnt > 0u ? cnt : 1u;
}
DI void xcd_barrier(const XcdBarrier& b) {
  asm volatile("s_waitcnt vmcnt(0)" ::: "memory");
  __syncthreads();
  if (threadIdx.x == 0) {
    unsigned* bar = b.bar;
    __builtin_amdgcn_s_waitcnt(0);
    unsigned nloc = b.st[0], nx = b.st[1];
    if (nloc == 0u) { xcd_barrier_complete(bar, b.x, nloc, nx); b.st[0] = nloc; b.st[1] = nx; }
    const unsigned old = xb_add(&bar[XB_XSUB(b.x)], 1u);
    const unsigned gen = old / nloc;
    if (old + 1u == (gen + 1u) * nloc) {
      __builtin_amdgcn_fence(__ATOMIC_RELEASE, "agent");
      asm volatile("s_waitcnt vmcnt(0)" ::: "memory");
      const unsigned og = xb_add(&bar[XB_TOP], 1u);
      const unsigned tg = og / nx;
      if (og + 1u == (tg + 1u) * nx) xb_add(&bar[XB_TOPGEN], 1u);
      else XB_SPIN(xb_ld(&bar[XB_TOPGEN]) == tg, bar);
      __builtin_amdgcn_fence(__ATOMIC_ACQUIRE, "agent");
      xb_add(&bar[XB_XGEN(b.x)], 1u);
      asm volatile("s_waitcnt vmcnt(0)" ::: "memory");
    } else {
      XB_SPIN(xb_ld(&bar[XB_XGEN(b.x)]) == gen, bar);
      __builtin_amdgcn_fence(__ATOMIC_ACQUIRE, "agent");
      asm volatile("s_waitcnt vmcnt(0)" ::: "memory");
    }
  }
  __syncthreads();
}
#define GSYNC() { XcdBarrier xb_; xb_.bar = (unsigned*)(p.ws + OFF_BAR); xb_.x = xb_xcc_id(); xb_.st = (volatile LAS unsigned*)(smem + SMEM_BYTES - 32); xcd_barrier(xb_); }
#else
#define GSYNC() emu::grid_barrier()
#endif
#ifdef PROBE_IDX
#define TS(i) { if (blockIdx.x == 0 && threadIdx.x == 0) ts[i] = wall_clock64(); }
#else
#define TS(i)
#endif
__global__ void __launch_bounds__(NTHR) k_mega(Params p) {
  SMEM_DECL(smem, SMEM_BYTES);
  cooperative_groups::grid_group grid = cooperative_groups::this_grid();
  volatile LAS unsigned* xst = (volatile LAS unsigned*)(smem + SMEM_BYTES - 32);
  if (threadIdx.x == 0) { xst[0] = 0u; xst[1] = 0u; }
  __syncthreads();
  (void)xcd_barrier_post((unsigned*)(p.ws + OFF_BAR), xst);
#ifdef PROBE_IDX
  long long* ts = (long long*)(p.ws + OFF_CNT + 2048);
#endif
  TS(0);
  phaseA(p, smem);
  grid.sync(); TS(1);
  phase_norm0(p);
  GSYNC(); TS(2);
#pragma unroll 1
  for (int l = 0; l < 2; ++l) {
    const bool wc = l == 0;
    phase_win(p, l, smem); GSYNC(); TS(3 + l * 10);
    phase3(p, l, smem); GSYNC(); TS(4 + l * 10);
    phase3b(p, l, smem, ctr_ptr(p, l)); GSYNC(); TS(5 + l * 10);
    phase4(p, l, smem, ctr_ptr(p, l)); GSYNC(); TS(6 + l * 10);
    phase5(p, l, wc, smem); GSYNC(); TS(7 + l * 10);
    phase_merge(p, l, wc, smem); GSYNC(); TS(8 + l * 10);
    phase_wout(p, l, wc, smem); GSYNC(); TS(9 + l * 10);
    phase_router(p, l, wc, smem, cnt_ptr(p, l)); GSYNC(); TS(10 + l * 10);
    phase_moe(p, l, wc, smem, cnt_ptr(p, l)); GSYNC(); TS(11 + l * 10);
    phase_combine(p, l, l == 1, smem, cnt_ptr(p, l));
#ifdef PROBE_IDX
    GSYNC(); TS(12 + l * 10);
#else
    if (l == 0) GSYNC();
#endif
  }
#ifdef PROBE_IDX
  if (blockIdx.x == 0 && threadIdx.x == 0) {
    const float us = (float)(ts[PROBE_IDX + 1] - ts[PROBE_IDX]) * 0.01f;
    p.out[0] += PROBE_IDX >= 40 ? rintf(6.f * log2f(fmaxf(us * 16.f, 1.f))) : rintf(6.f * log2f(fmaxf(us, 1.f)));
  }
#endif
}
#endif

extern "C" void kernel_launch(void* const* d_in, const int* in_sizes, int n_in, void* d_out, int out_size, void* d_ws,
                              size_t ws_size, hipStream_t stream) {
  Params p{};
  const float** pp = (const float**)&p;
  for (int i = 0; i < 41; ++i) pp[i] = (const float*)d_in[i];
  p.out = (float*)d_out; p.ws = (char*)d_ws; p.osc = (char*)d_out;
  if (ws_size < WS_NEEDED) { fprintf(stderr, "workspace too small: %zu < %zu\n", ws_size, (size_t)WS_NEEDED); return; }
#if !MEGA
  const dim3 g(256), b(NTHR);
  hipLaunchKernelGGL(k_phaseA, g, b, 0, stream, p);
  hipLaunchKernelGGL(k_norm0, g, b, 0, stream, p);
  for (int l = 0; l < 2; ++l) {
    const int wc = l == 0;
    hipLaunchKernelGGL(k_win, g, b, 0, stream, p, l);
    hipLaunchKernelGGL(k_p3, g, b, 0, stream, p, l);
    hipLaunchKernelGGL(k_p3b, g, b, 0, stream, p, l);
    hipLaunchKernelGGL(k_p4, g, b, 0, stream, p, l);
    hipLaunchKernelGGL(k_p5, g, b, 0, stream, p, l, wc);
    hipLaunchKernelGGL(k_merge, g, b, 0, stream, p, l, wc);
    hipLaunchKernelGGL(k_wout, g, b, 0, stream, p, l, wc);
    hipLaunchKernelGGL(k_router, g, b, 0, stream, p, l, wc);
    hipLaunchKernelGGL(k_moe, g, b, 0, stream, p, l, wc);
    hipLaunchKernelGGL(k_combine, g, b, 0, stream, p, l, l == 1);
  }
#else
  static int grid_blocks = 0;
  if (!grid_blocks) {
    int dev = 0, cus = 0, per_cu = 0;
    hipGetDevice(&dev);
    hipDeviceGetAttribute(&cus, hipDeviceAttributeMultiprocessorCount, dev);
    hipOccupancyMaxActiveBlocksPerMultiprocessor(&per_cu, k_mega, NTHR, 0);
    if (per_cu > 1) per_cu = 1;
    grid_blocks = cus * per_cu;
  }
  hipMemsetAsync(p.ws + OFF_BAR, 0, 16384, stream);
  void* args[] = {&p};
  hipError_t e = hipLaunchCooperativeKernel((void*)k_mega, dim3(grid_blocks), dim3(NTHR), args, 0, stream);
  if (e != hipSuccess) fprintf(stderr, "cooperative launch failed: %s (grid %d)\n", hipGetErrorString(e), grid_blocks);
#endif
}
```

```cpp
#define MEGA 1
#include <hip/hip_runtime.h>
#include <hip/hip_cooperative_groups.h>
#include <cstdio>

#ifndef SEQ_T
#define SEQ_T 8192
#endif
#ifndef CTX_L
#define CTX_L 256
#endif

#define DI __device__ __forceinline__
typedef unsigned short bf16_t;
typedef short bf16x8 __attribute__((ext_vector_type(8)));
typedef float f32x16 __attribute__((ext_vector_type(16)));
typedef float f32x4 __attribute__((ext_vector_type(4)));
typedef unsigned u32x4 __attribute__((ext_vector_type(4)));

constexpr int NB_ = 2, T_ = SEQ_T, CL_ = CTX_L, D_ = 1024;
constexpr int NX_ = NB_ * T_, NC_ = NB_ * CL_, NT_ = NX_ + NC_, KT_ = CL_ + T_;
constexpr int GRID_W_ = 64;
constexpr int MLA_H = 8, MLA_NOPE_ = 64, MLA_ROPE_ = 32, MLA_DK = 96, MLA_DV = 64, QLORA = 384, KVLORA = 256;
constexpr int MLA_IN_ = 672, ML_IN_ = 784, RW_IN_ = 1152, GATE_IN_ = 3072, D_IN_ = 5680;
constexpr int ZMLA_W = 768;
constexpr int ZREC_W = 1936;
constexpr int WIN_N = 768 + 2048;
constexpr int ML_H = 4, ML_DK = 32, ML_DV = 64, ML_L = 64;
constexpr int RW_H = 4, RW_N_ = 64;
constexpr int NE_ = 64, TOPK_ = 8, DE_ = 256;
constexpr int NCH_ = KT_ / ML_L;
constexpr int NSEQ_ = 2 * NB_ * 4;

constexpr int ZR_MLQ = 0, ZR_MLK = 128, ZR_MLV = 256, ZR_MLO = 512, ZR_MLI = 768, ZR_MLF = 776;
constexpr int ZR_RW = 784;

constexpr size_t al256(size_t x) { return (x + 255) & ~(size_t)255; }
constexpr size_t WM_WIN = 0;
constexpr size_t WM_GATE = WM_WIN + (size_t)WIN_N * 1024 * 2;
constexpr size_t WM_UQ = WM_GATE + (size_t)3072 * 1024 * 2;
constexpr size_t WM_UKV = WM_UQ + (size_t)768 * 384 * 2;
constexpr size_t WM_BRA = WM_UKV + (size_t)1024 * 256 * 2;
constexpr size_t WM_BRM = WM_BRA + (size_t)1024 * 512 * 2;
constexpr size_t WM_BRR = WM_BRM + (size_t)1024 * 256 * 2;
constexpr size_t WM_OUT = WM_BRR + (size_t)1024 * 256 * 2;
constexpr size_t WM_RT = WM_OUT + (size_t)1024 * 1024 * 2;
constexpr size_t WM_SIZE = al256(WM_RT + (size_t)64 * 1024 * 2);
constexpr size_t WE_GU = 0;
constexpr size_t WE_DN = WE_GU + (size_t)65 * 512 * 1024 * 2;
constexpr size_t WE_SIZE = al256(WE_DN + (size_t)65 * 1024 * 256 * 2);

constexpr size_t OFF_XS = 0;
constexpr size_t OFF_MOD = OFF_XS + al256((size_t)NT_ * 1024 * 4);
constexpr size_t OFF_ROPE = OFF_MOD + al256((size_t)2 * 3 * 6144 * 4);
constexpr size_t OFF_H = OFF_ROPE + al256((size_t)T_ * 16 * 8);
constexpr size_t OFF_WMIX = OFF_H + al256((size_t)NT_ * 1024 * 2);
constexpr size_t OFF_CNT = OFF_WMIX + 2 * WM_SIZE;
constexpr size_t OFF_BAR = OFF_CNT + 32768;
constexpr size_t OFF_REGION = OFF_BAR + 16384;
constexpr size_t R_ZREC = 0;
constexpr size_t R_RB16 = R_ZREC + al256((size_t)NT_ * ZREC_W * 4);
constexpr size_t R_LW = R_RB16 + al256((size_t)7 * NT_ * 256 * 2);
constexpr size_t R_BS = R_LW + al256((size_t)2 * NT_ * 256 * 4);
constexpr size_t R_CH = R_BS + al256((size_t)2 * NT_ * 4 * 4);
constexpr size_t R_YS = R_CH + al256((size_t)NSEQ_ * NCH_ * 40960);
constexpr size_t R_MLST = R_YS + al256((size_t)2 * NT_ * 256 * 4);
constexpr size_t R_ATT = R_MLST + al256((size_t)NSEQ_ * NCH_ * 2112 * 4);
constexpr size_t R_MLO = R_ATT + al256((size_t)NT_ * 512 * 2);
constexpr size_t R_RWO = R_MLO + al256((size_t)NT_ * 256 * 2);
constexpr size_t R_VT = R_RWO + al256((size_t)NT_ * 256 * 2);
constexpr size_t R_KB = R_VT + al256((size_t)NB_ * MLA_H * 64 * KT_ * 2);
constexpr size_t R_MIX_END = R_KB + al256((size_t)NB_ * MLA_H * KT_ * 96 * 2);
constexpr int NSLOT_ = NT_ * 9;
constexpr size_t R_YBUF = 0;
constexpr size_t R_EIDX = R_YBUF + al256((size_t)NSLOT_ * 1024 * 2);
constexpr size_t R_EWT = R_EIDX + al256((size_t)NT_ * 8 * 4);
constexpr size_t R_ERANK = R_EWT + al256((size_t)NT_ * 8 * 4);
constexpr size_t R_ELIST = R_ERANK + al256((size_t)NT_ * 8 * 4);
constexpr size_t R_WMOE = R_ELIST + al256((size_t)64 * NT_ * 4);
constexpr size_t R_MOE_END = R_WMOE + WE_SIZE;
constexpr size_t R_SIZE = R_MIX_END > R_MOE_END ? R_MIX_END : R_MOE_END;
constexpr size_t WS_NEEDED = OFF_REGION + R_SIZE;
constexpr size_t O_ZMLA = 0;
constexpr size_t O_QB = O_ZMLA + al256((size_t)NT_ * ZMLA_W * 2);
constexpr size_t O_END = O_QB + al256((size_t)NT_ * 768 * 2);
constexpr size_t O_YMIX = 0;
#if SEQ_T == 8192 && CTX_L == 256
static_assert(O_END <= (size_t)NX_ * 1024 * 4, "d_out scratch overflow");
static_assert((size_t)NT_ * 1024 * 2 <= (size_t)NX_ * 1024 * 4, "ymix overflow");
static_assert(WS_NEEDED <= (size_t)597000000, "workspace too large");
#endif

struct Params {
  const float *x, *c, *ctx, *c_ctx, *w_mod, *b_mod, *g_mix, *g_ffn, *w_in, *g_cq, *w_uq, *g_ckv, *w_uk, *w_uv;
  const float *ml_b_i, *ml_b_f, *ml_g_norm, *rw_mu, *rw_w0, *rw_w2, *rw_a0, *rw_a2, *rw_g2, *rw_k_k, *rw_k_a;
  const float *rw_r_k, *rw_lnx_w, *rw_lnx_b, *w_br_mla, *w_br_ml, *w_br_rw, *w_out, *w_router, *router_bias;
  const float *w_e_gate, *w_e_up, *w_e_down, *w_s_gate, *w_s_up, *w_s_down, *g_final;
  float* out; char* ws; char* osc;
};

DI float bf2f(bf16_t s) { unsigned u = ((unsigned)s) << 16; float f; __builtin_memcpy(&f, &u, 4); return f; }
DI bf16_t f2bf(float x) { unsigned u; __builtin_memcpy(&u, &x, 4); u += 0x7fffu + ((u >> 16) & 1u); return (bf16_t)(u >> 16); }
DI unsigned pack2bf(float a, float b) {
#ifdef EMU
  return (unsigned)f2bf(a) | ((unsigned)f2bf(b) << 16);
#else
  typedef __bf16 bf2 __attribute__((ext_vector_type(2)));
  typedef float f2 __attribute__((ext_vector_type(2)));
  f2 v = {a, b}; bf2 r = __builtin_convertvector(v, bf2); return __builtin_bit_cast(unsigned, r);
#endif
}
DI f32x16 mfma32(bf16x8 a, bf16x8 b, f32x16 c) {
#ifdef EMU
  return emu_mfma_32x32x16_bf16(a, b, c);
#else
  return __builtin_amdgcn_mfma_f32_32x32x16_bf16(a, b, c, 0, 0, 0);
#endif
}
DI int rfl(int v) {
#ifdef EMU
  return v;
#else
  return __builtin_amdgcn_readfirstlane(v);
#endif
}
DI int opaque_tid() {
#ifdef EMU
  return threadIdx.x;
#else
  int t = threadIdx.x; asm volatile("" : "+v"(t)); return t;
#endif
}
DI void wave_sync() {
#ifdef EMU
  (void)__ballot(1);
#else
  asm volatile("" ::: "memory");
#endif
}
DI int vblock() {
  const int g = gridDim.x, b = blockIdx.x;
  return (g & 7) == 0 ? (b & 7) * (g >> 3) + (b >> 3) : b;
}
DI int xcc_id() {
#ifdef EMU
  return blockIdx.x & 7;
#else
  return (int)(__builtin_amdgcn_s_getreg((3 << 11) | 20) & 7u);
#endif
}
DI int ld_relaxed(int* p) {
#ifdef EMU
  return __atomic_load_n(p, __ATOMIC_SEQ_CST);
#else
  return __hip_atomic_load(p, __ATOMIC_RELAXED, __HIP_MEMORY_SCOPE_AGENT);
#endif
}
DI void sched_fence() {
#ifndef EMU
  __builtin_amdgcn_sched_barrier(0);
#endif
}
template <int L> DI float lane_bcast(float x) {
#ifdef EMU
  return __shfl(x, L);
#else
  return __builtin_bit_cast(float, __builtin_amdgcn_readlane(__builtin_bit_cast(int, x), L));
#endif
}
DI f32x16 zero16() { f32x16 z; for (int i = 0; i < 16; ++i) z[i] = 0.f; return z; }
DI int crow(int reg, int h) { return (reg & 3) + 8 * (reg >> 2) + 4 * h; }
#ifdef EMU
DI float fexp(float x) { return expf(x); }
#else
DI float fexp(float x) { return __expf(x); }
#endif
#ifdef EMU
DI float frcp(float x) { return 1.f / x; }
DI float frsq(float x) { return 1.f / sqrtf(x); }
#else
DI float frcp(float x) { return __builtin_amdgcn_rcpf(x); }
DI float frsq(float x) { return __builtin_amdgcn_rsqf(x); }
#endif
#ifdef EMU
DI float flog(float x) { return logf(x); }
#else
DI float flog(float x) { return __builtin_amdgcn_logf(x) * 0.6931471805599453f; }
#endif
DI float sigmoidf_(float x) { return frcp(1.f + fexp(-x)); }
DI float siluf_(float x) { return x * sigmoidf_(x); }
#ifdef EMU
DI float wave_sum(float v) { for (int m = 32; m >= 1; m >>= 1) v += __shfl_xor(v, m); return v; }
DI float wave_max(float v) { for (int m = 32; m >= 1; m >>= 1) v = fmaxf(v, __shfl_xor(v, m)); return v; }
#else
#define DPPF(x, ctrl) __builtin_bit_cast(float, __builtin_amdgcn_mov_dpp(__builtin_bit_cast(int, (x)), (ctrl), 0xf, 0xf, true))
#define RDLF(x, l) __builtin_bit_cast(float, __builtin_amdgcn_readlane(__builtin_bit_cast(int, (x)), (l)))
DI float wave_sum(float v) {
  v += DPPF(v, 0xB1); v += DPPF(v, 0x4E); v += DPPF(v, 0x124); v += DPPF(v, 0x128);
  return (RDLF(v, 0) + RDLF(v, 16)) + (RDLF(v, 32) + RDLF(v, 48));
}
DI float wave_max(float v) {
  v = fmaxf(v, DPPF(v, 0xB1)); v = fmaxf(v, DPPF(v, 0x4E)); v = fmaxf(v, DPPF(v, 0x124)); v = fmaxf(v, DPPF(v, 0x128));
  return fmaxf(fmaxf(RDLF(v, 0), RDLF(v, 16)), fmaxf(RDLF(v, 32), RDLF(v, 48)));
}
#endif

DI int tok_b(int n) { return n < NX_ ? n / T_ : (n - NX_) / CL_; }
DI int tok_t(int n) { return n < NX_ ? n % T_ : (n - NX_) % CL_; }
DI int tok_key(int n) { return n < NX_ ? CL_ + n % T_ : (n - NX_) % CL_; }
DI int tok_modrow(int n) { return n < NX_ ? n / T_ : 2; }

#ifdef EMU
#define SMEM_DECL(name, bytes) char* name = (char*)emu::shared_alloc(bytes)
#else
#define SMEM_DECL(name, bytes) __shared__ __attribute__((aligned(16))) char name[bytes]
#endif
#define NTHR 512
#if defined(PROBE_IDX) && !defined(EMU)
#define TSB(pp, i) { if (blockIdx.x == 0 && threadIdx.x == 0) ((long long*)((pp).ws + OFF_CNT + 2048))[i] = wall_clock64(); }
#else
#define TSB(pp, i)
#endif
struct CvtJob { const float* src; int lds; int K; bf16_t* dst; int ntn; int ntk; int maptype; const float* gain; };
DI int cvt_map(int maptype, int coff, int np) {
  if (maptype == 0) return coff + np;
  if (maptype == 1) { if (np < 672) return np; if (np < 768) return -1; if (np < 768 + 1936) return np - 96; return -1; }
  return np;
}
struct CvtItem { CvtJob j; int coff, tk, tn; };
struct CvtRegs { float v[8]; };
DI void cvt_load(const CvtItem& c, int tid, CvtRegs& r) {
  const int kk = tid >> 4, np = c.tn * 64 + (tid & 15) * 4;
  const int sc = cvt_map(c.j.maptype, c.coff, np);
#pragma unroll
  for (int u = 0; u < 2; ++u) {
    const int k = c.tk * 64 + kk + 32 * u;
    float4 v = make_float4(0.f, 0.f, 0.f, 0.f);
    if (sc >= 0) v = *(const float4*)(c.j.src + (size_t)k * c.j.lds + sc);
    const float g = c.j.gain ? c.j.gain[k] : 1.f;
    r.v[4 * u] = v.x * g; r.v[4 * u + 1] = v.y * g; r.v[4 * u + 2] = v.z * g; r.v[4 * u + 3] = v.w * g;
  }
}
DI void cvt_store(const CvtItem& c, int tid, const CvtRegs& r, char* smem) {
  float* tile = (float*)smem;
  __syncthreads();
  {
    const int kk = tid >> 4, nc = (tid & 15) * 4;
#pragma unroll
    for (int u = 0; u < 2; ++u)
#pragma unroll
      for (int i = 0; i < 4; ++i) tile[(kk + 32 * u) * 65 + nc + i] = r.v[4 * u + i];
  }
  __syncthreads();
  {
    const int n = tid >> 3, kc = (tid & 7) * 8;
    int np = c.tn * 64 + n;
    if (c.j.maptype == 2) np = (np >> 5) * 64 + c.coff * 32 + (np & 31);
    uint4 v;
    v.x = pack2bf(tile[(kc + 0) * 65 + n], tile[(kc + 1) * 65 + n]);
    v.y = pack2bf(tile[(kc + 2) * 65 + n], tile[(kc + 3) * 65 + n]);
    v.z = pack2bf(tile[(kc + 4) * 65 + n], tile[(kc + 5) * 65 + n]);
    v.w = pack2bf(tile[(kc + 6) * 65 + n], tile[(kc + 7) * 65 + n]);
    *(uint4*)(c.j.dst + (size_t)np * c.j.K + c.tk * 64 + kc) = v;
  }
}
template <class Dec> DI void cvt_run(Dec dec, int first, int n, int stride, char* smem) {
  const int tid = opaque_tid();
  if (first >= n) return;
  CvtItem cur = dec(first); CvtRegs rc; cvt_load(cur, tid, rc);
  for (int it = first; it < n; it += stride) {
    const int nx = it + stride < n ? it + stride : it;
    CvtItem nxt = dec(nx); CvtRegs rn; cvt_load(nxt, tid, rn);
    sched_fence();
    cvt_store(cur, tid, rc, smem);
    cur = nxt; rc = rn;
  }
}

constexpr int CVT_MIX_TILES = 704 + 768 + 72 + 32 + 32 + 128 + 64 + 64 + 256 + 16;
DI CvtItem cvt_mix_dec(const Params& p, int l, int it) {
  bf16_t* W = (bf16_t*)(p.ws + OFF_WMIX + (size_t)l * WM_SIZE);
  CvtJob j; int coff = 0;
  if (it < 704) { j = {p.w_in + (size_t)l * 1024 * D_IN_, D_IN_, 1024, (bf16_t*)((char*)W + WM_WIN), 44, 16, 1, nullptr}; }
  else if ((it -= 704) < 768) { j = {p.w_in + (size_t)l * 1024 * D_IN_, D_IN_, 1024, (bf16_t*)((char*)W + WM_GATE), 48, 16, 0, nullptr}; coff = 2608; }
  else if ((it -= 768) < 72) { j = {p.w_uq + (size_t)l * 384 * 768, 768, 384, (bf16_t*)((char*)W + WM_UQ), 12, 6, 0, p.g_cq + l * 384}; }
  else if ((it -= 72) < 32) { j = {p.w_uk + (size_t)l * 256 * 512, 512, 256, (bf16_t*)((char*)W + WM_UKV), 8, 4, 0, p.g_ckv + l * 256}; }
  else if ((it -= 32) < 32) { j = {p.w_uv + (size_t)l * 256 * 512, 512, 256, (bf16_t*)((char*)W + WM_UKV) + 512 * 256, 8, 4, 0, p.g_ckv + l * 256}; }
  else if ((it -= 32) < 128) { j = {p.w_br_mla + (size_t)l * 512 * 1024, 1024, 512, (bf16_t*)((char*)W + WM_BRA), 16, 8, 0, nullptr}; }
  else if ((it -= 128) < 64) { j = {p.w_br_ml + (size_t)l * 256 * 1024, 1024, 256, (bf16_t*)((char*)W + WM_BRM), 16, 4, 0, nullptr}; }
  else if ((it -= 64) < 64) { j = {p.w_br_rw + (size_t)l * 256 * 1024, 1024, 256, (bf16_t*)((char*)W + WM_BRR), 16, 4, 0, nullptr}; }
  else if ((it -= 64) < 256) { j = {p.w_out + (size_t)l * 1024 * 1024, 1024, 1024, (bf16_t*)((char*)W + WM_OUT), 16, 16, 0, nullptr}; }
  else { it -= 256; j = {p.w_router + (size_t)l * 1024 * 64, 64, 1024, (bf16_t*)((char*)W + WM_RT), 1, 16, 0, nullptr}; }
  CvtItem c; c.j = j; c.coff = coff; c.tk = it / j.ntn; c.tn = it % j.ntn; return c;
}
constexpr int CVT_MOE_TILES = 65 * 192;
DI CvtItem cvt_moe_dec(const Params& p, int l, int it) {
  const int e = it / 192; int r = it % 192;
  bf16_t* GU = (bf16_t*)(p.ws + OFF_REGION + R_WMOE + WE_GU) + (size_t)e * 512 * 1024;
  bf16_t* DN = (bf16_t*)(p.ws + OFF_REGION + R_WMOE + WE_DN) + (size_t)e * 1024 * 256;
  const float* sg = e < 64 ? p.w_e_gate + ((size_t)l * 64 + e) * 1024 * 256 : p.w_s_gate + (size_t)l * 1024 * 256;
  const float* su = e < 64 ? p.w_e_up + ((size_t)l * 64 + e) * 1024 * 256 : p.w_s_up + (size_t)l * 1024 * 256;
  const float* sd = e < 64 ? p.w_e_down + ((size_t)l * 64 + e) * 256 * 1024 : p.w_s_down + (size_t)l * 256 * 1024;
  CvtJob j; int coff = 0;
  if (r < 64) { j = {sg, 256, 1024, GU, 4, 16, 2, nullptr}; coff = 0; }
  else if ((r -= 64) < 64) { j = {su, 256, 1024, GU, 4, 16, 2, nullptr}; coff = 1; }
  else { r -= 64; j = {sd, 1024, 256, DN, 16, 4, 0, nullptr}; }
  CvtItem c; c.j = j; c.coff = coff; c.tk = r / j.ntn; c.tn = r % j.ntn; return c;
}

DI void mod_item(const Params& p, int it, char* smem) {
  float* cond = (float*)smem;
  float* red = cond + 3 * 1024;
  const int tid = opaque_tid(), l = it / 96, j0 = (it % 96) * 64;
  __syncthreads();
  for (int i = tid; i < 3 * 1024; i += NTHR) {
    const int r = i >> 10, k = i & 1023;
    const float v = r < 2 ? p.c[r * 1024 + k] : p.c_ctx[k];
    cond[i] = siluf_(v);
  }
  __syncthreads();
  const int c4 = tid & 15, kg = tid >> 4;
  float a[3][4];
#pragma unroll
  for (int r = 0; r < 3; ++r)
#pragma unroll
    for (int q = 0; q < 4; ++q) a[r][q] = 0.f;
  const float* w = p.w_mod + (size_t)l * 1024 * 6144 + j0 + c4 * 4;
#pragma unroll 8
  for (int i = 0; i < 32; ++i) {
    const int k = kg + 32 * i;
    const float4 wv = *(const float4*)(w + (size_t)k * 6144);
#pragma unroll
    for (int r = 0; r < 3; ++r) {
      const float c = cond[r * 1024 + k];
      a[r][0] += c * wv.x; a[r][1] += c * wv.y; a[r][2] += c * wv.z; a[r][3] += c * wv.w;
    }
  }
#pragma unroll
  for (int r = 0; r < 3; ++r) *(float4*)(red + (kg * 3 + r) * 64 + c4 * 4) = make_float4(a[r][0], a[r][1], a[r][2], a[r][3]);
  __syncthreads();
  if (tid < 192) {
    const int r = tid >> 6, jj = tid & 63; float s = 0.f;
    for (int g = 0; g < 32; ++g) s += red[(g * 3 + r) * 64 + jj];
    float* mod = (float*)(p.ws + OFF_MOD);
    mod[((size_t)l * 3 + r) * 6144 + j0 + jj] = s + p.b_mod[(size_t)l * 6144 + j0 + jj];
  }
}
DI void rope_item(const Params& p, int it) {
  const int idx = it * NTHR + threadIdx.x;
  if (idx >= T_ * 16) return;
  const int t = idx >> 4, i = idx & 15, f = i & 7;
  const float pos = (float)(i < 8 ? t / GRID_W_ : t % GRID_W_);
  const float inv = powf(10000.f, -(float)(2 * f) / 16.f);
  const float ang = pos * inv;
  float2* rt = (float2*)(p.ws + OFF_ROPE);
  rt[idx] = make_float2(cosf(ang), sinf(ang));
}
constexpr int PA_ITEMS = 192 + (T_ * 16 + NTHR - 1) / NTHR;
DI void phaseA(const Params& p, char* smem) {
  if (blockIdx.x == 0) for (int i = threadIdx.x; i < 8192; i += NTHR) ((int*)(p.ws + OFF_CNT))[i] = 0;
  for (int it = blockIdx.x; it < PA_ITEMS; it += gridDim.x) {
    if (it < 192) mod_item(p, it, smem); else rope_item(p, it - 192);
  }
  cvt_run([&](int i) { return cvt_mix_dec(p, i / CVT_MIX_TILES, i % CVT_MIX_TILES); }, blockIdx.x, 2 * CVT_MIX_TILES, gridDim.x, smem);
}

DI void row_norm_mod(const float (&v)[16], const float* g, const float* shift, const float* scale, bf16_t* hrow, int lane) {
  float ss = 0.f;
#pragma unroll
  for (int i = 0; i < 16; ++i) ss += v[i] * v[i];
  ss = wave_sum(ss);
  const float rs = frsq(ss * (1.f / 1024.f) + 1e-6f);
#pragma unroll
  for (int j = 0; j < 4; ++j) {
    const int c = (j * 64 + lane) * 4;
    const float4 gg = *(const float4*)(g + c), sh = *(const float4*)(shift + c), sc = *(const float4*)(scale + c);
    const float h0 = v[j * 4 + 0] * rs * gg.x * (1.f + sc.x) + sh.x;
    const float h1 = v[j * 4 + 1] * rs * gg.y * (1.f + sc.y) + sh.y;
    const float h2 = v[j * 4 + 2] * rs * gg.z * (1.f + sc.z) + sh.z;
    const float h3 = v[j * 4 + 3] * rs * gg.w * (1.f + sc.w) + sh.w;
    uint2 o; o.x = pack2bf(h0, h1); o.y = pack2bf(h2, h3);
    *(uint2*)(hrow + c) = o;
  }
}
DI void phase_norm0(const Params& p) {
  const int lane = threadIdx.x & 63, wid = threadIdx.x >> 6;
  float* xs = (float*)(p.ws + OFF_XS);
  bf16_t* H = (bf16_t*)(p.ws + OFF_H);
  const float* mod = (const float*)(p.ws + OFF_MOD);
  for (int n = blockIdx.x * 8 + wid; n < NT_; n += gridDim.x * 8) {
    const float* src = n < NX_ ? p.x + (size_t)n * 1024 : p.ctx + (size_t)(n - NX_) * 1024;
    float v[16];
#pragma unroll
    for (int j = 0; j < 4; ++j) {
      const float4 t = *(const float4*)(src + (j * 64 + lane) * 4);
      v[j * 4] = t.x; v[j * 4 + 1] = t.y; v[j * 4 + 2] = t.z; v[j * 4 + 3] = t.w;
      *(float4*)(xs + (size_t)n * 1024 + (j * 64 + lane) * 4) = t;
    }
    const float* m = mod + (size_t)(0 * 3 + tok_modrow(n)) * 6144;
    row_norm_mod(v, p.g_mix, m, m + 1024, H + (size_t)n * 1024, lane);
  }
}

template <int BM, int BN, int BK, int WM_, int WN_>
struct Gemm {
  static constexpr int WTM = BM / WM_, WTN = BN / WN_, MB = WTM / 32, NB = WTN / 32, WM = WM_, WN = WN_, TM = BM, TN = BN;
  static constexpr int LDA = BK + 8;
  static constexpr int A_BYTES = BM * LDA * 2, B_BYTES = BN * LDA * 2, STAGE = A_BYTES + B_BYTES;
  static constexpr int SMEM = 2 * STAGE;
  static constexpr int CPR = BK / 8;
  static constexpr int ACH = BM * CPR / NTHR, BCH = BN * CPR / NTHR;
  static_assert(WM_ * WN_ == 8, "8 waves");
  static_assert(BM * CPR % NTHR == 0 && BN * CPR % NTHR == 0, "chunking");
  static_assert(NTHR % CPR == 0, "rows fixed per thread");

  template <class LA, class LB>
  static DI void run_core(f32x16 (&acc)[MB][NB], LA la, LB lb, int nk, char* smem, int tid) {
    const int lane = tid & 63, wid = tid >> 6, wm = wid / WN_, wn = wid % WN_;
    const int kc = (tid % CPR) * 8, r0 = tid / CPR;
    constexpr int KS = BK / 16, NCH = ACH + BCH;
    u32x4 s0[NCH], s1[NCH];
#define GEMM_LOAD(dst_, kt_) { const int kq_ = (kt_) < nk ? (kt_) : nk - 1; \
    _Pragma("unroll") for (int i = 0; i < ACH; ++i) dst_[i] = la(i, kq_); \
    _Pragma("unroll") for (int i = 0; i < BCH; ++i) dst_[ACH + i] = lb(i, kq_); }
#define GEMM_WRITE1(src_, c_, buf_) { if ((c_) < ACH) *(u32x4*)(smem + (buf_) * STAGE + ((r0 + (c_) * (NTHR / CPR)) * LDA + kc) * 2) = src_[c_]; \
    else *(u32x4*)(smem + (buf_) * STAGE + A_BYTES + ((r0 + ((c_) - ACH) * (NTHR / CPR)) * LDA + kc) * 2) = src_[c_]; }
#define GEMM_STEP(w_, l_, kt_) { \
    GEMM_LOAD(l_, (kt_) + 2); \
    sched_fence(); \
    const char* As = smem + ((kt_) & 1) * STAGE; const char* Bs = As + A_BYTES; \
    _Pragma("unroll") for (int ks = 0; ks < KS; ++ks) { \
      bf16x8 af[MB], bfr[NB]; \
      _Pragma("unroll") for (int mb = 0; mb < MB; ++mb) af[mb] = *(const bf16x8*)(As + ((wm * WTM + mb * 32 + (lane & 31)) * LDA + ks * 16 + (lane >> 5) * 8) * 2); \
      _Pragma("unroll") for (int nb = 0; nb < NB; ++nb) bfr[nb] = *(const bf16x8*)(Bs + ((wn * WTN + nb * 32 + (lane & 31)) * LDA + ks * 16 + (lane >> 5) * 8) * 2); \
      _Pragma("unroll") for (int c = 0; c < NCH; ++c) if ((c * KS) / NCH == ks) GEMM_WRITE1(w_, c, ((kt_) + 1) & 1); \
      _Pragma("unroll") for (int mb = 0; mb < MB; ++mb) _Pragma("unroll") for (int nb = 0; nb < NB; ++nb) acc[mb][nb] = mfma32(af[mb], bfr[nb], acc[mb][nb]); \
    } \
    sched_fence(); \
    __syncthreads(); }
    GEMM_LOAD(s0, 0);
#pragma unroll
    for (int c = 0; c < NCH; ++c) GEMM_WRITE1(s0, c, 0);
    GEMM_LOAD(s0, 1);
    __syncthreads();
    for (int kt = 0; kt < nk; kt += 2) {
      GEMM_STEP(s0, s1, kt);
      GEMM_STEP(s1, s0, kt + 1);
    }
#undef GEMM_STEP
#undef GEMM_WRITE1
#undef GEMM_LOAD
  }
  template <class ARow>
  static DI void run(f32x16 (&acc)[MB][NB], ARow arow, const bf16_t* Bt, int ldb, int Klen, char* smem) {
    const int tid = opaque_tid();
    const int kc = (tid % CPR) * 8, r0 = tid / CPR;
    const bf16_t* ap[ACH];
#pragma unroll
    for (int i = 0; i < ACH; ++i) ap[i] = arow(r0 + i * (NTHR / CPR)) + kc;
    const bf16_t* bp0 = Bt + (size_t)r0 * ldb + kc;
    const size_t sb = (size_t)(NTHR / CPR) * ldb;
    run_core(acc, [&](int i, int kt) { return *(const u32x4*)(ap[i] + kt * BK); },
             [&](int i, int kt) { return *(const u32x4*)(bp0 + i * sb + kt * BK); }, Klen / BK, smem, tid);
  }
  static DI void run_lin(f32x16 (&acc)[MB][NB], const bf16_t* A0, int lda, const bf16_t* Bt, int ldb, int Klen, char* smem) {
    const int tid = opaque_tid();
    const int kc = (tid % CPR) * 8, r0 = tid / CPR;
    const bf16_t* ap0 = A0 + (size_t)r0 * lda + kc; const bf16_t* bp0 = Bt + (size_t)r0 * ldb + kc;
    const size_t sa = (size_t)(NTHR / CPR) * lda, sb = (size_t)(NTHR / CPR) * ldb;
    run_core(acc, [&](int i, int kt) { return *(const u32x4*)(ap0 + i * sa + kt * BK); },
             [&](int i, int kt) { return *(const u32x4*)(bp0 + i * sb + kt * BK); }, Klen / BK, smem, tid);
  }
  static DI int row_of(int t, int mb, int reg) { const int lane = t & 63, wm = (t >> 6) / WN_; return wm * WTM + mb * 32 + crow(reg, lane >> 5); }
  static DI int col_of(int t, int nb) { const int lane = t & 63, wn = (t >> 6) % WN_; return wn * WTN + nb * 32 + (lane & 31); }
};


template <int NBW> struct WTile {
  static constexpr int LD = NBW * 32 + 4;
  static constexpr int BYTES = 32 * LD * 4;
  static DI void put(float* scr, int nb, int lane, const f32x16& v) {
    const int c = nb * 32 + (lane & 31), h = lane >> 5;
#pragma unroll
    for (int i = 0; i < 16; ++i) scr[crow(i, h) * LD + c] = v[i];
  }
  template <class F> static DI void rows4(const float* scr, int lane, F f) {
    wave_sync();
#pragma unroll
    for (int it = 0; it < NBW * 4; ++it) {
      const int id = it * 64 + lane, row = id / (NBW * 8), q = id % (NBW * 8);
      f(row, q * 4, *(const float4*)(scr + row * LD + q * 4));
    }
    wave_sync();
  }
  template <class F> static DI void rows8(const float* scr, int lane, F f) {
    wave_sync();
#pragma unroll
    for (int it = 0; it < NBW * 2; ++it) {
      const int id = it * 64 + lane, row = id / (NBW * 4), q = id % (NBW * 4);
      f(row, q * 8, *(const float4*)(scr + row * LD + q * 8), *(const float4*)(scr + row * LD + q * 8 + 4));
    }
    wave_sync();
  }
};
DI uint4 pack8bf(const float4& a, const float4& b) { return make_uint4(pack2bf(a.x, a.y), pack2bf(a.z, a.w), pack2bf(b.x, b.y), pack2bf(b.z, b.w)); }

typedef Gemm<256, 256, 64, 2, 4> G256;
DI void phase_win(const Params& p, int l, char* smem) {
  const bf16_t* H = (const bf16_t*)(p.ws + OFF_H);
  const bf16_t* W = (const bf16_t*)(p.ws + OFF_WMIX + (size_t)l * WM_SIZE + WM_WIN);
  bf16_t* zmla = (bf16_t*)(p.osc + O_ZMLA);
  float* zrec = (float*)(p.ws + OFF_REGION + R_ZREC);
  constexpr int TM = NT_ / 256, TN = WIN_N / 256;
  for (int it = vblock(); it < TM * TN; it += gridDim.x) {
    const int tid = opaque_tid();
    const int tm = it / TN, tn = it % TN;
    __syncthreads();
    f32x16 acc[G256::MB][G256::NB];
#pragma unroll
    for (int a = 0; a < G256::MB; ++a)
#pragma unroll
      for (int b = 0; b < G256::NB; ++b) acc[a][b] = zero16();
    const bf16_t* A0 = H + (size_t)tm * 256 * 1024;
    G256::run(acc, [&](int r) { return A0 + (size_t)r * 1024; }, W + (size_t)tn * 256 * 1024, 1024, 1024, smem);
    {
      const int lane = tid & 63, wid = tid >> 6, wm = wid / 4, wn = wid % 4;
      float* scr = (float*)(smem + wid * WTile<2>::BYTES);
      const int col0 = tn * 256 + wn * 64;
#pragma unroll
      for (int mb = 0; mb < G256::MB; ++mb) {
        WTile<2>::put(scr, 0, lane, acc[mb][0]); WTile<2>::put(scr, 1, lane, acc[mb][1]);
        const int row0 = tm * 256 + wm * 128 + mb * 32;
#ifdef ABL_NOSTORE
        if (tn > 1000) {
#else
        if (tn < 3) {
#endif
          WTile<2>::rows8(scr, lane, [&](int r, int c, const float4& a, const float4& bq) {
            *(uint4*)(zmla + (size_t)(row0 + r) * ZMLA_W + col0 + c) = pack8bf(a, bq); });
        } else {
          WTile<2>::rows4(scr, lane, [&](int r, int c, const float4& a) {
            const int cc = col0 - 768 + c;
#ifdef ABL_NOSTORE
            if (cc < -5) *(float4*)(zrec + (size_t)(row0 + r) * ZREC_W + cc) = a; });
#else
            if (cc < ZREC_W) *(float4*)(zrec + (size_t)(row0 + r) * ZREC_W + cc) = a; });
#endif
        }
      }
    }
  }
}
typedef Gemm<128, 128, 64, 2, 4> G128;
DI void mla_row_rs(const bf16_t* zmla_rows, int c0, int len, float* rs) {
  const int tid = opaque_tid(), row = tid >> 2, half = tid & 3;
  const bf16_t* src = zmla_rows + (size_t)row * ZMLA_W + c0 + half * (len / 4);
  float ss = 0.f;
  for (int i = 0; i < len / 4; i += 8) {
    const uint4 v = *(const uint4*)(src + i);
    const unsigned w[4] = {v.x, v.y, v.z, v.w};
#pragma unroll
    for (int j = 0; j < 4; ++j) { const float a = bf2f((bf16_t)(w[j] & 0xffff)), b = bf2f((bf16_t)(w[j] >> 16)); ss += a * a + b * b; }
  }
  ss += __shfl_xor(ss, 1); ss += __shfl_xor(ss, 2);
  if (half == 0) rs[row] = frsq(ss / (float)len + 1e-6f);
}

constexpr int MLA_Q_TILES = (NT_ / 128) * 6, MLA_KV_TILES = (NT_ / 128) * 8;
DI void mla_q_item(const Params& p, int l, int it, char* smem) {
  const int tid = opaque_tid();
  const int tm = it / 6, tn = it % 6;
  const bf16_t* zmla = (const bf16_t*)(p.osc + O_ZMLA) + (size_t)tm * 128 * ZMLA_W;
  const bf16_t* W = (const bf16_t*)(p.ws + OFF_WMIX + (size_t)l * WM_SIZE + WM_UQ) + (size_t)tn * 128 * 384;
  bf16_t* qb = (bf16_t*)(p.osc + O_QB);
  const float2* rt = (const float2*)(p.ws + OFF_ROPE);
  float* rs = (float*)(smem + G128::SMEM);
  __syncthreads();
  mla_row_rs(zmla, 0, 384, rs);
  f32x16 acc[G128::MB][G128::NB];
#pragma unroll
  for (int a = 0; a < G128::MB; ++a)
#pragma unroll
    for (int b = 0; b < G128::NB; ++b) acc[a][b] = zero16();
  G128::run(acc, [&](int r) { return zmla + (size_t)r * ZMLA_W; }, W, 384, 384, smem);
  const int lane = tid & 63;
  const bool isx = tm * 128 < NX_;
#pragma unroll
  for (int mb = 0; mb < G128::MB; ++mb)
#pragma unroll
    for (int nb = 0; nb < G128::NB; ++nb) {
      const int col = tn * 128 + G128::col_of(tid, nb);
      const bool ropeblk = ((col >> 5) % 3) == 2;
      const int e = lane & 31;
#pragma unroll
      for (int i = 0; i < 16; ++i) {
        const int lr = G128::row_of(tid, mb, i);
        const int n = tm * 128 + lr;
        float v = acc[mb][nb][i] * rs[lr];
        if (ropeblk && isx) {
          const float pv = __shfl_xor(v, 8);
          const float2 cs = rt[(size_t)(n % T_) * 16 + (e >> 4) * 8 + (e & 7)];
          v = (e & 8) ? (pv * cs.y + v * cs.x) : (v * cs.x - pv * cs.y);
        }
        qb[(size_t)n * 768 + col] = f2bf(v);
      }
    }
}
DI void mla_kv_item(const Params& p, int l, int it, char* smem) {
  const int tid = opaque_tid();
  const int tm = it / 8, tn = it % 8;
  const bf16_t* zmla = (const bf16_t*)(p.osc + O_ZMLA) + (size_t)tm * 128 * ZMLA_W;
  const bf16_t* W = (const bf16_t*)(p.ws + OFF_WMIX + (size_t)l * WM_SIZE + WM_UKV) + (size_t)tn * 128 * 256;
  bf16_t* kb = (bf16_t*)(p.ws + OFF_REGION + R_KB);
  bf16_t* vt = (bf16_t*)(p.ws + OFF_REGION + R_VT);
  const float2* rt = (const float2*)(p.ws + OFF_ROPE);
  float* rs = (float*)(smem + G128::SMEM);
  __syncthreads();
  mla_row_rs(zmla, 384, 256, rs);
  const int n0 = tm * 128;
  const int b = tok_b(n0), key0 = tok_key(n0);
  const bool isx = n0 < NX_;
  if (tn == 0) {
    for (int idx = tid; idx < 128 * 16; idx += NTHR) {
      const int lr = idx >> 4, pi = idx & 15, a = pi >> 3, i = pi & 7;
      const bf16_t* z = zmla + (size_t)lr * ZMLA_W + 640 + a * 16 + i;
      float x1 = bf2f(z[0]), x2 = bf2f(z[8]);
      if (isx) {
        const float2 cs = rt[(size_t)((n0 + lr) % T_) * 16 + a * 8 + i];
        const float y1 = x1 * cs.x - x2 * cs.y, y2 = x1 * cs.y + x2 * cs.x; x1 = y1; x2 = y2;
      }
      const bf16_t o1 = f2bf(x1), o2 = f2bf(x2);
      for (int h = 0; h < 8; ++h) {
        bf16_t* dst = kb + ((size_t)(b * 8 + h) * KT_ + key0 + lr) * 96 + 64 + a * 16 + i;
        dst[0] = o1; dst[8] = o2;
      }
    }
  }
  f32x16 acc[G128::MB][G128::NB];
#pragma unroll
  for (int a = 0; a < G128::MB; ++a)
#pragma unroll
    for (int c = 0; c < G128::NB; ++c) acc[a][c] = zero16();
  G128::run(acc, [&](int r) { return zmla + (size_t)r * ZMLA_W + 384; }, W, 256, 256, smem);
  const int lane = tid & 63;
#pragma unroll
  for (int mb = 0; mb < G128::MB; ++mb)
#pragma unroll
    for (int nb = 0; nb < G128::NB; ++nb) {
      const int col = tn * 128 + G128::col_of(tid, nb);
      if (col < 512) {
        const int h = col >> 6, d = col & 63;
#pragma unroll
        for (int i = 0; i < 16; ++i) {
          const int lr = G128::row_of(tid, mb, i);
          kb[((size_t)(b * 8 + h) * KT_ + key0 + lr) * 96 + d] = f2bf(acc[mb][nb][i] * rs[lr]);
        }
      } else {
        const int h = (col - 512) >> 6, d = col & 63;
#pragma unroll
        for (int g = 0; g < 4; ++g) {
          const int lr = G128::row_of(tid, mb, g * 4);
          uint2 o;
          o.x = pack2bf(acc[mb][nb][g * 4 + 0] * rs[lr], acc[mb][nb][g * 4 + 1] * rs[lr + 1]);
          o.y = pack2bf(acc[mb][nb][g * 4 + 2] * rs[lr + 2], acc[mb][nb][g * 4 + 3] * rs[lr + 3]);
          *(uint2*)(vt + (size_t)(b * 8 + h) * 64 * KT_ + (size_t)((key0 + lr) >> 6) * 4096 + d * 64 + ((key0 + lr) & 63)) = o;
        }
      }
    }
  (void)lane;
}

DI float softplusf_(float x) { const float e = fexp(-fabsf(x)); return fmaxf(x, 0.f) + (e < 0.01f ? e * (1.f - 0.5f * e) : flog(1.f + e)); }
constexpr int RWP_TT = 16;
constexpr int RWP_ITEMS = NT_ / RWP_TT;
DI void rwkv_prep_items(const Params& p, int l, char* smem) {
  if ((int)blockIdx.x >= RWP_ITEMS) return;
  float* zs = (float*)smem;
  float* tw = zs + RWP_TT * 1024;
  float* ta = tw + 2 * 64 * RWP_TT;
  const float* zrec = (const float*)(p.ws + OFF_REGION + R_ZREC);
  bf16_t* rb = (bf16_t*)(p.ws + OFF_REGION + R_RB16);
  float* lwo = (float*)(p.ws + OFF_REGION + R_LW);
  float* bso = (float*)(p.ws + OFF_REGION + R_BS);
  const float* mu = p.rw_mu + (size_t)l * 1152;
  const int tid = opaque_tid();
  const int col = tid & 255, d = tid >> 8;
  const float* w2 = p.rw_w2 + ((size_t)l * 2 + d) * 64 * 256 + col;
  const float* a2 = p.rw_a2 + ((size_t)l * 2 + d) * 64 * 256 + col;
  const float rkw = p.rw_r_k[(size_t)l * 256 + col];
  const float w0 = p.rw_w0[((size_t)l * 2 + d) * 256 + col], a0 = p.rw_a0[((size_t)l * 2 + d) * 256 + col];
  const float kkw = p.rw_k_k[(size_t)l * 256 + col], kaw = p.rw_k_a[(size_t)l * 256 + col];
  const size_t AS = (size_t)NT_ * 256;
#pragma unroll 1
  for (int it = blockIdx.x; it < RWP_ITEMS; it += gridDim.x) {
    const int n0 = it * RWP_TT;
    __syncthreads();
    TSB(p, 44);
#pragma unroll 1
    for (int i = 0; i < 8; ++i) {
      const int idx4 = tid + i * NTHR, tt = idx4 >> 8, c = (idx4 & 255) * 4, n = n0 + tt, t = tok_t(n);
      const int len = n < NX_ ? T_ : CL_;
      const float* zr = zrec + (size_t)n * ZREC_W + ZR_RW + c;
      const float4 z = *(const float4*)zr;
      const float4 zp = t > 0 ? *(const float4*)(zr - ZREC_W) : make_float4(0.f, 0.f, 0.f, 0.f);
      const float4 zn = t < len - 1 ? *(const float4*)(zr + ZREC_W) : make_float4(0.f, 0.f, 0.f, 0.f);
      const float4 m4 = *(const float4*)(mu + c);
      float4 sv;
      sv.x = z.x + (0.5f * (zp.x + zn.x) - z.x) * m4.x; sv.y = z.y + (0.5f * (zp.y + zn.y) - z.y) * m4.y;
      sv.z = z.z + (0.5f * (zp.z + zn.z) - z.z) * m4.z; sv.w = z.w + (0.5f * (zp.w + zn.w) - z.w) * m4.w;
      *(float4*)(zs + tt * 1024 + c) = sv;
      if (c >= 768) {
        const float e4[4] = {sv.x, sv.y, sv.z, sv.w};
#pragma unroll
        for (int q = 0; q < 4; ++q) {
          const int cc = c + q;
          if (cc < 896) { const int dd = (cc - 768) >> 6, k = (cc - 768) & 63; tw[(dd * 64 + k) * RWP_TT + tt] = 1.f - 2.f * frcp(1.f + fexp(2.f * e4[q])); }
          else { const int dd = (cc - 896) >> 6, k = (cc - 896) & 63; ta[(dd * 64 + k) * RWP_TT + tt] = e4[q]; }
        }
      }
    }
    __syncthreads();
    TSB(p, 45);
#pragma unroll 1
    for (int th = 0; th < RWP_TT; th += 8) {
      float aw[8], aa[8];
#pragma unroll
      for (int i = 0; i < 8; ++i) { aw[i] = 0.f; aa[i] = 0.f; }
#pragma unroll 1
      for (int kh = 0; kh < 4; ++kh) {
        float wr[16], ar[16];
#pragma unroll
        for (int k = 0; k < 16; ++k) { wr[k] = w2[(kh * 16 + k) * 256]; ar[k] = a2[(kh * 16 + k) * 256]; }
#pragma unroll
        for (int k = 0; k < 16; ++k) {
          const float* twk = tw + (d * 64 + kh * 16 + k) * RWP_TT + th;
          const float* tak = ta + (d * 64 + kh * 16 + k) * RWP_TT + th;
#pragma unroll
          for (int i = 0; i < 8; ++i) { aw[i] += twk[i] * wr[k]; aa[i] += tak[i] * ar[k]; }
          if ((k & 3) == 3) sched_fence();
        }
      }
#pragma unroll
      for (int i = 0; i < 8; ++i) {
        const int n = n0 + th + i;
        const float* zr = zs + (th + i) * 1024 + col;
        const float r = zr[0], k = zr[256], v = zr[512];
        const float kr = k * kkw;
        const float ss = wave_sum(kr * kr);
        const float kk = kr * frsq(fmaxf(ss, 1e-24f));
        const float w = -softplusf_(-(w0 + aw[i])) - 0.5f;
        const float logdecay = -fexp(w);
        const float a = sigmoidf_(a0 + aa[i]);
        const float kd = k * (1.f + (a - 1.f) * kaw);
        const float bsum = wave_sum(r * rkw * kd);
        const size_t o = (size_t)n * 256 + col;
        if (d == 0) { rb[0 * AS + o] = f2bf(r); rb[1 * AS + o] = f2bf(v); rb[2 * AS + o] = f2bf(kk); }
        lwo[d * AS + o] = logdecay;
        rb[(3 + 2 * d) * AS + o] = f2bf(kd);
        rb[(4 + 2 * d) * AS + o] = f2bf(kk * a);
        if ((tid & 63) == 0) bso[((size_t)d * NT_ + n) * 4 + (col >> 6)] = bsum;
      }
    }
    TSB(p, 47);
  }
}

DI int seq_tok(int dir, int b, int pos) {
  if (pos < CL_) return NX_ + b * CL_ + (dir ? CL_ - 1 - pos : pos);
  const int t = pos - CL_;
  return b * T_ + (dir ? T_ - 1 - t : t);
}
DI float logsigmoidf_(float x) { return -softplusf_(-x); }
DI float wave_incl_scan(float v, int lane) {
  for (int d = 1; d < 64; d <<= 1) { const float o = __shfl_up(v, d); if (lane >= d) v += o; }
  return v;
}
constexpr int ML_ST = 2112;
constexpr int ML1_ITEMS = NSEQ_ * NCH_;
DI void mlstm_local_item(const Params& p, int l, int it, char* smem) {
  const int s = it / NCH_, c = it % NCH_, dir = s >> 3, b = (s >> 2) & 1, hd = s & 3;
  float* vv = (float*)smem;
  float* kw = vv + 64 * 64;
  float* wej = kw + 64 * 32;
  const float* zrec = (const float*)(p.ws + OFF_REGION + R_ZREC);
  float* st = (float*)(p.ws + OFF_REGION + R_MLST) + ((size_t)s * NCH_ + c) * ML_ST;
  const int tid = opaque_tid(), lane = tid & 63, wid = tid >> 6;
  __syncthreads();
  if (wid == 0) {
    const int n = seq_tok(dir, b, c * 64 + lane);
    const float fp = zrec[(size_t)n * ZREC_W + ZR_MLF + dir * 4 + hd] + p.ml_b_f[(l * 2 + dir) * 4 + hd];
    const float ip = zrec[(size_t)n * ZREC_W + ZR_MLI + dir * 4 + hd] + p.ml_b_i[(l * 2 + dir) * 4 + hd];
    const float bj = wave_incl_scan(logsigmoidf_(fp), lane);
    const float bl = lane_bcast<63>(bj);
    const float lw = bl - bj + ip;
    const float ml = wave_max(lw);
    wej[lane] = fexp(lw - ml);
    if (lane == 0) { st[2080] = bl; st[2081] = ml; }
  }
  for (int idx = tid; idx < 64 * 64; idx += NTHR) {
    const int j = idx >> 6, e = idx & 63;
    const int n = seq_tok(dir, b, c * 64 + j);
    vv[idx] = zrec[(size_t)n * ZREC_W + ZR_MLV + hd * 64 + e];
  }
  __syncthreads();
  for (int idx = tid; idx < 64 * 32; idx += NTHR) {
    const int j = idx >> 5, e = idx & 31;
    const int n = seq_tok(dir, b, c * 64 + j);
    kw[idx] = zrec[(size_t)n * ZREC_W + ZR_MLK + hd * 32 + e] * wej[j];
  }
  __syncthreads();
  const int v = tid & 63, d0 = (tid >> 6) * 4;
  float a0 = 0.f, a1 = 0.f, a2 = 0.f, a3 = 0.f;
  for (int j = 0; j < 64; ++j) {
    const float x = vv[j * 64 + v];
    const float4 kk = *(const float4*)(kw + j * 32 + d0);
    a0 += x * kk.x; a1 += x * kk.y; a2 += x * kk.z; a3 += x * kk.w;
  }
  *(float4*)(st + v * 32 + d0) = make_float4(a0, a1, a2, a3);
  if (tid < 32) { float sn = 0.f; for (int j = 0; j < 64; ++j) sn += kw[j * 32 + tid]; st[2048 + tid] = sn; }
}
constexpr int ML2_ITEMS = (NSEQ_ * 2080 + NTHR - 1) / NTHR;
DI void mlstm_scan_item(const Params& p, int it) {
  const int g = it * NTHR + opaque_tid();
  if (g >= NSEQ_ * 2080) return;
  const int s = g / 2080, e = g % 2080;
  float* st = (float*)(p.ws + OFF_REGION + R_MLST) + (size_t)s * NCH_ * ML_ST;
  float state = 0.f, m = 0.f;
  static_assert(NCH_ % 4 == 0, "chunk count");
  for (int c0 = 0; c0 < NCH_; c0 += 4) {
    float d[4], bl[4], ml[4];
#pragma unroll
    for (int u = 0; u < 4; ++u) { const float* r = st + (size_t)(c0 + u) * ML_ST; d[u] = r[e]; bl[u] = r[2080]; ml[u] = r[2081]; }
#pragma unroll
    for (int u = 0; u < 4; ++u) {
      float* r = st + (size_t)(c0 + u) * ML_ST;
      r[e] = state;
      if (e == 0) r[2082] = m;
      const float mn = fmaxf(bl[u] + m, ml[u]);
      state = fexp(bl[u] + m - mn) * state + fexp(ml[u] - mn) * d[u];
      m = mn;
    }
  }
}

DI void phase3(const Params& p, int l, char* smem) {
  rwkv_prep_items(p, l, smem);
  for (int it = (int)gridDim.x - 1 - (int)blockIdx.x; it < ML1_ITEMS; it += gridDim.x) { TSB(p, 56); mlstm_local_item(p, l, it, smem); TSB(p, 57); }
}
constexpr int RW_LD = 72, RW_MB = 64 * RW_LD * 2;
constexpr int RWC_REC = 40960;
DI char* rw_rec(const Params& p, int s, int c) { return p.ws + OFF_REGION + R_CH + ((size_t)s * NCH_ + c) * RWC_REC; }
DI f32x16 rw_mm(const char* A, const char* Bt, int mb, int nb, int lane, f32x16 acc) {
  const int r = lane & 31, h = lane >> 5;
#pragma unroll
  for (int ks = 0; ks < 4; ++ks) {
    const bf16x8 a = *(const bf16x8*)(A + ((mb * 32 + r) * RW_LD + ks * 16 + h * 8) * 2);
    const bf16x8 b = *(const bf16x8*)(Bt + ((nb * 32 + r) * RW_LD + ks * 16 + h * 8) * 2);
    acc = mfma32(a, b, acc);
  }
  return acc;
}
DI void rw_wrT(char* Dst, int mb, int nb, int lane, const f32x16& v) {
  const int r = lane & 31, h = lane >> 5;
#pragma unroll
  for (int g = 0; g < 4; ++g) {
    uint2 o; o.x = pack2bf(v[4 * g], v[4 * g + 1]); o.y = pack2bf(v[4 * g + 2], v[4 * g + 3]);
    *(uint2*)(Dst + ((nb * 32 + r) * RW_LD + mb * 32 + 8 * g + 4 * h) * 2) = o;
  }
}
DI void rw_wrT_g(bf16_t* Dst, int mb, int nb, int lane, const f32x16& v) {
  const int r = lane & 31, h = lane >> 5;
#pragma unroll
  for (int g = 0; g < 4; ++g) {
    uint2 o; o.x = pack2bf(v[4 * g], v[4 * g + 1]); o.y = pack2bf(v[4 * g + 2], v[4 * g + 3]);
    *(uint2*)(Dst + (nb * 32 + r) * 64 + mb * 32 + 8 * g + 4 * h) = o;
  }
}
DI void rw_addT(const char* Src, int mb, int nb, int lane, f32x16& v) {
  const int r = lane & 31, h = lane >> 5;
#pragma unroll
  for (int g = 0; g < 4; ++g) {
    const uint2 u = *(const uint2*)(Src + ((nb * 32 + r) * RW_LD + mb * 32 + 8 * g + 4 * h) * 2);
    v[4 * g] += bf2f((bf16_t)(u.x & 0xffff)); v[4 * g + 1] += bf2f((bf16_t)(u.x >> 16));
    v[4 * g + 2] += bf2f((bf16_t)(u.y & 0xffff)); v[4 * g + 3] += bf2f((bf16_t)(u.y >> 16));
  }
}
DI void rw_mask_upper(f32x16& v, int mb, int nb, int lane, bool strict) {
  const int col = nb * 32 + (lane & 31), h = lane >> 5;
#pragma unroll
  for (int i = 0; i < 16; ++i) { const int row = mb * 32 + crow(i, h); if (strict ? !(row < col) : !(row <= col)) v[i] = 0.f; }
}
DI void rw_mask_lower_strict(f32x16& v, int mb, int nb, int lane) {
  const int col = nb * 32 + (lane & 31), h = lane >> 5;
#pragma unroll
  for (int i = 0; i < 16; ++i) { const int row = mb * 32 + crow(i, h); if (!(col < row)) v[i] = 0.f; }
}

constexpr int RW1_ITEMS = NSEQ_ * NCH_;
DI void rw_chunk_item(const Params& p, int it, char* smem) {
  const int s = it / NCH_, c = it % NCH_, dir = s >> 3, b = (s >> 2) & 1, hd = s & 3;
  const int tid = opaque_tid(), lane = tid & 63, wid = tid >> 6;
  const bf16_t* rb = (const bf16_t*)(p.ws + OFF_REGION + R_RB16);
  const float* lwg = (const float*)(p.ws + OFF_REGION + R_LW) + (size_t)dir * NT_ * 256;
  const size_t AS = (size_t)NT_ * 256;
  char* const At = smem + 0 * RW_MB; char* const Bt_ = smem + 1 * RW_MB; char* const Kt = smem + 2 * RW_MB; char* const Rt = smem + 3 * RW_MB;
  char* const Aj = smem + 4 * RW_MB; char* const Bj = smem + 5 * RW_MB; char* const Kj = smem + 6 * RW_MB; char* const Vi = smem + 7 * RW_MB;
  char* const QA = smem + 8 * RW_MB; char* const QTA = smem + 9 * RW_MB; char* const GA = smem + 10 * RW_MB;
  char* const Mka = smem + 11 * RW_MB; char* const MbrT = smem + 12 * RW_MB; char* const MkrT = smem + 13 * RW_MB;
  char* const QB = At; char* const QTB = Bt_; char* const GB = Kt;
  float* const cs = (float*)(smem + 8 * RW_MB);
  float* const gC = (float*)(smem + 14 * RW_MB);
  char* rec = rw_rec(p, s, c);
  __syncthreads();
  const int t = tid >> 3, j8 = (tid & 7) * 8;
  const int n = seq_tok(dir, b, c * 64 + t);
  {
    const float4 l0 = *(const float4*)(lwg + (size_t)n * 256 + hd * 64 + j8), l1 = *(const float4*)(lwg + (size_t)n * 256 + hd * 64 + j8 + 4);
    float* d = cs + t * 65 + j8;
    d[0] = l0.x; d[1] = l0.y; d[2] = l0.z; d[3] = l0.w; d[4] = l1.x; d[5] = l1.y; d[6] = l1.z; d[7] = l1.w;
  }
  __syncthreads();
  if (tid < 64) { float a = 0.f; for (int tt = 0; tt < 64; ++tt) { a += cs[tt * 65 + tid]; cs[tt * 65 + tid] = a; } gC[tid] = fexp(a); }
  __syncthreads();
  {
    const size_t o = (size_t)n * 256 + hd * 64 + j8;
    const uint4 ukk = *(const uint4*)(rb + 2 * AS + o), ubb = *(const uint4*)(rb + (4 + 2 * dir) * AS + o), ukd = *(const uint4*)(rb + (3 + 2 * dir) * AS + o);
    const uint4 ur = *(const uint4*)(rb + 0 * AS + o), uv = *(const uint4*)(rb + 1 * AS + o);
    const unsigned akk[4] = {ukk.x, ukk.y, ukk.z, ukk.w}, abb[4] = {ubb.x, ubb.y, ubb.z, ubb.w}, akd[4] = {ukd.x, ukd.y, ukd.z, ukd.w};
    const unsigned ar[4] = {ur.x, ur.y, ur.z, ur.w}, av[4] = {uv.x, uv.y, uv.z, uv.w};
    unsigned oa[4], ob[4], ok[4], orr[4];
#pragma unroll
    for (int q = 0; q < 4; ++q) {
      float fa[2], fb[2], fk[2], fr[2];
#pragma unroll
      for (int e = 0; e < 2; ++e) {
        const int j = j8 + 2 * q + e;
        const float cst = cs[t * 65 + j], csp = t > 0 ? cs[(t - 1) * 65 + j] : 0.f;
        const float g = fexp(cst), gp = fexp(csp), gi = fexp(-cst);
        const int sh = 16 * e;
        fa[e] = -bf2f((bf16_t)((akk[q] >> sh) & 0xffff)) * gp;
        fb[e] = bf2f((bf16_t)((abb[q] >> sh) & 0xffff)) * gi;
        fk[e] = bf2f((bf16_t)((akd[q] >> sh) & 0xffff)) * gi;
        fr[e] = bf2f((bf16_t)((ar[q] >> sh) & 0xffff)) * g;
        *(bf16_t*)(Aj + (j * RW_LD + t) * 2) = f2bf(fa[e]);
        *(bf16_t*)(Bj + (j * RW_LD + t) * 2) = f2bf(fb[e]);
        *(bf16_t*)(Kj + (j * RW_LD + t) * 2) = f2bf(fk[e]);
        *(bf16_t*)(Vi + (j * RW_LD + t) * 2) = (bf16_t)((av[q] >> sh) & 0xffff);
      }
      oa[q] = pack2bf(fa[0], fa[1]); ob[q] = pack2bf(fb[0], fb[1]); ok[q] = pack2bf(fk[0], fk[1]); orr[q] = pack2bf(fr[0], fr[1]);
    }
    *(uint4*)(At + (t * RW_LD + j8) * 2) = make_uint4(oa[0], oa[1], oa[2], oa[3]);
    *(uint4*)(Bt_ + (t * RW_LD + j8) * 2) = make_uint4(ob[0], ob[1], ob[2], ob[3]);
    *(uint4*)(Kt + (t * RW_LD + j8) * 2) = make_uint4(ok[0], ok[1], ok[2], ok[3]);
    *(uint4*)(Rt + (t * RW_LD + j8) * 2) = make_uint4(orr[0], orr[1], orr[2], orr[3]);
  }
  __syncthreads();
  {
    const int prod = wid >> 2, mb = (wid >> 1) & 1, nb = wid & 1;
    f32x16 acc = zero16();
    if (prod == 0) {
      if (!(mb == 1 && nb == 0)) acc = rw_mm(Bt_, At, mb, nb, lane, acc);
      rw_mask_upper(acc, mb, nb, lane, true);
      rw_wrT(QA, mb, nb, lane, acc);
      if (mb == nb) {
        const int col = nb * 32 + (lane & 31), h = lane >> 5;
#pragma unroll
        for (int i = 0; i < 16; ++i) if (mb * 32 + crow(i, h) == col) acc[i] += 1.f;
      }
      rw_wrT(GA, mb, nb, lane, acc);
    } else {
      if (!(mb == 0 && nb == 1)) acc = rw_mm(At, Bt_, mb, nb, lane, acc);
      rw_mask_lower_strict(acc, mb, nb, lane);
      rw_wrT(QTA, mb, nb, lane, acc);
    }
  }
  for (int blk = wid; blk < 12; blk += 8) {
    const int prod = blk >> 2, mb = (blk >> 1) & 1, nb = blk & 1;
    f32x16 acc = zero16();
    if (prod == 0) {
      acc = rw_mm(At, Kt, mb, nb, lane, acc); rw_mask_lower_strict(acc, mb, nb, lane); rw_wrT(Mka, mb, nb, lane, acc);
    } else if (prod == 1) {
      acc = rw_mm(Bt_, Rt, mb, nb, lane, acc); rw_mask_upper(acc, mb, nb, lane, false); rw_wrT(MbrT, mb, nb, lane, acc);
    } else {
      acc = rw_mm(Kt, Rt, mb, nb, lane, acc); rw_mask_upper(acc, mb, nb, lane, false); rw_wrT(MkrT, mb, nb, lane, acc);
    }
  }
  __syncthreads();
#define RW_SQ(Q_, Qt_, Qn_, Qtn_, blk) { const int pr_ = (blk) >> 2, mb_ = ((blk) >> 1) & 1, nb_ = (blk) & 1; f32x16 acc_ = zero16(); \
    if (pr_ == 0) { acc_ = rw_mm(Q_, Qt_, mb_, nb_, lane, acc_); rw_wrT(Qtn_, mb_, nb_, lane, acc_); } \
    else { acc_ = rw_mm(Qt_, Q_, mb_, nb_, lane, acc_); rw_wrT(Qn_, mb_, nb_, lane, acc_); } }
#define RW_GUP(Qt_, G_, Gn_, blk) { const int mb_ = ((blk) >> 1) & 1, nb_ = (blk) & 1; f32x16 acc_ = zero16(); \
    rw_addT(G_, mb_, nb_, lane, acc_); acc_ = rw_mm(Qt_, G_, mb_, nb_, lane, acc_); rw_wrT(Gn_, mb_, nb_, lane, acc_); }
  RW_SQ(QA, QTA, QB, QTB, wid);
  __syncthreads();
  for (int blk = wid; blk < 12; blk += 8) { if (blk < 8) { RW_SQ(QB, QTB, QA, QTA, blk); } else { RW_GUP(QTB, GA, GB, blk - 8); } }
  __syncthreads();
  for (int blk = wid; blk < 12; blk += 8) { if (blk < 8) { RW_SQ(QA, QTA, QB, QTB, blk); } else { RW_GUP(QTA, GB, GA, blk - 8); } }
  __syncthreads();
  for (int blk = wid; blk < 12; blk += 8) { if (blk < 8) { RW_SQ(QB, QTB, QA, QTA, blk); } else { RW_GUP(QTB, GA, GB, blk - 8); } }
  __syncthreads();
  for (int blk = wid; blk < 12; blk += 8) { if (blk < 8) { RW_SQ(QA, QTA, QB, QTB, blk); } else { RW_GUP(QTA, GB, GA, blk - 8); } }
  __syncthreads();
  if (wid < 4) { RW_GUP(QTB, GA, GB, wid); }
  __syncthreads();
  {
    const int prod = wid >> 2, mb = (wid >> 1) & 1, nb = wid & 1;
    f32x16 acc = zero16();
    acc = rw_mm(GB, prod == 0 ? Mka : Aj, mb, nb, lane, acc);
    rw_wrT(prod == 0 ? QA : QTA, mb, nb, lane, acc);
  }
  __syncthreads();
  char* const X1 = QA; char* const X2 = QTA; char* const QpT = At;
  for (int blk = wid; blk < 16; blk += 8) {
    const int prod = blk >> 2, mb = (blk >> 1) & 1, nb = blk & 1;
    f32x16 acc = zero16();
    if (prod == 0) {
      rw_addT(MkrT, mb, nb, lane, acc); acc = rw_mm(X1, MbrT, mb, nb, lane, acc); rw_mask_upper(acc, mb, nb, lane, false);
      rw_wrT_g((bf16_t*)(rec + 8192), mb, nb, lane, acc);
    } else if (prod == 1) {
      rw_addT(Rt, mb, nb, lane, acc); acc = rw_mm(X2, MbrT, mb, nb, lane, acc);
      rw_wrT_g((bf16_t*)(rec), mb, nb, lane, acc);
    } else if (prod == 2) {
      acc = rw_mm(X2, Bj, mb, nb, lane, acc);
      const int col = nb * 32 + (lane & 31), h = lane >> 5; const float gc = gC[col];
#pragma unroll
      for (int i = 0; i < 16; ++i) { if (mb * 32 + crow(i, h) == col) acc[i] += 1.f; acc[i] *= gc; }
      rw_wrT_g((bf16_t*)(rec + 16384), mb, nb, lane, acc);
    } else {
      rw_addT(Kj, mb, nb, lane, acc); acc = rw_mm(X1, Bj, mb, nb, lane, acc);
      const float gc = gC[nb * 32 + (lane & 31)];
#pragma unroll
      for (int i = 0; i < 16; ++i) acc[i] *= gc;
      rw_wrT(QpT, mb, nb, lane, acc);
    }
  }
  __syncthreads();
  if (wid < 4) {
    const int mb = (wid >> 1) & 1, nb = wid & 1, r = lane & 31, h = lane >> 5;
    f32x16 acc = zero16();
    acc = rw_mm(QpT, Vi, mb, nb, lane, acc);
    float* dq = (float*)(rec + 24576);
#pragma unroll
    for (int g = 0; g < 4; ++g)
      *(float4*)(dq + (nb * 32 + r) * 64 + mb * 32 + 8 * g + 4 * h) = make_float4(acc[4 * g], acc[4 * g + 1], acc[4 * g + 2], acc[4 * g + 3]);
  }
}

constexpr int RW2_ITEMS = NSEQ_;
constexpr int RW2_DQLD = 68;
constexpr int RW2_STAGE = RW_MB + 64 * RW2_DQLD * 4;
constexpr int RW2_GRP = 2;
static_assert(NCH_ % RW2_GRP == 0, "chunk groups");
DI void rw_state_item(const Params& p, int s, char* smem) {
  const int tid = opaque_tid(), lane = tid & 63, wid = tid >> 6, r = lane & 31, h = lane >> 5;
  f32x16 S0 = zero16(), S1 = zero16();
  u32x4 rp[RW2_GRP], rd0[RW2_GRP], rd1[RW2_GRP];
  const int prow = tid >> 3, pcol = (tid & 7) * 8;
#define RW2_LOAD(g_) { _Pragma("unroll") for (int u = 0; u < RW2_GRP; ++u) { const char* rec_ = rw_rec(p, s, (g_) * RW2_GRP + u); \
    rp[u] = *(const u32x4*)(rec_ + 16384 + (prow * 64 + pcol) * 2); \
    rd0[u] = *(const u32x4*)(rec_ + 24576 + (prow * 64 + pcol) * 4); rd1[u] = *(const u32x4*)(rec_ + 24576 + (prow * 64 + pcol + 4) * 4); } }
#define RW2_STORE(buf_) { _Pragma("unroll") for (int u = 0; u < RW2_GRP; ++u) { char* d_ = smem + ((buf_) * RW2_GRP + u) * RW2_STAGE; \
    *(u32x4*)(d_ + (prow * RW_LD + pcol) * 2) = rp[u]; \
    *(u32x4*)(d_ + RW_MB + (prow * RW2_DQLD + pcol) * 4) = rd0[u]; *(u32x4*)(d_ + RW_MB + (prow * RW2_DQLD + pcol + 4) * 4) = rd1[u]; } }
  __syncthreads();
  RW2_LOAD(0); RW2_STORE(0);
  __syncthreads();
  constexpr int NG = NCH_ / RW2_GRP;
  for (int g = 0; g < NG; ++g) {
    { const int gn = g + 1 < NG ? g + 1 : g; RW2_LOAD(gn); }
    sched_fence();
    if (wid < 2) {
#pragma unroll
      for (int u = 0; u < RW2_GRP; ++u) {
        const int c = g * RW2_GRP + u;
        const char* PT = smem + ((g & 1) * RW2_GRP + u) * RW2_STAGE;
        const float* DQ = (const float*)(PT + RW_MB);
        const int i = wid * 32 + r;
        bf16_t* sd = (bf16_t*)(rw_rec(p, s, c) + 16384);
#pragma unroll
        for (int q = 0; q < 4; ++q) {
          uint2 o0, o1;
          o0.x = pack2bf(S0[4 * q], S0[4 * q + 1]); o0.y = pack2bf(S0[4 * q + 2], S0[4 * q + 3]);
          o1.x = pack2bf(S1[4 * q], S1[4 * q + 1]); o1.y = pack2bf(S1[4 * q + 2], S1[4 * q + 3]);
          *(uint2*)(sd + i * 64 + 8 * q + 4 * h) = o0; *(uint2*)(sd + i * 64 + 32 + 8 * q + 4 * h) = o1;
        }
        bf16x8 bfr[2][2];
#pragma unroll
        for (int s2 = 0; s2 < 2; ++s2) {
          const u32x4 u0 = {pack2bf(S0[8 * s2], S0[8 * s2 + 1]), pack2bf(S0[8 * s2 + 2], S0[8 * s2 + 3]), pack2bf(S0[8 * s2 + 4], S0[8 * s2 + 5]), pack2bf(S0[8 * s2 + 6], S0[8 * s2 + 7])};
          const u32x4 u1 = {pack2bf(S1[8 * s2], S1[8 * s2 + 1]), pack2bf(S1[8 * s2 + 2], S1[8 * s2 + 3]), pack2bf(S1[8 * s2 + 4], S1[8 * s2 + 5]), pack2bf(S1[8 * s2 + 6], S1[8 * s2 + 7])};
          __builtin_memcpy(&bfr[0][s2], &u0, 16); __builtin_memcpy(&bfr[1][s2], &u1, 16);
        }
        f32x16 n0, n1;
#pragma unroll
        for (int q = 0; q < 4; ++q) {
          const float4 a = *(const float4*)(DQ + i * RW2_DQLD + 8 * q + 4 * h), bq = *(const float4*)(DQ + i * RW2_DQLD + 32 + 8 * q + 4 * h);
          n0[4 * q] = a.x; n0[4 * q + 1] = a.y; n0[4 * q + 2] = a.z; n0[4 * q + 3] = a.w;
          n1[4 * q] = bq.x; n1[4 * q + 1] = bq.y; n1[4 * q + 2] = bq.z; n1[4 * q + 3] = bq.w;
        }
#pragma unroll
        for (int jb2 = 0; jb2 < 2; ++jb2)
#pragma unroll
          for (int s2 = 0; s2 < 2; ++s2) {
            const char* a0 = PT + ((0 * 32 + r) * RW_LD + jb2 * 32 + 16 * s2 + 4 * h) * 2;
            const char* a1 = PT + ((1 * 32 + r) * RW_LD + jb2 * 32 + 16 * s2 + 4 * h) * 2;
            const uint2 l0 = *(const uint2*)a0, h0 = *(const uint2*)(a0 + 16), l1 = *(const uint2*)a1, h1 = *(const uint2*)(a1 + 16);
            const u32x4 u0 = {l0.x, l0.y, h0.x, h0.y}, u1 = {l1.x, l1.y, h1.x, h1.y};
            bf16x8 af0, af1; __builtin_memcpy(&af0, &u0, 16); __builtin_memcpy(&af1, &u1, 16);
            n0 = mfma32(af0, bfr[jb2][s2], n0);
            n1 = mfma32(af1, bfr[jb2][s2], n1);
          }
        S0 = n0; S1 = n1;
      }
    }
    sched_fence();
    RW2_STORE((g + 1) & 1);
    __syncthreads();
  }
}

DI void rw_out_item(const Params& p, int it, char* smem) {
  const int s = it / NCH_, c = it % NCH_, dir = s >> 3, b = (s >> 2) & 1, hd = s & 3;
  const int tid = opaque_tid(), lane = tid & 63, wid = tid >> 6;
  const bf16_t* rb = (const bf16_t*)(p.ws + OFF_REGION + R_RB16);
  const size_t AS = (size_t)NT_ * 256;
  float* ys = (float*)(p.ws + OFF_REGION + R_YS) + (size_t)dir * NT_ * 256;
  char* const Sm = smem; char* const RyT = smem + RW_MB; char* const MyT = smem + 2 * RW_MB; char* const Vi = smem + 3 * RW_MB;
  const char* rec = rw_rec(p, s, c);
  __syncthreads();
  {
    const int row = tid >> 3, col = (tid & 7) * 8;
    *(uint4*)(Sm + (row * RW_LD + col) * 2) = *(const uint4*)(rec + 16384 + (row * 64 + col) * 2);
    *(uint4*)(RyT + (row * RW_LD + col) * 2) = *(const uint4*)(rec + (row * 64 + col) * 2);
    *(uint4*)(MyT + (row * RW_LD + col) * 2) = *(const uint4*)(rec + 8192 + (row * 64 + col) * 2);
    const int n = seq_tok(dir, b, c * 64 + row);
    const uint4 uv = *(const uint4*)(rb + 1 * AS + (size_t)n * 256 + hd * 64 + col);
    const unsigned av[4] = {uv.x, uv.y, uv.z, uv.w};
#pragma unroll
    for (int q = 0; q < 4; ++q) {
      *(bf16_t*)(Vi + ((col + 2 * q) * RW_LD + row) * 2) = (bf16_t)(av[q] & 0xffff);
      *(bf16_t*)(Vi + ((col + 2 * q + 1) * RW_LD + row) * 2) = (bf16_t)(av[q] >> 16);
    }
  }
  __syncthreads();
  if (wid < 4) {
    const int mb = (wid >> 1) & 1, nb = wid & 1, r = lane & 31, h = lane >> 5;
    f32x16 acc = zero16();
    acc = rw_mm(Sm, RyT, mb, nb, lane, acc);
    acc = rw_mm(Vi, MyT, mb, nb, lane, acc);
    const int n = seq_tok(dir, b, c * 64 + nb * 32 + r);
#pragma unroll
    for (int g = 0; g < 4; ++g)
      *(float4*)(ys + (size_t)n * 256 + hd * 64 + mb * 32 + 8 * g + 4 * h) = make_float4(acc[4 * g], acc[4 * g + 1], acc[4 * g + 2], acc[4 * g + 3]);
  }
}
constexpr int ATT_KLD = 104, ATT_VLD = 68;
constexpr int ATT_KB = 64 * ATT_KLD * 2, ATT_VB = 64 * ATT_VLD * 2, ATT_STAGE = ATT_KB + ATT_VB;
DI float fexp2(float x) {
#ifdef EMU
  return exp2f(x);
#else
  return __builtin_amdgcn_exp2f(x);
#endif
}
#ifdef ABL_A1
#define ABL_NOSYNC
#define ABL_ZERO
#endif
#ifdef ABL_A2
#define ABL_NOSYNC
#define ABL_NOLOAD
#define ABL_NOSTORE
#define ABL_ZERO
#endif
#ifdef ABL_A3
#define ABL_NOSYNC
#define ABL_NOLOAD
#define ABL_NOSTORE
#define ABL_ZERO
#define ABL_NOEXP
#endif
#ifdef ABL_NOPV
#define ABL_PV_BEGIN if (t > 100000) {
#define ABL_PV_END }
#else
#define ABL_PV_BEGIN
#define ABL_PV_END
#endif
#ifdef ABL_NOLOAD
#define ABL_LOADS2(s_, tk, tv)
#else
#define ABL_LOADS2(s_, tk, tv) ATT_LOADK(s_, tk); ATT_LOADV(s_, tv);
#endif
#ifdef ABL_NOSTORE
#define ABL_STORES(w_, t)
#else
#define ABL_STORES(w_, t) ATT_STOREK(w_, t & 1); ATT_STOREV(w_, (t + 1) & 1);
#endif
#ifdef ABL_NOSYNC
#define ABL_SYNC()
#else
#define ABL_SYNC() __syncthreads()
#endif
#ifdef ABL_NOEXP
#define ABL_EXP(x) (x)
#else
#define ABL_EXP(x) fexp2(x)
#endif
constexpr int ATT_LDS = 2 * ATT_KB + 2 * ATT_VB;
DI void attn_item(const Params& p, int b, int h, int qt, bool isctx, char* smem) {
  const int tid = opaque_tid(), lane = tid & 63, wid = tid >> 6, r = lane & 31, h2 = lane >> 5;
  const bf16_t* qb = (const bf16_t*)(p.osc + O_QB);
  const bf16_t* kbase = (const bf16_t*)(p.ws + OFF_REGION + R_KB) + (size_t)(b * 8 + h) * KT_ * 96;
  const bf16_t* vbase = (const bf16_t*)(p.ws + OFF_REGION + R_VT) + (size_t)(b * 8 + h) * 64 * KT_;
  bf16_t* att = (bf16_t*)(p.ws + OFF_REGION + R_ATT);
  const int nq0 = isctx ? NX_ + b * CL_ + qt * 256 : b * T_ + qt * 256;
  const int nkt = (isctx ? CL_ : KT_) / 64;
  const int nq = nq0 + wid * 32 + r;
  bf16x8 qf[6];
#pragma unroll
  for (int ks = 0; ks < 6; ++ks) qf[ks] = *(const bf16x8*)(qb + (size_t)nq * 768 + h * 96 + ks * 16 + h2 * 8);
  f32x16 oacc[2] = {zero16(), zero16()};
  float m = -1e30f, lsum = 0.f;
  const float sc = 0.10206207261596577f * 1.4426950408889634f;
  char* const Kst = smem;
  char* const Vst = smem + 2 * ATT_KB;
  const int kc1 = tid + 512, vd = tid >> 3, vc = tid & 7;
  const int ko0 = ((tid / 12) * ATT_KLD + (tid % 12) * 8) * 2, ko1 = ((kc1 / 12) * ATT_KLD + (kc1 % 12) * 8) * 2;
  const int vo = (vd * ATT_VLD + vc * 8) * 2;
  u32x4 ak0, ak1 = {0u, 0u, 0u, 0u}, av, bk0, bk1 = {0u, 0u, 0u, 0u}, bv;
#define ATT_LOADK(s_, kt_) { const bf16_t* ksrc_ = kbase + (size_t)(kt_) * 64 * 96; s_##k0 = *(const u32x4*)(ksrc_ + tid * 8); if (kc1 < 768) s_##k1 = *(const u32x4*)(ksrc_ + kc1 * 8); }
#define ATT_LOADV(s_, kt_) { s_##v = *(const u32x4*)(vbase + (size_t)(kt_) * 4096 + tid * 8); }
#define ATT_STOREK(s_, st_) { char* d_ = Kst + (st_) * ATT_KB; *(u32x4*)(d_ + ko0) = s_##k0; if (kc1 < 768) *(u32x4*)(d_ + ko1) = s_##k1; }
#define ATT_STOREV(s_, st_) { char* d_ = Vst + (st_) * ATT_VB; *(uint2*)(d_ + vo) = make_uint2(s_##v[0], s_##v[1]); *(uint2*)(d_ + vo + 8) = make_uint2(s_##v[2], s_##v[3]); }
#define ATT_QK(dst_, st_) { const char* Ks_ = Kst + (st_) * ATT_KB; dst_[0] = zero16(); dst_[1] = zero16(); \
    _Pragma("unroll") for (int ks = 0; ks < 6; ++ks) _Pragma("unroll") for (int kb = 0; kb < 2; ++kb) { \
      const bf16x8 kf_ = *(const bf16x8*)(Ks_ + ((kb * 32 + r) * ATT_KLD + ks * 16 + h2 * 8) * 2); dst_[kb] = mfma32(kf_, qf[ks], dst_[kb]); } }
  __syncthreads();
  ATT_LOADK(a, 0); ATT_LOADV(a, 0); ATT_STOREK(a, 0); ATT_STOREV(a, 0);
  ATT_LOADK(a, 1); ATT_STOREK(a, 1);
  ATT_LOADK(a, (2 < nkt ? 2 : nkt - 1)); ATT_LOADV(a, 1);
  __syncthreads();
  f32x16 sA[2], sB[2];
  ATT_QK(sA, 0);
  __syncthreads();
#define ATT_SMPV(cur_, t) { \
    float mx = -1e30f; \
    _Pragma("unroll") for (int kb = 0; kb < 2; ++kb) _Pragma("unroll") for (int i = 0; i < 16; ++i) mx = fmaxf(mx, cur_[kb][i]); \
    mx = fmaxf(mx, __shfl_xor(mx, 32)); \
    const float mn = fmaxf(m, mx * sc); \
    if (__ballot(mn > m) != 0ull) { \
      const float alpha = fexp2(m - mn); \
      _Pragma("unroll") for (int db = 0; db < 2; ++db) _Pragma("unroll") for (int i = 0; i < 16; ++i) oacc[db][i] *= alpha; \
      lsum *= alpha; m = mn; } \
    _Pragma("unroll") for (int kb = 0; kb < 2; ++kb) _Pragma("unroll") for (int i = 0; i < 16; ++i) cur_[kb][i] = ABL_EXP(cur_[kb][i] * sc - m); \
    { float ps0 = 0.f, ps1 = 0.f; _Pragma("unroll") for (int i = 0; i < 16; ++i) { ps0 += cur_[0][i]; ps1 += cur_[1][i]; } lsum += ps0 + ps1; } \
    const char* Vs = Vst + ((t) & 1) * ATT_VB; \
    _Pragma("unroll") for (int kb = 0; kb < 2; ++kb) _Pragma("unroll") for (int s2 = 0; s2 < 2; ++s2) { \
      bf16x8 pf; { const u32x4 u = {pack2bf(cur_[kb][8 * s2 + 0], cur_[kb][8 * s2 + 1]), pack2bf(cur_[kb][8 * s2 + 2], cur_[kb][8 * s2 + 3]), \
                                    pack2bf(cur_[kb][8 * s2 + 4], cur_[kb][8 * s2 + 5]), pack2bf(cur_[kb][8 * s2 + 6], cur_[kb][8 * s2 + 7])}; __builtin_memcpy(&pf, &u, 16); } \
      ABL_PV_BEGIN \
      _Pragma("unroll") for (int db = 0; db < 2; ++db) { \
        const char* vrow = Vs + ((db * 32 + r) * ATT_VLD + kb * 32 + 16 * s2 + 4 * h2) * 2; \
        const uint2 lo = *(const uint2*)(vrow), hi = *(const uint2*)(vrow + 16); \
        const u32x4 u = {lo.x, lo.y, hi.x, hi.y}; bf16x8 vf; __builtin_memcpy(&vf, &u, 16); \
        oacc[db] = mfma32(vf, pf, oacc[db]); } ABL_PV_END } }
#define ATT_STEP(cur_, nxt_, t_, w_, l_) { \
    const int t = (t_); \
    const int tk = t + 3 < nkt ? t + 3 : nkt - 1, tv = t + 2 < nkt ? t + 2 : nkt - 1; \
    ABL_LOADS2(l_, tk, tv) \
    ABL_STORES(w_, t)        \
    sched_fence(); \
    if (first_half) { ATT_QK(nxt_, (t + 1) & 1); sched_fence(); ATT_SMPV(cur_, t); } \
    else { ATT_SMPV(cur_, t); sched_fence(); ATT_QK(nxt_, (t + 1) & 1); } \
    sched_fence(); \
    ABL_SYNC(); }
  const bool first_half = rfl(wid) < 4;
  for (int t0 = 0; t0 < nkt; t0 += 2) {
    ATT_STEP(sA, sB, t0, a, b);
    ATT_STEP(sB, sA, t0 + 1, b, a);
  }
  lsum += __shfl_xor(lsum, 32);
  const float inv = 1.f / lsum;
#pragma unroll
  for (int db = 0; db < 2; ++db)
#pragma unroll
    for (int g = 0; g < 4; ++g) {
      uint2 o;
      o.x = pack2bf(oacc[db][g * 4 + 0] * inv, oacc[db][g * 4 + 1] * inv);
      o.y = pack2bf(oacc[db][g * 4 + 2] * inv, oacc[db][g * 4 + 3] * inv);
#ifdef ABL_ZERO
      { const bool odd_ = o.x == 0x12345678u && o.y == 0x9abcdef0u; o.x = odd_ ? 1u : 0u; o.y = 0u; }
#endif
      *(uint2*)(att + (size_t)nq * 512 + h * 64 + db * 32 + 8 * g + 4 * h2) = o;
    }
}

DI constexpr int att_items(int l) { return NB_ * 8 * (T_ / 256) + (l == 0 ? NB_ * 8 * (CL_ / 256) : 0); }
DI void spin_until_ge(int* ctr, int target) {
#ifdef EMU
  while (__atomic_load_n(ctr, __ATOMIC_SEQ_CST) < target) emu::yield();
#else
  while (__hip_atomic_load(ctr, __ATOMIC_RELAXED, __HIP_MEMORY_SCOPE_AGENT) < target) __builtin_amdgcn_s_sleep(8);
#endif
}
constexpr int P3B_ITEMS = RW1_ITEMS + ML2_ITEMS + MLA_Q_TILES + MLA_KV_TILES;
DI void phase3b(const Params& p, int l, char* smem, int* ctr) {
  for (int it = vblock(); it < P3B_ITEMS; it += gridDim.x) {
    int i = it;
    if (i < RW1_ITEMS) { TSB(p, 58); rw_chunk_item(p, i, smem); TSB(p, 59); continue; }
    i -= RW1_ITEMS;
    if (i < ML2_ITEMS) { mlstm_scan_item(p, i); continue; }
    i -= ML2_ITEMS;
    TSB(p, 60);
    if (i < MLA_Q_TILES) mla_q_item(p, l, i, smem); else mla_kv_item(p, l, i - MLA_Q_TILES, smem);
    TSB(p, 61);
  }
}

DI void phase4(const Params& p, int l, char* smem, int* ctr) {
  const int G = gridDim.x, nsb = G >= 2 * RW2_ITEMS ? RW2_ITEMS : (G > 1 ? G / 2 : 1);
  if ((int)blockIdx.x < nsb) {
    TSB(p, 50);
    for (int s = blockIdx.x; s < RW2_ITEMS; s += nsb) rw_state_item(p, s, smem);
#ifndef EMU
    asm volatile("s_waitcnt vmcnt(0)" ::: "memory");
#endif
    __syncthreads();
    if (opaque_tid() == 0) { __threadfence(); atomicAdd(ctr + 2, (RW2_ITEMS - (int)blockIdx.x + nsb - 1) / nsb); }
    TSB(p, 51);
  }
  const int QT = T_ / 256, CQ = (l == 0 ? (NB_ * 8 * (CL_ / 256)) / 8 : 0), R3 = RW1_ITEMS / 8;
  const int per = 2 * QT + CQ + R3;
  int* sitem = (int*)(smem + 160 * 1024 - 16);
  bool r2ok = false;
  const int x0 = xcc_id();
  for (;;) {
    __syncthreads();
    if (opaque_tid() == 0) {
      int item = -1;
      for (int k = 0; k < 8 && item < 0; ++k) {
        const int x = (x0 + k) & 7;
        if (ld_relaxed(ctr + 8 + x) >= per) continue;
        const int li = atomicAdd(ctr + 8 + x, 1);
        if (li < per) item = x * per + li;
      }
      *sitem = item;
    }
    __syncthreads();
    const int item = *sitem;
    if (item < 0) break;
    const int x = item / per; int li = item % per;
    if (li < 2 * QT) { const int bh = 2 * x + li / QT, qt = li % QT; TSB(p, 54); attn_item(p, bh >> 3, bh & 7, qt, false, smem); TSB(p, 55); continue; }
    li -= 2 * QT;
    if (li < CQ) { const int ci = x * CQ + li, qt = ci % (CL_ / 256), bh = ci / (CL_ / 256); attn_item(p, bh >> 3, bh & 7, qt, true, smem); continue; }
    li -= CQ;
    if (!r2ok) {
      if (opaque_tid() == 0) { spin_until_ge(ctr + 2, RW2_ITEMS); __threadfence(); }
      __syncthreads();
      r2ok = true;
    }
    rw_out_item(p, x * R3 + li, smem);
  }
}
constexpr int ML3_CC = CL_ / 64, ML3_XC = T_ / 64;
DI constexpr int ml3_items(bool with_ctx) { return NB_ * 4 * (ML3_XC + (with_ctx ? ML3_CC : 0)); }
template <int KS> DI f32x16 ml_mm(const char* A, const char* Bt, int mb, int nb, int lane, f32x16 acc) {
  const int r = lane & 31, h = lane >> 5;
#pragma unroll
  for (int ks = 0; ks < KS; ++ks) {
    const bf16x8 a = *(const bf16x8*)(A + ((mb * 32 + r) * RW_LD + ks * 16 + h * 8) * 2);
    const bf16x8 b = *(const bf16x8*)(Bt + ((nb * 32 + r) * RW_LD + ks * 16 + h * 8) * 2);
    acc = mfma32(a, b, acc);
  }
  return acc;
}
DI float wave_incl_scan_max(float v, int lane) {
  for (int d = 1; d < 64; d <<= 1) { const float o = __shfl_up(v, d); if (lane >= d) v = fmaxf(v, o); }
  return v;
}
DI void mlstm_out_item(const Params& p, int l, int it, bool with_ctx, char* smem) {
  const int per = ML3_XC + (with_ctx ? ML3_CC : 0);
  const int bh = it / per, b = bh >> 2, hd = bh & 3;
  int tc = it % per; if (!with_ctx) tc += ML3_CC;
  const bool isctx = tc < ML3_CC;
  const int ntok0 = isctx ? NX_ + b * CL_ + tc * 64 : b * T_ + (tc - ML3_CC) * 64;
  char* const Qm = smem;
  char* const Km = smem + 1 * RW_MB;
  char* const Qp = smem + 2 * RW_MB;
  char* const Vi = smem + 3 * RW_MB;
  char* const Pp = smem + 4 * RW_MB;
  char* const Cm = smem + 5 * RW_MB;
  float* const hs = (float*)(smem + 6 * RW_MB);
  float* const ga = hs + 64 * 64;
  float* const denp = ga + 5 * 64;
  float* const nsv = denp + 128;
  const float* zrec = (const float*)(p.ws + OFF_REGION + R_ZREC);
  const int tid = opaque_tid(), lane = tid & 63, wid = tid >> 6;
  __syncthreads();
  for (int idx = tid; idx < 64 * 64; idx += NTHR) hs[idx] = 0.f;
#pragma unroll 1
  for (int dir = 0; dir < 2; ++dir) {
    const int c = dir == 0 ? tc : (isctx ? ML3_CC - 1 - tc : ML3_CC + (ML3_XC - 1 - (tc - ML3_CC)));
    const int s = dir * 8 + b * 4 + hd;
    const float* st = (const float*)(p.ws + OFF_REGION + R_MLST) + ((size_t)s * NCH_ + c) * ML_ST;
    const float m_start = st[2082];
    __syncthreads();
    {
      const int j = tid >> 3, pt = tid & 7;
      const int n = ntok0 + (dir ? 63 - j : j);
      const float* zr = zrec + (size_t)n * ZREC_W;
      const float4 q4 = *(const float4*)(zr + ZR_MLQ + hd * 32 + pt * 4), k4 = *(const float4*)(zr + ZR_MLK + hd * 32 + pt * 4);
      const float4 c4 = *(const float4*)(st + j * 32 + pt * 4);
      const float4 va = *(const float4*)(zr + ZR_MLV + hd * 64 + pt * 8), vb = *(const float4*)(zr + ZR_MLV + hd * 64 + pt * 8 + 4);
      const float qs = 0.17677669529663687f;
      const float q0 = q4.x * qs, q1 = q4.y * qs, q2 = q4.z * qs, q3 = q4.w * qs;
      *(uint2*)(Qm + (j * RW_LD + pt * 4) * 2) = make_uint2(pack2bf(q0, q1), pack2bf(q2, q3));
      *(uint2*)(Km + (j * RW_LD + pt * 4) * 2) = make_uint2(pack2bf(k4.x, k4.y), pack2bf(k4.z, k4.w));
      *(uint2*)(Cm + (j * RW_LD + pt * 4) * 2) = make_uint2(pack2bf(c4.x, c4.y), pack2bf(c4.z, c4.w));
      const float vv[8] = {va.x, va.y, va.z, va.w, vb.x, vb.y, vb.z, vb.w};
#pragma unroll
      for (int u = 0; u < 8; ++u) *(bf16_t*)(Vi + ((pt * 8 + u) * RW_LD + j) * 2) = f2bf(vv[u]);
      if (tid < 32) nsv[tid] = st[2048 + tid];
      const float4 n4 = *(const float4*)(st + 2048 + pt * 4);
      float nq = n4.x * q0 + n4.y * q1 + n4.z * q2 + n4.w * q3;
      nq += __shfl_xor(nq, 1); nq += __shfl_xor(nq, 2); nq += __shfl_xor(nq, 4);
      if (pt == 0) ga[4 * 64 + j] = nq;
    }
    if (wid == 0) {
      const int n = ntok0 + (dir ? 63 - lane : lane);
      const float fp = zrec[(size_t)n * ZREC_W + ZR_MLF + dir * 4 + hd] + p.ml_b_f[(l * 2 + dir) * 4 + hd];
      const float ipre = zrec[(size_t)n * ZREC_W + ZR_MLI + dir * 4 + hd] + p.ml_b_i[(l * 2 + dir) * 4 + hd];
      const float bj = wave_incl_scan(logsigmoidf_(fp), lane);
      const float g = ipre - bj;
      const float pm = wave_incl_scan_max(g, lane);
      const float c0 = wave_max(g);
      const float mj = fmaxf(bj + m_start, bj + pm);
      ga[0 * 64 + lane] = fexp(g - c0);
      ga[1 * 64 + lane] = fexp(fminf(bj + c0 - mj, 80.f));
      ga[2 * 64 + lane] = fexp(bj + m_start - mj);
      ga[3 * 64 + lane] = fexp(fminf(-mj, 80.f));
    }
    __syncthreads();
    if (wid < 4) {
      const int mb = wid >> 1, nb = wid & 1, r = lane & 31, h = lane >> 5;
      f32x16 acc = zero16();
      if (!(mb == 1 && nb == 0)) acc = ml_mm<2>(Km, Qm, mb, nb, lane, acc);
      rw_mask_upper(acc, mb, nb, lane, false);
      const float al = ga[1 * 64 + nb * 32 + r];
      float csum = 0.f;
#pragma unroll
      for (int i = 0; i < 16; ++i) { acc[i] *= ga[0 * 64 + mb * 32 + crow(i, h)] * al; csum += acc[i]; }
      csum += __shfl_xor(csum, 32);
      if (h == 0) denp[mb * 64 + nb * 32 + r] = csum;
      rw_wrT(Pp, mb, nb, lane, acc);
    } else {
      const int t2 = tid - 256, j = t2 >> 2, d8 = (t2 & 3) * 8;
      const float in = ga[2 * 64 + j];
      const uint4 u = *(const uint4*)(Qm + (j * RW_LD + d8) * 2);
      const unsigned w[4] = {u.x, u.y, u.z, u.w};
      unsigned o[4];
#pragma unroll
      for (int q = 0; q < 4; ++q) o[q] = pack2bf(bf2f((bf16_t)(w[q] & 0xffff)) * in, bf2f((bf16_t)(w[q] >> 16)) * in);
      *(uint4*)(Qp + (j * RW_LD + d8) * 2) = make_uint4(o[0], o[1], o[2], o[3]);
    }
    __syncthreads();
    if (wid < 4) {
      const int mb = wid >> 1, nb = wid & 1, r = lane & 31, h = lane >> 5;
      f32x16 acc = zero16();
      acc = ml_mm<4>(Vi, Pp, mb, nb, lane, acc);
      acc = ml_mm<2>(Cm, Qp, mb, nb, lane, acc);
      const int j = nb * 32 + r;
      const float den = denp[j] + denp[64 + j] + ga[2 * 64 + j] * ga[4 * 64 + j];
      const float rden = frcp(fmaxf(fabsf(den), ga[3 * 64 + j]));
      float* hrow = hs + (dir ? 63 - j : j) * 64 + mb * 32 + 4 * h;
#pragma unroll
      for (int g4 = 0; g4 < 4; ++g4) {
        float4 o = *(float4*)(hrow + 8 * g4);
        o.x += acc[4 * g4] * rden; o.y += acc[4 * g4 + 1] * rden; o.z += acc[4 * g4 + 2] * rden; o.w += acc[4 * g4 + 3] * rden;
        *(float4*)(hrow + 8 * g4) = o;
      }
    }
  }
  __syncthreads();
  const int tk = tid >> 3, v0 = (tid & 7) * 8, n = ntok0 + tk;
  float ss = 0.f; float hv[8];
#pragma unroll
  for (int u = 0; u < 8; ++u) { hv[u] = hs[tk * 64 + v0 + u]; ss += hv[u] * hv[u]; }
  ss += __shfl_xor(ss, 1); ss += __shfl_xor(ss, 2); ss += __shfl_xor(ss, 4);
  const float rs = frsq(ss * (1.f / 64.f) + 1e-6f);
  unsigned o[4];
#pragma unroll
  for (int u = 0; u < 8; u += 2) {
    const int cc = hd * 64 + v0 + u;
    const float a = hv[u] * rs * p.ml_g_norm[l * 256 + cc] * sigmoidf_(zrec[(size_t)n * ZREC_W + ZR_MLO + cc]);
    const float bq = hv[u + 1] * rs * p.ml_g_norm[l * 256 + cc + 1] * sigmoidf_(zrec[(size_t)n * ZREC_W + ZR_MLO + cc + 1]);
    o[u >> 1] = pack2bf(a, bq);
  }
  bf16_t* mlo = (bf16_t*)(p.ws + OFF_REGION + R_MLO);
  *(uint4*)(mlo + (size_t)n * 256 + hd * 64 + v0) = make_uint4(o[0], o[1], o[2], o[3]);
}

DI constexpr int rwo_items(bool with_ctx) { return (with_ctx ? NT_ : NX_) / 16; }
DI void rwkv_out_item(const Params& p, int l, int it, char* smem) {
  float* sg = (float*)smem;
  const float* zrec = (const float*)(p.ws + OFF_REGION + R_ZREC);
  const bf16_t* rb = (const bf16_t*)(p.ws + OFF_REGION + R_RB16);
  const float* bso = (const float*)(p.ws + OFF_REGION + R_BS);
  const float* ys = (const float*)(p.ws + OFF_REGION + R_YS);
  bf16_t* rwo = (bf16_t*)(p.ws + OFF_REGION + R_RWO);
  const float* mu = p.rw_mu + (size_t)l * 1152;
  const int tid = opaque_tid(), n0 = it * 16;
  __syncthreads();
  {
    const int tt = tid >> 5, k4 = (tid & 31) * 4, n = n0 + tt, t = tok_t(n), c = 1024 + k4;
    const int len = n < NX_ ? T_ : CL_;
    const float* zr = zrec + (size_t)n * ZREC_W + ZR_RW + c;
    const float4 z = *(const float4*)zr;
    const float4 zp = t > 0 ? *(const float4*)(zr - ZREC_W) : make_float4(0.f, 0.f, 0.f, 0.f);
    const float4 zn = t < len - 1 ? *(const float4*)(zr + ZREC_W) : make_float4(0.f, 0.f, 0.f, 0.f);
    const float4 m4 = *(const float4*)(mu + c);
    sg[(k4 + 0) * 16 + tt] = sigmoidf_(z.x + (0.5f * (zp.x + zn.x) - z.x) * m4.x);
    sg[(k4 + 1) * 16 + tt] = sigmoidf_(z.y + (0.5f * (zp.y + zn.y) - z.y) * m4.y);
    sg[(k4 + 2) * 16 + tt] = sigmoidf_(z.z + (0.5f * (zp.z + zn.z) - z.z) * m4.z);
    sg[(k4 + 3) * 16 + tt] = sigmoidf_(z.w + (0.5f * (zp.w + zn.w) - z.w) * m4.w);
  }
  __syncthreads();
  const int col = tid & 255, half = tid >> 8;
  float acc[8];
#pragma unroll
  for (int i = 0; i < 8; ++i) acc[i] = 0.f;
  const float* g2 = p.rw_g2 + (size_t)l * 128 * 256 + col;
#pragma unroll 1
  for (int kh = 0; kh < 8; ++kh) {
    float gr[16];
#pragma unroll
    for (int k = 0; k < 16; ++k) gr[k] = g2[(kh * 16 + k) * 256];
#pragma unroll
    for (int k = 0; k < 16; ++k) {
      const float* sk = sg + (kh * 16 + k) * 16 + half * 8;
#pragma unroll
      for (int i = 0; i < 8; ++i) acc[i] += sk[i] * gr[k];
      if ((k & 3) == 3) sched_fence();
    }
  }
  const size_t AS = (size_t)NT_ * 256;
  const float lw = p.rw_lnx_w[(size_t)l * 256 + col], lb = p.rw_lnx_b[(size_t)l * 256 + col];
  float yv[8], vv[8], bsv[8];
#pragma unroll
  for (int i = 0; i < 8; ++i) {
    const int n = n0 + half * 8 + i;
    const size_t o = (size_t)n * 256 + col;
    yv[i] = ys[o] + ys[AS + o];
    vv[i] = bf2f(rb[1 * AS + o]);
    bsv[i] = bso[(size_t)n * 4 + (col >> 6)] + bso[((size_t)NT_ + n) * 4 + (col >> 6)];
  }
#pragma unroll
  for (int i = 0; i < 8; ++i) {
    const int n = n0 + half * 8 + i;
    const size_t o = (size_t)n * 256 + col;
    const float y = yv[i];
    const float mean = wave_sum(y) * (1.f / 64.f);
    const float dv = y - mean;
    const float var = wave_sum(dv * dv) * (1.f / 64.f);
    const float yn = dv * (frsq(var + 64e-5f)) * lw + lb;
    rwo[o] = f2bf((yn + bsv[i] * vv[i]) * acc[i]);
  }
}
DI void phase5(const Params& p, int l, bool with_ctx, char* smem) {
  const int n1 = ml3_items(with_ctx), n2 = rwo_items(with_ctx), G = gridDim.x;
  for (int it = blockIdx.x; it < n1; it += G) { TSB(p, 62); mlstm_out_item(p, l, it, with_ctx, smem); TSB(p, 63); }
  for (int it = G - 1 - (int)blockIdx.x; it < n2; it += G) { TSB(p, 64); rwkv_out_item(p, l, it, smem); TSB(p, 65); }
}
typedef Gemm<256, 128, 64, 4, 2> G2;
template <class G> DI void merge_tile(const Params& p, int l, int row0, int col0, char* smem) {
  const bf16_t* H = (const bf16_t*)(p.ws + OFF_H);
  const char* W = p.ws + OFF_WMIX + (size_t)l * WM_SIZE;
  const bf16_t* Wg = (const bf16_t*)(W + WM_GATE);
  const bf16_t* att = (const bf16_t*)(p.ws + OFF_REGION + R_ATT);
  const bf16_t* mlo = (const bf16_t*)(p.ws + OFF_REGION + R_MLO);
  const bf16_t* rwo = (const bf16_t*)(p.ws + OFF_REGION + R_RWO);
  bf16_t* ymix = (bf16_t*)(p.osc + O_YMIX);
  const int tid = opaque_tid();
  __syncthreads();
  unsigned ypk[G::MB][G::NB][8];
  f32x16 acc[G::MB][G::NB];
#pragma unroll 1
  for (int i = 0; i < 3; ++i) {
    unsigned sg[G::MB][G::NB][8];
#pragma unroll
    for (int a = 0; a < G::MB; ++a)
#pragma unroll
      for (int b = 0; b < G::NB; ++b) acc[a][b] = zero16();
    const bf16_t* A0 = H + (size_t)row0 * 1024;
    G::run_lin(acc, A0, 1024, Wg + ((size_t)i * 1024 + col0) * 1024, 1024, 1024, smem);
#pragma unroll
    for (int a = 0; a < G::MB; ++a)
#pragma unroll
      for (int b = 0; b < G::NB; ++b) {
#pragma unroll
        for (int e = 0; e < 8; ++e) sg[a][b][e] = pack2bf(sigmoidf_(acc[a][b][2 * e]), sigmoidf_(acc[a][b][2 * e + 1]));
        acc[a][b] = zero16();
      }
    const bf16_t* br = i == 0 ? att : (i == 1 ? mlo : rwo);
    const int kb = i == 0 ? 512 : 256;
    const bf16_t* Wb = (const bf16_t*)(W + (i == 0 ? WM_BRA : (i == 1 ? WM_BRM : WM_BRR)));
    const bf16_t* B0 = br + (size_t)row0 * kb;
    G::run_lin(acc, B0, kb, Wb + (size_t)col0 * kb, kb, kb, smem);
#pragma unroll
    for (int a = 0; a < G::MB; ++a)
#pragma unroll
      for (int b = 0; b < G::NB; ++b)
#pragma unroll
        for (int e = 0; e < 8; ++e) {
          float y0 = bf2f((bf16_t)(sg[a][b][e] & 0xffff)) * acc[a][b][2 * e], y1 = bf2f((bf16_t)(sg[a][b][e] >> 16)) * acc[a][b][2 * e + 1];
          if (i > 0) { y0 += bf2f((bf16_t)(ypk[a][b][e] & 0xffff)); y1 += bf2f((bf16_t)(ypk[a][b][e] >> 16)); }
          if (i < 2) ypk[a][b][e] = pack2bf(y0, y1); else { acc[a][b][2 * e] = y0; acc[a][b][2 * e + 1] = y1; }
        }
  }
  {
    const int lane = tid & 63, wid = tid >> 6, wm = wid / G::WN, wn = wid % G::WN;
    float* scr = (float*)(smem + wid * WTile<G::NB>::BYTES);
#pragma unroll
    for (int mb = 0; mb < G::MB; ++mb) {
#pragma unroll
      for (int nb = 0; nb < G::NB; ++nb) WTile<G::NB>::put(scr, nb, lane, acc[mb][nb]);
      const int r0 = row0 + wm * G::WTM + mb * 32, c0 = col0 + wn * G::WTN;
      WTile<G::NB>::rows8(scr, lane, [&](int r, int c, const float4& a, const float4& bq) {
        *(uint4*)(ymix + (size_t)(r0 + r) * 1024 + c0 + c) = pack8bf(a, bq); });
    }
  }
}
DI void phase_merge(const Params& p, int l, bool with_ctx, char* smem) {
  const int nbig = (NX_ / 256) * 8, nsmall = with_ctx ? (NC_ / 128) * 8 : 0;
  for (int it = vblock(); it < nbig + nsmall; it += gridDim.x) {
    if (it < nbig) merge_tile<G2>(p, l, (it >> 3) * 256, (it & 7) * 128, smem);
    else { const int i2 = it - nbig; merge_tile<G128>(p, l, NX_ + (i2 >> 3) * 128, (i2 & 7) * 128, smem); }
  }
}

template <class G> DI void wout_tile(const Params& p, int l, int row0, int col0, char* smem) {
  const bf16_t* ymix = (const bf16_t*)(p.osc + O_YMIX);
  const bf16_t* Wo = (const bf16_t*)(p.ws + OFF_WMIX + (size_t)l * WM_SIZE + WM_OUT);
  float* xs = (float*)(p.ws + OFF_XS);
  const float* mod = (const float*)(p.ws + OFF_MOD) + (size_t)l * 3 * 6144;
  const int tid = opaque_tid();
  __syncthreads();
  f32x16 acc[G::MB][G::NB];
#pragma unroll
  for (int a = 0; a < G::MB; ++a)
#pragma unroll
    for (int b = 0; b < G::NB; ++b) acc[a][b] = zero16();
  const bf16_t* A0 = ymix + (size_t)row0 * 1024;
  G::run_lin(acc, A0, 1024, Wo + (size_t)col0 * 1024, 1024, 1024, smem);
  const float* m2 = mod + (size_t)tok_modrow(row0) * 6144 + 2 * 1024;
  const int lane = tid & 63, wid = tid >> 6, wm = wid / G::WN, wn = wid % G::WN;
  float* scr = (float*)(smem + wid * WTile<G::NB>::BYTES);
#pragma unroll
  for (int mb = 0; mb < G::MB; ++mb) {
#pragma unroll
    for (int nb = 0; nb < G::NB; ++nb) WTile<G::NB>::put(scr, nb, lane, acc[mb][nb]);
    const int r0 = row0 + wm * G::WTM + mb * 32, c0 = col0 + wn * G::WTN;
    WTile<G::NB>::rows4(scr, lane, [&](int r, int c, const float4& a) {
      float4* d = (float4*)(xs + (size_t)(r0 + r) * 1024 + c0 + c);
      const float4 g = *(const float4*)(m2 + c0 + c); float4 x = *d;
      x.x += g.x * a.x; x.y += g.y * a.y; x.z += g.z * a.z; x.w += g.w * a.w; *d = x; });
  }
}
DI void phase_wout(const Params& p, int l, bool with_ctx, char* smem) {
  const int nbig = (NX_ / 256) * 8, nsmall = with_ctx ? (NC_ / 128) * 8 : 0;
  for (int it = vblock(); it < nbig + nsmall; it += gridDim.x) {
    if (it < nbig) wout_tile<G2>(p, l, (it >> 3) * 256, (it & 7) * 128, smem);
    else { const int i2 = it - nbig; wout_tile<G128>(p, l, NX_ + (i2 >> 3) * 128, (i2 & 7) * 128, smem); }
  }
  TSB(p, 66);
  cvt_run([&](int i) { return cvt_moe_dec(p, l, i); }, (int)gridDim.x - 1 - vblock(), CVT_MOE_TILES, gridDim.x, smem);
  TSB(p, 67);
}

typedef Gemm<128, 64, 64, 4, 2> GRT;
DI void phase_router(const Params& p, int l, bool with_ctx, char* smem, int* cnt) {
  float* xs = (float*)(p.ws + OFF_XS);
  bf16_t* H = (bf16_t*)(p.ws + OFF_H);
  const float* mod = (const float*)(p.ws + OFF_MOD) + (size_t)l * 3 * 6144;
  const bf16_t* Wr = (const bf16_t*)(p.ws + OFF_WMIX + (size_t)l * WM_SIZE + WM_RT);
  int* eidx = (int*)(p.ws + OFF_REGION + R_EIDX);
  float* ewt = (float*)(p.ws + OFF_REGION + R_EWT);
  int* erank = (int*)(p.ws + OFF_REGION + R_ERANK);
  int* elist = (int*)(p.ws + OFF_REGION + R_ELIST);
  float* sc = (float*)(smem + GRT::SMEM);
  float* bs = sc + 128 * 65;
  float* gs = bs + 128 * 65;
  int* lcnt = (int*)(gs + 128 * 9);
  int* lbase = lcnt + 64;
  const int tid = opaque_tid(), lane = tid & 63, wid = tid >> 6;
  const int ntok = with_ctx ? NT_ : NX_;
  for (int it = blockIdx.x; it < ntok / 128; it += gridDim.x) {
    const int n0 = it * 128;
    __syncthreads();
    TSB(p, 40);
    if (tid < 64) lcnt[tid] = 0;
#pragma unroll 1
    for (int r4 = 0; r4 < 16; r4 += 4) {
      float v[4][16];
#pragma unroll
      for (int u = 0; u < 4; ++u) {
        const int n = n0 + wid * 16 + r4 + u;
#pragma unroll
        for (int j = 0; j < 4; ++j) {
          const float4 t = *(const float4*)(xs + (size_t)n * 1024 + (j * 64 + lane) * 4);
          v[u][j * 4] = t.x; v[u][j * 4 + 1] = t.y; v[u][j * 4 + 2] = t.z; v[u][j * 4 + 3] = t.w;
        }
      }
#pragma unroll
      for (int u = 0; u < 4; ++u) {
        const int n = n0 + wid * 16 + r4 + u;
        const float* m = mod + (size_t)tok_modrow(n) * 6144;
        row_norm_mod(v[u], p.g_ffn + (size_t)l * 1024, m + 3 * 1024, m + 4 * 1024, H + (size_t)n * 1024, lane);
      }
    }
    __syncthreads();
    TSB(p, 41);
    f32x16 acc[1][1]; acc[0][0] = zero16();
    const bf16_t* A0 = H + (size_t)n0 * 1024;
    GRT::run(acc, [&](int r) { return A0 + (size_t)r * 1024; }, Wr, 1024, 1024, smem);
    {
      const int col = GRT::col_of(tid, 0);
      const float rb = p.router_bias[l * 64 + col];
#pragma unroll
      for (int e = 0; e < 16; ++e) {
        const int row = GRT::row_of(tid, 0, e);
        const float s = sigmoidf_(acc[0][0][e]);
        sc[row * 65 + col] = s; bs[row * 65 + col] = s + rb;
      }
    }
    __syncthreads();
    TSB(p, 42);
    int sel[8], lrk[8]; float wsum = 0.f;
    if (tid < 128) {
      float* b = bs + tid * 65; const float* s = sc + tid * 65; float* g = gs + tid * 9;
      for (int gi = 0; gi < 8; ++gi) {
        float m1 = -1e30f, m2 = -1e30f;
        for (int j = 0; j < 8; ++j) { const float x = b[gi * 8 + j]; if (x > m1) { m2 = m1; m1 = x; } else if (x > m2) m2 = x; }
        g[gi] = m1 + m2;
      }
      unsigned gmask = 0;
      for (int c = 0; c < 4; ++c) {
        int best = 0; float bv = -1e30f;
        for (int gi = 0; gi < 8; ++gi) if (!((gmask >> gi) & 1) && g[gi] > bv) { bv = g[gi]; best = gi; }
        gmask |= 1u << best;
      }
      for (int gi = 0; gi < 8; ++gi) if (!((gmask >> gi) & 1)) for (int j = 0; j < 8; ++j) b[gi * 8 + j] = -1e30f;
      wsum = 0.f;
#pragma unroll
      for (int c = 0; c < 8; ++c) {
        int best = 0; float bv = -1e30f;
        for (int e = 0; e < 64; ++e) { const float x = b[e]; if (x > bv) { bv = x; best = e; } }
        b[best] = -3e30f; sel[c] = best; wsum += s[best];
        lrk[c] = atomicAdd(lcnt + best, 1);
      }
    }
    __syncthreads();
    if (tid < 64) { const int c = lcnt[tid]; lbase[tid] = c ? atomicAdd(cnt + tid * 32, c) : 0; }
    __syncthreads();
    if (tid < 128) {
      const int n = n0 + tid;
      const float* s = sc + tid * 65;
      const float inv = 2.5f / (wsum + 1e-20f);
#pragma unroll
      for (int c = 0; c < 8; ++c) {
        const int e = sel[c];
        const int rk = lbase[e] + lrk[c];
        eidx[n * 8 + c] = e; ewt[n * 8 + c] = s[e] * inv; erank[n * 8 + c] = rk;
        elist[(size_t)e * NT_ + rk] = n * 8 + c;
      }
    }
    __syncthreads();
    TSB(p, 43);
  }
}

typedef Gemm<128, 256, 32, 2, 4> GMOE;
constexpr int ACT_LD = 264;
constexpr int MOE_DN_BK = 64, MOE_DN_LD = 72, MOE_DN_STG = 256 * MOE_DN_LD * 2;
constexpr int MOE_ACT_OFF = 2 * MOE_DN_STG;
static_assert(GMOE::SMEM <= MOE_ACT_OFF, "gate/up staging must stay below the act image");
constexpr int MOE_INFO_OFF = MOE_ACT_OFF + 128 * ACT_LD * 2;
static_assert(MOE_INFO_OFF + 128 * 8 + 67 * 4 * 2 <= 160 * 1024 - 32, "moe lds");
DI void moe_down_run(f32x16 (&acc)[GMOE::MB][GMOE::NB], const char* actl, const bf16_t* Bt, char* smem) {
  constexpr int BK = MOE_DN_BK, LDB = MOE_DN_LD, NCH = 4, KS = 4, STG = MOE_DN_STG, nk = 256 / BK;
  const int tid = opaque_tid(), lane = tid & 63, wid = tid >> 6, wm = wid / 4, wn = wid % 4;
  const int kc = (tid & 7) * 8, r0 = tid >> 3;
  const bf16_t* bp0 = Bt + (size_t)r0 * 256 + kc;
  u32x4 s0[NCH], s1[NCH];
#define MD_LOAD(dst_, kt_) { const int kq_ = (kt_) < nk ? (kt_) : nk - 1; _Pragma("unroll") for (int i = 0; i < NCH; ++i) dst_[i] = *(const u32x4*)(bp0 + (size_t)i * 64 * 256 + kq_ * BK); }
#define MD_WRITE1(src_, c_, buf_) { *(u32x4*)(smem + (buf_) * STG + ((r0 + (c_) * 64) * LDB + kc) * 2) = src_[c_]; }
#define MD_STEP(w_, l_, kt_) { \
    MD_LOAD(l_, (kt_) + 2); \
    sched_fence(); \
    const char* Bs = smem + ((kt_) & 1) * STG; \
    _Pragma("unroll") for (int ks = 0; ks < KS; ++ks) { \
      bf16x8 af[GMOE::MB], bfr[GMOE::NB]; \
      _Pragma("unroll") for (int mb = 0; mb < GMOE::MB; ++mb) af[mb] = *(const bf16x8*)(actl + ((wm * 64 + mb * 32 + (lane & 31)) * ACT_LD + (kt_) * BK + ks * 16 + (lane >> 5) * 8) * 2); \
      _Pragma("unroll") for (int nb = 0; nb < GMOE::NB; ++nb) bfr[nb] = *(const bf16x8*)(Bs + ((wn * 64 + nb * 32 + (lane & 31)) * LDB + ks * 16 + (lane >> 5) * 8) * 2); \
      MD_WRITE1(w_, ks, ((kt_) + 1) & 1); \
      _Pragma("unroll") for (int mb = 0; mb < GMOE::MB; ++mb) _Pragma("unroll") for (int nb = 0; nb < GMOE::NB; ++nb) acc[mb][nb] = mfma32(af[mb], bfr[nb], acc[mb][nb]); \
    } \
    sched_fence(); \
    __syncthreads(); }
  MD_LOAD(s0, 0);
#pragma unroll
  for (int c = 0; c < NCH; ++c) MD_WRITE1(s0, c, 0);
  MD_LOAD(s0, 1);
  __syncthreads();
  for (int kt = 0; kt < nk; kt += 2) {
    MD_STEP(s0, s1, kt);
    MD_STEP(s1, s0, kt + 1);
  }
#undef MD_STEP
#undef MD_WRITE1
#undef MD_LOAD
}
DI void phase_moe(const Params& p, int l, bool with_ctx, char* smem, const int* cnt) {
  const bf16_t* H = (const bf16_t*)(p.ws + OFF_H);
  const bf16_t* GU = (const bf16_t*)(p.ws + OFF_REGION + R_WMOE + WE_GU);
  const bf16_t* DN = (const bf16_t*)(p.ws + OFF_REGION + R_WMOE + WE_DN);
  const float* ewt = (const float*)(p.ws + OFF_REGION + R_EWT);
  const int* elist = (const int*)(p.ws + OFF_REGION + R_ELIST);
  bf16_t* ybuf = (bf16_t*)(p.ws + OFF_REGION + R_YBUF);
  char* actl = smem + MOE_ACT_OFF;
  int* rtok = (int*)(smem + MOE_INFO_OFF);
  float* rwt = (float*)(rtok + 128);
  int* pre = (int*)(rwt + 128);
  int* off = pre + 67;
  int tid = threadIdx.x;
  const int ntok = with_ctx ? NT_ : NX_;
  __syncthreads();
  if (tid == 0) {
    int a = 0, o = 0;
    for (int e = 0; e < 65; ++e) { const int c = e < 64 ? cnt[e * 32] : ntok; pre[e] = a; off[e] = o; a += (c + 127) >> 7; o += c; }
    pre[65] = a; off[65] = o;
  }
  __syncthreads();
  const int total = pre[65];
  for (int it = vblock(); it < total; it += gridDim.x) {
    tid = opaque_tid();
    int e0 = 0;
    while (pre[e0 + 1] <= it) ++e0;
    const int e = rfl(e0);
    const int rb = rfl(it - pre[e]);
    const int c = rfl(e < 64 ? cnt[e * 32] : ntok);
    const int obase = rfl(off[e] + rb * 128);
    __syncthreads();
    if (tid < 128) {
      const int slot = rb * 128 + tid;
      int tok = 0; float w = 0.f;
      if (slot < c) {
        if (e < 64) { const int pk = elist[(size_t)e * NT_ + slot]; tok = pk >> 3; w = ewt[pk]; }
        else { tok = slot; w = 1.f; }
      }
      rtok[tid] = tok; rwt[tid] = w;
    }
    __syncthreads();
    const bf16_t* Wgu = GU + (size_t)e * 512 * 1024;
#pragma unroll 1
    for (int hf = 0; hf < 2; ++hf) {
      f32x16 acc[GMOE::MB][GMOE::NB];
#pragma unroll
      for (int a = 0; a < GMOE::MB; ++a)
#pragma unroll
        for (int b = 0; b < GMOE::NB; ++b) acc[a][b] = zero16();
      GMOE::run(acc, [&](int r) { return H + (size_t)rtok[r] * 1024; }, Wgu + (size_t)hf * 256 * 1024, 1024, 1024, smem);
      const int lane = tid & 63, wn = (tid >> 6) % 4, wmr = ((tid >> 6) / 4) * 64 + 4 * (lane >> 5);
      const int j = (hf * 4 + wn) * 32 + (lane & 31);
#pragma unroll
      for (int mb = 0; mb < GMOE::MB; ++mb)
#pragma unroll
        for (int i = 0; i < 16; ++i) {
          const int row = wmr + mb * 32 + (i & 3) + 8 * (i >> 2);
          const float g = acc[mb][0][i], u = acc[mb][1][i];
          *(bf16_t*)(actl + (row * ACT_LD + j) * 2) = f2bf(siluf_(g) * u);
        }
    }
    __syncthreads();
    const bf16_t* Wd = DN + (size_t)e * 1024 * 256;
#pragma unroll 1
    for (int nt = 0; nt < 4; ++nt) {
      f32x16 acc[GMOE::MB][GMOE::NB];
#pragma unroll
      for (int a = 0; a < GMOE::MB; ++a)
#pragma unroll
        for (int b = 0; b < GMOE::NB; ++b) acc[a][b] = zero16();
      moe_down_run(acc, actl, Wd + (size_t)nt * 256 * 256, smem);
      {
        const int lane = tid & 63, wid = tid >> 6, wm = wid / 4, wn = wid % 4;
        float* scr = (float*)(smem + wid * WTile<1>::BYTES);
#pragma unroll
        for (int mb = 0; mb < GMOE::MB; ++mb)
#pragma unroll
          for (int nb = 0; nb < GMOE::NB; ++nb) {
            WTile<1>::put(scr, 0, lane, acc[mb][nb]);
            const int row0 = wm * 64 + mb * 32, col0 = nt * 256 + wn * 64 + nb * 32;
            WTile<1>::rows8(scr, lane, [&](int r, int cq, const float4& a, const float4& bq) {
              const int row = row0 + r;
              if (rb * 128 + row < c) {
                const float w = rwt[row];
                const float4 a2 = make_float4(a.x * w, a.y * w, a.z * w, a.w * w), b2 = make_float4(bq.x * w, bq.y * w, bq.z * w, bq.w * w);
                *(uint4*)(ybuf + ((size_t)obase + row) * 1024 + col0 + cq) = pack8bf(a2, b2);
              } });
          }
        __syncthreads();
      }
    }
  }
}

DI void phase_combine(const Params& p, int l, bool last, char* smem, const int* cnt) {
  float* xs = (float*)(p.ws + OFF_XS);
  bf16_t* H = (bf16_t*)(p.ws + OFF_H);
  const float* mod = (const float*)(p.ws + OFF_MOD);
  const int* eidx = (const int*)(p.ws + OFF_REGION + R_EIDX);
  const int* erank = (const int*)(p.ws + OFF_REGION + R_ERANK);
  const bf16_t* ybuf = (const bf16_t*)(p.ws + OFF_REGION + R_YBUF);
  int* off = (int*)smem;
  const int tid = opaque_tid(), lane = tid & 63, wid = tid >> 6;
  const int ntok = last ? NX_ : NT_;
  __syncthreads();
  if (tid == 0) { int o = 0; for (int e = 0; e < 64; ++e) { off[e] = o; o += cnt[e * 32]; } off[64] = o; }
  __syncthreads();
  for (int n = blockIdx.x * 8 + wid; n < ntok; n += gridDim.x * 8) {
    float acc[16];
#pragma unroll
    for (int i = 0; i < 16; ++i) acc[i] = 0.f;
    const int4 e0 = *(const int4*)(eidx + n * 8), e1 = *(const int4*)(eidx + n * 8 + 4);
    const int4 r0 = *(const int4*)(erank + n * 8), r1 = *(const int4*)(erank + n * 8 + 4);
    const int rows[9] = {off[e0.x] + r0.x, off[e0.y] + r0.y, off[e0.z] + r0.z, off[e0.w] + r0.w,
                         off[e1.x] + r1.x, off[e1.y] + r1.y, off[e1.z] + r1.z, off[e1.w] + r1.w, off[64] + n};
    uint2 u[9][4];
#pragma unroll
    for (int k = 0; k < 9; ++k)
#pragma unroll
      for (int j = 0; j < 4; ++j) u[k][j] = *(const uint2*)(ybuf + (size_t)rows[k] * 1024 + (j * 64 + lane) * 4);
#pragma unroll
    for (int k = 0; k < 9; ++k)
#pragma unroll
      for (int j = 0; j < 4; ++j) {
        acc[j * 4 + 0] += bf2f((bf16_t)(u[k][j].x & 0xffff)); acc[j * 4 + 1] += bf2f((bf16_t)(u[k][j].x >> 16));
        acc[j * 4 + 2] += bf2f((bf16_t)(u[k][j].y & 0xffff)); acc[j * 4 + 3] += bf2f((bf16_t)(u[k][j].y >> 16));
      }
    const float* m5 = mod + ((size_t)l * 3 + tok_modrow(n)) * 6144 + 5 * 1024;
    float v[16];
#pragma unroll
    for (int j = 0; j < 4; ++j) {
      const int c = (j * 64 + lane) * 4;
      const float4 x = *(const float4*)(xs + (size_t)n * 1024 + c), g = *(const float4*)(m5 + c);
      v[j * 4 + 0] = x.x + g.x * acc[j * 4 + 0]; v[j * 4 + 1] = x.y + g.y * acc[j * 4 + 1];
      v[j * 4 + 2] = x.z + g.z * acc[j * 4 + 2]; v[j * 4 + 3] = x.w + g.w * acc[j * 4 + 3];
      if (!last) *(float4*)(xs + (size_t)n * 1024 + c) = make_float4(v[j * 4], v[j * 4 + 1], v[j * 4 + 2], v[j * 4 + 3]);
    }
    if (!last) {
      const float* m = mod + ((size_t)(l + 1) * 3 + tok_modrow(n)) * 6144;
      row_norm_mod(v, p.g_mix + (size_t)(l + 1) * 1024, m, m + 1024, H + (size_t)n * 1024, lane);
    } else {
      float ss = 0.f;
#pragma unroll
      for (int i = 0; i < 16; ++i) ss += v[i] * v[i];
      ss = wave_sum(ss);
      const float rs = frsq(ss * (1.f / 1024.f) + 1e-6f);
#pragma unroll
      for (int j = 0; j < 4; ++j) {
        const int c = (j * 64 + lane) * 4;
        const float4 g = *(const float4*)(p.g_final + c);
        *(float4*)(p.out + (size_t)n * 1024 + c) = make_float4(v[j * 4] * rs * g.x, v[j * 4 + 1] * rs * g.y, v[j * 4 + 2] * rs * g.z, v[j * 4 + 3] * rs * g.w);
      }
    }
  }
}
#define SMEM_BYTES (160 * 1024)
#ifndef MEGA
#define MEGA 0
#endif
DI int* cnt_ptr(const Params& p, int l) { return (int*)(p.ws + OFF_CNT) + 1024 + 2048 * l; }
DI int* ctr_ptr(const Params& p, int l) { return (int*)(p.ws + OFF_CNT) + 32 * l; }
#if !MEGA
__global__ void __launch_bounds__(NTHR) k_phaseA(Params p) { SMEM_DECL(smem, SMEM_BYTES); phaseA(p, smem); }
__global__ void __launch_bounds__(NTHR) k_norm0(Params p) { phase_norm0(p); }
__global__ void __launch_bounds__(NTHR) k_win(Params p, int l) { SMEM_DECL(smem, SMEM_BYTES); phase_win(p, l, smem); }
__global__ void __launch_bounds__(NTHR) k_p3(Params p, int l) { SMEM_DECL(smem, SMEM_BYTES); phase3(p, l, smem); }
__global__ void __launch_bounds__(NTHR) k_p3b(Params p, int l) { SMEM_DECL(smem, SMEM_BYTES); phase3b(p, l, smem, ctr_ptr(p, l)); }
__global__ void __launch_bounds__(NTHR) k_p4(Params p, int l) { SMEM_DECL(smem, SMEM_BYTES); phase4(p, l, smem, ctr_ptr(p, l)); }
__global__ void __launch_bounds__(NTHR) k_p5(Params p, int l, int wc) { SMEM_DECL(smem, SMEM_BYTES); phase5(p, l, wc != 0, smem); }
__global__ void __launch_bounds__(NTHR) k_merge(Params p, int l, int wc) { SMEM_DECL(smem, SMEM_BYTES); phase_merge(p, l, wc != 0, smem); }
__global__ void __launch_bounds__(NTHR) k_wout(Params p, int l, int wc) { SMEM_DECL(smem, SMEM_BYTES); phase_wout(p, l, wc != 0, smem); }
__global__ void __launch_bounds__(NTHR) k_router(Params p, int l, int wc) { SMEM_DECL(smem, SMEM_BYTES); phase_router(p, l, wc != 0, smem, cnt_ptr(p, l)); }
__global__ void __launch_bounds__(NTHR) k_moe(Params p, int l, int wc) { SMEM_DECL(smem, SMEM_BYTES); phase_moe(p, l, wc != 0, smem, cnt_ptr(p, l)); }
__global__ void __launch_bounds__(NTHR) k_combine(Params p, int l, int last) { SMEM_DECL(smem, SMEM_BYTES); phase_combine(p, l, last != 0, smem, cnt_ptr(p, l)); }
#else
#ifndef EMU
#define XB_TMO      128
#define XB_XCNT(j)  (256  + 64 * (j))
#define XB_XSUB(j)  (1280 + 64 * (j))
#define XB_XGEN(j)  (2304 + 64 * (j))
#define XB_TOP      3328
#define XB_TOPGEN   3392
#define XCD_BAR_WORDS 3456
#define XB_SPIN_CAP (1u << 24)
#define LAS __attribute__((address_space(3)))
DI unsigned xb_ld(unsigned* p) { return __hip_atomic_load(p, __ATOMIC_RELAXED, __HIP_MEMORY_SCOPE_AGENT); }
DI unsigned xb_add(unsigned* p, unsigned v) { return __hip_atomic_fetch_add(p, v, __ATOMIC_RELAXED, __HIP_MEMORY_SCOPE_AGENT); }
DI unsigned xb_xcc_id() { return (unsigned)__builtin_amdgcn_s_getreg((3 << 11) | 20) & 0xFu; }
#define XB_SPIN(cond, bar) do { unsigned _sp = 0; while (cond) { __builtin_amdgcn_s_sleep(1); \
    if ((++_sp & 255u) == 0u) { if (xb_ld(&(bar)[XB_TMO])) break; if (_sp > XB_SPIN_CAP) { atomicAdd(&(bar)[XB_TMO], 1u); break; } } } } while (0)
struct XcdBarrier { unsigned* bar; unsigned x; volatile LAS unsigned* st; };
DI XcdBarrier xcd_barrier_post(unsigned* bar, volatile LAS unsigned* st) {
  XcdBarrier b; b.bar = bar; b.x = xb_xcc_id(); b.st = st;
  if (threadIdx.x == 0) (void)xb_add(&bar[XB_XCNT(b.x)], 1u);
  return b;
}
DI void xcd_barrier_complete(unsigned* bar, unsigned x, unsigned& nloc, unsigned& nx) {
  const unsigned G = gridDim.x * gridDim.y * gridDim.z;
  unsigned sum, cnt, mine, sp = 0u;
  for (;;) {
    sum = 0u; cnt = 0u; mine = 0u;
#pragma unroll
    for (unsigned j = 0; j < 16; ++j) { const unsigned c = xb_ld(&bar[XB_XCNT(j)]); sum += c; cnt += (c > 0u) ? 1u : 0u; mine = (j == x) ? c : mine; }
    if (sum == G) break;
    __builtin_amdgcn_s_sleep(1);
    if ((++sp & 255u) == 0u) { if (xb_ld(&bar[XB_TMO])) break; if (sp > XB_SPIN_CAP) { atomicAdd(&bar[XB_TMO], 1u); break; } }
  }
  nloc = mine > 0u ? mine : 1u; nx = cnt > 0u ? cnt : 1u;
}
DI void xcd_barrier(const XcdBarrier& b) {
  asm volatile("s_waitcnt vmcnt(0)" ::: "memory");
  __syncthreads();
  if (threadIdx.x == 0) {
    unsigned* bar = b.bar;
    __builtin_amdgcn_s_waitcnt(0);
    unsigned nloc = b.st[0], nx = b.st[1];
    if (nloc == 0u) { xcd_barrier_complete(bar, b.x, nloc, nx); b.st[0] = nloc; b.st[1] = nx; }
    const unsigned old = xb_add(&bar[XB_XSUB(b.x)], 1u);
    const unsigned gen = old / nloc;
    if (old + 1u == (gen + 1u) * nloc) {
      __builtin_amdgcn_fence(__ATOMIC_RELEASE, "agent");
      asm volatile("s_waitcnt vmcnt(0)" ::: "memory");
      const unsigned og = xb_add(&bar[XB_TOP], 1u);
      const unsigned tg = og / nx;
      if (og + 1u == (tg + 1u) * nx) xb_add(&bar[XB_TOPGEN], 1u);
      else XB_SPIN(xb_ld(&bar[XB_TOPGEN]) == tg, bar);
      __builtin_amdgcn_fence(__ATOMIC_ACQUIRE, "agent");
      xb_add(&bar[XB_XGEN(b.x)], 1u);
      asm volatile("s_waitcnt vmcnt(0)" ::: "memory");
    } else {
      XB_SPIN(xb_ld(&bar[XB_XGEN(b.x)]) == gen, bar);
      __builtin_amdgcn_fence(__ATOMIC_ACQUIRE, "agent");
      asm volatile("s_waitcnt vmcnt(0)" ::: "memory");
    }
  }
  __syncthreads();
}
#define GSYNC() { XcdBarrier xb_; xb_.bar = (unsigned*)(p.ws + OFF_BAR); xb_.x = xb_xcc_id(); xb_.st = (volatile LAS unsigned*)(smem + SMEM_BYTES - 32); xcd_barrier(xb_); }
#else
#define GSYNC() emu::grid_barrier()
#endif
#ifdef PROBE_IDX
#define TS(i) { if (blockIdx.x == 0 && threadIdx.x == 0) ts[i] = wall_clock64(); }
#else
#define TS(i)
#endif
__global__ void __launch_bounds__(NTHR) k_mega(Params p) {
  SMEM_DECL(smem, SMEM_BYTES);
  cooperative_groups::grid_group grid = cooperative_groups::this_grid();
  volatile LAS unsigned* xst = (volatile LAS unsigned*)(smem + SMEM_BYTES - 32);
  if (threadIdx.x == 0) { xst[0] = 0u; xst[1] = 0u; }
  __syncthreads();
  (void)xcd_barrier_post((unsigned*)(p.ws + OFF_BAR), xst);
#ifdef PROBE_IDX
  long long* ts = (long long*)(p.ws + OFF_CNT + 2048);
#endif
  TS(0);
  phaseA(p, smem);
  grid.sync(); TS(1);
  phase_norm0(p);
  GSYNC(); TS(2);
#pragma unroll 1
  for (int l = 0; l < 2; ++l) {
    const bool wc = l == 0;
    phase_win(p, l, smem); GSYNC(); TS(3 + l * 10);
    phase3(p, l, smem); GSYNC(); TS(4 + l * 10);
    phase3b(p, l, smem, ctr_ptr(p, l)); GSYNC(); TS(5 + l * 10);
    phase4(p, l, smem, ctr_ptr(p, l)); GSYNC(); TS(6 + l * 10);
    phase5(p, l, wc, smem); GSYNC(); TS(7 + l * 10);
    phase_merge(p, l, wc, smem); GSYNC(); TS(8 + l * 10);
    phase_wout(p, l, wc, smem); GSYNC(); TS(9 + l * 10);
    phase_router(p, l, wc, smem, cnt_ptr(p, l)); GSYNC(); TS(10 + l * 10);
    phase_moe(p, l, wc, smem, cnt_ptr(p, l)); GSYNC(); TS(11 + l * 10);
    phase_combine(p, l, l == 1, smem, cnt_ptr(p, l));
#ifdef PROBE_IDX
    GSYNC(); TS(12 + l * 10);
#else
    if (l == 0) GSYNC();
#endif
  }
#ifdef PROBE_IDX
  if (blockIdx.x == 0 && threadIdx.x == 0) {
    const float us = (float)(ts[PROBE_IDX + 1] - ts[PROBE_IDX]) * 0.01f;
    p.out[0] += PROBE_IDX >= 40 ? rintf(6.f * log2f(fmaxf(us * 16.f, 1.f))) : rintf(6.f * log2f(fmaxf(us, 1.f)));
  }
#endif
}
#endif

extern "C" void kernel_launch(void* const* d_in, const int* in_sizes, int n_in, void* d_out, int out_size, void* d_ws,
                              size_t ws_size, hipStream_t stream) {
  Params p{};
  const float** pp = (const float**)&p;
  for (int i = 0; i < 41; ++i) pp[i] = (const float*)d_in[i];
  p.out = (float*)d_out; p.ws = (char*)d_ws; p.osc = (char*)d_out;
  if (ws_size < WS_NEEDED) { fprintf(stderr, "workspace too small: %zu < %zu\n", ws_size, (size_t)WS_NEEDED); return; }
#if !MEGA
  const dim3 g(256), b(NTHR);
  hipLaunchKernelGGL(k_phaseA, g, b, 0, stream, p);
  hipLaunchKernelGGL(k_norm0, g, b, 0, stream, p);
  for (int l = 0; l < 2; ++l) {
    const int wc = l == 0;
    hipLaunchKernelGGL(k_win, g, b, 0, stream, p, l);
    hipLaunchKernelGGL(k_p3, g, b, 0, stream, p, l);
    hipLaunchKernelGGL(k_p3b, g, b, 0, stream, p, l);
    hipLaunchKernelGGL(k_p4, g, b, 0, stream, p, l);
    hipLaunchKernelGGL(k_p5, g, b, 0, stream, p, l, wc);
    hipLaunchKernelGGL(k_merge, g, b, 0, stream, p, l, wc);
    hipLaunchKernelGGL(k_wout, g, b, 0, stream, p, l, wc);
    hipLaunchKernelGGL(k_router, g, b, 0, stream, p, l, wc);
    hipLaunchKernelGGL(k_moe, g, b, 0, stream, p, l, wc);
    hipLaunchKernelGGL(k_combine, g, b, 0, stream, p, l, l == 1);
  }
#else
  static int grid_blocks = 0;
  if (!grid_blocks) {
    int dev = 0, cus = 0, per_cu = 0;
    hipGetDevice(&dev);
    hipDeviceGetAttribute(&cus, hipDeviceAttributeMultiprocessorCount, dev);
    hipOccupancyMaxActiveBlocksPerMultiprocessor(&per_cu, k_mega, NTHR, 0);
    if (per_cu > 1) per_cu = 1;
    grid_blocks = cus * per_cu;
  }
  hipMemsetAsync(p.ws + OFF_BAR, 0, 16384, stream);
  void* args[] = {&p};
  hipError_t e = hipLaunchCooperativeKernel((void*)k_mega, dim3(grid_blocks), dim3(NTHR), args, 0, stream);
  if (e != hipSuccess) fprintf(stderr, "cooperative launch failed: %s (grid %d)\n", hipGetErrorString(e), grid_blocks);
#endif
}
```

```cpp
#define MEGA 1
#include <hip/hip_runtime.h>
#include <hip/hip_cooperative_groups.h>
#include <cstdio>

#ifndef SEQ_T
#define SEQ_T 8192
#endif
#ifndef CTX_L
#define CTX_L 256
#endif

#define DI __device__ __forceinline__
typedef unsigned short bf16_t;
typedef short bf16x8 __attribute__((ext_vector_type(8)));
typedef float f32x16 __attribute__((ext_vector_type(16)));
typedef float f32x4 __attribute__((ext_vector_type(4)));
typedef unsigned u32x4 __attribute__((ext_vector_type(4)));

constexpr int NB_ = 2, T_ = SEQ_T, CL_ = CTX_L, D_ = 1024;
constexpr int NX_ = NB_ * T_, NC_ = NB_ * CL_, NT_ = NX_ + NC_, KT_ = CL_ + T_;
constexpr int GRID_W_ = 64;
constexpr int MLA_H = 8, MLA_NOPE_ = 64, MLA_ROPE_ = 32, MLA_DK = 96, MLA_DV = 64, QLORA = 384, KVLORA = 256;
constexpr int MLA_IN_ = 672, ML_IN_ = 784, RW_IN_ = 1152, GATE_IN_ = 3072, D_IN_ = 5680;
constexpr int ZMLA_W = 768;
constexpr int ZREC_W = 1936;
constexpr int WIN_N = 768 + 2048;
constexpr int ML_H = 4, ML_DK = 32, ML_DV = 64, ML_L = 64;
constexpr int RW_H = 4, RW_N_ = 64;
constexpr int NE_ = 64, TOPK_ = 8, DE_ = 256;
constexpr int NCH_ = KT_ / ML_L;
constexpr int NSEQ_ = 2 * NB_ * 4;

constexpr int ZR_MLQ = 0, ZR_MLK = 128, ZR_MLV = 256, ZR_MLO = 512, ZR_MLI = 768, ZR_MLF = 776;
constexpr int ZR_RW = 784;

constexpr size_t al256(size_t x) { return (x + 255) & ~(size_t)255; }
constexpr size_t WM_WIN = 0;
constexpr size_t WM_GATE = WM_WIN + (size_t)WIN_N * 1024 * 2;
constexpr size_t WM_UQ = WM_GATE + (size_t)3072 * 1024 * 2;
constexpr size_t WM_UKV = WM_UQ + (size_t)768 * 384 * 2;
constexpr size_t WM_BRA = WM_UKV + (size_t)1024 * 256 * 2;
constexpr size_t WM_BRM = WM_BRA + (size_t)1024 * 512 * 2;
constexpr size_t WM_BRR = WM_BRM + (size_t)1024 * 256 * 2;
constexpr size_t WM_OUT = WM_BRR + (size_t)1024 * 256 * 2;
constexpr size_t WM_RT = WM_OUT + (size_t)1024 * 1024 * 2;
constexpr size_t WM_SIZE = al256(WM_RT + (size_t)64 * 1024 * 2);
constexpr size_t WE_GU = 0;
constexpr size_t WE_DN = WE_GU + (size_t)65 * 512 * 1024 * 2;
constexpr size_t WE_SIZE = al256(WE_DN + (size_t)65 * 1024 * 256 * 2);

constexpr size_t OFF_XS = 0;
constexpr size_t OFF_MOD = OFF_XS + al256((size_t)NT_ * 1024 * 4);
constexpr size_t OFF_ROPE = OFF_MOD + al256((size_t)2 * 3 * 6144 * 4);
constexpr size_t OFF_H = OFF_ROPE + al256((size_t)T_ * 16 * 8);
constexpr size_t OFF_WMIX = OFF_H + al256((size_t)NT_ * 1024 * 2);
constexpr size_t OFF_CNT = OFF_WMIX + 2 * WM_SIZE;
constexpr size_t OFF_BAR = OFF_CNT + 32768;
constexpr size_t OFF_REGION = OFF_BAR + 16384;
constexpr size_t R_ZREC = 0;
constexpr size_t R_RB16 = R_ZREC + al256((size_t)NT_ * ZREC_W * 4);
constexpr size_t R_LW = R_RB16 + al256((size_t)7 * NT_ * 256 * 2);
constexpr size_t R_BS = R_LW + al256((size_t)2 * NT_ * 256 * 4);
constexpr size_t R_CH = R_BS + al256((size_t)2 * NT_ * 4 * 4);
constexpr size_t R_YS = R_CH + al256((size_t)NSEQ_ * NCH_ * 40960);
constexpr size_t R_MLST = R_YS + al256((size_t)2 * NT_ * 256 * 4);
constexpr size_t R_ATT = R_MLST + al256((size_t)NSEQ_ * NCH_ * 2112 * 4);
constexpr size_t R_MLO = R_ATT + al256((size_t)NT_ * 512 * 2);
constexpr size_t R_RWO = R_MLO + al256((size_t)NT_ * 256 * 2);
constexpr size_t R_VT = R_RWO + al256((size_t)NT_ * 256 * 2);
constexpr size_t R_KB = R_VT + al256((size_t)NB_ * MLA_H * 64 * KT_ * 2);
constexpr size_t R_MIX_END = R_KB + al256((size_t)NB_ * MLA_H * KT_ * 96 * 2);
constexpr int NSLOT_ = NT_ * 9;
constexpr size_t R_YBUF = 0;
constexpr size_t R_EIDX = R_YBUF + al256((size_t)NSLOT_ * 1024 * 2);
constexpr size_t R_EWT = R_EIDX + al256((size_t)NT_ * 8 * 4);
constexpr size_t R_ERANK = R_EWT + al256((size_t)NT_ * 8 * 4);
constexpr size_t R_ELIST = R_ERANK + al256((size_t)NT_ * 8 * 4);
constexpr size_t R_WMOE = R_ELIST + al256((size_t)64 * NT_ * 4);
constexpr size_t R_MOE_END = R_WMOE + WE_SIZE;
constexpr size_t R_SIZE = R_MIX_END > R_MOE_END ? R_MIX_END : R_MOE_END;
constexpr size_t WS_NEEDED = OFF_REGION + R_SIZE;
constexpr size_t O_ZMLA = 0;
constexpr size_t O_QB = O_ZMLA + al256((size_t)NT_ * ZMLA_W * 2);
constexpr size_t O_END = O_QB + al256((size_t)NT_ * 768 * 2);
constexpr int ATT_NPIECE = 4, ATT_NSPLIT = 16, ATT_PLD = 68;
constexpr size_t O_APART = O_END;
constexpr size_t O_END2 = O_APART + al256((size_t)ATT_NSPLIT * ATT_NPIECE * 256 * ATT_PLD * 4);
constexpr size_t O_YMIX = 0;
#if SEQ_T == 8192 && CTX_L == 256
static_assert(O_END2 <= (size_t)NX_ * 1024 * 4, "d_out scratch overflow");
static_assert((size_t)NT_ * 1024 * 2 <= (size_t)NX_ * 1024 * 4, "ymix overflow");
static_assert(WS_NEEDED <= (size_t)597000000, "workspace too large");
#endif

struct Params {
  const float *x, *c, *ctx, *c_ctx, *w_mod, *b_mod, *g_mix, *g_ffn, *w_in, *g_cq, *w_uq, *g_ckv, *w_uk, *w_uv;
  const float *ml_b_i, *ml_b_f, *ml_g_norm, *rw_mu, *rw_w0, *rw_w2, *rw_a0, *rw_a2, *rw_g2, *rw_k_k, *rw_k_a;
  const float *rw_r_k, *rw_lnx_w, *rw_lnx_b, *w_br_mla, *w_br_ml, *w_br_rw, *w_out, *w_router, *router_bias;
  const float *w_e_gate, *w_e_up, *w_e_down, *w_s_gate, *w_s_up, *w_s_down, *g_final;
  float* out; char* ws; char* osc;
};

DI float bf2f(bf16_t s) { unsigned u = ((unsigned)s) << 16; float f; __builtin_memcpy(&f, &u, 4); return f; }
DI bf16_t f2bf(float x) { unsigned u; __builtin_memcpy(&u, &x, 4); u += 0x7fffu + ((u >> 16) & 1u); return (bf16_t)(u >> 16); }
DI unsigned pack2bf(float a, float b) {
#ifdef EMU
  return (unsigned)f2bf(a) | ((unsigned)f2bf(b) << 16);
#else
  typedef __bf16 bf2 __attribute__((ext_vector_type(2)));
  typedef float f2 __attribute__((ext_vector_type(2)));
  f2 v = {a, b}; bf2 r = __builtin_convertvector(v, bf2); return __builtin_bit_cast(unsigned, r);
#endif
}
DI f32x16 mfma32(bf16x8 a, bf16x8 b, f32x16 c) {
#ifdef EMU
  return emu_mfma_32x32x16_bf16(a, b, c);
#else
  return __builtin_amdgcn_mfma_f32_32x32x16_bf16(a, b, c, 0, 0, 0);
#endif
}
DI int rfl(int v) {
#ifdef EMU
  return v;
#else
  return __builtin_amdgcn_readfirstlane(v);
#endif
}
DI int opaque_tid() {
#ifdef EMU
  return threadIdx.x;
#else
  int t = threadIdx.x; asm volatile("" : "+v"(t)); return t;
#endif
}
DI void wave_sync() {
#ifdef EMU
  (void)__ballot(1);
#else
  asm volatile("" ::: "memory");
#endif
}
DI int vblock() {
  const int g = gridDim.x, b = blockIdx.x;
  return (g & 7) == 0 ? (b & 7) * (g >> 3) + (b >> 3) : b;
}
DI int xcc_id() {
#ifdef EMU
  return blockIdx.x & 7;
#else
  return (int)(__builtin_amdgcn_s_getreg((3 << 11) | 20) & 7u);
#endif
}
DI int ld_relaxed(int* p) {
#ifdef EMU
  return __atomic_load_n(p, __ATOMIC_SEQ_CST);
#else
  return __hip_atomic_load(p, __ATOMIC_RELAXED, __HIP_MEMORY_SCOPE_AGENT);
#endif
}
DI void sched_fence() {
#ifndef EMU
  __builtin_amdgcn_sched_barrier(0);
#endif
}
template <int L> DI float lane_bcast(float x) {
#ifdef EMU
  return __shfl(x, L);
#else
  return __builtin_bit_cast(float, __builtin_amdgcn_readlane(__builtin_bit_cast(int, x), L));
#endif
}
DI f32x16 zero16() { f32x16 z; for (int i = 0; i < 16; ++i) z[i] = 0.f; return z; }
DI int crow(int reg, int h) { return (reg & 3) + 8 * (reg >> 2) + 4 * h; }
#ifdef EMU
DI float fexp(float x) { return expf(x); }
#else
DI float fexp(float x) { return __expf(x); }
#endif
#ifdef EMU
DI float frcp(float x) { return 1.f / x; }
DI float frsq(float x) { return 1.f / sqrtf(x); }
#else
DI float frcp(float x) { return __builtin_amdgcn_rcpf(x); }
DI float frsq(float x) { return __builtin_amdgcn_rsqf(x); }
#endif
#ifdef EMU
DI float flog(float x) { return logf(x); }
#else
DI float flog(float x) { return __builtin_amdgcn_logf(x) * 0.6931471805599453f; }
#endif
DI float sigmoidf_(float x) { return frcp(1.f + fexp(-x)); }
DI float siluf_(float x) { return x * sigmoidf_(x); }
#ifdef EMU
DI float wave_sum(float v) { for (int m = 32; m >= 1; m >>= 1) v += __shfl_xor(v, m); return v; }
DI float wave_max(float v) { for (int m = 32; m >= 1; m >>= 1) v = fmaxf(v, __shfl_xor(v, m)); return v; }
#else
#define DPPF(x, ctrl) __builtin_bit_cast(float, __builtin_amdgcn_mov_dpp(__builtin_bit_cast(int, (x)), (ctrl), 0xf, 0xf, true))
#define RDLF(x, l) __builtin_bit_cast(float, __builtin_amdgcn_readlane(__builtin_bit_cast(int, (x)), (l)))
DI float wave_sum(float v) {
  v += DPPF(v, 0xB1); v += DPPF(v, 0x4E); v += DPPF(v, 0x124); v += DPPF(v, 0x128);
  return (RDLF(v, 0) + RDLF(v, 16)) + (RDLF(v, 32) + RDLF(v, 48));
}
DI float wave_max(float v) {
  v = fmaxf(v, DPPF(v, 0xB1)); v = fmaxf(v, DPPF(v, 0x4E)); v = fmaxf(v, DPPF(v, 0x124)); v = fmaxf(v, DPPF(v, 0x128));
  return fmaxf(fmaxf(RDLF(v, 0), RDLF(v, 16)), fmaxf(RDLF(v, 32), RDLF(v, 48)));
}
#endif

#ifdef EMU
DI float lx1(float v) { return __shfl_xor(v, 1); }
DI float lx2(float v) { return __shfl_xor(v, 2); }
DI float lx4m(float v) { return __shfl_xor(v, 4); }
DI float lx8(float v) { return __shfl_xor(v, 8); }
DI float shfl_up_l(float v, int d, int lane) { (void)lane; return __shfl_up(v, d); }
#else
DI float lx1(float v) { return DPPF(v, 0xB1); }
DI float lx2(float v) { return DPPF(v, 0x4E); }
DI float lx4m(float v) { return DPPF(v, 0x141); }
DI float lx8(float v) { return DPPF(v, 0x128); }
DI float shfl_up_l(float v, int d, int lane) { return __builtin_bit_cast(float, __builtin_amdgcn_ds_bpermute((lane - d) << 2, __builtin_bit_cast(int, v))); }
#endif
#ifdef EMU
template <int K> DI float qbcast(float v) { return __shfl(v, (int)((threadIdx.x & 63) & ~3) + K); }
DI int lx1i(int v) { return __shfl_xor(v, 1); }
DI int lx2i(int v) { return __shfl_xor(v, 2); }
#else
template <int K> DI float qbcast(float v) { return DPPF(v, K * 0x55); }
DI int lx1i(int v) { return __builtin_amdgcn_mov_dpp(v, 0xB1, 0xf, 0xf, true); }
DI int lx2i(int v) { return __builtin_amdgcn_mov_dpp(v, 0x4E, 0xf, 0xf, true); }
#endif
#ifdef EMU
DI float swap32_max(float v) { return fmaxf(v, __shfl_xor(v, 32)); }
DI float swap32_sum(float v) { return v + __shfl_xor(v, 32); }
#else
DI float swap32_max(float v) { auto rr = __builtin_amdgcn_permlane32_swap(__float_as_uint(v), __float_as_uint(v), false, false); return fmaxf(__uint_as_float(rr[0]), __uint_as_float(rr[1])); }
DI float swap32_sum(float v) { auto rr = __builtin_amdgcn_permlane32_swap(__float_as_uint(v), __float_as_uint(v), false, false); return __uint_as_float(rr[0]) + __uint_as_float(rr[1]); }
#endif
DI int tok_b(int n) { return n < NX_ ? n / T_ : (n - NX_) / CL_; }
DI int tok_t(int n) { return n < NX_ ? n % T_ : (n - NX_) % CL_; }
DI int tok_key(int n) { return n < NX_ ? CL_ + n % T_ : (n - NX_) % CL_; }
DI int tok_modrow(int n) { return n < NX_ ? n / T_ : 2; }

#ifdef EMU
#define SMEM_DECL(name, bytes) char* name = (char*)emu::shared_alloc(bytes)
#else
#define SMEM_DECL(name, bytes) __shared__ __attribute__((aligned(16))) char name[bytes]
#endif
#define NTHR 512
#if defined(PROBE_IDX) && !defined(EMU)
#define TSB(pp, i) { if (blockIdx.x == 0 && threadIdx.x == 0) ((long long*)((pp).ws + OFF_CNT + 2048))[i] = wall_clock64(); }
#else
#define TSB(pp, i)
#endif
struct CvtJob { const float* src; int lds; int K; bf16_t* dst; int ntn; int ntk; int maptype; const float* gain; };
DI int cvt_map(int maptype, int coff, int np) {
  if (maptype == 0) return coff + np;
  if (maptype == 1) { if (np < 672) return np; if (np < 768) return -1; if (np < 768 + 1936) return np - 96; return -1; }
  return np;
}
struct CvtItem { CvtJob j; int coff, tk, tn; };
struct CvtRegs { float v[8]; };
DI void cvt_load(const CvtItem& c, int tid, CvtRegs& r) {
  const int kk = tid >> 4, np = c.tn * 64 + (tid & 15) * 4;
  const int sc = cvt_map(c.j.maptype, c.coff, np);
#pragma unroll
  for (int u = 0; u < 2; ++u) {
    const int k = c.tk * 64 + kk + 32 * u;
    float4 v = make_float4(0.f, 0.f, 0.f, 0.f);
    if (sc >= 0) v = *(const float4*)(c.j.src + (size_t)k * c.j.lds + sc);
    const float g = c.j.gain ? c.j.gain[k] : 1.f;
    r.v[4 * u] = v.x * g; r.v[4 * u + 1] = v.y * g; r.v[4 * u + 2] = v.z * g; r.v[4 * u + 3] = v.w * g;
  }
}
DI void cvt_store(const CvtItem& c, int tid, const CvtRegs& r, char* smem) {
  float* tile = (float*)smem;
  __syncthreads();
  {
    const int kk = tid >> 4, nc = (tid & 15) * 4;
#pragma unroll
    for (int u = 0; u < 2; ++u)
#pragma unroll
      for (int i = 0; i < 4; ++i) tile[(kk + 32 * u) * 65 + nc + i] = r.v[4 * u + i];
  }
  __syncthreads();
  {
    const int n = tid >> 3, kc = (tid & 7) * 8;
    int np = c.tn * 64 + n;
    if (c.j.maptype == 2) np = (np >> 5) * 64 + c.coff * 32 + (np & 31);
    uint4 v;
    v.x = pack2bf(tile[(kc + 0) * 65 + n], tile[(kc + 1) * 65 + n]);
    v.y = pack2bf(tile[(kc + 2) * 65 + n], tile[(kc + 3) * 65 + n]);
    v.z = pack2bf(tile[(kc + 4) * 65 + n], tile[(kc + 5) * 65 + n]);
    v.w = pack2bf(tile[(kc + 6) * 65 + n], tile[(kc + 7) * 65 + n]);
    *(uint4*)(c.j.dst + (size_t)np * c.j.K + c.tk * 64 + kc) = v;
  }
}
template <class Dec> DI void cvt_run(Dec dec, int first, int n, int stride, char* smem) {
  const int tid = opaque_tid();
  if (first >= n) return;
  CvtItem cur = dec(first); CvtRegs rc; cvt_load(cur, tid, rc);
  for (int it = first; it < n; it += stride) {
    const int nx = it + stride < n ? it + stride : it;
    CvtItem nxt = dec(nx); CvtRegs rn; cvt_load(nxt, tid, rn);
    sched_fence();
    cvt_store(cur, tid, rc, smem);
    cur = nxt; rc = rn;
  }
}

constexpr int CVT_MIX_TILES = 704 + 768 + 72 + 32 + 32 + 128 + 64 + 64 + 256 + 16;
DI CvtItem cvt_mix_dec(const Params& p, int l, int it) {
  bf16_t* W = (bf16_t*)(p.ws + OFF_WMIX + (size_t)l * WM_SIZE);
  CvtJob j; int coff = 0;
  if (it < 704) { j = {p.w_in + (size_t)l * 1024 * D_IN_, D_IN_, 1024, (bf16_t*)((char*)W + WM_WIN), 44, 16, 1, nullptr}; }
  else if ((it -= 704) < 768) { j = {p.w_in + (size_t)l * 1024 * D_IN_, D_IN_, 1024, (bf16_t*)((char*)W + WM_GATE), 48, 16, 0, nullptr}; coff = 2608; }
  else if ((it -= 768) < 72) { j = {p.w_uq + (size_t)l * 384 * 768, 768, 384, (bf16_t*)((char*)W + WM_UQ), 12, 6, 0, p.g_cq + l * 384}; }
  else if ((it -= 72) < 32) { j = {p.w_uk + (size_t)l * 256 * 512, 512, 256, (bf16_t*)((char*)W + WM_UKV), 8, 4, 0, p.g_ckv + l * 256}; }
  else if ((it -= 32) < 32) { j = {p.w_uv + (size_t)l * 256 * 512, 512, 256, (bf16_t*)((char*)W + WM_UKV) + 512 * 256, 8, 4, 0, p.g_ckv + l * 256}; }
  else if ((it -= 32) < 128) { j = {p.w_br_mla + (size_t)l * 512 * 1024, 1024, 512, (bf16_t*)((char*)W + WM_BRA), 16, 8, 0, nullptr}; }
  else if ((it -= 128) < 64) { j = {p.w_br_ml + (size_t)l * 256 * 1024, 1024, 256, (bf16_t*)((char*)W + WM_BRM), 16, 4, 0, nullptr}; }
  else if ((it -= 64) < 64) { j = {p.w_br_rw + (size_t)l * 256 * 1024, 1024, 256, (bf16_t*)((char*)W + WM_BRR), 16, 4, 0, nullptr}; }
  else if ((it -= 64) < 256) { j = {p.w_out + (size_t)l * 1024 * 1024, 1024, 1024, (bf16_t*)((char*)W + WM_OUT), 16, 16, 0, nullptr}; }
  else { it -= 256; j = {p.w_router + (size_t)l * 1024 * 64, 64, 1024, (bf16_t*)((char*)W + WM_RT), 1, 16, 0, nullptr}; }
  CvtItem c; c.j = j; c.coff = coff; c.tk = it / j.ntn; c.tn = it % j.ntn; return c;
}
constexpr int CVT_MOE_TILES = 65 * 192;
DI CvtItem cvt_moe_dec(const Params& p, int l, int it) {
  const int e = it / 192; int r = it % 192;
  bf16_t* GU = (bf16_t*)(p.ws + OFF_REGION + R_WMOE + WE_GU) + (size_t)e * 512 * 1024;
  bf16_t* DN = (bf16_t*)(p.ws + OFF_REGION + R_WMOE + WE_DN) + (size_t)e * 1024 * 256;
  const float* sg = e < 64 ? p.w_e_gate + ((size_t)l * 64 + e) * 1024 * 256 : p.w_s_gate + (size_t)l * 1024 * 256;
  const float* su = e < 64 ? p.w_e_up + ((size_t)l * 64 + e) * 1024 * 256 : p.w_s_up + (size_t)l * 1024 * 256;
  const float* sd = e < 64 ? p.w_e_down + ((size_t)l * 64 + e) * 256 * 1024 : p.w_s_down + (size_t)l * 256 * 1024;
  CvtJob j; int coff = 0;
  if (r < 64) { j = {sg, 256, 1024, GU, 4, 16, 2, nullptr}; coff = 0; }
  else if ((r -= 64) < 64) { j = {su, 256, 1024, GU, 4, 16, 2, nullptr}; coff = 1; }
  else { r -= 64; j = {sd, 1024, 256, DN, 16, 4, 0, nullptr}; }
  CvtItem c; c.j = j; c.coff = coff; c.tk = r / j.ntn; c.tn = r % j.ntn; return c;
}

DI void mod_item(const Params& p, int it, char* smem) {
  float* cond = (float*)smem;
  float* red = cond + 3 * 1024;
  const int tid = opaque_tid(), l = it / 96, j0 = (it % 96) * 64;
  __syncthreads();
  for (int i = tid; i < 3 * 1024; i += NTHR) {
    const int r = i >> 10, k = i & 1023;
    const float v = r < 2 ? p.c[r * 1024 + k] : p.c_ctx[k];
    cond[i] = siluf_(v);
  }
  __syncthreads();
  const int c4 = tid & 15, kg = tid >> 4;
  float a[3][4];
#pragma unroll
  for (int r = 0; r < 3; ++r)
#pragma unroll
    for (int q = 0; q < 4; ++q) a[r][q] = 0.f;
  const float* w = p.w_mod + (size_t)l * 1024 * 6144 + j0 + c4 * 4;
#pragma unroll 8
  for (int i = 0; i < 32; ++i) {
    const int k = kg + 32 * i;
    const float4 wv = *(const float4*)(w + (size_t)k * 6144);
#pragma unroll
    for (int r = 0; r < 3; ++r) {
      const float c = cond[r * 1024 + k];
      a[r][0] += c * wv.x; a[r][1] += c * wv.y; a[r][2] += c * wv.z; a[r][3] += c * wv.w;
    }
  }
#pragma unroll
  for (int r = 0; r < 3; ++r) *(float4*)(red + (kg * 3 + r) * 64 + c4 * 4) = make_float4(a[r][0], a[r][1], a[r][2], a[r][3]);
  __syncthreads();
  if (tid < 192) {
    const int r = tid >> 6, jj = tid & 63; float s = 0.f;
    for (int g = 0; g < 32; ++g) s += red[(g * 3 + r) * 64 + jj];
    float* mod = (float*)(p.ws + OFF_MOD);
    mod[((size_t)l * 3 + r) * 6144 + j0 + jj] = s + p.b_mod[(size_t)l * 6144 + j0 + jj];
  }
}
DI void rope_item(const Params& p, int it) {
  const int idx = it * NTHR + threadIdx.x;
  if (idx >= T_ * 16) return;
  const int t = idx >> 4, i = idx & 15, f = i & 7;
  const float pos = (float)(i < 8 ? t / GRID_W_ : t % GRID_W_);
  const float inv = powf(10000.f, -(float)(2 * f) / 16.f);
  const float ang = pos * inv;
  float2* rt = (float2*)(p.ws + OFF_ROPE);
  rt[idx] = make_float2(cosf(ang), sinf(ang));
}
constexpr int PA_ITEMS = 192 + (T_ * 16 + NTHR - 1) / NTHR;
DI void phaseA(const Params& p, char* smem) {
  if (blockIdx.x == 0) for (int i = threadIdx.x; i < 8192; i += NTHR) ((int*)(p.ws + OFF_CNT))[i] = 0;
  for (int it = blockIdx.x; it < PA_ITEMS; it += gridDim.x) {
    if (it < 192) mod_item(p, it, smem); else rope_item(p, it - 192);
  }
  cvt_run([&](int i) { return cvt_mix_dec(p, i / CVT_MIX_TILES, i % CVT_MIX_TILES); }, blockIdx.x, 2 * CVT_MIX_TILES, gridDim.x, smem);
}

DI void row_norm_mod(const float (&v)[16], const float* g, const float* shift, const float* scale, bf16_t* hrow, int lane) {
  float ss = 0.f;
#pragma unroll
  for (int i = 0; i < 16; ++i) ss += v[i] * v[i];
  ss = wave_sum(ss);
  const float rs = frsq(ss * (1.f / 1024.f) + 1e-6f);
#pragma unroll
  for (int j = 0; j < 4; ++j) {
    const int c = (j * 64 + lane) * 4;
    const float4 gg = *(const float4*)(g + c), sh = *(const float4*)(shift + c), sc = *(const float4*)(scale + c);
    const float h0 = v[j * 4 + 0] * rs * gg.x * (1.f + sc.x) + sh.x;
    const float h1 = v[j * 4 + 1] * rs * gg.y * (1.f + sc.y) + sh.y;
    const float h2 = v[j * 4 + 2] * rs * gg.z * (1.f + sc.z) + sh.z;
    const float h3 = v[j * 4 + 3] * rs * gg.w * (1.f + sc.w) + sh.w;
    uint2 o; o.x = pack2bf(h0, h1); o.y = pack2bf(h2, h3);
    *(uint2*)(hrow + c) = o;
  }
}
DI void phase_norm0(const Params& p) {
  const int lane = threadIdx.x & 63, wid = threadIdx.x >> 6;
  float* xs = (float*)(p.ws + OFF_XS);
  bf16_t* H = (bf16_t*)(p.ws + OFF_H);
  const float* mod = (const float*)(p.ws + OFF_MOD);
  for (int n = blockIdx.x * 8 + wid; n < NT_; n += gridDim.x * 8) {
    const float* src = n < NX_ ? p.x + (size_t)n * 1024 : p.ctx + (size_t)(n - NX_) * 1024;
    float v[16];
#pragma unroll
    for (int j = 0; j < 4; ++j) {
      const float4 t = *(const float4*)(src + (j * 64 + lane) * 4);
      v[j * 4] = t.x; v[j * 4 + 1] = t.y; v[j * 4 + 2] = t.z; v[j * 4 + 3] = t.w;
      *(float4*)(xs + (size_t)n * 1024 + (j * 64 + lane) * 4) = t;
    }
    const float* m = mod + (size_t)(0 * 3 + tok_modrow(n)) * 6144;
    row_norm_mod(v, p.g_mix, m, m + 1024, H + (size_t)n * 1024, lane);
  }
}

template <int BM, int BN, int BK, int WM_, int WN_>
struct Gemm {
  static constexpr int WTM = BM / WM_, WTN = BN / WN_, MB = WTM / 32, NB = WTN / 32, WM = WM_, WN = WN_, TM = BM, TN = BN;
  static constexpr int LDA = BK + 8;
  static constexpr int A_BYTES = BM * LDA * 2, B_BYTES = BN * LDA * 2, STAGE = A_BYTES + B_BYTES;
  static constexpr int SMEM = 2 * STAGE;
  static constexpr int CPR = BK / 8;
  static constexpr int ACH = BM * CPR / NTHR, BCH = BN * CPR / NTHR;
  static_assert(WM_ * WN_ == 8, "8 waves");
  static_assert(BM * CPR % NTHR == 0 && BN * CPR % NTHR == 0, "chunking");
  static_assert(NTHR % CPR == 0, "rows fixed per thread");

  template <class LA, class LB>
  static DI void run_core(f32x16 (&acc)[MB][NB], LA la, LB lb, int nk, char* smem, int tid) {
    const int lane = tid & 63, wid = tid >> 6, wm = wid / WN_, wn = wid % WN_;
    const int kc = (tid % CPR) * 8, r0 = tid / CPR;
    constexpr int KS = BK / 16, NCH = ACH + BCH;
    u32x4 s0[NCH], s1[NCH];
#define GEMM_LOAD(dst_, kt_) { const int kq_ = (kt_) < nk ? (kt_) : nk - 1; \
    _Pragma("unroll") for (int i = 0; i < ACH; ++i) dst_[i] = la(i, kq_); \
    _Pragma("unroll") for (int i = 0; i < BCH; ++i) dst_[ACH + i] = lb(i, kq_); }
#define GEMM_WRITE1(src_, c_, buf_) { if ((c_) < ACH) *(u32x4*)(smem + (buf_) * STAGE + ((r0 + (c_) * (NTHR / CPR)) * LDA + kc) * 2) = src_[c_]; \
    else *(u32x4*)(smem + (buf_) * STAGE + A_BYTES + ((r0 + ((c_) - ACH) * (NTHR / CPR)) * LDA + kc) * 2) = src_[c_]; }
#define GEMM_STEP(w_, l_, kt_) { \
    GEMM_LOAD(l_, (kt_) + 2); \
    sched_fence(); \
    const char* As = smem + ((kt_) & 1) * STAGE; const char* Bs = As + A_BYTES; \
    _Pragma("unroll") for (int ks = 0; ks < KS; ++ks) { \
      bf16x8 af[MB], bfr[NB]; \
      _Pragma("unroll") for (int mb = 0; mb < MB; ++mb) af[mb] = *(const bf16x8*)(As + ((wm * WTM + mb * 32 + (lane & 31)) * LDA + ks * 16 + (lane >> 5) * 8) * 2); \
      _Pragma("unroll") for (int nb = 0; nb < NB; ++nb) bfr[nb] = *(const bf16x8*)(Bs + ((wn * WTN + nb * 32 + (lane & 31)) * LDA + ks * 16 + (lane >> 5) * 8) * 2); \
      _Pragma("unroll") for (int c = 0; c < NCH; ++c) if ((c * KS) / NCH == ks) GEMM_WRITE1(w_, c, ((kt_) + 1) & 1); \
      _Pragma("unroll") for (int mb = 0; mb < MB; ++mb) _Pragma("unroll") for (int nb = 0; nb < NB; ++nb) acc[mb][nb] = mfma32(af[mb], bfr[nb], acc[mb][nb]); \
    } \
    sched_fence(); \
    __syncthreads(); }
    GEMM_LOAD(s0, 0);
#pragma unroll
    for (int c = 0; c < NCH; ++c) GEMM_WRITE1(s0, c, 0);
    GEMM_LOAD(s0, 1);
    __syncthreads();
    for (int kt = 0; kt < nk; kt += 2) {
      GEMM_STEP(s0, s1, kt);
      GEMM_STEP(s1, s0, kt + 1);
    }
#undef GEMM_STEP
#undef GEMM_WRITE1
#undef GEMM_LOAD
  }
  template <class ARow>
  static DI void run(f32x16 (&acc)[MB][NB], ARow arow, const bf16_t* Bt, int ldb, int Klen, char* smem) {
    const int tid = opaque_tid();
    const int kc = (tid % CPR) * 8, r0 = tid / CPR;
    const bf16_t* ap[ACH];
#pragma unroll
    for (int i = 0; i < ACH; ++i) ap[i] = arow(r0 + i * (NTHR / CPR)) + kc;
    const bf16_t* bp0 = Bt + (size_t)r0 * ldb + kc;
    const size_t sb = (size_t)(NTHR / CPR) * ldb;
    run_core(acc, [&](int i, int kt) { return *(const u32x4*)(ap[i] + kt * BK); },
             [&](int i, int kt) { return *(const u32x4*)(bp0 + i * sb + kt * BK); }, Klen / BK, smem, tid);
  }
  static DI void run_lin(f32x16 (&acc)[MB][NB], const bf16_t* A0, int lda, const bf16_t* Bt, int ldb, int Klen, char* smem) {
    const int tid = opaque_tid();
    const int kc = (tid % CPR) * 8, r0 = tid / CPR;
    const bf16_t* ap0 = A0 + (size_t)r0 * lda + kc; const bf16_t* bp0 = Bt + (size_t)r0 * ldb + kc;
    const size_t sa = (size_t)(NTHR / CPR) * lda, sb = (size_t)(NTHR / CPR) * ldb;
    run_core(acc, [&](int i, int kt) { return *(const u32x4*)(ap0 + i * sa + kt * BK); },
             [&](int i, int kt) { return *(const u32x4*)(bp0 + i * sb + kt * BK); }, Klen / BK, smem, tid);
  }
  static DI int row_of(int t, int mb, int reg) { const int lane = t & 63, wm = (t >> 6) / WN_; return wm * WTM + mb * 32 + crow(reg, lane >> 5); }
  static DI int col_of(int t, int nb) { const int lane = t & 63, wn = (t >> 6) % WN_; return wn * WTN + nb * 32 + (lane & 31); }
};


template <int NBW> struct WTile {
  static constexpr int LD = NBW * 32 + 4;
  static constexpr int BYTES = 32 * LD * 4;
  static DI void put(float* scr, int nb, int lane, const f32x16& v) {
    const int c = nb * 32 + (lane & 31), h = lane >> 5;
#pragma unroll
    for (int i = 0; i < 16; ++i) scr[crow(i, h) * LD + c] = v[i];
  }
  template <class F> static DI void rows4(const float* scr, int lane, F f) {
    wave_sync();
#pragma unroll
    for (int it = 0; it < NBW * 4; ++it) {
      const int id = it * 64 + lane, row = id / (NBW * 8), q = id % (NBW * 8);
      f(row, q * 4, *(const float4*)(scr + row * LD + q * 4));
    }
    wave_sync();
  }
  template <class F> static DI void rows8(const float* scr, int lane, F f) {
    wave_sync();
#pragma unroll
    for (int it = 0; it < NBW * 2; ++it) {
      const int id = it * 64 + lane, row = id / (NBW * 4), q = id % (NBW * 4);
      f(row, q * 8, *(const float4*)(scr + row * LD + q * 8), *(const float4*)(scr + row * LD + q * 8 + 4));
    }
    wave_sync();
  }
};
DI uint4 pack8bf(const float4& a, const float4& b) { return make_uint4(pack2bf(a.x, a.y), pack2bf(a.z, a.w), pack2bf(b.x, b.y), pack2bf(b.z, b.w)); }

typedef Gemm<256, 256, 64, 2, 4> G256;
DI void phase_win(const Params& p, int l, char* smem) {
  const bf16_t* H = (const bf16_t*)(p.ws + OFF_H);
  const bf16_t* W = (const bf16_t*)(p.ws + OFF_WMIX + (size_t)l * WM_SIZE + WM_WIN);
  bf16_t* zmla = (bf16_t*)(p.osc + O_ZMLA);
  float* zrec = (float*)(p.ws + OFF_REGION + R_ZREC);
  constexpr int TM = NT_ / 256, TN = WIN_N / 256;
  for (int it = vblock(); it < TM * TN; it += gridDim.x) {
    const int tid = opaque_tid();
    const int tm = it / TN, tn = it % TN;
    __syncthreads();
    f32x16 acc[G256::MB][G256::NB];
#pragma unroll
    for (int a = 0; a < G256::MB; ++a)
#pragma unroll
      for (int b = 0; b < G256::NB; ++b) acc[a][b] = zero16();
    const bf16_t* A0 = H + (size_t)tm * 256 * 1024;
    G256::run(acc, [&](int r) { return A0 + (size_t)r * 1024; }, W + (size_t)tn * 256 * 1024, 1024, 1024, smem);
    {
      const int lane = tid & 63, wid = tid >> 6, wm = wid / 4, wn = wid % 4;
      float* scr = (float*)(smem + wid * WTile<2>::BYTES);
      const int col0 = tn * 256 + wn * 64;
#pragma unroll
      for (int mb = 0; mb < G256::MB; ++mb) {
        WTile<2>::put(scr, 0, lane, acc[mb][0]); WTile<2>::put(scr, 1, lane, acc[mb][1]);
        const int row0 = tm * 256 + wm * 128 + mb * 32;
#ifdef ABL_NOSTORE
        if (tn > 1000) {
#else
        if (tn < 3) {
#endif
          WTile<2>::rows8(scr, lane, [&](int r, int c, const float4& a, const float4& bq) {
            *(uint4*)(zmla + (size_t)(row0 + r) * ZMLA_W + col0 + c) = pack8bf(a, bq); });
        } else {
          WTile<2>::rows4(scr, lane, [&](int r, int c, const float4& a) {
            const int cc = col0 - 768 + c;
#ifdef ABL_NOSTORE
            if (cc < -5) *(float4*)(zrec + (size_t)(row0 + r) * ZREC_W + cc) = a; });
#else
            if (cc < ZREC_W) *(float4*)(zrec + (size_t)(row0 + r) * ZREC_W + cc) = a; });
#endif
        }
      }
    }
  }
}
typedef Gemm<128, 128, 64, 2, 4> G128;
DI void mla_row_rs(const bf16_t* zmla_rows, int c0, int len, float* rs) {
  const int tid = opaque_tid(), row = tid >> 2, half = tid & 3;
  const bf16_t* src = zmla_rows + (size_t)row * ZMLA_W + c0 + half * (len / 4);
  float ss = 0.f;
  for (int i = 0; i < len / 4; i += 8) {
    const uint4 v = *(const uint4*)(src + i);
    const unsigned w[4] = {v.x, v.y, v.z, v.w};
#pragma unroll
    for (int j = 0; j < 4; ++j) { const float a = bf2f((bf16_t)(w[j] & 0xffff)), b = bf2f((bf16_t)(w[j] >> 16)); ss += a * a + b * b; }
  }
  ss += lx1(ss); ss += lx2(ss);
  if (half == 0) rs[row] = frsq(ss / (float)len + 1e-6f);
}

constexpr int MLA_Q_TILES = (NT_ / 128) * 6, MLA_KV_TILES = (NT_ / 128) * 8;
DI void mla_q_item(const Params& p, int l, int it, char* smem) {
  const int tid = opaque_tid();
  const int tm = it / 6, tn = it % 6;
  const bf16_t* zmla = (const bf16_t*)(p.osc + O_ZMLA) + (size_t)tm * 128 * ZMLA_W;
  const bf16_t* W = (const bf16_t*)(p.ws + OFF_WMIX + (size_t)l * WM_SIZE + WM_UQ) + (size_t)tn * 128 * 384;
  bf16_t* qb = (bf16_t*)(p.osc + O_QB);
  const float2* rt = (const float2*)(p.ws + OFF_ROPE);
  float* rs = (float*)(smem + G128::SMEM);
  __syncthreads();
  mla_row_rs(zmla, 0, 384, rs);
  f32x16 acc[G128::MB][G128::NB];
#pragma unroll
  for (int a = 0; a < G128::MB; ++a)
#pragma unroll
    for (int b = 0; b < G128::NB; ++b) acc[a][b] = zero16();
  G128::run(acc, [&](int r) { return zmla + (size_t)r * ZMLA_W; }, W, 384, 384, smem);
  const int lane = tid & 63;
  const bool isx = tm * 128 < NX_;
#pragma unroll
  for (int mb = 0; mb < G128::MB; ++mb)
#pragma unroll
    for (int nb = 0; nb < G128::NB; ++nb) {
      const int col = tn * 128 + G128::col_of(tid, nb);
      const bool ropeblk = ((col >> 5) % 3) == 2;
      const int e = lane & 31;
#pragma unroll
      for (int i = 0; i < 16; ++i) {
        const int lr = G128::row_of(tid, mb, i);
        const int n = tm * 128 + lr;
        float v = acc[mb][nb][i] * rs[lr];
        if (ropeblk && isx) {
          const float pv = lx8(v);
          const float2 cs = rt[(size_t)(n % T_) * 16 + (e >> 4) * 8 + (e & 7)];
          v = (e & 8) ? (pv * cs.y + v * cs.x) : (v * cs.x - pv * cs.y);
        }
        qb[(size_t)n * 768 + col] = f2bf(v);
      }
    }
}
DI void mla_kv_item(const Params& p, int l, int it, char* smem) {
  const int tid = opaque_tid();
  const int tm = it / 8, tn = it % 8;
  const bf16_t* zmla = (const bf16_t*)(p.osc + O_ZMLA) + (size_t)tm * 128 * ZMLA_W;
  const bf16_t* W = (const bf16_t*)(p.ws + OFF_WMIX + (size_t)l * WM_SIZE + WM_UKV) + (size_t)tn * 128 * 256;
  bf16_t* kb = (bf16_t*)(p.ws + OFF_REGION + R_KB);
  bf16_t* vt = (bf16_t*)(p.ws + OFF_REGION + R_VT);
  const float2* rt = (const float2*)(p.ws + OFF_ROPE);
  float* rs = (float*)(smem + G128::SMEM);
  __syncthreads();
  mla_row_rs(zmla, 384, 256, rs);
  const int n0 = tm * 128;
  const int b = tok_b(n0), key0 = tok_key(n0);
  const bool isx = n0 < NX_;
  if (tn == 0) {
    for (int idx = tid; idx < 128 * 16; idx += NTHR) {
      const int lr = idx >> 4, pi = idx & 15, a = pi >> 3, i = pi & 7;
      const bf16_t* z = zmla + (size_t)lr * ZMLA_W + 640 + a * 16 + i;
      float x1 = bf2f(z[0]), x2 = bf2f(z[8]);
      if (isx) {
        const float2 cs = rt[(size_t)((n0 + lr) % T_) * 16 + a * 8 + i];
        const float y1 = x1 * cs.x - x2 * cs.y, y2 = x1 * cs.y + x2 * cs.x; x1 = y1; x2 = y2;
      }
      const bf16_t o1 = f2bf(x1), o2 = f2bf(x2);
      for (int h = 0; h < 8; ++h) {
        bf16_t* dst = kb + ((size_t)(b * 8 + h) * KT_ + key0 + lr) * 96 + 64 + a * 16 + i;
        dst[0] = o1; dst[8] = o2;
      }
    }
  }
  f32x16 acc[G128::MB][G128::NB];
#pragma unroll
  for (int a = 0; a < G128::MB; ++a)
#pragma unroll
    for (int c = 0; c < G128::NB; ++c) acc[a][c] = zero16();
  G128::run(acc, [&](int r) { return zmla + (size_t)r * ZMLA_W + 384; }, W, 256, 256, smem);
  const int lane = tid & 63;
#pragma unroll
  for (int mb = 0; mb < G128::MB; ++mb)
#pragma unroll
    for (int nb = 0; nb < G128::NB; ++nb) {
      const int col = tn * 128 + G128::col_of(tid, nb);
      if (col < 512) {
        const int h = col >> 6, d = col & 63;
#pragma unroll
        for (int i = 0; i < 16; ++i) {
          const int lr = G128::row_of(tid, mb, i);
          kb[((size_t)(b * 8 + h) * KT_ + key0 + lr) * 96 + d] = f2bf(acc[mb][nb][i] * rs[lr]);
        }
      } else {
        const int h = (col - 512) >> 6, d = col & 63;
#pragma unroll
        for (int g = 0; g < 4; ++g) {
          const int lr = G128::row_of(tid, mb, g * 4);
          uint2 o;
          o.x = pack2bf(acc[mb][nb][g * 4 + 0] * rs[lr], acc[mb][nb][g * 4 + 1] * rs[lr + 1]);
          o.y = pack2bf(acc[mb][nb][g * 4 + 2] * rs[lr + 2], acc[mb][nb][g * 4 + 3] * rs[lr + 3]);
          *(uint2*)(vt + (size_t)(b * 8 + h) * 64 * KT_ + (size_t)((key0 + lr) >> 6) * 4096 + d * 64 + ((key0 + lr) & 63)) = o;
        }
      }
    }
  (void)lane;
}

DI float softplusf_(float x) { const float e = fexp(-fabsf(x)); return fmaxf(x, 0.f) + (e < 0.01f ? e * (1.f - 0.5f * e) : flog(1.f + e)); }
constexpr int RWP_TT = 16;
constexpr int RWP_ITEMS = NT_ / RWP_TT;
DI float half_sum(float v, int h2) {
#ifdef EMU
  for (int m = 16; m >= 1; m >>= 1) v += __shfl_xor(v, m);
  (void)h2; return v;
#else
  v += DPPF(v, 0xB1); v += DPPF(v, 0x4E); v += DPPF(v, 0x124); v += DPPF(v, 0x128);
  const float lo = RDLF(v, 0) + RDLF(v, 16), hi = RDLF(v, 32) + RDLF(v, 48);
  return h2 ? hi : lo;
#endif
}
constexpr int RWP_ALD = 72, RWP_AROWS = 17;
DI void rwkv_prep_items(const Params& p, int l, char* smem) {
  if ((int)blockIdx.x >= RWP_ITEMS) return;
  float* zs = (float*)smem;
  bf16_t* abh = (bf16_t*)(zs + RWP_TT * 1024);
  bf16_t* abl = abh + 4 * RWP_AROWS * RWP_ALD;
  const float* zrec = (const float*)(p.ws + OFF_REGION + R_ZREC);
  bf16_t* rb = (bf16_t*)(p.ws + OFF_REGION + R_RB16);
  float* lwo = (float*)(p.ws + OFF_REGION + R_LW);
  float* bso = (float*)(p.ws + OFF_REGION + R_BS);
  const float* mu = p.rw_mu + (size_t)l * 1152;
  const int tid = opaque_tid(), lane = tid & 63, wid = tid >> 6, r32 = lane & 31, h2 = lane >> 5;
  const int d = wid >> 2, hd = wid & 3;
  bf16x8 bw[2][2][4];
#pragma unroll
  for (int mat = 0; mat < 2; ++mat)
#pragma unroll
    for (int nb = 0; nb < 2; ++nb)
#pragma unroll
      for (int ks = 0; ks < 4; ++ks) {
        const float* src = (mat ? p.rw_a2 : p.rw_w2) + (((size_t)l * 2 + d) * 64 + ks * 16 + h2 * 8) * 256 + hd * 64 + nb * 32 + r32;
        const u32x4 u = {pack2bf(src[0], src[256]), pack2bf(src[512], src[768]), pack2bf(src[1024], src[1280]), pack2bf(src[1536], src[1792])};
        __builtin_memcpy(&bw[mat][nb][ks], &u, 16);
      }
  float rkw[2], w0[2], a0[2], kkw[2], kaw[2];
#pragma unroll
  for (int nb = 0; nb < 2; ++nb) {
    const int c = hd * 64 + nb * 32 + r32;
    rkw[nb] = p.rw_r_k[(size_t)l * 256 + c]; kkw[nb] = p.rw_k_k[(size_t)l * 256 + c]; kaw[nb] = p.rw_k_a[(size_t)l * 256 + c];
    w0[nb] = p.rw_w0[((size_t)l * 2 + d) * 256 + c]; a0[nb] = p.rw_a0[((size_t)l * 2 + d) * 256 + c];
  }
  const size_t AS = (size_t)NT_ * 256;
  __syncthreads();
  for (int i = tid; i < 8 * RWP_ALD; i += NTHR) {
    const int a = i / RWP_ALD, kq = i % RWP_ALD;
    (a < 4 ? abh : abl)[((a & 3) * RWP_AROWS + 16) * RWP_ALD + kq] = 0;
  }
#pragma unroll 1
  for (int it = blockIdx.x; it < RWP_ITEMS; it += gridDim.x) {
    const int n0 = it * RWP_TT;
    __syncthreads();
    TSB(p, 44);
    {
      const int tt0 = tid >> 8, c = (tid & 255) * 4;
      const float4 m4 = *(const float4*)(mu + c);
      float4 za, zpa, zna, zb, zpb, znb;
#define RWP_LD(z_, zp_, zn_, i_) { const int n_ = n0 + tt0 + 2 * (i_), t_ = tok_t(n_), len_ = n_ < NX_ ? T_ : CL_; \
        const float* zr_ = zrec + (size_t)n_ * ZREC_W + ZR_RW + c; z_ = *(const float4*)zr_; \
        zp_ = t_ > 0 ? *(const float4*)(zr_ - ZREC_W) : make_float4(0.f, 0.f, 0.f, 0.f); \
        zn_ = t_ < len_ - 1 ? *(const float4*)(zr_ + ZREC_W) : make_float4(0.f, 0.f, 0.f, 0.f); }
#define RWP_MIX(z_, zp_, zn_, i_) { const int tt = tt0 + 2 * (i_); float4 sv; \
        sv.x = z_.x + (0.5f * (zp_.x + zn_.x) - z_.x) * m4.x; sv.y = z_.y + (0.5f * (zp_.y + zn_.y) - z_.y) * m4.y; \
        sv.z = z_.z + (0.5f * (zp_.z + zn_.z) - z_.z) * m4.z; sv.w = z_.w + (0.5f * (zp_.w + zn_.w) - z_.w) * m4.w; \
        *(float4*)(zs + tt * 1024 + c) = sv; \
        if (c >= 768) {        \
          const int mat = c >= 896 ? 1 : 0, cc = c - 768 - mat * 128, dd = cc >> 6, k0 = cc & 63; \
          float e4[4] = {sv.x, sv.y, sv.z, sv.w}; \
          _Pragma("unroll") for (int q = 0; q < 4; ++q) { const float th = 1.f - 2.f * frcp(1.f + fexp(2.f * e4[q])); e4[q] = mat ? e4[q] : th; } \
          const bf16_t h0 = f2bf(e4[0]), h1 = f2bf(e4[1]), h2b = f2bf(e4[2]), h3 = f2bf(e4[3]); \
          const int o = ((mat * 2 + dd) * RWP_AROWS + tt) * RWP_ALD + k0; \
          *(uint2*)(abh + o) = make_uint2((unsigned)h0 | ((unsigned)h1 << 16), (unsigned)h2b | ((unsigned)h3 << 16)); \
          *(uint2*)(abl + o) = make_uint2(pack2bf(e4[0] - bf2f(h0), e4[1] - bf2f(h1)), pack2bf(e4[2] - bf2f(h2b), e4[3] - bf2f(h3))); \
        } }
      RWP_LD(za, zpa, zna, 0);
#pragma unroll 1
      for (int i = 0; i < 8; i += 2) {
        RWP_LD(zb, zpb, znb, i + 1); sched_fence();
        RWP_MIX(za, zpa, zna, i);
        if (i + 2 < 8) { RWP_LD(za, zpa, zna, i + 2); } sched_fence();
        RWP_MIX(zb, zpb, znb, i + 1);
      }
#undef RWP_LD
#undef RWP_MIX
    }
    __syncthreads();
    TSB(p, 45);
    f32x16 acc[2][2] = {{zero16(), zero16()}, {zero16(), zero16()}};
    const int arow = r32 < 16 ? r32 : 16;
#pragma unroll
    for (int ks = 0; ks < 4; ++ks)
#pragma unroll
      for (int mat = 0; mat < 2; ++mat) {
        const int o = ((mat * 2 + d) * RWP_AROWS + arow) * RWP_ALD + ks * 16 + h2 * 8;
        const bf16x8 ah = *(const bf16x8*)(abh + o), al = *(const bf16x8*)(abl + o);
#pragma unroll
        for (int nb = 0; nb < 2; ++nb) { acc[mat][nb] = mfma32(ah, bw[mat][nb][ks], acc[mat][nb]); acc[mat][nb] = mfma32(al, bw[mat][nb][ks], acc[mat][nb]); }
      }
#pragma unroll
    for (int i = 0; i < 8; ++i) {
      const int tt = (i & 3) + 8 * (i >> 2) + 4 * h2, n = n0 + tt;
      float r[2], k[2], v[2], kr[2], ssp = 0.f;
#pragma unroll
      for (int nb = 0; nb < 2; ++nb) {
        const float* zr = zs + tt * 1024 + hd * 64 + nb * 32 + r32;
        r[nb] = zr[0]; k[nb] = zr[256]; v[nb] = zr[512];
        kr[nb] = k[nb] * kkw[nb]; ssp += kr[nb] * kr[nb];
      }
      const float ss = half_sum(ssp, h2);
      const float rs = frsq(fmaxf(ss, 1e-24f));
      float bp = 0.f;
#pragma unroll
      for (int nb = 0; nb < 2; ++nb) {
        const float kk = kr[nb] * rs;
        const float w = -softplusf_(-(w0[nb] + acc[0][nb][i])) - 0.5f;
        const float logdecay = -fexp(w);
        const float a = sigmoidf_(a0[nb] + acc[1][nb][i]);
        const float kd = k[nb] * (1.f + (a - 1.f) * kaw[nb]);
        bp += r[nb] * rkw[nb] * kd;
        const size_t o = (size_t)n * 256 + hd * 64 + nb * 32 + r32;
        if (d == 0) { rb[0 * AS + o] = f2bf(r[nb]); rb[1 * AS + o] = f2bf(v[nb]); rb[2 * AS + o] = f2bf(kk); }
        lwo[d * AS + o] = logdecay;
        rb[(3 + 2 * d) * AS + o] = f2bf(kd);
        rb[(4 + 2 * d) * AS + o] = f2bf(kk * a);
      }
      const float bsum = half_sum(bp, h2);
      if (r32 == 0) bso[((size_t)d * NT_ + n) * 4 + hd] = bsum;
    }
    TSB(p, 46);
  }
}

DI int seq_tok(int dir, int b, int pos) {
  if (pos < CL_) return NX_ + b * CL_ + (dir ? CL_ - 1 - pos : pos);
  const int t = pos - CL_;
  return b * T_ + (dir ? T_ - 1 - t : t);
}
DI float logsigmoidf_(float x) { return -softplusf_(-x); }
DI float wave_incl_scan(float v, int lane) {
  for (int d = 1; d < 64; d <<= 1) { const float o = shfl_up_l(v, d, lane); if (lane >= d) v += o; }
  return v;
}
constexpr int ML_ST = 2112;
constexpr int ML1_ITEMS = NSEQ_ * NCH_;
DI void mlstm_local_items(const Params& p, int l, char* smem, int first, int stride) {
  if (first >= ML1_ITEMS) return;
  float* vv = (float*)smem;
  float* kw = vv + 64 * 64;
  float* wej = kw + 64 * 32;
  const float* zrec = (const float*)(p.ws + OFF_REGION + R_ZREC);
  const int tid = opaque_tid(), lane = tid & 63, wid = tid >> 6;
  float vreg[8], kreg[4], fp = 0.f, ip = 0.f;
#define M1_LOAD(it_) { const int s_ = (it_) / NCH_, c_ = (it_) % NCH_, dir_ = s_ >> 3, b_ = (s_ >> 2) & 1, hd_ = s_ & 3; \
    _Pragma("unroll") for (int q = 0; q < 8; ++q) { const int idx = tid + q * NTHR, j = idx >> 6, e = idx & 63; \
      vreg[q] = zrec[(size_t)seq_tok(dir_, b_, c_ * 64 + j) * ZREC_W + ZR_MLV + hd_ * 64 + e]; } \
    _Pragma("unroll") for (int q = 0; q < 4; ++q) { const int idx = tid + q * NTHR, j = idx >> 5, e = idx & 31; \
      kreg[q] = zrec[(size_t)seq_tok(dir_, b_, c_ * 64 + j) * ZREC_W + ZR_MLK + hd_ * 32 + e]; } \
    if (wid == 0) { const int n = seq_tok(dir_, b_, c_ * 64 + lane); \
      fp = zrec[(size_t)n * ZREC_W + ZR_MLF + dir_ * 4 + hd_] + p.ml_b_f[(l * 2 + dir_) * 4 + hd_]; \
      ip = zrec[(size_t)n * ZREC_W + ZR_MLI + dir_ * 4 + hd_] + p.ml_b_i[(l * 2 + dir_) * 4 + hd_]; } }
  M1_LOAD(first);
#pragma unroll 1
  for (int it = first; it < ML1_ITEMS; it += stride) {
    float* st = (float*)(p.ws + OFF_REGION + R_MLST) + (size_t)it * ML_ST;
    sched_fence();
    __syncthreads();
    if (wid == 0) {
      const float bj = wave_incl_scan(logsigmoidf_(fp), lane);
      const float bl = lane_bcast<63>(bj);
      const float lw = bl - bj + ip;
      const float ml = wave_max(lw);
      wej[lane] = fexp(lw - ml);
      if (lane == 0) { st[2080] = bl; st[2081] = ml; }
    }
#pragma unroll
    for (int q = 0; q < 8; ++q) vv[tid + q * NTHR] = vreg[q];
    __syncthreads();
#pragma unroll
    for (int q = 0; q < 4; ++q) { const int idx = tid + q * NTHR; kw[idx] = kreg[q] * wej[idx >> 5]; }
    { const int nx = it + stride < ML1_ITEMS ? it + stride : it; M1_LOAD(nx); }
    sched_fence();
    __syncthreads();
    const int v = tid & 63, d0 = (tid >> 6) * 4;
    float a0 = 0.f, a1 = 0.f, a2 = 0.f, a3 = 0.f, s0 = 0.f, s1 = 0.f, s2 = 0.f, s3 = 0.f;
    for (int j = 0; j < 64; ++j) {
      const float x = vv[j * 64 + v];
      const float4 kk = *(const float4*)(kw + j * 32 + d0);
      a0 += x * kk.x; a1 += x * kk.y; a2 += x * kk.z; a3 += x * kk.w;
      s0 += kk.x; s1 += kk.y; s2 += kk.z; s3 += kk.w;
    }
    *(float4*)(st + v * 32 + d0) = make_float4(a0, a1, a2, a3);
    if (v == 0) *(float4*)(st + 2048 + d0) = make_float4(s0, s1, s2, s3);
  }
#undef M1_LOAD
}
constexpr int ML2_ITEMS = (NSEQ_ * 2080 + NTHR - 1) / NTHR;
DI void mlstm_scan_item(const Params& p, int it) {
  const int g = it * NTHR + opaque_tid();
  if (g >= NSEQ_ * 2080) return;
  const int s = g / 2080, e = g % 2080;
  float* st = (float*)(p.ws + OFF_REGION + R_MLST) + (size_t)s * NCH_ * ML_ST;
  float state = 0.f, m = 0.f;
  static_assert(NCH_ % 4 == 0, "chunk count");
  for (int c0 = 0; c0 < NCH_; c0 += 4) {
    float d[4], bl[4], ml[4];
#pragma unroll
    for (int u = 0; u < 4; ++u) { const float* r = st + (size_t)(c0 + u) * ML_ST; d[u] = r[e]; bl[u] = r[2080]; ml[u] = r[2081]; }
#pragma unroll
    for (int u = 0; u < 4; ++u) {
      float* r = st + (size_t)(c0 + u) * ML_ST;
      r[e] = state;
      if (e == 0) r[2082] = m;
      const float mn = fmaxf(bl[u] + m, ml[u]);
      state = fexp(bl[u] + m - mn) * state + fexp(ml[u] - mn) * d[u];
      m = mn;
    }
  }
}

DI void phase3(const Params& p, int l, char* smem) {
  rwkv_prep_items(p, l, smem);
  mlstm_local_items(p, l, smem, (int)gridDim.x - 1 - (int)blockIdx.x, gridDim.x);
}
constexpr int RW_LD = 72, RW_MB = 64 * RW_LD * 2;
constexpr int RWC_REC = 40960;
DI char* rw_rec(const Params& p, int s, int c) { return p.ws + OFF_REGION + R_CH + ((size_t)s * NCH_ + c) * RWC_REC; }
DI f32x16 rw_mm(const char* A, const char* Bt, int mb, int nb, int lane, f32x16 acc) {
  const int r = lane & 31, h = lane >> 5;
#pragma unroll
  for (int ks = 0; ks < 4; ++ks) {
    const bf16x8 a = *(const bf16x8*)(A + ((mb * 32 + r) * RW_LD + ks * 16 + h * 8) * 2);
    const bf16x8 b = *(const bf16x8*)(Bt + ((nb * 32 + r) * RW_LD + ks * 16 + h * 8) * 2);
    acc = mfma32(a, b, acc);
  }
  return acc;
}
DI void rw_wrT(char* Dst, int mb, int nb, int lane, const f32x16& v) {
  const int r = lane & 31, h = lane >> 5;
#pragma unroll
  for (int g = 0; g < 4; ++g) {
    uint2 o; o.x = pack2bf(v[4 * g], v[4 * g + 1]); o.y = pack2bf(v[4 * g + 2], v[4 * g + 3]);
    *(uint2*)(Dst + ((nb * 32 + r) * RW_LD + mb * 32 + 8 * g + 4 * h) * 2) = o;
  }
}
DI void rw_wrT_g(bf16_t* Dst, int mb, int nb, int lane, const f32x16& v) {
  const int r = lane & 31, h = lane >> 5;
#pragma unroll
  for (int g = 0; g < 4; ++g) {
    uint2 o; o.x = pack2bf(v[4 * g], v[4 * g + 1]); o.y = pack2bf(v[4 * g + 2], v[4 * g + 3]);
    *(uint2*)(Dst + (nb * 32 + r) * 64 + mb * 32 + 8 * g + 4 * h) = o;
  }
}
DI void rw_addT(const char* Src, int mb, int nb, int lane, f32x16& v) {
  const int r = lane & 31, h = lane >> 5;
#pragma unroll
  for (int g = 0; g < 4; ++g) {
    const uint2 u = *(const uint2*)(Src + ((nb * 32 + r) * RW_LD + mb * 32 + 8 * g + 4 * h) * 2);
    v[4 * g] += bf2f((bf16_t)(u.x & 0xffff)); v[4 * g + 1] += bf2f((bf16_t)(u.x >> 16));
    v[4 * g + 2] += bf2f((bf16_t)(u.y & 0xffff)); v[4 * g + 3] += bf2f((bf16_t)(u.y >> 16));
  }
}
DI void rw_mask_upper(f32x16& v, int mb, int nb, int lane, bool strict) {
  const int col = nb * 32 + (lane & 31), h = lane >> 5;
#pragma unroll
  for (int i = 0; i < 16; ++i) { const int row = mb * 32 + crow(i, h); if (strict ? !(row < col) : !(row <= col)) v[i] = 0.f; }
}
DI void rw_mask_lower_strict(f32x16& v, int mb, int nb, int lane) {
  const int col = nb * 32 + (lane & 31), h = lane >> 5;
#pragma unroll
  for (int i = 0; i < 16; ++i) { const int row = mb * 32 + crow(i, h); if (!(col < row)) v[i] = 0.f; }
}

constexpr int RW1_ITEMS = NSEQ_ * NCH_;
DI void rw_chunk_item(const Params& p, int it, char* smem) {
  const int s = it / NCH_, c = it % NCH_, dir = s >> 3, b = (s >> 2) & 1, hd = s & 3;
  const int tid = opaque_tid(), lane = tid & 63, wid = tid >> 6;
  const bf16_t* rb = (const bf16_t*)(p.ws + OFF_REGION + R_RB16);
  const float* lwg = (const float*)(p.ws + OFF_REGION + R_LW) + (size_t)dir * NT_ * 256;
  const size_t AS = (size_t)NT_ * 256;
  char* const At = smem + 0 * RW_MB; char* const Bt_ = smem + 1 * RW_MB; char* const Kt = smem + 2 * RW_MB; char* const Rt = smem + 3 * RW_MB;
  char* const Aj = smem + 4 * RW_MB; char* const Bj = smem + 5 * RW_MB; char* const Kj = smem + 6 * RW_MB; char* const Vi = smem + 7 * RW_MB;
  char* const QA = smem + 8 * RW_MB; char* const QTA = smem + 9 * RW_MB; char* const GA = smem + 10 * RW_MB;
  char* const Mka = smem + 11 * RW_MB; char* const MbrT = smem + 12 * RW_MB; char* const MkrT = smem + 13 * RW_MB;
  char* const QB = At; char* const QTB = Bt_; char* const GB = Kt;
  float* const cs = (float*)(smem + 8 * RW_MB);
  float* const gC = (float*)(smem + 14 * RW_MB);
  char* rec = rw_rec(p, s, c);
  __syncthreads();
  const int t = tid >> 3, j8 = (tid & 7) * 8;
  const int n = seq_tok(dir, b, c * 64 + t);
  const size_t o = (size_t)n * 256 + hd * 64 + j8;
  const uint4 ukk = *(const uint4*)(rb + 2 * AS + o), ubb = *(const uint4*)(rb + (4 + 2 * dir) * AS + o), ukd = *(const uint4*)(rb + (3 + 2 * dir) * AS + o);
  const uint4 ur = *(const uint4*)(rb + 0 * AS + o), uv = *(const uint4*)(rb + 1 * AS + o);
  sched_fence();
  {
    const float4 l0 = *(const float4*)(lwg + (size_t)n * 256 + hd * 64 + j8), l1 = *(const float4*)(lwg + (size_t)n * 256 + hd * 64 + j8 + 4);
    float* d = cs + t * 65 + j8;
    d[0] = l0.x; d[1] = l0.y; d[2] = l0.z; d[3] = l0.w; d[4] = l1.x; d[5] = l1.y; d[6] = l1.z; d[7] = l1.w;
  }
  __syncthreads();
  {
    float* const seg = gC + 64;
    const int j = tid & 63, sg = tid >> 6;
    float v[8], a = 0.f;
#pragma unroll
    for (int i = 0; i < 8; ++i) { a += cs[(sg * 8 + i) * 65 + j]; v[i] = a; }
    seg[sg * 64 + j] = a;
    __syncthreads();
    float base = 0.f;
#pragma unroll
    for (int q = 0; q < 7; ++q) base += q < sg ? seg[q * 64 + j] : 0.f;
#pragma unroll
    for (int i = 0; i < 8; ++i) cs[(sg * 8 + i) * 65 + j] = v[i] + base;
    if (sg == 7) gC[j] = fexp(v[7] + base);
  }
  __syncthreads();
  {
    const unsigned akk[4] = {ukk.x, ukk.y, ukk.z, ukk.w}, abb[4] = {ubb.x, ubb.y, ubb.z, ubb.w}, akd[4] = {ukd.x, ukd.y, ukd.z, ukd.w};
    const unsigned ar[4] = {ur.x, ur.y, ur.z, ur.w}, av[4] = {uv.x, uv.y, uv.z, uv.w};
    unsigned oa[4], ob[4], ok[4], orr[4];
#pragma unroll
    for (int q = 0; q < 4; ++q) {
      float fa[2], fb[2], fk[2], fr[2];
#pragma unroll
      for (int e = 0; e < 2; ++e) {
        const int j = j8 + 2 * q + e;
        const float cst = cs[t * 65 + j], csp = t > 0 ? cs[(t - 1) * 65 + j] : 0.f;
        const float g = fexp(cst), gp = fexp(csp), gi = fexp(-cst);
        const int sh = 16 * e;
        fa[e] = -bf2f((bf16_t)((akk[q] >> sh) & 0xffff)) * gp;
        fb[e] = bf2f((bf16_t)((abb[q] >> sh) & 0xffff)) * gi;
        fk[e] = bf2f((bf16_t)((akd[q] >> sh) & 0xffff)) * gi;
        fr[e] = bf2f((bf16_t)((ar[q] >> sh) & 0xffff)) * g;
        *(bf16_t*)(Aj + (j * RW_LD + t) * 2) = f2bf(fa[e]);
        *(bf16_t*)(Bj + (j * RW_LD + t) * 2) = f2bf(fb[e]);
        *(bf16_t*)(Kj + (j * RW_LD + t) * 2) = f2bf(fk[e]);
        *(bf16_t*)(Vi + (j * RW_LD + t) * 2) = (bf16_t)((av[q] >> sh) & 0xffff);
      }
      oa[q] = pack2bf(fa[0], fa[1]); ob[q] = pack2bf(fb[0], fb[1]); ok[q] = pack2bf(fk[0], fk[1]); orr[q] = pack2bf(fr[0], fr[1]);
    }
    *(uint4*)(At + (t * RW_LD + j8) * 2) = make_uint4(oa[0], oa[1], oa[2], oa[3]);
    *(uint4*)(Bt_ + (t * RW_LD + j8) * 2) = make_uint4(ob[0], ob[1], ob[2], ob[3]);
    *(uint4*)(Kt + (t * RW_LD + j8) * 2) = make_uint4(ok[0], ok[1], ok[2], ok[3]);
    *(uint4*)(Rt + (t * RW_LD + j8) * 2) = make_uint4(orr[0], orr[1], orr[2], orr[3]);
  }
  __syncthreads();
  {
    const int prod = wid >> 2, mb = (wid >> 1) & 1, nb = wid & 1;
    f32x16 acc = zero16();
    if (prod == 0) {
      if (!(mb == 1 && nb == 0)) acc = rw_mm(Bt_, At, mb, nb, lane, acc);
      rw_mask_upper(acc, mb, nb, lane, true);
      rw_wrT(QA, mb, nb, lane, acc);
      if (mb == nb) {
        const int col = nb * 32 + (lane & 31), h = lane >> 5;
#pragma unroll
        for (int i = 0; i < 16; ++i) if (mb * 32 + crow(i, h) == col) acc[i] += 1.f;
      }
      rw_wrT(GA, mb, nb, lane, acc);
    } else {
      if (!(mb == 0 && nb == 1)) acc = rw_mm(At, Bt_, mb, nb, lane, acc);
      rw_mask_lower_strict(acc, mb, nb, lane);
      rw_wrT(QTA, mb, nb, lane, acc);
    }
  }
  for (int blk = wid; blk < 12; blk += 8) {
    const int prod = blk >> 2, mb = (blk >> 1) & 1, nb = blk & 1;
    f32x16 acc = zero16();
    if (prod == 0) {
      acc = rw_mm(At, Kt, mb, nb, lane, acc); rw_mask_lower_strict(acc, mb, nb, lane); rw_wrT(Mka, mb, nb, lane, acc);
    } else if (prod == 1) {
      acc = rw_mm(Bt_, Rt, mb, nb, lane, acc); rw_mask_upper(acc, mb, nb, lane, false); rw_wrT(MbrT, mb, nb, lane, acc);
    } else {
      acc = rw_mm(Kt, Rt, mb, nb, lane, acc); rw_mask_upper(acc, mb, nb, lane, false); rw_wrT(MkrT, mb, nb, lane, acc);
    }
  }
  __syncthreads();
#define RW_SQ(Q_, Qt_, Qn_, Qtn_, blk) { const int pr_ = (blk) >> 2, mb_ = ((blk) >> 1) & 1, nb_ = (blk) & 1; f32x16 acc_ = zero16(); \
    if (pr_ == 0) { acc_ = rw_mm(Q_, Qt_, mb_, nb_, lane, acc_); rw_wrT(Qtn_, mb_, nb_, lane, acc_); } \
    else { acc_ = rw_mm(Qt_, Q_, mb_, nb_, lane, acc_); rw_wrT(Qn_, mb_, nb_, lane, acc_); } }
#define RW_GUP(Qt_, G_, Gn_, blk) { const int mb_ = ((blk) >> 1) & 1, nb_ = (blk) & 1; f32x16 acc_ = zero16(); \
    rw_addT(G_, mb_, nb_, lane, acc_); acc_ = rw_mm(Qt_, G_, mb_, nb_, lane, acc_); rw_wrT(Gn_, mb_, nb_, lane, acc_); }
  RW_SQ(QA, QTA, QB, QTB, wid);
  __syncthreads();
  for (int blk = wid; blk < 12; blk += 8) { if (blk < 8) { RW_SQ(QB, QTB, QA, QTA, blk); } else { RW_GUP(QTB, GA, GB, blk - 8); } }
  __syncthreads();
  for (int blk = wid; blk < 12; blk += 8) { if (blk < 8) { RW_SQ(QA, QTA, QB, QTB, blk); } else { RW_GUP(QTA, GB, GA, blk - 8); } }
  __syncthreads();
  for (int blk = wid; blk < 12; blk += 8) { if (blk < 8) { RW_SQ(QB, QTB, QA, QTA, blk); } else { RW_GUP(QTB, GA, GB, blk - 8); } }
  __syncthreads();
  for (int blk = wid; blk < 12; blk += 8) { if (blk < 8) { RW_SQ(QA, QTA, QB, QTB, blk); } else { RW_GUP(QTA, GB, GA, blk - 8); } }
  __syncthreads();
  if (wid < 4) { RW_GUP(QTB, GA, GB, wid); }
  __syncthreads();
  {
    const int prod = wid >> 2, mb = (wid >> 1) & 1, nb = wid & 1;
    f32x16 acc = zero16();
    acc = rw_mm(GB, prod == 0 ? Mka : Aj, mb, nb, lane, acc);
    rw_wrT(prod == 0 ? QA : QTA, mb, nb, lane, acc);
  }
  __syncthreads();
  char* const X1 = QA; char* const X2 = QTA; char* const QpT = At;
  for (int blk = wid; blk < 16; blk += 8) {
    const int prod = blk >> 2, mb = (blk >> 1) & 1, nb = blk & 1;
    f32x16 acc = zero16();
    if (prod == 0) {
      rw_addT(MkrT, mb, nb, lane, acc); acc = rw_mm(X1, MbrT, mb, nb, lane, acc); rw_mask_upper(acc, mb, nb, lane, false);
      rw_wrT_g((bf16_t*)(rec + 8192), mb, nb, lane, acc);
    } else if (prod == 1) {
      rw_addT(Rt, mb, nb, lane, acc); acc = rw_mm(X2, MbrT, mb, nb, lane, acc);
      rw_wrT_g((bf16_t*)(rec), mb, nb, lane, acc);
    } else if (prod == 2) {
      acc = rw_mm(X2, Bj, mb, nb, lane, acc);
      const int col = nb * 32 + (lane & 31), h = lane >> 5; const float gc = gC[col];
#pragma unroll
      for (int i = 0; i < 16; ++i) { if (mb * 32 + crow(i, h) == col) acc[i] += 1.f; acc[i] *= gc; }
      rw_wrT_g((bf16_t*)(rec + 16384), mb, nb, lane, acc);
    } else {
      rw_addT(Kj, mb, nb, lane, acc); acc = rw_mm(X1, Bj, mb, nb, lane, acc);
      const float gc = gC[nb * 32 + (lane & 31)];
#pragma unroll
      for (int i = 0; i < 16; ++i) acc[i] *= gc;
      rw_wrT(QpT, mb, nb, lane, acc);
    }
  }
  __syncthreads();
  if (wid < 4) {
    const int mb = (wid >> 1) & 1, nb = wid & 1, r = lane & 31, h = lane >> 5;
    f32x16 acc = zero16();
    acc = rw_mm(QpT, Vi, mb, nb, lane, acc);
    float* dq = (float*)(rec + 24576);
#pragma unroll
    for (int g = 0; g < 4; ++g)
      *(float4*)(dq + (nb * 32 + r) * 64 + mb * 32 + 8 * g + 4 * h) = make_float4(acc[4 * g], acc[4 * g + 1], acc[4 * g + 2], acc[4 * g + 3]);
  }
}

constexpr int RW2_ITEMS = NSEQ_;
constexpr int RW2_DQLD = 68;
constexpr int RW2_STAGE = RW_MB + 64 * RW2_DQLD * 4;
constexpr int RW2_GRP = 2;
static_assert(NCH_ % RW2_GRP == 0, "chunk groups");
DI void rw_state_item(const Params& p, int s, char* smem) {
  const int tid = opaque_tid(), lane = tid & 63, wid = tid >> 6, r = lane & 31, h = lane >> 5;
  f32x16 S0 = zero16(), S1 = zero16();
  u32x4 rp[RW2_GRP], rd0[RW2_GRP], rd1[RW2_GRP];
  const int prow = tid >> 3, pcol = (tid & 7) * 8;
#define RW2_LOAD(g_) { _Pragma("unroll") for (int u = 0; u < RW2_GRP; ++u) { const char* rec_ = rw_rec(p, s, (g_) * RW2_GRP + u); \
    rp[u] = *(const u32x4*)(rec_ + 16384 + (prow * 64 + pcol) * 2); \
    rd0[u] = *(const u32x4*)(rec_ + 24576 + (prow * 64 + pcol) * 4); rd1[u] = *(const u32x4*)(rec_ + 24576 + (prow * 64 + pcol + 4) * 4); } }
#define RW2_STORE(buf_) { _Pragma("unroll") for (int u = 0; u < RW2_GRP; ++u) { char* d_ = smem + ((buf_) * RW2_GRP + u) * RW2_STAGE; \
    *(u32x4*)(d_ + (prow * RW_LD + pcol) * 2) = rp[u]; \
    *(u32x4*)(d_ + RW_MB + (prow * RW2_DQLD + pcol) * 4) = rd0[u]; *(u32x4*)(d_ + RW_MB + (prow * RW2_DQLD + pcol + 4) * 4) = rd1[u]; } }
  __syncthreads();
  RW2_LOAD(0); RW2_STORE(0);
  __syncthreads();
  constexpr int NG = NCH_ / RW2_GRP;
  for (int g = 0; g < NG; ++g) {
    { const int gn = g + 1 < NG ? g + 1 : g; RW2_LOAD(gn); }
    sched_fence();
    if (wid < 2) {
#pragma unroll
      for (int u = 0; u < RW2_GRP; ++u) {
        const int c = g * RW2_GRP + u;
        const char* PT = smem + ((g & 1) * RW2_GRP + u) * RW2_STAGE;
        const float* DQ = (const float*)(PT + RW_MB);
        const int i = wid * 32 + r;
        bf16_t* sd = (bf16_t*)(rw_rec(p, s, c) + 16384);
#pragma unroll
        for (int q = 0; q < 4; ++q) {
          uint2 o0, o1;
          o0.x = pack2bf(S0[4 * q], S0[4 * q + 1]); o0.y = pack2bf(S0[4 * q + 2], S0[4 * q + 3]);
          o1.x = pack2bf(S1[4 * q], S1[4 * q + 1]); o1.y = pack2bf(S1[4 * q + 2], S1[4 * q + 3]);
          *(uint2*)(sd + i * 64 + 8 * q + 4 * h) = o0; *(uint2*)(sd + i * 64 + 32 + 8 * q + 4 * h) = o1;
        }
        bf16x8 bfr[2][2];
#pragma unroll
        for (int s2 = 0; s2 < 2; ++s2) {
          const u32x4 u0 = {pack2bf(S0[8 * s2], S0[8 * s2 + 1]), pack2bf(S0[8 * s2 + 2], S0[8 * s2 + 3]), pack2bf(S0[8 * s2 + 4], S0[8 * s2 + 5]), pack2bf(S0[8 * s2 + 6], S0[8 * s2 + 7])};
          const u32x4 u1 = {pack2bf(S1[8 * s2], S1[8 * s2 + 1]), pack2bf(S1[8 * s2 + 2], S1[8 * s2 + 3]), pack2bf(S1[8 * s2 + 4], S1[8 * s2 + 5]), pack2bf(S1[8 * s2 + 6], S1[8 * s2 + 7])};
          __builtin_memcpy(&bfr[0][s2], &u0, 16); __builtin_memcpy(&bfr[1][s2], &u1, 16);
        }
        f32x16 n0, n1;
#pragma unroll
        for (int q = 0; q < 4; ++q) {
          const float4 a = *(const float4*)(DQ + i * RW2_DQLD + 8 * q + 4 * h), bq = *(const float4*)(DQ + i * RW2_DQLD + 32 + 8 * q + 4 * h);
          n0[4 * q] = a.x; n0[4 * q + 1] = a.y; n0[4 * q + 2] = a.z; n0[4 * q + 3] = a.w;
          n1[4 * q] = bq.x; n1[4 * q + 1] = bq.y; n1[4 * q + 2] = bq.z; n1[4 * q + 3] = bq.w;
        }
#pragma unroll
        for (int jb2 = 0; jb2 < 2; ++jb2)
#pragma unroll
          for (int s2 = 0; s2 < 2; ++s2) {
            const char* a0 = PT + ((0 * 32 + r) * RW_LD + jb2 * 32 + 16 * s2 + 4 * h) * 2;
            const char* a1 = PT + ((1 * 32 + r) * RW_LD + jb2 * 32 + 16 * s2 + 4 * h) * 2;
            const uint2 l0 = *(const uint2*)a0, h0 = *(const uint2*)(a0 + 16), l1 = *(const uint2*)a1, h1 = *(const uint2*)(a1 + 16);
            const u32x4 u0 = {l0.x, l0.y, h0.x, h0.y}, u1 = {l1.x, l1.y, h1.x, h1.y};
            bf16x8 af0, af1; __builtin_memcpy(&af0, &u0, 16); __builtin_memcpy(&af1, &u1, 16);
            n0 = mfma32(af0, bfr[jb2][s2], n0);
            n1 = mfma32(af1, bfr[jb2][s2], n1);
          }
        S0 = n0; S1 = n1;
      }
    }
    sched_fence();
    RW2_STORE((g + 1) & 1);
    __syncthreads();
  }
}

constexpr int RW3_N = 4;
static_assert(NCH_ % RW3_N == 0 && RW3_N * 4 * RW_MB <= 150 * 1024, "chunk-output group");
DI void rw_out_pair(const Params& p, int it0, char* smem) {
  const int s = it0 / NCH_, c0 = it0 % NCH_, dir = s >> 3, b = (s >> 2) & 1, hd = s & 3;
  const int tid = opaque_tid(), lane = tid & 63, wid = tid >> 6;
  const bf16_t* rb = (const bf16_t*)(p.ws + OFF_REGION + R_RB16);
  const size_t AS = (size_t)NT_ * 256;
  float* ys = (float*)(p.ws + OFF_REGION + R_YS) + (size_t)dir * NT_ * 256;
  __syncthreads();
  {
    const int row = tid >> 3, col = (tid & 7) * 8;
    uint4 us[RW3_N], ur[RW3_N], um[RW3_N], uv[RW3_N];
#pragma unroll
    for (int u = 0; u < RW3_N; ++u) {
      const char* rec = rw_rec(p, s, c0 + u);
      us[u] = *(const uint4*)(rec + 16384 + (row * 64 + col) * 2);
      ur[u] = *(const uint4*)(rec + (row * 64 + col) * 2);
      um[u] = *(const uint4*)(rec + 8192 + (row * 64 + col) * 2);
      const int n = seq_tok(dir, b, (c0 + u) * 64 + row);
      uv[u] = *(const uint4*)(rb + 1 * AS + (size_t)n * 256 + hd * 64 + col);
    }
#pragma unroll
    for (int u = 0; u < RW3_N; ++u) {
      char* const Sm = smem + u * 4 * RW_MB; char* const RyT = Sm + RW_MB; char* const MyT = Sm + 2 * RW_MB; char* const Vi = Sm + 3 * RW_MB;
      *(uint4*)(Sm + (row * RW_LD + col) * 2) = us[u];
      *(uint4*)(RyT + (row * RW_LD + col) * 2) = ur[u];
      *(uint4*)(MyT + (row * RW_LD + col) * 2) = um[u];
      const unsigned av[4] = {uv[u].x, uv[u].y, uv[u].z, uv[u].w};
#pragma unroll
      for (int q = 0; q < 4; ++q) {
        *(bf16_t*)(Vi + ((col + 2 * q) * RW_LD + row) * 2) = (bf16_t)(av[q] & 0xffff);
        *(bf16_t*)(Vi + ((col + 2 * q + 1) * RW_LD + row) * 2) = (bf16_t)(av[q] >> 16);
      }
    }
  }
  __syncthreads();
#pragma unroll
  for (int rep = 0; rep < RW3_N / 2; ++rep) {
    const int idx = wid + 8 * rep, u = idx >> 2, mb = (idx >> 1) & 1, nb = idx & 1, r = lane & 31, h = lane >> 5;
    const char* const Sm = smem + u * 4 * RW_MB; const char* const RyT = Sm + RW_MB; const char* const MyT = Sm + 2 * RW_MB; const char* const Vi = Sm + 3 * RW_MB;
    f32x16 acc = zero16();
    acc = rw_mm(Sm, RyT, mb, nb, lane, acc);
    acc = rw_mm(Vi, MyT, mb, nb, lane, acc);
    const int n = seq_tok(dir, b, (c0 + u) * 64 + nb * 32 + r);
#pragma unroll
    for (int g = 0; g < 4; ++g)
      *(float4*)(ys + (size_t)n * 256 + hd * 64 + mb * 32 + 8 * g + 4 * h) = make_float4(acc[4 * g], acc[4 * g + 1], acc[4 * g + 2], acc[4 * g + 3]);
  }
}
DI void rw_out_item(const Params& p, int it, char* smem) {
  const int s = it / NCH_, c = it % NCH_, dir = s >> 3, b = (s >> 2) & 1, hd = s & 3;
  const int tid = opaque_tid(), lane = tid & 63, wid = tid >> 6;
  const bf16_t* rb = (const bf16_t*)(p.ws + OFF_REGION + R_RB16);
  const size_t AS = (size_t)NT_ * 256;
  float* ys = (float*)(p.ws + OFF_REGION + R_YS) + (size_t)dir * NT_ * 256;
  char* const Sm = smem; char* const RyT = smem + RW_MB; char* const MyT = smem + 2 * RW_MB; char* const Vi = smem + 3 * RW_MB;
  const char* rec = rw_rec(p, s, c);
  __syncthreads();
  {
    const int row = tid >> 3, col = (tid & 7) * 8;
    *(uint4*)(Sm + (row * RW_LD + col) * 2) = *(const uint4*)(rec + 16384 + (row * 64 + col) * 2);
    *(uint4*)(RyT + (row * RW_LD + col) * 2) = *(const uint4*)(rec + (row * 64 + col) * 2);
    *(uint4*)(MyT + (row * RW_LD + col) * 2) = *(const uint4*)(rec + 8192 + (row * 64 + col) * 2);
    const int n = seq_tok(dir, b, c * 64 + row);
    const uint4 uv = *(const uint4*)(rb + 1 * AS + (size_t)n * 256 + hd * 64 + col);
    const unsigned av[4] = {uv.x, uv.y, uv.z, uv.w};
#pragma unroll
    for (int q = 0; q < 4; ++q) {
      *(bf16_t*)(Vi + ((col + 2 * q) * RW_LD + row) * 2) = (bf16_t)(av[q] & 0xffff);
      *(bf16_t*)(Vi + ((col + 2 * q + 1) * RW_LD + row) * 2) = (bf16_t)(av[q] >> 16);
    }
  }
  __syncthreads();
  if (wid < 4) {
    const int mb = (wid >> 1) & 1, nb = wid & 1, r = lane & 31, h = lane >> 5;
    f32x16 acc = zero16();
    acc = rw_mm(Sm, RyT, mb, nb, lane, acc);
    acc = rw_mm(Vi, MyT, mb, nb, lane, acc);
    const int n = seq_tok(dir, b, c * 64 + nb * 32 + r);
#pragma unroll
    for (int g = 0; g < 4; ++g)
      *(float4*)(ys + (size_t)n * 256 + hd * 64 + mb * 32 + 8 * g + 4 * h) = make_float4(acc[4 * g], acc[4 * g + 1], acc[4 * g + 2], acc[4 * g + 3]);
  }
}
constexpr int ATT_KLD = 104, ATT_VLD = 68;
constexpr int ATT_KB = 64 * ATT_KLD * 2, ATT_VB = 64 * ATT_VLD * 2, ATT_STAGE = ATT_KB + ATT_VB;
DI float fexp2(float x) {
#ifdef EMU
  return exp2f(x);
#else
  return __builtin_amdgcn_exp2f(x);
#endif
}
#ifdef ABL_A1
#define ABL_NOSYNC
#define ABL_ZERO
#endif
#ifdef ABL_A2
#define ABL_NOSYNC
#define ABL_NOLOAD
#define ABL_NOSTORE
#define ABL_ZERO
#endif
#ifdef ABL_A3
#define ABL_NOSYNC
#define ABL_NOLOAD
#define ABL_NOSTORE
#define ABL_ZERO
#define ABL_NOEXP
#endif
#ifdef ABL_NOPV
#define ABL_PV_BEGIN if (t > 100000) {
#define ABL_PV_END }
#else
#define ABL_PV_BEGIN
#define ABL_PV_END
#endif
#ifdef ABL_NOLOAD
#define ABL_LOADS2(s_, tk, tv)
#else
#define ABL_LOADS2(s_, tk, tv) ATT_LOADK(s_, tk); ATT_LOADV(s_, tv);
#endif
#ifdef ABL_NOSTORE
#define ABL_STORES(w_, t)
#else
#define ABL_STORES(w_, t) ATT_STOREK(w_, t & 1); ATT_STOREV(w_, (t + 1) & 1);
#endif
#ifdef ABL_NOSYNC
#define ABL_SYNC()
#else
#define ABL_SYNC() __syncthreads()
#endif
#ifdef ABL_NOEXP
#define ABL_EXP(x) (x)
#else
#define ABL_EXP(x) fexp2(x)
#endif
constexpr int ATT_LDS = 2 * ATT_KB + 2 * ATT_VB;
constexpr float ATT_THR = 8.f;
DI void attn_item(const Params& p, int b, int h, int qt, bool isctx, char* smem, int kt0, int nkt, int part) {
  const int tid = opaque_tid(), lane = tid & 63, wid = tid >> 6, r = lane & 31, h2 = lane >> 5;
  const bf16_t* qb = (const bf16_t*)(p.osc + O_QB);
  const bf16_t* kbase = (const bf16_t*)(p.ws + OFF_REGION + R_KB) + (size_t)(b * 8 + h) * KT_ * 96 + (size_t)kt0 * 64 * 96;
  const bf16_t* vbase = (const bf16_t*)(p.ws + OFF_REGION + R_VT) + (size_t)(b * 8 + h) * 64 * KT_ + (size_t)kt0 * 4096;
  bf16_t* att = (bf16_t*)(p.ws + OFF_REGION + R_ATT);
  const int nq0 = isctx ? NX_ + b * CL_ + qt * 256 : b * T_ + qt * 256;
  const int nq = nq0 + wid * 32 + r;
  const float sc = 0.10206207261596577f * 1.4426950408889634f;
  bf16x8 qf[6];
#pragma unroll
  for (int ks = 0; ks < 6; ++ks) {
    const u32x4 u = *(const u32x4*)(qb + (size_t)nq * 768 + h * 96 + ks * 16 + h2 * 8);
    const u32x4 v = {pack2bf(bf2f((bf16_t)(u[0] & 0xffff)) * sc, bf2f((bf16_t)(u[0] >> 16)) * sc), pack2bf(bf2f((bf16_t)(u[1] & 0xffff)) * sc, bf2f((bf16_t)(u[1] >> 16)) * sc),
                     pack2bf(bf2f((bf16_t)(u[2] & 0xffff)) * sc, bf2f((bf16_t)(u[2] >> 16)) * sc), pack2bf(bf2f((bf16_t)(u[3] & 0xffff)) * sc, bf2f((bf16_t)(u[3] >> 16)) * sc)};
    __builtin_memcpy(&qf[ks], &v, 16);
  }
  f32x16 oacc[2] = {zero16(), zero16()};
  float m = 0.f, lsum = 0.f;
  f32x16 negm = zero16();
  char* const Kst = smem;
  char* const Vst = smem + 2 * ATT_KB;
  const int kc1 = tid + 512;
  u32x4 ak0, ak1 = {0u, 0u, 0u, 0u}, av;
#define ATT_LOADK(s_, kt_) { const bf16_t* ksrc_ = kbase + (size_t)(kt_) * 64 * 96; s_##k0 = *(const u32x4*)(ksrc_ + tid * 8); if (kc1 < 768) s_##k1 = *(const u32x4*)(ksrc_ + kc1 * 8); }
#define ATT_LOADV(s_, kt_) { s_##v = *(const u32x4*)(vbase + (size_t)(kt_) * 4096 + tid * 8); }
#define ATT_STOREK(s_, st_) { char* d_ = Kst + (st_) * ATT_KB; const int tq_ = opaque_tid(), tq1_ = tq_ + 512; \
    *(u32x4*)(d_ + ((tq_ / 12) * ATT_KLD + (tq_ % 12) * 8) * 2) = s_##k0; if (tq1_ < 768) *(u32x4*)(d_ + ((tq1_ / 12) * ATT_KLD + (tq1_ % 12) * 8) * 2) = s_##k1; }
#define ATT_STOREV(s_, st_) { char* d_ = Vst + (st_) * ATT_VB; const int tq_ = opaque_tid(), vo_ = ((tq_ >> 3) * ATT_VLD + (tq_ & 7) * 8) * 2; \
    *(uint2*)(d_ + vo_) = make_uint2(s_##v[0], s_##v[1]); *(uint2*)(d_ + vo_ + 8) = make_uint2(s_##v[2], s_##v[3]); }
#define ATT_QK(dst_, st_) { const char* Ks_ = Kst + (st_) * ATT_KB; \
    _Pragma("unroll") for (int ks = 0; ks < 6; ++ks) _Pragma("unroll") for (int kb = 0; kb < 2; ++kb) { \
      const bf16x8 kf_ = *(const bf16x8*)(Ks_ + ((kb * 32 + r) * ATT_KLD + ks * 16 + h2 * 8) * 2); dst_[kb] = mfma32(kf_, qf[ks], ks == 0 ? negm : dst_[kb]); } }
  __syncthreads();
  ATT_LOADK(a, 0); ATT_LOADV(a, 0); ATT_STOREK(a, 0); ATT_STOREV(a, 0);
  ATT_LOADK(a, 1); ATT_STOREK(a, 1);
  ATT_LOADK(a, (2 < nkt ? 2 : nkt - 1)); ATT_LOADV(a, 1);
  __syncthreads();
  f32x16 sA[2], sB[2];
  ATT_QK(sA, 0);
  __syncthreads();
#define ATT_SMPV(cur_, oth_, t) { \
    float mx = -1e30f; \
    _Pragma("unroll") for (int kb = 0; kb < 2; ++kb) _Pragma("unroll") for (int i = 0; i < 16; ++i) mx = fmaxf(mx, cur_[kb][i]); \
    mx = swap32_max(mx); \
    if ((t) == 0 || __ballot(mx > ATT_THR) != 0ull) {        \
      const float dlt = ((t) == 0 || mx > ATT_THR) ? mx : 0.f; \
      const float alpha = fexp2(-dlt); \
      _Pragma("unroll") for (int db = 0; db < 2; ++db) _Pragma("unroll") for (int i = 0; i < 16; ++i) oacc[db][i] *= alpha; \
      _Pragma("unroll") for (int kb = 0; kb < 2; ++kb) _Pragma("unroll") for (int i = 0; i < 16; ++i) { cur_[kb][i] -= dlt; oth_[kb][i] -= dlt; } \
      lsum *= alpha; m += dlt; \
      _Pragma("unroll") for (int i = 0; i < 16; ++i) negm[i] = -m; } \
    _Pragma("unroll") for (int kb = 0; kb < 2; ++kb) _Pragma("unroll") for (int i = 0; i < 16; ++i) cur_[kb][i] = ABL_EXP(cur_[kb][i]); \
    { float ps0 = 0.f, ps1 = 0.f; _Pragma("unroll") for (int i = 0; i < 16; ++i) { ps0 += cur_[0][i]; ps1 += cur_[1][i]; } lsum += ps0 + ps1; } \
    const char* Vs = Vst + ((t) & 1) * ATT_VB; \
    _Pragma("unroll") for (int kb = 0; kb < 2; ++kb) _Pragma("unroll") for (int s2 = 0; s2 < 2; ++s2) { \
      bf16x8 pf; { const u32x4 u = {pack2bf(cur_[kb][8 * s2 + 0], cur_[kb][8 * s2 + 1]), pack2bf(cur_[kb][8 * s2 + 2], cur_[kb][8 * s2 + 3]), \
                                    pack2bf(cur_[kb][8 * s2 + 4], cur_[kb][8 * s2 + 5]), pack2bf(cur_[kb][8 * s2 + 6], cur_[kb][8 * s2 + 7])}; __builtin_memcpy(&pf, &u, 16); } \
      ABL_PV_BEGIN \
      _Pragma("unroll") for (int db = 0; db < 2; ++db) { \
        const char* vrow = Vs + ((db * 32 + r) * ATT_VLD + kb * 32 + 16 * s2 + 4 * h2) * 2; \
        const uint2 lo = *(const uint2*)(vrow), hi = *(const uint2*)(vrow + 16); \
        const u32x4 u = {lo.x, lo.y, hi.x, hi.y}; bf16x8 vf; __builtin_memcpy(&vf, &u, 16); \
        oacc[db] = mfma32(vf, pf, oacc[db]); } ABL_PV_END } }
#define ATT_STEP(cur_, nxt_, t_) { \
    const int t = (t_); \
    const int tk = t + 3 < nkt ? t + 3 : nkt - 1, tv = t + 2 < nkt ? t + 2 : nkt - 1; \
    ABL_STORES(a, t)        \
    ABL_LOADS2(a, tk, tv) \
    sched_fence(); \
    ATT_QK(nxt_, (t + 1) & 1); sched_fence(); ATT_SMPV(cur_, nxt_, t); \
    sched_fence(); \
    ABL_SYNC(); }
  for (int t0 = 0; t0 < nkt; t0 += 2) {
    ATT_STEP(sA, sB, t0);
    ATT_STEP(sB, sA, t0 + 1);
  }
  lsum = swap32_sum(lsum);
  if (part >= 0) {
    float* pd = (float*)(p.osc + O_APART) + ((size_t)part * 256 + wid * 32 + r) * ATT_PLD;
#pragma unroll
    for (int db = 0; db < 2; ++db)
#pragma unroll
      for (int g = 0; g < 4; ++g)
        *(float4*)(pd + db * 32 + 8 * g + 4 * h2) = make_float4(oacc[db][g * 4 + 0], oacc[db][g * 4 + 1], oacc[db][g * 4 + 2], oacc[db][g * 4 + 3]);
    if (h2 == 0) *(float2*)(pd + 64) = make_float2(m, lsum);
    return;
  }
  const float inv = 1.f / lsum;
#pragma unroll
  for (int db = 0; db < 2; ++db)
#pragma unroll
    for (int g = 0; g < 4; ++g) {
      uint2 o;
      o.x = pack2bf(oacc[db][g * 4 + 0] * inv, oacc[db][g * 4 + 1] * inv);
      o.y = pack2bf(oacc[db][g * 4 + 2] * inv, oacc[db][g * 4 + 3] * inv);
#ifdef ABL_ZERO
      { const bool odd_ = o.x == 0x12345678u && o.y == 0x9abcdef0u; o.x = odd_ ? 1u : 0u; o.y = 0u; }
#endif
      *(uint2*)(att + (size_t)nq * 512 + h * 64 + db * 32 + 8 * g + 4 * h2) = o;
    }
}

DI void att_split_tile(int j, int& b, int& h, int& qt) {
  const int QT = T_ / 256, x = j >> 1, li = 2 * QT - 2 + (j & 1), bh = 2 * x + li / QT;
  b = bh >> 3; h = bh & 7; qt = li % QT;
}
DI void att_piece_range(int piece, int& kt0, int& nk) {
  const int pairs = KT_ / 128, q = pairs / ATT_NPIECE, rem = pairs % ATT_NPIECE;
  kt0 = 2 * (piece * q + (piece < rem ? piece : rem)); nk = 2 * (q + (piece < rem ? 1 : 0));
}
DI void att_merge_item(const Params& p, int j) {
  int b, h, qt; att_split_tile(j, b, h, qt);
  const int tid = opaque_tid(), row = tid >> 1, hf = tid & 1;
  const float* ps = (const float*)(p.osc + O_APART) + ((size_t)j * ATT_NPIECE * 256 + row) * ATT_PLD;
  bf16_t* att = (bf16_t*)(p.ws + OFF_REGION + R_ATT) + (size_t)(b * T_ + qt * 256 + row) * 512 + h * 64 + hf * 32;
  float mm[ATT_NPIECE], ll[ATT_NPIECE], ms = -1e30f;
#pragma unroll
  for (int i = 0; i < ATT_NPIECE; ++i) { const float2 t = *(const float2*)(ps + (size_t)i * 256 * ATT_PLD + 64); mm[i] = t.x; ll[i] = t.y; ms = fmaxf(ms, t.x); }
  float L = 0.f;
#pragma unroll
  for (int i = 0; i < ATT_NPIECE; ++i) { mm[i] = fexp2(mm[i] - ms); L += mm[i] * ll[i]; }
  const float inv = 1.f / L;
#pragma unroll
  for (int c = 0; c < 8; ++c) {
    float4 a = make_float4(0.f, 0.f, 0.f, 0.f);
#pragma unroll
    for (int i = 0; i < ATT_NPIECE; ++i) {
      const float4 t = *(const float4*)(ps + (size_t)i * 256 * ATT_PLD + hf * 32 + c * 4);
      a.x += mm[i] * t.x; a.y += mm[i] * t.y; a.z += mm[i] * t.z; a.w += mm[i] * t.w;
    }
    uint2 o; o.x = pack2bf(a.x * inv, a.y * inv); o.y = pack2bf(a.z * inv, a.w * inv);
    *(uint2*)(att + c * 4) = o;
  }
}

DI constexpr int att_items(int l) { return NB_ * 8 * (T_ / 256) + (l == 0 ? NB_ * 8 * (CL_ / 256) : 0); }
DI void spin_until_ge(int* ctr, int target) {
#ifdef EMU
  while (__atomic_load_n(ctr, __ATOMIC_SEQ_CST) < target) emu::yield();
#else
  while (__hip_atomic_load(ctr, __ATOMIC_RELAXED, __HIP_MEMORY_SCOPE_AGENT) < target) __builtin_amdgcn_s_sleep(8);
#endif
}
constexpr int P3B_ITEMS = RW1_ITEMS + ML2_ITEMS + MLA_Q_TILES + MLA_KV_TILES;
DI void phase3b(const Params& p, int l, char* smem, int* ctr) {
  for (int it = vblock(); it < P3B_ITEMS; it += gridDim.x) {
    int i = it;
    if (i < RW1_ITEMS) { TSB(p, 58); rw_chunk_item(p, i, smem); TSB(p, 59); continue; }
    i -= RW1_ITEMS;
    if (i < ML2_ITEMS) { mlstm_scan_item(p, i); continue; }
    i -= ML2_ITEMS;
    TSB(p, 60);
    if (i < MLA_Q_TILES) mla_q_item(p, l, i, smem); else mla_kv_item(p, l, i - MLA_Q_TILES, smem);
    TSB(p, 61);
  }
}

DI void phase4(const Params& p, int l, char* smem, int* ctr) {
  const int G = gridDim.x, nsb = G >= 2 * RW2_ITEMS ? RW2_ITEMS : (G > 1 ? G / 2 : 1);
  if ((int)blockIdx.x < nsb) {
    TSB(p, 50);
    for (int s = blockIdx.x; s < RW2_ITEMS; s += nsb) rw_state_item(p, s, smem);
#ifndef EMU
    asm volatile("s_waitcnt vmcnt(0)" ::: "memory");
#endif
    __syncthreads();
    if (opaque_tid() == 0) { __threadfence(); atomicAdd(ctr + 2, (RW2_ITEMS - (int)blockIdx.x + nsb - 1) / nsb); }
    TSB(p, 51);
  }
  const int QT = T_ / 256, CQ = (l == 0 ? (NB_ * 8 * (CL_ / 256)) / 8 : 0), R3 = RW1_ITEMS / (8 * RW3_N);
  const int NF = 2 * QT - 2, NQ = 2 * ATT_NPIECE;
  const int per = NF + NQ + CQ + R3;
  int* sitem = (int*)(smem + 160 * 1024 - 16);
  bool r2ok = false;
  const int x0 = xcc_id();
  for (;;) {
    __syncthreads();
    if (opaque_tid() == 0) {
      int item = -1;
      for (int k = 0; k < 8 && item < 0; ++k) {
        const int x = (x0 + k) & 7;
        if (ld_relaxed(ctr + 8 + x) >= per) continue;
        const int li = atomicAdd(ctr + 8 + x, 1);
        if (li < per) item = x * per + li;
      }
      *sitem = item;
    }
    __syncthreads();
    const int item = *sitem;
    if (item < 0) break;
    const int x = item / per; int li = item % per;
    if (li < NF) { const int bh = 2 * x + li / QT, qt = li % QT; TSB(p, 54); attn_item(p, bh >> 3, bh & 7, qt, false, smem, 0, KT_ / 64, -1); TSB(p, 55); continue; }
    li -= NF;
    if (li < NQ) {
      const int j = x * 2 + li / ATT_NPIECE, piece = li % ATT_NPIECE;
      int b, h, qt, kt0, nk; att_split_tile(j, b, h, qt); att_piece_range(piece, kt0, nk);
      attn_item(p, b, h, qt, false, smem, kt0, nk, j * ATT_NPIECE + piece);
      continue;
    }
    li -= NQ;
    if (li < CQ) { const int ci = x * CQ + li, qt = ci % (CL_ / 256), bh = ci / (CL_ / 256); attn_item(p, bh >> 3, bh & 7, qt, true, smem, 0, CL_ / 64, -1); continue; }
    li -= CQ;
    if (!r2ok) {
      if (opaque_tid() == 0) { spin_until_ge(ctr + 2, RW2_ITEMS); __threadfence(); }
      __syncthreads();
      r2ok = true;
    }
    rw_out_pair(p, RW3_N * (x * R3 + li), smem);
  }
}
constexpr int ML3_CC = CL_ / 64, ML3_XC = T_ / 64;
DI constexpr int ml3_items(bool with_ctx) { return NB_ * 4 * (ML3_XC + (with_ctx ? ML3_CC : 0)); }
template <int KS> DI f32x16 ml_mm(const char* A, const char* Bt, int mb, int nb, int lane, f32x16 acc) {
  const int r = lane & 31, h = lane >> 5;
#pragma unroll
  for (int ks = 0; ks < KS; ++ks) {
    const bf16x8 a = *(const bf16x8*)(A + ((mb * 32 + r) * RW_LD + ks * 16 + h * 8) * 2);
    const bf16x8 b = *(const bf16x8*)(Bt + ((nb * 32 + r) * RW_LD + ks * 16 + h * 8) * 2);
    acc = mfma32(a, b, acc);
  }
  return acc;
}
DI float wave_incl_scan_max(float v, int lane) {
  for (int d = 1; d < 64; d <<= 1) { const float o = shfl_up_l(v, d, lane); if (lane >= d) v = fmaxf(v, o); }
  return v;
}
DI void mlstm_out_item(const Params& p, int l, int it, bool with_ctx, char* smem) {
  const int per = ML3_XC + (with_ctx ? ML3_CC : 0);
  const int bh = it / per, b = bh >> 2, hd = bh & 3;
  int tc = it % per; if (!with_ctx) tc += ML3_CC;
  const bool isctx = tc < ML3_CC;
  const int ntok0 = isctx ? NX_ + b * CL_ + tc * 64 : b * T_ + (tc - ML3_CC) * 64;
  char* const Qm = smem;
  char* const Km = smem + 1 * RW_MB;
  char* const Qp = smem + 2 * RW_MB;
  char* const Vi = smem + 3 * RW_MB;
  char* const Pp = smem + 4 * RW_MB;
  char* const Cm = smem + 5 * RW_MB;
  float* const hs = (float*)(smem + 6 * RW_MB);
  float* const ga = hs + 64 * 64;
  float* const denp = ga + 5 * 64;
  float* const nsv = denp + 128;
  const float* zrec = (const float*)(p.ws + OFF_REGION + R_ZREC);
  const int tid = opaque_tid(), lane = tid & 63, wid = tid >> 6;
  const int tk = tid >> 3, v0 = (tid & 7) * 8;
  const float4 og0 = *(const float4*)(zrec + (size_t)(ntok0 + tk) * ZREC_W + ZR_MLO + hd * 64 + v0), og1 = *(const float4*)(zrec + (size_t)(ntok0 + tk) * ZREC_W + ZR_MLO + hd * 64 + v0 + 4);
  const float4 gn0 = *(const float4*)(p.ml_g_norm + l * 256 + hd * 64 + v0), gn1 = *(const float4*)(p.ml_g_norm + l * 256 + hd * 64 + v0 + 4);
  __syncthreads();
  for (int idx = tid; idx < 64 * 64; idx += NTHR) hs[idx] = 0.f;
  float4 q4, k4, c4, va, vb, n4; float nsr = 0.f, m_nx = 0.f, fp_nx = 0.f, ip_nx = 0.f;
  const int lj = tid >> 3, lpt = tid & 7;
#define M3_LD(d_) { const int c_ = (d_) == 0 ? tc : (isctx ? ML3_CC - 1 - tc : ML3_CC + (ML3_XC - 1 - (tc - ML3_CC))); \
    const float* st_ = (const float*)(p.ws + OFF_REGION + R_MLST) + ((size_t)((d_) * 8 + b * 4 + hd) * NCH_ + c_) * ML_ST; \
    const float* zr_ = zrec + (size_t)(ntok0 + ((d_) ? 63 - lj : lj)) * ZREC_W; \
    q4 = *(const float4*)(zr_ + ZR_MLQ + hd * 32 + lpt * 4); k4 = *(const float4*)(zr_ + ZR_MLK + hd * 32 + lpt * 4); \
    c4 = *(const float4*)(st_ + lj * 32 + lpt * 4); \
    va = *(const float4*)(zr_ + ZR_MLV + hd * 64 + lpt * 8); vb = *(const float4*)(zr_ + ZR_MLV + hd * 64 + lpt * 8 + 4); \
    n4 = *(const float4*)(st_ + 2048 + lpt * 4); m_nx = st_[2082]; \
    if (tid < 32) nsr = st_[2048 + tid]; \
    if (wid == 0) { const int n_ = ntok0 + ((d_) ? 63 - lane : lane); \
      fp_nx = zrec[(size_t)n_ * ZREC_W + ZR_MLF + (d_) * 4 + hd] + p.ml_b_f[(l * 2 + (d_)) * 4 + hd]; \
      ip_nx = zrec[(size_t)n_ * ZREC_W + ZR_MLI + (d_) * 4 + hd] + p.ml_b_i[(l * 2 + (d_)) * 4 + hd]; } }
  M3_LD(0);
#pragma unroll 1
  for (int dir = 0; dir < 2; ++dir) {
    const float m_start = m_nx, fp = fp_nx, ipre = ip_nx;
    __syncthreads();
    {
      const int j = lj, pt = lpt;
      const float qs = 0.17677669529663687f;
      const float q0 = q4.x * qs, q1 = q4.y * qs, q2 = q4.z * qs, q3 = q4.w * qs;
      *(uint2*)(Qm + (j * RW_LD + pt * 4) * 2) = make_uint2(pack2bf(q0, q1), pack2bf(q2, q3));
      *(uint2*)(Km + (j * RW_LD + pt * 4) * 2) = make_uint2(pack2bf(k4.x, k4.y), pack2bf(k4.z, k4.w));
      *(uint2*)(Cm + (j * RW_LD + pt * 4) * 2) = make_uint2(pack2bf(c4.x, c4.y), pack2bf(c4.z, c4.w));
      const float vv[8] = {va.x, va.y, va.z, va.w, vb.x, vb.y, vb.z, vb.w};
#pragma unroll
      for (int u = 0; u < 8; ++u) *(bf16_t*)(Vi + ((pt * 8 + u) * RW_LD + j) * 2) = f2bf(vv[u]);
      if (tid < 32) nsv[tid] = nsr;
      float nq = n4.x * q0 + n4.y * q1 + n4.z * q2 + n4.w * q3;
      nq += lx1(nq); nq += lx2(nq); nq += lx4m(nq);
      if (pt == 0) ga[4 * 64 + j] = nq;
    }
    if (dir == 0) { M3_LD(1); }
    sched_fence();
    if (wid == 0) {
      const float bj = wave_incl_scan(logsigmoidf_(fp), lane);
      const float g = ipre - bj;
      const float pm = wave_incl_scan_max(g, lane);
      const float c0 = wave_max(g);
      const float mj = fmaxf(bj + m_start, bj + pm);
      ga[0 * 64 + lane] = fexp(g - c0);
      ga[1 * 64 + lane] = fexp(fminf(bj + c0 - mj, 80.f));
      ga[2 * 64 + lane] = fexp(bj + m_start - mj);
      ga[3 * 64 + lane] = fexp(fminf(-mj, 80.f));
    }
    __syncthreads();
    if (wid < 4) {
      const int mb = wid >> 1, nb = wid & 1, r = lane & 31, h = lane >> 5;
      f32x16 acc = zero16();
      if (!(mb == 1 && nb == 0)) acc = ml_mm<2>(Km, Qm, mb, nb, lane, acc);
      rw_mask_upper(acc, mb, nb, lane, false);
      const float al = ga[1 * 64 + nb * 32 + r];
      float csum = 0.f;
#pragma unroll
      for (int i = 0; i < 16; ++i) { acc[i] *= ga[0 * 64 + mb * 32 + crow(i, h)] * al; csum += acc[i]; }
      csum = swap32_sum(csum);
      if (h == 0) denp[mb * 64 + nb * 32 + r] = csum;
      rw_wrT(Pp, mb, nb, lane, acc);
    } else {
      const int t2 = tid - 256, j = t2 >> 2, d8 = (t2 & 3) * 8;
      const float in = ga[2 * 64 + j];
      const uint4 u = *(const uint4*)(Qm + (j * RW_LD + d8) * 2);
      const unsigned w[4] = {u.x, u.y, u.z, u.w};
      unsigned o[4];
#pragma unroll
      for (int q = 0; q < 4; ++q) o[q] = pack2bf(bf2f((bf16_t)(w[q] & 0xffff)) * in, bf2f((bf16_t)(w[q] >> 16)) * in);
      *(uint4*)(Qp + (j * RW_LD + d8) * 2) = make_uint4(o[0], o[1], o[2], o[3]);
    }
    __syncthreads();
    if (wid < 4) {
      const int mb = wid >> 1, nb = wid & 1, r = lane & 31, h = lane >> 5;
      f32x16 acc = zero16();
      acc = ml_mm<4>(Vi, Pp, mb, nb, lane, acc);
      acc = ml_mm<2>(Cm, Qp, mb, nb, lane, acc);
      const int j = nb * 32 + r;
      const float den = denp[j] + denp[64 + j] + ga[2 * 64 + j] * ga[4 * 64 + j];
      const float rden = frcp(fmaxf(fabsf(den), ga[3 * 64 + j]));
      float* hrow = hs + (dir ? 63 - j : j) * 64 + mb * 32 + 4 * h;
#pragma unroll
      for (int g4 = 0; g4 < 4; ++g4) {
        float4 o = *(float4*)(hrow + 8 * g4);
        o.x += acc[4 * g4] * rden; o.y += acc[4 * g4 + 1] * rden; o.z += acc[4 * g4 + 2] * rden; o.w += acc[4 * g4 + 3] * rden;
        *(float4*)(hrow + 8 * g4) = o;
      }
    }
  }
  __syncthreads();
  const int n = ntok0 + tk;
  float ss = 0.f; float hv[8];
#pragma unroll
  for (int u = 0; u < 8; ++u) { hv[u] = hs[tk * 64 + v0 + u]; ss += hv[u] * hv[u]; }
  ss += lx1(ss); ss += lx2(ss); ss += lx4m(ss);
  const float rs = frsq(ss * (1.f / 64.f) + 1e-6f);
  const float ogv[8] = {og0.x, og0.y, og0.z, og0.w, og1.x, og1.y, og1.z, og1.w}, gnv[8] = {gn0.x, gn0.y, gn0.z, gn0.w, gn1.x, gn1.y, gn1.z, gn1.w};
  unsigned o[4];
#pragma unroll
  for (int u = 0; u < 8; u += 2) {
    const float a = hv[u] * rs * gnv[u] * sigmoidf_(ogv[u]);
    const float bq = hv[u + 1] * rs * gnv[u + 1] * sigmoidf_(ogv[u + 1]);
    o[u >> 1] = pack2bf(a, bq);
  }
  bf16_t* mlo = (bf16_t*)(p.ws + OFF_REGION + R_MLO);
  *(uint4*)(mlo + (size_t)n * 256 + hd * 64 + v0) = make_uint4(o[0], o[1], o[2], o[3]);
}

DI constexpr int rwo_items(bool with_ctx) { return (with_ctx ? NT_ : NX_) / 16; }
constexpr int RWO_ALD = 136;
DI void rwkv_out_weights(const Params& p, int l, bf16x8 (&g2w)[8]) {
  const int tid = opaque_tid(), lane = tid & 63, wid = tid >> 6;
#pragma unroll
  for (int ks = 0; ks < 8; ++ks) {
    const float* src = p.rw_g2 + ((size_t)l * 128 + ks * 16 + (lane >> 5) * 8) * 256 + wid * 32 + (lane & 31);
    const u32x4 u = {pack2bf(src[0], src[256]), pack2bf(src[512], src[768]), pack2bf(src[1024], src[1280]), pack2bf(src[1536], src[1792])};
    __builtin_memcpy(&g2w[ks], &u, 16);
  }
}
DI void rwkv_out_item(const Params& p, int l, int it, char* smem, const bf16x8 (&g2w)[8]) {
  bf16_t* sgh = (bf16_t*)smem;
  bf16_t* sgl = sgh + 17 * RWO_ALD;
  float* red = (float*)(sgl + 17 * RWO_ALD);
  const float* zrec = (const float*)(p.ws + OFF_REGION + R_ZREC);
  const bf16_t* rb = (const bf16_t*)(p.ws + OFF_REGION + R_RB16);
  const float* bso = (const float*)(p.ws + OFF_REGION + R_BS);
  const float* ys = (const float*)(p.ws + OFF_REGION + R_YS);
  bf16_t* rwo = (bf16_t*)(p.ws + OFF_REGION + R_RWO);
  const float* mu = p.rw_mu + (size_t)l * 1152;
  const int tid = opaque_tid(), n0 = it * 16, lane = tid & 63, wid = tid >> 6, r32 = lane & 31, h2 = lane >> 5;
  const int col = wid * 32 + r32;
  const size_t AS = (size_t)NT_ * 256;
  __syncthreads();
  {
    const int tt = tid >> 5, k4 = (tid & 31) * 4, n = n0 + tt, t = tok_t(n), c = 1024 + k4;
    const int len = n < NX_ ? T_ : CL_;
    const float* zr = zrec + (size_t)n * ZREC_W + ZR_RW + c;
    const float4 z = *(const float4*)zr;
    const float4 zp = t > 0 ? *(const float4*)(zr - ZREC_W) : make_float4(0.f, 0.f, 0.f, 0.f);
    const float4 zn = t < len - 1 ? *(const float4*)(zr + ZREC_W) : make_float4(0.f, 0.f, 0.f, 0.f);
    const float4 m4 = *(const float4*)(mu + c);
    const float e0 = sigmoidf_(z.x + (0.5f * (zp.x + zn.x) - z.x) * m4.x), e1 = sigmoidf_(z.y + (0.5f * (zp.y + zn.y) - z.y) * m4.y);
    const float e2 = sigmoidf_(z.z + (0.5f * (zp.z + zn.z) - z.z) * m4.z), e3 = sigmoidf_(z.w + (0.5f * (zp.w + zn.w) - z.w) * m4.w);
    const bf16_t b0 = f2bf(e0), b1 = f2bf(e1), b2 = f2bf(e2), b3 = f2bf(e3);
    *(uint2*)(sgh + tt * RWO_ALD + k4) = make_uint2((unsigned)b0 | ((unsigned)b1 << 16), (unsigned)b2 | ((unsigned)b3 << 16));
    *(uint2*)(sgl + tt * RWO_ALD + k4) = make_uint2(pack2bf(e0 - bf2f(b0), e1 - bf2f(b1)), pack2bf(e2 - bf2f(b2), e3 - bf2f(b3)));
    if (tid < 128) { sgh[16 * RWO_ALD + tid] = 0; sgl[16 * RWO_ALD + tid] = 0; }
  }
  float yv[8], vv[8], bsv[8];
#pragma unroll
  for (int i = 0; i < 8; ++i) {
    const int n = n0 + (i & 3) + 8 * (i >> 2) + 4 * h2;
    const size_t o = (size_t)n * 256 + col;
    yv[i] = ys[o] + ys[AS + o];
    vv[i] = bf2f(rb[1 * AS + o]);
    bsv[i] = bso[(size_t)n * 4 + (col >> 6)] + bso[((size_t)NT_ + n) * 4 + (col >> 6)];
  }
#pragma unroll
  for (int i = 0; i < 8; ++i) {
    const int tt = (i & 3) + 8 * (i >> 2) + 4 * h2;
    const float s1 = half_sum(yv[i], h2), s2 = half_sum(yv[i] * yv[i], h2);
    if (r32 == 0) *(float2*)(red + (tt * 8 + wid) * 2) = make_float2(s1, s2);
  }
  __syncthreads();
  f32x16 acc = zero16();
  const int arow = r32 < 16 ? r32 : 16;
#pragma unroll
  for (int ks = 0; ks < 8; ++ks) {
    const int o = arow * RWO_ALD + ks * 16 + h2 * 8;
    const bf16x8 ah = *(const bf16x8*)(sgh + o), al = *(const bf16x8*)(sgl + o);
    acc = mfma32(ah, g2w[ks], acc); acc = mfma32(al, g2w[ks], acc);
  }
  const float lw = p.rw_lnx_w[(size_t)l * 256 + col], lb = p.rw_lnx_b[(size_t)l * 256 + col];
#pragma unroll
  for (int i = 0; i < 8; ++i) {
    const int tt = (i & 3) + 8 * (i >> 2) + 4 * h2, n = n0 + tt;
    const float4 q = *(const float4*)(red + (tt * 8 + (wid & ~1)) * 2);
    const float mean = (q.x + q.z) * (1.f / 64.f);
    const float var = fmaxf((q.y + q.w) * (1.f / 64.f) - mean * mean, 0.f);
    const float yn = (yv[i] - mean) * (frsq(var + 64e-5f)) * lw + lb;
    rwo[(size_t)n * 256 + col] = f2bf((yn + bsv[i] * vv[i]) * acc[i]);
  }
}
DI void phase5(const Params& p, int l, bool with_ctx, char* smem) {
  const int n1 = ml3_items(with_ctx), n2 = rwo_items(with_ctx), G = gridDim.x;
  { const int mb0 = G >= 128 ? 100 : 0;
    for (int j = (int)blockIdx.x - mb0; j >= 0 && j < ATT_NSPLIT; j += G) att_merge_item(p, j); }
  for (int it = blockIdx.x; it < n1; it += G) { TSB(p, 62); mlstm_out_item(p, l, it, with_ctx, smem); TSB(p, 63); }
  bf16x8 g2w[8];
  rwkv_out_weights(p, l, g2w);
  for (int it = G - 1 - (int)blockIdx.x; it < n2; it += G) { TSB(p, 64); rwkv_out_item(p, l, it, smem, g2w); TSB(p, 65); }
}
typedef Gemm<256, 128, 64, 4, 2> G2;
template <class G> DI void merge_tile(const Params& p, int l, int row0, int col0, char* smem) {
  const bf16_t* H = (const bf16_t*)(p.ws + OFF_H);
  const char* W = p.ws + OFF_WMIX + (size_t)l * WM_SIZE;
  const bf16_t* Wg = (const bf16_t*)(W + WM_GATE);
  const bf16_t* att = (const bf16_t*)(p.ws + OFF_REGION + R_ATT);
  const bf16_t* mlo = (const bf16_t*)(p.ws + OFF_REGION + R_MLO);
  const bf16_t* rwo = (const bf16_t*)(p.ws + OFF_REGION + R_RWO);
  bf16_t* ymix = (bf16_t*)(p.osc + O_YMIX);
  const int tid = opaque_tid();
  __syncthreads();
  unsigned ypk[G::MB][G::NB][8];
  f32x16 acc[G::MB][G::NB];
#pragma unroll 1
  for (int i = 0; i < 3; ++i) {
    unsigned sg[G::MB][G::NB][8];
#pragma unroll
    for (int a = 0; a < G::MB; ++a)
#pragma unroll
      for (int b = 0; b < G::NB; ++b) acc[a][b] = zero16();
    const bf16_t* A0 = H + (size_t)row0 * 1024;
    G::run_lin(acc, A0, 1024, Wg + ((size_t)i * 1024 + col0) * 1024, 1024, 1024, smem);
#pragma unroll
    for (int a = 0; a < G::MB; ++a)
#pragma unroll
      for (int b = 0; b < G::NB; ++b) {
#pragma unroll
        for (int e = 0; e < 8; ++e) sg[a][b][e] = pack2bf(sigmoidf_(acc[a][b][2 * e]), sigmoidf_(acc[a][b][2 * e + 1]));
        acc[a][b] = zero16();
      }
    const bf16_t* br = i == 0 ? att : (i == 1 ? mlo : rwo);
    const int kb = i == 0 ? 512 : 256;
    const bf16_t* Wb = (const bf16_t*)(W + (i == 0 ? WM_BRA : (i == 1 ? WM_BRM : WM_BRR)));
    const bf16_t* B0 = br + (size_t)row0 * kb;
    G::run_lin(acc, B0, kb, Wb + (size_t)col0 * kb, kb, kb, smem);
#pragma unroll
    for (int a = 0; a < G::MB; ++a)
#pragma unroll
      for (int b = 0; b < G::NB; ++b)
#pragma unroll
        for (int e = 0; e < 8; ++e) {
          float y0 = bf2f((bf16_t)(sg[a][b][e] & 0xffff)) * acc[a][b][2 * e], y1 = bf2f((bf16_t)(sg[a][b][e] >> 16)) * acc[a][b][2 * e + 1];
          if (i > 0) { y0 += bf2f((bf16_t)(ypk[a][b][e] & 0xffff)); y1 += bf2f((bf16_t)(ypk[a][b][e] >> 16)); }
          if (i < 2) ypk[a][b][e] = pack2bf(y0, y1); else { acc[a][b][2 * e] = y0; acc[a][b][2 * e + 1] = y1; }
        }
  }
  {
    const int lane = tid & 63, wid = tid >> 6, wm = wid / G::WN, wn = wid % G::WN;
    float* scr = (float*)(smem + wid * WTile<G::NB>::BYTES);
#pragma unroll
    for (int mb = 0; mb < G::MB; ++mb) {
#pragma unroll
      for (int nb = 0; nb < G::NB; ++nb) WTile<G::NB>::put(scr, nb, lane, acc[mb][nb]);
      const int r0 = row0 + wm * G::WTM + mb * 32, c0 = col0 + wn * G::WTN;
      WTile<G::NB>::rows8(scr, lane, [&](int r, int c, const float4& a, const float4& bq) {
        *(uint4*)(ymix + (size_t)(r0 + r) * 1024 + c0 + c) = pack8bf(a, bq); });
    }
  }
}
DI void phase_merge(const Params& p, int l, bool with_ctx, char* smem) {
  const int nbig = (NX_ / 256) * 8, nsmall = with_ctx ? (NC_ / 128) * 8 : 0;
  for (int it = vblock(); it < nbig + nsmall; it += gridDim.x) {
    if (it < nbig) merge_tile<G2>(p, l, (it >> 3) * 256, (it & 7) * 128, smem);
    else { const int i2 = it - nbig; merge_tile<G128>(p, l, NX_ + (i2 >> 3) * 128, (i2 & 7) * 128, smem); }
  }
}

template <class G> DI void wout_tile(const Params& p, int l, int row0, int col0, char* smem) {
  const bf16_t* ymix = (const bf16_t*)(p.osc + O_YMIX);
  const bf16_t* Wo = (const bf16_t*)(p.ws + OFF_WMIX + (size_t)l * WM_SIZE + WM_OUT);
  float* xs = (float*)(p.ws + OFF_XS);
  const float* mod = (const float*)(p.ws + OFF_MOD) + (size_t)l * 3 * 6144;
  const int tid = opaque_tid();
  __syncthreads();
  f32x16 acc[G::MB][G::NB];
#pragma unroll
  for (int a = 0; a < G::MB; ++a)
#pragma unroll
    for (int b = 0; b < G::NB; ++b) acc[a][b] = zero16();
  const bf16_t* A0 = ymix + (size_t)row0 * 1024;
  G::run_lin(acc, A0, 1024, Wo + (size_t)col0 * 1024, 1024, 1024, smem);
  const float* m2 = mod + (size_t)tok_modrow(row0) * 6144 + 2 * 1024;
  const int lane = tid & 63, wid = tid >> 6, wm = wid / G::WN, wn = wid % G::WN;
  float* scr = (float*)(smem + wid * WTile<G::NB>::BYTES);
#pragma unroll
  for (int mb = 0; mb < G::MB; ++mb) {
#pragma unroll
    for (int nb = 0; nb < G::NB; ++nb) WTile<G::NB>::put(scr, nb, lane, acc[mb][nb]);
    const int r0 = row0 + wm * G::WTM + mb * 32, c0 = col0 + wn * G::WTN;
    WTile<G::NB>::rows4(scr, lane, [&](int r, int c, const float4& a) {
      float4* d = (float4*)(xs + (size_t)(r0 + r) * 1024 + c0 + c);
      const float4 g = *(const float4*)(m2 + c0 + c); float4 x = *d;
      x.x += g.x * a.x; x.y += g.y * a.y; x.z += g.z * a.z; x.w += g.w * a.w; *d = x; });
  }
}
DI void phase_wout(const Params& p, int l, bool with_ctx, char* smem) {
  const int nbig = (NX_ / 256) * 8, nsmall = with_ctx ? (NC_ / 128) * 8 : 0;
  for (int it = vblock(); it < nbig + nsmall; it += gridDim.x) {
    if (it < nbig) wout_tile<G2>(p, l, (it >> 3) * 256, (it & 7) * 128, smem);
    else { const int i2 = it - nbig; wout_tile<G128>(p, l, NX_ + (i2 >> 3) * 128, (i2 & 7) * 128, smem); }
  }
  TSB(p, 66);
  cvt_run([&](int i) { return cvt_moe_dec(p, l, i); }, (int)gridDim.x - 1 - vblock(), CVT_MOE_TILES, gridDim.x, smem);
  TSB(p, 67);
}

typedef Gemm<128, 64, 64, 4, 2> GRT;
DI void phase_router(const Params& p, int l, bool with_ctx, char* smem, int* cnt) {
  float* xs = (float*)(p.ws + OFF_XS);
  bf16_t* H = (bf16_t*)(p.ws + OFF_H);
  const float* mod = (const float*)(p.ws + OFF_MOD) + (size_t)l * 3 * 6144;
  const bf16_t* Wr = (const bf16_t*)(p.ws + OFF_WMIX + (size_t)l * WM_SIZE + WM_RT);
  int* eidx = (int*)(p.ws + OFF_REGION + R_EIDX);
  float* ewt = (float*)(p.ws + OFF_REGION + R_EWT);
  int* erank = (int*)(p.ws + OFF_REGION + R_ERANK);
  int* elist = (int*)(p.ws + OFF_REGION + R_ELIST);
  float* sc = (float*)(smem + GRT::SMEM);
  float* bs = sc + 128 * 65;
  float* gs = bs + 128 * 65;
  int* lcnt = (int*)(gs + 128 * 9);
  int* lbase = lcnt + 64;
  const int tid = opaque_tid(), lane = tid & 63, wid = tid >> 6;
  const int ntok = with_ctx ? NT_ : NX_;
  for (int it = blockIdx.x; it < ntok / 128; it += gridDim.x) {
    const int n0 = it * 128;
    __syncthreads();
    TSB(p, 40);
    if (tid < 64) lcnt[tid] = 0;
    {
      const float* mrow = mod + (size_t)tok_modrow(n0) * 6144;
      float gsc[16], shf[16];
#pragma unroll
      for (int j = 0; j < 4; ++j) {
        const int c = (j * 64 + lane) * 4;
        const float4 gg = *(const float4*)(p.g_ffn + (size_t)l * 1024 + c), sh = *(const float4*)(mrow + 3 * 1024 + c), sc4 = *(const float4*)(mrow + 4 * 1024 + c);
        gsc[j * 4] = gg.x * (1.f + sc4.x); gsc[j * 4 + 1] = gg.y * (1.f + sc4.y); gsc[j * 4 + 2] = gg.z * (1.f + sc4.z); gsc[j * 4 + 3] = gg.w * (1.f + sc4.w);
        shf[j * 4] = sh.x; shf[j * 4 + 1] = sh.y; shf[j * 4 + 2] = sh.z; shf[j * 4 + 3] = sh.w;
      }
      float va[4][16], vb[4][16];
#define RT_LOAD(v_, r4_) { _Pragma("unroll") for (int u = 0; u < 4; ++u) { const float* src_ = xs + (size_t)(n0 + wid * 16 + (r4_) + u) * 1024 + lane * 4; \
        _Pragma("unroll") for (int j = 0; j < 4; ++j) { const float4 t = *(const float4*)(src_ + j * 256); \
          v_[u][j * 4] = t.x; v_[u][j * 4 + 1] = t.y; v_[u][j * 4 + 2] = t.z; v_[u][j * 4 + 3] = t.w; } } }
#define RT_NORM(v_, r4_) { _Pragma("unroll") for (int u = 0; u < 4; ++u) { \
        float ss = 0.f; _Pragma("unroll") for (int i = 0; i < 16; ++i) ss += v_[u][i] * v_[u][i]; \
        const float rs = frsq(wave_sum(ss) * (1.f / 1024.f) + 1e-6f); \
        bf16_t* hrow = H + (size_t)(n0 + wid * 16 + (r4_) + u) * 1024 + lane * 4; \
        _Pragma("unroll") for (int j = 0; j < 4; ++j) { uint2 o; \
          o.x = pack2bf(v_[u][j * 4] * rs * gsc[j * 4] + shf[j * 4], v_[u][j * 4 + 1] * rs * gsc[j * 4 + 1] + shf[j * 4 + 1]); \
          o.y = pack2bf(v_[u][j * 4 + 2] * rs * gsc[j * 4 + 2] + shf[j * 4 + 2], v_[u][j * 4 + 3] * rs * gsc[j * 4 + 3] + shf[j * 4 + 3]); \
          *(uint2*)(hrow + j * 256) = o; } } }
      RT_LOAD(va, 0);
      RT_LOAD(vb, 4); sched_fence(); RT_NORM(va, 0);
      RT_LOAD(va, 8); sched_fence(); RT_NORM(vb, 4);
      RT_LOAD(vb, 12); sched_fence(); RT_NORM(va, 8);
      RT_NORM(vb, 12);
#undef RT_LOAD
#undef RT_NORM
    }
    __syncthreads();
    TSB(p, 41);
    f32x16 acc[1][1]; acc[0][0] = zero16();
    const bf16_t* A0 = H + (size_t)n0 * 1024;
    GRT::run(acc, [&](int r) { return A0 + (size_t)r * 1024; }, Wr, 1024, 1024, smem);
    {
      const int col = GRT::col_of(tid, 0);
      const float rb = p.router_bias[l * 64 + col];
#pragma unroll
      for (int e = 0; e < 16; ++e) {
        const int row = GRT::row_of(tid, 0, e);
        const float s = sigmoidf_(acc[0][0][e]);
        sc[row * 65 + col] = s; bs[row * 65 + col] = s + rb;
      }
    }
    __syncthreads();
    TSB(p, 42);
    int sel[8]; float wsum = 0.f;
    const int tok = tid >> 2, q4 = tid & 3;
    {
      float b[16];
#pragma unroll
      for (int j = 0; j < 16; ++j) b[j] = bs[tok * 65 + q4 * 16 + j];
      float gsc[2];
#pragma unroll
      for (int g = 0; g < 2; ++g) {
        float m1 = -1e30f, m2 = -1e30f;
#pragma unroll
        for (int j = 0; j < 8; ++j) { const float x = b[g * 8 + j]; if (x > m1) { m2 = m1; m1 = x; } else if (x > m2) m2 = x; }
        gsc[g] = m1 + m2;
      }
      const float ga[8] = {qbcast<0>(gsc[0]), qbcast<0>(gsc[1]), qbcast<1>(gsc[0]), qbcast<1>(gsc[1]), qbcast<2>(gsc[0]), qbcast<2>(gsc[1]), qbcast<3>(gsc[0]), qbcast<3>(gsc[1])};
#pragma unroll
      for (int g = 0; g < 2; ++g) {
        const int gi = q4 * 2 + g; int beat = 0;
#pragma unroll
        for (int gj = 0; gj < 8; ++gj) beat += (ga[gj] > gsc[g] || (ga[gj] == gsc[g] && gj < gi)) ? 1 : 0;
        if (beat >= 4) {
#pragma unroll
          for (int j = 0; j < 8; ++j) b[g * 8 + j] = -1e30f;
        }
      }
#pragma unroll
      for (int c = 0; c < 8; ++c) {
        float bv = -1e30f; int best = q4 * 16;
#pragma unroll
        for (int j = 0; j < 16; ++j) if (b[j] > bv) { bv = b[j]; best = q4 * 16 + j; }
        { const float ov = lx1(bv); const int oi = lx1i(best); if (ov > bv || (ov == bv && oi < best)) { bv = ov; best = oi; } }
        { const float ov = lx2(bv); const int oi = lx2i(best); if (ov > bv || (ov == bv && oi < best)) { bv = ov; best = oi; } }
#pragma unroll
        for (int j = 0; j < 16; ++j) b[j] = (best == q4 * 16 + j) ? -3e30f : b[j];
        sel[c] = best; wsum += sc[tok * 65 + best];
      }
    }
    const int e0 = q4 == 0 ? sel[0] : q4 == 1 ? sel[2] : q4 == 2 ? sel[4] : sel[6];
    const int e1 = q4 == 0 ? sel[1] : q4 == 1 ? sel[3] : q4 == 2 ? sel[5] : sel[7];
    const int lr0 = atomicAdd(lcnt + e0, 1), lr1 = atomicAdd(lcnt + e1, 1);
    __syncthreads();
    if (tid < 64) { const int c = lcnt[tid]; lbase[tid] = c ? atomicAdd(cnt + tid * 32, c) : 0; }
    __syncthreads();
    {
      const int n = n0 + tok;
      const float inv = 2.5f / (wsum + 1e-20f);
      const int c0 = q4 * 2;
      const int rk0 = lbase[e0] + lr0, rk1 = lbase[e1] + lr1;
      eidx[n * 8 + c0] = e0; ewt[n * 8 + c0] = sc[tok * 65 + e0] * inv; erank[n * 8 + c0] = rk0; elist[(size_t)e0 * NT_ + rk0] = n * 8 + c0;
      eidx[n * 8 + c0 + 1] = e1; ewt[n * 8 + c0 + 1] = sc[tok * 65 + e1] * inv; erank[n * 8 + c0 + 1] = rk1; elist[(size_t)e1 * NT_ + rk1] = n * 8 + c0 + 1;
    }
    __syncthreads();
    TSB(p, 43);
  }
}

typedef Gemm<128, 256, 32, 2, 4> GMOE;
constexpr int ACT_LD = 264;
constexpr int MOE_DN_BK = 64, MOE_DN_LD = 72, MOE_DN_STG = 256 * MOE_DN_LD * 2;
constexpr int MOE_ACT_OFF = 2 * MOE_DN_STG;
static_assert(GMOE::SMEM <= MOE_ACT_OFF, "gate/up staging must stay below the act image");
constexpr int MOE_INFO_OFF = MOE_ACT_OFF + 128 * ACT_LD * 2;
static_assert(MOE_INFO_OFF + 128 * 8 + 67 * 4 * 2 <= 160 * 1024 - 32, "moe lds");
DI void moe_down_run(f32x16 (&acc)[GMOE::MB][GMOE::NB], const char* actl, const bf16_t* Bt, char* smem) {
  constexpr int BK = MOE_DN_BK, LDB = MOE_DN_LD, NCH = 4, KS = 4, STG = MOE_DN_STG, nk = 256 / BK;
  const int tid = opaque_tid(), lane = tid & 63, wid = tid >> 6, wm = wid / 4, wn = wid % 4;
  const int kc = (tid & 7) * 8, r0 = tid >> 3;
  const bf16_t* bp0 = Bt + (size_t)r0 * 256 + kc;
  u32x4 s0[NCH], s1[NCH];
#define MD_LOAD(dst_, kt_) { const int kq_ = (kt_) < nk ? (kt_) : nk - 1; _Pragma("unroll") for (int i = 0; i < NCH; ++i) dst_[i] = *(const u32x4*)(bp0 + (size_t)i * 64 * 256 + kq_ * BK); }
#define MD_WRITE1(src_, c_, buf_) { *(u32x4*)(smem + (buf_) * STG + ((r0 + (c_) * 64) * LDB + kc) * 2) = src_[c_]; }
#define MD_STEP(w_, l_, kt_) { \
    MD_LOAD(l_, (kt_) + 2); \
    sched_fence(); \
    const char* Bs = smem + ((kt_) & 1) * STG; \
    _Pragma("unroll") for (int ks = 0; ks < KS; ++ks) { \
      bf16x8 af[GMOE::MB], bfr[GMOE::NB]; \
      _Pragma("unroll") for (int mb = 0; mb < GMOE::MB; ++mb) af[mb] = *(const bf16x8*)(actl + ((wm * 64 + mb * 32 + (lane & 31)) * ACT_LD + (kt_) * BK + ks * 16 + (lane >> 5) * 8) * 2); \
      _Pragma("unroll") for (int nb = 0; nb < GMOE::NB; ++nb) bfr[nb] = *(const bf16x8*)(Bs + ((wn * 64 + nb * 32 + (lane & 31)) * LDB + ks * 16 + (lane >> 5) * 8) * 2); \
      MD_WRITE1(w_, ks, ((kt_) + 1) & 1); \
      _Pragma("unroll") for (int mb = 0; mb < GMOE::MB; ++mb) _Pragma("unroll") for (int nb = 0; nb < GMOE::NB; ++nb) acc[mb][nb] = mfma32(af[mb], bfr[nb], acc[mb][nb]); \
    } \
    sched_fence(); \
    __syncthreads(); }
  MD_LOAD(s0, 0);
#pragma unroll
  for (int c = 0; c < NCH; ++c) MD_WRITE1(s0, c, 0);
  MD_LOAD(s0, 1);
  __syncthreads();
  for (int kt = 0; kt < nk; kt += 2) {
    MD_STEP(s0, s1, kt);
    MD_STEP(s1, s0, kt + 1);
  }
#undef MD_STEP
#undef MD_WRITE1
#undef MD_LOAD
}
DI void phase_moe(const Params& p, int l, bool with_ctx, char* smem, const int* cnt) {
  const bf16_t* H = (const bf16_t*)(p.ws + OFF_H);
  const bf16_t* GU = (const bf16_t*)(p.ws + OFF_REGION + R_WMOE + WE_GU);
  const bf16_t* DN = (const bf16_t*)(p.ws + OFF_REGION + R_WMOE + WE_DN);
  const float* ewt = (const float*)(p.ws + OFF_REGION + R_EWT);
  const int* elist = (const int*)(p.ws + OFF_REGION + R_ELIST);
  bf16_t* ybuf = (bf16_t*)(p.ws + OFF_REGION + R_YBUF);
  char* actl = smem + MOE_ACT_OFF;
  int* rtok = (int*)(smem + MOE_INFO_OFF);
  float* rwt = (float*)(rtok + 128);
  int* pre = (int*)(rwt + 128);
  int* off = pre + 67;
  int tid = threadIdx.x;
  const int ntok = with_ctx ? NT_ : NX_;
  __syncthreads();
  { const int t0 = opaque_tid(); if (t0 < 65) off[t0] = t0 < 64 ? cnt[t0 * 32] : ntok; }
  __syncthreads();
  if (tid == 0) {
    int a = 0, o = 0;
    for (int e = 0; e < 65; ++e) { const int c = off[e]; pre[e] = a; off[e] = o; a += (c + 127) >> 7; o += c; }
    pre[65] = a; off[65] = o;
  }
  __syncthreads();
  const int total = pre[65];
  for (int it = vblock(); it < total; it += gridDim.x) {
    tid = opaque_tid();
    int e0 = 0;
    while (pre[e0 + 1] <= it) ++e0;
    const int e = rfl(e0);
    const int rb = rfl(it - pre[e]);
    const int c = rfl(e < 64 ? cnt[e * 32] : ntok);
    const int obase = rfl(off[e] + rb * 128);
    __syncthreads();
    if (tid < 128) {
      const int slot = rb * 128 + tid;
      int tok = 0; float w = 0.f;
      if (slot < c) {
        if (e < 64) { const int pk = elist[(size_t)e * NT_ + slot]; tok = pk >> 3; w = ewt[pk]; }
        else { tok = slot; w = 1.f; }
      }
      rtok[tid] = tok; rwt[tid] = w;
    }
    __syncthreads();
    const bf16_t* Wgu = GU + (size_t)e * 512 * 1024;
#pragma unroll 1
    for (int hf = 0; hf < 2; ++hf) {
      f32x16 acc[GMOE::MB][GMOE::NB];
#pragma unroll
      for (int a = 0; a < GMOE::MB; ++a)
#pragma unroll
        for (int b = 0; b < GMOE::NB; ++b) acc[a][b] = zero16();
      GMOE::run(acc, [&](int r) { return H + (size_t)rtok[r] * 1024; }, Wgu + (size_t)hf * 256 * 1024, 1024, 1024, smem);
      const int lane = tid & 63, wn = (tid >> 6) % 4, wmr = ((tid >> 6) / 4) * 64 + 4 * (lane >> 5);
      const int j = (hf * 4 + wn) * 32 + (lane & 31);
#pragma unroll
      for (int mb = 0; mb < GMOE::MB; ++mb)
#pragma unroll
        for (int i = 0; i < 16; ++i) {
          const int row = wmr + mb * 32 + (i & 3) + 8 * (i >> 2);
          const float g = acc[mb][0][i], u = acc[mb][1][i];
          *(bf16_t*)(actl + (row * ACT_LD + j) * 2) = f2bf(siluf_(g) * u);
        }
    }
    __syncthreads();
    const bf16_t* Wd = DN + (size_t)e * 1024 * 256;
#pragma unroll 1
    for (int nt = 0; nt < 4; ++nt) {
      f32x16 acc[GMOE::MB][GMOE::NB];
#pragma unroll
      for (int a = 0; a < GMOE::MB; ++a)
#pragma unroll
        for (int b = 0; b < GMOE::NB; ++b) acc[a][b] = zero16();
      moe_down_run(acc, actl, Wd + (size_t)nt * 256 * 256, smem);
      {
        const int lane = tid & 63, wid = tid >> 6, wm = wid / 4, wn = wid % 4;
        float* scr = (float*)(smem + wid * WTile<1>::BYTES);
#pragma unroll
        for (int mb = 0; mb < GMOE::MB; ++mb)
#pragma unroll
          for (int nb = 0; nb < GMOE::NB; ++nb) {
            WTile<1>::put(scr, 0, lane, acc[mb][nb]);
            const int row0 = wm * 64 + mb * 32, col0 = nt * 256 + wn * 64 + nb * 32;
            WTile<1>::rows8(scr, lane, [&](int r, int cq, const float4& a, const float4& bq) {
              const int row = row0 + r;
              if (rb * 128 + row < c) {
                const float w = rwt[row];
                const float4 a2 = make_float4(a.x * w, a.y * w, a.z * w, a.w * w), b2 = make_float4(bq.x * w, bq.y * w, bq.z * w, bq.w * w);
                *(uint4*)(ybuf + ((size_t)obase + row) * 1024 + col0 + cq) = pack8bf(a2, b2);
              } });
          }
        __syncthreads();
      }
    }
  }
}

DI void phase_combine(const Params& p, int l, bool last, char* smem, const int* cnt) {
  float* xs = (float*)(p.ws + OFF_XS);
  bf16_t* H = (bf16_t*)(p.ws + OFF_H);
  const float* mod = (const float*)(p.ws + OFF_MOD);
  const int* eidx = (const int*)(p.ws + OFF_REGION + R_EIDX);
  const int* erank = (const int*)(p.ws + OFF_REGION + R_ERANK);
  const bf16_t* ybuf = (const bf16_t*)(p.ws + OFF_REGION + R_YBUF);
  int* off = (int*)smem;
  const int tid = opaque_tid(), lane = tid & 63, wid = tid >> 6;
  const int ntok = last ? NX_ : NT_;
  __syncthreads();
  if (tid < 64) off[tid] = cnt[tid * 32];
  __syncthreads();
  if (tid == 0) { int o = 0; for (int e = 0; e < 64; ++e) { const int c = off[e]; off[e] = o; o += c; } off[64] = o; }
  __syncthreads();
  for (int n = blockIdx.x * 8 + wid; n < ntok; n += gridDim.x * 8) {
    float acc[16];
#pragma unroll
    for (int i = 0; i < 16; ++i) acc[i] = 0.f;
    const int4 e0 = *(const int4*)(eidx + n * 8), e1 = *(const int4*)(eidx + n * 8 + 4);
    const int4 r0 = *(const int4*)(erank + n * 8), r1 = *(const int4*)(erank + n * 8 + 4);
    const int rows[9] = {off[e0.x] + r0.x, off[e0.y] + r0.y, off[e0.z] + r0.z, off[e0.w] + r0.w,
                         off[e1.x] + r1.x, off[e1.y] + r1.y, off[e1.z] + r1.z, off[e1.w] + r1.w, off[64] + n};
    uint2 u[9][4];
#pragma unroll
    for (int k = 0; k < 9; ++k)
#pragma unroll
      for (int j = 0; j < 4; ++j) u[k][j] = *(const uint2*)(ybuf + (size_t)rows[k] * 1024 + (j * 64 + lane) * 4);
#pragma unroll
    for (int k = 0; k < 9; ++k)
#pragma unroll
      for (int j = 0; j < 4; ++j) {
        acc[j * 4 + 0] += bf2f((bf16_t)(u[k][j].x & 0xffff)); acc[j * 4 + 1] += bf2f((bf16_t)(u[k][j].x >> 16));
        acc[j * 4 + 2] += bf2f((bf16_t)(u[k][j].y & 0xffff)); acc[j * 4 + 3] += bf2f((bf16_t)(u[k][j].y >> 16));
      }
    const float* m5 = mod + ((size_t)l * 3 + tok_modrow(n)) * 6144 + 5 * 1024;
    float v[16];
#pragma unroll
    for (int j = 0; j < 4; ++j) {
      const int c = (j * 64 + lane) * 4;
      const float4 x = *(const float4*)(xs + (size_t)n * 1024 + c), g = *(const float4*)(m5 + c);
      v[j * 4 + 0] = x.x + g.x * acc[j * 4 + 0]; v[j * 4 + 1] = x.y + g.y * acc[j * 4 + 1];
      v[j * 4 + 2] = x.z + g.z * acc[j * 4 + 2]; v[j * 4 + 3] = x.w + g.w * acc[j * 4 + 3];
      if (!last) *(float4*)(xs + (size_t)n * 1024 + c) = make_float4(v[j * 4], v[j * 4 + 1], v[j * 4 + 2], v[j * 4 + 3]);
    }
    if (!last) {
      const float* m = mod + ((size_t)(l + 1) * 3 + tok_modrow(n)) * 6144;
      row_norm_mod(v, p.g_mix + (size_t)(l + 1) * 1024, m, m + 1024, H + (size_t)n * 1024, lane);
    } else {
      float ss = 0.f;
#pragma unroll
      for (int i = 0; i < 16; ++i) ss += v[i] * v[i];
      ss = wave_sum(ss);
      const float rs = frsq(ss * (1.f / 1024.f) + 1e-6f);
#pragma unroll
      for (int j = 0; j < 4; ++j) {
        const int c = (j * 64 + lane) * 4;
        const float4 g = *(const float4*)(p.g_final + c);
        *(float4*)(p.out + (size_t)n * 1024 + c) = make_float4(v[j * 4] * rs * g.x, v[j * 4 + 1] * rs * g.y, v[j * 4 + 2] * rs * g.z, v[j * 4 + 3] * rs * g.w);
      }
    }
  }
}
#define SMEM_BYTES (160 * 1024)
#ifndef MEGA
#define MEGA 0
#endif
DI int* cnt_ptr(const Params& p, int l) { return (int*)(p.ws + OFF_CNT) + 1024 + 2048 * l; }
DI int* ctr_ptr(const Params& p, int l) { return (int*)(p.ws + OFF_CNT) + 32 * l; }
#if !MEGA
__global__ void __launch_bounds__(NTHR) k_phaseA(Params p) { SMEM_DECL(smem, SMEM_BYTES); phaseA(p, smem); }
__global__ void __launch_bounds__(NTHR) k_norm0(Params p) { phase_norm0(p); }
__global__ void __launch_bounds__(NTHR) k_win(Params p, int l) { SMEM_DECL(smem, SMEM_BYTES); phase_win(p, l, smem); }
__global__ void __launch_bounds__(NTHR) k_p3(Params p, int l) { SMEM_DECL(smem, SMEM_BYTES); phase3(p, l, smem); }
__global__ void __launch_bounds__(NTHR) k_p3b(Params p, int l) { SMEM_DECL(smem, SMEM_BYTES); phase3b(p, l, smem, ctr_ptr(p, l)); }
__global__ void __launch_bounds__(NTHR) k_p4(Params p, int l) { SMEM_DECL(smem, SMEM_BYTES); phase4(p, l, smem, ctr_ptr(p, l)); }
__global__ void __launch_bounds__(NTHR) k_p5(Params p, int l, int wc) { SMEM_DECL(smem, SMEM_BYTES); phase5(p, l, wc != 0, smem); }
__global__ void __launch_bounds__(NTHR) k_merge(Params p, int l, int wc) { SMEM_DECL(smem, SMEM_BYTES); phase_merge(p, l, wc != 0, smem); }
__global__ void __launch_bounds__(NTHR) k_wout(Params p, int l, int wc) { SMEM_DECL(smem, SMEM_BYTES); phase_wout(p, l, wc != 0, smem); }
__global__ void __launch_bounds__(NTHR) k_router(Params p, int l, int wc) { SMEM_DECL(smem, SMEM_BYTES); phase_router(p, l, wc != 0, smem, cnt_ptr(p, l)); }
__global__ void __launch_bounds__(NTHR) k_moe(Params p, int l, int wc) { SMEM_DECL(smem, SMEM_BYTES); phase_moe(p, l, wc != 0, smem, cnt_ptr(p, l)); }
__global__ void __launch_bounds__(NTHR) k_combine(Params p, int l, int last) { SMEM_DECL(smem, SMEM_BYTES); phase_combine(p, l, last != 0, smem, cnt_ptr(p, l)); }
#else
#ifndef EMU
#define XB_TMO      128
#define XB_XCNT(j)  (256  + 64 * (j))
#define XB_XSUB(j)  (1280 + 64 * (j))
#define XB_XGEN(j)  (2304 + 64 * (j))
#define XB_TOP      3328
#define XB_TOPGEN   3392
#define XCD_BAR_WORDS 3456
#define XB_SPIN_CAP (1u << 24)
#define LAS __attribute__((address_space(3)))
DI unsigned xb_ld(unsigned* p) { return __hip_atomic_load(p, __ATOMIC_RELAXED, __HIP_MEMORY_SCOPE_AGENT); }
DI unsigned xb_add(unsigned* p, unsigned v) { return __hip_atomic_fetch_add(p, v, __ATOMIC_RELAXED, __HIP_MEMORY_SCOPE_AGENT); }
DI unsigned xb_xcc_id() { return (unsigned)__builtin_amdgcn_s_getreg((3 << 11) | 20) & 0xFu; }
#define XB_SPIN(cond, bar) do { unsigned _sp = 0; while (cond) { __builtin_amdgcn_s_sleep(1); \
    if ((++_sp & 255u) == 0u) { if (xb_ld(&(bar)[XB_TMO])) break; if (_sp > XB_SPIN_CAP) { atomicAdd(&(bar)[XB_TMO], 1u); break; } } } } while (0)
struct XcdBarrier { unsigned* bar; unsigned x; volatile LAS unsigned* st; };
DI XcdBarrier xcd_barrier_post(unsigned* bar, volatile LAS unsigned* st) {
  XcdBarrier b; b.bar = bar; b.x = xb_xcc_id(); b.st = st;
  if (threadIdx.x == 0) (void)xb_add(&bar[XB_XCNT(b.x)], 1u);
  return b;
}
DI void xcd_barrier_complete(unsigned* bar, unsigned x, unsigned& nloc, unsigned& nx) {
  const unsigned G = gridDim.x * gridDim.y * gridDim.z;
  unsigned sum, cnt, mine, sp = 0u;
  for (;;) {
    sum = 0u; cnt = 0u; mine = 0u;
#pragma unroll
    for (unsigned j = 0; j < 16; ++j) { const unsigned c = xb_ld(&bar[XB_XCNT(j)]); sum += c; cnt += (c > 0u) ? 1u : 0u; mine = (j == x) ? c : mine; }
    if (sum == G) break;
    __builtin_amdgcn_s_sleep(1);
    if ((++sp & 255u) == 0u) { if (xb_ld(&bar[XB_TMO])) break; if (sp > XB_SPIN_CAP) { atomicAdd(&bar[XB_TMO], 1u); break; } }
  }
  nloc = mine > 0u ? mine : 1u; nx = cnt > 0u ? cnt : 1u;
}
DI void xcd_barrier(const XcdBarrier& b) {
  asm volatile("s_waitcnt vmcnt(0)" ::: "memory");
  __syncthreads();
  if (threadIdx.x == 0) {
    unsigned* bar = b.bar;
    __builtin_amdgcn_s_waitcnt(0);
    unsigned nloc = b.st[0], nx = b.st[1];
    if (nloc == 0u) { xcd_barrier_complete(bar, b.x, nloc, nx); b.st[0] = nloc; b.st[1] = nx; }
    const unsigned old = xb_add(&bar[XB_XSUB(b.x)], 1u);
    const unsigned gen = old / nloc;
    if (old + 1u == (gen + 1u) * nloc) {
      __builtin_amdgcn_fence(__ATOMIC_RELEASE, "agent");
      asm volatile("s_waitcnt vmcnt(0)" ::: "memory");
      const unsigned og = xb_add(&bar[XB_TOP], 1u);
      const unsigned tg = og / nx;
      if (og + 1u == (tg + 1u) * nx) xb_add(&bar[XB_TOPGEN], 1u);
      else XB_SPIN(xb_ld(&bar[XB_TOPGEN]) == tg, bar);
      __builtin_amdgcn_fence(__ATOMIC_ACQUIRE, "agent");
      xb_add(&bar[XB_XGEN(b.x)], 1u);
      asm volatile("s_waitcnt vmcnt(0)" ::: "memory");
    } else {
      XB_SPIN(xb_ld(&bar[XB_XGEN(b.x)]) == gen, bar);
      __builtin_amdgcn_fence(__ATOMIC_ACQUIRE, "agent");
      asm volatile("s_waitcnt vmcnt(0)" ::: "memory");
    }
  }
  __syncthreads();
}
#define GSYNC() { XcdBarrier xb_; xb_.bar = (unsigned*)(p.ws + OFF_BAR); xb_.x = xb_xcc_id(); xb_.st = (volatile LAS unsigned*)(smem + SMEM_BYTES - 32); xcd_barrier(xb_); }
#else
#define GSYNC() emu::grid_barrier()
#endif
#ifdef PROBE_IDX
#define TS(i) { if (blockIdx.x == 0 && threadIdx.x == 0) ts[i] = wall_clock64(); }
#else
#define TS(i)
#endif
__global__ void __launch_bounds__(NTHR) k_mega(Params p) {
  SMEM_DECL(smem, SMEM_BYTES);
  cooperative_groups::grid_group grid = cooperative_groups::this_grid();
  volatile LAS unsigned* xst = (volatile LAS unsigned*)(smem + SMEM_BYTES - 32);
  if (threadIdx.x == 0) { xst[0] = 0u; xst[1] = 0u; }
  __syncthreads();
  (void)xcd_barrier_post((unsigned*)(p.ws + OFF_BAR), xst);
#ifdef PROBE_IDX
  long long* ts = (long long*)(p.ws + OFF_CNT + 2048);
#endif
  TS(0);
  phaseA(p, smem);
  grid.sync(); TS(1);
  phase_norm0(p);
  GSYNC(); TS(2);
#pragma unroll 1
  for (int l = 0; l < 2; ++l) {
    const bool wc = l == 0;
    phase_win(p, l, smem); GSYNC(); TS(3 + l * 10);
    phase3(p, l, smem); GSYNC(); TS(4 + l * 10);
    phase3b(p, l, smem, ctr_ptr(p, l)); GSYNC(); TS(5 + l * 10);
    phase4(p, l, smem, ctr_ptr(p, l)); GSYNC(); TS(6 + l * 10);
    phase5(p, l, wc, smem); GSYNC(); TS(7 + l * 10);
    phase_merge(p, l, wc, smem); GSYNC(); TS(8 + l * 10);
    phase_wout(p, l, wc, smem); GSYNC(); TS(9 + l * 10);
    phase_router(p, l, wc, smem, cnt_ptr(p, l)); GSYNC(); TS(10 + l * 10);
    phase_moe(p, l, wc, smem, cnt_ptr(p, l)); GSYNC(); TS(11 + l * 10);
    phase_combine(p, l, l == 1, smem, cnt_ptr(p, l));
#ifdef PROBE_IDX
    GSYNC(); TS(12 + l * 10);
#else
    if (l == 0) GSYNC();
#endif
  }
#ifdef PROBE_IDX
  if (blockIdx.x == 0 && threadIdx.x == 0) {
    const float us = (float)(ts[PROBE_IDX + 1] - ts[PROBE_IDX]) * 0.01f;
    p.out[0] += PROBE_IDX >= 40 ? rintf(6.f * log2f(fmaxf(us * 16.f, 1.f))) : rintf(6.f * log2f(fmaxf(us, 1.f)));
  }
#endif
}
#endif

extern "C" void kernel_launch(void* const* d_in, const int* in_sizes, int n_in, void* d_out, int out_size, void* d_ws,
                              size_t ws_size, hipStream_t stream) {
  Params p{};
  const float** pp = (const float**)&p;
  for (int i = 0; i < 41; ++i) pp[i] = (const float*)d_in[i];
  p.out = (float*)d_out; p.ws = (char*)d_ws; p.osc = (char*)d_out;
  if (ws_size < WS_NEEDED) { fprintf(stderr, "workspace too small: %zu < %zu\n", ws_size, (size_t)WS_NEEDED); return; }
#if !MEGA
  const dim3 g(256), b(NTHR);
  hipLaunchKernelGGL(k_phaseA, g, b, 0, stream, p);
  hipLaunchKernelGGL(k_norm0, g, b, 0, stream, p);
  for (int l = 0; l < 2; ++l) {
    const int wc = l == 0;
    hipLaunchKernelGGL(k_win, g, b, 0, stream, p, l);
    hipLaunchKernelGGL(k_p3, g, b, 0, stream, p, l);
    hipLaunchKernelGGL(k_p3b, g, b, 0, stream, p, l);
    hipLaunchKernelGGL(k_p4, g, b, 0, stream, p, l);
    hipLaunchKernelGGL(k_p5, g, b, 0, stream, p, l, wc);
    hipLaunchKernelGGL(k_merge, g, b, 0, stream, p, l, wc);
    hipLaunchKernelGGL(k_wout, g, b, 0, stream, p, l, wc);
    hipLaunchKernelGGL(k_router, g, b, 0, stream, p, l, wc);
    hipLaunchKernelGGL(k_moe, g, b, 0, stream, p, l, wc);
    hipLaunchKernelGGL(k_combine, g, b, 0, stream, p, l, l == 1);
  }
#else
  static int grid_blocks = 0;
  if (!grid_blocks) {
    int dev = 0, cus = 0, per_cu = 0;
    hipGetDevice(&dev);
    hipDeviceGetAttribute(&cus, hipDeviceAttributeMultiprocessorCount, dev);
    hipOccupancyMaxActiveBlocksPerMultiprocessor(&per_cu, k_mega, NTHR, 0);
    if (per_cu > 1) per_cu = 1;
    grid_blocks = cus * per_cu;
  }
  hipMemsetAsync(p.ws + OFF_BAR, 0, 16384, stream);
  void* args[] = {&p};
  hipError_t e = hipLaunchCooperativeKernel((void*)k_mega, dim3(grid_blocks), dim3(NTHR), args, 0, stream);
  if (e != hipSuccess) fprintf(stderr, "cooperative launch failed: %s (grid %d)\n", hipGetErrorString(e), grid_blocks);
#endif
}
```
